# Optimizing an MI355X kernel written in HIP

```python
import math
import jax
import jax.numpy as jnp
from jax import lax
import numpy as np

D_MODEL = 1024
BATCH = 4
SEQ = 4096
DEPTH = 2

GRID_W = 64
CTX_LEN = 256
EPS = 1e-6
N_MOD = 6

MLA_HEADS = 4
Q_LORA = 256
KV_LORA = 128
QK_NOPE = 64
QK_ROPE = 32
V_HEAD = 64
MLA_WIDTH = MLA_HEADS * V_HEAD
MLA_SCALE = (QK_NOPE + QK_ROPE) ** -0.5
ROPE_THETA = 10000.0
Q_BLOCK = 128

SC_WIDTH = 256
SC_KERNEL = 3

SSD_HEADS = 8
SSD_HEAD_DIM = 64
SSD_WIDTH = SSD_HEADS * SSD_HEAD_DIM
SSD_GROUPS = 2
SSD_STATE = 64
SSD_CONV = 3
SSD_CHUNK = 128
SSD_GN = SSD_GROUPS * SSD_STATE
SSD_XBC = SSD_WIDTH + 2 * SSD_GN

D_MIX = MLA_WIDTH + SC_WIDTH + SSD_WIDTH
IN_MLA = Q_LORA + KV_LORA + QK_ROPE
IN_SC = 3 * SC_WIDTH
IN_SSD = SSD_WIDTH + SSD_XBC + 2 * SSD_HEADS
D_IN = IN_MLA + IN_SC + IN_SSD
D_FF = 4 * D_MODEL

kernel_name = 'hybrid_mla_shortconv_ssd_dit_block'


def _rms_norm(x, g):
    xf = x.astype(jnp.float32)
    y = xf * lax.rsqrt(jnp.mean(xf * xf, axis=-1, keepdims=True) + EPS)
    return (y * g.astype(jnp.float32)).astype(x.dtype)


def _modulate(h, shift, scale):
    return h * (1 + scale) + shift


def _dwconv(x, w):
    k = w.shape[0]
    return lax.conv_general_dilated(
        x, w[:, None, :].astype(x.dtype), window_strides=(1,),
        padding=[(k // 2, k // 2)], dimension_numbers=('NWC', 'WIO', 'NWC'),
        feature_group_count=x.shape[-1])


def _axial_rope_tables(rows):
    half = QK_ROPE // 2
    inv_freq = ROPE_THETA ** (-jnp.arange(0, half, 2, dtype=jnp.float32) / half)
    row = jnp.repeat(jnp.arange(rows, dtype=jnp.float32), GRID_W)
    col = jnp.tile(jnp.arange(GRID_W, dtype=jnp.float32), rows)
    ang_r = row[:, None] * inv_freq
    ang_c = col[:, None] * inv_freq
    ang = jnp.concatenate([ang_r, ang_r, ang_c, ang_c], axis=-1)
    return jnp.cos(ang), jnp.sin(ang)


def _apply_rope(x, cos, sin):
    xf = x.astype(jnp.float32)
    a, b, c, d = jnp.split(xf, 4, axis=-1)
    rot = jnp.concatenate([-b, a, -d, c], axis=-1)
    return (xf * cos + rot * sin).astype(x.dtype)


def _split_in(u):
    return u[..., :IN_MLA], u[..., IN_MLA:IN_MLA + IN_SC], u[..., IN_MLA + IN_SC:]


def _mla_kv(u, kv_g, w_ukv, rope):
    b, l, _ = u.shape
    ckv = _rms_norm(u[..., Q_LORA:Q_LORA + KV_LORA], kv_g)
    kv = (ckv @ w_ukv).reshape(b, l, MLA_HEADS, QK_NOPE + V_HEAD)
    k_nope, v = kv[..., :QK_NOPE], kv[..., QK_NOPE:]
    k_rope = u[..., Q_LORA + KV_LORA:]
    if rope is not None:
        k_rope = _apply_rope(k_rope, rope[0], rope[1])
    k_rope = jnp.broadcast_to(k_rope[:, :, None, :], (b, l, MLA_HEADS, QK_ROPE))
    return jnp.concatenate([k_nope, k_rope], axis=-1), v


def _mla_q(u, q_g, w_uq, rope):
    b, l, _ = u.shape
    cq = _rms_norm(u[..., :Q_LORA], q_g)
    q = (cq @ w_uq).reshape(b, l, MLA_HEADS, QK_NOPE + QK_ROPE)
    if rope is not None:
        q_rope = _apply_rope(q[..., QK_NOPE:], rope[0][:, None, :], rope[1][:, None, :])
        q = jnp.concatenate([q[..., :QK_NOPE], q_rope], axis=-1)
    return q


def _softmax_attend(q, k, v):
    s = jnp.einsum('bqhd,bkhd->bhqk', q, k).astype(jnp.float32) * MLA_SCALE
    p = jax.nn.softmax(s, axis=-1).astype(v.dtype)
    return jnp.einsum('bhqk,bkhd->bqhd', p, v)


def _blocked_attention(q, k, v):
    b, l, h, d = q.shape
    nb = l // Q_BLOCK
    qb = q.reshape(b, nb, Q_BLOCK, h, d).transpose(1, 0, 2, 3, 4)
    o = lax.map(lambda qi: _softmax_attend(qi, k, v), qb)
    return o.transpose(1, 0, 2, 3, 4).reshape(b, l, h * V_HEAD)


def _short_conv(u, w):
    gate_b, gate_c, val = jnp.split(u, 3, axis=-1)
    return gate_b * _dwconv(gate_c * val, w)


def _segsum_exp(cs):
    t = cs.shape[-1]
    diff = cs[..., :, None] - cs[..., None, :]
    mask = jnp.tril(jnp.ones((t, t), dtype=bool))
    return jnp.exp(jnp.where(mask, diff, -jnp.inf))


def _ssd_chunked(xs, dt, a, bm, cm, h0):
    b, l, h, p = xs.shape
    nc = l // SSD_CHUNK
    rep = h // SSD_GROUPS
    f32 = jnp.float32
    xdt = (xs.astype(f32) * dt[..., None]).reshape(b, nc, SSD_CHUNK, h, p)
    bc = jnp.repeat(bm.astype(f32), rep, axis=2).reshape(b, nc, SSD_CHUNK, h, SSD_STATE)
    cc = jnp.repeat(cm.astype(f32), rep, axis=2).reshape(b, nc, SSD_CHUNK, h, SSD_STATE)
    la = (dt * a).reshape(b, nc, SSD_CHUNK, h).transpose(0, 3, 1, 2)
    cs = jnp.cumsum(la, axis=-1)
    scores = jnp.einsum('bclhn,bcshn->bhcls', cc, bc) * _segsum_exp(cs)
    y_diag = jnp.einsum('bhcls,bcshp->bclhp', scores, xdt)
    decay_states = jnp.exp(cs[..., -1:] - cs).transpose(0, 2, 3, 1)
    states = jnp.einsum('bclhn,bclhp->bchpn', bc, xdt * decay_states[..., None])
    states = jnp.concatenate([h0[:, None], states], axis=1)
    chunk_tot = jnp.pad(cs[..., -1], ((0, 0), (0, 0), (1, 0)))
    decay_chunk = _segsum_exp(jnp.cumsum(chunk_tot, axis=-1))
    new_states = jnp.einsum('bhzc,bchpn->bzhpn', decay_chunk, states)
    state_decay = jnp.exp(cs).transpose(0, 2, 3, 1)[..., None]
    y_off = jnp.einsum('bclhn,bchpn->bclhp', cc, new_states[:, :-1]) * state_decay
    y = (y_diag + y_off).reshape(b, l, h, p)
    return y, new_states[:, -1]


def _ssd_prepare(u, conv_w, conv_b, dt_bias):
    b, l, _ = u.shape
    z = u[..., :SSD_WIDTH]
    xbc = jax.nn.silu(_dwconv(u[..., SSD_WIDTH:SSD_WIDTH + SSD_XBC], conv_w) + conv_b)
    xs = xbc[..., :SSD_WIDTH].reshape(b, l, SSD_HEADS, SSD_HEAD_DIM)
    bm = xbc[..., SSD_WIDTH:SSD_WIDTH + SSD_GN].reshape(b, l, SSD_GROUPS, SSD_STATE)
    cm = xbc[..., SSD_WIDTH + SSD_GN:].reshape(b, l, SSD_GROUPS, SSD_STATE)
    dt_raw = u[..., SSD_WIDTH + SSD_XBC:].reshape(b, l, 2, SSD_HEADS).astype(jnp.float32)
    dt = jax.nn.softplus(dt_raw + dt_bias.astype(jnp.float32))
    return z, xs, bm, cm, dt


def _bidir_ssd(xs, bm, cm, dt, a, h0):
    flip = lambda t: jnp.flip(t, axis=1)
    xs2 = jnp.stack([xs, flip(xs)])
    bm2 = jnp.stack([bm, flip(bm)])
    cm2 = jnp.stack([cm, flip(cm)])
    dt2 = jnp.stack([dt[:, :, 0], flip(dt[:, :, 1])])
    y2, h_final = jax.vmap(_ssd_chunked)(xs2, dt2, a, bm2, cm2, h0)
    return y2[0] + flip(y2[1]), h_final


def _ssd_output(y, xs, z, d_skip, norm_g):
    b, l = z.shape[0], z.shape[1]
    y = (y + d_skip.astype(jnp.float32)[:, None] * xs.astype(jnp.float32)).reshape(b, l, SSD_WIDTH)
    g = (y * jax.nn.silu(z.astype(jnp.float32))).reshape(b, l, SSD_GROUPS, SSD_WIDTH // SSD_GROUPS)
    g = g * lax.rsqrt(jnp.mean(g * g, axis=-1, keepdims=True) + EPS)
    return (g.reshape(b, l, SSD_WIDTH) * norm_g.astype(jnp.float32)).astype(z.dtype)


def _ffn_sublayer(x, shift, scale, gate, p):
    h = _modulate(_rms_norm(x, p['g_pre_ffn']), shift, scale)
    f = jnp.square(jax.nn.relu(h @ p['w_ff1'])) @ p['w_ff2']
    return x + gate * _rms_norm(f, p['g_post_ffn'])


def _layer(x, xc, mod, mod_c, rope, need_ctx, p):
    sh1, sc1, g1, sh2, sc2, g2 = jnp.split(mod[:, None, :], N_MOD, axis=-1)
    csh1, csc1, cg1, csh2, csc2, cg2 = jnp.split(mod_c, N_MOD, axis=-1)
    bsz, lc = xc.shape[0], xc.shape[1]

    h = _modulate(_rms_norm(x, p['g_pre_mix']), sh1, sc1)
    hc = _modulate(_rms_norm(xc, p['g_pre_mix']), csh1, csc1)
    ua, us, um = _split_in(h @ p['w_in'])
    uca, ucs, ucm = _split_in(hc @ p['w_in'])

    k, v = _mla_kv(ua, p['mla_kv_norm'], p['w_ukv'], rope)
    kc, vc = _mla_kv(uca, p['mla_kv_norm'], p['w_ukv'], None)
    q = _mla_q(ua, p['mla_q_norm'], p['w_uq'], rope)
    y_att = _blocked_attention(q, jnp.concatenate([kc, k], axis=1), jnp.concatenate([vc, v], axis=1))

    y_sc = _short_conv(us, p['sc_conv_w'])

    a = -jnp.exp(p['ssd_a_log'].astype(jnp.float32))
    zc, xsc, bmc, cmc, dtc = _ssd_prepare(ucm, p['ssd_conv_w'], p['ssd_conv_b'], p['ssd_dt_bias'])
    z, xs, bm, cm, dt = _ssd_prepare(um, p['ssd_conv_w'], p['ssd_conv_b'], p['ssd_dt_bias'])
    h0 = jnp.zeros((2, bsz, SSD_HEADS, SSD_HEAD_DIM, SSD_STATE), jnp.float32)
    yc_scan, h_ctx = _bidir_ssd(xsc, bmc, cmc, dtc, a, h0)
    y_scan, _ = _bidir_ssd(xs, bm, cm, dt, a, h_ctx)
    y_ssd = _ssd_output(y_scan, xs, z, p['ssd_d'], p['ssd_norm'])

    y = jnp.concatenate([y_att, y_sc, y_ssd], axis=-1) @ p['w_out']
    x = x + g1 * _rms_norm(y, p['g_post_mix'])
    x = _ffn_sublayer(x, sh2, sc2, g2, p)

    if need_ctx:
        qc = _mla_q(uca, p['mla_q_norm'], p['w_uq'], None)
        yc_att = _softmax_attend(qc, kc, vc).reshape(bsz, lc, MLA_WIDTH)
        yc_sc = _short_conv(ucs, p['sc_conv_w'])
        yc_ssd = _ssd_output(yc_scan, xsc, zc, p['ssd_d'], p['ssd_norm'])
        yc = jnp.concatenate([yc_att, yc_sc, yc_ssd], axis=-1) @ p['w_out']
        xc = xc + cg1 * _rms_norm(yc, p['g_post_mix'])
        xc = _ffn_sublayer(xc, csh2, csc2, cg2, p)
    return x, xc


def setup_inputs(seed: int = 0) -> dict:
    key = jax.random.key(seed)
    k = jax.random.split(key, 25)
    f32 = jnp.float32
    L = DEPTH

    def nrm(i, shape, scale):
        return jax.random.normal(k[i], shape, f32) * scale

    def gain(i, shape):
        return 1.0 + 0.1 * jax.random.normal(k[i], shape, f32)

    dt0 = jnp.exp(jax.random.uniform(k[16], (L, 2, SSD_HEADS), f32, math.log(1e-3), math.log(1e-1)))
    return {
        'x': nrm(0, (BATCH, SEQ, D_MODEL), 1.0),
        'c': nrm(1, (BATCH, D_MODEL), 1.0),
        'ctx': nrm(2, (BATCH, CTX_LEN, D_MODEL), 1.0),
        'c_ctx': nrm(3, (D_MODEL,), 1.0),
        'w_mod': nrm(4, (L, D_MODEL, N_MOD * D_MODEL), 0.5 * D_MODEL ** -0.5),
        'b_mod': nrm(5, (L, N_MOD * D_MODEL), 0.02),
        'g_pre_mix': gain(6, (L, D_MODEL)),
        'w_in': nrm(7, (L, D_MODEL, D_IN), D_MODEL ** -0.5),
        'mla_q_norm': gain(8, (L, Q_LORA)),
        'w_uq': nrm(9, (L, Q_LORA, MLA_HEADS * (QK_NOPE + QK_ROPE)), Q_LORA ** -0.5),
        'mla_kv_norm': gain(10, (L, KV_LORA)),
        'w_ukv': nrm(11, (L, KV_LORA, MLA_HEADS * (QK_NOPE + V_HEAD)), KV_LORA ** -0.5),
        'sc_conv_w': nrm(12, (L, SC_KERNEL, SC_WIDTH), SC_KERNEL ** -0.5),
        'ssd_conv_w': nrm(13, (L, SSD_CONV, SSD_XBC), SSD_CONV ** -0.5),
        'ssd_conv_b': nrm(14, (L, SSD_XBC), 0.02),
        'ssd_a_log': jnp.log(jax.random.uniform(k[15], (L, 2, SSD_HEADS), f32, 1.0, 16.0)),
        'ssd_dt_bias': dt0 + jnp.log(-jnp.expm1(-dt0)),
        'ssd_d': gain(17, (L, SSD_HEADS)),
        'ssd_norm': gain(18, (L, SSD_WIDTH)),
        'w_out': nrm(19, (L, D_MIX, D_MODEL), D_MIX ** -0.5),
        'g_post_mix': gain(20, (L, D_MODEL)),
        'g_pre_ffn': gain(21, (L, D_MODEL)),
        'w_ff1': nrm(22, (L, D_MODEL, D_FF), D_MODEL ** -0.5),
        'w_ff2': nrm(23, (L, D_FF, D_MODEL), D_FF ** -0.5),
        'g_post_ffn': gain(24, (L, D_MODEL)),
    }


def reference(x, c, ctx, c_ctx, w_mod, b_mod, g_pre_mix, w_in, mla_q_norm, w_uq, mla_kv_norm, w_ukv,
              sc_conv_w, ssd_conv_w, ssd_conv_b, ssd_a_log, ssd_dt_bias, ssd_d, ssd_norm, w_out,
              g_post_mix, g_pre_ffn, w_ff1, w_ff2, g_post_ffn):
    rows = x.shape[1] // GRID_W
    rope = _axial_rope_tables(rows)
    xc = ctx
    s_lat = jax.nn.silu(c)
    s_ctx = jax.nn.silu(c_ctx)
    for i in range(DEPTH):
        p = {
            'g_pre_mix': g_pre_mix[i], 'w_in': w_in[i],
            'mla_q_norm': mla_q_norm[i], 'w_uq': w_uq[i],
            'mla_kv_norm': mla_kv_norm[i], 'w_ukv': w_ukv[i],
            'sc_conv_w': sc_conv_w[i],
            'ssd_conv_w': ssd_conv_w[i], 'ssd_conv_b': ssd_conv_b[i],
            'ssd_a_log': ssd_a_log[i], 'ssd_dt_bias': ssd_dt_bias[i],
            'ssd_d': ssd_d[i], 'ssd_norm': ssd_norm[i],
            'w_out': w_out[i], 'g_post_mix': g_post_mix[i],
            'g_pre_ffn': g_pre_ffn[i], 'w_ff1': w_ff1[i], 'w_ff2': w_ff2[i],
            'g_post_ffn': g_post_ffn[i],
        }
        mod = s_lat @ w_mod[i] + b_mod[i]
        mod_c = s_ctx @ w_mod[i] + b_mod[i]
        x, xc = _layer(x, xc, mod, mod_c, rope, i < DEPTH - 1, p)
    return x
```

```cpp
#include <hip/hip_runtime.h>
#include <hip/hip_cooperative_groups.h>
#include <stdint.h>
#include <stdio.h>
namespace cg = cooperative_groups;

#ifndef MEGA
#define MEGA 1
#endif

typedef unsigned short bf16_t;
using bf16x8 = __attribute__((ext_vector_type(8))) short;
using s16x4  = __attribute__((ext_vector_type(4))) short;
using f32x4  = __attribute__((ext_vector_type(4))) float;
using f32x16 = __attribute__((ext_vector_type(16))) float;
using u32x4  = __attribute__((ext_vector_type(4))) unsigned;
using u32x2  = __attribute__((ext_vector_type(2))) unsigned;
#define DI __device__ __forceinline__
#define MFMA32(a, b, c) __builtin_amdgcn_mfma_f32_32x32x16_bf16((a), (b), (c), 0, 0, 0)
#define MFMA16(a, b, c) __builtin_amdgcn_mfma_f32_16x16x32_bf16((a), (b), (c), 0, 0, 0)

constexpr int DM = 1024, NB = 4, SEQ = 4096, CTX = 256;
constexpr int ML = NB * SEQ;
constexpr int MC = NB * CTX;
constexpr int MT = ML + MC;
constexpr int DIN = 2480, DINP = 2560;
constexpr int LK = CTX + SEQ;
constexpr int DFF = 4096;
constexpr int NCH = 34;
constexpr float EPS = 1e-6f;
constexpr int U_CKV = 256, U_KR = 384, U_GB = 416, U_GC = 672, U_VAL = 928, U_Z = 1184, U_XBC = 1696, U_DT = 2464;

constexpr size_t AL(size_t x) { return (x + 255) & ~(size_t)255; }
constexpr size_t WT_IN = 0;
constexpr size_t WT_UQ = WT_IN + (size_t)DINP * 1024;
constexpr size_t WT_UKV = WT_UQ + (size_t)384 * 256;
constexpr size_t WT_OUT = WT_UKV + (size_t)512 * 128;
constexpr size_t WT_FF1 = WT_OUT + (size_t)1024 * 1024;
constexpr size_t WT_FF2 = WT_FF1 + (size_t)4096 * 1024;
constexpr size_t WT_ELEMS = WT_FF2 + (size_t)4096 * 1024;
constexpr size_t OFF_WT = 0;
constexpr size_t OFF_MOD = AL(OFF_WT + 2 * WT_ELEMS * 2);
constexpr size_t OFF_XC = AL(OFF_MOD + 2 * 5 * 6144 * 4);
constexpr size_t OFF_H = AL(OFF_XC + (size_t)MC * DM * 4);
constexpr size_t OFF_R1 = AL(OFF_H + (size_t)MT * DM * 2);
constexpr size_t OFF_U = OFF_R1;
constexpr size_t OFF_DT = AL(OFF_U + (size_t)MT * DIN * 2);
constexpr size_t OFF_RSTD = AL(OFF_DT + (size_t)MT * 16 * 4);
constexpr size_t OFF_QB = AL(OFF_RSTD + (size_t)MT * 2 * 4);
constexpr size_t OFF_KB = AL(OFF_QB + (size_t)MT * 384 * 2);
constexpr size_t OFF_VT = AL(OFF_KB + (size_t)NB * 4 * LK * 96 * 2);
constexpr size_t OFF_XBC = AL(OFF_VT + (size_t)NB * 4 * 64 * LK * 2);
constexpr size_t OFF_SST = AL(OFF_XBC + (size_t)MT * 768 * 2);
constexpr size_t OFF_TDEC = AL(OFF_SST + (size_t)2 * NB * NCH * 8 * 4096 * 2);
constexpr size_t OFF_SSQ = AL(OFF_TDEC + (size_t)2 * NB * NCH * 8 * 4);
constexpr size_t OFF_END1 = AL(OFF_SSQ + (size_t)MT * 8 * 4);
constexpr size_t OFF_F1 = OFF_R1;
constexpr size_t OFF_END2 = AL(OFF_F1 + (size_t)MT * DFF * 2);
constexpr size_t WS_NEED = OFF_END1 > OFF_END2 ? OFF_END1 : OFF_END2;

struct Params {
  const float *x, *c, *ctx, *c_ctx, *w_mod, *b_mod, *g_pre_mix, *w_in, *q_norm, *w_uq, *kv_norm, *w_ukv, *sc_w, *ssd_cw, *ssd_cb,
      *a_log, *dt_bias, *ssd_d, *ssd_norm, *w_out, *g_post_mix, *g_pre_ffn, *w_ff1, *w_ff2, *g_post_ffn;
  float* out;
  char* ws;
};

DI int ltid() { int t = threadIdx.x; asm volatile("" : "+v"(t)); return t; }
DI bf16_t f2bf(float x) { unsigned u = __float_as_uint(x); u += 0x7fffu + ((u >> 16) & 1u); return (bf16_t)(u >> 16); }
DI float bf2f(unsigned v) { return __uint_as_float(v << 16); }
DI unsigned pack2(float a, float b) { return (unsigned)f2bf(a) | ((unsigned)f2bf(b) << 16); }
DI float lo2f(unsigned w) { return __uint_as_float(w << 16); }
DI float hi2f(unsigned w) { return __uint_as_float(w & 0xffff0000u); }
DI float wave_sum(float v) {
#pragma unroll
  for (int o = 32; o > 0; o >>= 1) v += __shfl_xor(v, o);
  return v;
}
DI float silu_f(float x) { return x / (1.f + __expf(-x)); }
DI int crow(int reg, int h) { return (reg & 3) + 8 * (reg >> 2) + 4 * h; }
DI bf16x8 pack8(const f32x16& x, int s) {
  u32x4 p;
  p[0] = pack2(x[8 * s + 0], x[8 * s + 1]); p[1] = pack2(x[8 * s + 2], x[8 * s + 3]);
  p[2] = pack2(x[8 * s + 4], x[8 * s + 5]); p[3] = pack2(x[8 * s + 6], x[8 * s + 7]);
  return __builtin_bit_cast(bf16x8, p);
}
DI const float* xin_row(const Params& p, int layer, int row) {
  if (layer == 0) return row < ML ? p.x + (size_t)row * DM : p.ctx + (size_t)(row - ML) * DM;
  return row < ML ? p.out + (size_t)row * DM : (const float*)(p.ws + OFF_XC) + (size_t)(row - ML) * DM;
}
DI float* xst_row(const Params& p, int row) {
  return row < ML ? p.out + (size_t)row * DM : (float*)(p.ws + OFF_XC) + (size_t)(row - ML) * DM;
}
DI const float* mod_ptr(const Params& p, int layer, int row, int which) {
  int bb = row < ML ? (row >> 12) : 4;
  return (const float*)(p.ws + OFF_MOD) + ((size_t)(layer * 5 + bb) * 6 + which) * DM;
}
DI bf16_t* wt_ptr(const Params& p, int layer, size_t off) { return (bf16_t*)(p.ws + OFF_WT) + (size_t)layer * WT_ELEMS + off; }

DI void transpose_item(const float* __restrict__ w, const float* __restrict__ gk, bf16_t* __restrict__ wt, int K, int N, int kt, int nt, char* smem) {
  float* tile = (float*)smem;
  const int tx = ltid() & 63, ty = ltid() >> 6;
  const int k0 = kt * 64, n0 = nt * 64;
#pragma unroll 4
  for (int i = 0; i < 16; ++i) {
    int kk = ty + 4 * i, n = n0 + tx;
    float v = 0.f;
    if (n < N) { v = w[(size_t)(k0 + kk) * N + n]; if (gk) v *= gk[k0 + kk]; }
    tile[kk * 65 + tx] = v;
  }
  __syncthreads();
#pragma unroll 4
  for (int i = 0; i < 16; ++i) {
    int nn = ty + 4 * i;
    wt[(size_t)(n0 + nn) * K + k0 + tx] = f2bf(tile[tx * 65 + nn]);
  }
  __syncthreads();
}

DI void modgemv_item(const Params& p, int layer, int ct, char* smem) {
  float* s = (float*)smem;
  float* red = s + 5 * 1024;
  const int tid = ltid(), w = tid >> 6, lane = tid & 63;
  for (int i = tid; i < 5 * 1024; i += 256) {
    int bb = i >> 10, k = i & 1023;
    float v = bb < 4 ? p.c[bb * 1024 + k] : p.c_ctx[k];
    s[i] = silu_f(v);
  }
  __syncthreads();
  const float* wm = p.w_mod + (size_t)layer * 1024 * 6144;
  const int n = ct * 64 + lane;
  float acc[5] = {0.f, 0.f, 0.f, 0.f, 0.f};
  for (int k = w * 256; k < w * 256 + 256; ++k) {
    float wv = wm[(size_t)k * 6144 + n];
#pragma unroll
    for (int bb = 0; bb < 5; ++bb) acc[bb] += s[bb * 1024 + k] * wv;
  }
#pragma unroll
  for (int bb = 0; bb < 5; ++bb) red[(w * 5 + bb) * 64 + lane] = acc[bb];
  __syncthreads();
  for (int i = tid; i < 320; i += 256) {
    int bb = i >> 6, ln = i & 63;
    float v = red[(0 * 5 + bb) * 64 + ln] + red[(1 * 5 + bb) * 64 + ln] + red[(2 * 5 + bb) * 64 + ln] + red[(3 * 5 + bb) * 64 + ln];
    int nn = ct * 64 + ln;
    v += p.b_mod[layer * 6144 + nn];
    ((float*)(p.ws + OFF_MOD))[(size_t)(layer * 5 + bb) * 6144 + nn] = v;
  }
  __syncthreads();
}

DI void phase_prep0(const Params& p, int bid, int nb, char* smem) {
  constexpr int PER = 2984 + 96;
  for (int it = bid; it < 2 * PER; it += nb) {
    int layer = it / PER, j = it % PER;
    if (j < 96) { modgemv_item(p, layer, j, smem); continue; }
    j -= 96;
    if (j < 640) transpose_item(p.w_in + (size_t)layer * 1024 * DIN, nullptr, wt_ptr(p, layer, WT_IN), 1024, DIN, j / 40, j % 40, smem);
    else if ((j -= 640) < 24) transpose_item(p.w_uq + (size_t)layer * 256 * 384, p.q_norm + layer * 256, wt_ptr(p, layer, WT_UQ), 256, 384, j / 6, j % 6, smem);
    else if ((j -= 24) < 16) transpose_item(p.w_ukv + (size_t)layer * 128 * 512, p.kv_norm + layer * 128, wt_ptr(p, layer, WT_UKV), 128, 512, j / 8, j % 8, smem);
    else if ((j -= 16) < 256) transpose_item(p.w_out + (size_t)layer * 1024 * 1024, nullptr, wt_ptr(p, layer, WT_OUT), 1024, 1024, j / 16, j % 16, smem);
    else if ((j -= 256) < 1024) transpose_item(p.w_ff1 + (size_t)layer * 1024 * 4096, nullptr, wt_ptr(p, layer, WT_FF1), 1024, 4096, j / 64, j % 64, smem);
    else { j -= 1024; transpose_item(p.w_ff2 + (size_t)layer * 4096 * 1024, nullptr, wt_ptr(p, layer, WT_FF2), 4096, 1024, j / 16, j % 16, smem); }
  }
}

DI void write_h_row(const float4 xv[4], float rstd, const float* g, const float* sh, const float* sc, bf16_t* hrow, int lane) {
#pragma unroll
  for (int i = 0; i < 4; ++i) {
    int col = lane * 4 + 256 * i;
    float4 gg = *(const float4*)(g + col), s1 = *(const float4*)(sc + col), s0 = *(const float4*)(sh + col);
    float a = xv[i].x * rstd * gg.x * (1.f + s1.x) + s0.x;
    float b = xv[i].y * rstd * gg.y * (1.f + s1.y) + s0.y;
    float c = xv[i].z * rstd * gg.z * (1.f + s1.z) + s0.z;
    float d = xv[i].w * rstd * gg.w * (1.f + s1.w) + s0.w;
    u32x2 o; o[0] = pack2(a, b); o[1] = pack2(c, d);
    *(u32x2*)(hrow + col) = o;
  }
}
DI float ssq4(const float4 v[4]) {
  float s = 0.f;
#pragma unroll
  for (int i = 0; i < 4; ++i) s += v[i].x * v[i].x + v[i].y * v[i].y + v[i].z * v[i].z + v[i].w * v[i].w;
  return s;
}
DI void load_bf_row(const bf16_t* r, int lane, float4 v[4]) {
#pragma unroll
  for (int i = 0; i < 4; ++i) {
    u32x2 t = *(const u32x2*)(r + lane * 4 + 256 * i);
    v[i] = make_float4(lo2f(t[0]), hi2f(t[0]), lo2f(t[1]), hi2f(t[1]));
  }
}

DI void phase_h0(const Params& p, int bid, int nb) {
  const int w = ltid() >> 6, lane = ltid() & 63;
  bf16_t* H = (bf16_t*)(p.ws + OFF_H);
  for (int row = bid * 4 + w; row < MT; row += nb * 4) {
    const float* xr = xin_row(p, 0, row);
    float4 xv[4];
#pragma unroll
    for (int i = 0; i < 4; ++i) xv[i] = *(const float4*)(xr + lane * 4 + 256 * i);
    float rstd = rsqrtf(wave_sum(ssq4(xv)) * (1.f / DM) + EPS);
    write_h_row(xv, rstd, p.g_pre_mix, mod_ptr(p, 0, row, 0), mod_ptr(p, 0, row, 1), H + (size_t)row * DM, lane);
  }
}

DI void phase_postmix(const Params& p, int layer, int bid, int nb) {
  const int w = ltid() >> 6, lane = ltid() & 63;
  const int M = layer == 0 ? MT : ML;
  bf16_t* H = (bf16_t*)(p.ws + OFF_H);
  const bf16_t* Y = (const bf16_t*)(p.ws + OFF_U);
  for (int row = bid * 4 + w; row < M; row += nb * 4) {
    float4 yv[4], xv[4];
    load_bf_row(Y + (size_t)row * DM, lane, yv);
    const float* xr = xin_row(p, layer, row);
#pragma unroll
    for (int i = 0; i < 4; ++i) xv[i] = *(const float4*)(xr + lane * 4 + 256 * i);
    float rstd = rsqrtf(wave_sum(ssq4(yv)) * (1.f / DM) + EPS);
    const float* g1 = mod_ptr(p, layer, row, 2);
    const float* gp = p.g_post_mix + layer * DM;
    float* xo = xst_row(p, row);
#pragma unroll
    for (int i = 0; i < 4; ++i) {
      int col = lane * 4 + 256 * i;
      float4 a = *(const float4*)(g1 + col), b = *(const float4*)(gp + col);
      xv[i].x += a.x * yv[i].x * rstd * b.x; xv[i].y += a.y * yv[i].y * rstd * b.y;
      xv[i].z += a.z * yv[i].z * rstd * b.z; xv[i].w += a.w * yv[i].w * rstd * b.w;
      *(float4*)(xo + col) = xv[i];
    }
    float rstd1 = rsqrtf(wave_sum(ssq4(xv)) * (1.f / DM) + EPS);
    write_h_row(xv, rstd1, p.g_pre_ffn + layer * DM, mod_ptr(p, layer, row, 3), mod_ptr(p, layer, row, 4), H + (size_t)row * DM, lane);
  }
}

DI void phase_postffn(const Params& p, int layer, int bid, int nb) {
  const int w = ltid() >> 6, lane = ltid() & 63;
  const int M = layer == 0 ? MT : ML;
  bf16_t* H = (bf16_t*)(p.ws + OFF_H);
  for (int row = bid * 4 + w; row < M; row += nb * 4) {
    float4 fv[4], xv[4];
    load_bf_row(H + (size_t)row * DM, lane, fv);
    float* xo = xst_row(p, row);
#pragma unroll
    for (int i = 0; i < 4; ++i) xv[i] = *(const float4*)(xo + lane * 4 + 256 * i);
    float rstd = rsqrtf(wave_sum(ssq4(fv)) * (1.f / DM) + EPS);
    const float* g2 = mod_ptr(p, layer, row, 5);
    const float* gp = p.g_post_ffn + layer * DM;
#pragma unroll
    for (int i = 0; i < 4; ++i) {
      int col = lane * 4 + 256 * i;
      float4 a = *(const float4*)(g2 + col), b = *(const float4*)(gp + col);
      xv[i].x += a.x * fv[i].x * rstd * b.x; xv[i].y += a.y * fv[i].y * rstd * b.y;
      xv[i].z += a.z * fv[i].z * rstd * b.z; xv[i].w += a.w * fv[i].w * rstd * b.w;
      *(float4*)(xo + col) = xv[i];
    }
    if (layer == 0) {
      float rstd1 = rsqrtf(wave_sum(ssq4(xv)) * (1.f / DM) + EPS);
      write_h_row(xv, rstd1, p.g_pre_mix + DM, mod_ptr(p, 1, row, 0), mod_ptr(p, 1, row, 1), H + (size_t)row * DM, lane);
    }
  }
}

DI void phase_prep(const Params& p, int layer, int bid, int nb) {
  const int w = ltid() >> 6, lane = ltid() & 63;
  const bf16_t* U = (const bf16_t*)(p.ws + OFF_U);
  float* DT = (float*)(p.ws + OFF_DT);
  float* RS = (float*)(p.ws + OFF_RSTD);
  bf16_t* KB = (bf16_t*)(p.ws + OFF_KB);
  bf16_t* XBC = (bf16_t*)(p.ws + OFF_XBC);
  bf16_t* YM = (bf16_t*)(p.ws + OFF_H);
  const float* scw = p.sc_w + layer * 3 * 256;
  const float* cw = p.ssd_cw + layer * 3 * 768;
  const float* cb = p.ssd_cb + layer * 768;
  for (int row = bid * 4 + w; row < MT; row += nb * 4) {
    int b, t, L, pos;
    bool lat = row < ML;
    if (lat) { b = row >> 12; t = row & 4095; L = SEQ; pos = t + CTX; }
    else { int rr = row - ML; b = rr >> 8; t = rr & 255; L = CTX; pos = t; }
    const bf16_t* u0 = U + (size_t)row * DIN;
    const bool hp = t > 0, hn = t < L - 1;
    const bf16_t* um = u0 - DIN;
    const bf16_t* up = u0 + DIN;
    {
      u32x2 v = *(const u32x2*)(u0 + lane * 4);
      float a = lo2f(v[0]), bq = hi2f(v[0]), c = lo2f(v[1]), d = hi2f(v[1]);
      float ss = wave_sum(a * a + bq * bq + c * c + d * d);
      float s2 = 0.f;
      if (lane < 32) {
        u32x2 v2 = *(const u32x2*)(u0 + U_CKV + lane * 4);
        float e = lo2f(v2[0]), f = hi2f(v2[0]), g = lo2f(v2[1]), h = hi2f(v2[1]);
        s2 = e * e + f * f + g * g + h * h;
      }
      s2 = wave_sum(s2);
      if (lane == 0) { RS[row * 2] = rsqrtf(ss * (1.f / 256) + EPS); RS[row * 2 + 1] = rsqrtf(s2 * (1.f / 128) + EPS); }
    }
    {
      float v = bf2f(u0[U_KR + (lane & 31)]);
      float partner = __shfl_xor(v, 8);
      float o = v;
      if (lat) {
        int grp = (lane & 31) >> 3, i = lane & 7;
        float posf = grp < 2 ? (float)(t >> 6) : (float)(t & 63);
        float invf = exp2f(-(float)(2 * i) * (13.287712379549449f / 16.f));
        float ang = posf * invf;
        float rev = ang * 0.15915494309189535f;
        float cs = __builtin_amdgcn_cosf(rev), sn = __builtin_amdgcn_sinf(rev);
        o = (grp & 1) ? v * cs + partner * sn : v * cs - partner * sn;
      }
      if (lane < 32) {
        bf16_t ob = f2bf(o);
#pragma unroll
        for (int hd = 0; hd < 4; ++hd) KB[((size_t)(b * 4 + hd) * LK + pos) * 96 + 64 + lane] = ob;
      }
    }
    {
      int c = lane * 4;
      float acc[4] = {0.f, 0.f, 0.f, 0.f};
#pragma unroll
      for (int k = 0; k < 3; ++k) {
        const bf16_t* ur = k == 0 ? um : (k == 1 ? u0 : up);
        bool ok = k == 0 ? hp : (k == 1 ? true : hn);
        if (ok) {
          u32x2 gc = *(const u32x2*)(ur + U_GC + c), vv = *(const u32x2*)(ur + U_VAL + c);
          float4 wk = *(const float4*)(scw + k * 256 + c);
          acc[0] += wk.x * lo2f(gc[0]) * lo2f(vv[0]); acc[1] += wk.y * hi2f(gc[0]) * hi2f(vv[0]);
          acc[2] += wk.z * lo2f(gc[1]) * lo2f(vv[1]); acc[3] += wk.w * hi2f(gc[1]) * hi2f(vv[1]);
        }
      }
      u32x2 gb = *(const u32x2*)(u0 + U_GB + c);
      u32x2 o; o[0] = pack2(lo2f(gb[0]) * acc[0], hi2f(gb[0]) * acc[1]); o[1] = pack2(lo2f(gb[1]) * acc[2], hi2f(gb[1]) * acc[3]);
      *(u32x2*)(YM + (size_t)row * DM + 256 + c) = o;
    }
#pragma unroll
    for (int i = 0; i < 3; ++i) {
      int c = lane * 4 + 256 * i;
      float4 bias = *(const float4*)(cb + c);
      float acc[4] = {bias.x, bias.y, bias.z, bias.w};
#pragma unroll
      for (int k = 0; k < 3; ++k) {
        const bf16_t* ur = k == 0 ? um : (k == 1 ? u0 : up);
        bool ok = k == 0 ? hp : (k == 1 ? true : hn);
        if (ok) {
          u32x2 vv = *(const u32x2*)(ur + U_XBC + c);
          float4 wk = *(const float4*)(cw + k * 768 + c);
          acc[0] += wk.x * lo2f(vv[0]); acc[1] += wk.y * hi2f(vv[0]); acc[2] += wk.z * lo2f(vv[1]); acc[3] += wk.w * hi2f(vv[1]);
        }
      }
      u32x2 o; o[0] = pack2(silu_f(acc[0]), silu_f(acc[1])); o[1] = pack2(silu_f(acc[2]), silu_f(acc[3]));
      *(u32x2*)(XBC + (size_t)row * 768 + c) = o;
    }
    if (lane < 16) {
      float v = DT[(size_t)row * 16 + lane] + p.dt_bias[layer * 16 + lane];
      float sp = fmaxf(v, 0.f) + log1pf(__expf(-fabsf(v)));
      DT[(size_t)row * 16 + lane] = sp;
    }
  }
}

DI void phase_ssdnorm(const Params& p, int layer, int bid, int nb) {
  const int w = ltid() >> 6, lane = ltid() & 63;
  const int M = layer == 0 ? MT : ML;
  bf16_t* YM = (bf16_t*)(p.ws + OFF_H);
  const float* SSQ = (const float*)(p.ws + OFF_SSQ);
  const float* ng = p.ssd_norm + layer * 512;
  for (int row = bid * 4 + w; row < M; row += nb * 4) {
    int g = lane >> 5;
    float4 s = *(const float4*)(SSQ + (size_t)row * 8 + g * 4);
    float rstd = rsqrtf((s.x + s.y + s.z + s.w) * (1.f / 256) + EPS);
    bf16_t* ptr = YM + (size_t)row * DM + 512 + lane * 8;
    u32x4 v = *(const u32x4*)ptr;
    float4 g0 = *(const float4*)(ng + lane * 8), g1 = *(const float4*)(ng + lane * 8 + 4);
    u32x4 o;
    o[0] = pack2(lo2f(v[0]) * rstd * g0.x, hi2f(v[0]) * rstd * g0.y);
    o[1] = pack2(lo2f(v[1]) * rstd * g0.z, hi2f(v[1]) * rstd * g0.w);
    o[2] = pack2(lo2f(v[2]) * rstd * g1.x, hi2f(v[2]) * rstd * g1.y);
    o[3] = pack2(lo2f(v[3]) * rstd * g1.z, hi2f(v[3]) * rstd * g1.w);
    *(u32x4*)ptr = o;
  }
}

constexpr int GST = 72;
template <class Epi>
DI void gemm_tile(const bf16_t* __restrict__ A, int lda, const bf16_t* __restrict__ Bt, int K, int row0, int col0, char* smem, Epi epi) {
  bf16_t* As = (bf16_t*)smem;
  bf16_t* Bs = As + 128 * GST;
  const int tid = ltid(), wid = tid >> 6, lane = tid & 63, wr = wid >> 1, wc = wid & 1, fr = lane & 15, fq = lane >> 4;
  f32x4 acc[4][4];
#pragma unroll
  for (int m = 0; m < 4; ++m)
#pragma unroll
    for (int n = 0; n < 4; ++n) acc[m][n] = f32x4{0.f, 0.f, 0.f, 0.f};
  u32x4 ra[4], rb[4];
  const int sr = tid >> 3, sp = tid & 7;
  const bf16_t* ga = A + (size_t)(row0 + sr) * lda + sp * 8;
  const bf16_t* gb = Bt + (size_t)(col0 + sr) * K + sp * 8;
  auto gload = [&](int k0) {
#pragma unroll
    for (int i = 0; i < 4; ++i) {
      ra[i] = *(const u32x4*)(ga + (size_t)(32 * i) * lda + k0);
      rb[i] = *(const u32x4*)(gb + (size_t)(32 * i) * K + k0);
    }
  };
  gload(0);
  const int KT = K / 64;
  for (int kt = 0; kt < KT; ++kt) {
#pragma unroll
    for (int i = 0; i < 4; ++i) {
      *(u32x4*)(As + (sr + 32 * i) * GST + sp * 8) = ra[i];
      *(u32x4*)(Bs + (sr + 32 * i) * GST + sp * 8) = rb[i];
    }
    __syncthreads();
    if (kt + 1 < KT) gload((kt + 1) * 64);
#pragma unroll
    for (int ks = 0; ks < 2; ++ks) {
      bf16x8 af[4], bfr[4];
#pragma unroll
      for (int m = 0; m < 4; ++m) af[m] = *(const bf16x8*)(As + (wr * 64 + m * 16 + fr) * GST + ks * 32 + fq * 8);
#pragma unroll
      for (int n = 0; n < 4; ++n) bfr[n] = *(const bf16x8*)(Bs + (wc * 64 + n * 16 + fr) * GST + ks * 32 + fq * 8);
#pragma unroll
      for (int m = 0; m < 4; ++m)
#pragma unroll
        for (int n = 0; n < 4; ++n) acc[m][n] = MFMA16(af[m], bfr[n], acc[m][n]);
    }
    __syncthreads();
  }
#pragma unroll
  for (int m = 0; m < 4; ++m)
#pragma unroll
    for (int n = 0; n < 4; ++n) epi(row0 + wr * 64 + m * 16 + fq * 4, col0 + wc * 64 + n * 16 + fr, acc[m][n]);
}

struct EpiBF {
  bf16_t* out; int ldo;
  DI void operator()(int row, int col, const f32x4& a) const {
#pragma unroll
    for (int j = 0; j < 4; ++j) out[(size_t)(row + j) * ldo + col] = f2bf(a[j]);
  }
};
struct EpiRelu2 {
  bf16_t* out; int ldo;
  DI void operator()(int row, int col, const f32x4& a) const {
#pragma unroll
    for (int j = 0; j < 4; ++j) { float r = fmaxf(a[j], 0.f); out[(size_t)(row + j) * ldo + col] = f2bf(r * r); }
  }
};
struct EpiU {
  bf16_t* u; float* dt;
  DI void operator()(int row, int col, const f32x4& a) const {
    if (col < DIN) {
#pragma unroll
      for (int j = 0; j < 4; ++j) u[(size_t)(row + j) * DIN + col] = f2bf(a[j]);
      if (col >= U_DT) {
#pragma unroll
        for (int j = 0; j < 4; ++j) dt[(size_t)(row + j) * 16 + col - U_DT] = a[j];
      }
    }
  }
};
struct EpiQ {
  bf16_t* q; const float* rs;
  DI void operator()(int row, int col, const f32x4& a) const {
#pragma unroll
    for (int j = 0; j < 4; ++j) q[(size_t)(row + j) * 384 + col] = f2bf(a[j] * rs[(row + j) * 2]);
  }
};
struct EpiKV {
  bf16_t* kb; bf16_t* vt; const float* rs;
  DI void operator()(int row, int col, const f32x4& a) const {
    int b, pos;
    if (row < ML) { b = row >> 12; pos = (row & 4095) + CTX; } else { int rr = row - ML; b = rr >> 8; pos = rr & 255; }
    int head = col >> 7, d = col & 127;
    float v[4];
#pragma unroll
    for (int j = 0; j < 4; ++j) v[j] = a[j] * rs[(row + j) * 2 + 1];
    if (d < 64) {
#pragma unroll
      for (int j = 0; j < 4; ++j) kb[((size_t)(b * 4 + head) * LK + pos + j) * 96 + d] = f2bf(v[j]);
    } else {
      u32x2 o; o[0] = pack2(v[0], v[1]); o[1] = pack2(v[2], v[3]);
      *(u32x2*)(vt + ((size_t)(b * 4 + head) * 64 + (d - 64)) * LK + pos) = o;
    }
  }
};

DI void phase_inproj(const Params& p, int layer, int bid, int nb, char* smem) {
  constexpr int NT = DINP / 128;
  EpiU epi{(bf16_t*)(p.ws + OFF_U), (float*)(p.ws + OFF_DT)};
  for (int it = bid; it < (MT / 128) * NT; it += nb)
    gemm_tile((const bf16_t*)(p.ws + OFF_H), DM, wt_ptr(p, layer, WT_IN), 1024, (it / NT) * 128, (it % NT) * 128, smem, epi);
}
DI void phase_wout(const Params& p, int layer, int bid, int nb, char* smem) {
  const int M = layer == 0 ? MT : ML;
  EpiBF epi{(bf16_t*)(p.ws + OFF_U), DM};
  for (int it = bid; it < (M / 128) * 8; it += nb)
    gemm_tile((const bf16_t*)(p.ws + OFF_H), DM, wt_ptr(p, layer, WT_OUT), 1024, (it / 8) * 128, (it % 8) * 128, smem, epi);
}
DI void phase_ff1(const Params& p, int layer, int bid, int nb, char* smem) {
  const int M = layer == 0 ? MT : ML;
  EpiRelu2 epi{(bf16_t*)(p.ws + OFF_F1), DFF};
  for (int it = bid; it < (M / 128) * 32; it += nb)
    gemm_tile((const bf16_t*)(p.ws + OFF_H), DM, wt_ptr(p, layer, WT_FF1), 1024, (it / 32) * 128, (it % 32) * 128, smem, epi);
}
DI void phase_ff2(const Params& p, int layer, int bid, int nb, char* smem) {
  const int M = layer == 0 ? MT : ML;
  EpiBF epi{(bf16_t*)(p.ws + OFF_H), DM};
  for (int it = bid; it < (M / 128) * 8; it += nb)
    gemm_tile((const bf16_t*)(p.ws + OFF_F1), DFF, wt_ptr(p, layer, WT_FF2), 4096, (it / 8) * 128, (it % 8) * 128, smem, epi);
}

DI int chunk_row0(int b, int tc) { return tc < 2 ? ML + b * CTX + tc * 128 : b * SEQ + (tc - 2) * 128; }
constexpr int TST = 136;
DI void load_tile_T(bf16_t* dst, const bf16_t* __restrict__ src, int ldg) {
  const int tid = ltid();
#pragma unroll
  for (int i = 0; i < 4; ++i) {
    int c = tid + 256 * i, tok = c & 127, pc = c >> 7;
    u32x4 v = *(const u32x4*)(src + (size_t)tok * ldg + pc * 8);
#pragma unroll
    for (int j = 0; j < 4; ++j) {
      dst[(pc * 8 + 2 * j) * TST + tok] = (bf16_t)(v[j] & 0xffffu);
      dst[(pc * 8 + 2 * j + 1) * TST + tok] = (bf16_t)(v[j] >> 16);
    }
  }
}
DI void chunk_scan(const Params& p, int layer, int row0, int h, float* csf, float* csb, float* dtF, float* dtB, float* laF, float* laB) {
  const int tid = ltid();
  const float* DT = (const float*)(p.ws + OFF_DT);
  if (tid < 128) {
    float af = -__expf(p.a_log[layer * 16 + h]), ab = -__expf(p.a_log[layer * 16 + 8 + h]);
    float df = DT[(size_t)(row0 + tid) * 16 + h], db = DT[(size_t)(row0 + tid) * 16 + 8 + h];
    dtF[tid] = df; dtB[tid] = db; laF[tid] = df * af; laB[tid] = db * ab;
  }
  __syncthreads();
  if (tid < 128) {
    float s = 0.f;
    for (int l = 0; l <= tid; ++l) s += laF[l];
    csf[tid] = s;
  } else {
    int t = tid - 128;
    float s = 0.f;
    for (int l = 127; l >= t; --l) s += laB[l];
    csb[t] = s;
  }
  __syncthreads();
}

DI void ssd_state_item(const Params& p, int layer, int b, int tc, int h, char* smem) {
  bf16_t* XT = (bf16_t*)smem;
  bf16_t* BT = XT + 64 * TST;
  float* csf = (float*)(BT + 64 * TST);
  float* csb = csf + 128; float* dtF = csb + 128; float* dtB = dtF + 128; float* laF = dtB + 128; float* laB = laF + 128;
  const int tid = ltid(), w = tid >> 6, lane = tid & 63, r = lane & 31, hh = lane >> 5;
  const int row0 = chunk_row0(b, tc);
  const bf16_t* XBC = (const bf16_t*)(p.ws + OFF_XBC);
  chunk_scan(p, layer, row0, h, csf, csb, dtF, dtB, laF, laB);
  load_tile_T(XT, XBC + (size_t)row0 * 768 + h * 64, 768);
  load_tile_T(BT, XBC + (size_t)row0 * 768 + 512 + (h >> 2) * 64, 768);
  __syncthreads();
  if (tid < 128) laF[tid] = dtF[tid] * __expf(csf[127] - csf[tid]);
  else { int t = tid - 128; laB[t] = dtB[t] * __expf(csb[0] - csb[t]); }
  __syncthreads();
  const int d = w >> 1, pt = w & 1;
  const float* wv = d == 0 ? laF : laB;
  f32x16 acc[2];
#pragma unroll
  for (int i = 0; i < 16; ++i) { acc[0][i] = 0.f; acc[1][i] = 0.f; }
#pragma unroll
  for (int s = 0; s < 8; ++s) {
    int l0 = 16 * s + 8 * hh;
    u32x4 xa = *(const u32x4*)(XT + (32 * pt + r) * TST + l0);
    u32x4 sa;
#pragma unroll
    for (int j = 0; j < 4; ++j) sa[j] = pack2(lo2f(xa[j]) * wv[l0 + 2 * j], hi2f(xa[j]) * wv[l0 + 2 * j + 1]);
    bf16x8 af = __builtin_bit_cast(bf16x8, sa);
#pragma unroll
    for (int nt = 0; nt < 2; ++nt) {
      bf16x8 bfr = *(const bf16x8*)(BT + (32 * nt + r) * TST + l0);
      acc[nt] = MFMA32(af, bfr, acc[nt]);
    }
  }
  bf16_t* S = (bf16_t*)(p.ws + OFF_SST) + ((((size_t)d * NB + b) * NCH + tc) * 8 + h) * 4096;
#pragma unroll
  for (int nt = 0; nt < 2; ++nt)
#pragma unroll
    for (int i = 0; i < 16; ++i) S[(32 * pt + crow(i, hh)) * 64 + 32 * nt + r] = f2bf(acc[nt][i]);
  if (tid == 0) {
    float* TD = (float*)(p.ws + OFF_TDEC);
    TD[((0 * NB + b) * NCH + tc) * 8 + h] = __expf(csf[127]);
    TD[((1 * NB + b) * NCH + tc) * 8 + h] = __expf(csb[0]);
  }
  __syncthreads();
}

DI void ssd_pass_item(const Params& p, int it) {
  const int e = it * 256 + ltid();
  const int pn2 = e & 2047, h = (e >> 11) & 7, b = (e >> 14) & 3, d = e >> 16;
  unsigned* S = (unsigned*)(p.ws + OFF_SST);
  const float* TD = (const float*)(p.ws + OFF_TDEC);
  float h0 = 0.f, h1 = 0.f;
  for (int i = 0; i < NCH; ++i) {
    int tc = d == 0 ? i : (i < 2 ? 1 - i : NCH + 1 - i);
    size_t idx = (((size_t)(d * NB + b) * NCH + tc) * 8 + h) * 2048 + pn2;
    unsigned sv = S[idx];
    float T = TD[((d * NB + b) * NCH + tc) * 8 + h];
    S[idx] = pack2(h0, h1);
    h0 = T * h0 + lo2f(sv); h1 = T * h1 + hi2f(sv);
  }
}

DI void ssd_out_item(const Params& p, int layer, int b, int tc, int h, char* smem) {
  bf16_t* XT = (bf16_t*)smem;
  bf16_t* Bs = XT + 64 * TST;
  float* csf = (float*)(Bs + 128 * GST);
  float* csb = csf + 128; float* dtF = csb + 128; float* dtB = dtF + 128; float* laF = dtB + 128; float* laB = laF + 128;
  const int tid = ltid(), w = tid >> 6, lane = tid & 63, r = lane & 31, hh = lane >> 5;
  const int row0 = chunk_row0(b, tc), g = h >> 2;
  const bf16_t* XBC = (const bf16_t*)(p.ws + OFF_XBC);
  chunk_scan(p, layer, row0, h, csf, csb, dtF, dtB, laF, laB);
  load_tile_T(XT, XBC + (size_t)row0 * 768 + h * 64, 768);
#pragma unroll
  for (int i = 0; i < 4; ++i) {
    int c = tid + 256 * i, tok = c >> 3, part = c & 7;
    *(u32x4*)(Bs + tok * GST + part * 8) = *(const u32x4*)(XBC + (size_t)(row0 + tok) * 768 + 512 + g * 64 + part * 8);
  }
  const int l = 32 * w + r;
  bf16x8 cf[4];
#pragma unroll
  for (int ks = 0; ks < 4; ++ks) cf[ks] = *(const bf16x8*)(XBC + (size_t)(row0 + l) * 768 + 640 + g * 64 + 16 * ks + 8 * hh);
  __syncthreads();
  const float csf_l = csf[l], csb_l = csb[l];
  f32x16 yacc[2];
#pragma unroll
  for (int i = 0; i < 16; ++i) { yacc[0][i] = 0.f; yacc[1][i] = 0.f; }
#pragma unroll
  for (int st = 0; st < 4; ++st) {
    f32x16 gacc;
#pragma unroll
    for (int i = 0; i < 16; ++i) gacc[i] = 0.f;
#pragma unroll
    for (int ks = 0; ks < 4; ++ks) {
      bf16x8 af = *(const bf16x8*)(Bs + (32 * st + r) * GST + 16 * ks + 8 * hh);
      gacc = MFMA32(af, cf[ks], gacc);
    }
#pragma unroll
    for (int i = 0; i < 16; ++i) {
      int s = 32 * st + crow(i, hh);
      float f;
      if (s < l) f = __expf(csf_l - csf[s]) * dtF[s];
      else if (s > l) f = __expf(csb_l - csb[s]) * dtB[s];
      else f = dtF[s] + dtB[s];
      gacc[i] *= f;
    }
#pragma unroll
    for (int s2 = 0; s2 < 2; ++s2) {
      bf16x8 mf = pack8(gacc, s2);
      int sb = 32 * st + 16 * s2 + 4 * hh;
#pragma unroll
      for (int pt = 0; pt < 2; ++pt) {
        u32x2 lo = *(const u32x2*)(XT + (32 * pt + r) * TST + sb);
        u32x2 hi = *(const u32x2*)(XT + (32 * pt + r) * TST + sb + 8);
        u32x4 xa; xa[0] = lo[0]; xa[1] = lo[1]; xa[2] = hi[0]; xa[3] = hi[1];
        yacc[pt] = MFMA32(__builtin_bit_cast(bf16x8, xa), mf, yacc[pt]);
      }
    }
  }
#pragma unroll
  for (int d = 0; d < 2; ++d) {
    const bf16_t* Hs = (const bf16_t*)(p.ws + OFF_SST) + ((((size_t)d * NB + b) * NCH + tc) * 8 + h) * 4096;
    const float e = __expf(d == 0 ? csf_l : csb_l);
#pragma unroll
    for (int pt = 0; pt < 2; ++pt) {
      f32x16 t;
#pragma unroll
      for (int i = 0; i < 16; ++i) t[i] = 0.f;
#pragma unroll
      for (int ks = 0; ks < 4; ++ks) {
        bf16x8 af = *(const bf16x8*)(Hs + (32 * pt + r) * 64 + 16 * ks + 8 * hh);
        t = MFMA32(af, cf[ks], t);
      }
#pragma unroll
      for (int i = 0; i < 16; ++i) yacc[pt][i] += e * t[i];
    }
  }
  const int row = row0 + l;
  const float Dh = p.ssd_d[layer * 8 + h];
  const bf16_t* U = (const bf16_t*)(p.ws + OFF_U);
  bf16_t* YM = (bf16_t*)(p.ws + OFF_H);
  float ssq = 0.f;
#pragma unroll
  for (int pt = 0; pt < 2; ++pt)
#pragma unroll
    for (int q = 0; q < 4; ++q) {
      int pp = 32 * pt + 8 * q + 4 * hh;
      u32x2 xv = *(const u32x2*)(XBC + (size_t)row * 768 + h * 64 + pp);
      u32x2 zv = *(const u32x2*)(U + (size_t)row * DIN + U_Z + h * 64 + pp);
      float y0 = (yacc[pt][4 * q + 0] + Dh * lo2f(xv[0])) * silu_f(lo2f(zv[0]));
      float y1 = (yacc[pt][4 * q + 1] + Dh * hi2f(xv[0])) * silu_f(hi2f(zv[0]));
      float y2 = (yacc[pt][4 * q + 2] + Dh * lo2f(xv[1])) * silu_f(lo2f(zv[1]));
      float y3 = (yacc[pt][4 * q + 3] + Dh * hi2f(xv[1])) * silu_f(hi2f(zv[1]));
      u32x2 o; o[0] = pack2(y0, y1); o[1] = pack2(y2, y3);
      float r0 = lo2f(o[0]), r1 = hi2f(o[0]), r2 = lo2f(o[1]), r3 = hi2f(o[1]);
      ssq += r0 * r0 + r1 * r1 + r2 * r2 + r3 * r3;
      *(u32x2*)(YM + (size_t)row * DM + 512 + h * 64 + pp) = o;
    }
  ssq += __shfl_xor(ssq, 32);
  if (hh == 0) ((float*)(p.ws + OFF_SSQ))[(size_t)row * 8 + h] = ssq;
  __syncthreads();
}

constexpr int KST = 104;
constexpr int VST = 68;
DI void attn_item(const Params& p, int b, int head, int qrow0, int t0, bool lat, int nkeys, char* smem) {
  bf16_t* Ks = (bf16_t*)smem;
  bf16_t* Vs = Ks + 64 * KST;
  const int tid = ltid(), w = tid >> 6, lane = tid & 63, r = lane & 31, hh = lane >> 5;
  const bf16_t* QB = (const bf16_t*)(p.ws + OFF_QB);
  const bf16_t* KB = (const bf16_t*)(p.ws + OFF_KB) + (size_t)(b * 4 + head) * LK * 96;
  const bf16_t* VT = (const bf16_t*)(p.ws + OFF_VT) + (size_t)(b * 4 + head) * 64 * LK;
  const float qscale = 0.10206207261596575f * 1.4426950408889634f;
  const int qrow = qrow0 + w * 32 + r;
  const int t = t0 + w * 32 + r;
  bf16x8 qf[6];
  {
    const bf16_t* src = QB + (size_t)qrow * 384 + head * 96;
#pragma unroll
    for (int s = 0; s < 4; ++s) {
      u32x4 v = *(const u32x4*)(src + 16 * s + 8 * hh);
      u32x4 o;
#pragma unroll
      for (int j = 0; j < 4; ++j) o[j] = pack2(lo2f(v[j]) * qscale, hi2f(v[j]) * qscale);
      qf[s] = __builtin_bit_cast(bf16x8, o);
    }
#pragma unroll
    for (int s = 4; s < 6; ++s) {
      u32x4 va = *(const u32x4*)(src + 16 * s), vb = *(const u32x4*)(src + 16 * s + 8);
      float posf = s == 4 ? (float)(t >> 6) : (float)(t & 63);
      float o[8];
#pragma unroll
      for (int j = 0; j < 8; ++j) {
        float a = (j & 1) ? hi2f(va[j >> 1]) : lo2f(va[j >> 1]);
        float bb = (j & 1) ? hi2f(vb[j >> 1]) : lo2f(vb[j >> 1]);
        float res;
        if (lat) {
          float invf = exp2f(-(float)(2 * j) * (13.287712379549449f / 16.f));
          float rev = posf * invf * 0.15915494309189535f;
          float cs = __builtin_amdgcn_cosf(rev), sn = __builtin_amdgcn_sinf(rev);
          res = hh == 0 ? a * cs - bb * sn : bb * cs + a * sn;
        } else res = hh == 0 ? a : bb;
        o[j] = res * qscale;
      }
      u32x4 ov; ov[0] = pack2(o[0], o[1]); ov[1] = pack2(o[2], o[3]); ov[2] = pack2(o[4], o[5]); ov[3] = pack2(o[6], o[7]);
      qf[s] = __builtin_bit_cast(bf16x8, ov);
    }
  }
  f32x16 oacc[2];
#pragma unroll
  for (int i = 0; i < 16; ++i) { oacc[0][i] = 0.f; oacc[1][i] = 0.f; }
  float m = -1e30f, lsum = 0.f;
  u32x4 rk[3], rv[2];
  auto gload = [&](int key0) {
#pragma unroll
    for (int i = 0; i < 3; ++i) rk[i] = *(const u32x4*)(KB + (size_t)key0 * 96 + (tid + 256 * i) * 8);
#pragma unroll
    for (int i = 0; i < 2; ++i) { int c = tid + 256 * i; rv[i] = *(const u32x4*)(VT + (size_t)(c >> 3) * LK + key0 + (c & 7) * 8); }
  };
  gload(0);
  const int NT = nkeys / 64;
  for (int kt = 0; kt < NT; ++kt) {
#pragma unroll
    for (int i = 0; i < 3; ++i) { int c = tid + 256 * i; *(u32x4*)(Ks + (c / 12) * KST + (c % 12) * 8) = rk[i]; }
#pragma unroll
    for (int i = 0; i < 2; ++i) {
      int c = tid + 256 * i;
      bf16_t* d = Vs + (c >> 3) * VST + (c & 7) * 8;
      u32x2 a; a[0] = rv[i][0]; a[1] = rv[i][1];
      u32x2 bq; bq[0] = rv[i][2]; bq[1] = rv[i][3];
      *(u32x2*)d = a; *(u32x2*)(d + 4) = bq;
    }
    __syncthreads();
    if (kt + 1 < NT) gload((kt + 1) * 64);
    f32x16 sacc[2];
#pragma unroll
    for (int i = 0; i < 16; ++i) { sacc[0][i] = 0.f; sacc[1][i] = 0.f; }
#pragma unroll
    for (int s = 0; s < 6; ++s)
#pragma unroll
      for (int k2 = 0; k2 < 2; ++k2) {
        bf16x8 af = *(const bf16x8*)(Ks + (32 * k2 + r) * KST + 16 * s + 8 * hh);
        sacc[k2] = MFMA32(af, qf[s], sacc[k2]);
      }
    float mx = sacc[0][0];
#pragma unroll
    for (int i = 0; i < 16; ++i) { mx = fmaxf(mx, sacc[0][i]); mx = fmaxf(mx, sacc[1][i]); }
    mx = fmaxf(mx, __shfl_xor(mx, 32));
    const float mn = fmaxf(m, mx);
    const float alpha = __builtin_amdgcn_exp2f(m - mn);
    m = mn;
    float ps = 0.f;
#pragma unroll
    for (int i = 0; i < 16; ++i) {
      sacc[0][i] = __builtin_amdgcn_exp2f(sacc[0][i] - mn); sacc[1][i] = __builtin_amdgcn_exp2f(sacc[1][i] - mn);
      ps += sacc[0][i] + sacc[1][i];
    }
    lsum = lsum * alpha + ps;
#pragma unroll
    for (int i = 0; i < 16; ++i) { oacc[0][i] *= alpha; oacc[1][i] *= alpha; }
#pragma unroll
    for (int k2 = 0; k2 < 2; ++k2)
#pragma unroll
      for (int s2 = 0; s2 < 2; ++s2) {
        bf16x8 pf = pack8(sacc[k2], s2);
        int kb0 = 32 * k2 + 16 * s2 + 4 * hh;
#pragma unroll
        for (int d = 0; d < 2; ++d) {
          u32x2 lo = *(const u32x2*)(Vs + (32 * d + r) * VST + kb0);
          u32x2 hi = *(const u32x2*)(Vs + (32 * d + r) * VST + kb0 + 8);
          u32x4 va; va[0] = lo[0]; va[1] = lo[1]; va[2] = hi[0]; va[3] = hi[1];
          oacc[d] = MFMA32(__builtin_bit_cast(bf16x8, va), pf, oacc[d]);
        }
      }
    __syncthreads();
  }
  lsum += __shfl_xor(lsum, 32);
  const float inv = 1.f / lsum;
  bf16_t* YM = (bf16_t*)(p.ws + OFF_H) + (size_t)qrow * DM + head * 64;
#pragma unroll
  for (int d = 0; d < 2; ++d)
#pragma unroll
    for (int q = 0; q < 4; ++q) {
      u32x2 o; o[0] = pack2(oacc[d][4 * q] * inv, oacc[d][4 * q + 1] * inv); o[1] = pack2(oacc[d][4 * q + 2] * inv, oacc[d][4 * q + 3] * inv);
      *(u32x2*)(YM + 32 * d + 8 * q + 4 * hh) = o;
    }
}

DI void phase_qkv(const Params& p, int layer, int bid, int nb, char* smem) {
  const int MQ = layer == 0 ? MT : ML;
  const int nq = (MQ / 128) * 3, nkv = (MT / 128) * 4, nst = NB * NCH * 8;
  const float* RS = (const float*)(p.ws + OFF_RSTD);
  EpiQ eq{(bf16_t*)(p.ws + OFF_QB), RS};
  EpiKV ekv{(bf16_t*)(p.ws + OFF_KB), (bf16_t*)(p.ws + OFF_VT), RS};
  const bf16_t* U = (const bf16_t*)(p.ws + OFF_U);
  for (int it = bid; it < nq + nkv + nst; it += nb) {
    if (it < nq) gemm_tile(U, DIN, wt_ptr(p, layer, WT_UQ), 256, (it / 3) * 128, (it % 3) * 128, smem, eq);
    else if (it < nq + nkv) { int j = it - nq; gemm_tile(U + U_CKV, DIN, wt_ptr(p, layer, WT_UKV), 128, (j / 4) * 128, (j % 4) * 128, smem, ekv); }
    else { int j = it - nq - nkv; ssd_state_item(p, layer, j / (NCH * 8), (j / 8) % NCH, j & 7, smem); }
  }
}
DI void phase_att(const Params& p, int layer, int bid, int nb, char* smem) {
  const int natt = 512 + (layer == 0 ? 32 : 0), npass = 512;
  for (int it = bid; it < natt + npass; it += nb) {
    if (it < 512) { int b = it >> 7, head = (it >> 5) & 3, qb = it & 31; attn_item(p, b, head, b * SEQ + qb * 128, qb * 128, true, LK, smem); }
    else if (it < natt) { int j = it - 512; int b = j >> 3, head = (j >> 1) & 3, qb = j & 1; attn_item(p, b, head, ML + b * CTX + qb * 128, qb * 128, false, CTX, smem); }
    else ssd_pass_item(p, it - natt);
  }
}
DI void phase_ssdout(const Params& p, int layer, int bid, int nb, char* smem) {
  for (int it = bid; it < NB * NCH * 8; it += nb) {
    int b = it / (NCH * 8), tc = (it / 8) % NCH, h = it & 7;
    if (layer == 1 && tc < 2) continue;
    ssd_out_item(p, layer, b, tc, h, smem);
  }
}

constexpr int SMEM_BYTES = 40960;
enum { PH_PREP0 = 0, PH_H0, PH_INPROJ, PH_PREP, PH_QKV, PH_ATT, PH_SSDOUT, PH_SSDNORM, PH_WOUT, PH_POSTMIX, PH_FF1, PH_FF2, PH_POSTFFN };

DI void run_phase(const Params& p, int ph, int layer, int bid, int nb, char* smem) {
  switch (ph) {
    case PH_PREP0: phase_prep0(p, bid, nb, smem); break;
    case PH_H0: phase_h0(p, bid, nb); break;
    case PH_INPROJ: phase_inproj(p, layer, bid, nb, smem); break;
    case PH_PREP: phase_prep(p, layer, bid, nb); break;
    case PH_QKV: phase_qkv(p, layer, bid, nb, smem); break;
    case PH_ATT: phase_att(p, layer, bid, nb, smem); break;
    case PH_SSDOUT: phase_ssdout(p, layer, bid, nb, smem); break;
    case PH_SSDNORM: phase_ssdnorm(p, layer, bid, nb); break;
    case PH_WOUT: phase_wout(p, layer, bid, nb, smem); break;
    case PH_POSTMIX: phase_postmix(p, layer, bid, nb); break;
    case PH_FF1: phase_ff1(p, layer, bid, nb, smem); break;
    case PH_FF2: phase_ff2(p, layer, bid, nb, smem); break;
    case PH_POSTFFN: phase_postffn(p, layer, bid, nb); break;
  }
}

template <int PH>
__global__ void __launch_bounds__(256) phase_kernel(Params p, int layer) {
  __shared__ __attribute__((aligned(16))) char smem[SMEM_BYTES];
  run_phase(p, PH, layer, blockIdx.x, gridDim.x, smem);
}

__global__ void __launch_bounds__(256, 2) mega_kernel(Params p) {
  __shared__ __attribute__((aligned(16))) char smem[SMEM_BYTES];
  cg::grid_group grid = cg::this_grid();
  const int bid = blockIdx.x, nb = gridDim.x;
  for (int step = 0; step < 24; ++step) {
    int ph, layer;
    if (step < 2) { ph = step; layer = 0; }
    else { int j = step - 2; layer = j / 11; ph = PH_INPROJ + j % 11; }
    run_phase(p, ph, layer, bid, nb, smem);
    if (step < 23) grid.sync();
  }
}

extern "C" void kernel_launch(void* const* d_in, const int* in_sizes, int n_in, void* d_out, int out_size, void* d_ws, size_t ws_size,
                              hipStream_t stream) {
  if (ws_size < WS_NEED) { fprintf(stderr, "workspace too small: %zu < %zu\n", ws_size, (size_t)WS_NEED); return; }
  Params p{};
  const float** f = (const float**)&p;
  for (int i = 0; i < 25; ++i) f[i] = (const float*)d_in[i];
  p.out = (float*)d_out;
  p.ws = (char*)d_ws;
#if MEGA
  static int grid_blocks = 0;
  if (!grid_blocks) {
    int dev = 0, cus = 0, per_cu = 0;
    hipGetDevice(&dev);
    hipDeviceGetAttribute(&cus, hipDeviceAttributeMultiprocessorCount, dev);
    hipOccupancyMaxActiveBlocksPerMultiprocessor(&per_cu, mega_kernel, 256, 0);
    if (per_cu > 2) per_cu = 2;
    grid_blocks = cus * per_cu;
  }
  void* args[] = {&p};
  hipError_t e = hipLaunchCooperativeKernel((void*)mega_kernel, dim3(grid_blocks), dim3(256), args, 0, stream);
  if (e != hipSuccess) fprintf(stderr, "cooperative launch failed: %s (grid %d)\n", hipGetErrorString(e), grid_blocks);
#else
  const int G = 1024;
  phase_kernel<PH_PREP0><<<G, 256, 0, stream>>>(p, 0);
  phase_kernel<PH_H0><<<G, 256, 0, stream>>>(p, 0);
  for (int layer = 0; layer < 2; ++layer) {
    phase_kernel<PH_INPROJ><<<G, 256, 0, stream>>>(p, layer);
    phase_kernel<PH_PREP><<<G, 256, 0, stream>>>(p, layer);
    phase_kernel<PH_QKV><<<G, 256, 0, stream>>>(p, layer);
    phase_kernel<PH_ATT><<<G, 256, 0, stream>>>(p, layer);
    phase_kernel<PH_SSDOUT><<<G, 256, 0, stream>>>(p, layer);
    phase_kernel<PH_SSDNORM><<<G, 256, 0, stream>>>(p, layer);
    phase_kernel<PH_WOUT><<<G, 256, 0, stream>>>(p, layer);
    phase_kernel<PH_POSTMIX><<<G, 256, 0, stream>>>(p, layer);
    phase_kernel<PH_FF1><<<G, 256, 0, stream>>>(p, layer);
    phase_kernel<PH_FF2><<<G, 256, 0, stream>>>(p, layer);
    phase_kernel<PH_POSTFFN><<<G, 256, 0, stream>>>(p, layer);
  }
#endif
}
```

```cpp
#include <hip/hip_runtime.h>
#include <hip/hip_cooperative_groups.h>
#include <stdint.h>
#include <stdio.h>
namespace cg = cooperative_groups;

#ifndef MEGA
#define MEGA 1
#endif
#ifndef REP_GEMM
#define REP_GEMM 1
#endif
#ifndef REP_ATT
#define REP_ATT 1
#endif
#ifndef REP_SSD
#define REP_SSD 1
#endif

typedef unsigned short bf16_t;
using bf16x8 = __attribute__((ext_vector_type(8))) short;
using s16x4  = __attribute__((ext_vector_type(4))) short;
using f32x4  = __attribute__((ext_vector_type(4))) float;
using f32x16 = __attribute__((ext_vector_type(16))) float;
using u32x4  = __attribute__((ext_vector_type(4))) unsigned;
using u32x2  = __attribute__((ext_vector_type(2))) unsigned;
#define DI __device__ __forceinline__
#define MFMA32(a, b, c) __builtin_amdgcn_mfma_f32_32x32x16_bf16((a), (b), (c), 0, 0, 0)
#define MFMA16(a, b, c) __builtin_amdgcn_mfma_f32_16x16x32_bf16((a), (b), (c), 0, 0, 0)

constexpr int DM = 1024, NB = 4, SEQ = 4096, CTX = 256;
constexpr int ML = NB * SEQ;
constexpr int MC = NB * CTX;
constexpr int MT = ML + MC;
constexpr int DIN = 2480, DINP = 2560;
constexpr int LK = CTX + SEQ;
constexpr int DFF = 4096;
constexpr int NCH = 34;
constexpr float EPS = 1e-6f;
constexpr int U_CKV = 256, U_KR = 384, U_GB = 416, U_GC = 672, U_VAL = 928, U_Z = 1184, U_XBC = 1696, U_DT = 2464;

constexpr size_t AL(size_t x) { return (x + 255) & ~(size_t)255; }
constexpr size_t WT_IN = 0;
constexpr size_t WT_UQ = WT_IN + (size_t)DINP * 1024;
constexpr size_t WT_UKV = WT_UQ + (size_t)384 * 256;
constexpr size_t WT_OUT = WT_UKV + (size_t)512 * 128;
constexpr size_t WT_FF1 = WT_OUT + (size_t)1024 * 1024;
constexpr size_t WT_FF2 = WT_FF1 + (size_t)4096 * 1024;
constexpr size_t WT_ELEMS = WT_FF2 + (size_t)4096 * 1024;
constexpr size_t OFF_WT = 0;
constexpr size_t OFF_MOD = AL(OFF_WT + 2 * WT_ELEMS * 2);
constexpr size_t OFF_XC = AL(OFF_MOD + 2 * 5 * 6144 * 4);
constexpr size_t OFF_H = AL(OFF_XC + (size_t)MC * DM * 4);
constexpr size_t OFF_R1 = AL(OFF_H + (size_t)MT * DM * 2);
constexpr size_t OFF_U = OFF_R1;
constexpr size_t OFF_DT = AL(OFF_U + (size_t)MT * DIN * 2);
constexpr size_t OFF_RSTD = AL(OFF_DT + (size_t)MT * 16 * 4);
constexpr size_t OFF_QB = AL(OFF_RSTD + (size_t)MT * 2 * 4);
constexpr size_t OFF_KB = AL(OFF_QB + (size_t)MT * 384 * 2);
constexpr size_t OFF_VT = AL(OFF_KB + (size_t)NB * 4 * LK * 96 * 2);
constexpr size_t OFF_XBC = AL(OFF_VT + (size_t)NB * 4 * 64 * LK * 2);
constexpr size_t OFF_SST = AL(OFF_XBC + (size_t)MT * 768 * 2);
constexpr size_t OFF_TDEC = AL(OFF_SST + (size_t)2 * NB * NCH * 8 * 4096 * 2);
constexpr size_t OFF_SSQ = AL(OFF_TDEC + (size_t)2 * NB * NCH * 8 * 4);
constexpr size_t OFF_END1 = AL(OFF_SSQ + (size_t)MT * 8 * 4);
constexpr size_t OFF_F1 = OFF_R1;
constexpr size_t OFF_END2 = AL(OFF_F1 + (size_t)MT * DFF * 2);
constexpr size_t OFF_BAR = OFF_END1 > OFF_END2 ? OFF_END1 : OFF_END2;
constexpr size_t WS_NEED = OFF_BAR + 16384;

struct Params {
  const float *x, *c, *ctx, *c_ctx, *w_mod, *b_mod, *g_pre_mix, *w_in, *q_norm, *w_uq, *kv_norm, *w_ukv, *sc_w, *ssd_cw, *ssd_cb,
      *a_log, *dt_bias, *ssd_d, *ssd_norm, *w_out, *g_post_mix, *g_pre_ffn, *w_ff1, *w_ff2, *g_post_ffn;
  float* out;
  char* ws;
};

DI int ltid() { int t = threadIdx.x; asm volatile("" : "+v"(t)); return t; }
DI bf16_t f2bf(float x) { unsigned u = __float_as_uint(x); u += 0x7fffu + ((u >> 16) & 1u); return (bf16_t)(u >> 16); }
DI float bf2f(unsigned v) { return __uint_as_float(v << 16); }
DI unsigned pack2(float a, float b) { return (unsigned)f2bf(a) | ((unsigned)f2bf(b) << 16); }
DI float lo2f(unsigned w) { return __uint_as_float(w << 16); }
DI float hi2f(unsigned w) { return __uint_as_float(w & 0xffff0000u); }
DI float wave_sum(float v) {
#pragma unroll
  for (int o = 32; o > 0; o >>= 1) v += __shfl_xor(v, o);
  return v;
}
DI float silu_f(float x) { return x / (1.f + __expf(-x)); }
DI int crow(int reg, int h) { return (reg & 3) + 8 * (reg >> 2) + 4 * h; }
DI bf16x8 pack8(const f32x16& x, int s) {
  u32x4 p;
  p[0] = pack2(x[8 * s + 0], x[8 * s + 1]); p[1] = pack2(x[8 * s + 2], x[8 * s + 3]);
  p[2] = pack2(x[8 * s + 4], x[8 * s + 5]); p[3] = pack2(x[8 * s + 6], x[8 * s + 7]);
  return __builtin_bit_cast(bf16x8, p);
}
DI const float* xin_row(const Params& p, int layer, int row) {
  if (layer == 0) return row < ML ? p.x + (size_t)row * DM : p.ctx + (size_t)(row - ML) * DM;
  return row < ML ? p.out + (size_t)row * DM : (const float*)(p.ws + OFF_XC) + (size_t)(row - ML) * DM;
}
DI float* xst_row(const Params& p, int row) {
  return row < ML ? p.out + (size_t)row * DM : (float*)(p.ws + OFF_XC) + (size_t)(row - ML) * DM;
}
DI const float* mod_ptr(const Params& p, int layer, int row, int which) {
  int bb = row < ML ? (row >> 12) : 4;
  return (const float*)(p.ws + OFF_MOD) + ((size_t)(layer * 5 + bb) * 6 + which) * DM;
}
DI bf16_t* wt_ptr(const Params& p, int layer, size_t off) { return (bf16_t*)(p.ws + OFF_WT) + (size_t)layer * WT_ELEMS + off; }

DI void transpose_item(const float* __restrict__ w, const float* __restrict__ gk, bf16_t* __restrict__ wt, int K, int N, int kt, int nt, char* smem) {
  float* tile = (float*)smem;
  const int tx = ltid() & 63, ty = ltid() >> 6;
  const int k0 = kt * 64, n0 = nt * 64;
#pragma unroll 4
  for (int i = 0; i < 16; ++i) {
    int kk = ty + 4 * i, n = n0 + tx;
    float v = 0.f;
    if (n < N) { v = w[(size_t)(k0 + kk) * N + n]; if (gk) v *= gk[k0 + kk]; }
    tile[kk * 65 + tx] = v;
  }
  __syncthreads();
#pragma unroll 4
  for (int i = 0; i < 16; ++i) {
    int nn = ty + 4 * i;
    wt[(size_t)(n0 + nn) * K + k0 + tx] = f2bf(tile[tx * 65 + nn]);
  }
  __syncthreads();
}

DI void modgemv_item(const Params& p, int layer, int ct, char* smem) {
  float* s = (float*)smem;
  float* red = s + 5 * 1024;
  const int tid = ltid(), w = tid >> 6, lane = tid & 63;
  for (int i = tid; i < 5 * 1024; i += 256) {
    int bb = i >> 10, k = i & 1023;
    float v = bb < 4 ? p.c[bb * 1024 + k] : p.c_ctx[k];
    s[i] = silu_f(v);
  }
  __syncthreads();
  const float* wm = p.w_mod + (size_t)layer * 1024 * 6144;
  const int n = ct * 64 + lane;
  float acc[5] = {0.f, 0.f, 0.f, 0.f, 0.f};
  for (int k = w * 256; k < w * 256 + 256; ++k) {
    float wv = wm[(size_t)k * 6144 + n];
#pragma unroll
    for (int bb = 0; bb < 5; ++bb) acc[bb] += s[bb * 1024 + k] * wv;
  }
#pragma unroll
  for (int bb = 0; bb < 5; ++bb) red[(w * 5 + bb) * 64 + lane] = acc[bb];
  __syncthreads();
  for (int i = tid; i < 320; i += 256) {
    int bb = i >> 6, ln = i & 63;
    float v = red[(0 * 5 + bb) * 64 + ln] + red[(1 * 5 + bb) * 64 + ln] + red[(2 * 5 + bb) * 64 + ln] + red[(3 * 5 + bb) * 64 + ln];
    int nn = ct * 64 + ln;
    v += p.b_mod[layer * 6144 + nn];
    ((float*)(p.ws + OFF_MOD))[(size_t)(layer * 5 + bb) * 6144 + nn] = v;
  }
  __syncthreads();
}

DI void phase_prep0(const Params& p, int bid, int nb, char* smem) {
  constexpr int PER = 2984 + 96;
  for (int it = bid; it < 2 * PER; it += nb) {
    int layer = it / PER, j = it % PER;
    if (j < 96) { modgemv_item(p, layer, j, smem); continue; }
    j -= 96;
    if (j < 640) transpose_item(p.w_in + (size_t)layer * 1024 * DIN, nullptr, wt_ptr(p, layer, WT_IN), 1024, DIN, j / 40, j % 40, smem);
    else if ((j -= 640) < 24) transpose_item(p.w_uq + (size_t)layer * 256 * 384, p.q_norm + layer * 256, wt_ptr(p, layer, WT_UQ), 256, 384, j / 6, j % 6, smem);
    else if ((j -= 24) < 16) transpose_item(p.w_ukv + (size_t)layer * 128 * 512, p.kv_norm + layer * 128, wt_ptr(p, layer, WT_UKV), 128, 512, j / 8, j % 8, smem);
    else if ((j -= 16) < 256) transpose_item(p.w_out + (size_t)layer * 1024 * 1024, nullptr, wt_ptr(p, layer, WT_OUT), 1024, 1024, j / 16, j % 16, smem);
    else if ((j -= 256) < 1024) transpose_item(p.w_ff1 + (size_t)layer * 1024 * 4096, nullptr, wt_ptr(p, layer, WT_FF1), 1024, 4096, j / 64, j % 64, smem);
    else { j -= 1024; transpose_item(p.w_ff2 + (size_t)layer * 4096 * 1024, nullptr, wt_ptr(p, layer, WT_FF2), 4096, 1024, j / 16, j % 16, smem); }
  }
}

DI void write_h_row(const float4 xv[4], float rstd, const float* g, const float* sh, const float* sc, bf16_t* hrow, int lane) {
#pragma unroll
  for (int i = 0; i < 4; ++i) {
    int col = lane * 4 + 256 * i;
    float4 gg = *(const float4*)(g + col), s1 = *(const float4*)(sc + col), s0 = *(const float4*)(sh + col);
    float a = xv[i].x * rstd * gg.x * (1.f + s1.x) + s0.x;
    float b = xv[i].y * rstd * gg.y * (1.f + s1.y) + s0.y;
    float c = xv[i].z * rstd * gg.z * (1.f + s1.z) + s0.z;
    float d = xv[i].w * rstd * gg.w * (1.f + s1.w) + s0.w;
    u32x2 o; o[0] = pack2(a, b); o[1] = pack2(c, d);
    *(u32x2*)(hrow + col) = o;
  }
}
DI float ssq4(const float4 v[4]) {
  float s = 0.f;
#pragma unroll
  for (int i = 0; i < 4; ++i) s += v[i].x * v[i].x + v[i].y * v[i].y + v[i].z * v[i].z + v[i].w * v[i].w;
  return s;
}
DI void load_bf_row(const bf16_t* r, int lane, float4 v[4]) {
#pragma unroll
  for (int i = 0; i < 4; ++i) {
    u32x2 t = *(const u32x2*)(r + lane * 4 + 256 * i);
    v[i] = make_float4(lo2f(t[0]), hi2f(t[0]), lo2f(t[1]), hi2f(t[1]));
  }
}

DI void phase_h0(const Params& p, int bid, int nb) {
  const int w = ltid() >> 6, lane = ltid() & 63;
  bf16_t* H = (bf16_t*)(p.ws + OFF_H);
  for (int row = bid * 4 + w; row < MT; row += nb * 4) {
    const float* xr = xin_row(p, 0, row);
    float4 xv[4];
#pragma unroll
    for (int i = 0; i < 4; ++i) xv[i] = *(const float4*)(xr + lane * 4 + 256 * i);
    float rstd = rsqrtf(wave_sum(ssq4(xv)) * (1.f / DM) + EPS);
    write_h_row(xv, rstd, p.g_pre_mix, mod_ptr(p, 0, row, 0), mod_ptr(p, 0, row, 1), H + (size_t)row * DM, lane);
  }
}

DI void phase_postmix(const Params& p, int layer, int bid, int nb) {
  const int w = ltid() >> 6, lane = ltid() & 63;
  const int M = layer == 0 ? MT : ML;
  bf16_t* H = (bf16_t*)(p.ws + OFF_H);
  const bf16_t* Y = (const bf16_t*)(p.ws + OFF_U);
  for (int row = bid * 4 + w; row < M; row += nb * 4) {
    float4 yv[4], xv[4];
    load_bf_row(Y + (size_t)row * DM, lane, yv);
    const float* xr = xin_row(p, layer, row);
#pragma unroll
    for (int i = 0; i < 4; ++i) xv[i] = *(const float4*)(xr + lane * 4 + 256 * i);
    float rstd = rsqrtf(wave_sum(ssq4(yv)) * (1.f / DM) + EPS);
    const float* g1 = mod_ptr(p, layer, row, 2);
    const float* gp = p.g_post_mix + layer * DM;
    float* xo = xst_row(p, row);
#pragma unroll
    for (int i = 0; i < 4; ++i) {
      int col = lane * 4 + 256 * i;
      float4 a = *(const float4*)(g1 + col), b = *(const float4*)(gp + col);
      xv[i].x += a.x * yv[i].x * rstd * b.x; xv[i].y += a.y * yv[i].y * rstd * b.y;
      xv[i].z += a.z * yv[i].z * rstd * b.z; xv[i].w += a.w * yv[i].w * rstd * b.w;
      *(float4*)(xo + col) = xv[i];
    }
    float rstd1 = rsqrtf(wave_sum(ssq4(xv)) * (1.f / DM) + EPS);
    write_h_row(xv, rstd1, p.g_pre_ffn + layer * DM, mod_ptr(p, layer, row, 3), mod_ptr(p, layer, row, 4), H + (size_t)row * DM, lane);
  }
}

DI void phase_postffn(const Params& p, int layer, int bid, int nb) {
  const int w = ltid() >> 6, lane = ltid() & 63;
  const int M = layer == 0 ? MT : ML;
  bf16_t* H = (bf16_t*)(p.ws + OFF_H);
  for (int row = bid * 4 + w; row < M; row += nb * 4) {
    float4 fv[4], xv[4];
    load_bf_row(H + (size_t)row * DM, lane, fv);
    float* xo = xst_row(p, row);
#pragma unroll
    for (int i = 0; i < 4; ++i) xv[i] = *(const float4*)(xo + lane * 4 + 256 * i);
    float rstd = rsqrtf(wave_sum(ssq4(fv)) * (1.f / DM) + EPS);
    const float* g2 = mod_ptr(p, layer, row, 5);
    const float* gp = p.g_post_ffn + layer * DM;
#pragma unroll
    for (int i = 0; i < 4; ++i) {
      int col = lane * 4 + 256 * i;
      float4 a = *(const float4*)(g2 + col), b = *(const float4*)(gp + col);
      xv[i].x += a.x * fv[i].x * rstd * b.x; xv[i].y += a.y * fv[i].y * rstd * b.y;
      xv[i].z += a.z * fv[i].z * rstd * b.z; xv[i].w += a.w * fv[i].w * rstd * b.w;
      *(float4*)(xo + col) = xv[i];
    }
    if (layer == 0) {
      float rstd1 = rsqrtf(wave_sum(ssq4(xv)) * (1.f / DM) + EPS);
      write_h_row(xv, rstd1, p.g_pre_mix + DM, mod_ptr(p, 1, row, 0), mod_ptr(p, 1, row, 1), H + (size_t)row * DM, lane);
    }
  }
}

DI void phase_prep(const Params& p, int layer, int bid, int nb) {
  const int w = ltid() >> 6, lane = ltid() & 63;
  const bf16_t* U = (const bf16_t*)(p.ws + OFF_U);
  float* DT = (float*)(p.ws + OFF_DT);
  float* RS = (float*)(p.ws + OFF_RSTD);
  bf16_t* KB = (bf16_t*)(p.ws + OFF_KB);
  bf16_t* XBC = (bf16_t*)(p.ws + OFF_XBC);
  bf16_t* YM = (bf16_t*)(p.ws + OFF_H);
  const float* scw = p.sc_w + layer * 3 * 256;
  const float* cw = p.ssd_cw + layer * 3 * 768;
  const float* cb = p.ssd_cb + layer * 768;
  for (int row = bid * 4 + w; row < MT; row += nb * 4) {
    int b, t, L, pos;
    bool lat = row < ML;
    if (lat) { b = row >> 12; t = row & 4095; L = SEQ; pos = t + CTX; }
    else { int rr = row - ML; b = rr >> 8; t = rr & 255; L = CTX; pos = t; }
    const bf16_t* u0 = U + (size_t)row * DIN;
    const bool hp = t > 0, hn = t < L - 1;
    const bf16_t* um = u0 - DIN;
    const bf16_t* up = u0 + DIN;
    {
      u32x2 v = *(const u32x2*)(u0 + lane * 4);
      float a = lo2f(v[0]), bq = hi2f(v[0]), c = lo2f(v[1]), d = hi2f(v[1]);
      float ss = wave_sum(a * a + bq * bq + c * c + d * d);
      float s2 = 0.f;
      if (lane < 32) {
        u32x2 v2 = *(const u32x2*)(u0 + U_CKV + lane * 4);
        float e = lo2f(v2[0]), f = hi2f(v2[0]), g = lo2f(v2[1]), h = hi2f(v2[1]);
        s2 = e * e + f * f + g * g + h * h;
      }
      s2 = wave_sum(s2);
      if (lane == 0) { RS[row * 2] = rsqrtf(ss * (1.f / 256) + EPS); RS[row * 2 + 1] = rsqrtf(s2 * (1.f / 128) + EPS); }
    }
    {
      float v = bf2f(u0[U_KR + (lane & 31)]);
      float partner = __shfl_xor(v, 8);
      float o = v;
      if (lat) {
        int grp = (lane & 31) >> 3, i = lane & 7;
        float posf = grp < 2 ? (float)(t >> 6) : (float)(t & 63);
        float invf = exp2f(-(float)(2 * i) * (13.287712379549449f / 16.f));
        float ang = posf * invf;
        float rev = ang * 0.15915494309189535f;
        float cs = __builtin_amdgcn_cosf(rev), sn = __builtin_amdgcn_sinf(rev);
        o = (grp & 1) ? v * cs + partner * sn : v * cs - partner * sn;
      }
      if (lane < 32) {
        bf16_t ob = f2bf(o);
#pragma unroll
        for (int hd = 0; hd < 4; ++hd) KB[((size_t)(b * 4 + hd) * LK + pos) * 96 + 64 + lane] = ob;
      }
    }
    {
      int c = lane * 4;
      float acc[4] = {0.f, 0.f, 0.f, 0.f};
#pragma unroll
      for (int k = 0; k < 3; ++k) {
        const bf16_t* ur = k == 0 ? um : (k == 1 ? u0 : up);
        bool ok = k == 0 ? hp : (k == 1 ? true : hn);
        if (ok) {
          u32x2 gc = *(const u32x2*)(ur + U_GC + c), vv = *(const u32x2*)(ur + U_VAL + c);
          float4 wk = *(const float4*)(scw + k * 256 + c);
          acc[0] += wk.x * lo2f(gc[0]) * lo2f(vv[0]); acc[1] += wk.y * hi2f(gc[0]) * hi2f(vv[0]);
          acc[2] += wk.z * lo2f(gc[1]) * lo2f(vv[1]); acc[3] += wk.w * hi2f(gc[1]) * hi2f(vv[1]);
        }
      }
      u32x2 gb = *(const u32x2*)(u0 + U_GB + c);
      u32x2 o; o[0] = pack2(lo2f(gb[0]) * acc[0], hi2f(gb[0]) * acc[1]); o[1] = pack2(lo2f(gb[1]) * acc[2], hi2f(gb[1]) * acc[3]);
      *(u32x2*)(YM + (size_t)row * DM + 256 + c) = o;
    }
#pragma unroll
    for (int i = 0; i < 3; ++i) {
      int c = lane * 4 + 256 * i;
      float4 bias = *(const float4*)(cb + c);
      float acc[4] = {bias.x, bias.y, bias.z, bias.w};
#pragma unroll
      for (int k = 0; k < 3; ++k) {
        const bf16_t* ur = k == 0 ? um : (k == 1 ? u0 : up);
        bool ok = k == 0 ? hp : (k == 1 ? true : hn);
        if (ok) {
          u32x2 vv = *(const u32x2*)(ur + U_XBC + c);
          float4 wk = *(const float4*)(cw + k * 768 + c);
          acc[0] += wk.x * lo2f(vv[0]); acc[1] += wk.y * hi2f(vv[0]); acc[2] += wk.z * lo2f(vv[1]); acc[3] += wk.w * hi2f(vv[1]);
        }
      }
      u32x2 o; o[0] = pack2(silu_f(acc[0]), silu_f(acc[1])); o[1] = pack2(silu_f(acc[2]), silu_f(acc[3]));
      *(u32x2*)(XBC + (size_t)row * 768 + c) = o;
    }
    if (lane < 16) {
      float v = DT[(size_t)row * 16 + lane] + p.dt_bias[layer * 16 + lane];
      float sp = fmaxf(v, 0.f) + log1pf(__expf(-fabsf(v)));
      DT[(size_t)row * 16 + lane] = sp;
    }
  }
}

DI void phase_ssdnorm(const Params& p, int layer, int bid, int nb) {
  const int w = ltid() >> 6, lane = ltid() & 63;
  const int M = layer == 0 ? MT : ML;
  bf16_t* YM = (bf16_t*)(p.ws + OFF_H);
  const float* SSQ = (const float*)(p.ws + OFF_SSQ);
  const float* ng = p.ssd_norm + layer * 512;
  for (int row = bid * 4 + w; row < M; row += nb * 4) {
    int g = lane >> 5;
    float4 s = *(const float4*)(SSQ + (size_t)row * 8 + g * 4);
    float rstd = rsqrtf((s.x + s.y + s.z + s.w) * (1.f / 256) + EPS);
    bf16_t* ptr = YM + (size_t)row * DM + 512 + lane * 8;
    u32x4 v = *(const u32x4*)ptr;
    float4 g0 = *(const float4*)(ng + lane * 8), g1 = *(const float4*)(ng + lane * 8 + 4);
    u32x4 o;
    o[0] = pack2(lo2f(v[0]) * rstd * g0.x, hi2f(v[0]) * rstd * g0.y);
    o[1] = pack2(lo2f(v[1]) * rstd * g0.z, hi2f(v[1]) * rstd * g0.w);
    o[2] = pack2(lo2f(v[2]) * rstd * g1.x, hi2f(v[2]) * rstd * g1.y);
    o[3] = pack2(lo2f(v[3]) * rstd * g1.z, hi2f(v[3]) * rstd * g1.w);
    *(u32x4*)ptr = o;
  }
}

constexpr int GST = 72;
template <class Epi>
DI void gemm_tile(const bf16_t* __restrict__ A, int lda, const bf16_t* __restrict__ Bt, int K, int row0, int col0, char* smem, Epi epi) {
  bf16_t* As = (bf16_t*)smem;
  bf16_t* Bs = As + 128 * GST;
  const int tid = ltid(), wid = tid >> 6, lane = tid & 63, wr = wid >> 1, wc = wid & 1, fr = lane & 15, fq = lane >> 4;
  f32x4 acc[4][4];
#pragma unroll
  for (int m = 0; m < 4; ++m)
#pragma unroll
    for (int n = 0; n < 4; ++n) acc[m][n] = f32x4{0.f, 0.f, 0.f, 0.f};
  u32x4 ra[4], rb[4];
  const int sr = tid >> 3, sp = tid & 7;
  const bf16_t* ga = A + (size_t)(row0 + sr) * lda + sp * 8;
  const bf16_t* gb = Bt + (size_t)(col0 + sr) * K + sp * 8;
  auto gload = [&](int k0) {
#pragma unroll
    for (int i = 0; i < 4; ++i) {
      ra[i] = *(const u32x4*)(ga + (size_t)(32 * i) * lda + k0);
      rb[i] = *(const u32x4*)(gb + (size_t)(32 * i) * K + k0);
    }
  };
  gload(0);
  const int KT = K / 64;
  for (int kt = 0; kt < KT; ++kt) {
#pragma unroll
    for (int i = 0; i < 4; ++i) {
      *(u32x4*)(As + (sr + 32 * i) * GST + sp * 8) = ra[i];
      *(u32x4*)(Bs + (sr + 32 * i) * GST + sp * 8) = rb[i];
    }
    __syncthreads();
    if (kt + 1 < KT) gload((kt + 1) * 64);
#pragma unroll
    for (int ks = 0; ks < 2; ++ks) {
      bf16x8 af[4], bfr[4];
#pragma unroll
      for (int m = 0; m < 4; ++m) af[m] = *(const bf16x8*)(As + (wr * 64 + m * 16 + fr) * GST + ks * 32 + fq * 8);
#pragma unroll
      for (int n = 0; n < 4; ++n) bfr[n] = *(const bf16x8*)(Bs + (wc * 64 + n * 16 + fr) * GST + ks * 32 + fq * 8);
#pragma unroll
      for (int m = 0; m < 4; ++m)
#pragma unroll
        for (int n = 0; n < 4; ++n) acc[m][n] = MFMA16(af[m], bfr[n], acc[m][n]);
    }
    __syncthreads();
  }
#pragma unroll
  for (int m = 0; m < 4; ++m)
#pragma unroll
    for (int n = 0; n < 4; ++n) epi(row0 + wr * 64 + m * 16 + fq * 4, col0 + wc * 64 + n * 16 + fr, acc[m][n]);
}

struct EpiBF {
  bf16_t* out; int ldo;
  DI void operator()(int row, int col, const f32x4& a) const {
#pragma unroll
    for (int j = 0; j < 4; ++j) out[(size_t)(row + j) * ldo + col] = f2bf(a[j]);
  }
};
struct EpiRelu2 {
  bf16_t* out; int ldo;
  DI void operator()(int row, int col, const f32x4& a) const {
#pragma unroll
    for (int j = 0; j < 4; ++j) { float r = fmaxf(a[j], 0.f); out[(size_t)(row + j) * ldo + col] = f2bf(r * r); }
  }
};
struct EpiU {
  bf16_t* u; float* dt;
  DI void operator()(int row, int col, const f32x4& a) const {
    if (col < DIN) {
#pragma unroll
      for (int j = 0; j < 4; ++j) u[(size_t)(row + j) * DIN + col] = f2bf(a[j]);
      if (col >= U_DT) {
#pragma unroll
        for (int j = 0; j < 4; ++j) dt[(size_t)(row + j) * 16 + col - U_DT] = a[j];
      }
    }
  }
};
struct EpiQ {
  bf16_t* q; const float* rs;
  DI void operator()(int row, int col, const f32x4& a) const {
#pragma unroll
    for (int j = 0; j < 4; ++j) q[(size_t)(row + j) * 384 + col] = f2bf(a[j] * rs[(row + j) * 2]);
  }
};
struct EpiKV {
  bf16_t* kb; bf16_t* vt; const float* rs;
  DI void operator()(int row, int col, const f32x4& a) const {
    int b, pos;
    if (row < ML) { b = row >> 12; pos = (row & 4095) + CTX; } else { int rr = row - ML; b = rr >> 8; pos = rr & 255; }
    int head = col >> 7, d = col & 127;
    float v[4];
#pragma unroll
    for (int j = 0; j < 4; ++j) v[j] = a[j] * rs[(row + j) * 2 + 1];
    if (d < 64) {
#pragma unroll
      for (int j = 0; j < 4; ++j) kb[((size_t)(b * 4 + head) * LK + pos + j) * 96 + d] = f2bf(v[j]);
    } else {
      u32x2 o; o[0] = pack2(v[0], v[1]); o[1] = pack2(v[2], v[3]);
      *(u32x2*)(vt + ((size_t)(b * 4 + head) * 64 + (d - 64)) * LK + pos) = o;
    }
  }
};

DI void phase_inproj(const Params& p, int layer, int bid, int nb, char* smem) {
  constexpr int NT = DINP / 128;
  EpiU epi{(bf16_t*)(p.ws + OFF_U), (float*)(p.ws + OFF_DT)};
  for (int rep = 0; rep < REP_GEMM; ++rep)
  for (int it = bid; it < (MT / 128) * NT; it += nb)
    gemm_tile((const bf16_t*)(p.ws + OFF_H), DM, wt_ptr(p, layer, WT_IN), 1024, (it / NT) * 128, (it % NT) * 128, smem, epi);
}
DI void phase_wout(const Params& p, int layer, int bid, int nb, char* smem) {
  const int M = layer == 0 ? MT : ML;
  EpiBF epi{(bf16_t*)(p.ws + OFF_U), DM};
  for (int rep = 0; rep < REP_GEMM; ++rep)
  for (int it = bid; it < (M / 128) * 8; it += nb)
    gemm_tile((const bf16_t*)(p.ws + OFF_H), DM, wt_ptr(p, layer, WT_OUT), 1024, (it / 8) * 128, (it % 8) * 128, smem, epi);
}
DI void phase_ff1(const Params& p, int layer, int bid, int nb, char* smem) {
  const int M = layer == 0 ? MT : ML;
  EpiRelu2 epi{(bf16_t*)(p.ws + OFF_F1), DFF};
  for (int rep = 0; rep < REP_GEMM; ++rep)
  for (int it = bid; it < (M / 128) * 32; it += nb)
    gemm_tile((const bf16_t*)(p.ws + OFF_H), DM, wt_ptr(p, layer, WT_FF1), 1024, (it / 32) * 128, (it % 32) * 128, smem, epi);
}
DI void phase_ff2(const Params& p, int layer, int bid, int nb, char* smem) {
  const int M = layer == 0 ? MT : ML;
  EpiBF epi{(bf16_t*)(p.ws + OFF_H), DM};
  for (int rep = 0; rep < REP_GEMM; ++rep)
  for (int it = bid; it < (M / 128) * 8; it += nb)
    gemm_tile((const bf16_t*)(p.ws + OFF_F1), DFF, wt_ptr(p, layer, WT_FF2), 4096, (it / 8) * 128, (it % 8) * 128, smem, epi);
}

DI int chunk_row0(int b, int tc) { return tc < 2 ? ML + b * CTX + tc * 128 : b * SEQ + (tc - 2) * 128; }
constexpr int TST = 136;
DI void load_tile_T(bf16_t* dst, const bf16_t* __restrict__ src, int ldg) {
  const int tid = ltid();
#pragma unroll
  for (int i = 0; i < 4; ++i) {
    int c = tid + 256 * i, tok = c & 127, pc = c >> 7;
    u32x4 v = *(const u32x4*)(src + (size_t)tok * ldg + pc * 8);
#pragma unroll
    for (int j = 0; j < 4; ++j) {
      dst[(pc * 8 + 2 * j) * TST + tok] = (bf16_t)(v[j] & 0xffffu);
      dst[(pc * 8 + 2 * j + 1) * TST + tok] = (bf16_t)(v[j] >> 16);
    }
  }
}
DI void chunk_scan(const Params& p, int layer, int row0, int h, float* csf, float* csb, float* dtF, float* dtB, float* laF, float* laB) {
  const int tid = ltid();
  const float* DT = (const float*)(p.ws + OFF_DT);
  if (tid < 128) {
    float af = -__expf(p.a_log[layer * 16 + h]), ab = -__expf(p.a_log[layer * 16 + 8 + h]);
    float df = DT[(size_t)(row0 + tid) * 16 + h], db = DT[(size_t)(row0 + tid) * 16 + 8 + h];
    dtF[tid] = df; dtB[tid] = db; laF[tid] = df * af; laB[tid] = db * ab;
  }
  __syncthreads();
  if (tid < 128) {
    float s = 0.f;
    for (int l = 0; l <= tid; ++l) s += laF[l];
    csf[tid] = s;
  } else {
    int t = tid - 128;
    float s = 0.f;
    for (int l = 127; l >= t; --l) s += laB[l];
    csb[t] = s;
  }
  __syncthreads();
}

DI void ssd_state_item(const Params& p, int layer, int b, int tc, int h, char* smem) {
  bf16_t* XT = (bf16_t*)smem;
  bf16_t* BT = XT + 64 * TST;
  float* csf = (float*)(BT + 64 * TST);
  float* csb = csf + 128; float* dtF = csb + 128; float* dtB = dtF + 128; float* laF = dtB + 128; float* laB = laF + 128;
  const int tid = ltid(), w = tid >> 6, lane = tid & 63, r = lane & 31, hh = lane >> 5;
  const int row0 = chunk_row0(b, tc);
  const bf16_t* XBC = (const bf16_t*)(p.ws + OFF_XBC);
  chunk_scan(p, layer, row0, h, csf, csb, dtF, dtB, laF, laB);
  load_tile_T(XT, XBC + (size_t)row0 * 768 + h * 64, 768);
  load_tile_T(BT, XBC + (size_t)row0 * 768 + 512 + (h >> 2) * 64, 768);
  __syncthreads();
  if (tid < 128) laF[tid] = dtF[tid] * __expf(csf[127] - csf[tid]);
  else { int t = tid - 128; laB[t] = dtB[t] * __expf(csb[0] - csb[t]); }
  __syncthreads();
  const int d = w >> 1, pt = w & 1;
  const float* wv = d == 0 ? laF : laB;
  f32x16 acc[2];
#pragma unroll
  for (int i = 0; i < 16; ++i) { acc[0][i] = 0.f; acc[1][i] = 0.f; }
#pragma unroll
  for (int s = 0; s < 8; ++s) {
    int l0 = 16 * s + 8 * hh;
    u32x4 xa = *(const u32x4*)(XT + (32 * pt + r) * TST + l0);
    u32x4 sa;
#pragma unroll
    for (int j = 0; j < 4; ++j) sa[j] = pack2(lo2f(xa[j]) * wv[l0 + 2 * j], hi2f(xa[j]) * wv[l0 + 2 * j + 1]);
    bf16x8 af = __builtin_bit_cast(bf16x8, sa);
#pragma unroll
    for (int nt = 0; nt < 2; ++nt) {
      bf16x8 bfr = *(const bf16x8*)(BT + (32 * nt + r) * TST + l0);
      acc[nt] = MFMA32(af, bfr, acc[nt]);
    }
  }
  bf16_t* S = (bf16_t*)(p.ws + OFF_SST) + ((((size_t)d * NB + b) * NCH + tc) * 8 + h) * 4096;
#pragma unroll
  for (int nt = 0; nt < 2; ++nt)
#pragma unroll
    for (int i = 0; i < 16; ++i) S[(32 * pt + crow(i, hh)) * 64 + 32 * nt + r] = f2bf(acc[nt][i]);
  if (tid == 0) {
    float* TD = (float*)(p.ws + OFF_TDEC);
    TD[((0 * NB + b) * NCH + tc) * 8 + h] = __expf(csf[127]);
    TD[((1 * NB + b) * NCH + tc) * 8 + h] = __expf(csb[0]);
  }
  __syncthreads();
}

DI void ssd_pass_item(const Params& p, int it) {
  const int e = it * 256 + ltid();
  const int pn2 = e & 2047, h = (e >> 11) & 7, b = (e >> 14) & 3, d = e >> 16;
  unsigned* S = (unsigned*)(p.ws + OFF_SST);
  const float* TD = (const float*)(p.ws + OFF_TDEC);
  float h0 = 0.f, h1 = 0.f;
  for (int i = 0; i < NCH; ++i) {
    int tc = d == 0 ? i : (i < 2 ? 1 - i : NCH + 1 - i);
    size_t idx = (((size_t)(d * NB + b) * NCH + tc) * 8 + h) * 2048 + pn2;
    unsigned sv = S[idx];
    float T = TD[((d * NB + b) * NCH + tc) * 8 + h];
    S[idx] = pack2(h0, h1);
    h0 = T * h0 + lo2f(sv); h1 = T * h1 + hi2f(sv);
  }
}

DI void ssd_out_item(const Params& p, int layer, int b, int tc, int h, char* smem) {
  bf16_t* XT = (bf16_t*)smem;
  bf16_t* Bs = XT + 64 * TST;
  float* csf = (float*)(Bs + 128 * GST);
  float* csb = csf + 128; float* dtF = csb + 128; float* dtB = dtF + 128; float* laF = dtB + 128; float* laB = laF + 128;
  const int tid = ltid(), w = tid >> 6, lane = tid & 63, r = lane & 31, hh = lane >> 5;
  const int row0 = chunk_row0(b, tc), g = h >> 2;
  const bf16_t* XBC = (const bf16_t*)(p.ws + OFF_XBC);
  chunk_scan(p, layer, row0, h, csf, csb, dtF, dtB, laF, laB);
  load_tile_T(XT, XBC + (size_t)row0 * 768 + h * 64, 768);
#pragma unroll
  for (int i = 0; i < 4; ++i) {
    int c = tid + 256 * i, tok = c >> 3, part = c & 7;
    *(u32x4*)(Bs + tok * GST + part * 8) = *(const u32x4*)(XBC + (size_t)(row0 + tok) * 768 + 512 + g * 64 + part * 8);
  }
  const int l = 32 * w + r;
  bf16x8 cf[4];
#pragma unroll
  for (int ks = 0; ks < 4; ++ks) cf[ks] = *(const bf16x8*)(XBC + (size_t)(row0 + l) * 768 + 640 + g * 64 + 16 * ks + 8 * hh);
  __syncthreads();
  const float csf_l = csf[l], csb_l = csb[l];
  f32x16 yacc[2];
#pragma unroll
  for (int i = 0; i < 16; ++i) { yacc[0][i] = 0.f; yacc[1][i] = 0.f; }
#pragma unroll
  for (int st = 0; st < 4; ++st) {
    f32x16 gacc;
#pragma unroll
    for (int i = 0; i < 16; ++i) gacc[i] = 0.f;
#pragma unroll
    for (int ks = 0; ks < 4; ++ks) {
      bf16x8 af = *(const bf16x8*)(Bs + (32 * st + r) * GST + 16 * ks + 8 * hh);
      gacc = MFMA32(af, cf[ks], gacc);
    }
#pragma unroll
    for (int i = 0; i < 16; ++i) {
      int s = 32 * st + crow(i, hh);
      float f;
      if (s < l) f = __expf(csf_l - csf[s]) * dtF[s];
      else if (s > l) f = __expf(csb_l - csb[s]) * dtB[s];
      else f = dtF[s] + dtB[s];
      gacc[i] *= f;
    }
#pragma unroll
    for (int s2 = 0; s2 < 2; ++s2) {
      bf16x8 mf = pack8(gacc, s2);
      int sb = 32 * st + 16 * s2 + 4 * hh;
#pragma unroll
      for (int pt = 0; pt < 2; ++pt) {
        u32x2 lo = *(const u32x2*)(XT + (32 * pt + r) * TST + sb);
        u32x2 hi = *(const u32x2*)(XT + (32 * pt + r) * TST + sb + 8);
        u32x4 xa; xa[0] = lo[0]; xa[1] = lo[1]; xa[2] = hi[0]; xa[3] = hi[1];
        yacc[pt] = MFMA32(__builtin_bit_cast(bf16x8, xa), mf, yacc[pt]);
      }
    }
  }
#pragma unroll
  for (int d = 0; d < 2; ++d) {
    const bf16_t* Hs = (const bf16_t*)(p.ws + OFF_SST) + ((((size_t)d * NB + b) * NCH + tc) * 8 + h) * 4096;
    const float e = __expf(d == 0 ? csf_l : csb_l);
#pragma unroll
    for (int pt = 0; pt < 2; ++pt) {
      f32x16 t;
#pragma unroll
      for (int i = 0; i < 16; ++i) t[i] = 0.f;
#pragma unroll
      for (int ks = 0; ks < 4; ++ks) {
        bf16x8 af = *(const bf16x8*)(Hs + (32 * pt + r) * 64 + 16 * ks + 8 * hh);
        t = MFMA32(af, cf[ks], t);
      }
#pragma unroll
      for (int i = 0; i < 16; ++i) yacc[pt][i] += e * t[i];
    }
  }
  const int row = row0 + l;
  const float Dh = p.ssd_d[layer * 8 + h];
  const bf16_t* U = (const bf16_t*)(p.ws + OFF_U);
  bf16_t* YM = (bf16_t*)(p.ws + OFF_H);
  float ssq = 0.f;
#pragma unroll
  for (int pt = 0; pt < 2; ++pt)
#pragma unroll
    for (int q = 0; q < 4; ++q) {
      int pp = 32 * pt + 8 * q + 4 * hh;
      u32x2 xv = *(const u32x2*)(XBC + (size_t)row * 768 + h * 64 + pp);
      u32x2 zv = *(const u32x2*)(U + (size_t)row * DIN + U_Z + h * 64 + pp);
      float y0 = (yacc[pt][4 * q + 0] + Dh * lo2f(xv[0])) * silu_f(lo2f(zv[0]));
      float y1 = (yacc[pt][4 * q + 1] + Dh * hi2f(xv[0])) * silu_f(hi2f(zv[0]));
      float y2 = (yacc[pt][4 * q + 2] + Dh * lo2f(xv[1])) * silu_f(lo2f(zv[1]));
      float y3 = (yacc[pt][4 * q + 3] + Dh * hi2f(xv[1])) * silu_f(hi2f(zv[1]));
      u32x2 o; o[0] = pack2(y0, y1); o[1] = pack2(y2, y3);
      float r0 = lo2f(o[0]), r1 = hi2f(o[0]), r2 = lo2f(o[1]), r3 = hi2f(o[1]);
      ssq += r0 * r0 + r1 * r1 + r2 * r2 + r3 * r3;
      *(u32x2*)(YM + (size_t)row * DM + 512 + h * 64 + pp) = o;
    }
  ssq += __shfl_xor(ssq, 32);
  if (hh == 0) ((float*)(p.ws + OFF_SSQ))[(size_t)row * 8 + h] = ssq;
  __syncthreads();
}

constexpr int KST = 104;
constexpr int VST = 68;
DI void attn_item(const Params& p, int b, int head, int qrow0, int t0, bool lat, int nkeys, char* smem) {
  bf16_t* Ks = (bf16_t*)smem;
  bf16_t* Vs = Ks + 64 * KST;
  const int tid = ltid(), w = tid >> 6, lane = tid & 63, r = lane & 31, hh = lane >> 5;
  const bf16_t* QB = (const bf16_t*)(p.ws + OFF_QB);
  const bf16_t* KB = (const bf16_t*)(p.ws + OFF_KB) + (size_t)(b * 4 + head) * LK * 96;
  const bf16_t* VT = (const bf16_t*)(p.ws + OFF_VT) + (size_t)(b * 4 + head) * 64 * LK;
  const float qscale = 0.10206207261596575f * 1.4426950408889634f;
  const int qrow = qrow0 + w * 32 + r;
  const int t = t0 + w * 32 + r;
  bf16x8 qf[6];
  {
    const bf16_t* src = QB + (size_t)qrow * 384 + head * 96;
#pragma unroll
    for (int s = 0; s < 4; ++s) {
      u32x4 v = *(const u32x4*)(src + 16 * s + 8 * hh);
      u32x4 o;
#pragma unroll
      for (int j = 0; j < 4; ++j) o[j] = pack2(lo2f(v[j]) * qscale, hi2f(v[j]) * qscale);
      qf[s] = __builtin_bit_cast(bf16x8, o);
    }
#pragma unroll
    for (int s = 4; s < 6; ++s) {
      u32x4 va = *(const u32x4*)(src + 16 * s), vb = *(const u32x4*)(src + 16 * s + 8);
      float posf = s == 4 ? (float)(t >> 6) : (float)(t & 63);
      float o[8];
#pragma unroll
      for (int j = 0; j < 8; ++j) {
        float a = (j & 1) ? hi2f(va[j >> 1]) : lo2f(va[j >> 1]);
        float bb = (j & 1) ? hi2f(vb[j >> 1]) : lo2f(vb[j >> 1]);
        float res;
        if (lat) {
          float invf = exp2f(-(float)(2 * j) * (13.287712379549449f / 16.f));
          float rev = posf * invf * 0.15915494309189535f;
          float cs = __builtin_amdgcn_cosf(rev), sn = __builtin_amdgcn_sinf(rev);
          res = hh == 0 ? a * cs - bb * sn : bb * cs + a * sn;
        } else res = hh == 0 ? a : bb;
        o[j] = res * qscale;
      }
      u32x4 ov; ov[0] = pack2(o[0], o[1]); ov[1] = pack2(o[2], o[3]); ov[2] = pack2(o[4], o[5]); ov[3] = pack2(o[6], o[7]);
      qf[s] = __builtin_bit_cast(bf16x8, ov);
    }
  }
  f32x16 oacc[2];
#pragma unroll
  for (int i = 0; i < 16; ++i) { oacc[0][i] = 0.f; oacc[1][i] = 0.f; }
  float m = -1e30f, lsum = 0.f;
  u32x4 rk[3], rv[2];
  auto gload = [&](int key0) {
#pragma unroll
    for (int i = 0; i < 3; ++i) rk[i] = *(const u32x4*)(KB + (size_t)key0 * 96 + (tid + 256 * i) * 8);
#pragma unroll
    for (int i = 0; i < 2; ++i) { int c = tid + 256 * i; rv[i] = *(const u32x4*)(VT + (size_t)(c >> 3) * LK + key0 + (c & 7) * 8); }
  };
  gload(0);
  const int NT = nkeys / 64;
  for (int kt = 0; kt < NT; ++kt) {
#pragma unroll
    for (int i = 0; i < 3; ++i) { int c = tid + 256 * i; *(u32x4*)(Ks + (c / 12) * KST + (c % 12) * 8) = rk[i]; }
#pragma unroll
    for (int i = 0; i < 2; ++i) {
      int c = tid + 256 * i;
      bf16_t* d = Vs + (c >> 3) * VST + (c & 7) * 8;
      u32x2 a; a[0] = rv[i][0]; a[1] = rv[i][1];
      u32x2 bq; bq[0] = rv[i][2]; bq[1] = rv[i][3];
      *(u32x2*)d = a; *(u32x2*)(d + 4) = bq;
    }
    __syncthreads();
    if (kt + 1 < NT) gload((kt + 1) * 64);
    f32x16 sacc[2];
#pragma unroll
    for (int i = 0; i < 16; ++i) { sacc[0][i] = 0.f; sacc[1][i] = 0.f; }
#pragma unroll
    for (int s = 0; s < 6; ++s)
#pragma unroll
      for (int k2 = 0; k2 < 2; ++k2) {
        bf16x8 af = *(const bf16x8*)(Ks + (32 * k2 + r) * KST + 16 * s + 8 * hh);
        sacc[k2] = MFMA32(af, qf[s], sacc[k2]);
      }
    float mx = sacc[0][0];
#pragma unroll
    for (int i = 0; i < 16; ++i) { mx = fmaxf(mx, sacc[0][i]); mx = fmaxf(mx, sacc[1][i]); }
    mx = fmaxf(mx, __shfl_xor(mx, 32));
    const float mn = fmaxf(m, mx);
    const float alpha = __builtin_amdgcn_exp2f(m - mn);
    m = mn;
    float ps = 0.f;
#pragma unroll
    for (int i = 0; i < 16; ++i) {
      sacc[0][i] = __builtin_amdgcn_exp2f(sacc[0][i] - mn); sacc[1][i] = __builtin_amdgcn_exp2f(sacc[1][i] - mn);
      ps += sacc[0][i] + sacc[1][i];
    }
    lsum = lsum * alpha + ps;
#pragma unroll
    for (int i = 0; i < 16; ++i) { oacc[0][i] *= alpha; oacc[1][i] *= alpha; }
#pragma unroll
    for (int k2 = 0; k2 < 2; ++k2)
#pragma unroll
      for (int s2 = 0; s2 < 2; ++s2) {
        bf16x8 pf = pack8(sacc[k2], s2);
        int kb0 = 32 * k2 + 16 * s2 + 4 * hh;
#pragma unroll
        for (int d = 0; d < 2; ++d) {
          u32x2 lo = *(const u32x2*)(Vs + (32 * d + r) * VST + kb0);
          u32x2 hi = *(const u32x2*)(Vs + (32 * d + r) * VST + kb0 + 8);
          u32x4 va; va[0] = lo[0]; va[1] = lo[1]; va[2] = hi[0]; va[3] = hi[1];
          oacc[d] = MFMA32(__builtin_bit_cast(bf16x8, va), pf, oacc[d]);
        }
      }
    __syncthreads();
  }
  lsum += __shfl_xor(lsum, 32);
  const float inv = 1.f / lsum;
  bf16_t* YM = (bf16_t*)(p.ws + OFF_H) + (size_t)qrow * DM + head * 64;
#pragma unroll
  for (int d = 0; d < 2; ++d)
#pragma unroll
    for (int q = 0; q < 4; ++q) {
      u32x2 o; o[0] = pack2(oacc[d][4 * q] * inv, oacc[d][4 * q + 1] * inv); o[1] = pack2(oacc[d][4 * q + 2] * inv, oacc[d][4 * q + 3] * inv);
      *(u32x2*)(YM + 32 * d + 8 * q + 4 * hh) = o;
    }
}

DI void phase_qkv(const Params& p, int layer, int bid, int nb, char* smem) {
  const int MQ = layer == 0 ? MT : ML;
  const int nq = (MQ / 128) * 3, nkv = (MT / 128) * 4, nst = NB * NCH * 8;
  const float* RS = (const float*)(p.ws + OFF_RSTD);
  EpiQ eq{(bf16_t*)(p.ws + OFF_QB), RS};
  EpiKV ekv{(bf16_t*)(p.ws + OFF_KB), (bf16_t*)(p.ws + OFF_VT), RS};
  const bf16_t* U = (const bf16_t*)(p.ws + OFF_U);
  for (int it = bid; it < nq + nkv + nst; it += nb) {
    if (it < nq) gemm_tile(U, DIN, wt_ptr(p, layer, WT_UQ), 256, (it / 3) * 128, (it % 3) * 128, smem, eq);
    else if (it < nq + nkv) { int j = it - nq; gemm_tile(U + U_CKV, DIN, wt_ptr(p, layer, WT_UKV), 128, (j / 4) * 128, (j % 4) * 128, smem, ekv); }
    else { int j = it - nq - nkv; for (int rep = 0; rep < REP_SSD; ++rep) ssd_state_item(p, layer, j / (NCH * 8), (j / 8) % NCH, j & 7, smem); }
  }
}
DI void phase_att(const Params& p, int layer, int bid, int nb, char* smem) {
  const int natt = 512 + (layer == 0 ? 32 : 0), npass = 512;
  for (int it = bid; it < natt + npass; it += nb) {
    if (it < 512) { int b = it >> 7, head = (it >> 5) & 3, qb = it & 31; for (int rep = 0; rep < REP_ATT; ++rep) attn_item(p, b, head, b * SEQ + qb * 128, qb * 128, true, LK, smem); }
    else if (it < natt) { int j = it - 512; int b = j >> 3, head = (j >> 1) & 3, qb = j & 1; attn_item(p, b, head, ML + b * CTX + qb * 128, qb * 128, false, CTX, smem); }
    else ssd_pass_item(p, it - natt);
  }
}
DI void phase_ssdout(const Params& p, int layer, int bid, int nb, char* smem) {
  for (int it = bid; it < NB * NCH * 8; it += nb) {
    int b = it / (NCH * 8), tc = (it / 8) % NCH, h = it & 7;
    if (layer == 1 && tc < 2) continue;
    for (int rep = 0; rep < REP_SSD; ++rep) ssd_out_item(p, layer, b, tc, h, smem);
  }
}


#define XB_TMO      128
#define XB_XCNT(j)  (256  + 64 * (j))
#define XB_XSUB(j)  (1280 + 64 * (j))
#define XB_XGEN(j)  (2304 + 64 * (j))
#define XB_TOP      3328
#define XB_TOPGEN   3392
#define XCD_BAR_WORDS 3456
#define XB_SPIN_CAP (1u << 22)
#define LAS __attribute__((address_space(3)))
DI unsigned xb_ld(unsigned* p) { return __hip_atomic_load(p, __ATOMIC_RELAXED, __HIP_MEMORY_SCOPE_AGENT); }
DI unsigned xb_add(unsigned* p, unsigned v) { return __hip_atomic_fetch_add(p, v, __ATOMIC_RELAXED, __HIP_MEMORY_SCOPE_AGENT); }
DI unsigned xb_xcc_id() { return (unsigned)__builtin_amdgcn_s_getreg((3 << 11) | 20) & 0xFu; }
#define XB_SPIN(cond, bar) do { unsigned _sp = 0; while (cond) { __builtin_amdgcn_s_sleep(1); \
    if ((++_sp & 255u) == 0u) { if (xb_ld(&(bar)[XB_TMO])) break; if (_sp > XB_SPIN_CAP) { atomicAdd(&(bar)[XB_TMO], 1u); break; } } } } while (0)
struct XcdBarrier { unsigned* bar; unsigned x; volatile LAS unsigned* st; };
DI XcdBarrier xcd_barrier_post(unsigned* bar, volatile LAS unsigned* st) {
  XcdBarrier b; b.bar = bar; b.x = xb_xcc_id(); b.st = st;
  if (threadIdx.x == 0) (void)xb_add(&bar[XB_XCNT(b.x)], 1u);
  return b;
}
DI void xcd_barrier_complete(unsigned* bar, unsigned x, unsigned& nloc, unsigned& nx) {
  const unsigned G = gridDim.x * gridDim.y * gridDim.z;
  unsigned sum, cnt, mine, sp = 0u;
  for (;;) {
    sum = 0u; cnt = 0u; mine = 0u;
#pragma unroll
    for (unsigned j = 0; j < 16; ++j) { const unsigned c = xb_ld(&bar[XB_XCNT(j)]); sum += c; cnt += (c > 0u) ? 1u : 0u; mine = (j == x) ? c : mine; }
    if (sum == G) break;
    __builtin_amdgcn_s_sleep(1);
    if ((++sp & 255u) == 0u) { if (xb_ld(&bar[XB_TMO])) break; if (sp > XB_SPIN_CAP) { atomicAdd(&bar[XB_TMO], 1u); break; } }
  }
  nloc = mine > 0u ? mine : 1u; nx = cnt > 0u ? cnt : 1u;
}
DI void xcd_barrier(const XcdBarrier& b) {
  asm volatile("s_waitcnt vmcnt(0)" ::: "memory");
  __syncthreads();
  if (threadIdx.x == 0) {
    unsigned* bar = b.bar;
    __builtin_amdgcn_s_waitcnt(0);
    unsigned nloc = b.st[0], nx = b.st[1];
    if (nloc == 0u) { xcd_barrier_complete(bar, b.x, nloc, nx); b.st[0] = nloc; b.st[1] = nx; }
    const unsigned old = xb_add(&bar[XB_XSUB(b.x)], 1u);
    const unsigned gen = old / nloc;
    if (old + 1u == (gen + 1u) * nloc) {
      __builtin_amdgcn_fence(__ATOMIC_RELEASE, "agent");
      asm volatile("s_waitcnt vmcnt(0)" ::: "memory");
      const unsigned og = xb_add(&bar[XB_TOP], 1u);
      const unsigned tg = og / nx;
      if (og + 1u == (tg + 1u) * nx) xb_add(&bar[XB_TOPGEN], 1u);
      else XB_SPIN(xb_ld(&bar[XB_TOPGEN]) == tg, bar);
      __builtin_amdgcn_fence(__ATOMIC_ACQUIRE, "agent");
      xb_add(&bar[XB_XGEN(b.x)], 1u);
      asm volatile("s_waitcnt vmcnt(0)" ::: "memory");
    } else {
      XB_SPIN(xb_ld(&bar[XB_XGEN(b.x)]) == gen, bar);
      __builtin_amdgcn_fence(__ATOMIC_ACQUIRE, "agent");
      asm volatile("s_waitcnt vmcnt(0)" ::: "memory");
    }
  }
  __syncthreads();
}

constexpr int SMEM_BYTES = 40960;
enum { PH_PREP0 = 0, PH_H0, PH_INPROJ, PH_PREP, PH_QKV, PH_ATT, PH_SSDOUT, PH_SSDNORM, PH_WOUT, PH_POSTMIX, PH_FF1, PH_FF2, PH_POSTFFN };

DI void run_phase(const Params& p, int ph, int layer, int bid, int nb, char* smem) {
  switch (ph) {
    case PH_PREP0: phase_prep0(p, bid, nb, smem); break;
    case PH_H0: phase_h0(p, bid, nb); break;
    case PH_INPROJ: phase_inproj(p, layer, bid, nb, smem); break;
    case PH_PREP: phase_prep(p, layer, bid, nb); break;
    case PH_QKV: phase_qkv(p, layer, bid, nb, smem); break;
    case PH_ATT: phase_att(p, layer, bid, nb, smem); break;
    case PH_SSDOUT: phase_ssdout(p, layer, bid, nb, smem); break;
    case PH_SSDNORM: phase_ssdnorm(p, layer, bid, nb); break;
    case PH_WOUT: phase_wout(p, layer, bid, nb, smem); break;
    case PH_POSTMIX: phase_postmix(p, layer, bid, nb); break;
    case PH_FF1: phase_ff1(p, layer, bid, nb, smem); break;
    case PH_FF2: phase_ff2(p, layer, bid, nb, smem); break;
    case PH_POSTFFN: phase_postffn(p, layer, bid, nb); break;
  }
}

template <int PH>
__global__ void __launch_bounds__(256) phase_kernel(Params p, int layer) {
  __shared__ __attribute__((aligned(16))) char smem[SMEM_BYTES];
  run_phase(p, PH, layer, blockIdx.x, gridDim.x, smem);
}

__global__ void __launch_bounds__(256, 2) mega_kernel(Params p) {
  __shared__ __attribute__((aligned(16))) char smem[SMEM_BYTES + 16];
  cg::grid_group grid = cg::this_grid();
  if (p.ws == nullptr) grid.sync();
  const int bid = blockIdx.x, nb = gridDim.x;
  volatile LAS unsigned* st = (volatile LAS unsigned*)(smem + SMEM_BYTES);
  if (threadIdx.x == 0) { st[0] = 0u; st[1] = 0u; st[2] = 0u; st[3] = 0u; }
  __syncthreads();
  XcdBarrier xb = xcd_barrier_post((unsigned*)(p.ws + OFF_BAR), st);
  for (int step = 0; step < 24; ++step) {
    int ph, layer;
    if (step < 2) { ph = step; layer = 0; }
    else { int j = step - 2; layer = j / 11; ph = PH_INPROJ + j % 11; }
    run_phase(p, ph, layer, bid, nb, smem);
    if (step < 23) xcd_barrier(xb);
  }
}

extern "C" void kernel_launch(void* const* d_in, const int* in_sizes, int n_in, void* d_out, int out_size, void* d_ws, size_t ws_size,
                              hipStream_t stream) {
  if (ws_size < WS_NEED) { fprintf(stderr, "workspace too small: %zu < %zu\n", ws_size, (size_t)WS_NEED); return; }
  Params p{};
  const float** f = (const float**)&p;
  for (int i = 0; i < 25; ++i) f[i] = (const float*)d_in[i];
  p.out = (float*)d_out;
  p.ws = (char*)d_ws;
#if MEGA
  static int grid_blocks = 0;
  if (!grid_blocks) {
    int dev = 0, cus = 0, per_cu = 0;
    hipGetDevice(&dev);
    hipDeviceGetAttribute(&cus, hipDeviceAttributeMultiprocessorCount, dev);
    hipOccupancyMaxActiveBlocksPerMultiprocessor(&per_cu, mega_kernel, 256, 0);
    if (per_cu > 2) per_cu = 2;
    grid_blocks = cus * per_cu;
  }
  hipMemsetAsync((char*)d_ws + OFF_BAR, 0, XCD_BAR_WORDS * 4, stream);
  void* args[] = {&p};
  hipError_t e = hipLaunchCooperativeKernel((void*)mega_kernel, dim3(grid_blocks), dim3(256), args, 0, stream);
  if (e != hipSuccess) fprintf(stderr, "cooperative launch failed: %s (grid %d)\n", hipGetErrorString(e), grid_blocks);
#else
  const int G = 1024;
  phase_kernel<PH_PREP0><<<G, 256, 0, stream>>>(p, 0);
  phase_kernel<PH_H0><<<G, 256, 0, stream>>>(p, 0);
  for (int layer = 0; layer < 2; ++layer) {
    phase_kernel<PH_INPROJ><<<G, 256, 0, stream>>>(p, layer);
    phase_kernel<PH_PREP><<<G, 256, 0, stream>>>(p, layer);
    phase_kernel<PH_QKV><<<G, 256, 0, stream>>>(p, layer);
    phase_kernel<PH_ATT><<<G, 256, 0, stream>>>(p, layer);
    phase_kernel<PH_SSDOUT><<<G, 256, 0, stream>>>(p, layer);
    phase_kernel<PH_SSDNORM><<<G, 256, 0, stream>>>(p, layer);
    phase_kernel<PH_WOUT><<<G, 256, 0, stream>>>(p, layer);
    phase_kernel<PH_POSTMIX><<<G, 256, 0, stream>>>(p, layer);
    phase_kernel<PH_FF1><<<G, 256, 0, stream>>>(p, layer);
    phase_kernel<PH_FF2><<<G, 256, 0, stream>>>(p, layer);
    phase_kernel<PH_POSTFFN><<<G, 256, 0, stream>>>(p, layer);
  }
#endif
}
```

```cpp
#include <hip/hip_runtime.h>
#include <hip/hip_cooperative_groups.h>
#include <stdint.h>
#include <stdio.h>
namespace cg = cooperative_groups;

#ifndef MEGA
#define MEGA 1
#endif
#ifndef REP_GEMM
#define REP_GEMM 1
#endif
#ifndef REP_ATT
#define REP_ATT 1
#endif
#ifndef REP_SSD
#define REP_SSD 1
#endif

typedef unsigned short bf16_t;
using bf16x8 = __attribute__((ext_vector_type(8))) short;
using s16x4  = __attribute__((ext_vector_type(4))) short;
using f32x4  = __attribute__((ext_vector_type(4))) float;
using f32x16 = __attribute__((ext_vector_type(16))) float;
using u32x4  = __attribute__((ext_vector_type(4))) unsigned;
using u32x2  = __attribute__((ext_vector_type(2))) unsigned;
#define DI __device__ __forceinline__
#define MFMA32(a, b, c) __builtin_amdgcn_mfma_f32_32x32x16_bf16((a), (b), (c), 0, 0, 0)
#define MFMA16(a, b, c) __builtin_amdgcn_mfma_f32_16x16x32_bf16((a), (b), (c), 0, 0, 0)

constexpr int DM = 1024, NB = 4, SEQ = 4096, CTX = 256;
constexpr int ML = NB * SEQ;
constexpr int MC = NB * CTX;
constexpr int MT = ML + MC;
constexpr int DIN = 2480, DINP = 2560;
constexpr int LK = CTX + SEQ;
constexpr int DFF = 4096;
constexpr int NCH = 34;
constexpr float EPS = 1e-6f;
constexpr int U_CKV = 256, U_KR = 384, U_GB = 416, U_GC = 672, U_VAL = 928, U_Z = 1184, U_XBC = 1696, U_DT = 2464;

constexpr size_t AL(size_t x) { return (x + 255) & ~(size_t)255; }
constexpr size_t WT_IN = 0;
constexpr size_t WT_UQ = WT_IN + (size_t)DINP * 1024;
constexpr size_t WT_UKV = WT_UQ + (size_t)384 * 256;
constexpr size_t WT_OUT = WT_UKV + (size_t)512 * 128;
constexpr size_t WT_FF1 = WT_OUT + (size_t)1024 * 1024;
constexpr size_t WT_FF2 = WT_FF1 + (size_t)4096 * 1024;
constexpr size_t WT_ELEMS = WT_FF2 + (size_t)4096 * 1024;
constexpr size_t OFF_WT = 0;
constexpr size_t OFF_MOD = AL(OFF_WT + 2 * WT_ELEMS * 2);
constexpr size_t OFF_XC = AL(OFF_MOD + 2 * 5 * 6144 * 4);
constexpr size_t OFF_H = AL(OFF_XC + (size_t)MC * DM * 4);
constexpr size_t OFF_R1 = AL(OFF_H + (size_t)MT * DM * 2);
constexpr size_t OFF_U = OFF_R1;
constexpr size_t OFF_DT = AL(OFF_U + (size_t)MT * DIN * 2);
constexpr size_t OFF_RSTD = AL(OFF_DT + (size_t)MT * 16 * 4);
constexpr size_t OFF_QB = AL(OFF_RSTD + (size_t)MT * 2 * 4);
constexpr size_t OFF_KB = AL(OFF_QB + (size_t)MT * 384 * 2);
constexpr size_t OFF_VT = AL(OFF_KB + (size_t)NB * 4 * LK * 96 * 2);
constexpr size_t OFF_XBC = AL(OFF_VT + (size_t)NB * 4 * 64 * LK * 2);
constexpr size_t OFF_SST = AL(OFF_XBC + (size_t)MT * 768 * 2);
constexpr size_t OFF_TDEC = AL(OFF_SST + (size_t)2 * NB * NCH * 8 * 4096 * 2);
constexpr size_t OFF_SSQ = AL(OFF_TDEC + (size_t)2 * NB * NCH * 8 * 4);
constexpr size_t OFF_END1 = AL(OFF_SSQ + (size_t)MT * 8 * 4);
constexpr size_t OFF_F1 = OFF_R1;
constexpr size_t OFF_END2 = AL(OFF_F1 + (size_t)MT * DFF * 2);
constexpr size_t OFF_BAR = OFF_END1 > OFF_END2 ? OFF_END1 : OFF_END2;
constexpr size_t WS_NEED = OFF_BAR + 16384;

struct Params {
  const float *x, *c, *ctx, *c_ctx, *w_mod, *b_mod, *g_pre_mix, *w_in, *q_norm, *w_uq, *kv_norm, *w_ukv, *sc_w, *ssd_cw, *ssd_cb,
      *a_log, *dt_bias, *ssd_d, *ssd_norm, *w_out, *g_post_mix, *g_pre_ffn, *w_ff1, *w_ff2, *g_post_ffn;
  float* out;
  char* ws;
};

DI int ltid() { int t = threadIdx.x; asm volatile("" : "+v"(t)); return t; }
DI bf16_t f2bf(float x) { unsigned u = __float_as_uint(x); u += 0x7fffu + ((u >> 16) & 1u); return (bf16_t)(u >> 16); }
DI float bf2f(unsigned v) { return __uint_as_float(v << 16); }
DI unsigned pack2(float a, float b) { return (unsigned)f2bf(a) | ((unsigned)f2bf(b) << 16); }
DI float lo2f(unsigned w) { return __uint_as_float(w << 16); }
DI float hi2f(unsigned w) { return __uint_as_float(w & 0xffff0000u); }
DI float wave_sum(float v) {
#pragma unroll
  for (int o = 32; o > 0; o >>= 1) v += __shfl_xor(v, o);
  return v;
}
DI float silu_f(float x) { return x / (1.f + __expf(-x)); }
DI int crow(int reg, int h) { return (reg & 3) + 8 * (reg >> 2) + 4 * h; }
DI bf16x8 pack8(const f32x16& x, int s) {
  u32x4 p;
  p[0] = pack2(x[8 * s + 0], x[8 * s + 1]); p[1] = pack2(x[8 * s + 2], x[8 * s + 3]);
  p[2] = pack2(x[8 * s + 4], x[8 * s + 5]); p[3] = pack2(x[8 * s + 6], x[8 * s + 7]);
  return __builtin_bit_cast(bf16x8, p);
}
DI const float* xin_row(const Params& p, int layer, int row) {
  if (layer == 0) return row < ML ? p.x + (size_t)row * DM : p.ctx + (size_t)(row - ML) * DM;
  return row < ML ? p.out + (size_t)row * DM : (const float*)(p.ws + OFF_XC) + (size_t)(row - ML) * DM;
}
DI float* xst_row(const Params& p, int row) {
  return row < ML ? p.out + (size_t)row * DM : (float*)(p.ws + OFF_XC) + (size_t)(row - ML) * DM;
}
DI const float* mod_ptr(const Params& p, int layer, int row, int which) {
  int bb = row < ML ? (row >> 12) : 4;
  return (const float*)(p.ws + OFF_MOD) + ((size_t)(layer * 5 + bb) * 6 + which) * DM;
}
DI bf16_t* wt_ptr(const Params& p, int layer, size_t off) { return (bf16_t*)(p.ws + OFF_WT) + (size_t)layer * WT_ELEMS + off; }

DI void transpose_item(const float* __restrict__ w, const float* __restrict__ gk, int gk_from, bf16_t* __restrict__ wt, int K, int N, int kt, int nt, char* smem) {
  float* tile = (float*)smem;
  const int tid = ltid(), tx = tid & 63, ty = tid >> 6;
  const int k0 = kt * 64, n0 = nt * 64;
  const int n = n0 + tx;
  float v[16];
#pragma unroll
  for (int i = 0; i < 16; ++i) {
    int kk = ty + 4 * i;
    v[i] = n < N ? w[(size_t)(k0 + kk) * N + n] : 0.f;
  }
  if (gk) {
#pragma unroll
    for (int i = 0; i < 16; ++i) { int k = k0 + ty + 4 * i; if (k >= gk_from) v[i] *= gk[k - gk_from]; }
  }
#pragma unroll
  for (int i = 0; i < 16; ++i) tile[(ty + 4 * i) * 65 + tx] = v[i];
  __syncthreads();
#pragma unroll
  for (int i = 0; i < 2; ++i) {
    int c = tid + 256 * i, nn = c >> 3, kc = c & 7;
    u32x4 o;
#pragma unroll
    for (int jj = 0; jj < 4; ++jj) o[jj] = pack2(tile[(kc * 8 + 2 * jj) * 65 + nn], tile[(kc * 8 + 2 * jj + 1) * 65 + nn]);
    *(u32x4*)(wt + (size_t)(n0 + nn) * K + k0 + kc * 8) = o;
  }
  __syncthreads();
}

DI void modgemv_item(const Params& p, int layer, int ct, char* smem) {
  float* s = (float*)smem;
  float* red = s + 5 * 1024;
  const int tid = ltid(), w = tid >> 6, lane = tid & 63;
  for (int i = tid; i < 5 * 1024; i += 256) {
    int bb = i >> 10, k = i & 1023;
    float v = bb < 4 ? p.c[bb * 1024 + k] : p.c_ctx[k];
    s[i] = silu_f(v);
  }
  __syncthreads();
  const float* wm = p.w_mod + (size_t)layer * 1024 * 6144;
  const int n = ct * 64 + lane;
  float acc[5] = {0.f, 0.f, 0.f, 0.f, 0.f};
#pragma unroll 16
  for (int k = w * 256; k < w * 256 + 256; ++k) {
    float wv = wm[(size_t)k * 6144 + n];
#pragma unroll
    for (int bb = 0; bb < 5; ++bb) acc[bb] += s[bb * 1024 + k] * wv;
  }
#pragma unroll
  for (int bb = 0; bb < 5; ++bb) red[(w * 5 + bb) * 64 + lane] = acc[bb];
  __syncthreads();
  for (int i = tid; i < 320; i += 256) {
    int bb = i >> 6, ln = i & 63;
    float v = red[(0 * 5 + bb) * 64 + ln] + red[(1 * 5 + bb) * 64 + ln] + red[(2 * 5 + bb) * 64 + ln] + red[(3 * 5 + bb) * 64 + ln];
    int nn = ct * 64 + ln;
    v += p.b_mod[layer * 6144 + nn];
    ((float*)(p.ws + OFF_MOD))[(size_t)(layer * 5 + bb) * 6144 + nn] = v;
  }
  __syncthreads();
}

DI void phase_prep0(const Params& p, int bid, int nb, char* smem) {
  constexpr int PER = 2984;
  for (int it = bid; it < 192 + 2 * PER; it += nb) {
    if (it < 192) { modgemv_item(p, it / 96, it % 96, smem); continue; }
    int layer = (it - 192) / PER, j = (it - 192) % PER;
    if (j < 640) transpose_item(p.w_in + (size_t)layer * 1024 * DIN, nullptr, 0, wt_ptr(p, layer, WT_IN), 1024, DIN, j / 40, j % 40, smem);
    else if ((j -= 640) < 24) transpose_item(p.w_uq + (size_t)layer * 256 * 384, p.q_norm + layer * 256, 0, wt_ptr(p, layer, WT_UQ), 256, 384, j / 6, j % 6, smem);
    else if ((j -= 24) < 16) transpose_item(p.w_ukv + (size_t)layer * 128 * 512, p.kv_norm + layer * 128, 0, wt_ptr(p, layer, WT_UKV), 128, 512, j / 8, j % 8, smem);
    else if ((j -= 16) < 256) transpose_item(p.w_out + (size_t)layer * 1024 * 1024, p.ssd_norm + layer * 512, 512, wt_ptr(p, layer, WT_OUT), 1024, 1024, j / 16, j % 16, smem);
    else if ((j -= 256) < 1024) transpose_item(p.w_ff1 + (size_t)layer * 1024 * 4096, nullptr, 0, wt_ptr(p, layer, WT_FF1), 1024, 4096, j / 64, j % 64, smem);
    else { j -= 1024; transpose_item(p.w_ff2 + (size_t)layer * 4096 * 1024, nullptr, 0, wt_ptr(p, layer, WT_FF2), 4096, 1024, j / 16, j % 16, smem); }
  }
}

DI void write_h_row(const float4 xv[4], float rstd, const float* g, const float* sh, const float* sc, bf16_t* hrow, int lane) {
#pragma unroll
  for (int i = 0; i < 4; ++i) {
    int col = lane * 4 + 256 * i;
    float4 gg = *(const float4*)(g + col), s1 = *(const float4*)(sc + col), s0 = *(const float4*)(sh + col);
    float a = xv[i].x * rstd * gg.x * (1.f + s1.x) + s0.x;
    float b = xv[i].y * rstd * gg.y * (1.f + s1.y) + s0.y;
    float c = xv[i].z * rstd * gg.z * (1.f + s1.z) + s0.z;
    float d = xv[i].w * rstd * gg.w * (1.f + s1.w) + s0.w;
    u32x2 o; o[0] = pack2(a, b); o[1] = pack2(c, d);
    *(u32x2*)(hrow + col) = o;
  }
}
DI float ssq4(const float4 v[4]) {
  float s = 0.f;
#pragma unroll
  for (int i = 0; i < 4; ++i) s += v[i].x * v[i].x + v[i].y * v[i].y + v[i].z * v[i].z + v[i].w * v[i].w;
  return s;
}
DI void load_bf_row(const bf16_t* r, int lane, float4 v[4]) {
#pragma unroll
  for (int i = 0; i < 4; ++i) {
    u32x2 t = *(const u32x2*)(r + lane * 4 + 256 * i);
    v[i] = make_float4(lo2f(t[0]), hi2f(t[0]), lo2f(t[1]), hi2f(t[1]));
  }
}

DI void phase_h0(const Params& p, int bid, int nb) {
  const int w = ltid() >> 6, lane = ltid() & 63;
  bf16_t* H = (bf16_t*)(p.ws + OFF_H);
  for (int row = bid * 4 + w; row < MT; row += nb * 4) {
    const float* xr = xin_row(p, 0, row);
    float4 xv[4];
#pragma unroll
    for (int i = 0; i < 4; ++i) xv[i] = *(const float4*)(xr + lane * 4 + 256 * i);
    float rstd = rsqrtf(wave_sum(ssq4(xv)) * (1.f / DM) + EPS);
    write_h_row(xv, rstd, p.g_pre_mix, mod_ptr(p, 0, row, 0), mod_ptr(p, 0, row, 1), H + (size_t)row * DM, lane);
  }
}

DI void phase_postmix(const Params& p, int layer, int bid, int nb) {
  const int w = ltid() >> 6, lane = ltid() & 63;
  const int M = layer == 0 ? MT : ML;
  bf16_t* H = (bf16_t*)(p.ws + OFF_H);
  const bf16_t* Y = (const bf16_t*)(p.ws + OFF_U);
  for (int row = bid * 4 + w; row < M; row += nb * 4) {
    float4 yv[4], xv[4];
    load_bf_row(Y + (size_t)row * DM, lane, yv);
    const float* xr = xin_row(p, layer, row);
#pragma unroll
    for (int i = 0; i < 4; ++i) xv[i] = *(const float4*)(xr + lane * 4 + 256 * i);
    float rstd = rsqrtf(wave_sum(ssq4(yv)) * (1.f / DM) + EPS);
    const float* g1 = mod_ptr(p, layer, row, 2);
    const float* gp = p.g_post_mix + layer * DM;
    float* xo = xst_row(p, row);
#pragma unroll
    for (int i = 0; i < 4; ++i) {
      int col = lane * 4 + 256 * i;
      float4 a = *(const float4*)(g1 + col), b = *(const float4*)(gp + col);
      xv[i].x += a.x * yv[i].x * rstd * b.x; xv[i].y += a.y * yv[i].y * rstd * b.y;
      xv[i].z += a.z * yv[i].z * rstd * b.z; xv[i].w += a.w * yv[i].w * rstd * b.w;
      *(float4*)(xo + col) = xv[i];
    }
    float rstd1 = rsqrtf(wave_sum(ssq4(xv)) * (1.f / DM) + EPS);
    write_h_row(xv, rstd1, p.g_pre_ffn + layer * DM, mod_ptr(p, layer, row, 3), mod_ptr(p, layer, row, 4), H + (size_t)row * DM, lane);
  }
}

DI void phase_postffn(const Params& p, int layer, int bid, int nb) {
  const int w = ltid() >> 6, lane = ltid() & 63;
  const int M = layer == 0 ? MT : ML;
  bf16_t* H = (bf16_t*)(p.ws + OFF_H);
  for (int row = bid * 4 + w; row < M; row += nb * 4) {
    float4 fv[4], xv[4];
    load_bf_row(H + (size_t)row * DM, lane, fv);
    float* xo = xst_row(p, row);
#pragma unroll
    for (int i = 0; i < 4; ++i) xv[i] = *(const float4*)(xo + lane * 4 + 256 * i);
    float rstd = rsqrtf(wave_sum(ssq4(fv)) * (1.f / DM) + EPS);
    const float* g2 = mod_ptr(p, layer, row, 5);
    const float* gp = p.g_post_ffn + layer * DM;
#pragma unroll
    for (int i = 0; i < 4; ++i) {
      int col = lane * 4 + 256 * i;
      float4 a = *(const float4*)(g2 + col), b = *(const float4*)(gp + col);
      xv[i].x += a.x * fv[i].x * rstd * b.x; xv[i].y += a.y * fv[i].y * rstd * b.y;
      xv[i].z += a.z * fv[i].z * rstd * b.z; xv[i].w += a.w * fv[i].w * rstd * b.w;
      *(float4*)(xo + col) = xv[i];
    }
    if (layer == 0) {
      float rstd1 = rsqrtf(wave_sum(ssq4(xv)) * (1.f / DM) + EPS);
      write_h_row(xv, rstd1, p.g_pre_mix + DM, mod_ptr(p, 1, row, 0), mod_ptr(p, 1, row, 1), H + (size_t)row * DM, lane);
    }
  }
}

DI void phase_prep(const Params& p, int layer, int bid, int nb) {
  const int w = ltid() >> 6, lane = ltid() & 63;
  const bf16_t* U = (const bf16_t*)(p.ws + OFF_U);
  float* DT = (float*)(p.ws + OFF_DT);
  float* RS = (float*)(p.ws + OFF_RSTD);
  bf16_t* KB = (bf16_t*)(p.ws + OFF_KB);
  bf16_t* XBC = (bf16_t*)(p.ws + OFF_XBC);
  bf16_t* YM = (bf16_t*)(p.ws + OFF_H);
  const float* scw = p.sc_w + layer * 3 * 256;
  const float* cw = p.ssd_cw + layer * 3 * 768;
  const float* cb = p.ssd_cb + layer * 768;
  for (int row = bid * 4 + w; row < MT; row += nb * 4) {
    int b, t, L, pos;
    bool lat = row < ML;
    if (lat) { b = row >> 12; t = row & 4095; L = SEQ; pos = t + CTX; }
    else { int rr = row - ML; b = rr >> 8; t = rr & 255; L = CTX; pos = t; }
    const bf16_t* u0 = U + (size_t)row * DIN;
    const bool hp = t > 0, hn = t < L - 1;
    const bf16_t* um = u0 - DIN;
    const bf16_t* up = u0 + DIN;
    {
      u32x2 v = *(const u32x2*)(u0 + lane * 4);
      float a = lo2f(v[0]), bq = hi2f(v[0]), c = lo2f(v[1]), d = hi2f(v[1]);
      float ss = wave_sum(a * a + bq * bq + c * c + d * d);
      float s2 = 0.f;
      if (lane < 32) {
        u32x2 v2 = *(const u32x2*)(u0 + U_CKV + lane * 4);
        float e = lo2f(v2[0]), f = hi2f(v2[0]), g = lo2f(v2[1]), h = hi2f(v2[1]);
        s2 = e * e + f * f + g * g + h * h;
      }
      s2 = wave_sum(s2);
      if (lane == 0) { RS[row * 2] = rsqrtf(ss * (1.f / 256) + EPS); RS[row * 2 + 1] = rsqrtf(s2 * (1.f / 128) + EPS); }
    }
    {
      float v = bf2f(u0[U_KR + (lane & 31)]);
      float partner = __shfl_xor(v, 8);
      float o = v;
      if (lat) {
        int grp = (lane & 31) >> 3, i = lane & 7;
        float posf = grp < 2 ? (float)(t >> 6) : (float)(t & 63);
        float invf = exp2f(-(float)(2 * i) * (13.287712379549449f / 16.f));
        float ang = posf * invf;
        float rev = ang * 0.15915494309189535f;
        float cs = __builtin_amdgcn_cosf(rev), sn = __builtin_amdgcn_sinf(rev);
        o = (grp & 1) ? v * cs + partner * sn : v * cs - partner * sn;
      }
      if (lane < 32) {
        bf16_t ob = f2bf(o);
#pragma unroll
        for (int hd = 0; hd < 4; ++hd) KB[((size_t)(b * 4 + hd) * LK + pos) * 96 + 64 + lane] = ob;
      }
    }
    {
      int c = lane * 4;
      float acc[4] = {0.f, 0.f, 0.f, 0.f};
#pragma unroll
      for (int k = 0; k < 3; ++k) {
        const bf16_t* ur = k == 0 ? um : (k == 1 ? u0 : up);
        bool ok = k == 0 ? hp : (k == 1 ? true : hn);
        if (ok) {
          u32x2 gc = *(const u32x2*)(ur + U_GC + c), vv = *(const u32x2*)(ur + U_VAL + c);
          float4 wk = *(const float4*)(scw + k * 256 + c);
          acc[0] += wk.x * lo2f(gc[0]) * lo2f(vv[0]); acc[1] += wk.y * hi2f(gc[0]) * hi2f(vv[0]);
          acc[2] += wk.z * lo2f(gc[1]) * lo2f(vv[1]); acc[3] += wk.w * hi2f(gc[1]) * hi2f(vv[1]);
        }
      }
      u32x2 gb = *(const u32x2*)(u0 + U_GB + c);
      u32x2 o; o[0] = pack2(lo2f(gb[0]) * acc[0], hi2f(gb[0]) * acc[1]); o[1] = pack2(lo2f(gb[1]) * acc[2], hi2f(gb[1]) * acc[3]);
      *(u32x2*)(YM + (size_t)row * DM + 256 + c) = o;
    }
#pragma unroll
    for (int i = 0; i < 3; ++i) {
      int c = lane * 4 + 256 * i;
      float4 bias = *(const float4*)(cb + c);
      float acc[4] = {bias.x, bias.y, bias.z, bias.w};
#pragma unroll
      for (int k = 0; k < 3; ++k) {
        const bf16_t* ur = k == 0 ? um : (k == 1 ? u0 : up);
        bool ok = k == 0 ? hp : (k == 1 ? true : hn);
        if (ok) {
          u32x2 vv = *(const u32x2*)(ur + U_XBC + c);
          float4 wk = *(const float4*)(cw + k * 768 + c);
          acc[0] += wk.x * lo2f(vv[0]); acc[1] += wk.y * hi2f(vv[0]); acc[2] += wk.z * lo2f(vv[1]); acc[3] += wk.w * hi2f(vv[1]);
        }
      }
      u32x2 o; o[0] = pack2(silu_f(acc[0]), silu_f(acc[1])); o[1] = pack2(silu_f(acc[2]), silu_f(acc[3]));
      *(u32x2*)(XBC + (size_t)row * 768 + c) = o;
    }
    if (lane < 16) {
      float v = DT[(size_t)row * 16 + lane] + p.dt_bias[layer * 16 + lane];
      float sp = fmaxf(v, 0.f) + log1pf(__expf(-fabsf(v)));
      DT[(size_t)row * 16 + lane] = sp;
    }
  }
}

DI void phase_ssdnorm(const Params& p, int layer, int bid, int nb) {
  const int w = ltid() >> 6, lane = ltid() & 63;
  const int M = layer == 0 ? MT : ML;
  bf16_t* YM = (bf16_t*)(p.ws + OFF_H);
  const float* SSQ = (const float*)(p.ws + OFF_SSQ);
  const float* ng = p.ssd_norm + layer * 512;
  for (int row = bid * 4 + w; row < M; row += nb * 4) {
    int g = lane >> 5;
    float4 s = *(const float4*)(SSQ + (size_t)row * 8 + g * 4);
    float rstd = rsqrtf((s.x + s.y + s.z + s.w) * (1.f / 256) + EPS);
    bf16_t* ptr = YM + (size_t)row * DM + 512 + lane * 8;
    u32x4 v = *(const u32x4*)ptr;
    float4 g0 = *(const float4*)(ng + lane * 8), g1 = *(const float4*)(ng + lane * 8 + 4);
    u32x4 o;
    o[0] = pack2(lo2f(v[0]) * rstd * g0.x, hi2f(v[0]) * rstd * g0.y);
    o[1] = pack2(lo2f(v[1]) * rstd * g0.z, hi2f(v[1]) * rstd * g0.w);
    o[2] = pack2(lo2f(v[2]) * rstd * g1.x, hi2f(v[2]) * rstd * g1.y);
    o[3] = pack2(lo2f(v[3]) * rstd * g1.z, hi2f(v[3]) * rstd * g1.w);
    *(u32x4*)ptr = o;
  }
}

constexpr int GST = 72;
template <bool GN, class Epi>
DI void gemm_tile(const bf16_t* __restrict__ A, int lda, const bf16_t* __restrict__ Bt, int K, int row0, int col0, char* smem, Epi epi, const float* __restrict__ ssq = nullptr) {
  bf16_t* As = (bf16_t*)smem;
  bf16_t* Bs = As + 128 * GST;
  const int tid = ltid(), wid = tid >> 6, lane = tid & 63, wr = wid >> 1, wc = wid & 1, fr = lane & 15, fq = lane >> 4;
  f32x4 acc[4][4];
#pragma unroll
  for (int m = 0; m < 4; ++m)
#pragma unroll
    for (int n = 0; n < 4; ++n) acc[m][n] = f32x4{0.f, 0.f, 0.f, 0.f};
  u32x4 ra[4], rb[4];
  const int sr = tid >> 3, sp = tid & 7;
  const bf16_t* ga = A + (size_t)(row0 + sr) * lda + sp * 8;
  const bf16_t* gb = Bt + (size_t)(col0 + sr) * K + sp * 8;
  auto gload = [&](int k0) {
#pragma unroll
    for (int i = 0; i < 4; ++i) {
      ra[i] = *(const u32x4*)(ga + (size_t)(32 * i) * lda + k0);
      rb[i] = *(const u32x4*)(gb + (size_t)(32 * i) * K + k0);
    }
  };
  gload(0);
  float gs[4][2];
  if (GN) {
#pragma unroll
    for (int i = 0; i < 4; ++i) {
      const float4 s0 = *(const float4*)(ssq + (size_t)(row0 + sr + 32 * i) * 8), s1 = *(const float4*)(ssq + (size_t)(row0 + sr + 32 * i) * 8 + 4);
      gs[i][0] = rsqrtf((s0.x + s0.y + s0.z + s0.w) * (1.f / 256) + EPS);
      gs[i][1] = rsqrtf((s1.x + s1.y + s1.z + s1.w) * (1.f / 256) + EPS);
    }
  }
  const int KT = K / 64;
  for (int kt = 0; kt < KT; ++kt) {
    if (GN && kt >= 8) {
      const int g = (kt - 8) >> 2;
#pragma unroll
      for (int i = 0; i < 4; ++i) {
        const float sc = g ? gs[i][1] : gs[i][0];
#pragma unroll
        for (int jj = 0; jj < 4; ++jj) ra[i][jj] = pack2(lo2f(ra[i][jj]) * sc, hi2f(ra[i][jj]) * sc);
      }
    }
#pragma unroll
    for (int i = 0; i < 4; ++i) {
      *(u32x4*)(As + (sr + 32 * i) * GST + sp * 8) = ra[i];
      *(u32x4*)(Bs + (sr + 32 * i) * GST + sp * 8) = rb[i];
    }
    __syncthreads();
    if (kt + 1 < KT) gload((kt + 1) * 64);
#pragma unroll
    for (int ks = 0; ks < 2; ++ks) {
      bf16x8 af[4], bfr[4];
#pragma unroll
      for (int m = 0; m < 4; ++m) af[m] = *(const bf16x8*)(As + (wr * 64 + m * 16 + fr) * GST + ks * 32 + fq * 8);
#pragma unroll
      for (int n = 0; n < 4; ++n) bfr[n] = *(const bf16x8*)(Bs + (wc * 64 + n * 16 + fr) * GST + ks * 32 + fq * 8);
#pragma unroll
      for (int m = 0; m < 4; ++m)
#pragma unroll
        for (int n = 0; n < 4; ++n) acc[m][n] = MFMA16(af[m], bfr[n], acc[m][n]);
    }
    __syncthreads();
  }
#pragma unroll
  for (int m = 0; m < 4; ++m)
#pragma unroll
    for (int n = 0; n < 4; ++n) epi(row0 + wr * 64 + m * 16 + fq * 4, col0 + wc * 64 + n * 16 + fr, acc[m][n]);
}

struct EpiBF {
  bf16_t* out; int ldo;
  DI void operator()(int row, int col, const f32x4& a) const {
#pragma unroll
    for (int j = 0; j < 4; ++j) out[(size_t)(row + j) * ldo + col] = f2bf(a[j]);
  }
};
struct EpiRelu2 {
  bf16_t* out; int ldo;
  DI void operator()(int row, int col, const f32x4& a) const {
#pragma unroll
    for (int j = 0; j < 4; ++j) { float r = fmaxf(a[j], 0.f); out[(size_t)(row + j) * ldo + col] = f2bf(r * r); }
  }
};
struct EpiU {
  bf16_t* u; float* dt;
  DI void operator()(int row, int col, const f32x4& a) const {
    if (col < DIN) {
#pragma unroll
      for (int j = 0; j < 4; ++j) u[(size_t)(row + j) * DIN + col] = f2bf(a[j]);
      if (col >= U_DT) {
#pragma unroll
        for (int j = 0; j < 4; ++j) dt[(size_t)(row + j) * 16 + col - U_DT] = a[j];
      }
    }
  }
};
struct EpiQ {
  bf16_t* q; const float* rs;
  DI void operator()(int row, int col, const f32x4& a) const {
#pragma unroll
    for (int j = 0; j < 4; ++j) q[(size_t)(row + j) * 384 + col] = f2bf(a[j] * rs[(row + j) * 2]);
  }
};
struct EpiKV {
  bf16_t* kb; bf16_t* vt; const float* rs;
  DI void operator()(int row, int col, const f32x4& a) const {
    int b, pos;
    if (row < ML) { b = row >> 12; pos = (row & 4095) + CTX; } else { int rr = row - ML; b = rr >> 8; pos = rr & 255; }
    int head = col >> 7, d = col & 127;
    float v[4];
#pragma unroll
    for (int j = 0; j < 4; ++j) v[j] = a[j] * rs[(row + j) * 2 + 1];
    if (d < 64) {
#pragma unroll
      for (int j = 0; j < 4; ++j) kb[((size_t)(b * 4 + head) * LK + pos + j) * 96 + d] = f2bf(v[j]);
    } else {
      u32x2 o; o[0] = pack2(v[0], v[1]); o[1] = pack2(v[2], v[3]);
      *(u32x2*)(vt + ((size_t)(b * 4 + head) * 64 + (d - 64)) * LK + pos) = o;
    }
  }
};

DI void phase_inproj(const Params& p, int layer, int bid, int nb, char* smem) {
  constexpr int NT = DINP / 128;
  EpiU epi{(bf16_t*)(p.ws + OFF_U), (float*)(p.ws + OFF_DT)};
  for (int rep = 0; rep < REP_GEMM; ++rep)
  for (int it = bid; it < (MT / 128) * NT; it += nb)
    gemm_tile<false>((const bf16_t*)(p.ws + OFF_H), DM, wt_ptr(p, layer, WT_IN), 1024, (it / NT) * 128, (it % NT) * 128, smem, epi);
}
DI void phase_wout(const Params& p, int layer, int bid, int nb, char* smem) {
  const int M = layer == 0 ? MT : ML;
  EpiBF epi{(bf16_t*)(p.ws + OFF_U), DM};
  for (int rep = 0; rep < REP_GEMM; ++rep)
  for (int it = bid; it < (M / 128) * 8; it += nb)
    gemm_tile<true>((const bf16_t*)(p.ws + OFF_H), DM, wt_ptr(p, layer, WT_OUT), 1024, (it / 8) * 128, (it % 8) * 128, smem, epi, (const float*)(p.ws + OFF_SSQ));
}
DI void phase_ff1(const Params& p, int layer, int bid, int nb, char* smem) {
  const int M = layer == 0 ? MT : ML;
  EpiRelu2 epi{(bf16_t*)(p.ws + OFF_F1), DFF};
  for (int rep = 0; rep < REP_GEMM; ++rep)
  for (int it = bid; it < (M / 128) * 32; it += nb)
    gemm_tile<false>((const bf16_t*)(p.ws + OFF_H), DM, wt_ptr(p, layer, WT_FF1), 1024, (it / 32) * 128, (it % 32) * 128, smem, epi);
}
DI void phase_ff2(const Params& p, int layer, int bid, int nb, char* smem) {
  const int M = layer == 0 ? MT : ML;
  EpiBF epi{(bf16_t*)(p.ws + OFF_H), DM};
  for (int rep = 0; rep < REP_GEMM; ++rep)
  for (int it = bid; it < (M / 128) * 8; it += nb)
    gemm_tile<false>((const bf16_t*)(p.ws + OFF_F1), DFF, wt_ptr(p, layer, WT_FF2), 4096, (it / 8) * 128, (it % 8) * 128, smem, epi);
}

DI int chunk_row0(int b, int tc) { return tc < 2 ? ML + b * CTX + tc * 128 : b * SEQ + (tc - 2) * 128; }
constexpr int TST = 136;
DI void load_tile_T(bf16_t* dst, const bf16_t* __restrict__ src, int ldg) {
  const int tid = ltid();
#pragma unroll
  for (int i = 0; i < 4; ++i) {
    int c = tid + 256 * i, tok = c & 127, pc = c >> 7;
    u32x4 v = *(const u32x4*)(src + (size_t)tok * ldg + pc * 8);
#pragma unroll
    for (int j = 0; j < 4; ++j) {
      dst[(pc * 8 + 2 * j) * TST + tok] = (bf16_t)(v[j] & 0xffffu);
      dst[(pc * 8 + 2 * j + 1) * TST + tok] = (bf16_t)(v[j] >> 16);
    }
  }
}
DI void chunk_scan(const Params& p, int layer, int row0, int h, float* csf, float* csb, float* dtF, float* dtB, float* laF, float* laB) {
  const int tid = ltid();
  const float* DT = (const float*)(p.ws + OFF_DT);
  if (tid < 128) {
    float af = -__expf(p.a_log[layer * 16 + h]), ab = -__expf(p.a_log[layer * 16 + 8 + h]);
    float df = DT[(size_t)(row0 + tid) * 16 + h], db = DT[(size_t)(row0 + tid) * 16 + 8 + h];
    dtF[tid] = df; dtB[tid] = db; laF[tid] = df * af; laB[tid] = db * ab;
  }
  __syncthreads();
  if (tid < 128) {
    float s = 0.f;
    for (int l = 0; l <= tid; ++l) s += laF[l];
    csf[tid] = s;
  } else {
    int t = tid - 128;
    float s = 0.f;
    for (int l = 127; l >= t; --l) s += laB[l];
    csb[t] = s;
  }
  __syncthreads();
}

DI void ssd_state_item(const Params& p, int layer, int b, int tc, int h, char* smem) {
  bf16_t* XT = (bf16_t*)smem;
  bf16_t* BT = XT + 64 * TST;
  float* csf = (float*)(BT + 64 * TST);
  float* csb = csf + 128; float* dtF = csb + 128; float* dtB = dtF + 128; float* laF = dtB + 128; float* laB = laF + 128;
  const int tid = ltid(), w = tid >> 6, lane = tid & 63, r = lane & 31, hh = lane >> 5;
  const int row0 = chunk_row0(b, tc);
  const bf16_t* XBC = (const bf16_t*)(p.ws + OFF_XBC);
  chunk_scan(p, layer, row0, h, csf, csb, dtF, dtB, laF, laB);
  load_tile_T(XT, XBC + (size_t)row0 * 768 + h * 64, 768);
  load_tile_T(BT, XBC + (size_t)row0 * 768 + 512 + (h >> 2) * 64, 768);
  __syncthreads();
  if (tid < 128) laF[tid] = dtF[tid] * __expf(csf[127] - csf[tid]);
  else { int t = tid - 128; laB[t] = dtB[t] * __expf(csb[0] - csb[t]); }
  __syncthreads();
  const int d = w >> 1, pt = w & 1;
  const float* wv = d == 0 ? laF : laB;
  f32x16 acc[2];
#pragma unroll
  for (int i = 0; i < 16; ++i) { acc[0][i] = 0.f; acc[1][i] = 0.f; }
#pragma unroll
  for (int s = 0; s < 8; ++s) {
    int l0 = 16 * s + 8 * hh;
    u32x4 xa = *(const u32x4*)(XT + (32 * pt + r) * TST + l0);
    u32x4 sa;
#pragma unroll
    for (int j = 0; j < 4; ++j) sa[j] = pack2(lo2f(xa[j]) * wv[l0 + 2 * j], hi2f(xa[j]) * wv[l0 + 2 * j + 1]);
    bf16x8 af = __builtin_bit_cast(bf16x8, sa);
#pragma unroll
    for (int nt = 0; nt < 2; ++nt) {
      bf16x8 bfr = *(const bf16x8*)(BT + (32 * nt + r) * TST + l0);
      acc[nt] = MFMA32(af, bfr, acc[nt]);
    }
  }
  bf16_t* S = (bf16_t*)(p.ws + OFF_SST) + ((((size_t)d * NB + b) * NCH + tc) * 8 + h) * 4096;
#pragma unroll
  for (int nt = 0; nt < 2; ++nt)
#pragma unroll
    for (int i = 0; i < 16; ++i) S[(32 * pt + crow(i, hh)) * 64 + 32 * nt + r] = f2bf(acc[nt][i]);
  if (tid == 0) {
    float* TD = (float*)(p.ws + OFF_TDEC);
    TD[((0 * NB + b) * NCH + tc) * 8 + h] = __expf(csf[127]);
    TD[((1 * NB + b) * NCH + tc) * 8 + h] = __expf(csb[0]);
  }
  __syncthreads();
}

DI void ssd_pass_item(const Params& p, int it) {
  const int e = it * 256 + ltid();
  const int pn2 = e & 2047, h = (e >> 11) & 7, b = (e >> 14) & 3, d = e >> 16;
  unsigned* S = (unsigned*)(p.ws + OFF_SST);
  const float* TD = (const float*)(p.ws + OFF_TDEC);
  unsigned sv[NCH]; float T[NCH];
#pragma unroll
  for (int i = 0; i < NCH; ++i) {
    int tc = d == 0 ? i : (i < 2 ? 1 - i : NCH + 1 - i);
    sv[i] = S[(((size_t)(d * NB + b) * NCH + tc) * 8 + h) * 2048 + pn2];
    T[i] = TD[((d * NB + b) * NCH + tc) * 8 + h];
  }
  float h0 = 0.f, h1 = 0.f;
#pragma unroll
  for (int i = 0; i < NCH; ++i) {
    int tc = d == 0 ? i : (i < 2 ? 1 - i : NCH + 1 - i);
    S[(((size_t)(d * NB + b) * NCH + tc) * 8 + h) * 2048 + pn2] = pack2(h0, h1);
    h0 = T[i] * h0 + lo2f(sv[i]); h1 = T[i] * h1 + hi2f(sv[i]);
  }
}

DI void ssd_out_item(const Params& p, int layer, int b, int tc, int h, char* smem) {
  bf16_t* XT = (bf16_t*)smem;
  bf16_t* Bs = XT + 64 * TST;
  float* csf = (float*)(Bs + 128 * GST);
  float* csb = csf + 128; float* dtF = csb + 128; float* dtB = dtF + 128; float* laF = dtB + 128; float* laB = laF + 128;
  const int tid = ltid(), w = tid >> 6, lane = tid & 63, r = lane & 31, hh = lane >> 5;
  const int row0 = chunk_row0(b, tc), g = h >> 2;
  const bf16_t* XBC = (const bf16_t*)(p.ws + OFF_XBC);
  chunk_scan(p, layer, row0, h, csf, csb, dtF, dtB, laF, laB);
  load_tile_T(XT, XBC + (size_t)row0 * 768 + h * 64, 768);
#pragma unroll
  for (int i = 0; i < 4; ++i) {
    int c = tid + 256 * i, tok = c >> 3, part = c & 7;
    *(u32x4*)(Bs + tok * GST + part * 8) = *(const u32x4*)(XBC + (size_t)(row0 + tok) * 768 + 512 + g * 64 + part * 8);
  }
  const int l = 32 * w + r;
  bf16x8 cf[4];
#pragma unroll
  for (int ks = 0; ks < 4; ++ks) cf[ks] = *(const bf16x8*)(XBC + (size_t)(row0 + l) * 768 + 640 + g * 64 + 16 * ks + 8 * hh);
  __syncthreads();
  const float csf_l = csf[l], csb_l = csb[l];
  f32x16 yacc[2];
#pragma unroll
  for (int i = 0; i < 16; ++i) { yacc[0][i] = 0.f; yacc[1][i] = 0.f; }
#pragma unroll
  for (int st = 0; st < 4; ++st) {
    f32x16 gacc;
#pragma unroll
    for (int i = 0; i < 16; ++i) gacc[i] = 0.f;
#pragma unroll
    for (int ks = 0; ks < 4; ++ks) {
      bf16x8 af = *(const bf16x8*)(Bs + (32 * st + r) * GST + 16 * ks + 8 * hh);
      gacc = MFMA32(af, cf[ks], gacc);
    }
#pragma unroll
    for (int i = 0; i < 16; ++i) {
      int s = 32 * st + crow(i, hh);
      float f;
      if (s < l) f = __expf(csf_l - csf[s]) * dtF[s];
      else if (s > l) f = __expf(csb_l - csb[s]) * dtB[s];
      else f = dtF[s] + dtB[s];
      gacc[i] *= f;
    }
#pragma unroll
    for (int s2 = 0; s2 < 2; ++s2) {
      bf16x8 mf = pack8(gacc, s2);
      int sb = 32 * st + 16 * s2 + 4 * hh;
#pragma unroll
      for (int pt = 0; pt < 2; ++pt) {
        u32x2 lo = *(const u32x2*)(XT + (32 * pt + r) * TST + sb);
        u32x2 hi = *(const u32x2*)(XT + (32 * pt + r) * TST + sb + 8);
        u32x4 xa; xa[0] = lo[0]; xa[1] = lo[1]; xa[2] = hi[0]; xa[3] = hi[1];
        yacc[pt] = MFMA32(__builtin_bit_cast(bf16x8, xa), mf, yacc[pt]);
      }
    }
  }
#pragma unroll
  for (int d = 0; d < 2; ++d) {
    const bf16_t* Hs = (const bf16_t*)(p.ws + OFF_SST) + ((((size_t)d * NB + b) * NCH + tc) * 8 + h) * 4096;
    const float e = __expf(d == 0 ? csf_l : csb_l);
#pragma unroll
    for (int pt = 0; pt < 2; ++pt) {
      f32x16 t;
#pragma unroll
      for (int i = 0; i < 16; ++i) t[i] = 0.f;
#pragma unroll
      for (int ks = 0; ks < 4; ++ks) {
        bf16x8 af = *(const bf16x8*)(Hs + (32 * pt + r) * 64 + 16 * ks + 8 * hh);
        t = MFMA32(af, cf[ks], t);
      }
#pragma unroll
      for (int i = 0; i < 16; ++i) yacc[pt][i] += e * t[i];
    }
  }
  const int row = row0 + l;
  const float Dh = p.ssd_d[layer * 8 + h];
  const bf16_t* U = (const bf16_t*)(p.ws + OFF_U);
  bf16_t* YM = (bf16_t*)(p.ws + OFF_H);
  float ssq = 0.f;
#pragma unroll
  for (int pt = 0; pt < 2; ++pt)
#pragma unroll
    for (int q = 0; q < 4; ++q) {
      int pp = 32 * pt + 8 * q + 4 * hh;
      u32x2 xv = *(const u32x2*)(XBC + (size_t)row * 768 + h * 64 + pp);
      u32x2 zv = *(const u32x2*)(U + (size_t)row * DIN + U_Z + h * 64 + pp);
      float y0 = (yacc[pt][4 * q + 0] + Dh * lo2f(xv[0])) * silu_f(lo2f(zv[0]));
      float y1 = (yacc[pt][4 * q + 1] + Dh * hi2f(xv[0])) * silu_f(hi2f(zv[0]));
      float y2 = (yacc[pt][4 * q + 2] + Dh * lo2f(xv[1])) * silu_f(lo2f(zv[1]));
      float y3 = (yacc[pt][4 * q + 3] + Dh * hi2f(xv[1])) * silu_f(hi2f(zv[1]));
      u32x2 o; o[0] = pack2(y0, y1); o[1] = pack2(y2, y3);
      float r0 = lo2f(o[0]), r1 = hi2f(o[0]), r2 = lo2f(o[1]), r3 = hi2f(o[1]);
      ssq += r0 * r0 + r1 * r1 + r2 * r2 + r3 * r3;
      *(u32x2*)(YM + (size_t)row * DM + 512 + h * 64 + pp) = o;
    }
  ssq += __shfl_xor(ssq, 32);
  if (hh == 0) ((float*)(p.ws + OFF_SSQ))[(size_t)row * 8 + h] = ssq;
  __syncthreads();
}

constexpr int KST = 104;
constexpr int VST = 68;
DI void attn_item(const Params& p, int b, int head, int qrow0, int t0, bool lat, int nkeys, char* smem) {
  bf16_t* Ks = (bf16_t*)smem;
  bf16_t* Vs = Ks + 64 * KST;
  const int tid = ltid(), w = tid >> 6, lane = tid & 63, r = lane & 31, hh = lane >> 5;
  const bf16_t* QB = (const bf16_t*)(p.ws + OFF_QB);
  const bf16_t* KB = (const bf16_t*)(p.ws + OFF_KB) + (size_t)(b * 4 + head) * LK * 96;
  const bf16_t* VT = (const bf16_t*)(p.ws + OFF_VT) + (size_t)(b * 4 + head) * 64 * LK;
  const float qscale = 0.10206207261596575f * 1.4426950408889634f;
  const int qrow = qrow0 + w * 32 + r;
  const int t = t0 + w * 32 + r;
  bf16x8 qf[6];
  {
    const bf16_t* src = QB + (size_t)qrow * 384 + head * 96;
#pragma unroll
    for (int s = 0; s < 4; ++s) {
      u32x4 v = *(const u32x4*)(src + 16 * s + 8 * hh);
      u32x4 o;
#pragma unroll
      for (int j = 0; j < 4; ++j) o[j] = pack2(lo2f(v[j]) * qscale, hi2f(v[j]) * qscale);
      qf[s] = __builtin_bit_cast(bf16x8, o);
    }
#pragma unroll
    for (int s = 4; s < 6; ++s) {
      u32x4 va = *(const u32x4*)(src + 16 * s), vb = *(const u32x4*)(src + 16 * s + 8);
      float posf = s == 4 ? (float)(t >> 6) : (float)(t & 63);
      float o[8];
#pragma unroll
      for (int j = 0; j < 8; ++j) {
        float a = (j & 1) ? hi2f(va[j >> 1]) : lo2f(va[j >> 1]);
        float bb = (j & 1) ? hi2f(vb[j >> 1]) : lo2f(vb[j >> 1]);
        float res;
        if (lat) {
          float invf = exp2f(-(float)(2 * j) * (13.287712379549449f / 16.f));
          float rev = posf * invf * 0.15915494309189535f;
          float cs = __builtin_amdgcn_cosf(rev), sn = __builtin_amdgcn_sinf(rev);
          res = hh == 0 ? a * cs - bb * sn : bb * cs + a * sn;
        } else res = hh == 0 ? a : bb;
        o[j] = res * qscale;
      }
      u32x4 ov; ov[0] = pack2(o[0], o[1]); ov[1] = pack2(o[2], o[3]); ov[2] = pack2(o[4], o[5]); ov[3] = pack2(o[6], o[7]);
      qf[s] = __builtin_bit_cast(bf16x8, ov);
    }
  }
  f32x16 oacc[2];
#pragma unroll
  for (int i = 0; i < 16; ++i) { oacc[0][i] = 0.f; oacc[1][i] = 0.f; }
  float m = -1e30f, lsum = 0.f;
  u32x4 rk[3], rv[2];
  auto gload = [&](int key0) {
#pragma unroll
    for (int i = 0; i < 3; ++i) rk[i] = *(const u32x4*)(KB + (size_t)key0 * 96 + (tid + 256 * i) * 8);
#pragma unroll
    for (int i = 0; i < 2; ++i) { int c = tid + 256 * i; rv[i] = *(const u32x4*)(VT + (size_t)(c >> 3) * LK + key0 + (c & 7) * 8); }
  };
  gload(0);
  const int NT = nkeys / 64;
  for (int kt = 0; kt < NT; ++kt) {
#pragma unroll
    for (int i = 0; i < 3; ++i) { int c = tid + 256 * i; *(u32x4*)(Ks + (c / 12) * KST + (c % 12) * 8) = rk[i]; }
#pragma unroll
    for (int i = 0; i < 2; ++i) {
      int c = tid + 256 * i;
      bf16_t* d = Vs + (c >> 3) * VST + (c & 7) * 8;
      u32x2 a; a[0] = rv[i][0]; a[1] = rv[i][1];
      u32x2 bq; bq[0] = rv[i][2]; bq[1] = rv[i][3];
      *(u32x2*)d = a; *(u32x2*)(d + 4) = bq;
    }
    __syncthreads();
    if (kt + 1 < NT) gload((kt + 1) * 64);
    f32x16 sacc[2];
#pragma unroll
    for (int i = 0; i < 16; ++i) { sacc[0][i] = 0.f; sacc[1][i] = 0.f; }
#pragma unroll
    for (int s = 0; s < 6; ++s)
#pragma unroll
      for (int k2 = 0; k2 < 2; ++k2) {
        bf16x8 af = *(const bf16x8*)(Ks + (32 * k2 + r) * KST + 16 * s + 8 * hh);
        sacc[k2] = MFMA32(af, qf[s], sacc[k2]);
      }
    float mx = sacc[0][0];
#pragma unroll
    for (int i = 0; i < 16; ++i) { mx = fmaxf(mx, sacc[0][i]); mx = fmaxf(mx, sacc[1][i]); }
    mx = fmaxf(mx, __shfl_xor(mx, 32));
    const float mn = fmaxf(m, mx);
    const float alpha = __builtin_amdgcn_exp2f(m - mn);
    m = mn;
    float ps = 0.f;
#pragma unroll
    for (int i = 0; i < 16; ++i) {
      sacc[0][i] = __builtin_amdgcn_exp2f(sacc[0][i] - mn); sacc[1][i] = __builtin_amdgcn_exp2f(sacc[1][i] - mn);
      ps += sacc[0][i] + sacc[1][i];
    }
    lsum = lsum * alpha + ps;
#pragma unroll
    for (int i = 0; i < 16; ++i) { oacc[0][i] *= alpha; oacc[1][i] *= alpha; }
#pragma unroll
    for (int k2 = 0; k2 < 2; ++k2)
#pragma unroll
      for (int s2 = 0; s2 < 2; ++s2) {
        bf16x8 pf = pack8(sacc[k2], s2);
        int kb0 = 32 * k2 + 16 * s2 + 4 * hh;
#pragma unroll
        for (int d = 0; d < 2; ++d) {
          u32x2 lo = *(const u32x2*)(Vs + (32 * d + r) * VST + kb0);
          u32x2 hi = *(const u32x2*)(Vs + (32 * d + r) * VST + kb0 + 8);
          u32x4 va; va[0] = lo[0]; va[1] = lo[1]; va[2] = hi[0]; va[3] = hi[1];
          oacc[d] = MFMA32(__builtin_bit_cast(bf16x8, va), pf, oacc[d]);
        }
      }
    __syncthreads();
  }
  lsum += __shfl_xor(lsum, 32);
  const float inv = 1.f / lsum;
  bf16_t* YM = (bf16_t*)(p.ws + OFF_H) + (size_t)qrow * DM + head * 64;
#pragma unroll
  for (int d = 0; d < 2; ++d)
#pragma unroll
    for (int q = 0; q < 4; ++q) {
      u32x2 o; o[0] = pack2(oacc[d][4 * q] * inv, oacc[d][4 * q + 1] * inv); o[1] = pack2(oacc[d][4 * q + 2] * inv, oacc[d][4 * q + 3] * inv);
      *(u32x2*)(YM + 32 * d + 8 * q + 4 * hh) = o;
    }
}

DI void phase_qkv(const Params& p, int layer, int bid, int nb, char* smem) {
  const int MQ = layer == 0 ? MT : ML;
  const int nq = (MQ / 128) * 3, nkv = (MT / 128) * 4, nst = NB * NCH * 8;
  const float* RS = (const float*)(p.ws + OFF_RSTD);
  EpiQ eq{(bf16_t*)(p.ws + OFF_QB), RS};
  EpiKV ekv{(bf16_t*)(p.ws + OFF_KB), (bf16_t*)(p.ws + OFF_VT), RS};
  const bf16_t* U = (const bf16_t*)(p.ws + OFF_U);
  for (int it = bid; it < nq + nkv + nst; it += nb) {
    if (it < nq) gemm_tile<false>(U, DIN, wt_ptr(p, layer, WT_UQ), 256, (it / 3) * 128, (it % 3) * 128, smem, eq);
    else if (it < nq + nkv) { int j = it - nq; gemm_tile<false>(U + U_CKV, DIN, wt_ptr(p, layer, WT_UKV), 128, (j / 4) * 128, (j % 4) * 128, smem, ekv); }
    else { int j = it - nq - nkv; for (int rep = 0; rep < REP_SSD; ++rep) ssd_state_item(p, layer, j / (NCH * 8), (j / 8) % NCH, j & 7, smem); }
  }
}
DI void phase_att(const Params& p, int layer, int bid, int nb, char* smem) {
  const int natt = 512 + (layer == 0 ? 32 : 0), npass = 512;
  for (int it = bid; it < natt + npass; it += nb) {
    if (it < 512) { int b = it >> 7, head = (it >> 5) & 3, qb = it & 31; for (int rep = 0; rep < REP_ATT; ++rep) attn_item(p, b, head, b * SEQ + qb * 128, qb * 128, true, LK, smem); }
    else if (it < natt) { int j = it - 512; int b = j >> 3, head = (j >> 1) & 3, qb = j & 1; attn_item(p, b, head, ML + b * CTX + qb * 128, qb * 128, false, CTX, smem); }
    else ssd_pass_item(p, it - natt);
  }
}
DI void phase_ssdout(const Params& p, int layer, int bid, int nb, char* smem) {
  for (int it = bid; it < NB * NCH * 8; it += nb) {
    int b = it / (NCH * 8), tc = (it / 8) % NCH, h = it & 7;
    if (layer == 1 && tc < 2) continue;
    for (int rep = 0; rep < REP_SSD; ++rep) ssd_out_item(p, layer, b, tc, h, smem);
  }
}


#define XB_TMO      128
#define XB_XCNT(j)  (256  + 64 * (j))
#define XB_XSUB(j)  (1280 + 64 * (j))
#define XB_XGEN(j)  (2304 + 64 * (j))
#define XB_TOP      3328
#define XB_TOPGEN   3392
#define XCD_BAR_WORDS 3456
#define XB_SPIN_CAP (1u << 22)
#define LAS __attribute__((address_space(3)))
DI unsigned xb_ld(unsigned* p) { return __hip_atomic_load(p, __ATOMIC_RELAXED, __HIP_MEMORY_SCOPE_AGENT); }
DI unsigned xb_add(unsigned* p, unsigned v) { return __hip_atomic_fetch_add(p, v, __ATOMIC_RELAXED, __HIP_MEMORY_SCOPE_AGENT); }
DI unsigned xb_xcc_id() { return (unsigned)__builtin_amdgcn_s_getreg((3 << 11) | 20) & 0xFu; }
#define XB_SPIN(cond, bar) do { unsigned _sp = 0; while (cond) { __builtin_amdgcn_s_sleep(1); \
    if ((++_sp & 255u) == 0u) { if (xb_ld(&(bar)[XB_TMO])) break; if (_sp > XB_SPIN_CAP) { atomicAdd(&(bar)[XB_TMO], 1u); break; } } } } while (0)
struct XcdBarrier { unsigned* bar; unsigned x; volatile LAS unsigned* st; };
DI XcdBarrier xcd_barrier_post(unsigned* bar, volatile LAS unsigned* st) {
  XcdBarrier b; b.bar = bar; b.x = xb_xcc_id(); b.st = st;
  if (threadIdx.x == 0) (void)xb_add(&bar[XB_XCNT(b.x)], 1u);
  return b;
}
DI void xcd_barrier_complete(unsigned* bar, unsigned x, unsigned& nloc, unsigned& nx) {
  const unsigned G = gridDim.x * gridDim.y * gridDim.z;
  unsigned sum, cnt, mine, sp = 0u;
  for (;;) {
    sum = 0u; cnt = 0u; mine = 0u;
#pragma unroll
    for (unsigned j = 0; j < 16; ++j) { const unsigned c = xb_ld(&bar[XB_XCNT(j)]); sum += c; cnt += (c > 0u) ? 1u : 0u; mine = (j == x) ? c : mine; }
    if (sum == G) break;
    __builtin_amdgcn_s_sleep(1);
    if ((++sp & 255u) == 0u) { if (xb_ld(&bar[XB_TMO])) break; if (sp > XB_SPIN_CAP) { atomicAdd(&bar[XB_TMO], 1u); break; } }
  }
  nloc = mine > 0u ? mine : 1u; nx = cnt > 0u ? cnt : 1u;
}
DI void xcd_barrier(const XcdBarrier& b) {
  asm volatile("s_waitcnt vmcnt(0)" ::: "memory");
  __syncthreads();
  if (threadIdx.x == 0) {
    unsigned* bar = b.bar;
    __builtin_amdgcn_s_waitcnt(0);
    unsigned nloc = b.st[0], nx = b.st[1];
    if (nloc == 0u) { xcd_barrier_complete(bar, b.x, nloc, nx); b.st[0] = nloc; b.st[1] = nx; }
    const unsigned old = xb_add(&bar[XB_XSUB(b.x)], 1u);
    const unsigned gen = old / nloc;
    if (old + 1u == (gen + 1u) * nloc) {
      __builtin_amdgcn_fence(__ATOMIC_RELEASE, "agent");
      asm volatile("s_waitcnt vmcnt(0)" ::: "memory");
      const unsigned og = xb_add(&bar[XB_TOP], 1u);
      const unsigned tg = og / nx;
      if (og + 1u == (tg + 1u) * nx) xb_add(&bar[XB_TOPGEN], 1u);
      else XB_SPIN(xb_ld(&bar[XB_TOPGEN]) == tg, bar);
      __builtin_amdgcn_fence(__ATOMIC_ACQUIRE, "agent");
      xb_add(&bar[XB_XGEN(b.x)], 1u);
      asm volatile("s_waitcnt vmcnt(0)" ::: "memory");
    } else {
      XB_SPIN(xb_ld(&bar[XB_XGEN(b.x)]) == gen, bar);
      __builtin_amdgcn_fence(__ATOMIC_ACQUIRE, "agent");
      asm volatile("s_waitcnt vmcnt(0)" ::: "memory");
    }
  }
  __syncthreads();
}

constexpr int SMEM_BYTES = 40960;
enum { PH_PREP0 = 0, PH_H0, PH_INPROJ, PH_PREP, PH_QKV, PH_ATT, PH_SSDOUT, PH_WOUT, PH_POSTMIX, PH_FF1, PH_FF2, PH_POSTFFN, PH_SSDNORM };

DI void run_phase(const Params& p, int ph, int layer, int bid, int nb, char* smem) {
  switch (ph) {
    case PH_PREP0: phase_prep0(p, bid, nb, smem); break;
    case PH_H0: phase_h0(p, bid, nb); break;
    case PH_INPROJ: phase_inproj(p, layer, bid, nb, smem); break;
    case PH_PREP: phase_prep(p, layer, bid, nb); break;
    case PH_QKV: phase_qkv(p, layer, bid, nb, smem); break;
    case PH_ATT: phase_att(p, layer, bid, nb, smem); break;
    case PH_SSDOUT: phase_ssdout(p, layer, bid, nb, smem); break;
    case PH_SSDNORM: phase_ssdnorm(p, layer, bid, nb); break;
    case PH_WOUT: phase_wout(p, layer, bid, nb, smem); break;
    case PH_POSTMIX: phase_postmix(p, layer, bid, nb); break;
    case PH_FF1: phase_ff1(p, layer, bid, nb, smem); break;
    case PH_FF2: phase_ff2(p, layer, bid, nb, smem); break;
    case PH_POSTFFN: phase_postffn(p, layer, bid, nb); break;
  }
}

template <int PH>
__global__ void __launch_bounds__(256) phase_kernel(Params p, int layer) {
  __shared__ __attribute__((aligned(16))) char smem[SMEM_BYTES];
  run_phase(p, PH, layer, blockIdx.x, gridDim.x, smem);
}

__global__ void __launch_bounds__(256, 2) mega_kernel(Params p) {
  __shared__ __attribute__((aligned(16))) char smem[SMEM_BYTES + 16];
  cg::grid_group grid = cg::this_grid();
  if (p.ws == nullptr) grid.sync();
  const int bid = blockIdx.x, nb = gridDim.x;
  volatile LAS unsigned* st = (volatile LAS unsigned*)(smem + SMEM_BYTES);
  if (threadIdx.x == 0) { st[0] = 0u; st[1] = 0u; st[2] = 0u; st[3] = 0u; }
  __syncthreads();
  XcdBarrier xb = xcd_barrier_post((unsigned*)(p.ws + OFF_BAR), st);
  for (int step = 0; step < 22; ++step) {
    int ph, layer;
    if (step < 2) { ph = step; layer = 0; }
    else { int j = step - 2; layer = j / 10; ph = PH_INPROJ + j % 10; }
    run_phase(p, ph, layer, bid, nb, smem);
    if (step < 21) xcd_barrier(xb);
  }
}

extern "C" void kernel_launch(void* const* d_in, const int* in_sizes, int n_in, void* d_out, int out_size, void* d_ws, size_t ws_size,
                              hipStream_t stream) {
  if (ws_size < WS_NEED) { fprintf(stderr, "workspace too small: %zu < %zu\n", ws_size, (size_t)WS_NEED); return; }
  Params p{};
  const float** f = (const float**)&p;
  for (int i = 0; i < 25; ++i) f[i] = (const float*)d_in[i];
  p.out = (float*)d_out;
  p.ws = (char*)d_ws;
#if MEGA
  static int grid_blocks = 0;
  if (!grid_blocks) {
    int dev = 0, cus = 0, per_cu = 0;
    hipGetDevice(&dev);
    hipDeviceGetAttribute(&cus, hipDeviceAttributeMultiprocessorCount, dev);
    hipOccupancyMaxActiveBlocksPerMultiprocessor(&per_cu, mega_kernel, 256, 0);
    if (per_cu > 2) per_cu = 2;
    grid_blocks = cus * per_cu;
  }
  hipMemsetAsync((char*)d_ws + OFF_BAR, 0, XCD_BAR_WORDS * 4, stream);
  void* args[] = {&p};
  hipError_t e = hipLaunchCooperativeKernel((void*)mega_kernel, dim3(grid_blocks), dim3(256), args, 0, stream);
  if (e != hipSuccess) fprintf(stderr, "cooperative launch failed: %s (grid %d)\n", hipGetErrorString(e), grid_blocks);
#else
  const int G = 1024;
  phase_kernel<PH_PREP0><<<G, 256, 0, stream>>>(p, 0);
  phase_kernel<PH_H0><<<G, 256, 0, stream>>>(p, 0);
  for (int layer = 0; layer < 2; ++layer) {
    phase_kernel<PH_INPROJ><<<G, 256, 0, stream>>>(p, layer);
    phase_kernel<PH_PREP><<<G, 256, 0, stream>>>(p, layer);
    phase_kernel<PH_QKV><<<G, 256, 0, stream>>>(p, layer);
    phase_kernel<PH_ATT><<<G, 256, 0, stream>>>(p, layer);
    phase_kernel<PH_SSDOUT><<<G, 256, 0, stream>>>(p, layer);
    phase_kernel<PH_WOUT><<<G, 256, 0, stream>>>(p, layer);
    phase_kernel<PH_POSTMIX><<<G, 256, 0, stream>>>(p, layer);
    phase_kernel<PH_FF1><<<G, 256, 0, stream>>>(p, layer);
    phase_kernel<PH_FF2><<<G, 256, 0, stream>>>(p, layer);
    phase_kernel<PH_POSTFFN><<<G, 256, 0, stream>>>(p, layer);
  }
#endif
}
```

```cpp
#include <hip/hip_runtime.h>
#include <hip/hip_cooperative_groups.h>
#include <stdint.h>
#include <stdio.h>
namespace cg = cooperative_groups;

#ifndef MEGA
#define MEGA 1
#endif
#ifndef REP_GEMM
#define REP_GEMM 1
#endif
#ifndef REP_ATT
#define REP_ATT 1
#endif
#ifndef REP_SSD
#define REP_SSD 1
#endif

typedef unsigned short bf16_t;
using bf16x8 = __attribute__((ext_vector_type(8))) short;
using s16x4  = __attribute__((ext_vector_type(4))) short;
using f32x4  = __attribute__((ext_vector_type(4))) float;
using f32x16 = __attribute__((ext_vector_type(16))) float;
using u32x4  = __attribute__((ext_vector_type(4))) unsigned;
using u32x2  = __attribute__((ext_vector_type(2))) unsigned;
#define DI __device__ __forceinline__
#define MFMA32(a, b, c) __builtin_amdgcn_mfma_f32_32x32x16_bf16((a), (b), (c), 0, 0, 0)
#define MFMA16(a, b, c) __builtin_amdgcn_mfma_f32_16x16x32_bf16((a), (b), (c), 0, 0, 0)

constexpr int DM = 1024, NB = 4, SEQ = 4096, CTX = 256;
constexpr int ML = NB * SEQ;
constexpr int MC = NB * CTX;
constexpr int MT = ML + MC;
constexpr int DIN = 2480, DINP = 2560;
constexpr int LK = CTX + SEQ;
constexpr int DFF = 4096;
constexpr int NCH = 34;
constexpr float EPS = 1e-6f;
constexpr int U_CKV = 256, U_KR = 384, U_GB = 416, U_GC = 672, U_VAL = 928, U_Z = 1184, U_XBC = 1696, U_DT = 2464;

constexpr size_t AL(size_t x) { return (x + 255) & ~(size_t)255; }
constexpr size_t WT_IN = 0;
constexpr size_t WT_UQ = WT_IN + (size_t)DINP * 1024;
constexpr size_t WT_UKV = WT_UQ + (size_t)384 * 256;
constexpr size_t WT_OUT = WT_UKV + (size_t)512 * 128;
constexpr size_t WT_FF1 = WT_OUT + (size_t)1024 * 1024;
constexpr size_t WT_FF2 = WT_FF1 + (size_t)4096 * 1024;
constexpr size_t WT_ELEMS = WT_FF2 + (size_t)4096 * 1024;
constexpr size_t OFF_WT = 0;
constexpr size_t OFF_MOD = AL(OFF_WT + 2 * WT_ELEMS * 2);
constexpr size_t OFF_XC = AL(OFF_MOD + 2 * 5 * 6144 * 4);
constexpr size_t OFF_H = AL(OFF_XC + (size_t)MC * DM * 4);
constexpr size_t OFF_R1 = AL(OFF_H + (size_t)MT * DM * 2);
constexpr size_t OFF_U = OFF_R1;
constexpr size_t OFF_DT = AL(OFF_U + (size_t)MT * DIN * 2);
constexpr size_t OFF_RSTD = AL(OFF_DT + (size_t)MT * 16 * 4);
constexpr size_t OFF_QB = AL(OFF_RSTD + (size_t)MT * 2 * 4);
constexpr size_t OFF_KB = AL(OFF_QB + (size_t)MT * 384 * 2);
constexpr size_t OFF_VT = AL(OFF_KB + (size_t)NB * 4 * LK * 96 * 2);
constexpr size_t OFF_XBC = AL(OFF_VT + (size_t)NB * 4 * 64 * LK * 2);
constexpr size_t OFF_SST = AL(OFF_XBC + (size_t)MT * 768 * 2);
constexpr size_t OFF_TDEC = AL(OFF_SST + (size_t)2 * NB * NCH * 8 * 4096 * 2);
constexpr size_t OFF_SSQ = AL(OFF_TDEC + (size_t)2 * NB * NCH * 8 * 4);
constexpr size_t OFF_END1 = AL(OFF_SSQ + (size_t)MT * 8 * 4);
constexpr size_t OFF_F1 = OFF_R1;
constexpr size_t OFF_END2 = AL(OFF_F1 + (size_t)MT * DFF * 2);
constexpr size_t OFF_BAR = OFF_END1 > OFF_END2 ? OFF_END1 : OFF_END2;
constexpr size_t WS_NEED = OFF_BAR + 16384;

struct Params {
  const float *x, *c, *ctx, *c_ctx, *w_mod, *b_mod, *g_pre_mix, *w_in, *q_norm, *w_uq, *kv_norm, *w_ukv, *sc_w, *ssd_cw, *ssd_cb,
      *a_log, *dt_bias, *ssd_d, *ssd_norm, *w_out, *g_post_mix, *g_pre_ffn, *w_ff1, *w_ff2, *g_post_ffn;
  float* out;
  char* ws;
};

DI int ltid() { int t = threadIdx.x; asm volatile("" : "+v"(t)); return t; }
DI bf16_t f2bf(float x) { unsigned u = __float_as_uint(x); u += 0x7fffu + ((u >> 16) & 1u); return (bf16_t)(u >> 16); }
DI float bf2f(unsigned v) { return __uint_as_float(v << 16); }
DI unsigned pack2(float a, float b) { return (unsigned)f2bf(a) | ((unsigned)f2bf(b) << 16); }
DI float lo2f(unsigned w) { return __uint_as_float(w << 16); }
DI float hi2f(unsigned w) { return __uint_as_float(w & 0xffff0000u); }
DI float wave_sum(float v) {
#pragma unroll
  for (int o = 32; o > 0; o >>= 1) v += __shfl_xor(v, o);
  return v;
}
DI float silu_f(float x) { return x / (1.f + __expf(-x)); }
DI int crow(int reg, int h) { return (reg & 3) + 8 * (reg >> 2) + 4 * h; }
DI bf16x8 pack8(const f32x16& x, int s) {
  u32x4 p;
  p[0] = pack2(x[8 * s + 0], x[8 * s + 1]); p[1] = pack2(x[8 * s + 2], x[8 * s + 3]);
  p[2] = pack2(x[8 * s + 4], x[8 * s + 5]); p[3] = pack2(x[8 * s + 6], x[8 * s + 7]);
  return __builtin_bit_cast(bf16x8, p);
}
DI const float* xin_row(const Params& p, int layer, int row) {
  if (layer == 0) return row < ML ? p.x + (size_t)row * DM : p.ctx + (size_t)(row - ML) * DM;
  return row < ML ? p.out + (size_t)row * DM : (const float*)(p.ws + OFF_XC) + (size_t)(row - ML) * DM;
}
DI float* xst_row(const Params& p, int row) {
  return row < ML ? p.out + (size_t)row * DM : (float*)(p.ws + OFF_XC) + (size_t)(row - ML) * DM;
}
DI const float* mod_ptr(const Params& p, int layer, int row, int which) {
  int bb = row < ML ? (row >> 12) : 4;
  return (const float*)(p.ws + OFF_MOD) + ((size_t)(layer * 5 + bb) * 6 + which) * DM;
}
DI bf16_t* wt_ptr(const Params& p, int layer, size_t off) { return (bf16_t*)(p.ws + OFF_WT) + (size_t)layer * WT_ELEMS + off; }

DI void transpose_item(const float* __restrict__ w, const float* __restrict__ gk, int gk_from, bf16_t* __restrict__ wt, int K, int N, int kt, int nt, char* smem) {
  float* tile = (float*)smem;
  const int tid = ltid(), tx = tid & 63, ty = tid >> 6;
  const int k0 = kt * 64, n0 = nt * 64;
  const int n = n0 + tx;
  float v[16];
#pragma unroll
  for (int i = 0; i < 16; ++i) {
    int kk = ty + 4 * i;
    v[i] = n < N ? w[(size_t)(k0 + kk) * N + n] : 0.f;
  }
  if (gk) {
#pragma unroll
    for (int i = 0; i < 16; ++i) { int k = k0 + ty + 4 * i; if (k >= gk_from) v[i] *= gk[k - gk_from]; }
  }
#pragma unroll
  for (int i = 0; i < 16; ++i) tile[(ty + 4 * i) * 65 + tx] = v[i];
  __syncthreads();
#pragma unroll
  for (int i = 0; i < 2; ++i) {
    int c = tid + 256 * i, nn = c >> 3, kc = c & 7;
    u32x4 o;
#pragma unroll
    for (int jj = 0; jj < 4; ++jj) o[jj] = pack2(tile[(kc * 8 + 2 * jj) * 65 + nn], tile[(kc * 8 + 2 * jj + 1) * 65 + nn]);
    *(u32x4*)(wt + (size_t)(n0 + nn) * K + k0 + kc * 8) = o;
  }
  __syncthreads();
}

DI void modgemv_item(const Params& p, int layer, int ct, char* smem) {
  float* s = (float*)smem;
  float* red = s + 5 * 1024;
  const int tid = ltid(), w = tid >> 6, lane = tid & 63;
  for (int i = tid; i < 5 * 1024; i += 256) {
    int bb = i >> 10, k = i & 1023;
    float v = bb < 4 ? p.c[bb * 1024 + k] : p.c_ctx[k];
    s[i] = silu_f(v);
  }
  __syncthreads();
  const float* wm = p.w_mod + (size_t)layer * 1024 * 6144;
  const int n = ct * 64 + lane;
  float acc[5] = {0.f, 0.f, 0.f, 0.f, 0.f};
#pragma unroll 16
  for (int k = w * 256; k < w * 256 + 256; ++k) {
    float wv = wm[(size_t)k * 6144 + n];
#pragma unroll
    for (int bb = 0; bb < 5; ++bb) acc[bb] += s[bb * 1024 + k] * wv;
  }
#pragma unroll
  for (int bb = 0; bb < 5; ++bb) red[(w * 5 + bb) * 64 + lane] = acc[bb];
  __syncthreads();
  for (int i = tid; i < 320; i += 256) {
    int bb = i >> 6, ln = i & 63;
    float v = red[(0 * 5 + bb) * 64 + ln] + red[(1 * 5 + bb) * 64 + ln] + red[(2 * 5 + bb) * 64 + ln] + red[(3 * 5 + bb) * 64 + ln];
    int nn = ct * 64 + ln;
    v += p.b_mod[layer * 6144 + nn];
    ((float*)(p.ws + OFF_MOD))[(size_t)(layer * 5 + bb) * 6144 + nn] = v;
  }
  __syncthreads();
}

DI void phase_prep0(const Params& p, int bid, int nb, char* smem) {
  constexpr int PER = 2984;
  for (int it = bid; it < 192 + 2 * PER; it += nb) {
    if (it < 192) { modgemv_item(p, it / 96, it % 96, smem); continue; }
    int layer = (it - 192) / PER, j = (it - 192) % PER;
    if (j < 640) transpose_item(p.w_in + (size_t)layer * 1024 * DIN, nullptr, 0, wt_ptr(p, layer, WT_IN), 1024, DIN, j / 40, j % 40, smem);
    else if ((j -= 640) < 24) transpose_item(p.w_uq + (size_t)layer * 256 * 384, p.q_norm + layer * 256, 0, wt_ptr(p, layer, WT_UQ), 256, 384, j / 6, j % 6, smem);
    else if ((j -= 24) < 16) transpose_item(p.w_ukv + (size_t)layer * 128 * 512, p.kv_norm + layer * 128, 0, wt_ptr(p, layer, WT_UKV), 128, 512, j / 8, j % 8, smem);
    else if ((j -= 16) < 256) transpose_item(p.w_out + (size_t)layer * 1024 * 1024, p.ssd_norm + layer * 512, 512, wt_ptr(p, layer, WT_OUT), 1024, 1024, j / 16, j % 16, smem);
    else if ((j -= 256) < 1024) transpose_item(p.w_ff1 + (size_t)layer * 1024 * 4096, nullptr, 0, wt_ptr(p, layer, WT_FF1), 1024, 4096, j / 64, j % 64, smem);
    else { j -= 1024; transpose_item(p.w_ff2 + (size_t)layer * 4096 * 1024, nullptr, 0, wt_ptr(p, layer, WT_FF2), 4096, 1024, j / 16, j % 16, smem); }
  }
}

DI void write_h_row(const float4 xv[4], float rstd, const float* g, const float* sh, const float* sc, bf16_t* hrow, int lane) {
#pragma unroll
  for (int i = 0; i < 4; ++i) {
    int col = lane * 4 + 256 * i;
    float4 gg = *(const float4*)(g + col), s1 = *(const float4*)(sc + col), s0 = *(const float4*)(sh + col);
    float a = xv[i].x * rstd * gg.x * (1.f + s1.x) + s0.x;
    float b = xv[i].y * rstd * gg.y * (1.f + s1.y) + s0.y;
    float c = xv[i].z * rstd * gg.z * (1.f + s1.z) + s0.z;
    float d = xv[i].w * rstd * gg.w * (1.f + s1.w) + s0.w;
    u32x2 o; o[0] = pack2(a, b); o[1] = pack2(c, d);
    *(u32x2*)(hrow + col) = o;
  }
}
DI float ssq4(const float4 v[4]) {
  float s = 0.f;
#pragma unroll
  for (int i = 0; i < 4; ++i) s += v[i].x * v[i].x + v[i].y * v[i].y + v[i].z * v[i].z + v[i].w * v[i].w;
  return s;
}
DI void load_bf_row(const bf16_t* r, int lane, float4 v[4]) {
#pragma unroll
  for (int i = 0; i < 4; ++i) {
    u32x2 t = *(const u32x2*)(r + lane * 4 + 256 * i);
    v[i] = make_float4(lo2f(t[0]), hi2f(t[0]), lo2f(t[1]), hi2f(t[1]));
  }
}

DI void phase_h0(const Params& p, int bid, int nb) {
  const int w = ltid() >> 6, lane = ltid() & 63;
  bf16_t* H = (bf16_t*)(p.ws + OFF_H);
  for (int row = bid * 4 + w; row < MT; row += nb * 4) {
    const float* xr = xin_row(p, 0, row);
    float4 xv[4];
#pragma unroll
    for (int i = 0; i < 4; ++i) xv[i] = *(const float4*)(xr + lane * 4 + 256 * i);
    float rstd = rsqrtf(wave_sum(ssq4(xv)) * (1.f / DM) + EPS);
    write_h_row(xv, rstd, p.g_pre_mix, mod_ptr(p, 0, row, 0), mod_ptr(p, 0, row, 1), H + (size_t)row * DM, lane);
  }
}

DI void phase_postmix(const Params& p, int layer, int bid, int nb) {
  const int w = ltid() >> 6, lane = ltid() & 63;
  const int M = layer == 0 ? MT : ML;
  bf16_t* H = (bf16_t*)(p.ws + OFF_H);
  const bf16_t* Y = (const bf16_t*)(p.ws + OFF_U);
  for (int row = bid * 4 + w; row < M; row += nb * 4) {
    float4 yv[4], xv[4];
    load_bf_row(Y + (size_t)row * DM, lane, yv);
    const float* xr = xin_row(p, layer, row);
#pragma unroll
    for (int i = 0; i < 4; ++i) xv[i] = *(const float4*)(xr + lane * 4 + 256 * i);
    float rstd = rsqrtf(wave_sum(ssq4(yv)) * (1.f / DM) + EPS);
    const float* g1 = mod_ptr(p, layer, row, 2);
    const float* gp = p.g_post_mix + layer * DM;
    float* xo = xst_row(p, row);
#pragma unroll
    for (int i = 0; i < 4; ++i) {
      int col = lane * 4 + 256 * i;
      float4 a = *(const float4*)(g1 + col), b = *(const float4*)(gp + col);
      xv[i].x += a.x * yv[i].x * rstd * b.x; xv[i].y += a.y * yv[i].y * rstd * b.y;
      xv[i].z += a.z * yv[i].z * rstd * b.z; xv[i].w += a.w * yv[i].w * rstd * b.w;
      *(float4*)(xo + col) = xv[i];
    }
    float rstd1 = rsqrtf(wave_sum(ssq4(xv)) * (1.f / DM) + EPS);
    write_h_row(xv, rstd1, p.g_pre_ffn + layer * DM, mod_ptr(p, layer, row, 3), mod_ptr(p, layer, row, 4), H + (size_t)row * DM, lane);
  }
}

DI void phase_postffn(const Params& p, int layer, int bid, int nb) {
  const int w = ltid() >> 6, lane = ltid() & 63;
  const int M = layer == 0 ? MT : ML;
  bf16_t* H = (bf16_t*)(p.ws + OFF_H);
  for (int row = bid * 4 + w; row < M; row += nb * 4) {
    float4 fv[4], xv[4];
    load_bf_row(H + (size_t)row * DM, lane, fv);
    float* xo = xst_row(p, row);
#pragma unroll
    for (int i = 0; i < 4; ++i) xv[i] = *(const float4*)(xo + lane * 4 + 256 * i);
    float rstd = rsqrtf(wave_sum(ssq4(fv)) * (1.f / DM) + EPS);
    const float* g2 = mod_ptr(p, layer, row, 5);
    const float* gp = p.g_post_ffn + layer * DM;
#pragma unroll
    for (int i = 0; i < 4; ++i) {
      int col = lane * 4 + 256 * i;
      float4 a = *(const float4*)(g2 + col), b = *(const float4*)(gp + col);
      xv[i].x += a.x * fv[i].x * rstd * b.x; xv[i].y += a.y * fv[i].y * rstd * b.y;
      xv[i].z += a.z * fv[i].z * rstd * b.z; xv[i].w += a.w * fv[i].w * rstd * b.w;
      *(float4*)(xo + col) = xv[i];
    }
    if (layer == 0) {
      float rstd1 = rsqrtf(wave_sum(ssq4(xv)) * (1.f / DM) + EPS);
      write_h_row(xv, rstd1, p.g_pre_mix + DM, mod_ptr(p, 1, row, 0), mod_ptr(p, 1, row, 1), H + (size_t)row * DM, lane);
    }
  }
}

DI void phase_prep(const Params& p, int layer, int bid, int nb) {
  const int w = ltid() >> 6, lane = ltid() & 63;
  const bf16_t* U = (const bf16_t*)(p.ws + OFF_U);
  float* DT = (float*)(p.ws + OFF_DT);
  float* RS = (float*)(p.ws + OFF_RSTD);
  bf16_t* KB = (bf16_t*)(p.ws + OFF_KB);
  bf16_t* XBC = (bf16_t*)(p.ws + OFF_XBC);
  bf16_t* YM = (bf16_t*)(p.ws + OFF_H);
  const float* scw = p.sc_w + layer * 3 * 256;
  const float* cw = p.ssd_cw + layer * 3 * 768;
  const float* cb = p.ssd_cb + layer * 768;
  for (int row = bid * 4 + w; row < MT; row += nb * 4) {
    int b, t, L, pos;
    bool lat = row < ML;
    if (lat) { b = row >> 12; t = row & 4095; L = SEQ; pos = t + CTX; }
    else { int rr = row - ML; b = rr >> 8; t = rr & 255; L = CTX; pos = t; }
    const bf16_t* u0 = U + (size_t)row * DIN;
    const bool hp = t > 0, hn = t < L - 1;
    const bf16_t* um = u0 - DIN;
    const bf16_t* up = u0 + DIN;
    {
      u32x2 v = *(const u32x2*)(u0 + lane * 4);
      float a = lo2f(v[0]), bq = hi2f(v[0]), c = lo2f(v[1]), d = hi2f(v[1]);
      float ss = wave_sum(a * a + bq * bq + c * c + d * d);
      float s2 = 0.f;
      if (lane < 32) {
        u32x2 v2 = *(const u32x2*)(u0 + U_CKV + lane * 4);
        float e = lo2f(v2[0]), f = hi2f(v2[0]), g = lo2f(v2[1]), h = hi2f(v2[1]);
        s2 = e * e + f * f + g * g + h * h;
      }
      s2 = wave_sum(s2);
      if (lane == 0) { RS[row * 2] = rsqrtf(ss * (1.f / 256) + EPS); RS[row * 2 + 1] = rsqrtf(s2 * (1.f / 128) + EPS); }
    }
    {
      float v = bf2f(u0[U_KR + (lane & 31)]);
      float partner = __shfl_xor(v, 8);
      float o = v;
      if (lat) {
        int grp = (lane & 31) >> 3, i = lane & 7;
        float posf = grp < 2 ? (float)(t >> 6) : (float)(t & 63);
        float invf = exp2f(-(float)(2 * i) * (13.287712379549449f / 16.f));
        float ang = posf * invf;
        float rev = ang * 0.15915494309189535f;
        float cs = __builtin_amdgcn_cosf(rev), sn = __builtin_amdgcn_sinf(rev);
        o = (grp & 1) ? v * cs + partner * sn : v * cs - partner * sn;
      }
      if (lane < 32) {
        bf16_t ob = f2bf(o);
#pragma unroll
        for (int hd = 0; hd < 4; ++hd) KB[((size_t)(b * 4 + hd) * LK + pos) * 96 + 64 + lane] = ob;
      }
    }
    {
      int c = lane * 4;
      float acc[4] = {0.f, 0.f, 0.f, 0.f};
#pragma unroll
      for (int k = 0; k < 3; ++k) {
        const bf16_t* ur = k == 0 ? um : (k == 1 ? u0 : up);
        bool ok = k == 0 ? hp : (k == 1 ? true : hn);
        if (ok) {
          u32x2 gc = *(const u32x2*)(ur + U_GC + c), vv = *(const u32x2*)(ur + U_VAL + c);
          float4 wk = *(const float4*)(scw + k * 256 + c);
          acc[0] += wk.x * lo2f(gc[0]) * lo2f(vv[0]); acc[1] += wk.y * hi2f(gc[0]) * hi2f(vv[0]);
          acc[2] += wk.z * lo2f(gc[1]) * lo2f(vv[1]); acc[3] += wk.w * hi2f(gc[1]) * hi2f(vv[1]);
        }
      }
      u32x2 gb = *(const u32x2*)(u0 + U_GB + c);
      u32x2 o; o[0] = pack2(lo2f(gb[0]) * acc[0], hi2f(gb[0]) * acc[1]); o[1] = pack2(lo2f(gb[1]) * acc[2], hi2f(gb[1]) * acc[3]);
      *(u32x2*)(YM + (size_t)row * DM + 256 + c) = o;
    }
#pragma unroll
    for (int i = 0; i < 3; ++i) {
      int c = lane * 4 + 256 * i;
      float4 bias = *(const float4*)(cb + c);
      float acc[4] = {bias.x, bias.y, bias.z, bias.w};
#pragma unroll
      for (int k = 0; k < 3; ++k) {
        const bf16_t* ur = k == 0 ? um : (k == 1 ? u0 : up);
        bool ok = k == 0 ? hp : (k == 1 ? true : hn);
        if (ok) {
          u32x2 vv = *(const u32x2*)(ur + U_XBC + c);
          float4 wk = *(const float4*)(cw + k * 768 + c);
          acc[0] += wk.x * lo2f(vv[0]); acc[1] += wk.y * hi2f(vv[0]); acc[2] += wk.z * lo2f(vv[1]); acc[3] += wk.w * hi2f(vv[1]);
        }
      }
      u32x2 o; o[0] = pack2(silu_f(acc[0]), silu_f(acc[1])); o[1] = pack2(silu_f(acc[2]), silu_f(acc[3]));
      *(u32x2*)(XBC + (size_t)row * 768 + c) = o;
    }
    if (lane < 16) {
      float v = DT[(size_t)row * 16 + lane] + p.dt_bias[layer * 16 + lane];
      float sp = fmaxf(v, 0.f) + log1pf(__expf(-fabsf(v)));
      DT[(size_t)row * 16 + lane] = sp;
    }
  }
}

DI void phase_ssdnorm(const Params& p, int layer, int bid, int nb) {
  const int w = ltid() >> 6, lane = ltid() & 63;
  const int M = layer == 0 ? MT : ML;
  bf16_t* YM = (bf16_t*)(p.ws + OFF_H);
  const float* SSQ = (const float*)(p.ws + OFF_SSQ);
  const float* ng = p.ssd_norm + layer * 512;
  for (int row = bid * 4 + w; row < M; row += nb * 4) {
    int g = lane >> 5;
    float4 s = *(const float4*)(SSQ + (size_t)row * 8 + g * 4);
    float rstd = rsqrtf((s.x + s.y + s.z + s.w) * (1.f / 256) + EPS);
    bf16_t* ptr = YM + (size_t)row * DM + 512 + lane * 8;
    u32x4 v = *(const u32x4*)ptr;
    float4 g0 = *(const float4*)(ng + lane * 8), g1 = *(const float4*)(ng + lane * 8 + 4);
    u32x4 o;
    o[0] = pack2(lo2f(v[0]) * rstd * g0.x, hi2f(v[0]) * rstd * g0.y);
    o[1] = pack2(lo2f(v[1]) * rstd * g0.z, hi2f(v[1]) * rstd * g0.w);
    o[2] = pack2(lo2f(v[2]) * rstd * g1.x, hi2f(v[2]) * rstd * g1.y);
    o[3] = pack2(lo2f(v[3]) * rstd * g1.z, hi2f(v[3]) * rstd * g1.w);
    *(u32x4*)ptr = o;
  }
}

constexpr int GST = 80;
constexpr int GBUF = 2 * 128 * GST;
template <bool GN, class Epi>
DI void gemm_tile(const bf16_t* __restrict__ A, int lda, const bf16_t* __restrict__ Bt, int K, int row0, int col0, char* smem, Epi epi, const float* __restrict__ ssq = nullptr) {
  bf16_t* S0 = (bf16_t*)smem;
  const int tid = ltid(), wid = tid >> 6, lane = tid & 63, wr = wid >> 1, wc = wid & 1, fr = lane & 15, fq = lane >> 4;
  f32x4 acc[4][4];
#pragma unroll
  for (int m = 0; m < 4; ++m)
#pragma unroll
    for (int n = 0; n < 4; ++n) acc[m][n] = f32x4{0.f, 0.f, 0.f, 0.f};
  u32x4 ra[4], rb[4];
  const int sr = tid >> 3, sp = tid & 7;
  const bf16_t* ga = A + (size_t)(row0 + sr) * lda + sp * 8;
  const bf16_t* gb = Bt + (size_t)(col0 + sr) * K + sp * 8;
  auto gload = [&](int k0) {
#pragma unroll
    for (int i = 0; i < 4; ++i) {
      ra[i] = *(const u32x4*)(ga + (size_t)(32 * i) * lda + k0);
      rb[i] = *(const u32x4*)(gb + (size_t)(32 * i) * K + k0);
    }
  };
  gload(0);
  float gs[4][2];
  if (GN) {
#pragma unroll
    for (int i = 0; i < 4; ++i) {
      const float4 s0 = *(const float4*)(ssq + (size_t)(row0 + sr + 32 * i) * 8), s1 = *(const float4*)(ssq + (size_t)(row0 + sr + 32 * i) * 8 + 4);
      gs[i][0] = rsqrtf((s0.x + s0.y + s0.z + s0.w) * (1.f / 256) + EPS);
      gs[i][1] = rsqrtf((s1.x + s1.y + s1.z + s1.w) * (1.f / 256) + EPS);
    }
  }
  auto swrite = [&](int kt) {
    if (GN && kt >= 8) {
      const int g = (kt - 8) >> 2;
#pragma unroll
      for (int i = 0; i < 4; ++i) {
        const float sc = g ? gs[i][1] : gs[i][0];
#pragma unroll
        for (int jj = 0; jj < 4; ++jj) ra[i][jj] = pack2(lo2f(ra[i][jj]) * sc, hi2f(ra[i][jj]) * sc);
      }
    }
    bf16_t* As = S0 + (kt & 1) * GBUF;
    bf16_t* Bs = As + 128 * GST;
#pragma unroll
    for (int i = 0; i < 4; ++i) {
      *(u32x4*)(As + (sr + 32 * i) * GST + sp * 8) = ra[i];
      *(u32x4*)(Bs + (sr + 32 * i) * GST + sp * 8) = rb[i];
    }
  };
  const int KT = K / 64;
  swrite(0);
  if (KT > 1) gload(64);
  __syncthreads();
  for (int kt = 0; kt < KT; ++kt) {
    const bf16_t* As = S0 + (kt & 1) * GBUF;
    const bf16_t* Bs = As + 128 * GST;
#pragma unroll
    for (int ks = 0; ks < 2; ++ks) {
      bf16x8 af[4], bfr[4];
#pragma unroll
      for (int m = 0; m < 4; ++m) af[m] = *(const bf16x8*)(As + (wr * 64 + m * 16 + fr) * GST + ks * 32 + fq * 8);
#pragma unroll
      for (int n = 0; n < 4; ++n) bfr[n] = *(const bf16x8*)(Bs + (wc * 64 + n * 16 + fr) * GST + ks * 32 + fq * 8);
#pragma unroll
      for (int m = 0; m < 4; ++m)
#pragma unroll
        for (int n = 0; n < 4; ++n) acc[m][n] = MFMA16(bfr[n], af[m], acc[m][n]);
      if (ks == 0 && kt + 1 < KT) {
        swrite(kt + 1);
        if (kt + 2 < KT) gload((kt + 2) * 64);
      }
    }
    __syncthreads();
  }
#pragma unroll
  for (int m = 0; m < 4; ++m)
#pragma unroll
    for (int n = 0; n < 4; ++n) epi(row0 + wr * 64 + m * 16 + fr, col0 + wc * 64 + n * 16 + fq * 4, acc[m][n]);
}

struct EpiBF {
  bf16_t* out; int ldo;
  DI void operator()(int row, int col, const f32x4& a) const {
    u32x2 o; o[0] = pack2(a[0], a[1]); o[1] = pack2(a[2], a[3]);
    *(u32x2*)(out + (size_t)row * ldo + col) = o;
  }
};
struct EpiRelu2 {
  bf16_t* out; int ldo;
  DI void operator()(int row, int col, const f32x4& a) const {
    float r0 = fmaxf(a[0], 0.f), r1 = fmaxf(a[1], 0.f), r2 = fmaxf(a[2], 0.f), r3 = fmaxf(a[3], 0.f);
    u32x2 o; o[0] = pack2(r0 * r0, r1 * r1); o[1] = pack2(r2 * r2, r3 * r3);
    *(u32x2*)(out + (size_t)row * ldo + col) = o;
  }
};
struct EpiU {
  bf16_t* u; float* dt;
  DI void operator()(int row, int col, const f32x4& a) const {
    if (col < DIN) {
      u32x2 o; o[0] = pack2(a[0], a[1]); o[1] = pack2(a[2], a[3]);
      *(u32x2*)(u + (size_t)row * DIN + col) = o;
      if (col >= U_DT) *(float4*)(dt + (size_t)row * 16 + col - U_DT) = make_float4(a[0], a[1], a[2], a[3]);
    }
  }
};
struct EpiQ {
  bf16_t* q; const float* rs;
  DI void operator()(int row, int col, const f32x4& a) const {
    const float r = rs[row * 2];
    u32x2 o; o[0] = pack2(a[0] * r, a[1] * r); o[1] = pack2(a[2] * r, a[3] * r);
    *(u32x2*)(q + (size_t)row * 384 + col) = o;
  }
};
struct EpiKV {
  bf16_t* kb; bf16_t* vt; const float* rs;
  DI void operator()(int row, int col, const f32x4& a) const {
    int b, pos;
    if (row < ML) { b = row >> 12; pos = (row & 4095) + CTX; } else { int rr = row - ML; b = rr >> 8; pos = rr & 255; }
    const int head = col >> 7, d = col & 127;
    const float r = rs[row * 2 + 1];
    if (d < 64) {
      u32x2 o; o[0] = pack2(a[0] * r, a[1] * r); o[1] = pack2(a[2] * r, a[3] * r);
      *(u32x2*)(kb + ((size_t)(b * 4 + head) * LK + pos) * 96 + d) = o;
    } else {
#pragma unroll
      for (int j = 0; j < 4; ++j) vt[((size_t)(b * 4 + head) * 64 + (d - 64 + j)) * LK + pos] = f2bf(a[j] * r);
    }
  }
};

DI void phase_inproj(const Params& p, int layer, int bid, int nb, char* smem) {
  constexpr int NT = DINP / 128;
  EpiU epi{(bf16_t*)(p.ws + OFF_U), (float*)(p.ws + OFF_DT)};
  for (int rep = 0; rep < REP_GEMM; ++rep)
  for (int it = bid; it < (MT / 128) * NT; it += nb)
    gemm_tile<false>((const bf16_t*)(p.ws + OFF_H), DM, wt_ptr(p, layer, WT_IN), 1024, (it / NT) * 128, (it % NT) * 128, smem, epi);
}
DI void phase_wout(const Params& p, int layer, int bid, int nb, char* smem) {
  const int M = layer == 0 ? MT : ML;
  EpiBF epi{(bf16_t*)(p.ws + OFF_U), DM};
  for (int rep = 0; rep < REP_GEMM; ++rep)
  for (int it = bid; it < (M / 128) * 8; it += nb)
    gemm_tile<true>((const bf16_t*)(p.ws + OFF_H), DM, wt_ptr(p, layer, WT_OUT), 1024, (it / 8) * 128, (it % 8) * 128, smem, epi, (const float*)(p.ws + OFF_SSQ));
}
DI void phase_ff1(const Params& p, int layer, int bid, int nb, char* smem) {
  const int M = layer == 0 ? MT : ML;
  EpiRelu2 epi{(bf16_t*)(p.ws + OFF_F1), DFF};
  for (int rep = 0; rep < REP_GEMM; ++rep)
  for (int it = bid; it < (M / 128) * 32; it += nb)
    gemm_tile<false>((const bf16_t*)(p.ws + OFF_H), DM, wt_ptr(p, layer, WT_FF1), 1024, (it / 32) * 128, (it % 32) * 128, smem, epi);
}
DI void phase_ff2(const Params& p, int layer, int bid, int nb, char* smem) {
  const int M = layer == 0 ? MT : ML;
  EpiBF epi{(bf16_t*)(p.ws + OFF_H), DM};
  for (int rep = 0; rep < REP_GEMM; ++rep)
  for (int it = bid; it < (M / 128) * 8; it += nb)
    gemm_tile<false>((const bf16_t*)(p.ws + OFF_F1), DFF, wt_ptr(p, layer, WT_FF2), 4096, (it / 8) * 128, (it % 8) * 128, smem, epi);
}

DI int chunk_row0(int b, int tc) { return tc < 2 ? ML + b * CTX + tc * 128 : b * SEQ + (tc - 2) * 128; }
constexpr int BST = 72;
constexpr int TST = 136;
DI void load_tile_T(bf16_t* dst, const bf16_t* __restrict__ src, int ldg) {
  const int tid = ltid();
#pragma unroll
  for (int i = 0; i < 4; ++i) {
    int c = tid + 256 * i, tok = c & 127, pc = c >> 7;
    u32x4 v = *(const u32x4*)(src + (size_t)tok * ldg + pc * 8);
#pragma unroll
    for (int j = 0; j < 4; ++j) {
      dst[(pc * 8 + 2 * j) * TST + tok] = (bf16_t)(v[j] & 0xffffu);
      dst[(pc * 8 + 2 * j + 1) * TST + tok] = (bf16_t)(v[j] >> 16);
    }
  }
}
DI void chunk_scan(const Params& p, int layer, int row0, int h, float* csf, float* csb, float* dtF, float* dtB, float* laF, float* laB) {
  const int tid = ltid();
  const float* DT = (const float*)(p.ws + OFF_DT);
  if (tid < 128) {
    float af = -__expf(p.a_log[layer * 16 + h]), ab = -__expf(p.a_log[layer * 16 + 8 + h]);
    float df = DT[(size_t)(row0 + tid) * 16 + h], db = DT[(size_t)(row0 + tid) * 16 + 8 + h];
    dtF[tid] = df; dtB[tid] = db; laF[tid] = df * af; laB[tid] = db * ab;
  }
  __syncthreads();
  if (tid < 128) {
    float s = 0.f;
    for (int l = 0; l <= tid; ++l) s += laF[l];
    csf[tid] = s;
  } else {
    int t = tid - 128;
    float s = 0.f;
    for (int l = 127; l >= t; --l) s += laB[l];
    csb[t] = s;
  }
  __syncthreads();
}

DI void ssd_state_item(const Params& p, int layer, int b, int tc, int h, char* smem) {
  bf16_t* XT = (bf16_t*)smem;
  bf16_t* BT = XT + 64 * TST;
  float* csf = (float*)(BT + 64 * TST);
  float* csb = csf + 128; float* dtF = csb + 128; float* dtB = dtF + 128; float* laF = dtB + 128; float* laB = laF + 128;
  const int tid = ltid(), w = tid >> 6, lane = tid & 63, r = lane & 31, hh = lane >> 5;
  const int row0 = chunk_row0(b, tc);
  const bf16_t* XBC = (const bf16_t*)(p.ws + OFF_XBC);
  chunk_scan(p, layer, row0, h, csf, csb, dtF, dtB, laF, laB);
  load_tile_T(XT, XBC + (size_t)row0 * 768 + h * 64, 768);
  load_tile_T(BT, XBC + (size_t)row0 * 768 + 512 + (h >> 2) * 64, 768);
  __syncthreads();
  if (tid < 128) laF[tid] = dtF[tid] * __expf(csf[127] - csf[tid]);
  else { int t = tid - 128; laB[t] = dtB[t] * __expf(csb[0] - csb[t]); }
  __syncthreads();
  const int d = w >> 1, pt = w & 1;
  const float* wv = d == 0 ? laF : laB;
  f32x16 acc[2];
#pragma unroll
  for (int i = 0; i < 16; ++i) { acc[0][i] = 0.f; acc[1][i] = 0.f; }
#pragma unroll
  for (int s = 0; s < 8; ++s) {
    int l0 = 16 * s + 8 * hh;
    u32x4 xa = *(const u32x4*)(XT + (32 * pt + r) * TST + l0);
    u32x4 sa;
#pragma unroll
    for (int j = 0; j < 4; ++j) sa[j] = pack2(lo2f(xa[j]) * wv[l0 + 2 * j], hi2f(xa[j]) * wv[l0 + 2 * j + 1]);
    bf16x8 af = __builtin_bit_cast(bf16x8, sa);
#pragma unroll
    for (int nt = 0; nt < 2; ++nt) {
      bf16x8 bfr = *(const bf16x8*)(BT + (32 * nt + r) * TST + l0);
      acc[nt] = MFMA32(af, bfr, acc[nt]);
    }
  }
  bf16_t* S = (bf16_t*)(p.ws + OFF_SST) + ((((size_t)d * NB + b) * NCH + tc) * 8 + h) * 4096;
#pragma unroll
  for (int nt = 0; nt < 2; ++nt)
#pragma unroll
    for (int i = 0; i < 16; ++i) S[(32 * pt + crow(i, hh)) * 64 + 32 * nt + r] = f2bf(acc[nt][i]);
  if (tid == 0) {
    float* TD = (float*)(p.ws + OFF_TDEC);
    TD[((0 * NB + b) * NCH + tc) * 8 + h] = __expf(csf[127]);
    TD[((1 * NB + b) * NCH + tc) * 8 + h] = __expf(csb[0]);
  }
  __syncthreads();
}

DI void ssd_pass_item(const Params& p, int it) {
  const int e = it * 256 + ltid();
  const int pn2 = e & 2047, h = (e >> 11) & 7, b = (e >> 14) & 3, d = e >> 16;
  unsigned* S = (unsigned*)(p.ws + OFF_SST);
  const float* TD = (const float*)(p.ws + OFF_TDEC);
  unsigned sv[NCH]; float T[NCH];
#pragma unroll
  for (int i = 0; i < NCH; ++i) {
    int tc = d == 0 ? i : (i < 2 ? 1 - i : NCH + 1 - i);
    sv[i] = S[(((size_t)(d * NB + b) * NCH + tc) * 8 + h) * 2048 + pn2];
    T[i] = TD[((d * NB + b) * NCH + tc) * 8 + h];
  }
  float h0 = 0.f, h1 = 0.f;
#pragma unroll
  for (int i = 0; i < NCH; ++i) {
    int tc = d == 0 ? i : (i < 2 ? 1 - i : NCH + 1 - i);
    S[(((size_t)(d * NB + b) * NCH + tc) * 8 + h) * 2048 + pn2] = pack2(h0, h1);
    h0 = T[i] * h0 + lo2f(sv[i]); h1 = T[i] * h1 + hi2f(sv[i]);
  }
}

DI void ssd_out_item(const Params& p, int layer, int b, int tc, int h, char* smem) {
  bf16_t* XT = (bf16_t*)smem;
  bf16_t* Bs = XT + 64 * TST;
  float* csf = (float*)(Bs + 128 * BST);
  float* csb = csf + 128; float* dtF = csb + 128; float* dtB = dtF + 128; float* laF = dtB + 128; float* laB = laF + 128;
  const int tid = ltid(), w = tid >> 6, lane = tid & 63, r = lane & 31, hh = lane >> 5;
  const int row0 = chunk_row0(b, tc), g = h >> 2;
  const bf16_t* XBC = (const bf16_t*)(p.ws + OFF_XBC);
  chunk_scan(p, layer, row0, h, csf, csb, dtF, dtB, laF, laB);
  load_tile_T(XT, XBC + (size_t)row0 * 768 + h * 64, 768);
#pragma unroll
  for (int i = 0; i < 4; ++i) {
    int c = tid + 256 * i, tok = c >> 3, part = c & 7;
    *(u32x4*)(Bs + tok * BST + part * 8) = *(const u32x4*)(XBC + (size_t)(row0 + tok) * 768 + 512 + g * 64 + part * 8);
  }
  const int l = 32 * w + r;
  bf16x8 cf[4];
#pragma unroll
  for (int ks = 0; ks < 4; ++ks) cf[ks] = *(const bf16x8*)(XBC + (size_t)(row0 + l) * 768 + 640 + g * 64 + 16 * ks + 8 * hh);
  __syncthreads();
  const float csf_l = csf[l], csb_l = csb[l];
  f32x16 yacc[2];
#pragma unroll
  for (int i = 0; i < 16; ++i) { yacc[0][i] = 0.f; yacc[1][i] = 0.f; }
#pragma unroll
  for (int st = 0; st < 4; ++st) {
    f32x16 gacc;
#pragma unroll
    for (int i = 0; i < 16; ++i) gacc[i] = 0.f;
#pragma unroll
    for (int ks = 0; ks < 4; ++ks) {
      bf16x8 af = *(const bf16x8*)(Bs + (32 * st + r) * BST + 16 * ks + 8 * hh);
      gacc = MFMA32(af, cf[ks], gacc);
    }
#pragma unroll
    for (int i = 0; i < 16; ++i) {
      int s = 32 * st + crow(i, hh);
      float f;
      if (s < l) f = __expf(csf_l - csf[s]) * dtF[s];
      else if (s > l) f = __expf(csb_l - csb[s]) * dtB[s];
      else f = dtF[s] + dtB[s];
      gacc[i] *= f;
    }
#pragma unroll
    for (int s2 = 0; s2 < 2; ++s2) {
      bf16x8 mf = pack8(gacc, s2);
      int sb = 32 * st + 16 * s2 + 4 * hh;
#pragma unroll
      for (int pt = 0; pt < 2; ++pt) {
        u32x2 lo = *(const u32x2*)(XT + (32 * pt + r) * TST + sb);
        u32x2 hi = *(const u32x2*)(XT + (32 * pt + r) * TST + sb + 8);
        u32x4 xa; xa[0] = lo[0]; xa[1] = lo[1]; xa[2] = hi[0]; xa[3] = hi[1];
        yacc[pt] = MFMA32(__builtin_bit_cast(bf16x8, xa), mf, yacc[pt]);
      }
    }
  }
#pragma unroll
  for (int d = 0; d < 2; ++d) {
    const bf16_t* Hs = (const bf16_t*)(p.ws + OFF_SST) + ((((size_t)d * NB + b) * NCH + tc) * 8 + h) * 4096;
    const float e = __expf(d == 0 ? csf_l : csb_l);
#pragma unroll
    for (int pt = 0; pt < 2; ++pt) {
      f32x16 t;
#pragma unroll
      for (int i = 0; i < 16; ++i) t[i] = 0.f;
#pragma unroll
      for (int ks = 0; ks < 4; ++ks) {
        bf16x8 af = *(const bf16x8*)(Hs + (32 * pt + r) * 64 + 16 * ks + 8 * hh);
        t = MFMA32(af, cf[ks], t);
      }
#pragma unroll
      for (int i = 0; i < 16; ++i) yacc[pt][i] += e * t[i];
    }
  }
  const int row = row0 + l;
  const float Dh = p.ssd_d[layer * 8 + h];
  const bf16_t* U = (const bf16_t*)(p.ws + OFF_U);
  bf16_t* YM = (bf16_t*)(p.ws + OFF_H);
  float ssq = 0.f;
#pragma unroll
  for (int pt = 0; pt < 2; ++pt)
#pragma unroll
    for (int q = 0; q < 4; ++q) {
      int pp = 32 * pt + 8 * q + 4 * hh;
      u32x2 xv = *(const u32x2*)(XBC + (size_t)row * 768 + h * 64 + pp);
      u32x2 zv = *(const u32x2*)(U + (size_t)row * DIN + U_Z + h * 64 + pp);
      float y0 = (yacc[pt][4 * q + 0] + Dh * lo2f(xv[0])) * silu_f(lo2f(zv[0]));
      float y1 = (yacc[pt][4 * q + 1] + Dh * hi2f(xv[0])) * silu_f(hi2f(zv[0]));
      float y2 = (yacc[pt][4 * q + 2] + Dh * lo2f(xv[1])) * silu_f(lo2f(zv[1]));
      float y3 = (yacc[pt][4 * q + 3] + Dh * hi2f(xv[1])) * silu_f(hi2f(zv[1]));
      u32x2 o; o[0] = pack2(y0, y1); o[1] = pack2(y2, y3);
      float r0 = lo2f(o[0]), r1 = hi2f(o[0]), r2 = lo2f(o[1]), r3 = hi2f(o[1]);
      ssq += r0 * r0 + r1 * r1 + r2 * r2 + r3 * r3;
      *(u32x2*)(YM + (size_t)row * DM + 512 + h * 64 + pp) = o;
    }
  ssq += __shfl_xor(ssq, 32);
  if (hh == 0) ((float*)(p.ws + OFF_SSQ))[(size_t)row * 8 + h] = ssq;
  __syncthreads();
}

constexpr int KST = 104;
constexpr int VST = 68;
DI void attn_item(const Params& p, int b, int head, int qrow0, int t0, bool lat, int nkeys, char* smem) {
  bf16_t* Ks = (bf16_t*)smem;
  bf16_t* Vs = Ks + 64 * KST;
  const int tid = ltid(), w = tid >> 6, lane = tid & 63, r = lane & 31, hh = lane >> 5;
  const bf16_t* QB = (const bf16_t*)(p.ws + OFF_QB);
  const bf16_t* KB = (const bf16_t*)(p.ws + OFF_KB) + (size_t)(b * 4 + head) * LK * 96;
  const bf16_t* VT = (const bf16_t*)(p.ws + OFF_VT) + (size_t)(b * 4 + head) * 64 * LK;
  const float qscale = 0.10206207261596575f * 1.4426950408889634f;
  const int qrow = qrow0 + w * 32 + r;
  const int t = t0 + w * 32 + r;
  bf16x8 qf[6];
  {
    const bf16_t* src = QB + (size_t)qrow * 384 + head * 96;
#pragma unroll
    for (int s = 0; s < 4; ++s) {
      u32x4 v = *(const u32x4*)(src + 16 * s + 8 * hh);
      u32x4 o;
#pragma unroll
      for (int j = 0; j < 4; ++j) o[j] = pack2(lo2f(v[j]) * qscale, hi2f(v[j]) * qscale);
      qf[s] = __builtin_bit_cast(bf16x8, o);
    }
#pragma unroll
    for (int s = 4; s < 6; ++s) {
      u32x4 va = *(const u32x4*)(src + 16 * s), vb = *(const u32x4*)(src + 16 * s + 8);
      float posf = s == 4 ? (float)(t >> 6) : (float)(t & 63);
      float o[8];
#pragma unroll
      for (int j = 0; j < 8; ++j) {
        float a = (j & 1) ? hi2f(va[j >> 1]) : lo2f(va[j >> 1]);
        float bb = (j & 1) ? hi2f(vb[j >> 1]) : lo2f(vb[j >> 1]);
        float res;
        if (lat) {
          float invf = exp2f(-(float)(2 * j) * (13.287712379549449f / 16.f));
          float rev = posf * invf * 0.15915494309189535f;
          float cs = __builtin_amdgcn_cosf(rev), sn = __builtin_amdgcn_sinf(rev);
          res = hh == 0 ? a * cs - bb * sn : bb * cs + a * sn;
        } else res = hh == 0 ? a : bb;
        o[j] = res * qscale;
      }
      u32x4 ov; ov[0] = pack2(o[0], o[1]); ov[1] = pack2(o[2], o[3]); ov[2] = pack2(o[4], o[5]); ov[3] = pack2(o[6], o[7]);
      qf[s] = __builtin_bit_cast(bf16x8, ov);
    }
  }
  f32x16 oacc[2];
#pragma unroll
  for (int i = 0; i < 16; ++i) { oacc[0][i] = 0.f; oacc[1][i] = 0.f; }
  float m = -1e30f, lsum = 0.f;
  u32x4 rk[3], rv[2];
  auto gload = [&](int key0) {
#pragma unroll
    for (int i = 0; i < 3; ++i) rk[i] = *(const u32x4*)(KB + (size_t)key0 * 96 + (tid + 256 * i) * 8);
#pragma unroll
    for (int i = 0; i < 2; ++i) { int c = tid + 256 * i; rv[i] = *(const u32x4*)(VT + (size_t)(c >> 3) * LK + key0 + (c & 7) * 8); }
  };
  gload(0);
  const int NT = nkeys / 64;
  for (int kt = 0; kt < NT; ++kt) {
#pragma unroll
    for (int i = 0; i < 3; ++i) { int c = tid + 256 * i; *(u32x4*)(Ks + (c / 12) * KST + (c % 12) * 8) = rk[i]; }
#pragma unroll
    for (int i = 0; i < 2; ++i) {
      int c = tid + 256 * i;
      bf16_t* d = Vs + (c >> 3) * VST + (c & 7) * 8;
      u32x2 a; a[0] = rv[i][0]; a[1] = rv[i][1];
      u32x2 bq; bq[0] = rv[i][2]; bq[1] = rv[i][3];
      *(u32x2*)d = a; *(u32x2*)(d + 4) = bq;
    }
    __syncthreads();
    if (kt + 1 < NT) gload((kt + 1) * 64);
    f32x16 sacc[2];
#pragma unroll
    for (int i = 0; i < 16; ++i) { sacc[0][i] = 0.f; sacc[1][i] = 0.f; }
#pragma unroll
    for (int s = 0; s < 6; ++s)
#pragma unroll
      for (int k2 = 0; k2 < 2; ++k2) {
        bf16x8 af = *(const bf16x8*)(Ks + (32 * k2 + r) * KST + 16 * s + 8 * hh);
        sacc[k2] = MFMA32(af, qf[s], sacc[k2]);
      }
    float mx = sacc[0][0];
#pragma unroll
    for (int i = 0; i < 16; ++i) { mx = fmaxf(mx, sacc[0][i]); mx = fmaxf(mx, sacc[1][i]); }
    mx = fmaxf(mx, __shfl_xor(mx, 32));
    const float mn = fmaxf(m, mx);
    const float alpha = __builtin_amdgcn_exp2f(m - mn);
    m = mn;
    float ps = 0.f;
#pragma unroll
    for (int i = 0; i < 16; ++i) {
      sacc[0][i] = __builtin_amdgcn_exp2f(sacc[0][i] - mn); sacc[1][i] = __builtin_amdgcn_exp2f(sacc[1][i] - mn);
      ps += sacc[0][i] + sacc[1][i];
    }
    lsum = lsum * alpha + ps;
#pragma unroll
    for (int i = 0; i < 16; ++i) { oacc[0][i] *= alpha; oacc[1][i] *= alpha; }
#pragma unroll
    for (int k2 = 0; k2 < 2; ++k2)
#pragma unroll
      for (int s2 = 0; s2 < 2; ++s2) {
        bf16x8 pf = pack8(sacc[k2], s2);
        int kb0 = 32 * k2 + 16 * s2 + 4 * hh;
#pragma unroll
        for (int d = 0; d < 2; ++d) {
          u32x2 lo = *(const u32x2*)(Vs + (32 * d + r) * VST + kb0);
          u32x2 hi = *(const u32x2*)(Vs + (32 * d + r) * VST + kb0 + 8);
          u32x4 va; va[0] = lo[0]; va[1] = lo[1]; va[2] = hi[0]; va[3] = hi[1];
          oacc[d] = MFMA32(__builtin_bit_cast(bf16x8, va), pf, oacc[d]);
        }
      }
    __syncthreads();
  }
  lsum += __shfl_xor(lsum, 32);
  const float inv = 1.f / lsum;
  bf16_t* YM = (bf16_t*)(p.ws + OFF_H) + (size_t)qrow * DM + head * 64;
#pragma unroll
  for (int d = 0; d < 2; ++d)
#pragma unroll
    for (int q = 0; q < 4; ++q) {
      u32x2 o; o[0] = pack2(oacc[d][4 * q] * inv, oacc[d][4 * q + 1] * inv); o[1] = pack2(oacc[d][4 * q + 2] * inv, oacc[d][4 * q + 3] * inv);
      *(u32x2*)(YM + 32 * d + 8 * q + 4 * hh) = o;
    }
}

DI void phase_qkv(const Params& p, int layer, int bid, int nb, char* smem) {
  const int MQ = layer == 0 ? MT : ML;
  const int nq = (MQ / 128) * 3, nkv = (MT / 128) * 4, nst = NB * NCH * 8;
  const float* RS = (const float*)(p.ws + OFF_RSTD);
  EpiQ eq{(bf16_t*)(p.ws + OFF_QB), RS};
  EpiKV ekv{(bf16_t*)(p.ws + OFF_KB), (bf16_t*)(p.ws + OFF_VT), RS};
  const bf16_t* U = (const bf16_t*)(p.ws + OFF_U);
  for (int it = bid; it < nq + nkv + nst; it += nb) {
    if (it < nq) gemm_tile<false>(U, DIN, wt_ptr(p, layer, WT_UQ), 256, (it / 3) * 128, (it % 3) * 128, smem, eq);
    else if (it < nq + nkv) { int j = it - nq; gemm_tile<false>(U + U_CKV, DIN, wt_ptr(p, layer, WT_UKV), 128, (j / 4) * 128, (j % 4) * 128, smem, ekv); }
    else { int j = it - nq - nkv; for (int rep = 0; rep < REP_SSD; ++rep) ssd_state_item(p, layer, j / (NCH * 8), (j / 8) % NCH, j & 7, smem); }
  }
}
DI void phase_att(const Params& p, int layer, int bid, int nb, char* smem) {
  const int natt = 512 + (layer == 0 ? 32 : 0), npass = 512;
  for (int it = bid; it < natt + npass; it += nb) {
    if (it < 512) { int b = it >> 7, head = (it >> 5) & 3, qb = it & 31; for (int rep = 0; rep < REP_ATT; ++rep) attn_item(p, b, head, b * SEQ + qb * 128, qb * 128, true, LK, smem); }
    else if (it < natt) { int j = it - 512; int b = j >> 3, head = (j >> 1) & 3, qb = j & 1; attn_item(p, b, head, ML + b * CTX + qb * 128, qb * 128, false, CTX, smem); }
    else ssd_pass_item(p, it - natt);
  }
}
DI void phase_ssdout(const Params& p, int layer, int bid, int nb, char* smem) {
  for (int it = bid; it < NB * NCH * 8; it += nb) {
    int b = it / (NCH * 8), tc = (it / 8) % NCH, h = it & 7;
    if (layer == 1 && tc < 2) continue;
    for (int rep = 0; rep < REP_SSD; ++rep) ssd_out_item(p, layer, b, tc, h, smem);
  }
}


#define XB_TMO      128
#define XB_XCNT(j)  (256  + 64 * (j))
#define XB_XSUB(j)  (1280 + 64 * (j))
#define XB_XGEN(j)  (2304 + 64 * (j))
#define XB_TOP      3328
#define XB_TOPGEN   3392
#define XCD_BAR_WORDS 3456
#define XB_SPIN_CAP (1u << 22)
#define LAS __attribute__((address_space(3)))
DI unsigned xb_ld(unsigned* p) { return __hip_atomic_load(p, __ATOMIC_RELAXED, __HIP_MEMORY_SCOPE_AGENT); }
DI unsigned xb_add(unsigned* p, unsigned v) { return __hip_atomic_fetch_add(p, v, __ATOMIC_RELAXED, __HIP_MEMORY_SCOPE_AGENT); }
DI unsigned xb_xcc_id() { return (unsigned)__builtin_amdgcn_s_getreg((3 << 11) | 20) & 0xFu; }
#define XB_SPIN(cond, bar) do { unsigned _sp = 0; while (cond) { __builtin_amdgcn_s_sleep(1); \
    if ((++_sp & 255u) == 0u) { if (xb_ld(&(bar)[XB_TMO])) break; if (_sp > XB_SPIN_CAP) { atomicAdd(&(bar)[XB_TMO], 1u); break; } } } } while (0)
struct XcdBarrier { unsigned* bar; unsigned x; volatile LAS unsigned* st; };
DI XcdBarrier xcd_barrier_post(unsigned* bar, volatile LAS unsigned* st) {
  XcdBarrier b; b.bar = bar; b.x = xb_xcc_id(); b.st = st;
  if (threadIdx.x == 0) (void)xb_add(&bar[XB_XCNT(b.x)], 1u);
  return b;
}
DI void xcd_barrier_complete(unsigned* bar, unsigned x, unsigned& nloc, unsigned& nx) {
  const unsigned G = gridDim.x * gridDim.y * gridDim.z;
  unsigned sum, cnt, mine, sp = 0u;
  for (;;) {
    sum = 0u; cnt = 0u; mine = 0u;
#pragma unroll
    for (unsigned j = 0; j < 16; ++j) { const unsigned c = xb_ld(&bar[XB_XCNT(j)]); sum += c; cnt += (c > 0u) ? 1u : 0u; mine = (j == x) ? c : mine; }
    if (sum == G) break;
    __builtin_amdgcn_s_sleep(1);
    if ((++sp & 255u) == 0u) { if (xb_ld(&bar[XB_TMO])) break; if (sp > XB_SPIN_CAP) { atomicAdd(&bar[XB_TMO], 1u); break; } }
  }
  nloc = mine > 0u ? mine : 1u; nx = cnt > 0u ? cnt : 1u;
}
DI void xcd_barrier(const XcdBarrier& b) {
  asm volatile("s_waitcnt vmcnt(0)" ::: "memory");
  __syncthreads();
  if (threadIdx.x == 0) {
    unsigned* bar = b.bar;
    __builtin_amdgcn_s_waitcnt(0);
    unsigned nloc = b.st[0], nx = b.st[1];
    if (nloc == 0u) { xcd_barrier_complete(bar, b.x, nloc, nx); b.st[0] = nloc; b.st[1] = nx; }
    const unsigned old = xb_add(&bar[XB_XSUB(b.x)], 1u);
    const unsigned gen = old / nloc;
    if (old + 1u == (gen + 1u) * nloc) {
      __builtin_amdgcn_fence(__ATOMIC_RELEASE, "agent");
      asm volatile("s_waitcnt vmcnt(0)" ::: "memory");
      const unsigned og = xb_add(&bar[XB_TOP], 1u);
      const unsigned tg = og / nx;
      if (og + 1u == (tg + 1u) * nx) xb_add(&bar[XB_TOPGEN], 1u);
      else XB_SPIN(xb_ld(&bar[XB_TOPGEN]) == tg, bar);
      __builtin_amdgcn_fence(__ATOMIC_ACQUIRE, "agent");
      xb_add(&bar[XB_XGEN(b.x)], 1u);
      asm volatile("s_waitcnt vmcnt(0)" ::: "memory");
    } else {
      XB_SPIN(xb_ld(&bar[XB_XGEN(b.x)]) == gen, bar);
      __builtin_amdgcn_fence(__ATOMIC_ACQUIRE, "agent");
      asm volatile("s_waitcnt vmcnt(0)" ::: "memory");
    }
  }
  __syncthreads();
}

constexpr int SMEM_BYTES = 2 * GBUF * 2;
enum { PH_PREP0 = 0, PH_H0, PH_INPROJ, PH_PREP, PH_QKV, PH_ATT, PH_SSDOUT, PH_WOUT, PH_POSTMIX, PH_FF1, PH_FF2, PH_POSTFFN, PH_SSDNORM };

DI void run_phase(const Params& p, int ph, int layer, int bid, int nb, char* smem) {
  switch (ph) {
    case PH_PREP0: phase_prep0(p, bid, nb, smem); break;
    case PH_H0: phase_h0(p, bid, nb); break;
    case PH_INPROJ: phase_inproj(p, layer, bid, nb, smem); break;
    case PH_PREP: phase_prep(p, layer, bid, nb); break;
    case PH_QKV: phase_qkv(p, layer, bid, nb, smem); break;
    case PH_ATT: phase_att(p, layer, bid, nb, smem); break;
    case PH_SSDOUT: phase_ssdout(p, layer, bid, nb, smem); break;
    case PH_SSDNORM: phase_ssdnorm(p, layer, bid, nb); break;
    case PH_WOUT: phase_wout(p, layer, bid, nb, smem); break;
    case PH_POSTMIX: phase_postmix(p, layer, bid, nb); break;
    case PH_FF1: phase_ff1(p, layer, bid, nb, smem); break;
    case PH_FF2: phase_ff2(p, layer, bid, nb, smem); break;
    case PH_POSTFFN: phase_postffn(p, layer, bid, nb); break;
  }
}

__global__ void __launch_bounds__(256, 2) mega_kernel(Params p) {
  extern __shared__ __attribute__((aligned(16))) char smem[];
  cg::grid_group grid = cg::this_grid();
  if (p.ws == nullptr) grid.sync();
  const int bid = blockIdx.x, nb = gridDim.x;
  volatile LAS unsigned* st = (volatile LAS unsigned*)(smem + SMEM_BYTES - 16);
  if (threadIdx.x == 0) { st[0] = 0u; st[1] = 0u; st[2] = 0u; st[3] = 0u; }
  __syncthreads();
  XcdBarrier xb = xcd_barrier_post((unsigned*)(p.ws + OFF_BAR), st);
  for (int step = 0; step < 22; ++step) {
    int ph, layer;
    if (step < 2) { ph = step; layer = 0; }
    else { int j = step - 2; layer = j / 10; ph = PH_INPROJ + j % 10; }
    run_phase(p, ph, layer, bid, nb, smem);
    if (step < 21) xcd_barrier(xb);
  }
}

extern "C" void kernel_launch(void* const* d_in, const int* in_sizes, int n_in, void* d_out, int out_size, void* d_ws, size_t ws_size,
                              hipStream_t stream) {
  if (ws_size < WS_NEED) { fprintf(stderr, "workspace too small: %zu < %zu\n", ws_size, (size_t)WS_NEED); return; }
  Params p{};
  const float** f = (const float**)&p;
  for (int i = 0; i < 25; ++i) f[i] = (const float*)d_in[i];
  p.out = (float*)d_out;
  p.ws = (char*)d_ws;
  static int grid_blocks = 0;
  if (!grid_blocks) {
    int dev = 0, cus = 0, per_cu = 0;
    hipGetDevice(&dev);
    hipDeviceGetAttribute(&cus, hipDeviceAttributeMultiprocessorCount, dev);
    hipFuncSetAttribute((const void*)mega_kernel, hipFuncAttributeMaxDynamicSharedMemorySize, SMEM_BYTES);
    hipOccupancyMaxActiveBlocksPerMultiprocessor(&per_cu, mega_kernel, 256, SMEM_BYTES);
    if (per_cu > 2) per_cu = 2;
    grid_blocks = cus * per_cu;
  }
  hipMemsetAsync((char*)d_ws + OFF_BAR, 0, XCD_BAR_WORDS * 4, stream);
  void* args[] = {&p};
  hipError_t e = hipLaunchCooperativeKernel((void*)mega_kernel, dim3(grid_blocks), dim3(256), args, SMEM_BYTES, stream);
  if (e != hipSuccess) fprintf(stderr, "cooperative launch failed: %s (grid %d)\n", hipGetErrorString(e), grid_blocks);
}
```

```cpp
#include <hip/hip_runtime.h>
#include <hip/hip_cooperative_groups.h>
#include <stdint.h>
#include <stdio.h>
namespace cg = cooperative_groups;

#ifndef MEGA
#define MEGA 1
#endif
#ifndef REP_GEMM
#define REP_GEMM 1
#endif
#ifndef REP_ATT
#define REP_ATT 1
#endif
#ifndef REP_SSD
#define REP_SSD 1
#endif

typedef unsigned short bf16_t;
using bf16x8 = __attribute__((ext_vector_type(8))) short;
using s16x4  = __attribute__((ext_vector_type(4))) short;
using f32x4  = __attribute__((ext_vector_type(4))) float;
using f32x16 = __attribute__((ext_vector_type(16))) float;
using u32x4  = __attribute__((ext_vector_type(4))) unsigned;
using u32x2  = __attribute__((ext_vector_type(2))) unsigned;
#define DI __device__ __forceinline__
#define MFMA32(a, b, c) __builtin_amdgcn_mfma_f32_32x32x16_bf16((a), (b), (c), 0, 0, 0)
#define MFMA16(a, b, c) __builtin_amdgcn_mfma_f32_16x16x32_bf16((a), (b), (c), 0, 0, 0)

constexpr int DM = 1024, NB = 4, SEQ = 4096, CTX = 256;
constexpr int ML = NB * SEQ;
constexpr int MC = NB * CTX;
constexpr int MT = ML + MC;
constexpr int DIN = 2480, DINP = 2560;
constexpr int LK = CTX + SEQ;
constexpr int DFF = 4096;
constexpr int NCH = 34;
constexpr float EPS = 1e-6f;
constexpr int U_CKV = 256, U_KR = 384, U_GB = 416, U_GC = 672, U_VAL = 928, U_Z = 1184, U_XBC = 1696, U_DT = 2464;

constexpr size_t AL(size_t x) { return (x + 255) & ~(size_t)255; }
constexpr size_t WT_IN = 0;
constexpr size_t WT_UQ = WT_IN + (size_t)DINP * 1024;
constexpr size_t WT_UKV = WT_UQ + (size_t)384 * 256;
constexpr size_t WT_OUT = WT_UKV + (size_t)512 * 128;
constexpr size_t WT_FF1 = WT_OUT + (size_t)1024 * 1024;
constexpr size_t WT_FF2 = WT_FF1 + (size_t)4096 * 1024;
constexpr size_t WT_ELEMS = WT_FF2 + (size_t)4096 * 1024;
constexpr size_t OFF_WT = 0;
constexpr size_t OFF_MOD = AL(OFF_WT + 2 * WT_ELEMS * 2);
constexpr size_t OFF_XC = AL(OFF_MOD + 2 * 5 * 6144 * 4);
constexpr size_t OFF_H = AL(OFF_XC + (size_t)MC * DM * 4);
constexpr size_t OFF_R1 = AL(OFF_H + (size_t)MT * DM * 2);
constexpr size_t OFF_U = OFF_R1;
constexpr size_t OFF_DT = AL(OFF_U + (size_t)MT * DIN * 2);
constexpr size_t OFF_RSTD = AL(OFF_DT + (size_t)MT * 16 * 4);
constexpr size_t OFF_QB = AL(OFF_RSTD + (size_t)MT * 2 * 4);
constexpr size_t OFF_KB = AL(OFF_QB + (size_t)MT * 384 * 2);
constexpr size_t OFF_VT = AL(OFF_KB + (size_t)NB * 4 * LK * 96 * 2);
constexpr size_t OFF_XBC = AL(OFF_VT + (size_t)NB * 4 * 64 * LK * 2);
constexpr size_t OFF_SST = AL(OFF_XBC + (size_t)MT * 768 * 2);
constexpr size_t OFF_TDEC = AL(OFF_SST + (size_t)2 * NB * NCH * 8 * 4096 * 2);
constexpr size_t OFF_SSQ = AL(OFF_TDEC + (size_t)2 * NB * NCH * 8 * 4);
constexpr size_t OFF_END1 = AL(OFF_SSQ + (size_t)MT * 8 * 4);
constexpr size_t OFF_F1 = OFF_R1;
constexpr size_t OFF_END2 = AL(OFF_F1 + (size_t)MT * DFF * 2);
constexpr size_t OFF_BAR = OFF_END1 > OFF_END2 ? OFF_END1 : OFF_END2;
constexpr size_t WS_NEED = OFF_BAR + 16384;

struct Params {
  const float *x, *c, *ctx, *c_ctx, *w_mod, *b_mod, *g_pre_mix, *w_in, *q_norm, *w_uq, *kv_norm, *w_ukv, *sc_w, *ssd_cw, *ssd_cb,
      *a_log, *dt_bias, *ssd_d, *ssd_norm, *w_out, *g_post_mix, *g_pre_ffn, *w_ff1, *w_ff2, *g_post_ffn;
  float* out;
  char* ws;
};

DI int ltid() { int t = threadIdx.x; asm volatile("" : "+v"(t)); return t; }
DI bf16_t f2bf(float x) { unsigned u = __float_as_uint(x); u += 0x7fffu + ((u >> 16) & 1u); return (bf16_t)(u >> 16); }
DI float bf2f(unsigned v) { return __uint_as_float(v << 16); }
DI unsigned pack2(float a, float b) { return (unsigned)f2bf(a) | ((unsigned)f2bf(b) << 16); }
DI float lo2f(unsigned w) { return __uint_as_float(w << 16); }
DI float hi2f(unsigned w) { return __uint_as_float(w & 0xffff0000u); }
DI float wave_sum(float v) {
#pragma unroll
  for (int o = 32; o > 0; o >>= 1) v += __shfl_xor(v, o);
  return v;
}
DI float silu_f(float x) { return x / (1.f + __expf(-x)); }
DI int crow(int reg, int h) { return (reg & 3) + 8 * (reg >> 2) + 4 * h; }
DI bf16x8 pack8(const f32x16& x, int s) {
  u32x4 p;
  p[0] = pack2(x[8 * s + 0], x[8 * s + 1]); p[1] = pack2(x[8 * s + 2], x[8 * s + 3]);
  p[2] = pack2(x[8 * s + 4], x[8 * s + 5]); p[3] = pack2(x[8 * s + 6], x[8 * s + 7]);
  return __builtin_bit_cast(bf16x8, p);
}
DI const float* xin_row(const Params& p, int layer, int row) {
  if (layer == 0) return row < ML ? p.x + (size_t)row * DM : p.ctx + (size_t)(row - ML) * DM;
  return row < ML ? p.out + (size_t)row * DM : (const float*)(p.ws + OFF_XC) + (size_t)(row - ML) * DM;
}
DI float* xst_row(const Params& p, int row) {
  return row < ML ? p.out + (size_t)row * DM : (float*)(p.ws + OFF_XC) + (size_t)(row - ML) * DM;
}
DI const float* mod_ptr(const Params& p, int layer, int row, int which) {
  int bb = row < ML ? (row >> 12) : 4;
  return (const float*)(p.ws + OFF_MOD) + ((size_t)(layer * 5 + bb) * 6 + which) * DM;
}
DI bf16_t* wt_ptr(const Params& p, int layer, size_t off) { return (bf16_t*)(p.ws + OFF_WT) + (size_t)layer * WT_ELEMS + off; }

DI void transpose_item(const float* __restrict__ w, const float* __restrict__ gk, int gk_from, bf16_t* __restrict__ wt, int K, int N, int kt, int nt, char* smem) {
  float* tile = (float*)smem;
  const int tid = ltid(), tx = tid & 63, ty = tid >> 6;
  const int k0 = kt * 64, n0 = nt * 64;
  const int n = n0 + tx;
  float v[16];
#pragma unroll
  for (int i = 0; i < 16; ++i) {
    int kk = ty + 4 * i;
    v[i] = n < N ? w[(size_t)(k0 + kk) * N + n] : 0.f;
  }
  if (gk) {
#pragma unroll
    for (int i = 0; i < 16; ++i) { int k = k0 + ty + 4 * i; if (k >= gk_from) v[i] *= gk[k - gk_from]; }
  }
#pragma unroll
  for (int i = 0; i < 16; ++i) tile[(ty + 4 * i) * 65 + tx] = v[i];
  __syncthreads();
#pragma unroll
  for (int i = 0; i < 2; ++i) {
    int c = tid + 256 * i, nn = c >> 3, kc = c & 7;
    u32x4 o;
#pragma unroll
    for (int jj = 0; jj < 4; ++jj) o[jj] = pack2(tile[(kc * 8 + 2 * jj) * 65 + nn], tile[(kc * 8 + 2 * jj + 1) * 65 + nn]);
    *(u32x4*)(wt + (size_t)(n0 + nn) * K + k0 + kc * 8) = o;
  }
  __syncthreads();
}

DI void modgemv_item(const Params& p, int layer, int ct, char* smem) {
  float* s = (float*)smem;
  float* red = s + 5 * 1024;
  const int tid = ltid(), w = tid >> 6, lane = tid & 63;
  for (int i = tid; i < 5 * 1024; i += 256) {
    int bb = i >> 10, k = i & 1023;
    float v = bb < 4 ? p.c[bb * 1024 + k] : p.c_ctx[k];
    s[i] = silu_f(v);
  }
  __syncthreads();
  const float* wm = p.w_mod + (size_t)layer * 1024 * 6144;
  const int n = ct * 64 + lane;
  float acc[5] = {0.f, 0.f, 0.f, 0.f, 0.f};
#pragma unroll 16
  for (int k = w * 256; k < w * 256 + 256; ++k) {
    float wv = wm[(size_t)k * 6144 + n];
#pragma unroll
    for (int bb = 0; bb < 5; ++bb) acc[bb] += s[bb * 1024 + k] * wv;
  }
#pragma unroll
  for (int bb = 0; bb < 5; ++bb) red[(w * 5 + bb) * 64 + lane] = acc[bb];
  __syncthreads();
  for (int i = tid; i < 320; i += 256) {
    int bb = i >> 6, ln = i & 63;
    float v = red[(0 * 5 + bb) * 64 + ln] + red[(1 * 5 + bb) * 64 + ln] + red[(2 * 5 + bb) * 64 + ln] + red[(3 * 5 + bb) * 64 + ln];
    int nn = ct * 64 + ln;
    v += p.b_mod[layer * 6144 + nn];
    ((float*)(p.ws + OFF_MOD))[(size_t)(layer * 5 + bb) * 6144 + nn] = v;
  }
  __syncthreads();
}

DI void phase_prep0(const Params& p, int bid, int nb, char* smem) {
  constexpr int PER = 2984;
  for (int it = bid; it < 192 + 2 * PER; it += nb) {
    if (it < 192) { modgemv_item(p, it / 96, it % 96, smem); continue; }
    int layer = (it - 192) / PER, j = (it - 192) % PER;
    if (j < 640) transpose_item(p.w_in + (size_t)layer * 1024 * DIN, nullptr, 0, wt_ptr(p, layer, WT_IN), 1024, DIN, j / 40, j % 40, smem);
    else if ((j -= 640) < 24) transpose_item(p.w_uq + (size_t)layer * 256 * 384, p.q_norm + layer * 256, 0, wt_ptr(p, layer, WT_UQ), 256, 384, j / 6, j % 6, smem);
    else if ((j -= 24) < 16) transpose_item(p.w_ukv + (size_t)layer * 128 * 512, p.kv_norm + layer * 128, 0, wt_ptr(p, layer, WT_UKV), 128, 512, j / 8, j % 8, smem);
    else if ((j -= 16) < 256) transpose_item(p.w_out + (size_t)layer * 1024 * 1024, p.ssd_norm + layer * 512, 512, wt_ptr(p, layer, WT_OUT), 1024, 1024, j / 16, j % 16, smem);
    else if ((j -= 256) < 1024) transpose_item(p.w_ff1 + (size_t)layer * 1024 * 4096, nullptr, 0, wt_ptr(p, layer, WT_FF1), 1024, 4096, j / 64, j % 64, smem);
    else { j -= 1024; transpose_item(p.w_ff2 + (size_t)layer * 4096 * 1024, nullptr, 0, wt_ptr(p, layer, WT_FF2), 4096, 1024, j / 16, j % 16, smem); }
  }
}

DI void write_h_row(const float4 xv[4], float rstd, const float* g, const float* sh, const float* sc, bf16_t* hrow, int lane) {
#pragma unroll
  for (int i = 0; i < 4; ++i) {
    int col = lane * 4 + 256 * i;
    float4 gg = *(const float4*)(g + col), s1 = *(const float4*)(sc + col), s0 = *(const float4*)(sh + col);
    float a = xv[i].x * rstd * gg.x * (1.f + s1.x) + s0.x;
    float b = xv[i].y * rstd * gg.y * (1.f + s1.y) + s0.y;
    float c = xv[i].z * rstd * gg.z * (1.f + s1.z) + s0.z;
    float d = xv[i].w * rstd * gg.w * (1.f + s1.w) + s0.w;
    u32x2 o; o[0] = pack2(a, b); o[1] = pack2(c, d);
    *(u32x2*)(hrow + col) = o;
  }
}
DI float ssq4(const float4 v[4]) {
  float s = 0.f;
#pragma unroll
  for (int i = 0; i < 4; ++i) s += v[i].x * v[i].x + v[i].y * v[i].y + v[i].z * v[i].z + v[i].w * v[i].w;
  return s;
}
DI void load_bf_row(const bf16_t* r, int lane, float4 v[4]) {
#pragma unroll
  for (int i = 0; i < 4; ++i) {
    u32x2 t = *(const u32x2*)(r + lane * 4 + 256 * i);
    v[i] = make_float4(lo2f(t[0]), hi2f(t[0]), lo2f(t[1]), hi2f(t[1]));
  }
}

DI void phase_h0(const Params& p, int bid, int nb) {
  const int w = ltid() >> 6, lane = ltid() & 63;
  bf16_t* H = (bf16_t*)(p.ws + OFF_H);
  for (int row = bid * 4 + w; row < MT; row += nb * 4) {
    const float* xr = xin_row(p, 0, row);
    float4 xv[4];
#pragma unroll
    for (int i = 0; i < 4; ++i) xv[i] = *(const float4*)(xr + lane * 4 + 256 * i);
    float rstd = rsqrtf(wave_sum(ssq4(xv)) * (1.f / DM) + EPS);
    write_h_row(xv, rstd, p.g_pre_mix, mod_ptr(p, 0, row, 0), mod_ptr(p, 0, row, 1), H + (size_t)row * DM, lane);
  }
}

DI void phase_postmix(const Params& p, int layer, int bid, int nb) {
  const int w = ltid() >> 6, lane = ltid() & 63;
  const int M = layer == 0 ? MT : ML;
  bf16_t* H = (bf16_t*)(p.ws + OFF_H);
  const bf16_t* Y = (const bf16_t*)(p.ws + OFF_U);
  for (int row = bid * 4 + w; row < M; row += nb * 4) {
    float4 yv[4], xv[4];
    load_bf_row(Y + (size_t)row * DM, lane, yv);
    const float* xr = xin_row(p, layer, row);
#pragma unroll
    for (int i = 0; i < 4; ++i) xv[i] = *(const float4*)(xr + lane * 4 + 256 * i);
    float rstd = rsqrtf(wave_sum(ssq4(yv)) * (1.f / DM) + EPS);
    const float* g1 = mod_ptr(p, layer, row, 2);
    const float* gp = p.g_post_mix + layer * DM;
    float* xo = xst_row(p, row);
#pragma unroll
    for (int i = 0; i < 4; ++i) {
      int col = lane * 4 + 256 * i;
      float4 a = *(const float4*)(g1 + col), b = *(const float4*)(gp + col);
      xv[i].x += a.x * yv[i].x * rstd * b.x; xv[i].y += a.y * yv[i].y * rstd * b.y;
      xv[i].z += a.z * yv[i].z * rstd * b.z; xv[i].w += a.w * yv[i].w * rstd * b.w;
      *(float4*)(xo + col) = xv[i];
    }
    float rstd1 = rsqrtf(wave_sum(ssq4(xv)) * (1.f / DM) + EPS);
    write_h_row(xv, rstd1, p.g_pre_ffn + layer * DM, mod_ptr(p, layer, row, 3), mod_ptr(p, layer, row, 4), H + (size_t)row * DM, lane);
  }
}

DI void phase_postffn(const Params& p, int layer, int bid, int nb) {
  const int w = ltid() >> 6, lane = ltid() & 63;
  const int M = layer == 0 ? MT : ML;
  bf16_t* H = (bf16_t*)(p.ws + OFF_H);
  for (int row = bid * 4 + w; row < M; row += nb * 4) {
    float4 fv[4], xv[4];
    load_bf_row(H + (size_t)row * DM, lane, fv);
    float* xo = xst_row(p, row);
#pragma unroll
    for (int i = 0; i < 4; ++i) xv[i] = *(const float4*)(xo + lane * 4 + 256 * i);
    float rstd = rsqrtf(wave_sum(ssq4(fv)) * (1.f / DM) + EPS);
    const float* g2 = mod_ptr(p, layer, row, 5);
    const float* gp = p.g_post_ffn + layer * DM;
#pragma unroll
    for (int i = 0; i < 4; ++i) {
      int col = lane * 4 + 256 * i;
      float4 a = *(const float4*)(g2 + col), b = *(const float4*)(gp + col);
      xv[i].x += a.x * fv[i].x * rstd * b.x; xv[i].y += a.y * fv[i].y * rstd * b.y;
      xv[i].z += a.z * fv[i].z * rstd * b.z; xv[i].w += a.w * fv[i].w * rstd * b.w;
      *(float4*)(xo + col) = xv[i];
    }
    if (layer == 0) {
      float rstd1 = rsqrtf(wave_sum(ssq4(xv)) * (1.f / DM) + EPS);
      write_h_row(xv, rstd1, p.g_pre_mix + DM, mod_ptr(p, 1, row, 0), mod_ptr(p, 1, row, 1), H + (size_t)row * DM, lane);
    }
  }
}

DI void phase_prep(const Params& p, int layer, int bid, int nb) {
  const int w = ltid() >> 6, lane = ltid() & 63;
  const bf16_t* U = (const bf16_t*)(p.ws + OFF_U);
  float* DT = (float*)(p.ws + OFF_DT);
  float* RS = (float*)(p.ws + OFF_RSTD);
  bf16_t* KB = (bf16_t*)(p.ws + OFF_KB);
  bf16_t* XBC = (bf16_t*)(p.ws + OFF_XBC);
  bf16_t* YM = (bf16_t*)(p.ws + OFF_H);
  const float* scw = p.sc_w + layer * 3 * 256;
  const float* cw = p.ssd_cw + layer * 3 * 768;
  const float* cb = p.ssd_cb + layer * 768;
  for (int row = bid * 4 + w; row < MT; row += nb * 4) {
    int b, t, L, pos;
    bool lat = row < ML;
    if (lat) { b = row >> 12; t = row & 4095; L = SEQ; pos = t + CTX; }
    else { int rr = row - ML; b = rr >> 8; t = rr & 255; L = CTX; pos = t; }
    const bf16_t* u0 = U + (size_t)row * DIN;
    const bool hp = t > 0, hn = t < L - 1;
    const bf16_t* um = u0 - DIN;
    const bf16_t* up = u0 + DIN;
    {
      u32x2 v = *(const u32x2*)(u0 + lane * 4);
      float a = lo2f(v[0]), bq = hi2f(v[0]), c = lo2f(v[1]), d = hi2f(v[1]);
      float ss = wave_sum(a * a + bq * bq + c * c + d * d);
      float s2 = 0.f;
      if (lane < 32) {
        u32x2 v2 = *(const u32x2*)(u0 + U_CKV + lane * 4);
        float e = lo2f(v2[0]), f = hi2f(v2[0]), g = lo2f(v2[1]), h = hi2f(v2[1]);
        s2 = e * e + f * f + g * g + h * h;
      }
      s2 = wave_sum(s2);
      if (lane == 0) { RS[row * 2] = rsqrtf(ss * (1.f / 256) + EPS); RS[row * 2 + 1] = rsqrtf(s2 * (1.f / 128) + EPS); }
    }
    {
      float v = bf2f(u0[U_KR + (lane & 31)]);
      float partner = __shfl_xor(v, 8);
      float o = v;
      if (lat) {
        int grp = (lane & 31) >> 3, i = lane & 7;
        float posf = grp < 2 ? (float)(t >> 6) : (float)(t & 63);
        float invf = exp2f(-(float)(2 * i) * (13.287712379549449f / 16.f));
        float ang = posf * invf;
        float rev = ang * 0.15915494309189535f;
        float cs = __builtin_amdgcn_cosf(rev), sn = __builtin_amdgcn_sinf(rev);
        o = (grp & 1) ? v * cs + partner * sn : v * cs - partner * sn;
      }
      if (lane < 32) {
        bf16_t ob = f2bf(o);
#pragma unroll
        for (int hd = 0; hd < 4; ++hd) KB[((size_t)(b * 4 + hd) * LK + pos) * 96 + 64 + lane] = ob;
      }
    }
    {
      int c = lane * 4;
      float acc[4] = {0.f, 0.f, 0.f, 0.f};
#pragma unroll
      for (int k = 0; k < 3; ++k) {
        const bf16_t* ur = k == 0 ? um : (k == 1 ? u0 : up);
        bool ok = k == 0 ? hp : (k == 1 ? true : hn);
        if (ok) {
          u32x2 gc = *(const u32x2*)(ur + U_GC + c), vv = *(const u32x2*)(ur + U_VAL + c);
          float4 wk = *(const float4*)(scw + k * 256 + c);
          acc[0] += wk.x * lo2f(gc[0]) * lo2f(vv[0]); acc[1] += wk.y * hi2f(gc[0]) * hi2f(vv[0]);
          acc[2] += wk.z * lo2f(gc[1]) * lo2f(vv[1]); acc[3] += wk.w * hi2f(gc[1]) * hi2f(vv[1]);
        }
      }
      u32x2 gb = *(const u32x2*)(u0 + U_GB + c);
      u32x2 o; o[0] = pack2(lo2f(gb[0]) * acc[0], hi2f(gb[0]) * acc[1]); o[1] = pack2(lo2f(gb[1]) * acc[2], hi2f(gb[1]) * acc[3]);
      *(u32x2*)(YM + (size_t)row * DM + 256 + c) = o;
    }
#pragma unroll
    for (int i = 0; i < 3; ++i) {
      int c = lane * 4 + 256 * i;
      float4 bias = *(const float4*)(cb + c);
      float acc[4] = {bias.x, bias.y, bias.z, bias.w};
#pragma unroll
      for (int k = 0; k < 3; ++k) {
        const bf16_t* ur = k == 0 ? um : (k == 1 ? u0 : up);
        bool ok = k == 0 ? hp : (k == 1 ? true : hn);
        if (ok) {
          u32x2 vv = *(const u32x2*)(ur + U_XBC + c);
          float4 wk = *(const float4*)(cw + k * 768 + c);
          acc[0] += wk.x * lo2f(vv[0]); acc[1] += wk.y * hi2f(vv[0]); acc[2] += wk.z * lo2f(vv[1]); acc[3] += wk.w * hi2f(vv[1]);
        }
      }
      u32x2 o; o[0] = pack2(silu_f(acc[0]), silu_f(acc[1])); o[1] = pack2(silu_f(acc[2]), silu_f(acc[3]));
      *(u32x2*)(XBC + (size_t)row * 768 + c) = o;
    }
    if (lane < 16) {
      float v = DT[(size_t)row * 16 + lane] + p.dt_bias[layer * 16 + lane];
      float sp = fmaxf(v, 0.f) + log1pf(__expf(-fabsf(v)));
      DT[(size_t)row * 16 + lane] = sp;
    }
  }
}

DI void phase_ssdnorm(const Params& p, int layer, int bid, int nb) {
  const int w = ltid() >> 6, lane = ltid() & 63;
  const int M = layer == 0 ? MT : ML;
  bf16_t* YM = (bf16_t*)(p.ws + OFF_H);
  const float* SSQ = (const float*)(p.ws + OFF_SSQ);
  const float* ng = p.ssd_norm + layer * 512;
  for (int row = bid * 4 + w; row < M; row += nb * 4) {
    int g = lane >> 5;
    float4 s = *(const float4*)(SSQ + (size_t)row * 8 + g * 4);
    float rstd = rsqrtf((s.x + s.y + s.z + s.w) * (1.f / 256) + EPS);
    bf16_t* ptr = YM + (size_t)row * DM + 512 + lane * 8;
    u32x4 v = *(const u32x4*)ptr;
    float4 g0 = *(const float4*)(ng + lane * 8), g1 = *(const float4*)(ng + lane * 8 + 4);
    u32x4 o;
    o[0] = pack2(lo2f(v[0]) * rstd * g0.x, hi2f(v[0]) * rstd * g0.y);
    o[1] = pack2(lo2f(v[1]) * rstd * g0.z, hi2f(v[1]) * rstd * g0.w);
    o[2] = pack2(lo2f(v[2]) * rstd * g1.x, hi2f(v[2]) * rstd * g1.y);
    o[3] = pack2(lo2f(v[3]) * rstd * g1.z, hi2f(v[3]) * rstd * g1.w);
    *(u32x4*)ptr = o;
  }
}

constexpr int GST = 80;
constexpr int GBUF = 2 * 128 * GST;
template <bool GN, class Epi>
DI void gemm_tile(const bf16_t* __restrict__ A, int lda, const bf16_t* __restrict__ Bt, int K, int row0, int col0, char* smem, Epi epi, const float* __restrict__ ssq = nullptr) {
  bf16_t* S0 = (bf16_t*)smem;
  const int tid = ltid(), wid = tid >> 6, lane = tid & 63, wr = wid >> 1, wc = wid & 1, fr = lane & 15, fq = lane >> 4;
  f32x4 acc[4][4];
#pragma unroll
  for (int m = 0; m < 4; ++m)
#pragma unroll
    for (int n = 0; n < 4; ++n) acc[m][n] = f32x4{0.f, 0.f, 0.f, 0.f};
  u32x4 ra[4], rb[4];
  const int sr = tid >> 3, sp = tid & 7;
  const bf16_t* ga = A + (size_t)(row0 + sr) * lda + sp * 8;
  const bf16_t* gb = Bt + (size_t)(col0 + sr) * K + sp * 8;
  auto gload = [&](int k0) {
#pragma unroll
    for (int i = 0; i < 4; ++i) {
      ra[i] = *(const u32x4*)(ga + (size_t)(32 * i) * lda + k0);
      rb[i] = *(const u32x4*)(gb + (size_t)(32 * i) * K + k0);
    }
  };
  gload(0);
  float gs[4][2];
  if (GN) {
#pragma unroll
    for (int i = 0; i < 4; ++i) {
      const float4 s0 = *(const float4*)(ssq + (size_t)(row0 + sr + 32 * i) * 8), s1 = *(const float4*)(ssq + (size_t)(row0 + sr + 32 * i) * 8 + 4);
      gs[i][0] = rsqrtf((s0.x + s0.y + s0.z + s0.w) * (1.f / 256) + EPS);
      gs[i][1] = rsqrtf((s1.x + s1.y + s1.z + s1.w) * (1.f / 256) + EPS);
    }
  }
  auto swrite = [&](int kt) {
    if (GN && kt >= 8) {
      const int g = (kt - 8) >> 2;
#pragma unroll
      for (int i = 0; i < 4; ++i) {
        const float sc = g ? gs[i][1] : gs[i][0];
#pragma unroll
        for (int jj = 0; jj < 4; ++jj) ra[i][jj] = pack2(lo2f(ra[i][jj]) * sc, hi2f(ra[i][jj]) * sc);
      }
    }
    bf16_t* As = S0 + (kt & 1) * GBUF;
    bf16_t* Bs = As + 128 * GST;
#pragma unroll
    for (int i = 0; i < 4; ++i) {
      *(u32x4*)(As + (sr + 32 * i) * GST + sp * 8) = ra[i];
      *(u32x4*)(Bs + (sr + 32 * i) * GST + sp * 8) = rb[i];
    }
  };
  const int KT = K / 64;
  swrite(0);
  if (KT > 1) gload(64);
  __syncthreads();
  for (int kt = 0; kt < KT; ++kt) {
    const bf16_t* As = S0 + (kt & 1) * GBUF;
    const bf16_t* Bs = As + 128 * GST;
#pragma unroll
    for (int ks = 0; ks < 2; ++ks) {
      bf16x8 af[4], bfr[4];
#pragma unroll
      for (int m = 0; m < 4; ++m) af[m] = *(const bf16x8*)(As + (wr * 64 + m * 16 + fr) * GST + ks * 32 + fq * 8);
#pragma unroll
      for (int n = 0; n < 4; ++n) bfr[n] = *(const bf16x8*)(Bs + (wc * 64 + n * 16 + fr) * GST + ks * 32 + fq * 8);
#pragma unroll
      for (int m = 0; m < 4; ++m)
#pragma unroll
        for (int n = 0; n < 4; ++n) acc[m][n] = MFMA16(bfr[n], af[m], acc[m][n]);
      if (ks == 0 && kt + 1 < KT) {
        swrite(kt + 1);
        if (kt + 2 < KT) gload((kt + 2) * 64);
      }
    }
    __syncthreads();
  }
#pragma unroll
  for (int m = 0; m < 4; ++m)
#pragma unroll
    for (int n = 0; n < 4; ++n) epi(row0 + wr * 64 + m * 16 + fr, col0 + wc * 64 + n * 16 + fq * 4, acc[m][n]);
}

template <class Epi>
DI void gemm_tile_glds(const bf16_t* __restrict__ A, int lda, const bf16_t* __restrict__ Bt, int K, int row0, int col0, char* smem, Epi epi) {
  const int tid = ltid(), wid = tid >> 6, lane = tid & 63, wr = wid >> 1, wc = wid & 1, fr = lane & 15, fq = lane >> 4;
  f32x4 acc[4][4];
#pragma unroll
  for (int m = 0; m < 4; ++m)
#pragma unroll
    for (int n = 0; n < 4; ++n) acc[m][n] = f32x4{0.f, 0.f, 0.f, 0.f};
  const int crow = tid >> 3, cslot = tid & 7, cpart = cslot ^ (crow & 7);
  const bf16_t* ga = A + (size_t)(row0 + crow) * lda + cpart * 8;
  const bf16_t* gb = Bt + (size_t)(col0 + crow) * K + cpart * 8;
  auto issue = [&](int kt, int stage) {
    char* sa = smem + stage * 32768 + tid * 16;
#pragma unroll
    for (int i = 0; i < 4; ++i) {
      __builtin_amdgcn_global_load_lds((const unsigned*)(ga + (size_t)(32 * i) * lda + kt * 64), (__attribute__((address_space(3))) unsigned*)(sa + i * 4096), 16, 0, 0);
      __builtin_amdgcn_global_load_lds((const unsigned*)(gb + (size_t)(32 * i) * K + kt * 64), (__attribute__((address_space(3))) unsigned*)(sa + 16384 + i * 4096), 16, 0, 0);
    }
  };
  const int KT = K / 64;
  issue(0, 0);
  asm volatile("s_waitcnt vmcnt(0)" ::: "memory");
  __syncthreads();
  const int sw = fr & 7;
  for (int kt = 0; kt < KT; ++kt) {
    if (kt + 1 < KT) issue(kt + 1, (kt + 1) & 1);
    const char* As = smem + (kt & 1) * 32768;
    const char* Bs = As + 16384;
#pragma unroll
    for (int ks = 0; ks < 2; ++ks) {
      bf16x8 af[4], bfr[4];
      const int so = ((ks * 4 + fq) ^ sw) * 16;
#pragma unroll
      for (int m = 0; m < 4; ++m) af[m] = *(const bf16x8*)(As + (wr * 64 + m * 16 + fr) * 128 + so);
#pragma unroll
      for (int n = 0; n < 4; ++n) bfr[n] = *(const bf16x8*)(Bs + (wc * 64 + n * 16 + fr) * 128 + so);
#pragma unroll
      for (int m = 0; m < 4; ++m)
#pragma unroll
        for (int n = 0; n < 4; ++n) acc[m][n] = MFMA16(bfr[n], af[m], acc[m][n]);
    }
    asm volatile("s_waitcnt vmcnt(0)" ::: "memory");
    __syncthreads();
  }
#pragma unroll
  for (int m = 0; m < 4; ++m)
#pragma unroll
    for (int n = 0; n < 4; ++n) epi(row0 + wr * 64 + m * 16 + fr, col0 + wc * 64 + n * 16 + fq * 4, acc[m][n]);
}

struct EpiBF {
  bf16_t* out; int ldo;
  DI void operator()(int row, int col, const f32x4& a) const {
    u32x2 o; o[0] = pack2(a[0], a[1]); o[1] = pack2(a[2], a[3]);
    *(u32x2*)(out + (size_t)row * ldo + col) = o;
  }
};
struct EpiRelu2 {
  bf16_t* out; int ldo;
  DI void operator()(int row, int col, const f32x4& a) const {
    float r0 = fmaxf(a[0], 0.f), r1 = fmaxf(a[1], 0.f), r2 = fmaxf(a[2], 0.f), r3 = fmaxf(a[3], 0.f);
    u32x2 o; o[0] = pack2(r0 * r0, r1 * r1); o[1] = pack2(r2 * r2, r3 * r3);
    *(u32x2*)(out + (size_t)row * ldo + col) = o;
  }
};
struct EpiU {
  bf16_t* u; float* dt;
  DI void operator()(int row, int col, const f32x4& a) const {
    if (col < DIN) {
      u32x2 o; o[0] = pack2(a[0], a[1]); o[1] = pack2(a[2], a[3]);
      *(u32x2*)(u + (size_t)row * DIN + col) = o;
      if (col >= U_DT) *(float4*)(dt + (size_t)row * 16 + col - U_DT) = make_float4(a[0], a[1], a[2], a[3]);
    }
  }
};
struct EpiQ {
  bf16_t* q; const float* rs;
  DI void operator()(int row, int col, const f32x4& a) const {
    const float r = rs[row * 2];
    u32x2 o; o[0] = pack2(a[0] * r, a[1] * r); o[1] = pack2(a[2] * r, a[3] * r);
    *(u32x2*)(q + (size_t)row * 384 + col) = o;
  }
};
struct EpiKV {
  bf16_t* kb; bf16_t* vt; const float* rs;
  DI void operator()(int row, int col, const f32x4& a) const {
    int b, pos;
    if (row < ML) { b = row >> 12; pos = (row & 4095) + CTX; } else { int rr = row - ML; b = rr >> 8; pos = rr & 255; }
    const int head = col >> 7, d = col & 127;
    const float r = rs[row * 2 + 1];
    if (d < 64) {
      u32x2 o; o[0] = pack2(a[0] * r, a[1] * r); o[1] = pack2(a[2] * r, a[3] * r);
      *(u32x2*)(kb + ((size_t)(b * 4 + head) * LK + pos) * 96 + d) = o;
    } else {
#pragma unroll
      for (int j = 0; j < 4; ++j) vt[((size_t)(b * 4 + head) * 64 + (d - 64 + j)) * LK + pos] = f2bf(a[j] * r);
    }
  }
};

DI void phase_inproj(const Params& p, int layer, int bid, int nb, char* smem) {
  constexpr int NT = DINP / 128;
  EpiU epi{(bf16_t*)(p.ws + OFF_U), (float*)(p.ws + OFF_DT)};
  for (int rep = 0; rep < REP_GEMM; ++rep)
  for (int it = bid; it < (MT / 128) * NT; it += nb)
    gemm_tile_glds((const bf16_t*)(p.ws + OFF_H), DM, wt_ptr(p, layer, WT_IN), 1024, (it / NT) * 128, (it % NT) * 128, smem, epi);
}
DI void phase_wout(const Params& p, int layer, int bid, int nb, char* smem) {
  const int M = layer == 0 ? MT : ML;
  EpiBF epi{(bf16_t*)(p.ws + OFF_U), DM};
  for (int rep = 0; rep < REP_GEMM; ++rep)
  for (int it = bid; it < (M / 128) * 8; it += nb)
    gemm_tile<true>((const bf16_t*)(p.ws + OFF_H), DM, wt_ptr(p, layer, WT_OUT), 1024, (it / 8) * 128, (it % 8) * 128, smem, epi, (const float*)(p.ws + OFF_SSQ));
}
DI void phase_ff1(const Params& p, int layer, int bid, int nb, char* smem) {
  const int M = layer == 0 ? MT : ML;
  EpiRelu2 epi{(bf16_t*)(p.ws + OFF_F1), DFF};
  for (int rep = 0; rep < REP_GEMM; ++rep)
  for (int it = bid; it < (M / 128) * 32; it += nb)
    gemm_tile_glds((const bf16_t*)(p.ws + OFF_H), DM, wt_ptr(p, layer, WT_FF1), 1024, (it / 32) * 128, (it % 32) * 128, smem, epi);
}
DI void phase_ff2(const Params& p, int layer, int bid, int nb, char* smem) {
  const int M = layer == 0 ? MT : ML;
  EpiBF epi{(bf16_t*)(p.ws + OFF_H), DM};
  for (int rep = 0; rep < REP_GEMM; ++rep)
  for (int it = bid; it < (M / 128) * 8; it += nb)
    gemm_tile_glds((const bf16_t*)(p.ws + OFF_F1), DFF, wt_ptr(p, layer, WT_FF2), 4096, (it / 8) * 128, (it % 8) * 128, smem, epi);
}

DI int chunk_row0(int b, int tc) { return tc < 2 ? ML + b * CTX + tc * 128 : b * SEQ + (tc - 2) * 128; }
constexpr int BST = 72;
constexpr int TST = 136;
DI void load_tile_T(bf16_t* dst, const bf16_t* __restrict__ src, int ldg) {
  const int tid = ltid();
#pragma unroll
  for (int i = 0; i < 4; ++i) {
    int c = tid + 256 * i, tok = c & 127, pc = c >> 7;
    u32x4 v = *(const u32x4*)(src + (size_t)tok * ldg + pc * 8);
#pragma unroll
    for (int j = 0; j < 4; ++j) {
      dst[(pc * 8 + 2 * j) * TST + tok] = (bf16_t)(v[j] & 0xffffu);
      dst[(pc * 8 + 2 * j + 1) * TST + tok] = (bf16_t)(v[j] >> 16);
    }
  }
}
DI void chunk_scan(const Params& p, int layer, int row0, int h, float* csf, float* csb, float* dtF, float* dtB, float* laF, float* laB) {
  const int tid = ltid();
  const float* DT = (const float*)(p.ws + OFF_DT);
  if (tid < 128) {
    float af = -__expf(p.a_log[layer * 16 + h]), ab = -__expf(p.a_log[layer * 16 + 8 + h]);
    float df = DT[(size_t)(row0 + tid) * 16 + h], db = DT[(size_t)(row0 + tid) * 16 + 8 + h];
    dtF[tid] = df; dtB[tid] = db; laF[tid] = df * af; laB[tid] = db * ab;
  }
  __syncthreads();
  if (tid < 128) {
    float s = 0.f;
    for (int l = 0; l <= tid; ++l) s += laF[l];
    csf[tid] = s;
  } else {
    int t = tid - 128;
    float s = 0.f;
    for (int l = 127; l >= t; --l) s += laB[l];
    csb[t] = s;
  }
  __syncthreads();
}

DI void ssd_state_item(const Params& p, int layer, int b, int tc, int h, char* smem) {
  bf16_t* XT = (bf16_t*)smem;
  bf16_t* BT = XT + 64 * TST;
  float* csf = (float*)(BT + 64 * TST);
  float* csb = csf + 128; float* dtF = csb + 128; float* dtB = dtF + 128; float* laF = dtB + 128; float* laB = laF + 128;
  const int tid = ltid(), w = tid >> 6, lane = tid & 63, r = lane & 31, hh = lane >> 5;
  const int row0 = chunk_row0(b, tc);
  const bf16_t* XBC = (const bf16_t*)(p.ws + OFF_XBC);
  chunk_scan(p, layer, row0, h, csf, csb, dtF, dtB, laF, laB);
  load_tile_T(XT, XBC + (size_t)row0 * 768 + h * 64, 768);
  load_tile_T(BT, XBC + (size_t)row0 * 768 + 512 + (h >> 2) * 64, 768);
  __syncthreads();
  if (tid < 128) laF[tid] = dtF[tid] * __expf(csf[127] - csf[tid]);
  else { int t = tid - 128; laB[t] = dtB[t] * __expf(csb[0] - csb[t]); }
  __syncthreads();
  const int d = w >> 1, pt = w & 1;
  const float* wv = d == 0 ? laF : laB;
  f32x16 acc[2];
#pragma unroll
  for (int i = 0; i < 16; ++i) { acc[0][i] = 0.f; acc[1][i] = 0.f; }
#pragma unroll
  for (int s = 0; s < 8; ++s) {
    int l0 = 16 * s + 8 * hh;
    u32x4 xa = *(const u32x4*)(XT + (32 * pt + r) * TST + l0);
    u32x4 sa;
#pragma unroll
    for (int j = 0; j < 4; ++j) sa[j] = pack2(lo2f(xa[j]) * wv[l0 + 2 * j], hi2f(xa[j]) * wv[l0 + 2 * j + 1]);
    bf16x8 af = __builtin_bit_cast(bf16x8, sa);
#pragma unroll
    for (int nt = 0; nt < 2; ++nt) {
      bf16x8 bfr = *(const bf16x8*)(BT + (32 * nt + r) * TST + l0);
      acc[nt] = MFMA32(af, bfr, acc[nt]);
    }
  }
  bf16_t* S = (bf16_t*)(p.ws + OFF_SST) + ((((size_t)d * NB + b) * NCH + tc) * 8 + h) * 4096;
#pragma unroll
  for (int nt = 0; nt < 2; ++nt)
#pragma unroll
    for (int i = 0; i < 16; ++i) S[(32 * pt + crow(i, hh)) * 64 + 32 * nt + r] = f2bf(acc[nt][i]);
  if (tid == 0) {
    float* TD = (float*)(p.ws + OFF_TDEC);
    TD[((0 * NB + b) * NCH + tc) * 8 + h] = __expf(csf[127]);
    TD[((1 * NB + b) * NCH + tc) * 8 + h] = __expf(csb[0]);
  }
  __syncthreads();
}

DI void ssd_pass_item(const Params& p, int it) {
  const int e = it * 256 + ltid();
  const int pn2 = e & 2047, h = (e >> 11) & 7, b = (e >> 14) & 3, d = e >> 16;
  unsigned* S = (unsigned*)(p.ws + OFF_SST);
  const float* TD = (const float*)(p.ws + OFF_TDEC);
  unsigned sv[NCH]; float T[NCH];
#pragma unroll
  for (int i = 0; i < NCH; ++i) {
    int tc = d == 0 ? i : (i < 2 ? 1 - i : NCH + 1 - i);
    sv[i] = S[(((size_t)(d * NB + b) * NCH + tc) * 8 + h) * 2048 + pn2];
    T[i] = TD[((d * NB + b) * NCH + tc) * 8 + h];
  }
  float h0 = 0.f, h1 = 0.f;
#pragma unroll
  for (int i = 0; i < NCH; ++i) {
    int tc = d == 0 ? i : (i < 2 ? 1 - i : NCH + 1 - i);
    S[(((size_t)(d * NB + b) * NCH + tc) * 8 + h) * 2048 + pn2] = pack2(h0, h1);
    h0 = T[i] * h0 + lo2f(sv[i]); h1 = T[i] * h1 + hi2f(sv[i]);
  }
}

DI void ssd_out_item(const Params& p, int layer, int b, int tc, int h, char* smem) {
  bf16_t* XT = (bf16_t*)smem;
  bf16_t* Bs = XT + 64 * TST;
  float* csf = (float*)(Bs + 128 * BST);
  float* csb = csf + 128; float* dtF = csb + 128; float* dtB = dtF + 128; float* laF = dtB + 128; float* laB = laF + 128;
  const int tid = ltid(), w = tid >> 6, lane = tid & 63, r = lane & 31, hh = lane >> 5;
  const int row0 = chunk_row0(b, tc), g = h >> 2;
  const bf16_t* XBC = (const bf16_t*)(p.ws + OFF_XBC);
  chunk_scan(p, layer, row0, h, csf, csb, dtF, dtB, laF, laB);
  load_tile_T(XT, XBC + (size_t)row0 * 768 + h * 64, 768);
#pragma unroll
  for (int i = 0; i < 4; ++i) {
    int c = tid + 256 * i, tok = c >> 3, part = c & 7;
    *(u32x4*)(Bs + tok * BST + part * 8) = *(const u32x4*)(XBC + (size_t)(row0 + tok) * 768 + 512 + g * 64 + part * 8);
  }
  const int l = 32 * w + r;
  bf16x8 cf[4];
#pragma unroll
  for (int ks = 0; ks < 4; ++ks) cf[ks] = *(const bf16x8*)(XBC + (size_t)(row0 + l) * 768 + 640 + g * 64 + 16 * ks + 8 * hh);
  __syncthreads();
  const float csf_l = csf[l], csb_l = csb[l];
  f32x16 yacc[2];
#pragma unroll
  for (int i = 0; i < 16; ++i) { yacc[0][i] = 0.f; yacc[1][i] = 0.f; }
#pragma unroll
  for (int st = 0; st < 4; ++st) {
    f32x16 gacc;
#pragma unroll
    for (int i = 0; i < 16; ++i) gacc[i] = 0.f;
#pragma unroll
    for (int ks = 0; ks < 4; ++ks) {
      bf16x8 af = *(const bf16x8*)(Bs + (32 * st + r) * BST + 16 * ks + 8 * hh);
      gacc = MFMA32(af, cf[ks], gacc);
    }
#pragma unroll
    for (int i = 0; i < 16; ++i) {
      int s = 32 * st + crow(i, hh);
      float f;
      if (s < l) f = __expf(csf_l - csf[s]) * dtF[s];
      else if (s > l) f = __expf(csb_l - csb[s]) * dtB[s];
      else f = dtF[s] + dtB[s];
      gacc[i] *= f;
    }
#pragma unroll
    for (int s2 = 0; s2 < 2; ++s2) {
      bf16x8 mf = pack8(gacc, s2);
      int sb = 32 * st + 16 * s2 + 4 * hh;
#pragma unroll
      for (int pt = 0; pt < 2; ++pt) {
        u32x2 lo = *(const u32x2*)(XT + (32 * pt + r) * TST + sb);
        u32x2 hi = *(const u32x2*)(XT + (32 * pt + r) * TST + sb + 8);
        u32x4 xa; xa[0] = lo[0]; xa[1] = lo[1]; xa[2] = hi[0]; xa[3] = hi[1];
        yacc[pt] = MFMA32(__builtin_bit_cast(bf16x8, xa), mf, yacc[pt]);
      }
    }
  }
#pragma unroll
  for (int d = 0; d < 2; ++d) {
    const bf16_t* Hs = (const bf16_t*)(p.ws + OFF_SST) + ((((size_t)d * NB + b) * NCH + tc) * 8 + h) * 4096;
    const float e = __expf(d == 0 ? csf_l : csb_l);
#pragma unroll
    for (int pt = 0; pt < 2; ++pt) {
      f32x16 t;
#pragma unroll
      for (int i = 0; i < 16; ++i) t[i] = 0.f;
#pragma unroll
      for (int ks = 0; ks < 4; ++ks) {
        bf16x8 af = *(const bf16x8*)(Hs + (32 * pt + r) * 64 + 16 * ks + 8 * hh);
        t = MFMA32(af, cf[ks], t);
      }
#pragma unroll
      for (int i = 0; i < 16; ++i) yacc[pt][i] += e * t[i];
    }
  }
  const int row = row0 + l;
  const float Dh = p.ssd_d[layer * 8 + h];
  const bf16_t* U = (const bf16_t*)(p.ws + OFF_U);
  bf16_t* YM = (bf16_t*)(p.ws + OFF_H);
  float ssq = 0.f;
#pragma unroll
  for (int pt = 0; pt < 2; ++pt)
#pragma unroll
    for (int q = 0; q < 4; ++q) {
      int pp = 32 * pt + 8 * q + 4 * hh;
      u32x2 xv = *(const u32x2*)(XBC + (size_t)row * 768 + h * 64 + pp);
      u32x2 zv = *(const u32x2*)(U + (size_t)row * DIN + U_Z + h * 64 + pp);
      float y0 = (yacc[pt][4 * q + 0] + Dh * lo2f(xv[0])) * silu_f(lo2f(zv[0]));
      float y1 = (yacc[pt][4 * q + 1] + Dh * hi2f(xv[0])) * silu_f(hi2f(zv[0]));
      float y2 = (yacc[pt][4 * q + 2] + Dh * lo2f(xv[1])) * silu_f(lo2f(zv[1]));
      float y3 = (yacc[pt][4 * q + 3] + Dh * hi2f(xv[1])) * silu_f(hi2f(zv[1]));
      u32x2 o; o[0] = pack2(y0, y1); o[1] = pack2(y2, y3);
      float r0 = lo2f(o[0]), r1 = hi2f(o[0]), r2 = lo2f(o[1]), r3 = hi2f(o[1]);
      ssq += r0 * r0 + r1 * r1 + r2 * r2 + r3 * r3;
      *(u32x2*)(YM + (size_t)row * DM + 512 + h * 64 + pp) = o;
    }
  ssq += __shfl_xor(ssq, 32);
  if (hh == 0) ((float*)(p.ws + OFF_SSQ))[(size_t)row * 8 + h] = ssq;
  __syncthreads();
}

constexpr int KST = 104;
constexpr int VST = 68;
DI void attn_item(const Params& p, int b, int head, int qrow0, int t0, bool lat, int nkeys, char* smem) {
  bf16_t* Ks = (bf16_t*)smem;
  bf16_t* Vs = Ks + 64 * KST;
  const int tid = ltid(), w = tid >> 6, lane = tid & 63, r = lane & 31, hh = lane >> 5;
  const bf16_t* QB = (const bf16_t*)(p.ws + OFF_QB);
  const bf16_t* KB = (const bf16_t*)(p.ws + OFF_KB) + (size_t)(b * 4 + head) * LK * 96;
  const bf16_t* VT = (const bf16_t*)(p.ws + OFF_VT) + (size_t)(b * 4 + head) * 64 * LK;
  const float qscale = 0.10206207261596575f * 1.4426950408889634f;
  const int qrow = qrow0 + w * 32 + r;
  const int t = t0 + w * 32 + r;
  bf16x8 qf[6];
  {
    const bf16_t* src = QB + (size_t)qrow * 384 + head * 96;
#pragma unroll
    for (int s = 0; s < 4; ++s) {
      u32x4 v = *(const u32x4*)(src + 16 * s + 8 * hh);
      u32x4 o;
#pragma unroll
      for (int j = 0; j < 4; ++j) o[j] = pack2(lo2f(v[j]) * qscale, hi2f(v[j]) * qscale);
      qf[s] = __builtin_bit_cast(bf16x8, o);
    }
#pragma unroll
    for (int s = 4; s < 6; ++s) {
      u32x4 va = *(const u32x4*)(src + 16 * s), vb = *(const u32x4*)(src + 16 * s + 8);
      float posf = s == 4 ? (float)(t >> 6) : (float)(t & 63);
      float o[8];
#pragma unroll
      for (int j = 0; j < 8; ++j) {
        float a = (j & 1) ? hi2f(va[j >> 1]) : lo2f(va[j >> 1]);
        float bb = (j & 1) ? hi2f(vb[j >> 1]) : lo2f(vb[j >> 1]);
        float res;
        if (lat) {
          float invf = exp2f(-(float)(2 * j) * (13.287712379549449f / 16.f));
          float rev = posf * invf * 0.15915494309189535f;
          float cs = __builtin_amdgcn_cosf(rev), sn = __builtin_amdgcn_sinf(rev);
          res = hh == 0 ? a * cs - bb * sn : bb * cs + a * sn;
        } else res = hh == 0 ? a : bb;
        o[j] = res * qscale;
      }
      u32x4 ov; ov[0] = pack2(o[0], o[1]); ov[1] = pack2(o[2], o[3]); ov[2] = pack2(o[4], o[5]); ov[3] = pack2(o[6], o[7]);
      qf[s] = __builtin_bit_cast(bf16x8, ov);
    }
  }
  f32x16 oacc[2];
#pragma unroll
  for (int i = 0; i < 16; ++i) { oacc[0][i] = 0.f; oacc[1][i] = 0.f; }
  float m = -1e30f, lsum = 0.f;
  u32x4 rk[3], rv[2];
  auto gload = [&](int key0) {
#pragma unroll
    for (int i = 0; i < 3; ++i) rk[i] = *(const u32x4*)(KB + (size_t)key0 * 96 + (tid + 256 * i) * 8);
#pragma unroll
    for (int i = 0; i < 2; ++i) { int c = tid + 256 * i; rv[i] = *(const u32x4*)(VT + (size_t)(c >> 3) * LK + key0 + (c & 7) * 8); }
  };
  gload(0);
  const int NT = nkeys / 64;
  for (int kt = 0; kt < NT; ++kt) {
#pragma unroll
    for (int i = 0; i < 3; ++i) { int c = tid + 256 * i; *(u32x4*)(Ks + (c / 12) * KST + (c % 12) * 8) = rk[i]; }
#pragma unroll
    for (int i = 0; i < 2; ++i) {
      int c = tid + 256 * i;
      bf16_t* d = Vs + (c >> 3) * VST + (c & 7) * 8;
      u32x2 a; a[0] = rv[i][0]; a[1] = rv[i][1];
      u32x2 bq; bq[0] = rv[i][2]; bq[1] = rv[i][3];
      *(u32x2*)d = a; *(u32x2*)(d + 4) = bq;
    }
    __syncthreads();
    if (kt + 1 < NT) gload((kt + 1) * 64);
    f32x16 sacc[2];
#pragma unroll
    for (int i = 0; i < 16; ++i) { sacc[0][i] = 0.f; sacc[1][i] = 0.f; }
#pragma unroll
    for (int s = 0; s < 6; ++s)
#pragma unroll
      for (int k2 = 0; k2 < 2; ++k2) {
        bf16x8 af = *(const bf16x8*)(Ks + (32 * k2 + r) * KST + 16 * s + 8 * hh);
        sacc[k2] = MFMA32(af, qf[s], sacc[k2]);
      }
    float mx = sacc[0][0];
#pragma unroll
    for (int i = 0; i < 16; ++i) { mx = fmaxf(mx, sacc[0][i]); mx = fmaxf(mx, sacc[1][i]); }
    mx = fmaxf(mx, __shfl_xor(mx, 32));
    const float mn = fmaxf(m, mx);
    const float alpha = __builtin_amdgcn_exp2f(m - mn);
    m = mn;
    float ps = 0.f;
#pragma unroll
    for (int i = 0; i < 16; ++i) {
      sacc[0][i] = __builtin_amdgcn_exp2f(sacc[0][i] - mn); sacc[1][i] = __builtin_amdgcn_exp2f(sacc[1][i] - mn);
      ps += sacc[0][i] + sacc[1][i];
    }
    lsum = lsum * alpha + ps;
#pragma unroll
    for (int i = 0; i < 16; ++i) { oacc[0][i] *= alpha; oacc[1][i] *= alpha; }
#pragma unroll
    for (int k2 = 0; k2 < 2; ++k2)
#pragma unroll
      for (int s2 = 0; s2 < 2; ++s2) {
        bf16x8 pf = pack8(sacc[k2], s2);
        int kb0 = 32 * k2 + 16 * s2 + 4 * hh;
#pragma unroll
        for (int d = 0; d < 2; ++d) {
          u32x2 lo = *(const u32x2*)(Vs + (32 * d + r) * VST + kb0);
          u32x2 hi = *(const u32x2*)(Vs + (32 * d + r) * VST + kb0 + 8);
          u32x4 va; va[0] = lo[0]; va[1] = lo[1]; va[2] = hi[0]; va[3] = hi[1];
          oacc[d] = MFMA32(__builtin_bit_cast(bf16x8, va), pf, oacc[d]);
        }
      }
    __syncthreads();
  }
  lsum += __shfl_xor(lsum, 32);
  const float inv = 1.f / lsum;
  bf16_t* YM = (bf16_t*)(p.ws + OFF_H) + (size_t)qrow * DM + head * 64;
#pragma unroll
  for (int d = 0; d < 2; ++d)
#pragma unroll
    for (int q = 0; q < 4; ++q) {
      u32x2 o; o[0] = pack2(oacc[d][4 * q] * inv, oacc[d][4 * q + 1] * inv); o[1] = pack2(oacc[d][4 * q + 2] * inv, oacc[d][4 * q + 3] * inv);
      *(u32x2*)(YM + 32 * d + 8 * q + 4 * hh) = o;
    }
}

DI void phase_qkv(const Params& p, int layer, int bid, int nb, char* smem) {
  const int MQ = layer == 0 ? MT : ML;
  const int nq = (MQ / 128) * 3, nkv = (MT / 128) * 4, nst = NB * NCH * 8;
  const float* RS = (const float*)(p.ws + OFF_RSTD);
  EpiQ eq{(bf16_t*)(p.ws + OFF_QB), RS};
  EpiKV ekv{(bf16_t*)(p.ws + OFF_KB), (bf16_t*)(p.ws + OFF_VT), RS};
  const bf16_t* U = (const bf16_t*)(p.ws + OFF_U);
  for (int it = bid; it < nq + nkv + nst; it += nb) {
    if (it < nq) gemm_tile<false>(U, DIN, wt_ptr(p, layer, WT_UQ), 256, (it / 3) * 128, (it % 3) * 128, smem, eq);
    else if (it < nq + nkv) { int j = it - nq; gemm_tile<false>(U + U_CKV, DIN, wt_ptr(p, layer, WT_UKV), 128, (j / 4) * 128, (j % 4) * 128, smem, ekv); }
    else { int j = it - nq - nkv; for (int rep = 0; rep < REP_SSD; ++rep) ssd_state_item(p, layer, j / (NCH * 8), (j / 8) % NCH, j & 7, smem); }
  }
}
DI void phase_att(const Params& p, int layer, int bid, int nb, char* smem) {
  const int natt = 512 + (layer == 0 ? 32 : 0), npass = 512;
  for (int it = bid; it < natt + npass; it += nb) {
    if (it < 512) { int b = it >> 7, head = (it >> 5) & 3, qb = it & 31; for (int rep = 0; rep < REP_ATT; ++rep) attn_item(p, b, head, b * SEQ + qb * 128, qb * 128, true, LK, smem); }
    else if (it < natt) { int j = it - 512; int b = j >> 3, head = (j >> 1) & 3, qb = j & 1; attn_item(p, b, head, ML + b * CTX + qb * 128, qb * 128, false, CTX, smem); }
    else ssd_pass_item(p, it - natt);
  }
}
DI void phase_ssdout(const Params& p, int layer, int bid, int nb, char* smem) {
  for (int it = bid; it < NB * NCH * 8; it += nb) {
    int b = it / (NCH * 8), tc = (it / 8) % NCH, h = it & 7;
    if (layer == 1 && tc < 2) continue;
    for (int rep = 0; rep < REP_SSD; ++rep) ssd_out_item(p, layer, b, tc, h, smem);
  }
}


#define XB_TMO      128
#define XB_XCNT(j)  (256  + 64 * (j))
#define XB_XSUB(j)  (1280 + 64 * (j))
#define XB_XGEN(j)  (2304 + 64 * (j))
#define XB_TOP      3328
#define XB_TOPGEN   3392
#define XCD_BAR_WORDS 3456
#define XB_SPIN_CAP (1u << 22)
#define LAS __attribute__((address_space(3)))
DI unsigned xb_ld(unsigned* p) { return __hip_atomic_load(p, __ATOMIC_RELAXED, __HIP_MEMORY_SCOPE_AGENT); }
DI unsigned xb_add(unsigned* p, unsigned v) { return __hip_atomic_fetch_add(p, v, __ATOMIC_RELAXED, __HIP_MEMORY_SCOPE_AGENT); }
DI unsigned xb_xcc_id() { return (unsigned)__builtin_amdgcn_s_getreg((3 << 11) | 20) & 0xFu; }
#define XB_SPIN(cond, bar) do { unsigned _sp = 0; while (cond) { __builtin_amdgcn_s_sleep(1); \
    if ((++_sp & 255u) == 0u) { if (xb_ld(&(bar)[XB_TMO])) break; if (_sp > XB_SPIN_CAP) { atomicAdd(&(bar)[XB_TMO], 1u); break; } } } } while (0)
struct XcdBarrier { unsigned* bar; unsigned x; volatile LAS unsigned* st; };
DI XcdBarrier xcd_barrier_post(unsigned* bar, volatile LAS unsigned* st) {
  XcdBarrier b; b.bar = bar; b.x = xb_xcc_id(); b.st = st;
  if (threadIdx.x == 0) (void)xb_add(&bar[XB_XCNT(b.x)], 1u);
  return b;
}
DI void xcd_barrier_complete(unsigned* bar, unsigned x, unsigned& nloc, unsigned& nx) {
  const unsigned G = gridDim.x * gridDim.y * gridDim.z;
  unsigned sum, cnt, mine, sp = 0u;
  for (;;) {
    sum = 0u; cnt = 0u; mine = 0u;
#pragma unroll
    for (unsigned j = 0; j < 16; ++j) { const unsigned c = xb_ld(&bar[XB_XCNT(j)]); sum += c; cnt += (c > 0u) ? 1u : 0u; mine = (j == x) ? c : mine; }
    if (sum == G) break;
    __builtin_amdgcn_s_sleep(1);
    if ((++sp & 255u) == 0u) { if (xb_ld(&bar[XB_TMO])) break; if (sp > XB_SPIN_CAP) { atomicAdd(&bar[XB_TMO], 1u); break; } }
  }
  nloc = mine > 0u ? mine : 1u; nx = cnt > 0u ? cnt : 1u;
}
DI void xcd_barrier(const XcdBarrier& b) {
  asm volatile("s_waitcnt vmcnt(0)" ::: "memory");
  __syncthreads();
  if (threadIdx.x == 0) {
    unsigned* bar = b.bar;
    __builtin_amdgcn_s_waitcnt(0);
    unsigned nloc = b.st[0], nx = b.st[1];
    if (nloc == 0u) { xcd_barrier_complete(bar, b.x, nloc, nx); b.st[0] = nloc; b.st[1] = nx; }
    const unsigned old = xb_add(&bar[XB_XSUB(b.x)], 1u);
    const unsigned gen = old / nloc;
    if (old + 1u == (gen + 1u) * nloc) {
      __builtin_amdgcn_fence(__ATOMIC_RELEASE, "agent");
      asm volatile("s_waitcnt vmcnt(0)" ::: "memory");
      const unsigned og = xb_add(&bar[XB_TOP], 1u);
      const unsigned tg = og / nx;
      if (og + 1u == (tg + 1u) * nx) xb_add(&bar[XB_TOPGEN], 1u);
      else XB_SPIN(xb_ld(&bar[XB_TOPGEN]) == tg, bar);
      __builtin_amdgcn_fence(__ATOMIC_ACQUIRE, "agent");
      xb_add(&bar[XB_XGEN(b.x)], 1u);
      asm volatile("s_waitcnt vmcnt(0)" ::: "memory");
    } else {
      XB_SPIN(xb_ld(&bar[XB_XGEN(b.x)]) == gen, bar);
      __builtin_amdgcn_fence(__ATOMIC_ACQUIRE, "agent");
      asm volatile("s_waitcnt vmcnt(0)" ::: "memory");
    }
  }
  __syncthreads();
}

constexpr int SMEM_BYTES = 2 * GBUF * 2;
enum { PH_PREP0 = 0, PH_H0, PH_INPROJ, PH_PREP, PH_QKV, PH_ATT, PH_SSDOUT, PH_WOUT, PH_POSTMIX, PH_FF1, PH_FF2, PH_POSTFFN, PH_SSDNORM };

DI void run_phase(const Params& p, int ph, int layer, int bid, int nb, char* smem) {
  switch (ph) {
    case PH_PREP0: phase_prep0(p, bid, nb, smem); break;
    case PH_H0: phase_h0(p, bid, nb); break;
    case PH_INPROJ: phase_inproj(p, layer, bid, nb, smem); break;
    case PH_PREP: phase_prep(p, layer, bid, nb); break;
    case PH_QKV: phase_qkv(p, layer, bid, nb, smem); break;
    case PH_ATT: phase_att(p, layer, bid, nb, smem); break;
    case PH_SSDOUT: phase_ssdout(p, layer, bid, nb, smem); break;
    case PH_SSDNORM: phase_ssdnorm(p, layer, bid, nb); break;
    case PH_WOUT: phase_wout(p, layer, bid, nb, smem); break;
    case PH_POSTMIX: phase_postmix(p, layer, bid, nb); break;
    case PH_FF1: phase_ff1(p, layer, bid, nb, smem); break;
    case PH_FF2: phase_ff2(p, layer, bid, nb, smem); break;
    case PH_POSTFFN: phase_postffn(p, layer, bid, nb); break;
  }
}

__global__ void __launch_bounds__(256, 2) mega_kernel(Params p) {
  extern __shared__ __attribute__((aligned(16))) char smem[];
  cg::grid_group grid = cg::this_grid();
  if (p.ws == nullptr) grid.sync();
  const int bid = blockIdx.x, nb = gridDim.x;
  volatile LAS unsigned* st = (volatile LAS unsigned*)(smem + SMEM_BYTES - 16);
  if (threadIdx.x == 0) { st[0] = 0u; st[1] = 0u; st[2] = 0u; st[3] = 0u; }
  __syncthreads();
  XcdBarrier xb = xcd_barrier_post((unsigned*)(p.ws + OFF_BAR), st);
  for (int step = 0; step < 22; ++step) {
    int ph, layer;
    if (step < 2) { ph = step; layer = 0; }
    else { int j = step - 2; layer = j / 10; ph = PH_INPROJ + j % 10; }
    run_phase(p, ph, layer, bid, nb, smem);
    if (step < 21) xcd_barrier(xb);
  }
}

extern "C" void kernel_launch(void* const* d_in, const int* in_sizes, int n_in, void* d_out, int out_size, void* d_ws, size_t ws_size,
                              hipStream_t stream) {
  if (ws_size < WS_NEED) { fprintf(stderr, "workspace too small: %zu < %zu\n", ws_size, (size_t)WS_NEED); return; }
  Params p{};
  const float** f = (const float**)&p;
  for (int i = 0; i < 25; ++i) f[i] = (const float*)d_in[i];
  p.out = (float*)d_out;
  p.ws = (char*)d_ws;
  static int grid_blocks = 0;
  if (!grid_blocks) {
    int dev = 0, cus = 0, per_cu = 0;
    hipGetDevice(&dev);
    hipDeviceGetAttribute(&cus, hipDeviceAttributeMultiprocessorCount, dev);
    hipFuncSetAttribute((const void*)mega_kernel, hipFuncAttributeMaxDynamicSharedMemorySize, SMEM_BYTES);
    hipOccupancyMaxActiveBlocksPerMultiprocessor(&per_cu, mega_kernel, 256, SMEM_BYTES);
    if (per_cu > 2) per_cu = 2;
    grid_blocks = cus * per_cu;
  }
  hipMemsetAsync((char*)d_ws + OFF_BAR, 0, XCD_BAR_WORDS * 4, stream);
  void* args[] = {&p};
  hipError_t e = hipLaunchCooperativeKernel((void*)mega_kernel, dim3(grid_blocks), dim3(256), args, SMEM_BYTES, stream);
  if (e != hipSuccess) fprintf(stderr, "cooperative launch failed: %s (grid %d)\n", hipGetErrorString(e), grid_blocks);
}
```

```cpp
#include <hip/hip_runtime.h>
#include <hip/hip_cooperative_groups.h>
#include <stdint.h>
#include <stdio.h>
namespace cg = cooperative_groups;

#ifndef MEGA
#define MEGA 1
#endif
#ifndef REP_GEMM
#define REP_GEMM 1
#endif
#ifndef REP_ATT
#define REP_ATT 1
#endif
#ifndef REP_SSD
#define REP_SSD 1
#endif

typedef unsigned short bf16_t;
using bf16x8 = __attribute__((ext_vector_type(8))) short;
using s16x4  = __attribute__((ext_vector_type(4))) short;
using f32x4  = __attribute__((ext_vector_type(4))) float;
using f32x16 = __attribute__((ext_vector_type(16))) float;
using u32x4  = __attribute__((ext_vector_type(4))) unsigned;
using u32x2  = __attribute__((ext_vector_type(2))) unsigned;
#define DI __device__ __forceinline__
#define MFMA32(a, b, c) __builtin_amdgcn_mfma_f32_32x32x16_bf16((a), (b), (c), 0, 0, 0)
#define MFMA16(a, b, c) __builtin_amdgcn_mfma_f32_16x16x32_bf16((a), (b), (c), 0, 0, 0)

constexpr int DM = 1024, NB = 4, SEQ = 4096, CTX = 256;
constexpr int ML = NB * SEQ;
constexpr int MC = NB * CTX;
constexpr int MT = ML + MC;
constexpr int DIN = 2480, DINP = 2560;
constexpr int LK = CTX + SEQ;
constexpr int DFF = 4096;
constexpr int NCH = 34;
constexpr float EPS = 1e-6f;
constexpr int U_CKV = 256, U_KR = 384, U_GB = 416, U_GC = 672, U_VAL = 928, U_Z = 1184, U_XBC = 1696, U_DT = 2464;

constexpr size_t AL(size_t x) { return (x + 255) & ~(size_t)255; }
constexpr size_t WT_IN = 0;
constexpr size_t WT_UQ = WT_IN + (size_t)DINP * 1024;
constexpr size_t WT_UKV = WT_UQ + (size_t)384 * 256;
constexpr size_t WT_OUT = WT_UKV + (size_t)512 * 128;
constexpr size_t WT_FF1 = WT_OUT + (size_t)1024 * 1024;
constexpr size_t WT_FF2 = WT_FF1 + (size_t)4096 * 1024;
constexpr size_t WT_ELEMS = WT_FF2 + (size_t)4096 * 1024;
constexpr size_t OFF_WT = 0;
constexpr size_t OFF_MOD = AL(OFF_WT + 2 * WT_ELEMS * 2);
constexpr size_t OFF_XC = AL(OFF_MOD + 2 * 5 * 6144 * 4);
constexpr size_t OFF_H = AL(OFF_XC + (size_t)MC * DM * 4);
constexpr size_t OFF_R1 = AL(OFF_H + (size_t)MT * DM * 2);
constexpr size_t OFF_U = OFF_R1;
constexpr size_t OFF_DT = AL(OFF_U + (size_t)MT * DIN * 2);
constexpr size_t OFF_RSTD = AL(OFF_DT + (size_t)MT * 16 * 4);
constexpr size_t OFF_QB = AL(OFF_RSTD + (size_t)MT * 2 * 4);
constexpr size_t OFF_KB = AL(OFF_QB + (size_t)MT * 384 * 2);
constexpr size_t OFF_VT = AL(OFF_KB + (size_t)NB * 4 * LK * 96 * 2);
constexpr size_t OFF_XBC = AL(OFF_VT + (size_t)NB * 4 * 64 * LK * 2);
constexpr size_t OFF_SST = AL(OFF_XBC + (size_t)MT * 768 * 2);
constexpr size_t OFF_TDEC = AL(OFF_SST + (size_t)2 * NB * NCH * 8 * 4096 * 2);
constexpr size_t OFF_SSQ = AL(OFF_TDEC + (size_t)2 * NB * NCH * 8 * 4);
constexpr size_t OFF_END1 = AL(OFF_SSQ + (size_t)MT * 8 * 4);
constexpr size_t OFF_F1 = OFF_R1;
constexpr size_t OFF_END2 = AL(OFF_F1 + (size_t)MT * DFF * 2);
constexpr size_t OFF_BAR = OFF_END1 > OFF_END2 ? OFF_END1 : OFF_END2;
constexpr size_t WS_NEED = OFF_BAR + 16384;

struct Params {
  const float *x, *c, *ctx, *c_ctx, *w_mod, *b_mod, *g_pre_mix, *w_in, *q_norm, *w_uq, *kv_norm, *w_ukv, *sc_w, *ssd_cw, *ssd_cb,
      *a_log, *dt_bias, *ssd_d, *ssd_norm, *w_out, *g_post_mix, *g_pre_ffn, *w_ff1, *w_ff2, *g_post_ffn;
  float* out;
  char* ws;
};

DI int ltid() { int t = threadIdx.x; asm volatile("" : "+v"(t)); return t; }
DI bf16_t f2bf(float x) { unsigned u = __float_as_uint(x); u += 0x7fffu + ((u >> 16) & 1u); return (bf16_t)(u >> 16); }
DI float bf2f(unsigned v) { return __uint_as_float(v << 16); }
DI unsigned pack2(float a, float b) { return (unsigned)f2bf(a) | ((unsigned)f2bf(b) << 16); }
DI float lo2f(unsigned w) { return __uint_as_float(w << 16); }
DI float hi2f(unsigned w) { return __uint_as_float(w & 0xffff0000u); }
DI float wave_sum(float v) {
#pragma unroll
  for (int o = 32; o > 0; o >>= 1) v += __shfl_xor(v, o);
  return v;
}
DI float silu_f(float x) { return x / (1.f + __expf(-x)); }
DI int crow(int reg, int h) { return (reg & 3) + 8 * (reg >> 2) + 4 * h; }
DI bf16x8 pack8(const f32x16& x, int s) {
  u32x4 p;
  p[0] = pack2(x[8 * s + 0], x[8 * s + 1]); p[1] = pack2(x[8 * s + 2], x[8 * s + 3]);
  p[2] = pack2(x[8 * s + 4], x[8 * s + 5]); p[3] = pack2(x[8 * s + 6], x[8 * s + 7]);
  return __builtin_bit_cast(bf16x8, p);
}
DI const float* xin_row(const Params& p, int layer, int row) {
  if (layer == 0) return row < ML ? p.x + (size_t)row * DM : p.ctx + (size_t)(row - ML) * DM;
  return row < ML ? p.out + (size_t)row * DM : (const float*)(p.ws + OFF_XC) + (size_t)(row - ML) * DM;
}
DI float* xst_row(const Params& p, int row) {
  return row < ML ? p.out + (size_t)row * DM : (float*)(p.ws + OFF_XC) + (size_t)(row - ML) * DM;
}
DI const float* mod_ptr(const Params& p, int layer, int row, int which) {
  int bb = row < ML ? (row >> 12) : 4;
  return (const float*)(p.ws + OFF_MOD) + ((size_t)(layer * 5 + bb) * 6 + which) * DM;
}
DI bf16_t* wt_ptr(const Params& p, int layer, size_t off) { return (bf16_t*)(p.ws + OFF_WT) + (size_t)layer * WT_ELEMS + off; }

DI void transpose_item(const float* __restrict__ w, const float* __restrict__ gk, int gk_from, bf16_t* __restrict__ wt, int K, int N, int kt, int nt, char* smem) {
  float* tile = (float*)smem;
  const int tid = ltid(), tx = tid & 63, ty = tid >> 6;
  const int k0 = kt * 64, n0 = nt * 64;
  const int n = n0 + tx;
  float v[16];
#pragma unroll
  for (int i = 0; i < 16; ++i) {
    int kk = ty + 4 * i;
    v[i] = n < N ? w[(size_t)(k0 + kk) * N + n] : 0.f;
  }
  if (gk) {
#pragma unroll
    for (int i = 0; i < 16; ++i) { int k = k0 + ty + 4 * i; if (k >= gk_from) v[i] *= gk[k - gk_from]; }
  }
#pragma unroll
  for (int i = 0; i < 16; ++i) tile[(ty + 4 * i) * 65 + tx] = v[i];
  __syncthreads();
#pragma unroll
  for (int i = 0; i < 2; ++i) {
    int c = tid + 256 * i, nn = c >> 3, kc = c & 7;
    u32x4 o;
#pragma unroll
    for (int jj = 0; jj < 4; ++jj) o[jj] = pack2(tile[(kc * 8 + 2 * jj) * 65 + nn], tile[(kc * 8 + 2 * jj + 1) * 65 + nn]);
    *(u32x4*)(wt + (size_t)(n0 + nn) * K + k0 + kc * 8) = o;
  }
  __syncthreads();
}

DI void modgemv_item(const Params& p, int layer, int ct, char* smem) {
  float* s = (float*)smem;
  float* red = s + 5 * 1024;
  const int tid = ltid(), w = tid >> 6, lane = tid & 63;
  for (int i = tid; i < 5 * 1024; i += 256) {
    int bb = i >> 10, k = i & 1023;
    float v = bb < 4 ? p.c[bb * 1024 + k] : p.c_ctx[k];
    s[i] = silu_f(v);
  }
  __syncthreads();
  const float* wm = p.w_mod + (size_t)layer * 1024 * 6144;
  const int n = ct * 64 + lane;
  float acc[5] = {0.f, 0.f, 0.f, 0.f, 0.f};
#pragma unroll 16
  for (int k = w * 256; k < w * 256 + 256; ++k) {
    float wv = wm[(size_t)k * 6144 + n];
#pragma unroll
    for (int bb = 0; bb < 5; ++bb) acc[bb] += s[bb * 1024 + k] * wv;
  }
#pragma unroll
  for (int bb = 0; bb < 5; ++bb) red[(w * 5 + bb) * 64 + lane] = acc[bb];
  __syncthreads();
  for (int i = tid; i < 320; i += 256) {
    int bb = i >> 6, ln = i & 63;
    float v = red[(0 * 5 + bb) * 64 + ln] + red[(1 * 5 + bb) * 64 + ln] + red[(2 * 5 + bb) * 64 + ln] + red[(3 * 5 + bb) * 64 + ln];
    int nn = ct * 64 + ln;
    v += p.b_mod[layer * 6144 + nn];
    ((float*)(p.ws + OFF_MOD))[(size_t)(layer * 5 + bb) * 6144 + nn] = v;
  }
  __syncthreads();
}

DI void phase_prep0(const Params& p, int bid, int nb, char* smem) {
  constexpr int PER = 2984;
  for (int it = bid; it < 192 + 2 * PER; it += nb) {
    if (it < 192) { modgemv_item(p, it / 96, it % 96, smem); continue; }
    int layer = (it - 192) / PER, j = (it - 192) % PER;
    if (j < 640) transpose_item(p.w_in + (size_t)layer * 1024 * DIN, nullptr, 0, wt_ptr(p, layer, WT_IN), 1024, DIN, j / 40, j % 40, smem);
    else if ((j -= 640) < 24) transpose_item(p.w_uq + (size_t)layer * 256 * 384, p.q_norm + layer * 256, 0, wt_ptr(p, layer, WT_UQ), 256, 384, j / 6, j % 6, smem);
    else if ((j -= 24) < 16) transpose_item(p.w_ukv + (size_t)layer * 128 * 512, p.kv_norm + layer * 128, 0, wt_ptr(p, layer, WT_UKV), 128, 512, j / 8, j % 8, smem);
    else if ((j -= 16) < 256) transpose_item(p.w_out + (size_t)layer * 1024 * 1024, p.ssd_norm + layer * 512, 512, wt_ptr(p, layer, WT_OUT), 1024, 1024, j / 16, j % 16, smem);
    else if ((j -= 256) < 1024) transpose_item(p.w_ff1 + (size_t)layer * 1024 * 4096, nullptr, 0, wt_ptr(p, layer, WT_FF1), 1024, 4096, j / 64, j % 64, smem);
    else { j -= 1024; transpose_item(p.w_ff2 + (size_t)layer * 4096 * 1024, nullptr, 0, wt_ptr(p, layer, WT_FF2), 4096, 1024, j / 16, j % 16, smem); }
  }
}

DI void write_h_row(const float4 xv[4], float rstd, const float* g, const float* sh, const float* sc, bf16_t* hrow, int lane) {
#pragma unroll
  for (int i = 0; i < 4; ++i) {
    int col = lane * 4 + 256 * i;
    float4 gg = *(const float4*)(g + col), s1 = *(const float4*)(sc + col), s0 = *(const float4*)(sh + col);
    float a = xv[i].x * rstd * gg.x * (1.f + s1.x) + s0.x;
    float b = xv[i].y * rstd * gg.y * (1.f + s1.y) + s0.y;
    float c = xv[i].z * rstd * gg.z * (1.f + s1.z) + s0.z;
    float d = xv[i].w * rstd * gg.w * (1.f + s1.w) + s0.w;
    u32x2 o; o[0] = pack2(a, b); o[1] = pack2(c, d);
    *(u32x2*)(hrow + col) = o;
  }
}
DI float ssq4(const float4 v[4]) {
  float s = 0.f;
#pragma unroll
  for (int i = 0; i < 4; ++i) s += v[i].x * v[i].x + v[i].y * v[i].y + v[i].z * v[i].z + v[i].w * v[i].w;
  return s;
}
DI void load_bf_row(const bf16_t* r, int lane, float4 v[4]) {
#pragma unroll
  for (int i = 0; i < 4; ++i) {
    u32x2 t = *(const u32x2*)(r + lane * 4 + 256 * i);
    v[i] = make_float4(lo2f(t[0]), hi2f(t[0]), lo2f(t[1]), hi2f(t[1]));
  }
}

DI void phase_h0(const Params& p, int bid, int nb) {
  const int w = ltid() >> 6, lane = ltid() & 63;
  bf16_t* H = (bf16_t*)(p.ws + OFF_H);
  for (int row = bid * 4 + w; row < MT; row += nb * 4) {
    const float* xr = xin_row(p, 0, row);
    float4 xv[4];
#pragma unroll
    for (int i = 0; i < 4; ++i) xv[i] = *(const float4*)(xr + lane * 4 + 256 * i);
    float rstd = rsqrtf(wave_sum(ssq4(xv)) * (1.f / DM) + EPS);
    write_h_row(xv, rstd, p.g_pre_mix, mod_ptr(p, 0, row, 0), mod_ptr(p, 0, row, 1), H + (size_t)row * DM, lane);
  }
}

DI void phase_postmix(const Params& p, int layer, int bid, int nb) {
  const int w = ltid() >> 6, lane = ltid() & 63;
  const int M = layer == 0 ? MT : ML;
  bf16_t* H = (bf16_t*)(p.ws + OFF_H);
  const bf16_t* Y = (const bf16_t*)(p.ws + OFF_U);
  for (int row = bid * 4 + w; row < M; row += nb * 4) {
    float4 yv[4], xv[4];
    load_bf_row(Y + (size_t)row * DM, lane, yv);
    const float* xr = xin_row(p, layer, row);
#pragma unroll
    for (int i = 0; i < 4; ++i) xv[i] = *(const float4*)(xr + lane * 4 + 256 * i);
    float rstd = rsqrtf(wave_sum(ssq4(yv)) * (1.f / DM) + EPS);
    const float* g1 = mod_ptr(p, layer, row, 2);
    const float* gp = p.g_post_mix + layer * DM;
    float* xo = xst_row(p, row);
#pragma unroll
    for (int i = 0; i < 4; ++i) {
      int col = lane * 4 + 256 * i;
      float4 a = *(const float4*)(g1 + col), b = *(const float4*)(gp + col);
      xv[i].x += a.x * yv[i].x * rstd * b.x; xv[i].y += a.y * yv[i].y * rstd * b.y;
      xv[i].z += a.z * yv[i].z * rstd * b.z; xv[i].w += a.w * yv[i].w * rstd * b.w;
      *(float4*)(xo + col) = xv[i];
    }
    float rstd1 = rsqrtf(wave_sum(ssq4(xv)) * (1.f / DM) + EPS);
    write_h_row(xv, rstd1, p.g_pre_ffn + layer * DM, mod_ptr(p, layer, row, 3), mod_ptr(p, layer, row, 4), H + (size_t)row * DM, lane);
  }
}

DI void phase_postffn(const Params& p, int layer, int bid, int nb) {
  const int w = ltid() >> 6, lane = ltid() & 63;
  const int M = layer == 0 ? MT : ML;
  bf16_t* H = (bf16_t*)(p.ws + OFF_H);
  for (int row = bid * 4 + w; row < M; row += nb * 4) {
    float4 fv[4], xv[4];
    load_bf_row(H + (size_t)row * DM, lane, fv);
    float* xo = xst_row(p, row);
#pragma unroll
    for (int i = 0; i < 4; ++i) xv[i] = *(const float4*)(xo + lane * 4 + 256 * i);
    float rstd = rsqrtf(wave_sum(ssq4(fv)) * (1.f / DM) + EPS);
    const float* g2 = mod_ptr(p, layer, row, 5);
    const float* gp = p.g_post_ffn + layer * DM;
#pragma unroll
    for (int i = 0; i < 4; ++i) {
      int col = lane * 4 + 256 * i;
      float4 a = *(const float4*)(g2 + col), b = *(const float4*)(gp + col);
      xv[i].x += a.x * fv[i].x * rstd * b.x; xv[i].y += a.y * fv[i].y * rstd * b.y;
      xv[i].z += a.z * fv[i].z * rstd * b.z; xv[i].w += a.w * fv[i].w * rstd * b.w;
      *(float4*)(xo + col) = xv[i];
    }
    if (layer == 0) {
      float rstd1 = rsqrtf(wave_sum(ssq4(xv)) * (1.f / DM) + EPS);
      write_h_row(xv, rstd1, p.g_pre_mix + DM, mod_ptr(p, 1, row, 0), mod_ptr(p, 1, row, 1), H + (size_t)row * DM, lane);
    }
  }
}

DI void phase_prep(const Params& p, int layer, int bid, int nb) {
  const int w = ltid() >> 6, lane = ltid() & 63;
  const bf16_t* U = (const bf16_t*)(p.ws + OFF_U);
  float* DT = (float*)(p.ws + OFF_DT);
  float* RS = (float*)(p.ws + OFF_RSTD);
  bf16_t* KB = (bf16_t*)(p.ws + OFF_KB);
  bf16_t* XBC = (bf16_t*)(p.ws + OFF_XBC);
  bf16_t* YM = (bf16_t*)(p.ws + OFF_H);
  const float* scw = p.sc_w + layer * 3 * 256;
  const float* cw = p.ssd_cw + layer * 3 * 768;
  const float* cb = p.ssd_cb + layer * 768;
  for (int row = bid * 4 + w; row < MT; row += nb * 4) {
    int b, t, L, pos;
    bool lat = row < ML;
    if (lat) { b = row >> 12; t = row & 4095; L = SEQ; pos = t + CTX; }
    else { int rr = row - ML; b = rr >> 8; t = rr & 255; L = CTX; pos = t; }
    const bf16_t* u0 = U + (size_t)row * DIN;
    const bool hp = t > 0, hn = t < L - 1;
    const bf16_t* um = u0 - DIN;
    const bf16_t* up = u0 + DIN;
    {
      u32x2 v = *(const u32x2*)(u0 + lane * 4);
      float a = lo2f(v[0]), bq = hi2f(v[0]), c = lo2f(v[1]), d = hi2f(v[1]);
      float ss = wave_sum(a * a + bq * bq + c * c + d * d);
      float s2 = 0.f;
      if (lane < 32) {
        u32x2 v2 = *(const u32x2*)(u0 + U_CKV + lane * 4);
        float e = lo2f(v2[0]), f = hi2f(v2[0]), g = lo2f(v2[1]), h = hi2f(v2[1]);
        s2 = e * e + f * f + g * g + h * h;
      }
      s2 = wave_sum(s2);
      if (lane == 0) { RS[row * 2] = rsqrtf(ss * (1.f / 256) + EPS); RS[row * 2 + 1] = rsqrtf(s2 * (1.f / 128) + EPS); }
    }
    {
      float v = bf2f(u0[U_KR + (lane & 31)]);
      float partner = __shfl_xor(v, 8);
      float o = v;
      if (lat) {
        int grp = (lane & 31) >> 3, i = lane & 7;
        float posf = grp < 2 ? (float)(t >> 6) : (float)(t & 63);
        float invf = exp2f(-(float)(2 * i) * (13.287712379549449f / 16.f));
        float ang = posf * invf;
        float rev = ang * 0.15915494309189535f;
        float cs = __builtin_amdgcn_cosf(rev), sn = __builtin_amdgcn_sinf(rev);
        o = (grp & 1) ? v * cs + partner * sn : v * cs - partner * sn;
      }
      if (lane < 32) {
        bf16_t ob = f2bf(o);
#pragma unroll
        for (int hd = 0; hd < 4; ++hd) KB[((size_t)(b * 4 + hd) * LK + pos) * 96 + 64 + lane] = ob;
      }
    }
    {
      int c = lane * 4;
      float acc[4] = {0.f, 0.f, 0.f, 0.f};
#pragma unroll
      for (int k = 0; k < 3; ++k) {
        const bf16_t* ur = k == 0 ? um : (k == 1 ? u0 : up);
        bool ok = k == 0 ? hp : (k == 1 ? true : hn);
        if (ok) {
          u32x2 gc = *(const u32x2*)(ur + U_GC + c), vv = *(const u32x2*)(ur + U_VAL + c);
          float4 wk = *(const float4*)(scw + k * 256 + c);
          acc[0] += wk.x * lo2f(gc[0]) * lo2f(vv[0]); acc[1] += wk.y * hi2f(gc[0]) * hi2f(vv[0]);
          acc[2] += wk.z * lo2f(gc[1]) * lo2f(vv[1]); acc[3] += wk.w * hi2f(gc[1]) * hi2f(vv[1]);
        }
      }
      u32x2 gb = *(const u32x2*)(u0 + U_GB + c);
      u32x2 o; o[0] = pack2(lo2f(gb[0]) * acc[0], hi2f(gb[0]) * acc[1]); o[1] = pack2(lo2f(gb[1]) * acc[2], hi2f(gb[1]) * acc[3]);
      *(u32x2*)(YM + (size_t)row * DM + 256 + c) = o;
    }
#pragma unroll
    for (int i = 0; i < 3; ++i) {
      int c = lane * 4 + 256 * i;
      float4 bias = *(const float4*)(cb + c);
      float acc[4] = {bias.x, bias.y, bias.z, bias.w};
#pragma unroll
      for (int k = 0; k < 3; ++k) {
        const bf16_t* ur = k == 0 ? um : (k == 1 ? u0 : up);
        bool ok = k == 0 ? hp : (k == 1 ? true : hn);
        if (ok) {
          u32x2 vv = *(const u32x2*)(ur + U_XBC + c);
          float4 wk = *(const float4*)(cw + k * 768 + c);
          acc[0] += wk.x * lo2f(vv[0]); acc[1] += wk.y * hi2f(vv[0]); acc[2] += wk.z * lo2f(vv[1]); acc[3] += wk.w * hi2f(vv[1]);
        }
      }
      u32x2 o; o[0] = pack2(silu_f(acc[0]), silu_f(acc[1])); o[1] = pack2(silu_f(acc[2]), silu_f(acc[3]));
      *(u32x2*)(XBC + (size_t)row * 768 + c) = o;
    }
    if (lane < 16) {
      float v = DT[(size_t)row * 16 + lane] + p.dt_bias[layer * 16 + lane];
      float sp = fmaxf(v, 0.f) + log1pf(__expf(-fabsf(v)));
      DT[(size_t)row * 16 + lane] = sp;
    }
  }
}

DI void phase_ssdnorm(const Params& p, int layer, int bid, int nb) {
  const int w = ltid() >> 6, lane = ltid() & 63;
  const int M = layer == 0 ? MT : ML;
  bf16_t* YM = (bf16_t*)(p.ws + OFF_H);
  const float* SSQ = (const float*)(p.ws + OFF_SSQ);
  const float* ng = p.ssd_norm + layer * 512;
  for (int row = bid * 4 + w; row < M; row += nb * 4) {
    int g = lane >> 5;
    float4 s = *(const float4*)(SSQ + (size_t)row * 8 + g * 4);
    float rstd = rsqrtf((s.x + s.y + s.z + s.w) * (1.f / 256) + EPS);
    bf16_t* ptr = YM + (size_t)row * DM + 512 + lane * 8;
    u32x4 v = *(const u32x4*)ptr;
    float4 g0 = *(const float4*)(ng + lane * 8), g1 = *(const float4*)(ng + lane * 8 + 4);
    u32x4 o;
    o[0] = pack2(lo2f(v[0]) * rstd * g0.x, hi2f(v[0]) * rstd * g0.y);
    o[1] = pack2(lo2f(v[1]) * rstd * g0.z, hi2f(v[1]) * rstd * g0.w);
    o[2] = pack2(lo2f(v[2]) * rstd * g1.x, hi2f(v[2]) * rstd * g1.y);
    o[3] = pack2(lo2f(v[3]) * rstd * g1.z, hi2f(v[3]) * rstd * g1.w);
    *(u32x4*)ptr = o;
  }
}

constexpr int GST = 80;
constexpr int GBUF = 2 * 128 * GST;
template <bool GN, class Epi>
DI void gemm_tile(const bf16_t* __restrict__ A, int lda, const bf16_t* __restrict__ Bt, int K, int row0, int col0, char* smem, Epi epi, const float* __restrict__ ssq = nullptr) {
  bf16_t* S0 = (bf16_t*)smem;
  const int tid = ltid(), wid = tid >> 6, lane = tid & 63, wr = wid >> 1, wc = wid & 1, fr = lane & 15, fq = lane >> 4;
  f32x4 acc[4][4];
#pragma unroll
  for (int m = 0; m < 4; ++m)
#pragma unroll
    for (int n = 0; n < 4; ++n) acc[m][n] = f32x4{0.f, 0.f, 0.f, 0.f};
  u32x4 ra[4], rb[4];
  const int sr = tid >> 3, sp = tid & 7;
  const bf16_t* ga = A + (size_t)(row0 + sr) * lda + sp * 8;
  const bf16_t* gb = Bt + (size_t)(col0 + sr) * K + sp * 8;
  auto gload = [&](int k0) {
#pragma unroll
    for (int i = 0; i < 4; ++i) {
      ra[i] = *(const u32x4*)(ga + (size_t)(32 * i) * lda + k0);
      rb[i] = *(const u32x4*)(gb + (size_t)(32 * i) * K + k0);
    }
  };
  gload(0);
  float gs[4][2];
  if (GN) {
#pragma unroll
    for (int i = 0; i < 4; ++i) {
      const float4 s0 = *(const float4*)(ssq + (size_t)(row0 + sr + 32 * i) * 8), s1 = *(const float4*)(ssq + (size_t)(row0 + sr + 32 * i) * 8 + 4);
      gs[i][0] = rsqrtf((s0.x + s0.y + s0.z + s0.w) * (1.f / 256) + EPS);
      gs[i][1] = rsqrtf((s1.x + s1.y + s1.z + s1.w) * (1.f / 256) + EPS);
    }
  }
  auto swrite = [&](int kt) {
    if (GN && kt >= 8) {
      const int g = (kt - 8) >> 2;
#pragma unroll
      for (int i = 0; i < 4; ++i) {
        const float sc = g ? gs[i][1] : gs[i][0];
#pragma unroll
        for (int jj = 0; jj < 4; ++jj) ra[i][jj] = pack2(lo2f(ra[i][jj]) * sc, hi2f(ra[i][jj]) * sc);
      }
    }
    bf16_t* As = S0 + (kt & 1) * GBUF;
    bf16_t* Bs = As + 128 * GST;
#pragma unroll
    for (int i = 0; i < 4; ++i) {
      *(u32x4*)(As + (sr + 32 * i) * GST + sp * 8) = ra[i];
      *(u32x4*)(Bs + (sr + 32 * i) * GST + sp * 8) = rb[i];
    }
  };
  const int KT = K / 64;
  swrite(0);
  if (KT > 1) gload(64);
  __syncthreads();
  for (int kt = 0; kt < KT; ++kt) {
    const bf16_t* As = S0 + (kt & 1) * GBUF;
    const bf16_t* Bs = As + 128 * GST;
#pragma unroll
    for (int ks = 0; ks < 2; ++ks) {
      bf16x8 af[4], bfr[4];
#pragma unroll
      for (int m = 0; m < 4; ++m) af[m] = *(const bf16x8*)(As + (wr * 64 + m * 16 + fr) * GST + ks * 32 + fq * 8);
#pragma unroll
      for (int n = 0; n < 4; ++n) bfr[n] = *(const bf16x8*)(Bs + (wc * 64 + n * 16 + fr) * GST + ks * 32 + fq * 8);
#pragma unroll
      for (int m = 0; m < 4; ++m)
#pragma unroll
        for (int n = 0; n < 4; ++n) acc[m][n] = MFMA16(bfr[n], af[m], acc[m][n]);
      if (ks == 0 && kt + 1 < KT) {
        swrite(kt + 1);
        if (kt + 2 < KT) gload((kt + 2) * 64);
      }
    }
    __syncthreads();
  }
#pragma unroll
  for (int m = 0; m < 4; ++m)
#pragma unroll
    for (int n = 0; n < 4; ++n) epi(row0 + wr * 64 + m * 16 + fr, col0 + wc * 64 + n * 16 + fq * 4, acc[m][n]);
}

template <class Epi>
DI void gemm_tile_glds(const bf16_t* __restrict__ A, int lda, const bf16_t* __restrict__ Bt, int K, int row0, int col0, char* smem, Epi epi) {
  const int tid = ltid(), wid = tid >> 6, lane = tid & 63, wr = wid >> 1, wc = wid & 1, fr = lane & 15, fq = lane >> 4;
  f32x4 acc[4][4];
#pragma unroll
  for (int m = 0; m < 4; ++m)
#pragma unroll
    for (int n = 0; n < 4; ++n) acc[m][n] = f32x4{0.f, 0.f, 0.f, 0.f};
  const int crow = tid >> 3, cslot = tid & 7, cpart = cslot ^ (crow & 7);
  const bf16_t* ga = A + (size_t)(row0 + crow) * lda + cpart * 8;
  const bf16_t* gb = Bt + (size_t)(col0 + crow) * K + cpart * 8;
  auto issue = [&](int kt, int stage) {
    char* sa = smem + stage * 32768 + tid * 16;
#pragma unroll
    for (int i = 0; i < 4; ++i) {
      __builtin_amdgcn_global_load_lds((const unsigned*)(ga + (size_t)(32 * i) * lda + kt * 64), (__attribute__((address_space(3))) unsigned*)(sa + i * 4096), 16, 0, 0);
      __builtin_amdgcn_global_load_lds((const unsigned*)(gb + (size_t)(32 * i) * K + kt * 64), (__attribute__((address_space(3))) unsigned*)(sa + 16384 + i * 4096), 16, 0, 0);
    }
  };
  const int KT = K / 64;
  issue(0, 0);
  asm volatile("s_waitcnt vmcnt(0)" ::: "memory");
  __syncthreads();
  const int sw = fr & 7;
  for (int kt = 0; kt < KT; ++kt) {
    if (kt + 1 < KT) issue(kt + 1, (kt + 1) & 1);
    const char* As = smem + (kt & 1) * 32768;
    const char* Bs = As + 16384;
#pragma unroll
    for (int ks = 0; ks < 2; ++ks) {
      bf16x8 af[4], bfr[4];
      const int so = ((ks * 4 + fq) ^ sw) * 16;
#pragma unroll
      for (int m = 0; m < 4; ++m) af[m] = *(const bf16x8*)(As + (wr * 64 + m * 16 + fr) * 128 + so);
#pragma unroll
      for (int n = 0; n < 4; ++n) bfr[n] = *(const bf16x8*)(Bs + (wc * 64 + n * 16 + fr) * 128 + so);
#pragma unroll
      for (int m = 0; m < 4; ++m)
#pragma unroll
        for (int n = 0; n < 4; ++n) acc[m][n] = MFMA16(bfr[n], af[m], acc[m][n]);
    }
    asm volatile("s_waitcnt vmcnt(0)" ::: "memory");
    __syncthreads();
  }
#pragma unroll
  for (int m = 0; m < 4; ++m)
#pragma unroll
    for (int n = 0; n < 4; ++n) epi(row0 + wr * 64 + m * 16 + fr, col0 + wc * 64 + n * 16 + fq * 4, acc[m][n]);
}

struct EpiBF {
  bf16_t* out; int ldo;
  DI void operator()(int row, int col, const f32x4& a) const {
    u32x2 o; o[0] = pack2(a[0], a[1]); o[1] = pack2(a[2], a[3]);
    *(u32x2*)(out + (size_t)row * ldo + col) = o;
  }
};
struct EpiRelu2 {
  bf16_t* out; int ldo;
  DI void operator()(int row, int col, const f32x4& a) const {
    float r0 = fmaxf(a[0], 0.f), r1 = fmaxf(a[1], 0.f), r2 = fmaxf(a[2], 0.f), r3 = fmaxf(a[3], 0.f);
    u32x2 o; o[0] = pack2(r0 * r0, r1 * r1); o[1] = pack2(r2 * r2, r3 * r3);
    *(u32x2*)(out + (size_t)row * ldo + col) = o;
  }
};
struct EpiU {
  bf16_t* u; float* dt;
  DI void operator()(int row, int col, const f32x4& a) const {
    if (col < DIN) {
      u32x2 o; o[0] = pack2(a[0], a[1]); o[1] = pack2(a[2], a[3]);
      *(u32x2*)(u + (size_t)row * DIN + col) = o;
      if (col >= U_DT) *(float4*)(dt + (size_t)row * 16 + col - U_DT) = make_float4(a[0], a[1], a[2], a[3]);
    }
  }
};
struct EpiQ {
  bf16_t* q; const float* rs;
  DI void operator()(int row, int col, const f32x4& a) const {
    const float r = rs[row * 2];
    u32x2 o; o[0] = pack2(a[0] * r, a[1] * r); o[1] = pack2(a[2] * r, a[3] * r);
    *(u32x2*)(q + (size_t)row * 384 + col) = o;
  }
};
struct EpiKV {
  bf16_t* kb; bf16_t* vt; const float* rs;
  DI void operator()(int row, int col, const f32x4& a) const {
    int b, pos;
    if (row < ML) { b = row >> 12; pos = (row & 4095) + CTX; } else { int rr = row - ML; b = rr >> 8; pos = rr & 255; }
    const int head = col >> 7, d = col & 127;
    const float r = rs[row * 2 + 1];
    if (d < 64) {
      u32x2 o; o[0] = pack2(a[0] * r, a[1] * r); o[1] = pack2(a[2] * r, a[3] * r);
      *(u32x2*)(kb + ((size_t)(b * 4 + head) * LK + pos) * 96 + d) = o;
    } else {
#pragma unroll
      for (int j = 0; j < 4; ++j) vt[((size_t)(b * 4 + head) * 64 + (d - 64 + j)) * LK + pos] = f2bf(a[j] * r);
    }
  }
};

DI void phase_inproj(const Params& p, int layer, int bid, int nb, char* smem) {
  constexpr int NT = DINP / 128;
  EpiU epi{(bf16_t*)(p.ws + OFF_U), (float*)(p.ws + OFF_DT)};
  for (int rep = 0; rep < REP_GEMM; ++rep)
  for (int it = bid; it < (MT / 128) * NT; it += nb)
    gemm_tile_glds((const bf16_t*)(p.ws + OFF_H), DM, wt_ptr(p, layer, WT_IN), 1024, (it / NT) * 128, (it % NT) * 128, smem, epi);
}
DI void phase_wout(const Params& p, int layer, int bid, int nb, char* smem) {
  const int M = layer == 0 ? MT : ML;
  EpiBF epi{(bf16_t*)(p.ws + OFF_U), DM};
  for (int rep = 0; rep < REP_GEMM; ++rep)
  for (int it = bid; it < (M / 128) * 8; it += nb)
    gemm_tile<true>((const bf16_t*)(p.ws + OFF_H), DM, wt_ptr(p, layer, WT_OUT), 1024, (it / 8) * 128, (it % 8) * 128, smem, epi, (const float*)(p.ws + OFF_SSQ));
}
DI void phase_ff1(const Params& p, int layer, int bid, int nb, char* smem) {
  const int M = layer == 0 ? MT : ML;
  EpiRelu2 epi{(bf16_t*)(p.ws + OFF_F1), DFF};
  for (int rep = 0; rep < REP_GEMM; ++rep)
  for (int it = bid; it < (M / 128) * 32; it += nb)
    gemm_tile_glds((const bf16_t*)(p.ws + OFF_H), DM, wt_ptr(p, layer, WT_FF1), 1024, (it / 32) * 128, (it % 32) * 128, smem, epi);
}
DI void phase_ff2(const Params& p, int layer, int bid, int nb, char* smem) {
  const int M = layer == 0 ? MT : ML;
  EpiBF epi{(bf16_t*)(p.ws + OFF_H), DM};
  for (int rep = 0; rep < REP_GEMM; ++rep)
  for (int it = bid; it < (M / 128) * 8; it += nb)
    gemm_tile_glds((const bf16_t*)(p.ws + OFF_F1), DFF, wt_ptr(p, layer, WT_FF2), 4096, (it / 8) * 128, (it % 8) * 128, smem, epi);
}

DI int chunk_row0(int b, int tc) { return tc < 2 ? ML + b * CTX + tc * 128 : b * SEQ + (tc - 2) * 128; }
constexpr int BST = 72;
constexpr int TST = 136;
DI void load_tile_T(bf16_t* dst, const bf16_t* __restrict__ src, int ldg) {
  const int tid = ltid();
#pragma unroll
  for (int i = 0; i < 4; ++i) {
    int c = tid + 256 * i, tok = c & 127, pc = c >> 7;
    u32x4 v = *(const u32x4*)(src + (size_t)tok * ldg + pc * 8);
#pragma unroll
    for (int j = 0; j < 4; ++j) {
      dst[(pc * 8 + 2 * j) * TST + tok] = (bf16_t)(v[j] & 0xffffu);
      dst[(pc * 8 + 2 * j + 1) * TST + tok] = (bf16_t)(v[j] >> 16);
    }
  }
}
DI void chunk_scan(const Params& p, int layer, int row0, int h, float* csf, float* csb, float* dtF, float* dtB, float* tot, float*  ) {
  const int tid = ltid(), w = tid >> 6, lane = tid & 63;
  const float* DT = (const float*)(p.ws + OFF_DT);
  float v;
  if (tid < 128) {
    const float dt = DT[(size_t)(row0 + tid) * 16 + h];
    v = dt * -__expf(p.a_log[layer * 16 + h]);
    dtF[tid] = dt;
  } else {
    const int e = 255 - tid;
    const float dt = DT[(size_t)(row0 + e) * 16 + 8 + h];
    v = dt * -__expf(p.a_log[layer * 16 + 8 + h]);
    dtB[e] = dt;
  }
#pragma unroll
  for (int o = 1; o < 64; o <<= 1) { const float t = __shfl_up(v, o); if (lane >= o) v += t; }
  if (lane == 63) tot[w] = v;
  __syncthreads();
  if (w == 1) v += tot[0];
  if (w == 3) v += tot[2];
  if (tid < 128) csf[tid] = v; else csb[255 - tid] = v;
  __syncthreads();
}

DI void ssd_state_item(const Params& p, int layer, int b, int tc, int h, char* smem) {
  bf16_t* XT = (bf16_t*)smem;
  bf16_t* BT = XT + 64 * TST;
  float* csf = (float*)(BT + 64 * TST);
  float* csb = csf + 128; float* dtF = csb + 128; float* dtB = dtF + 128; float* laF = dtB + 128; float* laB = laF + 128;
  const int tid = ltid(), w = tid >> 6, lane = tid & 63, r = lane & 31, hh = lane >> 5;
  const int row0 = chunk_row0(b, tc);
  const bf16_t* XBC = (const bf16_t*)(p.ws + OFF_XBC);
  load_tile_T(XT, XBC + (size_t)row0 * 768 + h * 64, 768);
  load_tile_T(BT, XBC + (size_t)row0 * 768 + 512 + (h >> 2) * 64, 768);
  chunk_scan(p, layer, row0, h, csf, csb, dtF, dtB, laF, laB);
  __syncthreads();
  if (tid < 128) laF[tid] = dtF[tid] * __expf(csf[127] - csf[tid]);
  else { int t = tid - 128; laB[t] = dtB[t] * __expf(csb[0] - csb[t]); }
  __syncthreads();
  const int d = w >> 1, pt = w & 1;
  const float* wv = d == 0 ? laF : laB;
  f32x16 acc[2];
#pragma unroll
  for (int i = 0; i < 16; ++i) { acc[0][i] = 0.f; acc[1][i] = 0.f; }
#pragma unroll
  for (int s = 0; s < 8; ++s) {
    int l0 = 16 * s + 8 * hh;
    u32x4 xa = *(const u32x4*)(XT + (32 * pt + r) * TST + l0);
    u32x4 sa;
#pragma unroll
    for (int j = 0; j < 4; ++j) sa[j] = pack2(lo2f(xa[j]) * wv[l0 + 2 * j], hi2f(xa[j]) * wv[l0 + 2 * j + 1]);
    bf16x8 af = __builtin_bit_cast(bf16x8, sa);
#pragma unroll
    for (int nt = 0; nt < 2; ++nt) {
      bf16x8 bfr = *(const bf16x8*)(BT + (32 * nt + r) * TST + l0);
      acc[nt] = MFMA32(af, bfr, acc[nt]);
    }
  }
  bf16_t* S = (bf16_t*)(p.ws + OFF_SST) + ((((size_t)d * NB + b) * NCH + tc) * 8 + h) * 4096;
#pragma unroll
  for (int nt = 0; nt < 2; ++nt)
#pragma unroll
    for (int i = 0; i < 16; ++i) S[(32 * pt + crow(i, hh)) * 64 + 32 * nt + r] = f2bf(acc[nt][i]);
  if (tid == 0) {
    float* TD = (float*)(p.ws + OFF_TDEC);
    TD[((0 * NB + b) * NCH + tc) * 8 + h] = __expf(csf[127]);
    TD[((1 * NB + b) * NCH + tc) * 8 + h] = __expf(csb[0]);
  }
  __syncthreads();
}

DI void ssd_pass_item(const Params& p, int it) {
  const int e = it * 256 + ltid();
  const int pn2 = e & 2047, h = (e >> 11) & 7, b = (e >> 14) & 3, d = e >> 16;
  unsigned* S = (unsigned*)(p.ws + OFF_SST);
  const float* TD = (const float*)(p.ws + OFF_TDEC);
  unsigned sv[NCH]; float T[NCH];
#pragma unroll
  for (int i = 0; i < NCH; ++i) {
    int tc = d == 0 ? i : (i < 2 ? 1 - i : NCH + 1 - i);
    sv[i] = S[(((size_t)(d * NB + b) * NCH + tc) * 8 + h) * 2048 + pn2];
    T[i] = TD[((d * NB + b) * NCH + tc) * 8 + h];
  }
  float h0 = 0.f, h1 = 0.f;
#pragma unroll
  for (int i = 0; i < NCH; ++i) {
    int tc = d == 0 ? i : (i < 2 ? 1 - i : NCH + 1 - i);
    S[(((size_t)(d * NB + b) * NCH + tc) * 8 + h) * 2048 + pn2] = pack2(h0, h1);
    h0 = T[i] * h0 + lo2f(sv[i]); h1 = T[i] * h1 + hi2f(sv[i]);
  }
}

DI void ssd_out_item(const Params& p, int layer, int b, int tc, int h, char* smem) {
  bf16_t* XT = (bf16_t*)smem;
  bf16_t* Bs = XT + 64 * TST;
  float* csf = (float*)(Bs + 128 * BST);
  float* csb = csf + 128; float* dtF = csb + 128; float* dtB = dtF + 128; float* laF = dtB + 128; float* laB = laF + 128;
  const int tid = ltid(), w = tid >> 6, lane = tid & 63, r = lane & 31, hh = lane >> 5;
  const int row0 = chunk_row0(b, tc), g = h >> 2;
  const bf16_t* XBC = (const bf16_t*)(p.ws + OFF_XBC);
  load_tile_T(XT, XBC + (size_t)row0 * 768 + h * 64, 768);
#pragma unroll
  for (int i = 0; i < 4; ++i) {
    int c = tid + 256 * i, tok = c >> 3, part = c & 7;
    *(u32x4*)(Bs + tok * BST + part * 8) = *(const u32x4*)(XBC + (size_t)(row0 + tok) * 768 + 512 + g * 64 + part * 8);
  }
  const int l = 32 * w + r;
  bf16x8 cf[4];
#pragma unroll
  for (int ks = 0; ks < 4; ++ks) cf[ks] = *(const bf16x8*)(XBC + (size_t)(row0 + l) * 768 + 640 + g * 64 + 16 * ks + 8 * hh);
  chunk_scan(p, layer, row0, h, csf, csb, dtF, dtB, laF, laB);
  const float csf_l = csf[l], csb_l = csb[l];
  f32x16 yacc[2];
#pragma unroll
  for (int i = 0; i < 16; ++i) { yacc[0][i] = 0.f; yacc[1][i] = 0.f; }
#pragma unroll
  for (int st = 0; st < 4; ++st) {
    f32x16 gacc;
#pragma unroll
    for (int i = 0; i < 16; ++i) gacc[i] = 0.f;
#pragma unroll
    for (int ks = 0; ks < 4; ++ks) {
      bf16x8 af = *(const bf16x8*)(Bs + (32 * st + r) * BST + 16 * ks + 8 * hh);
      gacc = MFMA32(af, cf[ks], gacc);
    }
#pragma unroll
    for (int i = 0; i < 16; ++i) {
      int s = 32 * st + crow(i, hh);
      float f;
      if (s < l) f = __expf(csf_l - csf[s]) * dtF[s];
      else if (s > l) f = __expf(csb_l - csb[s]) * dtB[s];
      else f = dtF[s] + dtB[s];
      gacc[i] *= f;
    }
#pragma unroll
    for (int s2 = 0; s2 < 2; ++s2) {
      bf16x8 mf = pack8(gacc, s2);
      int sb = 32 * st + 16 * s2 + 4 * hh;
#pragma unroll
      for (int pt = 0; pt < 2; ++pt) {
        u32x2 lo = *(const u32x2*)(XT + (32 * pt + r) * TST + sb);
        u32x2 hi = *(const u32x2*)(XT + (32 * pt + r) * TST + sb + 8);
        u32x4 xa; xa[0] = lo[0]; xa[1] = lo[1]; xa[2] = hi[0]; xa[3] = hi[1];
        yacc[pt] = MFMA32(__builtin_bit_cast(bf16x8, xa), mf, yacc[pt]);
      }
    }
  }
#pragma unroll
  for (int d = 0; d < 2; ++d) {
    const bf16_t* Hs = (const bf16_t*)(p.ws + OFF_SST) + ((((size_t)d * NB + b) * NCH + tc) * 8 + h) * 4096;
    const float e = __expf(d == 0 ? csf_l : csb_l);
#pragma unroll
    for (int pt = 0; pt < 2; ++pt) {
      f32x16 t;
#pragma unroll
      for (int i = 0; i < 16; ++i) t[i] = 0.f;
#pragma unroll
      for (int ks = 0; ks < 4; ++ks) {
        bf16x8 af = *(const bf16x8*)(Hs + (32 * pt + r) * 64 + 16 * ks + 8 * hh);
        t = MFMA32(af, cf[ks], t);
      }
#pragma unroll
      for (int i = 0; i < 16; ++i) yacc[pt][i] += e * t[i];
    }
  }
  const int row = row0 + l;
  const float Dh = p.ssd_d[layer * 8 + h];
  const bf16_t* U = (const bf16_t*)(p.ws + OFF_U);
  bf16_t* YM = (bf16_t*)(p.ws + OFF_H);
  float ssq = 0.f;
#pragma unroll
  for (int pt = 0; pt < 2; ++pt)
#pragma unroll
    for (int q = 0; q < 4; ++q) {
      int pp = 32 * pt + 8 * q + 4 * hh;
      u32x2 xv = *(const u32x2*)(XBC + (size_t)row * 768 + h * 64 + pp);
      u32x2 zv = *(const u32x2*)(U + (size_t)row * DIN + U_Z + h * 64 + pp);
      float y0 = (yacc[pt][4 * q + 0] + Dh * lo2f(xv[0])) * silu_f(lo2f(zv[0]));
      float y1 = (yacc[pt][4 * q + 1] + Dh * hi2f(xv[0])) * silu_f(hi2f(zv[0]));
      float y2 = (yacc[pt][4 * q + 2] + Dh * lo2f(xv[1])) * silu_f(lo2f(zv[1]));
      float y3 = (yacc[pt][4 * q + 3] + Dh * hi2f(xv[1])) * silu_f(hi2f(zv[1]));
      u32x2 o; o[0] = pack2(y0, y1); o[1] = pack2(y2, y3);
      float r0 = lo2f(o[0]), r1 = hi2f(o[0]), r2 = lo2f(o[1]), r3 = hi2f(o[1]);
      ssq += r0 * r0 + r1 * r1 + r2 * r2 + r3 * r3;
      *(u32x2*)(YM + (size_t)row * DM + 512 + h * 64 + pp) = o;
    }
  ssq += __shfl_xor(ssq, 32);
  if (hh == 0) ((float*)(p.ws + OFF_SSQ))[(size_t)row * 8 + h] = ssq;
  __syncthreads();
}

constexpr int KST = 104;
constexpr int VST = 68;
DI void attn_item(const Params& p, int b, int head, int qrow0, int t0, bool lat, int nkeys, char* smem) {
  bf16_t* Ks = (bf16_t*)smem;
  bf16_t* Vs = Ks + 64 * KST;
  const int tid = ltid(), w = tid >> 6, lane = tid & 63, r = lane & 31, hh = lane >> 5;
  const bf16_t* QB = (const bf16_t*)(p.ws + OFF_QB);
  const bf16_t* KB = (const bf16_t*)(p.ws + OFF_KB) + (size_t)(b * 4 + head) * LK * 96;
  const bf16_t* VT = (const bf16_t*)(p.ws + OFF_VT) + (size_t)(b * 4 + head) * 64 * LK;
  const float qscale = 0.10206207261596575f * 1.4426950408889634f;
  const int qrow = qrow0 + w * 32 + r;
  const int t = t0 + w * 32 + r;
  bf16x8 qf[6];
  {
    const bf16_t* src = QB + (size_t)qrow * 384 + head * 96;
#pragma unroll
    for (int s = 0; s < 4; ++s) {
      u32x4 v = *(const u32x4*)(src + 16 * s + 8 * hh);
      u32x4 o;
#pragma unroll
      for (int j = 0; j < 4; ++j) o[j] = pack2(lo2f(v[j]) * qscale, hi2f(v[j]) * qscale);
      qf[s] = __builtin_bit_cast(bf16x8, o);
    }
#pragma unroll
    for (int s = 4; s < 6; ++s) {
      u32x4 va = *(const u32x4*)(src + 16 * s), vb = *(const u32x4*)(src + 16 * s + 8);
      float posf = s == 4 ? (float)(t >> 6) : (float)(t & 63);
      float o[8];
#pragma unroll
      for (int j = 0; j < 8; ++j) {
        float a = (j & 1) ? hi2f(va[j >> 1]) : lo2f(va[j >> 1]);
        float bb = (j & 1) ? hi2f(vb[j >> 1]) : lo2f(vb[j >> 1]);
        float res;
        if (lat) {
          float invf = exp2f(-(float)(2 * j) * (13.287712379549449f / 16.f));
          float rev = posf * invf * 0.15915494309189535f;
          float cs = __builtin_amdgcn_cosf(rev), sn = __builtin_amdgcn_sinf(rev);
          res = hh == 0 ? a * cs - bb * sn : bb * cs + a * sn;
        } else res = hh == 0 ? a : bb;
        o[j] = res * qscale;
      }
      u32x4 ov; ov[0] = pack2(o[0], o[1]); ov[1] = pack2(o[2], o[3]); ov[2] = pack2(o[4], o[5]); ov[3] = pack2(o[6], o[7]);
      qf[s] = __builtin_bit_cast(bf16x8, ov);
    }
  }
  f32x16 oacc[2];
#pragma unroll
  for (int i = 0; i < 16; ++i) { oacc[0][i] = 0.f; oacc[1][i] = 0.f; }
  float m = -1e30f, lsum = 0.f;
  u32x4 rk[3], rv[2];
  auto gload = [&](int key0) {
#pragma unroll
    for (int i = 0; i < 3; ++i) rk[i] = *(const u32x4*)(KB + (size_t)key0 * 96 + (tid + 256 * i) * 8);
#pragma unroll
    for (int i = 0; i < 2; ++i) { int c = tid + 256 * i; rv[i] = *(const u32x4*)(VT + (size_t)(c >> 3) * LK + key0 + (c & 7) * 8); }
  };
  gload(0);
  const int NT = nkeys / 64;
  for (int kt = 0; kt < NT; ++kt) {
#pragma unroll
    for (int i = 0; i < 3; ++i) { int c = tid + 256 * i; *(u32x4*)(Ks + (c / 12) * KST + (c % 12) * 8) = rk[i]; }
#pragma unroll
    for (int i = 0; i < 2; ++i) {
      int c = tid + 256 * i;
      bf16_t* d = Vs + (c >> 3) * VST + (c & 7) * 8;
      u32x2 a; a[0] = rv[i][0]; a[1] = rv[i][1];
      u32x2 bq; bq[0] = rv[i][2]; bq[1] = rv[i][3];
      *(u32x2*)d = a; *(u32x2*)(d + 4) = bq;
    }
    __syncthreads();
    if (kt + 1 < NT) gload((kt + 1) * 64);
    f32x16 sacc[2];
#pragma unroll
    for (int i = 0; i < 16; ++i) { sacc[0][i] = 0.f; sacc[1][i] = 0.f; }
#pragma unroll
    for (int s = 0; s < 6; ++s)
#pragma unroll
      for (int k2 = 0; k2 < 2; ++k2) {
        bf16x8 af = *(const bf16x8*)(Ks + (32 * k2 + r) * KST + 16 * s + 8 * hh);
        sacc[k2] = MFMA32(af, qf[s], sacc[k2]);
      }
    float mx = sacc[0][0];
#pragma unroll
    for (int i = 0; i < 16; ++i) { mx = fmaxf(mx, sacc[0][i]); mx = fmaxf(mx, sacc[1][i]); }
    mx = fmaxf(mx, __shfl_xor(mx, 32));
    const float mn = fmaxf(m, mx);
    const float alpha = __builtin_amdgcn_exp2f(m - mn);
    m = mn;
    float ps = 0.f;
#pragma unroll
    for (int i = 0; i < 16; ++i) {
      sacc[0][i] = __builtin_amdgcn_exp2f(sacc[0][i] - mn); sacc[1][i] = __builtin_amdgcn_exp2f(sacc[1][i] - mn);
      ps += sacc[0][i] + sacc[1][i];
    }
    lsum = lsum * alpha + ps;
#pragma unroll
    for (int i = 0; i < 16; ++i) { oacc[0][i] *= alpha; oacc[1][i] *= alpha; }
#pragma unroll
    for (int k2 = 0; k2 < 2; ++k2)
#pragma unroll
      for (int s2 = 0; s2 < 2; ++s2) {
        bf16x8 pf = pack8(sacc[k2], s2);
        int kb0 = 32 * k2 + 16 * s2 + 4 * hh;
#pragma unroll
        for (int d = 0; d < 2; ++d) {
          u32x2 lo = *(const u32x2*)(Vs + (32 * d + r) * VST + kb0);
          u32x2 hi = *(const u32x2*)(Vs + (32 * d + r) * VST + kb0 + 8);
          u32x4 va; va[0] = lo[0]; va[1] = lo[1]; va[2] = hi[0]; va[3] = hi[1];
          oacc[d] = MFMA32(__builtin_bit_cast(bf16x8, va), pf, oacc[d]);
        }
      }
    __syncthreads();
  }
  lsum += __shfl_xor(lsum, 32);
  const float inv = 1.f / lsum;
  bf16_t* YM = (bf16_t*)(p.ws + OFF_H) + (size_t)qrow * DM + head * 64;
#pragma unroll
  for (int d = 0; d < 2; ++d)
#pragma unroll
    for (int q = 0; q < 4; ++q) {
      u32x2 o; o[0] = pack2(oacc[d][4 * q] * inv, oacc[d][4 * q + 1] * inv); o[1] = pack2(oacc[d][4 * q + 2] * inv, oacc[d][4 * q + 3] * inv);
      *(u32x2*)(YM + 32 * d + 8 * q + 4 * hh) = o;
    }
}

DI void phase_qkv(const Params& p, int layer, int bid, int nb, char* smem) {
  const int MQ = layer == 0 ? MT : ML;
  const int nq = (MQ / 128) * 3, nkv = (MT / 128) * 4, nst = NB * NCH * 8;
  const float* RS = (const float*)(p.ws + OFF_RSTD);
  EpiQ eq{(bf16_t*)(p.ws + OFF_QB), RS};
  EpiKV ekv{(bf16_t*)(p.ws + OFF_KB), (bf16_t*)(p.ws + OFF_VT), RS};
  const bf16_t* U = (const bf16_t*)(p.ws + OFF_U);
  for (int it = bid; it < nq + nkv + nst; it += nb) {
    if (it < nq) gemm_tile<false>(U, DIN, wt_ptr(p, layer, WT_UQ), 256, (it / 3) * 128, (it % 3) * 128, smem, eq);
    else if (it < nq + nkv) { int j = it - nq; gemm_tile<false>(U + U_CKV, DIN, wt_ptr(p, layer, WT_UKV), 128, (j / 4) * 128, (j % 4) * 128, smem, ekv); }
    else { int j = it - nq - nkv; for (int rep = 0; rep < REP_SSD; ++rep) ssd_state_item(p, layer, j / (NCH * 8), (j / 8) % NCH, j & 7, smem); }
  }
}
DI void phase_att(const Params& p, int layer, int bid, int nb, char* smem) {
  const int natt = 512 + (layer == 0 ? 32 : 0), npass = 512;
  for (int it = bid; it < natt + npass; it += nb) {
    if (it < 512) { int b = it >> 7, head = (it >> 5) & 3, qb = it & 31; for (int rep = 0; rep < REP_ATT; ++rep) attn_item(p, b, head, b * SEQ + qb * 128, qb * 128, true, LK, smem); }
    else if (it < natt) { int j = it - 512; int b = j >> 3, head = (j >> 1) & 3, qb = j & 1; attn_item(p, b, head, ML + b * CTX + qb * 128, qb * 128, false, CTX, smem); }
    else ssd_pass_item(p, it - natt);
  }
}
DI void phase_ssdout(const Params& p, int layer, int bid, int nb, char* smem) {
  for (int it = bid; it < NB * NCH * 8; it += nb) {
    int b = it / (NCH * 8), tc = (it / 8) % NCH, h = it & 7;
    if (layer == 1 && tc < 2) continue;
    for (int rep = 0; rep < REP_SSD; ++rep) ssd_out_item(p, layer, b, tc, h, smem);
  }
}


#define XB_TMO      128
#define XB_XCNT(j)  (256  + 64 * (j))
#define XB_XSUB(j)  (1280 + 64 * (j))
#define XB_XGEN(j)  (2304 + 64 * (j))
#define XB_TOP      3328
#define XB_TOPGEN   3392
#define XCD_BAR_WORDS 3456
#define XB_SPIN_CAP (1u << 22)
#define LAS __attribute__((address_space(3)))
DI unsigned xb_ld(unsigned* p) { return __hip_atomic_load(p, __ATOMIC_RELAXED, __HIP_MEMORY_SCOPE_AGENT); }
DI unsigned xb_add(unsigned* p, unsigned v) { return __hip_atomic_fetch_add(p, v, __ATOMIC_RELAXED, __HIP_MEMORY_SCOPE_AGENT); }
DI unsigned xb_xcc_id() { return (unsigned)__builtin_amdgcn_s_getreg((3 << 11) | 20) & 0xFu; }
#define XB_SPIN(cond, bar) do { unsigned _sp = 0; while (cond) { __builtin_amdgcn_s_sleep(1); \
    if ((++_sp & 255u) == 0u) { if (xb_ld(&(bar)[XB_TMO])) break; if (_sp > XB_SPIN_CAP) { atomicAdd(&(bar)[XB_TMO], 1u); break; } } } } while (0)
struct XcdBarrier { unsigned* bar; unsigned x; volatile LAS unsigned* st; };
DI XcdBarrier xcd_barrier_post(unsigned* bar, volatile LAS unsigned* st) {
  XcdBarrier b; b.bar = bar; b.x = xb_xcc_id(); b.st = st;
  if (threadIdx.x == 0) (void)xb_add(&bar[XB_XCNT(b.x)], 1u);
  return b;
}
DI void xcd_barrier_complete(unsigned* bar, unsigned x, unsigned& nloc, unsigned& nx) {
  const unsigned G = gridDim.x * gridDim.y * gridDim.z;
  unsigned sum, cnt, mine, sp = 0u;
  for (;;) {
    sum = 0u; cnt = 0u; mine = 0u;
#pragma unroll
    for (unsigned j = 0; j < 16; ++j) { const unsigned c = xb_ld(&bar[XB_XCNT(j)]); sum += c; cnt += (c > 0u) ? 1u : 0u; mine = (j == x) ? c : mine; }
    if (sum == G) break;
    __builtin_amdgcn_s_sleep(1);
    if ((++sp & 255u) == 0u) { if (xb_ld(&bar[XB_TMO])) break; if (sp > XB_SPIN_CAP) { atomicAdd(&bar[XB_TMO], 1u); break; } }
  }
  nloc = mine > 0u ? mine : 1u; nx = cnt > 0u ? cnt : 1u;
}
DI void xcd_barrier(const XcdBarrier& b) {
  asm volatile("s_waitcnt vmcnt(0)" ::: "memory");
  __syncthreads();
  if (threadIdx.x == 0) {
    unsigned* bar = b.bar;
    __builtin_amdgcn_s_waitcnt(0);
    unsigned nloc = b.st[0], nx = b.st[1];
    if (nloc == 0u) { xcd_barrier_complete(bar, b.x, nloc, nx); b.st[0] = nloc; b.st[1] = nx; }
    const unsigned old = xb_add(&bar[XB_XSUB(b.x)], 1u);
    const unsigned gen = old / nloc;
    if (old + 1u == (gen + 1u) * nloc) {
      __builtin_amdgcn_fence(__ATOMIC_RELEASE, "agent");
      asm volatile("s_waitcnt vmcnt(0)" ::: "memory");
      const unsigned og = xb_add(&bar[XB_TOP], 1u);
      const unsigned tg = og / nx;
      if (og + 1u == (tg + 1u) * nx) xb_add(&bar[XB_TOPGEN], 1u);
      else XB_SPIN(xb_ld(&bar[XB_TOPGEN]) == tg, bar);
      __builtin_amdgcn_fence(__ATOMIC_ACQUIRE, "agent");
      xb_add(&bar[XB_XGEN(b.x)], 1u);
      asm volatile("s_waitcnt vmcnt(0)" ::: "memory");
    } else {
      XB_SPIN(xb_ld(&bar[XB_XGEN(b.x)]) == gen, bar);
      __builtin_amdgcn_fence(__ATOMIC_ACQUIRE, "agent");
      asm volatile("s_waitcnt vmcnt(0)" ::: "memory");
    }
  }
  __syncthreads();
}

constexpr int SMEM_BYTES = 2 * GBUF * 2;
enum { PH_PREP0 = 0, PH_H0, PH_INPROJ, PH_PREP, PH_QKV, PH_ATT, PH_SSDOUT, PH_WOUT, PH_POSTMIX, PH_FF1, PH_FF2, PH_POSTFFN, PH_SSDNORM };

DI void run_phase(const Params& p, int ph, int layer, int bid, int nb, char* smem) {
  switch (ph) {
    case PH_PREP0: phase_prep0(p, bid, nb, smem); break;
    case PH_H0: phase_h0(p, bid, nb); break;
    case PH_INPROJ: phase_inproj(p, layer, bid, nb, smem); break;
    case PH_PREP: phase_prep(p, layer, bid, nb); break;
    case PH_QKV: phase_qkv(p, layer, bid, nb, smem); break;
    case PH_ATT: phase_att(p, layer, bid, nb, smem); break;
    case PH_SSDOUT: phase_ssdout(p, layer, bid, nb, smem); break;
    case PH_SSDNORM: phase_ssdnorm(p, layer, bid, nb); break;
    case PH_WOUT: phase_wout(p, layer, bid, nb, smem); break;
    case PH_POSTMIX: phase_postmix(p, layer, bid, nb); break;
    case PH_FF1: phase_ff1(p, layer, bid, nb, smem); break;
    case PH_FF2: phase_ff2(p, layer, bid, nb, smem); break;
    case PH_POSTFFN: phase_postffn(p, layer, bid, nb); break;
  }
}

__global__ void __launch_bounds__(256, 2) mega_kernel(Params p) {
  extern __shared__ __attribute__((aligned(16))) char smem[];
  cg::grid_group grid = cg::this_grid();
  if (p.ws == nullptr) grid.sync();
  const int bid = blockIdx.x, nb = gridDim.x;
  volatile LAS unsigned* st = (volatile LAS unsigned*)(smem + SMEM_BYTES - 16);
  if (threadIdx.x == 0) { st[0] = 0u; st[1] = 0u; st[2] = 0u; st[3] = 0u; }
  __syncthreads();
  XcdBarrier xb = xcd_barrier_post((unsigned*)(p.ws + OFF_BAR), st);
  for (int step = 0; step < 22; ++step) {
    int ph, layer;
    if (step < 2) { ph = step; layer = 0; }
    else { int j = step - 2; layer = j / 10; ph = PH_INPROJ + j % 10; }
    run_phase(p, ph, layer, bid, nb, smem);
    if (step < 21) xcd_barrier(xb);
  }
}

extern "C" void kernel_launch(void* const* d_in, const int* in_sizes, int n_in, void* d_out, int out_size, void* d_ws, size_t ws_size,
                              hipStream_t stream) {
  if (ws_size < WS_NEED) { fprintf(stderr, "workspace too small: %zu < %zu\n", ws_size, (size_t)WS_NEED); return; }
  Params p{};
  const float** f = (const float**)&p;
  for (int i = 0; i < 25; ++i) f[i] = (const float*)d_in[i];
  p.out = (float*)d_out;
  p.ws = (char*)d_ws;
  static int grid_blocks = 0;
  if (!grid_blocks) {
    int dev = 0, cus = 0, per_cu = 0;
    hipGetDevice(&dev);
    hipDeviceGetAttribute(&cus, hipDeviceAttributeMultiprocessorCount, dev);
    hipFuncSetAttribute((const void*)mega_kernel, hipFuncAttributeMaxDynamicSharedMemorySize, SMEM_BYTES);
    hipOccupancyMaxActiveBlocksPerMultiprocessor(&per_cu, mega_kernel, 256, SMEM_BYTES);
    if (per_cu > 2) per_cu = 2;
    grid_blocks = cus * per_cu;
  }
  hipMemsetAsync((char*)d_ws + OFF_BAR, 0, XCD_BAR_WORDS * 4, stream);
  void* args[] = {&p};
  hipError_t e = hipLaunchCooperativeKernel((void*)mega_kernel, dim3(grid_blocks), dim3(256), args, SMEM_BYTES, stream);
  if (e != hipSuccess) fprintf(stderr, "cooperative launch failed: %s (grid %d)\n", hipGetErrorString(e), grid_blocks);
}
```

```cpp
#include <hip/hip_runtime.h>
#include <hip/hip_cooperative_groups.h>
#include <stdint.h>
#include <stdio.h>
namespace cg = cooperative_groups;

#ifndef MEGA
#define MEGA 1
#endif
#ifndef REP_GEMM
#define REP_GEMM 1
#endif
#ifndef REP_ATT
#define REP_ATT 1
#endif
#ifndef REP_SSD
#define REP_SSD 1
#endif

typedef unsigned short bf16_t;
using bf16x8 = __attribute__((ext_vector_type(8))) short;
using s16x4  = __attribute__((ext_vector_type(4))) short;
using f32x4  = __attribute__((ext_vector_type(4))) float;
using f32x16 = __attribute__((ext_vector_type(16))) float;
using u32x4  = __attribute__((ext_vector_type(4))) unsigned;
using u32x2  = __attribute__((ext_vector_type(2))) unsigned;
#define DI __device__ __forceinline__
#define MFMA32(a, b, c) __builtin_amdgcn_mfma_f32_32x32x16_bf16((a), (b), (c), 0, 0, 0)
#define MFMA16(a, b, c) __builtin_amdgcn_mfma_f32_16x16x32_bf16((a), (b), (c), 0, 0, 0)

constexpr int DM = 1024, NB = 4, SEQ = 4096, CTX = 256;
constexpr int ML = NB * SEQ;
constexpr int MC = NB * CTX;
constexpr int MT = ML + MC;
constexpr int DIN = 2480, DINP = 2560;
constexpr int LK = CTX + SEQ;
constexpr int DFF = 4096;
constexpr int NCH = 34;
constexpr float EPS = 1e-6f;
constexpr int U_CKV = 256, U_KR = 384, U_GB = 416, U_GC = 672, U_VAL = 928, U_Z = 1184, U_XBC = 1696, U_DT = 2464;

constexpr size_t AL(size_t x) { return (x + 255) & ~(size_t)255; }
constexpr size_t WT_IN = 0;
constexpr size_t WT_UQ = WT_IN + (size_t)DINP * 1024;
constexpr size_t WT_UKV = WT_UQ + (size_t)384 * 256;
constexpr size_t WT_OUT = WT_UKV + (size_t)512 * 128;
constexpr size_t WT_FF1 = WT_OUT + (size_t)1024 * 1024;
constexpr size_t WT_FF2 = WT_FF1 + (size_t)4096 * 1024;
constexpr size_t WT_ELEMS = WT_FF2 + (size_t)4096 * 1024;
constexpr size_t OFF_WT = 0;
constexpr size_t OFF_MOD = AL(OFF_WT + 2 * WT_ELEMS * 2);
constexpr size_t OFF_XC = AL(OFF_MOD + 2 * 5 * 6144 * 4);
constexpr size_t OFF_H = AL(OFF_XC + (size_t)MC * DM * 4);
constexpr size_t OFF_R1 = AL(OFF_H + (size_t)MT * DM * 2);
constexpr size_t OFF_U = OFF_R1;
constexpr size_t OFF_DT = AL(OFF_U + (size_t)MT * DIN * 2);
constexpr size_t OFF_RSTD = AL(OFF_DT + (size_t)MT * 16 * 4);
constexpr size_t OFF_QB = AL(OFF_RSTD + (size_t)MT * 2 * 4);
constexpr size_t OFF_KB = AL(OFF_QB + (size_t)MT * 384 * 2);
constexpr size_t OFF_VT = AL(OFF_KB + (size_t)NB * 4 * LK * 96 * 2);
constexpr size_t OFF_XBC = AL(OFF_VT + (size_t)NB * 4 * 64 * LK * 2);
constexpr size_t OFF_SST = AL(OFF_XBC + (size_t)MT * 768 * 2);
constexpr size_t OFF_TDEC = AL(OFF_SST + (size_t)2 * NB * NCH * 8 * 4096 * 2);
constexpr size_t OFF_SSQ = AL(OFF_TDEC + (size_t)2 * NB * NCH * 8 * 4);
constexpr size_t OFF_END1 = AL(OFF_SSQ + (size_t)MT * 8 * 4);
constexpr size_t OFF_F1 = OFF_R1;
constexpr size_t OFF_END2 = AL(OFF_F1 + (size_t)MT * DFF * 2);
constexpr size_t OFF_BAR = OFF_END1 > OFF_END2 ? OFF_END1 : OFF_END2;
constexpr size_t WS_NEED = OFF_BAR + 16384;

struct Params {
  const float *x, *c, *ctx, *c_ctx, *w_mod, *b_mod, *g_pre_mix, *w_in, *q_norm, *w_uq, *kv_norm, *w_ukv, *sc_w, *ssd_cw, *ssd_cb,
      *a_log, *dt_bias, *ssd_d, *ssd_norm, *w_out, *g_post_mix, *g_pre_ffn, *w_ff1, *w_ff2, *g_post_ffn;
  float* out;
  char* ws;
};

DI int ltid() { int t = threadIdx.x; asm volatile("" : "+v"(t)); return t; }
typedef __bf16 hbf2 __attribute__((ext_vector_type(2)));
typedef float hf2 __attribute__((ext_vector_type(2)));
DI bf16_t f2bf(float x) { return __builtin_bit_cast(bf16_t, (__bf16)x); }
DI float bf2f(unsigned v) { return __uint_as_float(v << 16); }
DI unsigned pack2(float a, float b) { hf2 v = {a, b}; return __builtin_bit_cast(unsigned, __builtin_convertvector(v, hbf2)); }
DI float lo2f(unsigned w) { return __uint_as_float(w << 16); }
DI float hi2f(unsigned w) { return __uint_as_float(w & 0xffff0000u); }
DI float wave_sum(float v) {
#pragma unroll
  for (int o = 32; o > 0; o >>= 1) v += __shfl_xor(v, o);
  return v;
}
DI float silu_f(float x) { return x / (1.f + __expf(-x)); }
DI int crow(int reg, int h) { return (reg & 3) + 8 * (reg >> 2) + 4 * h; }
DI bf16x8 pack8(const f32x16& x, int s) {
  u32x4 p;
  p[0] = pack2(x[8 * s + 0], x[8 * s + 1]); p[1] = pack2(x[8 * s + 2], x[8 * s + 3]);
  p[2] = pack2(x[8 * s + 4], x[8 * s + 5]); p[3] = pack2(x[8 * s + 6], x[8 * s + 7]);
  return __builtin_bit_cast(bf16x8, p);
}
DI const float* xin_row(const Params& p, int layer, int row) {
  if (layer == 0) return row < ML ? p.x + (size_t)row * DM : p.ctx + (size_t)(row - ML) * DM;
  return row < ML ? p.out + (size_t)row * DM : (const float*)(p.ws + OFF_XC) + (size_t)(row - ML) * DM;
}
DI float* xst_row(const Params& p, int row) {
  return row < ML ? p.out + (size_t)row * DM : (float*)(p.ws + OFF_XC) + (size_t)(row - ML) * DM;
}
DI const float* mod_ptr(const Params& p, int layer, int row, int which) {
  int bb = row < ML ? (row >> 12) : 4;
  return (const float*)(p.ws + OFF_MOD) + ((size_t)(layer * 5 + bb) * 6 + which) * DM;
}
DI bf16_t* wt_ptr(const Params& p, int layer, size_t off) { return (bf16_t*)(p.ws + OFF_WT) + (size_t)layer * WT_ELEMS + off; }

DI void transpose_item(const float* __restrict__ w, const float* __restrict__ gk, int gk_from, bf16_t* __restrict__ wt, int K, int N, int kt, int nt, char* smem) {
  float* tile = (float*)smem;
  const int tid = ltid(), tx = tid & 63, ty = tid >> 6;
  const int k0 = kt * 64, n0 = nt * 64;
  const int n = n0 + tx;
  float v[16];
#pragma unroll
  for (int i = 0; i < 16; ++i) {
    int kk = ty + 4 * i;
    v[i] = n < N ? w[(size_t)(k0 + kk) * N + n] : 0.f;
  }
  if (gk) {
#pragma unroll
    for (int i = 0; i < 16; ++i) { int k = k0 + ty + 4 * i; if (k >= gk_from) v[i] *= gk[k - gk_from]; }
  }
#pragma unroll
  for (int i = 0; i < 16; ++i) tile[(ty + 4 * i) * 65 + tx] = v[i];
  __syncthreads();
#pragma unroll
  for (int i = 0; i < 2; ++i) {
    int c = tid + 256 * i, nn = c >> 3, kc = c & 7;
    u32x4 o;
#pragma unroll
    for (int jj = 0; jj < 4; ++jj) o[jj] = pack2(tile[(kc * 8 + 2 * jj) * 65 + nn], tile[(kc * 8 + 2 * jj + 1) * 65 + nn]);
    *(u32x4*)(wt + (size_t)(n0 + nn) * K + k0 + kc * 8) = o;
  }
  __syncthreads();
}

DI void modgemv_item(const Params& p, int layer, int ct, char* smem) {
  float* s = (float*)smem;
  float* red = s + 5 * 1024;
  const int tid = ltid(), w = tid >> 6, lane = tid & 63;
  for (int i = tid; i < 5 * 1024; i += 256) {
    int bb = i >> 10, k = i & 1023;
    float v = bb < 4 ? p.c[bb * 1024 + k] : p.c_ctx[k];
    s[i] = silu_f(v);
  }
  __syncthreads();
  const float* wm = p.w_mod + (size_t)layer * 1024 * 6144;
  const int n = ct * 64 + lane;
  float acc[5] = {0.f, 0.f, 0.f, 0.f, 0.f};
#pragma unroll 16
  for (int k = w * 256; k < w * 256 + 256; ++k) {
    float wv = wm[(size_t)k * 6144 + n];
#pragma unroll
    for (int bb = 0; bb < 5; ++bb) acc[bb] += s[bb * 1024 + k] * wv;
  }
#pragma unroll
  for (int bb = 0; bb < 5; ++bb) red[(w * 5 + bb) * 64 + lane] = acc[bb];
  __syncthreads();
  for (int i = tid; i < 320; i += 256) {
    int bb = i >> 6, ln = i & 63;
    float v = red[(0 * 5 + bb) * 64 + ln] + red[(1 * 5 + bb) * 64 + ln] + red[(2 * 5 + bb) * 64 + ln] + red[(3 * 5 + bb) * 64 + ln];
    int nn = ct * 64 + ln;
    v += p.b_mod[layer * 6144 + nn];
    ((float*)(p.ws + OFF_MOD))[(size_t)(layer * 5 + bb) * 6144 + nn] = v;
  }
  __syncthreads();
}

DI void phase_prep0(const Params& p, int bid, int nb, char* smem) {
  constexpr int PER = 2984;
  for (int it = bid; it < 192 + 2 * PER; it += nb) {
    if (it < 192) { modgemv_item(p, it / 96, it % 96, smem); continue; }
    int layer = (it - 192) / PER, j = (it - 192) % PER;
    if (j < 640) transpose_item(p.w_in + (size_t)layer * 1024 * DIN, nullptr, 0, wt_ptr(p, layer, WT_IN), 1024, DIN, j / 40, j % 40, smem);
    else if ((j -= 640) < 24) transpose_item(p.w_uq + (size_t)layer * 256 * 384, p.q_norm + layer * 256, 0, wt_ptr(p, layer, WT_UQ), 256, 384, j / 6, j % 6, smem);
    else if ((j -= 24) < 16) transpose_item(p.w_ukv + (size_t)layer * 128 * 512, p.kv_norm + layer * 128, 0, wt_ptr(p, layer, WT_UKV), 128, 512, j / 8, j % 8, smem);
    else if ((j -= 16) < 256) transpose_item(p.w_out + (size_t)layer * 1024 * 1024, p.ssd_norm + layer * 512, 512, wt_ptr(p, layer, WT_OUT), 1024, 1024, j / 16, j % 16, smem);
    else if ((j -= 256) < 1024) transpose_item(p.w_ff1 + (size_t)layer * 1024 * 4096, nullptr, 0, wt_ptr(p, layer, WT_FF1), 1024, 4096, j / 64, j % 64, smem);
    else { j -= 1024; transpose_item(p.w_ff2 + (size_t)layer * 4096 * 1024, nullptr, 0, wt_ptr(p, layer, WT_FF2), 4096, 1024, j / 16, j % 16, smem); }
  }
}

DI void write_h_row(const float4 xv[4], float rstd, const float* g, const float* sh, const float* sc, bf16_t* hrow, int lane) {
#pragma unroll
  for (int i = 0; i < 4; ++i) {
    int col = lane * 4 + 256 * i;
    float4 gg = *(const float4*)(g + col), s1 = *(const float4*)(sc + col), s0 = *(const float4*)(sh + col);
    float a = xv[i].x * rstd * gg.x * (1.f + s1.x) + s0.x;
    float b = xv[i].y * rstd * gg.y * (1.f + s1.y) + s0.y;
    float c = xv[i].z * rstd * gg.z * (1.f + s1.z) + s0.z;
    float d = xv[i].w * rstd * gg.w * (1.f + s1.w) + s0.w;
    u32x2 o; o[0] = pack2(a, b); o[1] = pack2(c, d);
    *(u32x2*)(hrow + col) = o;
  }
}
DI float ssq4(const float4 v[4]) {
  float s = 0.f;
#pragma unroll
  for (int i = 0; i < 4; ++i) s += v[i].x * v[i].x + v[i].y * v[i].y + v[i].z * v[i].z + v[i].w * v[i].w;
  return s;
}
DI void load_bf_row(const bf16_t* r, int lane, float4 v[4]) {
#pragma unroll
  for (int i = 0; i < 4; ++i) {
    u32x2 t = *(const u32x2*)(r + lane * 4 + 256 * i);
    v[i] = make_float4(lo2f(t[0]), hi2f(t[0]), lo2f(t[1]), hi2f(t[1]));
  }
}

DI void phase_h0(const Params& p, int bid, int nb) {
  const int w = ltid() >> 6, lane = ltid() & 63;
  bf16_t* H = (bf16_t*)(p.ws + OFF_H);
  for (int row = bid * 4 + w; row < MT; row += nb * 4) {
    const float* xr = xin_row(p, 0, row);
    float4 xv[4];
#pragma unroll
    for (int i = 0; i < 4; ++i) xv[i] = *(const float4*)(xr + lane * 4 + 256 * i);
    float rstd = rsqrtf(wave_sum(ssq4(xv)) * (1.f / DM) + EPS);
    write_h_row(xv, rstd, p.g_pre_mix, mod_ptr(p, 0, row, 0), mod_ptr(p, 0, row, 1), H + (size_t)row * DM, lane);
  }
}

DI void phase_postmix(const Params& p, int layer, int bid, int nb) {
  const int w = ltid() >> 6, lane = ltid() & 63;
  const int M = layer == 0 ? MT : ML;
  bf16_t* H = (bf16_t*)(p.ws + OFF_H);
  const bf16_t* Y = (const bf16_t*)(p.ws + OFF_U);
  for (int row = bid * 4 + w; row < M; row += nb * 4) {
    float4 yv[4], xv[4];
    load_bf_row(Y + (size_t)row * DM, lane, yv);
    const float* xr = xin_row(p, layer, row);
#pragma unroll
    for (int i = 0; i < 4; ++i) xv[i] = *(const float4*)(xr + lane * 4 + 256 * i);
    float rstd = rsqrtf(wave_sum(ssq4(yv)) * (1.f / DM) + EPS);
    const float* g1 = mod_ptr(p, layer, row, 2);
    const float* gp = p.g_post_mix + layer * DM;
    float* xo = xst_row(p, row);
#pragma unroll
    for (int i = 0; i < 4; ++i) {
      int col = lane * 4 + 256 * i;
      float4 a = *(const float4*)(g1 + col), b = *(const float4*)(gp + col);
      xv[i].x += a.x * yv[i].x * rstd * b.x; xv[i].y += a.y * yv[i].y * rstd * b.y;
      xv[i].z += a.z * yv[i].z * rstd * b.z; xv[i].w += a.w * yv[i].w * rstd * b.w;
      *(float4*)(xo + col) = xv[i];
    }
    float rstd1 = rsqrtf(wave_sum(ssq4(xv)) * (1.f / DM) + EPS);
    write_h_row(xv, rstd1, p.g_pre_ffn + layer * DM, mod_ptr(p, layer, row, 3), mod_ptr(p, layer, row, 4), H + (size_t)row * DM, lane);
  }
}

DI void phase_postffn(const Params& p, int layer, int bid, int nb) {
  const int w = ltid() >> 6, lane = ltid() & 63;
  const int M = layer == 0 ? MT : ML;
  bf16_t* H = (bf16_t*)(p.ws + OFF_H);
  for (int row = bid * 4 + w; row < M; row += nb * 4) {
    float4 fv[4], xv[4];
    load_bf_row(H + (size_t)row * DM, lane, fv);
    float* xo = xst_row(p, row);
#pragma unroll
    for (int i = 0; i < 4; ++i) xv[i] = *(const float4*)(xo + lane * 4 + 256 * i);
    float rstd = rsqrtf(wave_sum(ssq4(fv)) * (1.f / DM) + EPS);
    const float* g2 = mod_ptr(p, layer, row, 5);
    const float* gp = p.g_post_ffn + layer * DM;
#pragma unroll
    for (int i = 0; i < 4; ++i) {
      int col = lane * 4 + 256 * i;
      float4 a = *(const float4*)(g2 + col), b = *(const float4*)(gp + col);
      xv[i].x += a.x * fv[i].x * rstd * b.x; xv[i].y += a.y * fv[i].y * rstd * b.y;
      xv[i].z += a.z * fv[i].z * rstd * b.z; xv[i].w += a.w * fv[i].w * rstd * b.w;
      *(float4*)(xo + col) = xv[i];
    }
    if (layer == 0) {
      float rstd1 = rsqrtf(wave_sum(ssq4(xv)) * (1.f / DM) + EPS);
      write_h_row(xv, rstd1, p.g_pre_mix + DM, mod_ptr(p, 1, row, 0), mod_ptr(p, 1, row, 1), H + (size_t)row * DM, lane);
    }
  }
}

DI void phase_prep(const Params& p, int layer, int bid, int nb) {
  const int w = ltid() >> 6, lane = ltid() & 63;
  const bf16_t* U = (const bf16_t*)(p.ws + OFF_U);
  float* DT = (float*)(p.ws + OFF_DT);
  float* RS = (float*)(p.ws + OFF_RSTD);
  bf16_t* KB = (bf16_t*)(p.ws + OFF_KB);
  bf16_t* XBC = (bf16_t*)(p.ws + OFF_XBC);
  bf16_t* YM = (bf16_t*)(p.ws + OFF_H);
  const float* scw = p.sc_w + layer * 3 * 256;
  const float* cw = p.ssd_cw + layer * 3 * 768;
  const float* cb = p.ssd_cb + layer * 768;
  for (int row = bid * 4 + w; row < MT; row += nb * 4) {
    int b, t, L, pos;
    bool lat = row < ML;
    if (lat) { b = row >> 12; t = row & 4095; L = SEQ; pos = t + CTX; }
    else { int rr = row - ML; b = rr >> 8; t = rr & 255; L = CTX; pos = t; }
    const bf16_t* u0 = U + (size_t)row * DIN;
    const bool hp = t > 0, hn = t < L - 1;
    const bf16_t* um = u0 - DIN;
    const bf16_t* up = u0 + DIN;
    {
      u32x2 v = *(const u32x2*)(u0 + lane * 4);
      float a = lo2f(v[0]), bq = hi2f(v[0]), c = lo2f(v[1]), d = hi2f(v[1]);
      float ss = wave_sum(a * a + bq * bq + c * c + d * d);
      float s2 = 0.f;
      if (lane < 32) {
        u32x2 v2 = *(const u32x2*)(u0 + U_CKV + lane * 4);
        float e = lo2f(v2[0]), f = hi2f(v2[0]), g = lo2f(v2[1]), h = hi2f(v2[1]);
        s2 = e * e + f * f + g * g + h * h;
      }
      s2 = wave_sum(s2);
      if (lane == 0) { RS[row * 2] = rsqrtf(ss * (1.f / 256) + EPS); RS[row * 2 + 1] = rsqrtf(s2 * (1.f / 128) + EPS); }
    }
    {
      float v = bf2f(u0[U_KR + (lane & 31)]);
      float partner = __shfl_xor(v, 8);
      float o = v;
      if (lat) {
        int grp = (lane & 31) >> 3, i = lane & 7;
        float posf = grp < 2 ? (float)(t >> 6) : (float)(t & 63);
        float invf = exp2f(-(float)(2 * i) * (13.287712379549449f / 16.f));
        float ang = posf * invf;
        float rev = ang * 0.15915494309189535f;
        float cs = __builtin_amdgcn_cosf(rev), sn = __builtin_amdgcn_sinf(rev);
        o = (grp & 1) ? v * cs + partner * sn : v * cs - partner * sn;
      }
      if (lane < 32) {
        bf16_t ob = f2bf(o);
#pragma unroll
        for (int hd = 0; hd < 4; ++hd) KB[((size_t)(b * 4 + hd) * LK + pos) * 96 + 64 + lane] = ob;
      }
    }
    {
      int c = lane * 4;
      float acc[4] = {0.f, 0.f, 0.f, 0.f};
#pragma unroll
      for (int k = 0; k < 3; ++k) {
        const bf16_t* ur = k == 0 ? um : (k == 1 ? u0 : up);
        bool ok = k == 0 ? hp : (k == 1 ? true : hn);
        if (ok) {
          u32x2 gc = *(const u32x2*)(ur + U_GC + c), vv = *(const u32x2*)(ur + U_VAL + c);
          float4 wk = *(const float4*)(scw + k * 256 + c);
          acc[0] += wk.x * lo2f(gc[0]) * lo2f(vv[0]); acc[1] += wk.y * hi2f(gc[0]) * hi2f(vv[0]);
          acc[2] += wk.z * lo2f(gc[1]) * lo2f(vv[1]); acc[3] += wk.w * hi2f(gc[1]) * hi2f(vv[1]);
        }
      }
      u32x2 gb = *(const u32x2*)(u0 + U_GB + c);
      u32x2 o; o[0] = pack2(lo2f(gb[0]) * acc[0], hi2f(gb[0]) * acc[1]); o[1] = pack2(lo2f(gb[1]) * acc[2], hi2f(gb[1]) * acc[3]);
      *(u32x2*)(YM + (size_t)row * DM + 256 + c) = o;
    }
#pragma unroll
    for (int i = 0; i < 3; ++i) {
      int c = lane * 4 + 256 * i;
      float4 bias = *(const float4*)(cb + c);
      float acc[4] = {bias.x, bias.y, bias.z, bias.w};
#pragma unroll
      for (int k = 0; k < 3; ++k) {
        const bf16_t* ur = k == 0 ? um : (k == 1 ? u0 : up);
        bool ok = k == 0 ? hp : (k == 1 ? true : hn);
        if (ok) {
          u32x2 vv = *(const u32x2*)(ur + U_XBC + c);
          float4 wk = *(const float4*)(cw + k * 768 + c);
          acc[0] += wk.x * lo2f(vv[0]); acc[1] += wk.y * hi2f(vv[0]); acc[2] += wk.z * lo2f(vv[1]); acc[3] += wk.w * hi2f(vv[1]);
        }
      }
      u32x2 o; o[0] = pack2(silu_f(acc[0]), silu_f(acc[1])); o[1] = pack2(silu_f(acc[2]), silu_f(acc[3]));
      *(u32x2*)(XBC + (size_t)row * 768 + c) = o;
    }
    if (lane < 16) {
      float v = DT[(size_t)row * 16 + lane] + p.dt_bias[layer * 16 + lane];
      float sp = fmaxf(v, 0.f) + log1pf(__expf(-fabsf(v)));
      DT[(size_t)row * 16 + lane] = sp;
    }
  }
}

DI void phase_ssdnorm(const Params& p, int layer, int bid, int nb) {
  const int w = ltid() >> 6, lane = ltid() & 63;
  const int M = layer == 0 ? MT : ML;
  bf16_t* YM = (bf16_t*)(p.ws + OFF_H);
  const float* SSQ = (const float*)(p.ws + OFF_SSQ);
  const float* ng = p.ssd_norm + layer * 512;
  for (int row = bid * 4 + w; row < M; row += nb * 4) {
    int g = lane >> 5;
    float4 s = *(const float4*)(SSQ + (size_t)row * 8 + g * 4);
    float rstd = rsqrtf((s.x + s.y + s.z + s.w) * (1.f / 256) + EPS);
    bf16_t* ptr = YM + (size_t)row * DM + 512 + lane * 8;
    u32x4 v = *(const u32x4*)ptr;
    float4 g0 = *(const float4*)(ng + lane * 8), g1 = *(const float4*)(ng + lane * 8 + 4);
    u32x4 o;
    o[0] = pack2(lo2f(v[0]) * rstd * g0.x, hi2f(v[0]) * rstd * g0.y);
    o[1] = pack2(lo2f(v[1]) * rstd * g0.z, hi2f(v[1]) * rstd * g0.w);
    o[2] = pack2(lo2f(v[2]) * rstd * g1.x, hi2f(v[2]) * rstd * g1.y);
    o[3] = pack2(lo2f(v[3]) * rstd * g1.z, hi2f(v[3]) * rstd * g1.w);
    *(u32x4*)ptr = o;
  }
}

constexpr int GST = 80;
constexpr int GBUF = 2 * 128 * GST;
template <bool GN, class Epi>
DI void gemm_tile(const bf16_t* __restrict__ A, int lda, const bf16_t* __restrict__ Bt, int K, int row0, int col0, char* smem, Epi epi, const float* __restrict__ ssq = nullptr) {
  bf16_t* S0 = (bf16_t*)smem;
  const int tid = ltid(), wid = tid >> 6, lane = tid & 63, wr = wid >> 1, wc = wid & 1, fr = lane & 15, fq = lane >> 4;
  f32x4 acc[4][4];
#pragma unroll
  for (int m = 0; m < 4; ++m)
#pragma unroll
    for (int n = 0; n < 4; ++n) acc[m][n] = f32x4{0.f, 0.f, 0.f, 0.f};
  u32x4 ra[4], rb[4];
  const int sr = tid >> 3, sp = tid & 7;
  const bf16_t* ga = A + (size_t)(row0 + sr) * lda + sp * 8;
  const bf16_t* gb = Bt + (size_t)(col0 + sr) * K + sp * 8;
  auto gload = [&](int k0) {
#pragma unroll
    for (int i = 0; i < 4; ++i) {
      ra[i] = *(const u32x4*)(ga + (size_t)(32 * i) * lda + k0);
      rb[i] = *(const u32x4*)(gb + (size_t)(32 * i) * K + k0);
    }
  };
  gload(0);
  float gs[4][2];
  if (GN) {
#pragma unroll
    for (int i = 0; i < 4; ++i) {
      const float4 s0 = *(const float4*)(ssq + (size_t)(row0 + sr + 32 * i) * 8), s1 = *(const float4*)(ssq + (size_t)(row0 + sr + 32 * i) * 8 + 4);
      gs[i][0] = rsqrtf((s0.x + s0.y + s0.z + s0.w) * (1.f / 256) + EPS);
      gs[i][1] = rsqrtf((s1.x + s1.y + s1.z + s1.w) * (1.f / 256) + EPS);
    }
  }
  auto swrite = [&](int kt) {
    if (GN && kt >= 8) {
      const int g = (kt - 8) >> 2;
#pragma unroll
      for (int i = 0; i < 4; ++i) {
        const float sc = g ? gs[i][1] : gs[i][0];
#pragma unroll
        for (int jj = 0; jj < 4; ++jj) ra[i][jj] = pack2(lo2f(ra[i][jj]) * sc, hi2f(ra[i][jj]) * sc);
      }
    }
    bf16_t* As = S0 + (kt & 1) * GBUF;
    bf16_t* Bs = As + 128 * GST;
#pragma unroll
    for (int i = 0; i < 4; ++i) {
      *(u32x4*)(As + (sr + 32 * i) * GST + sp * 8) = ra[i];
      *(u32x4*)(Bs + (sr + 32 * i) * GST + sp * 8) = rb[i];
    }
  };
  const int KT = K / 64;
  swrite(0);
  if (KT > 1) gload(64);
  __syncthreads();
  for (int kt = 0; kt < KT; ++kt) {
    const bf16_t* As = S0 + (kt & 1) * GBUF;
    const bf16_t* Bs = As + 128 * GST;
#pragma unroll
    for (int ks = 0; ks < 2; ++ks) {
      bf16x8 af[4], bfr[4];
#pragma unroll
      for (int m = 0; m < 4; ++m) af[m] = *(const bf16x8*)(As + (wr * 64 + m * 16 + fr) * GST + ks * 32 + fq * 8);
#pragma unroll
      for (int n = 0; n < 4; ++n) bfr[n] = *(const bf16x8*)(Bs + (wc * 64 + n * 16 + fr) * GST + ks * 32 + fq * 8);
#pragma unroll
      for (int m = 0; m < 4; ++m)
#pragma unroll
        for (int n = 0; n < 4; ++n) acc[m][n] = MFMA16(bfr[n], af[m], acc[m][n]);
      if (ks == 0 && kt + 1 < KT) {
        swrite(kt + 1);
        if (kt + 2 < KT) gload((kt + 2) * 64);
      }
    }
    __syncthreads();
  }
#pragma unroll
  for (int m = 0; m < 4; ++m)
#pragma unroll
    for (int n = 0; n < 4; ++n) epi(row0 + wr * 64 + m * 16 + fr, col0 + wc * 64 + n * 16 + fq * 4, acc[m][n]);
}

template <class Epi>
DI void gemm_tile_glds(const bf16_t* __restrict__ A, int lda, const bf16_t* __restrict__ Bt, int K, int row0, int col0, char* smem, Epi epi) {
  const int tid = ltid(), wid = tid >> 6, lane = tid & 63, wr = wid >> 1, wc = wid & 1, fr = lane & 15, fq = lane >> 4;
  f32x4 acc[4][4];
#pragma unroll
  for (int m = 0; m < 4; ++m)
#pragma unroll
    for (int n = 0; n < 4; ++n) acc[m][n] = f32x4{0.f, 0.f, 0.f, 0.f};
  const int crow = tid >> 3, cslot = tid & 7, cpart = cslot ^ (crow & 7);
  const bf16_t* ga = A + (size_t)(row0 + crow) * lda + cpart * 8;
  const bf16_t* gb = Bt + (size_t)(col0 + crow) * K + cpart * 8;
  auto issue = [&](int kt, int stage) {
    char* sa = smem + stage * 32768 + tid * 16;
#pragma unroll
    for (int i = 0; i < 4; ++i) {
      __builtin_amdgcn_global_load_lds((const unsigned*)(ga + (size_t)(32 * i) * lda + kt * 64), (__attribute__((address_space(3))) unsigned*)(sa + i * 4096), 16, 0, 0);
      __builtin_amdgcn_global_load_lds((const unsigned*)(gb + (size_t)(32 * i) * K + kt * 64), (__attribute__((address_space(3))) unsigned*)(sa + 16384 + i * 4096), 16, 0, 0);
    }
  };
  const int KT = K / 64;
  issue(0, 0);
  asm volatile("s_waitcnt vmcnt(0)" ::: "memory");
  __syncthreads();
  const int sw = fr & 7;
  for (int kt = 0; kt < KT; ++kt) {
    if (kt + 1 < KT) issue(kt + 1, (kt + 1) & 1);
    const char* As = smem + (kt & 1) * 32768;
    const char* Bs = As + 16384;
#pragma unroll
    for (int ks = 0; ks < 2; ++ks) {
      bf16x8 af[4], bfr[4];
      const int so = ((ks * 4 + fq) ^ sw) * 16;
#pragma unroll
      for (int m = 0; m < 4; ++m) af[m] = *(const bf16x8*)(As + (wr * 64 + m * 16 + fr) * 128 + so);
#pragma unroll
      for (int n = 0; n < 4; ++n) bfr[n] = *(const bf16x8*)(Bs + (wc * 64 + n * 16 + fr) * 128 + so);
#pragma unroll
      for (int m = 0; m < 4; ++m)
#pragma unroll
        for (int n = 0; n < 4; ++n) acc[m][n] = MFMA16(bfr[n], af[m], acc[m][n]);
    }
    asm volatile("s_waitcnt vmcnt(0)" ::: "memory");
    __syncthreads();
  }
#pragma unroll
  for (int m = 0; m < 4; ++m)
#pragma unroll
    for (int n = 0; n < 4; ++n) epi(row0 + wr * 64 + m * 16 + fr, col0 + wc * 64 + n * 16 + fq * 4, acc[m][n]);
}

struct EpiBF {
  bf16_t* out; int ldo;
  DI void operator()(int row, int col, const f32x4& a) const {
    u32x2 o; o[0] = pack2(a[0], a[1]); o[1] = pack2(a[2], a[3]);
    *(u32x2*)(out + (size_t)row * ldo + col) = o;
  }
};
struct EpiRelu2 {
  bf16_t* out; int ldo;
  DI void operator()(int row, int col, const f32x4& a) const {
    float r0 = fmaxf(a[0], 0.f), r1 = fmaxf(a[1], 0.f), r2 = fmaxf(a[2], 0.f), r3 = fmaxf(a[3], 0.f);
    u32x2 o; o[0] = pack2(r0 * r0, r1 * r1); o[1] = pack2(r2 * r2, r3 * r3);
    *(u32x2*)(out + (size_t)row * ldo + col) = o;
  }
};
struct EpiU {
  bf16_t* u; float* dt;
  DI void operator()(int row, int col, const f32x4& a) const {
    if (col < DIN) {
      u32x2 o; o[0] = pack2(a[0], a[1]); o[1] = pack2(a[2], a[3]);
      *(u32x2*)(u + (size_t)row * DIN + col) = o;
      if (col >= U_DT) *(float4*)(dt + (size_t)row * 16 + col - U_DT) = make_float4(a[0], a[1], a[2], a[3]);
    }
  }
};
struct EpiQ {
  bf16_t* q; const float* rs;
  DI void operator()(int row, int col, const f32x4& a) const {
    const float r = rs[row * 2];
    u32x2 o; o[0] = pack2(a[0] * r, a[1] * r); o[1] = pack2(a[2] * r, a[3] * r);
    *(u32x2*)(q + (size_t)row * 384 + col) = o;
  }
};
struct EpiKV {
  bf16_t* kb; bf16_t* vt; const float* rs;
  DI void operator()(int row, int col, const f32x4& a) const {
    int b, pos;
    if (row < ML) { b = row >> 12; pos = (row & 4095) + CTX; } else { int rr = row - ML; b = rr >> 8; pos = rr & 255; }
    const int head = col >> 7, d = col & 127;
    const float r = rs[row * 2 + 1];
    if (d < 64) {
      u32x2 o; o[0] = pack2(a[0] * r, a[1] * r); o[1] = pack2(a[2] * r, a[3] * r);
      *(u32x2*)(kb + ((size_t)(b * 4 + head) * LK + pos) * 96 + d) = o;
    } else {
#pragma unroll
      for (int j = 0; j < 4; ++j) vt[((size_t)(b * 4 + head) * 64 + (d - 64 + j)) * LK + pos] = f2bf(a[j] * r);
    }
  }
};

DI void phase_inproj(const Params& p, int layer, int bid, int nb, char* smem) {
  constexpr int NT = DINP / 128;
  EpiU epi{(bf16_t*)(p.ws + OFF_U), (float*)(p.ws + OFF_DT)};
  for (int rep = 0; rep < REP_GEMM; ++rep)
  for (int it = bid; it < (MT / 128) * NT; it += nb)
    gemm_tile_glds((const bf16_t*)(p.ws + OFF_H), DM, wt_ptr(p, layer, WT_IN), 1024, (it / NT) * 128, (it % NT) * 128, smem, epi);
}
DI void phase_wout(const Params& p, int layer, int bid, int nb, char* smem) {
  const int M = layer == 0 ? MT : ML;
  EpiBF epi{(bf16_t*)(p.ws + OFF_U), DM};
  for (int rep = 0; rep < REP_GEMM; ++rep)
  for (int it = bid; it < (M / 128) * 8; it += nb)
    gemm_tile<true>((const bf16_t*)(p.ws + OFF_H), DM, wt_ptr(p, layer, WT_OUT), 1024, (it / 8) * 128, (it % 8) * 128, smem, epi, (const float*)(p.ws + OFF_SSQ));
}
DI void phase_ff1(const Params& p, int layer, int bid, int nb, char* smem) {
  const int M = layer == 0 ? MT : ML;
  EpiRelu2 epi{(bf16_t*)(p.ws + OFF_F1), DFF};
  for (int rep = 0; rep < REP_GEMM; ++rep)
  for (int it = bid; it < (M / 128) * 32; it += nb)
    gemm_tile_glds((const bf16_t*)(p.ws + OFF_H), DM, wt_ptr(p, layer, WT_FF1), 1024, (it / 32) * 128, (it % 32) * 128, smem, epi);
}
DI void phase_ff2(const Params& p, int layer, int bid, int nb, char* smem) {
  const int M = layer == 0 ? MT : ML;
  EpiBF epi{(bf16_t*)(p.ws + OFF_H), DM};
  for (int rep = 0; rep < REP_GEMM; ++rep)
  for (int it = bid; it < (M / 128) * 8; it += nb)
    gemm_tile_glds((const bf16_t*)(p.ws + OFF_F1), DFF, wt_ptr(p, layer, WT_FF2), 4096, (it / 8) * 128, (it % 8) * 128, smem, epi);
}

DI int chunk_row0(int b, int tc) { return tc < 2 ? ML + b * CTX + tc * 128 : b * SEQ + (tc - 2) * 128; }
constexpr int BST = 72;
constexpr int TST = 136;
DI void load_tile_T(bf16_t* dst, const bf16_t* __restrict__ src, int ldg) {
  const int tid = ltid();
#pragma unroll
  for (int i = 0; i < 4; ++i) {
    int c = tid + 256 * i, tok = c & 127, pc = c >> 7;
    u32x4 v = *(const u32x4*)(src + (size_t)tok * ldg + pc * 8);
#pragma unroll
    for (int j = 0; j < 4; ++j) {
      dst[(pc * 8 + 2 * j) * TST + tok] = (bf16_t)(v[j] & 0xffffu);
      dst[(pc * 8 + 2 * j + 1) * TST + tok] = (bf16_t)(v[j] >> 16);
    }
  }
}
DI void chunk_scan(const Params& p, int layer, int row0, int h, float* csf, float* csb, float* dtF, float* dtB, float* tot, float*  ) {
  const int tid = ltid(), w = tid >> 6, lane = tid & 63;
  const float* DT = (const float*)(p.ws + OFF_DT);
  float v;
  if (tid < 128) {
    const float dt = DT[(size_t)(row0 + tid) * 16 + h];
    v = dt * -__expf(p.a_log[layer * 16 + h]);
    dtF[tid] = dt;
  } else {
    const int e = 255 - tid;
    const float dt = DT[(size_t)(row0 + e) * 16 + 8 + h];
    v = dt * -__expf(p.a_log[layer * 16 + 8 + h]);
    dtB[e] = dt;
  }
#pragma unroll
  for (int o = 1; o < 64; o <<= 1) { const float t = __shfl_up(v, o); if (lane >= o) v += t; }
  if (lane == 63) tot[w] = v;
  __syncthreads();
  if (w == 1) v += tot[0];
  if (w == 3) v += tot[2];
  if (tid < 128) csf[tid] = v; else csb[255 - tid] = v;
  __syncthreads();
}

DI void ssd_state_item(const Params& p, int layer, int b, int tc, int h, char* smem) {
  bf16_t* XT = (bf16_t*)smem;
  bf16_t* BT = XT + 64 * TST;
  float* csf = (float*)(BT + 64 * TST);
  float* csb = csf + 128; float* dtF = csb + 128; float* dtB = dtF + 128; float* laF = dtB + 128; float* laB = laF + 128;
  const int tid = ltid(), w = tid >> 6, lane = tid & 63, r = lane & 31, hh = lane >> 5;
  const int row0 = chunk_row0(b, tc);
  const bf16_t* XBC = (const bf16_t*)(p.ws + OFF_XBC);
  load_tile_T(XT, XBC + (size_t)row0 * 768 + h * 64, 768);
  load_tile_T(BT, XBC + (size_t)row0 * 768 + 512 + (h >> 2) * 64, 768);
  chunk_scan(p, layer, row0, h, csf, csb, dtF, dtB, laF, laB);
  __syncthreads();
  if (tid < 128) laF[tid] = dtF[tid] * __expf(csf[127] - csf[tid]);
  else { int t = tid - 128; laB[t] = dtB[t] * __expf(csb[0] - csb[t]); }
  __syncthreads();
  const int d = w >> 1, pt = w & 1;
  const float* wv = d == 0 ? laF : laB;
  f32x16 acc[2];
#pragma unroll
  for (int i = 0; i < 16; ++i) { acc[0][i] = 0.f; acc[1][i] = 0.f; }
#pragma unroll
  for (int s = 0; s < 8; ++s) {
    int l0 = 16 * s + 8 * hh;
    u32x4 xa = *(const u32x4*)(XT + (32 * pt + r) * TST + l0);
    u32x4 sa;
#pragma unroll
    for (int j = 0; j < 4; ++j) sa[j] = pack2(lo2f(xa[j]) * wv[l0 + 2 * j], hi2f(xa[j]) * wv[l0 + 2 * j + 1]);
    bf16x8 af = __builtin_bit_cast(bf16x8, sa);
#pragma unroll
    for (int nt = 0; nt < 2; ++nt) {
      bf16x8 bfr = *(const bf16x8*)(BT + (32 * nt + r) * TST + l0);
      acc[nt] = MFMA32(af, bfr, acc[nt]);
    }
  }
  bf16_t* S = (bf16_t*)(p.ws + OFF_SST) + ((((size_t)d * NB + b) * NCH + tc) * 8 + h) * 4096;
#pragma unroll
  for (int nt = 0; nt < 2; ++nt)
#pragma unroll
    for (int i = 0; i < 16; ++i) S[(32 * pt + crow(i, hh)) * 64 + 32 * nt + r] = f2bf(acc[nt][i]);
  if (tid == 0) {
    float* TD = (float*)(p.ws + OFF_TDEC);
    TD[((0 * NB + b) * NCH + tc) * 8 + h] = __expf(csf[127]);
    TD[((1 * NB + b) * NCH + tc) * 8 + h] = __expf(csb[0]);
  }
  __syncthreads();
}

DI void ssd_pass_item(const Params& p, int it) {
  const int e = it * 256 + ltid();
  const int pn2 = e & 2047, h = (e >> 11) & 7, b = (e >> 14) & 3, d = e >> 16;
  unsigned* S = (unsigned*)(p.ws + OFF_SST);
  const float* TD = (const float*)(p.ws + OFF_TDEC);
  unsigned sv[NCH]; float T[NCH];
#pragma unroll
  for (int i = 0; i < NCH; ++i) {
    int tc = d == 0 ? i : (i < 2 ? 1 - i : NCH + 1 - i);
    sv[i] = S[(((size_t)(d * NB + b) * NCH + tc) * 8 + h) * 2048 + pn2];
    T[i] = TD[((d * NB + b) * NCH + tc) * 8 + h];
  }
  float h0 = 0.f, h1 = 0.f;
#pragma unroll
  for (int i = 0; i < NCH; ++i) {
    int tc = d == 0 ? i : (i < 2 ? 1 - i : NCH + 1 - i);
    S[(((size_t)(d * NB + b) * NCH + tc) * 8 + h) * 2048 + pn2] = pack2(h0, h1);
    h0 = T[i] * h0 + lo2f(sv[i]); h1 = T[i] * h1 + hi2f(sv[i]);
  }
}

DI void ssd_out_item(const Params& p, int layer, int b, int tc, int h, char* smem) {
  bf16_t* XT = (bf16_t*)smem;
  bf16_t* Bs = XT + 64 * TST;
  float* csf = (float*)(Bs + 128 * BST);
  float* csb = csf + 128; float* dtF = csb + 128; float* dtB = dtF + 128; float* laF = dtB + 128; float* laB = laF + 128;
  const int tid = ltid(), w = tid >> 6, lane = tid & 63, r = lane & 31, hh = lane >> 5;
  const int row0 = chunk_row0(b, tc), g = h >> 2;
  const bf16_t* XBC = (const bf16_t*)(p.ws + OFF_XBC);
  load_tile_T(XT, XBC + (size_t)row0 * 768 + h * 64, 768);
#pragma unroll
  for (int i = 0; i < 4; ++i) {
    int c = tid + 256 * i, tok = c >> 3, part = c & 7;
    *(u32x4*)(Bs + tok * BST + part * 8) = *(const u32x4*)(XBC + (size_t)(row0 + tok) * 768 + 512 + g * 64 + part * 8);
  }
  const int l = 32 * w + r;
  bf16x8 cf[4];
#pragma unroll
  for (int ks = 0; ks < 4; ++ks) cf[ks] = *(const bf16x8*)(XBC + (size_t)(row0 + l) * 768 + 640 + g * 64 + 16 * ks + 8 * hh);
  chunk_scan(p, layer, row0, h, csf, csb, dtF, dtB, laF, laB);
  const float csf_l = csf[l], csb_l = csb[l];
  f32x16 yacc[2];
#pragma unroll
  for (int i = 0; i < 16; ++i) { yacc[0][i] = 0.f; yacc[1][i] = 0.f; }
#pragma unroll
  for (int st = 0; st < 4; ++st) {
    f32x16 gacc;
#pragma unroll
    for (int i = 0; i < 16; ++i) gacc[i] = 0.f;
#pragma unroll
    for (int ks = 0; ks < 4; ++ks) {
      bf16x8 af = *(const bf16x8*)(Bs + (32 * st + r) * BST + 16 * ks + 8 * hh);
      gacc = MFMA32(af, cf[ks], gacc);
    }
#pragma unroll
    for (int i = 0; i < 16; ++i) {
      int s = 32 * st + crow(i, hh);
      float f;
      if (s < l) f = __expf(csf_l - csf[s]) * dtF[s];
      else if (s > l) f = __expf(csb_l - csb[s]) * dtB[s];
      else f = dtF[s] + dtB[s];
      gacc[i] *= f;
    }
#pragma unroll
    for (int s2 = 0; s2 < 2; ++s2) {
      bf16x8 mf = pack8(gacc, s2);
      int sb = 32 * st + 16 * s2 + 4 * hh;
#pragma unroll
      for (int pt = 0; pt < 2; ++pt) {
        u32x2 lo = *(const u32x2*)(XT + (32 * pt + r) * TST + sb);
        u32x2 hi = *(const u32x2*)(XT + (32 * pt + r) * TST + sb + 8);
        u32x4 xa; xa[0] = lo[0]; xa[1] = lo[1]; xa[2] = hi[0]; xa[3] = hi[1];
        yacc[pt] = MFMA32(__builtin_bit_cast(bf16x8, xa), mf, yacc[pt]);
      }
    }
  }
#pragma unroll
  for (int d = 0; d < 2; ++d) {
    const bf16_t* Hs = (const bf16_t*)(p.ws + OFF_SST) + ((((size_t)d * NB + b) * NCH + tc) * 8 + h) * 4096;
    const float e = __expf(d == 0 ? csf_l : csb_l);
#pragma unroll
    for (int pt = 0; pt < 2; ++pt) {
      f32x16 t;
#pragma unroll
      for (int i = 0; i < 16; ++i) t[i] = 0.f;
#pragma unroll
      for (int ks = 0; ks < 4; ++ks) {
        bf16x8 af = *(const bf16x8*)(Hs + (32 * pt + r) * 64 + 16 * ks + 8 * hh);
        t = MFMA32(af, cf[ks], t);
      }
#pragma unroll
      for (int i = 0; i < 16; ++i) yacc[pt][i] += e * t[i];
    }
  }
  const int row = row0 + l;
  const float Dh = p.ssd_d[layer * 8 + h];
  const bf16_t* U = (const bf16_t*)(p.ws + OFF_U);
  bf16_t* YM = (bf16_t*)(p.ws + OFF_H);
  float ssq = 0.f;
#pragma unroll
  for (int pt = 0; pt < 2; ++pt)
#pragma unroll
    for (int q = 0; q < 4; ++q) {
      int pp = 32 * pt + 8 * q + 4 * hh;
      u32x2 xv = *(const u32x2*)(XBC + (size_t)row * 768 + h * 64 + pp);
      u32x2 zv = *(const u32x2*)(U + (size_t)row * DIN + U_Z + h * 64 + pp);
      float y0 = (yacc[pt][4 * q + 0] + Dh * lo2f(xv[0])) * silu_f(lo2f(zv[0]));
      float y1 = (yacc[pt][4 * q + 1] + Dh * hi2f(xv[0])) * silu_f(hi2f(zv[0]));
      float y2 = (yacc[pt][4 * q + 2] + Dh * lo2f(xv[1])) * silu_f(lo2f(zv[1]));
      float y3 = (yacc[pt][4 * q + 3] + Dh * hi2f(xv[1])) * silu_f(hi2f(zv[1]));
      u32x2 o; o[0] = pack2(y0, y1); o[1] = pack2(y2, y3);
      float r0 = lo2f(o[0]), r1 = hi2f(o[0]), r2 = lo2f(o[1]), r3 = hi2f(o[1]);
      ssq += r0 * r0 + r1 * r1 + r2 * r2 + r3 * r3;
      *(u32x2*)(YM + (size_t)row * DM + 512 + h * 64 + pp) = o;
    }
  ssq += __shfl_xor(ssq, 32);
  if (hh == 0) ((float*)(p.ws + OFF_SSQ))[(size_t)row * 8 + h] = ssq;
  __syncthreads();
}

constexpr int KST = 104;
constexpr int VST = 68;
DI void attn_item(const Params& p, int b, int head, int qrow0, int t0, bool lat, int nkeys, char* smem) {
  bf16_t* Ks = (bf16_t*)smem;
  bf16_t* Vs = Ks + 64 * KST;
  const int tid = ltid(), w = tid >> 6, lane = tid & 63, r = lane & 31, hh = lane >> 5;
  const bf16_t* QB = (const bf16_t*)(p.ws + OFF_QB);
  const bf16_t* KB = (const bf16_t*)(p.ws + OFF_KB) + (size_t)(b * 4 + head) * LK * 96;
  const bf16_t* VT = (const bf16_t*)(p.ws + OFF_VT) + (size_t)(b * 4 + head) * 64 * LK;
  const float qscale = 0.10206207261596575f * 1.4426950408889634f;
  const int qrow = qrow0 + w * 32 + r;
  const int t = t0 + w * 32 + r;
  bf16x8 qf[6];
  {
    const bf16_t* src = QB + (size_t)qrow * 384 + head * 96;
#pragma unroll
    for (int s = 0; s < 4; ++s) {
      u32x4 v = *(const u32x4*)(src + 16 * s + 8 * hh);
      u32x4 o;
#pragma unroll
      for (int j = 0; j < 4; ++j) o[j] = pack2(lo2f(v[j]) * qscale, hi2f(v[j]) * qscale);
      qf[s] = __builtin_bit_cast(bf16x8, o);
    }
#pragma unroll
    for (int s = 4; s < 6; ++s) {
      u32x4 va = *(const u32x4*)(src + 16 * s), vb = *(const u32x4*)(src + 16 * s + 8);
      float posf = s == 4 ? (float)(t >> 6) : (float)(t & 63);
      float o[8];
#pragma unroll
      for (int j = 0; j < 8; ++j) {
        float a = (j & 1) ? hi2f(va[j >> 1]) : lo2f(va[j >> 1]);
        float bb = (j & 1) ? hi2f(vb[j >> 1]) : lo2f(vb[j >> 1]);
        float res;
        if (lat) {
          float invf = exp2f(-(float)(2 * j) * (13.287712379549449f / 16.f));
          float rev = posf * invf * 0.15915494309189535f;
          float cs = __builtin_amdgcn_cosf(rev), sn = __builtin_amdgcn_sinf(rev);
          res = hh == 0 ? a * cs - bb * sn : bb * cs + a * sn;
        } else res = hh == 0 ? a : bb;
        o[j] = res * qscale;
      }
      u32x4 ov; ov[0] = pack2(o[0], o[1]); ov[1] = pack2(o[2], o[3]); ov[2] = pack2(o[4], o[5]); ov[3] = pack2(o[6], o[7]);
      qf[s] = __builtin_bit_cast(bf16x8, ov);
    }
  }
  f32x16 oacc[2];
#pragma unroll
  for (int i = 0; i < 16; ++i) { oacc[0][i] = 0.f; oacc[1][i] = 0.f; }
  float m = -1e30f, lsum = 0.f;
  u32x4 rk[3], rv[2];
  auto gload = [&](int key0) {
#pragma unroll
    for (int i = 0; i < 3; ++i) rk[i] = *(const u32x4*)(KB + (size_t)key0 * 96 + (tid + 256 * i) * 8);
#pragma unroll
    for (int i = 0; i < 2; ++i) { int c = tid + 256 * i; rv[i] = *(const u32x4*)(VT + (size_t)(c >> 3) * LK + key0 + (c & 7) * 8); }
  };
  gload(0);
  const int NT = nkeys / 64;
  for (int kt = 0; kt < NT; ++kt) {
#pragma unroll
    for (int i = 0; i < 3; ++i) { int c = tid + 256 * i; *(u32x4*)(Ks + (c / 12) * KST + (c % 12) * 8) = rk[i]; }
#pragma unroll
    for (int i = 0; i < 2; ++i) {
      int c = tid + 256 * i;
      bf16_t* d = Vs + (c >> 3) * VST + (c & 7) * 8;
      u32x2 a; a[0] = rv[i][0]; a[1] = rv[i][1];
      u32x2 bq; bq[0] = rv[i][2]; bq[1] = rv[i][3];
      *(u32x2*)d = a; *(u32x2*)(d + 4) = bq;
    }
    __syncthreads();
    if (kt + 1 < NT) gload((kt + 1) * 64);
    f32x16 sacc[2];
#pragma unroll
    for (int i = 0; i < 16; ++i) { sacc[0][i] = 0.f; sacc[1][i] = 0.f; }
#pragma unroll
    for (int s = 0; s < 6; ++s)
#pragma unroll
      for (int k2 = 0; k2 < 2; ++k2) {
        bf16x8 af = *(const bf16x8*)(Ks + (32 * k2 + r) * KST + 16 * s + 8 * hh);
        sacc[k2] = MFMA32(af, qf[s], sacc[k2]);
      }
    float mx = sacc[0][0];
#pragma unroll
    for (int i = 0; i < 16; ++i) { mx = fmaxf(mx, sacc[0][i]); mx = fmaxf(mx, sacc[1][i]); }
    mx = fmaxf(mx, __shfl_xor(mx, 32));
    const float mn = fmaxf(m, mx);
    const float alpha = __builtin_amdgcn_exp2f(m - mn);
    m = mn;
    float ps = 0.f;
#pragma unroll
    for (int i = 0; i < 16; ++i) {
      sacc[0][i] = __builtin_amdgcn_exp2f(sacc[0][i] - mn); sacc[1][i] = __builtin_amdgcn_exp2f(sacc[1][i] - mn);
      ps += sacc[0][i] + sacc[1][i];
    }
    lsum = lsum * alpha + ps;
#pragma unroll
    for (int i = 0; i < 16; ++i) { oacc[0][i] *= alpha; oacc[1][i] *= alpha; }
#pragma unroll
    for (int k2 = 0; k2 < 2; ++k2)
#pragma unroll
      for (int s2 = 0; s2 < 2; ++s2) {
        bf16x8 pf = pack8(sacc[k2], s2);
        int kb0 = 32 * k2 + 16 * s2 + 4 * hh;
#pragma unroll
        for (int d = 0; d < 2; ++d) {
          u32x2 lo = *(const u32x2*)(Vs + (32 * d + r) * VST + kb0);
          u32x2 hi = *(const u32x2*)(Vs + (32 * d + r) * VST + kb0 + 8);
          u32x4 va; va[0] = lo[0]; va[1] = lo[1]; va[2] = hi[0]; va[3] = hi[1];
          oacc[d] = MFMA32(__builtin_bit_cast(bf16x8, va), pf, oacc[d]);
        }
      }
    __syncthreads();
  }
  lsum += __shfl_xor(lsum, 32);
  const float inv = 1.f / lsum;
  bf16_t* YM = (bf16_t*)(p.ws + OFF_H) + (size_t)qrow * DM + head * 64;
#pragma unroll
  for (int d = 0; d < 2; ++d)
#pragma unroll
    for (int q = 0; q < 4; ++q) {
      u32x2 o; o[0] = pack2(oacc[d][4 * q] * inv, oacc[d][4 * q + 1] * inv); o[1] = pack2(oacc[d][4 * q + 2] * inv, oacc[d][4 * q + 3] * inv);
      *(u32x2*)(YM + 32 * d + 8 * q + 4 * hh) = o;
    }
}

DI void phase_qkv(const Params& p, int layer, int bid, int nb, char* smem) {
  const int MQ = layer == 0 ? MT : ML;
  const int nq = (MQ / 128) * 3, nkv = (MT / 128) * 4, nst = NB * NCH * 8;
  const float* RS = (const float*)(p.ws + OFF_RSTD);
  EpiQ eq{(bf16_t*)(p.ws + OFF_QB), RS};
  EpiKV ekv{(bf16_t*)(p.ws + OFF_KB), (bf16_t*)(p.ws + OFF_VT), RS};
  const bf16_t* U = (const bf16_t*)(p.ws + OFF_U);
  for (int it = bid; it < nq + nkv + nst; it += nb) {
    if (it < nq) gemm_tile<false>(U, DIN, wt_ptr(p, layer, WT_UQ), 256, (it / 3) * 128, (it % 3) * 128, smem, eq);
    else if (it < nq + nkv) { int j = it - nq; gemm_tile<false>(U + U_CKV, DIN, wt_ptr(p, layer, WT_UKV), 128, (j / 4) * 128, (j % 4) * 128, smem, ekv); }
    else { int j = it - nq - nkv; for (int rep = 0; rep < REP_SSD; ++rep) ssd_state_item(p, layer, j / (NCH * 8), (j / 8) % NCH, j & 7, smem); }
  }
}
DI void phase_att(const Params& p, int layer, int bid, int nb, char* smem) {
  const int natt = 512 + (layer == 0 ? 32 : 0), npass = 512;
  for (int it = bid; it < natt + npass; it += nb) {
    if (it < 512) { int b = it >> 7, head = (it >> 5) & 3, qb = it & 31; for (int rep = 0; rep < REP_ATT; ++rep) attn_item(p, b, head, b * SEQ + qb * 128, qb * 128, true, LK, smem); }
    else if (it < natt) { int j = it - 512; int b = j >> 3, head = (j >> 1) & 3, qb = j & 1; attn_item(p, b, head, ML + b * CTX + qb * 128, qb * 128, false, CTX, smem); }
    else ssd_pass_item(p, it - natt);
  }
}
DI void phase_ssdout(const Params& p, int layer, int bid, int nb, char* smem) {
  for (int it = bid; it < NB * NCH * 8; it += nb) {
    int b = it / (NCH * 8), tc = (it / 8) % NCH, h = it & 7;
    if (layer == 1 && tc < 2) continue;
    for (int rep = 0; rep < REP_SSD; ++rep) ssd_out_item(p, layer, b, tc, h, smem);
  }
}


#define XB_TMO      128
#define XB_XCNT(j)  (256  + 64 * (j))
#define XB_XSUB(j)  (1280 + 64 * (j))
#define XB_XGEN(j)  (2304 + 64 * (j))
#define XB_TOP      3328
#define XB_TOPGEN   3392
#define XCD_BAR_WORDS 3456
#define XB_SPIN_CAP (1u << 22)
#define LAS __attribute__((address_space(3)))
DI unsigned xb_ld(unsigned* p) { return __hip_atomic_load(p, __ATOMIC_RELAXED, __HIP_MEMORY_SCOPE_AGENT); }
DI unsigned xb_add(unsigned* p, unsigned v) { return __hip_atomic_fetch_add(p, v, __ATOMIC_RELAXED, __HIP_MEMORY_SCOPE_AGENT); }
DI unsigned xb_xcc_id() { return (unsigned)__builtin_amdgcn_s_getreg((3 << 11) | 20) & 0xFu; }
#define XB_SPIN(cond, bar) do { unsigned _sp = 0; while (cond) { __builtin_amdgcn_s_sleep(1); \
    if ((++_sp & 255u) == 0u) { if (xb_ld(&(bar)[XB_TMO])) break; if (_sp > XB_SPIN_CAP) { atomicAdd(&(bar)[XB_TMO], 1u); break; } } } } while (0)
struct XcdBarrier { unsigned* bar; unsigned x; volatile LAS unsigned* st; };
DI XcdBarrier xcd_barrier_post(unsigned* bar, volatile LAS unsigned* st) {
  XcdBarrier b; b.bar = bar; b.x = xb_xcc_id(); b.st = st;
  if (threadIdx.x == 0) (void)xb_add(&bar[XB_XCNT(b.x)], 1u);
  return b;
}
DI void xcd_barrier_complete(unsigned* bar, unsigned x, unsigned& nloc, unsigned& nx) {
  const unsigned G = gridDim.x * gridDim.y * gridDim.z;
  unsigned sum, cnt, mine, sp = 0u;
  for (;;) {
    sum = 0u; cnt = 0u; mine = 0u;
#pragma unroll
    for (unsigned j = 0; j < 16; ++j) { const unsigned c = xb_ld(&bar[XB_XCNT(j)]); sum += c; cnt += (c > 0u) ? 1u : 0u; mine = (j == x) ? c : mine; }
    if (sum == G) break;
    __builtin_amdgcn_s_sleep(1);
    if ((++sp & 255u) == 0u) { if (xb_ld(&bar[XB_TMO])) break; if (sp > XB_SPIN_CAP) { atomicAdd(&bar[XB_TMO], 1u); break; } }
  }
  nloc = mine > 0u ? mine : 1u; nx = cnt > 0u ? cnt : 1u;
}
DI void xcd_barrier(const XcdBarrier& b) {
  asm volatile("s_waitcnt vmcnt(0)" ::: "memory");
  __syncthreads();
  if (threadIdx.x == 0) {
    unsigned* bar = b.bar;
    __builtin_amdgcn_s_waitcnt(0);
    unsigned nloc = b.st[0], nx = b.st[1];
    if (nloc == 0u) { xcd_barrier_complete(bar, b.x, nloc, nx); b.st[0] = nloc; b.st[1] = nx; }
    const unsigned old = xb_add(&bar[XB_XSUB(b.x)], 1u);
    const unsigned gen = old / nloc;
    if (old + 1u == (gen + 1u) * nloc) {
      __builtin_amdgcn_fence(__ATOMIC_RELEASE, "agent");
      asm volatile("s_waitcnt vmcnt(0)" ::: "memory");
      const unsigned og = xb_add(&bar[XB_TOP], 1u);
      const unsigned tg = og / nx;
      if (og + 1u == (tg + 1u) * nx) xb_add(&bar[XB_TOPGEN], 1u);
      else XB_SPIN(xb_ld(&bar[XB_TOPGEN]) == tg, bar);
      __builtin_amdgcn_fence(__ATOMIC_ACQUIRE, "agent");
      xb_add(&bar[XB_XGEN(b.x)], 1u);
      asm volatile("s_waitcnt vmcnt(0)" ::: "memory");
    } else {
      XB_SPIN(xb_ld(&bar[XB_XGEN(b.x)]) == gen, bar);
      __builtin_amdgcn_fence(__ATOMIC_ACQUIRE, "agent");
      asm volatile("s_waitcnt vmcnt(0)" ::: "memory");
    }
  }
  __syncthreads();
}

constexpr int SMEM_BYTES = 2 * GBUF * 2;
enum { PH_PREP0 = 0, PH_H0, PH_INPROJ, PH_PREP, PH_QKV, PH_ATT, PH_SSDOUT, PH_WOUT, PH_POSTMIX, PH_FF1, PH_FF2, PH_POSTFFN, PH_SSDNORM };

DI void run_phase(const Params& p, int ph, int layer, int bid, int nb, char* smem) {
  switch (ph) {
    case PH_PREP0: phase_prep0(p, bid, nb, smem); break;
    case PH_H0: phase_h0(p, bid, nb); break;
    case PH_INPROJ: phase_inproj(p, layer, bid, nb, smem); break;
    case PH_PREP: phase_prep(p, layer, bid, nb); break;
    case PH_QKV: phase_qkv(p, layer, bid, nb, smem); break;
    case PH_ATT: phase_att(p, layer, bid, nb, smem); break;
    case PH_SSDOUT: phase_ssdout(p, layer, bid, nb, smem); break;
    case PH_SSDNORM: phase_ssdnorm(p, layer, bid, nb); break;
    case PH_WOUT: phase_wout(p, layer, bid, nb, smem); break;
    case PH_POSTMIX: phase_postmix(p, layer, bid, nb); break;
    case PH_FF1: phase_ff1(p, layer, bid, nb, smem); break;
    case PH_FF2: phase_ff2(p, layer, bid, nb, smem); break;
    case PH_POSTFFN: phase_postffn(p, layer, bid, nb); break;
  }
}

__global__ void __launch_bounds__(256, 2) mega_kernel(Params p) {
  extern __shared__ __attribute__((aligned(16))) char smem[];
  cg::grid_group grid = cg::this_grid();
  if (p.ws == nullptr) grid.sync();
  const int bid = blockIdx.x, nb = gridDim.x;
  volatile LAS unsigned* st = (volatile LAS unsigned*)(smem + SMEM_BYTES - 16);
  if (threadIdx.x == 0) { st[0] = 0u; st[1] = 0u; st[2] = 0u; st[3] = 0u; }
  __syncthreads();
  XcdBarrier xb = xcd_barrier_post((unsigned*)(p.ws + OFF_BAR), st);
  for (int step = 0; step < 22; ++step) {
    int ph, layer;
    if (step < 2) { ph = step; layer = 0; }
    else { int j = step - 2; layer = j / 10; ph = PH_INPROJ + j % 10; }
    run_phase(p, ph, layer, bid, nb, smem);
    if (step < 21) xcd_barrier(xb);
  }
}

extern "C" void kernel_launch(void* const* d_in, const int* in_sizes, int n_in, void* d_out, int out_size, void* d_ws, size_t ws_size,
                              hipStream_t stream) {
  if (ws_size < WS_NEED) { fprintf(stderr, "workspace too small: %zu < %zu\n", ws_size, (size_t)WS_NEED); return; }
  Params p{};
  const float** f = (const float**)&p;
  for (int i = 0; i < 25; ++i) f[i] = (const float*)d_in[i];
  p.out = (float*)d_out;
  p.ws = (char*)d_ws;
  static int grid_blocks = 0;
  if (!grid_blocks) {
    int dev = 0, cus = 0, per_cu = 0;
    hipGetDevice(&dev);
    hipDeviceGetAttribute(&cus, hipDeviceAttributeMultiprocessorCount, dev);
    hipFuncSetAttribute((const void*)mega_kernel, hipFuncAttributeMaxDynamicSharedMemorySize, SMEM_BYTES);
    hipOccupancyMaxActiveBlocksPerMultiprocessor(&per_cu, mega_kernel, 256, SMEM_BYTES);
    if (per_cu > 2) per_cu = 2;
    grid_blocks = cus * per_cu;
  }
  hipMemsetAsync((char*)d_ws + OFF_BAR, 0, XCD_BAR_WORDS * 4, stream);
  void* args[] = {&p};
  hipError_t e = hipLaunchCooperativeKernel((void*)mega_kernel, dim3(grid_blocks), dim3(256), args, SMEM_BYTES, stream);
  if (e != hipSuccess) fprintf(stderr, "cooperative launch failed: %s (grid %d)\n", hipGetErrorString(e), grid_blocks);
}
```

```cpp
#include <hip/hip_runtime.h>
#include <hip/hip_cooperative_groups.h>
#include <stdint.h>
#include <stdio.h>
namespace cg = cooperative_groups;

#ifndef MEGA
#define MEGA 1
#endif
#ifndef REP_GEMM
#define REP_GEMM 1
#endif
#ifndef REP_ATT
#define REP_ATT 1
#endif
#ifndef REP_SSD
#define REP_SSD 1
#endif

typedef unsigned short bf16_t;
using bf16x8 = __attribute__((ext_vector_type(8))) short;
using s16x4  = __attribute__((ext_vector_type(4))) short;
using f32x4  = __attribute__((ext_vector_type(4))) float;
using f32x16 = __attribute__((ext_vector_type(16))) float;
using u32x4  = __attribute__((ext_vector_type(4))) unsigned;
using u32x2  = __attribute__((ext_vector_type(2))) unsigned;
#define DI __device__ __forceinline__
#define MFMA32(a, b, c) __builtin_amdgcn_mfma_f32_32x32x16_bf16((a), (b), (c), 0, 0, 0)
#define MFMA16(a, b, c) __builtin_amdgcn_mfma_f32_16x16x32_bf16((a), (b), (c), 0, 0, 0)

constexpr int DM = 1024, NB = 4, SEQ = 4096, CTX = 256;
constexpr int ML = NB * SEQ;
constexpr int MC = NB * CTX;
constexpr int MT = ML + MC;
constexpr int DIN = 2480, DINP = 2560;
constexpr int LK = CTX + SEQ;
constexpr int DFF = 4096;
constexpr int NCH = 34;
constexpr float EPS = 1e-6f;
constexpr int U_CKV = 256, U_KR = 384, U_GB = 416, U_GC = 672, U_VAL = 928, U_Z = 1184, U_XBC = 1696, U_DT = 2464;

constexpr size_t AL(size_t x) { return (x + 255) & ~(size_t)255; }
constexpr size_t WT_IN = 0;
constexpr size_t WT_UQ = WT_IN + (size_t)DINP * 1024;
constexpr size_t WT_UKV = WT_UQ + (size_t)384 * 256;
constexpr size_t WT_OUT = WT_UKV + (size_t)512 * 128;
constexpr size_t WT_FF1 = WT_OUT + (size_t)1024 * 1024;
constexpr size_t WT_FF2 = WT_FF1 + (size_t)4096 * 1024;
constexpr size_t WT_ELEMS = WT_FF2 + (size_t)4096 * 1024;
constexpr size_t OFF_WT = 0;
constexpr size_t OFF_MOD = AL(OFF_WT + 2 * WT_ELEMS * 2);
constexpr size_t OFF_XC = AL(OFF_MOD + 2 * 5 * 6144 * 4);
constexpr size_t OFF_H = AL(OFF_XC + (size_t)MC * DM * 4);
constexpr size_t OFF_R1 = AL(OFF_H + (size_t)MT * DM * 2);
constexpr size_t OFF_U = OFF_R1;
constexpr size_t OFF_DT = AL(OFF_U + (size_t)MT * DIN * 2);
constexpr size_t OFF_RSTD = AL(OFF_DT + (size_t)MT * 16 * 4);
constexpr size_t OFF_QB = AL(OFF_RSTD + (size_t)MT * 2 * 4);
constexpr size_t OFF_KB = AL(OFF_QB + (size_t)MT * 384 * 2);
constexpr size_t OFF_VT = AL(OFF_KB + (size_t)NB * 4 * LK * 96 * 2);
constexpr size_t OFF_XBC = AL(OFF_VT + (size_t)NB * 4 * 64 * LK * 2);
constexpr size_t OFF_SST = AL(OFF_XBC + (size_t)MT * 768 * 2);
constexpr size_t OFF_TDEC = AL(OFF_SST + (size_t)2 * NB * NCH * 8 * 4096 * 2);
constexpr size_t OFF_SSQ = AL(OFF_TDEC + (size_t)2 * NB * NCH * 8 * 4);
constexpr size_t OFF_END1 = AL(OFF_SSQ + (size_t)MT * 8 * 4);
constexpr size_t OFF_F1 = OFF_R1;
constexpr size_t OFF_END2 = AL(OFF_F1 + (size_t)MT * DFF * 2);
constexpr size_t OFF_BAR = OFF_END1 > OFF_END2 ? OFF_END1 : OFF_END2;
constexpr size_t WS_NEED = OFF_BAR + 16384;

struct Params {
  const float *x, *c, *ctx, *c_ctx, *w_mod, *b_mod, *g_pre_mix, *w_in, *q_norm, *w_uq, *kv_norm, *w_ukv, *sc_w, *ssd_cw, *ssd_cb,
      *a_log, *dt_bias, *ssd_d, *ssd_norm, *w_out, *g_post_mix, *g_pre_ffn, *w_ff1, *w_ff2, *g_post_ffn;
  float* out;
  char* ws;
};

DI int ltid() { int t = threadIdx.x; asm volatile("" : "+v"(t)); return t; }
typedef __bf16 hbf2 __attribute__((ext_vector_type(2)));
typedef float hf2 __attribute__((ext_vector_type(2)));
DI bf16_t f2bf(float x) { return __builtin_bit_cast(bf16_t, (__bf16)x); }
DI float bf2f(unsigned v) { return __uint_as_float(v << 16); }
DI unsigned pack2(float a, float b) { hf2 v = {a, b}; return __builtin_bit_cast(unsigned, __builtin_convertvector(v, hbf2)); }
DI float lo2f(unsigned w) { return __uint_as_float(w << 16); }
DI float hi2f(unsigned w) { return __uint_as_float(w & 0xffff0000u); }
DI float wave_sum(float v) {
#pragma unroll
  for (int o = 32; o > 0; o >>= 1) v += __shfl_xor(v, o);
  return v;
}
DI float silu_f(float x) { return x / (1.f + __expf(-x)); }
DI int crow(int reg, int h) { return (reg & 3) + 8 * (reg >> 2) + 4 * h; }
DI bf16x8 pack8(const f32x16& x, int s) {
  u32x4 p;
  p[0] = pack2(x[8 * s + 0], x[8 * s + 1]); p[1] = pack2(x[8 * s + 2], x[8 * s + 3]);
  p[2] = pack2(x[8 * s + 4], x[8 * s + 5]); p[3] = pack2(x[8 * s + 6], x[8 * s + 7]);
  return __builtin_bit_cast(bf16x8, p);
}
DI const float* xin_row(const Params& p, int layer, int row) {
  if (layer == 0) return row < ML ? p.x + (size_t)row * DM : p.ctx + (size_t)(row - ML) * DM;
  return row < ML ? p.out + (size_t)row * DM : (const float*)(p.ws + OFF_XC) + (size_t)(row - ML) * DM;
}
DI float* xst_row(const Params& p, int row) {
  return row < ML ? p.out + (size_t)row * DM : (float*)(p.ws + OFF_XC) + (size_t)(row - ML) * DM;
}
DI const float* mod_ptr(const Params& p, int layer, int row, int which) {
  int bb = row < ML ? (row >> 12) : 4;
  return (const float*)(p.ws + OFF_MOD) + ((size_t)(layer * 5 + bb) * 6 + which) * DM;
}
DI bf16_t* wt_ptr(const Params& p, int layer, size_t off) { return (bf16_t*)(p.ws + OFF_WT) + (size_t)layer * WT_ELEMS + off; }

DI void transpose_item(const float* __restrict__ w, const float* __restrict__ gk, int gk_from, bf16_t* __restrict__ wt, int K, int N, int kt, int nt, char* smem) {
  float* tile = (float*)smem;
  const int tid = ltid(), tx = tid & 63, ty = tid >> 6;
  const int k0 = kt * 64, n0 = nt * 64;
  const int n = n0 + tx;
  float v[16];
#pragma unroll
  for (int i = 0; i < 16; ++i) {
    int kk = ty + 4 * i;
    v[i] = n < N ? w[(size_t)(k0 + kk) * N + n] : 0.f;
  }
  if (gk) {
#pragma unroll
    for (int i = 0; i < 16; ++i) { int k = k0 + ty + 4 * i; if (k >= gk_from) v[i] *= gk[k - gk_from]; }
  }
#pragma unroll
  for (int i = 0; i < 16; ++i) tile[(ty + 4 * i) * 65 + tx] = v[i];
  __syncthreads();
#pragma unroll
  for (int i = 0; i < 2; ++i) {
    int c = tid + 256 * i, nn = c >> 3, kc = c & 7;
    u32x4 o;
#pragma unroll
    for (int jj = 0; jj < 4; ++jj) o[jj] = pack2(tile[(kc * 8 + 2 * jj) * 65 + nn], tile[(kc * 8 + 2 * jj + 1) * 65 + nn]);
    *(u32x4*)(wt + (size_t)(n0 + nn) * K + k0 + kc * 8) = o;
  }
  __syncthreads();
}

DI void modgemv_item(const Params& p, int layer, int ct, char* smem) {
  float* s = (float*)smem;
  float* red = s + 5 * 1024;
  const int tid = ltid(), w = tid >> 6, lane = tid & 63;
  for (int i = tid; i < 5 * 1024; i += 256) {
    int bb = i >> 10, k = i & 1023;
    float v = bb < 4 ? p.c[bb * 1024 + k] : p.c_ctx[k];
    s[i] = silu_f(v);
  }
  __syncthreads();
  const float* wm = p.w_mod + (size_t)layer * 1024 * 6144;
  const int n = ct * 64 + lane;
  float acc[5] = {0.f, 0.f, 0.f, 0.f, 0.f};
#pragma unroll 16
  for (int k = w * 256; k < w * 256 + 256; ++k) {
    float wv = wm[(size_t)k * 6144 + n];
#pragma unroll
    for (int bb = 0; bb < 5; ++bb) acc[bb] += s[bb * 1024 + k] * wv;
  }
#pragma unroll
  for (int bb = 0; bb < 5; ++bb) red[(w * 5 + bb) * 64 + lane] = acc[bb];
  __syncthreads();
  for (int i = tid; i < 320; i += 256) {
    int bb = i >> 6, ln = i & 63;
    float v = red[(0 * 5 + bb) * 64 + ln] + red[(1 * 5 + bb) * 64 + ln] + red[(2 * 5 + bb) * 64 + ln] + red[(3 * 5 + bb) * 64 + ln];
    int nn = ct * 64 + ln;
    v += p.b_mod[layer * 6144 + nn];
    ((float*)(p.ws + OFF_MOD))[(size_t)(layer * 5 + bb) * 6144 + nn] = v;
  }
  __syncthreads();
}

DI void phase_prep0(const Params& p, int bid, int nb, char* smem) {
  constexpr int PER = 2984;
  for (int it = bid; it < 192 + 2 * PER; it += nb) {
    if (it < 192) { modgemv_item(p, it / 96, it % 96, smem); continue; }
    int layer = (it - 192) / PER, j = (it - 192) % PER;
    if (j < 640) transpose_item(p.w_in + (size_t)layer * 1024 * DIN, nullptr, 0, wt_ptr(p, layer, WT_IN), 1024, DIN, j / 40, j % 40, smem);
    else if ((j -= 640) < 24) transpose_item(p.w_uq + (size_t)layer * 256 * 384, p.q_norm + layer * 256, 0, wt_ptr(p, layer, WT_UQ), 256, 384, j / 6, j % 6, smem);
    else if ((j -= 24) < 16) transpose_item(p.w_ukv + (size_t)layer * 128 * 512, p.kv_norm + layer * 128, 0, wt_ptr(p, layer, WT_UKV), 128, 512, j / 8, j % 8, smem);
    else if ((j -= 16) < 256) transpose_item(p.w_out + (size_t)layer * 1024 * 1024, p.ssd_norm + layer * 512, 512, wt_ptr(p, layer, WT_OUT), 1024, 1024, j / 16, j % 16, smem);
    else if ((j -= 256) < 1024) transpose_item(p.w_ff1 + (size_t)layer * 1024 * 4096, nullptr, 0, wt_ptr(p, layer, WT_FF1), 1024, 4096, j / 64, j % 64, smem);
    else { j -= 1024; transpose_item(p.w_ff2 + (size_t)layer * 4096 * 1024, nullptr, 0, wt_ptr(p, layer, WT_FF2), 4096, 1024, j / 16, j % 16, smem); }
  }
}

DI void write_h_row(const float4 xv[4], float rstd, const float* g, const float* sh, const float* sc, bf16_t* hrow, int lane) {
#pragma unroll
  for (int i = 0; i < 4; ++i) {
    int col = lane * 4 + 256 * i;
    float4 gg = *(const float4*)(g + col), s1 = *(const float4*)(sc + col), s0 = *(const float4*)(sh + col);
    float a = xv[i].x * rstd * gg.x * (1.f + s1.x) + s0.x;
    float b = xv[i].y * rstd * gg.y * (1.f + s1.y) + s0.y;
    float c = xv[i].z * rstd * gg.z * (1.f + s1.z) + s0.z;
    float d = xv[i].w * rstd * gg.w * (1.f + s1.w) + s0.w;
    u32x2 o; o[0] = pack2(a, b); o[1] = pack2(c, d);
    *(u32x2*)(hrow + col) = o;
  }
}
DI float ssq4(const float4 v[4]) {
  float s = 0.f;
#pragma unroll
  for (int i = 0; i < 4; ++i) s += v[i].x * v[i].x + v[i].y * v[i].y + v[i].z * v[i].z + v[i].w * v[i].w;
  return s;
}
DI void load_bf_row(const bf16_t* r, int lane, float4 v[4]) {
#pragma unroll
  for (int i = 0; i < 4; ++i) {
    u32x2 t = *(const u32x2*)(r + lane * 4 + 256 * i);
    v[i] = make_float4(lo2f(t[0]), hi2f(t[0]), lo2f(t[1]), hi2f(t[1]));
  }
}

DI void phase_h0(const Params& p, int bid, int nb) {
  const int w = ltid() >> 6, lane = ltid() & 63;
  bf16_t* H = (bf16_t*)(p.ws + OFF_H);
  for (int row = bid * 4 + w; row < MT; row += nb * 4) {
    const float* xr = xin_row(p, 0, row);
    float4 xv[4];
#pragma unroll
    for (int i = 0; i < 4; ++i) xv[i] = *(const float4*)(xr + lane * 4 + 256 * i);
    float rstd = rsqrtf(wave_sum(ssq4(xv)) * (1.f / DM) + EPS);
    write_h_row(xv, rstd, p.g_pre_mix, mod_ptr(p, 0, row, 0), mod_ptr(p, 0, row, 1), H + (size_t)row * DM, lane);
  }
}

DI void phase_postmix(const Params& p, int layer, int bid, int nb) {
  const int w = ltid() >> 6, lane = ltid() & 63;
  const int M = layer == 0 ? MT : ML;
  bf16_t* H = (bf16_t*)(p.ws + OFF_H);
  const bf16_t* Y = (const bf16_t*)(p.ws + OFF_U);
  for (int row = bid * 4 + w; row < M; row += nb * 4) {
    float4 yv[4], xv[4];
    load_bf_row(Y + (size_t)row * DM, lane, yv);
    const float* xr = xin_row(p, layer, row);
#pragma unroll
    for (int i = 0; i < 4; ++i) xv[i] = *(const float4*)(xr + lane * 4 + 256 * i);
    float rstd = rsqrtf(wave_sum(ssq4(yv)) * (1.f / DM) + EPS);
    const float* g1 = mod_ptr(p, layer, row, 2);
    const float* gp = p.g_post_mix + layer * DM;
    float* xo = xst_row(p, row);
#pragma unroll
    for (int i = 0; i < 4; ++i) {
      int col = lane * 4 + 256 * i;
      float4 a = *(const float4*)(g1 + col), b = *(const float4*)(gp + col);
      xv[i].x += a.x * yv[i].x * rstd * b.x; xv[i].y += a.y * yv[i].y * rstd * b.y;
      xv[i].z += a.z * yv[i].z * rstd * b.z; xv[i].w += a.w * yv[i].w * rstd * b.w;
      *(float4*)(xo + col) = xv[i];
    }
    float rstd1 = rsqrtf(wave_sum(ssq4(xv)) * (1.f / DM) + EPS);
    write_h_row(xv, rstd1, p.g_pre_ffn + layer * DM, mod_ptr(p, layer, row, 3), mod_ptr(p, layer, row, 4), H + (size_t)row * DM, lane);
  }
}

DI void phase_postffn(const Params& p, int layer, int bid, int nb) {
  const int w = ltid() >> 6, lane = ltid() & 63;
  const int M = layer == 0 ? MT : ML;
  bf16_t* H = (bf16_t*)(p.ws + OFF_H);
  for (int row = bid * 4 + w; row < M; row += nb * 4) {
    float4 fv[4], xv[4];
    load_bf_row(H + (size_t)row * DM, lane, fv);
    float* xo = xst_row(p, row);
#pragma unroll
    for (int i = 0; i < 4; ++i) xv[i] = *(const float4*)(xo + lane * 4 + 256 * i);
    float rstd = rsqrtf(wave_sum(ssq4(fv)) * (1.f / DM) + EPS);
    const float* g2 = mod_ptr(p, layer, row, 5);
    const float* gp = p.g_post_ffn + layer * DM;
#pragma unroll
    for (int i = 0; i < 4; ++i) {
      int col = lane * 4 + 256 * i;
      float4 a = *(const float4*)(g2 + col), b = *(const float4*)(gp + col);
      xv[i].x += a.x * fv[i].x * rstd * b.x; xv[i].y += a.y * fv[i].y * rstd * b.y;
      xv[i].z += a.z * fv[i].z * rstd * b.z; xv[i].w += a.w * fv[i].w * rstd * b.w;
      *(float4*)(xo + col) = xv[i];
    }
    if (layer == 0) {
      float rstd1 = rsqrtf(wave_sum(ssq4(xv)) * (1.f / DM) + EPS);
      write_h_row(xv, rstd1, p.g_pre_mix + DM, mod_ptr(p, 1, row, 0), mod_ptr(p, 1, row, 1), H + (size_t)row * DM, lane);
    }
  }
}

DI void phase_prep(const Params& p, int layer, int bid, int nb) {
  const int w = ltid() >> 6, lane = ltid() & 63;
  const bf16_t* U = (const bf16_t*)(p.ws + OFF_U);
  float* DT = (float*)(p.ws + OFF_DT);
  float* RS = (float*)(p.ws + OFF_RSTD);
  bf16_t* KB = (bf16_t*)(p.ws + OFF_KB);
  bf16_t* XBC = (bf16_t*)(p.ws + OFF_XBC);
  bf16_t* YM = (bf16_t*)(p.ws + OFF_H);
  const float* scw = p.sc_w + layer * 3 * 256;
  const float* cw = p.ssd_cw + layer * 3 * 768;
  const float* cb = p.ssd_cb + layer * 768;
  for (int row = bid * 4 + w; row < MT; row += nb * 4) {
    int b, t, L, pos;
    bool lat = row < ML;
    if (lat) { b = row >> 12; t = row & 4095; L = SEQ; pos = t + CTX; }
    else { int rr = row - ML; b = rr >> 8; t = rr & 255; L = CTX; pos = t; }
    const bf16_t* u0 = U + (size_t)row * DIN;
    const bool hp = t > 0, hn = t < L - 1;
    const bf16_t* um = u0 - DIN;
    const bf16_t* up = u0 + DIN;
    {
      u32x2 v = *(const u32x2*)(u0 + lane * 4);
      float a = lo2f(v[0]), bq = hi2f(v[0]), c = lo2f(v[1]), d = hi2f(v[1]);
      float ss = wave_sum(a * a + bq * bq + c * c + d * d);
      float s2 = 0.f;
      if (lane < 32) {
        u32x2 v2 = *(const u32x2*)(u0 + U_CKV + lane * 4);
        float e = lo2f(v2[0]), f = hi2f(v2[0]), g = lo2f(v2[1]), h = hi2f(v2[1]);
        s2 = e * e + f * f + g * g + h * h;
      }
      s2 = wave_sum(s2);
      if (lane == 0) { RS[row * 2] = rsqrtf(ss * (1.f / 256) + EPS); RS[row * 2 + 1] = rsqrtf(s2 * (1.f / 128) + EPS); }
    }
    {
      float v = bf2f(u0[U_KR + (lane & 31)]);
      float partner = __shfl_xor(v, 8);
      float o = v;
      if (lat) {
        int grp = (lane & 31) >> 3, i = lane & 7;
        float posf = grp < 2 ? (float)(t >> 6) : (float)(t & 63);
        float invf = exp2f(-(float)(2 * i) * (13.287712379549449f / 16.f));
        float ang = posf * invf;
        float rev = ang * 0.15915494309189535f;
        float cs = __builtin_amdgcn_cosf(rev), sn = __builtin_amdgcn_sinf(rev);
        o = (grp & 1) ? v * cs + partner * sn : v * cs - partner * sn;
      }
      if (lane < 32) {
        bf16_t ob = f2bf(o);
#pragma unroll
        for (int hd = 0; hd < 4; ++hd) KB[((size_t)(b * 4 + hd) * LK + pos) * 96 + 64 + lane] = ob;
      }
    }
    {
      int c = lane * 4;
      float acc[4] = {0.f, 0.f, 0.f, 0.f};
#pragma unroll
      for (int k = 0; k < 3; ++k) {
        const bf16_t* ur = k == 0 ? um : (k == 1 ? u0 : up);
        bool ok = k == 0 ? hp : (k == 1 ? true : hn);
        if (ok) {
          u32x2 gc = *(const u32x2*)(ur + U_GC + c), vv = *(const u32x2*)(ur + U_VAL + c);
          float4 wk = *(const float4*)(scw + k * 256 + c);
          acc[0] += wk.x * lo2f(gc[0]) * lo2f(vv[0]); acc[1] += wk.y * hi2f(gc[0]) * hi2f(vv[0]);
          acc[2] += wk.z * lo2f(gc[1]) * lo2f(vv[1]); acc[3] += wk.w * hi2f(gc[1]) * hi2f(vv[1]);
        }
      }
      u32x2 gb = *(const u32x2*)(u0 + U_GB + c);
      u32x2 o; o[0] = pack2(lo2f(gb[0]) * acc[0], hi2f(gb[0]) * acc[1]); o[1] = pack2(lo2f(gb[1]) * acc[2], hi2f(gb[1]) * acc[3]);
      *(u32x2*)(YM + (size_t)row * DM + 256 + c) = o;
    }
#pragma unroll
    for (int i = 0; i < 3; ++i) {
      int c = lane * 4 + 256 * i;
      float4 bias = *(const float4*)(cb + c);
      float acc[4] = {bias.x, bias.y, bias.z, bias.w};
#pragma unroll
      for (int k = 0; k < 3; ++k) {
        const bf16_t* ur = k == 0 ? um : (k == 1 ? u0 : up);
        bool ok = k == 0 ? hp : (k == 1 ? true : hn);
        if (ok) {
          u32x2 vv = *(const u32x2*)(ur + U_XBC + c);
          float4 wk = *(const float4*)(cw + k * 768 + c);
          acc[0] += wk.x * lo2f(vv[0]); acc[1] += wk.y * hi2f(vv[0]); acc[2] += wk.z * lo2f(vv[1]); acc[3] += wk.w * hi2f(vv[1]);
        }
      }
      u32x2 o; o[0] = pack2(silu_f(acc[0]), silu_f(acc[1])); o[1] = pack2(silu_f(acc[2]), silu_f(acc[3]));
      *(u32x2*)(XBC + (size_t)row * 768 + c) = o;
    }
    if (lane < 16) {
      float v = DT[(size_t)row * 16 + lane] + p.dt_bias[layer * 16 + lane];
      float sp = fmaxf(v, 0.f) + log1pf(__expf(-fabsf(v)));
      DT[(size_t)row * 16 + lane] = sp;
    }
  }
}

DI void phase_ssdnorm(const Params& p, int layer, int bid, int nb) {
  const int w = ltid() >> 6, lane = ltid() & 63;
  const int M = layer == 0 ? MT : ML;
  bf16_t* YM = (bf16_t*)(p.ws + OFF_H);
  const float* SSQ = (const float*)(p.ws + OFF_SSQ);
  const float* ng = p.ssd_norm + layer * 512;
  for (int row = bid * 4 + w; row < M; row += nb * 4) {
    int g = lane >> 5;
    float4 s = *(const float4*)(SSQ + (size_t)row * 8 + g * 4);
    float rstd = rsqrtf((s.x + s.y + s.z + s.w) * (1.f / 256) + EPS);
    bf16_t* ptr = YM + (size_t)row * DM + 512 + lane * 8;
    u32x4 v = *(const u32x4*)ptr;
    float4 g0 = *(const float4*)(ng + lane * 8), g1 = *(const float4*)(ng + lane * 8 + 4);
    u32x4 o;
    o[0] = pack2(lo2f(v[0]) * rstd * g0.x, hi2f(v[0]) * rstd * g0.y);
    o[1] = pack2(lo2f(v[1]) * rstd * g0.z, hi2f(v[1]) * rstd * g0.w);
    o[2] = pack2(lo2f(v[2]) * rstd * g1.x, hi2f(v[2]) * rstd * g1.y);
    o[3] = pack2(lo2f(v[3]) * rstd * g1.z, hi2f(v[3]) * rstd * g1.w);
    *(u32x4*)ptr = o;
  }
}

constexpr int GST = 80;
constexpr int GBUF = 2 * 128 * GST;
template <bool GN, class Epi>
DI void gemm_tile(const bf16_t* __restrict__ A, int lda, const bf16_t* __restrict__ Bt, int K, int row0, int col0, char* smem, Epi epi, const float* __restrict__ ssq = nullptr) {
  bf16_t* S0 = (bf16_t*)smem;
  const int tid = ltid(), wid = tid >> 6, lane = tid & 63, wr = wid >> 1, wc = wid & 1, fr = lane & 15, fq = lane >> 4;
  f32x4 acc[4][4];
#pragma unroll
  for (int m = 0; m < 4; ++m)
#pragma unroll
    for (int n = 0; n < 4; ++n) acc[m][n] = f32x4{0.f, 0.f, 0.f, 0.f};
  u32x4 ra[4], rb[4];
  const int sr = tid >> 3, sp = tid & 7;
  const bf16_t* ga = A + (size_t)(row0 + sr) * lda + sp * 8;
  const bf16_t* gb = Bt + (size_t)(col0 + sr) * K + sp * 8;
  auto gload = [&](int k0) {
#pragma unroll
    for (int i = 0; i < 4; ++i) {
      ra[i] = *(const u32x4*)(ga + (size_t)(32 * i) * lda + k0);
      rb[i] = *(const u32x4*)(gb + (size_t)(32 * i) * K + k0);
    }
  };
  gload(0);
  float gs[4][2];
  if (GN) {
#pragma unroll
    for (int i = 0; i < 4; ++i) {
      const float4 s0 = *(const float4*)(ssq + (size_t)(row0 + sr + 32 * i) * 8), s1 = *(const float4*)(ssq + (size_t)(row0 + sr + 32 * i) * 8 + 4);
      gs[i][0] = rsqrtf((s0.x + s0.y + s0.z + s0.w) * (1.f / 256) + EPS);
      gs[i][1] = rsqrtf((s1.x + s1.y + s1.z + s1.w) * (1.f / 256) + EPS);
    }
  }
  auto swrite = [&](int kt) {
    if (GN && kt >= 8) {
      const int g = (kt - 8) >> 2;
#pragma unroll
      for (int i = 0; i < 4; ++i) {
        const float sc = g ? gs[i][1] : gs[i][0];
#pragma unroll
        for (int jj = 0; jj < 4; ++jj) ra[i][jj] = pack2(lo2f(ra[i][jj]) * sc, hi2f(ra[i][jj]) * sc);
      }
    }
    bf16_t* As = S0 + (kt & 1) * GBUF;
    bf16_t* Bs = As + 128 * GST;
#pragma unroll
    for (int i = 0; i < 4; ++i) {
      *(u32x4*)(As + (sr + 32 * i) * GST + sp * 8) = ra[i];
      *(u32x4*)(Bs + (sr + 32 * i) * GST + sp * 8) = rb[i];
    }
  };
  const int KT = K / 64;
  swrite(0);
  if (KT > 1) gload(64);
  __syncthreads();
  for (int kt = 0; kt < KT; ++kt) {
    const bf16_t* As = S0 + (kt & 1) * GBUF;
    const bf16_t* Bs = As + 128 * GST;
#pragma unroll
    for (int ks = 0; ks < 2; ++ks) {
      bf16x8 af[4], bfr[4];
#pragma unroll
      for (int m = 0; m < 4; ++m) af[m] = *(const bf16x8*)(As + (wr * 64 + m * 16 + fr) * GST + ks * 32 + fq * 8);
#pragma unroll
      for (int n = 0; n < 4; ++n) bfr[n] = *(const bf16x8*)(Bs + (wc * 64 + n * 16 + fr) * GST + ks * 32 + fq * 8);
#pragma unroll
      for (int m = 0; m < 4; ++m)
#pragma unroll
        for (int n = 0; n < 4; ++n) acc[m][n] = MFMA16(bfr[n], af[m], acc[m][n]);
      if (ks == 0 && kt + 1 < KT) {
        swrite(kt + 1);
        if (kt + 2 < KT) gload((kt + 2) * 64);
      }
    }
    __syncthreads();
  }
#pragma unroll
  for (int m = 0; m < 4; ++m)
#pragma unroll
    for (int n = 0; n < 4; ++n) epi(row0 + wr * 64 + m * 16 + fr, col0 + wc * 64 + n * 16 + fq * 4, acc[m][n]);
}

template <class Epi>
DI void gemm_tile_glds(const bf16_t* __restrict__ A, int lda, const bf16_t* __restrict__ Bt, int K, int row0, int col0, char* smem, Epi epi) {
  const int tid = ltid(), wid = tid >> 6, lane = tid & 63, wr = wid >> 1, wc = wid & 1, fr = lane & 15, fq = lane >> 4;
  f32x4 acc[4][4];
#pragma unroll
  for (int m = 0; m < 4; ++m)
#pragma unroll
    for (int n = 0; n < 4; ++n) acc[m][n] = f32x4{0.f, 0.f, 0.f, 0.f};
  const int crow = tid >> 3, cslot = tid & 7, cpart = cslot ^ (crow & 7);
  const bf16_t* ga = A + (size_t)(row0 + crow) * lda + cpart * 8;
  const bf16_t* gb = Bt + (size_t)(col0 + crow) * K + cpart * 8;
  auto issue = [&](int kt, int stage) {
    char* sa = smem + stage * 32768 + tid * 16;
#pragma unroll
    for (int i = 0; i < 4; ++i) {
      __builtin_amdgcn_global_load_lds((const unsigned*)(ga + (size_t)(32 * i) * lda + kt * 64), (__attribute__((address_space(3))) unsigned*)(sa + i * 4096), 16, 0, 0);
      __builtin_amdgcn_global_load_lds((const unsigned*)(gb + (size_t)(32 * i) * K + kt * 64), (__attribute__((address_space(3))) unsigned*)(sa + 16384 + i * 4096), 16, 0, 0);
    }
  };
  const int KT = K / 64;
  issue(0, 0);
  asm volatile("s_waitcnt vmcnt(0)" ::: "memory");
  __syncthreads();
  const int sw = fr & 7;
  for (int kt = 0; kt < KT; ++kt) {
    if (kt + 1 < KT) issue(kt + 1, (kt + 1) & 1);
    const char* As = smem + (kt & 1) * 32768;
    const char* Bs = As + 16384;
#pragma unroll
    for (int ks = 0; ks < 2; ++ks) {
      bf16x8 af[4], bfr[4];
      const int so = ((ks * 4 + fq) ^ sw) * 16;
#pragma unroll
      for (int m = 0; m < 4; ++m) af[m] = *(const bf16x8*)(As + (wr * 64 + m * 16 + fr) * 128 + so);
#pragma unroll
      for (int n = 0; n < 4; ++n) bfr[n] = *(const bf16x8*)(Bs + (wc * 64 + n * 16 + fr) * 128 + so);
#pragma unroll
      for (int m = 0; m < 4; ++m)
#pragma unroll
        for (int n = 0; n < 4; ++n) acc[m][n] = MFMA16(bfr[n], af[m], acc[m][n]);
    }
    asm volatile("s_waitcnt vmcnt(0)" ::: "memory");
    __syncthreads();
  }
#pragma unroll
  for (int m = 0; m < 4; ++m)
#pragma unroll
    for (int n = 0; n < 4; ++n) epi(row0 + wr * 64 + m * 16 + fr, col0 + wc * 64 + n * 16 + fq * 4, acc[m][n]);
}

struct EpiBF {
  bf16_t* out; int ldo;
  DI void operator()(int row, int col, const f32x4& a) const {
    u32x2 o; o[0] = pack2(a[0], a[1]); o[1] = pack2(a[2], a[3]);
    *(u32x2*)(out + (size_t)row * ldo + col) = o;
  }
};
struct EpiRelu2 {
  bf16_t* out; int ldo;
  DI void operator()(int row, int col, const f32x4& a) const {
    float r0 = fmaxf(a[0], 0.f), r1 = fmaxf(a[1], 0.f), r2 = fmaxf(a[2], 0.f), r3 = fmaxf(a[3], 0.f);
    u32x2 o; o[0] = pack2(r0 * r0, r1 * r1); o[1] = pack2(r2 * r2, r3 * r3);
    *(u32x2*)(out + (size_t)row * ldo + col) = o;
  }
};
struct EpiU {
  bf16_t* u; float* dt;
  DI void operator()(int row, int col, const f32x4& a) const {
    if (col < DIN) {
      u32x2 o; o[0] = pack2(a[0], a[1]); o[1] = pack2(a[2], a[3]);
      *(u32x2*)(u + (size_t)row * DIN + col) = o;
      if (col >= U_DT) *(float4*)(dt + (size_t)row * 16 + col - U_DT) = make_float4(a[0], a[1], a[2], a[3]);
    }
  }
};
struct EpiQ {
  bf16_t* q; const float* rs;
  DI void operator()(int row, int col, const f32x4& a) const {
    const float r = rs[row * 2];
    u32x2 o; o[0] = pack2(a[0] * r, a[1] * r); o[1] = pack2(a[2] * r, a[3] * r);
    *(u32x2*)(q + (size_t)row * 384 + col) = o;
  }
};
struct EpiKV {
  bf16_t* kb; bf16_t* vt; const float* rs;
  DI void operator()(int row, int col, const f32x4& a) const {
    int b, pos;
    if (row < ML) { b = row >> 12; pos = (row & 4095) + CTX; } else { int rr = row - ML; b = rr >> 8; pos = rr & 255; }
    const int head = col >> 7, d = col & 127;
    const float r = rs[row * 2 + 1];
    if (d < 64) {
      u32x2 o; o[0] = pack2(a[0] * r, a[1] * r); o[1] = pack2(a[2] * r, a[3] * r);
      *(u32x2*)(kb + ((size_t)(b * 4 + head) * LK + pos) * 96 + d) = o;
    } else {
#pragma unroll
      for (int j = 0; j < 4; ++j) vt[((size_t)(b * 4 + head) * 64 + (d - 64 + j)) * LK + pos] = f2bf(a[j] * r);
    }
  }
};

DI void phase_inproj(const Params& p, int layer, int bid, int nb, char* smem) {
  constexpr int NT = DINP / 128;
  EpiU epi{(bf16_t*)(p.ws + OFF_U), (float*)(p.ws + OFF_DT)};
  for (int rep = 0; rep < REP_GEMM; ++rep)
  for (int it = bid; it < (MT / 128) * NT; it += nb)
    gemm_tile_glds((const bf16_t*)(p.ws + OFF_H), DM, wt_ptr(p, layer, WT_IN), 1024, (it / NT) * 128, (it % NT) * 128, smem, epi);
}
DI void phase_wout(const Params& p, int layer, int bid, int nb, char* smem) {
  const int M = layer == 0 ? MT : ML;
  EpiBF epi{(bf16_t*)(p.ws + OFF_U), DM};
  const int x = bid & 7, per = nb >> 3;
  for (int rep = 0; rep < REP_GEMM; ++rep)
  for (int q = bid >> 3; q < M / 128; q += per)
    gemm_tile<true>((const bf16_t*)(p.ws + OFF_H), DM, wt_ptr(p, layer, WT_OUT), 1024, ((q >> 3) * 8 + x) * 128, (q & 7) * 128, smem, epi, (const float*)(p.ws + OFF_SSQ));
}
DI void phase_ff1(const Params& p, int layer, int bid, int nb, char* smem) {
  const int M = layer == 0 ? MT : ML;
  EpiRelu2 epi{(bf16_t*)(p.ws + OFF_F1), DFF};
  for (int rep = 0; rep < REP_GEMM; ++rep)
  for (int it = bid; it < (M / 128) * 32; it += nb)
    gemm_tile_glds((const bf16_t*)(p.ws + OFF_H), DM, wt_ptr(p, layer, WT_FF1), 1024, (it / 32) * 128, (it % 32) * 128, smem, epi);
}
DI void phase_ff2(const Params& p, int layer, int bid, int nb, char* smem) {
  const int M = layer == 0 ? MT : ML;
  EpiBF epi{(bf16_t*)(p.ws + OFF_H), DM};
  const int x = bid & 7, per = nb >> 3;
  for (int rep = 0; rep < REP_GEMM; ++rep)
  for (int q = bid >> 3; q < M / 128; q += per)
    gemm_tile_glds((const bf16_t*)(p.ws + OFF_F1), DFF, wt_ptr(p, layer, WT_FF2), 4096, ((q >> 3) * 8 + x) * 128, (q & 7) * 128, smem, epi);
}

DI int chunk_row0(int b, int tc) { return tc < 2 ? ML + b * CTX + tc * 128 : b * SEQ + (tc - 2) * 128; }
constexpr int BST = 72;
constexpr int TST = 136;
DI void load_tile_T(bf16_t* dst, const bf16_t* __restrict__ src, int ldg) {
  const int tid = ltid();
#pragma unroll
  for (int i = 0; i < 4; ++i) {
    int c = tid + 256 * i, tok = c & 127, pc = c >> 7;
    u32x4 v = *(const u32x4*)(src + (size_t)tok * ldg + pc * 8);
#pragma unroll
    for (int j = 0; j < 4; ++j) {
      dst[(pc * 8 + 2 * j) * TST + tok] = (bf16_t)(v[j] & 0xffffu);
      dst[(pc * 8 + 2 * j + 1) * TST + tok] = (bf16_t)(v[j] >> 16);
    }
  }
}
DI void chunk_scan(const Params& p, int layer, int row0, int h, float* csf, float* csb, float* dtF, float* dtB, float* tot, float*  ) {
  const int tid = ltid(), w = tid >> 6, lane = tid & 63;
  const float* DT = (const float*)(p.ws + OFF_DT);
  float v;
  if (tid < 128) {
    const float dt = DT[(size_t)(row0 + tid) * 16 + h];
    v = dt * -__expf(p.a_log[layer * 16 + h]);
    dtF[tid] = dt;
  } else {
    const int e = 255 - tid;
    const float dt = DT[(size_t)(row0 + e) * 16 + 8 + h];
    v = dt * -__expf(p.a_log[layer * 16 + 8 + h]);
    dtB[e] = dt;
  }
#pragma unroll
  for (int o = 1; o < 64; o <<= 1) { const float t = __shfl_up(v, o); if (lane >= o) v += t; }
  if (lane == 63) tot[w] = v;
  __syncthreads();
  if (w == 1) v += tot[0];
  if (w == 3) v += tot[2];
  if (tid < 128) csf[tid] = v; else csb[255 - tid] = v;
  __syncthreads();
}

DI void ssd_state_item(const Params& p, int layer, int b, int tc, int h, char* smem) {
  bf16_t* XT = (bf16_t*)smem;
  bf16_t* BT = XT + 64 * TST;
  float* csf = (float*)(BT + 64 * TST);
  float* csb = csf + 128; float* dtF = csb + 128; float* dtB = dtF + 128; float* laF = dtB + 128; float* laB = laF + 128;
  const int tid = ltid(), w = tid >> 6, lane = tid & 63, r = lane & 31, hh = lane >> 5;
  const int row0 = chunk_row0(b, tc);
  const bf16_t* XBC = (const bf16_t*)(p.ws + OFF_XBC);
  load_tile_T(XT, XBC + (size_t)row0 * 768 + h * 64, 768);
  load_tile_T(BT, XBC + (size_t)row0 * 768 + 512 + (h >> 2) * 64, 768);
  chunk_scan(p, layer, row0, h, csf, csb, dtF, dtB, laF, laB);
  __syncthreads();
  if (tid < 128) laF[tid] = dtF[tid] * __expf(csf[127] - csf[tid]);
  else { int t = tid - 128; laB[t] = dtB[t] * __expf(csb[0] - csb[t]); }
  __syncthreads();
  const int d = w >> 1, pt = w & 1;
  const float* wv = d == 0 ? laF : laB;
  f32x16 acc[2];
#pragma unroll
  for (int i = 0; i < 16; ++i) { acc[0][i] = 0.f; acc[1][i] = 0.f; }
#pragma unroll
  for (int s = 0; s < 8; ++s) {
    int l0 = 16 * s + 8 * hh;
    u32x4 xa = *(const u32x4*)(XT + (32 * pt + r) * TST + l0);
    u32x4 sa;
#pragma unroll
    for (int j = 0; j < 4; ++j) sa[j] = pack2(lo2f(xa[j]) * wv[l0 + 2 * j], hi2f(xa[j]) * wv[l0 + 2 * j + 1]);
    bf16x8 af = __builtin_bit_cast(bf16x8, sa);
#pragma unroll
    for (int nt = 0; nt < 2; ++nt) {
      bf16x8 bfr = *(const bf16x8*)(BT + (32 * nt + r) * TST + l0);
      acc[nt] = MFMA32(af, bfr, acc[nt]);
    }
  }
  bf16_t* S = (bf16_t*)(p.ws + OFF_SST) + ((((size_t)d * NB + b) * NCH + tc) * 8 + h) * 4096;
#pragma unroll
  for (int nt = 0; nt < 2; ++nt)
#pragma unroll
    for (int i = 0; i < 16; ++i) S[(32 * pt + crow(i, hh)) * 64 + 32 * nt + r] = f2bf(acc[nt][i]);
  if (tid == 0) {
    float* TD = (float*)(p.ws + OFF_TDEC);
    TD[((0 * NB + b) * NCH + tc) * 8 + h] = __expf(csf[127]);
    TD[((1 * NB + b) * NCH + tc) * 8 + h] = __expf(csb[0]);
  }
  __syncthreads();
}

DI void ssd_pass_item(const Params& p, int it) {
  const int e = it * 256 + ltid();
  const int pn2 = e & 2047, h = (e >> 11) & 7, b = (e >> 14) & 3, d = e >> 16;
  unsigned* S = (unsigned*)(p.ws + OFF_SST);
  const float* TD = (const float*)(p.ws + OFF_TDEC);
  unsigned sv[NCH]; float T[NCH];
#pragma unroll
  for (int i = 0; i < NCH; ++i) {
    int tc = d == 0 ? i : (i < 2 ? 1 - i : NCH + 1 - i);
    sv[i] = S[(((size_t)(d * NB + b) * NCH + tc) * 8 + h) * 2048 + pn2];
    T[i] = TD[((d * NB + b) * NCH + tc) * 8 + h];
  }
  float h0 = 0.f, h1 = 0.f;
#pragma unroll
  for (int i = 0; i < NCH; ++i) {
    int tc = d == 0 ? i : (i < 2 ? 1 - i : NCH + 1 - i);
    S[(((size_t)(d * NB + b) * NCH + tc) * 8 + h) * 2048 + pn2] = pack2(h0, h1);
    h0 = T[i] * h0 + lo2f(sv[i]); h1 = T[i] * h1 + hi2f(sv[i]);
  }
}

DI void ssd_out_item(const Params& p, int layer, int b, int tc, int h, char* smem) {
  bf16_t* XT = (bf16_t*)smem;
  bf16_t* Bs = XT + 64 * TST;
  float* csf = (float*)(Bs + 128 * BST);
  float* csb = csf + 128; float* dtF = csb + 128; float* dtB = dtF + 128; float* laF = dtB + 128; float* laB = laF + 128;
  const int tid = ltid(), w = tid >> 6, lane = tid & 63, r = lane & 31, hh = lane >> 5;
  const int row0 = chunk_row0(b, tc), g = h >> 2;
  const bf16_t* XBC = (const bf16_t*)(p.ws + OFF_XBC);
  load_tile_T(XT, XBC + (size_t)row0 * 768 + h * 64, 768);
#pragma unroll
  for (int i = 0; i < 4; ++i) {
    int c = tid + 256 * i, tok = c >> 3, part = c & 7;
    *(u32x4*)(Bs + tok * BST + part * 8) = *(const u32x4*)(XBC + (size_t)(row0 + tok) * 768 + 512 + g * 64 + part * 8);
  }
  const int l = 32 * w + r;
  bf16x8 cf[4];
#pragma unroll
  for (int ks = 0; ks < 4; ++ks) cf[ks] = *(const bf16x8*)(XBC + (size_t)(row0 + l) * 768 + 640 + g * 64 + 16 * ks + 8 * hh);
  chunk_scan(p, layer, row0, h, csf, csb, dtF, dtB, laF, laB);
  const float csf_l = csf[l], csb_l = csb[l];
  f32x16 yacc[2];
#pragma unroll
  for (int i = 0; i < 16; ++i) { yacc[0][i] = 0.f; yacc[1][i] = 0.f; }
#pragma unroll
  for (int st = 0; st < 4; ++st) {
    f32x16 gacc;
#pragma unroll
    for (int i = 0; i < 16; ++i) gacc[i] = 0.f;
#pragma unroll
    for (int ks = 0; ks < 4; ++ks) {
      bf16x8 af = *(const bf16x8*)(Bs + (32 * st + r) * BST + 16 * ks + 8 * hh);
      gacc = MFMA32(af, cf[ks], gacc);
    }
#pragma unroll
    for (int i = 0; i < 16; ++i) {
      int s = 32 * st + crow(i, hh);
      float f;
      if (s < l) f = __expf(csf_l - csf[s]) * dtF[s];
      else if (s > l) f = __expf(csb_l - csb[s]) * dtB[s];
      else f = dtF[s] + dtB[s];
      gacc[i] *= f;
    }
#pragma unroll
    for (int s2 = 0; s2 < 2; ++s2) {
      bf16x8 mf = pack8(gacc, s2);
      int sb = 32 * st + 16 * s2 + 4 * hh;
#pragma unroll
      for (int pt = 0; pt < 2; ++pt) {
        u32x2 lo = *(const u32x2*)(XT + (32 * pt + r) * TST + sb);
        u32x2 hi = *(const u32x2*)(XT + (32 * pt + r) * TST + sb + 8);
        u32x4 xa; xa[0] = lo[0]; xa[1] = lo[1]; xa[2] = hi[0]; xa[3] = hi[1];
        yacc[pt] = MFMA32(__builtin_bit_cast(bf16x8, xa), mf, yacc[pt]);
      }
    }
  }
#pragma unroll
  for (int d = 0; d < 2; ++d) {
    const bf16_t* Hs = (const bf16_t*)(p.ws + OFF_SST) + ((((size_t)d * NB + b) * NCH + tc) * 8 + h) * 4096;
    const float e = __expf(d == 0 ? csf_l : csb_l);
#pragma unroll
    for (int pt = 0; pt < 2; ++pt) {
      f32x16 t;
#pragma unroll
      for (int i = 0; i < 16; ++i) t[i] = 0.f;
#pragma unroll
      for (int ks = 0; ks < 4; ++ks) {
        bf16x8 af = *(const bf16x8*)(Hs + (32 * pt + r) * 64 + 16 * ks + 8 * hh);
        t = MFMA32(af, cf[ks], t);
      }
#pragma unroll
      for (int i = 0; i < 16; ++i) yacc[pt][i] += e * t[i];
    }
  }
  const int row = row0 + l;
  const float Dh = p.ssd_d[layer * 8 + h];
  const bf16_t* U = (const bf16_t*)(p.ws + OFF_U);
  bf16_t* YM = (bf16_t*)(p.ws + OFF_H);
  float ssq = 0.f;
#pragma unroll
  for (int pt = 0; pt < 2; ++pt)
#pragma unroll
    for (int q = 0; q < 4; ++q) {
      int pp = 32 * pt + 8 * q + 4 * hh;
      u32x2 xv = *(const u32x2*)(XBC + (size_t)row * 768 + h * 64 + pp);
      u32x2 zv = *(const u32x2*)(U + (size_t)row * DIN + U_Z + h * 64 + pp);
      float y0 = (yacc[pt][4 * q + 0] + Dh * lo2f(xv[0])) * silu_f(lo2f(zv[0]));
      float y1 = (yacc[pt][4 * q + 1] + Dh * hi2f(xv[0])) * silu_f(hi2f(zv[0]));
      float y2 = (yacc[pt][4 * q + 2] + Dh * lo2f(xv[1])) * silu_f(lo2f(zv[1]));
      float y3 = (yacc[pt][4 * q + 3] + Dh * hi2f(xv[1])) * silu_f(hi2f(zv[1]));
      u32x2 o; o[0] = pack2(y0, y1); o[1] = pack2(y2, y3);
      float r0 = lo2f(o[0]), r1 = hi2f(o[0]), r2 = lo2f(o[1]), r3 = hi2f(o[1]);
      ssq += r0 * r0 + r1 * r1 + r2 * r2 + r3 * r3;
      *(u32x2*)(YM + (size_t)row * DM + 512 + h * 64 + pp) = o;
    }
  ssq += __shfl_xor(ssq, 32);
  if (hh == 0) ((float*)(p.ws + OFF_SSQ))[(size_t)row * 8 + h] = ssq;
  __syncthreads();
}

constexpr int KST = 104;
constexpr int VST = 68;
DI void attn_item(const Params& p, int b, int head, int qrow0, int t0, bool lat, int nkeys, char* smem) {
  bf16_t* Ks = (bf16_t*)smem;
  bf16_t* Vs = Ks + 64 * KST;
  const int tid = ltid(), w = tid >> 6, lane = tid & 63, r = lane & 31, hh = lane >> 5;
  const bf16_t* QB = (const bf16_t*)(p.ws + OFF_QB);
  const bf16_t* KB = (const bf16_t*)(p.ws + OFF_KB) + (size_t)(b * 4 + head) * LK * 96;
  const bf16_t* VT = (const bf16_t*)(p.ws + OFF_VT) + (size_t)(b * 4 + head) * 64 * LK;
  const float qscale = 0.10206207261596575f * 1.4426950408889634f;
  const int qrow = qrow0 + w * 32 + r;
  const int t = t0 + w * 32 + r;
  bf16x8 qf[6];
  {
    const bf16_t* src = QB + (size_t)qrow * 384 + head * 96;
#pragma unroll
    for (int s = 0; s < 4; ++s) {
      u32x4 v = *(const u32x4*)(src + 16 * s + 8 * hh);
      u32x4 o;
#pragma unroll
      for (int j = 0; j < 4; ++j) o[j] = pack2(lo2f(v[j]) * qscale, hi2f(v[j]) * qscale);
      qf[s] = __builtin_bit_cast(bf16x8, o);
    }
#pragma unroll
    for (int s = 4; s < 6; ++s) {
      u32x4 va = *(const u32x4*)(src + 16 * s), vb = *(const u32x4*)(src + 16 * s + 8);
      float posf = s == 4 ? (float)(t >> 6) : (float)(t & 63);
      float o[8];
#pragma unroll
      for (int j = 0; j < 8; ++j) {
        float a = (j & 1) ? hi2f(va[j >> 1]) : lo2f(va[j >> 1]);
        float bb = (j & 1) ? hi2f(vb[j >> 1]) : lo2f(vb[j >> 1]);
        float res;
        if (lat) {
          float invf = exp2f(-(float)(2 * j) * (13.287712379549449f / 16.f));
          float rev = posf * invf * 0.15915494309189535f;
          float cs = __builtin_amdgcn_cosf(rev), sn = __builtin_amdgcn_sinf(rev);
          res = hh == 0 ? a * cs - bb * sn : bb * cs + a * sn;
        } else res = hh == 0 ? a : bb;
        o[j] = res * qscale;
      }
      u32x4 ov; ov[0] = pack2(o[0], o[1]); ov[1] = pack2(o[2], o[3]); ov[2] = pack2(o[4], o[5]); ov[3] = pack2(o[6], o[7]);
      qf[s] = __builtin_bit_cast(bf16x8, ov);
    }
  }
  f32x16 oacc[2];
#pragma unroll
  for (int i = 0; i < 16; ++i) { oacc[0][i] = 0.f; oacc[1][i] = 0.f; }
  float m = -1e30f, lsum = 0.f;
  u32x4 rk[3], rv[2];
  auto gload = [&](int key0) {
#pragma unroll
    for (int i = 0; i < 3; ++i) rk[i] = *(const u32x4*)(KB + (size_t)key0 * 96 + (tid + 256 * i) * 8);
#pragma unroll
    for (int i = 0; i < 2; ++i) { int c = tid + 256 * i; rv[i] = *(const u32x4*)(VT + (size_t)(c >> 3) * LK + key0 + (c & 7) * 8); }
  };
  gload(0);
  const int NT = nkeys / 64;
  for (int kt = 0; kt < NT; ++kt) {
#pragma unroll
    for (int i = 0; i < 3; ++i) { int c = tid + 256 * i; *(u32x4*)(Ks + (c / 12) * KST + (c % 12) * 8) = rk[i]; }
#pragma unroll
    for (int i = 0; i < 2; ++i) {
      int c = tid + 256 * i;
      bf16_t* d = Vs + (c >> 3) * VST + (c & 7) * 8;
      u32x2 a; a[0] = rv[i][0]; a[1] = rv[i][1];
      u32x2 bq; bq[0] = rv[i][2]; bq[1] = rv[i][3];
      *(u32x2*)d = a; *(u32x2*)(d + 4) = bq;
    }
    __syncthreads();
    if (kt + 1 < NT) gload((kt + 1) * 64);
    f32x16 sacc[2];
#pragma unroll
    for (int i = 0; i < 16; ++i) { sacc[0][i] = 0.f; sacc[1][i] = 0.f; }
#pragma unroll
    for (int s = 0; s < 6; ++s)
#pragma unroll
      for (int k2 = 0; k2 < 2; ++k2) {
        bf16x8 af = *(const bf16x8*)(Ks + (32 * k2 + r) * KST + 16 * s + 8 * hh);
        sacc[k2] = MFMA32(af, qf[s], sacc[k2]);
      }
    float mx = sacc[0][0];
#pragma unroll
    for (int i = 0; i < 16; ++i) { mx = fmaxf(mx, sacc[0][i]); mx = fmaxf(mx, sacc[1][i]); }
    mx = fmaxf(mx, __shfl_xor(mx, 32));
    const float mn = fmaxf(m, mx);
    const float alpha = __builtin_amdgcn_exp2f(m - mn);
    m = mn;
    float ps = 0.f;
#pragma unroll
    for (int i = 0; i < 16; ++i) {
      sacc[0][i] = __builtin_amdgcn_exp2f(sacc[0][i] - mn); sacc[1][i] = __builtin_amdgcn_exp2f(sacc[1][i] - mn);
      ps += sacc[0][i] + sacc[1][i];
    }
    lsum = lsum * alpha + ps;
#pragma unroll
    for (int i = 0; i < 16; ++i) { oacc[0][i] *= alpha; oacc[1][i] *= alpha; }
#pragma unroll
    for (int k2 = 0; k2 < 2; ++k2)
#pragma unroll
      for (int s2 = 0; s2 < 2; ++s2) {
        bf16x8 pf = pack8(sacc[k2], s2);
        int kb0 = 32 * k2 + 16 * s2 + 4 * hh;
#pragma unroll
        for (int d = 0; d < 2; ++d) {
          u32x2 lo = *(const u32x2*)(Vs + (32 * d + r) * VST + kb0);
          u32x2 hi = *(const u32x2*)(Vs + (32 * d + r) * VST + kb0 + 8);
          u32x4 va; va[0] = lo[0]; va[1] = lo[1]; va[2] = hi[0]; va[3] = hi[1];
          oacc[d] = MFMA32(__builtin_bit_cast(bf16x8, va), pf, oacc[d]);
        }
      }
    __syncthreads();
  }
  lsum += __shfl_xor(lsum, 32);
  const float inv = 1.f / lsum;
  bf16_t* YM = (bf16_t*)(p.ws + OFF_H) + (size_t)qrow * DM + head * 64;
#pragma unroll
  for (int d = 0; d < 2; ++d)
#pragma unroll
    for (int q = 0; q < 4; ++q) {
      u32x2 o; o[0] = pack2(oacc[d][4 * q] * inv, oacc[d][4 * q + 1] * inv); o[1] = pack2(oacc[d][4 * q + 2] * inv, oacc[d][4 * q + 3] * inv);
      *(u32x2*)(YM + 32 * d + 8 * q + 4 * hh) = o;
    }
}

DI void phase_qkv(const Params& p, int layer, int bid, int nb, char* smem) {
  const int MQ = layer == 0 ? MT : ML;
  const int nq = (MQ / 128) * 3, nkv = (MT / 128) * 4, nst = NB * NCH * 8;
  const float* RS = (const float*)(p.ws + OFF_RSTD);
  EpiQ eq{(bf16_t*)(p.ws + OFF_QB), RS};
  EpiKV ekv{(bf16_t*)(p.ws + OFF_KB), (bf16_t*)(p.ws + OFF_VT), RS};
  const bf16_t* U = (const bf16_t*)(p.ws + OFF_U);
  for (int it = bid; it < nq + nkv + nst; it += nb) {
    if (it < nq) gemm_tile<false>(U, DIN, wt_ptr(p, layer, WT_UQ), 256, (it / 3) * 128, (it % 3) * 128, smem, eq);
    else if (it < nq + nkv) { int j = it - nq; gemm_tile<false>(U + U_CKV, DIN, wt_ptr(p, layer, WT_UKV), 128, (j / 4) * 128, (j % 4) * 128, smem, ekv); }
    else { int j = it - nq - nkv; for (int rep = 0; rep < REP_SSD; ++rep) ssd_state_item(p, layer, j / (NCH * 8), (j / 8) % NCH, j & 7, smem); }
  }
}
DI void phase_att(const Params& p, int layer, int bid, int nb, char* smem) {
  const int natt = 512 + (layer == 0 ? 32 : 0), npass = 512;
  for (int it = bid; it < natt + npass; it += nb) {
    if (it < 512) { int b = it >> 7, head = (it >> 5) & 3, qb = it & 31; for (int rep = 0; rep < REP_ATT; ++rep) attn_item(p, b, head, b * SEQ + qb * 128, qb * 128, true, LK, smem); }
    else if (it < natt) { int j = it - 512; int b = j >> 3, head = (j >> 1) & 3, qb = j & 1; attn_item(p, b, head, ML + b * CTX + qb * 128, qb * 128, false, CTX, smem); }
    else ssd_pass_item(p, it - natt);
  }
}
DI void phase_ssdout(const Params& p, int layer, int bid, int nb, char* smem) {
  for (int it = bid; it < NB * NCH * 8; it += nb) {
    int b = it / (NCH * 8), tc = (it / 8) % NCH, h = it & 7;
    if (layer == 1 && tc < 2) continue;
    for (int rep = 0; rep < REP_SSD; ++rep) ssd_out_item(p, layer, b, tc, h, smem);
  }
}


#define XB_TMO      128
#define XB_XCNT(j)  (256  + 64 * (j))
#define XB_XSUB(j)  (1280 + 64 * (j))
#define XB_XGEN(j)  (2304 + 64 * (j))
#define XB_TOP      3328
#define XB_TOPGEN   3392
#define XCD_BAR_WORDS 3456
#define XB_SPIN_CAP (1u << 22)
#define LAS __attribute__((address_space(3)))
DI unsigned xb_ld(unsigned* p) { return __hip_atomic_load(p, __ATOMIC_RELAXED, __HIP_MEMORY_SCOPE_AGENT); }
DI unsigned xb_add(unsigned* p, unsigned v) { return __hip_atomic_fetch_add(p, v, __ATOMIC_RELAXED, __HIP_MEMORY_SCOPE_AGENT); }
DI unsigned xb_xcc_id() { return (unsigned)__builtin_amdgcn_s_getreg((3 << 11) | 20) & 0xFu; }
#define XB_SPIN(cond, bar) do { unsigned _sp = 0; while (cond) { __builtin_amdgcn_s_sleep(1); \
    if ((++_sp & 255u) == 0u) { if (xb_ld(&(bar)[XB_TMO])) break; if (_sp > XB_SPIN_CAP) { atomicAdd(&(bar)[XB_TMO], 1u); break; } } } } while (0)
struct XcdBarrier { unsigned* bar; unsigned x; volatile LAS unsigned* st; };
DI XcdBarrier xcd_barrier_post(unsigned* bar, volatile LAS unsigned* st) {
  XcdBarrier b; b.bar = bar; b.x = xb_xcc_id(); b.st = st;
  if (threadIdx.x == 0) (void)xb_add(&bar[XB_XCNT(b.x)], 1u);
  return b;
}
DI void xcd_barrier_complete(unsigned* bar, unsigned x, unsigned& nloc, unsigned& nx) {
  const unsigned G = gridDim.x * gridDim.y * gridDim.z;
  unsigned sum, cnt, mine, sp = 0u;
  for (;;) {
    sum = 0u; cnt = 0u; mine = 0u;
#pragma unroll
    for (unsigned j = 0; j < 16; ++j) { const unsigned c = xb_ld(&bar[XB_XCNT(j)]); sum += c; cnt += (c > 0u) ? 1u : 0u; mine = (j == x) ? c : mine; }
    if (sum == G) break;
    __builtin_amdgcn_s_sleep(1);
    if ((++sp & 255u) == 0u) { if (xb_ld(&bar[XB_TMO])) break; if (sp > XB_SPIN_CAP) { atomicAdd(&bar[XB_TMO], 1u); break; } }
  }
  nloc = mine > 0u ? mine : 1u; nx = cnt > 0u ? cnt : 1u;
}
DI void xcd_barrier(const XcdBarrier& b) {
  asm volatile("s_waitcnt vmcnt(0)" ::: "memory");
  __syncthreads();
  if (threadIdx.x == 0) {
    unsigned* bar = b.bar;
    __builtin_amdgcn_s_waitcnt(0);
    unsigned nloc = b.st[0], nx = b.st[1];
    if (nloc == 0u) { xcd_barrier_complete(bar, b.x, nloc, nx); b.st[0] = nloc; b.st[1] = nx; }
    const unsigned old = xb_add(&bar[XB_XSUB(b.x)], 1u);
    const unsigned gen = old / nloc;
    if (old + 1u == (gen + 1u) * nloc) {
      __builtin_amdgcn_fence(__ATOMIC_RELEASE, "agent");
      asm volatile("s_waitcnt vmcnt(0)" ::: "memory");
      const unsigned og = xb_add(&bar[XB_TOP], 1u);
      const unsigned tg = og / nx;
      if (og + 1u == (tg + 1u) * nx) xb_add(&bar[XB_TOPGEN], 1u);
      else XB_SPIN(xb_ld(&bar[XB_TOPGEN]) == tg, bar);
      __builtin_amdgcn_fence(__ATOMIC_ACQUIRE, "agent");
      xb_add(&bar[XB_XGEN(b.x)], 1u);
      asm volatile("s_waitcnt vmcnt(0)" ::: "memory");
    } else {
      XB_SPIN(xb_ld(&bar[XB_XGEN(b.x)]) == gen, bar);
      __builtin_amdgcn_fence(__ATOMIC_ACQUIRE, "agent");
      asm volatile("s_waitcnt vmcnt(0)" ::: "memory");
    }
  }
  __syncthreads();
}

constexpr int SMEM_BYTES = 2 * GBUF * 2;
enum { PH_PREP0 = 0, PH_H0, PH_INPROJ, PH_PREP, PH_QKV, PH_ATT, PH_SSDOUT, PH_WOUT, PH_POSTMIX, PH_FF1, PH_FF2, PH_POSTFFN, PH_SSDNORM };

DI void run_phase(const Params& p, int ph, int layer, int bid, int nb, char* smem) {
  switch (ph) {
    case PH_PREP0: phase_prep0(p, bid, nb, smem); break;
    case PH_H0: phase_h0(p, bid, nb); break;
    case PH_INPROJ: phase_inproj(p, layer, bid, nb, smem); break;
    case PH_PREP: phase_prep(p, layer, bid, nb); break;
    case PH_QKV: phase_qkv(p, layer, bid, nb, smem); break;
    case PH_ATT: phase_att(p, layer, bid, nb, smem); break;
    case PH_SSDOUT: phase_ssdout(p, layer, bid, nb, smem); break;
    case PH_SSDNORM: phase_ssdnorm(p, layer, bid, nb); break;
    case PH_WOUT: phase_wout(p, layer, bid, nb, smem); break;
    case PH_POSTMIX: phase_postmix(p, layer, bid, nb); break;
    case PH_FF1: phase_ff1(p, layer, bid, nb, smem); break;
    case PH_FF2: phase_ff2(p, layer, bid, nb, smem); break;
    case PH_POSTFFN: phase_postffn(p, layer, bid, nb); break;
  }
}

__global__ void __launch_bounds__(256, 2) mega_kernel(Params p) {
  extern __shared__ __attribute__((aligned(16))) char smem[];
  cg::grid_group grid = cg::this_grid();
  if (p.ws == nullptr) grid.sync();
  const int bid = blockIdx.x, nb = gridDim.x;
  volatile LAS unsigned* st = (volatile LAS unsigned*)(smem + SMEM_BYTES - 16);
  if (threadIdx.x == 0) { st[0] = 0u; st[1] = 0u; st[2] = 0u; st[3] = 0u; }
  __syncthreads();
  XcdBarrier xb = xcd_barrier_post((unsigned*)(p.ws + OFF_BAR), st);
  for (int step = 0; step < 22; ++step) {
    int ph, layer;
    if (step < 2) { ph = step; layer = 0; }
    else { int j = step - 2; layer = j / 10; ph = PH_INPROJ + j % 10; }
    run_phase(p, ph, layer, bid, nb, smem);
    if (step < 21) xcd_barrier(xb);
  }
}

extern "C" void kernel_launch(void* const* d_in, const int* in_sizes, int n_in, void* d_out, int out_size, void* d_ws, size_t ws_size,
                              hipStream_t stream) {
  if (ws_size < WS_NEED) { fprintf(stderr, "workspace too small: %zu < %zu\n", ws_size, (size_t)WS_NEED); return; }
  Params p{};
  const float** f = (const float**)&p;
  for (int i = 0; i < 25; ++i) f[i] = (const float*)d_in[i];
  p.out = (float*)d_out;
  p.ws = (char*)d_ws;
  static int grid_blocks = 0;
  if (!grid_blocks) {
    int dev = 0, cus = 0, per_cu = 0;
    hipGetDevice(&dev);
    hipDeviceGetAttribute(&cus, hipDeviceAttributeMultiprocessorCount, dev);
    hipFuncSetAttribute((const void*)mega_kernel, hipFuncAttributeMaxDynamicSharedMemorySize, SMEM_BYTES);
    hipOccupancyMaxActiveBlocksPerMultiprocessor(&per_cu, mega_kernel, 256, SMEM_BYTES);
    if (per_cu > 2) per_cu = 2;
    grid_blocks = cus * per_cu;
  }
  hipMemsetAsync((char*)d_ws + OFF_BAR, 0, XCD_BAR_WORDS * 4, stream);
  void* args[] = {&p};
  hipError_t e = hipLaunchCooperativeKernel((void*)mega_kernel, dim3(grid_blocks), dim3(256), args, SMEM_BYTES, stream);
  if (e != hipSuccess) fprintf(stderr, "cooperative launch failed: %s (grid %d)\n", hipGetErrorString(e), grid_blocks);
}
```

```cpp
#include <hip/hip_runtime.h>
#include <hip/hip_cooperative_groups.h>
#include <stdint.h>
#include <stdio.h>
namespace cg = cooperative_groups;

#ifndef MEGA
#define MEGA 1
#endif
#ifndef REP_GEMM
#define REP_GEMM 1
#endif
#ifndef REP_ATT
#define REP_ATT 1
#endif
#ifndef REP_SSD
#define REP_SSD 1
#endif

typedef unsigned short bf16_t;
using bf16x8 = __attribute__((ext_vector_type(8))) short;
using s16x4  = __attribute__((ext_vector_type(4))) short;
using f32x4  = __attribute__((ext_vector_type(4))) float;
using f32x16 = __attribute__((ext_vector_type(16))) float;
using u32x4  = __attribute__((ext_vector_type(4))) unsigned;
using u32x2  = __attribute__((ext_vector_type(2))) unsigned;
#define DI __device__ __forceinline__
#define MFMA32(a, b, c) __builtin_amdgcn_mfma_f32_32x32x16_bf16((a), (b), (c), 0, 0, 0)
#define MFMA16(a, b, c) __builtin_amdgcn_mfma_f32_16x16x32_bf16((a), (b), (c), 0, 0, 0)

constexpr int DM = 1024, NB = 4, SEQ = 4096, CTX = 256;
constexpr int ML = NB * SEQ;
constexpr int MC = NB * CTX;
constexpr int MT = ML + MC;
constexpr int DIN = 2480, DINP = 2560;
constexpr int LK = CTX + SEQ;
constexpr int DFF = 4096;
constexpr int NCH = 34;
constexpr float EPS = 1e-6f;
constexpr int U_CKV = 256, U_KR = 384, U_GB = 416, U_GC = 672, U_VAL = 928, U_Z = 1184, U_XBC = 1696, U_DT = 2464;

constexpr size_t AL(size_t x) { return (x + 255) & ~(size_t)255; }
constexpr size_t WT_IN = 0;
constexpr size_t WT_UQ = WT_IN + (size_t)DINP * 1024;
constexpr size_t WT_UKV = WT_UQ + (size_t)384 * 256;
constexpr size_t WT_OUT = WT_UKV + (size_t)512 * 128;
constexpr size_t WT_FF1 = WT_OUT + (size_t)1024 * 1024;
constexpr size_t WT_FF2 = WT_FF1 + (size_t)4096 * 1024;
constexpr size_t WT_ELEMS = WT_FF2 + (size_t)4096 * 1024;
constexpr size_t OFF_WT = 0;
constexpr size_t OFF_MOD = AL(OFF_WT + 2 * WT_ELEMS * 2);
constexpr size_t OFF_XC = AL(OFF_MOD + 2 * 5 * 6144 * 4);
constexpr size_t OFF_H = AL(OFF_XC + (size_t)MC * DM * 4);
constexpr size_t OFF_R1 = AL(OFF_H + (size_t)MT * DM * 2);
constexpr size_t OFF_U = OFF_R1;
constexpr size_t OFF_DT = AL(OFF_U + (size_t)MT * DIN * 2);
constexpr size_t OFF_RSTD = AL(OFF_DT + (size_t)MT * 16 * 4);
constexpr size_t OFF_QB = AL(OFF_RSTD + (size_t)MT * 2 * 4);
constexpr size_t OFF_KB = AL(OFF_QB + (size_t)MT * 384 * 2);
constexpr size_t OFF_VT = AL(OFF_KB + (size_t)NB * 4 * LK * 96 * 2);
constexpr size_t OFF_XBC = AL(OFF_VT + (size_t)NB * 4 * 64 * LK * 2);
constexpr size_t OFF_SST = AL(OFF_XBC + (size_t)MT * 768 * 2);
constexpr size_t OFF_TDEC = AL(OFF_SST + (size_t)2 * NB * NCH * 8 * 4096 * 2);
constexpr size_t OFF_SSQ = AL(OFF_TDEC + (size_t)2 * NB * NCH * 8 * 4);
constexpr size_t OFF_END1 = AL(OFF_SSQ + (size_t)MT * 8 * 4);
constexpr size_t OFF_F1 = OFF_R1;
constexpr size_t OFF_END2 = AL(OFF_F1 + (size_t)MT * DFF * 2);
constexpr size_t OFF_BAR = OFF_END1 > OFF_END2 ? OFF_END1 : OFF_END2;
constexpr size_t WS_NEED = OFF_BAR + 16384;

struct Params {
  const float *x, *c, *ctx, *c_ctx, *w_mod, *b_mod, *g_pre_mix, *w_in, *q_norm, *w_uq, *kv_norm, *w_ukv, *sc_w, *ssd_cw, *ssd_cb,
      *a_log, *dt_bias, *ssd_d, *ssd_norm, *w_out, *g_post_mix, *g_pre_ffn, *w_ff1, *w_ff2, *g_post_ffn;
  float* out;
  char* ws;
};

DI int ltid() { int t = threadIdx.x & 255; asm volatile("" : "+v"(t)); return t; }
DI int ltid512() { int t = threadIdx.x; asm volatile("" : "+v"(t)); return t; }
typedef __bf16 hbf2 __attribute__((ext_vector_type(2)));
typedef float hf2 __attribute__((ext_vector_type(2)));
DI bf16_t f2bf(float x) { return __builtin_bit_cast(bf16_t, (__bf16)x); }
DI float bf2f(unsigned v) { return __uint_as_float(v << 16); }
DI unsigned pack2(float a, float b) { hf2 v = {a, b}; return __builtin_bit_cast(unsigned, __builtin_convertvector(v, hbf2)); }
DI float lo2f(unsigned w) { return __uint_as_float(w << 16); }
DI float hi2f(unsigned w) { return __uint_as_float(w & 0xffff0000u); }
DI float wave_sum(float v) {
#pragma unroll
  for (int o = 32; o > 0; o >>= 1) v += __shfl_xor(v, o);
  return v;
}
DI float silu_f(float x) { return x / (1.f + __expf(-x)); }
DI int crow(int reg, int h) { return (reg & 3) + 8 * (reg >> 2) + 4 * h; }
DI bf16x8 pack8(const f32x16& x, int s) {
  u32x4 p;
  p[0] = pack2(x[8 * s + 0], x[8 * s + 1]); p[1] = pack2(x[8 * s + 2], x[8 * s + 3]);
  p[2] = pack2(x[8 * s + 4], x[8 * s + 5]); p[3] = pack2(x[8 * s + 6], x[8 * s + 7]);
  return __builtin_bit_cast(bf16x8, p);
}
DI const float* xin_row(const Params& p, int layer, int row) {
  if (layer == 0) return row < ML ? p.x + (size_t)row * DM : p.ctx + (size_t)(row - ML) * DM;
  return row < ML ? p.out + (size_t)row * DM : (const float*)(p.ws + OFF_XC) + (size_t)(row - ML) * DM;
}
DI float* xst_row(const Params& p, int row) {
  return row < ML ? p.out + (size_t)row * DM : (float*)(p.ws + OFF_XC) + (size_t)(row - ML) * DM;
}
DI const float* mod_ptr(const Params& p, int layer, int row, int which) {
  int bb = row < ML ? (row >> 12) : 4;
  return (const float*)(p.ws + OFF_MOD) + ((size_t)(layer * 5 + bb) * 6 + which) * DM;
}
DI bf16_t* wt_ptr(const Params& p, int layer, size_t off) { return (bf16_t*)(p.ws + OFF_WT) + (size_t)layer * WT_ELEMS + off; }

DI void transpose_item(const float* __restrict__ w, const float* __restrict__ gk, int gk_from, bf16_t* __restrict__ wt, int K, int N, int kt, int nt, char* smem) {
  float* tile = (float*)smem;
  const int tid = ltid(), tx = tid & 63, ty = tid >> 6;
  const int k0 = kt * 64, n0 = nt * 64;
  const int n = n0 + tx;
  float v[16];
#pragma unroll
  for (int i = 0; i < 16; ++i) {
    int kk = ty + 4 * i;
    v[i] = n < N ? w[(size_t)(k0 + kk) * N + n] : 0.f;
  }
  if (gk) {
#pragma unroll
    for (int i = 0; i < 16; ++i) { int k = k0 + ty + 4 * i; if (k >= gk_from) v[i] *= gk[k - gk_from]; }
  }
#pragma unroll
  for (int i = 0; i < 16; ++i) tile[(ty + 4 * i) * 65 + tx] = v[i];
  __syncthreads();
#pragma unroll
  for (int i = 0; i < 2; ++i) {
    int c = tid + 256 * i, nn = c >> 3, kc = c & 7;
    u32x4 o;
#pragma unroll
    for (int jj = 0; jj < 4; ++jj) o[jj] = pack2(tile[(kc * 8 + 2 * jj) * 65 + nn], tile[(kc * 8 + 2 * jj + 1) * 65 + nn]);
    *(u32x4*)(wt + (size_t)(n0 + nn) * K + k0 + kc * 8) = o;
  }
  __syncthreads();
}

DI void modgemv_item(const Params& p, int layer, int ct, char* smem) {
  float* s = (float*)smem;
  float* red = s + 5 * 1024;
  const int tid = ltid(), w = tid >> 6, lane = tid & 63;
  for (int i = tid; i < 5 * 1024; i += 256) {
    int bb = i >> 10, k = i & 1023;
    float v = bb < 4 ? p.c[bb * 1024 + k] : p.c_ctx[k];
    s[i] = silu_f(v);
  }
  __syncthreads();
  const float* wm = p.w_mod + (size_t)layer * 1024 * 6144;
  const int n = ct * 64 + lane;
  float acc[5] = {0.f, 0.f, 0.f, 0.f, 0.f};
#pragma unroll 16
  for (int k = w * 256; k < w * 256 + 256; ++k) {
    float wv = wm[(size_t)k * 6144 + n];
#pragma unroll
    for (int bb = 0; bb < 5; ++bb) acc[bb] += s[bb * 1024 + k] * wv;
  }
#pragma unroll
  for (int bb = 0; bb < 5; ++bb) red[(w * 5 + bb) * 64 + lane] = acc[bb];
  __syncthreads();
  for (int i = tid; i < 320; i += 256) {
    int bb = i >> 6, ln = i & 63;
    float v = red[(0 * 5 + bb) * 64 + ln] + red[(1 * 5 + bb) * 64 + ln] + red[(2 * 5 + bb) * 64 + ln] + red[(3 * 5 + bb) * 64 + ln];
    int nn = ct * 64 + ln;
    v += p.b_mod[layer * 6144 + nn];
    ((float*)(p.ws + OFF_MOD))[(size_t)(layer * 5 + bb) * 6144 + nn] = v;
  }
  __syncthreads();
}

DI void phase_prep0(const Params& p, int bid, int nb, char* smem) {
  constexpr int PER = 2984;
  for (int it = bid; it < 192 + 2 * PER; it += nb) {
    if (it < 192) { modgemv_item(p, it / 96, it % 96, smem); continue; }
    int layer = (it - 192) / PER, j = (it - 192) % PER;
    if (j < 640) transpose_item(p.w_in + (size_t)layer * 1024 * DIN, nullptr, 0, wt_ptr(p, layer, WT_IN), 1024, DIN, j / 40, j % 40, smem);
    else if ((j -= 640) < 24) transpose_item(p.w_uq + (size_t)layer * 256 * 384, p.q_norm + layer * 256, 0, wt_ptr(p, layer, WT_UQ), 256, 384, j / 6, j % 6, smem);
    else if ((j -= 24) < 16) transpose_item(p.w_ukv + (size_t)layer * 128 * 512, p.kv_norm + layer * 128, 0, wt_ptr(p, layer, WT_UKV), 128, 512, j / 8, j % 8, smem);
    else if ((j -= 16) < 256) transpose_item(p.w_out + (size_t)layer * 1024 * 1024, p.ssd_norm + layer * 512, 512, wt_ptr(p, layer, WT_OUT), 1024, 1024, j / 16, j % 16, smem);
    else if ((j -= 256) < 1024) transpose_item(p.w_ff1 + (size_t)layer * 1024 * 4096, nullptr, 0, wt_ptr(p, layer, WT_FF1), 1024, 4096, j / 64, j % 64, smem);
    else { j -= 1024; transpose_item(p.w_ff2 + (size_t)layer * 4096 * 1024, nullptr, 0, wt_ptr(p, layer, WT_FF2), 4096, 1024, j / 16, j % 16, smem); }
  }
}

DI void write_h_row(const float4 xv[4], float rstd, const float* g, const float* sh, const float* sc, bf16_t* hrow, int lane) {
#pragma unroll
  for (int i = 0; i < 4; ++i) {
    int col = lane * 4 + 256 * i;
    float4 gg = *(const float4*)(g + col), s1 = *(const float4*)(sc + col), s0 = *(const float4*)(sh + col);
    float a = xv[i].x * rstd * gg.x * (1.f + s1.x) + s0.x;
    float b = xv[i].y * rstd * gg.y * (1.f + s1.y) + s0.y;
    float c = xv[i].z * rstd * gg.z * (1.f + s1.z) + s0.z;
    float d = xv[i].w * rstd * gg.w * (1.f + s1.w) + s0.w;
    u32x2 o; o[0] = pack2(a, b); o[1] = pack2(c, d);
    *(u32x2*)(hrow + col) = o;
  }
}
DI float ssq4(const float4 v[4]) {
  float s = 0.f;
#pragma unroll
  for (int i = 0; i < 4; ++i) s += v[i].x * v[i].x + v[i].y * v[i].y + v[i].z * v[i].z + v[i].w * v[i].w;
  return s;
}
DI void load_bf_row(const bf16_t* r, int lane, float4 v[4]) {
#pragma unroll
  for (int i = 0; i < 4; ++i) {
    u32x2 t = *(const u32x2*)(r + lane * 4 + 256 * i);
    v[i] = make_float4(lo2f(t[0]), hi2f(t[0]), lo2f(t[1]), hi2f(t[1]));
  }
}

DI void phase_h0(const Params& p, int bid, int nb) {
  const int w = ltid() >> 6, lane = ltid() & 63;
  bf16_t* H = (bf16_t*)(p.ws + OFF_H);
  for (int row = bid * 4 + w; row < MT; row += nb * 4) {
    const float* xr = xin_row(p, 0, row);
    float4 xv[4];
#pragma unroll
    for (int i = 0; i < 4; ++i) xv[i] = *(const float4*)(xr + lane * 4 + 256 * i);
    float rstd = rsqrtf(wave_sum(ssq4(xv)) * (1.f / DM) + EPS);
    write_h_row(xv, rstd, p.g_pre_mix, mod_ptr(p, 0, row, 0), mod_ptr(p, 0, row, 1), H + (size_t)row * DM, lane);
  }
}

DI void phase_postmix(const Params& p, int layer, int bid, int nb) {
  const int w = ltid() >> 6, lane = ltid() & 63;
  const int M = layer == 0 ? MT : ML;
  bf16_t* H = (bf16_t*)(p.ws + OFF_H);
  const bf16_t* Y = (const bf16_t*)(p.ws + OFF_U);
  for (int row = bid * 4 + w; row < M; row += nb * 4) {
    float4 yv[4], xv[4];
    load_bf_row(Y + (size_t)row * DM, lane, yv);
    const float* xr = xin_row(p, layer, row);
#pragma unroll
    for (int i = 0; i < 4; ++i) xv[i] = *(const float4*)(xr + lane * 4 + 256 * i);
    float rstd = rsqrtf(wave_sum(ssq4(yv)) * (1.f / DM) + EPS);
    const float* g1 = mod_ptr(p, layer, row, 2);
    const float* gp = p.g_post_mix + layer * DM;
    float* xo = xst_row(p, row);
#pragma unroll
    for (int i = 0; i < 4; ++i) {
      int col = lane * 4 + 256 * i;
      float4 a = *(const float4*)(g1 + col), b = *(const float4*)(gp + col);
      xv[i].x += a.x * yv[i].x * rstd * b.x; xv[i].y += a.y * yv[i].y * rstd * b.y;
      xv[i].z += a.z * yv[i].z * rstd * b.z; xv[i].w += a.w * yv[i].w * rstd * b.w;
      *(float4*)(xo + col) = xv[i];
    }
    float rstd1 = rsqrtf(wave_sum(ssq4(xv)) * (1.f / DM) + EPS);
    write_h_row(xv, rstd1, p.g_pre_ffn + layer * DM, mod_ptr(p, layer, row, 3), mod_ptr(p, layer, row, 4), H + (size_t)row * DM, lane);
  }
}

DI void phase_postffn(const Params& p, int layer, int bid, int nb) {
  const int w = ltid() >> 6, lane = ltid() & 63;
  const int M = layer == 0 ? MT : ML;
  bf16_t* H = (bf16_t*)(p.ws + OFF_H);
  for (int row = bid * 4 + w; row < M; row += nb * 4) {
    float4 fv[4], xv[4];
    load_bf_row(H + (size_t)row * DM, lane, fv);
    float* xo = xst_row(p, row);
#pragma unroll
    for (int i = 0; i < 4; ++i) xv[i] = *(const float4*)(xo + lane * 4 + 256 * i);
    float rstd = rsqrtf(wave_sum(ssq4(fv)) * (1.f / DM) + EPS);
    const float* g2 = mod_ptr(p, layer, row, 5);
    const float* gp = p.g_post_ffn + layer * DM;
#pragma unroll
    for (int i = 0; i < 4; ++i) {
      int col = lane * 4 + 256 * i;
      float4 a = *(const float4*)(g2 + col), b = *(const float4*)(gp + col);
      xv[i].x += a.x * fv[i].x * rstd * b.x; xv[i].y += a.y * fv[i].y * rstd * b.y;
      xv[i].z += a.z * fv[i].z * rstd * b.z; xv[i].w += a.w * fv[i].w * rstd * b.w;
      *(float4*)(xo + col) = xv[i];
    }
    if (layer == 0) {
      float rstd1 = rsqrtf(wave_sum(ssq4(xv)) * (1.f / DM) + EPS);
      write_h_row(xv, rstd1, p.g_pre_mix + DM, mod_ptr(p, 1, row, 0), mod_ptr(p, 1, row, 1), H + (size_t)row * DM, lane);
    }
  }
}

DI void phase_prep(const Params& p, int layer, int bid, int nb) {
  const int w = ltid() >> 6, lane = ltid() & 63;
  const bf16_t* U = (const bf16_t*)(p.ws + OFF_U);
  float* DT = (float*)(p.ws + OFF_DT);
  float* RS = (float*)(p.ws + OFF_RSTD);
  bf16_t* KB = (bf16_t*)(p.ws + OFF_KB);
  bf16_t* XBC = (bf16_t*)(p.ws + OFF_XBC);
  bf16_t* YM = (bf16_t*)(p.ws + OFF_H);
  const float* scw = p.sc_w + layer * 3 * 256;
  const float* cw = p.ssd_cw + layer * 3 * 768;
  const float* cb = p.ssd_cb + layer * 768;
  for (int row = bid * 4 + w; row < MT; row += nb * 4) {
    int b, t, L, pos;
    bool lat = row < ML;
    if (lat) { b = row >> 12; t = row & 4095; L = SEQ; pos = t + CTX; }
    else { int rr = row - ML; b = rr >> 8; t = rr & 255; L = CTX; pos = t; }
    const bf16_t* u0 = U + (size_t)row * DIN;
    const bool hp = t > 0, hn = t < L - 1;
    const bf16_t* um = u0 - DIN;
    const bf16_t* up = u0 + DIN;
    {
      u32x2 v = *(const u32x2*)(u0 + lane * 4);
      float a = lo2f(v[0]), bq = hi2f(v[0]), c = lo2f(v[1]), d = hi2f(v[1]);
      float ss = wave_sum(a * a + bq * bq + c * c + d * d);
      float s2 = 0.f;
      if (lane < 32) {
        u32x2 v2 = *(const u32x2*)(u0 + U_CKV + lane * 4);
        float e = lo2f(v2[0]), f = hi2f(v2[0]), g = lo2f(v2[1]), h = hi2f(v2[1]);
        s2 = e * e + f * f + g * g + h * h;
      }
      s2 = wave_sum(s2);
      if (lane == 0) { RS[row * 2] = rsqrtf(ss * (1.f / 256) + EPS); RS[row * 2 + 1] = rsqrtf(s2 * (1.f / 128) + EPS); }
    }
    {
      float v = bf2f(u0[U_KR + (lane & 31)]);
      float partner = __shfl_xor(v, 8);
      float o = v;
      if (lat) {
        int grp = (lane & 31) >> 3, i = lane & 7;
        float posf = grp < 2 ? (float)(t >> 6) : (float)(t & 63);
        float invf = exp2f(-(float)(2 * i) * (13.287712379549449f / 16.f));
        float ang = posf * invf;
        float rev = ang * 0.15915494309189535f;
        float cs = __builtin_amdgcn_cosf(rev), sn = __builtin_amdgcn_sinf(rev);
        o = (grp & 1) ? v * cs + partner * sn : v * cs - partner * sn;
      }
      if (lane < 32) {
        bf16_t ob = f2bf(o);
#pragma unroll
        for (int hd = 0; hd < 4; ++hd) KB[((size_t)(b * 4 + hd) * LK + pos) * 96 + 64 + lane] = ob;
      }
    }
    {
      int c = lane * 4;
      float acc[4] = {0.f, 0.f, 0.f, 0.f};
#pragma unroll
      for (int k = 0; k < 3; ++k) {
        const bf16_t* ur = k == 0 ? um : (k == 1 ? u0 : up);
        bool ok = k == 0 ? hp : (k == 1 ? true : hn);
        if (ok) {
          u32x2 gc = *(const u32x2*)(ur + U_GC + c), vv = *(const u32x2*)(ur + U_VAL + c);
          float4 wk = *(const float4*)(scw + k * 256 + c);
          acc[0] += wk.x * lo2f(gc[0]) * lo2f(vv[0]); acc[1] += wk.y * hi2f(gc[0]) * hi2f(vv[0]);
          acc[2] += wk.z * lo2f(gc[1]) * lo2f(vv[1]); acc[3] += wk.w * hi2f(gc[1]) * hi2f(vv[1]);
        }
      }
      u32x2 gb = *(const u32x2*)(u0 + U_GB + c);
      u32x2 o; o[0] = pack2(lo2f(gb[0]) * acc[0], hi2f(gb[0]) * acc[1]); o[1] = pack2(lo2f(gb[1]) * acc[2], hi2f(gb[1]) * acc[3]);
      *(u32x2*)(YM + (size_t)row * DM + 256 + c) = o;
    }
#pragma unroll
    for (int i = 0; i < 3; ++i) {
      int c = lane * 4 + 256 * i;
      float4 bias = *(const float4*)(cb + c);
      float acc[4] = {bias.x, bias.y, bias.z, bias.w};
#pragma unroll
      for (int k = 0; k < 3; ++k) {
        const bf16_t* ur = k == 0 ? um : (k == 1 ? u0 : up);
        bool ok = k == 0 ? hp : (k == 1 ? true : hn);
        if (ok) {
          u32x2 vv = *(const u32x2*)(ur + U_XBC + c);
          float4 wk = *(const float4*)(cw + k * 768 + c);
          acc[0] += wk.x * lo2f(vv[0]); acc[1] += wk.y * hi2f(vv[0]); acc[2] += wk.z * lo2f(vv[1]); acc[3] += wk.w * hi2f(vv[1]);
        }
      }
      u32x2 o; o[0] = pack2(silu_f(acc[0]), silu_f(acc[1])); o[1] = pack2(silu_f(acc[2]), silu_f(acc[3]));
      *(u32x2*)(XBC + (size_t)row * 768 + c) = o;
    }
    if (lane < 16) {
      float v = DT[(size_t)row * 16 + lane] + p.dt_bias[layer * 16 + lane];
      const float e = __expf(-fabsf(v));
      float sp = fmaxf(v, 0.f) + (e < 1e-3f ? e * (1.f - 0.5f * e) : __logf(1.f + e));
      DT[(size_t)row * 16 + lane] = sp;
    }
  }
}

DI void phase_ssdnorm(const Params& p, int layer, int bid, int nb) {
  const int w = ltid() >> 6, lane = ltid() & 63;
  const int M = layer == 0 ? MT : ML;
  bf16_t* YM = (bf16_t*)(p.ws + OFF_H);
  const float* SSQ = (const float*)(p.ws + OFF_SSQ);
  const float* ng = p.ssd_norm + layer * 512;
  for (int row = bid * 4 + w; row < M; row += nb * 4) {
    int g = lane >> 5;
    float4 s = *(const float4*)(SSQ + (size_t)row * 8 + g * 4);
    float rstd = rsqrtf((s.x + s.y + s.z + s.w) * (1.f / 256) + EPS);
    bf16_t* ptr = YM + (size_t)row * DM + 512 + lane * 8;
    u32x4 v = *(const u32x4*)ptr;
    float4 g0 = *(const float4*)(ng + lane * 8), g1 = *(const float4*)(ng + lane * 8 + 4);
    u32x4 o;
    o[0] = pack2(lo2f(v[0]) * rstd * g0.x, hi2f(v[0]) * rstd * g0.y);
    o[1] = pack2(lo2f(v[1]) * rstd * g0.z, hi2f(v[1]) * rstd * g0.w);
    o[2] = pack2(lo2f(v[2]) * rstd * g1.x, hi2f(v[2]) * rstd * g1.y);
    o[3] = pack2(lo2f(v[3]) * rstd * g1.z, hi2f(v[3]) * rstd * g1.w);
    *(u32x4*)ptr = o;
  }
}

constexpr int GST = 80;
constexpr int GBUF = 2 * 128 * GST;
template <bool GN, class Epi>
DI void gemm_tile(const bf16_t* __restrict__ A, int lda, const bf16_t* __restrict__ Bt, int K, int row0, int col0, char* smem, Epi epi, const float* __restrict__ ssq = nullptr) {
  bf16_t* S0 = (bf16_t*)smem;
  const int tid = ltid(), wid = tid >> 6, lane = tid & 63, wr = wid >> 1, wc = wid & 1, fr = lane & 15, fq = lane >> 4;
  f32x4 acc[4][4];
#pragma unroll
  for (int m = 0; m < 4; ++m)
#pragma unroll
    for (int n = 0; n < 4; ++n) acc[m][n] = f32x4{0.f, 0.f, 0.f, 0.f};
  u32x4 ra[4], rb[4];
  const int sr = tid >> 3, sp = tid & 7;
  const bf16_t* ga = A + (size_t)(row0 + sr) * lda + sp * 8;
  const bf16_t* gb = Bt + (size_t)(col0 + sr) * K + sp * 8;
  auto gload = [&](int k0) {
#pragma unroll
    for (int i = 0; i < 4; ++i) {
      ra[i] = *(const u32x4*)(ga + (size_t)(32 * i) * lda + k0);
      rb[i] = *(const u32x4*)(gb + (size_t)(32 * i) * K + k0);
    }
  };
  gload(0);
  float gs[4][2];
  if (GN) {
#pragma unroll
    for (int i = 0; i < 4; ++i) {
      const float4 s0 = *(const float4*)(ssq + (size_t)(row0 + sr + 32 * i) * 8), s1 = *(const float4*)(ssq + (size_t)(row0 + sr + 32 * i) * 8 + 4);
      gs[i][0] = rsqrtf((s0.x + s0.y + s0.z + s0.w) * (1.f / 256) + EPS);
      gs[i][1] = rsqrtf((s1.x + s1.y + s1.z + s1.w) * (1.f / 256) + EPS);
    }
  }
  auto swrite = [&](int kt) {
    if (GN && kt >= 8) {
      const int g = (kt - 8) >> 2;
#pragma unroll
      for (int i = 0; i < 4; ++i) {
        const float sc = g ? gs[i][1] : gs[i][0];
#pragma unroll
        for (int jj = 0; jj < 4; ++jj) ra[i][jj] = pack2(lo2f(ra[i][jj]) * sc, hi2f(ra[i][jj]) * sc);
      }
    }
    bf16_t* As = S0 + (kt & 1) * GBUF;
    bf16_t* Bs = As + 128 * GST;
#pragma unroll
    for (int i = 0; i < 4; ++i) {
      *(u32x4*)(As + (sr + 32 * i) * GST + sp * 8) = ra[i];
      *(u32x4*)(Bs + (sr + 32 * i) * GST + sp * 8) = rb[i];
    }
  };
  const int KT = K / 64;
  swrite(0);
  if (KT > 1) gload(64);
  __syncthreads();
  for (int kt = 0; kt < KT; ++kt) {
    const bf16_t* As = S0 + (kt & 1) * GBUF;
    const bf16_t* Bs = As + 128 * GST;
#pragma unroll
    for (int ks = 0; ks < 2; ++ks) {
      bf16x8 af[4], bfr[4];
#pragma unroll
      for (int m = 0; m < 4; ++m) af[m] = *(const bf16x8*)(As + (wr * 64 + m * 16 + fr) * GST + ks * 32 + fq * 8);
#pragma unroll
      for (int n = 0; n < 4; ++n) bfr[n] = *(const bf16x8*)(Bs + (wc * 64 + n * 16 + fr) * GST + ks * 32 + fq * 8);
#pragma unroll
      for (int m = 0; m < 4; ++m)
#pragma unroll
        for (int n = 0; n < 4; ++n) acc[m][n] = MFMA16(bfr[n], af[m], acc[m][n]);
      if (ks == 0 && kt + 1 < KT) {
        swrite(kt + 1);
        if (kt + 2 < KT) gload((kt + 2) * 64);
      }
    }
    __syncthreads();
  }
#pragma unroll
  for (int m = 0; m < 4; ++m)
#pragma unroll
    for (int n = 0; n < 4; ++n) epi(row0 + wr * 64 + m * 16 + fr, col0 + wc * 64 + n * 16 + fq * 4, acc[m][n]);
}

template <class Epi>
DI void gemm_tile_glds(const bf16_t* __restrict__ A, int lda, const bf16_t* __restrict__ Bt, int K, int row0, int col0, char* smem, Epi epi) {
  const int tid = ltid(), wid = tid >> 6, lane = tid & 63, wr = wid >> 1, wc = wid & 1, fr = lane & 15, fq = lane >> 4;
  f32x4 acc[4][4];
#pragma unroll
  for (int m = 0; m < 4; ++m)
#pragma unroll
    for (int n = 0; n < 4; ++n) acc[m][n] = f32x4{0.f, 0.f, 0.f, 0.f};
  const int crow = tid >> 3, cslot = tid & 7, cpart = cslot ^ (crow & 7);
  const bf16_t* ga = A + (size_t)(row0 + crow) * lda + cpart * 8;
  const bf16_t* gb = Bt + (size_t)(col0 + crow) * K + cpart * 8;
  auto issue = [&](int kt, int stage) {
    char* sa = smem + stage * 32768 + tid * 16;
#pragma unroll
    for (int i = 0; i < 4; ++i) {
      __builtin_amdgcn_global_load_lds((const unsigned*)(ga + (size_t)(32 * i) * lda + kt * 64), (__attribute__((address_space(3))) unsigned*)(sa + i * 4096), 16, 0, 0);
      __builtin_amdgcn_global_load_lds((const unsigned*)(gb + (size_t)(32 * i) * K + kt * 64), (__attribute__((address_space(3))) unsigned*)(sa + 16384 + i * 4096), 16, 0, 0);
    }
  };
  const int KT = K / 64;
  issue(0, 0);
  asm volatile("s_waitcnt vmcnt(0)" ::: "memory");
  __syncthreads();
  const int sw = fr & 7;
  for (int kt = 0; kt < KT; ++kt) {
    if (kt + 1 < KT) issue(kt + 1, (kt + 1) & 1);
    const char* As = smem + (kt & 1) * 32768;
    const char* Bs = As + 16384;
#pragma unroll
    for (int ks = 0; ks < 2; ++ks) {
      bf16x8 af[4], bfr[4];
      const int so = ((ks * 4 + fq) ^ sw) * 16;
#pragma unroll
      for (int m = 0; m < 4; ++m) af[m] = *(const bf16x8*)(As + (wr * 64 + m * 16 + fr) * 128 + so);
#pragma unroll
      for (int n = 0; n < 4; ++n) bfr[n] = *(const bf16x8*)(Bs + (wc * 64 + n * 16 + fr) * 128 + so);
#pragma unroll
      for (int m = 0; m < 4; ++m)
#pragma unroll
        for (int n = 0; n < 4; ++n) acc[m][n] = MFMA16(bfr[n], af[m], acc[m][n]);
    }
    asm volatile("s_waitcnt vmcnt(0)" ::: "memory");
    __syncthreads();
  }
#pragma unroll
  for (int m = 0; m < 4; ++m)
#pragma unroll
    for (int n = 0; n < 4; ++n) epi(row0 + wr * 64 + m * 16 + fr, col0 + wc * 64 + n * 16 + fq * 4, acc[m][n]);
}

constexpr int G8_HT = 128 * 64;
DI int g8_lds_byte(int r, int c) {
  int st = (r >> 4) * 2 + (c >> 5), rr = r & 15, cc = c & 31, ob = rr * 64 + cc * 2;
  return st * 1024 + (ob ^ (((ob >> 9) & 1) << 5));
}
DI void g8_stage_rc(int b, int& R, int& C) {
  int st = b / 1024, sb = b % 1024, swz = sb ^ (((sb >> 9) & 1) << 5);
  R = (st >> 1) * 16 + swz / 64; C = (st & 1) * 32 + (swz % 64) / 2;
}
template <class Epi>
DI void gemm8_tile(const bf16_t* __restrict__ A, int lda, const bf16_t* __restrict__ Bt, int ldb, int K, int brow, int bcol, char* smem, Epi epi) {
  bf16_t* shm = (bf16_t*)smem;
  const int tid = ltid512();
#define G8_SA(b, h) (shm + ((b) * 2 + (h)) * G8_HT)
#define G8_SB(b, h) (shm + (4 + (b) * 2 + (h)) * G8_HT)
#define G8_STAGE(P, BASE, LD, br, kt) do { const bf16_t* _g = (BASE) + (size_t)(br) * (LD) + (size_t)(kt) * 64; \
    _Pragma("unroll") for (int _i = 0; _i < 2; ++_i) { int _b = tid * 16 + _i * 8192; int _r, _c; g8_stage_rc(_b, _r, _c); \
      __builtin_amdgcn_global_load_lds((const unsigned*)(_g + (size_t)_r * (LD) + _c), \
        (__attribute__((address_space(3))) unsigned*)((char*)(P) + _b), 16, 0, 0); } } while (0)
#define G8_LDA(dst, b, h) _Pragma("unroll") for (int m = 0; m < 4; ++m) _Pragma("unroll") for (int k = 0; k < 2; ++k) \
    dst[m][k] = *reinterpret_cast<const bf16x8*>((char*)G8_SA(b, h) + g8_lds_byte(wr * 64 + m * 16 + fr, k * 32 + fq * 8))
#define G8_LDB(dst, b, h) _Pragma("unroll") for (int n = 0; n < 2; ++n) _Pragma("unroll") for (int k = 0; k < 2; ++k) \
    dst[n][k] = *reinterpret_cast<const bf16x8*>((char*)G8_SB(b, h) + g8_lds_byte(wc * 32 + n * 16 + fr, k * 32 + fq * 8))
#define G8_MMA(ai, bj, At, Bx) do { __builtin_amdgcn_s_setprio(1); \
    _Pragma("unroll") for (int m = 0; m < 4; ++m) _Pragma("unroll") for (int n = 0; n < 2; ++n) _Pragma("unroll") for (int k = 0; k < 2; ++k) \
      acc[ai][bj][m][n] = __builtin_amdgcn_mfma_f32_16x16x32_bf16(Bx[n][k], At[m][k], acc[ai][bj][m][n], 0, 0, 0); \
    __builtin_amdgcn_s_setprio(0); } while (0)
#define G8_WAIT_V(n) asm volatile("s_waitcnt vmcnt(" #n ")" ::: "memory")
#define G8_WAIT_L(n) asm volatile("s_waitcnt lgkmcnt(" #n ")" ::: "memory")
#define G8_BAR __builtin_amdgcn_s_barrier()
#define G8_SCHED __builtin_amdgcn_sched_barrier(0)
  const int wid = tid >> 6, lane = tid & 63, wr = wid >> 2, wc = wid & 3, fr = lane & 15, fq = lane >> 4;
  f32x4 acc[2][2][4][2];
#pragma unroll
  for (int a = 0; a < 2; ++a)
#pragma unroll
    for (int b = 0; b < 2; ++b)
#pragma unroll
      for (int m = 0; m < 4; ++m)
#pragma unroll
        for (int n = 0; n < 2; ++n) acc[a][b][m][n] = f32x4{0.f, 0.f, 0.f, 0.f};
  bf16x8 At[4][2], B0[2][2], B1[2][2];
  const int nt = K / 64;
  G8_STAGE(G8_SB(0, 0), Bt, ldb, bcol, 0); G8_STAGE(G8_SA(0, 0), A, lda, brow, 0);
  G8_STAGE(G8_SB(0, 1), Bt, ldb, bcol + 128, 0); G8_STAGE(G8_SA(0, 1), A, lda, brow + 128, 0);
  if (wr == 1) G8_BAR;
  G8_WAIT_V(4); G8_BAR;
  G8_STAGE(G8_SB(1, 0), Bt, ldb, bcol, 1); G8_STAGE(G8_SA(1, 0), A, lda, brow, 1); G8_STAGE(G8_SB(1, 1), Bt, ldb, bcol + 128, 1);
  G8_WAIT_V(6); G8_BAR;
  for (int t = 0; t < nt - 2; t += 2) {
    G8_LDB(B0, 0, 0); G8_SCHED; G8_LDA(At, 0, 0); G8_STAGE(G8_SA(1, 1), A, lda, brow + 128, t + 1);
    G8_WAIT_L(8); G8_BAR; G8_WAIT_L(0); G8_MMA(0, 0, At, B0); G8_BAR; G8_SCHED;
    G8_LDB(B1, 0, 1); G8_STAGE(G8_SB(0, 0), Bt, ldb, bcol, t + 2);
    G8_BAR; G8_WAIT_L(0); G8_MMA(0, 1, At, B1); G8_BAR;
    G8_LDA(At, 0, 1); G8_STAGE(G8_SA(0, 0), A, lda, brow, t + 2);
    G8_BAR; G8_WAIT_L(0); G8_MMA(1, 0, At, B0); G8_BAR; G8_SCHED;
    G8_STAGE(G8_SB(0, 1), Bt, ldb, bcol + 128, t + 2);
    G8_WAIT_V(6); G8_BAR; G8_MMA(1, 1, At, B1); G8_BAR;
    G8_LDB(B0, 1, 0); G8_SCHED; G8_LDA(At, 1, 0); G8_STAGE(G8_SA(0, 1), A, lda, brow + 128, t + 2);
    G8_WAIT_L(8); G8_BAR; G8_WAIT_L(0); G8_MMA(0, 0, At, B0); G8_BAR; G8_SCHED;
    G8_LDB(B1, 1, 1); G8_STAGE(G8_SB(1, 0), Bt, ldb, bcol, t + 3);
    G8_BAR; G8_WAIT_L(0); G8_MMA(0, 1, At, B1); G8_BAR;
    G8_LDA(At, 1, 1); G8_STAGE(G8_SA(1, 0), A, lda, brow, t + 3);
    G8_BAR; G8_WAIT_L(0); G8_MMA(1, 0, At, B0); G8_BAR; G8_SCHED;
    G8_STAGE(G8_SB(1, 1), Bt, ldb, bcol + 128, t + 3);
    G8_WAIT_V(6); G8_BAR; G8_MMA(1, 1, At, B1); G8_BAR;
  }
  { G8_LDB(B0, 0, 0); G8_LDA(At, 0, 0); G8_STAGE(G8_SA(1, 1), A, lda, brow + 128, nt - 1);
    G8_BAR; G8_WAIT_L(0); G8_MMA(0, 0, At, B0); G8_BAR;
    G8_LDB(B1, 0, 1); G8_BAR; G8_WAIT_L(0); G8_MMA(0, 1, At, B1); G8_BAR;
    G8_LDA(At, 0, 1); G8_WAIT_V(4); G8_BAR; G8_WAIT_L(0); G8_MMA(1, 0, At, B0); G8_MMA(1, 1, At, B1); G8_BAR; }
  { G8_LDB(B0, 1, 0); G8_LDA(At, 1, 0); G8_WAIT_V(2); G8_BAR; G8_WAIT_L(0); G8_MMA(0, 0, At, B0); G8_BAR;
    G8_LDB(B1, 1, 1); G8_WAIT_V(0); G8_BAR; G8_WAIT_L(0); G8_MMA(0, 1, At, B1); G8_BAR;
    G8_LDA(At, 1, 1); G8_BAR; G8_WAIT_L(0); G8_MMA(1, 0, At, B0); G8_MMA(1, 1, At, B1); G8_BAR; }
  if (wr == 0) G8_BAR;
#pragma unroll
  for (int ai = 0; ai < 2; ++ai)
#pragma unroll
    for (int bj = 0; bj < 2; ++bj)
#pragma unroll
      for (int m = 0; m < 4; ++m)
#pragma unroll
        for (int n = 0; n < 2; ++n) epi(brow + ai * 128 + wr * 64 + m * 16 + fr, bcol + bj * 128 + wc * 32 + n * 16 + fq * 4, acc[ai][bj][m][n]);
  __syncthreads();
}

struct EpiBF {
  bf16_t* out; int ldo;
  DI void operator()(int row, int col, const f32x4& a) const {
    u32x2 o; o[0] = pack2(a[0], a[1]); o[1] = pack2(a[2], a[3]);
    *(u32x2*)(out + (size_t)row * ldo + col) = o;
  }
};
struct EpiRelu2 {
  bf16_t* out; int ldo;
  DI void operator()(int row, int col, const f32x4& a) const {
    float r0 = fmaxf(a[0], 0.f), r1 = fmaxf(a[1], 0.f), r2 = fmaxf(a[2], 0.f), r3 = fmaxf(a[3], 0.f);
    u32x2 o; o[0] = pack2(r0 * r0, r1 * r1); o[1] = pack2(r2 * r2, r3 * r3);
    *(u32x2*)(out + (size_t)row * ldo + col) = o;
  }
};
struct EpiU {
  bf16_t* u; float* dt;
  DI void operator()(int row, int col, const f32x4& a) const {
    if (col < DIN) {
      u32x2 o; o[0] = pack2(a[0], a[1]); o[1] = pack2(a[2], a[3]);
      *(u32x2*)(u + (size_t)row * DIN + col) = o;
      if (col >= U_DT) *(float4*)(dt + (size_t)row * 16 + col - U_DT) = make_float4(a[0], a[1], a[2], a[3]);
    }
  }
};
struct EpiQ {
  bf16_t* q; const float* rs;
  DI void operator()(int row, int col, const f32x4& a) const {
    const float r = rs[row * 2];
    u32x2 o; o[0] = pack2(a[0] * r, a[1] * r); o[1] = pack2(a[2] * r, a[3] * r);
    *(u32x2*)(q + (size_t)row * 384 + col) = o;
  }
};
struct EpiKV {
  bf16_t* kb; bf16_t* vt; const float* rs;
  DI void operator()(int row, int col, const f32x4& a) const {
    int b, pos;
    if (row < ML) { b = row >> 12; pos = (row & 4095) + CTX; } else { int rr = row - ML; b = rr >> 8; pos = rr & 255; }
    const int head = col >> 7, d = col & 127;
    const float r = rs[row * 2 + 1];
    if (d < 64) {
      u32x2 o; o[0] = pack2(a[0] * r, a[1] * r); o[1] = pack2(a[2] * r, a[3] * r);
      *(u32x2*)(kb + ((size_t)(b * 4 + head) * LK + pos) * 96 + d) = o;
    } else {
#pragma unroll
      for (int j = 0; j < 4; ++j) vt[((size_t)(b * 4 + head) * 64 + (d - 64 + j)) * LK + pos] = f2bf(a[j] * r);
    }
  }
};

DI void phase_inproj(const Params& p, int layer, int bid, int nb, char* smem) {
  EpiU epi{(bf16_t*)(p.ws + OFF_U), (float*)(p.ws + OFF_DT)};
  const int x = bid & 7, per = nb >> 3;
  for (int rep = 0; rep < REP_GEMM; ++rep)
  for (int q = bid >> 3; q < 85; q += per) {
    const int m = (x >> 1) * 17 + q / 5, n = 5 * (x & 1) + q % 5;
    gemm8_tile((const bf16_t*)(p.ws + OFF_H), DM, wt_ptr(p, layer, WT_IN), 1024, 1024, m * 256, n * 256, smem, epi);
  }
}
DI void phase_wout(const Params& p, int layer, int lid, int nvb, char* smem) {
  const int M = layer == 0 ? MT : ML;
  EpiBF epi{(bf16_t*)(p.ws + OFF_U), DM};
  const int x = lid & 7, per = nvb >> 3;
  for (int rep = 0; rep < REP_GEMM; ++rep)
  for (int q = lid >> 3; q < M / 128; q += per)
    gemm_tile<true>((const bf16_t*)(p.ws + OFF_H), DM, wt_ptr(p, layer, WT_OUT), 1024, ((q >> 3) * 8 + x) * 128, (q & 7) * 128, smem, epi, (const float*)(p.ws + OFF_SSQ));
}
DI void phase_ff1(const Params& p, int layer, int bid, int nb, int vbid, int nvb, char* smem, char* smem_half) {
  EpiRelu2 epi{(bf16_t*)(p.ws + OFF_F1), DFF};
  const int x = bid & 7, per = nb >> 3;
  for (int rep = 0; rep < REP_GEMM; ++rep) {
    for (int q = bid >> 3; q < 128; q += per) {
      const int m = (x >> 2) * 32 + (q >> 2), n = 4 * (x & 3) + (q & 3);
      gemm8_tile((const bf16_t*)(p.ws + OFF_H), DM, wt_ptr(p, layer, WT_FF1), 1024, 1024, m * 256, n * 256, smem, epi);
    }
    if (layer == 0)
      for (int it = vbid; it < (MC / 128) * 32; it += nvb)
        gemm_tile_glds((const bf16_t*)(p.ws + OFF_H), DM, wt_ptr(p, layer, WT_FF1), 1024, ML + (it / 32) * 128, (it % 32) * 128, smem_half, epi);
  }
}
DI void phase_ff2(const Params& p, int layer, int bid, int nb, int vbid, int nvb, char* smem, char* smem_half) {
  EpiBF epi{(bf16_t*)(p.ws + OFF_H), DM};
  const int x = bid & 7, per = nb >> 3;
  for (int rep = 0; rep < REP_GEMM; ++rep) {
    for (int q = bid >> 3; q < 32; q += per) {
      const int T = x * 32 + q;
      gemm8_tile((const bf16_t*)(p.ws + OFF_F1), DFF, wt_ptr(p, layer, WT_FF2), 4096, 4096, (T >> 2) * 256, (T & 3) * 256, smem, epi);
    }
    if (layer == 0)
      for (int it = vbid; it < (MC / 128) * 8; it += nvb)
        gemm_tile_glds((const bf16_t*)(p.ws + OFF_F1), DFF, wt_ptr(p, layer, WT_FF2), 4096, ML + (it / 8) * 128, (it % 8) * 128, smem_half, epi);
  }
}

DI int chunk_row0(int b, int tc) { return tc < 2 ? ML + b * CTX + tc * 128 : b * SEQ + (tc - 2) * 128; }
constexpr int BST = 72;
constexpr int TST = 136;
DI void load_tile_T(bf16_t* dst, const bf16_t* __restrict__ src, int ldg) {
  const int tid = ltid();
#pragma unroll
  for (int i = 0; i < 4; ++i) {
    int c = tid + 256 * i, tok = c & 127, pc = c >> 7;
    u32x4 v = *(const u32x4*)(src + (size_t)tok * ldg + pc * 8);
#pragma unroll
    for (int j = 0; j < 4; ++j) {
      dst[(pc * 8 + 2 * j) * TST + tok] = (bf16_t)(v[j] & 0xffffu);
      dst[(pc * 8 + 2 * j + 1) * TST + tok] = (bf16_t)(v[j] >> 16);
    }
  }
}
DI void chunk_scan(const Params& p, int layer, int row0, int h, float* csf, float* csb, float* dtF, float* dtB, float* tot, float*  ) {
  const int tid = ltid(), w = tid >> 6, lane = tid & 63;
  const float* DT = (const float*)(p.ws + OFF_DT);
  float v;
  if (tid < 128) {
    const float dt = DT[(size_t)(row0 + tid) * 16 + h];
    v = dt * -__expf(p.a_log[layer * 16 + h]);
    dtF[tid] = dt;
  } else {
    const int e = 255 - tid;
    const float dt = DT[(size_t)(row0 + e) * 16 + 8 + h];
    v = dt * -__expf(p.a_log[layer * 16 + 8 + h]);
    dtB[e] = dt;
  }
#pragma unroll
  for (int o = 1; o < 64; o <<= 1) { const float t = __shfl_up(v, o); if (lane >= o) v += t; }
  if (lane == 63) tot[w] = v;
  __syncthreads();
  if (w == 1) v += tot[0];
  if (w == 3) v += tot[2];
  if (tid < 128) csf[tid] = v; else csb[255 - tid] = v;
  __syncthreads();
}

DI void ssd_state_item(const Params& p, int layer, int b, int tc, int h, char* smem) {
  bf16_t* XT = (bf16_t*)smem;
  bf16_t* BT = XT + 64 * TST;
  float* csf = (float*)(BT + 64 * TST);
  float* csb = csf + 128; float* dtF = csb + 128; float* dtB = dtF + 128; float* laF = dtB + 128; float* laB = laF + 128;
  const int tid = ltid(), w = tid >> 6, lane = tid & 63, r = lane & 31, hh = lane >> 5;
  const int row0 = chunk_row0(b, tc);
  const bf16_t* XBC = (const bf16_t*)(p.ws + OFF_XBC);
  load_tile_T(XT, XBC + (size_t)row0 * 768 + h * 64, 768);
  load_tile_T(BT, XBC + (size_t)row0 * 768 + 512 + (h >> 2) * 64, 768);
  chunk_scan(p, layer, row0, h, csf, csb, dtF, dtB, laF, laB);
  __syncthreads();
  if (tid < 128) laF[tid] = dtF[tid] * __expf(csf[127] - csf[tid]);
  else { int t = tid - 128; laB[t] = dtB[t] * __expf(csb[0] - csb[t]); }
  __syncthreads();
  const int d = w >> 1, pt = w & 1;
  const float* wv = d == 0 ? laF : laB;
  f32x16 acc[2];
#pragma unroll
  for (int i = 0; i < 16; ++i) { acc[0][i] = 0.f; acc[1][i] = 0.f; }
#pragma unroll
  for (int s = 0; s < 8; ++s) {
    int l0 = 16 * s + 8 * hh;
    u32x4 xa = *(const u32x4*)(XT + (32 * pt + r) * TST + l0);
    u32x4 sa;
#pragma unroll
    for (int j = 0; j < 4; ++j) sa[j] = pack2(lo2f(xa[j]) * wv[l0 + 2 * j], hi2f(xa[j]) * wv[l0 + 2 * j + 1]);
    bf16x8 af = __builtin_bit_cast(bf16x8, sa);
#pragma unroll
    for (int nt = 0; nt < 2; ++nt) {
      bf16x8 bfr = *(const bf16x8*)(BT + (32 * nt + r) * TST + l0);
      acc[nt] = MFMA32(af, bfr, acc[nt]);
    }
  }
  bf16_t* S = (bf16_t*)(p.ws + OFF_SST) + ((((size_t)d * NB + b) * NCH + tc) * 8 + h) * 4096;
#pragma unroll
  for (int nt = 0; nt < 2; ++nt)
#pragma unroll
    for (int i = 0; i < 16; ++i) S[(32 * pt + crow(i, hh)) * 64 + 32 * nt + r] = f2bf(acc[nt][i]);
  if (tid == 0) {
    float* TD = (float*)(p.ws + OFF_TDEC);
    TD[((0 * NB + b) * NCH + tc) * 8 + h] = __expf(csf[127]);
    TD[((1 * NB + b) * NCH + tc) * 8 + h] = __expf(csb[0]);
  }
  __syncthreads();
}

DI void ssd_pass_item(const Params& p, int it) {
  const int e = it * 256 + ltid();
  const int pn2 = e & 2047, h = (e >> 11) & 7, b = (e >> 14) & 3, d = e >> 16;
  unsigned* S = (unsigned*)(p.ws + OFF_SST);
  const float* TD = (const float*)(p.ws + OFF_TDEC);
  unsigned sv[NCH]; float T[NCH];
#pragma unroll
  for (int i = 0; i < NCH; ++i) {
    int tc = d == 0 ? i : (i < 2 ? 1 - i : NCH + 1 - i);
    sv[i] = S[(((size_t)(d * NB + b) * NCH + tc) * 8 + h) * 2048 + pn2];
    T[i] = TD[((d * NB + b) * NCH + tc) * 8 + h];
  }
  float h0 = 0.f, h1 = 0.f;
#pragma unroll
  for (int i = 0; i < NCH; ++i) {
    int tc = d == 0 ? i : (i < 2 ? 1 - i : NCH + 1 - i);
    S[(((size_t)(d * NB + b) * NCH + tc) * 8 + h) * 2048 + pn2] = pack2(h0, h1);
    h0 = T[i] * h0 + lo2f(sv[i]); h1 = T[i] * h1 + hi2f(sv[i]);
  }
}

DI void ssd_out_item(const Params& p, int layer, int b, int tc, int h, char* smem) {
  bf16_t* XT = (bf16_t*)smem;
  bf16_t* Bs = XT + 64 * TST;
  float* csf = (float*)(Bs + 128 * BST);
  float* csb = csf + 128; float* dtF = csb + 128; float* dtB = dtF + 128; float* laF = dtB + 128; float* laB = laF + 128;
  const int tid = ltid(), w = tid >> 6, lane = tid & 63, r = lane & 31, hh = lane >> 5;
  const int row0 = chunk_row0(b, tc), g = h >> 2;
  const bf16_t* XBC = (const bf16_t*)(p.ws + OFF_XBC);
  load_tile_T(XT, XBC + (size_t)row0 * 768 + h * 64, 768);
#pragma unroll
  for (int i = 0; i < 4; ++i) {
    int c = tid + 256 * i, tok = c >> 3, part = c & 7;
    *(u32x4*)(Bs + tok * BST + part * 8) = *(const u32x4*)(XBC + (size_t)(row0 + tok) * 768 + 512 + g * 64 + part * 8);
  }
  const int l = 32 * w + r;
  bf16x8 cf[4];
#pragma unroll
  for (int ks = 0; ks < 4; ++ks) cf[ks] = *(const bf16x8*)(XBC + (size_t)(row0 + l) * 768 + 640 + g * 64 + 16 * ks + 8 * hh);
  chunk_scan(p, layer, row0, h, csf, csb, dtF, dtB, laF, laB);
  const float csf_l = csf[l], csb_l = csb[l];
  f32x16 yacc[2];
#pragma unroll
  for (int i = 0; i < 16; ++i) { yacc[0][i] = 0.f; yacc[1][i] = 0.f; }
#pragma unroll
  for (int st = 0; st < 4; ++st) {
    f32x16 gacc;
#pragma unroll
    for (int i = 0; i < 16; ++i) gacc[i] = 0.f;
#pragma unroll
    for (int ks = 0; ks < 4; ++ks) {
      bf16x8 af = *(const bf16x8*)(Bs + (32 * st + r) * BST + 16 * ks + 8 * hh);
      gacc = MFMA32(af, cf[ks], gacc);
    }
#pragma unroll
    for (int i = 0; i < 16; ++i) {
      int s = 32 * st + crow(i, hh);
      float f;
      if (s < l) f = __expf(csf_l - csf[s]) * dtF[s];
      else if (s > l) f = __expf(csb_l - csb[s]) * dtB[s];
      else f = dtF[s] + dtB[s];
      gacc[i] *= f;
    }
#pragma unroll
    for (int s2 = 0; s2 < 2; ++s2) {
      bf16x8 mf = pack8(gacc, s2);
      int sb = 32 * st + 16 * s2 + 4 * hh;
#pragma unroll
      for (int pt = 0; pt < 2; ++pt) {
        u32x2 lo = *(const u32x2*)(XT + (32 * pt + r) * TST + sb);
        u32x2 hi = *(const u32x2*)(XT + (32 * pt + r) * TST + sb + 8);
        u32x4 xa; xa[0] = lo[0]; xa[1] = lo[1]; xa[2] = hi[0]; xa[3] = hi[1];
        yacc[pt] = MFMA32(__builtin_bit_cast(bf16x8, xa), mf, yacc[pt]);
      }
    }
  }
#pragma unroll
  for (int d = 0; d < 2; ++d) {
    const bf16_t* Hs = (const bf16_t*)(p.ws + OFF_SST) + ((((size_t)d * NB + b) * NCH + tc) * 8 + h) * 4096;
    const float e = __expf(d == 0 ? csf_l : csb_l);
#pragma unroll
    for (int pt = 0; pt < 2; ++pt) {
      f32x16 t;
#pragma unroll
      for (int i = 0; i < 16; ++i) t[i] = 0.f;
#pragma unroll
      for (int ks = 0; ks < 4; ++ks) {
        bf16x8 af = *(const bf16x8*)(Hs + (32 * pt + r) * 64 + 16 * ks + 8 * hh);
        t = MFMA32(af, cf[ks], t);
      }
#pragma unroll
      for (int i = 0; i < 16; ++i) yacc[pt][i] += e * t[i];
    }
  }
  const int row = row0 + l;
  const float Dh = p.ssd_d[layer * 8 + h];
  const bf16_t* U = (const bf16_t*)(p.ws + OFF_U);
  bf16_t* YM = (bf16_t*)(p.ws + OFF_H);
  float ssq = 0.f;
#pragma unroll
  for (int pt = 0; pt < 2; ++pt)
#pragma unroll
    for (int q = 0; q < 4; ++q) {
      int pp = 32 * pt + 8 * q + 4 * hh;
      u32x2 xv = *(const u32x2*)(XBC + (size_t)row * 768 + h * 64 + pp);
      u32x2 zv = *(const u32x2*)(U + (size_t)row * DIN + U_Z + h * 64 + pp);
      float y0 = (yacc[pt][4 * q + 0] + Dh * lo2f(xv[0])) * silu_f(lo2f(zv[0]));
      float y1 = (yacc[pt][4 * q + 1] + Dh * hi2f(xv[0])) * silu_f(hi2f(zv[0]));
      float y2 = (yacc[pt][4 * q + 2] + Dh * lo2f(xv[1])) * silu_f(lo2f(zv[1]));
      float y3 = (yacc[pt][4 * q + 3] + Dh * hi2f(xv[1])) * silu_f(hi2f(zv[1]));
      u32x2 o; o[0] = pack2(y0, y1); o[1] = pack2(y2, y3);
      float r0 = lo2f(o[0]), r1 = hi2f(o[0]), r2 = lo2f(o[1]), r3 = hi2f(o[1]);
      ssq += r0 * r0 + r1 * r1 + r2 * r2 + r3 * r3;
      *(u32x2*)(YM + (size_t)row * DM + 512 + h * 64 + pp) = o;
    }
  ssq += __shfl_xor(ssq, 32);
  if (hh == 0) ((float*)(p.ws + OFF_SSQ))[(size_t)row * 8 + h] = ssq;
  __syncthreads();
}

constexpr int KST = 104;
constexpr int VST = 68;
DI void attn_item(const Params& p, int b, int head, int qrow0, int t0, bool lat, int nkeys, char* smem) {
  bf16_t* Ks = (bf16_t*)smem;
  bf16_t* Vs = Ks + 64 * KST;
  const int tid = ltid(), w = tid >> 6, lane = tid & 63, r = lane & 31, hh = lane >> 5;
  const bf16_t* QB = (const bf16_t*)(p.ws + OFF_QB);
  const bf16_t* KB = (const bf16_t*)(p.ws + OFF_KB) + (size_t)(b * 4 + head) * LK * 96;
  const bf16_t* VT = (const bf16_t*)(p.ws + OFF_VT) + (size_t)(b * 4 + head) * 64 * LK;
  const float qscale = 0.10206207261596575f * 1.4426950408889634f;
  const int qrow = qrow0 + w * 32 + r;
  const int t = t0 + w * 32 + r;
  bf16x8 qf[6];
  {
    const bf16_t* src = QB + (size_t)qrow * 384 + head * 96;
#pragma unroll
    for (int s = 0; s < 4; ++s) {
      u32x4 v = *(const u32x4*)(src + 16 * s + 8 * hh);
      u32x4 o;
#pragma unroll
      for (int j = 0; j < 4; ++j) o[j] = pack2(lo2f(v[j]) * qscale, hi2f(v[j]) * qscale);
      qf[s] = __builtin_bit_cast(bf16x8, o);
    }
#pragma unroll
    for (int s = 4; s < 6; ++s) {
      u32x4 va = *(const u32x4*)(src + 16 * s), vb = *(const u32x4*)(src + 16 * s + 8);
      float posf = s == 4 ? (float)(t >> 6) : (float)(t & 63);
      float o[8];
#pragma unroll
      for (int j = 0; j < 8; ++j) {
        float a = (j & 1) ? hi2f(va[j >> 1]) : lo2f(va[j >> 1]);
        float bb = (j & 1) ? hi2f(vb[j >> 1]) : lo2f(vb[j >> 1]);
        float res;
        if (lat) {
          float invf = exp2f(-(float)(2 * j) * (13.287712379549449f / 16.f));
          float rev = posf * invf * 0.15915494309189535f;
          float cs = __builtin_amdgcn_cosf(rev), sn = __builtin_amdgcn_sinf(rev);
          res = hh == 0 ? a * cs - bb * sn : bb * cs + a * sn;
        } else res = hh == 0 ? a : bb;
        o[j] = res * qscale;
      }
      u32x4 ov; ov[0] = pack2(o[0], o[1]); ov[1] = pack2(o[2], o[3]); ov[2] = pack2(o[4], o[5]); ov[3] = pack2(o[6], o[7]);
      qf[s] = __builtin_bit_cast(bf16x8, ov);
    }
  }
  f32x16 oacc[2];
#pragma unroll
  for (int i = 0; i < 16; ++i) { oacc[0][i] = 0.f; oacc[1][i] = 0.f; }
  float m = -1e30f, lsum = 0.f;
  u32x4 rk[3], rv[2];
  auto gload = [&](int key0) {
#pragma unroll
    for (int i = 0; i < 3; ++i) rk[i] = *(const u32x4*)(KB + (size_t)key0 * 96 + (tid + 256 * i) * 8);
#pragma unroll
    for (int i = 0; i < 2; ++i) { int c = tid + 256 * i; rv[i] = *(const u32x4*)(VT + (size_t)(c >> 3) * LK + key0 + (c & 7) * 8); }
  };
  gload(0);
  const int NT = nkeys / 64;
  for (int kt = 0; kt < NT; ++kt) {
#pragma unroll
    for (int i = 0; i < 3; ++i) { int c = tid + 256 * i; *(u32x4*)(Ks + (c / 12) * KST + (c % 12) * 8) = rk[i]; }
#pragma unroll
    for (int i = 0; i < 2; ++i) {
      int c = tid + 256 * i;
      bf16_t* d = Vs + (c >> 3) * VST + (c & 7) * 8;
      u32x2 a; a[0] = rv[i][0]; a[1] = rv[i][1];
      u32x2 bq; bq[0] = rv[i][2]; bq[1] = rv[i][3];
      *(u32x2*)d = a; *(u32x2*)(d + 4) = bq;
    }
    __syncthreads();
    if (kt + 1 < NT) gload((kt + 1) * 64);
    f32x16 sacc[2];
#pragma unroll
    for (int i = 0; i < 16; ++i) { sacc[0][i] = 0.f; sacc[1][i] = 0.f; }
#pragma unroll
    for (int s = 0; s < 6; ++s)
#pragma unroll
      for (int k2 = 0; k2 < 2; ++k2) {
        bf16x8 af = *(const bf16x8*)(Ks + (32 * k2 + r) * KST + 16 * s + 8 * hh);
        sacc[k2] = MFMA32(af, qf[s], sacc[k2]);
      }
    float mx = sacc[0][0];
#pragma unroll
    for (int i = 0; i < 16; ++i) { mx = fmaxf(mx, sacc[0][i]); mx = fmaxf(mx, sacc[1][i]); }
    mx = fmaxf(mx, __shfl_xor(mx, 32));
    const float mn = fmaxf(m, mx);
    const float alpha = __builtin_amdgcn_exp2f(m - mn);
    m = mn;
    float ps = 0.f;
#pragma unroll
    for (int i = 0; i < 16; ++i) {
      sacc[0][i] = __builtin_amdgcn_exp2f(sacc[0][i] - mn); sacc[1][i] = __builtin_amdgcn_exp2f(sacc[1][i] - mn);
      ps += sacc[0][i] + sacc[1][i];
    }
    lsum = lsum * alpha + ps;
#pragma unroll
    for (int i = 0; i < 16; ++i) { oacc[0][i] *= alpha; oacc[1][i] *= alpha; }
#pragma unroll
    for (int k2 = 0; k2 < 2; ++k2)
#pragma unroll
      for (int s2 = 0; s2 < 2; ++s2) {
        bf16x8 pf = pack8(sacc[k2], s2);
        int kb0 = 32 * k2 + 16 * s2 + 4 * hh;
#pragma unroll
        for (int d = 0; d < 2; ++d) {
          u32x2 lo = *(const u32x2*)(Vs + (32 * d + r) * VST + kb0);
          u32x2 hi = *(const u32x2*)(Vs + (32 * d + r) * VST + kb0 + 8);
          u32x4 va; va[0] = lo[0]; va[1] = lo[1]; va[2] = hi[0]; va[3] = hi[1];
          oacc[d] = MFMA32(__builtin_bit_cast(bf16x8, va), pf, oacc[d]);
        }
      }
    __syncthreads();
  }
  lsum += __shfl_xor(lsum, 32);
  const float inv = 1.f / lsum;
  bf16_t* YM = (bf16_t*)(p.ws + OFF_H) + (size_t)qrow * DM + head * 64;
#pragma unroll
  for (int d = 0; d < 2; ++d)
#pragma unroll
    for (int q = 0; q < 4; ++q) {
      u32x2 o; o[0] = pack2(oacc[d][4 * q] * inv, oacc[d][4 * q + 1] * inv); o[1] = pack2(oacc[d][4 * q + 2] * inv, oacc[d][4 * q + 3] * inv);
      *(u32x2*)(YM + 32 * d + 8 * q + 4 * hh) = o;
    }
}

DI void phase_qkv(const Params& p, int layer, int bid, int nb, char* smem) {
  const int MQ = layer == 0 ? MT : ML;
  const int nq = (MQ / 128) * 3, nkv = (MT / 128) * 4, nst = NB * NCH * 8;
  const float* RS = (const float*)(p.ws + OFF_RSTD);
  EpiQ eq{(bf16_t*)(p.ws + OFF_QB), RS};
  EpiKV ekv{(bf16_t*)(p.ws + OFF_KB), (bf16_t*)(p.ws + OFF_VT), RS};
  const bf16_t* U = (const bf16_t*)(p.ws + OFF_U);
  for (int it = bid; it < nq + nkv + nst; it += nb) {
    if (it < nq) gemm_tile<false>(U, DIN, wt_ptr(p, layer, WT_UQ), 256, (it / 3) * 128, (it % 3) * 128, smem, eq);
    else if (it < nq + nkv) { int j = it - nq; gemm_tile<false>(U + U_CKV, DIN, wt_ptr(p, layer, WT_UKV), 128, (j / 4) * 128, (j % 4) * 128, smem, ekv); }
    else { int j = it - nq - nkv; for (int rep = 0; rep < REP_SSD; ++rep) ssd_state_item(p, layer, j / (NCH * 8), (j / 8) % NCH, j & 7, smem); }
  }
}
DI void phase_att(const Params& p, int layer, int bid, int nb, int lid, char* smem) {
  const int natt = 512 + (layer == 0 ? 32 : 0), npass = 512;
  for (int it = bid; it < natt + npass; it += nb) {
    if (it < 512) {
      const int a = (lid + (it - bid)) & 511;
      const int x = a & 7, j = a >> 3, bh = 2 * x + (j >> 5), qb = j & 31, b = bh >> 2, head = bh & 3;
      for (int rep = 0; rep < REP_ATT; ++rep) attn_item(p, b, head, b * SEQ + qb * 128, qb * 128, true, LK, smem);
    }
    else if (it < natt) { int j = it - 512; int b = j >> 3, head = (j >> 1) & 3, qb = j & 1; attn_item(p, b, head, ML + b * CTX + qb * 128, qb * 128, false, CTX, smem); }
    else ssd_pass_item(p, it - natt);
  }
}
DI void phase_ssdout(const Params& p, int layer, int bid, int nb, char* smem) {
  for (int it = bid; it < NB * NCH * 8; it += nb) {
    int b = it / (NCH * 8), tc = (it / 8) % NCH, h = it & 7;
    if (layer == 1 && tc < 2) continue;
    for (int rep = 0; rep < REP_SSD; ++rep) ssd_out_item(p, layer, b, tc, h, smem);
  }
}


#define XB_TMO      128
#define XB_XCNT(j)  (256  + 64 * (j))
#define XB_XSUB(j)  (1280 + 64 * (j))
#define XB_XGEN(j)  (2304 + 64 * (j))
#define XB_TOP      3328
#define XB_TOPGEN   3392
#define XCD_BAR_WORDS 3456
#define XB_SPIN_CAP (1u << 22)
#define LAS __attribute__((address_space(3)))
DI unsigned xb_ld(unsigned* p) { return __hip_atomic_load(p, __ATOMIC_RELAXED, __HIP_MEMORY_SCOPE_AGENT); }
DI unsigned xb_add(unsigned* p, unsigned v) { return __hip_atomic_fetch_add(p, v, __ATOMIC_RELAXED, __HIP_MEMORY_SCOPE_AGENT); }
DI unsigned xb_xcc_id() { return (unsigned)__builtin_amdgcn_s_getreg((3 << 11) | 20) & 0xFu; }
#define XB_SPIN(cond, bar) do { unsigned _sp = 0; while (cond) { __builtin_amdgcn_s_sleep(1); \
    if ((++_sp & 255u) == 0u) { if (xb_ld(&(bar)[XB_TMO])) break; if (_sp > XB_SPIN_CAP) { atomicAdd(&(bar)[XB_TMO], 1u); break; } } } } while (0)
struct XcdBarrier { unsigned* bar; unsigned x; volatile LAS unsigned* st; };
DI XcdBarrier xcd_barrier_post(unsigned* bar, volatile LAS unsigned* st) {
  XcdBarrier b; b.bar = bar; b.x = xb_xcc_id(); b.st = st;
  if (threadIdx.x == 0) (void)xb_add(&bar[XB_XCNT(b.x)], 1u);
  return b;
}
DI void xcd_barrier_complete(unsigned* bar, unsigned x, unsigned& nloc, unsigned& nx) {
  const unsigned G = gridDim.x * gridDim.y * gridDim.z;
  unsigned sum, cnt, mine, sp = 0u;
  for (;;) {
    sum = 0u; cnt = 0u; mine = 0u;
#pragma unroll
    for (unsigned j = 0; j < 16; ++j) { const unsigned c = xb_ld(&bar[XB_XCNT(j)]); sum += c; cnt += (c > 0u) ? 1u : 0u; mine = (j == x) ? c : mine; }
    if (sum == G) break;
    __builtin_amdgcn_s_sleep(1);
    if ((++sp & 255u) == 0u) { if (xb_ld(&bar[XB_TMO])) break; if (sp > XB_SPIN_CAP) { atomicAdd(&bar[XB_TMO], 1u); break; } }
  }
  nloc = mine > 0u ? mine : 1u; nx = cnt > 0u ? cnt : 1u;
}
DI void xcd_barrier(const XcdBarrier& b) {
  asm volatile("s_waitcnt vmcnt(0)" ::: "memory");
  __syncthreads();
  if (threadIdx.x == 0) {
    unsigned* bar = b.bar;
    asm volatile("" : "+s"(bar));
    __builtin_amdgcn_s_waitcnt(0);
    unsigned nloc = b.st[0], nx = b.st[1];
    if (nloc == 0u) { xcd_barrier_complete(bar, b.x, nloc, nx); b.st[0] = nloc; b.st[1] = nx; }
    const unsigned old = xb_add(&bar[XB_XSUB(b.x)], 1u);
    const unsigned gen = old / nloc;
    if (old + 1u == (gen + 1u) * nloc) {
      __builtin_amdgcn_fence(__ATOMIC_RELEASE, "agent");
      asm volatile("s_waitcnt vmcnt(0)" ::: "memory");
      const unsigned og = xb_add(&bar[XB_TOP], 1u);
      const unsigned tg = og / nx;
      if (og + 1u == (tg + 1u) * nx) xb_add(&bar[XB_TOPGEN], 1u);
      else XB_SPIN(xb_ld(&bar[XB_TOPGEN]) == tg, bar);
      __builtin_amdgcn_fence(__ATOMIC_ACQUIRE, "agent");
      xb_add(&bar[XB_XGEN(b.x)], 1u);
      asm volatile("s_waitcnt vmcnt(0)" ::: "memory");
    } else {
      XB_SPIN(xb_ld(&bar[XB_XGEN(b.x)]) == gen, bar);
      __builtin_amdgcn_fence(__ATOMIC_ACQUIRE, "agent");
      asm volatile("s_waitcnt vmcnt(0)" ::: "memory");
    }
  }
  __syncthreads();
}

constexpr int SMEM_BYTES = 2 * GBUF * 2;
enum { PH_PREP0 = 0, PH_H0, PH_INPROJ, PH_PREP, PH_QKV, PH_ATT, PH_SSDOUT, PH_WOUT, PH_POSTMIX, PH_FF1, PH_FF2, PH_POSTFFN, PH_SSDNORM };

struct Ids { int bid, nb, vbid, nvb, lid; };
DI void run_phase(const Params& p, int ph, int layer, const Ids& id, char* smem, char* sh) {
  switch (ph) {
    case PH_PREP0: phase_prep0(p, id.vbid, id.nvb, sh); break;
    case PH_H0: phase_h0(p, id.vbid, id.nvb); break;
    case PH_INPROJ: phase_inproj(p, layer, id.bid, id.nb, smem); break;
    case PH_PREP: phase_prep(p, layer, id.vbid, id.nvb); break;
    case PH_QKV: phase_qkv(p, layer, id.vbid, id.nvb, sh); break;
    case PH_ATT: phase_att(p, layer, id.vbid, id.nvb, id.lid, sh); break;
    case PH_SSDOUT: phase_ssdout(p, layer, id.vbid, id.nvb, sh); break;
    case PH_WOUT: phase_wout(p, layer, id.lid, id.nvb, sh); break;
    case PH_POSTMIX: phase_postmix(p, layer, id.vbid, id.nvb); break;
    case PH_FF1: phase_ff1(p, layer, id.bid, id.nb, id.vbid, id.nvb, smem, sh); break;
    case PH_FF2: phase_ff2(p, layer, id.bid, id.nb, id.vbid, id.nvb, smem, sh); break;
    case PH_POSTFFN: phase_postffn(p, layer, id.vbid, id.nvb); break;
  }
}

__global__ void __launch_bounds__(512) mega_kernel(Params p) {
  extern __shared__ __attribute__((aligned(16))) char smem[];
  cg::grid_group grid = cg::this_grid();
  if (p.ws == nullptr) grid.sync();
  const int half = __builtin_amdgcn_readfirstlane((int)(threadIdx.x >> 8));
  Ids id;
  id.bid = blockIdx.x; id.nb = gridDim.x;
  id.vbid = 2 * id.bid + half; id.nvb = 2 * id.nb;
  id.lid = (id.bid & 7) + 8 * (2 * (id.bid >> 3) + half);
  char* sh = smem + half * SMEM_BYTES;
  volatile LAS unsigned* st = (volatile LAS unsigned*)(smem + 2 * SMEM_BYTES - 16);
  if (threadIdx.x == 0) { st[0] = 0u; st[1] = 0u; st[2] = 0u; st[3] = 0u; }
  __syncthreads();
  XcdBarrier xb = xcd_barrier_post((unsigned*)(p.ws + OFF_BAR), st);
  for (int step = 0; step < 22; ++step) {
    int ph, layer;
    if (step < 2) { ph = step; layer = 0; }
    else { int j = step - 2; layer = j / 10; ph = PH_INPROJ + j % 10; }
    typedef const void* __attribute__((address_space(4))) * KArgs;
    KArgs ka = (KArgs)__builtin_amdgcn_kernarg_segment_ptr();
    asm volatile("" : "+s"(ka));
    Params q;
    {
      const void** dst = (const void**)&q;
#pragma unroll
      for (int i = 0; i < 27; ++i) dst[i] = ka[i];
    }
    run_phase(q, ph, layer, id, smem, sh);
    if (step < 21) xcd_barrier(xb);
  }
}

extern "C" void kernel_launch(void* const* d_in, const int* in_sizes, int n_in, void* d_out, int out_size, void* d_ws, size_t ws_size,
                              hipStream_t stream) {
  if (ws_size < WS_NEED) { fprintf(stderr, "workspace too small: %zu < %zu\n", ws_size, (size_t)WS_NEED); return; }
  Params p{};
  const float** f = (const float**)&p;
  for (int i = 0; i < 25; ++i) f[i] = (const float*)d_in[i];
  p.out = (float*)d_out;
  p.ws = (char*)d_ws;
  static int grid_blocks = 0;
  if (!grid_blocks) {
    int dev = 0, cus = 0, per_cu = 0;
    hipGetDevice(&dev);
    hipDeviceGetAttribute(&cus, hipDeviceAttributeMultiprocessorCount, dev);
    hipFuncSetAttribute((const void*)mega_kernel, hipFuncAttributeMaxDynamicSharedMemorySize, 2 * SMEM_BYTES);
    hipOccupancyMaxActiveBlocksPerMultiprocessor(&per_cu, mega_kernel, 512, 2 * SMEM_BYTES);
    if (per_cu > 1) per_cu = 1;
    grid_blocks = cus * per_cu;
  }
  hipMemsetAsync((char*)d_ws + OFF_BAR, 0, XCD_BAR_WORDS * 4, stream);
  void* args[] = {&p};
  hipError_t e = hipLaunchCooperativeKernel((void*)mega_kernel, dim3(grid_blocks), dim3(512), args, 2 * SMEM_BYTES, stream);
  if (e != hipSuccess) fprintf(stderr, "cooperative launch failed: %s (grid %d)\n", hipGetErrorString(e), grid_blocks);
}
```

```cpp
#include <hip/hip_runtime.h>
#include <hip/hip_cooperative_groups.h>
#include <stdint.h>
#include <stdio.h>
namespace cg = cooperative_groups;

#ifndef MEGA
#define MEGA 1
#endif
#ifndef REP_GEMM
#define REP_GEMM 1
#endif
#ifndef REP_ATT
#define REP_ATT 1
#endif
#ifndef REP_SSD
#define REP_SSD 1
#endif

typedef unsigned short bf16_t;
using bf16x8 = __attribute__((ext_vector_type(8))) short;
using s16x4  = __attribute__((ext_vector_type(4))) short;
using f32x4  = __attribute__((ext_vector_type(4))) float;
using f32x16 = __attribute__((ext_vector_type(16))) float;
using u32x4  = __attribute__((ext_vector_type(4))) unsigned;
using u32x2  = __attribute__((ext_vector_type(2))) unsigned;
#define DI __device__ __forceinline__
#define MFMA32(a, b, c) __builtin_amdgcn_mfma_f32_32x32x16_bf16((a), (b), (c), 0, 0, 0)
#define MFMA16(a, b, c) __builtin_amdgcn_mfma_f32_16x16x32_bf16((a), (b), (c), 0, 0, 0)

constexpr int DM = 1024, NB = 4, SEQ = 4096, CTX = 256;
constexpr int ML = NB * SEQ;
constexpr int MC = NB * CTX;
constexpr int MT = ML + MC;
constexpr int DIN = 2480, DINP = 2560;
constexpr int LK = CTX + SEQ;
constexpr int DFF = 4096;
constexpr int NCH = 34;
constexpr float EPS = 1e-6f;
constexpr int U_CKV = 256, U_KR = 384, U_GB = 416, U_GC = 672, U_VAL = 928, U_Z = 1184, U_XBC = 1696, U_DT = 2464;

constexpr size_t AL(size_t x) { return (x + 255) & ~(size_t)255; }
constexpr size_t WT_IN = 0;
constexpr size_t WT_UQ = WT_IN + (size_t)DINP * 1024;
constexpr size_t WT_UKV = WT_UQ + (size_t)384 * 256;
constexpr size_t WT_OUT = WT_UKV + (size_t)512 * 128;
constexpr size_t WT_FF1 = WT_OUT + (size_t)1024 * 1024;
constexpr size_t WT_FF2 = WT_FF1 + (size_t)4096 * 1024;
constexpr size_t WT_ELEMS = WT_FF2 + (size_t)4096 * 1024;
constexpr size_t OFF_WT = 0;
constexpr size_t OFF_MOD = AL(OFF_WT + 2 * WT_ELEMS * 2);
constexpr size_t OFF_XC = AL(OFF_MOD + 2 * 5 * 6144 * 4);
constexpr size_t OFF_H = AL(OFF_XC + (size_t)MC * DM * 4);
constexpr size_t OFF_R1 = AL(OFF_H + (size_t)MT * DM * 2);
constexpr size_t OFF_U = OFF_R1;
constexpr size_t OFF_DT = AL(OFF_U + (size_t)MT * DIN * 2);
constexpr size_t OFF_RSTD = AL(OFF_DT + (size_t)MT * 16 * 4);
constexpr size_t OFF_QB = AL(OFF_RSTD + (size_t)MT * 2 * 4);
constexpr size_t OFF_KB = AL(OFF_QB + (size_t)MT * 384 * 2);
constexpr size_t OFF_VT = AL(OFF_KB + (size_t)NB * 4 * LK * 96 * 2);
constexpr size_t OFF_XBC = AL(OFF_VT + (size_t)NB * 4 * 64 * LK * 2);
constexpr size_t OFF_SST = AL(OFF_XBC + (size_t)MT * 768 * 2);
constexpr size_t OFF_TDEC = AL(OFF_SST + (size_t)2 * NB * NCH * 8 * 4096 * 2);
constexpr size_t OFF_SSQ = AL(OFF_TDEC + (size_t)2 * NB * NCH * 8 * 4);
constexpr size_t OFF_END1 = AL(OFF_SSQ + (size_t)MT * 8 * 4);
constexpr size_t OFF_F1 = OFF_R1;
constexpr size_t OFF_END2 = AL(OFF_F1 + (size_t)MT * DFF * 2);
constexpr size_t OFF_BAR = OFF_END1 > OFF_END2 ? OFF_END1 : OFF_END2;
constexpr size_t WS_NEED = OFF_BAR + 16384;

struct Params {
  const float *x, *c, *ctx, *c_ctx, *w_mod, *b_mod, *g_pre_mix, *w_in, *q_norm, *w_uq, *kv_norm, *w_ukv, *sc_w, *ssd_cw, *ssd_cb,
      *a_log, *dt_bias, *ssd_d, *ssd_norm, *w_out, *g_post_mix, *g_pre_ffn, *w_ff1, *w_ff2, *g_post_ffn;
  float* out;
  char* ws;
};

DI int ltid() { int t = threadIdx.x & 255; asm volatile("" : "+v"(t)); return t; }
DI int ltid512() { int t = threadIdx.x; asm volatile("" : "+v"(t)); return t; }
typedef __bf16 hbf2 __attribute__((ext_vector_type(2)));
typedef float hf2 __attribute__((ext_vector_type(2)));
DI bf16_t f2bf(float x) { return __builtin_bit_cast(bf16_t, (__bf16)x); }
DI float bf2f(unsigned v) { return __uint_as_float(v << 16); }
DI unsigned pack2(float a, float b) { hf2 v = {a, b}; return __builtin_bit_cast(unsigned, __builtin_convertvector(v, hbf2)); }
DI float lo2f(unsigned w) { return __uint_as_float(w << 16); }
DI float hi2f(unsigned w) { return __uint_as_float(w & 0xffff0000u); }
DI float wave_sum(float v) {
#pragma unroll
  for (int o = 32; o > 0; o >>= 1) v += __shfl_xor(v, o);
  return v;
}
DI float silu_f(float x) { return x / (1.f + __expf(-x)); }
DI int crow(int reg, int h) { return (reg & 3) + 8 * (reg >> 2) + 4 * h; }
DI bf16x8 pack8(const f32x16& x, int s) {
  u32x4 p;
  p[0] = pack2(x[8 * s + 0], x[8 * s + 1]); p[1] = pack2(x[8 * s + 2], x[8 * s + 3]);
  p[2] = pack2(x[8 * s + 4], x[8 * s + 5]); p[3] = pack2(x[8 * s + 6], x[8 * s + 7]);
  return __builtin_bit_cast(bf16x8, p);
}
DI const float* xin_row(const Params& p, int layer, int row) {
  if (layer == 0) return row < ML ? p.x + (size_t)row * DM : p.ctx + (size_t)(row - ML) * DM;
  return row < ML ? p.out + (size_t)row * DM : (const float*)(p.ws + OFF_XC) + (size_t)(row - ML) * DM;
}
DI float* xst_row(const Params& p, int row) {
  return row < ML ? p.out + (size_t)row * DM : (float*)(p.ws + OFF_XC) + (size_t)(row - ML) * DM;
}
DI const float* mod_ptr(const Params& p, int layer, int row, int which) {
  int bb = row < ML ? (row >> 12) : 4;
  return (const float*)(p.ws + OFF_MOD) + ((size_t)(layer * 5 + bb) * 6 + which) * DM;
}
DI bf16_t* wt_ptr(const Params& p, int layer, size_t off) { return (bf16_t*)(p.ws + OFF_WT) + (size_t)layer * WT_ELEMS + off; }

DI void transpose_item(const float* __restrict__ w, const float* __restrict__ gk, int gk_from, bf16_t* __restrict__ wt, int K, int N, int kt, int nt, char* smem) {
  float* tile = (float*)smem;
  const int tid = ltid(), tx = tid & 63, ty = tid >> 6;
  const int k0 = kt * 64, n0 = nt * 64;
  const int n = n0 + tx;
  float v[16];
#pragma unroll
  for (int i = 0; i < 16; ++i) {
    int kk = ty + 4 * i;
    v[i] = n < N ? w[(size_t)(k0 + kk) * N + n] : 0.f;
  }
  if (gk) {
#pragma unroll
    for (int i = 0; i < 16; ++i) { int k = k0 + ty + 4 * i; if (k >= gk_from) v[i] *= gk[k - gk_from]; }
  }
#pragma unroll
  for (int i = 0; i < 16; ++i) tile[(ty + 4 * i) * 65 + tx] = v[i];
  __syncthreads();
#pragma unroll
  for (int i = 0; i < 2; ++i) {
    int c = tid + 256 * i, nn = c >> 3, kc = c & 7;
    u32x4 o;
#pragma unroll
    for (int jj = 0; jj < 4; ++jj) o[jj] = pack2(tile[(kc * 8 + 2 * jj) * 65 + nn], tile[(kc * 8 + 2 * jj + 1) * 65 + nn]);
    *(u32x4*)(wt + (size_t)(n0 + nn) * K + k0 + kc * 8) = o;
  }
  __syncthreads();
}

DI void modgemv_item(const Params& p, int layer, int ct, char* smem) {
  float* s = (float*)smem;
  float* red = s + 5 * 1024;
  const int tid = ltid(), w = tid >> 6, lane = tid & 63;
  for (int i = tid; i < 5 * 1024; i += 256) {
    int bb = i >> 10, k = i & 1023;
    float v = bb < 4 ? p.c[bb * 1024 + k] : p.c_ctx[k];
    s[i] = silu_f(v);
  }
  __syncthreads();
  const float* wm = p.w_mod + (size_t)layer * 1024 * 6144;
  const int n = ct * 64 + lane;
  float acc[5] = {0.f, 0.f, 0.f, 0.f, 0.f};
#pragma unroll 16
  for (int k = w * 256; k < w * 256 + 256; ++k) {
    float wv = wm[(size_t)k * 6144 + n];
#pragma unroll
    for (int bb = 0; bb < 5; ++bb) acc[bb] += s[bb * 1024 + k] * wv;
  }
#pragma unroll
  for (int bb = 0; bb < 5; ++bb) red[(w * 5 + bb) * 64 + lane] = acc[bb];
  __syncthreads();
  for (int i = tid; i < 320; i += 256) {
    int bb = i >> 6, ln = i & 63;
    float v = red[(0 * 5 + bb) * 64 + ln] + red[(1 * 5 + bb) * 64 + ln] + red[(2 * 5 + bb) * 64 + ln] + red[(3 * 5 + bb) * 64 + ln];
    int nn = ct * 64 + ln;
    v += p.b_mod[layer * 6144 + nn];
    ((float*)(p.ws + OFF_MOD))[(size_t)(layer * 5 + bb) * 6144 + nn] = v;
  }
  __syncthreads();
}

DI void phase_prep0(const Params& p, int bid, int nb, char* smem) {
  constexpr int PER = 2984;
  for (int it = bid; it < 192 + 2 * PER; it += nb) {
    if (it < 192) { modgemv_item(p, it / 96, it % 96, smem); continue; }
    int layer = (it - 192) / PER, j = (it - 192) % PER;
    if (j < 640) transpose_item(p.w_in + (size_t)layer * 1024 * DIN, nullptr, 0, wt_ptr(p, layer, WT_IN), 1024, DIN, j / 40, j % 40, smem);
    else if ((j -= 640) < 24) transpose_item(p.w_uq + (size_t)layer * 256 * 384, p.q_norm + layer * 256, 0, wt_ptr(p, layer, WT_UQ), 256, 384, j / 6, j % 6, smem);
    else if ((j -= 24) < 16) transpose_item(p.w_ukv + (size_t)layer * 128 * 512, p.kv_norm + layer * 128, 0, wt_ptr(p, layer, WT_UKV), 128, 512, j / 8, j % 8, smem);
    else if ((j -= 16) < 256) transpose_item(p.w_out + (size_t)layer * 1024 * 1024, p.ssd_norm + layer * 512, 512, wt_ptr(p, layer, WT_OUT), 1024, 1024, j / 16, j % 16, smem);
    else if ((j -= 256) < 1024) transpose_item(p.w_ff1 + (size_t)layer * 1024 * 4096, nullptr, 0, wt_ptr(p, layer, WT_FF1), 1024, 4096, j / 64, j % 64, smem);
    else { j -= 1024; transpose_item(p.w_ff2 + (size_t)layer * 4096 * 1024, nullptr, 0, wt_ptr(p, layer, WT_FF2), 4096, 1024, j / 16, j % 16, smem); }
  }
}

DI void write_h_row(const float4 xv[4], float rstd, const float* g, const float* sh, const float* sc, bf16_t* hrow, int lane) {
#pragma unroll
  for (int i = 0; i < 4; ++i) {
    int col = lane * 4 + 256 * i;
    float4 gg = *(const float4*)(g + col), s1 = *(const float4*)(sc + col), s0 = *(const float4*)(sh + col);
    float a = xv[i].x * rstd * gg.x * (1.f + s1.x) + s0.x;
    float b = xv[i].y * rstd * gg.y * (1.f + s1.y) + s0.y;
    float c = xv[i].z * rstd * gg.z * (1.f + s1.z) + s0.z;
    float d = xv[i].w * rstd * gg.w * (1.f + s1.w) + s0.w;
    u32x2 o; o[0] = pack2(a, b); o[1] = pack2(c, d);
    *(u32x2*)(hrow + col) = o;
  }
}
DI float ssq4(const float4 v[4]) {
  float s = 0.f;
#pragma unroll
  for (int i = 0; i < 4; ++i) s += v[i].x * v[i].x + v[i].y * v[i].y + v[i].z * v[i].z + v[i].w * v[i].w;
  return s;
}
DI void load_bf_row(const bf16_t* r, int lane, float4 v[4]) {
#pragma unroll
  for (int i = 0; i < 4; ++i) {
    u32x2 t = *(const u32x2*)(r + lane * 4 + 256 * i);
    v[i] = make_float4(lo2f(t[0]), hi2f(t[0]), lo2f(t[1]), hi2f(t[1]));
  }
}

DI void phase_h0(const Params& p, int bid, int nb) {
  const int w = ltid() >> 6, lane = ltid() & 63;
  bf16_t* H = (bf16_t*)(p.ws + OFF_H);
  for (int row = bid * 4 + w; row < MT; row += nb * 4) {
    const float* xr = xin_row(p, 0, row);
    float4 xv[4];
#pragma unroll
    for (int i = 0; i < 4; ++i) xv[i] = *(const float4*)(xr + lane * 4 + 256 * i);
    float rstd = rsqrtf(wave_sum(ssq4(xv)) * (1.f / DM) + EPS);
    write_h_row(xv, rstd, p.g_pre_mix, mod_ptr(p, 0, row, 0), mod_ptr(p, 0, row, 1), H + (size_t)row * DM, lane);
  }
}

DI void phase_postmix(const Params& p, int layer, int bid, int nb) {
  const int w = ltid() >> 6, lane = ltid() & 63;
  const int M = layer == 0 ? MT : ML;
  bf16_t* H = (bf16_t*)(p.ws + OFF_H);
  const bf16_t* Y = (const bf16_t*)(p.ws + OFF_U);
  for (int row = bid * 4 + w; row < M; row += nb * 4) {
    float4 yv[4], xv[4];
    load_bf_row(Y + (size_t)row * DM, lane, yv);
    const float* xr = xin_row(p, layer, row);
#pragma unroll
    for (int i = 0; i < 4; ++i) xv[i] = *(const float4*)(xr + lane * 4 + 256 * i);
    float rstd = rsqrtf(wave_sum(ssq4(yv)) * (1.f / DM) + EPS);
    const float* g1 = mod_ptr(p, layer, row, 2);
    const float* gp = p.g_post_mix + layer * DM;
    float* xo = xst_row(p, row);
#pragma unroll
    for (int i = 0; i < 4; ++i) {
      int col = lane * 4 + 256 * i;
      float4 a = *(const float4*)(g1 + col), b = *(const float4*)(gp + col);
      xv[i].x += a.x * yv[i].x * rstd * b.x; xv[i].y += a.y * yv[i].y * rstd * b.y;
      xv[i].z += a.z * yv[i].z * rstd * b.z; xv[i].w += a.w * yv[i].w * rstd * b.w;
      *(float4*)(xo + col) = xv[i];
    }
    float rstd1 = rsqrtf(wave_sum(ssq4(xv)) * (1.f / DM) + EPS);
    write_h_row(xv, rstd1, p.g_pre_ffn + layer * DM, mod_ptr(p, layer, row, 3), mod_ptr(p, layer, row, 4), H + (size_t)row * DM, lane);
  }
}

DI void phase_postffn(const Params& p, int layer, int bid, int nb) {
  const int w = ltid() >> 6, lane = ltid() & 63;
  const int M = layer == 0 ? MT : ML;
  bf16_t* H = (bf16_t*)(p.ws + OFF_H);
  for (int row = bid * 4 + w; row < M; row += nb * 4) {
    float4 fv[4], xv[4];
    if (row < ML) load_bf_row(H + (size_t)row * DM, lane, fv);
    else {
      const float* pp = (const float*)(p.ws + OFF_END2) + (size_t)(row - ML) * DM;
#pragma unroll
      for (int i = 0; i < 4; ++i) {
        float4 a = *(const float4*)(pp + lane * 4 + 256 * i), b = *(const float4*)(pp + (size_t)MC * DM + lane * 4 + 256 * i);
        float4 c = *(const float4*)(pp + (size_t)2 * MC * DM + lane * 4 + 256 * i), d = *(const float4*)(pp + (size_t)3 * MC * DM + lane * 4 + 256 * i);
        fv[i] = make_float4((a.x + b.x) + (c.x + d.x), (a.y + b.y) + (c.y + d.y), (a.z + b.z) + (c.z + d.z), (a.w + b.w) + (c.w + d.w));
      }
    }
    float* xo = xst_row(p, row);
#pragma unroll
    for (int i = 0; i < 4; ++i) xv[i] = *(const float4*)(xo + lane * 4 + 256 * i);
    float rstd = rsqrtf(wave_sum(ssq4(fv)) * (1.f / DM) + EPS);
    const float* g2 = mod_ptr(p, layer, row, 5);
    const float* gp = p.g_post_ffn + layer * DM;
#pragma unroll
    for (int i = 0; i < 4; ++i) {
      int col = lane * 4 + 256 * i;
      float4 a = *(const float4*)(g2 + col), b = *(const float4*)(gp + col);
      xv[i].x += a.x * fv[i].x * rstd * b.x; xv[i].y += a.y * fv[i].y * rstd * b.y;
      xv[i].z += a.z * fv[i].z * rstd * b.z; xv[i].w += a.w * fv[i].w * rstd * b.w;
      *(float4*)(xo + col) = xv[i];
    }
    if (layer == 0) {
      float rstd1 = rsqrtf(wave_sum(ssq4(xv)) * (1.f / DM) + EPS);
      write_h_row(xv, rstd1, p.g_pre_mix + DM, mod_ptr(p, 1, row, 0), mod_ptr(p, 1, row, 1), H + (size_t)row * DM, lane);
    }
  }
}

DI void phase_prep(const Params& p, int layer, int bid, int nb) {
  const int w = ltid() >> 6, lane = ltid() & 63;
  const bf16_t* U = (const bf16_t*)(p.ws + OFF_U);
  float* DT = (float*)(p.ws + OFF_DT);
  float* RS = (float*)(p.ws + OFF_RSTD);
  bf16_t* KB = (bf16_t*)(p.ws + OFF_KB);
  bf16_t* XBC = (bf16_t*)(p.ws + OFF_XBC);
  bf16_t* YM = (bf16_t*)(p.ws + OFF_H);
  const float* scw = p.sc_w + layer * 3 * 256;
  const float* cw = p.ssd_cw + layer * 3 * 768;
  const float* cb = p.ssd_cb + layer * 768;
  for (int row = bid * 4 + w; row < MT; row += nb * 4) {
    int b, t, L, pos;
    bool lat = row < ML;
    if (lat) { b = row >> 12; t = row & 4095; L = SEQ; pos = t + CTX; }
    else { int rr = row - ML; b = rr >> 8; t = rr & 255; L = CTX; pos = t; }
    const bf16_t* u0 = U + (size_t)row * DIN;
    const bool hp = t > 0, hn = t < L - 1;
    const bf16_t* um = u0 - DIN;
    const bf16_t* up = u0 + DIN;
    {
      u32x2 v = *(const u32x2*)(u0 + lane * 4);
      float a = lo2f(v[0]), bq = hi2f(v[0]), c = lo2f(v[1]), d = hi2f(v[1]);
      float ss = wave_sum(a * a + bq * bq + c * c + d * d);
      float s2 = 0.f;
      if (lane < 32) {
        u32x2 v2 = *(const u32x2*)(u0 + U_CKV + lane * 4);
        float e = lo2f(v2[0]), f = hi2f(v2[0]), g = lo2f(v2[1]), h = hi2f(v2[1]);
        s2 = e * e + f * f + g * g + h * h;
      }
      s2 = wave_sum(s2);
      if (lane == 0) { RS[row * 2] = rsqrtf(ss * (1.f / 256) + EPS); RS[row * 2 + 1] = rsqrtf(s2 * (1.f / 128) + EPS); }
    }
    {
      float v = bf2f(u0[U_KR + (lane & 31)]);
      float partner = __shfl_xor(v, 8);
      float o = v;
      if (lat) {
        int grp = (lane & 31) >> 3, i = lane & 7;
        float posf = grp < 2 ? (float)(t >> 6) : (float)(t & 63);
        float invf = exp2f(-(float)(2 * i) * (13.287712379549449f / 16.f));
        float ang = posf * invf;
        float rev = ang * 0.15915494309189535f;
        float cs = __builtin_amdgcn_cosf(rev), sn = __builtin_amdgcn_sinf(rev);
        o = (grp & 1) ? v * cs + partner * sn : v * cs - partner * sn;
      }
      if (lane < 32) {
        bf16_t ob = f2bf(o);
#pragma unroll
        for (int hd = 0; hd < 4; ++hd) KB[((size_t)(b * 4 + hd) * LK + pos) * 96 + 64 + lane] = ob;
      }
    }
    {
      int c = lane * 4;
      float acc[4] = {0.f, 0.f, 0.f, 0.f};
#pragma unroll
      for (int k = 0; k < 3; ++k) {
        const bf16_t* ur = k == 0 ? um : (k == 1 ? u0 : up);
        bool ok = k == 0 ? hp : (k == 1 ? true : hn);
        if (ok) {
          u32x2 gc = *(const u32x2*)(ur + U_GC + c), vv = *(const u32x2*)(ur + U_VAL + c);
          float4 wk = *(const float4*)(scw + k * 256 + c);
          acc[0] += wk.x * lo2f(gc[0]) * lo2f(vv[0]); acc[1] += wk.y * hi2f(gc[0]) * hi2f(vv[0]);
          acc[2] += wk.z * lo2f(gc[1]) * lo2f(vv[1]); acc[3] += wk.w * hi2f(gc[1]) * hi2f(vv[1]);
        }
      }
      u32x2 gb = *(const u32x2*)(u0 + U_GB + c);
      u32x2 o; o[0] = pack2(lo2f(gb[0]) * acc[0], hi2f(gb[0]) * acc[1]); o[1] = pack2(lo2f(gb[1]) * acc[2], hi2f(gb[1]) * acc[3]);
      *(u32x2*)(YM + (size_t)row * DM + 256 + c) = o;
    }
#pragma unroll
    for (int i = 0; i < 3; ++i) {
      int c = lane * 4 + 256 * i;
      float4 bias = *(const float4*)(cb + c);
      float acc[4] = {bias.x, bias.y, bias.z, bias.w};
#pragma unroll
      for (int k = 0; k < 3; ++k) {
        const bf16_t* ur = k == 0 ? um : (k == 1 ? u0 : up);
        bool ok = k == 0 ? hp : (k == 1 ? true : hn);
        if (ok) {
          u32x2 vv = *(const u32x2*)(ur + U_XBC + c);
          float4 wk = *(const float4*)(cw + k * 768 + c);
          acc[0] += wk.x * lo2f(vv[0]); acc[1] += wk.y * hi2f(vv[0]); acc[2] += wk.z * lo2f(vv[1]); acc[3] += wk.w * hi2f(vv[1]);
        }
      }
      u32x2 o; o[0] = pack2(silu_f(acc[0]), silu_f(acc[1])); o[1] = pack2(silu_f(acc[2]), silu_f(acc[3]));
      *(u32x2*)(XBC + (size_t)row * 768 + c) = o;
    }
    if (lane < 16) {
      float v = DT[(size_t)row * 16 + lane] + p.dt_bias[layer * 16 + lane];
      const float e = __expf(-fabsf(v));
      float sp = fmaxf(v, 0.f) + (e < 1e-3f ? e * (1.f - 0.5f * e) : __logf(1.f + e));
      DT[(size_t)row * 16 + lane] = sp;
    }
  }
}

DI void phase_ssdnorm(const Params& p, int layer, int bid, int nb) {
  const int w = ltid() >> 6, lane = ltid() & 63;
  const int M = layer == 0 ? MT : ML;
  bf16_t* YM = (bf16_t*)(p.ws + OFF_H);
  const float* SSQ = (const float*)(p.ws + OFF_SSQ);
  const float* ng = p.ssd_norm + layer * 512;
  for (int row = bid * 4 + w; row < M; row += nb * 4) {
    int g = lane >> 5;
    float4 s = *(const float4*)(SSQ + (size_t)row * 8 + g * 4);
    float rstd = rsqrtf((s.x + s.y + s.z + s.w) * (1.f / 256) + EPS);
    bf16_t* ptr = YM + (size_t)row * DM + 512 + lane * 8;
    u32x4 v = *(const u32x4*)ptr;
    float4 g0 = *(const float4*)(ng + lane * 8), g1 = *(const float4*)(ng + lane * 8 + 4);
    u32x4 o;
    o[0] = pack2(lo2f(v[0]) * rstd * g0.x, hi2f(v[0]) * rstd * g0.y);
    o[1] = pack2(lo2f(v[1]) * rstd * g0.z, hi2f(v[1]) * rstd * g0.w);
    o[2] = pack2(lo2f(v[2]) * rstd * g1.x, hi2f(v[2]) * rstd * g1.y);
    o[3] = pack2(lo2f(v[3]) * rstd * g1.z, hi2f(v[3]) * rstd * g1.w);
    *(u32x4*)ptr = o;
  }
}

constexpr int GST = 80;
constexpr int GBUF = 2 * 128 * GST;
template <bool GN, class Epi>
DI void gemm_tile(const bf16_t* __restrict__ A, int lda, const bf16_t* __restrict__ Bt, int K, int row0, int col0, char* smem, Epi epi, const float* __restrict__ ssq = nullptr) {
  bf16_t* S0 = (bf16_t*)smem;
  const int tid = ltid(), wid = tid >> 6, lane = tid & 63, wr = wid >> 1, wc = wid & 1, fr = lane & 15, fq = lane >> 4;
  f32x4 acc[4][4];
#pragma unroll
  for (int m = 0; m < 4; ++m)
#pragma unroll
    for (int n = 0; n < 4; ++n) acc[m][n] = f32x4{0.f, 0.f, 0.f, 0.f};
  u32x4 ra[4], rb[4];
  const int sr = tid >> 3, sp = tid & 7;
  const bf16_t* ga = A + (size_t)(row0 + sr) * lda + sp * 8;
  const bf16_t* gb = Bt + (size_t)(col0 + sr) * K + sp * 8;
  auto gload = [&](int k0) {
#pragma unroll
    for (int i = 0; i < 4; ++i) {
      ra[i] = *(const u32x4*)(ga + (size_t)(32 * i) * lda + k0);
      rb[i] = *(const u32x4*)(gb + (size_t)(32 * i) * K + k0);
    }
  };
  gload(0);
  float gs[4][2];
  if (GN) {
#pragma unroll
    for (int i = 0; i < 4; ++i) {
      const float4 s0 = *(const float4*)(ssq + (size_t)(row0 + sr + 32 * i) * 8), s1 = *(const float4*)(ssq + (size_t)(row0 + sr + 32 * i) * 8 + 4);
      gs[i][0] = rsqrtf((s0.x + s0.y + s0.z + s0.w) * (1.f / 256) + EPS);
      gs[i][1] = rsqrtf((s1.x + s1.y + s1.z + s1.w) * (1.f / 256) + EPS);
    }
  }
  auto swrite = [&](int kt) {
    if (GN && kt >= 8) {
      const int g = (kt - 8) >> 2;
#pragma unroll
      for (int i = 0; i < 4; ++i) {
        const float sc = g ? gs[i][1] : gs[i][0];
#pragma unroll
        for (int jj = 0; jj < 4; ++jj) ra[i][jj] = pack2(lo2f(ra[i][jj]) * sc, hi2f(ra[i][jj]) * sc);
      }
    }
    bf16_t* As = S0 + (kt & 1) * GBUF;
    bf16_t* Bs = As + 128 * GST;
#pragma unroll
    for (int i = 0; i < 4; ++i) {
      *(u32x4*)(As + (sr + 32 * i) * GST + sp * 8) = ra[i];
      *(u32x4*)(Bs + (sr + 32 * i) * GST + sp * 8) = rb[i];
    }
  };
  const int KT = K / 64;
  swrite(0);
  if (KT > 1) gload(64);
  __syncthreads();
  for (int kt = 0; kt < KT; ++kt) {
    const bf16_t* As = S0 + (kt & 1) * GBUF;
    const bf16_t* Bs = As + 128 * GST;
#pragma unroll
    for (int ks = 0; ks < 2; ++ks) {
      bf16x8 af[4], bfr[4];
#pragma unroll
      for (int m = 0; m < 4; ++m) af[m] = *(const bf16x8*)(As + (wr * 64 + m * 16 + fr) * GST + ks * 32 + fq * 8);
#pragma unroll
      for (int n = 0; n < 4; ++n) bfr[n] = *(const bf16x8*)(Bs + (wc * 64 + n * 16 + fr) * GST + ks * 32 + fq * 8);
#pragma unroll
      for (int m = 0; m < 4; ++m)
#pragma unroll
        for (int n = 0; n < 4; ++n) acc[m][n] = MFMA16(bfr[n], af[m], acc[m][n]);
      if (ks == 0 && kt + 1 < KT) {
        swrite(kt + 1);
        if (kt + 2 < KT) gload((kt + 2) * 64);
      }
    }
    __syncthreads();
  }
#pragma unroll
  for (int m = 0; m < 4; ++m)
#pragma unroll
    for (int n = 0; n < 4; ++n) epi(row0 + wr * 64 + m * 16 + fr, col0 + wc * 64 + n * 16 + fq * 4, acc[m][n]);
}

template <class Epi>
DI void gemm_tile_glds(const bf16_t* __restrict__ A, int lda, const bf16_t* __restrict__ Bt, int ldb, int K, int row0, int col0, char* smem, Epi epi) {
  const int tid = ltid(), wid = tid >> 6, lane = tid & 63, wr = wid >> 1, wc = wid & 1, fr = lane & 15, fq = lane >> 4;
  f32x4 acc[4][4];
#pragma unroll
  for (int m = 0; m < 4; ++m)
#pragma unroll
    for (int n = 0; n < 4; ++n) acc[m][n] = f32x4{0.f, 0.f, 0.f, 0.f};
  const int crow = tid >> 3, cslot = tid & 7, cpart = cslot ^ (crow & 7);
  const bf16_t* ga = A + (size_t)(row0 + crow) * lda + cpart * 8;
  const bf16_t* gb = Bt + (size_t)(col0 + crow) * ldb + cpart * 8;
  auto issue = [&](int kt, int stage) {
    char* sa = smem + stage * 32768 + tid * 16;
#pragma unroll
    for (int i = 0; i < 4; ++i) {
      __builtin_amdgcn_global_load_lds((const unsigned*)(ga + (size_t)(32 * i) * lda + kt * 64), (__attribute__((address_space(3))) unsigned*)(sa + i * 4096), 16, 0, 0);
      __builtin_amdgcn_global_load_lds((const unsigned*)(gb + (size_t)(32 * i) * ldb + kt * 64), (__attribute__((address_space(3))) unsigned*)(sa + 16384 + i * 4096), 16, 0, 0);
    }
  };
  const int KT = K / 64;
  issue(0, 0);
  asm volatile("s_waitcnt vmcnt(0)" ::: "memory");
  __syncthreads();
  const int sw = fr & 7;
  for (int kt = 0; kt < KT; ++kt) {
    if (kt + 1 < KT) issue(kt + 1, (kt + 1) & 1);
    const char* As = smem + (kt & 1) * 32768;
    const char* Bs = As + 16384;
#pragma unroll
    for (int ks = 0; ks < 2; ++ks) {
      bf16x8 af[4], bfr[4];
      const int so = ((ks * 4 + fq) ^ sw) * 16;
#pragma unroll
      for (int m = 0; m < 4; ++m) af[m] = *(const bf16x8*)(As + (wr * 64 + m * 16 + fr) * 128 + so);
#pragma unroll
      for (int n = 0; n < 4; ++n) bfr[n] = *(const bf16x8*)(Bs + (wc * 64 + n * 16 + fr) * 128 + so);
#pragma unroll
      for (int m = 0; m < 4; ++m)
#pragma unroll
        for (int n = 0; n < 4; ++n) acc[m][n] = MFMA16(bfr[n], af[m], acc[m][n]);
    }
    asm volatile("s_waitcnt vmcnt(0)" ::: "memory");
    __syncthreads();
  }
#pragma unroll
  for (int m = 0; m < 4; ++m)
#pragma unroll
    for (int n = 0; n < 4; ++n) epi(row0 + wr * 64 + m * 16 + fr, col0 + wc * 64 + n * 16 + fq * 4, acc[m][n]);
}

constexpr int G8_HT = 128 * 64;
DI int g8_lds_byte(int r, int c) {
  int st = (r >> 4) * 2 + (c >> 5), rr = r & 15, cc = c & 31, ob = rr * 64 + cc * 2;
  return st * 1024 + (ob ^ (((ob >> 9) & 1) << 5));
}
DI void g8_stage_rc(int b, int& R, int& C) {
  int st = b / 1024, sb = b % 1024, swz = sb ^ (((sb >> 9) & 1) << 5);
  R = (st >> 1) * 16 + swz / 64; C = (st & 1) * 32 + (swz % 64) / 2;
}
template <class Epi>
DI void gemm8_tile(const bf16_t* __restrict__ A, int lda, const bf16_t* __restrict__ Bt, int ldb, int K, int brow, int bcol, char* smem, Epi epi) {
  bf16_t* shm = (bf16_t*)smem;
  const int tid = ltid512();
#define G8_SA(b, h) (shm + ((b) * 2 + (h)) * G8_HT)
#define G8_SB(b, h) (shm + (4 + (b) * 2 + (h)) * G8_HT)
#define G8_STAGE(P, BASE, LD, br, kt) do { const bf16_t* _g = (BASE) + (size_t)(br) * (LD) + (size_t)(kt) * 64; \
    _Pragma("unroll") for (int _i = 0; _i < 2; ++_i) { int _b = tid * 16 + _i * 8192; int _r, _c; g8_stage_rc(_b, _r, _c); \
      __builtin_amdgcn_global_load_lds((const unsigned*)(_g + (size_t)_r * (LD) + _c), \
        (__attribute__((address_space(3))) unsigned*)((char*)(P) + _b), 16, 0, 0); } } while (0)
#define G8_LDA(dst, b, h) _Pragma("unroll") for (int m = 0; m < 4; ++m) _Pragma("unroll") for (int k = 0; k < 2; ++k) \
    dst[m][k] = *reinterpret_cast<const bf16x8*>((char*)G8_SA(b, h) + g8_lds_byte(wr * 64 + m * 16 + fr, k * 32 + fq * 8))
#define G8_LDB(dst, b, h) _Pragma("unroll") for (int n = 0; n < 2; ++n) _Pragma("unroll") for (int k = 0; k < 2; ++k) \
    dst[n][k] = *reinterpret_cast<const bf16x8*>((char*)G8_SB(b, h) + g8_lds_byte(wc * 32 + n * 16 + fr, k * 32 + fq * 8))
#define G8_MMA(ai, bj, At, Bx) do { __builtin_amdgcn_s_setprio(1); \
    _Pragma("unroll") for (int m = 0; m < 4; ++m) _Pragma("unroll") for (int n = 0; n < 2; ++n) _Pragma("unroll") for (int k = 0; k < 2; ++k) \
      acc[ai][bj][m][n] = __builtin_amdgcn_mfma_f32_16x16x32_bf16(Bx[n][k], At[m][k], acc[ai][bj][m][n], 0, 0, 0); \
    __builtin_amdgcn_s_setprio(0); } while (0)
#define G8_WAIT_V(n) asm volatile("s_waitcnt vmcnt(" #n ")" ::: "memory")
#define G8_WAIT_L(n) asm volatile("s_waitcnt lgkmcnt(" #n ")" ::: "memory")
#define G8_BAR __builtin_amdgcn_s_barrier()
#define G8_SCHED __builtin_amdgcn_sched_barrier(0)
  const int wid = tid >> 6, lane = tid & 63, wr = wid >> 2, wc = wid & 3, fr = lane & 15, fq = lane >> 4;
  f32x4 acc[2][2][4][2];
#pragma unroll
  for (int a = 0; a < 2; ++a)
#pragma unroll
    for (int b = 0; b < 2; ++b)
#pragma unroll
      for (int m = 0; m < 4; ++m)
#pragma unroll
        for (int n = 0; n < 2; ++n) acc[a][b][m][n] = f32x4{0.f, 0.f, 0.f, 0.f};
  bf16x8 At[4][2], B0[2][2], B1[2][2];
  const int nt = K / 64;
  G8_STAGE(G8_SB(0, 0), Bt, ldb, bcol, 0); G8_STAGE(G8_SA(0, 0), A, lda, brow, 0);
  G8_STAGE(G8_SB(0, 1), Bt, ldb, bcol + 128, 0); G8_STAGE(G8_SA(0, 1), A, lda, brow + 128, 0);
  if (wr == 1) G8_BAR;
  G8_WAIT_V(4); G8_BAR;
  G8_STAGE(G8_SB(1, 0), Bt, ldb, bcol, 1); G8_STAGE(G8_SA(1, 0), A, lda, brow, 1); G8_STAGE(G8_SB(1, 1), Bt, ldb, bcol + 128, 1);
  G8_WAIT_V(6); G8_BAR;
  for (int t = 0; t < nt - 2; t += 2) {
    G8_LDB(B0, 0, 0); G8_SCHED; G8_LDA(At, 0, 0); G8_STAGE(G8_SA(1, 1), A, lda, brow + 128, t + 1);
    G8_WAIT_L(8); G8_BAR; G8_WAIT_L(0); G8_MMA(0, 0, At, B0); G8_BAR; G8_SCHED;
    G8_LDB(B1, 0, 1); G8_STAGE(G8_SB(0, 0), Bt, ldb, bcol, t + 2);
    G8_BAR; G8_WAIT_L(0); G8_MMA(0, 1, At, B1); G8_BAR;
    G8_LDA(At, 0, 1); G8_STAGE(G8_SA(0, 0), A, lda, brow, t + 2);
    G8_BAR; G8_WAIT_L(0); G8_MMA(1, 0, At, B0); G8_BAR; G8_SCHED;
    G8_STAGE(G8_SB(0, 1), Bt, ldb, bcol + 128, t + 2);
    G8_WAIT_V(6); G8_BAR; G8_MMA(1, 1, At, B1); G8_BAR;
    G8_LDB(B0, 1, 0); G8_SCHED; G8_LDA(At, 1, 0); G8_STAGE(G8_SA(0, 1), A, lda, brow + 128, t + 2);
    G8_WAIT_L(8); G8_BAR; G8_WAIT_L(0); G8_MMA(0, 0, At, B0); G8_BAR; G8_SCHED;
    G8_LDB(B1, 1, 1); G8_STAGE(G8_SB(1, 0), Bt, ldb, bcol, t + 3);
    G8_BAR; G8_WAIT_L(0); G8_MMA(0, 1, At, B1); G8_BAR;
    G8_LDA(At, 1, 1); G8_STAGE(G8_SA(1, 0), A, lda, brow, t + 3);
    G8_BAR; G8_WAIT_L(0); G8_MMA(1, 0, At, B0); G8_BAR; G8_SCHED;
    G8_STAGE(G8_SB(1, 1), Bt, ldb, bcol + 128, t + 3);
    G8_WAIT_V(6); G8_BAR; G8_MMA(1, 1, At, B1); G8_BAR;
  }
  { G8_LDB(B0, 0, 0); G8_LDA(At, 0, 0); G8_STAGE(G8_SA(1, 1), A, lda, brow + 128, nt - 1);
    G8_BAR; G8_WAIT_L(0); G8_MMA(0, 0, At, B0); G8_BAR;
    G8_LDB(B1, 0, 1); G8_BAR; G8_WAIT_L(0); G8_MMA(0, 1, At, B1); G8_BAR;
    G8_LDA(At, 0, 1); G8_WAIT_V(4); G8_BAR; G8_WAIT_L(0); G8_MMA(1, 0, At, B0); G8_MMA(1, 1, At, B1); G8_BAR; }
  { G8_LDB(B0, 1, 0); G8_LDA(At, 1, 0); G8_WAIT_V(2); G8_BAR; G8_WAIT_L(0); G8_MMA(0, 0, At, B0); G8_BAR;
    G8_LDB(B1, 1, 1); G8_WAIT_V(0); G8_BAR; G8_WAIT_L(0); G8_MMA(0, 1, At, B1); G8_BAR;
    G8_LDA(At, 1, 1); G8_BAR; G8_WAIT_L(0); G8_MMA(1, 0, At, B0); G8_MMA(1, 1, At, B1); G8_BAR; }
  if (wr == 0) G8_BAR;
#pragma unroll
  for (int ai = 0; ai < 2; ++ai)
#pragma unroll
    for (int bj = 0; bj < 2; ++bj)
#pragma unroll
      for (int m = 0; m < 4; ++m)
#pragma unroll
        for (int n = 0; n < 2; ++n) epi(brow + ai * 128 + wr * 64 + m * 16 + fr, bcol + bj * 128 + wc * 32 + n * 16 + fq * 4, acc[ai][bj][m][n]);
  __syncthreads();
}

struct EpiBF {
  bf16_t* out; int ldo;
  DI void operator()(int row, int col, const f32x4& a) const {
    u32x2 o; o[0] = pack2(a[0], a[1]); o[1] = pack2(a[2], a[3]);
    *(u32x2*)(out + (size_t)row * ldo + col) = o;
  }
};
struct EpiRelu2 {
  bf16_t* out; int ldo;
  DI void operator()(int row, int col, const f32x4& a) const {
    float r0 = fmaxf(a[0], 0.f), r1 = fmaxf(a[1], 0.f), r2 = fmaxf(a[2], 0.f), r3 = fmaxf(a[3], 0.f);
    u32x2 o; o[0] = pack2(r0 * r0, r1 * r1); o[1] = pack2(r2 * r2, r3 * r3);
    *(u32x2*)(out + (size_t)row * ldo + col) = o;
  }
};
struct EpiU {
  bf16_t* u; float* dt;
  DI void operator()(int row, int col, const f32x4& a) const {
    if (col < DIN) {
      u32x2 o; o[0] = pack2(a[0], a[1]); o[1] = pack2(a[2], a[3]);
      *(u32x2*)(u + (size_t)row * DIN + col) = o;
      if (col >= U_DT) *(float4*)(dt + (size_t)row * 16 + col - U_DT) = make_float4(a[0], a[1], a[2], a[3]);
    }
  }
};
struct EpiQ {
  bf16_t* q; const float* rs;
  DI void operator()(int row, int col, const f32x4& a) const {
    const float r = rs[row * 2];
    u32x2 o; o[0] = pack2(a[0] * r, a[1] * r); o[1] = pack2(a[2] * r, a[3] * r);
    *(u32x2*)(q + (size_t)row * 384 + col) = o;
  }
};
struct EpiKV {
  bf16_t* kb; bf16_t* vt; const float* rs;
  DI void operator()(int row, int col, const f32x4& a) const {
    int b, pos;
    if (row < ML) { b = row >> 12; pos = (row & 4095) + CTX; } else { int rr = row - ML; b = rr >> 8; pos = rr & 255; }
    const int head = col >> 7, d = col & 127;
    const float r = rs[row * 2 + 1];
    if (d < 64) {
      u32x2 o; o[0] = pack2(a[0] * r, a[1] * r); o[1] = pack2(a[2] * r, a[3] * r);
      *(u32x2*)(kb + ((size_t)(b * 4 + head) * LK + pos) * 96 + d) = o;
    } else {
#pragma unroll
      for (int j = 0; j < 4; ++j) vt[((size_t)(b * 4 + head) * 64 + (d - 64 + j)) * LK + pos] = f2bf(a[j] * r);
    }
  }
};

struct EpiPart {
  float* part;
  DI void operator()(int row, int col, const f32x4& a) const {
    *(float4*)(part + (size_t)(row - ML) * DM + col) = make_float4(a[0], a[1], a[2], a[3]);
  }
};
DI void phase_inproj(const Params& p, int layer, int bid, int nb, char* smem) {
  EpiU epi{(bf16_t*)(p.ws + OFF_U), (float*)(p.ws + OFF_DT)};
  const int x = bid & 7, per = nb >> 3;
  for (int rep = 0; rep < REP_GEMM; ++rep)
  for (int q = bid >> 3; q < 85; q += per) {
    const int m = (x >> 1) * 17 + q / 5, n = 5 * (x & 1) + q % 5;
    gemm8_tile((const bf16_t*)(p.ws + OFF_H), DM, wt_ptr(p, layer, WT_IN), 1024, 1024, m * 256, n * 256, smem, epi);
  }
}
DI void phase_wout(const Params& p, int layer, int lid, int nvb, char* smem) {
  const int M = layer == 0 ? MT : ML;
  EpiBF epi{(bf16_t*)(p.ws + OFF_U), DM};
  const int x = lid & 7, per = nvb >> 3;
  for (int rep = 0; rep < REP_GEMM; ++rep)
  for (int q = lid >> 3; q < M / 128; q += per)
    gemm_tile<true>((const bf16_t*)(p.ws + OFF_H), DM, wt_ptr(p, layer, WT_OUT), 1024, ((q >> 3) * 8 + x) * 128, (q & 7) * 128, smem, epi, (const float*)(p.ws + OFF_SSQ));
}
DI void phase_ff1(const Params& p, int layer, int bid, int nb, int vbid, int nvb, char* smem, char* smem_half) {
  EpiRelu2 epi{(bf16_t*)(p.ws + OFF_F1), DFF};
  const int x = bid & 7, per = nb >> 3;
  for (int rep = 0; rep < REP_GEMM; ++rep) {
    for (int q = bid >> 3; q < 128; q += per) {
      const int m = (x >> 2) * 32 + (q >> 2), n = 4 * (x & 3) + (q & 3);
      gemm8_tile((const bf16_t*)(p.ws + OFF_H), DM, wt_ptr(p, layer, WT_FF1), 1024, 1024, m * 256, n * 256, smem, epi);
    }
    if (layer == 0)
      for (int it = vbid; it < (MC / 128) * 32; it += nvb)
        gemm_tile_glds((const bf16_t*)(p.ws + OFF_H), DM, wt_ptr(p, layer, WT_FF1), 1024, 1024, ML + (it / 32) * 128, (it % 32) * 128, smem_half, epi);
  }
}
DI void phase_ff2(const Params& p, int layer, int bid, int nb, int vbid, int nvb, char* smem, char* smem_half) {
  EpiBF epi{(bf16_t*)(p.ws + OFF_H), DM};
  const int x = bid & 7, per = nb >> 3;
  for (int rep = 0; rep < REP_GEMM; ++rep) {
    for (int q = bid >> 3; q < 32; q += per) {
      const int T = x * 32 + q;
      gemm8_tile((const bf16_t*)(p.ws + OFF_F1), DFF, wt_ptr(p, layer, WT_FF2), 4096, 4096, (T >> 2) * 256, (T & 3) * 256, smem, epi);
    }
    if (layer == 0)
      for (int it = vbid; it < (MC / 128) * 8 * 4; it += nvb) {
        const int tile = it >> 2, ks = it & 3;
        EpiPart ep{(float*)(p.ws + OFF_END2) + (size_t)ks * MC * DM};
        gemm_tile_glds((const bf16_t*)(p.ws + OFF_F1) + ks * 1024, DFF, wt_ptr(p, layer, WT_FF2) + ks * 1024, 4096, 1024, ML + (tile >> 3) * 128, (tile & 7) * 128, smem_half, ep);
      }
  }
}

DI int chunk_row0(int b, int tc) { return tc < 2 ? ML + b * CTX + tc * 128 : b * SEQ + (tc - 2) * 128; }
constexpr int BST = 72;
constexpr int TST = 136;
DI void load_tile_T(bf16_t* dst, const bf16_t* __restrict__ src, int ldg) {
  const int tid = ltid();
#pragma unroll
  for (int i = 0; i < 4; ++i) {
    int c = tid + 256 * i, tok = c & 127, pc = c >> 7;
    u32x4 v = *(const u32x4*)(src + (size_t)tok * ldg + pc * 8);
#pragma unroll
    for (int j = 0; j < 4; ++j) {
      dst[(pc * 8 + 2 * j) * TST + tok] = (bf16_t)(v[j] & 0xffffu);
      dst[(pc * 8 + 2 * j + 1) * TST + tok] = (bf16_t)(v[j] >> 16);
    }
  }
}
DI void chunk_scan(const Params& p, int layer, int row0, int h, float* csf, float* csb, float* dtF, float* dtB, float* tot, float*  ) {
  const int tid = ltid(), w = tid >> 6, lane = tid & 63;
  const float* DT = (const float*)(p.ws + OFF_DT);
  float v;
  if (tid < 128) {
    const float dt = DT[(size_t)(row0 + tid) * 16 + h];
    v = dt * -__expf(p.a_log[layer * 16 + h]);
    dtF[tid] = dt;
  } else {
    const int e = 255 - tid;
    const float dt = DT[(size_t)(row0 + e) * 16 + 8 + h];
    v = dt * -__expf(p.a_log[layer * 16 + 8 + h]);
    dtB[e] = dt;
  }
#pragma unroll
  for (int o = 1; o < 64; o <<= 1) { const float t = __shfl_up(v, o); if (lane >= o) v += t; }
  if (lane == 63) tot[w] = v;
  __syncthreads();
  if (w == 1) v += tot[0];
  if (w == 3) v += tot[2];
  if (tid < 128) csf[tid] = v; else csb[255 - tid] = v;
  __syncthreads();
}

DI void ssd_state_item(const Params& p, int layer, int b, int tc, int h, char* smem) {
  bf16_t* XT = (bf16_t*)smem;
  bf16_t* BT = XT + 64 * TST;
  float* csf = (float*)(BT + 64 * TST);
  float* csb = csf + 128; float* dtF = csb + 128; float* dtB = dtF + 128; float* laF = dtB + 128; float* laB = laF + 128;
  const int tid = ltid(), w = tid >> 6, lane = tid & 63, r = lane & 31, hh = lane >> 5;
  const int row0 = chunk_row0(b, tc);
  const bf16_t* XBC = (const bf16_t*)(p.ws + OFF_XBC);
  load_tile_T(XT, XBC + (size_t)row0 * 768 + h * 64, 768);
  load_tile_T(BT, XBC + (size_t)row0 * 768 + 512 + (h >> 2) * 64, 768);
  chunk_scan(p, layer, row0, h, csf, csb, dtF, dtB, laF, laB);
  __syncthreads();
  if (tid < 128) laF[tid] = dtF[tid] * __expf(csf[127] - csf[tid]);
  else { int t = tid - 128; laB[t] = dtB[t] * __expf(csb[0] - csb[t]); }
  __syncthreads();
  const int d = w >> 1, pt = w & 1;
  const float* wv = d == 0 ? laF : laB;
  f32x16 acc[2];
#pragma unroll
  for (int i = 0; i < 16; ++i) { acc[0][i] = 0.f; acc[1][i] = 0.f; }
#pragma unroll
  for (int s = 0; s < 8; ++s) {
    int l0 = 16 * s + 8 * hh;
    u32x4 xa = *(const u32x4*)(XT + (32 * pt + r) * TST + l0);
    u32x4 sa;
#pragma unroll
    for (int j = 0; j < 4; ++j) sa[j] = pack2(lo2f(xa[j]) * wv[l0 + 2 * j], hi2f(xa[j]) * wv[l0 + 2 * j + 1]);
    bf16x8 af = __builtin_bit_cast(bf16x8, sa);
#pragma unroll
    for (int nt = 0; nt < 2; ++nt) {
      bf16x8 bfr = *(const bf16x8*)(BT + (32 * nt + r) * TST + l0);
      acc[nt] = MFMA32(af, bfr, acc[nt]);
    }
  }
  bf16_t* S = (bf16_t*)(p.ws + OFF_SST) + ((((size_t)d * NB + b) * NCH + tc) * 8 + h) * 4096;
#pragma unroll
  for (int nt = 0; nt < 2; ++nt)
#pragma unroll
    for (int i = 0; i < 16; ++i) S[(32 * pt + crow(i, hh)) * 64 + 32 * nt + r] = f2bf(acc[nt][i]);
  if (tid == 0) {
    float* TD = (float*)(p.ws + OFF_TDEC);
    TD[((0 * NB + b) * NCH + tc) * 8 + h] = __expf(csf[127]);
    TD[((1 * NB + b) * NCH + tc) * 8 + h] = __expf(csb[0]);
  }
  __syncthreads();
}

DI void ssd_pass_item(const Params& p, int it) {
  const int e = it * 256 + ltid();
  const int pn2 = e & 2047, h = (e >> 11) & 7, b = (e >> 14) & 3, d = e >> 16;
  unsigned* S = (unsigned*)(p.ws + OFF_SST);
  const float* TD = (const float*)(p.ws + OFF_TDEC);
  unsigned sv[NCH]; float T[NCH];
#pragma unroll
  for (int i = 0; i < NCH; ++i) {
    int tc = d == 0 ? i : (i < 2 ? 1 - i : NCH + 1 - i);
    sv[i] = S[(((size_t)(d * NB + b) * NCH + tc) * 8 + h) * 2048 + pn2];
    T[i] = TD[((d * NB + b) * NCH + tc) * 8 + h];
  }
  float h0 = 0.f, h1 = 0.f;
#pragma unroll
  for (int i = 0; i < NCH; ++i) {
    int tc = d == 0 ? i : (i < 2 ? 1 - i : NCH + 1 - i);
    S[(((size_t)(d * NB + b) * NCH + tc) * 8 + h) * 2048 + pn2] = pack2(h0, h1);
    h0 = T[i] * h0 + lo2f(sv[i]); h1 = T[i] * h1 + hi2f(sv[i]);
  }
}

DI void ssd_out_item(const Params& p, int layer, int b, int tc, int h, char* smem) {
  bf16_t* XT = (bf16_t*)smem;
  bf16_t* Bs = XT + 64 * TST;
  float* csf = (float*)(Bs + 128 * BST);
  float* csb = csf + 128; float* dtF = csb + 128; float* dtB = dtF + 128; float* laF = dtB + 128; float* laB = laF + 128;
  const int tid = ltid(), w = tid >> 6, lane = tid & 63, r = lane & 31, hh = lane >> 5;
  const int row0 = chunk_row0(b, tc), g = h >> 2;
  const bf16_t* XBC = (const bf16_t*)(p.ws + OFF_XBC);
  load_tile_T(XT, XBC + (size_t)row0 * 768 + h * 64, 768);
#pragma unroll
  for (int i = 0; i < 4; ++i) {
    int c = tid + 256 * i, tok = c >> 3, part = c & 7;
    *(u32x4*)(Bs + tok * BST + part * 8) = *(const u32x4*)(XBC + (size_t)(row0 + tok) * 768 + 512 + g * 64 + part * 8);
  }
  const int l = 32 * w + r;
  bf16x8 cf[4];
#pragma unroll
  for (int ks = 0; ks < 4; ++ks) cf[ks] = *(const bf16x8*)(XBC + (size_t)(row0 + l) * 768 + 640 + g * 64 + 16 * ks + 8 * hh);
  chunk_scan(p, layer, row0, h, csf, csb, dtF, dtB, laF, laB);
  const float csf_l = csf[l], csb_l = csb[l];
  f32x16 yacc[2];
#pragma unroll
  for (int i = 0; i < 16; ++i) { yacc[0][i] = 0.f; yacc[1][i] = 0.f; }
#pragma unroll
  for (int st = 0; st < 4; ++st) {
    f32x16 gacc;
#pragma unroll
    for (int i = 0; i < 16; ++i) gacc[i] = 0.f;
#pragma unroll
    for (int ks = 0; ks < 4; ++ks) {
      bf16x8 af = *(const bf16x8*)(Bs + (32 * st + r) * BST + 16 * ks + 8 * hh);
      gacc = MFMA32(af, cf[ks], gacc);
    }
#pragma unroll
    for (int i = 0; i < 16; ++i) {
      int s = 32 * st + crow(i, hh);
      float f;
      if (s < l) f = __expf(csf_l - csf[s]) * dtF[s];
      else if (s > l) f = __expf(csb_l - csb[s]) * dtB[s];
      else f = dtF[s] + dtB[s];
      gacc[i] *= f;
    }
#pragma unroll
    for (int s2 = 0; s2 < 2; ++s2) {
      bf16x8 mf = pack8(gacc, s2);
      int sb = 32 * st + 16 * s2 + 4 * hh;
#pragma unroll
      for (int pt = 0; pt < 2; ++pt) {
        u32x2 lo = *(const u32x2*)(XT + (32 * pt + r) * TST + sb);
        u32x2 hi = *(const u32x2*)(XT + (32 * pt + r) * TST + sb + 8);
        u32x4 xa; xa[0] = lo[0]; xa[1] = lo[1]; xa[2] = hi[0]; xa[3] = hi[1];
        yacc[pt] = MFMA32(__builtin_bit_cast(bf16x8, xa), mf, yacc[pt]);
      }
    }
  }
#pragma unroll
  for (int d = 0; d < 2; ++d) {
    const bf16_t* Hs = (const bf16_t*)(p.ws + OFF_SST) + ((((size_t)d * NB + b) * NCH + tc) * 8 + h) * 4096;
    const float e = __expf(d == 0 ? csf_l : csb_l);
#pragma unroll
    for (int pt = 0; pt < 2; ++pt) {
      f32x16 t;
#pragma unroll
      for (int i = 0; i < 16; ++i) t[i] = 0.f;
#pragma unroll
      for (int ks = 0; ks < 4; ++ks) {
        bf16x8 af = *(const bf16x8*)(Hs + (32 * pt + r) * 64 + 16 * ks + 8 * hh);
        t = MFMA32(af, cf[ks], t);
      }
#pragma unroll
      for (int i = 0; i < 16; ++i) yacc[pt][i] += e * t[i];
    }
  }
  const int row = row0 + l;
  const float Dh = p.ssd_d[layer * 8 + h];
  const bf16_t* U = (const bf16_t*)(p.ws + OFF_U);
  bf16_t* YM = (bf16_t*)(p.ws + OFF_H);
  float ssq = 0.f;
#pragma unroll
  for (int pt = 0; pt < 2; ++pt)
#pragma unroll
    for (int q = 0; q < 4; ++q) {
      int pp = 32 * pt + 8 * q + 4 * hh;
      u32x2 xv = *(const u32x2*)(XBC + (size_t)row * 768 + h * 64 + pp);
      u32x2 zv = *(const u32x2*)(U + (size_t)row * DIN + U_Z + h * 64 + pp);
      float y0 = (yacc[pt][4 * q + 0] + Dh * lo2f(xv[0])) * silu_f(lo2f(zv[0]));
      float y1 = (yacc[pt][4 * q + 1] + Dh * hi2f(xv[0])) * silu_f(hi2f(zv[0]));
      float y2 = (yacc[pt][4 * q + 2] + Dh * lo2f(xv[1])) * silu_f(lo2f(zv[1]));
      float y3 = (yacc[pt][4 * q + 3] + Dh * hi2f(xv[1])) * silu_f(hi2f(zv[1]));
      u32x2 o; o[0] = pack2(y0, y1); o[1] = pack2(y2, y3);
      float r0 = lo2f(o[0]), r1 = hi2f(o[0]), r2 = lo2f(o[1]), r3 = hi2f(o[1]);
      ssq += r0 * r0 + r1 * r1 + r2 * r2 + r3 * r3;
      *(u32x2*)(YM + (size_t)row * DM + 512 + h * 64 + pp) = o;
    }
  ssq += __shfl_xor(ssq, 32);
  if (hh == 0) ((float*)(p.ws + OFF_SSQ))[(size_t)row * 8 + h] = ssq;
  __syncthreads();
}

constexpr int KST = 104;
constexpr int VST = 68;
DI void attn_item(const Params& p, int b, int head, int qrow0, int t0, bool lat, int nkeys, char* smem) {
  bf16_t* Ks = (bf16_t*)smem;
  bf16_t* Vs = Ks + 64 * KST;
  const int tid = ltid(), w = tid >> 6, lane = tid & 63, r = lane & 31, hh = lane >> 5;
  const bf16_t* QB = (const bf16_t*)(p.ws + OFF_QB);
  const bf16_t* KB = (const bf16_t*)(p.ws + OFF_KB) + (size_t)(b * 4 + head) * LK * 96;
  const bf16_t* VT = (const bf16_t*)(p.ws + OFF_VT) + (size_t)(b * 4 + head) * 64 * LK;
  const float qscale = 0.10206207261596575f * 1.4426950408889634f;
  const int qrow = qrow0 + w * 32 + r;
  const int t = t0 + w * 32 + r;
  bf16x8 qf[6];
  {
    const bf16_t* src = QB + (size_t)qrow * 384 + head * 96;
#pragma unroll
    for (int s = 0; s < 4; ++s) {
      u32x4 v = *(const u32x4*)(src + 16 * s + 8 * hh);
      u32x4 o;
#pragma unroll
      for (int j = 0; j < 4; ++j) o[j] = pack2(lo2f(v[j]) * qscale, hi2f(v[j]) * qscale);
      qf[s] = __builtin_bit_cast(bf16x8, o);
    }
#pragma unroll
    for (int s = 4; s < 6; ++s) {
      u32x4 va = *(const u32x4*)(src + 16 * s), vb = *(const u32x4*)(src + 16 * s + 8);
      float posf = s == 4 ? (float)(t >> 6) : (float)(t & 63);
      float o[8];
#pragma unroll
      for (int j = 0; j < 8; ++j) {
        float a = (j & 1) ? hi2f(va[j >> 1]) : lo2f(va[j >> 1]);
        float bb = (j & 1) ? hi2f(vb[j >> 1]) : lo2f(vb[j >> 1]);
        float res;
        if (lat) {
          float invf = exp2f(-(float)(2 * j) * (13.287712379549449f / 16.f));
          float rev = posf * invf * 0.15915494309189535f;
          float cs = __builtin_amdgcn_cosf(rev), sn = __builtin_amdgcn_sinf(rev);
          res = hh == 0 ? a * cs - bb * sn : bb * cs + a * sn;
        } else res = hh == 0 ? a : bb;
        o[j] = res * qscale;
      }
      u32x4 ov; ov[0] = pack2(o[0], o[1]); ov[1] = pack2(o[2], o[3]); ov[2] = pack2(o[4], o[5]); ov[3] = pack2(o[6], o[7]);
      qf[s] = __builtin_bit_cast(bf16x8, ov);
    }
  }
  f32x16 oacc[2];
#pragma unroll
  for (int i = 0; i < 16; ++i) { oacc[0][i] = 0.f; oacc[1][i] = 0.f; }
  float m = -1e30f, lsum = 0.f;
  u32x4 rk[3], rv[2];
  auto gload = [&](int key0) {
#pragma unroll
    for (int i = 0; i < 3; ++i) rk[i] = *(const u32x4*)(KB + (size_t)key0 * 96 + (tid + 256 * i) * 8);
#pragma unroll
    for (int i = 0; i < 2; ++i) { int c = tid + 256 * i; rv[i] = *(const u32x4*)(VT + (size_t)(c >> 3) * LK + key0 + (c & 7) * 8); }
  };
  gload(0);
  const int NT = nkeys / 64;
  for (int kt = 0; kt < NT; ++kt) {
#pragma unroll
    for (int i = 0; i < 3; ++i) { int c = tid + 256 * i; *(u32x4*)(Ks + (c / 12) * KST + (c % 12) * 8) = rk[i]; }
#pragma unroll
    for (int i = 0; i < 2; ++i) {
      int c = tid + 256 * i;
      bf16_t* d = Vs + (c >> 3) * VST + (c & 7) * 8;
      u32x2 a; a[0] = rv[i][0]; a[1] = rv[i][1];
      u32x2 bq; bq[0] = rv[i][2]; bq[1] = rv[i][3];
      *(u32x2*)d = a; *(u32x2*)(d + 4) = bq;
    }
    __syncthreads();
    if (kt + 1 < NT) gload((kt + 1) * 64);
    f32x16 sacc[2];
#pragma unroll
    for (int i = 0; i < 16; ++i) { sacc[0][i] = 0.f; sacc[1][i] = 0.f; }
#pragma unroll
    for (int s = 0; s < 6; ++s)
#pragma unroll
      for (int k2 = 0; k2 < 2; ++k2) {
        bf16x8 af = *(const bf16x8*)(Ks + (32 * k2 + r) * KST + 16 * s + 8 * hh);
        sacc[k2] = MFMA32(af, qf[s], sacc[k2]);
      }
    float mx = sacc[0][0];
#pragma unroll
    for (int i = 0; i < 16; ++i) { mx = fmaxf(mx, sacc[0][i]); mx = fmaxf(mx, sacc[1][i]); }
    mx = fmaxf(mx, __shfl_xor(mx, 32));
    const float mn = fmaxf(m, mx);
    const float alpha = __builtin_amdgcn_exp2f(m - mn);
    m = mn;
    float ps = 0.f;
#pragma unroll
    for (int i = 0; i < 16; ++i) {
      sacc[0][i] = __builtin_amdgcn_exp2f(sacc[0][i] - mn); sacc[1][i] = __builtin_amdgcn_exp2f(sacc[1][i] - mn);
      ps += sacc[0][i] + sacc[1][i];
    }
    lsum = lsum * alpha + ps;
#pragma unroll
    for (int i = 0; i < 16; ++i) { oacc[0][i] *= alpha; oacc[1][i] *= alpha; }
#pragma unroll
    for (int k2 = 0; k2 < 2; ++k2)
#pragma unroll
      for (int s2 = 0; s2 < 2; ++s2) {
        bf16x8 pf = pack8(sacc[k2], s2);
        int kb0 = 32 * k2 + 16 * s2 + 4 * hh;
#pragma unroll
        for (int d = 0; d < 2; ++d) {
          u32x2 lo = *(const u32x2*)(Vs + (32 * d + r) * VST + kb0);
          u32x2 hi = *(const u32x2*)(Vs + (32 * d + r) * VST + kb0 + 8);
          u32x4 va; va[0] = lo[0]; va[1] = lo[1]; va[2] = hi[0]; va[3] = hi[1];
          oacc[d] = MFMA32(__builtin_bit_cast(bf16x8, va), pf, oacc[d]);
        }
      }
    __syncthreads();
  }
  lsum += __shfl_xor(lsum, 32);
  const float inv = 1.f / lsum;
  bf16_t* YM = (bf16_t*)(p.ws + OFF_H) + (size_t)qrow * DM + head * 64;
#pragma unroll
  for (int d = 0; d < 2; ++d)
#pragma unroll
    for (int q = 0; q < 4; ++q) {
      u32x2 o; o[0] = pack2(oacc[d][4 * q] * inv, oacc[d][4 * q + 1] * inv); o[1] = pack2(oacc[d][4 * q + 2] * inv, oacc[d][4 * q + 3] * inv);
      *(u32x2*)(YM + 32 * d + 8 * q + 4 * hh) = o;
    }
}

DI void attn_item8(const Params& p, int b, int head, int qrow0, int t0, bool lat, int nkeys, char* smem) {
  bf16_t* Ks = (bf16_t*)smem;
  bf16_t* Vs = Ks + 64 * KST;
  const int tid = ltid512(), w = tid >> 6, lane = tid & 63, r = lane & 31, hh = lane >> 5;
  const bf16_t* QB = (const bf16_t*)(p.ws + OFF_QB);
  const bf16_t* KB = (const bf16_t*)(p.ws + OFF_KB) + (size_t)(b * 4 + head) * LK * 96;
  const bf16_t* VT = (const bf16_t*)(p.ws + OFF_VT) + (size_t)(b * 4 + head) * 64 * LK;
  const float qscale = 0.10206207261596575f * 1.4426950408889634f;
  const int qrow = qrow0 + w * 32 + r;
  const int t = t0 + w * 32 + r;
  bf16x8 qf[6];
  {
    const bf16_t* src = QB + (size_t)qrow * 384 + head * 96;
#pragma unroll
    for (int s = 0; s < 4; ++s) {
      u32x4 v = *(const u32x4*)(src + 16 * s + 8 * hh);
      u32x4 o;
#pragma unroll
      for (int j = 0; j < 4; ++j) o[j] = pack2(lo2f(v[j]) * qscale, hi2f(v[j]) * qscale);
      qf[s] = __builtin_bit_cast(bf16x8, o);
    }
#pragma unroll
    for (int s = 4; s < 6; ++s) {
      u32x4 va = *(const u32x4*)(src + 16 * s), vb = *(const u32x4*)(src + 16 * s + 8);
      float posf = s == 4 ? (float)(t >> 6) : (float)(t & 63);
      float o[8];
#pragma unroll
      for (int j = 0; j < 8; ++j) {
        float a = (j & 1) ? hi2f(va[j >> 1]) : lo2f(va[j >> 1]);
        float bb = (j & 1) ? hi2f(vb[j >> 1]) : lo2f(vb[j >> 1]);
        float res;
        if (lat) {
          float invf = exp2f(-(float)(2 * j) * (13.287712379549449f / 16.f));
          float rev = posf * invf * 0.15915494309189535f;
          float cs = __builtin_amdgcn_cosf(rev), sn = __builtin_amdgcn_sinf(rev);
          res = hh == 0 ? a * cs - bb * sn : bb * cs + a * sn;
        } else res = hh == 0 ? a : bb;
        o[j] = res * qscale;
      }
      u32x4 ov; ov[0] = pack2(o[0], o[1]); ov[1] = pack2(o[2], o[3]); ov[2] = pack2(o[4], o[5]); ov[3] = pack2(o[6], o[7]);
      qf[s] = __builtin_bit_cast(bf16x8, ov);
    }
  }
  f32x16 oacc[2];
#pragma unroll
  for (int i = 0; i < 16; ++i) { oacc[0][i] = 0.f; oacc[1][i] = 0.f; }
  float m = -1e30f, lsum = 0.f;
  u32x4 rk[3], rv[2];
  auto gload = [&](int key0) {
    rk[0] = *(const u32x4*)(KB + (size_t)key0 * 96 + tid * 8);
    if (tid < 256) rk[1] = *(const u32x4*)(KB + (size_t)key0 * 96 + (512 + tid) * 8);
    rv[0] = *(const u32x4*)(VT + (size_t)(tid >> 3) * LK + key0 + (tid & 7) * 8);
  };
  gload(0);
  const int NT = nkeys / 64;
  for (int kt = 0; kt < NT; ++kt) {
    *(u32x4*)(Ks + (tid / 12) * KST + (tid % 12) * 8) = rk[0];
    if (tid < 256) { const int c = 512 + tid; *(u32x4*)(Ks + (c / 12) * KST + (c % 12) * 8) = rk[1]; }
    {
      bf16_t* d = Vs + (tid >> 3) * VST + (tid & 7) * 8;
      u32x2 a; a[0] = rv[0][0]; a[1] = rv[0][1];
      u32x2 bq; bq[0] = rv[0][2]; bq[1] = rv[0][3];
      *(u32x2*)d = a; *(u32x2*)(d + 4) = bq;
    }
    __syncthreads();
    if (kt + 1 < NT) gload((kt + 1) * 64);
    f32x16 sacc[2];
#pragma unroll
    for (int i = 0; i < 16; ++i) { sacc[0][i] = 0.f; sacc[1][i] = 0.f; }
#pragma unroll
    for (int s = 0; s < 6; ++s)
#pragma unroll
      for (int k2 = 0; k2 < 2; ++k2) {
        bf16x8 af = *(const bf16x8*)(Ks + (32 * k2 + r) * KST + 16 * s + 8 * hh);
        sacc[k2] = MFMA32(af, qf[s], sacc[k2]);
      }
    float mx = sacc[0][0];
#pragma unroll
    for (int i = 0; i < 16; ++i) { mx = fmaxf(mx, sacc[0][i]); mx = fmaxf(mx, sacc[1][i]); }
    mx = fmaxf(mx, __shfl_xor(mx, 32));
    const float mn = fmaxf(m, mx);
    const float alpha = __builtin_amdgcn_exp2f(m - mn);
    m = mn;
    float ps = 0.f;
#pragma unroll
    for (int i = 0; i < 16; ++i) {
      sacc[0][i] = __builtin_amdgcn_exp2f(sacc[0][i] - mn); sacc[1][i] = __builtin_amdgcn_exp2f(sacc[1][i] - mn);
      ps += sacc[0][i] + sacc[1][i];
    }
    lsum = lsum * alpha + ps;
#pragma unroll
    for (int i = 0; i < 16; ++i) { oacc[0][i] *= alpha; oacc[1][i] *= alpha; }
#pragma unroll
    for (int k2 = 0; k2 < 2; ++k2)
#pragma unroll
      for (int s2 = 0; s2 < 2; ++s2) {
        bf16x8 pf = pack8(sacc[k2], s2);
        int kb0 = 32 * k2 + 16 * s2 + 4 * hh;
#pragma unroll
        for (int d = 0; d < 2; ++d) {
          u32x2 lo = *(const u32x2*)(Vs + (32 * d + r) * VST + kb0);
          u32x2 hi = *(const u32x2*)(Vs + (32 * d + r) * VST + kb0 + 8);
          u32x4 va; va[0] = lo[0]; va[1] = lo[1]; va[2] = hi[0]; va[3] = hi[1];
          oacc[d] = MFMA32(__builtin_bit_cast(bf16x8, va), pf, oacc[d]);
        }
      }
    __syncthreads();
  }
  lsum += __shfl_xor(lsum, 32);
  const float inv = 1.f / lsum;
  bf16_t* YM = (bf16_t*)(p.ws + OFF_H) + (size_t)qrow * DM + head * 64;
#pragma unroll
  for (int d = 0; d < 2; ++d)
#pragma unroll
    for (int q = 0; q < 4; ++q) {
      u32x2 o; o[0] = pack2(oacc[d][4 * q] * inv, oacc[d][4 * q + 1] * inv); o[1] = pack2(oacc[d][4 * q + 2] * inv, oacc[d][4 * q + 3] * inv);
      *(u32x2*)(YM + 32 * d + 8 * q + 4 * hh) = o;
    }
}

DI void phase_qkv(const Params& p, int layer, int bid, int nb, char* smem) {
  const int MQ = layer == 0 ? MT : ML;
  const int nq = (MQ / 128) * 3, nkv = (MT / 128) * 4, nst = NB * NCH * 8;
  const float* RS = (const float*)(p.ws + OFF_RSTD);
  EpiQ eq{(bf16_t*)(p.ws + OFF_QB), RS};
  EpiKV ekv{(bf16_t*)(p.ws + OFF_KB), (bf16_t*)(p.ws + OFF_VT), RS};
  const bf16_t* U = (const bf16_t*)(p.ws + OFF_U);
  for (int it = bid; it < nq + nkv + nst; it += nb) {
    if (it < nq) gemm_tile<false>(U, DIN, wt_ptr(p, layer, WT_UQ), 256, (it / 3) * 128, (it % 3) * 128, smem, eq);
    else if (it < nq + nkv) { int j = it - nq; gemm_tile<false>(U + U_CKV, DIN, wt_ptr(p, layer, WT_UKV), 128, (j / 4) * 128, (j % 4) * 128, smem, ekv); }
    else { int j = it - nq - nkv; for (int rep = 0; rep < REP_SSD; ++rep) ssd_state_item(p, layer, j / (NCH * 8), (j / 8) % NCH, j & 7, smem); }
  }
}
DI void phase_att(const Params& p, int layer, int bid, int nb, int vbid, int nvb, char* smem, char* sh) {
  for (int it = bid; it < 256; it += nb) {
    const int x = it & 7, j = it >> 3, bh = 2 * x + (j >> 4), qb = j & 15, b = bh >> 2, head = bh & 3;
    for (int rep = 0; rep < REP_ATT; ++rep) attn_item8(p, b, head, b * SEQ + qb * 256, qb * 256, true, LK, smem);
  }
  const int nctx = layer == 0 ? 32 : 0, npass = 512;
  for (int it = vbid; it < nctx + npass; it += nvb) {
    if (it < nctx) { int b = it >> 3, head = (it >> 1) & 3, qb = it & 1; attn_item(p, b, head, ML + b * CTX + qb * 128, qb * 128, false, CTX, sh); }
    else ssd_pass_item(p, it - nctx);
  }
}
DI void phase_ssdout(const Params& p, int layer, int bid, int nb, char* smem) {
  for (int it = bid; it < NB * NCH * 8; it += nb) {
    int b = it / (NCH * 8), tc = (it / 8) % NCH, h = it & 7;
    if (layer == 1 && tc < 2) continue;
    for (int rep = 0; rep < REP_SSD; ++rep) ssd_out_item(p, layer, b, tc, h, smem);
  }
}


#define XB_TMO      128
#define XB_XCNT(j)  (256  + 64 * (j))
#define XB_XSUB(j)  (1280 + 64 * (j))
#define XB_XGEN(j)  (2304 + 64 * (j))
#define XB_TOP      3328
#define XB_TOPGEN   3392
#define XCD_BAR_WORDS 3456
#define XB_SPIN_CAP (1u << 22)
#define LAS __attribute__((address_space(3)))
DI unsigned xb_ld(unsigned* p) { return __hip_atomic_load(p, __ATOMIC_RELAXED, __HIP_MEMORY_SCOPE_AGENT); }
DI unsigned xb_add(unsigned* p, unsigned v) { return __hip_atomic_fetch_add(p, v, __ATOMIC_RELAXED, __HIP_MEMORY_SCOPE_AGENT); }
DI unsigned xb_xcc_id() { return (unsigned)__builtin_amdgcn_s_getreg((3 << 11) | 20) & 0xFu; }
#define XB_SPIN(cond, bar) do { unsigned _sp = 0; while (cond) { __builtin_amdgcn_s_sleep(1); \
    if ((++_sp & 255u) == 0u) { if (xb_ld(&(bar)[XB_TMO])) break; if (_sp > XB_SPIN_CAP) { atomicAdd(&(bar)[XB_TMO], 1u); break; } } } } while (0)
struct XcdBarrier { unsigned* bar; unsigned x; volatile LAS unsigned* st; };
DI XcdBarrier xcd_barrier_post(unsigned* bar, volatile LAS unsigned* st) {
  XcdBarrier b; b.bar = bar; b.x = xb_xcc_id(); b.st = st;
  if (threadIdx.x == 0) (void)xb_add(&bar[XB_XCNT(b.x)], 1u);
  return b;
}
DI void xcd_barrier_complete(unsigned* bar, unsigned x, unsigned& nloc, unsigned& nx) {
  const unsigned G = gridDim.x * gridDim.y * gridDim.z;
  unsigned sum, cnt, mine, sp = 0u;
  for (;;) {
    sum = 0u; cnt = 0u; mine = 0u;
#pragma unroll
    for (unsigned j = 0; j < 16; ++j) { const unsigned c = xb_ld(&bar[XB_XCNT(j)]); sum += c; cnt += (c > 0u) ? 1u : 0u; mine = (j == x) ? c : mine; }
    if (sum == G) break;
    __builtin_amdgcn_s_sleep(1);
    if ((++sp & 255u) == 0u) { if (xb_ld(&bar[XB_TMO])) break; if (sp > XB_SPIN_CAP) { atomicAdd(&bar[XB_TMO], 1u); break; } }
  }
  nloc = mine > 0u ? mine : 1u; nx = cnt > 0u ? cnt : 1u;
}
DI void xcd_barrier(const XcdBarrier& b) {
  asm volatile("s_waitcnt vmcnt(0)" ::: "memory");
  __syncthreads();
  if (threadIdx.x == 0) {
    unsigned* bar = b.bar;
    asm volatile("" : "+s"(bar));
    __builtin_amdgcn_s_waitcnt(0);
    unsigned nloc = b.st[0], nx = b.st[1];
    if (nloc == 0u) { xcd_barrier_complete(bar, b.x, nloc, nx); b.st[0] = nloc; b.st[1] = nx; }
    const unsigned old = xb_add(&bar[XB_XSUB(b.x)], 1u);
    const unsigned gen = old / nloc;
    if (old + 1u == (gen + 1u) * nloc) {
      __builtin_amdgcn_fence(__ATOMIC_RELEASE, "agent");
      asm volatile("s_waitcnt vmcnt(0)" ::: "memory");
      const unsigned og = xb_add(&bar[XB_TOP], 1u);
      const unsigned tg = og / nx;
      if (og + 1u == (tg + 1u) * nx) xb_add(&bar[XB_TOPGEN], 1u);
      else XB_SPIN(xb_ld(&bar[XB_TOPGEN]) == tg, bar);
      __builtin_amdgcn_fence(__ATOMIC_ACQUIRE, "agent");
      xb_add(&bar[XB_XGEN(b.x)], 1u);
      asm volatile("s_waitcnt vmcnt(0)" ::: "memory");
    } else {
      XB_SPIN(xb_ld(&bar[XB_XGEN(b.x)]) == gen, bar);
      __builtin_amdgcn_fence(__ATOMIC_ACQUIRE, "agent");
      asm volatile("s_waitcnt vmcnt(0)" ::: "memory");
    }
  }
  __syncthreads();
}

constexpr int SMEM_BYTES = 2 * GBUF * 2;
enum { PH_PREP0 = 0, PH_H0, PH_INPROJ, PH_PREP, PH_QKV, PH_ATT, PH_SSDOUT, PH_WOUT, PH_POSTMIX, PH_FF1, PH_FF2, PH_POSTFFN, PH_SSDNORM };

struct Ids { int bid, nb, vbid, nvb, lid; };
DI void run_phase(const Params& p, int ph, int layer, const Ids& id, char* smem, char* sh) {
  switch (ph) {
    case PH_PREP0: phase_prep0(p, id.vbid, id.nvb, sh); break;
    case PH_H0: phase_h0(p, id.vbid, id.nvb); break;
    case PH_INPROJ: phase_inproj(p, layer, id.bid, id.nb, smem); break;
    case PH_PREP: phase_prep(p, layer, id.vbid, id.nvb); break;
    case PH_QKV: phase_qkv(p, layer, id.vbid, id.nvb, sh); break;
    case PH_ATT: phase_att(p, layer, id.bid, id.nb, id.vbid, id.nvb, smem, sh); break;
    case PH_SSDOUT: phase_ssdout(p, layer, id.vbid, id.nvb, sh); break;
    case PH_WOUT: phase_wout(p, layer, id.lid, id.nvb, sh); break;
    case PH_POSTMIX: phase_postmix(p, layer, id.vbid, id.nvb); break;
    case PH_FF1: phase_ff1(p, layer, id.bid, id.nb, id.vbid, id.nvb, smem, sh); break;
    case PH_FF2: phase_ff2(p, layer, id.bid, id.nb, id.vbid, id.nvb, smem, sh); break;
    case PH_POSTFFN: phase_postffn(p, layer, id.vbid, id.nvb); break;
  }
}

__global__ void __launch_bounds__(512) mega_kernel(Params p) {
  extern __shared__ __attribute__((aligned(16))) char smem[];
  cg::grid_group grid = cg::this_grid();
  if (p.ws == nullptr) grid.sync();
  const int half = __builtin_amdgcn_readfirstlane((int)(threadIdx.x >> 8));
  Ids id;
  id.bid = blockIdx.x; id.nb = gridDim.x;
  id.vbid = 2 * id.bid + half; id.nvb = 2 * id.nb;
  id.lid = (id.bid & 7) + 8 * (2 * (id.bid >> 3) + half);
  char* sh = smem + half * SMEM_BYTES;
  volatile LAS unsigned* st = (volatile LAS unsigned*)(smem + 2 * SMEM_BYTES - 16);
  if (threadIdx.x == 0) { st[0] = 0u; st[1] = 0u; st[2] = 0u; st[3] = 0u; }
  __syncthreads();
  XcdBarrier xb = xcd_barrier_post((unsigned*)(p.ws + OFF_BAR), st);
  for (int step = 0; step < 22; ++step) {
    int ph, layer;
    if (step < 2) { ph = step; layer = 0; }
    else { int j = step - 2; layer = j / 10; ph = PH_INPROJ + j % 10; }
    typedef const void* __attribute__((address_space(4))) * KArgs;
    KArgs ka = (KArgs)__builtin_amdgcn_kernarg_segment_ptr();
    asm volatile("" : "+s"(ka));
    Params q;
    {
      const void** dst = (const void**)&q;
#pragma unroll
      for (int i = 0; i < 27; ++i) dst[i] = ka[i];
    }
    run_phase(q, ph, layer, id, smem, sh);
    if (step < 21) xcd_barrier(xb);
  }
}

extern "C" void kernel_launch(void* const* d_in, const int* in_sizes, int n_in, void* d_out, int out_size, void* d_ws, size_t ws_size,
                              hipStream_t stream) {
  if (ws_size < WS_NEED) { fprintf(stderr, "workspace too small: %zu < %zu\n", ws_size, (size_t)WS_NEED); return; }
  Params p{};
  const float** f = (const float**)&p;
  for (int i = 0; i < 25; ++i) f[i] = (const float*)d_in[i];
  p.out = (float*)d_out;
  p.ws = (char*)d_ws;
  static int grid_blocks = 0;
  if (!grid_blocks) {
    int dev = 0, cus = 0, per_cu = 0;
    hipGetDevice(&dev);
    hipDeviceGetAttribute(&cus, hipDeviceAttributeMultiprocessorCount, dev);
    hipFuncSetAttribute((const void*)mega_kernel, hipFuncAttributeMaxDynamicSharedMemorySize, 2 * SMEM_BYTES);
    hipOccupancyMaxActiveBlocksPerMultiprocessor(&per_cu, mega_kernel, 512, 2 * SMEM_BYTES);
    if (per_cu > 1) per_cu = 1;
    grid_blocks = cus * per_cu;
  }
  hipMemsetAsync((char*)d_ws + OFF_BAR, 0, XCD_BAR_WORDS * 4, stream);
  void* args[] = {&p};
  hipError_t e = hipLaunchCooperativeKernel((void*)mega_kernel, dim3(grid_blocks), dim3(512), args, 2 * SMEM_BYTES, stream);
  if (e != hipSuccess) fprintf(stderr, "cooperative launch failed: %s (grid %d)\n", hipGetErrorString(e), grid_blocks);
}
```

```cpp
#include <hip/hip_runtime.h>
#include <hip/hip_cooperative_groups.h>
#include <stdint.h>
#include <stdio.h>
namespace cg = cooperative_groups;

#ifndef MEGA
#define MEGA 1
#endif
#ifndef REP_GEMM
#define REP_GEMM 1
#endif
#ifndef REP_ATT
#define REP_ATT 1
#endif
#ifndef REP_SSD
#define REP_SSD 1
#endif

typedef unsigned short bf16_t;
using bf16x8 = __attribute__((ext_vector_type(8))) short;
using s16x4  = __attribute__((ext_vector_type(4))) short;
using f32x4  = __attribute__((ext_vector_type(4))) float;
using f32x16 = __attribute__((ext_vector_type(16))) float;
using u32x4  = __attribute__((ext_vector_type(4))) unsigned;
using u32x2  = __attribute__((ext_vector_type(2))) unsigned;
#define DI __device__ __forceinline__
#define MFMA32(a, b, c) __builtin_amdgcn_mfma_f32_32x32x16_bf16((a), (b), (c), 0, 0, 0)
#define MFMA16(a, b, c) __builtin_amdgcn_mfma_f32_16x16x32_bf16((a), (b), (c), 0, 0, 0)

constexpr int DM = 1024, NB = 4, SEQ = 4096, CTX = 256;
constexpr int ML = NB * SEQ;
constexpr int MC = NB * CTX;
constexpr int MT = ML + MC;
constexpr int DIN = 2480, DINP = 2560;
constexpr int LK = CTX + SEQ;
constexpr int DFF = 4096;
constexpr int NCH = 34;
constexpr float EPS = 1e-6f;
constexpr int U_CKV = 256, U_KR = 384, U_GB = 416, U_GC = 672, U_VAL = 928, U_Z = 1184, U_XBC = 1696, U_DT = 2464;

constexpr size_t AL(size_t x) { return (x + 255) & ~(size_t)255; }
constexpr size_t WT_IN = 0;
constexpr size_t WT_UQ = WT_IN + (size_t)DINP * 1024;
constexpr size_t WT_UKV = WT_UQ + (size_t)384 * 256;
constexpr size_t WT_OUT = WT_UKV + (size_t)512 * 128;
constexpr size_t WT_FF1 = WT_OUT + (size_t)1024 * 1024;
constexpr size_t WT_FF2 = WT_FF1 + (size_t)4096 * 1024;
constexpr size_t WT_ELEMS = WT_FF2 + (size_t)4096 * 1024;
constexpr size_t OFF_WT = 0;
constexpr size_t OFF_MOD = AL(OFF_WT + 2 * WT_ELEMS * 2);
constexpr size_t OFF_XC = AL(OFF_MOD + 2 * 5 * 6144 * 4);
constexpr size_t OFF_H = AL(OFF_XC + (size_t)MC * DM * 4);
constexpr size_t OFF_R1 = AL(OFF_H + (size_t)MT * DM * 2);
constexpr size_t OFF_U = OFF_R1;
constexpr size_t OFF_DT = AL(OFF_U + (size_t)MT * DIN * 2);
constexpr size_t OFF_RSTD = AL(OFF_DT + (size_t)MT * 16 * 4);
constexpr size_t OFF_QB = AL(OFF_RSTD + (size_t)MT * 2 * 4);
constexpr size_t OFF_KB = AL(OFF_QB + (size_t)MT * 384 * 2);
constexpr size_t OFF_VT = AL(OFF_KB + (size_t)NB * 4 * LK * 96 * 2);
constexpr size_t OFF_XBC = AL(OFF_VT + (size_t)NB * 4 * 64 * LK * 2);
constexpr size_t OFF_SST = AL(OFF_XBC + (size_t)MT * 768 * 2);
constexpr size_t OFF_TDEC = AL(OFF_SST + (size_t)2 * NB * NCH * 8 * 4096 * 2);
constexpr size_t OFF_SSQ = AL(OFF_TDEC + (size_t)2 * NB * NCH * 8 * 4);
constexpr size_t OFF_END1 = AL(OFF_SSQ + (size_t)MT * 8 * 4);
constexpr size_t OFF_F1 = OFF_R1;
constexpr size_t OFF_END2 = AL(OFF_F1 + (size_t)MT * DFF * 2);
constexpr size_t OFF_BAR = OFF_END1 > OFF_END2 ? OFF_END1 : OFF_END2;
constexpr size_t WS_NEED = OFF_BAR + 16384;

struct Params {
  const float *x, *c, *ctx, *c_ctx, *w_mod, *b_mod, *g_pre_mix, *w_in, *q_norm, *w_uq, *kv_norm, *w_ukv, *sc_w, *ssd_cw, *ssd_cb,
      *a_log, *dt_bias, *ssd_d, *ssd_norm, *w_out, *g_post_mix, *g_pre_ffn, *w_ff1, *w_ff2, *g_post_ffn;
  float* out;
  char* ws;
};

DI int ltid() { int t = threadIdx.x & 255; asm volatile("" : "+v"(t)); return t; }
DI int ltid512() { int t = threadIdx.x; asm volatile("" : "+v"(t)); return t; }
typedef __bf16 hbf2 __attribute__((ext_vector_type(2)));
typedef float hf2 __attribute__((ext_vector_type(2)));
DI bf16_t f2bf(float x) { return __builtin_bit_cast(bf16_t, (__bf16)x); }
DI float bf2f(unsigned v) { return __uint_as_float(v << 16); }
DI unsigned pack2(float a, float b) { hf2 v = {a, b}; return __builtin_bit_cast(unsigned, __builtin_convertvector(v, hbf2)); }
DI float lo2f(unsigned w) { return __uint_as_float(w << 16); }
DI float hi2f(unsigned w) { return __uint_as_float(w & 0xffff0000u); }
DI float wave_sum(float v) {
#pragma unroll
  for (int o = 32; o > 0; o >>= 1) v += __shfl_xor(v, o);
  return v;
}
DI float silu_f(float x) { return x / (1.f + __expf(-x)); }
DI int crow(int reg, int h) { return (reg & 3) + 8 * (reg >> 2) + 4 * h; }
DI bf16x8 pack8(const f32x16& x, int s) {
  u32x4 p;
  p[0] = pack2(x[8 * s + 0], x[8 * s + 1]); p[1] = pack2(x[8 * s + 2], x[8 * s + 3]);
  p[2] = pack2(x[8 * s + 4], x[8 * s + 5]); p[3] = pack2(x[8 * s + 6], x[8 * s + 7]);
  return __builtin_bit_cast(bf16x8, p);
}
DI const float* xin_row(const Params& p, int layer, int row) {
  if (layer == 0) return row < ML ? p.x + (size_t)row * DM : p.ctx + (size_t)(row - ML) * DM;
  return row < ML ? p.out + (size_t)row * DM : (const float*)(p.ws + OFF_XC) + (size_t)(row - ML) * DM;
}
DI float* xst_row(const Params& p, int row) {
  return row < ML ? p.out + (size_t)row * DM : (float*)(p.ws + OFF_XC) + (size_t)(row - ML) * DM;
}
DI const float* mod_ptr(const Params& p, int layer, int row, int which) {
  int bb = row < ML ? (row >> 12) : 4;
  return (const float*)(p.ws + OFF_MOD) + ((size_t)(layer * 5 + bb) * 6 + which) * DM;
}
DI bf16_t* wt_ptr(const Params& p, int layer, size_t off) { return (bf16_t*)(p.ws + OFF_WT) + (size_t)layer * WT_ELEMS + off; }

DI void transpose_item(const float* __restrict__ w, const float* __restrict__ gk, int gk_from, bf16_t* __restrict__ wt, int K, int N, int kt, int nt, char* smem) {
  float* tile = (float*)smem;
  const int tid = ltid(), tx = tid & 63, ty = tid >> 6;
  const int k0 = kt * 64, n0 = nt * 64;
  const int n = n0 + tx;
  float v[16];
#pragma unroll
  for (int i = 0; i < 16; ++i) {
    int kk = ty + 4 * i;
    v[i] = n < N ? w[(size_t)(k0 + kk) * N + n] : 0.f;
  }
  if (gk) {
#pragma unroll
    for (int i = 0; i < 16; ++i) { int k = k0 + ty + 4 * i; if (k >= gk_from) v[i] *= gk[k - gk_from]; }
  }
#pragma unroll
  for (int i = 0; i < 16; ++i) tile[(ty + 4 * i) * 65 + tx] = v[i];
  __syncthreads();
#pragma unroll
  for (int i = 0; i < 2; ++i) {
    int c = tid + 256 * i, nn = c >> 3, kc = c & 7;
    u32x4 o;
#pragma unroll
    for (int jj = 0; jj < 4; ++jj) o[jj] = pack2(tile[(kc * 8 + 2 * jj) * 65 + nn], tile[(kc * 8 + 2 * jj + 1) * 65 + nn]);
    *(u32x4*)(wt + (size_t)(n0 + nn) * K + k0 + kc * 8) = o;
  }
  __syncthreads();
}

DI void modgemv_item(const Params& p, int layer, int ct, char* smem) {
  float* s = (float*)smem;
  float* red = s + 5 * 1024;
  const int tid = ltid(), w = tid >> 6, lane = tid & 63;
  for (int i = tid; i < 5 * 1024; i += 256) {
    int bb = i >> 10, k = i & 1023;
    float v = bb < 4 ? p.c[bb * 1024 + k] : p.c_ctx[k];
    s[i] = silu_f(v);
  }
  __syncthreads();
  const float* wm = p.w_mod + (size_t)layer * 1024 * 6144;
  const int n = ct * 64 + lane;
  float acc[5] = {0.f, 0.f, 0.f, 0.f, 0.f};
#pragma unroll 16
  for (int k = w * 256; k < w * 256 + 256; ++k) {
    float wv = wm[(size_t)k * 6144 + n];
#pragma unroll
    for (int bb = 0; bb < 5; ++bb) acc[bb] += s[bb * 1024 + k] * wv;
  }
#pragma unroll
  for (int bb = 0; bb < 5; ++bb) red[(w * 5 + bb) * 64 + lane] = acc[bb];
  __syncthreads();
  for (int i = tid; i < 320; i += 256) {
    int bb = i >> 6, ln = i & 63;
    float v = red[(0 * 5 + bb) * 64 + ln] + red[(1 * 5 + bb) * 64 + ln] + red[(2 * 5 + bb) * 64 + ln] + red[(3 * 5 + bb) * 64 + ln];
    int nn = ct * 64 + ln;
    v += p.b_mod[layer * 6144 + nn];
    ((float*)(p.ws + OFF_MOD))[(size_t)(layer * 5 + bb) * 6144 + nn] = v;
  }
  __syncthreads();
}

DI void phase_prep0(const Params& p, int bid, int nb, char* smem) {
  constexpr int PER = 2984;
  for (int it = bid; it < 192 + 2 * PER; it += nb) {
    if (it < 192) { modgemv_item(p, it / 96, it % 96, smem); continue; }
    int layer = (it - 192) / PER, j = (it - 192) % PER;
    if (j < 640) transpose_item(p.w_in + (size_t)layer * 1024 * DIN, nullptr, 0, wt_ptr(p, layer, WT_IN), 1024, DIN, j / 40, j % 40, smem);
    else if ((j -= 640) < 24) transpose_item(p.w_uq + (size_t)layer * 256 * 384, p.q_norm + layer * 256, 0, wt_ptr(p, layer, WT_UQ), 256, 384, j / 6, j % 6, smem);
    else if ((j -= 24) < 16) transpose_item(p.w_ukv + (size_t)layer * 128 * 512, p.kv_norm + layer * 128, 0, wt_ptr(p, layer, WT_UKV), 128, 512, j / 8, j % 8, smem);
    else if ((j -= 16) < 256) transpose_item(p.w_out + (size_t)layer * 1024 * 1024, p.ssd_norm + layer * 512, 512, wt_ptr(p, layer, WT_OUT), 1024, 1024, j / 16, j % 16, smem);
    else if ((j -= 256) < 1024) transpose_item(p.w_ff1 + (size_t)layer * 1024 * 4096, nullptr, 0, wt_ptr(p, layer, WT_FF1), 1024, 4096, j / 64, j % 64, smem);
    else { j -= 1024; transpose_item(p.w_ff2 + (size_t)layer * 4096 * 1024, nullptr, 0, wt_ptr(p, layer, WT_FF2), 4096, 1024, j / 16, j % 16, smem); }
  }
}

DI void write_h_row(const float4 xv[4], float rstd, const float* g, const float* sh, const float* sc, bf16_t* hrow, int lane) {
#pragma unroll
  for (int i = 0; i < 4; ++i) {
    int col = lane * 4 + 256 * i;
    float4 gg = *(const float4*)(g + col), s1 = *(const float4*)(sc + col), s0 = *(const float4*)(sh + col);
    float a = xv[i].x * rstd * gg.x * (1.f + s1.x) + s0.x;
    float b = xv[i].y * rstd * gg.y * (1.f + s1.y) + s0.y;
    float c = xv[i].z * rstd * gg.z * (1.f + s1.z) + s0.z;
    float d = xv[i].w * rstd * gg.w * (1.f + s1.w) + s0.w;
    u32x2 o; o[0] = pack2(a, b); o[1] = pack2(c, d);
    *(u32x2*)(hrow + col) = o;
  }
}
DI float ssq4(const float4 v[4]) {
  float s = 0.f;
#pragma unroll
  for (int i = 0; i < 4; ++i) s += v[i].x * v[i].x + v[i].y * v[i].y + v[i].z * v[i].z + v[i].w * v[i].w;
  return s;
}
DI void load_bf_row(const bf16_t* r, int lane, float4 v[4]) {
#pragma unroll
  for (int i = 0; i < 4; ++i) {
    u32x2 t = *(const u32x2*)(r + lane * 4 + 256 * i);
    v[i] = make_float4(lo2f(t[0]), hi2f(t[0]), lo2f(t[1]), hi2f(t[1]));
  }
}

DI void phase_h0(const Params& p, int bid, int nb) {
  const int w = ltid() >> 6, lane = ltid() & 63;
  bf16_t* H = (bf16_t*)(p.ws + OFF_H);
  for (int row = bid * 4 + w; row < MT; row += nb * 4) {
    const float* xr = xin_row(p, 0, row);
    float4 xv[4];
#pragma unroll
    for (int i = 0; i < 4; ++i) xv[i] = *(const float4*)(xr + lane * 4 + 256 * i);
    float rstd = rsqrtf(wave_sum(ssq4(xv)) * (1.f / DM) + EPS);
    write_h_row(xv, rstd, p.g_pre_mix, mod_ptr(p, 0, row, 0), mod_ptr(p, 0, row, 1), H + (size_t)row * DM, lane);
  }
}

DI void phase_postmix(const Params& p, int layer, int bid, int nb) {
  const int w = ltid() >> 6, lane = ltid() & 63;
  const int M = layer == 0 ? MT : ML;
  bf16_t* H = (bf16_t*)(p.ws + OFF_H);
  const bf16_t* Y = (const bf16_t*)(p.ws + OFF_U);
  for (int row = bid * 4 + w; row < M; row += nb * 4) {
    float4 yv[4], xv[4];
    load_bf_row(Y + (size_t)row * DM, lane, yv);
    const float* xr = xin_row(p, layer, row);
#pragma unroll
    for (int i = 0; i < 4; ++i) xv[i] = *(const float4*)(xr + lane * 4 + 256 * i);
    float rstd = rsqrtf(wave_sum(ssq4(yv)) * (1.f / DM) + EPS);
    const float* g1 = mod_ptr(p, layer, row, 2);
    const float* gp = p.g_post_mix + layer * DM;
    float* xo = xst_row(p, row);
#pragma unroll
    for (int i = 0; i < 4; ++i) {
      int col = lane * 4 + 256 * i;
      float4 a = *(const float4*)(g1 + col), b = *(const float4*)(gp + col);
      xv[i].x += a.x * yv[i].x * rstd * b.x; xv[i].y += a.y * yv[i].y * rstd * b.y;
      xv[i].z += a.z * yv[i].z * rstd * b.z; xv[i].w += a.w * yv[i].w * rstd * b.w;
      *(float4*)(xo + col) = xv[i];
    }
    float rstd1 = rsqrtf(wave_sum(ssq4(xv)) * (1.f / DM) + EPS);
    write_h_row(xv, rstd1, p.g_pre_ffn + layer * DM, mod_ptr(p, layer, row, 3), mod_ptr(p, layer, row, 4), H + (size_t)row * DM, lane);
  }
}

DI void phase_postffn(const Params& p, int layer, int bid, int nb) {
  const int w = ltid() >> 6, lane = ltid() & 63;
  const int M = layer == 0 ? MT : ML;
  bf16_t* H = (bf16_t*)(p.ws + OFF_H);
  for (int row = bid * 4 + w; row < M; row += nb * 4) {
    float4 fv[4], xv[4];
    if (row < ML) load_bf_row(H + (size_t)row * DM, lane, fv);
    else {
      const float* pp = (const float*)(p.ws + OFF_END2) + (size_t)(row - ML) * DM;
#pragma unroll
      for (int i = 0; i < 4; ++i) {
        float4 a = *(const float4*)(pp + lane * 4 + 256 * i), b = *(const float4*)(pp + (size_t)MC * DM + lane * 4 + 256 * i);
        float4 c = *(const float4*)(pp + (size_t)2 * MC * DM + lane * 4 + 256 * i), d = *(const float4*)(pp + (size_t)3 * MC * DM + lane * 4 + 256 * i);
        fv[i] = make_float4((a.x + b.x) + (c.x + d.x), (a.y + b.y) + (c.y + d.y), (a.z + b.z) + (c.z + d.z), (a.w + b.w) + (c.w + d.w));
      }
    }
    float* xo = xst_row(p, row);
#pragma unroll
    for (int i = 0; i < 4; ++i) xv[i] = *(const float4*)(xo + lane * 4 + 256 * i);
    float rstd = rsqrtf(wave_sum(ssq4(fv)) * (1.f / DM) + EPS);
    const float* g2 = mod_ptr(p, layer, row, 5);
    const float* gp = p.g_post_ffn + layer * DM;
#pragma unroll
    for (int i = 0; i < 4; ++i) {
      int col = lane * 4 + 256 * i;
      float4 a = *(const float4*)(g2 + col), b = *(const float4*)(gp + col);
      xv[i].x += a.x * fv[i].x * rstd * b.x; xv[i].y += a.y * fv[i].y * rstd * b.y;
      xv[i].z += a.z * fv[i].z * rstd * b.z; xv[i].w += a.w * fv[i].w * rstd * b.w;
      *(float4*)(xo + col) = xv[i];
    }
    if (layer == 0) {
      float rstd1 = rsqrtf(wave_sum(ssq4(xv)) * (1.f / DM) + EPS);
      write_h_row(xv, rstd1, p.g_pre_mix + DM, mod_ptr(p, 1, row, 0), mod_ptr(p, 1, row, 1), H + (size_t)row * DM, lane);
    }
  }
}

DI void phase_prep(const Params& p, int layer, int bid, int nb) {
  const int w = ltid() >> 6, lane = ltid() & 63;
  const bf16_t* U = (const bf16_t*)(p.ws + OFF_U);
  float* DT = (float*)(p.ws + OFF_DT);
  float* RS = (float*)(p.ws + OFF_RSTD);
  bf16_t* KB = (bf16_t*)(p.ws + OFF_KB);
  bf16_t* XBC = (bf16_t*)(p.ws + OFF_XBC);
  bf16_t* YM = (bf16_t*)(p.ws + OFF_H);
  const float* scw = p.sc_w + layer * 3 * 256;
  const float* cw = p.ssd_cw + layer * 3 * 768;
  const float* cb = p.ssd_cb + layer * 768;
  const int c4 = lane * 4;
  const float4 sw0 = *(const float4*)(scw + c4), sw1 = *(const float4*)(scw + 256 + c4), sw2 = *(const float4*)(scw + 512 + c4);
  float4 cwk[3][3], cbi[3];
#pragma unroll
  for (int i = 0; i < 3; ++i) {
    cbi[i] = *(const float4*)(cb + c4 + 256 * i);
#pragma unroll
    for (int k = 0; k < 3; ++k) cwk[i][k] = *(const float4*)(cw + k * 768 + c4 + 256 * i);
  }
  const float dtb = p.dt_bias[layer * 16 + (lane & 15)];
  const float invf = exp2f(-(float)(2 * (lane & 7)) * (13.287712379549449f / 16.f));
  for (int row = bid * 4 + w; row < MT; row += nb * 4) {
    int b, t, L, pos;
    const bool lat = row < ML;
    if (lat) { b = row >> 12; t = row & 4095; L = SEQ; pos = t + CTX; }
    else { int rr = row - ML; b = rr >> 8; t = rr & 255; L = CTX; pos = t; }
    const bf16_t* u0 = U + (size_t)row * DIN;
    const bool hp = t > 0, hn = t < L - 1;
    const bf16_t* um = hp ? u0 - DIN : u0;
    const bf16_t* up = hn ? u0 + DIN : u0;
    const float mp = hp ? 1.f : 0.f, mn = hn ? 1.f : 0.f;
    const u32x2 vq = *(const u32x2*)(u0 + c4);
    const u32x2 vkv = *(const u32x2*)(u0 + U_CKV + (lane & 31) * 4);
    const float kr = bf2f(u0[U_KR + (lane & 31)]);
    const u32x2 gcm = *(const u32x2*)(um + U_GC + c4), gc0 = *(const u32x2*)(u0 + U_GC + c4), gcp = *(const u32x2*)(up + U_GC + c4);
    const u32x2 vvm = *(const u32x2*)(um + U_VAL + c4), vv0 = *(const u32x2*)(u0 + U_VAL + c4), vvp = *(const u32x2*)(up + U_VAL + c4);
    const u32x2 gb = *(const u32x2*)(u0 + U_GB + c4);
    u32x2 xm[3], x0[3], xp[3];
#pragma unroll
    for (int i = 0; i < 3; ++i) {
      xm[i] = *(const u32x2*)(um + U_XBC + c4 + 256 * i);
      x0[i] = *(const u32x2*)(u0 + U_XBC + c4 + 256 * i);
      xp[i] = *(const u32x2*)(up + U_XBC + c4 + 256 * i);
    }
    const float dtr = DT[(size_t)row * 16 + (lane & 15)];
    {
      float a = lo2f(vq[0]), bq = hi2f(vq[0]), c = lo2f(vq[1]), d = hi2f(vq[1]);
      float ss = wave_sum(a * a + bq * bq + c * c + d * d);
      float e = lo2f(vkv[0]), f = hi2f(vkv[0]), g = lo2f(vkv[1]), h = hi2f(vkv[1]);
      float s2 = lane < 32 ? e * e + f * f + g * g + h * h : 0.f;
      s2 = wave_sum(s2);
      if (lane == 0) { RS[row * 2] = rsqrtf(ss * (1.f / 256) + EPS); RS[row * 2 + 1] = rsqrtf(s2 * (1.f / 128) + EPS); }
    }
    {
      const float partner = __shfl_xor(kr, 8);
      float o = kr;
      if (lat) {
        const int grp = (lane & 31) >> 3;
        const float posf = grp < 2 ? (float)(t >> 6) : (float)(t & 63);
        const float rev = posf * invf * 0.15915494309189535f;
        const float cs = __builtin_amdgcn_cosf(rev), sn = __builtin_amdgcn_sinf(rev);
        o = (grp & 1) ? kr * cs + partner * sn : kr * cs - partner * sn;
      }
      if (lane < 32) {
        const bf16_t ob = f2bf(o);
#pragma unroll
        for (int hd = 0; hd < 4; ++hd) KB[((size_t)(b * 4 + hd) * LK + pos) * 96 + 64 + lane] = ob;
      }
    }
    {
      float a0 = sw1.x * lo2f(gc0[0]) * lo2f(vv0[0]) + mp * sw0.x * lo2f(gcm[0]) * lo2f(vvm[0]) + mn * sw2.x * lo2f(gcp[0]) * lo2f(vvp[0]);
      float a1 = sw1.y * hi2f(gc0[0]) * hi2f(vv0[0]) + mp * sw0.y * hi2f(gcm[0]) * hi2f(vvm[0]) + mn * sw2.y * hi2f(gcp[0]) * hi2f(vvp[0]);
      float a2 = sw1.z * lo2f(gc0[1]) * lo2f(vv0[1]) + mp * sw0.z * lo2f(gcm[1]) * lo2f(vvm[1]) + mn * sw2.z * lo2f(gcp[1]) * lo2f(vvp[1]);
      float a3 = sw1.w * hi2f(gc0[1]) * hi2f(vv0[1]) + mp * sw0.w * hi2f(gcm[1]) * hi2f(vvm[1]) + mn * sw2.w * hi2f(gcp[1]) * hi2f(vvp[1]);
      u32x2 o; o[0] = pack2(lo2f(gb[0]) * a0, hi2f(gb[0]) * a1); o[1] = pack2(lo2f(gb[1]) * a2, hi2f(gb[1]) * a3);
      *(u32x2*)(YM + (size_t)row * DM + 256 + c4) = o;
    }
#pragma unroll
    for (int i = 0; i < 3; ++i) {
      float a0 = cbi[i].x + cwk[i][1].x * lo2f(x0[i][0]) + mp * cwk[i][0].x * lo2f(xm[i][0]) + mn * cwk[i][2].x * lo2f(xp[i][0]);
      float a1 = cbi[i].y + cwk[i][1].y * hi2f(x0[i][0]) + mp * cwk[i][0].y * hi2f(xm[i][0]) + mn * cwk[i][2].y * hi2f(xp[i][0]);
      float a2 = cbi[i].z + cwk[i][1].z * lo2f(x0[i][1]) + mp * cwk[i][0].z * lo2f(xm[i][1]) + mn * cwk[i][2].z * lo2f(xp[i][1]);
      float a3 = cbi[i].w + cwk[i][1].w * hi2f(x0[i][1]) + mp * cwk[i][0].w * hi2f(xm[i][1]) + mn * cwk[i][2].w * hi2f(xp[i][1]);
      u32x2 o; o[0] = pack2(silu_f(a0), silu_f(a1)); o[1] = pack2(silu_f(a2), silu_f(a3));
      *(u32x2*)(XBC + (size_t)row * 768 + c4 + 256 * i) = o;
    }
    if (lane < 16) {
      const float v = dtr + dtb;
      const float e = __expf(-fabsf(v));
      DT[(size_t)row * 16 + lane] = fmaxf(v, 0.f) + (e < 1e-3f ? e * (1.f - 0.5f * e) : __logf(1.f + e));
    }
  }
}

DI void phase_ssdnorm(const Params& p, int layer, int bid, int nb) {
  const int w = ltid() >> 6, lane = ltid() & 63;
  const int M = layer == 0 ? MT : ML;
  bf16_t* YM = (bf16_t*)(p.ws + OFF_H);
  const float* SSQ = (const float*)(p.ws + OFF_SSQ);
  const float* ng = p.ssd_norm + layer * 512;
  for (int row = bid * 4 + w; row < M; row += nb * 4) {
    int g = lane >> 5;
    float4 s = *(const float4*)(SSQ + (size_t)row * 8 + g * 4);
    float rstd = rsqrtf((s.x + s.y + s.z + s.w) * (1.f / 256) + EPS);
    bf16_t* ptr = YM + (size_t)row * DM + 512 + lane * 8;
    u32x4 v = *(const u32x4*)ptr;
    float4 g0 = *(const float4*)(ng + lane * 8), g1 = *(const float4*)(ng + lane * 8 + 4);
    u32x4 o;
    o[0] = pack2(lo2f(v[0]) * rstd * g0.x, hi2f(v[0]) * rstd * g0.y);
    o[1] = pack2(lo2f(v[1]) * rstd * g0.z, hi2f(v[1]) * rstd * g0.w);
    o[2] = pack2(lo2f(v[2]) * rstd * g1.x, hi2f(v[2]) * rstd * g1.y);
    o[3] = pack2(lo2f(v[3]) * rstd * g1.z, hi2f(v[3]) * rstd * g1.w);
    *(u32x4*)ptr = o;
  }
}

constexpr int GST = 80;
constexpr int GBUF = 2 * 128 * GST;
template <bool GN, class Epi>
DI void gemm_tile(const bf16_t* __restrict__ A, int lda, const bf16_t* __restrict__ Bt, int K, int row0, int col0, char* smem, Epi epi, const float* __restrict__ ssq = nullptr) {
  bf16_t* S0 = (bf16_t*)smem;
  const int tid = ltid(), wid = tid >> 6, lane = tid & 63, wr = wid >> 1, wc = wid & 1, fr = lane & 15, fq = lane >> 4;
  f32x4 acc[4][4];
#pragma unroll
  for (int m = 0; m < 4; ++m)
#pragma unroll
    for (int n = 0; n < 4; ++n) acc[m][n] = f32x4{0.f, 0.f, 0.f, 0.f};
  u32x4 ra[4], rb[4];
  const int sr = tid >> 3, sp = tid & 7;
  const bf16_t* ga = A + (size_t)(row0 + sr) * lda + sp * 8;
  const bf16_t* gb = Bt + (size_t)(col0 + sr) * K + sp * 8;
  auto gload = [&](int k0) {
#pragma unroll
    for (int i = 0; i < 4; ++i) {
      ra[i] = *(const u32x4*)(ga + (size_t)(32 * i) * lda + k0);
      rb[i] = *(const u32x4*)(gb + (size_t)(32 * i) * K + k0);
    }
  };
  gload(0);
  float gs[4][2];
  if (GN) {
#pragma unroll
    for (int i = 0; i < 4; ++i) {
      const float4 s0 = *(const float4*)(ssq + (size_t)(row0 + sr + 32 * i) * 8), s1 = *(const float4*)(ssq + (size_t)(row0 + sr + 32 * i) * 8 + 4);
      gs[i][0] = rsqrtf((s0.x + s0.y + s0.z + s0.w) * (1.f / 256) + EPS);
      gs[i][1] = rsqrtf((s1.x + s1.y + s1.z + s1.w) * (1.f / 256) + EPS);
    }
  }
  auto swrite = [&](int kt) {
    if (GN && kt >= 8) {
      const int g = (kt - 8) >> 2;
#pragma unroll
      for (int i = 0; i < 4; ++i) {
        const float sc = g ? gs[i][1] : gs[i][0];
#pragma unroll
        for (int jj = 0; jj < 4; ++jj) ra[i][jj] = pack2(lo2f(ra[i][jj]) * sc, hi2f(ra[i][jj]) * sc);
      }
    }
    bf16_t* As = S0 + (kt & 1) * GBUF;
    bf16_t* Bs = As + 128 * GST;
#pragma unroll
    for (int i = 0; i < 4; ++i) {
      *(u32x4*)(As + (sr + 32 * i) * GST + sp * 8) = ra[i];
      *(u32x4*)(Bs + (sr + 32 * i) * GST + sp * 8) = rb[i];
    }
  };
  const int KT = K / 64;
  swrite(0);
  if (KT > 1) gload(64);
  __syncthreads();
  for (int kt = 0; kt < KT; ++kt) {
    const bf16_t* As = S0 + (kt & 1) * GBUF;
    const bf16_t* Bs = As + 128 * GST;
#pragma unroll
    for (int ks = 0; ks < 2; ++ks) {
      bf16x8 af[4], bfr[4];
#pragma unroll
      for (int m = 0; m < 4; ++m) af[m] = *(const bf16x8*)(As + (wr * 64 + m * 16 + fr) * GST + ks * 32 + fq * 8);
#pragma unroll
      for (int n = 0; n < 4; ++n) bfr[n] = *(const bf16x8*)(Bs + (wc * 64 + n * 16 + fr) * GST + ks * 32 + fq * 8);
#pragma unroll
      for (int m = 0; m < 4; ++m)
#pragma unroll
        for (int n = 0; n < 4; ++n) acc[m][n] = MFMA16(bfr[n], af[m], acc[m][n]);
      if (ks == 0 && kt + 1 < KT) {
        swrite(kt + 1);
        if (kt + 2 < KT) gload((kt + 2) * 64);
      }
    }
    __syncthreads();
  }
#pragma unroll
  for (int m = 0; m < 4; ++m)
#pragma unroll
    for (int n = 0; n < 4; ++n) epi(row0 + wr * 64 + m * 16 + fr, col0 + wc * 64 + n * 16 + fq * 4, acc[m][n]);
}

template <class Epi>
DI void gemm_tile_glds(const bf16_t* __restrict__ A, int lda, const bf16_t* __restrict__ Bt, int ldb, int K, int row0, int col0, char* smem, Epi epi) {
  const int tid = ltid(), wid = tid >> 6, lane = tid & 63, wr = wid >> 1, wc = wid & 1, fr = lane & 15, fq = lane >> 4;
  f32x4 acc[4][4];
#pragma unroll
  for (int m = 0; m < 4; ++m)
#pragma unroll
    for (int n = 0; n < 4; ++n) acc[m][n] = f32x4{0.f, 0.f, 0.f, 0.f};
  const int crow = tid >> 3, cslot = tid & 7, cpart = cslot ^ (crow & 7);
  const bf16_t* ga = A + (size_t)(row0 + crow) * lda + cpart * 8;
  const bf16_t* gb = Bt + (size_t)(col0 + crow) * ldb + cpart * 8;
  auto issue = [&](int kt, int stage) {
    char* sa = smem + stage * 32768 + tid * 16;
#pragma unroll
    for (int i = 0; i < 4; ++i) {
      __builtin_amdgcn_global_load_lds((const unsigned*)(ga + (size_t)(32 * i) * lda + kt * 64), (__attribute__((address_space(3))) unsigned*)(sa + i * 4096), 16, 0, 0);
      __builtin_amdgcn_global_load_lds((const unsigned*)(gb + (size_t)(32 * i) * ldb + kt * 64), (__attribute__((address_space(3))) unsigned*)(sa + 16384 + i * 4096), 16, 0, 0);
    }
  };
  const int KT = K / 64;
  issue(0, 0);
  asm volatile("s_waitcnt vmcnt(0)" ::: "memory");
  __syncthreads();
  const int sw = fr & 7;
  for (int kt = 0; kt < KT; ++kt) {
    if (kt + 1 < KT) issue(kt + 1, (kt + 1) & 1);
    const char* As = smem + (kt & 1) * 32768;
    const char* Bs = As + 16384;
#pragma unroll
    for (int ks = 0; ks < 2; ++ks) {
      bf16x8 af[4], bfr[4];
      const int so = ((ks * 4 + fq) ^ sw) * 16;
#pragma unroll
      for (int m = 0; m < 4; ++m) af[m] = *(const bf16x8*)(As + (wr * 64 + m * 16 + fr) * 128 + so);
#pragma unroll
      for (int n = 0; n < 4; ++n) bfr[n] = *(const bf16x8*)(Bs + (wc * 64 + n * 16 + fr) * 128 + so);
#pragma unroll
      for (int m = 0; m < 4; ++m)
#pragma unroll
        for (int n = 0; n < 4; ++n) acc[m][n] = MFMA16(bfr[n], af[m], acc[m][n]);
    }
    asm volatile("s_waitcnt vmcnt(0)" ::: "memory");
    __syncthreads();
  }
#pragma unroll
  for (int m = 0; m < 4; ++m)
#pragma unroll
    for (int n = 0; n < 4; ++n) epi(row0 + wr * 64 + m * 16 + fr, col0 + wc * 64 + n * 16 + fq * 4, acc[m][n]);
}

constexpr int G8_HT = 128 * 64;
DI int g8_lds_byte(int r, int c) {
  int st = (r >> 4) * 2 + (c >> 5), rr = r & 15, cc = c & 31, ob = rr * 64 + cc * 2;
  return st * 1024 + (ob ^ (((ob >> 9) & 1) << 5));
}
DI void g8_stage_rc(int b, int& R, int& C) {
  int st = b / 1024, sb = b % 1024, swz = sb ^ (((sb >> 9) & 1) << 5);
  R = (st >> 1) * 16 + swz / 64; C = (st & 1) * 32 + (swz % 64) / 2;
}
template <class Epi>
DI void gemm8_tile(const bf16_t* __restrict__ A, int lda, const bf16_t* __restrict__ Bt, int ldb, int K, int brow, int bcol, char* smem, Epi epi) {
  bf16_t* shm = (bf16_t*)smem;
  const int tid = ltid512();
#define G8_SA(b, h) (shm + ((b) * 2 + (h)) * G8_HT)
#define G8_SB(b, h) (shm + (4 + (b) * 2 + (h)) * G8_HT)
#define G8_STAGE(P, BASE, LD, br, kt) do { const bf16_t* _g = (BASE) + (size_t)(br) * (LD) + (size_t)(kt) * 64; \
    _Pragma("unroll") for (int _i = 0; _i < 2; ++_i) { int _b = tid * 16 + _i * 8192; int _r, _c; g8_stage_rc(_b, _r, _c); \
      __builtin_amdgcn_global_load_lds((const unsigned*)(_g + (size_t)_r * (LD) + _c), \
        (__attribute__((address_space(3))) unsigned*)((char*)(P) + _b), 16, 0, 0); } } while (0)
#define G8_LDA(dst, b, h) _Pragma("unroll") for (int m = 0; m < 4; ++m) _Pragma("unroll") for (int k = 0; k < 2; ++k) \
    dst[m][k] = *reinterpret_cast<const bf16x8*>((char*)G8_SA(b, h) + g8_lds_byte(wr * 64 + m * 16 + fr, k * 32 + fq * 8))
#define G8_LDB(dst, b, h) _Pragma("unroll") for (int n = 0; n < 2; ++n) _Pragma("unroll") for (int k = 0; k < 2; ++k) \
    dst[n][k] = *reinterpret_cast<const bf16x8*>((char*)G8_SB(b, h) + g8_lds_byte(wc * 32 + n * 16 + fr, k * 32 + fq * 8))
#define G8_MMA(ai, bj, At, Bx) do { __builtin_amdgcn_s_setprio(1); \
    _Pragma("unroll") for (int m = 0; m < 4; ++m) _Pragma("unroll") for (int n = 0; n < 2; ++n) _Pragma("unroll") for (int k = 0; k < 2; ++k) \
      acc[ai][bj][m][n] = __builtin_amdgcn_mfma_f32_16x16x32_bf16(Bx[n][k], At[m][k], acc[ai][bj][m][n], 0, 0, 0); \
    __builtin_amdgcn_s_setprio(0); } while (0)
#define G8_WAIT_V(n) asm volatile("s_waitcnt vmcnt(" #n ")" ::: "memory")
#define G8_WAIT_L(n) asm volatile("s_waitcnt lgkmcnt(" #n ")" ::: "memory")
#define G8_BAR __builtin_amdgcn_s_barrier()
#define G8_SCHED __builtin_amdgcn_sched_barrier(0)
  const int wid = tid >> 6, lane = tid & 63, wr = wid >> 2, wc = wid & 3, fr = lane & 15, fq = lane >> 4;
  f32x4 acc[2][2][4][2];
#pragma unroll
  for (int a = 0; a < 2; ++a)
#pragma unroll
    for (int b = 0; b < 2; ++b)
#pragma unroll
      for (int m = 0; m < 4; ++m)
#pragma unroll
        for (int n = 0; n < 2; ++n) acc[a][b][m][n] = f32x4{0.f, 0.f, 0.f, 0.f};
  bf16x8 At[4][2], B0[2][2], B1[2][2];
  const int nt = K / 64;
  G8_STAGE(G8_SB(0, 0), Bt, ldb, bcol, 0); G8_STAGE(G8_SA(0, 0), A, lda, brow, 0);
  G8_STAGE(G8_SB(0, 1), Bt, ldb, bcol + 128, 0); G8_STAGE(G8_SA(0, 1), A, lda, brow + 128, 0);
  if (wr == 1) G8_BAR;
  G8_WAIT_V(4); G8_BAR;
  G8_STAGE(G8_SB(1, 0), Bt, ldb, bcol, 1); G8_STAGE(G8_SA(1, 0), A, lda, brow, 1); G8_STAGE(G8_SB(1, 1), Bt, ldb, bcol + 128, 1);
  G8_WAIT_V(6); G8_BAR;
  for (int t = 0; t < nt - 2; t += 2) {
    G8_LDB(B0, 0, 0); G8_SCHED; G8_LDA(At, 0, 0); G8_STAGE(G8_SA(1, 1), A, lda, brow + 128, t + 1);
    G8_WAIT_L(8); G8_BAR; G8_WAIT_L(0); G8_MMA(0, 0, At, B0); G8_BAR; G8_SCHED;
    G8_LDB(B1, 0, 1); G8_STAGE(G8_SB(0, 0), Bt, ldb, bcol, t + 2);
    G8_BAR; G8_WAIT_L(0); G8_MMA(0, 1, At, B1); G8_BAR;
    G8_LDA(At, 0, 1); G8_STAGE(G8_SA(0, 0), A, lda, brow, t + 2);
    G8_BAR; G8_WAIT_L(0); G8_MMA(1, 0, At, B0); G8_BAR; G8_SCHED;
    G8_STAGE(G8_SB(0, 1), Bt, ldb, bcol + 128, t + 2);
    G8_WAIT_V(6); G8_BAR; G8_MMA(1, 1, At, B1); G8_BAR;
    G8_LDB(B0, 1, 0); G8_SCHED; G8_LDA(At, 1, 0); G8_STAGE(G8_SA(0, 1), A, lda, brow + 128, t + 2);
    G8_WAIT_L(8); G8_BAR; G8_WAIT_L(0); G8_MMA(0, 0, At, B0); G8_BAR; G8_SCHED;
    G8_LDB(B1, 1, 1); G8_STAGE(G8_SB(1, 0), Bt, ldb, bcol, t + 3);
    G8_BAR; G8_WAIT_L(0); G8_MMA(0, 1, At, B1); G8_BAR;
    G8_LDA(At, 1, 1); G8_STAGE(G8_SA(1, 0), A, lda, brow, t + 3);
    G8_BAR; G8_WAIT_L(0); G8_MMA(1, 0, At, B0); G8_BAR; G8_SCHED;
    G8_STAGE(G8_SB(1, 1), Bt, ldb, bcol + 128, t + 3);
    G8_WAIT_V(6); G8_BAR; G8_MMA(1, 1, At, B1); G8_BAR;
  }
  { G8_LDB(B0, 0, 0); G8_LDA(At, 0, 0); G8_STAGE(G8_SA(1, 1), A, lda, brow + 128, nt - 1);
    G8_BAR; G8_WAIT_L(0); G8_MMA(0, 0, At, B0); G8_BAR;
    G8_LDB(B1, 0, 1); G8_BAR; G8_WAIT_L(0); G8_MMA(0, 1, At, B1); G8_BAR;
    G8_LDA(At, 0, 1); G8_WAIT_V(4); G8_BAR; G8_WAIT_L(0); G8_MMA(1, 0, At, B0); G8_MMA(1, 1, At, B1); G8_BAR; }
  { G8_LDB(B0, 1, 0); G8_LDA(At, 1, 0); G8_WAIT_V(2); G8_BAR; G8_WAIT_L(0); G8_MMA(0, 0, At, B0); G8_BAR;
    G8_LDB(B1, 1, 1); G8_WAIT_V(0); G8_BAR; G8_WAIT_L(0); G8_MMA(0, 1, At, B1); G8_BAR;
    G8_LDA(At, 1, 1); G8_BAR; G8_WAIT_L(0); G8_MMA(1, 0, At, B0); G8_MMA(1, 1, At, B1); G8_BAR; }
  if (wr == 0) G8_BAR;
#pragma unroll
  for (int ai = 0; ai < 2; ++ai)
#pragma unroll
    for (int bj = 0; bj < 2; ++bj)
#pragma unroll
      for (int m = 0; m < 4; ++m)
#pragma unroll
        for (int n = 0; n < 2; ++n) epi(brow + ai * 128 + wr * 64 + m * 16 + fr, bcol + bj * 128 + wc * 32 + n * 16 + fq * 4, acc[ai][bj][m][n]);
  __syncthreads();
}

struct EpiBF {
  bf16_t* out; int ldo;
  DI void operator()(int row, int col, const f32x4& a) const {
    u32x2 o; o[0] = pack2(a[0], a[1]); o[1] = pack2(a[2], a[3]);
    *(u32x2*)(out + (size_t)row * ldo + col) = o;
  }
};
struct EpiRelu2 {
  bf16_t* out; int ldo;
  DI void operator()(int row, int col, const f32x4& a) const {
    float r0 = fmaxf(a[0], 0.f), r1 = fmaxf(a[1], 0.f), r2 = fmaxf(a[2], 0.f), r3 = fmaxf(a[3], 0.f);
    u32x2 o; o[0] = pack2(r0 * r0, r1 * r1); o[1] = pack2(r2 * r2, r3 * r3);
    *(u32x2*)(out + (size_t)row * ldo + col) = o;
  }
};
struct EpiU {
  bf16_t* u; float* dt;
  DI void operator()(int row, int col, const f32x4& a) const {
    if (col < DIN) {
      u32x2 o; o[0] = pack2(a[0], a[1]); o[1] = pack2(a[2], a[3]);
      *(u32x2*)(u + (size_t)row * DIN + col) = o;
      if (col >= U_DT) *(float4*)(dt + (size_t)row * 16 + col - U_DT) = make_float4(a[0], a[1], a[2], a[3]);
    }
  }
};
struct EpiQ {
  bf16_t* q; const float* rs;
  DI void operator()(int row, int col, const f32x4& a) const {
    const float r = rs[row * 2];
    u32x2 o; o[0] = pack2(a[0] * r, a[1] * r); o[1] = pack2(a[2] * r, a[3] * r);
    *(u32x2*)(q + (size_t)row * 384 + col) = o;
  }
};
struct EpiKV {
  bf16_t* kb; bf16_t* vt; const float* rs;
  DI void operator()(int row, int col, const f32x4& a) const {
    int b, pos;
    if (row < ML) { b = row >> 12; pos = (row & 4095) + CTX; } else { int rr = row - ML; b = rr >> 8; pos = rr & 255; }
    const int head = col >> 7, d = col & 127;
    const float r = rs[row * 2 + 1];
    if (d < 64) {
      u32x2 o; o[0] = pack2(a[0] * r, a[1] * r); o[1] = pack2(a[2] * r, a[3] * r);
      *(u32x2*)(kb + ((size_t)(b * 4 + head) * LK + pos) * 96 + d) = o;
    } else {
#pragma unroll
      for (int j = 0; j < 4; ++j) vt[((size_t)(b * 4 + head) * 64 + (d - 64 + j)) * LK + pos] = f2bf(a[j] * r);
    }
  }
};

struct EpiPart {
  float* part;
  DI void operator()(int row, int col, const f32x4& a) const {
    *(float4*)(part + (size_t)(row - ML) * DM + col) = make_float4(a[0], a[1], a[2], a[3]);
  }
};
DI void phase_inproj(const Params& p, int layer, int bid, int nb, char* smem) {
  EpiU epi{(bf16_t*)(p.ws + OFF_U), (float*)(p.ws + OFF_DT)};
  const int x = bid & 7, per = nb >> 3;
  for (int rep = 0; rep < REP_GEMM; ++rep)
  for (int q = bid >> 3; q < 85; q += per) {
    const int m = (x >> 1) * 17 + q / 5, n = 5 * (x & 1) + q % 5;
    gemm8_tile((const bf16_t*)(p.ws + OFF_H), DM, wt_ptr(p, layer, WT_IN), 1024, 1024, m * 256, n * 256, smem, epi);
  }
}
DI void phase_wout(const Params& p, int layer, int lid, int nvb, char* smem) {
  const int M = layer == 0 ? MT : ML;
  EpiBF epi{(bf16_t*)(p.ws + OFF_U), DM};
  const int x = lid & 7, per = nvb >> 3;
  for (int rep = 0; rep < REP_GEMM; ++rep)
  for (int q = lid >> 3; q < M / 128; q += per)
    gemm_tile<true>((const bf16_t*)(p.ws + OFF_H), DM, wt_ptr(p, layer, WT_OUT), 1024, ((q >> 3) * 8 + x) * 128, (q & 7) * 128, smem, epi, (const float*)(p.ws + OFF_SSQ));
}
DI void phase_ff1(const Params& p, int layer, int bid, int nb, int vbid, int nvb, char* smem, char* smem_half) {
  EpiRelu2 epi{(bf16_t*)(p.ws + OFF_F1), DFF};
  const int x = bid & 7, per = nb >> 3;
  for (int rep = 0; rep < REP_GEMM; ++rep) {
    for (int q = bid >> 3; q < 128; q += per) {
      const int m = (x >> 2) * 32 + (q >> 2), n = 4 * (x & 3) + (q & 3);
      gemm8_tile((const bf16_t*)(p.ws + OFF_H), DM, wt_ptr(p, layer, WT_FF1), 1024, 1024, m * 256, n * 256, smem, epi);
    }
    if (layer == 0)
      for (int it = vbid; it < (MC / 128) * 32; it += nvb)
        gemm_tile_glds((const bf16_t*)(p.ws + OFF_H), DM, wt_ptr(p, layer, WT_FF1), 1024, 1024, ML + (it / 32) * 128, (it % 32) * 128, smem_half, epi);
  }
}
DI void phase_ff2(const Params& p, int layer, int bid, int nb, int vbid, int nvb, char* smem, char* smem_half) {
  EpiBF epi{(bf16_t*)(p.ws + OFF_H), DM};
  const int x = bid & 7, per = nb >> 3;
  for (int rep = 0; rep < REP_GEMM; ++rep) {
    for (int q = bid >> 3; q < 32; q += per) {
      const int T = x * 32 + q;
      gemm8_tile((const bf16_t*)(p.ws + OFF_F1), DFF, wt_ptr(p, layer, WT_FF2), 4096, 4096, (T >> 2) * 256, (T & 3) * 256, smem, epi);
    }
    if (layer == 0)
      for (int it = vbid; it < (MC / 128) * 8 * 4; it += nvb) {
        const int tile = it >> 2, ks = it & 3;
        EpiPart ep{(float*)(p.ws + OFF_END2) + (size_t)ks * MC * DM};
        gemm_tile_glds((const bf16_t*)(p.ws + OFF_F1) + ks * 1024, DFF, wt_ptr(p, layer, WT_FF2) + ks * 1024, 4096, 1024, ML + (tile >> 3) * 128, (tile & 7) * 128, smem_half, ep);
      }
  }
}

DI int chunk_row0(int b, int tc) { return tc < 2 ? ML + b * CTX + tc * 128 : b * SEQ + (tc - 2) * 128; }
constexpr int BST = 72;
constexpr int TST = 136;
DI void load_tile_T(bf16_t* dst, const bf16_t* __restrict__ src, int ldg) {
  const int tid = ltid();
#pragma unroll
  for (int i = 0; i < 4; ++i) {
    int c = tid + 256 * i, tok = c & 127, pc = c >> 7;
    u32x4 v = *(const u32x4*)(src + (size_t)tok * ldg + pc * 8);
#pragma unroll
    for (int j = 0; j < 4; ++j) {
      dst[(pc * 8 + 2 * j) * TST + tok] = (bf16_t)(v[j] & 0xffffu);
      dst[(pc * 8 + 2 * j + 1) * TST + tok] = (bf16_t)(v[j] >> 16);
    }
  }
}
DI void chunk_scan(const Params& p, int layer, int row0, int h, float* csf, float* csb, float* dtF, float* dtB, float* tot, float*  ) {
  const int tid = ltid(), w = tid >> 6, lane = tid & 63;
  const float* DT = (const float*)(p.ws + OFF_DT);
  float v;
  if (tid < 128) {
    const float dt = DT[(size_t)(row0 + tid) * 16 + h];
    v = dt * -__expf(p.a_log[layer * 16 + h]);
    dtF[tid] = dt;
  } else {
    const int e = 255 - tid;
    const float dt = DT[(size_t)(row0 + e) * 16 + 8 + h];
    v = dt * -__expf(p.a_log[layer * 16 + 8 + h]);
    dtB[e] = dt;
  }
#pragma unroll
  for (int o = 1; o < 64; o <<= 1) { const float t = __shfl_up(v, o); if (lane >= o) v += t; }
  if (lane == 63) tot[w] = v;
  __syncthreads();
  if (w == 1) v += tot[0];
  if (w == 3) v += tot[2];
  if (tid < 128) csf[tid] = v; else csb[255 - tid] = v;
  __syncthreads();
}

DI void ssd_state_item(const Params& p, int layer, int b, int tc, int h, char* smem) {
  bf16_t* XT = (bf16_t*)smem;
  bf16_t* BT = XT + 64 * TST;
  float* csf = (float*)(BT + 64 * TST);
  float* csb = csf + 128; float* dtF = csb + 128; float* dtB = dtF + 128; float* laF = dtB + 128; float* laB = laF + 128;
  const int tid = ltid(), w = tid >> 6, lane = tid & 63, r = lane & 31, hh = lane >> 5;
  const int row0 = chunk_row0(b, tc);
  const bf16_t* XBC = (const bf16_t*)(p.ws + OFF_XBC);
  load_tile_T(XT, XBC + (size_t)row0 * 768 + h * 64, 768);
  load_tile_T(BT, XBC + (size_t)row0 * 768 + 512 + (h >> 2) * 64, 768);
  chunk_scan(p, layer, row0, h, csf, csb, dtF, dtB, laF, laB);
  __syncthreads();
  if (tid < 128) laF[tid] = dtF[tid] * __expf(csf[127] - csf[tid]);
  else { int t = tid - 128; laB[t] = dtB[t] * __expf(csb[0] - csb[t]); }
  __syncthreads();
  const int d = w >> 1, pt = w & 1;
  const float* wv = d == 0 ? laF : laB;
  f32x16 acc[2];
#pragma unroll
  for (int i = 0; i < 16; ++i) { acc[0][i] = 0.f; acc[1][i] = 0.f; }
#pragma unroll
  for (int s = 0; s < 8; ++s) {
    int l0 = 16 * s + 8 * hh;
    u32x4 xa = *(const u32x4*)(XT + (32 * pt + r) * TST + l0);
    u32x4 sa;
#pragma unroll
    for (int j = 0; j < 4; ++j) sa[j] = pack2(lo2f(xa[j]) * wv[l0 + 2 * j], hi2f(xa[j]) * wv[l0 + 2 * j + 1]);
    bf16x8 af = __builtin_bit_cast(bf16x8, sa);
#pragma unroll
    for (int nt = 0; nt < 2; ++nt) {
      bf16x8 bfr = *(const bf16x8*)(BT + (32 * nt + r) * TST + l0);
      acc[nt] = MFMA32(af, bfr, acc[nt]);
    }
  }
  bf16_t* S = (bf16_t*)(p.ws + OFF_SST) + ((((size_t)d * NB + b) * NCH + tc) * 8 + h) * 4096;
#pragma unroll
  for (int nt = 0; nt < 2; ++nt)
#pragma unroll
    for (int i = 0; i < 16; ++i) S[(32 * pt + crow(i, hh)) * 64 + 32 * nt + r] = f2bf(acc[nt][i]);
  if (tid == 0) {
    float* TD = (float*)(p.ws + OFF_TDEC);
    TD[((0 * NB + b) * NCH + tc) * 8 + h] = __expf(csf[127]);
    TD[((1 * NB + b) * NCH + tc) * 8 + h] = __expf(csb[0]);
  }
  __syncthreads();
}

DI void ssd_pass_item(const Params& p, int it) {
  const int e = it * 256 + ltid();
  const int pn2 = e & 2047, h = (e >> 11) & 7, b = (e >> 14) & 3, d = e >> 16;
  unsigned* S = (unsigned*)(p.ws + OFF_SST);
  const float* TD = (const float*)(p.ws + OFF_TDEC);
  unsigned sv[NCH]; float T[NCH];
#pragma unroll
  for (int i = 0; i < NCH; ++i) {
    int tc = d == 0 ? i : (i < 2 ? 1 - i : NCH + 1 - i);
    sv[i] = S[(((size_t)(d * NB + b) * NCH + tc) * 8 + h) * 2048 + pn2];
    T[i] = TD[((d * NB + b) * NCH + tc) * 8 + h];
  }
  float h0 = 0.f, h1 = 0.f;
#pragma unroll
  for (int i = 0; i < NCH; ++i) {
    int tc = d == 0 ? i : (i < 2 ? 1 - i : NCH + 1 - i);
    S[(((size_t)(d * NB + b) * NCH + tc) * 8 + h) * 2048 + pn2] = pack2(h0, h1);
    h0 = T[i] * h0 + lo2f(sv[i]); h1 = T[i] * h1 + hi2f(sv[i]);
  }
}

DI void ssd_out_item(const Params& p, int layer, int b, int tc, int h, char* smem) {
  bf16_t* XT = (bf16_t*)smem;
  bf16_t* Bs = XT + 64 * TST;
  float* csf = (float*)(Bs + 128 * BST);
  float* csb = csf + 128; float* dtF = csb + 128; float* dtB = dtF + 128; float* laF = dtB + 128; float* laB = laF + 128;
  const int tid = ltid(), w = tid >> 6, lane = tid & 63, r = lane & 31, hh = lane >> 5;
  const int row0 = chunk_row0(b, tc), g = h >> 2;
  const bf16_t* XBC = (const bf16_t*)(p.ws + OFF_XBC);
  load_tile_T(XT, XBC + (size_t)row0 * 768 + h * 64, 768);
#pragma unroll
  for (int i = 0; i < 4; ++i) {
    int c = tid + 256 * i, tok = c >> 3, part = c & 7;
    *(u32x4*)(Bs + tok * BST + part * 8) = *(const u32x4*)(XBC + (size_t)(row0 + tok) * 768 + 512 + g * 64 + part * 8);
  }
  const int l = 32 * w + r;
  bf16x8 cf[4];
#pragma unroll
  for (int ks = 0; ks < 4; ++ks) cf[ks] = *(const bf16x8*)(XBC + (size_t)(row0 + l) * 768 + 640 + g * 64 + 16 * ks + 8 * hh);
  chunk_scan(p, layer, row0, h, csf, csb, dtF, dtB, laF, laB);
  const float csf_l = csf[l], csb_l = csb[l];
  f32x16 yacc[2];
#pragma unroll
  for (int i = 0; i < 16; ++i) { yacc[0][i] = 0.f; yacc[1][i] = 0.f; }
#pragma unroll
  for (int st = 0; st < 4; ++st) {
    f32x16 gacc;
#pragma unroll
    for (int i = 0; i < 16; ++i) gacc[i] = 0.f;
#pragma unroll
    for (int ks = 0; ks < 4; ++ks) {
      bf16x8 af = *(const bf16x8*)(Bs + (32 * st + r) * BST + 16 * ks + 8 * hh);
      gacc = MFMA32(af, cf[ks], gacc);
    }
#pragma unroll
    for (int i = 0; i < 16; ++i) {
      int s = 32 * st + crow(i, hh);
      float f;
      if (s < l) f = __expf(csf_l - csf[s]) * dtF[s];
      else if (s > l) f = __expf(csb_l - csb[s]) * dtB[s];
      else f = dtF[s] + dtB[s];
      gacc[i] *= f;
    }
#pragma unroll
    for (int s2 = 0; s2 < 2; ++s2) {
      bf16x8 mf = pack8(gacc, s2);
      int sb = 32 * st + 16 * s2 + 4 * hh;
#pragma unroll
      for (int pt = 0; pt < 2; ++pt) {
        u32x2 lo = *(const u32x2*)(XT + (32 * pt + r) * TST + sb);
        u32x2 hi = *(const u32x2*)(XT + (32 * pt + r) * TST + sb + 8);
        u32x4 xa; xa[0] = lo[0]; xa[1] = lo[1]; xa[2] = hi[0]; xa[3] = hi[1];
        yacc[pt] = MFMA32(__builtin_bit_cast(bf16x8, xa), mf, yacc[pt]);
      }
    }
  }
#pragma unroll
  for (int d = 0; d < 2; ++d) {
    const bf16_t* Hs = (const bf16_t*)(p.ws + OFF_SST) + ((((size_t)d * NB + b) * NCH + tc) * 8 + h) * 4096;
    const float e = __expf(d == 0 ? csf_l : csb_l);
#pragma unroll
    for (int pt = 0; pt < 2; ++pt) {
      f32x16 t;
#pragma unroll
      for (int i = 0; i < 16; ++i) t[i] = 0.f;
#pragma unroll
      for (int ks = 0; ks < 4; ++ks) {
        bf16x8 af = *(const bf16x8*)(Hs + (32 * pt + r) * 64 + 16 * ks + 8 * hh);
        t = MFMA32(af, cf[ks], t);
      }
#pragma unroll
      for (int i = 0; i < 16; ++i) yacc[pt][i] += e * t[i];
    }
  }
  const int row = row0 + l;
  const float Dh = p.ssd_d[layer * 8 + h];
  const bf16_t* U = (const bf16_t*)(p.ws + OFF_U);
  bf16_t* YM = (bf16_t*)(p.ws + OFF_H);
  float ssq = 0.f;
#pragma unroll
  for (int pt = 0; pt < 2; ++pt)
#pragma unroll
    for (int q = 0; q < 4; ++q) {
      int pp = 32 * pt + 8 * q + 4 * hh;
      u32x2 xv = *(const u32x2*)(XBC + (size_t)row * 768 + h * 64 + pp);
      u32x2 zv = *(const u32x2*)(U + (size_t)row * DIN + U_Z + h * 64 + pp);
      float y0 = (yacc[pt][4 * q + 0] + Dh * lo2f(xv[0])) * silu_f(lo2f(zv[0]));
      float y1 = (yacc[pt][4 * q + 1] + Dh * hi2f(xv[0])) * silu_f(hi2f(zv[0]));
      float y2 = (yacc[pt][4 * q + 2] + Dh * lo2f(xv[1])) * silu_f(lo2f(zv[1]));
      float y3 = (yacc[pt][4 * q + 3] + Dh * hi2f(xv[1])) * silu_f(hi2f(zv[1]));
      u32x2 o; o[0] = pack2(y0, y1); o[1] = pack2(y2, y3);
      float r0 = lo2f(o[0]), r1 = hi2f(o[0]), r2 = lo2f(o[1]), r3 = hi2f(o[1]);
      ssq += r0 * r0 + r1 * r1 + r2 * r2 + r3 * r3;
      *(u32x2*)(YM + (size_t)row * DM + 512 + h * 64 + pp) = o;
    }
  ssq += __shfl_xor(ssq, 32);
  if (hh == 0) ((float*)(p.ws + OFF_SSQ))[(size_t)row * 8 + h] = ssq;
  __syncthreads();
}

constexpr int KST = 104;
constexpr int VST = 68;
DI void attn_item(const Params& p, int b, int head, int qrow0, int t0, bool lat, int nkeys, char* smem) {
  bf16_t* Ks = (bf16_t*)smem;
  bf16_t* Vs = Ks + 64 * KST;
  const int tid = ltid(), w = tid >> 6, lane = tid & 63, r = lane & 31, hh = lane >> 5;
  const bf16_t* QB = (const bf16_t*)(p.ws + OFF_QB);
  const bf16_t* KB = (const bf16_t*)(p.ws + OFF_KB) + (size_t)(b * 4 + head) * LK * 96;
  const bf16_t* VT = (const bf16_t*)(p.ws + OFF_VT) + (size_t)(b * 4 + head) * 64 * LK;
  const float qscale = 0.10206207261596575f * 1.4426950408889634f;
  const int qrow = qrow0 + w * 32 + r;
  const int t = t0 + w * 32 + r;
  bf16x8 qf[6];
  {
    const bf16_t* src = QB + (size_t)qrow * 384 + head * 96;
#pragma unroll
    for (int s = 0; s < 4; ++s) {
      u32x4 v = *(const u32x4*)(src + 16 * s + 8 * hh);
      u32x4 o;
#pragma unroll
      for (int j = 0; j < 4; ++j) o[j] = pack2(lo2f(v[j]) * qscale, hi2f(v[j]) * qscale);
      qf[s] = __builtin_bit_cast(bf16x8, o);
    }
#pragma unroll
    for (int s = 4; s < 6; ++s) {
      u32x4 va = *(const u32x4*)(src + 16 * s), vb = *(const u32x4*)(src + 16 * s + 8);
      float posf = s == 4 ? (float)(t >> 6) : (float)(t & 63);
      float o[8];
#pragma unroll
      for (int j = 0; j < 8; ++j) {
        float a = (j & 1) ? hi2f(va[j >> 1]) : lo2f(va[j >> 1]);
        float bb = (j & 1) ? hi2f(vb[j >> 1]) : lo2f(vb[j >> 1]);
        float res;
        if (lat) {
          float invf = exp2f(-(float)(2 * j) * (13.287712379549449f / 16.f));
          float rev = posf * invf * 0.15915494309189535f;
          float cs = __builtin_amdgcn_cosf(rev), sn = __builtin_amdgcn_sinf(rev);
          res = hh == 0 ? a * cs - bb * sn : bb * cs + a * sn;
        } else res = hh == 0 ? a : bb;
        o[j] = res * qscale;
      }
      u32x4 ov; ov[0] = pack2(o[0], o[1]); ov[1] = pack2(o[2], o[3]); ov[2] = pack2(o[4], o[5]); ov[3] = pack2(o[6], o[7]);
      qf[s] = __builtin_bit_cast(bf16x8, ov);
    }
  }
  f32x16 oacc[2];
#pragma unroll
  for (int i = 0; i < 16; ++i) { oacc[0][i] = 0.f; oacc[1][i] = 0.f; }
  float m = -1e30f, lsum = 0.f;
  u32x4 rk[3], rv[2];
  auto gload = [&](int key0) {
#pragma unroll
    for (int i = 0; i < 3; ++i) rk[i] = *(const u32x4*)(KB + (size_t)key0 * 96 + (tid + 256 * i) * 8);
#pragma unroll
    for (int i = 0; i < 2; ++i) { int c = tid + 256 * i; rv[i] = *(const u32x4*)(VT + (size_t)(c >> 3) * LK + key0 + (c & 7) * 8); }
  };
  gload(0);
  const int NT = nkeys / 64;
  for (int kt = 0; kt < NT; ++kt) {
#pragma unroll
    for (int i = 0; i < 3; ++i) { int c = tid + 256 * i; *(u32x4*)(Ks + (c / 12) * KST + (c % 12) * 8) = rk[i]; }
#pragma unroll
    for (int i = 0; i < 2; ++i) {
      int c = tid + 256 * i;
      bf16_t* d = Vs + (c >> 3) * VST + (c & 7) * 8;
      u32x2 a; a[0] = rv[i][0]; a[1] = rv[i][1];
      u32x2 bq; bq[0] = rv[i][2]; bq[1] = rv[i][3];
      *(u32x2*)d = a; *(u32x2*)(d + 4) = bq;
    }
    __syncthreads();
    if (kt + 1 < NT) gload((kt + 1) * 64);
    f32x16 sacc[2];
#pragma unroll
    for (int i = 0; i < 16; ++i) { sacc[0][i] = 0.f; sacc[1][i] = 0.f; }
#pragma unroll
    for (int s = 0; s < 6; ++s)
#pragma unroll
      for (int k2 = 0; k2 < 2; ++k2) {
        bf16x8 af = *(const bf16x8*)(Ks + (32 * k2 + r) * KST + 16 * s + 8 * hh);
        sacc[k2] = MFMA32(af, qf[s], sacc[k2]);
      }
    float mx = sacc[0][0];
#pragma unroll
    for (int i = 0; i < 16; ++i) { mx = fmaxf(mx, sacc[0][i]); mx = fmaxf(mx, sacc[1][i]); }
    mx = fmaxf(mx, __shfl_xor(mx, 32));
    const float mn = fmaxf(m, mx);
    const float alpha = __builtin_amdgcn_exp2f(m - mn);
    m = mn;
    float ps = 0.f;
#pragma unroll
    for (int i = 0; i < 16; ++i) {
      sacc[0][i] = __builtin_amdgcn_exp2f(sacc[0][i] - mn); sacc[1][i] = __builtin_amdgcn_exp2f(sacc[1][i] - mn);
      ps += sacc[0][i] + sacc[1][i];
    }
    lsum = lsum * alpha + ps;
#pragma unroll
    for (int i = 0; i < 16; ++i) { oacc[0][i] *= alpha; oacc[1][i] *= alpha; }
#pragma unroll
    for (int k2 = 0; k2 < 2; ++k2)
#pragma unroll
      for (int s2 = 0; s2 < 2; ++s2) {
        bf16x8 pf = pack8(sacc[k2], s2);
        int kb0 = 32 * k2 + 16 * s2 + 4 * hh;
#pragma unroll
        for (int d = 0; d < 2; ++d) {
          u32x2 lo = *(const u32x2*)(Vs + (32 * d + r) * VST + kb0);
          u32x2 hi = *(const u32x2*)(Vs + (32 * d + r) * VST + kb0 + 8);
          u32x4 va; va[0] = lo[0]; va[1] = lo[1]; va[2] = hi[0]; va[3] = hi[1];
          oacc[d] = MFMA32(__builtin_bit_cast(bf16x8, va), pf, oacc[d]);
        }
      }
    __syncthreads();
  }
  lsum += __shfl_xor(lsum, 32);
  const float inv = 1.f / lsum;
  bf16_t* YM = (bf16_t*)(p.ws + OFF_H) + (size_t)qrow * DM + head * 64;
#pragma unroll
  for (int d = 0; d < 2; ++d)
#pragma unroll
    for (int q = 0; q < 4; ++q) {
      u32x2 o; o[0] = pack2(oacc[d][4 * q] * inv, oacc[d][4 * q + 1] * inv); o[1] = pack2(oacc[d][4 * q + 2] * inv, oacc[d][4 * q + 3] * inv);
      *(u32x2*)(YM + 32 * d + 8 * q + 4 * hh) = o;
    }
}

DI void attn_item8(const Params& p, int b, int head, int qrow0, int t0, bool lat, int nkeys, char* smem) {
  bf16_t* Ks = (bf16_t*)smem;
  bf16_t* Vs = Ks + 64 * KST;
  const int tid = ltid512(), w = tid >> 6, lane = tid & 63, r = lane & 31, hh = lane >> 5;
  const bf16_t* QB = (const bf16_t*)(p.ws + OFF_QB);
  const bf16_t* KB = (const bf16_t*)(p.ws + OFF_KB) + (size_t)(b * 4 + head) * LK * 96;
  const bf16_t* VT = (const bf16_t*)(p.ws + OFF_VT) + (size_t)(b * 4 + head) * 64 * LK;
  const float qscale = 0.10206207261596575f * 1.4426950408889634f;
  const int qrow = qrow0 + w * 32 + r;
  const int t = t0 + w * 32 + r;
  bf16x8 qf[6];
  {
    const bf16_t* src = QB + (size_t)qrow * 384 + head * 96;
#pragma unroll
    for (int s = 0; s < 4; ++s) {
      u32x4 v = *(const u32x4*)(src + 16 * s + 8 * hh);
      u32x4 o;
#pragma unroll
      for (int j = 0; j < 4; ++j) o[j] = pack2(lo2f(v[j]) * qscale, hi2f(v[j]) * qscale);
      qf[s] = __builtin_bit_cast(bf16x8, o);
    }
#pragma unroll
    for (int s = 4; s < 6; ++s) {
      u32x4 va = *(const u32x4*)(src + 16 * s), vb = *(const u32x4*)(src + 16 * s + 8);
      float posf = s == 4 ? (float)(t >> 6) : (float)(t & 63);
      float o[8];
#pragma unroll
      for (int j = 0; j < 8; ++j) {
        float a = (j & 1) ? hi2f(va[j >> 1]) : lo2f(va[j >> 1]);
        float bb = (j & 1) ? hi2f(vb[j >> 1]) : lo2f(vb[j >> 1]);
        float res;
        if (lat) {
          float invf = exp2f(-(float)(2 * j) * (13.287712379549449f / 16.f));
          float rev = posf * invf * 0.15915494309189535f;
          float cs = __builtin_amdgcn_cosf(rev), sn = __builtin_amdgcn_sinf(rev);
          res = hh == 0 ? a * cs - bb * sn : bb * cs + a * sn;
        } else res = hh == 0 ? a : bb;
        o[j] = res * qscale;
      }
      u32x4 ov; ov[0] = pack2(o[0], o[1]); ov[1] = pack2(o[2], o[3]); ov[2] = pack2(o[4], o[5]); ov[3] = pack2(o[6], o[7]);
      qf[s] = __builtin_bit_cast(bf16x8, ov);
    }
  }
  f32x16 oacc[2];
#pragma unroll
  for (int i = 0; i < 16; ++i) { oacc[0][i] = 0.f; oacc[1][i] = 0.f; }
  float m = -1e30f, lsum = 0.f;
  u32x4 rk[3], rv[2];
  auto gload = [&](int key0) {
    rk[0] = *(const u32x4*)(KB + (size_t)key0 * 96 + tid * 8);
    if (tid < 256) rk[1] = *(const u32x4*)(KB + (size_t)key0 * 96 + (512 + tid) * 8);
    rv[0] = *(const u32x4*)(VT + (size_t)(tid >> 3) * LK + key0 + (tid & 7) * 8);
  };
  gload(0);
  const int NT = nkeys / 64;
  for (int kt = 0; kt < NT; ++kt) {
    *(u32x4*)(Ks + (tid / 12) * KST + (tid % 12) * 8) = rk[0];
    if (tid < 256) { const int c = 512 + tid; *(u32x4*)(Ks + (c / 12) * KST + (c % 12) * 8) = rk[1]; }
    {
      bf16_t* d = Vs + (tid >> 3) * VST + (tid & 7) * 8;
      u32x2 a; a[0] = rv[0][0]; a[1] = rv[0][1];
      u32x2 bq; bq[0] = rv[0][2]; bq[1] = rv[0][3];
      *(u32x2*)d = a; *(u32x2*)(d + 4) = bq;
    }
    __syncthreads();
    if (kt + 1 < NT) gload((kt + 1) * 64);
    f32x16 sacc[2];
#pragma unroll
    for (int i = 0; i < 16; ++i) { sacc[0][i] = 0.f; sacc[1][i] = 0.f; }
#pragma unroll
    for (int s = 0; s < 6; ++s)
#pragma unroll
      for (int k2 = 0; k2 < 2; ++k2) {
        bf16x8 af = *(const bf16x8*)(Ks + (32 * k2 + r) * KST + 16 * s + 8 * hh);
        sacc[k2] = MFMA32(af, qf[s], sacc[k2]);
      }
    float mx = sacc[0][0];
#pragma unroll
    for (int i = 0; i < 16; ++i) { mx = fmaxf(mx, sacc[0][i]); mx = fmaxf(mx, sacc[1][i]); }
    mx = fmaxf(mx, __shfl_xor(mx, 32));
    const float mn = fmaxf(m, mx);
    const float alpha = __builtin_amdgcn_exp2f(m - mn);
    m = mn;
    float ps = 0.f;
#pragma unroll
    for (int i = 0; i < 16; ++i) {
      sacc[0][i] = __builtin_amdgcn_exp2f(sacc[0][i] - mn); sacc[1][i] = __builtin_amdgcn_exp2f(sacc[1][i] - mn);
      ps += sacc[0][i] + sacc[1][i];
    }
    lsum = lsum * alpha + ps;
#pragma unroll
    for (int i = 0; i < 16; ++i) { oacc[0][i] *= alpha; oacc[1][i] *= alpha; }
#pragma unroll
    for (int k2 = 0; k2 < 2; ++k2)
#pragma unroll
      for (int s2 = 0; s2 < 2; ++s2) {
        bf16x8 pf = pack8(sacc[k2], s2);
        int kb0 = 32 * k2 + 16 * s2 + 4 * hh;
#pragma unroll
        for (int d = 0; d < 2; ++d) {
          u32x2 lo = *(const u32x2*)(Vs + (32 * d + r) * VST + kb0);
          u32x2 hi = *(const u32x2*)(Vs + (32 * d + r) * VST + kb0 + 8);
          u32x4 va; va[0] = lo[0]; va[1] = lo[1]; va[2] = hi[0]; va[3] = hi[1];
          oacc[d] = MFMA32(__builtin_bit_cast(bf16x8, va), pf, oacc[d]);
        }
      }
    __syncthreads();
  }
  lsum += __shfl_xor(lsum, 32);
  const float inv = 1.f / lsum;
  bf16_t* YM = (bf16_t*)(p.ws + OFF_H) + (size_t)qrow * DM + head * 64;
#pragma unroll
  for (int d = 0; d < 2; ++d)
#pragma unroll
    for (int q = 0; q < 4; ++q) {
      u32x2 o; o[0] = pack2(oacc[d][4 * q] * inv, oacc[d][4 * q + 1] * inv); o[1] = pack2(oacc[d][4 * q + 2] * inv, oacc[d][4 * q + 3] * inv);
      *(u32x2*)(YM + 32 * d + 8 * q + 4 * hh) = o;
    }
}

DI void phase_qkv(const Params& p, int layer, int bid, int nb, char* smem) {
  const int MQ = layer == 0 ? MT : ML;
  const int nq = (MQ / 128) * 3, nkv = (MT / 128) * 4, nst = NB * NCH * 8;
  const float* RS = (const float*)(p.ws + OFF_RSTD);
  EpiQ eq{(bf16_t*)(p.ws + OFF_QB), RS};
  EpiKV ekv{(bf16_t*)(p.ws + OFF_KB), (bf16_t*)(p.ws + OFF_VT), RS};
  const bf16_t* U = (const bf16_t*)(p.ws + OFF_U);
  for (int it = bid; it < nq + nkv + nst; it += nb) {
    if (it < nq) gemm_tile<false>(U, DIN, wt_ptr(p, layer, WT_UQ), 256, (it / 3) * 128, (it % 3) * 128, smem, eq);
    else if (it < nq + nkv) { int j = it - nq; gemm_tile<false>(U + U_CKV, DIN, wt_ptr(p, layer, WT_UKV), 128, (j / 4) * 128, (j % 4) * 128, smem, ekv); }
    else { int j = it - nq - nkv; for (int rep = 0; rep < REP_SSD; ++rep) ssd_state_item(p, layer, j / (NCH * 8), (j / 8) % NCH, j & 7, smem); }
  }
}
DI void phase_att(const Params& p, int layer, int bid, int nb, int vbid, int nvb, char* smem, char* sh) {
  for (int it = bid; it < 256; it += nb) {
    const int x = it & 7, j = it >> 3, bh = 2 * x + (j >> 4), qb = j & 15, b = bh >> 2, head = bh & 3;
    for (int rep = 0; rep < REP_ATT; ++rep) attn_item8(p, b, head, b * SEQ + qb * 256, qb * 256, true, LK, smem);
  }
  const int nctx = layer == 0 ? 32 : 0, npass = 512;
  for (int it = vbid; it < nctx + npass; it += nvb) {
    if (it < nctx) { int b = it >> 3, head = (it >> 1) & 3, qb = it & 1; attn_item(p, b, head, ML + b * CTX + qb * 128, qb * 128, false, CTX, sh); }
    else ssd_pass_item(p, it - nctx);
  }
}
DI void phase_ssdout(const Params& p, int layer, int bid, int nb, char* smem) {
  for (int it = bid; it < NB * NCH * 8; it += nb) {
    int b = it / (NCH * 8), tc = (it / 8) % NCH, h = it & 7;
    if (layer == 1 && tc < 2) continue;
    for (int rep = 0; rep < REP_SSD; ++rep) ssd_out_item(p, layer, b, tc, h, smem);
  }
}


#define XB_TMO      128
#define XB_XCNT(j)  (256  + 64 * (j))
#define XB_XSUB(j)  (1280 + 64 * (j))
#define XB_XGEN(j)  (2304 + 64 * (j))
#define XB_TOP      3328
#define XB_TOPGEN   3392
#define XCD_BAR_WORDS 3456
#define XB_SPIN_CAP (1u << 22)
#define LAS __attribute__((address_space(3)))
DI unsigned xb_ld(unsigned* p) { return __hip_atomic_load(p, __ATOMIC_RELAXED, __HIP_MEMORY_SCOPE_AGENT); }
DI unsigned xb_add(unsigned* p, unsigned v) { return __hip_atomic_fetch_add(p, v, __ATOMIC_RELAXED, __HIP_MEMORY_SCOPE_AGENT); }
DI unsigned xb_xcc_id() { return (unsigned)__builtin_amdgcn_s_getreg((3 << 11) | 20) & 0xFu; }
#define XB_SPIN(cond, bar) do { unsigned _sp = 0; while (cond) { __builtin_amdgcn_s_sleep(1); \
    if ((++_sp & 255u) == 0u) { if (xb_ld(&(bar)[XB_TMO])) break; if (_sp > XB_SPIN_CAP) { atomicAdd(&(bar)[XB_TMO], 1u); break; } } } } while (0)
struct XcdBarrier { unsigned* bar; unsigned x; volatile LAS unsigned* st; };
DI XcdBarrier xcd_barrier_post(unsigned* bar, volatile LAS unsigned* st) {
  XcdBarrier b; b.bar = bar; b.x = xb_xcc_id(); b.st = st;
  if (threadIdx.x == 0) (void)xb_add(&bar[XB_XCNT(b.x)], 1u);
  return b;
}
DI void xcd_barrier_complete(unsigned* bar, unsigned x, unsigned& nloc, unsigned& nx) {
  const unsigned G = gridDim.x * gridDim.y * gridDim.z;
  unsigned sum, cnt, mine, sp = 0u;
  for (;;) {
    sum = 0u; cnt = 0u; mine = 0u;
#pragma unroll
    for (unsigned j = 0; j < 16; ++j) { const unsigned c = xb_ld(&bar[XB_XCNT(j)]); sum += c; cnt += (c > 0u) ? 1u : 0u; mine = (j == x) ? c : mine; }
    if (sum == G) break;
    __builtin_amdgcn_s_sleep(1);
    if ((++sp & 255u) == 0u) { if (xb_ld(&bar[XB_TMO])) break; if (sp > XB_SPIN_CAP) { atomicAdd(&bar[XB_TMO], 1u); break; } }
  }
  nloc = mine > 0u ? mine : 1u; nx = cnt > 0u ? cnt : 1u;
}
DI void xcd_barrier(const XcdBarrier& b) {
  asm volatile("s_waitcnt vmcnt(0)" ::: "memory");
  __syncthreads();
  if (threadIdx.x == 0) {
    unsigned* bar = b.bar;
    asm volatile("" : "+s"(bar));
    __builtin_amdgcn_s_waitcnt(0);
    unsigned nloc = b.st[0], nx = b.st[1];
    if (nloc == 0u) { xcd_barrier_complete(bar, b.x, nloc, nx); b.st[0] = nloc; b.st[1] = nx; }
    const unsigned old = xb_add(&bar[XB_XSUB(b.x)], 1u);
    const unsigned gen = old / nloc;
    if (old + 1u == (gen + 1u) * nloc) {
      __builtin_amdgcn_fence(__ATOMIC_RELEASE, "agent");
      asm volatile("s_waitcnt vmcnt(0)" ::: "memory");
      const unsigned og = xb_add(&bar[XB_TOP], 1u);
      const unsigned tg = og / nx;
      if (og + 1u == (tg + 1u) * nx) xb_add(&bar[XB_TOPGEN], 1u);
      else XB_SPIN(xb_ld(&bar[XB_TOPGEN]) == tg, bar);
      __builtin_amdgcn_fence(__ATOMIC_ACQUIRE, "agent");
      xb_add(&bar[XB_XGEN(b.x)], 1u);
      asm volatile("s_waitcnt vmcnt(0)" ::: "memory");
    } else {
      XB_SPIN(xb_ld(&bar[XB_XGEN(b.x)]) == gen, bar);
      __builtin_amdgcn_fence(__ATOMIC_ACQUIRE, "agent");
      asm volatile("s_waitcnt vmcnt(0)" ::: "memory");
    }
  }
  __syncthreads();
}

constexpr int SMEM_BYTES = 2 * GBUF * 2;
enum { PH_PREP0 = 0, PH_H0, PH_INPROJ, PH_PREP, PH_QKV, PH_ATT, PH_SSDOUT, PH_WOUT, PH_POSTMIX, PH_FF1, PH_FF2, PH_POSTFFN, PH_SSDNORM };

struct Ids { int bid, nb, vbid, nvb, lid; };
DI void run_phase(const Params& p, int ph, int layer, const Ids& id, char* smem, char* sh) {
  switch (ph) {
    case PH_PREP0: phase_prep0(p, id.vbid, id.nvb, sh); break;
    case PH_H0: phase_h0(p, id.vbid, id.nvb); break;
    case PH_INPROJ: phase_inproj(p, layer, id.bid, id.nb, smem); break;
    case PH_PREP: phase_prep(p, layer, id.vbid, id.nvb); break;
    case PH_QKV: phase_qkv(p, layer, id.vbid, id.nvb, sh); break;
    case PH_ATT: phase_att(p, layer, id.bid, id.nb, id.vbid, id.nvb, smem, sh); break;
    case PH_SSDOUT: phase_ssdout(p, layer, id.vbid, id.nvb, sh); break;
    case PH_WOUT: phase_wout(p, layer, id.lid, id.nvb, sh); break;
    case PH_POSTMIX: phase_postmix(p, layer, id.vbid, id.nvb); break;
    case PH_FF1: phase_ff1(p, layer, id.bid, id.nb, id.vbid, id.nvb, smem, sh); break;
    case PH_FF2: phase_ff2(p, layer, id.bid, id.nb, id.vbid, id.nvb, smem, sh); break;
    case PH_POSTFFN: phase_postffn(p, layer, id.vbid, id.nvb); break;
  }
}

__global__ void __launch_bounds__(512) mega_kernel(Params p) {
  extern __shared__ __attribute__((aligned(16))) char smem[];
  cg::grid_group grid = cg::this_grid();
  if (p.ws == nullptr) grid.sync();
  const int half = __builtin_amdgcn_readfirstlane((int)(threadIdx.x >> 8));
  Ids id;
  id.bid = blockIdx.x; id.nb = gridDim.x;
  id.vbid = 2 * id.bid + half; id.nvb = 2 * id.nb;
  id.lid = (id.bid & 7) + 8 * (2 * (id.bid >> 3) + half);
  char* sh = smem + half * SMEM_BYTES;
  volatile LAS unsigned* st = (volatile LAS unsigned*)(smem + 2 * SMEM_BYTES - 16);
  if (threadIdx.x == 0) { st[0] = 0u; st[1] = 0u; st[2] = 0u; st[3] = 0u; }
  __syncthreads();
  XcdBarrier xb = xcd_barrier_post((unsigned*)(p.ws + OFF_BAR), st);
  for (int step = 0; step < 22; ++step) {
    int ph, layer;
    if (step < 2) { ph = step; layer = 0; }
    else { int j = step - 2; layer = j / 10; ph = PH_INPROJ + j % 10; }
    typedef const void* __attribute__((address_space(4))) * KArgs;
    KArgs ka = (KArgs)__builtin_amdgcn_kernarg_segment_ptr();
    asm volatile("" : "+s"(ka));
    Params q;
    {
      const void** dst = (const void**)&q;
#pragma unroll
      for (int i = 0; i < 27; ++i) dst[i] = ka[i];
    }
    run_phase(q, ph, layer, id, smem, sh);
    if (step < 21) xcd_barrier(xb);
  }
}

extern "C" void kernel_launch(void* const* d_in, const int* in_sizes, int n_in, void* d_out, int out_size, void* d_ws, size_t ws_size,
                              hipStream_t stream) {
  if (ws_size < WS_NEED) { fprintf(stderr, "workspace too small: %zu < %zu\n", ws_size, (size_t)WS_NEED); return; }
  Params p{};
  const float** f = (const float**)&p;
  for (int i = 0; i < 25; ++i) f[i] = (const float*)d_in[i];
  p.out = (float*)d_out;
  p.ws = (char*)d_ws;
  static int grid_blocks = 0;
  if (!grid_blocks) {
    int dev = 0, cus = 0, per_cu = 0;
    hipGetDevice(&dev);
    hipDeviceGetAttribute(&cus, hipDeviceAttributeMultiprocessorCount, dev);
    hipFuncSetAttribute((const void*)mega_kernel, hipFuncAttributeMaxDynamicSharedMemorySize, 2 * SMEM_BYTES);
    hipOccupancyMaxActiveBlocksPerMultiprocessor(&per_cu, mega_kernel, 512, 2 * SMEM_BYTES);
    if (per_cu > 1) per_cu = 1;
    grid_blocks = cus * per_cu;
  }
  hipMemsetAsync((char*)d_ws + OFF_BAR, 0, XCD_BAR_WORDS * 4, stream);
  void* args[] = {&p};
  hipError_t e = hipLaunchCooperativeKernel((void*)mega_kernel, dim3(grid_blocks), dim3(512), args, 2 * SMEM_BYTES, stream);
  if (e != hipSuccess) fprintf(stderr, "cooperative launch failed: %s (grid %d)\n", hipGetErrorString(e), grid_blocks);
}
```

```cpp
#include <hip/hip_runtime.h>
#include <hip/hip_cooperative_groups.h>
#include <stdint.h>
#include <stdio.h>
namespace cg = cooperative_groups;

#ifndef MEGA
#define MEGA 1
#endif
#ifndef REP_GEMM
#define REP_GEMM 1
#endif
#ifndef REP_ATT
#define REP_ATT 1
#endif
#ifndef REP_SSD
#define REP_SSD 1
#endif

typedef unsigned short bf16_t;
using bf16x8 = __attribute__((ext_vector_type(8))) short;
using s16x4  = __attribute__((ext_vector_type(4))) short;
using f32x4  = __attribute__((ext_vector_type(4))) float;
using f32x16 = __attribute__((ext_vector_type(16))) float;
using u32x4  = __attribute__((ext_vector_type(4))) unsigned;
using u32x2  = __attribute__((ext_vector_type(2))) unsigned;
#define DI __device__ __forceinline__
#define MFMA32(a, b, c) __builtin_amdgcn_mfma_f32_32x32x16_bf16((a), (b), (c), 0, 0, 0)
#define MFMA16(a, b, c) __builtin_amdgcn_mfma_f32_16x16x32_bf16((a), (b), (c), 0, 0, 0)

constexpr int DM = 1024, NB = 4, SEQ = 4096, CTX = 256;
constexpr int ML = NB * SEQ;
constexpr int MC = NB * CTX;
constexpr int MT = ML + MC;
constexpr int DIN = 2480, DINP = 2560;
constexpr int LK = CTX + SEQ;
constexpr int DFF = 4096;
constexpr int NCH = 34;
constexpr float EPS = 1e-6f;
constexpr int U_CKV = 256, U_KR = 384, U_GB = 416, U_GC = 672, U_VAL = 928, U_Z = 1184, U_XBC = 1696, U_DT = 2464;

constexpr size_t AL(size_t x) { return (x + 255) & ~(size_t)255; }
constexpr size_t WT_IN = 0;
constexpr size_t WT_UQ = WT_IN + (size_t)DINP * 1024;
constexpr size_t WT_UKV = WT_UQ + (size_t)384 * 256;
constexpr size_t WT_OUT = WT_UKV + (size_t)512 * 128;
constexpr size_t WT_FF1 = WT_OUT + (size_t)1024 * 1024;
constexpr size_t WT_FF2 = WT_FF1 + (size_t)4096 * 1024;
constexpr size_t WT_ELEMS = WT_FF2 + (size_t)4096 * 1024;
constexpr size_t OFF_WT = 0;
constexpr size_t OFF_MOD = AL(OFF_WT + 2 * WT_ELEMS * 2);
constexpr size_t OFF_XC = AL(OFF_MOD + 2 * 5 * 6144 * 4);
constexpr size_t OFF_H = AL(OFF_XC + (size_t)MC * DM * 4);
constexpr size_t OFF_R1 = AL(OFF_H + (size_t)MT * DM * 2);
constexpr size_t OFF_U = OFF_R1;
constexpr size_t OFF_DT = AL(OFF_U + (size_t)MT * DIN * 2);
constexpr size_t OFF_RSTD = AL(OFF_DT + (size_t)MT * 16 * 4);
constexpr size_t OFF_QB = AL(OFF_RSTD + (size_t)MT * 2 * 4);
constexpr size_t OFF_KB = AL(OFF_QB + (size_t)MT * 384 * 2);
constexpr size_t OFF_VT = AL(OFF_KB + (size_t)NB * 4 * LK * 96 * 2);
constexpr size_t OFF_XBC = AL(OFF_VT + (size_t)NB * 4 * 64 * LK * 2);
constexpr size_t OFF_SST = AL(OFF_XBC + (size_t)MT * 768 * 2);
constexpr size_t OFF_TDEC = AL(OFF_SST + (size_t)2 * NB * NCH * 8 * 4096 * 2);
constexpr size_t OFF_SSQ = AL(OFF_TDEC + (size_t)2 * NB * NCH * 8 * 4);
constexpr size_t OFF_END1 = AL(OFF_SSQ + (size_t)MT * 8 * 4);
constexpr size_t OFF_F1 = OFF_R1;
constexpr size_t OFF_END2 = AL(OFF_F1 + (size_t)MT * DFF * 2);
constexpr size_t OFF_BAR = OFF_END1 > OFF_END2 ? OFF_END1 : OFF_END2;
constexpr size_t WS_NEED = OFF_BAR + 16384;

struct Params {
  const float *x, *c, *ctx, *c_ctx, *w_mod, *b_mod, *g_pre_mix, *w_in, *q_norm, *w_uq, *kv_norm, *w_ukv, *sc_w, *ssd_cw, *ssd_cb,
      *a_log, *dt_bias, *ssd_d, *ssd_norm, *w_out, *g_post_mix, *g_pre_ffn, *w_ff1, *w_ff2, *g_post_ffn;
  float* out;
  char* ws;
};

DI int ltid() { int t = threadIdx.x & 255; asm volatile("" : "+v"(t)); return t; }
DI int ltid512() { int t = threadIdx.x; asm volatile("" : "+v"(t)); return t; }
typedef __bf16 hbf2 __attribute__((ext_vector_type(2)));
typedef float hf2 __attribute__((ext_vector_type(2)));
DI bf16_t f2bf(float x) { return __builtin_bit_cast(bf16_t, (__bf16)x); }
DI float bf2f(unsigned v) { return __uint_as_float(v << 16); }
DI unsigned pack2(float a, float b) { hf2 v = {a, b}; return __builtin_bit_cast(unsigned, __builtin_convertvector(v, hbf2)); }
DI float lo2f(unsigned w) { return __uint_as_float(w << 16); }
DI float hi2f(unsigned w) { return __uint_as_float(w & 0xffff0000u); }
DI float wave_sum(float v) {
#pragma unroll
  for (int o = 32; o > 0; o >>= 1) v += __shfl_xor(v, o);
  return v;
}
DI float silu_f(float x) { return x / (1.f + __expf(-x)); }
DI int crow(int reg, int h) { return (reg & 3) + 8 * (reg >> 2) + 4 * h; }
DI bf16x8 pack8(const f32x16& x, int s) {
  u32x4 p;
  p[0] = pack2(x[8 * s + 0], x[8 * s + 1]); p[1] = pack2(x[8 * s + 2], x[8 * s + 3]);
  p[2] = pack2(x[8 * s + 4], x[8 * s + 5]); p[3] = pack2(x[8 * s + 6], x[8 * s + 7]);
  return __builtin_bit_cast(bf16x8, p);
}
DI const float* xin_row(const Params& p, int layer, int row) {
  if (layer == 0) return row < ML ? p.x + (size_t)row * DM : p.ctx + (size_t)(row - ML) * DM;
  return row < ML ? p.out + (size_t)row * DM : (const float*)(p.ws + OFF_XC) + (size_t)(row - ML) * DM;
}
DI float* xst_row(const Params& p, int row) {
  return row < ML ? p.out + (size_t)row * DM : (float*)(p.ws + OFF_XC) + (size_t)(row - ML) * DM;
}
DI const float* mod_ptr(const Params& p, int layer, int row, int which) {
  int bb = row < ML ? (row >> 12) : 4;
  return (const float*)(p.ws + OFF_MOD) + ((size_t)(layer * 5 + bb) * 6 + which) * DM;
}
DI bf16_t* wt_ptr(const Params& p, int layer, size_t off) { return (bf16_t*)(p.ws + OFF_WT) + (size_t)layer * WT_ELEMS + off; }

DI void transpose_item(const float* __restrict__ w, const float* __restrict__ gk, int gk_from, bf16_t* __restrict__ wt, int K, int N, int kt, int nt, char* smem) {
  float* tile = (float*)smem;
  const int tid = ltid(), tx = tid & 63, ty = tid >> 6;
  const int k0 = kt * 64, n0 = nt * 64;
  const int n = n0 + tx;
  float v[16];
#pragma unroll
  for (int i = 0; i < 16; ++i) {
    int kk = ty + 4 * i;
    v[i] = n < N ? w[(size_t)(k0 + kk) * N + n] : 0.f;
  }
  if (gk) {
#pragma unroll
    for (int i = 0; i < 16; ++i) { int k = k0 + ty + 4 * i; if (k >= gk_from) v[i] *= gk[k - gk_from]; }
  }
#pragma unroll
  for (int i = 0; i < 16; ++i) tile[(ty + 4 * i) * 65 + tx] = v[i];
  __syncthreads();
#pragma unroll
  for (int i = 0; i < 2; ++i) {
    int c = tid + 256 * i, nn = c >> 3, kc = c & 7;
    u32x4 o;
#pragma unroll
    for (int jj = 0; jj < 4; ++jj) o[jj] = pack2(tile[(kc * 8 + 2 * jj) * 65 + nn], tile[(kc * 8 + 2 * jj + 1) * 65 + nn]);
    *(u32x4*)(wt + (size_t)(n0 + nn) * K + k0 + kc * 8) = o;
  }
  __syncthreads();
}

DI void modgemv_item(const Params& p, int layer, int ct, char* smem) {
  float* s = (float*)smem;
  float* red = s + 5 * 1024;
  const int tid = ltid(), w = tid >> 6, lane = tid & 63;
  for (int i = tid; i < 5 * 1024; i += 256) {
    int bb = i >> 10, k = i & 1023;
    float v = bb < 4 ? p.c[bb * 1024 + k] : p.c_ctx[k];
    s[i] = silu_f(v);
  }
  __syncthreads();
  const float* wm = p.w_mod + (size_t)layer * 1024 * 6144;
  const int n = ct * 64 + lane;
  float acc[5] = {0.f, 0.f, 0.f, 0.f, 0.f};
#pragma unroll 16
  for (int k = w * 256; k < w * 256 + 256; ++k) {
    float wv = wm[(size_t)k * 6144 + n];
#pragma unroll
    for (int bb = 0; bb < 5; ++bb) acc[bb] += s[bb * 1024 + k] * wv;
  }
#pragma unroll
  for (int bb = 0; bb < 5; ++bb) red[(w * 5 + bb) * 64 + lane] = acc[bb];
  __syncthreads();
  for (int i = tid; i < 320; i += 256) {
    int bb = i >> 6, ln = i & 63;
    float v = red[(0 * 5 + bb) * 64 + ln] + red[(1 * 5 + bb) * 64 + ln] + red[(2 * 5 + bb) * 64 + ln] + red[(3 * 5 + bb) * 64 + ln];
    int nn = ct * 64 + ln;
    v += p.b_mod[layer * 6144 + nn];
    ((float*)(p.ws + OFF_MOD))[(size_t)(layer * 5 + bb) * 6144 + nn] = v;
  }
  __syncthreads();
}

DI void phase_prep0(const Params& p, int bid, int nb, char* smem) {
  constexpr int PER = 2984;
  for (int it = bid; it < 192 + 2 * PER; it += nb) {
    if (it < 192) { modgemv_item(p, it / 96, it % 96, smem); continue; }
    int layer = (it - 192) / PER, j = (it - 192) % PER;
    if (j < 640) transpose_item(p.w_in + (size_t)layer * 1024 * DIN, nullptr, 0, wt_ptr(p, layer, WT_IN), 1024, DIN, j / 40, j % 40, smem);
    else if ((j -= 640) < 24) transpose_item(p.w_uq + (size_t)layer * 256 * 384, p.q_norm + layer * 256, 0, wt_ptr(p, layer, WT_UQ), 256, 384, j / 6, j % 6, smem);
    else if ((j -= 24) < 16) transpose_item(p.w_ukv + (size_t)layer * 128 * 512, p.kv_norm + layer * 128, 0, wt_ptr(p, layer, WT_UKV), 128, 512, j / 8, j % 8, smem);
    else if ((j -= 16) < 256) transpose_item(p.w_out + (size_t)layer * 1024 * 1024, p.ssd_norm + layer * 512, 512, wt_ptr(p, layer, WT_OUT), 1024, 1024, j / 16, j % 16, smem);
    else if ((j -= 256) < 1024) transpose_item(p.w_ff1 + (size_t)layer * 1024 * 4096, nullptr, 0, wt_ptr(p, layer, WT_FF1), 1024, 4096, j / 64, j % 64, smem);
    else { j -= 1024; transpose_item(p.w_ff2 + (size_t)layer * 4096 * 1024, nullptr, 0, wt_ptr(p, layer, WT_FF2), 4096, 1024, j / 16, j % 16, smem); }
  }
}

struct HMod { float4 g[4], s1[4], s0[4]; };
DI void load_hmod(HMod& m, const float* g, const float* sh, const float* sc, int lane) {
#pragma unroll
  for (int i = 0; i < 4; ++i) {
    const int col = lane * 4 + 256 * i;
    m.g[i] = *(const float4*)(g + col); m.s1[i] = *(const float4*)(sc + col); m.s0[i] = *(const float4*)(sh + col);
  }
}
DI void write_h_row(const float4 xv[4], float rstd, const HMod& m, bf16_t* hrow, int lane) {
#pragma unroll
  for (int i = 0; i < 4; ++i) {
    const int col = lane * 4 + 256 * i;
    float a = xv[i].x * rstd * m.g[i].x * (1.f + m.s1[i].x) + m.s0[i].x;
    float b = xv[i].y * rstd * m.g[i].y * (1.f + m.s1[i].y) + m.s0[i].y;
    float c = xv[i].z * rstd * m.g[i].z * (1.f + m.s1[i].z) + m.s0[i].z;
    float d = xv[i].w * rstd * m.g[i].w * (1.f + m.s1[i].w) + m.s0[i].w;
    u32x2 o; o[0] = pack2(a, b); o[1] = pack2(c, d);
    *(u32x2*)(hrow + col) = o;
  }
}
DI float ssq4(const float4 v[4]) {
  float s = 0.f;
#pragma unroll
  for (int i = 0; i < 4; ++i) s += v[i].x * v[i].x + v[i].y * v[i].y + v[i].z * v[i].z + v[i].w * v[i].w;
  return s;
}
DI void load_bf_row(const bf16_t* r, int lane, float4 v[4]) {
#pragma unroll
  for (int i = 0; i < 4; ++i) {
    u32x2 t = *(const u32x2*)(r + lane * 4 + 256 * i);
    v[i] = make_float4(lo2f(t[0]), hi2f(t[0]), lo2f(t[1]), hi2f(t[1]));
  }
}

DI void phase_h0(const Params& p, int bid, int nb) {
  const int w = ltid() >> 6, lane = ltid() & 63;
  bf16_t* H = (bf16_t*)(p.ws + OFF_H);
  for (int row = bid * 4 + w; row < MT; row += nb * 4) {
    const float* xr = xin_row(p, 0, row);
    float4 xv[4];
#pragma unroll
    for (int i = 0; i < 4; ++i) xv[i] = *(const float4*)(xr + lane * 4 + 256 * i);
    HMod m; load_hmod(m, p.g_pre_mix, mod_ptr(p, 0, row, 0), mod_ptr(p, 0, row, 1), lane);
    float rstd = rsqrtf(wave_sum(ssq4(xv)) * (1.f / DM) + EPS);
    write_h_row(xv, rstd, m, H + (size_t)row * DM, lane);
  }
}

DI void phase_postmix(const Params& p, int layer, int bid, int nb) {
  const int w = ltid() >> 6, lane = ltid() & 63;
  const int M = layer == 0 ? MT : ML;
  bf16_t* H = (bf16_t*)(p.ws + OFF_H);
  const bf16_t* Y = (const bf16_t*)(p.ws + OFF_U);
  for (int row = bid * 4 + w; row < M; row += nb * 4) {
    float4 yv[4], xv[4], ga[4], gb[4];
    load_bf_row(Y + (size_t)row * DM, lane, yv);
    const float* xr = xin_row(p, layer, row);
    const float* g1 = mod_ptr(p, layer, row, 2);
    const float* gp = p.g_post_mix + layer * DM;
#pragma unroll
    for (int i = 0; i < 4; ++i) {
      const int col = lane * 4 + 256 * i;
      xv[i] = *(const float4*)(xr + col); ga[i] = *(const float4*)(g1 + col); gb[i] = *(const float4*)(gp + col);
    }
    HMod m; load_hmod(m, p.g_pre_ffn + layer * DM, mod_ptr(p, layer, row, 3), mod_ptr(p, layer, row, 4), lane);
    float rstd = rsqrtf(wave_sum(ssq4(yv)) * (1.f / DM) + EPS);
    float* xo = xst_row(p, row);
#pragma unroll
    for (int i = 0; i < 4; ++i) {
      xv[i].x += ga[i].x * yv[i].x * rstd * gb[i].x; xv[i].y += ga[i].y * yv[i].y * rstd * gb[i].y;
      xv[i].z += ga[i].z * yv[i].z * rstd * gb[i].z; xv[i].w += ga[i].w * yv[i].w * rstd * gb[i].w;
    }
#pragma unroll
    for (int i = 0; i < 4; ++i) *(float4*)(xo + lane * 4 + 256 * i) = xv[i];
    float rstd1 = rsqrtf(wave_sum(ssq4(xv)) * (1.f / DM) + EPS);
    write_h_row(xv, rstd1, m, H + (size_t)row * DM, lane);
  }
}

DI void phase_postffn(const Params& p, int layer, int bid, int nb) {
  const int w = ltid() >> 6, lane = ltid() & 63;
  const int M = layer == 0 ? MT : ML;
  bf16_t* H = (bf16_t*)(p.ws + OFF_H);
  for (int row = bid * 4 + w; row < M; row += nb * 4) {
    float4 fv[4], xv[4];
    if (row < ML) load_bf_row(H + (size_t)row * DM, lane, fv);
    else {
      const float* pp = (const float*)(p.ws + OFF_END2) + (size_t)(row - ML) * DM;
#pragma unroll
      for (int i = 0; i < 4; ++i) {
        float4 a = *(const float4*)(pp + lane * 4 + 256 * i), b = *(const float4*)(pp + (size_t)MC * DM + lane * 4 + 256 * i);
        float4 c = *(const float4*)(pp + (size_t)2 * MC * DM + lane * 4 + 256 * i), d = *(const float4*)(pp + (size_t)3 * MC * DM + lane * 4 + 256 * i);
        fv[i] = make_float4((a.x + b.x) + (c.x + d.x), (a.y + b.y) + (c.y + d.y), (a.z + b.z) + (c.z + d.z), (a.w + b.w) + (c.w + d.w));
      }
    }
    float* xo = xst_row(p, row);
    const float* g2 = mod_ptr(p, layer, row, 5);
    const float* gp = p.g_post_ffn + layer * DM;
    float4 ga[4], gb[4];
#pragma unroll
    for (int i = 0; i < 4; ++i) {
      const int col = lane * 4 + 256 * i;
      xv[i] = *(const float4*)(xo + col); ga[i] = *(const float4*)(g2 + col); gb[i] = *(const float4*)(gp + col);
    }
    HMod m;
    if (layer == 0) load_hmod(m, p.g_pre_mix + DM, mod_ptr(p, 1, row, 0), mod_ptr(p, 1, row, 1), lane);
    float rstd = rsqrtf(wave_sum(ssq4(fv)) * (1.f / DM) + EPS);
#pragma unroll
    for (int i = 0; i < 4; ++i) {
      xv[i].x += ga[i].x * fv[i].x * rstd * gb[i].x; xv[i].y += ga[i].y * fv[i].y * rstd * gb[i].y;
      xv[i].z += ga[i].z * fv[i].z * rstd * gb[i].z; xv[i].w += ga[i].w * fv[i].w * rstd * gb[i].w;
    }
#pragma unroll
    for (int i = 0; i < 4; ++i) *(float4*)(xo + lane * 4 + 256 * i) = xv[i];
    if (layer == 0) {
      float rstd1 = rsqrtf(wave_sum(ssq4(xv)) * (1.f / DM) + EPS);
      write_h_row(xv, rstd1, m, H + (size_t)row * DM, lane);
    }
  }
}

DI void phase_prep(const Params& p, int layer, int bid, int nb) {
  const int w = ltid() >> 6, lane = ltid() & 63;
  const bf16_t* U = (const bf16_t*)(p.ws + OFF_U);
  float* DT = (float*)(p.ws + OFF_DT);
  float* RS = (float*)(p.ws + OFF_RSTD);
  bf16_t* KB = (bf16_t*)(p.ws + OFF_KB);
  bf16_t* XBC = (bf16_t*)(p.ws + OFF_XBC);
  bf16_t* YM = (bf16_t*)(p.ws + OFF_H);
  const float* scw = p.sc_w + layer * 3 * 256;
  const float* cw = p.ssd_cw + layer * 3 * 768;
  const float* cb = p.ssd_cb + layer * 768;
  const int c4 = lane * 4;
  const float4 sw0 = *(const float4*)(scw + c4), sw1 = *(const float4*)(scw + 256 + c4), sw2 = *(const float4*)(scw + 512 + c4);
  float4 cwk[3][3], cbi[3];
#pragma unroll
  for (int i = 0; i < 3; ++i) {
    cbi[i] = *(const float4*)(cb + c4 + 256 * i);
#pragma unroll
    for (int k = 0; k < 3; ++k) cwk[i][k] = *(const float4*)(cw + k * 768 + c4 + 256 * i);
  }
  const float dtb = p.dt_bias[layer * 16 + (lane & 15)];
  const float invf = exp2f(-(float)(2 * (lane & 7)) * (13.287712379549449f / 16.f));
  for (int row = bid * 4 + w; row < MT; row += nb * 4) {
    int b, t, L, pos;
    const bool lat = row < ML;
    if (lat) { b = row >> 12; t = row & 4095; L = SEQ; pos = t + CTX; }
    else { int rr = row - ML; b = rr >> 8; t = rr & 255; L = CTX; pos = t; }
    const bf16_t* u0 = U + (size_t)row * DIN;
    const bool hp = t > 0, hn = t < L - 1;
    const bf16_t* um = hp ? u0 - DIN : u0;
    const bf16_t* up = hn ? u0 + DIN : u0;
    const float mp = hp ? 1.f : 0.f, mn = hn ? 1.f : 0.f;
    const u32x2 vq = *(const u32x2*)(u0 + c4);
    const u32x2 vkv = *(const u32x2*)(u0 + U_CKV + (lane & 31) * 4);
    const float kr = bf2f(u0[U_KR + (lane & 31)]);
    const u32x2 gcm = *(const u32x2*)(um + U_GC + c4), gc0 = *(const u32x2*)(u0 + U_GC + c4), gcp = *(const u32x2*)(up + U_GC + c4);
    const u32x2 vvm = *(const u32x2*)(um + U_VAL + c4), vv0 = *(const u32x2*)(u0 + U_VAL + c4), vvp = *(const u32x2*)(up + U_VAL + c4);
    const u32x2 gb = *(const u32x2*)(u0 + U_GB + c4);
    u32x2 xm[3], x0[3], xp[3];
#pragma unroll
    for (int i = 0; i < 3; ++i) {
      xm[i] = *(const u32x2*)(um + U_XBC + c4 + 256 * i);
      x0[i] = *(const u32x2*)(u0 + U_XBC + c4 + 256 * i);
      xp[i] = *(const u32x2*)(up + U_XBC + c4 + 256 * i);
    }
    const float dtr = DT[(size_t)row * 16 + (lane & 15)];
    {
      float a = lo2f(vq[0]), bq = hi2f(vq[0]), c = lo2f(vq[1]), d = hi2f(vq[1]);
      float ss = wave_sum(a * a + bq * bq + c * c + d * d);
      float e = lo2f(vkv[0]), f = hi2f(vkv[0]), g = lo2f(vkv[1]), h = hi2f(vkv[1]);
      float s2 = lane < 32 ? e * e + f * f + g * g + h * h : 0.f;
      s2 = wave_sum(s2);
      if (lane == 0) { RS[row * 2] = rsqrtf(ss * (1.f / 256) + EPS); RS[row * 2 + 1] = rsqrtf(s2 * (1.f / 128) + EPS); }
    }
    {
      const float partner = __shfl_xor(kr, 8);
      float o = kr;
      if (lat) {
        const int grp = (lane & 31) >> 3;
        const float posf = grp < 2 ? (float)(t >> 6) : (float)(t & 63);
        const float rev = posf * invf * 0.15915494309189535f;
        const float cs = __builtin_amdgcn_cosf(rev), sn = __builtin_amdgcn_sinf(rev);
        o = (grp & 1) ? kr * cs + partner * sn : kr * cs - partner * sn;
      }
      if (lane < 32) {
        const bf16_t ob = f2bf(o);
#pragma unroll
        for (int hd = 0; hd < 4; ++hd) KB[((size_t)(b * 4 + hd) * LK + pos) * 96 + 64 + lane] = ob;
      }
    }
    {
      float a0 = sw1.x * lo2f(gc0[0]) * lo2f(vv0[0]) + mp * sw0.x * lo2f(gcm[0]) * lo2f(vvm[0]) + mn * sw2.x * lo2f(gcp[0]) * lo2f(vvp[0]);
      float a1 = sw1.y * hi2f(gc0[0]) * hi2f(vv0[0]) + mp * sw0.y * hi2f(gcm[0]) * hi2f(vvm[0]) + mn * sw2.y * hi2f(gcp[0]) * hi2f(vvp[0]);
      float a2 = sw1.z * lo2f(gc0[1]) * lo2f(vv0[1]) + mp * sw0.z * lo2f(gcm[1]) * lo2f(vvm[1]) + mn * sw2.z * lo2f(gcp[1]) * lo2f(vvp[1]);
      float a3 = sw1.w * hi2f(gc0[1]) * hi2f(vv0[1]) + mp * sw0.w * hi2f(gcm[1]) * hi2f(vvm[1]) + mn * sw2.w * hi2f(gcp[1]) * hi2f(vvp[1]);
      u32x2 o; o[0] = pack2(lo2f(gb[0]) * a0, hi2f(gb[0]) * a1); o[1] = pack2(lo2f(gb[1]) * a2, hi2f(gb[1]) * a3);
      *(u32x2*)(YM + (size_t)row * DM + 256 + c4) = o;
    }
#pragma unroll
    for (int i = 0; i < 3; ++i) {
      float a0 = cbi[i].x + cwk[i][1].x * lo2f(x0[i][0]) + mp * cwk[i][0].x * lo2f(xm[i][0]) + mn * cwk[i][2].x * lo2f(xp[i][0]);
      float a1 = cbi[i].y + cwk[i][1].y * hi2f(x0[i][0]) + mp * cwk[i][0].y * hi2f(xm[i][0]) + mn * cwk[i][2].y * hi2f(xp[i][0]);
      float a2 = cbi[i].z + cwk[i][1].z * lo2f(x0[i][1]) + mp * cwk[i][0].z * lo2f(xm[i][1]) + mn * cwk[i][2].z * lo2f(xp[i][1]);
      float a3 = cbi[i].w + cwk[i][1].w * hi2f(x0[i][1]) + mp * cwk[i][0].w * hi2f(xm[i][1]) + mn * cwk[i][2].w * hi2f(xp[i][1]);
      u32x2 o; o[0] = pack2(silu_f(a0), silu_f(a1)); o[1] = pack2(silu_f(a2), silu_f(a3));
      *(u32x2*)(XBC + (size_t)row * 768 + c4 + 256 * i) = o;
    }
    if (lane < 16) {
      const float v = dtr + dtb;
      const float e = __expf(-fabsf(v));
      DT[(size_t)row * 16 + lane] = fmaxf(v, 0.f) + (e < 1e-3f ? e * (1.f - 0.5f * e) : __logf(1.f + e));
    }
  }
}

DI void phase_ssdnorm(const Params& p, int layer, int bid, int nb) {
  const int w = ltid() >> 6, lane = ltid() & 63;
  const int M = layer == 0 ? MT : ML;
  bf16_t* YM = (bf16_t*)(p.ws + OFF_H);
  const float* SSQ = (const float*)(p.ws + OFF_SSQ);
  const float* ng = p.ssd_norm + layer * 512;
  for (int row = bid * 4 + w; row < M; row += nb * 4) {
    int g = lane >> 5;
    float4 s = *(const float4*)(SSQ + (size_t)row * 8 + g * 4);
    float rstd = rsqrtf((s.x + s.y + s.z + s.w) * (1.f / 256) + EPS);
    bf16_t* ptr = YM + (size_t)row * DM + 512 + lane * 8;
    u32x4 v = *(const u32x4*)ptr;
    float4 g0 = *(const float4*)(ng + lane * 8), g1 = *(const float4*)(ng + lane * 8 + 4);
    u32x4 o;
    o[0] = pack2(lo2f(v[0]) * rstd * g0.x, hi2f(v[0]) * rstd * g0.y);
    o[1] = pack2(lo2f(v[1]) * rstd * g0.z, hi2f(v[1]) * rstd * g0.w);
    o[2] = pack2(lo2f(v[2]) * rstd * g1.x, hi2f(v[2]) * rstd * g1.y);
    o[3] = pack2(lo2f(v[3]) * rstd * g1.z, hi2f(v[3]) * rstd * g1.w);
    *(u32x4*)ptr = o;
  }
}

constexpr int GST = 80;
constexpr int GBUF = 2 * 128 * GST;
template <bool GN, class Epi>
DI void gemm_tile(const bf16_t* __restrict__ A, int lda, const bf16_t* __restrict__ Bt, int K, int row0, int col0, char* smem, Epi epi, const float* __restrict__ ssq = nullptr) {
  bf16_t* S0 = (bf16_t*)smem;
  const int tid = ltid(), wid = tid >> 6, lane = tid & 63, wr = wid >> 1, wc = wid & 1, fr = lane & 15, fq = lane >> 4;
  f32x4 acc[4][4];
#pragma unroll
  for (int m = 0; m < 4; ++m)
#pragma unroll
    for (int n = 0; n < 4; ++n) acc[m][n] = f32x4{0.f, 0.f, 0.f, 0.f};
  u32x4 ra[4], rb[4];
  const int sr = tid >> 3, sp = tid & 7;
  const bf16_t* ga = A + (size_t)(row0 + sr) * lda + sp * 8;
  const bf16_t* gb = Bt + (size_t)(col0 + sr) * K + sp * 8;
  auto gload = [&](int k0) {
#pragma unroll
    for (int i = 0; i < 4; ++i) {
      ra[i] = *(const u32x4*)(ga + (size_t)(32 * i) * lda + k0);
      rb[i] = *(const u32x4*)(gb + (size_t)(32 * i) * K + k0);
    }
  };
  gload(0);
  float gs[4][2];
  if (GN) {
#pragma unroll
    for (int i = 0; i < 4; ++i) {
      const float4 s0 = *(const float4*)(ssq + (size_t)(row0 + sr + 32 * i) * 8), s1 = *(const float4*)(ssq + (size_t)(row0 + sr + 32 * i) * 8 + 4);
      gs[i][0] = rsqrtf((s0.x + s0.y + s0.z + s0.w) * (1.f / 256) + EPS);
      gs[i][1] = rsqrtf((s1.x + s1.y + s1.z + s1.w) * (1.f / 256) + EPS);
    }
  }
  auto swrite = [&](int kt) {
    if (GN && kt >= 8) {
      const int g = (kt - 8) >> 2;
#pragma unroll
      for (int i = 0; i < 4; ++i) {
        const float sc = g ? gs[i][1] : gs[i][0];
#pragma unroll
        for (int jj = 0; jj < 4; ++jj) ra[i][jj] = pack2(lo2f(ra[i][jj]) * sc, hi2f(ra[i][jj]) * sc);
      }
    }
    bf16_t* As = S0 + (kt & 1) * GBUF;
    bf16_t* Bs = As + 128 * GST;
#pragma unroll
    for (int i = 0; i < 4; ++i) {
      *(u32x4*)(As + (sr + 32 * i) * GST + sp * 8) = ra[i];
      *(u32x4*)(Bs + (sr + 32 * i) * GST + sp * 8) = rb[i];
    }
  };
  const int KT = K / 64;
  swrite(0);
  if (KT > 1) gload(64);
  __syncthreads();
  for (int kt = 0; kt < KT; ++kt) {
    const bf16_t* As = S0 + (kt & 1) * GBUF;
    const bf16_t* Bs = As + 128 * GST;
#pragma unroll
    for (int ks = 0; ks < 2; ++ks) {
      bf16x8 af[4], bfr[4];
#pragma unroll
      for (int m = 0; m < 4; ++m) af[m] = *(const bf16x8*)(As + (wr * 64 + m * 16 + fr) * GST + ks * 32 + fq * 8);
#pragma unroll
      for (int n = 0; n < 4; ++n) bfr[n] = *(const bf16x8*)(Bs + (wc * 64 + n * 16 + fr) * GST + ks * 32 + fq * 8);
#pragma unroll
      for (int m = 0; m < 4; ++m)
#pragma unroll
        for (int n = 0; n < 4; ++n) acc[m][n] = MFMA16(bfr[n], af[m], acc[m][n]);
      if (ks == 0 && kt + 1 < KT) {
        swrite(kt + 1);
        if (kt + 2 < KT) gload((kt + 2) * 64);
      }
    }
    __syncthreads();
  }
  float rsc[4];
#pragma unroll
  for (int m = 0; m < 4; ++m) rsc[m] = epi.scale(row0 + wr * 64 + m * 16 + fr);
#pragma unroll
  for (int m = 0; m < 4; ++m)
#pragma unroll
    for (int n = 0; n < 4; ++n) epi(row0 + wr * 64 + m * 16 + fr, col0 + wc * 64 + n * 16 + fq * 4, acc[m][n], rsc[m]);
}

template <class Epi>
DI void gemm_tile_glds(const bf16_t* __restrict__ A, int lda, const bf16_t* __restrict__ Bt, int ldb, int K, int row0, int col0, char* smem, Epi epi) {
  const int tid = ltid(), wid = tid >> 6, lane = tid & 63, wr = wid >> 1, wc = wid & 1, fr = lane & 15, fq = lane >> 4;
  f32x4 acc[4][4];
#pragma unroll
  for (int m = 0; m < 4; ++m)
#pragma unroll
    for (int n = 0; n < 4; ++n) acc[m][n] = f32x4{0.f, 0.f, 0.f, 0.f};
  const int crow = tid >> 3, cslot = tid & 7, cpart = cslot ^ (crow & 7);
  const bf16_t* ga = A + (size_t)(row0 + crow) * lda + cpart * 8;
  const bf16_t* gb = Bt + (size_t)(col0 + crow) * ldb + cpart * 8;
  auto issue = [&](int kt, int stage) {
    char* sa = smem + stage * 32768 + tid * 16;
#pragma unroll
    for (int i = 0; i < 4; ++i) {
      __builtin_amdgcn_global_load_lds((const unsigned*)(ga + (size_t)(32 * i) * lda + kt * 64), (__attribute__((address_space(3))) unsigned*)(sa + i * 4096), 16, 0, 0);
      __builtin_amdgcn_global_load_lds((const unsigned*)(gb + (size_t)(32 * i) * ldb + kt * 64), (__attribute__((address_space(3))) unsigned*)(sa + 16384 + i * 4096), 16, 0, 0);
    }
  };
  const int KT = K / 64;
  issue(0, 0);
  asm volatile("s_waitcnt vmcnt(0)" ::: "memory");
  __syncthreads();
  const int sw = fr & 7;
  for (int kt = 0; kt < KT; ++kt) {
    if (kt + 1 < KT) issue(kt + 1, (kt + 1) & 1);
    const char* As = smem + (kt & 1) * 32768;
    const char* Bs = As + 16384;
#pragma unroll
    for (int ks = 0; ks < 2; ++ks) {
      bf16x8 af[4], bfr[4];
      const int so = ((ks * 4 + fq) ^ sw) * 16;
#pragma unroll
      for (int m = 0; m < 4; ++m) af[m] = *(const bf16x8*)(As + (wr * 64 + m * 16 + fr) * 128 + so);
#pragma unroll
      for (int n = 0; n < 4; ++n) bfr[n] = *(const bf16x8*)(Bs + (wc * 64 + n * 16 + fr) * 128 + so);
#pragma unroll
      for (int m = 0; m < 4; ++m)
#pragma unroll
        for (int n = 0; n < 4; ++n) acc[m][n] = MFMA16(bfr[n], af[m], acc[m][n]);
    }
    asm volatile("s_waitcnt vmcnt(0)" ::: "memory");
    __syncthreads();
  }
#pragma unroll
  for (int m = 0; m < 4; ++m)
#pragma unroll
    for (int n = 0; n < 4; ++n) epi(row0 + wr * 64 + m * 16 + fr, col0 + wc * 64 + n * 16 + fq * 4, acc[m][n]);
}

constexpr int G8_HT = 128 * 64;
DI int g8_lds_byte(int r, int c) {
  int st = (r >> 4) * 2 + (c >> 5), rr = r & 15, cc = c & 31, ob = rr * 64 + cc * 2;
  return st * 1024 + (ob ^ (((ob >> 9) & 1) << 5));
}
DI void g8_stage_rc(int b, int& R, int& C) {
  int st = b / 1024, sb = b % 1024, swz = sb ^ (((sb >> 9) & 1) << 5);
  R = (st >> 1) * 16 + swz / 64; C = (st & 1) * 32 + (swz % 64) / 2;
}
template <class Epi>
DI void gemm8_tile(const bf16_t* __restrict__ A, int lda, const bf16_t* __restrict__ Bt, int ldb, int K, int brow, int bcol, char* smem, Epi epi) {
  bf16_t* shm = (bf16_t*)smem;
  const int tid = ltid512();
#define G8_SA(b, h) (shm + ((b) * 2 + (h)) * G8_HT)
#define G8_SB(b, h) (shm + (4 + (b) * 2 + (h)) * G8_HT)
#define G8_STAGE(P, BASE, LD, br, kt) do { const bf16_t* _g = (BASE) + (size_t)(br) * (LD) + (size_t)(kt) * 64; \
    _Pragma("unroll") for (int _i = 0; _i < 2; ++_i) { int _b = tid * 16 + _i * 8192; int _r, _c; g8_stage_rc(_b, _r, _c); \
      __builtin_amdgcn_global_load_lds((const unsigned*)(_g + (size_t)_r * (LD) + _c), \
        (__attribute__((address_space(3))) unsigned*)((char*)(P) + _b), 16, 0, 0); } } while (0)
#define G8_LDA(dst, b, h) _Pragma("unroll") for (int m = 0; m < 4; ++m) _Pragma("unroll") for (int k = 0; k < 2; ++k) \
    dst[m][k] = *reinterpret_cast<const bf16x8*>((char*)G8_SA(b, h) + g8_lds_byte(wr * 64 + m * 16 + fr, k * 32 + fq * 8))
#define G8_LDB(dst, b, h) _Pragma("unroll") for (int n = 0; n < 2; ++n) _Pragma("unroll") for (int k = 0; k < 2; ++k) \
    dst[n][k] = *reinterpret_cast<const bf16x8*>((char*)G8_SB(b, h) + g8_lds_byte(wc * 32 + n * 16 + fr, k * 32 + fq * 8))
#define G8_MMA(ai, bj, At, Bx) do { __builtin_amdgcn_s_setprio(1); \
    _Pragma("unroll") for (int m = 0; m < 4; ++m) _Pragma("unroll") for (int n = 0; n < 2; ++n) _Pragma("unroll") for (int k = 0; k < 2; ++k) \
      acc[ai][bj][m][n] = __builtin_amdgcn_mfma_f32_16x16x32_bf16(Bx[n][k], At[m][k], acc[ai][bj][m][n], 0, 0, 0); \
    __builtin_amdgcn_s_setprio(0); } while (0)
#define G8_WAIT_V(n) asm volatile("s_waitcnt vmcnt(" #n ")" ::: "memory")
#define G8_WAIT_L(n) asm volatile("s_waitcnt lgkmcnt(" #n ")" ::: "memory")
#define G8_BAR __builtin_amdgcn_s_barrier()
#define G8_SCHED __builtin_amdgcn_sched_barrier(0)
  const int wid = tid >> 6, lane = tid & 63, wr = wid >> 2, wc = wid & 3, fr = lane & 15, fq = lane >> 4;
  f32x4 acc[2][2][4][2];
#pragma unroll
  for (int a = 0; a < 2; ++a)
#pragma unroll
    for (int b = 0; b < 2; ++b)
#pragma unroll
      for (int m = 0; m < 4; ++m)
#pragma unroll
        for (int n = 0; n < 2; ++n) acc[a][b][m][n] = f32x4{0.f, 0.f, 0.f, 0.f};
  bf16x8 At[4][2], B0[2][2], B1[2][2];
  const int nt = K / 64;
  G8_STAGE(G8_SB(0, 0), Bt, ldb, bcol, 0); G8_STAGE(G8_SA(0, 0), A, lda, brow, 0);
  G8_STAGE(G8_SB(0, 1), Bt, ldb, bcol + 128, 0); G8_STAGE(G8_SA(0, 1), A, lda, brow + 128, 0);
  if (wr == 1) G8_BAR;
  G8_WAIT_V(4); G8_BAR;
  G8_STAGE(G8_SB(1, 0), Bt, ldb, bcol, 1); G8_STAGE(G8_SA(1, 0), A, lda, brow, 1); G8_STAGE(G8_SB(1, 1), Bt, ldb, bcol + 128, 1);
  G8_WAIT_V(6); G8_BAR;
  for (int t = 0; t < nt - 2; t += 2) {
    G8_LDB(B0, 0, 0); G8_SCHED; G8_LDA(At, 0, 0); G8_STAGE(G8_SA(1, 1), A, lda, brow + 128, t + 1);
    G8_WAIT_L(8); G8_BAR; G8_WAIT_L(0); G8_MMA(0, 0, At, B0); G8_BAR; G8_SCHED;
    G8_LDB(B1, 0, 1); G8_STAGE(G8_SB(0, 0), Bt, ldb, bcol, t + 2);
    G8_BAR; G8_WAIT_L(0); G8_MMA(0, 1, At, B1); G8_BAR;
    G8_LDA(At, 0, 1); G8_STAGE(G8_SA(0, 0), A, lda, brow, t + 2);
    G8_BAR; G8_WAIT_L(0); G8_MMA(1, 0, At, B0); G8_BAR; G8_SCHED;
    G8_STAGE(G8_SB(0, 1), Bt, ldb, bcol + 128, t + 2);
    G8_WAIT_V(6); G8_BAR; G8_MMA(1, 1, At, B1); G8_BAR;
    G8_LDB(B0, 1, 0); G8_SCHED; G8_LDA(At, 1, 0); G8_STAGE(G8_SA(0, 1), A, lda, brow + 128, t + 2);
    G8_WAIT_L(8); G8_BAR; G8_WAIT_L(0); G8_MMA(0, 0, At, B0); G8_BAR; G8_SCHED;
    G8_LDB(B1, 1, 1); G8_STAGE(G8_SB(1, 0), Bt, ldb, bcol, t + 3);
    G8_BAR; G8_WAIT_L(0); G8_MMA(0, 1, At, B1); G8_BAR;
    G8_LDA(At, 1, 1); G8_STAGE(G8_SA(1, 0), A, lda, brow, t + 3);
    G8_BAR; G8_WAIT_L(0); G8_MMA(1, 0, At, B0); G8_BAR; G8_SCHED;
    G8_STAGE(G8_SB(1, 1), Bt, ldb, bcol + 128, t + 3);
    G8_WAIT_V(6); G8_BAR; G8_MMA(1, 1, At, B1); G8_BAR;
  }
  { G8_LDB(B0, 0, 0); G8_LDA(At, 0, 0); G8_STAGE(G8_SA(1, 1), A, lda, brow + 128, nt - 1);
    G8_BAR; G8_WAIT_L(0); G8_MMA(0, 0, At, B0); G8_BAR;
    G8_LDB(B1, 0, 1); G8_BAR; G8_WAIT_L(0); G8_MMA(0, 1, At, B1); G8_BAR;
    G8_LDA(At, 0, 1); G8_WAIT_V(4); G8_BAR; G8_WAIT_L(0); G8_MMA(1, 0, At, B0); G8_MMA(1, 1, At, B1); G8_BAR; }
  { G8_LDB(B0, 1, 0); G8_LDA(At, 1, 0); G8_WAIT_V(2); G8_BAR; G8_WAIT_L(0); G8_MMA(0, 0, At, B0); G8_BAR;
    G8_LDB(B1, 1, 1); G8_WAIT_V(0); G8_BAR; G8_WAIT_L(0); G8_MMA(0, 1, At, B1); G8_BAR;
    G8_LDA(At, 1, 1); G8_BAR; G8_WAIT_L(0); G8_MMA(1, 0, At, B0); G8_MMA(1, 1, At, B1); G8_BAR; }
  if (wr == 0) G8_BAR;
  const bool odd = fq & 1;
#pragma unroll
  for (int ai = 0; ai < 2; ++ai)
#pragma unroll
    for (int bj = 0; bj < 2; ++bj)
#pragma unroll
      for (int m = 0; m < 4; ++m) {
        const int row = brow + ai * 128 + wr * 64 + m * 16 + fr, cb = bcol + bj * 128 + wc * 32;
        epi.side(row, cb + fq * 4, acc[ai][bj][m][0]);
        epi.side(row, cb + 16 + fq * 4, acc[ai][bj][m][1]);
        const u32x2 p0 = epi.pack(acc[ai][bj][m][0]), p1 = epi.pack(acc[ai][bj][m][1]);
        const u32x2 snd = odd ? p0 : p1;
        u32x2 rcv; rcv[0] = (unsigned)__shfl_xor((int)snd[0], 16); rcv[1] = (unsigned)__shfl_xor((int)snd[1], 16);
        u32x4 o;
        if (odd) { o[0] = rcv[0]; o[1] = rcv[1]; o[2] = p1[0]; o[3] = p1[1]; }
        else     { o[0] = p0[0]; o[1] = p0[1]; o[2] = rcv[0]; o[3] = rcv[1]; }
        epi.store16(row, odd ? cb + 16 + (fq - 1) * 4 : cb + fq * 4, o);
      }
  __syncthreads();
}

struct EpiBF {
  bf16_t* out; int ldo;
  DI void side(int, int, const f32x4&) const {}
  DI u32x2 pack(const f32x4& a) const { u32x2 o; o[0] = pack2(a[0], a[1]); o[1] = pack2(a[2], a[3]); return o; }
  DI void store16(int row, int col, const u32x4& v) const { *(u32x4*)(out + (size_t)row * ldo + col) = v; }
  DI float scale(int) const { return 1.f; }
  DI void operator()(int row, int col, const f32x4& a, float) const { (*this)(row, col, a); }
  DI void operator()(int row, int col, const f32x4& a) const {
    u32x2 o; o[0] = pack2(a[0], a[1]); o[1] = pack2(a[2], a[3]);
    *(u32x2*)(out + (size_t)row * ldo + col) = o;
  }
};
struct EpiRelu2 {
  bf16_t* out; int ldo;
  DI void side(int, int, const f32x4&) const {}
  DI u32x2 pack(const f32x4& a) const {
    float r0 = fmaxf(a[0], 0.f), r1 = fmaxf(a[1], 0.f), r2 = fmaxf(a[2], 0.f), r3 = fmaxf(a[3], 0.f);
    u32x2 o; o[0] = pack2(r0 * r0, r1 * r1); o[1] = pack2(r2 * r2, r3 * r3); return o;
  }
  DI void store16(int row, int col, const u32x4& v) const { *(u32x4*)(out + (size_t)row * ldo + col) = v; }
  DI void operator()(int row, int col, const f32x4& a) const {
    float r0 = fmaxf(a[0], 0.f), r1 = fmaxf(a[1], 0.f), r2 = fmaxf(a[2], 0.f), r3 = fmaxf(a[3], 0.f);
    u32x2 o; o[0] = pack2(r0 * r0, r1 * r1); o[1] = pack2(r2 * r2, r3 * r3);
    *(u32x2*)(out + (size_t)row * ldo + col) = o;
  }
};
struct EpiU {
  bf16_t* u; float* dt;
  DI void side(int row, int col, const f32x4& a) const { if (col >= U_DT && col < DIN) *(float4*)(dt + (size_t)row * 16 + col - U_DT) = make_float4(a[0], a[1], a[2], a[3]); }
  DI u32x2 pack(const f32x4& a) const { u32x2 o; o[0] = pack2(a[0], a[1]); o[1] = pack2(a[2], a[3]); return o; }
  DI void store16(int row, int col, const u32x4& v) const { if (col < DIN) *(u32x4*)(u + (size_t)row * DIN + col) = v; }
  DI void operator()(int row, int col, const f32x4& a) const {
    if (col < DIN) {
      u32x2 o; o[0] = pack2(a[0], a[1]); o[1] = pack2(a[2], a[3]);
      *(u32x2*)(u + (size_t)row * DIN + col) = o;
      if (col >= U_DT) *(float4*)(dt + (size_t)row * 16 + col - U_DT) = make_float4(a[0], a[1], a[2], a[3]);
    }
  }
};
struct EpiQ {
  bf16_t* q; const float* rs;
  DI float scale(int row) const { return rs[row * 2]; }
  DI void operator()(int row, int col, const f32x4& a, float r) const {
    u32x2 o; o[0] = pack2(a[0] * r, a[1] * r); o[1] = pack2(a[2] * r, a[3] * r);
    *(u32x2*)(q + (size_t)row * 384 + col) = o;
  }
};
struct EpiKV {
  bf16_t* kb; bf16_t* vt; const float* rs;
  DI float scale(int row) const { return rs[row * 2 + 1]; }
  DI void operator()(int row, int col, const f32x4& a, float r) const {
    int b, pos;
    if (row < ML) { b = row >> 12; pos = (row & 4095) + CTX; } else { int rr = row - ML; b = rr >> 8; pos = rr & 255; }
    const int head = col >> 7, d = col & 127;
    if (d < 64) {
      u32x2 o; o[0] = pack2(a[0] * r, a[1] * r); o[1] = pack2(a[2] * r, a[3] * r);
      *(u32x2*)(kb + ((size_t)(b * 4 + head) * LK + pos) * 96 + d) = o;
    } else {
#pragma unroll
      for (int j = 0; j < 4; ++j) vt[((size_t)(b * 4 + head) * 64 + (d - 64 + j)) * LK + pos] = f2bf(a[j] * r);
    }
  }
};

struct EpiPart {
  float* part;
  DI void operator()(int row, int col, const f32x4& a) const {
    *(float4*)(part + (size_t)(row - ML) * DM + col) = make_float4(a[0], a[1], a[2], a[3]);
  }
};
DI void phase_inproj(const Params& p, int layer, int bid, int nb, char* smem) {
  EpiU epi{(bf16_t*)(p.ws + OFF_U), (float*)(p.ws + OFF_DT)};
  const int x = bid & 7, per = nb >> 3;
  for (int rep = 0; rep < REP_GEMM; ++rep)
  for (int q = bid >> 3; q < 85; q += per) {
    const int m = (x >> 1) * 17 + q / 5, n = 5 * (x & 1) + q % 5;
    gemm8_tile((const bf16_t*)(p.ws + OFF_H), DM, wt_ptr(p, layer, WT_IN), 1024, 1024, m * 256, n * 256, smem, epi);
  }
}
DI void phase_wout(const Params& p, int layer, int lid, int nvb, char* smem) {
  const int M = layer == 0 ? MT : ML;
  EpiBF epi{(bf16_t*)(p.ws + OFF_U), DM};
  const int x = lid & 7, per = nvb >> 3;
  for (int rep = 0; rep < REP_GEMM; ++rep)
  for (int q = lid >> 3; q < M / 128; q += per)
    gemm_tile<true>((const bf16_t*)(p.ws + OFF_H), DM, wt_ptr(p, layer, WT_OUT), 1024, ((q >> 3) * 8 + x) * 128, (q & 7) * 128, smem, epi, (const float*)(p.ws + OFF_SSQ));
}
DI void phase_ff1(const Params& p, int layer, int bid, int nb, int vbid, int nvb, char* smem, char* smem_half) {
  EpiRelu2 epi{(bf16_t*)(p.ws + OFF_F1), DFF};
  const int x = bid & 7, per = nb >> 3;
  for (int rep = 0; rep < REP_GEMM; ++rep) {
    for (int q = bid >> 3; q < 128; q += per) {
      const int m = (x >> 2) * 32 + (q >> 2), n = 4 * (x & 3) + (q & 3);
      gemm8_tile((const bf16_t*)(p.ws + OFF_H), DM, wt_ptr(p, layer, WT_FF1), 1024, 1024, m * 256, n * 256, smem, epi);
    }
    if (layer == 0)
      for (int it = vbid; it < (MC / 128) * 32; it += nvb)
        gemm_tile_glds((const bf16_t*)(p.ws + OFF_H), DM, wt_ptr(p, layer, WT_FF1), 1024, 1024, ML + (it / 32) * 128, (it % 32) * 128, smem_half, epi);
  }
}
DI void phase_ff2(const Params& p, int layer, int bid, int nb, int vbid, int nvb, char* smem, char* smem_half) {
  EpiBF epi{(bf16_t*)(p.ws + OFF_H), DM};
  const int x = bid & 7, per = nb >> 3;
  for (int rep = 0; rep < REP_GEMM; ++rep) {
    for (int q = bid >> 3; q < 32; q += per) {
      const int T = x * 32 + q;
      gemm8_tile((const bf16_t*)(p.ws + OFF_F1), DFF, wt_ptr(p, layer, WT_FF2), 4096, 4096, (T >> 2) * 256, (T & 3) * 256, smem, epi);
    }
    if (layer == 0)
      for (int it = vbid; it < (MC / 128) * 8 * 4; it += nvb) {
        const int tile = it >> 2, ks = it & 3;
        EpiPart ep{(float*)(p.ws + OFF_END2) + (size_t)ks * MC * DM};
        gemm_tile_glds((const bf16_t*)(p.ws + OFF_F1) + ks * 1024, DFF, wt_ptr(p, layer, WT_FF2) + ks * 1024, 4096, 1024, ML + (tile >> 3) * 128, (tile & 7) * 128, smem_half, ep);
      }
  }
}

DI int chunk_row0(int b, int tc) { return tc < 2 ? ML + b * CTX + tc * 128 : b * SEQ + (tc - 2) * 128; }
constexpr int BST = 72;
constexpr int TST = 136;
DI void load_tile_T(bf16_t* dst, const bf16_t* __restrict__ src, int ldg) {
  const int tid = ltid();
#pragma unroll
  for (int i = 0; i < 4; ++i) {
    int c = tid + 256 * i, tok = c & 127, pc = c >> 7;
    u32x4 v = *(const u32x4*)(src + (size_t)tok * ldg + pc * 8);
#pragma unroll
    for (int j = 0; j < 4; ++j) {
      dst[(pc * 8 + 2 * j) * TST + tok] = (bf16_t)(v[j] & 0xffffu);
      dst[(pc * 8 + 2 * j + 1) * TST + tok] = (bf16_t)(v[j] >> 16);
    }
  }
}
DI void chunk_scan(const Params& p, int layer, int row0, int h, float* csf, float* csb, float* dtF, float* dtB, float* tot, float*  ) {
  const int tid = ltid(), w = tid >> 6, lane = tid & 63;
  const float* DT = (const float*)(p.ws + OFF_DT);
  float v;
  if (tid < 128) {
    const float dt = DT[(size_t)(row0 + tid) * 16 + h];
    v = dt * -__expf(p.a_log[layer * 16 + h]);
    dtF[tid] = dt;
  } else {
    const int e = 255 - tid;
    const float dt = DT[(size_t)(row0 + e) * 16 + 8 + h];
    v = dt * -__expf(p.a_log[layer * 16 + 8 + h]);
    dtB[e] = dt;
  }
#pragma unroll
  for (int o = 1; o < 64; o <<= 1) { const float t = __shfl_up(v, o); if (lane >= o) v += t; }
  if (lane == 63) tot[w] = v;
  __syncthreads();
  if (w == 1) v += tot[0];
  if (w == 3) v += tot[2];
  if (tid < 128) csf[tid] = v; else csb[255 - tid] = v;
  __syncthreads();
}

DI void ssd_state_item(const Params& p, int layer, int b, int tc, int h, char* smem) {
  bf16_t* XT = (bf16_t*)smem;
  bf16_t* BT = XT + 64 * TST;
  float* csf = (float*)(BT + 64 * TST);
  float* csb = csf + 128; float* dtF = csb + 128; float* dtB = dtF + 128; float* laF = dtB + 128; float* laB = laF + 128;
  const int tid = ltid(), w = tid >> 6, lane = tid & 63, r = lane & 31, hh = lane >> 5;
  const int row0 = chunk_row0(b, tc);
  const bf16_t* XBC = (const bf16_t*)(p.ws + OFF_XBC);
  load_tile_T(XT, XBC + (size_t)row0 * 768 + h * 64, 768);
  load_tile_T(BT, XBC + (size_t)row0 * 768 + 512 + (h >> 2) * 64, 768);
  chunk_scan(p, layer, row0, h, csf, csb, dtF, dtB, laF, laB);
  __syncthreads();
  if (tid < 128) laF[tid] = dtF[tid] * __expf(csf[127] - csf[tid]);
  else { int t = tid - 128; laB[t] = dtB[t] * __expf(csb[0] - csb[t]); }
  __syncthreads();
  const int d = w >> 1, pt = w & 1;
  const float* wv = d == 0 ? laF : laB;
  f32x16 acc[2];
#pragma unroll
  for (int i = 0; i < 16; ++i) { acc[0][i] = 0.f; acc[1][i] = 0.f; }
#pragma unroll
  for (int s = 0; s < 8; ++s) {
    int l0 = 16 * s + 8 * hh;
    u32x4 xa = *(const u32x4*)(XT + (32 * pt + r) * TST + l0);
    u32x4 sa;
#pragma unroll
    for (int j = 0; j < 4; ++j) sa[j] = pack2(lo2f(xa[j]) * wv[l0 + 2 * j], hi2f(xa[j]) * wv[l0 + 2 * j + 1]);
    bf16x8 af = __builtin_bit_cast(bf16x8, sa);
#pragma unroll
    for (int nt = 0; nt < 2; ++nt) {
      bf16x8 bfr = *(const bf16x8*)(BT + (32 * nt + r) * TST + l0);
      acc[nt] = MFMA32(af, bfr, acc[nt]);
    }
  }
  bf16_t* S = (bf16_t*)(p.ws + OFF_SST) + ((((size_t)d * NB + b) * NCH + tc) * 8 + h) * 4096;
#pragma unroll
  for (int nt = 0; nt < 2; ++nt)
#pragma unroll
    for (int i = 0; i < 16; ++i) S[(32 * pt + crow(i, hh)) * 64 + 32 * nt + r] = f2bf(acc[nt][i]);
  if (tid == 0) {
    float* TD = (float*)(p.ws + OFF_TDEC);
    TD[((0 * NB + b) * NCH + tc) * 8 + h] = __expf(csf[127]);
    TD[((1 * NB + b) * NCH + tc) * 8 + h] = __expf(csb[0]);
  }
  __syncthreads();
}

DI void ssd_pass_item(const Params& p, int it) {
  const int e = it * 256 + ltid();
  const int pn2 = e & 2047, h = (e >> 11) & 7, b = (e >> 14) & 3, d = e >> 16;
  unsigned* S = (unsigned*)(p.ws + OFF_SST);
  const float* TD = (const float*)(p.ws + OFF_TDEC);
  unsigned sv[NCH]; float T[NCH];
#pragma unroll
  for (int i = 0; i < NCH; ++i) {
    int tc = d == 0 ? i : (i < 2 ? 1 - i : NCH + 1 - i);
    sv[i] = S[(((size_t)(d * NB + b) * NCH + tc) * 8 + h) * 2048 + pn2];
    T[i] = TD[((d * NB + b) * NCH + tc) * 8 + h];
  }
  float h0 = 0.f, h1 = 0.f;
#pragma unroll
  for (int i = 0; i < NCH; ++i) {
    int tc = d == 0 ? i : (i < 2 ? 1 - i : NCH + 1 - i);
    S[(((size_t)(d * NB + b) * NCH + tc) * 8 + h) * 2048 + pn2] = pack2(h0, h1);
    h0 = T[i] * h0 + lo2f(sv[i]); h1 = T[i] * h1 + hi2f(sv[i]);
  }
}

DI void ssd_out_item(const Params& p, int layer, int b, int tc, int h, char* smem) {
  bf16_t* XT = (bf16_t*)smem;
  bf16_t* Bs = XT + 64 * TST;
  float* csf = (float*)(Bs + 128 * BST);
  float* csb = csf + 128; float* dtF = csb + 128; float* dtB = dtF + 128; float* laF = dtB + 128; float* laB = laF + 128;
  const int tid = ltid(), w = tid >> 6, lane = tid & 63, r = lane & 31, hh = lane >> 5;
  const int row0 = chunk_row0(b, tc), g = h >> 2;
  const bf16_t* XBC = (const bf16_t*)(p.ws + OFF_XBC);
  load_tile_T(XT, XBC + (size_t)row0 * 768 + h * 64, 768);
#pragma unroll
  for (int i = 0; i < 4; ++i) {
    int c = tid + 256 * i, tok = c >> 3, part = c & 7;
    *(u32x4*)(Bs + tok * BST + part * 8) = *(const u32x4*)(XBC + (size_t)(row0 + tok) * 768 + 512 + g * 64 + part * 8);
  }
  const int l = 32 * w + r;
  bf16x8 cf[4];
#pragma unroll
  for (int ks = 0; ks < 4; ++ks) cf[ks] = *(const bf16x8*)(XBC + (size_t)(row0 + l) * 768 + 640 + g * 64 + 16 * ks + 8 * hh);
  chunk_scan(p, layer, row0, h, csf, csb, dtF, dtB, laF, laB);
  const float csf_l = csf[l], csb_l = csb[l];
  f32x16 yacc[2];
#pragma unroll
  for (int i = 0; i < 16; ++i) { yacc[0][i] = 0.f; yacc[1][i] = 0.f; }
#pragma unroll
  for (int st = 0; st < 4; ++st) {
    f32x16 gacc;
#pragma unroll
    for (int i = 0; i < 16; ++i) gacc[i] = 0.f;
#pragma unroll
    for (int ks = 0; ks < 4; ++ks) {
      bf16x8 af = *(const bf16x8*)(Bs + (32 * st + r) * BST + 16 * ks + 8 * hh);
      gacc = MFMA32(af, cf[ks], gacc);
    }
#pragma unroll
    for (int i = 0; i < 16; ++i) {
      int s = 32 * st + crow(i, hh);
      float f;
      if (s < l) f = __expf(csf_l - csf[s]) * dtF[s];
      else if (s > l) f = __expf(csb_l - csb[s]) * dtB[s];
      else f = dtF[s] + dtB[s];
      gacc[i] *= f;
    }
#pragma unroll
    for (int s2 = 0; s2 < 2; ++s2) {
      bf16x8 mf = pack8(gacc, s2);
      int sb = 32 * st + 16 * s2 + 4 * hh;
#pragma unroll
      for (int pt = 0; pt < 2; ++pt) {
        u32x2 lo = *(const u32x2*)(XT + (32 * pt + r) * TST + sb);
        u32x2 hi = *(const u32x2*)(XT + (32 * pt + r) * TST + sb + 8);
        u32x4 xa; xa[0] = lo[0]; xa[1] = lo[1]; xa[2] = hi[0]; xa[3] = hi[1];
        yacc[pt] = MFMA32(__builtin_bit_cast(bf16x8, xa), mf, yacc[pt]);
      }
    }
  }
#pragma unroll
  for (int d = 0; d < 2; ++d) {
    const bf16_t* Hs = (const bf16_t*)(p.ws + OFF_SST) + ((((size_t)d * NB + b) * NCH + tc) * 8 + h) * 4096;
    const float e = __expf(d == 0 ? csf_l : csb_l);
#pragma unroll
    for (int pt = 0; pt < 2; ++pt) {
      f32x16 t;
#pragma unroll
      for (int i = 0; i < 16; ++i) t[i] = 0.f;
#pragma unroll
      for (int ks = 0; ks < 4; ++ks) {
        bf16x8 af = *(const bf16x8*)(Hs + (32 * pt + r) * 64 + 16 * ks + 8 * hh);
        t = MFMA32(af, cf[ks], t);
      }
#pragma unroll
      for (int i = 0; i < 16; ++i) yacc[pt][i] += e * t[i];
    }
  }
  const int row = row0 + l;
  const float Dh = p.ssd_d[layer * 8 + h];
  const bf16_t* U = (const bf16_t*)(p.ws + OFF_U);
  bf16_t* YM = (bf16_t*)(p.ws + OFF_H);
  float ssq = 0.f;
  u32x2 xvv[2][4], zvv[2][4];
#pragma unroll
  for (int pt = 0; pt < 2; ++pt)
#pragma unroll
    for (int q = 0; q < 4; ++q) {
      const int pp = 32 * pt + 8 * q + 4 * hh;
      xvv[pt][q] = *(const u32x2*)(XBC + (size_t)row * 768 + h * 64 + pp);
      zvv[pt][q] = *(const u32x2*)(U + (size_t)row * DIN + U_Z + h * 64 + pp);
    }
#pragma unroll
  for (int pt = 0; pt < 2; ++pt)
#pragma unroll
    for (int q = 0; q < 4; ++q) {
      const int pp = 32 * pt + 8 * q + 4 * hh;
      const u32x2 xv = xvv[pt][q], zv = zvv[pt][q];
      float y0 = (yacc[pt][4 * q + 0] + Dh * lo2f(xv[0])) * silu_f(lo2f(zv[0]));
      float y1 = (yacc[pt][4 * q + 1] + Dh * hi2f(xv[0])) * silu_f(hi2f(zv[0]));
      float y2 = (yacc[pt][4 * q + 2] + Dh * lo2f(xv[1])) * silu_f(lo2f(zv[1]));
      float y3 = (yacc[pt][4 * q + 3] + Dh * hi2f(xv[1])) * silu_f(hi2f(zv[1]));
      u32x2 o; o[0] = pack2(y0, y1); o[1] = pack2(y2, y3);
      float r0 = lo2f(o[0]), r1 = hi2f(o[0]), r2 = lo2f(o[1]), r3 = hi2f(o[1]);
      ssq += r0 * r0 + r1 * r1 + r2 * r2 + r3 * r3;
      *(u32x2*)(YM + (size_t)row * DM + 512 + h * 64 + pp) = o;
    }
  ssq += __shfl_xor(ssq, 32);
  if (hh == 0) ((float*)(p.ws + OFF_SSQ))[(size_t)row * 8 + h] = ssq;
  __syncthreads();
}

constexpr int KST = 104;
constexpr int VST = 68;
DI void attn_item(const Params& p, int b, int head, int qrow0, int t0, bool lat, int nkeys, char* smem) {
  bf16_t* Ks = (bf16_t*)smem;
  bf16_t* Vs = Ks + 64 * KST;
  const int tid = ltid(), w = tid >> 6, lane = tid & 63, r = lane & 31, hh = lane >> 5;
  const bf16_t* QB = (const bf16_t*)(p.ws + OFF_QB);
  const bf16_t* KB = (const bf16_t*)(p.ws + OFF_KB) + (size_t)(b * 4 + head) * LK * 96;
  const bf16_t* VT = (const bf16_t*)(p.ws + OFF_VT) + (size_t)(b * 4 + head) * 64 * LK;
  const float qscale = 0.10206207261596575f * 1.4426950408889634f;
  const int qrow = qrow0 + w * 32 + r;
  const int t = t0 + w * 32 + r;
  bf16x8 qf[6];
  {
    const bf16_t* src = QB + (size_t)qrow * 384 + head * 96;
#pragma unroll
    for (int s = 0; s < 4; ++s) {
      u32x4 v = *(const u32x4*)(src + 16 * s + 8 * hh);
      u32x4 o;
#pragma unroll
      for (int j = 0; j < 4; ++j) o[j] = pack2(lo2f(v[j]) * qscale, hi2f(v[j]) * qscale);
      qf[s] = __builtin_bit_cast(bf16x8, o);
    }
#pragma unroll
    for (int s = 4; s < 6; ++s) {
      u32x4 va = *(const u32x4*)(src + 16 * s), vb = *(const u32x4*)(src + 16 * s + 8);
      float posf = s == 4 ? (float)(t >> 6) : (float)(t & 63);
      float o[8];
#pragma unroll
      for (int j = 0; j < 8; ++j) {
        float a = (j & 1) ? hi2f(va[j >> 1]) : lo2f(va[j >> 1]);
        float bb = (j & 1) ? hi2f(vb[j >> 1]) : lo2f(vb[j >> 1]);
        float res;
        if (lat) {
          float invf = exp2f(-(float)(2 * j) * (13.287712379549449f / 16.f));
          float rev = posf * invf * 0.15915494309189535f;
          float cs = __builtin_amdgcn_cosf(rev), sn = __builtin_amdgcn_sinf(rev);
          res = hh == 0 ? a * cs - bb * sn : bb * cs + a * sn;
        } else res = hh == 0 ? a : bb;
        o[j] = res * qscale;
      }
      u32x4 ov; ov[0] = pack2(o[0], o[1]); ov[1] = pack2(o[2], o[3]); ov[2] = pack2(o[4], o[5]); ov[3] = pack2(o[6], o[7]);
      qf[s] = __builtin_bit_cast(bf16x8, ov);
    }
  }
  f32x16 oacc[2];
#pragma unroll
  for (int i = 0; i < 16; ++i) { oacc[0][i] = 0.f; oacc[1][i] = 0.f; }
  float m = -1e30f, lsum = 0.f;
  u32x4 rk[3], rv[2];
  auto gload = [&](int key0) {
#pragma unroll
    for (int i = 0; i < 3; ++i) rk[i] = *(const u32x4*)(KB + (size_t)key0 * 96 + (tid + 256 * i) * 8);
#pragma unroll
    for (int i = 0; i < 2; ++i) { int c = tid + 256 * i; rv[i] = *(const u32x4*)(VT + (size_t)(c >> 3) * LK + key0 + (c & 7) * 8); }
  };
  gload(0);
  const int NT = nkeys / 64;
  for (int kt = 0; kt < NT; ++kt) {
#pragma unroll
    for (int i = 0; i < 3; ++i) { int c = tid + 256 * i; *(u32x4*)(Ks + (c / 12) * KST + (c % 12) * 8) = rk[i]; }
#pragma unroll
    for (int i = 0; i < 2; ++i) {
      int c = tid + 256 * i;
      bf16_t* d = Vs + (c >> 3) * VST + (c & 7) * 8;
      u32x2 a; a[0] = rv[i][0]; a[1] = rv[i][1];
      u32x2 bq; bq[0] = rv[i][2]; bq[1] = rv[i][3];
      *(u32x2*)d = a; *(u32x2*)(d + 4) = bq;
    }
    __syncthreads();
    if (kt + 1 < NT) gload((kt + 1) * 64);
    f32x16 sacc[2];
#pragma unroll
    for (int i = 0; i < 16; ++i) { sacc[0][i] = 0.f; sacc[1][i] = 0.f; }
#pragma unroll
    for (int s = 0; s < 6; ++s)
#pragma unroll
      for (int k2 = 0; k2 < 2; ++k2) {
        bf16x8 af = *(const bf16x8*)(Ks + (32 * k2 + r) * KST + 16 * s + 8 * hh);
        sacc[k2] = MFMA32(af, qf[s], sacc[k2]);
      }
    float mx = sacc[0][0];
#pragma unroll
    for (int i = 0; i < 16; ++i) { mx = fmaxf(mx, sacc[0][i]); mx = fmaxf(mx, sacc[1][i]); }
    mx = fmaxf(mx, __shfl_xor(mx, 32));
    const float mn = fmaxf(m, mx);
    const float alpha = __builtin_amdgcn_exp2f(m - mn);
    m = mn;
    float ps = 0.f;
#pragma unroll
    for (int i = 0; i < 16; ++i) {
      sacc[0][i] = __builtin_amdgcn_exp2f(sacc[0][i] - mn); sacc[1][i] = __builtin_amdgcn_exp2f(sacc[1][i] - mn);
      ps += sacc[0][i] + sacc[1][i];
    }
    lsum = lsum * alpha + ps;
#pragma unroll
    for (int i = 0; i < 16; ++i) { oacc[0][i] *= alpha; oacc[1][i] *= alpha; }
#pragma unroll
    for (int k2 = 0; k2 < 2; ++k2)
#pragma unroll
      for (int s2 = 0; s2 < 2; ++s2) {
        bf16x8 pf = pack8(sacc[k2], s2);
        int kb0 = 32 * k2 + 16 * s2 + 4 * hh;
#pragma unroll
        for (int d = 0; d < 2; ++d) {
          u32x2 lo = *(const u32x2*)(Vs + (32 * d + r) * VST + kb0);
          u32x2 hi = *(const u32x2*)(Vs + (32 * d + r) * VST + kb0 + 8);
          u32x4 va; va[0] = lo[0]; va[1] = lo[1]; va[2] = hi[0]; va[3] = hi[1];
          oacc[d] = MFMA32(__builtin_bit_cast(bf16x8, va), pf, oacc[d]);
        }
      }
    __syncthreads();
  }
  lsum += __shfl_xor(lsum, 32);
  const float inv = 1.f / lsum;
  bf16_t* YM = (bf16_t*)(p.ws + OFF_H) + (size_t)qrow * DM + head * 64;
#pragma unroll
  for (int d = 0; d < 2; ++d)
#pragma unroll
    for (int q = 0; q < 4; ++q) {
      u32x2 o; o[0] = pack2(oacc[d][4 * q] * inv, oacc[d][4 * q + 1] * inv); o[1] = pack2(oacc[d][4 * q + 2] * inv, oacc[d][4 * q + 3] * inv);
      *(u32x2*)(YM + 32 * d + 8 * q + 4 * hh) = o;
    }
}

DI void attn_item8(const Params& p, int b, int head, int qrow0, int t0, bool lat, int nkeys, char* smem) {
  bf16_t* Ks = (bf16_t*)smem;
  bf16_t* Vs = Ks + 64 * KST;
  const int tid = ltid512(), w = tid >> 6, lane = tid & 63, r = lane & 31, hh = lane >> 5;
  const bf16_t* QB = (const bf16_t*)(p.ws + OFF_QB);
  const bf16_t* KB = (const bf16_t*)(p.ws + OFF_KB) + (size_t)(b * 4 + head) * LK * 96;
  const bf16_t* VT = (const bf16_t*)(p.ws + OFF_VT) + (size_t)(b * 4 + head) * 64 * LK;
  const float qscale = 0.10206207261596575f * 1.4426950408889634f;
  const int qrow = qrow0 + w * 32 + r;
  const int t = t0 + w * 32 + r;
  bf16x8 qf[6];
  {
    const bf16_t* src = QB + (size_t)qrow * 384 + head * 96;
#pragma unroll
    for (int s = 0; s < 4; ++s) {
      u32x4 v = *(const u32x4*)(src + 16 * s + 8 * hh);
      u32x4 o;
#pragma unroll
      for (int j = 0; j < 4; ++j) o[j] = pack2(lo2f(v[j]) * qscale, hi2f(v[j]) * qscale);
      qf[s] = __builtin_bit_cast(bf16x8, o);
    }
#pragma unroll
    for (int s = 4; s < 6; ++s) {
      u32x4 va = *(const u32x4*)(src + 16 * s), vb = *(const u32x4*)(src + 16 * s + 8);
      float posf = s == 4 ? (float)(t >> 6) : (float)(t & 63);
      float o[8];
#pragma unroll
      for (int j = 0; j < 8; ++j) {
        float a = (j & 1) ? hi2f(va[j >> 1]) : lo2f(va[j >> 1]);
        float bb = (j & 1) ? hi2f(vb[j >> 1]) : lo2f(vb[j >> 1]);
        float res;
        if (lat) {
          float invf = exp2f(-(float)(2 * j) * (13.287712379549449f / 16.f));
          float rev = posf * invf * 0.15915494309189535f;
          float cs = __builtin_amdgcn_cosf(rev), sn = __builtin_amdgcn_sinf(rev);
          res = hh == 0 ? a * cs - bb * sn : bb * cs + a * sn;
        } else res = hh == 0 ? a : bb;
        o[j] = res * qscale;
      }
      u32x4 ov; ov[0] = pack2(o[0], o[1]); ov[1] = pack2(o[2], o[3]); ov[2] = pack2(o[4], o[5]); ov[3] = pack2(o[6], o[7]);
      qf[s] = __builtin_bit_cast(bf16x8, ov);
    }
  }
  f32x16 oacc[2];
#pragma unroll
  for (int i = 0; i < 16; ++i) { oacc[0][i] = 0.f; oacc[1][i] = 0.f; }
  float m = -1e30f, lsum = 0.f;
  u32x4 rk[3], rv[2];
  auto gload = [&](int key0) {
    rk[0] = *(const u32x4*)(KB + (size_t)key0 * 96 + tid * 8);
    if (tid < 256) rk[1] = *(const u32x4*)(KB + (size_t)key0 * 96 + (512 + tid) * 8);
    rv[0] = *(const u32x4*)(VT + (size_t)(tid >> 3) * LK + key0 + (tid & 7) * 8);
  };
  gload(0);
  const int NT = nkeys / 64;
  for (int kt = 0; kt < NT; ++kt) {
    *(u32x4*)(Ks + (tid / 12) * KST + (tid % 12) * 8) = rk[0];
    if (tid < 256) { const int c = 512 + tid; *(u32x4*)(Ks + (c / 12) * KST + (c % 12) * 8) = rk[1]; }
    {
      bf16_t* d = Vs + (tid >> 3) * VST + (tid & 7) * 8;
      u32x2 a; a[0] = rv[0][0]; a[1] = rv[0][1];
      u32x2 bq; bq[0] = rv[0][2]; bq[1] = rv[0][3];
      *(u32x2*)d = a; *(u32x2*)(d + 4) = bq;
    }
    __syncthreads();
    if (kt + 1 < NT) gload((kt + 1) * 64);
    f32x16 sacc[2];
#pragma unroll
    for (int i = 0; i < 16; ++i) { sacc[0][i] = 0.f; sacc[1][i] = 0.f; }
#pragma unroll
    for (int s = 0; s < 6; ++s)
#pragma unroll
      for (int k2 = 0; k2 < 2; ++k2) {
        bf16x8 af = *(const bf16x8*)(Ks + (32 * k2 + r) * KST + 16 * s + 8 * hh);
        sacc[k2] = MFMA32(af, qf[s], sacc[k2]);
      }
    float mx = sacc[0][0];
#pragma unroll
    for (int i = 0; i < 16; ++i) { mx = fmaxf(mx, sacc[0][i]); mx = fmaxf(mx, sacc[1][i]); }
    mx = fmaxf(mx, __shfl_xor(mx, 32));
    const float mn = fmaxf(m, mx);
    const float alpha = __builtin_amdgcn_exp2f(m - mn);
    m = mn;
    float ps = 0.f;
#pragma unroll
    for (int i = 0; i < 16; ++i) {
      sacc[0][i] = __builtin_amdgcn_exp2f(sacc[0][i] - mn); sacc[1][i] = __builtin_amdgcn_exp2f(sacc[1][i] - mn);
      ps += sacc[0][i] + sacc[1][i];
    }
    lsum = lsum * alpha + ps;
#pragma unroll
    for (int i = 0; i < 16; ++i) { oacc[0][i] *= alpha; oacc[1][i] *= alpha; }
#pragma unroll
    for (int k2 = 0; k2 < 2; ++k2)
#pragma unroll
      for (int s2 = 0; s2 < 2; ++s2) {
        bf16x8 pf = pack8(sacc[k2], s2);
        int kb0 = 32 * k2 + 16 * s2 + 4 * hh;
#pragma unroll
        for (int d = 0; d < 2; ++d) {
          u32x2 lo = *(const u32x2*)(Vs + (32 * d + r) * VST + kb0);
          u32x2 hi = *(const u32x2*)(Vs + (32 * d + r) * VST + kb0 + 8);
          u32x4 va; va[0] = lo[0]; va[1] = lo[1]; va[2] = hi[0]; va[3] = hi[1];
          oacc[d] = MFMA32(__builtin_bit_cast(bf16x8, va), pf, oacc[d]);
        }
      }
    __syncthreads();
  }
  lsum += __shfl_xor(lsum, 32);
  const float inv = 1.f / lsum;
  bf16_t* YM = (bf16_t*)(p.ws + OFF_H) + (size_t)qrow * DM + head * 64;
#pragma unroll
  for (int d = 0; d < 2; ++d)
#pragma unroll
    for (int q = 0; q < 4; ++q) {
      u32x2 o; o[0] = pack2(oacc[d][4 * q] * inv, oacc[d][4 * q + 1] * inv); o[1] = pack2(oacc[d][4 * q + 2] * inv, oacc[d][4 * q + 3] * inv);
      *(u32x2*)(YM + 32 * d + 8 * q + 4 * hh) = o;
    }
}

DI void phase_qkv(const Params& p, int layer, int bid, int nb, char* smem) {
  const int MQ = layer == 0 ? MT : ML;
  const int nq = (MQ / 128) * 3, nkv = (MT / 128) * 4, nst = NB * NCH * 8;
  const float* RS = (const float*)(p.ws + OFF_RSTD);
  EpiQ eq{(bf16_t*)(p.ws + OFF_QB), RS};
  EpiKV ekv{(bf16_t*)(p.ws + OFF_KB), (bf16_t*)(p.ws + OFF_VT), RS};
  const bf16_t* U = (const bf16_t*)(p.ws + OFF_U);
  for (int it = bid; it < nq + nkv + nst; it += nb) {
    if (it < nq) gemm_tile<false>(U, DIN, wt_ptr(p, layer, WT_UQ), 256, (it / 3) * 128, (it % 3) * 128, smem, eq);
    else if (it < nq + nkv) { int j = it - nq; gemm_tile<false>(U + U_CKV, DIN, wt_ptr(p, layer, WT_UKV), 128, (j / 4) * 128, (j % 4) * 128, smem, ekv); }
    else { int j = it - nq - nkv; for (int rep = 0; rep < REP_SSD; ++rep) ssd_state_item(p, layer, j / (NCH * 8), (j / 8) % NCH, j & 7, smem); }
  }
}
DI void phase_att(const Params& p, int layer, int bid, int nb, int vbid, int nvb, char* smem, char* sh) {
  for (int it = bid; it < 256; it += nb) {
    const int x = it & 7, j = it >> 3, bh = 2 * x + (j >> 4), qb = j & 15, b = bh >> 2, head = bh & 3;
    for (int rep = 0; rep < REP_ATT; ++rep) attn_item8(p, b, head, b * SEQ + qb * 256, qb * 256, true, LK, smem);
  }
  const int nctx = layer == 0 ? 32 : 0, npass = 512;
  for (int it = vbid; it < nctx + npass; it += nvb) {
    if (it < nctx) { int b = it >> 3, head = (it >> 1) & 3, qb = it & 1; attn_item(p, b, head, ML + b * CTX + qb * 128, qb * 128, false, CTX, sh); }
    else ssd_pass_item(p, it - nctx);
  }
}
DI void phase_ssdout(const Params& p, int layer, int bid, int nb, char* smem) {
  for (int it = bid; it < NB * NCH * 8; it += nb) {
    int b = it / (NCH * 8), tc = (it / 8) % NCH, h = it & 7;
    if (layer == 1 && tc < 2) continue;
    for (int rep = 0; rep < REP_SSD; ++rep) ssd_out_item(p, layer, b, tc, h, smem);
  }
}


#define XB_TMO      128
#define XB_XCNT(j)  (256  + 64 * (j))
#define XB_XSUB(j)  (1280 + 64 * (j))
#define XB_XGEN(j)  (2304 + 64 * (j))
#define XB_TOP      3328
#define XB_TOPGEN   3392
#define XCD_BAR_WORDS 3456
#define XB_SPIN_CAP (1u << 22)
#define LAS __attribute__((address_space(3)))
DI unsigned xb_ld(unsigned* p) { return __hip_atomic_load(p, __ATOMIC_RELAXED, __HIP_MEMORY_SCOPE_AGENT); }
DI unsigned xb_add(unsigned* p, unsigned v) { return __hip_atomic_fetch_add(p, v, __ATOMIC_RELAXED, __HIP_MEMORY_SCOPE_AGENT); }
DI unsigned xb_xcc_id() { return (unsigned)__builtin_amdgcn_s_getreg((3 << 11) | 20) & 0xFu; }
#define XB_SPIN(cond, bar) do { unsigned _sp = 0; while (cond) { __builtin_amdgcn_s_sleep(1); \
    if ((++_sp & 255u) == 0u) { if (xb_ld(&(bar)[XB_TMO])) break; if (_sp > XB_SPIN_CAP) { atomicAdd(&(bar)[XB_TMO], 1u); break; } } } } while (0)
struct XcdBarrier { unsigned* bar; unsigned x; volatile LAS unsigned* st; };
DI XcdBarrier xcd_barrier_post(unsigned* bar, volatile LAS unsigned* st) {
  XcdBarrier b; b.bar = bar; b.x = xb_xcc_id(); b.st = st;
  if (threadIdx.x == 0) (void)xb_add(&bar[XB_XCNT(b.x)], 1u);
  return b;
}
DI void xcd_barrier_complete(unsigned* bar, unsigned x, unsigned& nloc, unsigned& nx) {
  const unsigned G = gridDim.x * gridDim.y * gridDim.z;
  unsigned sum, cnt, mine, sp = 0u;
  for (;;) {
    sum = 0u; cnt = 0u; mine = 0u;
#pragma unroll
    for (unsigned j = 0; j < 16; ++j) { const unsigned c = xb_ld(&bar[XB_XCNT(j)]); sum += c; cnt += (c > 0u) ? 1u : 0u; mine = (j == x) ? c : mine; }
    if (sum == G) break;
    __builtin_amdgcn_s_sleep(1);
    if ((++sp & 255u) == 0u) { if (xb_ld(&bar[XB_TMO])) break; if (sp > XB_SPIN_CAP) { atomicAdd(&bar[XB_TMO], 1u); break; } }
  }
  nloc = mine > 0u ? mine : 1u; nx = cnt > 0u ? cnt : 1u;
}
DI void xcd_barrier(const XcdBarrier& b) {
  asm volatile("s_waitcnt vmcnt(0)" ::: "memory");
  __syncthreads();
  if (threadIdx.x == 0) {
    unsigned* bar = b.bar;
    asm volatile("" : "+s"(bar));
    __builtin_amdgcn_s_waitcnt(0);
    unsigned nloc = b.st[0], nx = b.st[1];
    if (nloc == 0u) { xcd_barrier_complete(bar, b.x, nloc, nx); b.st[0] = nloc; b.st[1] = nx; }
    const unsigned old = xb_add(&bar[XB_XSUB(b.x)], 1u);
    const unsigned gen = old / nloc;
    if (old + 1u == (gen + 1u) * nloc) {
      __builtin_amdgcn_fence(__ATOMIC_RELEASE, "agent");
      asm volatile("s_waitcnt vmcnt(0)" ::: "memory");
      const unsigned og = xb_add(&bar[XB_TOP], 1u);
      const unsigned tg = og / nx;
      if (og + 1u == (tg + 1u) * nx) xb_add(&bar[XB_TOPGEN], 1u);
      else XB_SPIN(xb_ld(&bar[XB_TOPGEN]) == tg, bar);
      __builtin_amdgcn_fence(__ATOMIC_ACQUIRE, "agent");
      xb_add(&bar[XB_XGEN(b.x)], 1u);
      asm volatile("s_waitcnt vmcnt(0)" ::: "memory");
    } else {
      XB_SPIN(xb_ld(&bar[XB_XGEN(b.x)]) == gen, bar);
      __builtin_amdgcn_fence(__ATOMIC_ACQUIRE, "agent");
      asm volatile("s_waitcnt vmcnt(0)" ::: "memory");
    }
  }
  __syncthreads();
}

constexpr int SMEM_BYTES = 2 * GBUF * 2;
enum { PH_PREP0 = 0, PH_H0, PH_INPROJ, PH_PREP, PH_QKV, PH_ATT, PH_SSDOUT, PH_WOUT, PH_POSTMIX, PH_FF1, PH_FF2, PH_POSTFFN, PH_SSDNORM };

struct Ids { int bid, nb, vbid, nvb, lid; };
DI void run_phase(const Params& p, int ph, int layer, const Ids& id, char* smem, char* sh) {
  switch (ph) {
    case PH_PREP0: phase_prep0(p, id.vbid, id.nvb, sh); break;
    case PH_H0: phase_h0(p, id.vbid, id.nvb); break;
    case PH_INPROJ: phase_inproj(p, layer, id.bid, id.nb, smem); break;
    case PH_PREP: phase_prep(p, layer, id.vbid, id.nvb); break;
    case PH_QKV: phase_qkv(p, layer, id.vbid, id.nvb, sh); break;
    case PH_ATT: phase_att(p, layer, id.bid, id.nb, id.vbid, id.nvb, smem, sh); break;
    case PH_SSDOUT: phase_ssdout(p, layer, id.vbid, id.nvb, sh); break;
    case PH_WOUT: phase_wout(p, layer, id.lid, id.nvb, sh); break;
    case PH_POSTMIX: phase_postmix(p, layer, id.vbid, id.nvb); break;
    case PH_FF1: phase_ff1(p, layer, id.bid, id.nb, id.vbid, id.nvb, smem, sh); break;
    case PH_FF2: phase_ff2(p, layer, id.bid, id.nb, id.vbid, id.nvb, smem, sh); break;
    case PH_POSTFFN: phase_postffn(p, layer, id.vbid, id.nvb); break;
  }
}

__global__ void __launch_bounds__(512) mega_kernel(Params p) {
  extern __shared__ __attribute__((aligned(16))) char smem[];
  cg::grid_group grid = cg::this_grid();
  if (p.ws == nullptr) grid.sync();
  const int half = __builtin_amdgcn_readfirstlane((int)(threadIdx.x >> 8));
  Ids id;
  id.bid = blockIdx.x; id.nb = gridDim.x;
  id.vbid = 2 * id.bid + half; id.nvb = 2 * id.nb;
  id.lid = (id.bid & 7) + 8 * (2 * (id.bid >> 3) + half);
  char* sh = smem + half * SMEM_BYTES;
  volatile LAS unsigned* st = (volatile LAS unsigned*)(smem + 2 * SMEM_BYTES - 16);
  if (threadIdx.x == 0) { st[0] = 0u; st[1] = 0u; st[2] = 0u; st[3] = 0u; }
  __syncthreads();
  XcdBarrier xb = xcd_barrier_post((unsigned*)(p.ws + OFF_BAR), st);
  for (int step = 0; step < 22; ++step) {
    int ph, layer;
    if (step < 2) { ph = step; layer = 0; }
    else { int j = step - 2; layer = j / 10; ph = PH_INPROJ + j % 10; }
    typedef const void* __attribute__((address_space(4))) * KArgs;
    KArgs ka = (KArgs)__builtin_amdgcn_kernarg_segment_ptr();
    asm volatile("" : "+s"(ka));
    Params q;
    {
      const void** dst = (const void**)&q;
#pragma unroll
      for (int i = 0; i < 27; ++i) dst[i] = ka[i];
    }
    run_phase(q, ph, layer, id, smem, sh);
    if (step < 21) xcd_barrier(xb);
  }
}

extern "C" void kernel_launch(void* const* d_in, const int* in_sizes, int n_in, void* d_out, int out_size, void* d_ws, size_t ws_size,
                              hipStream_t stream) {
  if (ws_size < WS_NEED) { fprintf(stderr, "workspace too small: %zu < %zu\n", ws_size, (size_t)WS_NEED); return; }
  Params p{};
  const float** f = (const float**)&p;
  for (int i = 0; i < 25; ++i) f[i] = (const float*)d_in[i];
  p.out = (float*)d_out;
  p.ws = (char*)d_ws;
  static int grid_blocks = 0;
  if (!grid_blocks) {
    int dev = 0, cus = 0, per_cu = 0;
    hipGetDevice(&dev);
    hipDeviceGetAttribute(&cus, hipDeviceAttributeMultiprocessorCount, dev);
    hipFuncSetAttribute((const void*)mega_kernel, hipFuncAttributeMaxDynamicSharedMemorySize, 2 * SMEM_BYTES);
    hipOccupancyMaxActiveBlocksPerMultiprocessor(&per_cu, mega_kernel, 512, 2 * SMEM_BYTES);
    if (per_cu > 1) per_cu = 1;
    grid_blocks = cus * per_cu;
  }
  hipMemsetAsync((char*)d_ws + OFF_BAR, 0, XCD_BAR_WORDS * 4, stream);
  void* args[] = {&p};
  hipError_t e = hipLaunchCooperativeKernel((void*)mega_kernel, dim3(grid_blocks), dim3(512), args, 2 * SMEM_BYTES, stream);
  if (e != hipSuccess) fprintf(stderr, "cooperative launch failed: %s (grid %d)\n", hipGetErrorString(e), grid_blocks);
}
```

```cpp
#include <hip/hip_runtime.h>
#include <hip/hip_cooperative_groups.h>
#include <stdint.h>
#include <stdio.h>
namespace cg = cooperative_groups;

#ifndef MEGA
#define MEGA 1
#endif
#ifndef REP_GEMM
#define REP_GEMM 1
#endif
#ifndef REP_ATT
#define REP_ATT 1
#endif
#ifndef REP_SSD
#define REP_SSD 1
#endif

typedef unsigned short bf16_t;
using bf16x8 = __attribute__((ext_vector_type(8))) short;
using s16x4  = __attribute__((ext_vector_type(4))) short;
using f32x4  = __attribute__((ext_vector_type(4))) float;
using f32x16 = __attribute__((ext_vector_type(16))) float;
using u32x4  = __attribute__((ext_vector_type(4))) unsigned;
using u32x2  = __attribute__((ext_vector_type(2))) unsigned;
#define DI __device__ __forceinline__
#define MFMA32(a, b, c) __builtin_amdgcn_mfma_f32_32x32x16_bf16((a), (b), (c), 0, 0, 0)
#define MFMA16(a, b, c) __builtin_amdgcn_mfma_f32_16x16x32_bf16((a), (b), (c), 0, 0, 0)

constexpr int DM = 1024, NB = 4, SEQ = 4096, CTX = 256;
constexpr int ML = NB * SEQ;
constexpr int MC = NB * CTX;
constexpr int MT = ML + MC;
constexpr int DIN = 2480, DINP = 2560;
constexpr int LK = CTX + SEQ;
constexpr int DFF = 4096;
constexpr int NCH = 34;
constexpr float EPS = 1e-6f;
constexpr int U_CKV = 256, U_KR = 384, U_GB = 416, U_GC = 672, U_VAL = 928, U_Z = 1184, U_XBC = 1696, U_DT = 2464;

constexpr size_t AL(size_t x) { return (x + 255) & ~(size_t)255; }
constexpr size_t WT_IN = 0;
constexpr size_t WT_UQ = WT_IN + (size_t)DINP * 1024;
constexpr size_t WT_UKV = WT_UQ + (size_t)384 * 256;
constexpr size_t WT_OUT = WT_UKV + (size_t)512 * 128;
constexpr size_t WT_FF1 = WT_OUT + (size_t)1024 * 1024;
constexpr size_t WT_FF2 = WT_FF1 + (size_t)4096 * 1024;
constexpr size_t WT_ELEMS = WT_FF2 + (size_t)4096 * 1024;
constexpr size_t OFF_WT = 0;
constexpr size_t OFF_MOD = AL(OFF_WT + 2 * WT_ELEMS * 2);
constexpr size_t OFF_XC = AL(OFF_MOD + 2 * 5 * 6144 * 4);
constexpr size_t OFF_H = AL(OFF_XC + (size_t)MC * DM * 4);
constexpr size_t OFF_R1 = AL(OFF_H + (size_t)MT * DM * 2);
constexpr size_t OFF_U = OFF_R1;
constexpr size_t OFF_DT = AL(OFF_U + (size_t)MT * DIN * 2);
constexpr size_t OFF_RSTD = AL(OFF_DT + (size_t)MT * 16 * 4);
constexpr size_t OFF_QB = AL(OFF_RSTD + (size_t)MT * 2 * 4);
constexpr size_t OFF_KB = AL(OFF_QB + (size_t)MT * 384 * 2);
constexpr size_t OFF_VT = AL(OFF_KB + (size_t)NB * 4 * LK * 96 * 2);
constexpr size_t OFF_XBC = AL(OFF_VT + (size_t)NB * 4 * 64 * LK * 2);
constexpr size_t OFF_SST = AL(OFF_XBC + (size_t)MT * 768 * 2);
constexpr size_t OFF_TDEC = AL(OFF_SST + (size_t)2 * NB * NCH * 8 * 4096 * 2);
constexpr size_t OFF_SSQ = AL(OFF_TDEC + (size_t)2 * NB * NCH * 8 * 4);
constexpr size_t OFF_END1 = AL(OFF_SSQ + (size_t)MT * 8 * 4);
constexpr size_t OFF_F1 = OFF_R1;
constexpr size_t OFF_END2 = AL(OFF_F1 + (size_t)MT * DFF * 2);
constexpr size_t OFF_BAR = OFF_END1 > OFF_END2 ? OFF_END1 : OFF_END2;
constexpr size_t WS_NEED = OFF_BAR + 16384;

struct Params {
  const float *x, *c, *ctx, *c_ctx, *w_mod, *b_mod, *g_pre_mix, *w_in, *q_norm, *w_uq, *kv_norm, *w_ukv, *sc_w, *ssd_cw, *ssd_cb,
      *a_log, *dt_bias, *ssd_d, *ssd_norm, *w_out, *g_post_mix, *g_pre_ffn, *w_ff1, *w_ff2, *g_post_ffn;
  float* out;
  char* ws;
};

DI int ltid() { int t = threadIdx.x; asm volatile("" : "+v"(t)); return t & 255; }
DI int ltid512() { int t = threadIdx.x; asm volatile("" : "+v"(t)); return t; }
typedef __bf16 hbf2 __attribute__((ext_vector_type(2)));
typedef float hf2 __attribute__((ext_vector_type(2)));
DI bf16_t f2bf(float x) { return __builtin_bit_cast(bf16_t, (__bf16)x); }
DI float bf2f(unsigned v) { return __uint_as_float(v << 16); }
DI unsigned pack2(float a, float b) { hf2 v = {a, b}; return __builtin_bit_cast(unsigned, __builtin_convertvector(v, hbf2)); }
DI float lo2f(unsigned w) { return __uint_as_float(w << 16); }
DI float hi2f(unsigned w) { return __uint_as_float(w & 0xffff0000u); }
DI float wave_sum(float v) {
#pragma unroll
  for (int o = 32; o > 0; o >>= 1) v += __shfl_xor(v, o);
  return v;
}
DI float silu_f(float x) { return x / (1.f + __expf(-x)); }
DI int crow(int reg, int h) { return (reg & 3) + 8 * (reg >> 2) + 4 * h; }
DI bf16x8 pack8(const f32x16& x, int s) {
  u32x4 p;
  p[0] = pack2(x[8 * s + 0], x[8 * s + 1]); p[1] = pack2(x[8 * s + 2], x[8 * s + 3]);
  p[2] = pack2(x[8 * s + 4], x[8 * s + 5]); p[3] = pack2(x[8 * s + 6], x[8 * s + 7]);
  return __builtin_bit_cast(bf16x8, p);
}
DI const float* xin_row(const Params& p, int layer, int row) {
  if (layer == 0) return row < ML ? p.x + (size_t)row * DM : p.ctx + (size_t)(row - ML) * DM;
  return row < ML ? p.out + (size_t)row * DM : (const float*)(p.ws + OFF_XC) + (size_t)(row - ML) * DM;
}
DI float* xst_row(const Params& p, int row) {
  return row < ML ? p.out + (size_t)row * DM : (float*)(p.ws + OFF_XC) + (size_t)(row - ML) * DM;
}
DI const float* mod_ptr(const Params& p, int layer, int row, int which) {
  int bb = row < ML ? (row >> 12) : 4;
  return (const float*)(p.ws + OFF_MOD) + ((size_t)(layer * 5 + bb) * 6 + which) * DM;
}
DI bf16_t* wt_ptr(const Params& p, int layer, size_t off) { return (bf16_t*)(p.ws + OFF_WT) + (size_t)layer * WT_ELEMS + off; }

DI void transpose_item(const float* __restrict__ w, const float* __restrict__ gk, int gk_from, bf16_t* __restrict__ wt, int K, int N, int kt, int nt, char* smem) {
  float* tile = (float*)smem;
  const int tid = ltid(), tx = tid & 63, ty = tid >> 6;
  const int k0 = kt * 64, n0 = nt * 64;
  const int n = n0 + tx;
  float v[16];
#pragma unroll
  for (int i = 0; i < 16; ++i) {
    int kk = ty + 4 * i;
    v[i] = n < N ? w[(size_t)(k0 + kk) * N + n] : 0.f;
  }
  if (gk) {
#pragma unroll
    for (int i = 0; i < 16; ++i) { int k = k0 + ty + 4 * i; if (k >= gk_from) v[i] *= gk[k - gk_from]; }
  }
#pragma unroll
  for (int i = 0; i < 16; ++i) tile[(ty + 4 * i) * 65 + tx] = v[i];
  __syncthreads();
#pragma unroll
  for (int i = 0; i < 2; ++i) {
    int c = tid + 256 * i, nn = c >> 3, kc = c & 7;
    u32x4 o;
#pragma unroll
    for (int jj = 0; jj < 4; ++jj) o[jj] = pack2(tile[(kc * 8 + 2 * jj) * 65 + nn], tile[(kc * 8 + 2 * jj + 1) * 65 + nn]);
    *(u32x4*)(wt + (size_t)(n0 + nn) * K + k0 + kc * 8) = o;
  }
  __syncthreads();
}

DI void modgemv_item(const Params& p, int layer, int ct, char* smem) {
  float* s = (float*)smem;
  float* red = s + 5 * 1024;
  const int tid = ltid(), w = tid >> 6, lane = tid & 63;
  for (int i = tid; i < 5 * 1024; i += 256) {
    int bb = i >> 10, k = i & 1023;
    float v = bb < 4 ? p.c[bb * 1024 + k] : p.c_ctx[k];
    s[i] = silu_f(v);
  }
  __syncthreads();
  const float* wm = p.w_mod + (size_t)layer * 1024 * 6144;
  const int n = ct * 64 + lane;
  float acc[5] = {0.f, 0.f, 0.f, 0.f, 0.f};
#pragma unroll 16
  for (int k = w * 256; k < w * 256 + 256; ++k) {
    float wv = wm[(size_t)k * 6144 + n];
#pragma unroll
    for (int bb = 0; bb < 5; ++bb) acc[bb] += s[bb * 1024 + k] * wv;
  }
#pragma unroll
  for (int bb = 0; bb < 5; ++bb) red[(w * 5 + bb) * 64 + lane] = acc[bb];
  __syncthreads();
  for (int i = tid; i < 320; i += 256) {
    int bb = i >> 6, ln = i & 63;
    float v = red[(0 * 5 + bb) * 64 + ln] + red[(1 * 5 + bb) * 64 + ln] + red[(2 * 5 + bb) * 64 + ln] + red[(3 * 5 + bb) * 64 + ln];
    int nn = ct * 64 + ln;
    v += p.b_mod[layer * 6144 + nn];
    ((float*)(p.ws + OFF_MOD))[(size_t)(layer * 5 + bb) * 6144 + nn] = v;
  }
  __syncthreads();
}

DI void phase_prep0(const Params& p, int bid, int nb, char* smem) {
  constexpr int PER = 2984;
  for (int it = bid; it < 192 + 2 * PER; it += nb) {
    if (it < 192) { modgemv_item(p, it / 96, it % 96, smem); continue; }
    int layer = (it - 192) / PER, j = (it - 192) % PER;
    if (j < 640) transpose_item(p.w_in + (size_t)layer * 1024 * DIN, nullptr, 0, wt_ptr(p, layer, WT_IN), 1024, DIN, j / 40, j % 40, smem);
    else if ((j -= 640) < 24) transpose_item(p.w_uq + (size_t)layer * 256 * 384, p.q_norm + layer * 256, 0, wt_ptr(p, layer, WT_UQ), 256, 384, j / 6, j % 6, smem);
    else if ((j -= 24) < 16) transpose_item(p.w_ukv + (size_t)layer * 128 * 512, p.kv_norm + layer * 128, 0, wt_ptr(p, layer, WT_UKV), 128, 512, j / 8, j % 8, smem);
    else if ((j -= 16) < 256) transpose_item(p.w_out + (size_t)layer * 1024 * 1024, p.ssd_norm + layer * 512, 512, wt_ptr(p, layer, WT_OUT), 1024, 1024, j / 16, j % 16, smem);
    else if ((j -= 256) < 1024) transpose_item(p.w_ff1 + (size_t)layer * 1024 * 4096, nullptr, 0, wt_ptr(p, layer, WT_FF1), 1024, 4096, j / 64, j % 64, smem);
    else { j -= 1024; transpose_item(p.w_ff2 + (size_t)layer * 4096 * 1024, nullptr, 0, wt_ptr(p, layer, WT_FF2), 4096, 1024, j / 16, j % 16, smem); }
  }
}

struct HMod { float4 g[4], s1[4], s0[4]; };
DI void load_hmod(HMod& m, const float* g, const float* sh, const float* sc, int lane) {
#pragma unroll
  for (int i = 0; i < 4; ++i) {
    const int col = lane * 4 + 256 * i;
    m.g[i] = *(const float4*)(g + col); m.s1[i] = *(const float4*)(sc + col); m.s0[i] = *(const float4*)(sh + col);
  }
}
DI void write_h_row(const float4 xv[4], float rstd, const HMod& m, bf16_t* hrow, int lane) {
#pragma unroll
  for (int i = 0; i < 4; ++i) {
    const int col = lane * 4 + 256 * i;
    float a = xv[i].x * rstd * m.g[i].x * (1.f + m.s1[i].x) + m.s0[i].x;
    float b = xv[i].y * rstd * m.g[i].y * (1.f + m.s1[i].y) + m.s0[i].y;
    float c = xv[i].z * rstd * m.g[i].z * (1.f + m.s1[i].z) + m.s0[i].z;
    float d = xv[i].w * rstd * m.g[i].w * (1.f + m.s1[i].w) + m.s0[i].w;
    u32x2 o; o[0] = pack2(a, b); o[1] = pack2(c, d);
    *(u32x2*)(hrow + col) = o;
  }
}
DI float ssq4(const float4 v[4]) {
  float s = 0.f;
#pragma unroll
  for (int i = 0; i < 4; ++i) s += v[i].x * v[i].x + v[i].y * v[i].y + v[i].z * v[i].z + v[i].w * v[i].w;
  return s;
}
DI void load_bf_row(const bf16_t* r, int lane, float4 v[4]) {
#pragma unroll
  for (int i = 0; i < 4; ++i) {
    u32x2 t = *(const u32x2*)(r + lane * 4 + 256 * i);
    v[i] = make_float4(lo2f(t[0]), hi2f(t[0]), lo2f(t[1]), hi2f(t[1]));
  }
}

DI void phase_h0(const Params& p, int bid, int nb) {
  const int w = ltid() >> 6, lane = ltid() & 63;
  bf16_t* H = (bf16_t*)(p.ws + OFF_H);
  for (int row = bid * 4 + w; row < MT; row += nb * 4) {
    const float* xr = xin_row(p, 0, row);
    float4 xv[4];
#pragma unroll
    for (int i = 0; i < 4; ++i) xv[i] = *(const float4*)(xr + lane * 4 + 256 * i);
    HMod m; load_hmod(m, p.g_pre_mix, mod_ptr(p, 0, row, 0), mod_ptr(p, 0, row, 1), lane);
    float rstd = rsqrtf(wave_sum(ssq4(xv)) * (1.f / DM) + EPS);
    write_h_row(xv, rstd, m, H + (size_t)row * DM, lane);
  }
}

DI void phase_postmix(const Params& p, int layer, int bid, int nb) {
  const int w = ltid() >> 6, lane = ltid() & 63;
  const int M = layer == 0 ? MT : ML;
  bf16_t* H = (bf16_t*)(p.ws + OFF_H);
  const bf16_t* Y = (const bf16_t*)(p.ws + OFF_U);
  for (int row = bid * 4 + w; row < M; row += nb * 4) {
    float4 yv[4], xv[4], ga[4], gb[4];
    load_bf_row(Y + (size_t)row * DM, lane, yv);
    const float* xr = xin_row(p, layer, row);
    const float* g1 = mod_ptr(p, layer, row, 2);
    const float* gp = p.g_post_mix + layer * DM;
#pragma unroll
    for (int i = 0; i < 4; ++i) {
      const int col = lane * 4 + 256 * i;
      xv[i] = *(const float4*)(xr + col); ga[i] = *(const float4*)(g1 + col); gb[i] = *(const float4*)(gp + col);
    }
    HMod m; load_hmod(m, p.g_pre_ffn + layer * DM, mod_ptr(p, layer, row, 3), mod_ptr(p, layer, row, 4), lane);
    float rstd = rsqrtf(wave_sum(ssq4(yv)) * (1.f / DM) + EPS);
    float* xo = xst_row(p, row);
#pragma unroll
    for (int i = 0; i < 4; ++i) {
      xv[i].x += ga[i].x * yv[i].x * rstd * gb[i].x; xv[i].y += ga[i].y * yv[i].y * rstd * gb[i].y;
      xv[i].z += ga[i].z * yv[i].z * rstd * gb[i].z; xv[i].w += ga[i].w * yv[i].w * rstd * gb[i].w;
    }
#pragma unroll
    for (int i = 0; i < 4; ++i) *(float4*)(xo + lane * 4 + 256 * i) = xv[i];
    float rstd1 = rsqrtf(wave_sum(ssq4(xv)) * (1.f / DM) + EPS);
    write_h_row(xv, rstd1, m, H + (size_t)row * DM, lane);
  }
}

DI void phase_postffn(const Params& p, int layer, int bid, int nb) {
  const int w = ltid() >> 6, lane = ltid() & 63;
  const int M = layer == 0 ? MT : ML;
  bf16_t* H = (bf16_t*)(p.ws + OFF_H);
  for (int row = bid * 4 + w; row < M; row += nb * 4) {
    float4 fv[4], xv[4];
    if (row < ML) load_bf_row(H + (size_t)row * DM, lane, fv);
    else {
      const float* pp = (const float*)(p.ws + OFF_END2) + (size_t)(row - ML) * DM;
#pragma unroll
      for (int i = 0; i < 4; ++i) {
        float4 a = *(const float4*)(pp + lane * 4 + 256 * i), b = *(const float4*)(pp + (size_t)MC * DM + lane * 4 + 256 * i);
        float4 c = *(const float4*)(pp + (size_t)2 * MC * DM + lane * 4 + 256 * i), d = *(const float4*)(pp + (size_t)3 * MC * DM + lane * 4 + 256 * i);
        fv[i] = make_float4((a.x + b.x) + (c.x + d.x), (a.y + b.y) + (c.y + d.y), (a.z + b.z) + (c.z + d.z), (a.w + b.w) + (c.w + d.w));
      }
    }
    float* xo = xst_row(p, row);
    const float* g2 = mod_ptr(p, layer, row, 5);
    const float* gp = p.g_post_ffn + layer * DM;
    float4 ga[4], gb[4];
#pragma unroll
    for (int i = 0; i < 4; ++i) {
      const int col = lane * 4 + 256 * i;
      xv[i] = *(const float4*)(xo + col); ga[i] = *(const float4*)(g2 + col); gb[i] = *(const float4*)(gp + col);
    }
    HMod m;
    if (layer == 0) load_hmod(m, p.g_pre_mix + DM, mod_ptr(p, 1, row, 0), mod_ptr(p, 1, row, 1), lane);
    float rstd = rsqrtf(wave_sum(ssq4(fv)) * (1.f / DM) + EPS);
#pragma unroll
    for (int i = 0; i < 4; ++i) {
      xv[i].x += ga[i].x * fv[i].x * rstd * gb[i].x; xv[i].y += ga[i].y * fv[i].y * rstd * gb[i].y;
      xv[i].z += ga[i].z * fv[i].z * rstd * gb[i].z; xv[i].w += ga[i].w * fv[i].w * rstd * gb[i].w;
    }
#pragma unroll
    for (int i = 0; i < 4; ++i) *(float4*)(xo + lane * 4 + 256 * i) = xv[i];
    if (layer == 0) {
      float rstd1 = rsqrtf(wave_sum(ssq4(xv)) * (1.f / DM) + EPS);
      write_h_row(xv, rstd1, m, H + (size_t)row * DM, lane);
    }
  }
}

DI void phase_prep(const Params& p, int layer, int bid, int nb) {
  const int w = ltid() >> 6, lane = ltid() & 63;
  const bf16_t* U = (const bf16_t*)(p.ws + OFF_U);
  float* DT = (float*)(p.ws + OFF_DT);
  float* RS = (float*)(p.ws + OFF_RSTD);
  bf16_t* KB = (bf16_t*)(p.ws + OFF_KB);
  bf16_t* XBC = (bf16_t*)(p.ws + OFF_XBC);
  bf16_t* YM = (bf16_t*)(p.ws + OFF_H);
  const float* scw = p.sc_w + layer * 3 * 256;
  const float* cw = p.ssd_cw + layer * 3 * 768;
  const float* cb = p.ssd_cb + layer * 768;
  const int c4 = lane * 4;
  const float4 sw0 = *(const float4*)(scw + c4), sw1 = *(const float4*)(scw + 256 + c4), sw2 = *(const float4*)(scw + 512 + c4);
  float4 cwk[3][3], cbi[3];
#pragma unroll
  for (int i = 0; i < 3; ++i) {
    cbi[i] = *(const float4*)(cb + c4 + 256 * i);
#pragma unroll
    for (int k = 0; k < 3; ++k) cwk[i][k] = *(const float4*)(cw + k * 768 + c4 + 256 * i);
  }
  const float dtb = p.dt_bias[layer * 16 + (lane & 15)];
  const float invf = exp2f(-(float)(2 * (lane & 7)) * (13.287712379549449f / 16.f));
  for (int row = bid * 4 + w; row < MT; row += nb * 4) {
    int b, t, L, pos;
    const bool lat = row < ML;
    if (lat) { b = row >> 12; t = row & 4095; L = SEQ; pos = t + CTX; }
    else { int rr = row - ML; b = rr >> 8; t = rr & 255; L = CTX; pos = t; }
    const bf16_t* u0 = U + (size_t)row * DIN;
    const bool hp = t > 0, hn = t < L - 1;
    const bf16_t* um = hp ? u0 - DIN : u0;
    const bf16_t* up = hn ? u0 + DIN : u0;
    const float mp = hp ? 1.f : 0.f, mn = hn ? 1.f : 0.f;
    const u32x2 vq = *(const u32x2*)(u0 + c4);
    const u32x2 vkv = *(const u32x2*)(u0 + U_CKV + (lane & 31) * 4);
    const float kr = bf2f(u0[U_KR + (lane & 31)]);
    const u32x2 gcm = *(const u32x2*)(um + U_GC + c4), gc0 = *(const u32x2*)(u0 + U_GC + c4), gcp = *(const u32x2*)(up + U_GC + c4);
    const u32x2 vvm = *(const u32x2*)(um + U_VAL + c4), vv0 = *(const u32x2*)(u0 + U_VAL + c4), vvp = *(const u32x2*)(up + U_VAL + c4);
    const u32x2 gb = *(const u32x2*)(u0 + U_GB + c4);
    u32x2 xm[3], x0[3], xp[3];
#pragma unroll
    for (int i = 0; i < 3; ++i) {
      xm[i] = *(const u32x2*)(um + U_XBC + c4 + 256 * i);
      x0[i] = *(const u32x2*)(u0 + U_XBC + c4 + 256 * i);
      xp[i] = *(const u32x2*)(up + U_XBC + c4 + 256 * i);
    }
    const float dtr = DT[(size_t)row * 16 + (lane & 15)];
    {
      float a = lo2f(vq[0]), bq = hi2f(vq[0]), c = lo2f(vq[1]), d = hi2f(vq[1]);
      float ss = wave_sum(a * a + bq * bq + c * c + d * d);
      float e = lo2f(vkv[0]), f = hi2f(vkv[0]), g = lo2f(vkv[1]), h = hi2f(vkv[1]);
      float s2 = lane < 32 ? e * e + f * f + g * g + h * h : 0.f;
      s2 = wave_sum(s2);
      if (lane == 0) { RS[row * 2] = rsqrtf(ss * (1.f / 256) + EPS); RS[row * 2 + 1] = rsqrtf(s2 * (1.f / 128) + EPS); }
    }
    {
      const float partner = __shfl_xor(kr, 8);
      float o = kr;
      if (lat) {
        const int grp = (lane & 31) >> 3;
        const float posf = grp < 2 ? (float)(t >> 6) : (float)(t & 63);
        const float rev = posf * invf * 0.15915494309189535f;
        const float cs = __builtin_amdgcn_cosf(rev), sn = __builtin_amdgcn_sinf(rev);
        o = (grp & 1) ? kr * cs + partner * sn : kr * cs - partner * sn;
      }
      if (lane < 32) {
        const bf16_t ob = f2bf(o);
#pragma unroll
        for (int hd = 0; hd < 4; ++hd) KB[((size_t)(b * 4 + hd) * LK + pos) * 96 + 64 + lane] = ob;
      }
    }
    {
      float a0 = sw1.x * lo2f(gc0[0]) * lo2f(vv0[0]) + mp * sw0.x * lo2f(gcm[0]) * lo2f(vvm[0]) + mn * sw2.x * lo2f(gcp[0]) * lo2f(vvp[0]);
      float a1 = sw1.y * hi2f(gc0[0]) * hi2f(vv0[0]) + mp * sw0.y * hi2f(gcm[0]) * hi2f(vvm[0]) + mn * sw2.y * hi2f(gcp[0]) * hi2f(vvp[0]);
      float a2 = sw1.z * lo2f(gc0[1]) * lo2f(vv0[1]) + mp * sw0.z * lo2f(gcm[1]) * lo2f(vvm[1]) + mn * sw2.z * lo2f(gcp[1]) * lo2f(vvp[1]);
      float a3 = sw1.w * hi2f(gc0[1]) * hi2f(vv0[1]) + mp * sw0.w * hi2f(gcm[1]) * hi2f(vvm[1]) + mn * sw2.w * hi2f(gcp[1]) * hi2f(vvp[1]);
      u32x2 o; o[0] = pack2(lo2f(gb[0]) * a0, hi2f(gb[0]) * a1); o[1] = pack2(lo2f(gb[1]) * a2, hi2f(gb[1]) * a3);
      *(u32x2*)(YM + (size_t)row * DM + 256 + c4) = o;
    }
#pragma unroll
    for (int i = 0; i < 3; ++i) {
      float a0 = cbi[i].x + cwk[i][1].x * lo2f(x0[i][0]) + mp * cwk[i][0].x * lo2f(xm[i][0]) + mn * cwk[i][2].x * lo2f(xp[i][0]);
      float a1 = cbi[i].y + cwk[i][1].y * hi2f(x0[i][0]) + mp * cwk[i][0].y * hi2f(xm[i][0]) + mn * cwk[i][2].y * hi2f(xp[i][0]);
      float a2 = cbi[i].z + cwk[i][1].z * lo2f(x0[i][1]) + mp * cwk[i][0].z * lo2f(xm[i][1]) + mn * cwk[i][2].z * lo2f(xp[i][1]);
      float a3 = cbi[i].w + cwk[i][1].w * hi2f(x0[i][1]) + mp * cwk[i][0].w * hi2f(xm[i][1]) + mn * cwk[i][2].w * hi2f(xp[i][1]);
      u32x2 o; o[0] = pack2(silu_f(a0), silu_f(a1)); o[1] = pack2(silu_f(a2), silu_f(a3));
      *(u32x2*)(XBC + (size_t)row * 768 + c4 + 256 * i) = o;
    }
    if (lane < 16) {
      const float v = dtr + dtb;
      const float e = __expf(-fabsf(v));
      DT[(size_t)row * 16 + lane] = fmaxf(v, 0.f) + (e < 1e-3f ? e * (1.f - 0.5f * e) : __logf(1.f + e));
    }
  }
}

DI void phase_ssdnorm(const Params& p, int layer, int bid, int nb) {
  const int w = ltid() >> 6, lane = ltid() & 63;
  const int M = layer == 0 ? MT : ML;
  bf16_t* YM = (bf16_t*)(p.ws + OFF_H);
  const float* SSQ = (const float*)(p.ws + OFF_SSQ);
  const float* ng = p.ssd_norm + layer * 512;
  for (int row = bid * 4 + w; row < M; row += nb * 4) {
    int g = lane >> 5;
    float4 s = *(const float4*)(SSQ + (size_t)row * 8 + g * 4);
    float rstd = rsqrtf((s.x + s.y + s.z + s.w) * (1.f / 256) + EPS);
    bf16_t* ptr = YM + (size_t)row * DM + 512 + lane * 8;
    u32x4 v = *(const u32x4*)ptr;
    float4 g0 = *(const float4*)(ng + lane * 8), g1 = *(const float4*)(ng + lane * 8 + 4);
    u32x4 o;
    o[0] = pack2(lo2f(v[0]) * rstd * g0.x, hi2f(v[0]) * rstd * g0.y);
    o[1] = pack2(lo2f(v[1]) * rstd * g0.z, hi2f(v[1]) * rstd * g0.w);
    o[2] = pack2(lo2f(v[2]) * rstd * g1.x, hi2f(v[2]) * rstd * g1.y);
    o[3] = pack2(lo2f(v[3]) * rstd * g1.z, hi2f(v[3]) * rstd * g1.w);
    *(u32x4*)ptr = o;
  }
}

constexpr int GST = 80;
constexpr int GBUF = 2 * 128 * GST;
template <bool GN, class Epi>
DI void gemm_tile(const bf16_t* __restrict__ A, int lda, const bf16_t* __restrict__ Bt, int K, int row0, int col0, char* smem, Epi epi, const float* __restrict__ ssq = nullptr) {
  bf16_t* S0 = (bf16_t*)smem;
  const int tid = ltid(), wid = tid >> 6, lane = tid & 63, wr = wid >> 1, wc = wid & 1, fr = lane & 15, fq = lane >> 4;
  f32x4 acc[4][4];
#pragma unroll
  for (int m = 0; m < 4; ++m)
#pragma unroll
    for (int n = 0; n < 4; ++n) acc[m][n] = f32x4{0.f, 0.f, 0.f, 0.f};
  u32x4 ra[4], rb[4];
  const int sr = tid >> 3, sp = tid & 7;
  const bf16_t* ga = A + (size_t)(row0 + sr) * lda + sp * 8;
  const bf16_t* gb = Bt + (size_t)(col0 + sr) * K + sp * 8;
  auto gload = [&](int k0) {
#pragma unroll
    for (int i = 0; i < 4; ++i) {
      ra[i] = *(const u32x4*)(ga + (size_t)(32 * i) * lda + k0);
      rb[i] = *(const u32x4*)(gb + (size_t)(32 * i) * K + k0);
    }
  };
  gload(0);
  float gs[4][2];
  if (GN) {
#pragma unroll
    for (int i = 0; i < 4; ++i) {
      const float4 s0 = *(const float4*)(ssq + (size_t)(row0 + sr + 32 * i) * 8), s1 = *(const float4*)(ssq + (size_t)(row0 + sr + 32 * i) * 8 + 4);
      gs[i][0] = rsqrtf((s0.x + s0.y + s0.z + s0.w) * (1.f / 256) + EPS);
      gs[i][1] = rsqrtf((s1.x + s1.y + s1.z + s1.w) * (1.f / 256) + EPS);
    }
  }
  auto swrite = [&](int kt) {
    if (GN && kt >= 8) {
      const int g = (kt - 8) >> 2;
#pragma unroll
      for (int i = 0; i < 4; ++i) {
        const float sc = g ? gs[i][1] : gs[i][0];
#pragma unroll
        for (int jj = 0; jj < 4; ++jj) ra[i][jj] = pack2(lo2f(ra[i][jj]) * sc, hi2f(ra[i][jj]) * sc);
      }
    }
    bf16_t* As = S0 + (kt & 1) * GBUF;
    bf16_t* Bs = As + 128 * GST;
#pragma unroll
    for (int i = 0; i < 4; ++i) {
      *(u32x4*)(As + (sr + 32 * i) * GST + sp * 8) = ra[i];
      *(u32x4*)(Bs + (sr + 32 * i) * GST + sp * 8) = rb[i];
    }
  };
  const int KT = K / 64;
  swrite(0);
  if (KT > 1) gload(64);
  __syncthreads();
  for (int kt = 0; kt < KT; ++kt) {
    const bf16_t* As = S0 + (kt & 1) * GBUF;
    const bf16_t* Bs = As + 128 * GST;
#pragma unroll
    for (int ks = 0; ks < 2; ++ks) {
      bf16x8 af[4], bfr[4];
#pragma unroll
      for (int m = 0; m < 4; ++m) af[m] = *(const bf16x8*)(As + (wr * 64 + m * 16 + fr) * GST + ks * 32 + fq * 8);
#pragma unroll
      for (int n = 0; n < 4; ++n) bfr[n] = *(const bf16x8*)(Bs + (wc * 64 + n * 16 + fr) * GST + ks * 32 + fq * 8);
#pragma unroll
      for (int m = 0; m < 4; ++m)
#pragma unroll
        for (int n = 0; n < 4; ++n) acc[m][n] = MFMA16(bfr[n], af[m], acc[m][n]);
      if (ks == 0 && kt + 1 < KT) {
        swrite(kt + 1);
        if (kt + 2 < KT) gload((kt + 2) * 64);
      }
    }
    __syncthreads();
  }
  float rsc[4];
#pragma unroll
  for (int m = 0; m < 4; ++m) rsc[m] = epi.scale(row0 + wr * 64 + m * 16 + fr);
#pragma unroll
  for (int m = 0; m < 4; ++m)
#pragma unroll
    for (int n = 0; n < 4; ++n) epi(row0 + wr * 64 + m * 16 + fr, col0 + wc * 64 + n * 16 + fq * 4, acc[m][n], rsc[m]);
}

template <class Epi>
DI void gemm_tile_glds(const bf16_t* __restrict__ A, int lda, const bf16_t* __restrict__ Bt, int ldb, int K, int row0, int col0, char* smem, Epi epi) {
  const int tid = ltid(), wid = tid >> 6, lane = tid & 63, wr = wid >> 1, wc = wid & 1, fr = lane & 15, fq = lane >> 4;
  f32x4 acc[4][4];
#pragma unroll
  for (int m = 0; m < 4; ++m)
#pragma unroll
    for (int n = 0; n < 4; ++n) acc[m][n] = f32x4{0.f, 0.f, 0.f, 0.f};
  const int crow = tid >> 3, cslot = tid & 7, cpart = cslot ^ (crow & 7);
  const bf16_t* ga = A + (size_t)(row0 + crow) * lda + cpart * 8;
  const bf16_t* gb = Bt + (size_t)(col0 + crow) * ldb + cpart * 8;
  auto issue = [&](int kt, int stage) {
    char* sa = smem + stage * 32768 + tid * 16;
#pragma unroll
    for (int i = 0; i < 4; ++i) {
      __builtin_amdgcn_global_load_lds((const unsigned*)(ga + (size_t)(32 * i) * lda + kt * 64), (__attribute__((address_space(3))) unsigned*)(sa + i * 4096), 16, 0, 0);
      __builtin_amdgcn_global_load_lds((const unsigned*)(gb + (size_t)(32 * i) * ldb + kt * 64), (__attribute__((address_space(3))) unsigned*)(sa + 16384 + i * 4096), 16, 0, 0);
    }
  };
  const int KT = K / 64;
  issue(0, 0);
  asm volatile("s_waitcnt vmcnt(0)" ::: "memory");
  __syncthreads();
  const int sw = fr & 7;
  for (int kt = 0; kt < KT; ++kt) {
    if (kt + 1 < KT) issue(kt + 1, (kt + 1) & 1);
    const char* As = smem + (kt & 1) * 32768;
    const char* Bs = As + 16384;
#pragma unroll
    for (int ks = 0; ks < 2; ++ks) {
      bf16x8 af[4], bfr[4];
      const int so = ((ks * 4 + fq) ^ sw) * 16;
#pragma unroll
      for (int m = 0; m < 4; ++m) af[m] = *(const bf16x8*)(As + (wr * 64 + m * 16 + fr) * 128 + so);
#pragma unroll
      for (int n = 0; n < 4; ++n) bfr[n] = *(const bf16x8*)(Bs + (wc * 64 + n * 16 + fr) * 128 + so);
#pragma unroll
      for (int m = 0; m < 4; ++m)
#pragma unroll
        for (int n = 0; n < 4; ++n) acc[m][n] = MFMA16(bfr[n], af[m], acc[m][n]);
    }
    asm volatile("s_waitcnt vmcnt(0)" ::: "memory");
    __syncthreads();
  }
#pragma unroll
  for (int m = 0; m < 4; ++m)
#pragma unroll
    for (int n = 0; n < 4; ++n) epi(row0 + wr * 64 + m * 16 + fr, col0 + wc * 64 + n * 16 + fq * 4, acc[m][n]);
}

constexpr int G8_HT = 128 * 64;
DI int g8_lds_byte(int r, int c) {
  int st = (r >> 4) * 2 + (c >> 5), rr = r & 15, cc = c & 31, ob = rr * 64 + cc * 2;
  return st * 1024 + (ob ^ (((ob >> 9) & 1) << 5));
}
DI void g8_stage_rc(int b, int& R, int& C) {
  int st = b / 1024, sb = b % 1024, swz = sb ^ (((sb >> 9) & 1) << 5);
  R = (st >> 1) * 16 + swz / 64; C = (st & 1) * 32 + (swz % 64) / 2;
}
template <class Epi>
DI void gemm8_tile(const bf16_t* __restrict__ A, int lda, const bf16_t* __restrict__ Bt, int ldb, int K, int brow, int bcol, char* smem, Epi epi,
                   bool first = true, bool has_next = false, int nbrow = 0, int nbcol = 0) {
  bf16_t* shm = (bf16_t*)smem;
  const int tid = ltid512();
#define G8_SA(b, h) (shm + ((b) * 2 + (h)) * G8_HT)
#define G8_SB(b, h) (shm + (4 + (b) * 2 + (h)) * G8_HT)
#define G8_STAGE(P, BASE, LD, br, kt) do { const bf16_t* _g = (BASE) + (size_t)(br) * (LD) + (size_t)(kt) * 64; \
    _Pragma("unroll") for (int _i = 0; _i < 2; ++_i) { int _b = tid * 16 + _i * 8192; int _r, _c; g8_stage_rc(_b, _r, _c); \
      __builtin_amdgcn_global_load_lds((const unsigned*)(_g + (size_t)_r * (LD) + _c), \
        (__attribute__((address_space(3))) unsigned*)((char*)(P) + _b), 16, 0, 0); } } while (0)
#define G8_LDA(dst, b, h) _Pragma("unroll") for (int m = 0; m < 4; ++m) _Pragma("unroll") for (int k = 0; k < 2; ++k) \
    dst[m][k] = *reinterpret_cast<const bf16x8*>((char*)G8_SA(b, h) + g8_lds_byte(wr * 64 + m * 16 + fr, k * 32 + fq * 8))
#define G8_LDB(dst, b, h) _Pragma("unroll") for (int n = 0; n < 2; ++n) _Pragma("unroll") for (int k = 0; k < 2; ++k) \
    dst[n][k] = *reinterpret_cast<const bf16x8*>((char*)G8_SB(b, h) + g8_lds_byte(wc * 32 + n * 16 + fr, k * 32 + fq * 8))
#define G8_MMA(ai, bj, At, Bx) do { __builtin_amdgcn_s_setprio(1); \
    _Pragma("unroll") for (int m = 0; m < 4; ++m) _Pragma("unroll") for (int n = 0; n < 2; ++n) _Pragma("unroll") for (int k = 0; k < 2; ++k) \
      acc[ai][bj][m][n] = __builtin_amdgcn_mfma_f32_16x16x32_bf16(Bx[n][k], At[m][k], acc[ai][bj][m][n], 0, 0, 0); \
    __builtin_amdgcn_s_setprio(0); } while (0)
#define G8_WAIT_V(n) asm volatile("s_waitcnt vmcnt(" #n ")" ::: "memory")
#define G8_WAIT_L(n) asm volatile("s_waitcnt lgkmcnt(" #n ")" ::: "memory")
#define G8_BAR __builtin_amdgcn_s_barrier()
#define G8_SCHED __builtin_amdgcn_sched_barrier(0)
  const int wid = tid >> 6, lane = tid & 63, wr = wid >> 2, wc = wid & 3, fr = lane & 15, fq = lane >> 4;
  f32x4 acc[2][2][4][2];
#pragma unroll
  for (int a = 0; a < 2; ++a)
#pragma unroll
    for (int b = 0; b < 2; ++b)
#pragma unroll
      for (int m = 0; m < 4; ++m)
#pragma unroll
        for (int n = 0; n < 2; ++n) acc[a][b][m][n] = f32x4{0.f, 0.f, 0.f, 0.f};
  bf16x8 At[4][2], B0[2][2], B1[2][2];
  const int nt = K / 64;
  if (first) {
    G8_STAGE(G8_SB(0, 0), Bt, ldb, bcol, 0); G8_STAGE(G8_SA(0, 0), A, lda, brow, 0);
    G8_STAGE(G8_SB(0, 1), Bt, ldb, bcol + 128, 0); G8_STAGE(G8_SA(0, 1), A, lda, brow + 128, 0);
  }
  if (wr == 1) G8_BAR;
  if (first) G8_WAIT_V(4); else G8_WAIT_V(0);
  G8_BAR;
  G8_STAGE(G8_SB(1, 0), Bt, ldb, bcol, 1); G8_STAGE(G8_SA(1, 0), A, lda, brow, 1); G8_STAGE(G8_SB(1, 1), Bt, ldb, bcol + 128, 1);
  G8_WAIT_V(6); G8_BAR;
  for (int t = 0; t < nt - 2; t += 2) {
    G8_LDB(B0, 0, 0); G8_SCHED; G8_LDA(At, 0, 0); G8_STAGE(G8_SA(1, 1), A, lda, brow + 128, t + 1);
    G8_WAIT_L(8); G8_BAR; G8_WAIT_L(0); G8_MMA(0, 0, At, B0); G8_BAR; G8_SCHED;
    G8_LDB(B1, 0, 1); G8_STAGE(G8_SB(0, 0), Bt, ldb, bcol, t + 2);
    G8_BAR; G8_WAIT_L(0); G8_MMA(0, 1, At, B1); G8_BAR;
    G8_LDA(At, 0, 1); G8_STAGE(G8_SA(0, 0), A, lda, brow, t + 2);
    G8_BAR; G8_WAIT_L(0); G8_MMA(1, 0, At, B0); G8_BAR; G8_SCHED;
    G8_STAGE(G8_SB(0, 1), Bt, ldb, bcol + 128, t + 2);
    G8_WAIT_V(6); G8_BAR; G8_MMA(1, 1, At, B1); G8_BAR;
    G8_LDB(B0, 1, 0); G8_SCHED; G8_LDA(At, 1, 0); G8_STAGE(G8_SA(0, 1), A, lda, brow + 128, t + 2);
    G8_WAIT_L(8); G8_BAR; G8_WAIT_L(0); G8_MMA(0, 0, At, B0); G8_BAR; G8_SCHED;
    G8_LDB(B1, 1, 1); G8_STAGE(G8_SB(1, 0), Bt, ldb, bcol, t + 3);
    G8_BAR; G8_WAIT_L(0); G8_MMA(0, 1, At, B1); G8_BAR;
    G8_LDA(At, 1, 1); G8_STAGE(G8_SA(1, 0), A, lda, brow, t + 3);
    G8_BAR; G8_WAIT_L(0); G8_MMA(1, 0, At, B0); G8_BAR; G8_SCHED;
    G8_STAGE(G8_SB(1, 1), Bt, ldb, bcol + 128, t + 3);
    G8_WAIT_V(6); G8_BAR; G8_MMA(1, 1, At, B1); G8_BAR;
  }
  { G8_LDB(B0, 0, 0); G8_LDA(At, 0, 0); G8_STAGE(G8_SA(1, 1), A, lda, brow + 128, nt - 1);
    G8_BAR; G8_WAIT_L(0); G8_MMA(0, 0, At, B0); G8_BAR;
    G8_LDB(B1, 0, 1); G8_BAR; G8_WAIT_L(0); G8_MMA(0, 1, At, B1); G8_BAR;
    G8_LDA(At, 0, 1); G8_WAIT_V(4); G8_BAR; G8_WAIT_L(0); G8_MMA(1, 0, At, B0); G8_MMA(1, 1, At, B1); G8_BAR; }
  { G8_LDB(B0, 1, 0); G8_LDA(At, 1, 0); G8_WAIT_V(2); G8_BAR; G8_WAIT_L(0); G8_MMA(0, 0, At, B0); G8_BAR;
    G8_LDB(B1, 1, 1); G8_WAIT_V(0); G8_BAR; G8_WAIT_L(0); G8_MMA(0, 1, At, B1); G8_BAR;
    G8_LDA(At, 1, 1); G8_BAR; G8_WAIT_L(0); G8_MMA(1, 0, At, B0); G8_MMA(1, 1, At, B1); G8_BAR; }
  if (has_next) {
    G8_STAGE(G8_SB(0, 0), Bt, ldb, nbcol, 0); G8_STAGE(G8_SA(0, 0), A, lda, nbrow, 0);
    G8_STAGE(G8_SB(0, 1), Bt, ldb, nbcol + 128, 0); G8_STAGE(G8_SA(0, 1), A, lda, nbrow + 128, 0);
  }
  if (wr == 0) G8_BAR;
  const bool odd = fq & 1;
#pragma unroll
  for (int ai = 0; ai < 2; ++ai)
#pragma unroll
    for (int bj = 0; bj < 2; ++bj)
#pragma unroll
      for (int m = 0; m < 4; ++m) {
        const int row = brow + ai * 128 + wr * 64 + m * 16 + fr, cb = bcol + bj * 128 + wc * 32;
        epi.side(row, cb + fq * 4, acc[ai][bj][m][0]);
        epi.side(row, cb + 16 + fq * 4, acc[ai][bj][m][1]);
        const u32x2 p0 = epi.pack(acc[ai][bj][m][0]), p1 = epi.pack(acc[ai][bj][m][1]);
        const u32x2 snd = odd ? p0 : p1;
        u32x2 rcv; rcv[0] = (unsigned)__shfl_xor((int)snd[0], 16); rcv[1] = (unsigned)__shfl_xor((int)snd[1], 16);
        u32x4 o;
        if (odd) { o[0] = rcv[0]; o[1] = rcv[1]; o[2] = p1[0]; o[3] = p1[1]; }
        else     { o[0] = p0[0]; o[1] = p0[1]; o[2] = rcv[0]; o[3] = rcv[1]; }
        epi.store16(row, odd ? cb + 16 + (fq - 1) * 4 : cb + fq * 4, o);
      }
  __syncthreads();
}

struct EpiBF {
  bf16_t* out; int ldo;
  DI void side(int, int, const f32x4&) const {}
  DI u32x2 pack(const f32x4& a) const { u32x2 o; o[0] = pack2(a[0], a[1]); o[1] = pack2(a[2], a[3]); return o; }
  DI void store16(int row, int col, const u32x4& v) const { *(u32x4*)(out + (size_t)row * ldo + col) = v; }
  DI float scale(int) const { return 1.f; }
  DI void operator()(int row, int col, const f32x4& a, float) const { (*this)(row, col, a); }
  DI void operator()(int row, int col, const f32x4& a) const {
    u32x2 o; o[0] = pack2(a[0], a[1]); o[1] = pack2(a[2], a[3]);
    *(u32x2*)(out + (size_t)row * ldo + col) = o;
  }
};
struct EpiRelu2 {
  bf16_t* out; int ldo;
  DI void side(int, int, const f32x4&) const {}
  DI u32x2 pack(const f32x4& a) const {
    float r0 = fmaxf(a[0], 0.f), r1 = fmaxf(a[1], 0.f), r2 = fmaxf(a[2], 0.f), r3 = fmaxf(a[3], 0.f);
    u32x2 o; o[0] = pack2(r0 * r0, r1 * r1); o[1] = pack2(r2 * r2, r3 * r3); return o;
  }
  DI void store16(int row, int col, const u32x4& v) const { *(u32x4*)(out + (size_t)row * ldo + col) = v; }
  DI void operator()(int row, int col, const f32x4& a) const {
    float r0 = fmaxf(a[0], 0.f), r1 = fmaxf(a[1], 0.f), r2 = fmaxf(a[2], 0.f), r3 = fmaxf(a[3], 0.f);
    u32x2 o; o[0] = pack2(r0 * r0, r1 * r1); o[1] = pack2(r2 * r2, r3 * r3);
    *(u32x2*)(out + (size_t)row * ldo + col) = o;
  }
};
struct EpiU {
  bf16_t* u; float* dt;
  DI void side(int row, int col, const f32x4& a) const { if (col >= U_DT && col < DIN) *(float4*)(dt + (size_t)row * 16 + col - U_DT) = make_float4(a[0], a[1], a[2], a[3]); }
  DI u32x2 pack(const f32x4& a) const { u32x2 o; o[0] = pack2(a[0], a[1]); o[1] = pack2(a[2], a[3]); return o; }
  DI void store16(int row, int col, const u32x4& v) const { if (col < DIN) *(u32x4*)(u + (size_t)row * DIN + col) = v; }
  DI void operator()(int row, int col, const f32x4& a) const {
    if (col < DIN) {
      u32x2 o; o[0] = pack2(a[0], a[1]); o[1] = pack2(a[2], a[3]);
      *(u32x2*)(u + (size_t)row * DIN + col) = o;
      if (col >= U_DT) *(float4*)(dt + (size_t)row * 16 + col - U_DT) = make_float4(a[0], a[1], a[2], a[3]);
    }
  }
};
struct EpiQ {
  bf16_t* q; const float* rs;
  DI float scale(int row) const { return rs[row * 2]; }
  DI void operator()(int row, int col, const f32x4& a, float r) const {
    u32x2 o; o[0] = pack2(a[0] * r, a[1] * r); o[1] = pack2(a[2] * r, a[3] * r);
    *(u32x2*)(q + (size_t)row * 384 + col) = o;
  }
};
struct EpiKV {
  bf16_t* kb; bf16_t* vt; const float* rs;
  DI float scale(int row) const { return rs[row * 2 + 1]; }
  DI void operator()(int row, int col, const f32x4& a, float r) const {
    int b, pos;
    if (row < ML) { b = row >> 12; pos = (row & 4095) + CTX; } else { int rr = row - ML; b = rr >> 8; pos = rr & 255; }
    const int head = col >> 7, d = col & 127;
    if (d < 64) {
      u32x2 o; o[0] = pack2(a[0] * r, a[1] * r); o[1] = pack2(a[2] * r, a[3] * r);
      *(u32x2*)(kb + ((size_t)(b * 4 + head) * LK + pos) * 96 + d) = o;
    } else {
#pragma unroll
      for (int j = 0; j < 4; ++j) vt[((size_t)(b * 4 + head) * 64 + (d - 64 + j)) * LK + pos] = f2bf(a[j] * r);
    }
  }
};

struct EpiPart {
  float* part;
  DI void operator()(int row, int col, const f32x4& a) const {
    *(float4*)(part + (size_t)(row - ML) * DM + col) = make_float4(a[0], a[1], a[2], a[3]);
  }
};
DI void phase_inproj(const Params& p, int layer, int bid, int nb, char* smem) {
  EpiU epi{(bf16_t*)(p.ws + OFF_U), (float*)(p.ws + OFF_DT)};
  const int x = bid & 7, per = nb >> 3;
  for (int rep = 0; rep < REP_GEMM; ++rep)
  for (int q = bid >> 3; q < 85; q += per) {
    const int m = (x >> 1) * 17 + q / 5, n = 5 * (x & 1) + q % 5;
    const int q2 = q + per, m2 = (x >> 1) * 17 + q2 / 5, n2 = 5 * (x & 1) + q2 % 5;
    gemm8_tile((const bf16_t*)(p.ws + OFF_H), DM, wt_ptr(p, layer, WT_IN), 1024, 1024, m * 256, n * 256, smem, epi,
               q == (bid >> 3), q2 < 85, m2 * 256, n2 * 256);
  }
}
DI void phase_wout(const Params& p, int layer, int lid, int nvb, char* smem) {
  const int M = layer == 0 ? MT : ML;
  EpiBF epi{(bf16_t*)(p.ws + OFF_U), DM};
  const int x = lid & 7, per = nvb >> 3;
  for (int rep = 0; rep < REP_GEMM; ++rep)
  for (int q = lid >> 3; q < M / 128; q += per)
    gemm_tile<true>((const bf16_t*)(p.ws + OFF_H), DM, wt_ptr(p, layer, WT_OUT), 1024, ((q >> 3) * 8 + x) * 128, (q & 7) * 128, smem, epi, (const float*)(p.ws + OFF_SSQ));
}
DI void phase_ff1(const Params& p, int layer, int bid, int nb, int vbid, int nvb, char* smem, char* smem_half) {
  EpiRelu2 epi{(bf16_t*)(p.ws + OFF_F1), DFF};
  const int x = bid & 7, per = nb >> 3;
  for (int rep = 0; rep < REP_GEMM; ++rep) {
    for (int q = bid >> 3; q < 128; q += per) {
      const int m = (x >> 2) * 32 + (q >> 2), n = 4 * (x & 3) + (q & 3);
      const int q2 = q + per, m2 = (x >> 2) * 32 + (q2 >> 2), n2 = 4 * (x & 3) + (q2 & 3);
      gemm8_tile((const bf16_t*)(p.ws + OFF_H), DM, wt_ptr(p, layer, WT_FF1), 1024, 1024, m * 256, n * 256, smem, epi,
                 q == (bid >> 3), q2 < 128, m2 * 256, n2 * 256);
    }
    if (layer == 0)
      for (int it = vbid; it < (MC / 128) * 32; it += nvb)
        gemm_tile_glds((const bf16_t*)(p.ws + OFF_H), DM, wt_ptr(p, layer, WT_FF1), 1024, 1024, ML + (it / 32) * 128, (it % 32) * 128, smem_half, epi);
  }
}
DI void phase_ff2(const Params& p, int layer, int bid, int nb, int vbid, int nvb, char* smem, char* smem_half) {
  EpiBF epi{(bf16_t*)(p.ws + OFF_H), DM};
  const int x = bid & 7, per = nb >> 3;
  for (int rep = 0; rep < REP_GEMM; ++rep) {
    for (int q = bid >> 3; q < 32; q += per) {
      const int T = x * 32 + q;
      gemm8_tile((const bf16_t*)(p.ws + OFF_F1), DFF, wt_ptr(p, layer, WT_FF2), 4096, 4096, (T >> 2) * 256, (T & 3) * 256, smem, epi);
    }
    if (layer == 0)
      for (int it = vbid; it < (MC / 128) * 8 * 4; it += nvb) {
        const int tile = it >> 2, ks = it & 3;
        EpiPart ep{(float*)(p.ws + OFF_END2) + (size_t)ks * MC * DM};
        gemm_tile_glds((const bf16_t*)(p.ws + OFF_F1) + ks * 1024, DFF, wt_ptr(p, layer, WT_FF2) + ks * 1024, 4096, 1024, ML + (tile >> 3) * 128, (tile & 7) * 128, smem_half, ep);
      }
  }
}

DI int chunk_row0(int b, int tc) { return tc < 2 ? ML + b * CTX + tc * 128 : b * SEQ + (tc - 2) * 128; }
constexpr int BST = 72;
constexpr int TST = 136;
DI void load_tile_T(bf16_t* dst, const bf16_t* __restrict__ src, int ldg) {
  const int tid = ltid();
#pragma unroll
  for (int i = 0; i < 4; ++i) {
    int c = tid + 256 * i, tok = c & 127, pc = c >> 7;
    u32x4 v = *(const u32x4*)(src + (size_t)tok * ldg + pc * 8);
#pragma unroll
    for (int j = 0; j < 4; ++j) {
      dst[(pc * 8 + 2 * j) * TST + tok] = (bf16_t)(v[j] & 0xffffu);
      dst[(pc * 8 + 2 * j + 1) * TST + tok] = (bf16_t)(v[j] >> 16);
    }
  }
}
DI void chunk_scan(const Params& p, int layer, int row0, int h, float* csf, float* csb, float* dtF, float* dtB, float* tot, float*  ) {
  const int tid = ltid(), w = tid >> 6, lane = tid & 63;
  const float* DT = (const float*)(p.ws + OFF_DT);
  float v;
  if (tid < 128) {
    const float dt = DT[(size_t)(row0 + tid) * 16 + h];
    v = dt * -__expf(p.a_log[layer * 16 + h]);
    dtF[tid] = dt;
  } else {
    const int e = 255 - tid;
    const float dt = DT[(size_t)(row0 + e) * 16 + 8 + h];
    v = dt * -__expf(p.a_log[layer * 16 + 8 + h]);
    dtB[e] = dt;
  }
#pragma unroll
  for (int o = 1; o < 64; o <<= 1) { const float t = __shfl_up(v, o); if (lane >= o) v += t; }
  if (lane == 63) tot[w] = v;
  __syncthreads();
  if (w == 1) v += tot[0];
  if (w == 3) v += tot[2];
  if (tid < 128) csf[tid] = v; else csb[255 - tid] = v;
  __syncthreads();
}

DI void ssd_state_item(const Params& p, int layer, int b, int tc, int h, char* smem) {
  bf16_t* XT = (bf16_t*)smem;
  bf16_t* BT = XT + 64 * TST;
  float* csf = (float*)(BT + 64 * TST);
  float* csb = csf + 128; float* dtF = csb + 128; float* dtB = dtF + 128; float* laF = dtB + 128; float* laB = laF + 128;
  const int tid = ltid(), w = tid >> 6, lane = tid & 63, r = lane & 31, hh = lane >> 5;
  const int row0 = chunk_row0(b, tc);
  const bf16_t* XBC = (const bf16_t*)(p.ws + OFF_XBC);
  load_tile_T(XT, XBC + (size_t)row0 * 768 + h * 64, 768);
  load_tile_T(BT, XBC + (size_t)row0 * 768 + 512 + (h >> 2) * 64, 768);
  chunk_scan(p, layer, row0, h, csf, csb, dtF, dtB, laF, laB);
  __syncthreads();
  if (tid < 128) laF[tid] = dtF[tid] * __expf(csf[127] - csf[tid]);
  else { int t = tid - 128; laB[t] = dtB[t] * __expf(csb[0] - csb[t]); }
  __syncthreads();
  const int d = w >> 1, pt = w & 1;
  const float* wv = d == 0 ? laF : laB;
  f32x16 acc[2];
#pragma unroll
  for (int i = 0; i < 16; ++i) { acc[0][i] = 0.f; acc[1][i] = 0.f; }
#pragma unroll
  for (int s = 0; s < 8; ++s) {
    int l0 = 16 * s + 8 * hh;
    u32x4 xa = *(const u32x4*)(XT + (32 * pt + r) * TST + l0);
    u32x4 sa;
#pragma unroll
    for (int j = 0; j < 4; ++j) sa[j] = pack2(lo2f(xa[j]) * wv[l0 + 2 * j], hi2f(xa[j]) * wv[l0 + 2 * j + 1]);
    bf16x8 af = __builtin_bit_cast(bf16x8, sa);
#pragma unroll
    for (int nt = 0; nt < 2; ++nt) {
      bf16x8 bfr = *(const bf16x8*)(BT + (32 * nt + r) * TST + l0);
      acc[nt] = MFMA32(af, bfr, acc[nt]);
    }
  }
  bf16_t* S = (bf16_t*)(p.ws + OFF_SST) + ((((size_t)d * NB + b) * NCH + tc) * 8 + h) * 4096;
#pragma unroll
  for (int nt = 0; nt < 2; ++nt)
#pragma unroll
    for (int i = 0; i < 16; ++i) S[(32 * pt + crow(i, hh)) * 64 + 32 * nt + r] = f2bf(acc[nt][i]);
  if (tid == 0) {
    float* TD = (float*)(p.ws + OFF_TDEC);
    TD[((0 * NB + b) * NCH + tc) * 8 + h] = __expf(csf[127]);
    TD[((1 * NB + b) * NCH + tc) * 8 + h] = __expf(csb[0]);
  }
  __syncthreads();
}

DI void ssd_pass_item(const Params& p, int it) {
  const int e = it * 256 + ltid();
  const int pn2 = e & 2047, h = (e >> 11) & 7, b = (e >> 14) & 3, d = e >> 16;
  unsigned* S = (unsigned*)(p.ws + OFF_SST);
  const float* TD = (const float*)(p.ws + OFF_TDEC);
  unsigned sv[NCH]; float T[NCH];
#pragma unroll
  for (int i = 0; i < NCH; ++i) {
    int tc = d == 0 ? i : (i < 2 ? 1 - i : NCH + 1 - i);
    sv[i] = S[(((size_t)(d * NB + b) * NCH + tc) * 8 + h) * 2048 + pn2];
    T[i] = TD[((d * NB + b) * NCH + tc) * 8 + h];
  }
  float h0 = 0.f, h1 = 0.f;
#pragma unroll
  for (int i = 0; i < NCH; ++i) {
    int tc = d == 0 ? i : (i < 2 ? 1 - i : NCH + 1 - i);
    S[(((size_t)(d * NB + b) * NCH + tc) * 8 + h) * 2048 + pn2] = pack2(h0, h1);
    h0 = T[i] * h0 + lo2f(sv[i]); h1 = T[i] * h1 + hi2f(sv[i]);
  }
}

DI void ssd_out_item(const Params& p, int layer, int b, int tc, int h, char* smem) {
  bf16_t* XT = (bf16_t*)smem;
  bf16_t* Bs = XT + 64 * TST;
  float* csf = (float*)(Bs + 128 * BST);
  float* csb = csf + 128; float* dtF = csb + 128; float* dtB = dtF + 128; float* laF = dtB + 128; float* laB = laF + 128;
  const int tid = ltid(), w = tid >> 6, lane = tid & 63, r = lane & 31, hh = lane >> 5;
  const int row0 = chunk_row0(b, tc), g = h >> 2;
  const bf16_t* XBC = (const bf16_t*)(p.ws + OFF_XBC);
  load_tile_T(XT, XBC + (size_t)row0 * 768 + h * 64, 768);
#pragma unroll
  for (int i = 0; i < 4; ++i) {
    int c = tid + 256 * i, tok = c >> 3, part = c & 7;
    *(u32x4*)(Bs + tok * BST + part * 8) = *(const u32x4*)(XBC + (size_t)(row0 + tok) * 768 + 512 + g * 64 + part * 8);
  }
  const int l = 32 * w + r;
  bf16x8 cf[4];
#pragma unroll
  for (int ks = 0; ks < 4; ++ks) cf[ks] = *(const bf16x8*)(XBC + (size_t)(row0 + l) * 768 + 640 + g * 64 + 16 * ks + 8 * hh);
  chunk_scan(p, layer, row0, h, csf, csb, dtF, dtB, laF, laB);
  const float csf_l = csf[l], csb_l = csb[l];
  f32x16 yacc[2];
#pragma unroll
  for (int i = 0; i < 16; ++i) { yacc[0][i] = 0.f; yacc[1][i] = 0.f; }
#pragma unroll
  for (int st = 0; st < 4; ++st) {
    f32x16 gacc;
#pragma unroll
    for (int i = 0; i < 16; ++i) gacc[i] = 0.f;
#pragma unroll
    for (int ks = 0; ks < 4; ++ks) {
      bf16x8 af = *(const bf16x8*)(Bs + (32 * st + r) * BST + 16 * ks + 8 * hh);
      gacc = MFMA32(af, cf[ks], gacc);
    }
#pragma unroll
    for (int i = 0; i < 16; ++i) {
      int s = 32 * st + crow(i, hh);
      float f;
      if (s < l) f = __expf(csf_l - csf[s]) * dtF[s];
      else if (s > l) f = __expf(csb_l - csb[s]) * dtB[s];
      else f = dtF[s] + dtB[s];
      gacc[i] *= f;
    }
#pragma unroll
    for (int s2 = 0; s2 < 2; ++s2) {
      bf16x8 mf = pack8(gacc, s2);
      int sb = 32 * st + 16 * s2 + 4 * hh;
#pragma unroll
      for (int pt = 0; pt < 2; ++pt) {
        u32x2 lo = *(const u32x2*)(XT + (32 * pt + r) * TST + sb);
        u32x2 hi = *(const u32x2*)(XT + (32 * pt + r) * TST + sb + 8);
        u32x4 xa; xa[0] = lo[0]; xa[1] = lo[1]; xa[2] = hi[0]; xa[3] = hi[1];
        yacc[pt] = MFMA32(__builtin_bit_cast(bf16x8, xa), mf, yacc[pt]);
      }
    }
  }
#pragma unroll
  for (int d = 0; d < 2; ++d) {
    const bf16_t* Hs = (const bf16_t*)(p.ws + OFF_SST) + ((((size_t)d * NB + b) * NCH + tc) * 8 + h) * 4096;
    const float e = __expf(d == 0 ? csf_l : csb_l);
#pragma unroll
    for (int pt = 0; pt < 2; ++pt) {
      f32x16 t;
#pragma unroll
      for (int i = 0; i < 16; ++i) t[i] = 0.f;
#pragma unroll
      for (int ks = 0; ks < 4; ++ks) {
        bf16x8 af = *(const bf16x8*)(Hs + (32 * pt + r) * 64 + 16 * ks + 8 * hh);
        t = MFMA32(af, cf[ks], t);
      }
#pragma unroll
      for (int i = 0; i < 16; ++i) yacc[pt][i] += e * t[i];
    }
  }
  const int row = row0 + l;
  const float Dh = p.ssd_d[layer * 8 + h];
  const bf16_t* U = (const bf16_t*)(p.ws + OFF_U);
  bf16_t* YM = (bf16_t*)(p.ws + OFF_H);
  float ssq = 0.f;
  u32x2 xvv[2][4], zvv[2][4];
#pragma unroll
  for (int pt = 0; pt < 2; ++pt)
#pragma unroll
    for (int q = 0; q < 4; ++q) {
      const int pp = 32 * pt + 8 * q + 4 * hh;
      xvv[pt][q] = *(const u32x2*)(XBC + (size_t)row * 768 + h * 64 + pp);
      zvv[pt][q] = *(const u32x2*)(U + (size_t)row * DIN + U_Z + h * 64 + pp);
    }
#pragma unroll
  for (int pt = 0; pt < 2; ++pt)
#pragma unroll
    for (int q = 0; q < 4; ++q) {
      const int pp = 32 * pt + 8 * q + 4 * hh;
      const u32x2 xv = xvv[pt][q], zv = zvv[pt][q];
      float y0 = (yacc[pt][4 * q + 0] + Dh * lo2f(xv[0])) * silu_f(lo2f(zv[0]));
      float y1 = (yacc[pt][4 * q + 1] + Dh * hi2f(xv[0])) * silu_f(hi2f(zv[0]));
      float y2 = (yacc[pt][4 * q + 2] + Dh * lo2f(xv[1])) * silu_f(lo2f(zv[1]));
      float y3 = (yacc[pt][4 * q + 3] + Dh * hi2f(xv[1])) * silu_f(hi2f(zv[1]));
      u32x2 o; o[0] = pack2(y0, y1); o[1] = pack2(y2, y3);
      float r0 = lo2f(o[0]), r1 = hi2f(o[0]), r2 = lo2f(o[1]), r3 = hi2f(o[1]);
      ssq += r0 * r0 + r1 * r1 + r2 * r2 + r3 * r3;
      *(u32x2*)(YM + (size_t)row * DM + 512 + h * 64 + pp) = o;
    }
  ssq += __shfl_xor(ssq, 32);
  if (hh == 0) ((float*)(p.ws + OFF_SSQ))[(size_t)row * 8 + h] = ssq;
  __syncthreads();
}

constexpr int KST = 104;
constexpr int VST = 68;
constexpr int ASTG = 64 * KST + 64 * VST;
DI void attn_item(const Params& p, int b, int head, int qrow0, int t0, bool lat, int nkeys, char* smem) {
  bf16_t* Ks = (bf16_t*)smem;
  bf16_t* Vs = Ks + 64 * KST;
  const int tid = ltid(), w = tid >> 6, lane = tid & 63, r = lane & 31, hh = lane >> 5;
  const bf16_t* QB = (const bf16_t*)(p.ws + OFF_QB);
  const bf16_t* KB = (const bf16_t*)(p.ws + OFF_KB) + (size_t)(b * 4 + head) * LK * 96;
  const bf16_t* VT = (const bf16_t*)(p.ws + OFF_VT) + (size_t)(b * 4 + head) * 64 * LK;
  const float qscale = 0.10206207261596575f * 1.4426950408889634f;
  const int qrow = qrow0 + w * 32 + r;
  const int t = t0 + w * 32 + r;
  bf16x8 qf[6];
  {
    const bf16_t* src = QB + (size_t)qrow * 384 + head * 96;
#pragma unroll
    for (int s = 0; s < 4; ++s) {
      u32x4 v = *(const u32x4*)(src + 16 * s + 8 * hh);
      u32x4 o;
#pragma unroll
      for (int j = 0; j < 4; ++j) o[j] = pack2(lo2f(v[j]) * qscale, hi2f(v[j]) * qscale);
      qf[s] = __builtin_bit_cast(bf16x8, o);
    }
#pragma unroll
    for (int s = 4; s < 6; ++s) {
      u32x4 va = *(const u32x4*)(src + 16 * s), vb = *(const u32x4*)(src + 16 * s + 8);
      float posf = s == 4 ? (float)(t >> 6) : (float)(t & 63);
      float o[8];
#pragma unroll
      for (int j = 0; j < 8; ++j) {
        float a = (j & 1) ? hi2f(va[j >> 1]) : lo2f(va[j >> 1]);
        float bb = (j & 1) ? hi2f(vb[j >> 1]) : lo2f(vb[j >> 1]);
        float res;
        if (lat) {
          float invf = exp2f(-(float)(2 * j) * (13.287712379549449f / 16.f));
          float rev = posf * invf * 0.15915494309189535f;
          float cs = __builtin_amdgcn_cosf(rev), sn = __builtin_amdgcn_sinf(rev);
          res = hh == 0 ? a * cs - bb * sn : bb * cs + a * sn;
        } else res = hh == 0 ? a : bb;
        o[j] = res * qscale;
      }
      u32x4 ov; ov[0] = pack2(o[0], o[1]); ov[1] = pack2(o[2], o[3]); ov[2] = pack2(o[4], o[5]); ov[3] = pack2(o[6], o[7]);
      qf[s] = __builtin_bit_cast(bf16x8, ov);
    }
  }
  f32x16 oacc[2];
#pragma unroll
  for (int i = 0; i < 16; ++i) { oacc[0][i] = 0.f; oacc[1][i] = 0.f; }
  float m = -1e30f, lsum = 0.f;
  u32x4 rk[3], rv[2];
  auto gload = [&](int key0) {
#pragma unroll
    for (int i = 0; i < 3; ++i) rk[i] = *(const u32x4*)(KB + (size_t)key0 * 96 + (tid + 256 * i) * 8);
#pragma unroll
    for (int i = 0; i < 2; ++i) { int c = tid + 256 * i; rv[i] = *(const u32x4*)(VT + (size_t)(c >> 3) * LK + key0 + (c & 7) * 8); }
  };
  gload(0);
  const int NT = nkeys / 64;
  for (int kt = 0; kt < NT; ++kt) {
#pragma unroll
    for (int i = 0; i < 3; ++i) { int c = tid + 256 * i; *(u32x4*)(Ks + (c / 12) * KST + (c % 12) * 8) = rk[i]; }
#pragma unroll
    for (int i = 0; i < 2; ++i) {
      int c = tid + 256 * i;
      bf16_t* d = Vs + (c >> 3) * VST + (c & 7) * 8;
      u32x2 a; a[0] = rv[i][0]; a[1] = rv[i][1];
      u32x2 bq; bq[0] = rv[i][2]; bq[1] = rv[i][3];
      *(u32x2*)d = a; *(u32x2*)(d + 4) = bq;
    }
    __syncthreads();
    if (kt + 1 < NT) gload((kt + 1) * 64);
    f32x16 sacc[2];
#pragma unroll
    for (int i = 0; i < 16; ++i) { sacc[0][i] = 0.f; sacc[1][i] = 0.f; }
#pragma unroll
    for (int s = 0; s < 6; ++s)
#pragma unroll
      for (int k2 = 0; k2 < 2; ++k2) {
        bf16x8 af = *(const bf16x8*)(Ks + (32 * k2 + r) * KST + 16 * s + 8 * hh);
        sacc[k2] = MFMA32(af, qf[s], sacc[k2]);
      }
    float mx = sacc[0][0];
#pragma unroll
    for (int i = 0; i < 16; ++i) { mx = fmaxf(mx, sacc[0][i]); mx = fmaxf(mx, sacc[1][i]); }
    mx = fmaxf(mx, __shfl_xor(mx, 32));
    const float mn = fmaxf(m, mx);
    const float alpha = __builtin_amdgcn_exp2f(m - mn);
    m = mn;
    float ps = 0.f;
#pragma unroll
    for (int i = 0; i < 16; ++i) {
      sacc[0][i] = __builtin_amdgcn_exp2f(sacc[0][i] - mn); sacc[1][i] = __builtin_amdgcn_exp2f(sacc[1][i] - mn);
      ps += sacc[0][i] + sacc[1][i];
    }
    lsum = lsum * alpha + ps;
#pragma unroll
    for (int i = 0; i < 16; ++i) { oacc[0][i] *= alpha; oacc[1][i] *= alpha; }
#pragma unroll
    for (int k2 = 0; k2 < 2; ++k2)
#pragma unroll
      for (int s2 = 0; s2 < 2; ++s2) {
        bf16x8 pf = pack8(sacc[k2], s2);
        int kb0 = 32 * k2 + 16 * s2 + 4 * hh;
#pragma unroll
        for (int d = 0; d < 2; ++d) {
          u32x2 lo = *(const u32x2*)(Vs + (32 * d + r) * VST + kb0);
          u32x2 hi = *(const u32x2*)(Vs + (32 * d + r) * VST + kb0 + 8);
          u32x4 va; va[0] = lo[0]; va[1] = lo[1]; va[2] = hi[0]; va[3] = hi[1];
          oacc[d] = MFMA32(__builtin_bit_cast(bf16x8, va), pf, oacc[d]);
        }
      }
    __syncthreads();
  }
  lsum += __shfl_xor(lsum, 32);
  const float inv = 1.f / lsum;
  bf16_t* YM = (bf16_t*)(p.ws + OFF_H) + (size_t)qrow * DM + head * 64;
#pragma unroll
  for (int d = 0; d < 2; ++d)
#pragma unroll
    for (int q = 0; q < 4; ++q) {
      u32x2 o; o[0] = pack2(oacc[d][4 * q] * inv, oacc[d][4 * q + 1] * inv); o[1] = pack2(oacc[d][4 * q + 2] * inv, oacc[d][4 * q + 3] * inv);
      *(u32x2*)(YM + 32 * d + 8 * q + 4 * hh) = o;
    }
}

DI void attn_item8(const Params& p, int b, int head, int qrow0, int t0, bool lat, int nkeys, char* smem) {
  bf16_t* Ks = (bf16_t*)smem;
  bf16_t* Vs = Ks + 64 * KST;
  const int tid = ltid512(), w = tid >> 6, lane = tid & 63, r = lane & 31, hh = lane >> 5;
  const bf16_t* QB = (const bf16_t*)(p.ws + OFF_QB);
  const bf16_t* KB = (const bf16_t*)(p.ws + OFF_KB) + (size_t)(b * 4 + head) * LK * 96;
  const bf16_t* VT = (const bf16_t*)(p.ws + OFF_VT) + (size_t)(b * 4 + head) * 64 * LK;
  const float qscale = 0.10206207261596575f * 1.4426950408889634f;
  const int qrow = qrow0 + w * 32 + r;
  const int t = t0 + w * 32 + r;
  bf16x8 qf[6];
  {
    const bf16_t* src = QB + (size_t)qrow * 384 + head * 96;
#pragma unroll
    for (int s = 0; s < 4; ++s) {
      u32x4 v = *(const u32x4*)(src + 16 * s + 8 * hh);
      u32x4 o;
#pragma unroll
      for (int j = 0; j < 4; ++j) o[j] = pack2(lo2f(v[j]) * qscale, hi2f(v[j]) * qscale);
      qf[s] = __builtin_bit_cast(bf16x8, o);
    }
#pragma unroll
    for (int s = 4; s < 6; ++s) {
      u32x4 va = *(const u32x4*)(src + 16 * s), vb = *(const u32x4*)(src + 16 * s + 8);
      float posf = s == 4 ? (float)(t >> 6) : (float)(t & 63);
      float o[8];
#pragma unroll
      for (int j = 0; j < 8; ++j) {
        float a = (j & 1) ? hi2f(va[j >> 1]) : lo2f(va[j >> 1]);
        float bb = (j & 1) ? hi2f(vb[j >> 1]) : lo2f(vb[j >> 1]);
        float res;
        if (lat) {
          float invf = exp2f(-(float)(2 * j) * (13.287712379549449f / 16.f));
          float rev = posf * invf * 0.15915494309189535f;
          float cs = __builtin_amdgcn_cosf(rev), sn = __builtin_amdgcn_sinf(rev);
          res = hh == 0 ? a * cs - bb * sn : bb * cs + a * sn;
        } else res = hh == 0 ? a : bb;
        o[j] = res * qscale;
      }
      u32x4 ov; ov[0] = pack2(o[0], o[1]); ov[1] = pack2(o[2], o[3]); ov[2] = pack2(o[4], o[5]); ov[3] = pack2(o[6], o[7]);
      qf[s] = __builtin_bit_cast(bf16x8, ov);
    }
  }
  f32x16 oacc[2];
#pragma unroll
  for (int i = 0; i < 16; ++i) { oacc[0][i] = 0.f; oacc[1][i] = 0.f; }
  float m = -1e30f, lsum = 0.f;
  u32x4 rk[2], rv;
  auto gload = [&](int key0) {
    rk[0] = *(const u32x4*)(KB + (size_t)key0 * 96 + tid * 8);
    if (tid < 256) rk[1] = *(const u32x4*)(KB + (size_t)key0 * 96 + (512 + tid) * 8);
    rv = *(const u32x4*)(VT + (size_t)(tid >> 3) * LK + key0 + (tid & 7) * 8);
  };
  const int kro = (tid / 12) * KST + (tid % 12) * 8, kro2 = ((512 + tid) / 12) * KST + ((512 + tid) % 12) * 8;
  auto swrite = [&](int stage) {
    bf16_t* Kd = Ks + stage * ASTG;
    *(u32x4*)(Kd + kro) = rk[0];
    if (tid < 256) *(u32x4*)(Kd + kro2) = rk[1];
    bf16_t* d = Kd + 64 * KST + (tid >> 3) * VST + (tid & 7) * 8;
    u32x2 a; a[0] = rv[0]; a[1] = rv[1];
    u32x2 bq; bq[0] = rv[2]; bq[1] = rv[3];
    *(u32x2*)d = a; *(u32x2*)(d + 4) = bq;
  };
  auto qk = [&](int stage, f32x16 (&sa)[2]) {
    const bf16_t* Kc = Ks + stage * ASTG;
#pragma unroll
    for (int i = 0; i < 16; ++i) { sa[0][i] = 0.f; sa[1][i] = 0.f; }
#pragma unroll
    for (int s = 0; s < 6; ++s)
#pragma unroll
      for (int k2 = 0; k2 < 2; ++k2) {
        bf16x8 af = *(const bf16x8*)(Kc + (32 * k2 + r) * KST + 16 * s + 8 * hh);
        sa[k2] = MFMA32(af, qf[s], sa[k2]);
      }
  };
  const int NT = nkeys / 64;
  f32x16 sacc[2], snext[2];
  gload(0); swrite(0);
  gload(64);
  __syncthreads();
  swrite(1);
  gload(128);
  qk(0, sacc);
  __syncthreads();
  int cur = 0, nxt = 1, nn = 2;
  for (int kt = 0; kt < NT; ++kt) {
    if (kt + 1 < NT) qk(nxt, snext);
    if (kt + 2 < NT) {
      swrite(nn);
      if (kt + 3 < NT) gload((kt + 3) * 64);
    }
    const bf16_t* Vc = Ks + cur * ASTG + 64 * KST;
    float mx = sacc[0][0];
#pragma unroll
    for (int i = 0; i < 16; ++i) { mx = fmaxf(mx, sacc[0][i]); mx = fmaxf(mx, sacc[1][i]); }
    mx = fmaxf(mx, __shfl_xor(mx, 32));
    const float mn = fmaxf(m, mx);
    const float alpha = __builtin_amdgcn_exp2f(m - mn);
    m = mn;
    float ps = 0.f;
#pragma unroll
    for (int i = 0; i < 16; ++i) {
      sacc[0][i] = __builtin_amdgcn_exp2f(sacc[0][i] - mn); sacc[1][i] = __builtin_amdgcn_exp2f(sacc[1][i] - mn);
      ps += sacc[0][i] + sacc[1][i];
    }
    lsum = lsum * alpha + ps;
#pragma unroll
    for (int i = 0; i < 16; ++i) { oacc[0][i] *= alpha; oacc[1][i] *= alpha; }
#pragma unroll
    for (int k2 = 0; k2 < 2; ++k2)
#pragma unroll
      for (int s2 = 0; s2 < 2; ++s2) {
        bf16x8 pf = pack8(sacc[k2], s2);
        int kb0 = 32 * k2 + 16 * s2 + 4 * hh;
#pragma unroll
        for (int d = 0; d < 2; ++d) {
          u32x2 lo = *(const u32x2*)(Vc + (32 * d + r) * VST + kb0);
          u32x2 hi = *(const u32x2*)(Vc + (32 * d + r) * VST + kb0 + 8);
          u32x4 va; va[0] = lo[0]; va[1] = lo[1]; va[2] = hi[0]; va[3] = hi[1];
          oacc[d] = MFMA32(__builtin_bit_cast(bf16x8, va), pf, oacc[d]);
        }
      }
    sacc[0] = snext[0]; sacc[1] = snext[1];
    const int t3 = cur; cur = nxt; nxt = nn; nn = t3;
    __syncthreads();
  }
  lsum += __shfl_xor(lsum, 32);
  const float inv = 1.f / lsum;
  bf16_t* YM = (bf16_t*)(p.ws + OFF_H) + (size_t)qrow * DM + head * 64;
#pragma unroll
  for (int d = 0; d < 2; ++d)
#pragma unroll
    for (int q = 0; q < 4; ++q) {
      u32x2 o; o[0] = pack2(oacc[d][4 * q] * inv, oacc[d][4 * q + 1] * inv); o[1] = pack2(oacc[d][4 * q + 2] * inv, oacc[d][4 * q + 3] * inv);
      *(u32x2*)(YM + 32 * d + 8 * q + 4 * hh) = o;
    }
}

DI void phase_qkv(const Params& p, int layer, int bid, int nb, char* smem) {
  const int MQ = layer == 0 ? MT : ML;
  const int nq = (MQ / 128) * 3, nkv = (MT / 128) * 4, nst = NB * NCH * 8;
  const float* RS = (const float*)(p.ws + OFF_RSTD);
  EpiQ eq{(bf16_t*)(p.ws + OFF_QB), RS};
  EpiKV ekv{(bf16_t*)(p.ws + OFF_KB), (bf16_t*)(p.ws + OFF_VT), RS};
  const bf16_t* U = (const bf16_t*)(p.ws + OFF_U);
  for (int it = bid; it < nq + nkv + nst; it += nb) {
    if (it < nq) gemm_tile<false>(U, DIN, wt_ptr(p, layer, WT_UQ), 256, (it / 3) * 128, (it % 3) * 128, smem, eq);
    else if (it < nq + nkv) { int j = it - nq; gemm_tile<false>(U + U_CKV, DIN, wt_ptr(p, layer, WT_UKV), 128, (j / 4) * 128, (j % 4) * 128, smem, ekv); }
    else { int j = it - nq - nkv; for (int rep = 0; rep < REP_SSD; ++rep) ssd_state_item(p, layer, j / (NCH * 8), (j / 8) % NCH, j & 7, smem); }
  }
}
DI void phase_att(const Params& p, int layer, int bid, int nb, int vbid, int nvb, char* smem, char* sh) {
  for (int it = bid; it < 256; it += nb) {
    const int x = it & 7, j = it >> 3, bh = 2 * x + (j >> 4), qb = j & 15, b = bh >> 2, head = bh & 3;
    for (int rep = 0; rep < REP_ATT; ++rep) attn_item8(p, b, head, b * SEQ + qb * 256, qb * 256, true, LK, smem);
  }
  const int nctx = layer == 0 ? 32 : 0, npass = 512;
  for (int it = vbid; it < nctx + npass; it += nvb) {
    if (it < nctx) { int b = it >> 3, head = (it >> 1) & 3, qb = it & 1; attn_item(p, b, head, ML + b * CTX + qb * 128, qb * 128, false, CTX, sh); }
    else ssd_pass_item(p, it - nctx);
  }
}
DI void phase_ssdout(const Params& p, int layer, int bid, int nb, char* smem) {
  for (int it = bid; it < NB * NCH * 8; it += nb) {
    int b = it / (NCH * 8), tc = (it / 8) % NCH, h = it & 7;
    if (layer == 1 && tc < 2) continue;
    for (int rep = 0; rep < REP_SSD; ++rep) ssd_out_item(p, layer, b, tc, h, smem);
  }
}


#define XB_TMO      128
#define XB_XCNT(j)  (256  + 64 * (j))
#define XB_XSUB(j)  (1280 + 64 * (j))
#define XB_XGEN(j)  (2304 + 64 * (j))
#define XB_TOP      3328
#define XB_TOPGEN   3392
#define XCD_BAR_WORDS 3456
#define XB_SPIN_CAP (1u << 22)
#define LAS __attribute__((address_space(3)))
DI unsigned xb_ld(unsigned* p) { return __hip_atomic_load(p, __ATOMIC_RELAXED, __HIP_MEMORY_SCOPE_AGENT); }
DI unsigned xb_add(unsigned* p, unsigned v) { return __hip_atomic_fetch_add(p, v, __ATOMIC_RELAXED, __HIP_MEMORY_SCOPE_AGENT); }
DI unsigned xb_xcc_id() { return (unsigned)__builtin_amdgcn_s_getreg((3 << 11) | 20) & 0xFu; }
#define XB_SPIN(cond, bar) do { unsigned _sp = 0; while (cond) { __builtin_amdgcn_s_sleep(1); \
    if ((++_sp & 255u) == 0u) { if (xb_ld(&(bar)[XB_TMO])) break; if (_sp > XB_SPIN_CAP) { atomicAdd(&(bar)[XB_TMO], 1u); break; } } } } while (0)
struct XcdBarrier { unsigned* bar; unsigned x; volatile LAS unsigned* st; };
DI XcdBarrier xcd_barrier_post(unsigned* bar, volatile LAS unsigned* st) {
  XcdBarrier b; b.bar = bar; b.x = xb_xcc_id(); b.st = st;
  if (threadIdx.x == 0) (void)xb_add(&bar[XB_XCNT(b.x)], 1u);
  return b;
}
DI void xcd_barrier_complete(unsigned* bar, unsigned x, unsigned& nloc, unsigned& nx) {
  const unsigned G = gridDim.x * gridDim.y * gridDim.z;
  unsigned sum, cnt, mine, sp = 0u;
  for (;;) {
    sum = 0u; cnt = 0u; mine = 0u;
#pragma unroll
    for (unsigned j = 0; j < 16; ++j) { const unsigned c = xb_ld(&bar[XB_XCNT(j)]); sum += c; cnt += (c > 0u) ? 1u : 0u; mine = (j == x) ? c : mine; }
    if (sum == G) break;
    __builtin_amdgcn_s_sleep(1);
    if ((++sp & 255u) == 0u) { if (xb_ld(&bar[XB_TMO])) break; if (sp > XB_SPIN_CAP) { atomicAdd(&bar[XB_TMO], 1u); break; } }
  }
  nloc = mine > 0u ? mine : 1u; nx = cnt > 0u ? cnt : 1u;
}
DI void xcd_barrier(const XcdBarrier& b) {
  asm volatile("s_waitcnt vmcnt(0)" ::: "memory");
  __syncthreads();
  if (threadIdx.x == 0) {
    unsigned* bar = b.bar;
    asm volatile("" : "+s"(bar));
    __builtin_amdgcn_s_waitcnt(0);
    unsigned nloc = b.st[0], nx = b.st[1];
    if (nloc == 0u) { xcd_barrier_complete(bar, b.x, nloc, nx); b.st[0] = nloc; b.st[1] = nx; }
    const unsigned old = xb_add(&bar[XB_XSUB(b.x)], 1u);
    const unsigned gen = old / nloc;
    if (old + 1u == (gen + 1u) * nloc) {
      __builtin_amdgcn_fence(__ATOMIC_RELEASE, "agent");
      asm volatile("s_waitcnt vmcnt(0)" ::: "memory");
      const unsigned og = xb_add(&bar[XB_TOP], 1u);
      const unsigned tg = og / nx;
      if (og + 1u == (tg + 1u) * nx) xb_add(&bar[XB_TOPGEN], 1u);
      else XB_SPIN(xb_ld(&bar[XB_TOPGEN]) == tg, bar);
      __builtin_amdgcn_fence(__ATOMIC_ACQUIRE, "agent");
      xb_add(&bar[XB_XGEN(b.x)], 1u);
      asm volatile("s_waitcnt vmcnt(0)" ::: "memory");
    } else {
      XB_SPIN(xb_ld(&bar[XB_XGEN(b.x)]) == gen, bar);
      __builtin_amdgcn_fence(__ATOMIC_ACQUIRE, "agent");
      asm volatile("s_waitcnt vmcnt(0)" ::: "memory");
    }
  }
  __syncthreads();
}

constexpr int SMEM_BYTES = 2 * GBUF * 2;
enum { PH_PREP0 = 0, PH_H0, PH_INPROJ, PH_PREP, PH_QKV, PH_ATT, PH_SSDOUT, PH_WOUT, PH_POSTMIX, PH_FF1, PH_FF2, PH_POSTFFN, PH_SSDNORM };

struct Ids { int bid, nb, vbid, nvb, lid; };
DI void run_phase(const Params& p, int ph, int layer, const Ids& id, char* smem, char* sh) {
  switch (ph) {
    case PH_PREP0: phase_prep0(p, id.vbid, id.nvb, sh); break;
    case PH_H0: phase_h0(p, id.vbid, id.nvb); break;
    case PH_INPROJ: phase_inproj(p, layer, id.bid, id.nb, smem); break;
    case PH_PREP: phase_prep(p, layer, id.vbid, id.nvb); break;
    case PH_QKV: phase_qkv(p, layer, id.vbid, id.nvb, sh); break;
    case PH_ATT: phase_att(p, layer, id.bid, id.nb, id.vbid, id.nvb, smem, sh); break;
    case PH_SSDOUT: phase_ssdout(p, layer, id.vbid, id.nvb, sh); break;
    case PH_WOUT: phase_wout(p, layer, id.lid, id.nvb, sh); break;
    case PH_POSTMIX: phase_postmix(p, layer, id.vbid, id.nvb); break;
    case PH_FF1: phase_ff1(p, layer, id.bid, id.nb, id.vbid, id.nvb, smem, sh); break;
    case PH_FF2: phase_ff2(p, layer, id.bid, id.nb, id.vbid, id.nvb, smem, sh); break;
    case PH_POSTFFN: phase_postffn(p, layer, id.vbid, id.nvb); break;
  }
}

__global__ void __launch_bounds__(512) mega_kernel(Params p) {
  extern __shared__ __attribute__((aligned(16))) char smem[];
  cg::grid_group grid = cg::this_grid();
  if (p.ws == nullptr) grid.sync();
  const int half = __builtin_amdgcn_readfirstlane((int)(threadIdx.x >> 8));
  Ids id;
  id.bid = blockIdx.x; id.nb = gridDim.x;
  id.vbid = 2 * id.bid + half; id.nvb = 2 * id.nb;
  id.lid = (id.bid & 7) + 8 * (2 * (id.bid >> 3) + half);
  char* sh = smem + half * SMEM_BYTES;
  volatile LAS unsigned* st = (volatile LAS unsigned*)(smem + 2 * SMEM_BYTES - 16);
  if (threadIdx.x == 0) { st[0] = 0u; st[1] = 0u; st[2] = 0u; st[3] = 0u; }
  __syncthreads();
  XcdBarrier xb = xcd_barrier_post((unsigned*)(p.ws + OFF_BAR), st);
#define MK_STEP(PH, LAYER, LAST) do { \
    typedef const void* __attribute__((address_space(4))) * KArgs; \
    KArgs ka = (KArgs)__builtin_amdgcn_kernarg_segment_ptr(); \
    asm volatile("" : "+s"(ka)); \
    Params q; \
    { const void** dst = (const void**)&q; _Pragma("unroll") for (int i = 0; i < 27; ++i) dst[i] = ka[i]; } \
    run_phase(q, PH, LAYER, id, smem, sh); \
    if (!(LAST)) xcd_barrier(xb); } while (0)
  MK_STEP(PH_PREP0, 0, false);
  MK_STEP(PH_H0, 0, false);
  MK_STEP(PH_INPROJ, 0, false); MK_STEP(PH_PREP, 0, false); MK_STEP(PH_QKV, 0, false); MK_STEP(PH_ATT, 0, false); MK_STEP(PH_SSDOUT, 0, false);
  MK_STEP(PH_WOUT, 0, false); MK_STEP(PH_POSTMIX, 0, false); MK_STEP(PH_FF1, 0, false); MK_STEP(PH_FF2, 0, false); MK_STEP(PH_POSTFFN, 0, false);
  MK_STEP(PH_INPROJ, 1, false); MK_STEP(PH_PREP, 1, false); MK_STEP(PH_QKV, 1, false); MK_STEP(PH_ATT, 1, false); MK_STEP(PH_SSDOUT, 1, false);
  MK_STEP(PH_WOUT, 1, false); MK_STEP(PH_POSTMIX, 1, false); MK_STEP(PH_FF1, 1, false); MK_STEP(PH_FF2, 1, false); MK_STEP(PH_POSTFFN, 1, true);
#undef MK_STEP
}

extern "C" void kernel_launch(void* const* d_in, const int* in_sizes, int n_in, void* d_out, int out_size, void* d_ws, size_t ws_size,
                              hipStream_t stream) {
  if (ws_size < WS_NEED) { fprintf(stderr, "workspace too small: %zu < %zu\n", ws_size, (size_t)WS_NEED); return; }
  Params p{};
  const float** f = (const float**)&p;
  for (int i = 0; i < 25; ++i) f[i] = (const float*)d_in[i];
  p.out = (float*)d_out;
  p.ws = (char*)d_ws;
  static int grid_blocks = 0;
  if (!grid_blocks) {
    int dev = 0, cus = 0, per_cu = 0;
    hipGetDevice(&dev);
    hipDeviceGetAttribute(&cus, hipDeviceAttributeMultiprocessorCount, dev);
    hipFuncSetAttribute((const void*)mega_kernel, hipFuncAttributeMaxDynamicSharedMemorySize, 2 * SMEM_BYTES);
    hipOccupancyMaxActiveBlocksPerMultiprocessor(&per_cu, mega_kernel, 512, 2 * SMEM_BYTES);
    if (per_cu > 1) per_cu = 1;
    grid_blocks = cus * per_cu;
  }
  hipMemsetAsync((char*)d_ws + OFF_BAR, 0, XCD_BAR_WORDS * 4, stream);
  void* args[] = {&p};
  hipError_t e = hipLaunchCooperativeKernel((void*)mega_kernel, dim3(grid_blocks), dim3(512), args, 2 * SMEM_BYTES, stream);
  if (e != hipSuccess) fprintf(stderr, "cooperative launch failed: %s (grid %d)\n", hipGetErrorString(e), grid_blocks);
}
```

```cpp
#include <hip/hip_runtime.h>
#include <hip/hip_cooperative_groups.h>
#include <stdint.h>
#include <stdio.h>
namespace cg = cooperative_groups;

#ifndef MEGA
#define MEGA 1
#endif
#ifndef REP_GEMM
#define REP_GEMM 1
#endif
#ifndef REP_ATT
#define REP_ATT 1
#endif
#ifndef REP_SSD
#define REP_SSD 1
#endif

typedef unsigned short bf16_t;
using bf16x8 = __attribute__((ext_vector_type(8))) short;
using s16x4  = __attribute__((ext_vector_type(4))) short;
using f32x4  = __attribute__((ext_vector_type(4))) float;
using f32x16 = __attribute__((ext_vector_type(16))) float;
using u32x4  = __attribute__((ext_vector_type(4))) unsigned;
using u32x2  = __attribute__((ext_vector_type(2))) unsigned;
#define DI __device__ __forceinline__
#define MFMA32(a, b, c) __builtin_amdgcn_mfma_f32_32x32x16_bf16((a), (b), (c), 0, 0, 0)
#define MFMA16(a, b, c) __builtin_amdgcn_mfma_f32_16x16x32_bf16((a), (b), (c), 0, 0, 0)

constexpr int DM = 1024, NB = 4, SEQ = 4096, CTX = 256;
constexpr int ML = NB * SEQ;
constexpr int MC = NB * CTX;
constexpr int MT = ML + MC;
constexpr int DIN = 2480, DINP = 2560;
constexpr int LK = CTX + SEQ;
constexpr int DFF = 4096;
constexpr int NCH = 34;
constexpr float EPS = 1e-6f;
constexpr int U_CKV = 256, U_KR = 384, U_GB = 416, U_GC = 672, U_VAL = 928, U_Z = 1184, U_XBC = 1696, U_DT = 2464;

constexpr size_t AL(size_t x) { return (x + 255) & ~(size_t)255; }
constexpr size_t WT_IN = 0;
constexpr size_t WT_UQ = WT_IN + (size_t)DINP * 1024;
constexpr size_t WT_UKV = WT_UQ + (size_t)384 * 256;
constexpr size_t WT_OUT = WT_UKV + (size_t)512 * 128;
constexpr size_t WT_FF1 = WT_OUT + (size_t)1024 * 1024;
constexpr size_t WT_FF2 = WT_FF1 + (size_t)4096 * 1024;
constexpr size_t WT_ELEMS = WT_FF2 + (size_t)4096 * 1024;
constexpr size_t OFF_WT = 0;
constexpr size_t OFF_MOD = AL(OFF_WT + 2 * WT_ELEMS * 2);
constexpr size_t OFF_XC = AL(OFF_MOD + 2 * 5 * 6144 * 4);
constexpr size_t OFF_H = AL(OFF_XC + (size_t)MC * DM * 4);
constexpr size_t OFF_R1 = AL(OFF_H + (size_t)MT * DM * 2);
constexpr size_t OFF_U = OFF_R1;
constexpr size_t OFF_DT = AL(OFF_U + (size_t)MT * DIN * 2);
constexpr size_t OFF_RSTD = AL(OFF_DT + (size_t)MT * 16 * 4);
constexpr size_t OFF_QB = AL(OFF_RSTD + (size_t)MT * 2 * 4);
constexpr size_t OFF_KB = AL(OFF_QB + (size_t)MT * 384 * 2);
constexpr size_t OFF_VT = AL(OFF_KB + (size_t)NB * 4 * LK * 96 * 2);
constexpr size_t OFF_XBC = AL(OFF_VT + (size_t)NB * 4 * 64 * LK * 2);
constexpr size_t OFF_SST = AL(OFF_XBC + (size_t)MT * 768 * 2);
constexpr size_t OFF_TDEC = AL(OFF_SST + (size_t)2 * NB * NCH * 8 * 4096 * 2);
constexpr size_t OFF_SSQ = AL(OFF_TDEC + (size_t)2 * NB * NCH * 8 * 4);
constexpr size_t OFF_END1 = AL(OFF_SSQ + (size_t)MT * 8 * 4);
constexpr size_t OFF_F1 = OFF_R1;
constexpr size_t OFF_END2 = AL(OFF_F1 + (size_t)MT * DFF * 2);
constexpr size_t OFF_BAR = OFF_END1 > OFF_END2 ? OFF_END1 : OFF_END2;
constexpr size_t WS_NEED = OFF_BAR + 16384;

struct Params {
  const float *x, *c, *ctx, *c_ctx, *w_mod, *b_mod, *g_pre_mix, *w_in, *q_norm, *w_uq, *kv_norm, *w_ukv, *sc_w, *ssd_cw, *ssd_cb,
      *a_log, *dt_bias, *ssd_d, *ssd_norm, *w_out, *g_post_mix, *g_pre_ffn, *w_ff1, *w_ff2, *g_post_ffn;
  float* out;
  char* ws;
};

DI int ltid() { int t = threadIdx.x; asm volatile("" : "+v"(t)); return t & 255; }
DI int ltid512() { int t = threadIdx.x; asm volatile("" : "+v"(t)); return t; }
typedef __bf16 hbf2 __attribute__((ext_vector_type(2)));
typedef float hf2 __attribute__((ext_vector_type(2)));
DI bf16_t f2bf(float x) { return __builtin_bit_cast(bf16_t, (__bf16)x); }
DI float bf2f(unsigned v) { return __uint_as_float(v << 16); }
DI unsigned pack2(float a, float b) { hf2 v = {a, b}; return __builtin_bit_cast(unsigned, __builtin_convertvector(v, hbf2)); }
DI float lo2f(unsigned w) { return __uint_as_float(w << 16); }
DI float hi2f(unsigned w) { return __uint_as_float(w & 0xffff0000u); }
DI float wave_sum(float v) {
#pragma unroll
  for (int o = 32; o > 0; o >>= 1) v += __shfl_xor(v, o);
  return v;
}
DI float silu_f(float x) { return x / (1.f + __expf(-x)); }
DI int crow(int reg, int h) { return (reg & 3) + 8 * (reg >> 2) + 4 * h; }
DI bf16x8 pack8(const f32x16& x, int s) {
  u32x4 p;
  p[0] = pack2(x[8 * s + 0], x[8 * s + 1]); p[1] = pack2(x[8 * s + 2], x[8 * s + 3]);
  p[2] = pack2(x[8 * s + 4], x[8 * s + 5]); p[3] = pack2(x[8 * s + 6], x[8 * s + 7]);
  return __builtin_bit_cast(bf16x8, p);
}
DI const float* xin_row(const Params& p, int layer, int row) {
  if (layer == 0) return row < ML ? p.x + (size_t)row * DM : p.ctx + (size_t)(row - ML) * DM;
  return row < ML ? p.out + (size_t)row * DM : (const float*)(p.ws + OFF_XC) + (size_t)(row - ML) * DM;
}
DI float* xst_row(const Params& p, int row) {
  return row < ML ? p.out + (size_t)row * DM : (float*)(p.ws + OFF_XC) + (size_t)(row - ML) * DM;
}
DI const float* mod_ptr(const Params& p, int layer, int row, int which) {
  int bb = row < ML ? (row >> 12) : 4;
  return (const float*)(p.ws + OFF_MOD) + ((size_t)(layer * 5 + bb) * 6 + which) * DM;
}
DI bf16_t* wt_ptr(const Params& p, int layer, size_t off) { return (bf16_t*)(p.ws + OFF_WT) + (size_t)layer * WT_ELEMS + off; }

DI void transpose_item(const float* __restrict__ w, const float* __restrict__ gk, int gk_from, bf16_t* __restrict__ wt, int K, int N, int kt, int nt, char* smem) {
  float* tile = (float*)smem;
  const int tid = ltid(), tx = tid & 63, ty = tid >> 6;
  const int k0 = kt * 64, n0 = nt * 64;
  const int n = n0 + tx;
  float v[16];
#pragma unroll
  for (int i = 0; i < 16; ++i) {
    int kk = ty + 4 * i;
    v[i] = n < N ? w[(size_t)(k0 + kk) * N + n] : 0.f;
  }
  if (gk) {
#pragma unroll
    for (int i = 0; i < 16; ++i) { int k = k0 + ty + 4 * i; if (k >= gk_from) v[i] *= gk[k - gk_from]; }
  }
#pragma unroll
  for (int i = 0; i < 16; ++i) tile[(ty + 4 * i) * 65 + tx] = v[i];
  __syncthreads();
#pragma unroll
  for (int i = 0; i < 2; ++i) {
    int c = tid + 256 * i, nn = c >> 3, kc = c & 7;
    u32x4 o;
#pragma unroll
    for (int jj = 0; jj < 4; ++jj) o[jj] = pack2(tile[(kc * 8 + 2 * jj) * 65 + nn], tile[(kc * 8 + 2 * jj + 1) * 65 + nn]);
    *(u32x4*)(wt + (size_t)(n0 + nn) * K + k0 + kc * 8) = o;
  }
  __syncthreads();
}

DI void modgemv_item(const Params& p, int layer, int ct, char* smem) {
  float* s = (float*)smem;
  float* red = s + 5 * 1024;
  const int tid = ltid(), w = tid >> 6, lane = tid & 63;
  for (int i = tid; i < 5 * 1024; i += 256) {
    int bb = i >> 10, k = i & 1023;
    float v = bb < 4 ? p.c[bb * 1024 + k] : p.c_ctx[k];
    s[i] = silu_f(v);
  }
  __syncthreads();
  const float* wm = p.w_mod + (size_t)layer * 1024 * 6144;
  const int n = ct * 64 + lane;
  float acc[5] = {0.f, 0.f, 0.f, 0.f, 0.f};
#pragma unroll 16
  for (int k = w * 256; k < w * 256 + 256; ++k) {
    float wv = wm[(size_t)k * 6144 + n];
#pragma unroll
    for (int bb = 0; bb < 5; ++bb) acc[bb] += s[bb * 1024 + k] * wv;
  }
#pragma unroll
  for (int bb = 0; bb < 5; ++bb) red[(w * 5 + bb) * 64 + lane] = acc[bb];
  __syncthreads();
  for (int i = tid; i < 320; i += 256) {
    int bb = i >> 6, ln = i & 63;
    float v = red[(0 * 5 + bb) * 64 + ln] + red[(1 * 5 + bb) * 64 + ln] + red[(2 * 5 + bb) * 64 + ln] + red[(3 * 5 + bb) * 64 + ln];
    int nn = ct * 64 + ln;
    v += p.b_mod[layer * 6144 + nn];
    ((float*)(p.ws + OFF_MOD))[(size_t)(layer * 5 + bb) * 6144 + nn] = v;
  }
  __syncthreads();
}

DI void phase_prep0(const Params& p, int bid, int nb, char* smem) {
  constexpr int PER = 2984;
  for (int it = bid; it < 192 + 2 * PER; it += nb) {
    if (it < 192) { modgemv_item(p, it / 96, it % 96, smem); continue; }
    int layer = (it - 192) / PER, j = (it - 192) % PER;
    if (j < 640) transpose_item(p.w_in + (size_t)layer * 1024 * DIN, nullptr, 0, wt_ptr(p, layer, WT_IN), 1024, DIN, j / 40, j % 40, smem);
    else if ((j -= 640) < 24) transpose_item(p.w_uq + (size_t)layer * 256 * 384, p.q_norm + layer * 256, 0, wt_ptr(p, layer, WT_UQ), 256, 384, j / 6, j % 6, smem);
    else if ((j -= 24) < 16) transpose_item(p.w_ukv + (size_t)layer * 128 * 512, p.kv_norm + layer * 128, 0, wt_ptr(p, layer, WT_UKV), 128, 512, j / 8, j % 8, smem);
    else if ((j -= 16) < 256) transpose_item(p.w_out + (size_t)layer * 1024 * 1024, p.ssd_norm + layer * 512, 512, wt_ptr(p, layer, WT_OUT), 1024, 1024, j / 16, j % 16, smem);
    else if ((j -= 256) < 1024) transpose_item(p.w_ff1 + (size_t)layer * 1024 * 4096, nullptr, 0, wt_ptr(p, layer, WT_FF1), 1024, 4096, j / 64, j % 64, smem);
    else { j -= 1024; transpose_item(p.w_ff2 + (size_t)layer * 4096 * 1024, nullptr, 0, wt_ptr(p, layer, WT_FF2), 4096, 1024, j / 16, j % 16, smem); }
  }
}

struct HMod { float4 g[4], s1[4], s0[4]; };
DI void load_hmod(HMod& m, const float* g, const float* sh, const float* sc, int lane) {
#pragma unroll
  for (int i = 0; i < 4; ++i) {
    const int col = lane * 4 + 256 * i;
    m.g[i] = *(const float4*)(g + col); m.s1[i] = *(const float4*)(sc + col); m.s0[i] = *(const float4*)(sh + col);
  }
}
DI void write_h_row(const float4 xv[4], float rstd, const HMod& m, bf16_t* hrow, int lane) {
#pragma unroll
  for (int i = 0; i < 4; ++i) {
    const int col = lane * 4 + 256 * i;
    float a = xv[i].x * rstd * m.g[i].x * (1.f + m.s1[i].x) + m.s0[i].x;
    float b = xv[i].y * rstd * m.g[i].y * (1.f + m.s1[i].y) + m.s0[i].y;
    float c = xv[i].z * rstd * m.g[i].z * (1.f + m.s1[i].z) + m.s0[i].z;
    float d = xv[i].w * rstd * m.g[i].w * (1.f + m.s1[i].w) + m.s0[i].w;
    u32x2 o; o[0] = pack2(a, b); o[1] = pack2(c, d);
    *(u32x2*)(hrow + col) = o;
  }
}
DI float ssq4(const float4 v[4]) {
  float s = 0.f;
#pragma unroll
  for (int i = 0; i < 4; ++i) s += v[i].x * v[i].x + v[i].y * v[i].y + v[i].z * v[i].z + v[i].w * v[i].w;
  return s;
}
DI void load_bf_row(const bf16_t* r, int lane, float4 v[4]) {
#pragma unroll
  for (int i = 0; i < 4; ++i) {
    u32x2 t = *(const u32x2*)(r + lane * 4 + 256 * i);
    v[i] = make_float4(lo2f(t[0]), hi2f(t[0]), lo2f(t[1]), hi2f(t[1]));
  }
}

DI void phase_h0(const Params& p, int bid, int nb) {
  const int w = ltid() >> 6, lane = ltid() & 63;
  bf16_t* H = (bf16_t*)(p.ws + OFF_H);
  for (int row = bid * 4 + w; row < MT; row += nb * 4) {
    const float* xr = xin_row(p, 0, row);
    float4 xv[4];
#pragma unroll
    for (int i = 0; i < 4; ++i) xv[i] = *(const float4*)(xr + lane * 4 + 256 * i);
    HMod m; load_hmod(m, p.g_pre_mix, mod_ptr(p, 0, row, 0), mod_ptr(p, 0, row, 1), lane);
    float rstd = rsqrtf(wave_sum(ssq4(xv)) * (1.f / DM) + EPS);
    write_h_row(xv, rstd, m, H + (size_t)row * DM, lane);
  }
}

DI void phase_postmix(const Params& p, int layer, int bid, int nb) {
  const int w = ltid() >> 6, lane = ltid() & 63;
  const int M = layer == 0 ? MT : ML;
  bf16_t* H = (bf16_t*)(p.ws + OFF_H);
  const bf16_t* Y = (const bf16_t*)(p.ws + OFF_U);
  for (int row = bid * 4 + w; row < M; row += nb * 4) {
    float4 yv[4], xv[4], ga[4], gb[4];
    load_bf_row(Y + (size_t)row * DM, lane, yv);
    const float* xr = xin_row(p, layer, row);
    const float* g1 = mod_ptr(p, layer, row, 2);
    const float* gp = p.g_post_mix + layer * DM;
#pragma unroll
    for (int i = 0; i < 4; ++i) {
      const int col = lane * 4 + 256 * i;
      xv[i] = *(const float4*)(xr + col); ga[i] = *(const float4*)(g1 + col); gb[i] = *(const float4*)(gp + col);
    }
    HMod m; load_hmod(m, p.g_pre_ffn + layer * DM, mod_ptr(p, layer, row, 3), mod_ptr(p, layer, row, 4), lane);
    float rstd = rsqrtf(wave_sum(ssq4(yv)) * (1.f / DM) + EPS);
    float* xo = xst_row(p, row);
#pragma unroll
    for (int i = 0; i < 4; ++i) {
      xv[i].x += ga[i].x * yv[i].x * rstd * gb[i].x; xv[i].y += ga[i].y * yv[i].y * rstd * gb[i].y;
      xv[i].z += ga[i].z * yv[i].z * rstd * gb[i].z; xv[i].w += ga[i].w * yv[i].w * rstd * gb[i].w;
    }
#pragma unroll
    for (int i = 0; i < 4; ++i) *(float4*)(xo + lane * 4 + 256 * i) = xv[i];
    float rstd1 = rsqrtf(wave_sum(ssq4(xv)) * (1.f / DM) + EPS);
    write_h_row(xv, rstd1, m, H + (size_t)row * DM, lane);
  }
}

DI void phase_postffn(const Params& p, int layer, int bid, int nb) {
  const int w = ltid() >> 6, lane = ltid() & 63;
  const int M = layer == 0 ? MT : ML;
  bf16_t* H = (bf16_t*)(p.ws + OFF_H);
  for (int row = bid * 4 + w; row < M; row += nb * 4) {
    float4 fv[4], xv[4];
    if (row < ML) load_bf_row(H + (size_t)row * DM, lane, fv);
    else {
      const float* pp = (const float*)(p.ws + OFF_END2) + (size_t)(row - ML) * DM;
#pragma unroll
      for (int i = 0; i < 4; ++i) {
        float4 a = *(const float4*)(pp + lane * 4 + 256 * i), b = *(const float4*)(pp + (size_t)MC * DM + lane * 4 + 256 * i);
        float4 c = *(const float4*)(pp + (size_t)2 * MC * DM + lane * 4 + 256 * i), d = *(const float4*)(pp + (size_t)3 * MC * DM + lane * 4 + 256 * i);
        fv[i] = make_float4((a.x + b.x) + (c.x + d.x), (a.y + b.y) + (c.y + d.y), (a.z + b.z) + (c.z + d.z), (a.w + b.w) + (c.w + d.w));
      }
    }
    float* xo = xst_row(p, row);
    const float* g2 = mod_ptr(p, layer, row, 5);
    const float* gp = p.g_post_ffn + layer * DM;
    float4 ga[4], gb[4];
#pragma unroll
    for (int i = 0; i < 4; ++i) {
      const int col = lane * 4 + 256 * i;
      xv[i] = *(const float4*)(xo + col); ga[i] = *(const float4*)(g2 + col); gb[i] = *(const float4*)(gp + col);
    }
    HMod m;
    if (layer == 0) load_hmod(m, p.g_pre_mix + DM, mod_ptr(p, 1, row, 0), mod_ptr(p, 1, row, 1), lane);
    float rstd = rsqrtf(wave_sum(ssq4(fv)) * (1.f / DM) + EPS);
#pragma unroll
    for (int i = 0; i < 4; ++i) {
      xv[i].x += ga[i].x * fv[i].x * rstd * gb[i].x; xv[i].y += ga[i].y * fv[i].y * rstd * gb[i].y;
      xv[i].z += ga[i].z * fv[i].z * rstd * gb[i].z; xv[i].w += ga[i].w * fv[i].w * rstd * gb[i].w;
    }
#pragma unroll
    for (int i = 0; i < 4; ++i) *(float4*)(xo + lane * 4 + 256 * i) = xv[i];
    if (layer == 0) {
      float rstd1 = rsqrtf(wave_sum(ssq4(xv)) * (1.f / DM) + EPS);
      write_h_row(xv, rstd1, m, H + (size_t)row * DM, lane);
    }
  }
}

DI void phase_prep(const Params& p, int layer, int bid, int nb) {
  const int w = ltid() >> 6, lane = ltid() & 63;
  const bf16_t* U = (const bf16_t*)(p.ws + OFF_U);
  float* DT = (float*)(p.ws + OFF_DT);
  float* RS = (float*)(p.ws + OFF_RSTD);
  bf16_t* KB = (bf16_t*)(p.ws + OFF_KB);
  bf16_t* XBC = (bf16_t*)(p.ws + OFF_XBC);
  bf16_t* YM = (bf16_t*)(p.ws + OFF_H);
  const float* scw = p.sc_w + layer * 3 * 256;
  const float* cw = p.ssd_cw + layer * 3 * 768;
  const float* cb = p.ssd_cb + layer * 768;
  const int c4 = lane * 4;
  const float4 sw0 = *(const float4*)(scw + c4), sw1 = *(const float4*)(scw + 256 + c4), sw2 = *(const float4*)(scw + 512 + c4);
  float4 cwk[3][3], cbi[3];
#pragma unroll
  for (int i = 0; i < 3; ++i) {
    cbi[i] = *(const float4*)(cb + c4 + 256 * i);
#pragma unroll
    for (int k = 0; k < 3; ++k) cwk[i][k] = *(const float4*)(cw + k * 768 + c4 + 256 * i);
  }
  const float dtb = p.dt_bias[layer * 16 + (lane & 15)];
  const float invf = exp2f(-(float)(2 * (lane & 7)) * (13.287712379549449f / 16.f));
  for (int row = bid * 4 + w; row < MT; row += nb * 4) {
    int b, t, L, pos;
    const bool lat = row < ML;
    if (lat) { b = row >> 12; t = row & 4095; L = SEQ; pos = t + CTX; }
    else { int rr = row - ML; b = rr >> 8; t = rr & 255; L = CTX; pos = t; }
    const bf16_t* u0 = U + (size_t)row * DIN;
    const bool hp = t > 0, hn = t < L - 1;
    const bf16_t* um = hp ? u0 - DIN : u0;
    const bf16_t* up = hn ? u0 + DIN : u0;
    const float mp = hp ? 1.f : 0.f, mn = hn ? 1.f : 0.f;
    const u32x2 vq = *(const u32x2*)(u0 + c4);
    const u32x2 vkv = *(const u32x2*)(u0 + U_CKV + (lane & 31) * 4);
    const float kr = bf2f(u0[U_KR + (lane & 31)]);
    const u32x2 gcm = *(const u32x2*)(um + U_GC + c4), gc0 = *(const u32x2*)(u0 + U_GC + c4), gcp = *(const u32x2*)(up + U_GC + c4);
    const u32x2 vvm = *(const u32x2*)(um + U_VAL + c4), vv0 = *(const u32x2*)(u0 + U_VAL + c4), vvp = *(const u32x2*)(up + U_VAL + c4);
    const u32x2 gb = *(const u32x2*)(u0 + U_GB + c4);
    u32x2 xm[3], x0[3], xp[3];
#pragma unroll
    for (int i = 0; i < 3; ++i) {
      xm[i] = *(const u32x2*)(um + U_XBC + c4 + 256 * i);
      x0[i] = *(const u32x2*)(u0 + U_XBC + c4 + 256 * i);
      xp[i] = *(const u32x2*)(up + U_XBC + c4 + 256 * i);
    }
    const float dtr = DT[(size_t)row * 16 + (lane & 15)];
    {
      float a = lo2f(vq[0]), bq = hi2f(vq[0]), c = lo2f(vq[1]), d = hi2f(vq[1]);
      float ss = wave_sum(a * a + bq * bq + c * c + d * d);
      float e = lo2f(vkv[0]), f = hi2f(vkv[0]), g = lo2f(vkv[1]), h = hi2f(vkv[1]);
      float s2 = lane < 32 ? e * e + f * f + g * g + h * h : 0.f;
      s2 = wave_sum(s2);
      if (lane == 0) { RS[row * 2] = rsqrtf(ss * (1.f / 256) + EPS); RS[row * 2 + 1] = rsqrtf(s2 * (1.f / 128) + EPS); }
    }
    {
      const float partner = __shfl_xor(kr, 8);
      float o = kr;
      if (lat) {
        const int grp = (lane & 31) >> 3;
        const float posf = grp < 2 ? (float)(t >> 6) : (float)(t & 63);
        const float rev = posf * invf * 0.15915494309189535f;
        const float cs = __builtin_amdgcn_cosf(rev), sn = __builtin_amdgcn_sinf(rev);
        o = (grp & 1) ? kr * cs + partner * sn : kr * cs - partner * sn;
      }
      if (lane < 32) {
        const bf16_t ob = f2bf(o);
#pragma unroll
        for (int hd = 0; hd < 4; ++hd) KB[((size_t)(b * 4 + hd) * LK + pos) * 96 + 64 + lane] = ob;
      }
    }
    {
      float a0 = sw1.x * lo2f(gc0[0]) * lo2f(vv0[0]) + mp * sw0.x * lo2f(gcm[0]) * lo2f(vvm[0]) + mn * sw2.x * lo2f(gcp[0]) * lo2f(vvp[0]);
      float a1 = sw1.y * hi2f(gc0[0]) * hi2f(vv0[0]) + mp * sw0.y * hi2f(gcm[0]) * hi2f(vvm[0]) + mn * sw2.y * hi2f(gcp[0]) * hi2f(vvp[0]);
      float a2 = sw1.z * lo2f(gc0[1]) * lo2f(vv0[1]) + mp * sw0.z * lo2f(gcm[1]) * lo2f(vvm[1]) + mn * sw2.z * lo2f(gcp[1]) * lo2f(vvp[1]);
      float a3 = sw1.w * hi2f(gc0[1]) * hi2f(vv0[1]) + mp * sw0.w * hi2f(gcm[1]) * hi2f(vvm[1]) + mn * sw2.w * hi2f(gcp[1]) * hi2f(vvp[1]);
      u32x2 o; o[0] = pack2(lo2f(gb[0]) * a0, hi2f(gb[0]) * a1); o[1] = pack2(lo2f(gb[1]) * a2, hi2f(gb[1]) * a3);
      *(u32x2*)(YM + (size_t)row * DM + 256 + c4) = o;
    }
#pragma unroll
    for (int i = 0; i < 3; ++i) {
      float a0 = cbi[i].x + cwk[i][1].x * lo2f(x0[i][0]) + mp * cwk[i][0].x * lo2f(xm[i][0]) + mn * cwk[i][2].x * lo2f(xp[i][0]);
      float a1 = cbi[i].y + cwk[i][1].y * hi2f(x0[i][0]) + mp * cwk[i][0].y * hi2f(xm[i][0]) + mn * cwk[i][2].y * hi2f(xp[i][0]);
      float a2 = cbi[i].z + cwk[i][1].z * lo2f(x0[i][1]) + mp * cwk[i][0].z * lo2f(xm[i][1]) + mn * cwk[i][2].z * lo2f(xp[i][1]);
      float a3 = cbi[i].w + cwk[i][1].w * hi2f(x0[i][1]) + mp * cwk[i][0].w * hi2f(xm[i][1]) + mn * cwk[i][2].w * hi2f(xp[i][1]);
      u32x2 o; o[0] = pack2(silu_f(a0), silu_f(a1)); o[1] = pack2(silu_f(a2), silu_f(a3));
      *(u32x2*)(XBC + (size_t)row * 768 + c4 + 256 * i) = o;
    }
    if (lane < 16) {
      const float v = dtr + dtb;
      const float e = __expf(-fabsf(v));
      DT[(size_t)row * 16 + lane] = fmaxf(v, 0.f) + (e < 1e-3f ? e * (1.f - 0.5f * e) : __logf(1.f + e));
    }
  }
}

DI void phase_ssdnorm(const Params& p, int layer, int bid, int nb) {
  const int w = ltid() >> 6, lane = ltid() & 63;
  const int M = layer == 0 ? MT : ML;
  bf16_t* YM = (bf16_t*)(p.ws + OFF_H);
  const float* SSQ = (const float*)(p.ws + OFF_SSQ);
  const float* ng = p.ssd_norm + layer * 512;
  for (int row = bid * 4 + w; row < M; row += nb * 4) {
    int g = lane >> 5;
    float4 s = *(const float4*)(SSQ + (size_t)row * 8 + g * 4);
    float rstd = rsqrtf((s.x + s.y + s.z + s.w) * (1.f / 256) + EPS);
    bf16_t* ptr = YM + (size_t)row * DM + 512 + lane * 8;
    u32x4 v = *(const u32x4*)ptr;
    float4 g0 = *(const float4*)(ng + lane * 8), g1 = *(const float4*)(ng + lane * 8 + 4);
    u32x4 o;
    o[0] = pack2(lo2f(v[0]) * rstd * g0.x, hi2f(v[0]) * rstd * g0.y);
    o[1] = pack2(lo2f(v[1]) * rstd * g0.z, hi2f(v[1]) * rstd * g0.w);
    o[2] = pack2(lo2f(v[2]) * rstd * g1.x, hi2f(v[2]) * rstd * g1.y);
    o[3] = pack2(lo2f(v[3]) * rstd * g1.z, hi2f(v[3]) * rstd * g1.w);
    *(u32x4*)ptr = o;
  }
}

constexpr int GST = 80;
constexpr int GBUF = 2 * 128 * GST;
template <bool GN, class Epi>
DI void gemm_tile(const bf16_t* __restrict__ A, int lda, const bf16_t* __restrict__ Bt, int K, int row0, int col0, char* smem, Epi epi, const float* __restrict__ ssq = nullptr) {
  bf16_t* S0 = (bf16_t*)smem;
  const int tid = ltid(), wid = tid >> 6, lane = tid & 63, wr = wid >> 1, wc = wid & 1, fr = lane & 15, fq = lane >> 4;
  f32x4 acc[4][4];
#pragma unroll
  for (int m = 0; m < 4; ++m)
#pragma unroll
    for (int n = 0; n < 4; ++n) acc[m][n] = f32x4{0.f, 0.f, 0.f, 0.f};
  u32x4 ra[4], rb[4];
  const int sr = tid >> 3, sp = tid & 7;
  const bf16_t* ga = A + (size_t)(row0 + sr) * lda + sp * 8;
  const bf16_t* gb = Bt + (size_t)(col0 + sr) * K + sp * 8;
  auto gload = [&](int k0) {
#pragma unroll
    for (int i = 0; i < 4; ++i) {
      ra[i] = *(const u32x4*)(ga + (size_t)(32 * i) * lda + k0);
      rb[i] = *(const u32x4*)(gb + (size_t)(32 * i) * K + k0);
    }
  };
  gload(0);
  float gs[4][2];
  if (GN) {
#pragma unroll
    for (int i = 0; i < 4; ++i) {
      const float4 s0 = *(const float4*)(ssq + (size_t)(row0 + sr + 32 * i) * 8), s1 = *(const float4*)(ssq + (size_t)(row0 + sr + 32 * i) * 8 + 4);
      gs[i][0] = rsqrtf((s0.x + s0.y + s0.z + s0.w) * (1.f / 256) + EPS);
      gs[i][1] = rsqrtf((s1.x + s1.y + s1.z + s1.w) * (1.f / 256) + EPS);
    }
  }
  auto swrite = [&](int kt) {
    if (GN && kt >= 8) {
      const int g = (kt - 8) >> 2;
#pragma unroll
      for (int i = 0; i < 4; ++i) {
        const float sc = g ? gs[i][1] : gs[i][0];
#pragma unroll
        for (int jj = 0; jj < 4; ++jj) ra[i][jj] = pack2(lo2f(ra[i][jj]) * sc, hi2f(ra[i][jj]) * sc);
      }
    }
    bf16_t* As = S0 + (kt & 1) * GBUF;
    bf16_t* Bs = As + 128 * GST;
#pragma unroll
    for (int i = 0; i < 4; ++i) {
      *(u32x4*)(As + (sr + 32 * i) * GST + sp * 8) = ra[i];
      *(u32x4*)(Bs + (sr + 32 * i) * GST + sp * 8) = rb[i];
    }
  };
  const int KT = K / 64;
  swrite(0);
  if (KT > 1) gload(64);
  __syncthreads();
  for (int kt = 0; kt < KT; ++kt) {
    const bf16_t* As = S0 + (kt & 1) * GBUF;
    const bf16_t* Bs = As + 128 * GST;
#pragma unroll
    for (int ks = 0; ks < 2; ++ks) {
      bf16x8 af[4], bfr[4];
#pragma unroll
      for (int m = 0; m < 4; ++m) af[m] = *(const bf16x8*)(As + (wr * 64 + m * 16 + fr) * GST + ks * 32 + fq * 8);
#pragma unroll
      for (int n = 0; n < 4; ++n) bfr[n] = *(const bf16x8*)(Bs + (wc * 64 + n * 16 + fr) * GST + ks * 32 + fq * 8);
#pragma unroll
      for (int m = 0; m < 4; ++m)
#pragma unroll
        for (int n = 0; n < 4; ++n) acc[m][n] = MFMA16(bfr[n], af[m], acc[m][n]);
      if (ks == 0 && kt + 1 < KT) {
        swrite(kt + 1);
        if (kt + 2 < KT) gload((kt + 2) * 64);
      }
    }
    __syncthreads();
  }
  float rsc[4];
#pragma unroll
  for (int m = 0; m < 4; ++m) rsc[m] = epi.scale(row0 + wr * 64 + m * 16 + fr);
#pragma unroll
  for (int m = 0; m < 4; ++m)
#pragma unroll
    for (int n = 0; n < 4; ++n) epi(row0 + wr * 64 + m * 16 + fr, col0 + wc * 64 + n * 16 + fq * 4, acc[m][n], rsc[m]);
}

template <bool GN, class Epi>
DI void gemm_tile_glds(const bf16_t* __restrict__ A, int lda, const bf16_t* __restrict__ Bt, int ldb, int K, int row0, int col0, char* smem, Epi epi,
                       const float* __restrict__ ssq = nullptr) {
  const int tid = ltid(), wid = tid >> 6, lane = tid & 63, wr = wid >> 1, wc = wid & 1, fr = lane & 15, fq = lane >> 4;
  f32x4 acc[4][4];
#pragma unroll
  for (int m = 0; m < 4; ++m)
#pragma unroll
    for (int n = 0; n < 4; ++n) acc[m][n] = f32x4{0.f, 0.f, 0.f, 0.f};
  const int crow = tid >> 3, cslot = tid & 7, cpart = cslot ^ (crow & 7);
  const bf16_t* ga = A + (size_t)(row0 + crow) * lda + cpart * 8;
  const bf16_t* gb = Bt + (size_t)(col0 + crow) * ldb + cpart * 8;
  auto issue = [&](int kt, int stage) {
    char* sa = smem + stage * 32768 + tid * 16;
#pragma unroll
    for (int i = 0; i < 4; ++i) {
      __builtin_amdgcn_global_load_lds((const unsigned*)(ga + (size_t)(32 * i) * lda + kt * 64), (__attribute__((address_space(3))) unsigned*)(sa + i * 4096), 16, 0, 0);
      __builtin_amdgcn_global_load_lds((const unsigned*)(gb + (size_t)(32 * i) * ldb + kt * 64), (__attribute__((address_space(3))) unsigned*)(sa + 16384 + i * 4096), 16, 0, 0);
    }
  };
  float gsc[4][2];
  if (GN) {
#pragma unroll
    for (int m = 0; m < 4; ++m) {
      const float* sp = ssq + (size_t)(row0 + wr * 64 + m * 16 + fr) * 8;
      const float4 s0 = *(const float4*)sp, s1 = *(const float4*)(sp + 4);
      gsc[m][0] = rsqrtf((s0.x + s0.y + s0.z + s0.w) * (1.f / 256) + EPS);
      gsc[m][1] = rsqrtf((s1.x + s1.y + s1.z + s1.w) * (1.f / 256) + EPS);
    }
  }
  const int KT = K / 64;
  issue(0, 0);
  asm volatile("s_waitcnt vmcnt(0)" ::: "memory");
  __syncthreads();
  const int sw = fr & 7;
  auto kstep = [&](int kt, f32x4 (&ac)[4][4]) {
    if (kt + 1 < KT) issue(kt + 1, (kt + 1) & 1);
    const char* As = smem + (kt & 1) * 32768;
    const char* Bs = As + 16384;
#pragma unroll
    for (int ks = 0; ks < 2; ++ks) {
      bf16x8 af[4], bfr[4];
      const int so = ((ks * 4 + fq) ^ sw) * 16;
#pragma unroll
      for (int m = 0; m < 4; ++m) af[m] = *(const bf16x8*)(As + (wr * 64 + m * 16 + fr) * 128 + so);
#pragma unroll
      for (int n = 0; n < 4; ++n) bfr[n] = *(const bf16x8*)(Bs + (wc * 64 + n * 16 + fr) * 128 + so);
#pragma unroll
      for (int m = 0; m < 4; ++m)
#pragma unroll
        for (int n = 0; n < 4; ++n) ac[m][n] = MFMA16(bfr[n], af[m], ac[m][n]);
    }
    asm volatile("s_waitcnt vmcnt(0)" ::: "memory");
    __syncthreads();
  };
  if (GN) {
    f32x4 seg[4][4];
#pragma unroll
    for (int m = 0; m < 4; ++m)
#pragma unroll
      for (int n = 0; n < 4; ++n) seg[m][n] = f32x4{0.f, 0.f, 0.f, 0.f};
    for (int kt = 0; kt < 16; ++kt) {
      kstep(kt, seg);
      if (kt == 7 || kt == 11 || kt == 15) {
#pragma unroll
        for (int m = 0; m < 4; ++m) {
          const float sc = kt == 7 ? 1.f : (kt == 11 ? gsc[m][0] : gsc[m][1]);
#pragma unroll
          for (int n = 0; n < 4; ++n) { acc[m][n] += sc * seg[m][n]; seg[m][n] = f32x4{0.f, 0.f, 0.f, 0.f}; }
        }
      }
    }
  } else {
    for (int kt = 0; kt < KT; ++kt) kstep(kt, acc);
  }
#pragma unroll
  for (int m = 0; m < 4; ++m)
#pragma unroll
    for (int n = 0; n < 4; ++n) epi(row0 + wr * 64 + m * 16 + fr, col0 + wc * 64 + n * 16 + fq * 4, acc[m][n]);
}

constexpr int G8_HT = 128 * 64;
DI int g8_lds_byte(int r, int c) {
  int st = (r >> 4) * 2 + (c >> 5), rr = r & 15, cc = c & 31, ob = rr * 64 + cc * 2;
  return st * 1024 + (ob ^ (((ob >> 9) & 1) << 5));
}
DI void g8_stage_rc(int b, int& R, int& C) {
  int st = b / 1024, sb = b % 1024, swz = sb ^ (((sb >> 9) & 1) << 5);
  R = (st >> 1) * 16 + swz / 64; C = (st & 1) * 32 + (swz % 64) / 2;
}
template <class Epi>
DI void gemm8_tile(const bf16_t* __restrict__ A, int lda, const bf16_t* __restrict__ Bt, int ldb, int K, int brow, int bcol, char* smem, Epi epi,
                   bool first = true, bool has_next = false, int nbrow = 0, int nbcol = 0) {
  bf16_t* shm = (bf16_t*)smem;
  const int tid = ltid512();
#define G8_SA(b, h) (shm + ((b) * 2 + (h)) * G8_HT)
#define G8_SB(b, h) (shm + (4 + (b) * 2 + (h)) * G8_HT)
#define G8_STAGE(P, BASE, LD, br, kt) do { const bf16_t* _g = (BASE) + (size_t)(br) * (LD) + (size_t)(kt) * 64; \
    _Pragma("unroll") for (int _i = 0; _i < 2; ++_i) { int _b = tid * 16 + _i * 8192; int _r, _c; g8_stage_rc(_b, _r, _c); \
      __builtin_amdgcn_global_load_lds((const unsigned*)(_g + (size_t)_r * (LD) + _c), \
        (__attribute__((address_space(3))) unsigned*)((char*)(P) + _b), 16, 0, 0); } } while (0)
#define G8_LDA(dst, b, h) _Pragma("unroll") for (int m = 0; m < 4; ++m) _Pragma("unroll") for (int k = 0; k < 2; ++k) \
    dst[m][k] = *reinterpret_cast<const bf16x8*>((char*)G8_SA(b, h) + g8_lds_byte(wr * 64 + m * 16 + fr, k * 32 + fq * 8))
#define G8_LDB(dst, b, h) _Pragma("unroll") for (int n = 0; n < 2; ++n) _Pragma("unroll") for (int k = 0; k < 2; ++k) \
    dst[n][k] = *reinterpret_cast<const bf16x8*>((char*)G8_SB(b, h) + g8_lds_byte(wc * 32 + n * 16 + fr, k * 32 + fq * 8))
#define G8_MMA(ai, bj, At, Bx) do { __builtin_amdgcn_s_setprio(1); \
    _Pragma("unroll") for (int m = 0; m < 4; ++m) _Pragma("unroll") for (int n = 0; n < 2; ++n) _Pragma("unroll") for (int k = 0; k < 2; ++k) \
      acc[ai][bj][m][n] = __builtin_amdgcn_mfma_f32_16x16x32_bf16(Bx[n][k], At[m][k], acc[ai][bj][m][n], 0, 0, 0); \
    __builtin_amdgcn_s_setprio(0); } while (0)
#define G8_WAIT_V(n) asm volatile("s_waitcnt vmcnt(" #n ")" ::: "memory")
#define G8_WAIT_L(n) asm volatile("s_waitcnt lgkmcnt(" #n ")" ::: "memory")
#define G8_BAR __builtin_amdgcn_s_barrier()
#define G8_SCHED __builtin_amdgcn_sched_barrier(0)
  const int wid = tid >> 6, lane = tid & 63, wr = wid >> 2, wc = wid & 3, fr = lane & 15, fq = lane >> 4;
  f32x4 acc[2][2][4][2];
#pragma unroll
  for (int a = 0; a < 2; ++a)
#pragma unroll
    for (int b = 0; b < 2; ++b)
#pragma unroll
      for (int m = 0; m < 4; ++m)
#pragma unroll
        for (int n = 0; n < 2; ++n) acc[a][b][m][n] = f32x4{0.f, 0.f, 0.f, 0.f};
  bf16x8 At[4][2], B0[2][2], B1[2][2];
  const int nt = K / 64;
  if (first) {
    G8_STAGE(G8_SB(0, 0), Bt, ldb, bcol, 0); G8_STAGE(G8_SA(0, 0), A, lda, brow, 0);
    G8_STAGE(G8_SB(0, 1), Bt, ldb, bcol + 128, 0); G8_STAGE(G8_SA(0, 1), A, lda, brow + 128, 0);
  }
  if (wr == 1) G8_BAR;
  if (first) G8_WAIT_V(4); else G8_WAIT_V(0);
  G8_BAR;
  G8_STAGE(G8_SB(1, 0), Bt, ldb, bcol, 1); G8_STAGE(G8_SA(1, 0), A, lda, brow, 1); G8_STAGE(G8_SB(1, 1), Bt, ldb, bcol + 128, 1);
  G8_WAIT_V(6); G8_BAR;
  for (int t = 0; t < nt - 2; t += 2) {
    G8_LDB(B0, 0, 0); G8_SCHED; G8_LDA(At, 0, 0); G8_STAGE(G8_SA(1, 1), A, lda, brow + 128, t + 1);
    G8_WAIT_L(8); G8_BAR; G8_WAIT_L(0); G8_MMA(0, 0, At, B0); G8_BAR; G8_SCHED;
    G8_LDB(B1, 0, 1); G8_STAGE(G8_SB(0, 0), Bt, ldb, bcol, t + 2);
    G8_BAR; G8_WAIT_L(0); G8_MMA(0, 1, At, B1); G8_BAR;
    G8_LDA(At, 0, 1); G8_STAGE(G8_SA(0, 0), A, lda, brow, t + 2);
    G8_BAR; G8_WAIT_L(0); G8_MMA(1, 0, At, B0); G8_BAR; G8_SCHED;
    G8_STAGE(G8_SB(0, 1), Bt, ldb, bcol + 128, t + 2);
    G8_WAIT_V(6); G8_BAR; G8_MMA(1, 1, At, B1); G8_BAR;
    G8_LDB(B0, 1, 0); G8_SCHED; G8_LDA(At, 1, 0); G8_STAGE(G8_SA(0, 1), A, lda, brow + 128, t + 2);
    G8_WAIT_L(8); G8_BAR; G8_WAIT_L(0); G8_MMA(0, 0, At, B0); G8_BAR; G8_SCHED;
    G8_LDB(B1, 1, 1); G8_STAGE(G8_SB(1, 0), Bt, ldb, bcol, t + 3);
    G8_BAR; G8_WAIT_L(0); G8_MMA(0, 1, At, B1); G8_BAR;
    G8_LDA(At, 1, 1); G8_STAGE(G8_SA(1, 0), A, lda, brow, t + 3);
    G8_BAR; G8_WAIT_L(0); G8_MMA(1, 0, At, B0); G8_BAR; G8_SCHED;
    G8_STAGE(G8_SB(1, 1), Bt, ldb, bcol + 128, t + 3);
    G8_WAIT_V(6); G8_BAR; G8_MMA(1, 1, At, B1); G8_BAR;
  }
  { G8_LDB(B0, 0, 0); G8_LDA(At, 0, 0); G8_STAGE(G8_SA(1, 1), A, lda, brow + 128, nt - 1);
    G8_BAR; G8_WAIT_L(0); G8_MMA(0, 0, At, B0); G8_BAR;
    G8_LDB(B1, 0, 1); G8_BAR; G8_WAIT_L(0); G8_MMA(0, 1, At, B1); G8_BAR;
    G8_LDA(At, 0, 1); G8_WAIT_V(4); G8_BAR; G8_WAIT_L(0); G8_MMA(1, 0, At, B0); G8_MMA(1, 1, At, B1); G8_BAR; }
  { G8_LDB(B0, 1, 0); G8_LDA(At, 1, 0); G8_WAIT_V(2); G8_BAR; G8_WAIT_L(0); G8_MMA(0, 0, At, B0); G8_BAR;
    G8_LDB(B1, 1, 1); G8_WAIT_V(0); G8_BAR; G8_WAIT_L(0); G8_MMA(0, 1, At, B1); G8_BAR;
    G8_LDA(At, 1, 1); G8_BAR; G8_WAIT_L(0); G8_MMA(1, 0, At, B0); G8_MMA(1, 1, At, B1); G8_BAR; }
  if (has_next) {
    G8_STAGE(G8_SB(0, 0), Bt, ldb, nbcol, 0); G8_STAGE(G8_SA(0, 0), A, lda, nbrow, 0);
    G8_STAGE(G8_SB(0, 1), Bt, ldb, nbcol + 128, 0); G8_STAGE(G8_SA(0, 1), A, lda, nbrow + 128, 0);
  }
  if (wr == 0) G8_BAR;
  const bool odd = fq & 1;
#pragma unroll
  for (int ai = 0; ai < 2; ++ai)
#pragma unroll
    for (int bj = 0; bj < 2; ++bj)
#pragma unroll
      for (int m = 0; m < 4; ++m) {
        const int row = brow + ai * 128 + wr * 64 + m * 16 + fr, cb = bcol + bj * 128 + wc * 32;
        epi.side(row, cb + fq * 4, acc[ai][bj][m][0]);
        epi.side(row, cb + 16 + fq * 4, acc[ai][bj][m][1]);
        const u32x2 p0 = epi.pack(acc[ai][bj][m][0]), p1 = epi.pack(acc[ai][bj][m][1]);
        const u32x2 snd = odd ? p0 : p1;
        u32x2 rcv; rcv[0] = (unsigned)__shfl_xor((int)snd[0], 16); rcv[1] = (unsigned)__shfl_xor((int)snd[1], 16);
        u32x4 o;
        if (odd) { o[0] = rcv[0]; o[1] = rcv[1]; o[2] = p1[0]; o[3] = p1[1]; }
        else     { o[0] = p0[0]; o[1] = p0[1]; o[2] = rcv[0]; o[3] = rcv[1]; }
        epi.store16(row, odd ? cb + 16 + (fq - 1) * 4 : cb + fq * 4, o);
      }
  __syncthreads();
}

struct EpiBF {
  bf16_t* out; int ldo;
  DI void side(int, int, const f32x4&) const {}
  DI u32x2 pack(const f32x4& a) const { u32x2 o; o[0] = pack2(a[0], a[1]); o[1] = pack2(a[2], a[3]); return o; }
  DI void store16(int row, int col, const u32x4& v) const { *(u32x4*)(out + (size_t)row * ldo + col) = v; }
  DI float scale(int) const { return 1.f; }
  DI void operator()(int row, int col, const f32x4& a, float) const { (*this)(row, col, a); }
  DI void operator()(int row, int col, const f32x4& a) const {
    u32x2 o; o[0] = pack2(a[0], a[1]); o[1] = pack2(a[2], a[3]);
    *(u32x2*)(out + (size_t)row * ldo + col) = o;
  }
};
struct EpiRelu2 {
  bf16_t* out; int ldo;
  DI void side(int, int, const f32x4&) const {}
  DI u32x2 pack(const f32x4& a) const {
    float r0 = fmaxf(a[0], 0.f), r1 = fmaxf(a[1], 0.f), r2 = fmaxf(a[2], 0.f), r3 = fmaxf(a[3], 0.f);
    u32x2 o; o[0] = pack2(r0 * r0, r1 * r1); o[1] = pack2(r2 * r2, r3 * r3); return o;
  }
  DI void store16(int row, int col, const u32x4& v) const { *(u32x4*)(out + (size_t)row * ldo + col) = v; }
  DI void operator()(int row, int col, const f32x4& a) const {
    float r0 = fmaxf(a[0], 0.f), r1 = fmaxf(a[1], 0.f), r2 = fmaxf(a[2], 0.f), r3 = fmaxf(a[3], 0.f);
    u32x2 o; o[0] = pack2(r0 * r0, r1 * r1); o[1] = pack2(r2 * r2, r3 * r3);
    *(u32x2*)(out + (size_t)row * ldo + col) = o;
  }
};
struct EpiU {
  bf16_t* u; float* dt;
  DI void side(int row, int col, const f32x4& a) const { if (col >= U_DT && col < DIN) *(float4*)(dt + (size_t)row * 16 + col - U_DT) = make_float4(a[0], a[1], a[2], a[3]); }
  DI u32x2 pack(const f32x4& a) const { u32x2 o; o[0] = pack2(a[0], a[1]); o[1] = pack2(a[2], a[3]); return o; }
  DI void store16(int row, int col, const u32x4& v) const { if (col < DIN) *(u32x4*)(u + (size_t)row * DIN + col) = v; }
  DI void operator()(int row, int col, const f32x4& a) const {
    if (col < DIN) {
      u32x2 o; o[0] = pack2(a[0], a[1]); o[1] = pack2(a[2], a[3]);
      *(u32x2*)(u + (size_t)row * DIN + col) = o;
      if (col >= U_DT) *(float4*)(dt + (size_t)row * 16 + col - U_DT) = make_float4(a[0], a[1], a[2], a[3]);
    }
  }
};
struct EpiQ {
  bf16_t* q; const float* rs;
  DI float scale(int row) const { return rs[row * 2]; }
  DI void operator()(int row, int col, const f32x4& a, float r) const {
    u32x2 o; o[0] = pack2(a[0] * r, a[1] * r); o[1] = pack2(a[2] * r, a[3] * r);
    *(u32x2*)(q + (size_t)row * 384 + col) = o;
  }
};
struct EpiKV {
  bf16_t* kb; bf16_t* vt; const float* rs;
  DI float scale(int row) const { return rs[row * 2 + 1]; }
  DI void operator()(int row, int col, const f32x4& a, float r) const {
    int b, pos;
    if (row < ML) { b = row >> 12; pos = (row & 4095) + CTX; } else { int rr = row - ML; b = rr >> 8; pos = rr & 255; }
    const int head = col >> 7, d = col & 127;
    if (d < 64) {
      u32x2 o; o[0] = pack2(a[0] * r, a[1] * r); o[1] = pack2(a[2] * r, a[3] * r);
      *(u32x2*)(kb + ((size_t)(b * 4 + head) * LK + pos) * 96 + d) = o;
    } else {
#pragma unroll
      for (int j = 0; j < 4; ++j) vt[((size_t)(b * 4 + head) * 64 + (d - 64 + j)) * LK + pos] = f2bf(a[j] * r);
    }
  }
};

struct EpiPart {
  float* part;
  DI void operator()(int row, int col, const f32x4& a) const {
    *(float4*)(part + (size_t)(row - ML) * DM + col) = make_float4(a[0], a[1], a[2], a[3]);
  }
};
DI void phase_inproj(const Params& p, int layer, int bid, int nb, char* smem) {
  EpiU epi{(bf16_t*)(p.ws + OFF_U), (float*)(p.ws + OFF_DT)};
  const int x = bid & 7, per = nb >> 3;
  for (int rep = 0; rep < REP_GEMM; ++rep)
  for (int q = bid >> 3; q < 85; q += per) {
    const int m = (x >> 1) * 17 + q / 5, n = 5 * (x & 1) + q % 5;
    const int q2 = q + per, m2 = (x >> 1) * 17 + q2 / 5, n2 = 5 * (x & 1) + q2 % 5;
    gemm8_tile((const bf16_t*)(p.ws + OFF_H), DM, wt_ptr(p, layer, WT_IN), 1024, 1024, m * 256, n * 256, smem, epi,
               q == (bid >> 3), q2 < 85, m2 * 256, n2 * 256);
  }
}
DI void phase_wout(const Params& p, int layer, int lid, int nvb, char* smem) {
  const int M = layer == 0 ? MT : ML;
  EpiBF epi{(bf16_t*)(p.ws + OFF_U), DM};
  const int x = lid & 7, per = nvb >> 3;
  for (int rep = 0; rep < REP_GEMM; ++rep)
  for (int q = lid >> 3; q < M / 128; q += per)
    gemm_tile_glds<true>((const bf16_t*)(p.ws + OFF_H), DM, wt_ptr(p, layer, WT_OUT), 1024, 1024, ((q >> 3) * 8 + x) * 128, (q & 7) * 128, smem, epi, (const float*)(p.ws + OFF_SSQ));
}
DI void phase_ff1(const Params& p, int layer, int bid, int nb, int vbid, int nvb, char* smem, char* smem_half) {
  EpiRelu2 epi{(bf16_t*)(p.ws + OFF_F1), DFF};
  const int x = bid & 7, per = nb >> 3;
  for (int rep = 0; rep < REP_GEMM; ++rep) {
    for (int q = bid >> 3; q < 128; q += per) {
      const int m = (x >> 2) * 32 + (q >> 2), n = 4 * (x & 3) + (q & 3);
      const int q2 = q + per, m2 = (x >> 2) * 32 + (q2 >> 2), n2 = 4 * (x & 3) + (q2 & 3);
      gemm8_tile((const bf16_t*)(p.ws + OFF_H), DM, wt_ptr(p, layer, WT_FF1), 1024, 1024, m * 256, n * 256, smem, epi,
                 q == (bid >> 3), q2 < 128, m2 * 256, n2 * 256);
    }
    if (layer == 0)
      for (int it = vbid; it < (MC / 128) * 32; it += nvb)
        gemm_tile_glds<false>((const bf16_t*)(p.ws + OFF_H), DM, wt_ptr(p, layer, WT_FF1), 1024, 1024, ML + (it / 32) * 128, (it % 32) * 128, smem_half, epi);
  }
}
DI void phase_ff2(const Params& p, int layer, int bid, int nb, int vbid, int nvb, char* smem, char* smem_half) {
  EpiBF epi{(bf16_t*)(p.ws + OFF_H), DM};
  const int x = bid & 7, per = nb >> 3;
  for (int rep = 0; rep < REP_GEMM; ++rep) {
    for (int q = bid >> 3; q < 32; q += per) {
      const int T = x * 32 + q;
      gemm8_tile((const bf16_t*)(p.ws + OFF_F1), DFF, wt_ptr(p, layer, WT_FF2), 4096, 4096, (T >> 2) * 256, (T & 3) * 256, smem, epi);
    }
    if (layer == 0)
      for (int it = vbid; it < (MC / 128) * 8 * 4; it += nvb) {
        const int tile = it >> 2, ks = it & 3;
        EpiPart ep{(float*)(p.ws + OFF_END2) + (size_t)ks * MC * DM};
        gemm_tile_glds<false>((const bf16_t*)(p.ws + OFF_F1) + ks * 1024, DFF, wt_ptr(p, layer, WT_FF2) + ks * 1024, 4096, 1024, ML + (tile >> 3) * 128, (tile & 7) * 128, smem_half, ep);
      }
  }
}

DI int chunk_row0(int b, int tc) { return tc < 2 ? ML + b * CTX + tc * 128 : b * SEQ + (tc - 2) * 128; }
constexpr int BST = 72;
constexpr int TST = 136;
DI void load_tile_T(bf16_t* dst, const bf16_t* __restrict__ src, int ldg) {
  const int tid = ltid();
#pragma unroll
  for (int i = 0; i < 4; ++i) {
    int c = tid + 256 * i, tok = c & 127, pc = c >> 7;
    u32x4 v = *(const u32x4*)(src + (size_t)tok * ldg + pc * 8);
#pragma unroll
    for (int j = 0; j < 4; ++j) {
      dst[(pc * 8 + 2 * j) * TST + tok] = (bf16_t)(v[j] & 0xffffu);
      dst[(pc * 8 + 2 * j + 1) * TST + tok] = (bf16_t)(v[j] >> 16);
    }
  }
}
DI void chunk_scan(const Params& p, int layer, int row0, int h, float* csf, float* csb, float* dtF, float* dtB, float* tot, float*  ) {
  const int tid = ltid(), w = tid >> 6, lane = tid & 63;
  const float* DT = (const float*)(p.ws + OFF_DT);
  float v;
  if (tid < 128) {
    const float dt = DT[(size_t)(row0 + tid) * 16 + h];
    v = dt * -__expf(p.a_log[layer * 16 + h]);
    dtF[tid] = dt;
  } else {
    const int e = 255 - tid;
    const float dt = DT[(size_t)(row0 + e) * 16 + 8 + h];
    v = dt * -__expf(p.a_log[layer * 16 + 8 + h]);
    dtB[e] = dt;
  }
#pragma unroll
  for (int o = 1; o < 64; o <<= 1) { const float t = __shfl_up(v, o); if (lane >= o) v += t; }
  if (lane == 63) tot[w] = v;
  __syncthreads();
  if (w == 1) v += tot[0];
  if (w == 3) v += tot[2];
  if (tid < 128) csf[tid] = v; else csb[255 - tid] = v;
  __syncthreads();
}

DI void ssd_state_item(const Params& p, int layer, int b, int tc, int h, char* smem) {
  bf16_t* XT = (bf16_t*)smem;
  bf16_t* BT = XT + 64 * TST;
  float* csf = (float*)(BT + 64 * TST);
  float* csb = csf + 128; float* dtF = csb + 128; float* dtB = dtF + 128; float* laF = dtB + 128; float* laB = laF + 128;
  const int tid = ltid(), w = tid >> 6, lane = tid & 63, r = lane & 31, hh = lane >> 5;
  const int row0 = chunk_row0(b, tc);
  const bf16_t* XBC = (const bf16_t*)(p.ws + OFF_XBC);
  load_tile_T(XT, XBC + (size_t)row0 * 768 + h * 64, 768);
  load_tile_T(BT, XBC + (size_t)row0 * 768 + 512 + (h >> 2) * 64, 768);
  chunk_scan(p, layer, row0, h, csf, csb, dtF, dtB, laF, laB);
  __syncthreads();
  if (tid < 128) laF[tid] = dtF[tid] * __expf(csf[127] - csf[tid]);
  else { int t = tid - 128; laB[t] = dtB[t] * __expf(csb[0] - csb[t]); }
  __syncthreads();
  const int d = w >> 1, pt = w & 1;
  const float* wv = d == 0 ? laF : laB;
  f32x16 acc[2];
#pragma unroll
  for (int i = 0; i < 16; ++i) { acc[0][i] = 0.f; acc[1][i] = 0.f; }
#pragma unroll
  for (int s = 0; s < 8; ++s) {
    int l0 = 16 * s + 8 * hh;
    u32x4 xa = *(const u32x4*)(XT + (32 * pt + r) * TST + l0);
    u32x4 sa;
#pragma unroll
    for (int j = 0; j < 4; ++j) sa[j] = pack2(lo2f(xa[j]) * wv[l0 + 2 * j], hi2f(xa[j]) * wv[l0 + 2 * j + 1]);
    bf16x8 af = __builtin_bit_cast(bf16x8, sa);
#pragma unroll
    for (int nt = 0; nt < 2; ++nt) {
      bf16x8 bfr = *(const bf16x8*)(BT + (32 * nt + r) * TST + l0);
      acc[nt] = MFMA32(af, bfr, acc[nt]);
    }
  }
  bf16_t* S = (bf16_t*)(p.ws + OFF_SST) + ((((size_t)d * NB + b) * NCH + tc) * 8 + h) * 4096;
#pragma unroll
  for (int nt = 0; nt < 2; ++nt)
#pragma unroll
    for (int i = 0; i < 16; ++i) S[(32 * pt + crow(i, hh)) * 64 + 32 * nt + r] = f2bf(acc[nt][i]);
  if (tid == 0) {
    float* TD = (float*)(p.ws + OFF_TDEC);
    TD[((0 * NB + b) * NCH + tc) * 8 + h] = __expf(csf[127]);
    TD[((1 * NB + b) * NCH + tc) * 8 + h] = __expf(csb[0]);
  }
  __syncthreads();
}

DI void ssd_pass_item(const Params& p, int it) {
  const int e = it * 256 + ltid();
  const int pn2 = e & 2047, h = (e >> 11) & 7, b = (e >> 14) & 3, d = e >> 16;
  unsigned* S = (unsigned*)(p.ws + OFF_SST);
  const float* TD = (const float*)(p.ws + OFF_TDEC);
  unsigned sv[NCH]; float T[NCH];
#pragma unroll
  for (int i = 0; i < NCH; ++i) {
    int tc = d == 0 ? i : (i < 2 ? 1 - i : NCH + 1 - i);
    sv[i] = S[(((size_t)(d * NB + b) * NCH + tc) * 8 + h) * 2048 + pn2];
    T[i] = TD[((d * NB + b) * NCH + tc) * 8 + h];
  }
  float h0 = 0.f, h1 = 0.f;
#pragma unroll
  for (int i = 0; i < NCH; ++i) {
    int tc = d == 0 ? i : (i < 2 ? 1 - i : NCH + 1 - i);
    S[(((size_t)(d * NB + b) * NCH + tc) * 8 + h) * 2048 + pn2] = pack2(h0, h1);
    h0 = T[i] * h0 + lo2f(sv[i]); h1 = T[i] * h1 + hi2f(sv[i]);
  }
}

DI void ssd_out_item(const Params& p, int layer, int b, int tc, int h, char* smem) {
  bf16_t* XT = (bf16_t*)smem;
  bf16_t* Bs = XT + 64 * TST;
  float* csf = (float*)(Bs + 128 * BST);
  float* csb = csf + 128; float* dtF = csb + 128; float* dtB = dtF + 128; float* laF = dtB + 128; float* laB = laF + 128;
  const int tid = ltid(), w = tid >> 6, lane = tid & 63, r = lane & 31, hh = lane >> 5;
  const int row0 = chunk_row0(b, tc), g = h >> 2;
  const bf16_t* XBC = (const bf16_t*)(p.ws + OFF_XBC);
  load_tile_T(XT, XBC + (size_t)row0 * 768 + h * 64, 768);
#pragma unroll
  for (int i = 0; i < 4; ++i) {
    int c = tid + 256 * i, tok = c >> 3, part = c & 7;
    *(u32x4*)(Bs + tok * BST + part * 8) = *(const u32x4*)(XBC + (size_t)(row0 + tok) * 768 + 512 + g * 64 + part * 8);
  }
  const int l = 32 * w + r;
  bf16x8 cf[4];
#pragma unroll
  for (int ks = 0; ks < 4; ++ks) cf[ks] = *(const bf16x8*)(XBC + (size_t)(row0 + l) * 768 + 640 + g * 64 + 16 * ks + 8 * hh);
  chunk_scan(p, layer, row0, h, csf, csb, dtF, dtB, laF, laB);
  const float csf_l = csf[l], csb_l = csb[l];
  f32x16 yacc[2];
#pragma unroll
  for (int i = 0; i < 16; ++i) { yacc[0][i] = 0.f; yacc[1][i] = 0.f; }
#pragma unroll
  for (int st = 0; st < 4; ++st) {
    f32x16 gacc;
#pragma unroll
    for (int i = 0; i < 16; ++i) gacc[i] = 0.f;
#pragma unroll
    for (int ks = 0; ks < 4; ++ks) {
      bf16x8 af = *(const bf16x8*)(Bs + (32 * st + r) * BST + 16 * ks + 8 * hh);
      gacc = MFMA32(af, cf[ks], gacc);
    }
#pragma unroll
    for (int i = 0; i < 16; ++i) {
      int s = 32 * st + crow(i, hh);
      float f;
      if (s < l) f = __expf(csf_l - csf[s]) * dtF[s];
      else if (s > l) f = __expf(csb_l - csb[s]) * dtB[s];
      else f = dtF[s] + dtB[s];
      gacc[i] *= f;
    }
#pragma unroll
    for (int s2 = 0; s2 < 2; ++s2) {
      bf16x8 mf = pack8(gacc, s2);
      int sb = 32 * st + 16 * s2 + 4 * hh;
#pragma unroll
      for (int pt = 0; pt < 2; ++pt) {
        u32x2 lo = *(const u32x2*)(XT + (32 * pt + r) * TST + sb);
        u32x2 hi = *(const u32x2*)(XT + (32 * pt + r) * TST + sb + 8);
        u32x4 xa; xa[0] = lo[0]; xa[1] = lo[1]; xa[2] = hi[0]; xa[3] = hi[1];
        yacc[pt] = MFMA32(__builtin_bit_cast(bf16x8, xa), mf, yacc[pt]);
      }
    }
  }
#pragma unroll
  for (int d = 0; d < 2; ++d) {
    const bf16_t* Hs = (const bf16_t*)(p.ws + OFF_SST) + ((((size_t)d * NB + b) * NCH + tc) * 8 + h) * 4096;
    const float e = __expf(d == 0 ? csf_l : csb_l);
#pragma unroll
    for (int pt = 0; pt < 2; ++pt) {
      f32x16 t;
#pragma unroll
      for (int i = 0; i < 16; ++i) t[i] = 0.f;
#pragma unroll
      for (int ks = 0; ks < 4; ++ks) {
        bf16x8 af = *(const bf16x8*)(Hs + (32 * pt + r) * 64 + 16 * ks + 8 * hh);
        t = MFMA32(af, cf[ks], t);
      }
#pragma unroll
      for (int i = 0; i < 16; ++i) yacc[pt][i] += e * t[i];
    }
  }
  const int row = row0 + l;
  const float Dh = p.ssd_d[layer * 8 + h];
  const bf16_t* U = (const bf16_t*)(p.ws + OFF_U);
  bf16_t* YM = (bf16_t*)(p.ws + OFF_H);
  float ssq = 0.f;
  u32x2 xvv[2][4], zvv[2][4];
#pragma unroll
  for (int pt = 0; pt < 2; ++pt)
#pragma unroll
    for (int q = 0; q < 4; ++q) {
      const int pp = 32 * pt + 8 * q + 4 * hh;
      xvv[pt][q] = *(const u32x2*)(XBC + (size_t)row * 768 + h * 64 + pp);
      zvv[pt][q] = *(const u32x2*)(U + (size_t)row * DIN + U_Z + h * 64 + pp);
    }
#pragma unroll
  for (int pt = 0; pt < 2; ++pt)
#pragma unroll
    for (int q = 0; q < 4; ++q) {
      const int pp = 32 * pt + 8 * q + 4 * hh;
      const u32x2 xv = xvv[pt][q], zv = zvv[pt][q];
      float y0 = (yacc[pt][4 * q + 0] + Dh * lo2f(xv[0])) * silu_f(lo2f(zv[0]));
      float y1 = (yacc[pt][4 * q + 1] + Dh * hi2f(xv[0])) * silu_f(hi2f(zv[0]));
      float y2 = (yacc[pt][4 * q + 2] + Dh * lo2f(xv[1])) * silu_f(lo2f(zv[1]));
      float y3 = (yacc[pt][4 * q + 3] + Dh * hi2f(xv[1])) * silu_f(hi2f(zv[1]));
      u32x2 o; o[0] = pack2(y0, y1); o[1] = pack2(y2, y3);
      float r0 = lo2f(o[0]), r1 = hi2f(o[0]), r2 = lo2f(o[1]), r3 = hi2f(o[1]);
      ssq += r0 * r0 + r1 * r1 + r2 * r2 + r3 * r3;
      *(u32x2*)(YM + (size_t)row * DM + 512 + h * 64 + pp) = o;
    }
  ssq += __shfl_xor(ssq, 32);
  if (hh == 0) ((float*)(p.ws + OFF_SSQ))[(size_t)row * 8 + h] = ssq;
  __syncthreads();
}

constexpr int KST = 104;
constexpr int VST = 68;
constexpr int ASTG = 64 * KST + 64 * VST;
DI void attn_item(const Params& p, int b, int head, int qrow0, int t0, bool lat, int nkeys, char* smem) {
  bf16_t* Ks = (bf16_t*)smem;
  bf16_t* Vs = Ks + 64 * KST;
  const int tid = ltid(), w = tid >> 6, lane = tid & 63, r = lane & 31, hh = lane >> 5;
  const bf16_t* QB = (const bf16_t*)(p.ws + OFF_QB);
  const bf16_t* KB = (const bf16_t*)(p.ws + OFF_KB) + (size_t)(b * 4 + head) * LK * 96;
  const bf16_t* VT = (const bf16_t*)(p.ws + OFF_VT) + (size_t)(b * 4 + head) * 64 * LK;
  const float qscale = 0.10206207261596575f * 1.4426950408889634f;
  const int qrow = qrow0 + w * 32 + r;
  const int t = t0 + w * 32 + r;
  bf16x8 qf[6];
  {
    const bf16_t* src = QB + (size_t)qrow * 384 + head * 96;
#pragma unroll
    for (int s = 0; s < 4; ++s) {
      u32x4 v = *(const u32x4*)(src + 16 * s + 8 * hh);
      u32x4 o;
#pragma unroll
      for (int j = 0; j < 4; ++j) o[j] = pack2(lo2f(v[j]) * qscale, hi2f(v[j]) * qscale);
      qf[s] = __builtin_bit_cast(bf16x8, o);
    }
#pragma unroll
    for (int s = 4; s < 6; ++s) {
      u32x4 va = *(const u32x4*)(src + 16 * s), vb = *(const u32x4*)(src + 16 * s + 8);
      float posf = s == 4 ? (float)(t >> 6) : (float)(t & 63);
      float o[8];
#pragma unroll
      for (int j = 0; j < 8; ++j) {
        float a = (j & 1) ? hi2f(va[j >> 1]) : lo2f(va[j >> 1]);
        float bb = (j & 1) ? hi2f(vb[j >> 1]) : lo2f(vb[j >> 1]);
        float res;
        if (lat) {
          float invf = exp2f(-(float)(2 * j) * (13.287712379549449f / 16.f));
          float rev = posf * invf * 0.15915494309189535f;
          float cs = __builtin_amdgcn_cosf(rev), sn = __builtin_amdgcn_sinf(rev);
          res = hh == 0 ? a * cs - bb * sn : bb * cs + a * sn;
        } else res = hh == 0 ? a : bb;
        o[j] = res * qscale;
      }
      u32x4 ov; ov[0] = pack2(o[0], o[1]); ov[1] = pack2(o[2], o[3]); ov[2] = pack2(o[4], o[5]); ov[3] = pack2(o[6], o[7]);
      qf[s] = __builtin_bit_cast(bf16x8, ov);
    }
  }
  f32x16 oacc[2];
#pragma unroll
  for (int i = 0; i < 16; ++i) { oacc[0][i] = 0.f; oacc[1][i] = 0.f; }
  float m = -1e30f, lsum = 0.f;
  u32x4 rk[3], rv[2];
  auto gload = [&](int key0) {
#pragma unroll
    for (int i = 0; i < 3; ++i) rk[i] = *(const u32x4*)(KB + (size_t)key0 * 96 + (tid + 256 * i) * 8);
#pragma unroll
    for (int i = 0; i < 2; ++i) { int c = tid + 256 * i; rv[i] = *(const u32x4*)(VT + (size_t)(c >> 3) * LK + key0 + (c & 7) * 8); }
  };
  gload(0);
  const int NT = nkeys / 64;
  for (int kt = 0; kt < NT; ++kt) {
#pragma unroll
    for (int i = 0; i < 3; ++i) { int c = tid + 256 * i; *(u32x4*)(Ks + (c / 12) * KST + (c % 12) * 8) = rk[i]; }
#pragma unroll
    for (int i = 0; i < 2; ++i) {
      int c = tid + 256 * i;
      bf16_t* d = Vs + (c >> 3) * VST + (c & 7) * 8;
      u32x2 a; a[0] = rv[i][0]; a[1] = rv[i][1];
      u32x2 bq; bq[0] = rv[i][2]; bq[1] = rv[i][3];
      *(u32x2*)d = a; *(u32x2*)(d + 4) = bq;
    }
    __syncthreads();
    if (kt + 1 < NT) gload((kt + 1) * 64);
    f32x16 sacc[2];
#pragma unroll
    for (int i = 0; i < 16; ++i) { sacc[0][i] = 0.f; sacc[1][i] = 0.f; }
#pragma unroll
    for (int s = 0; s < 6; ++s)
#pragma unroll
      for (int k2 = 0; k2 < 2; ++k2) {
        bf16x8 af = *(const bf16x8*)(Ks + (32 * k2 + r) * KST + 16 * s + 8 * hh);
        sacc[k2] = MFMA32(af, qf[s], sacc[k2]);
      }
    float mx = sacc[0][0];
#pragma unroll
    for (int i = 0; i < 16; ++i) { mx = fmaxf(mx, sacc[0][i]); mx = fmaxf(mx, sacc[1][i]); }
    mx = fmaxf(mx, __shfl_xor(mx, 32));
    const float mn = fmaxf(m, mx);
    const float alpha = __builtin_amdgcn_exp2f(m - mn);
    m = mn;
    float ps = 0.f;
#pragma unroll
    for (int i = 0; i < 16; ++i) {
      sacc[0][i] = __builtin_amdgcn_exp2f(sacc[0][i] - mn); sacc[1][i] = __builtin_amdgcn_exp2f(sacc[1][i] - mn);
      ps += sacc[0][i] + sacc[1][i];
    }
    lsum = lsum * alpha + ps;
#pragma unroll
    for (int i = 0; i < 16; ++i) { oacc[0][i] *= alpha; oacc[1][i] *= alpha; }
#pragma unroll
    for (int k2 = 0; k2 < 2; ++k2)
#pragma unroll
      for (int s2 = 0; s2 < 2; ++s2) {
        bf16x8 pf = pack8(sacc[k2], s2);
        int kb0 = 32 * k2 + 16 * s2 + 4 * hh;
#pragma unroll
        for (int d = 0; d < 2; ++d) {
          u32x2 lo = *(const u32x2*)(Vs + (32 * d + r) * VST + kb0);
          u32x2 hi = *(const u32x2*)(Vs + (32 * d + r) * VST + kb0 + 8);
          u32x4 va; va[0] = lo[0]; va[1] = lo[1]; va[2] = hi[0]; va[3] = hi[1];
          oacc[d] = MFMA32(__builtin_bit_cast(bf16x8, va), pf, oacc[d]);
        }
      }
    __syncthreads();
  }
  lsum += __shfl_xor(lsum, 32);
  const float inv = 1.f / lsum;
  bf16_t* YM = (bf16_t*)(p.ws + OFF_H) + (size_t)qrow * DM + head * 64;
#pragma unroll
  for (int d = 0; d < 2; ++d)
#pragma unroll
    for (int q = 0; q < 4; ++q) {
      u32x2 o; o[0] = pack2(oacc[d][4 * q] * inv, oacc[d][4 * q + 1] * inv); o[1] = pack2(oacc[d][4 * q + 2] * inv, oacc[d][4 * q + 3] * inv);
      *(u32x2*)(YM + 32 * d + 8 * q + 4 * hh) = o;
    }
}

DI void attn_item8(const Params& p, int b, int head, int qrow0, int t0, bool lat, int nkeys, char* smem) {
  bf16_t* Ks = (bf16_t*)smem;
  bf16_t* Vs = Ks + 64 * KST;
  const int tid = ltid512(), w = tid >> 6, lane = tid & 63, r = lane & 31, hh = lane >> 5;
  const bf16_t* QB = (const bf16_t*)(p.ws + OFF_QB);
  const bf16_t* KB = (const bf16_t*)(p.ws + OFF_KB) + (size_t)(b * 4 + head) * LK * 96;
  const bf16_t* VT = (const bf16_t*)(p.ws + OFF_VT) + (size_t)(b * 4 + head) * 64 * LK;
  const float qscale = 0.10206207261596575f * 1.4426950408889634f;
  const int qrow = qrow0 + w * 32 + r;
  const int t = t0 + w * 32 + r;
  bf16x8 qf[6];
  {
    const bf16_t* src = QB + (size_t)qrow * 384 + head * 96;
#pragma unroll
    for (int s = 0; s < 4; ++s) {
      u32x4 v = *(const u32x4*)(src + 16 * s + 8 * hh);
      u32x4 o;
#pragma unroll
      for (int j = 0; j < 4; ++j) o[j] = pack2(lo2f(v[j]) * qscale, hi2f(v[j]) * qscale);
      qf[s] = __builtin_bit_cast(bf16x8, o);
    }
#pragma unroll
    for (int s = 4; s < 6; ++s) {
      u32x4 va = *(const u32x4*)(src + 16 * s), vb = *(const u32x4*)(src + 16 * s + 8);
      float posf = s == 4 ? (float)(t >> 6) : (float)(t & 63);
      float o[8];
#pragma unroll
      for (int j = 0; j < 8; ++j) {
        float a = (j & 1) ? hi2f(va[j >> 1]) : lo2f(va[j >> 1]);
        float bb = (j & 1) ? hi2f(vb[j >> 1]) : lo2f(vb[j >> 1]);
        float res;
        if (lat) {
          float invf = exp2f(-(float)(2 * j) * (13.287712379549449f / 16.f));
          float rev = posf * invf * 0.15915494309189535f;
          float cs = __builtin_amdgcn_cosf(rev), sn = __builtin_amdgcn_sinf(rev);
          res = hh == 0 ? a * cs - bb * sn : bb * cs + a * sn;
        } else res = hh == 0 ? a : bb;
        o[j] = res * qscale;
      }
      u32x4 ov; ov[0] = pack2(o[0], o[1]); ov[1] = pack2(o[2], o[3]); ov[2] = pack2(o[4], o[5]); ov[3] = pack2(o[6], o[7]);
      qf[s] = __builtin_bit_cast(bf16x8, ov);
    }
  }
  f32x16 oacc[2];
#pragma unroll
  for (int i = 0; i < 16; ++i) { oacc[0][i] = 0.f; oacc[1][i] = 0.f; }
  float m = -1e30f, lsum = 0.f;
  u32x4 rk[2], rv;
  auto gload = [&](int key0) {
    rk[0] = *(const u32x4*)(KB + (size_t)key0 * 96 + tid * 8);
    if (tid < 256) rk[1] = *(const u32x4*)(KB + (size_t)key0 * 96 + (512 + tid) * 8);
    rv = *(const u32x4*)(VT + (size_t)(tid >> 3) * LK + key0 + (tid & 7) * 8);
  };
  const int kro = (tid / 12) * KST + (tid % 12) * 8, kro2 = ((512 + tid) / 12) * KST + ((512 + tid) % 12) * 8;
  auto swrite = [&](int stage) {
    bf16_t* Kd = Ks + stage * ASTG;
    *(u32x4*)(Kd + kro) = rk[0];
    if (tid < 256) *(u32x4*)(Kd + kro2) = rk[1];
    bf16_t* d = Kd + 64 * KST + (tid >> 3) * VST + (tid & 7) * 8;
    u32x2 a; a[0] = rv[0]; a[1] = rv[1];
    u32x2 bq; bq[0] = rv[2]; bq[1] = rv[3];
    *(u32x2*)d = a; *(u32x2*)(d + 4) = bq;
  };
  auto qk = [&](int stage, f32x16 (&sa)[2]) {
    const bf16_t* Kc = Ks + stage * ASTG;
#pragma unroll
    for (int i = 0; i < 16; ++i) { sa[0][i] = 0.f; sa[1][i] = 0.f; }
#pragma unroll
    for (int s = 0; s < 6; ++s)
#pragma unroll
      for (int k2 = 0; k2 < 2; ++k2) {
        bf16x8 af = *(const bf16x8*)(Kc + (32 * k2 + r) * KST + 16 * s + 8 * hh);
        sa[k2] = MFMA32(af, qf[s], sa[k2]);
      }
  };
  const int NT = nkeys / 64;
  f32x16 sacc[2], snext[2];
  gload(0); swrite(0);
  gload(64);
  __syncthreads();
  swrite(1);
  gload(128);
  qk(0, sacc);
  __syncthreads();
  int cur = 0, nxt = 1, nn = 2;
  for (int kt = 0; kt < NT; ++kt) {
    if (kt + 1 < NT) qk(nxt, snext);
    if (kt + 2 < NT) {
      swrite(nn);
      if (kt + 3 < NT) gload((kt + 3) * 64);
    }
    const bf16_t* Vc = Ks + cur * ASTG + 64 * KST;
    float mx = sacc[0][0];
#pragma unroll
    for (int i = 0; i < 16; ++i) { mx = fmaxf(mx, sacc[0][i]); mx = fmaxf(mx, sacc[1][i]); }
    mx = fmaxf(mx, __shfl_xor(mx, 32));
    const float mn = fmaxf(m, mx);
    const float alpha = __builtin_amdgcn_exp2f(m - mn);
    m = mn;
    float ps = 0.f;
#pragma unroll
    for (int i = 0; i < 16; ++i) {
      sacc[0][i] = __builtin_amdgcn_exp2f(sacc[0][i] - mn); sacc[1][i] = __builtin_amdgcn_exp2f(sacc[1][i] - mn);
      ps += sacc[0][i] + sacc[1][i];
    }
    lsum = lsum * alpha + ps;
#pragma unroll
    for (int i = 0; i < 16; ++i) { oacc[0][i] *= alpha; oacc[1][i] *= alpha; }
#pragma unroll
    for (int k2 = 0; k2 < 2; ++k2)
#pragma unroll
      for (int s2 = 0; s2 < 2; ++s2) {
        bf16x8 pf = pack8(sacc[k2], s2);
        int kb0 = 32 * k2 + 16 * s2 + 4 * hh;
#pragma unroll
        for (int d = 0; d < 2; ++d) {
          u32x2 lo = *(const u32x2*)(Vc + (32 * d + r) * VST + kb0);
          u32x2 hi = *(const u32x2*)(Vc + (32 * d + r) * VST + kb0 + 8);
          u32x4 va; va[0] = lo[0]; va[1] = lo[1]; va[2] = hi[0]; va[3] = hi[1];
          oacc[d] = MFMA32(__builtin_bit_cast(bf16x8, va), pf, oacc[d]);
        }
      }
    sacc[0] = snext[0]; sacc[1] = snext[1];
    const int t3 = cur; cur = nxt; nxt = nn; nn = t3;
    __syncthreads();
  }
  lsum += __shfl_xor(lsum, 32);
  const float inv = 1.f / lsum;
  bf16_t* YM = (bf16_t*)(p.ws + OFF_H) + (size_t)qrow * DM + head * 64;
#pragma unroll
  for (int d = 0; d < 2; ++d)
#pragma unroll
    for (int q = 0; q < 4; ++q) {
      u32x2 o; o[0] = pack2(oacc[d][4 * q] * inv, oacc[d][4 * q + 1] * inv); o[1] = pack2(oacc[d][4 * q + 2] * inv, oacc[d][4 * q + 3] * inv);
      *(u32x2*)(YM + 32 * d + 8 * q + 4 * hh) = o;
    }
}

DI void phase_qkv(const Params& p, int layer, int bid, int nb, char* smem) {
  const int MQ = layer == 0 ? MT : ML;
  const int nq = (MQ / 128) * 3, nkv = (MT / 128) * 4, nst = NB * NCH * 8;
  const float* RS = (const float*)(p.ws + OFF_RSTD);
  EpiQ eq{(bf16_t*)(p.ws + OFF_QB), RS};
  EpiKV ekv{(bf16_t*)(p.ws + OFF_KB), (bf16_t*)(p.ws + OFF_VT), RS};
  const bf16_t* U = (const bf16_t*)(p.ws + OFF_U);
  for (int it = bid; it < nq + nkv + nst; it += nb) {
    if (it < nq) gemm_tile<false>(U, DIN, wt_ptr(p, layer, WT_UQ), 256, (it / 3) * 128, (it % 3) * 128, smem, eq);
    else if (it < nq + nkv) { int j = it - nq; gemm_tile<false>(U + U_CKV, DIN, wt_ptr(p, layer, WT_UKV), 128, (j / 4) * 128, (j % 4) * 128, smem, ekv); }
    else { int j = it - nq - nkv; for (int rep = 0; rep < REP_SSD; ++rep) ssd_state_item(p, layer, j / (NCH * 8), (j / 8) % NCH, j & 7, smem); }
  }
}
DI void phase_att(const Params& p, int layer, int bid, int nb, int vbid, int nvb, char* smem, char* sh) {
  for (int it = bid; it < 256; it += nb) {
    const int x = it & 7, j = it >> 3, bh = 2 * x + (j >> 4), qb = j & 15, b = bh >> 2, head = bh & 3;
    for (int rep = 0; rep < REP_ATT; ++rep) attn_item8(p, b, head, b * SEQ + qb * 256, qb * 256, true, LK, smem);
  }
  const int nctx = layer == 0 ? 32 : 0, npass = 512;
  for (int it = vbid; it < nctx + npass; it += nvb) {
    if (it < nctx) { int b = it >> 3, head = (it >> 1) & 3, qb = it & 1; attn_item(p, b, head, ML + b * CTX + qb * 128, qb * 128, false, CTX, sh); }
    else ssd_pass_item(p, it - nctx);
  }
}
DI void phase_ssdout(const Params& p, int layer, int bid, int nb, char* smem) {
  for (int it = bid; it < NB * NCH * 8; it += nb) {
    int b = it / (NCH * 8), tc = (it / 8) % NCH, h = it & 7;
    if (layer == 1 && tc < 2) continue;
    for (int rep = 0; rep < REP_SSD; ++rep) ssd_out_item(p, layer, b, tc, h, smem);
  }
}


#define XB_TMO      128
#define XB_XCNT(j)  (256  + 64 * (j))
#define XB_XSUB(j)  (1280 + 64 * (j))
#define XB_XGEN(j)  (2304 + 64 * (j))
#define XB_TOP      3328
#define XB_TOPGEN   3392
#define XCD_BAR_WORDS 3456
#define XB_SPIN_CAP (1u << 22)
#define LAS __attribute__((address_space(3)))
DI unsigned xb_ld(unsigned* p) { return __hip_atomic_load(p, __ATOMIC_RELAXED, __HIP_MEMORY_SCOPE_AGENT); }
DI unsigned xb_add(unsigned* p, unsigned v) { return __hip_atomic_fetch_add(p, v, __ATOMIC_RELAXED, __HIP_MEMORY_SCOPE_AGENT); }
DI unsigned xb_xcc_id() { return (unsigned)__builtin_amdgcn_s_getreg((3 << 11) | 20) & 0xFu; }
#define XB_SPIN(cond, bar) do { unsigned _sp = 0; while (cond) { __builtin_amdgcn_s_sleep(1); \
    if ((++_sp & 255u) == 0u) { if (xb_ld(&(bar)[XB_TMO])) break; if (_sp > XB_SPIN_CAP) { atomicAdd(&(bar)[XB_TMO], 1u); break; } } } } while (0)
struct XcdBarrier { unsigned* bar; unsigned x; volatile LAS unsigned* st; };
DI XcdBarrier xcd_barrier_post(unsigned* bar, volatile LAS unsigned* st) {
  XcdBarrier b; b.bar = bar; b.x = xb_xcc_id(); b.st = st;
  if (threadIdx.x == 0) (void)xb_add(&bar[XB_XCNT(b.x)], 1u);
  return b;
}
DI void xcd_barrier_complete(unsigned* bar, unsigned x, unsigned& nloc, unsigned& nx) {
  const unsigned G = gridDim.x * gridDim.y * gridDim.z;
  unsigned sum, cnt, mine, sp = 0u;
  for (;;) {
    sum = 0u; cnt = 0u; mine = 0u;
#pragma unroll
    for (unsigned j = 0; j < 16; ++j) { const unsigned c = xb_ld(&bar[XB_XCNT(j)]); sum += c; cnt += (c > 0u) ? 1u : 0u; mine = (j == x) ? c : mine; }
    if (sum == G) break;
    __builtin_amdgcn_s_sleep(1);
    if ((++sp & 255u) == 0u) { if (xb_ld(&bar[XB_TMO])) break; if (sp > XB_SPIN_CAP) { atomicAdd(&bar[XB_TMO], 1u); break; } }
  }
  nloc = mine > 0u ? mine : 1u; nx = cnt > 0u ? cnt : 1u;
}
DI void xcd_barrier(const XcdBarrier& b) {
  asm volatile("s_waitcnt vmcnt(0)" ::: "memory");
  __syncthreads();
  if (threadIdx.x == 0) {
    unsigned* bar = b.bar;
    asm volatile("" : "+s"(bar));
    __builtin_amdgcn_s_waitcnt(0);
    unsigned nloc = b.st[0], nx = b.st[1];
    if (nloc == 0u) { xcd_barrier_complete(bar, b.x, nloc, nx); b.st[0] = nloc; b.st[1] = nx; }
    const unsigned old = xb_add(&bar[XB_XSUB(b.x)], 1u);
    const unsigned gen = old / nloc;
    if (old + 1u == (gen + 1u) * nloc) {
      __builtin_amdgcn_fence(__ATOMIC_RELEASE, "agent");
      asm volatile("s_waitcnt vmcnt(0)" ::: "memory");
      const unsigned og = xb_add(&bar[XB_TOP], 1u);
      const unsigned tg = og / nx;
      if (og + 1u == (tg + 1u) * nx) xb_add(&bar[XB_TOPGEN], 1u);
      else XB_SPIN(xb_ld(&bar[XB_TOPGEN]) == tg, bar);
      __builtin_amdgcn_fence(__ATOMIC_ACQUIRE, "agent");
      xb_add(&bar[XB_XGEN(b.x)], 1u);
      asm volatile("s_waitcnt vmcnt(0)" ::: "memory");
    } else {
      XB_SPIN(xb_ld(&bar[XB_XGEN(b.x)]) == gen, bar);
      __builtin_amdgcn_fence(__ATOMIC_ACQUIRE, "agent");
      asm volatile("s_waitcnt vmcnt(0)" ::: "memory");
    }
  }
  __syncthreads();
}

constexpr int SMEM_BYTES = 2 * GBUF * 2;
enum { PH_PREP0 = 0, PH_H0, PH_INPROJ, PH_PREP, PH_QKV, PH_ATT, PH_SSDOUT, PH_WOUT, PH_POSTMIX, PH_FF1, PH_FF2, PH_POSTFFN, PH_SSDNORM };

struct Ids { int bid, nb, vbid, nvb, lid; };
DI void run_phase(const Params& p, int ph, int layer, const Ids& id, char* smem, char* sh) {
  switch (ph) {
    case PH_PREP0: phase_prep0(p, id.vbid, id.nvb, sh); break;
    case PH_H0: phase_h0(p, id.vbid, id.nvb); break;
    case PH_INPROJ: phase_inproj(p, layer, id.bid, id.nb, smem); break;
    case PH_PREP: phase_prep(p, layer, id.vbid, id.nvb); break;
    case PH_QKV: phase_qkv(p, layer, id.vbid, id.nvb, sh); break;
    case PH_ATT: phase_att(p, layer, id.bid, id.nb, id.vbid, id.nvb, smem, sh); break;
    case PH_SSDOUT: phase_ssdout(p, layer, id.vbid, id.nvb, sh); break;
    case PH_WOUT: phase_wout(p, layer, id.lid, id.nvb, sh); break;
    case PH_POSTMIX: phase_postmix(p, layer, id.vbid, id.nvb); break;
    case PH_FF1: phase_ff1(p, layer, id.bid, id.nb, id.vbid, id.nvb, smem, sh); break;
    case PH_FF2: phase_ff2(p, layer, id.bid, id.nb, id.vbid, id.nvb, smem, sh); break;
    case PH_POSTFFN: phase_postffn(p, layer, id.vbid, id.nvb); break;
  }
}

__global__ void __launch_bounds__(512) mega_kernel(Params p) {
  extern __shared__ __attribute__((aligned(16))) char smem[];
  cg::grid_group grid = cg::this_grid();
  if (p.ws == nullptr) grid.sync();
  const int half = __builtin_amdgcn_readfirstlane((int)(threadIdx.x >> 8));
  Ids id;
  id.bid = blockIdx.x; id.nb = gridDim.x;
  id.vbid = 2 * id.bid + half; id.nvb = 2 * id.nb;
  id.lid = (id.bid & 7) + 8 * (2 * (id.bid >> 3) + half);
  char* sh = smem + half * SMEM_BYTES;
  volatile LAS unsigned* st = (volatile LAS unsigned*)(smem + 2 * SMEM_BYTES - 16);
  if (threadIdx.x == 0) { st[0] = 0u; st[1] = 0u; st[2] = 0u; st[3] = 0u; }
  __syncthreads();
  XcdBarrier xb = xcd_barrier_post((unsigned*)(p.ws + OFF_BAR), st);
#define MK_STEP(PH, LAYER, LAST) do { \
    typedef const void* __attribute__((address_space(4))) * KArgs; \
    KArgs ka = (KArgs)__builtin_amdgcn_kernarg_segment_ptr(); \
    asm volatile("" : "+s"(ka)); \
    Params q; \
    { const void** dst = (const void**)&q; _Pragma("unroll") for (int i = 0; i < 27; ++i) dst[i] = ka[i]; } \
    run_phase(q, PH, LAYER, id, smem, sh); \
    if (!(LAST)) xcd_barrier(xb); } while (0)
  MK_STEP(PH_PREP0, 0, false);
  MK_STEP(PH_H0, 0, false);
  MK_STEP(PH_INPROJ, 0, false); MK_STEP(PH_PREP, 0, false); MK_STEP(PH_QKV, 0, false); MK_STEP(PH_ATT, 0, false); MK_STEP(PH_SSDOUT, 0, false);
  MK_STEP(PH_WOUT, 0, false); MK_STEP(PH_POSTMIX, 0, false); MK_STEP(PH_FF1, 0, false); MK_STEP(PH_FF2, 0, false); MK_STEP(PH_POSTFFN, 0, false);
  MK_STEP(PH_INPROJ, 1, false); MK_STEP(PH_PREP, 1, false); MK_STEP(PH_QKV, 1, false); MK_STEP(PH_ATT, 1, false); MK_STEP(PH_SSDOUT, 1, false);
  MK_STEP(PH_WOUT, 1, false); MK_STEP(PH_POSTMIX, 1, false); MK_STEP(PH_FF1, 1, false); MK_STEP(PH_FF2, 1, false); MK_STEP(PH_POSTFFN, 1, true);
#undef MK_STEP
}

extern "C" void kernel_launch(void* const* d_in, const int* in_sizes, int n_in, void* d_out, int out_size, void* d_ws, size_t ws_size,
                              hipStream_t stream) {
  if (ws_size < WS_NEED) { fprintf(stderr, "workspace too small: %zu < %zu\n", ws_size, (size_t)WS_NEED); return; }
  Params p{};
  const float** f = (const float**)&p;
  for (int i = 0; i < 25; ++i) f[i] = (const float*)d_in[i];
  p.out = (float*)d_out;
  p.ws = (char*)d_ws;
  static int grid_blocks = 0;
  if (!grid_blocks) {
    int dev = 0, cus = 0, per_cu = 0;
    hipGetDevice(&dev);
    hipDeviceGetAttribute(&cus, hipDeviceAttributeMultiprocessorCount, dev);
    hipFuncSetAttribute((const void*)mega_kernel, hipFuncAttributeMaxDynamicSharedMemorySize, 2 * SMEM_BYTES);
    hipOccupancyMaxActiveBlocksPerMultiprocessor(&per_cu, mega_kernel, 512, 2 * SMEM_BYTES);
    if (per_cu > 1) per_cu = 1;
    grid_blocks = cus * per_cu;
  }
  hipMemsetAsync((char*)d_ws + OFF_BAR, 0, XCD_BAR_WORDS * 4, stream);
  void* args[] = {&p};
  hipError_t e = hipLaunchCooperativeKernel((void*)mega_kernel, dim3(grid_blocks), dim3(512), args, 2 * SMEM_BYTES, stream);
  if (e != hipSuccess) fprintf(stderr, "cooperative launch failed: %s (grid %d)\n", hipGetErrorString(e), grid_blocks);
}
```

```cpp
#include <hip/hip_runtime.h>
#include <hip/hip_cooperative_groups.h>
#include <stdint.h>
#include <stdio.h>
namespace cg = cooperative_groups;

#ifndef MEGA
#define MEGA 1
#endif
#ifndef REP_GEMM
#define REP_GEMM 1
#endif
#ifndef REP_ATT
#define REP_ATT 1
#endif
#ifndef REP_SSD
#define REP_SSD 1
#endif

typedef unsigned short bf16_t;
using bf16x8 = __attribute__((ext_vector_type(8))) short;
using s16x4  = __attribute__((ext_vector_type(4))) short;
using f32x4  = __attribute__((ext_vector_type(4))) float;
using f32x16 = __attribute__((ext_vector_type(16))) float;
using u32x4  = __attribute__((ext_vector_type(4))) unsigned;
using u32x2  = __attribute__((ext_vector_type(2))) unsigned;
#define DI __device__ __forceinline__
#define MFMA32(a, b, c) __builtin_amdgcn_mfma_f32_32x32x16_bf16((a), (b), (c), 0, 0, 0)
#define MFMA16(a, b, c) __builtin_amdgcn_mfma_f32_16x16x32_bf16((a), (b), (c), 0, 0, 0)

constexpr int DM = 1024, NB = 4, SEQ = 4096, CTX = 256;
constexpr int ML = NB * SEQ;
constexpr int MC = NB * CTX;
constexpr int MT = ML + MC;
constexpr int DIN = 2480, DINP = 2560;
constexpr int LK = CTX + SEQ;
constexpr int DFF = 4096;
constexpr int NCH = 34;
constexpr float EPS = 1e-6f;
constexpr int U_CKV = 256, U_KR = 384, U_GB = 416, U_GC = 672, U_VAL = 928, U_Z = 1184, U_XBC = 1696, U_DT = 2464;

constexpr size_t AL(size_t x) { return (x + 255) & ~(size_t)255; }
constexpr size_t WT_IN = 0;
constexpr size_t WT_UQ = WT_IN + (size_t)DINP * 1024;
constexpr size_t WT_UKV = WT_UQ + (size_t)384 * 256;
constexpr size_t WT_OUT = WT_UKV + (size_t)512 * 128;
constexpr size_t WT_FF1 = WT_OUT + (size_t)1024 * 1024;
constexpr size_t WT_FF2 = WT_FF1 + (size_t)4096 * 1024;
constexpr size_t WT_ELEMS = WT_FF2 + (size_t)4096 * 1024;
constexpr size_t OFF_WT = 0;
constexpr size_t OFF_MOD = AL(OFF_WT + 2 * WT_ELEMS * 2);
constexpr size_t OFF_XC = AL(OFF_MOD + 2 * 5 * 6144 * 4);
constexpr size_t OFF_H = AL(OFF_XC + (size_t)MC * DM * 4);
constexpr size_t OFF_R1 = AL(OFF_H + (size_t)MT * DM * 2);
constexpr size_t OFF_U = OFF_R1;
constexpr size_t OFF_DT = AL(OFF_U + (size_t)MT * DIN * 2);
constexpr size_t OFF_RSTD = AL(OFF_DT + (size_t)MT * 16 * 4);
constexpr size_t OFF_QB = AL(OFF_RSTD + (size_t)MT * 2 * 4);
constexpr size_t OFF_KB = AL(OFF_QB + (size_t)MT * 384 * 2);
constexpr size_t OFF_VT = AL(OFF_KB + (size_t)NB * 4 * LK * 96 * 2);
constexpr size_t OFF_XBC = AL(OFF_VT + (size_t)NB * 4 * 64 * LK * 2);
constexpr size_t OFF_SST = AL(OFF_XBC + (size_t)MT * 768 * 2);
constexpr size_t OFF_TDEC = AL(OFF_SST + (size_t)2 * NB * NCH * 8 * 4096 * 2);
constexpr size_t OFF_SSQ = AL(OFF_TDEC + (size_t)2 * NB * NCH * 8 * 4);
constexpr size_t OFF_END1 = AL(OFF_SSQ + (size_t)MT * 8 * 4);
constexpr size_t OFF_F1 = OFF_R1;
constexpr size_t OFF_END2 = AL(OFF_F1 + (size_t)MT * DFF * 2);
constexpr size_t OFF_BAR = OFF_END1 > OFF_END2 ? OFF_END1 : OFF_END2;
constexpr size_t WS_NEED = OFF_BAR + 16384;

struct Params {
  const float *x, *c, *ctx, *c_ctx, *w_mod, *b_mod, *g_pre_mix, *w_in, *q_norm, *w_uq, *kv_norm, *w_ukv, *sc_w, *ssd_cw, *ssd_cb,
      *a_log, *dt_bias, *ssd_d, *ssd_norm, *w_out, *g_post_mix, *g_pre_ffn, *w_ff1, *w_ff2, *g_post_ffn;
  float* out;
  char* ws;
};

DI int ltid() { int t = threadIdx.x; asm volatile("" : "+v"(t)); return t & 255; }
DI int ltid512() { int t = threadIdx.x; asm volatile("" : "+v"(t)); return t; }
typedef __bf16 hbf2 __attribute__((ext_vector_type(2)));
typedef float hf2 __attribute__((ext_vector_type(2)));
DI bf16_t f2bf(float x) { return __builtin_bit_cast(bf16_t, (__bf16)x); }
DI float bf2f(unsigned v) { return __uint_as_float(v << 16); }
DI unsigned pack2(float a, float b) { hf2 v = {a, b}; return __builtin_bit_cast(unsigned, __builtin_convertvector(v, hbf2)); }
DI float lo2f(unsigned w) { return __uint_as_float(w << 16); }
DI float hi2f(unsigned w) { return __uint_as_float(w & 0xffff0000u); }
DI float wave_sum(float v) {
#pragma unroll
  for (int o = 32; o > 0; o >>= 1) v += __shfl_xor(v, o);
  return v;
}
DI float silu_f(float x) { return x / (1.f + __expf(-x)); }
DI int crow(int reg, int h) { return (reg & 3) + 8 * (reg >> 2) + 4 * h; }
DI bf16x8 pack8(const f32x16& x, int s) {
  u32x4 p;
  p[0] = pack2(x[8 * s + 0], x[8 * s + 1]); p[1] = pack2(x[8 * s + 2], x[8 * s + 3]);
  p[2] = pack2(x[8 * s + 4], x[8 * s + 5]); p[3] = pack2(x[8 * s + 6], x[8 * s + 7]);
  return __builtin_bit_cast(bf16x8, p);
}
DI const float* xin_row(const Params& p, int layer, int row) {
  if (layer == 0) return row < ML ? p.x + (size_t)row * DM : p.ctx + (size_t)(row - ML) * DM;
  return row < ML ? p.out + (size_t)row * DM : (const float*)(p.ws + OFF_XC) + (size_t)(row - ML) * DM;
}
DI float* xst_row(const Params& p, int row) {
  return row < ML ? p.out + (size_t)row * DM : (float*)(p.ws + OFF_XC) + (size_t)(row - ML) * DM;
}
DI const float* mod_ptr(const Params& p, int layer, int row, int which) {
  int bb = row < ML ? (row >> 12) : 4;
  return (const float*)(p.ws + OFF_MOD) + ((size_t)(layer * 5 + bb) * 6 + which) * DM;
}
DI bf16_t* wt_ptr(const Params& p, int layer, size_t off) { return (bf16_t*)(p.ws + OFF_WT) + (size_t)layer * WT_ELEMS + off; }

DI void transpose_item(const float* __restrict__ w, const float* __restrict__ gk, int gk_from, bf16_t* __restrict__ wt, int K, int N, int kt, int nt, char* smem) {
  float* tile = (float*)smem;
  const int tid = ltid(), tx = tid & 63, ty = tid >> 6;
  const int k0 = kt * 64, n0 = nt * 64;
  const int n = n0 + tx;
  float v[16];
#pragma unroll
  for (int i = 0; i < 16; ++i) {
    int kk = ty + 4 * i;
    v[i] = n < N ? w[(size_t)(k0 + kk) * N + n] : 0.f;
  }
  if (gk) {
#pragma unroll
    for (int i = 0; i < 16; ++i) { int k = k0 + ty + 4 * i; if (k >= gk_from) v[i] *= gk[k - gk_from]; }
  }
#pragma unroll
  for (int i = 0; i < 16; ++i) tile[(ty + 4 * i) * 65 + tx] = v[i];
  __syncthreads();
#pragma unroll
  for (int i = 0; i < 2; ++i) {
    int c = tid + 256 * i, nn = c >> 3, kc = c & 7;
    u32x4 o;
#pragma unroll
    for (int jj = 0; jj < 4; ++jj) o[jj] = pack2(tile[(kc * 8 + 2 * jj) * 65 + nn], tile[(kc * 8 + 2 * jj + 1) * 65 + nn]);
    *(u32x4*)(wt + (size_t)(n0 + nn) * K + k0 + kc * 8) = o;
  }
  __syncthreads();
}

DI void modgemv_item(const Params& p, int layer, int ct, char* smem) {
  float* s = (float*)smem;
  float* red = s + 5 * 1024;
  const int tid = ltid(), w = tid >> 6, lane = tid & 63;
  for (int i = tid; i < 5 * 1024; i += 256) {
    int bb = i >> 10, k = i & 1023;
    float v = bb < 4 ? p.c[bb * 1024 + k] : p.c_ctx[k];
    s[i] = silu_f(v);
  }
  __syncthreads();
  const float* wm = p.w_mod + (size_t)layer * 1024 * 6144;
  const int n = ct * 64 + lane;
  float acc[5] = {0.f, 0.f, 0.f, 0.f, 0.f};
#pragma unroll 16
  for (int k = w * 256; k < w * 256 + 256; ++k) {
    float wv = wm[(size_t)k * 6144 + n];
#pragma unroll
    for (int bb = 0; bb < 5; ++bb) acc[bb] += s[bb * 1024 + k] * wv;
  }
#pragma unroll
  for (int bb = 0; bb < 5; ++bb) red[(w * 5 + bb) * 64 + lane] = acc[bb];
  __syncthreads();
  for (int i = tid; i < 320; i += 256) {
    int bb = i >> 6, ln = i & 63;
    float v = red[(0 * 5 + bb) * 64 + ln] + red[(1 * 5 + bb) * 64 + ln] + red[(2 * 5 + bb) * 64 + ln] + red[(3 * 5 + bb) * 64 + ln];
    int nn = ct * 64 + ln;
    v += p.b_mod[layer * 6144 + nn];
    ((float*)(p.ws + OFF_MOD))[(size_t)(layer * 5 + bb) * 6144 + nn] = v;
  }
  __syncthreads();
}

DI void phase_prep0(const Params& p, int bid, int nb, char* smem) {
  constexpr int PER = 2984;
  for (int it = bid; it < 192 + 2 * PER; it += nb) {
    if (it < 192) { modgemv_item(p, it / 96, it % 96, smem); continue; }
    int layer = (it - 192) / PER, j = (it - 192) % PER;
    if (j < 640) transpose_item(p.w_in + (size_t)layer * 1024 * DIN, nullptr, 0, wt_ptr(p, layer, WT_IN), 1024, DIN, j / 40, j % 40, smem);
    else if ((j -= 640) < 24) transpose_item(p.w_uq + (size_t)layer * 256 * 384, p.q_norm + layer * 256, 0, wt_ptr(p, layer, WT_UQ), 256, 384, j / 6, j % 6, smem);
    else if ((j -= 24) < 16) transpose_item(p.w_ukv + (size_t)layer * 128 * 512, p.kv_norm + layer * 128, 0, wt_ptr(p, layer, WT_UKV), 128, 512, j / 8, j % 8, smem);
    else if ((j -= 16) < 256) transpose_item(p.w_out + (size_t)layer * 1024 * 1024, p.ssd_norm + layer * 512, 512, wt_ptr(p, layer, WT_OUT), 1024, 1024, j / 16, j % 16, smem);
    else if ((j -= 256) < 1024) transpose_item(p.w_ff1 + (size_t)layer * 1024 * 4096, nullptr, 0, wt_ptr(p, layer, WT_FF1), 1024, 4096, j / 64, j % 64, smem);
    else { j -= 1024; transpose_item(p.w_ff2 + (size_t)layer * 4096 * 1024, nullptr, 0, wt_ptr(p, layer, WT_FF2), 4096, 1024, j / 16, j % 16, smem); }
  }
}

struct HMod { float4 g[4], s1[4], s0[4]; };
DI void load_hmod(HMod& m, const float* g, const float* sh, const float* sc, int lane) {
#pragma unroll
  for (int i = 0; i < 4; ++i) {
    const int col = lane * 4 + 256 * i;
    m.g[i] = *(const float4*)(g + col); m.s1[i] = *(const float4*)(sc + col); m.s0[i] = *(const float4*)(sh + col);
  }
}
DI void write_h_row(const float4 xv[4], float rstd, const HMod& m, bf16_t* hrow, int lane) {
#pragma unroll
  for (int i = 0; i < 4; ++i) {
    const int col = lane * 4 + 256 * i;
    float a = xv[i].x * rstd * m.g[i].x * (1.f + m.s1[i].x) + m.s0[i].x;
    float b = xv[i].y * rstd * m.g[i].y * (1.f + m.s1[i].y) + m.s0[i].y;
    float c = xv[i].z * rstd * m.g[i].z * (1.f + m.s1[i].z) + m.s0[i].z;
    float d = xv[i].w * rstd * m.g[i].w * (1.f + m.s1[i].w) + m.s0[i].w;
    u32x2 o; o[0] = pack2(a, b); o[1] = pack2(c, d);
    *(u32x2*)(hrow + col) = o;
  }
}
DI float ssq4(const float4 v[4]) {
  float s = 0.f;
#pragma unroll
  for (int i = 0; i < 4; ++i) s += v[i].x * v[i].x + v[i].y * v[i].y + v[i].z * v[i].z + v[i].w * v[i].w;
  return s;
}
DI void load_bf_row(const bf16_t* r, int lane, float4 v[4]) {
#pragma unroll
  for (int i = 0; i < 4; ++i) {
    u32x2 t = *(const u32x2*)(r + lane * 4 + 256 * i);
    v[i] = make_float4(lo2f(t[0]), hi2f(t[0]), lo2f(t[1]), hi2f(t[1]));
  }
}

struct RowVec { float4 c1[4], c2[4], c3[4]; };
DI const float* mod_ptr_b(const Params& p, int layer, int bb, int which) {
  return (const float*)(p.ws + OFF_MOD) + ((size_t)(layer * 5 + bb) * 6 + which) * DM;
}
template <int MODE>
DI void rowwise_phase(const Params& p, int layer, int bid, int nb) {
  const int w = ltid() >> 6, lane = ltid() & 63;
  const int M = (MODE == 0 || layer == 0) ? MT : ML;
  const bool wh = MODE != 2 || layer == 0;
  bf16_t* H = (bf16_t*)(p.ws + OFF_H);
  const bf16_t* Y = MODE == 1 ? (const bf16_t*)(p.ws + OFF_U) : (const bf16_t*)(p.ws + OFF_H);
  const int NW = nb * 4, W = bid * 4 + w, nwb = NW >> 2;
  auto load_vec = [&](RowVec& v, int bb) {
    const float* gate = MODE == 1 ? mod_ptr_b(p, layer, bb, 2) : mod_ptr_b(p, layer, bb, 5);
    const float* gres = MODE == 1 ? p.g_post_mix + layer * DM : p.g_post_ffn + layer * DM;
    const int hl = MODE == 2 ? 1 : layer;
    const float* gn = MODE == 1 ? p.g_pre_ffn + layer * DM : p.g_pre_mix + hl * DM;
    const float* sh = mod_ptr_b(p, hl, bb, MODE == 1 ? 3 : 0);
    const float* sc = mod_ptr_b(p, hl, bb, MODE == 1 ? 4 : 1);
#pragma unroll
    for (int i = 0; i < 4; ++i) {
      const int col = lane * 4 + 256 * i;
      if (MODE != 0) {
        const float4 a = *(const float4*)(gate + col), b = *(const float4*)(gres + col);
        v.c1[i] = make_float4(a.x * b.x, a.y * b.y, a.z * b.z, a.w * b.w);
      }
      if (wh) {
        const float4 g = *(const float4*)(gn + col), s1 = *(const float4*)(sc + col);
        v.c2[i] = make_float4(g.x * (1.f + s1.x), g.y * (1.f + s1.y), g.z * (1.f + s1.z), g.w * (1.f + s1.w));
        v.c3[i] = *(const float4*)(sh + col);
      }
    }
  };
  struct RowIn { u32x2 y[4]; float4 x[4]; };
  auto load_row = [&](RowIn& r, int row) {
    const float* xr = MODE == 2 ? (const float*)xst_row(p, row) : xin_row(p, layer, row);
#pragma unroll
    for (int i = 0; i < 4; ++i) {
      r.x[i] = *(const float4*)(xr + lane * 4 + 256 * i);
      if (MODE != 0) r.y[i] = *(const u32x2*)(Y + (size_t)row * DM + lane * 4 + 256 * i);
    }
  };
  auto finish = [&](float4 (&xv)[4], const float4 (&yv)[4], const RowVec& v, int row) {
    if (MODE != 0) {
      const float rstd = rsqrtf(wave_sum(ssq4(yv)) * (1.f / DM) + EPS);
#pragma unroll
      for (int i = 0; i < 4; ++i) {
        xv[i].x += yv[i].x * rstd * v.c1[i].x; xv[i].y += yv[i].y * rstd * v.c1[i].y;
        xv[i].z += yv[i].z * rstd * v.c1[i].z; xv[i].w += yv[i].w * rstd * v.c1[i].w;
      }
      float* xo = xst_row(p, row);
#pragma unroll
      for (int i = 0; i < 4; ++i) *(float4*)(xo + lane * 4 + 256 * i) = xv[i];
    }
    if (wh) {
      const float rstd1 = rsqrtf(wave_sum(ssq4(xv)) * (1.f / DM) + EPS);
      bf16_t* hrow = H + (size_t)row * DM;
#pragma unroll
      for (int i = 0; i < 4; ++i) {
        u32x2 o;
        o[0] = pack2(xv[i].x * rstd1 * v.c2[i].x + v.c3[i].x, xv[i].y * rstd1 * v.c2[i].y + v.c3[i].y);
        o[1] = pack2(xv[i].z * rstd1 * v.c2[i].z + v.c3[i].z, xv[i].w * rstd1 * v.c2[i].w + v.c3[i].w);
        *(u32x2*)(hrow + lane * 4 + 256 * i) = o;
      }
    }
  };
  auto process = [&](RowIn& r, const RowVec& v, int row) {
    float4 yv[4];
#pragma unroll
    for (int i = 0; i < 4; ++i) yv[i] = make_float4(lo2f(r.y[i][0]), hi2f(r.y[i][0]), lo2f(r.y[i][1]), hi2f(r.y[i][1]));
    finish(r.x, yv, v, row);
  };
  RowVec v;
  {
    const int bb = W / nwb, j = W - bb * nwb, end = SEQ * (bb + 1);
    load_vec(v, bb);
    RowIn ra, rb;
    int row = SEQ * bb + j;
    if (row < end) load_row(ra, row);
    while (row < end) {
      const int rowb = row + nwb;
      const bool hb = rowb < end;
      if (hb) load_row(rb, rowb);
      process(ra, v, row);
      if (!hb) break;
      const int rowa = rowb + nwb;
      const bool ha = rowa < end;
      if (ha) load_row(ra, rowa);
      process(rb, v, rowb);
      if (!ha) break;
      row = rowa;
    }
  }
  if (M > ML) {
    load_vec(v, 4);
    for (int row = ML + W; row < M; row += NW) {
      float4 xv[4], yv[4];
      const float* xr = MODE == 2 ? (const float*)xst_row(p, row) : xin_row(p, layer, row);
#pragma unroll
      for (int i = 0; i < 4; ++i) xv[i] = *(const float4*)(xr + lane * 4 + 256 * i);
      if (MODE == 1) load_bf_row(Y + (size_t)row * DM, lane, yv);
      if (MODE == 2) {
        const float* pp = (const float*)(p.ws + OFF_END2) + (size_t)(row - ML) * DM;
#pragma unroll
        for (int i = 0; i < 4; ++i) {
          float4 a = *(const float4*)(pp + lane * 4 + 256 * i), b = *(const float4*)(pp + (size_t)MC * DM + lane * 4 + 256 * i);
          float4 c = *(const float4*)(pp + (size_t)2 * MC * DM + lane * 4 + 256 * i), d = *(const float4*)(pp + (size_t)3 * MC * DM + lane * 4 + 256 * i);
          yv[i] = make_float4((a.x + b.x) + (c.x + d.x), (a.y + b.y) + (c.y + d.y), (a.z + b.z) + (c.z + d.z), (a.w + b.w) + (c.w + d.w));
        }
      }
      finish(xv, yv, v, row);
    }
  }
}
DI void phase_h0(const Params& p, int bid, int nb) { rowwise_phase<0>(p, 0, bid, nb); }
DI void phase_postmix(const Params& p, int layer, int bid, int nb) { rowwise_phase<1>(p, layer, bid, nb); }
DI void phase_postffn(const Params& p, int layer, int bid, int nb) { rowwise_phase<2>(p, layer, bid, nb); }

DI void phase_prep(const Params& p, int layer, int bid, int nb) {
  const int w = ltid() >> 6, lane = ltid() & 63;
  const bf16_t* U = (const bf16_t*)(p.ws + OFF_U);
  float* DT = (float*)(p.ws + OFF_DT);
  float* RS = (float*)(p.ws + OFF_RSTD);
  bf16_t* KB = (bf16_t*)(p.ws + OFF_KB);
  bf16_t* XBC = (bf16_t*)(p.ws + OFF_XBC);
  bf16_t* YM = (bf16_t*)(p.ws + OFF_H);
  const float* scw = p.sc_w + layer * 3 * 256;
  const float* cw = p.ssd_cw + layer * 3 * 768;
  const float* cb = p.ssd_cb + layer * 768;
  const int c4 = lane * 4;
  const float4 sw0 = *(const float4*)(scw + c4), sw1 = *(const float4*)(scw + 256 + c4), sw2 = *(const float4*)(scw + 512 + c4);
  float4 cwk[3][3], cbi[3];
#pragma unroll
  for (int i = 0; i < 3; ++i) {
    cbi[i] = *(const float4*)(cb + c4 + 256 * i);
#pragma unroll
    for (int k = 0; k < 3; ++k) cwk[i][k] = *(const float4*)(cw + k * 768 + c4 + 256 * i);
  }
  const float dtb = p.dt_bias[layer * 16 + (lane & 15)];
  const float invf = exp2f(-(float)(2 * (lane & 7)) * (13.287712379549449f / 16.f));
  for (int row = bid * 4 + w; row < MT; row += nb * 4) {
    int b, t, L, pos;
    const bool lat = row < ML;
    if (lat) { b = row >> 12; t = row & 4095; L = SEQ; pos = t + CTX; }
    else { int rr = row - ML; b = rr >> 8; t = rr & 255; L = CTX; pos = t; }
    const bf16_t* u0 = U + (size_t)row * DIN;
    const bool hp = t > 0, hn = t < L - 1;
    const bf16_t* um = hp ? u0 - DIN : u0;
    const bf16_t* up = hn ? u0 + DIN : u0;
    const float mp = hp ? 1.f : 0.f, mn = hn ? 1.f : 0.f;
    const u32x2 vq = *(const u32x2*)(u0 + c4);
    const u32x2 vkv = *(const u32x2*)(u0 + U_CKV + (lane & 31) * 4);
    const float kr = bf2f(u0[U_KR + (lane & 31)]);
    const u32x2 gcm = *(const u32x2*)(um + U_GC + c4), gc0 = *(const u32x2*)(u0 + U_GC + c4), gcp = *(const u32x2*)(up + U_GC + c4);
    const u32x2 vvm = *(const u32x2*)(um + U_VAL + c4), vv0 = *(const u32x2*)(u0 + U_VAL + c4), vvp = *(const u32x2*)(up + U_VAL + c4);
    const u32x2 gb = *(const u32x2*)(u0 + U_GB + c4);
    u32x2 xm[3], x0[3], xp[3];
#pragma unroll
    for (int i = 0; i < 3; ++i) {
      xm[i] = *(const u32x2*)(um + U_XBC + c4 + 256 * i);
      x0[i] = *(const u32x2*)(u0 + U_XBC + c4 + 256 * i);
      xp[i] = *(const u32x2*)(up + U_XBC + c4 + 256 * i);
    }
    const float dtr = DT[(size_t)row * 16 + (lane & 15)];
    {
      float a = lo2f(vq[0]), bq = hi2f(vq[0]), c = lo2f(vq[1]), d = hi2f(vq[1]);
      float ss = wave_sum(a * a + bq * bq + c * c + d * d);
      float e = lo2f(vkv[0]), f = hi2f(vkv[0]), g = lo2f(vkv[1]), h = hi2f(vkv[1]);
      float s2 = lane < 32 ? e * e + f * f + g * g + h * h : 0.f;
      s2 = wave_sum(s2);
      if (lane == 0) { RS[row * 2] = rsqrtf(ss * (1.f / 256) + EPS); RS[row * 2 + 1] = rsqrtf(s2 * (1.f / 128) + EPS); }
    }
    {
      const float partner = __shfl_xor(kr, 8);
      float o = kr;
      if (lat) {
        const int grp = (lane & 31) >> 3;
        const float posf = grp < 2 ? (float)(t >> 6) : (float)(t & 63);
        const float rev = posf * invf * 0.15915494309189535f;
        const float cs = __builtin_amdgcn_cosf(rev), sn = __builtin_amdgcn_sinf(rev);
        o = (grp & 1) ? kr * cs + partner * sn : kr * cs - partner * sn;
      }
      if (lane < 32) {
        const bf16_t ob = f2bf(o);
#pragma unroll
        for (int hd = 0; hd < 4; ++hd) KB[((size_t)(b * 4 + hd) * LK + pos) * 96 + 64 + lane] = ob;
      }
    }
    {
      float a0 = sw1.x * lo2f(gc0[0]) * lo2f(vv0[0]) + mp * sw0.x * lo2f(gcm[0]) * lo2f(vvm[0]) + mn * sw2.x * lo2f(gcp[0]) * lo2f(vvp[0]);
      float a1 = sw1.y * hi2f(gc0[0]) * hi2f(vv0[0]) + mp * sw0.y * hi2f(gcm[0]) * hi2f(vvm[0]) + mn * sw2.y * hi2f(gcp[0]) * hi2f(vvp[0]);
      float a2 = sw1.z * lo2f(gc0[1]) * lo2f(vv0[1]) + mp * sw0.z * lo2f(gcm[1]) * lo2f(vvm[1]) + mn * sw2.z * lo2f(gcp[1]) * lo2f(vvp[1]);
      float a3 = sw1.w * hi2f(gc0[1]) * hi2f(vv0[1]) + mp * sw0.w * hi2f(gcm[1]) * hi2f(vvm[1]) + mn * sw2.w * hi2f(gcp[1]) * hi2f(vvp[1]);
      u32x2 o; o[0] = pack2(lo2f(gb[0]) * a0, hi2f(gb[0]) * a1); o[1] = pack2(lo2f(gb[1]) * a2, hi2f(gb[1]) * a3);
      *(u32x2*)(YM + (size_t)row * DM + 256 + c4) = o;
    }
#pragma unroll
    for (int i = 0; i < 3; ++i) {
      float a0 = cbi[i].x + cwk[i][1].x * lo2f(x0[i][0]) + mp * cwk[i][0].x * lo2f(xm[i][0]) + mn * cwk[i][2].x * lo2f(xp[i][0]);
      float a1 = cbi[i].y + cwk[i][1].y * hi2f(x0[i][0]) + mp * cwk[i][0].y * hi2f(xm[i][0]) + mn * cwk[i][2].y * hi2f(xp[i][0]);
      float a2 = cbi[i].z + cwk[i][1].z * lo2f(x0[i][1]) + mp * cwk[i][0].z * lo2f(xm[i][1]) + mn * cwk[i][2].z * lo2f(xp[i][1]);
      float a3 = cbi[i].w + cwk[i][1].w * hi2f(x0[i][1]) + mp * cwk[i][0].w * hi2f(xm[i][1]) + mn * cwk[i][2].w * hi2f(xp[i][1]);
      u32x2 o; o[0] = pack2(silu_f(a0), silu_f(a1)); o[1] = pack2(silu_f(a2), silu_f(a3));
      *(u32x2*)(XBC + (size_t)row * 768 + c4 + 256 * i) = o;
    }
    if (lane < 16) {
      const float v = dtr + dtb;
      const float e = __expf(-fabsf(v));
      DT[(size_t)row * 16 + lane] = fmaxf(v, 0.f) + (e < 1e-3f ? e * (1.f - 0.5f * e) : __logf(1.f + e));
    }
  }
}

DI void phase_ssdnorm(const Params& p, int layer, int bid, int nb) {
  const int w = ltid() >> 6, lane = ltid() & 63;
  const int M = layer == 0 ? MT : ML;
  bf16_t* YM = (bf16_t*)(p.ws + OFF_H);
  const float* SSQ = (const float*)(p.ws + OFF_SSQ);
  const float* ng = p.ssd_norm + layer * 512;
  for (int row = bid * 4 + w; row < M; row += nb * 4) {
    int g = lane >> 5;
    float4 s = *(const float4*)(SSQ + (size_t)row * 8 + g * 4);
    float rstd = rsqrtf((s.x + s.y + s.z + s.w) * (1.f / 256) + EPS);
    bf16_t* ptr = YM + (size_t)row * DM + 512 + lane * 8;
    u32x4 v = *(const u32x4*)ptr;
    float4 g0 = *(const float4*)(ng + lane * 8), g1 = *(const float4*)(ng + lane * 8 + 4);
    u32x4 o;
    o[0] = pack2(lo2f(v[0]) * rstd * g0.x, hi2f(v[0]) * rstd * g0.y);
    o[1] = pack2(lo2f(v[1]) * rstd * g0.z, hi2f(v[1]) * rstd * g0.w);
    o[2] = pack2(lo2f(v[2]) * rstd * g1.x, hi2f(v[2]) * rstd * g1.y);
    o[3] = pack2(lo2f(v[3]) * rstd * g1.z, hi2f(v[3]) * rstd * g1.w);
    *(u32x4*)ptr = o;
  }
}

constexpr int GST = 80;
constexpr int GBUF = 2 * 128 * GST;
template <bool GN, class Epi>
DI void gemm_tile(const bf16_t* __restrict__ A, int lda, const bf16_t* __restrict__ Bt, int K, int row0, int col0, char* smem, Epi epi, const float* __restrict__ ssq = nullptr) {
  bf16_t* S0 = (bf16_t*)smem;
  const int tid = ltid(), wid = tid >> 6, lane = tid & 63, wr = wid >> 1, wc = wid & 1, fr = lane & 15, fq = lane >> 4;
  f32x4 acc[4][4];
#pragma unroll
  for (int m = 0; m < 4; ++m)
#pragma unroll
    for (int n = 0; n < 4; ++n) acc[m][n] = f32x4{0.f, 0.f, 0.f, 0.f};
  u32x4 ra[4], rb[4];
  const int sr = tid >> 3, sp = tid & 7;
  const bf16_t* ga = A + (size_t)(row0 + sr) * lda + sp * 8;
  const bf16_t* gb = Bt + (size_t)(col0 + sr) * K + sp * 8;
  auto gload = [&](int k0) {
#pragma unroll
    for (int i = 0; i < 4; ++i) {
      ra[i] = *(const u32x4*)(ga + (size_t)(32 * i) * lda + k0);
      rb[i] = *(const u32x4*)(gb + (size_t)(32 * i) * K + k0);
    }
  };
  gload(0);
  float gs[4][2];
  if (GN) {
#pragma unroll
    for (int i = 0; i < 4; ++i) {
      const float4 s0 = *(const float4*)(ssq + (size_t)(row0 + sr + 32 * i) * 8), s1 = *(const float4*)(ssq + (size_t)(row0 + sr + 32 * i) * 8 + 4);
      gs[i][0] = rsqrtf((s0.x + s0.y + s0.z + s0.w) * (1.f / 256) + EPS);
      gs[i][1] = rsqrtf((s1.x + s1.y + s1.z + s1.w) * (1.f / 256) + EPS);
    }
  }
  auto swrite = [&](int kt) {
    if (GN && kt >= 8) {
      const int g = (kt - 8) >> 2;
#pragma unroll
      for (int i = 0; i < 4; ++i) {
        const float sc = g ? gs[i][1] : gs[i][0];
#pragma unroll
        for (int jj = 0; jj < 4; ++jj) ra[i][jj] = pack2(lo2f(ra[i][jj]) * sc, hi2f(ra[i][jj]) * sc);
      }
    }
    bf16_t* As = S0 + (kt & 1) * GBUF;
    bf16_t* Bs = As + 128 * GST;
#pragma unroll
    for (int i = 0; i < 4; ++i) {
      *(u32x4*)(As + (sr + 32 * i) * GST + sp * 8) = ra[i];
      *(u32x4*)(Bs + (sr + 32 * i) * GST + sp * 8) = rb[i];
    }
  };
  const int KT = K / 64;
  swrite(0);
  if (KT > 1) gload(64);
  __syncthreads();
  for (int kt = 0; kt < KT; ++kt) {
    const bf16_t* As = S0 + (kt & 1) * GBUF;
    const bf16_t* Bs = As + 128 * GST;
#pragma unroll
    for (int ks = 0; ks < 2; ++ks) {
      bf16x8 af[4], bfr[4];
#pragma unroll
      for (int m = 0; m < 4; ++m) af[m] = *(const bf16x8*)(As + (wr * 64 + m * 16 + fr) * GST + ks * 32 + fq * 8);
#pragma unroll
      for (int n = 0; n < 4; ++n) bfr[n] = *(const bf16x8*)(Bs + (wc * 64 + n * 16 + fr) * GST + ks * 32 + fq * 8);
#pragma unroll
      for (int m = 0; m < 4; ++m)
#pragma unroll
        for (int n = 0; n < 4; ++n) acc[m][n] = MFMA16(bfr[n], af[m], acc[m][n]);
      if (ks == 0 && kt + 1 < KT) {
        swrite(kt + 1);
        if (kt + 2 < KT) gload((kt + 2) * 64);
      }
    }
    __syncthreads();
  }
  float rsc[4];
#pragma unroll
  for (int m = 0; m < 4; ++m) rsc[m] = epi.scale(row0 + wr * 64 + m * 16 + fr);
#pragma unroll
  for (int m = 0; m < 4; ++m)
#pragma unroll
    for (int n = 0; n < 4; ++n) epi(row0 + wr * 64 + m * 16 + fr, col0 + wc * 64 + n * 16 + fq * 4, acc[m][n], rsc[m]);
}

template <class Epi>
DI void gemm_tile_glds(const bf16_t* __restrict__ A, int lda, const bf16_t* __restrict__ Bt, int ldb, int K, int row0, int col0, char* smem, Epi epi) {
  const int tid = ltid(), wid = tid >> 6, lane = tid & 63, wr = wid >> 1, wc = wid & 1, fr = lane & 15, fq = lane >> 4;
  f32x4 acc[4][4];
#pragma unroll
  for (int m = 0; m < 4; ++m)
#pragma unroll
    for (int n = 0; n < 4; ++n) acc[m][n] = f32x4{0.f, 0.f, 0.f, 0.f};
  const int crow = tid >> 3, cslot = tid & 7, cpart = cslot ^ (crow & 7);
  const bf16_t* ga = A + (size_t)(row0 + crow) * lda + cpart * 8;
  const bf16_t* gb = Bt + (size_t)(col0 + crow) * ldb + cpart * 8;
  auto issue = [&](int kt, int stage) {
    char* sa = smem + stage * 32768 + tid * 16;
#pragma unroll
    for (int i = 0; i < 4; ++i) {
      __builtin_amdgcn_global_load_lds((const unsigned*)(ga + (size_t)(32 * i) * lda + kt * 64), (__attribute__((address_space(3))) unsigned*)(sa + i * 4096), 16, 0, 0);
      __builtin_amdgcn_global_load_lds((const unsigned*)(gb + (size_t)(32 * i) * ldb + kt * 64), (__attribute__((address_space(3))) unsigned*)(sa + 16384 + i * 4096), 16, 0, 0);
    }
  };
  const int KT = K / 64;
  issue(0, 0);
  asm volatile("s_waitcnt vmcnt(0)" ::: "memory");
  __syncthreads();
  const int sw = fr & 7;
  for (int kt = 0; kt < KT; ++kt) {
    if (kt + 1 < KT) issue(kt + 1, (kt + 1) & 1);
    const char* As = smem + (kt & 1) * 32768;
    const char* Bs = As + 16384;
#pragma unroll
    for (int ks = 0; ks < 2; ++ks) {
      bf16x8 af[4], bfr[4];
      const int so = ((ks * 4 + fq) ^ sw) * 16;
#pragma unroll
      for (int m = 0; m < 4; ++m) af[m] = *(const bf16x8*)(As + (wr * 64 + m * 16 + fr) * 128 + so);
#pragma unroll
      for (int n = 0; n < 4; ++n) bfr[n] = *(const bf16x8*)(Bs + (wc * 64 + n * 16 + fr) * 128 + so);
#pragma unroll
      for (int m = 0; m < 4; ++m)
#pragma unroll
        for (int n = 0; n < 4; ++n) acc[m][n] = MFMA16(bfr[n], af[m], acc[m][n]);
    }
    asm volatile("s_waitcnt vmcnt(0)" ::: "memory");
    __syncthreads();
  }
#pragma unroll
  for (int m = 0; m < 4; ++m)
#pragma unroll
    for (int n = 0; n < 4; ++n) epi(row0 + wr * 64 + m * 16 + fr, col0 + wc * 64 + n * 16 + fq * 4, acc[m][n]);
}

constexpr int G8_HT = 128 * 64;
DI int g8_lds_byte(int r, int c) {
  int st = (r >> 4) * 2 + (c >> 5), rr = r & 15, cc = c & 31, ob = rr * 64 + cc * 2;
  return st * 1024 + (ob ^ (((ob >> 9) & 1) << 5));
}
DI void g8_stage_rc(int b, int& R, int& C) {
  int st = b / 1024, sb = b % 1024, swz = sb ^ (((sb >> 9) & 1) << 5);
  R = (st >> 1) * 16 + swz / 64; C = (st & 1) * 32 + (swz % 64) / 2;
}
template <class Epi>
DI void gemm8_tile(const bf16_t* __restrict__ A, int lda, const bf16_t* __restrict__ Bt, int ldb, int K, int brow, int bcol, char* smem, Epi epi,
                   bool first = true, bool has_next = false, int nbrow = 0, int nbcol = 0) {
  bf16_t* shm = (bf16_t*)smem;
  const int tid = ltid512();
#define G8_SA(b, h) (shm + ((b) * 2 + (h)) * G8_HT)
#define G8_SB(b, h) (shm + (4 + (b) * 2 + (h)) * G8_HT)
#define G8_STAGE(P, BASE, LD, br, kt) do { const bf16_t* _g = (BASE) + (size_t)(br) * (LD) + (size_t)(kt) * 64; \
    _Pragma("unroll") for (int _i = 0; _i < 2; ++_i) { int _b = tid * 16 + _i * 8192; int _r, _c; g8_stage_rc(_b, _r, _c); \
      __builtin_amdgcn_global_load_lds((const unsigned*)(_g + (size_t)_r * (LD) + _c), \
        (__attribute__((address_space(3))) unsigned*)((char*)(P) + _b), 16, 0, 0); } } while (0)
#define G8_LDA(dst, b, h) _Pragma("unroll") for (int m = 0; m < 4; ++m) _Pragma("unroll") for (int k = 0; k < 2; ++k) \
    dst[m][k] = *reinterpret_cast<const bf16x8*>((char*)G8_SA(b, h) + g8_lds_byte(wr * 64 + m * 16 + fr, k * 32 + fq * 8))
#define G8_LDB(dst, b, h) _Pragma("unroll") for (int n = 0; n < 2; ++n) _Pragma("unroll") for (int k = 0; k < 2; ++k) \
    dst[n][k] = *reinterpret_cast<const bf16x8*>((char*)G8_SB(b, h) + g8_lds_byte(wc * 32 + n * 16 + fr, k * 32 + fq * 8))
#define G8_MMA(ai, bj, At, Bx) do { __builtin_amdgcn_s_setprio(1); \
    _Pragma("unroll") for (int m = 0; m < 4; ++m) _Pragma("unroll") for (int n = 0; n < 2; ++n) _Pragma("unroll") for (int k = 0; k < 2; ++k) \
      acc[ai][bj][m][n] = __builtin_amdgcn_mfma_f32_16x16x32_bf16(Bx[n][k], At[m][k], acc[ai][bj][m][n], 0, 0, 0); \
    __builtin_amdgcn_s_setprio(0); } while (0)
#define G8_WAIT_V(n) asm volatile("s_waitcnt vmcnt(" #n ")" ::: "memory")
#define G8_WAIT_L(n) asm volatile("s_waitcnt lgkmcnt(" #n ")" ::: "memory")
#define G8_BAR __builtin_amdgcn_s_barrier()
#define G8_SCHED __builtin_amdgcn_sched_barrier(0)
  const int wid = tid >> 6, lane = tid & 63, wr = wid >> 2, wc = wid & 3, fr = lane & 15, fq = lane >> 4;
  f32x4 acc[2][2][4][2];
#pragma unroll
  for (int a = 0; a < 2; ++a)
#pragma unroll
    for (int b = 0; b < 2; ++b)
#pragma unroll
      for (int m = 0; m < 4; ++m)
#pragma unroll
        for (int n = 0; n < 2; ++n) acc[a][b][m][n] = f32x4{0.f, 0.f, 0.f, 0.f};
  bf16x8 At[4][2], B0[2][2], B1[2][2];
  const int nt = K / 64;
  if (first) {
    G8_STAGE(G8_SB(0, 0), Bt, ldb, bcol, 0); G8_STAGE(G8_SA(0, 0), A, lda, brow, 0);
    G8_STAGE(G8_SB(0, 1), Bt, ldb, bcol + 128, 0); G8_STAGE(G8_SA(0, 1), A, lda, brow + 128, 0);
  }
  if (wr == 1) G8_BAR;
  if (first) G8_WAIT_V(4); else G8_WAIT_V(0);
  G8_BAR;
  G8_STAGE(G8_SB(1, 0), Bt, ldb, bcol, 1); G8_STAGE(G8_SA(1, 0), A, lda, brow, 1); G8_STAGE(G8_SB(1, 1), Bt, ldb, bcol + 128, 1);
  G8_WAIT_V(6); G8_BAR;
  for (int t = 0; t < nt - 2; t += 2) {
    G8_LDB(B0, 0, 0); G8_SCHED; G8_LDA(At, 0, 0); G8_STAGE(G8_SA(1, 1), A, lda, brow + 128, t + 1);
    G8_WAIT_L(8); G8_BAR; G8_WAIT_L(0); G8_MMA(0, 0, At, B0); G8_BAR; G8_SCHED;
    G8_LDB(B1, 0, 1); G8_STAGE(G8_SB(0, 0), Bt, ldb, bcol, t + 2);
    G8_BAR; G8_WAIT_L(0); G8_MMA(0, 1, At, B1); G8_BAR;
    G8_LDA(At, 0, 1); G8_STAGE(G8_SA(0, 0), A, lda, brow, t + 2);
    G8_BAR; G8_WAIT_L(0); G8_MMA(1, 0, At, B0); G8_BAR; G8_SCHED;
    G8_STAGE(G8_SB(0, 1), Bt, ldb, bcol + 128, t + 2);
    G8_WAIT_V(6); G8_BAR; G8_MMA(1, 1, At, B1); G8_BAR;
    G8_LDB(B0, 1, 0); G8_SCHED; G8_LDA(At, 1, 0); G8_STAGE(G8_SA(0, 1), A, lda, brow + 128, t + 2);
    G8_WAIT_L(8); G8_BAR; G8_WAIT_L(0); G8_MMA(0, 0, At, B0); G8_BAR; G8_SCHED;
    G8_LDB(B1, 1, 1); G8_STAGE(G8_SB(1, 0), Bt, ldb, bcol, t + 3);
    G8_BAR; G8_WAIT_L(0); G8_MMA(0, 1, At, B1); G8_BAR;
    G8_LDA(At, 1, 1); G8_STAGE(G8_SA(1, 0), A, lda, brow, t + 3);
    G8_BAR; G8_WAIT_L(0); G8_MMA(1, 0, At, B0); G8_BAR; G8_SCHED;
    G8_STAGE(G8_SB(1, 1), Bt, ldb, bcol + 128, t + 3);
    G8_WAIT_V(6); G8_BAR; G8_MMA(1, 1, At, B1); G8_BAR;
  }
  { G8_LDB(B0, 0, 0); G8_LDA(At, 0, 0); G8_STAGE(G8_SA(1, 1), A, lda, brow + 128, nt - 1);
    G8_BAR; G8_WAIT_L(0); G8_MMA(0, 0, At, B0); G8_BAR;
    G8_LDB(B1, 0, 1); G8_BAR; G8_WAIT_L(0); G8_MMA(0, 1, At, B1); G8_BAR;
    G8_LDA(At, 0, 1); G8_WAIT_V(4); G8_BAR; G8_WAIT_L(0); G8_MMA(1, 0, At, B0); G8_MMA(1, 1, At, B1); G8_BAR; }
  { G8_LDB(B0, 1, 0); G8_LDA(At, 1, 0); G8_WAIT_V(2); G8_BAR; G8_WAIT_L(0); G8_MMA(0, 0, At, B0); G8_BAR;
    G8_LDB(B1, 1, 1); G8_WAIT_V(0); G8_BAR; G8_WAIT_L(0); G8_MMA(0, 1, At, B1); G8_BAR;
    G8_LDA(At, 1, 1); G8_BAR; G8_WAIT_L(0); G8_MMA(1, 0, At, B0); G8_MMA(1, 1, At, B1); G8_BAR; }
  if (has_next) {
    G8_STAGE(G8_SB(0, 0), Bt, ldb, nbcol, 0); G8_STAGE(G8_SA(0, 0), A, lda, nbrow, 0);
    G8_STAGE(G8_SB(0, 1), Bt, ldb, nbcol + 128, 0); G8_STAGE(G8_SA(0, 1), A, lda, nbrow + 128, 0);
  }
  if (wr == 0) G8_BAR;
  const bool odd = fq & 1;
#pragma unroll
  for (int ai = 0; ai < 2; ++ai)
#pragma unroll
    for (int bj = 0; bj < 2; ++bj)
#pragma unroll
      for (int m = 0; m < 4; ++m) {
        const int row = brow + ai * 128 + wr * 64 + m * 16 + fr, cb = bcol + bj * 128 + wc * 32;
        epi.side(row, cb + fq * 4, acc[ai][bj][m][0]);
        epi.side(row, cb + 16 + fq * 4, acc[ai][bj][m][1]);
        const u32x2 p0 = epi.pack(acc[ai][bj][m][0]), p1 = epi.pack(acc[ai][bj][m][1]);
        const u32x2 snd = odd ? p0 : p1;
        u32x2 rcv; rcv[0] = (unsigned)__shfl_xor((int)snd[0], 16); rcv[1] = (unsigned)__shfl_xor((int)snd[1], 16);
        u32x4 o;
        if (odd) { o[0] = rcv[0]; o[1] = rcv[1]; o[2] = p1[0]; o[3] = p1[1]; }
        else     { o[0] = p0[0]; o[1] = p0[1]; o[2] = rcv[0]; o[3] = rcv[1]; }
        epi.store16(row, odd ? cb + 16 + (fq - 1) * 4 : cb + fq * 4, o);
      }
  __syncthreads();
}

struct EpiBF {
  bf16_t* out; int ldo;
  DI void side(int, int, const f32x4&) const {}
  DI u32x2 pack(const f32x4& a) const { u32x2 o; o[0] = pack2(a[0], a[1]); o[1] = pack2(a[2], a[3]); return o; }
  DI void store16(int row, int col, const u32x4& v) const { *(u32x4*)(out + (size_t)row * ldo + col) = v; }
  DI float scale(int) const { return 1.f; }
  DI void operator()(int row, int col, const f32x4& a, float) const { (*this)(row, col, a); }
  DI void operator()(int row, int col, const f32x4& a) const {
    u32x2 o; o[0] = pack2(a[0], a[1]); o[1] = pack2(a[2], a[3]);
    *(u32x2*)(out + (size_t)row * ldo + col) = o;
  }
};
struct EpiRelu2 {
  bf16_t* out; int ldo;
  DI void side(int, int, const f32x4&) const {}
  DI u32x2 pack(const f32x4& a) const {
    float r0 = fmaxf(a[0], 0.f), r1 = fmaxf(a[1], 0.f), r2 = fmaxf(a[2], 0.f), r3 = fmaxf(a[3], 0.f);
    u32x2 o; o[0] = pack2(r0 * r0, r1 * r1); o[1] = pack2(r2 * r2, r3 * r3); return o;
  }
  DI void store16(int row, int col, const u32x4& v) const { *(u32x4*)(out + (size_t)row * ldo + col) = v; }
  DI void operator()(int row, int col, const f32x4& a) const {
    float r0 = fmaxf(a[0], 0.f), r1 = fmaxf(a[1], 0.f), r2 = fmaxf(a[2], 0.f), r3 = fmaxf(a[3], 0.f);
    u32x2 o; o[0] = pack2(r0 * r0, r1 * r1); o[1] = pack2(r2 * r2, r3 * r3);
    *(u32x2*)(out + (size_t)row * ldo + col) = o;
  }
};
struct EpiU {
  bf16_t* u; float* dt;
  DI void side(int row, int col, const f32x4& a) const { if (col >= U_DT && col < DIN) *(float4*)(dt + (size_t)row * 16 + col - U_DT) = make_float4(a[0], a[1], a[2], a[3]); }
  DI u32x2 pack(const f32x4& a) const { u32x2 o; o[0] = pack2(a[0], a[1]); o[1] = pack2(a[2], a[3]); return o; }
  DI void store16(int row, int col, const u32x4& v) const { if (col < DIN) *(u32x4*)(u + (size_t)row * DIN + col) = v; }
  DI void operator()(int row, int col, const f32x4& a) const {
    if (col < DIN) {
      u32x2 o; o[0] = pack2(a[0], a[1]); o[1] = pack2(a[2], a[3]);
      *(u32x2*)(u + (size_t)row * DIN + col) = o;
      if (col >= U_DT) *(float4*)(dt + (size_t)row * 16 + col - U_DT) = make_float4(a[0], a[1], a[2], a[3]);
    }
  }
};
struct EpiQ {
  bf16_t* q; const float* rs;
  DI float scale(int row) const { return rs[row * 2]; }
  DI void operator()(int row, int col, const f32x4& a, float r) const {
    u32x2 o; o[0] = pack2(a[0] * r, a[1] * r); o[1] = pack2(a[2] * r, a[3] * r);
    *(u32x2*)(q + (size_t)row * 384 + col) = o;
  }
};
struct EpiKV {
  bf16_t* kb; bf16_t* vt; const float* rs;
  DI float scale(int row) const { return rs[row * 2 + 1]; }
  DI void operator()(int row, int col, const f32x4& a, float r) const {
    int b, pos;
    if (row < ML) { b = row >> 12; pos = (row & 4095) + CTX; } else { int rr = row - ML; b = rr >> 8; pos = rr & 255; }
    const int head = col >> 7, d = col & 127;
    if (d < 64) {
      u32x2 o; o[0] = pack2(a[0] * r, a[1] * r); o[1] = pack2(a[2] * r, a[3] * r);
      *(u32x2*)(kb + ((size_t)(b * 4 + head) * LK + pos) * 96 + d) = o;
    } else {
#pragma unroll
      for (int j = 0; j < 4; ++j) vt[((size_t)(b * 4 + head) * 64 + (d - 64 + j)) * LK + pos] = f2bf(a[j] * r);
    }
  }
};

struct EpiPart {
  float* part;
  DI void operator()(int row, int col, const f32x4& a) const {
    *(float4*)(part + (size_t)(row - ML) * DM + col) = make_float4(a[0], a[1], a[2], a[3]);
  }
};
DI void phase_inproj(const Params& p, int layer, int bid, int nb, char* smem) {
  EpiU epi{(bf16_t*)(p.ws + OFF_U), (float*)(p.ws + OFF_DT)};
  const int x = bid & 7, per = nb >> 3;
  for (int rep = 0; rep < REP_GEMM; ++rep)
  for (int q = bid >> 3; q < 85; q += per) {
    const int m = (x >> 1) * 17 + q / 5, n = 5 * (x & 1) + q % 5;
    const int q2 = q + per, m2 = (x >> 1) * 17 + q2 / 5, n2 = 5 * (x & 1) + q2 % 5;
    gemm8_tile((const bf16_t*)(p.ws + OFF_H), DM, wt_ptr(p, layer, WT_IN), 1024, 1024, m * 256, n * 256, smem, epi,
               q == (bid >> 3), q2 < 85, m2 * 256, n2 * 256);
  }
}
DI void phase_wout(const Params& p, int layer, int lid, int nvb, char* smem) {
  const int M = layer == 0 ? MT : ML;
  EpiBF epi{(bf16_t*)(p.ws + OFF_U), DM};
  const int x = lid & 7, per = nvb >> 3;
  for (int rep = 0; rep < REP_GEMM; ++rep)
  for (int q = lid >> 3; q < M / 128; q += per)
    gemm_tile<true>((const bf16_t*)(p.ws + OFF_H), DM, wt_ptr(p, layer, WT_OUT), 1024, ((q >> 3) * 8 + x) * 128, (q & 7) * 128, smem, epi, (const float*)(p.ws + OFF_SSQ));
}
DI void phase_ff1(const Params& p, int layer, int bid, int nb, int vbid, int nvb, char* smem, char* smem_half) {
  EpiRelu2 epi{(bf16_t*)(p.ws + OFF_F1), DFF};
  const int x = bid & 7, per = nb >> 3;
  for (int rep = 0; rep < REP_GEMM; ++rep) {
    for (int q = bid >> 3; q < 128; q += per) {
      const int m = (x >> 2) * 32 + (q >> 2), n = 4 * (x & 3) + (q & 3);
      const int q2 = q + per, m2 = (x >> 2) * 32 + (q2 >> 2), n2 = 4 * (x & 3) + (q2 & 3);
      gemm8_tile((const bf16_t*)(p.ws + OFF_H), DM, wt_ptr(p, layer, WT_FF1), 1024, 1024, m * 256, n * 256, smem, epi,
                 q == (bid >> 3), q2 < 128, m2 * 256, n2 * 256);
    }
    if (layer == 0)
      for (int it = vbid; it < (MC / 128) * 32; it += nvb)
        gemm_tile_glds((const bf16_t*)(p.ws + OFF_H), DM, wt_ptr(p, layer, WT_FF1), 1024, 1024, ML + (it / 32) * 128, (it % 32) * 128, smem_half, epi);
  }
}
DI void phase_ff2(const Params& p, int layer, int bid, int nb, int vbid, int nvb, char* smem, char* smem_half) {
  EpiBF epi{(bf16_t*)(p.ws + OFF_H), DM};
  const int x = bid & 7, per = nb >> 3;
  for (int rep = 0; rep < REP_GEMM; ++rep) {
    for (int q = bid >> 3; q < 32; q += per) {
      const int T = x * 32 + q;
      gemm8_tile((const bf16_t*)(p.ws + OFF_F1), DFF, wt_ptr(p, layer, WT_FF2), 4096, 4096, (T >> 2) * 256, (T & 3) * 256, smem, epi);
    }
    if (layer == 0)
      for (int it = vbid; it < (MC / 128) * 8 * 4; it += nvb) {
        const int tile = it >> 2, ks = it & 3;
        EpiPart ep{(float*)(p.ws + OFF_END2) + (size_t)ks * MC * DM};
        gemm_tile_glds((const bf16_t*)(p.ws + OFF_F1) + ks * 1024, DFF, wt_ptr(p, layer, WT_FF2) + ks * 1024, 4096, 1024, ML + (tile >> 3) * 128, (tile & 7) * 128, smem_half, ep);
      }
  }
}

DI int chunk_row0(int b, int tc) { return tc < 2 ? ML + b * CTX + tc * 128 : b * SEQ + (tc - 2) * 128; }
constexpr int BST = 72;
constexpr int TST = 136;
DI void load_tile_T(bf16_t* dst, const bf16_t* __restrict__ src, int ldg) {
  const int tid = ltid();
#pragma unroll
  for (int i = 0; i < 4; ++i) {
    int c = tid + 256 * i, tok = c & 127, pc = c >> 7;
    u32x4 v = *(const u32x4*)(src + (size_t)tok * ldg + pc * 8);
#pragma unroll
    for (int j = 0; j < 4; ++j) {
      dst[(pc * 8 + 2 * j) * TST + tok] = (bf16_t)(v[j] & 0xffffu);
      dst[(pc * 8 + 2 * j + 1) * TST + tok] = (bf16_t)(v[j] >> 16);
    }
  }
}
DI void chunk_scan(const Params& p, int layer, int row0, int h, float* csf, float* csb, float* dtF, float* dtB, float* tot, float*  ) {
  const int tid = ltid(), w = tid >> 6, lane = tid & 63;
  const float* DT = (const float*)(p.ws + OFF_DT);
  float v;
  if (tid < 128) {
    const float dt = DT[(size_t)(row0 + tid) * 16 + h];
    v = dt * -__expf(p.a_log[layer * 16 + h]);
    dtF[tid] = dt;
  } else {
    const int e = 255 - tid;
    const float dt = DT[(size_t)(row0 + e) * 16 + 8 + h];
    v = dt * -__expf(p.a_log[layer * 16 + 8 + h]);
    dtB[e] = dt;
  }
#pragma unroll
  for (int o = 1; o < 64; o <<= 1) { const float t = __shfl_up(v, o); if (lane >= o) v += t; }
  if (lane == 63) tot[w] = v;
  __syncthreads();
  if (w == 1) v += tot[0];
  if (w == 3) v += tot[2];
  if (tid < 128) csf[tid] = v; else csb[255 - tid] = v;
  __syncthreads();
}

DI void ssd_state_item(const Params& p, int layer, int b, int tc, int h, char* smem) {
  bf16_t* XT = (bf16_t*)smem;
  bf16_t* BT = XT + 64 * TST;
  float* csf = (float*)(BT + 64 * TST);
  float* csb = csf + 128; float* dtF = csb + 128; float* dtB = dtF + 128; float* laF = dtB + 128; float* laB = laF + 128;
  const int tid = ltid(), w = tid >> 6, lane = tid & 63, r = lane & 31, hh = lane >> 5;
  const int row0 = chunk_row0(b, tc);
  const bf16_t* XBC = (const bf16_t*)(p.ws + OFF_XBC);
  load_tile_T(XT, XBC + (size_t)row0 * 768 + h * 64, 768);
  load_tile_T(BT, XBC + (size_t)row0 * 768 + 512 + (h >> 2) * 64, 768);
  chunk_scan(p, layer, row0, h, csf, csb, dtF, dtB, laF, laB);
  __syncthreads();
  if (tid < 128) laF[tid] = dtF[tid] * __expf(csf[127] - csf[tid]);
  else { int t = tid - 128; laB[t] = dtB[t] * __expf(csb[0] - csb[t]); }
  __syncthreads();
  const int d = w >> 1, pt = w & 1;
  const float* wv = d == 0 ? laF : laB;
  f32x16 acc[2];
#pragma unroll
  for (int i = 0; i < 16; ++i) { acc[0][i] = 0.f; acc[1][i] = 0.f; }
#pragma unroll
  for (int s = 0; s < 8; ++s) {
    int l0 = 16 * s + 8 * hh;
    u32x4 xa = *(const u32x4*)(XT + (32 * pt + r) * TST + l0);
    u32x4 sa;
#pragma unroll
    for (int j = 0; j < 4; ++j) sa[j] = pack2(lo2f(xa[j]) * wv[l0 + 2 * j], hi2f(xa[j]) * wv[l0 + 2 * j + 1]);
    bf16x8 af = __builtin_bit_cast(bf16x8, sa);
#pragma unroll
    for (int nt = 0; nt < 2; ++nt) {
      bf16x8 bfr = *(const bf16x8*)(BT + (32 * nt + r) * TST + l0);
      acc[nt] = MFMA32(af, bfr, acc[nt]);
    }
  }
  bf16_t* S = (bf16_t*)(p.ws + OFF_SST) + ((((size_t)d * NB + b) * NCH + tc) * 8 + h) * 4096;
#pragma unroll
  for (int nt = 0; nt < 2; ++nt)
#pragma unroll
    for (int i = 0; i < 16; ++i) S[(32 * pt + crow(i, hh)) * 64 + 32 * nt + r] = f2bf(acc[nt][i]);
  if (tid == 0) {
    float* TD = (float*)(p.ws + OFF_TDEC);
    TD[((0 * NB + b) * NCH + tc) * 8 + h] = __expf(csf[127]);
    TD[((1 * NB + b) * NCH + tc) * 8 + h] = __expf(csb[0]);
  }
  __syncthreads();
}

DI void ssd_pass_item(const Params& p, int it) {
  const int e = it * 256 + ltid();
  const int pn2 = e & 2047, h = (e >> 11) & 7, b = (e >> 14) & 3, d = e >> 16;
  unsigned* S = (unsigned*)(p.ws + OFF_SST);
  const float* TD = (const float*)(p.ws + OFF_TDEC);
  unsigned sv[NCH]; float T[NCH];
#pragma unroll
  for (int i = 0; i < NCH; ++i) {
    int tc = d == 0 ? i : (i < 2 ? 1 - i : NCH + 1 - i);
    sv[i] = S[(((size_t)(d * NB + b) * NCH + tc) * 8 + h) * 2048 + pn2];
    T[i] = TD[((d * NB + b) * NCH + tc) * 8 + h];
  }
  float h0 = 0.f, h1 = 0.f;
#pragma unroll
  for (int i = 0; i < NCH; ++i) {
    int tc = d == 0 ? i : (i < 2 ? 1 - i : NCH + 1 - i);
    S[(((size_t)(d * NB + b) * NCH + tc) * 8 + h) * 2048 + pn2] = pack2(h0, h1);
    h0 = T[i] * h0 + lo2f(sv[i]); h1 = T[i] * h1 + hi2f(sv[i]);
  }
}

DI void ssd_out_item(const Params& p, int layer, int b, int tc, int h, char* smem) {
  bf16_t* XT = (bf16_t*)smem;
  bf16_t* Bs = XT + 64 * TST;
  float* csf = (float*)(Bs + 128 * BST);
  float* csb = csf + 128; float* dtF = csb + 128; float* dtB = dtF + 128; float* laF = dtB + 128; float* laB = laF + 128;
  const int tid = ltid(), w = tid >> 6, lane = tid & 63, r = lane & 31, hh = lane >> 5;
  const int row0 = chunk_row0(b, tc), g = h >> 2;
  const bf16_t* XBC = (const bf16_t*)(p.ws + OFF_XBC);
  load_tile_T(XT, XBC + (size_t)row0 * 768 + h * 64, 768);
#pragma unroll
  for (int i = 0; i < 4; ++i) {
    int c = tid + 256 * i, tok = c >> 3, part = c & 7;
    *(u32x4*)(Bs + tok * BST + part * 8) = *(const u32x4*)(XBC + (size_t)(row0 + tok) * 768 + 512 + g * 64 + part * 8);
  }
  const int l = 32 * w + r;
  bf16x8 cf[4];
#pragma unroll
  for (int ks = 0; ks < 4; ++ks) cf[ks] = *(const bf16x8*)(XBC + (size_t)(row0 + l) * 768 + 640 + g * 64 + 16 * ks + 8 * hh);
  chunk_scan(p, layer, row0, h, csf, csb, dtF, dtB, laF, laB);
  const float csf_l = csf[l], csb_l = csb[l];
  f32x16 yacc[2];
#pragma unroll
  for (int i = 0; i < 16; ++i) { yacc[0][i] = 0.f; yacc[1][i] = 0.f; }
#pragma unroll
  for (int st = 0; st < 4; ++st) {
    f32x16 gacc;
#pragma unroll
    for (int i = 0; i < 16; ++i) gacc[i] = 0.f;
#pragma unroll
    for (int ks = 0; ks < 4; ++ks) {
      bf16x8 af = *(const bf16x8*)(Bs + (32 * st + r) * BST + 16 * ks + 8 * hh);
      gacc = MFMA32(af, cf[ks], gacc);
    }
#pragma unroll
    for (int i = 0; i < 16; ++i) {
      int s = 32 * st + crow(i, hh);
      float f;
      if (s < l) f = __expf(csf_l - csf[s]) * dtF[s];
      else if (s > l) f = __expf(csb_l - csb[s]) * dtB[s];
      else f = dtF[s] + dtB[s];
      gacc[i] *= f;
    }
#pragma unroll
    for (int s2 = 0; s2 < 2; ++s2) {
      bf16x8 mf = pack8(gacc, s2);
      int sb = 32 * st + 16 * s2 + 4 * hh;
#pragma unroll
      for (int pt = 0; pt < 2; ++pt) {
        u32x2 lo = *(const u32x2*)(XT + (32 * pt + r) * TST + sb);
        u32x2 hi = *(const u32x2*)(XT + (32 * pt + r) * TST + sb + 8);
        u32x4 xa; xa[0] = lo[0]; xa[1] = lo[1]; xa[2] = hi[0]; xa[3] = hi[1];
        yacc[pt] = MFMA32(__builtin_bit_cast(bf16x8, xa), mf, yacc[pt]);
      }
    }
  }
#pragma unroll
  for (int d = 0; d < 2; ++d) {
    const bf16_t* Hs = (const bf16_t*)(p.ws + OFF_SST) + ((((size_t)d * NB + b) * NCH + tc) * 8 + h) * 4096;
    const float e = __expf(d == 0 ? csf_l : csb_l);
#pragma unroll
    for (int pt = 0; pt < 2; ++pt) {
      f32x16 t;
#pragma unroll
      for (int i = 0; i < 16; ++i) t[i] = 0.f;
#pragma unroll
      for (int ks = 0; ks < 4; ++ks) {
        bf16x8 af = *(const bf16x8*)(Hs + (32 * pt + r) * 64 + 16 * ks + 8 * hh);
        t = MFMA32(af, cf[ks], t);
      }
#pragma unroll
      for (int i = 0; i < 16; ++i) yacc[pt][i] += e * t[i];
    }
  }
  const int row = row0 + l;
  const float Dh = p.ssd_d[layer * 8 + h];
  const bf16_t* U = (const bf16_t*)(p.ws + OFF_U);
  bf16_t* YM = (bf16_t*)(p.ws + OFF_H);
  float ssq = 0.f;
  u32x2 xvv[2][4], zvv[2][4];
#pragma unroll
  for (int pt = 0; pt < 2; ++pt)
#pragma unroll
    for (int q = 0; q < 4; ++q) {
      const int pp = 32 * pt + 8 * q + 4 * hh;
      xvv[pt][q] = *(const u32x2*)(XBC + (size_t)row * 768 + h * 64 + pp);
      zvv[pt][q] = *(const u32x2*)(U + (size_t)row * DIN + U_Z + h * 64 + pp);
    }
#pragma unroll
  for (int pt = 0; pt < 2; ++pt)
#pragma unroll
    for (int q = 0; q < 4; ++q) {
      const int pp = 32 * pt + 8 * q + 4 * hh;
      const u32x2 xv = xvv[pt][q], zv = zvv[pt][q];
      float y0 = (yacc[pt][4 * q + 0] + Dh * lo2f(xv[0])) * silu_f(lo2f(zv[0]));
      float y1 = (yacc[pt][4 * q + 1] + Dh * hi2f(xv[0])) * silu_f(hi2f(zv[0]));
      float y2 = (yacc[pt][4 * q + 2] + Dh * lo2f(xv[1])) * silu_f(lo2f(zv[1]));
      float y3 = (yacc[pt][4 * q + 3] + Dh * hi2f(xv[1])) * silu_f(hi2f(zv[1]));
      u32x2 o; o[0] = pack2(y0, y1); o[1] = pack2(y2, y3);
      float r0 = lo2f(o[0]), r1 = hi2f(o[0]), r2 = lo2f(o[1]), r3 = hi2f(o[1]);
      ssq += r0 * r0 + r1 * r1 + r2 * r2 + r3 * r3;
      *(u32x2*)(YM + (size_t)row * DM + 512 + h * 64 + pp) = o;
    }
  ssq += __shfl_xor(ssq, 32);
  if (hh == 0) ((float*)(p.ws + OFF_SSQ))[(size_t)row * 8 + h] = ssq;
  __syncthreads();
}

constexpr int KST = 104;
constexpr int VST = 68;
constexpr int ASTG = 64 * KST + 64 * VST;
DI void attn_item(const Params& p, int b, int head, int qrow0, int t0, bool lat, int nkeys, char* smem) {
  bf16_t* Ks = (bf16_t*)smem;
  bf16_t* Vs = Ks + 64 * KST;
  const int tid = ltid(), w = tid >> 6, lane = tid & 63, r = lane & 31, hh = lane >> 5;
  const bf16_t* QB = (const bf16_t*)(p.ws + OFF_QB);
  const bf16_t* KB = (const bf16_t*)(p.ws + OFF_KB) + (size_t)(b * 4 + head) * LK * 96;
  const bf16_t* VT = (const bf16_t*)(p.ws + OFF_VT) + (size_t)(b * 4 + head) * 64 * LK;
  const float qscale = 0.10206207261596575f * 1.4426950408889634f;
  const int qrow = qrow0 + w * 32 + r;
  const int t = t0 + w * 32 + r;
  bf16x8 qf[6];
  {
    const bf16_t* src = QB + (size_t)qrow * 384 + head * 96;
#pragma unroll
    for (int s = 0; s < 4; ++s) {
      u32x4 v = *(const u32x4*)(src + 16 * s + 8 * hh);
      u32x4 o;
#pragma unroll
      for (int j = 0; j < 4; ++j) o[j] = pack2(lo2f(v[j]) * qscale, hi2f(v[j]) * qscale);
      qf[s] = __builtin_bit_cast(bf16x8, o);
    }
#pragma unroll
    for (int s = 4; s < 6; ++s) {
      u32x4 va = *(const u32x4*)(src + 16 * s), vb = *(const u32x4*)(src + 16 * s + 8);
      float posf = s == 4 ? (float)(t >> 6) : (float)(t & 63);
      float o[8];
#pragma unroll
      for (int j = 0; j < 8; ++j) {
        float a = (j & 1) ? hi2f(va[j >> 1]) : lo2f(va[j >> 1]);
        float bb = (j & 1) ? hi2f(vb[j >> 1]) : lo2f(vb[j >> 1]);
        float res;
        if (lat) {
          float invf = exp2f(-(float)(2 * j) * (13.287712379549449f / 16.f));
          float rev = posf * invf * 0.15915494309189535f;
          float cs = __builtin_amdgcn_cosf(rev), sn = __builtin_amdgcn_sinf(rev);
          res = hh == 0 ? a * cs - bb * sn : bb * cs + a * sn;
        } else res = hh == 0 ? a : bb;
        o[j] = res * qscale;
      }
      u32x4 ov; ov[0] = pack2(o[0], o[1]); ov[1] = pack2(o[2], o[3]); ov[2] = pack2(o[4], o[5]); ov[3] = pack2(o[6], o[7]);
      qf[s] = __builtin_bit_cast(bf16x8, ov);
    }
  }
  f32x16 oacc[2];
#pragma unroll
  for (int i = 0; i < 16; ++i) { oacc[0][i] = 0.f; oacc[1][i] = 0.f; }
  float m = -1e30f, lsum = 0.f;
  u32x4 rk[3], rv[2];
  auto gload = [&](int key0) {
#pragma unroll
    for (int i = 0; i < 3; ++i) rk[i] = *(const u32x4*)(KB + (size_t)key0 * 96 + (tid + 256 * i) * 8);
#pragma unroll
    for (int i = 0; i < 2; ++i) { int c = tid + 256 * i; rv[i] = *(const u32x4*)(VT + (size_t)(c >> 3) * LK + key0 + (c & 7) * 8); }
  };
  gload(0);
  const int NT = nkeys / 64;
  for (int kt = 0; kt < NT; ++kt) {
#pragma unroll
    for (int i = 0; i < 3; ++i) { int c = tid + 256 * i; *(u32x4*)(Ks + (c / 12) * KST + (c % 12) * 8) = rk[i]; }
#pragma unroll
    for (int i = 0; i < 2; ++i) {
      int c = tid + 256 * i;
      bf16_t* d = Vs + (c >> 3) * VST + (c & 7) * 8;
      u32x2 a; a[0] = rv[i][0]; a[1] = rv[i][1];
      u32x2 bq; bq[0] = rv[i][2]; bq[1] = rv[i][3];
      *(u32x2*)d = a; *(u32x2*)(d + 4) = bq;
    }
    __syncthreads();
    if (kt + 1 < NT) gload((kt + 1) * 64);
    f32x16 sacc[2];
#pragma unroll
    for (int i = 0; i < 16; ++i) { sacc[0][i] = 0.f; sacc[1][i] = 0.f; }
#pragma unroll
    for (int s = 0; s < 6; ++s)
#pragma unroll
      for (int k2 = 0; k2 < 2; ++k2) {
        bf16x8 af = *(const bf16x8*)(Ks + (32 * k2 + r) * KST + 16 * s + 8 * hh);
        sacc[k2] = MFMA32(af, qf[s], sacc[k2]);
      }
    float mx = sacc[0][0];
#pragma unroll
    for (int i = 0; i < 16; ++i) { mx = fmaxf(mx, sacc[0][i]); mx = fmaxf(mx, sacc[1][i]); }
    mx = fmaxf(mx, __shfl_xor(mx, 32));
    const float mn = fmaxf(m, mx);
    const float alpha = __builtin_amdgcn_exp2f(m - mn);
    m = mn;
    float ps = 0.f;
#pragma unroll
    for (int i = 0; i < 16; ++i) {
      sacc[0][i] = __builtin_amdgcn_exp2f(sacc[0][i] - mn); sacc[1][i] = __builtin_amdgcn_exp2f(sacc[1][i] - mn);
      ps += sacc[0][i] + sacc[1][i];
    }
    lsum = lsum * alpha + ps;
#pragma unroll
    for (int i = 0; i < 16; ++i) { oacc[0][i] *= alpha; oacc[1][i] *= alpha; }
#pragma unroll
    for (int k2 = 0; k2 < 2; ++k2)
#pragma unroll
      for (int s2 = 0; s2 < 2; ++s2) {
        bf16x8 pf = pack8(sacc[k2], s2);
        int kb0 = 32 * k2 + 16 * s2 + 4 * hh;
#pragma unroll
        for (int d = 0; d < 2; ++d) {
          u32x2 lo = *(const u32x2*)(Vs + (32 * d + r) * VST + kb0);
          u32x2 hi = *(const u32x2*)(Vs + (32 * d + r) * VST + kb0 + 8);
          u32x4 va; va[0] = lo[0]; va[1] = lo[1]; va[2] = hi[0]; va[3] = hi[1];
          oacc[d] = MFMA32(__builtin_bit_cast(bf16x8, va), pf, oacc[d]);
        }
      }
    __syncthreads();
  }
  lsum += __shfl_xor(lsum, 32);
  const float inv = 1.f / lsum;
  bf16_t* YM = (bf16_t*)(p.ws + OFF_H) + (size_t)qrow * DM + head * 64;
#pragma unroll
  for (int d = 0; d < 2; ++d)
#pragma unroll
    for (int q = 0; q < 4; ++q) {
      u32x2 o; o[0] = pack2(oacc[d][4 * q] * inv, oacc[d][4 * q + 1] * inv); o[1] = pack2(oacc[d][4 * q + 2] * inv, oacc[d][4 * q + 3] * inv);
      *(u32x2*)(YM + 32 * d + 8 * q + 4 * hh) = o;
    }
}

DI void attn_item8(const Params& p, int b, int head, int qrow0, int t0, bool lat, int nkeys, char* smem) {
  bf16_t* Ks = (bf16_t*)smem;
  bf16_t* Vs = Ks + 64 * KST;
  const int tid = ltid512(), w = tid >> 6, lane = tid & 63, r = lane & 31, hh = lane >> 5;
  const bf16_t* QB = (const bf16_t*)(p.ws + OFF_QB);
  const bf16_t* KB = (const bf16_t*)(p.ws + OFF_KB) + (size_t)(b * 4 + head) * LK * 96;
  const bf16_t* VT = (const bf16_t*)(p.ws + OFF_VT) + (size_t)(b * 4 + head) * 64 * LK;
  const float qscale = 0.10206207261596575f * 1.4426950408889634f;
  const int qrow = qrow0 + w * 32 + r;
  const int t = t0 + w * 32 + r;
  bf16x8 qf[6];
  {
    const bf16_t* src = QB + (size_t)qrow * 384 + head * 96;
#pragma unroll
    for (int s = 0; s < 4; ++s) {
      u32x4 v = *(const u32x4*)(src + 16 * s + 8 * hh);
      u32x4 o;
#pragma unroll
      for (int j = 0; j < 4; ++j) o[j] = pack2(lo2f(v[j]) * qscale, hi2f(v[j]) * qscale);
      qf[s] = __builtin_bit_cast(bf16x8, o);
    }
#pragma unroll
    for (int s = 4; s < 6; ++s) {
      u32x4 va = *(const u32x4*)(src + 16 * s), vb = *(const u32x4*)(src + 16 * s + 8);
      float posf = s == 4 ? (float)(t >> 6) : (float)(t & 63);
      float o[8];
#pragma unroll
      for (int j = 0; j < 8; ++j) {
        float a = (j & 1) ? hi2f(va[j >> 1]) : lo2f(va[j >> 1]);
        float bb = (j & 1) ? hi2f(vb[j >> 1]) : lo2f(vb[j >> 1]);
        float res;
        if (lat) {
          float invf = exp2f(-(float)(2 * j) * (13.287712379549449f / 16.f));
          float rev = posf * invf * 0.15915494309189535f;
          float cs = __builtin_amdgcn_cosf(rev), sn = __builtin_amdgcn_sinf(rev);
          res = hh == 0 ? a * cs - bb * sn : bb * cs + a * sn;
        } else res = hh == 0 ? a : bb;
        o[j] = res * qscale;
      }
      u32x4 ov; ov[0] = pack2(o[0], o[1]); ov[1] = pack2(o[2], o[3]); ov[2] = pack2(o[4], o[5]); ov[3] = pack2(o[6], o[7]);
      qf[s] = __builtin_bit_cast(bf16x8, ov);
    }
  }
  f32x16 oacc[2];
#pragma unroll
  for (int i = 0; i < 16; ++i) { oacc[0][i] = 0.f; oacc[1][i] = 0.f; }
  float m = -1e30f, lsum = 0.f;
  u32x4 rk[2], rv;
  auto gload = [&](int key0) {
    rk[0] = *(const u32x4*)(KB + (size_t)key0 * 96 + tid * 8);
    if (tid < 256) rk[1] = *(const u32x4*)(KB + (size_t)key0 * 96 + (512 + tid) * 8);
    rv = *(const u32x4*)(VT + (size_t)(tid >> 3) * LK + key0 + (tid & 7) * 8);
  };
  const int kro = (tid / 12) * KST + (tid % 12) * 8, kro2 = ((512 + tid) / 12) * KST + ((512 + tid) % 12) * 8;
  auto swrite = [&](int stage) {
    bf16_t* Kd = Ks + stage * ASTG;
    *(u32x4*)(Kd + kro) = rk[0];
    if (tid < 256) *(u32x4*)(Kd + kro2) = rk[1];
    bf16_t* d = Kd + 64 * KST + (tid >> 3) * VST + (tid & 7) * 8;
    u32x2 a; a[0] = rv[0]; a[1] = rv[1];
    u32x2 bq; bq[0] = rv[2]; bq[1] = rv[3];
    *(u32x2*)d = a; *(u32x2*)(d + 4) = bq;
  };
  auto qk = [&](int stage, f32x16 (&sa)[2]) {
    const bf16_t* Kc = Ks + stage * ASTG;
#pragma unroll
    for (int i = 0; i < 16; ++i) { sa[0][i] = 0.f; sa[1][i] = 0.f; }
#pragma unroll
    for (int s = 0; s < 6; ++s)
#pragma unroll
      for (int k2 = 0; k2 < 2; ++k2) {
        bf16x8 af = *(const bf16x8*)(Kc + (32 * k2 + r) * KST + 16 * s + 8 * hh);
        sa[k2] = MFMA32(af, qf[s], sa[k2]);
      }
  };
  const int NT = nkeys / 64;
  f32x16 sacc[2], snext[2];
  gload(0); swrite(0);
  gload(64);
  __syncthreads();
  swrite(1);
  gload(128);
  qk(0, sacc);
  __syncthreads();
  int cur = 0, nxt = 1, nn = 2;
  for (int kt = 0; kt < NT; ++kt) {
    if (kt + 1 < NT) qk(nxt, snext);
    if (kt + 2 < NT) {
      swrite(nn);
      if (kt + 3 < NT) gload((kt + 3) * 64);
    }
    const bf16_t* Vc = Ks + cur * ASTG + 64 * KST;
    float mx = sacc[0][0];
#pragma unroll
    for (int i = 0; i < 16; ++i) { mx = fmaxf(mx, sacc[0][i]); mx = fmaxf(mx, sacc[1][i]); }
    mx = fmaxf(mx, __shfl_xor(mx, 32));
    const float mn = fmaxf(m, mx);
    const float alpha = __builtin_amdgcn_exp2f(m - mn);
    m = mn;
    float ps = 0.f;
#pragma unroll
    for (int i = 0; i < 16; ++i) {
      sacc[0][i] = __builtin_amdgcn_exp2f(sacc[0][i] - mn); sacc[1][i] = __builtin_amdgcn_exp2f(sacc[1][i] - mn);
      ps += sacc[0][i] + sacc[1][i];
    }
    lsum = lsum * alpha + ps;
#pragma unroll
    for (int i = 0; i < 16; ++i) { oacc[0][i] *= alpha; oacc[1][i] *= alpha; }
#pragma unroll
    for (int k2 = 0; k2 < 2; ++k2)
#pragma unroll
      for (int s2 = 0; s2 < 2; ++s2) {
        bf16x8 pf = pack8(sacc[k2], s2);
        int kb0 = 32 * k2 + 16 * s2 + 4 * hh;
#pragma unroll
        for (int d = 0; d < 2; ++d) {
          u32x2 lo = *(const u32x2*)(Vc + (32 * d + r) * VST + kb0);
          u32x2 hi = *(const u32x2*)(Vc + (32 * d + r) * VST + kb0 + 8);
          u32x4 va; va[0] = lo[0]; va[1] = lo[1]; va[2] = hi[0]; va[3] = hi[1];
          oacc[d] = MFMA32(__builtin_bit_cast(bf16x8, va), pf, oacc[d]);
        }
      }
    sacc[0] = snext[0]; sacc[1] = snext[1];
    const int t3 = cur; cur = nxt; nxt = nn; nn = t3;
    __syncthreads();
  }
  lsum += __shfl_xor(lsum, 32);
  const float inv = 1.f / lsum;
  bf16_t* YM = (bf16_t*)(p.ws + OFF_H) + (size_t)qrow * DM + head * 64;
#pragma unroll
  for (int d = 0; d < 2; ++d)
#pragma unroll
    for (int q = 0; q < 4; ++q) {
      u32x2 o; o[0] = pack2(oacc[d][4 * q] * inv, oacc[d][4 * q + 1] * inv); o[1] = pack2(oacc[d][4 * q + 2] * inv, oacc[d][4 * q + 3] * inv);
      *(u32x2*)(YM + 32 * d + 8 * q + 4 * hh) = o;
    }
}

DI void phase_qkv(const Params& p, int layer, int bid, int nb, char* smem) {
  const int MQ = layer == 0 ? MT : ML;
  const int nq = (MQ / 128) * 3, nkv = (MT / 128) * 4, nst = NB * NCH * 8;
  const float* RS = (const float*)(p.ws + OFF_RSTD);
  EpiQ eq{(bf16_t*)(p.ws + OFF_QB), RS};
  EpiKV ekv{(bf16_t*)(p.ws + OFF_KB), (bf16_t*)(p.ws + OFF_VT), RS};
  const bf16_t* U = (const bf16_t*)(p.ws + OFF_U);
  for (int it = bid; it < nq + nkv + nst; it += nb) {
    if (it < nq) gemm_tile<false>(U, DIN, wt_ptr(p, layer, WT_UQ), 256, (it / 3) * 128, (it % 3) * 128, smem, eq);
    else if (it < nq + nkv) { int j = it - nq; gemm_tile<false>(U + U_CKV, DIN, wt_ptr(p, layer, WT_UKV), 128, (j / 4) * 128, (j % 4) * 128, smem, ekv); }
    else { int j = it - nq - nkv; for (int rep = 0; rep < REP_SSD; ++rep) ssd_state_item(p, layer, j / (NCH * 8), (j / 8) % NCH, j & 7, smem); }
  }
}
DI void phase_att(const Params& p, int layer, int bid, int nb, int vbid, int nvb, char* smem, char* sh) {
  for (int it = bid; it < 256; it += nb) {
    const int x = it & 7, j = it >> 3, bh = 2 * x + (j >> 4), qb = j & 15, b = bh >> 2, head = bh & 3;
    for (int rep = 0; rep < REP_ATT; ++rep) attn_item8(p, b, head, b * SEQ + qb * 256, qb * 256, true, LK, smem);
  }
  const int nctx = layer == 0 ? 32 : 0, npass = 512;
  for (int it = vbid; it < nctx + npass; it += nvb) {
    if (it < nctx) { int b = it >> 3, head = (it >> 1) & 3, qb = it & 1; attn_item(p, b, head, ML + b * CTX + qb * 128, qb * 128, false, CTX, sh); }
    else ssd_pass_item(p, it - nctx);
  }
}
DI void phase_ssdout(const Params& p, int layer, int bid, int nb, char* smem) {
  for (int it = bid; it < NB * NCH * 8; it += nb) {
    int b = it / (NCH * 8), tc = (it / 8) % NCH, h = it & 7;
    if (layer == 1 && tc < 2) continue;
    for (int rep = 0; rep < REP_SSD; ++rep) ssd_out_item(p, layer, b, tc, h, smem);
  }
}


#define XB_TMO      128
#define XB_XCNT(j)  (256  + 64 * (j))
#define XB_XSUB(j)  (1280 + 64 * (j))
#define XB_XGEN(j)  (2304 + 64 * (j))
#define XB_TOP      3328
#define XB_TOPGEN   3392
#define XCD_BAR_WORDS 3456
#define XB_SPIN_CAP (1u << 22)
#define LAS __attribute__((address_space(3)))
DI unsigned xb_ld(unsigned* p) { return __hip_atomic_load(p, __ATOMIC_RELAXED, __HIP_MEMORY_SCOPE_AGENT); }
DI unsigned xb_add(unsigned* p, unsigned v) { return __hip_atomic_fetch_add(p, v, __ATOMIC_RELAXED, __HIP_MEMORY_SCOPE_AGENT); }
DI unsigned xb_xcc_id() { return (unsigned)__builtin_amdgcn_s_getreg((3 << 11) | 20) & 0xFu; }
#define XB_SPIN(cond, bar) do { unsigned _sp = 0; while (cond) { __builtin_amdgcn_s_sleep(1); \
    if ((++_sp & 255u) == 0u) { if (xb_ld(&(bar)[XB_TMO])) break; if (_sp > XB_SPIN_CAP) { atomicAdd(&(bar)[XB_TMO], 1u); break; } } } } while (0)
struct XcdBarrier { unsigned* bar; unsigned x; volatile LAS unsigned* st; };
DI XcdBarrier xcd_barrier_post(unsigned* bar, volatile LAS unsigned* st) {
  XcdBarrier b; b.bar = bar; b.x = xb_xcc_id(); b.st = st;
  if (threadIdx.x == 0) (void)xb_add(&bar[XB_XCNT(b.x)], 1u);
  return b;
}
DI void xcd_barrier_complete(unsigned* bar, unsigned x, unsigned& nloc, unsigned& nx) {
  const unsigned G = gridDim.x * gridDim.y * gridDim.z;
  unsigned sum, cnt, mine, sp = 0u;
  for (;;) {
    sum = 0u; cnt = 0u; mine = 0u;
#pragma unroll
    for (unsigned j = 0; j < 16; ++j) { const unsigned c = xb_ld(&bar[XB_XCNT(j)]); sum += c; cnt += (c > 0u) ? 1u : 0u; mine = (j == x) ? c : mine; }
    if (sum == G) break;
    __builtin_amdgcn_s_sleep(1);
    if ((++sp & 255u) == 0u) { if (xb_ld(&bar[XB_TMO])) break; if (sp > XB_SPIN_CAP) { atomicAdd(&bar[XB_TMO], 1u); break; } }
  }
  nloc = mine > 0u ? mine : 1u; nx = cnt > 0u ? cnt : 1u;
}
DI void xcd_barrier(const XcdBarrier& b) {
  asm volatile("s_waitcnt vmcnt(0)" ::: "memory");
  __syncthreads();
  if (threadIdx.x == 0) {
    unsigned* bar = b.bar;
    asm volatile("" : "+s"(bar));
    __builtin_amdgcn_s_waitcnt(0);
    unsigned nloc = b.st[0], nx = b.st[1];
    if (nloc == 0u) { xcd_barrier_complete(bar, b.x, nloc, nx); b.st[0] = nloc; b.st[1] = nx; }
    const unsigned old = xb_add(&bar[XB_XSUB(b.x)], 1u);
    const unsigned gen = old / nloc;
    if (old + 1u == (gen + 1u) * nloc) {
      __builtin_amdgcn_fence(__ATOMIC_RELEASE, "agent");
      asm volatile("s_waitcnt vmcnt(0)" ::: "memory");
      const unsigned og = xb_add(&bar[XB_TOP], 1u);
      const unsigned tg = og / nx;
      if (og + 1u == (tg + 1u) * nx) xb_add(&bar[XB_TOPGEN], 1u);
      else XB_SPIN(xb_ld(&bar[XB_TOPGEN]) == tg, bar);
      __builtin_amdgcn_fence(__ATOMIC_ACQUIRE, "agent");
      xb_add(&bar[XB_XGEN(b.x)], 1u);
      asm volatile("s_waitcnt vmcnt(0)" ::: "memory");
    } else {
      XB_SPIN(xb_ld(&bar[XB_XGEN(b.x)]) == gen, bar);
      __builtin_amdgcn_fence(__ATOMIC_ACQUIRE, "agent");
      asm volatile("s_waitcnt vmcnt(0)" ::: "memory");
    }
  }
  __syncthreads();
}

constexpr int SMEM_BYTES = 2 * GBUF * 2;
enum { PH_PREP0 = 0, PH_H0, PH_INPROJ, PH_PREP, PH_QKV, PH_ATT, PH_SSDOUT, PH_WOUT, PH_POSTMIX, PH_FF1, PH_FF2, PH_POSTFFN, PH_SSDNORM };

struct Ids { int bid, nb, vbid, nvb, lid; };
DI void run_phase(const Params& p, int ph, int layer, const Ids& id, char* smem, char* sh) {
  switch (ph) {
    case PH_PREP0: phase_prep0(p, id.vbid, id.nvb, sh); break;
    case PH_H0: phase_h0(p, id.vbid, id.nvb); break;
    case PH_INPROJ: phase_inproj(p, layer, id.bid, id.nb, smem); break;
    case PH_PREP: phase_prep(p, layer, id.vbid, id.nvb); break;
    case PH_QKV: phase_qkv(p, layer, id.vbid, id.nvb, sh); break;
    case PH_ATT: phase_att(p, layer, id.bid, id.nb, id.vbid, id.nvb, smem, sh); break;
    case PH_SSDOUT: phase_ssdout(p, layer, id.vbid, id.nvb, sh); break;
    case PH_WOUT: phase_wout(p, layer, id.lid, id.nvb, sh); break;
    case PH_POSTMIX: phase_postmix(p, layer, id.vbid, id.nvb); break;
    case PH_FF1: phase_ff1(p, layer, id.bid, id.nb, id.vbid, id.nvb, smem, sh); break;
    case PH_FF2: phase_ff2(p, layer, id.bid, id.nb, id.vbid, id.nvb, smem, sh); break;
    case PH_POSTFFN: phase_postffn(p, layer, id.vbid, id.nvb); break;
  }
}

__global__ void __launch_bounds__(512) mega_kernel(Params p) {
  extern __shared__ __attribute__((aligned(16))) char smem[];
  cg::grid_group grid = cg::this_grid();
  if (p.ws == nullptr) grid.sync();
  const int half = __builtin_amdgcn_readfirstlane((int)(threadIdx.x >> 8));
  Ids id;
  id.bid = blockIdx.x; id.nb = gridDim.x;
  id.vbid = 2 * id.bid + half; id.nvb = 2 * id.nb;
  id.lid = (id.bid & 7) + 8 * (2 * (id.bid >> 3) + half);
  char* sh = smem + half * SMEM_BYTES;
  volatile LAS unsigned* st = (volatile LAS unsigned*)(smem + 2 * SMEM_BYTES - 16);
  if (threadIdx.x == 0) { st[0] = 0u; st[1] = 0u; st[2] = 0u; st[3] = 0u; }
  __syncthreads();
  XcdBarrier xb = xcd_barrier_post((unsigned*)(p.ws + OFF_BAR), st);
#define MK_STEP(PH, LAYER, LAST) do { \
    typedef const void* __attribute__((address_space(4))) * KArgs; \
    KArgs ka = (KArgs)__builtin_amdgcn_kernarg_segment_ptr(); \
    asm volatile("" : "+s"(ka)); \
    Params q; \
    { const void** dst = (const void**)&q; _Pragma("unroll") for (int i = 0; i < 27; ++i) dst[i] = ka[i]; } \
    run_phase(q, PH, LAYER, id, smem, sh); \
    if (!(LAST)) xcd_barrier(xb); } while (0)
  MK_STEP(PH_PREP0, 0, false);
  MK_STEP(PH_H0, 0, false);
  MK_STEP(PH_INPROJ, 0, false); MK_STEP(PH_PREP, 0, false); MK_STEP(PH_QKV, 0, false); MK_STEP(PH_ATT, 0, false); MK_STEP(PH_SSDOUT, 0, false);
  MK_STEP(PH_WOUT, 0, false); MK_STEP(PH_POSTMIX, 0, false); MK_STEP(PH_FF1, 0, false); MK_STEP(PH_FF2, 0, false); MK_STEP(PH_POSTFFN, 0, false);
  MK_STEP(PH_INPROJ, 1, false); MK_STEP(PH_PREP, 1, false); MK_STEP(PH_QKV, 1, false); MK_STEP(PH_ATT, 1, false); MK_STEP(PH_SSDOUT, 1, false);
  MK_STEP(PH_WOUT, 1, false); MK_STEP(PH_POSTMIX, 1, false); MK_STEP(PH_FF1, 1, false); MK_STEP(PH_FF2, 1, false); MK_STEP(PH_POSTFFN, 1, true);
#undef MK_STEP
}

extern "C" void kernel_launch(void* const* d_in, const int* in_sizes, int n_in, void* d_out, int out_size, void* d_ws, size_t ws_size,
                              hipStream_t stream) {
  if (ws_size < WS_NEED) { fprintf(stderr, "workspace too small: %zu < %zu\n", ws_size, (size_t)WS_NEED); return; }
  Params p{};
  const float** f = (const float**)&p;
  for (int i = 0; i < 25; ++i) f[i] = (const float*)d_in[i];
  p.out = (float*)d_out;
  p.ws = (char*)d_ws;
  static int grid_blocks = 0;
  if (!grid_blocks) {
    int dev = 0, cus = 0, per_cu = 0;
    hipGetDevice(&dev);
    hipDeviceGetAttribute(&cus, hipDeviceAttributeMultiprocessorCount, dev);
    hipFuncSetAttribute((const void*)mega_kernel, hipFuncAttributeMaxDynamicSharedMemorySize, 2 * SMEM_BYTES);
    hipOccupancyMaxActiveBlocksPerMultiprocessor(&per_cu, mega_kernel, 512, 2 * SMEM_BYTES);
    if (per_cu > 1) per_cu = 1;
    grid_blocks = cus * per_cu;
  }
  hipMemsetAsync((char*)d_ws + OFF_BAR, 0, XCD_BAR_WORDS * 4, stream);
  void* args[] = {&p};
  hipError_t e = hipLaunchCooperativeKernel((void*)mega_kernel, dim3(grid_blocks), dim3(512), args, 2 * SMEM_BYTES, stream);
  if (e != hipSuccess) fprintf(stderr, "cooperative launch failed: %s (grid %d)\n", hipGetErrorString(e), grid_blocks);
}
```

```cpp
#include <hip/hip_runtime.h>
#include <hip/hip_cooperative_groups.h>
#include <stdint.h>
#include <stdio.h>
namespace cg = cooperative_groups;

#ifndef MEGA
#define MEGA 1
#endif
#ifndef REP_GEMM
#define REP_GEMM 1
#endif
#ifndef REP_ATT
#define REP_ATT 1
#endif
#ifndef REP_SSD
#define REP_SSD 1
#endif

typedef unsigned short bf16_t;
using bf16x8 = __attribute__((ext_vector_type(8))) short;
using s16x4  = __attribute__((ext_vector_type(4))) short;
using f32x4  = __attribute__((ext_vector_type(4))) float;
using f32x16 = __attribute__((ext_vector_type(16))) float;
using u32x4  = __attribute__((ext_vector_type(4))) unsigned;
using u32x2  = __attribute__((ext_vector_type(2))) unsigned;
#define DI __device__ __forceinline__
#define MFMA32(a, b, c) __builtin_amdgcn_mfma_f32_32x32x16_bf16((a), (b), (c), 0, 0, 0)
#define MFMA16(a, b, c) __builtin_amdgcn_mfma_f32_16x16x32_bf16((a), (b), (c), 0, 0, 0)

constexpr int DM = 1024, NB = 4, SEQ = 4096, CTX = 256;
constexpr int ML = NB * SEQ;
constexpr int MC = NB * CTX;
constexpr int MT = ML + MC;
constexpr int DIN = 2480, DINP = 2560;
constexpr int LK = CTX + SEQ;
constexpr int DFF = 4096;
constexpr int NCH = 34;
constexpr float EPS = 1e-6f;
constexpr int U_CKV = 256, U_KR = 384, U_GB = 416, U_GC = 672, U_VAL = 928, U_Z = 1184, U_XBC = 1696, U_DT = 2464;

constexpr size_t AL(size_t x) { return (x + 255) & ~(size_t)255; }
constexpr size_t WT_IN = 0;
constexpr size_t WT_UQ = WT_IN + (size_t)DINP * 1024;
constexpr size_t WT_UKV = WT_UQ + (size_t)384 * 256;
constexpr size_t WT_OUT = WT_UKV + (size_t)512 * 128;
constexpr size_t WT_FF1 = WT_OUT + (size_t)1024 * 1024;
constexpr size_t WT_FF2 = WT_FF1 + (size_t)4096 * 1024;
constexpr size_t WT_ELEMS = WT_FF2 + (size_t)4096 * 1024;
constexpr size_t OFF_WT = 0;
constexpr size_t OFF_MOD = AL(OFF_WT + 2 * WT_ELEMS * 2);
constexpr size_t OFF_XC = AL(OFF_MOD + 2 * 5 * 6144 * 4);
constexpr size_t OFF_H = AL(OFF_XC + (size_t)MC * DM * 4);
constexpr size_t OFF_R1 = AL(OFF_H + (size_t)MT * DM * 2);
constexpr size_t OFF_U = OFF_R1;
constexpr size_t OFF_DT = AL(OFF_U + (size_t)MT * DIN * 2);
constexpr size_t OFF_RSTD = AL(OFF_DT + (size_t)MT * 16 * 4);
constexpr size_t OFF_QB = AL(OFF_RSTD + (size_t)MT * 2 * 4);
constexpr size_t OFF_KB = AL(OFF_QB + (size_t)MT * 384 * 2);
constexpr size_t OFF_VT = AL(OFF_KB + (size_t)NB * 4 * LK * 96 * 2);
constexpr size_t OFF_XBC = AL(OFF_VT + (size_t)NB * 4 * 64 * LK * 2);
constexpr size_t OFF_SST = AL(OFF_XBC + (size_t)MT * 768 * 2);
constexpr size_t OFF_TDEC = AL(OFF_SST + (size_t)2 * NB * NCH * 8 * 4096 * 2);
constexpr size_t OFF_SSQ = AL(OFF_TDEC + (size_t)2 * NB * NCH * 8 * 4);
constexpr size_t OFF_END1 = AL(OFF_SSQ + (size_t)MT * 8 * 4);
constexpr size_t OFF_F1 = OFF_R1;
constexpr size_t OFF_END2 = AL(OFF_F1 + (size_t)MT * DFF * 2);
constexpr size_t OFF_BAR = OFF_END1 > OFF_END2 ? OFF_END1 : OFF_END2;
constexpr size_t WS_NEED = OFF_BAR + 16384;

struct Params {
  const float *x, *c, *ctx, *c_ctx, *w_mod, *b_mod, *g_pre_mix, *w_in, *q_norm, *w_uq, *kv_norm, *w_ukv, *sc_w, *ssd_cw, *ssd_cb,
      *a_log, *dt_bias, *ssd_d, *ssd_norm, *w_out, *g_post_mix, *g_pre_ffn, *w_ff1, *w_ff2, *g_post_ffn;
  float* out;
  char* ws;
};

DI int ltid() { int t = threadIdx.x; asm volatile("" : "+v"(t)); return t & 255; }
DI int ltid512() { int t = threadIdx.x; asm volatile("" : "+v"(t)); return t; }
typedef __bf16 hbf2 __attribute__((ext_vector_type(2)));
typedef float hf2 __attribute__((ext_vector_type(2)));
DI bf16_t f2bf(float x) { return __builtin_bit_cast(bf16_t, (__bf16)x); }
DI float bf2f(unsigned v) { return __uint_as_float(v << 16); }
DI unsigned pack2(float a, float b) { hf2 v = {a, b}; return __builtin_bit_cast(unsigned, __builtin_convertvector(v, hbf2)); }
DI float lo2f(unsigned w) { return __uint_as_float(w << 16); }
DI float hi2f(unsigned w) { return __uint_as_float(w & 0xffff0000u); }
DI float wave_sum(float v) {
#pragma unroll
  for (int o = 32; o > 0; o >>= 1) v += __shfl_xor(v, o);
  return v;
}
DI float silu_f(float x) { return x / (1.f + __expf(-x)); }
DI int crow(int reg, int h) { return (reg & 3) + 8 * (reg >> 2) + 4 * h; }
DI bf16x8 pack8(const f32x16& x, int s) {
  u32x4 p;
  p[0] = pack2(x[8 * s + 0], x[8 * s + 1]); p[1] = pack2(x[8 * s + 2], x[8 * s + 3]);
  p[2] = pack2(x[8 * s + 4], x[8 * s + 5]); p[3] = pack2(x[8 * s + 6], x[8 * s + 7]);
  return __builtin_bit_cast(bf16x8, p);
}
DI const float* xin_row(const Params& p, int layer, int row) {
  if (layer == 0) return row < ML ? p.x + (size_t)row * DM : p.ctx + (size_t)(row - ML) * DM;
  return row < ML ? p.out + (size_t)row * DM : (const float*)(p.ws + OFF_XC) + (size_t)(row - ML) * DM;
}
DI float* xst_row(const Params& p, int row) {
  return row < ML ? p.out + (size_t)row * DM : (float*)(p.ws + OFF_XC) + (size_t)(row - ML) * DM;
}
DI const float* mod_ptr(const Params& p, int layer, int row, int which) {
  int bb = row < ML ? (row >> 12) : 4;
  return (const float*)(p.ws + OFF_MOD) + ((size_t)(layer * 5 + bb) * 6 + which) * DM;
}
DI bf16_t* wt_ptr(const Params& p, int layer, size_t off) { return (bf16_t*)(p.ws + OFF_WT) + (size_t)layer * WT_ELEMS + off; }

DI void transpose_item(const float* __restrict__ w, const float* __restrict__ gk, int gk_from, bf16_t* __restrict__ wt, int K, int N, int kt, int nt, char* smem) {
  float* tile = (float*)smem;
  const int tid = ltid(), tx = tid & 63, ty = tid >> 6;
  const int k0 = kt * 64, n0 = nt * 64;
  const int n = n0 + tx;
  float v[16];
#pragma unroll
  for (int i = 0; i < 16; ++i) {
    int kk = ty + 4 * i;
    v[i] = n < N ? w[(size_t)(k0 + kk) * N + n] : 0.f;
  }
  if (gk) {
#pragma unroll
    for (int i = 0; i < 16; ++i) { int k = k0 + ty + 4 * i; if (k >= gk_from) v[i] *= gk[k - gk_from]; }
  }
#pragma unroll
  for (int i = 0; i < 16; ++i) tile[(ty + 4 * i) * 65 + tx] = v[i];
  __syncthreads();
#pragma unroll
  for (int i = 0; i < 2; ++i) {
    int c = tid + 256 * i, nn = c >> 3, kc = c & 7;
    u32x4 o;
#pragma unroll
    for (int jj = 0; jj < 4; ++jj) o[jj] = pack2(tile[(kc * 8 + 2 * jj) * 65 + nn], tile[(kc * 8 + 2 * jj + 1) * 65 + nn]);
    *(u32x4*)(wt + (size_t)(n0 + nn) * K + k0 + kc * 8) = o;
  }
  __syncthreads();
}

DI void modgemv_item(const Params& p, int layer, int ct, char* smem) {
  float* s = (float*)smem;
  float* red = s + 5 * 1024;
  const int tid = ltid(), w = tid >> 6, lane = tid & 63, ln = lane & 31, kh = lane >> 5;
  for (int i = tid; i < 5 * 1024; i += 256) {
    int bb = i >> 10, k = i & 1023;
    float v = bb < 4 ? p.c[bb * 1024 + k] : p.c_ctx[k];
    s[i] = silu_f(v);
  }
  __syncthreads();
  const float* wm = p.w_mod + (size_t)layer * 1024 * 6144;
  const int n = ct * 32 + ln;
  float acc[5] = {0.f, 0.f, 0.f, 0.f, 0.f};
#pragma unroll 16
  for (int i = 0; i < 128; ++i) {
    const int k = w * 256 + 2 * i + kh;
    float wv = wm[(size_t)k * 6144 + n];
#pragma unroll
    for (int bb = 0; bb < 5; ++bb) acc[bb] += s[bb * 1024 + k] * wv;
  }
#pragma unroll
  for (int bb = 0; bb < 5; ++bb) {
    acc[bb] += __shfl_xor(acc[bb], 32);
    if (kh == 0) red[(w * 5 + bb) * 32 + ln] = acc[bb];
  }
  __syncthreads();
  if (tid < 160) {
    int bb = tid >> 5, l2 = tid & 31;
    float v = red[(0 * 5 + bb) * 32 + l2] + red[(1 * 5 + bb) * 32 + l2] + red[(2 * 5 + bb) * 32 + l2] + red[(3 * 5 + bb) * 32 + l2];
    int nn = ct * 32 + l2;
    v += p.b_mod[layer * 6144 + nn];
    ((float*)(p.ws + OFF_MOD))[(size_t)(layer * 5 + bb) * 6144 + nn] = v;
  }
  __syncthreads();
}

DI void phase_prep0(const Params& p, int bid, int nb, char* smem) {
  constexpr int PER = 2984;
  for (int it = bid; it < 384 + 2 * PER; it += nb) {
    if (it < 384) { modgemv_item(p, it / 192, it % 192, smem); continue; }
    int layer = (it - 384) / PER, j = (it - 384) % PER;
    if (j < 640) transpose_item(p.w_in + (size_t)layer * 1024 * DIN, nullptr, 0, wt_ptr(p, layer, WT_IN), 1024, DIN, j / 40, j % 40, smem);
    else if ((j -= 640) < 24) transpose_item(p.w_uq + (size_t)layer * 256 * 384, p.q_norm + layer * 256, 0, wt_ptr(p, layer, WT_UQ), 256, 384, j / 6, j % 6, smem);
    else if ((j -= 24) < 16) transpose_item(p.w_ukv + (size_t)layer * 128 * 512, p.kv_norm + layer * 128, 0, wt_ptr(p, layer, WT_UKV), 128, 512, j / 8, j % 8, smem);
    else if ((j -= 16) < 256) transpose_item(p.w_out + (size_t)layer * 1024 * 1024, p.ssd_norm + layer * 512, 512, wt_ptr(p, layer, WT_OUT), 1024, 1024, j / 16, j % 16, smem);
    else if ((j -= 256) < 1024) transpose_item(p.w_ff1 + (size_t)layer * 1024 * 4096, nullptr, 0, wt_ptr(p, layer, WT_FF1), 1024, 4096, j / 64, j % 64, smem);
    else { j -= 1024; transpose_item(p.w_ff2 + (size_t)layer * 4096 * 1024, nullptr, 0, wt_ptr(p, layer, WT_FF2), 4096, 1024, j / 16, j % 16, smem); }
  }
}

struct HMod { float4 g[4], s1[4], s0[4]; };
DI void load_hmod(HMod& m, const float* g, const float* sh, const float* sc, int lane) {
#pragma unroll
  for (int i = 0; i < 4; ++i) {
    const int col = lane * 4 + 256 * i;
    m.g[i] = *(const float4*)(g + col); m.s1[i] = *(const float4*)(sc + col); m.s0[i] = *(const float4*)(sh + col);
  }
}
DI void write_h_row(const float4 xv[4], float rstd, const HMod& m, bf16_t* hrow, int lane) {
#pragma unroll
  for (int i = 0; i < 4; ++i) {
    const int col = lane * 4 + 256 * i;
    float a = xv[i].x * rstd * m.g[i].x * (1.f + m.s1[i].x) + m.s0[i].x;
    float b = xv[i].y * rstd * m.g[i].y * (1.f + m.s1[i].y) + m.s0[i].y;
    float c = xv[i].z * rstd * m.g[i].z * (1.f + m.s1[i].z) + m.s0[i].z;
    float d = xv[i].w * rstd * m.g[i].w * (1.f + m.s1[i].w) + m.s0[i].w;
    u32x2 o; o[0] = pack2(a, b); o[1] = pack2(c, d);
    *(u32x2*)(hrow + col) = o;
  }
}
DI float ssq4(const float4 v[4]) {
  float s = 0.f;
#pragma unroll
  for (int i = 0; i < 4; ++i) s += v[i].x * v[i].x + v[i].y * v[i].y + v[i].z * v[i].z + v[i].w * v[i].w;
  return s;
}
DI void load_bf_row(const bf16_t* r, int lane, float4 v[4]) {
#pragma unroll
  for (int i = 0; i < 4; ++i) {
    u32x2 t = *(const u32x2*)(r + lane * 4 + 256 * i);
    v[i] = make_float4(lo2f(t[0]), hi2f(t[0]), lo2f(t[1]), hi2f(t[1]));
  }
}

struct RowVec { float4 c1[4], c2[4], c3[4]; };
DI const float* mod_ptr_b(const Params& p, int layer, int bb, int which) {
  return (const float*)(p.ws + OFF_MOD) + ((size_t)(layer * 5 + bb) * 6 + which) * DM;
}
template <int MODE>
DI void rowwise_phase(const Params& p, int layer, int bid, int nb) {
  const int w = ltid() >> 6, lane = ltid() & 63;
  const int M = (MODE == 0 || layer == 0) ? MT : ML;
  const bool wh = MODE != 2 || layer == 0;
  bf16_t* H = (bf16_t*)(p.ws + OFF_H);
  const bf16_t* Y = MODE == 1 ? (const bf16_t*)(p.ws + OFF_U) : (const bf16_t*)(p.ws + OFF_H);
  const int NW = nb * 4, W = bid * 4 + w, nwb = NW >> 2;
  auto load_vec = [&](RowVec& v, int bb) {
    const float* gate = MODE == 1 ? mod_ptr_b(p, layer, bb, 2) : mod_ptr_b(p, layer, bb, 5);
    const float* gres = MODE == 1 ? p.g_post_mix + layer * DM : p.g_post_ffn + layer * DM;
    const int hl = MODE == 2 ? 1 : layer;
    const float* gn = MODE == 1 ? p.g_pre_ffn + layer * DM : p.g_pre_mix + hl * DM;
    const float* sh = mod_ptr_b(p, hl, bb, MODE == 1 ? 3 : 0);
    const float* sc = mod_ptr_b(p, hl, bb, MODE == 1 ? 4 : 1);
#pragma unroll
    for (int i = 0; i < 4; ++i) {
      const int col = lane * 4 + 256 * i;
      if (MODE != 0) {
        const float4 a = *(const float4*)(gate + col), b = *(const float4*)(gres + col);
        v.c1[i] = make_float4(a.x * b.x, a.y * b.y, a.z * b.z, a.w * b.w);
      }
      if (wh) {
        const float4 g = *(const float4*)(gn + col), s1 = *(const float4*)(sc + col);
        v.c2[i] = make_float4(g.x * (1.f + s1.x), g.y * (1.f + s1.y), g.z * (1.f + s1.z), g.w * (1.f + s1.w));
        v.c3[i] = *(const float4*)(sh + col);
      }
    }
  };
  struct RowIn { u32x2 y[4]; float4 x[4]; };
  auto load_row = [&](RowIn& r, int row) {
    const float* xr = MODE == 2 ? (const float*)xst_row(p, row) : xin_row(p, layer, row);
#pragma unroll
    for (int i = 0; i < 4; ++i) {
      r.x[i] = *(const float4*)(xr + lane * 4 + 256 * i);
      if (MODE != 0) r.y[i] = *(const u32x2*)(Y + (size_t)row * DM + lane * 4 + 256 * i);
    }
  };
  auto finish = [&](float4 (&xv)[4], const float4 (&yv)[4], const RowVec& v, int row) {
    if (MODE != 0) {
      const float rstd = rsqrtf(wave_sum(ssq4(yv)) * (1.f / DM) + EPS);
#pragma unroll
      for (int i = 0; i < 4; ++i) {
        xv[i].x += yv[i].x * rstd * v.c1[i].x; xv[i].y += yv[i].y * rstd * v.c1[i].y;
        xv[i].z += yv[i].z * rstd * v.c1[i].z; xv[i].w += yv[i].w * rstd * v.c1[i].w;
      }
      float* xo = xst_row(p, row);
#pragma unroll
      for (int i = 0; i < 4; ++i) *(float4*)(xo + lane * 4 + 256 * i) = xv[i];
    }
    if (wh) {
      const float rstd1 = rsqrtf(wave_sum(ssq4(xv)) * (1.f / DM) + EPS);
      bf16_t* hrow = H + (size_t)row * DM;
#pragma unroll
      for (int i = 0; i < 4; ++i) {
        u32x2 o;
        o[0] = pack2(xv[i].x * rstd1 * v.c2[i].x + v.c3[i].x, xv[i].y * rstd1 * v.c2[i].y + v.c3[i].y);
        o[1] = pack2(xv[i].z * rstd1 * v.c2[i].z + v.c3[i].z, xv[i].w * rstd1 * v.c2[i].w + v.c3[i].w);
        *(u32x2*)(hrow + lane * 4 + 256 * i) = o;
      }
    }
  };
  auto process = [&](RowIn& r, const RowVec& v, int row) {
    float4 yv[4];
#pragma unroll
    for (int i = 0; i < 4; ++i) yv[i] = make_float4(lo2f(r.y[i][0]), hi2f(r.y[i][0]), lo2f(r.y[i][1]), hi2f(r.y[i][1]));
    finish(r.x, yv, v, row);
  };
  RowVec v;
  {
    const int bb = W / nwb, j = W - bb * nwb, end = SEQ * (bb + 1);
    load_vec(v, bb);
    RowIn ra, rb;
    int row = SEQ * bb + j;
    if (row < end) load_row(ra, row);
    while (row < end) {
      const int rowb = row + nwb;
      const bool hb = rowb < end;
      if (hb) load_row(rb, rowb);
      process(ra, v, row);
      if (!hb) break;
      const int rowa = rowb + nwb;
      const bool ha = rowa < end;
      if (ha) load_row(ra, rowa);
      process(rb, v, rowb);
      if (!ha) break;
      row = rowa;
    }
  }
  if (M > ML) {
    load_vec(v, 4);
    for (int row = ML + W; row < M; row += NW) {
      float4 xv[4], yv[4];
      const float* xr = MODE == 2 ? (const float*)xst_row(p, row) : xin_row(p, layer, row);
#pragma unroll
      for (int i = 0; i < 4; ++i) xv[i] = *(const float4*)(xr + lane * 4 + 256 * i);
      if (MODE == 1) load_bf_row(Y + (size_t)row * DM, lane, yv);
      if (MODE == 2) {
        const float* pp = (const float*)(p.ws + OFF_END2) + (size_t)(row - ML) * DM;
#pragma unroll
        for (int i = 0; i < 4; ++i) {
          float4 a = *(const float4*)(pp + lane * 4 + 256 * i), b = *(const float4*)(pp + (size_t)MC * DM + lane * 4 + 256 * i);
          float4 c = *(const float4*)(pp + (size_t)2 * MC * DM + lane * 4 + 256 * i), d = *(const float4*)(pp + (size_t)3 * MC * DM + lane * 4 + 256 * i);
          yv[i] = make_float4((a.x + b.x) + (c.x + d.x), (a.y + b.y) + (c.y + d.y), (a.z + b.z) + (c.z + d.z), (a.w + b.w) + (c.w + d.w));
        }
      }
      finish(xv, yv, v, row);
    }
  }
}
DI void phase_h0(const Params& p, int bid, int nb) { rowwise_phase<0>(p, 0, bid, nb); }
DI void phase_postmix(const Params& p, int layer, int bid, int nb) { rowwise_phase<1>(p, layer, bid, nb); }
DI void phase_postffn(const Params& p, int layer, int bid, int nb) { rowwise_phase<2>(p, layer, bid, nb); }

DI void phase_prep(const Params& p, int layer, int bid, int nb) {
  const int w = ltid() >> 6, lane = ltid() & 63;
  const bf16_t* U = (const bf16_t*)(p.ws + OFF_U);
  float* DT = (float*)(p.ws + OFF_DT);
  float* RS = (float*)(p.ws + OFF_RSTD);
  bf16_t* KB = (bf16_t*)(p.ws + OFF_KB);
  bf16_t* XBC = (bf16_t*)(p.ws + OFF_XBC);
  bf16_t* YM = (bf16_t*)(p.ws + OFF_H);
  const float* scw = p.sc_w + layer * 3 * 256;
  const float* cw = p.ssd_cw + layer * 3 * 768;
  const float* cb = p.ssd_cb + layer * 768;
  const int c4 = lane * 4;
  const float4 sw0 = *(const float4*)(scw + c4), sw1 = *(const float4*)(scw + 256 + c4), sw2 = *(const float4*)(scw + 512 + c4);
  float4 cwk[3][3], cbi[3];
#pragma unroll
  for (int i = 0; i < 3; ++i) {
    cbi[i] = *(const float4*)(cb + c4 + 256 * i);
#pragma unroll
    for (int k = 0; k < 3; ++k) cwk[i][k] = *(const float4*)(cw + k * 768 + c4 + 256 * i);
  }
  const float dtb = p.dt_bias[layer * 16 + (lane & 15)];
  const float invf = exp2f(-(float)(2 * (lane & 7)) * (13.287712379549449f / 16.f));
  for (int row = bid * 4 + w; row < MT; row += nb * 4) {
    int b, t, L, pos;
    const bool lat = row < ML;
    if (lat) { b = row >> 12; t = row & 4095; L = SEQ; pos = t + CTX; }
    else { int rr = row - ML; b = rr >> 8; t = rr & 255; L = CTX; pos = t; }
    const bf16_t* u0 = U + (size_t)row * DIN;
    const bool hp = t > 0, hn = t < L - 1;
    const bf16_t* um = hp ? u0 - DIN : u0;
    const bf16_t* up = hn ? u0 + DIN : u0;
    const float mp = hp ? 1.f : 0.f, mn = hn ? 1.f : 0.f;
    const u32x2 vq = *(const u32x2*)(u0 + c4);
    const u32x2 vkv = *(const u32x2*)(u0 + U_CKV + (lane & 31) * 4);
    const float kr = bf2f(u0[U_KR + (lane & 31)]);
    const u32x2 gcm = *(const u32x2*)(um + U_GC + c4), gc0 = *(const u32x2*)(u0 + U_GC + c4), gcp = *(const u32x2*)(up + U_GC + c4);
    const u32x2 vvm = *(const u32x2*)(um + U_VAL + c4), vv0 = *(const u32x2*)(u0 + U_VAL + c4), vvp = *(const u32x2*)(up + U_VAL + c4);
    const u32x2 gb = *(const u32x2*)(u0 + U_GB + c4);
    u32x2 xm[3], x0[3], xp[3];
#pragma unroll
    for (int i = 0; i < 3; ++i) {
      xm[i] = *(const u32x2*)(um + U_XBC + c4 + 256 * i);
      x0[i] = *(const u32x2*)(u0 + U_XBC + c4 + 256 * i);
      xp[i] = *(const u32x2*)(up + U_XBC + c4 + 256 * i);
    }
    const float dtr = DT[(size_t)row * 16 + (lane & 15)];
    {
      float a = lo2f(vq[0]), bq = hi2f(vq[0]), c = lo2f(vq[1]), d = hi2f(vq[1]);
      float ss = wave_sum(a * a + bq * bq + c * c + d * d);
      float e = lo2f(vkv[0]), f = hi2f(vkv[0]), g = lo2f(vkv[1]), h = hi2f(vkv[1]);
      float s2 = lane < 32 ? e * e + f * f + g * g + h * h : 0.f;
      s2 = wave_sum(s2);
      if (lane == 0) { RS[row * 2] = rsqrtf(ss * (1.f / 256) + EPS); RS[row * 2 + 1] = rsqrtf(s2 * (1.f / 128) + EPS); }
    }
    {
      const float partner = __shfl_xor(kr, 8);
      float o = kr;
      if (lat) {
        const int grp = (lane & 31) >> 3;
        const float posf = grp < 2 ? (float)(t >> 6) : (float)(t & 63);
        const float rev = posf * invf * 0.15915494309189535f;
        const float cs = __builtin_amdgcn_cosf(rev), sn = __builtin_amdgcn_sinf(rev);
        o = (grp & 1) ? kr * cs + partner * sn : kr * cs - partner * sn;
      }
      if (lane < 32) {
        const bf16_t ob = f2bf(o);
#pragma unroll
        for (int hd = 0; hd < 4; ++hd) KB[((size_t)(b * 4 + hd) * LK + pos) * 96 + 64 + lane] = ob;
      }
    }
    {
      float a0 = sw1.x * lo2f(gc0[0]) * lo2f(vv0[0]) + mp * sw0.x * lo2f(gcm[0]) * lo2f(vvm[0]) + mn * sw2.x * lo2f(gcp[0]) * lo2f(vvp[0]);
      float a1 = sw1.y * hi2f(gc0[0]) * hi2f(vv0[0]) + mp * sw0.y * hi2f(gcm[0]) * hi2f(vvm[0]) + mn * sw2.y * hi2f(gcp[0]) * hi2f(vvp[0]);
      float a2 = sw1.z * lo2f(gc0[1]) * lo2f(vv0[1]) + mp * sw0.z * lo2f(gcm[1]) * lo2f(vvm[1]) + mn * sw2.z * lo2f(gcp[1]) * lo2f(vvp[1]);
      float a3 = sw1.w * hi2f(gc0[1]) * hi2f(vv0[1]) + mp * sw0.w * hi2f(gcm[1]) * hi2f(vvm[1]) + mn * sw2.w * hi2f(gcp[1]) * hi2f(vvp[1]);
      u32x2 o; o[0] = pack2(lo2f(gb[0]) * a0, hi2f(gb[0]) * a1); o[1] = pack2(lo2f(gb[1]) * a2, hi2f(gb[1]) * a3);
      *(u32x2*)(YM + (size_t)row * DM + 256 + c4) = o;
    }
#pragma unroll
    for (int i = 0; i < 3; ++i) {
      float a0 = cbi[i].x + cwk[i][1].x * lo2f(x0[i][0]) + mp * cwk[i][0].x * lo2f(xm[i][0]) + mn * cwk[i][2].x * lo2f(xp[i][0]);
      float a1 = cbi[i].y + cwk[i][1].y * hi2f(x0[i][0]) + mp * cwk[i][0].y * hi2f(xm[i][0]) + mn * cwk[i][2].y * hi2f(xp[i][0]);
      float a2 = cbi[i].z + cwk[i][1].z * lo2f(x0[i][1]) + mp * cwk[i][0].z * lo2f(xm[i][1]) + mn * cwk[i][2].z * lo2f(xp[i][1]);
      float a3 = cbi[i].w + cwk[i][1].w * hi2f(x0[i][1]) + mp * cwk[i][0].w * hi2f(xm[i][1]) + mn * cwk[i][2].w * hi2f(xp[i][1]);
      u32x2 o; o[0] = pack2(silu_f(a0), silu_f(a1)); o[1] = pack2(silu_f(a2), silu_f(a3));
      *(u32x2*)(XBC + (size_t)row * 768 + c4 + 256 * i) = o;
    }
    if (lane < 16) {
      const float v = dtr + dtb;
      const float e = __expf(-fabsf(v));
      DT[(size_t)row * 16 + lane] = fmaxf(v, 0.f) + (e < 1e-3f ? e * (1.f - 0.5f * e) : __logf(1.f + e));
    }
  }
}

DI void phase_ssdnorm(const Params& p, int layer, int bid, int nb) {
  const int w = ltid() >> 6, lane = ltid() & 63;
  const int M = layer == 0 ? MT : ML;
  bf16_t* YM = (bf16_t*)(p.ws + OFF_H);
  const float* SSQ = (const float*)(p.ws + OFF_SSQ);
  const float* ng = p.ssd_norm + layer * 512;
  for (int row = bid * 4 + w; row < M; row += nb * 4) {
    int g = lane >> 5;
    float4 s = *(const float4*)(SSQ + (size_t)row * 8 + g * 4);
    float rstd = rsqrtf((s.x + s.y + s.z + s.w) * (1.f / 256) + EPS);
    bf16_t* ptr = YM + (size_t)row * DM + 512 + lane * 8;
    u32x4 v = *(const u32x4*)ptr;
    float4 g0 = *(const float4*)(ng + lane * 8), g1 = *(const float4*)(ng + lane * 8 + 4);
    u32x4 o;
    o[0] = pack2(lo2f(v[0]) * rstd * g0.x, hi2f(v[0]) * rstd * g0.y);
    o[1] = pack2(lo2f(v[1]) * rstd * g0.z, hi2f(v[1]) * rstd * g0.w);
    o[2] = pack2(lo2f(v[2]) * rstd * g1.x, hi2f(v[2]) * rstd * g1.y);
    o[3] = pack2(lo2f(v[3]) * rstd * g1.z, hi2f(v[3]) * rstd * g1.w);
    *(u32x4*)ptr = o;
  }
}

constexpr int GST = 80;
constexpr int GBUF = 2 * 128 * GST;
template <bool GN, class Epi>
DI void gemm_tile(const bf16_t* __restrict__ A, int lda, const bf16_t* __restrict__ Bt, int K, int row0, int col0, char* smem, Epi epi, const float* __restrict__ ssq = nullptr) {
  bf16_t* S0 = (bf16_t*)smem;
  const int tid = ltid(), wid = tid >> 6, lane = tid & 63, wr = wid >> 1, wc = wid & 1, fr = lane & 15, fq = lane >> 4;
  f32x4 acc[4][4];
#pragma unroll
  for (int m = 0; m < 4; ++m)
#pragma unroll
    for (int n = 0; n < 4; ++n) acc[m][n] = f32x4{0.f, 0.f, 0.f, 0.f};
  u32x4 ra[4], rb[4];
  const int sr = tid >> 3, sp = tid & 7;
  const bf16_t* ga = A + (size_t)(row0 + sr) * lda + sp * 8;
  const bf16_t* gb = Bt + (size_t)(col0 + sr) * K + sp * 8;
  auto gload = [&](int k0) {
#pragma unroll
    for (int i = 0; i < 4; ++i) {
      ra[i] = *(const u32x4*)(ga + (size_t)(32 * i) * lda + k0);
      rb[i] = *(const u32x4*)(gb + (size_t)(32 * i) * K + k0);
    }
  };
  gload(0);
  float gs[4][2];
  if (GN) {
#pragma unroll
    for (int i = 0; i < 4; ++i) {
      const float4 s0 = *(const float4*)(ssq + (size_t)(row0 + sr + 32 * i) * 8), s1 = *(const float4*)(ssq + (size_t)(row0 + sr + 32 * i) * 8 + 4);
      gs[i][0] = rsqrtf((s0.x + s0.y + s0.z + s0.w) * (1.f / 256) + EPS);
      gs[i][1] = rsqrtf((s1.x + s1.y + s1.z + s1.w) * (1.f / 256) + EPS);
    }
  }
  auto swrite = [&](int kt) {
    if (GN && kt >= 8) {
      const int g = (kt - 8) >> 2;
#pragma unroll
      for (int i = 0; i < 4; ++i) {
        const float sc = g ? gs[i][1] : gs[i][0];
#pragma unroll
        for (int jj = 0; jj < 4; ++jj) ra[i][jj] = pack2(lo2f(ra[i][jj]) * sc, hi2f(ra[i][jj]) * sc);
      }
    }
    bf16_t* As = S0 + (kt & 1) * GBUF;
    bf16_t* Bs = As + 128 * GST;
#pragma unroll
    for (int i = 0; i < 4; ++i) {
      *(u32x4*)(As + (sr + 32 * i) * GST + sp * 8) = ra[i];
      *(u32x4*)(Bs + (sr + 32 * i) * GST + sp * 8) = rb[i];
    }
  };
  const int KT = K / 64;
  swrite(0);
  if (KT > 1) gload(64);
  __syncthreads();
  for (int kt = 0; kt < KT; ++kt) {
    const bf16_t* As = S0 + (kt & 1) * GBUF;
    const bf16_t* Bs = As + 128 * GST;
#pragma unroll
    for (int ks = 0; ks < 2; ++ks) {
      bf16x8 af[4], bfr[4];
#pragma unroll
      for (int m = 0; m < 4; ++m) af[m] = *(const bf16x8*)(As + (wr * 64 + m * 16 + fr) * GST + ks * 32 + fq * 8);
#pragma unroll
      for (int n = 0; n < 4; ++n) bfr[n] = *(const bf16x8*)(Bs + (wc * 64 + n * 16 + fr) * GST + ks * 32 + fq * 8);
#pragma unroll
      for (int m = 0; m < 4; ++m)
#pragma unroll
        for (int n = 0; n < 4; ++n) acc[m][n] = MFMA16(bfr[n], af[m], acc[m][n]);
      if (ks == 0 && kt + 1 < KT) {
        swrite(kt + 1);
        if (kt + 2 < KT) gload((kt + 2) * 64);
      }
    }
    __syncthreads();
  }
  float rsc[4];
#pragma unroll
  for (int m = 0; m < 4; ++m) rsc[m] = epi.scale(row0 + wr * 64 + m * 16 + fr);
#pragma unroll
  for (int m = 0; m < 4; ++m)
#pragma unroll
    for (int n = 0; n < 4; ++n) epi(row0 + wr * 64 + m * 16 + fr, col0 + wc * 64 + n * 16 + fq * 4, acc[m][n], rsc[m]);
}

template <class Epi>
DI void gemm_tile_glds(const bf16_t* __restrict__ A, int lda, const bf16_t* __restrict__ Bt, int ldb, int K, int row0, int col0, char* smem, Epi epi) {
  const int tid = ltid(), wid = tid >> 6, lane = tid & 63, wr = wid >> 1, wc = wid & 1, fr = lane & 15, fq = lane >> 4;
  f32x4 acc[4][4];
#pragma unroll
  for (int m = 0; m < 4; ++m)
#pragma unroll
    for (int n = 0; n < 4; ++n) acc[m][n] = f32x4{0.f, 0.f, 0.f, 0.f};
  const int crow = tid >> 3, cslot = tid & 7, cpart = cslot ^ (crow & 7);
  const bf16_t* ga = A + (size_t)(row0 + crow) * lda + cpart * 8;
  const bf16_t* gb = Bt + (size_t)(col0 + crow) * ldb + cpart * 8;
  auto issue = [&](int kt, int stage) {
    char* sa = smem + stage * 32768 + tid * 16;
#pragma unroll
    for (int i = 0; i < 4; ++i) {
      __builtin_amdgcn_global_load_lds((const unsigned*)(ga + (size_t)(32 * i) * lda + kt * 64), (__attribute__((address_space(3))) unsigned*)(sa + i * 4096), 16, 0, 0);
      __builtin_amdgcn_global_load_lds((const unsigned*)(gb + (size_t)(32 * i) * ldb + kt * 64), (__attribute__((address_space(3))) unsigned*)(sa + 16384 + i * 4096), 16, 0, 0);
    }
  };
  const int KT = K / 64;
  issue(0, 0);
  asm volatile("s_waitcnt vmcnt(0)" ::: "memory");
  __syncthreads();
  const int sw = fr & 7;
  for (int kt = 0; kt < KT; ++kt) {
    if (kt + 1 < KT) issue(kt + 1, (kt + 1) & 1);
    const char* As = smem + (kt & 1) * 32768;
    const char* Bs = As + 16384;
#pragma unroll
    for (int ks = 0; ks < 2; ++ks) {
      bf16x8 af[4], bfr[4];
      const int so = ((ks * 4 + fq) ^ sw) * 16;
#pragma unroll
      for (int m = 0; m < 4; ++m) af[m] = *(const bf16x8*)(As + (wr * 64 + m * 16 + fr) * 128 + so);
#pragma unroll
      for (int n = 0; n < 4; ++n) bfr[n] = *(const bf16x8*)(Bs + (wc * 64 + n * 16 + fr) * 128 + so);
#pragma unroll
      for (int m = 0; m < 4; ++m)
#pragma unroll
        for (int n = 0; n < 4; ++n) acc[m][n] = MFMA16(bfr[n], af[m], acc[m][n]);
    }
    asm volatile("s_waitcnt vmcnt(0)" ::: "memory");
    __syncthreads();
  }
#pragma unroll
  for (int m = 0; m < 4; ++m)
#pragma unroll
    for (int n = 0; n < 4; ++n) epi(row0 + wr * 64 + m * 16 + fr, col0 + wc * 64 + n * 16 + fq * 4, acc[m][n]);
}

constexpr int G8_HT = 128 * 64;
DI int g8_lds_byte(int r, int c) {
  int st = (r >> 4) * 2 + (c >> 5), rr = r & 15, cc = c & 31, ob = rr * 64 + cc * 2;
  return st * 1024 + (ob ^ (((ob >> 9) & 1) << 5));
}
DI void g8_stage_rc(int b, int& R, int& C) {
  int st = b / 1024, sb = b % 1024, swz = sb ^ (((sb >> 9) & 1) << 5);
  R = (st >> 1) * 16 + swz / 64; C = (st & 1) * 32 + (swz % 64) / 2;
}
template <class Epi>
DI void gemm8_tile(const bf16_t* __restrict__ A, int lda, const bf16_t* __restrict__ Bt, int ldb, int K, int brow, int bcol, char* smem, Epi epi,
                   bool first = true, bool has_next = false, int nbrow = 0, int nbcol = 0) {
  bf16_t* shm = (bf16_t*)smem;
  const int tid = ltid512();
#define G8_SA(b, h) (shm + ((b) * 2 + (h)) * G8_HT)
#define G8_SB(b, h) (shm + (4 + (b) * 2 + (h)) * G8_HT)
#define G8_STAGE(P, BASE, LD, br, kt) do { const bf16_t* _g = (BASE) + (size_t)(br) * (LD) + (size_t)(kt) * 64; \
    _Pragma("unroll") for (int _i = 0; _i < 2; ++_i) { int _b = tid * 16 + _i * 8192; int _r, _c; g8_stage_rc(_b, _r, _c); \
      __builtin_amdgcn_global_load_lds((const unsigned*)(_g + (size_t)_r * (LD) + _c), \
        (__attribute__((address_space(3))) unsigned*)((char*)(P) + _b), 16, 0, 0); } } while (0)
#define G8_LDA(dst, b, h) _Pragma("unroll") for (int m = 0; m < 4; ++m) _Pragma("unroll") for (int k = 0; k < 2; ++k) \
    dst[m][k] = *reinterpret_cast<const bf16x8*>((char*)G8_SA(b, h) + g8_lds_byte(wr * 64 + m * 16 + fr, k * 32 + fq * 8))
#define G8_LDB(dst, b, h) _Pragma("unroll") for (int n = 0; n < 2; ++n) _Pragma("unroll") for (int k = 0; k < 2; ++k) \
    dst[n][k] = *reinterpret_cast<const bf16x8*>((char*)G8_SB(b, h) + g8_lds_byte(wc * 32 + n * 16 + fr, k * 32 + fq * 8))
#define G8_MMA(ai, bj, At, Bx) do { __builtin_amdgcn_s_setprio(1); \
    _Pragma("unroll") for (int m = 0; m < 4; ++m) _Pragma("unroll") for (int n = 0; n < 2; ++n) _Pragma("unroll") for (int k = 0; k < 2; ++k) \
      acc[ai][bj][m][n] = __builtin_amdgcn_mfma_f32_16x16x32_bf16(Bx[n][k], At[m][k], acc[ai][bj][m][n], 0, 0, 0); \
    __builtin_amdgcn_s_setprio(0); } while (0)
#define G8_WAIT_V(n) asm volatile("s_waitcnt vmcnt(" #n ")" ::: "memory")
#define G8_WAIT_L(n) asm volatile("s_waitcnt lgkmcnt(" #n ")" ::: "memory")
#define G8_BAR __builtin_amdgcn_s_barrier()
#define G8_SCHED __builtin_amdgcn_sched_barrier(0)
  const int wid = tid >> 6, lane = tid & 63, wr = wid >> 2, wc = wid & 3, fr = lane & 15, fq = lane >> 4;
  f32x4 acc[2][2][4][2];
#pragma unroll
  for (int a = 0; a < 2; ++a)
#pragma unroll
    for (int b = 0; b < 2; ++b)
#pragma unroll
      for (int m = 0; m < 4; ++m)
#pragma unroll
        for (int n = 0; n < 2; ++n) acc[a][b][m][n] = f32x4{0.f, 0.f, 0.f, 0.f};
  bf16x8 At[4][2], B0[2][2], B1[2][2];
  const int nt = K / 64;
  if (first) {
    G8_STAGE(G8_SB(0, 0), Bt, ldb, bcol, 0); G8_STAGE(G8_SA(0, 0), A, lda, brow, 0);
    G8_STAGE(G8_SB(0, 1), Bt, ldb, bcol + 128, 0); G8_STAGE(G8_SA(0, 1), A, lda, brow + 128, 0);
  }
  if (wr == 1) G8_BAR;
  if (first) G8_WAIT_V(4); else G8_WAIT_V(0);
  G8_BAR;
  G8_STAGE(G8_SB(1, 0), Bt, ldb, bcol, 1); G8_STAGE(G8_SA(1, 0), A, lda, brow, 1); G8_STAGE(G8_SB(1, 1), Bt, ldb, bcol + 128, 1);
  G8_WAIT_V(6); G8_BAR;
  for (int t = 0; t < nt - 2; t += 2) {
    G8_LDB(B0, 0, 0); G8_SCHED; G8_LDA(At, 0, 0); G8_STAGE(G8_SA(1, 1), A, lda, brow + 128, t + 1);
    G8_WAIT_L(8); G8_BAR; G8_WAIT_L(0); G8_MMA(0, 0, At, B0); G8_BAR; G8_SCHED;
    G8_LDB(B1, 0, 1); G8_STAGE(G8_SB(0, 0), Bt, ldb, bcol, t + 2);
    G8_BAR; G8_WAIT_L(0); G8_MMA(0, 1, At, B1); G8_BAR;
    G8_LDA(At, 0, 1); G8_STAGE(G8_SA(0, 0), A, lda, brow, t + 2);
    G8_BAR; G8_WAIT_L(0); G8_MMA(1, 0, At, B0); G8_BAR; G8_SCHED;
    G8_STAGE(G8_SB(0, 1), Bt, ldb, bcol + 128, t + 2);
    G8_WAIT_V(6); G8_BAR; G8_MMA(1, 1, At, B1); G8_BAR;
    G8_LDB(B0, 1, 0); G8_SCHED; G8_LDA(At, 1, 0); G8_STAGE(G8_SA(0, 1), A, lda, brow + 128, t + 2);
    G8_WAIT_L(8); G8_BAR; G8_WAIT_L(0); G8_MMA(0, 0, At, B0); G8_BAR; G8_SCHED;
    G8_LDB(B1, 1, 1); G8_STAGE(G8_SB(1, 0), Bt, ldb, bcol, t + 3);
    G8_BAR; G8_WAIT_L(0); G8_MMA(0, 1, At, B1); G8_BAR;
    G8_LDA(At, 1, 1); G8_STAGE(G8_SA(1, 0), A, lda, brow, t + 3);
    G8_BAR; G8_WAIT_L(0); G8_MMA(1, 0, At, B0); G8_BAR; G8_SCHED;
    G8_STAGE(G8_SB(1, 1), Bt, ldb, bcol + 128, t + 3);
    G8_WAIT_V(6); G8_BAR; G8_MMA(1, 1, At, B1); G8_BAR;
  }
  { G8_LDB(B0, 0, 0); G8_LDA(At, 0, 0); G8_STAGE(G8_SA(1, 1), A, lda, brow + 128, nt - 1);
    G8_BAR; G8_WAIT_L(0); G8_MMA(0, 0, At, B0); G8_BAR;
    G8_LDB(B1, 0, 1); G8_BAR; G8_WAIT_L(0); G8_MMA(0, 1, At, B1); G8_BAR;
    G8_LDA(At, 0, 1); G8_WAIT_V(4); G8_BAR; G8_WAIT_L(0); G8_MMA(1, 0, At, B0); G8_MMA(1, 1, At, B1); G8_BAR; }
  { G8_LDB(B0, 1, 0); G8_LDA(At, 1, 0); G8_WAIT_V(2); G8_BAR; G8_WAIT_L(0); G8_MMA(0, 0, At, B0); G8_BAR;
    G8_LDB(B1, 1, 1); G8_WAIT_V(0); G8_BAR; G8_WAIT_L(0); G8_MMA(0, 1, At, B1); G8_BAR;
    G8_LDA(At, 1, 1); G8_BAR; G8_WAIT_L(0); G8_MMA(1, 0, At, B0); G8_MMA(1, 1, At, B1); G8_BAR; }
  if (has_next) {
    G8_STAGE(G8_SB(0, 0), Bt, ldb, nbcol, 0); G8_STAGE(G8_SA(0, 0), A, lda, nbrow, 0);
    G8_STAGE(G8_SB(0, 1), Bt, ldb, nbcol + 128, 0); G8_STAGE(G8_SA(0, 1), A, lda, nbrow + 128, 0);
  }
  if (wr == 0) G8_BAR;
  const bool odd = fq & 1;
#pragma unroll
  for (int ai = 0; ai < 2; ++ai)
#pragma unroll
    for (int bj = 0; bj < 2; ++bj)
#pragma unroll
      for (int m = 0; m < 4; ++m) {
        const int row = brow + ai * 128 + wr * 64 + m * 16 + fr, cb = bcol + bj * 128 + wc * 32;
        epi.side(row, cb + fq * 4, acc[ai][bj][m][0]);
        epi.side(row, cb + 16 + fq * 4, acc[ai][bj][m][1]);
        const u32x2 p0 = epi.pack(acc[ai][bj][m][0]), p1 = epi.pack(acc[ai][bj][m][1]);
        const u32x2 snd = odd ? p0 : p1;
        u32x2 rcv; rcv[0] = (unsigned)__shfl_xor((int)snd[0], 16); rcv[1] = (unsigned)__shfl_xor((int)snd[1], 16);
        u32x4 o;
        if (odd) { o[0] = rcv[0]; o[1] = rcv[1]; o[2] = p1[0]; o[3] = p1[1]; }
        else     { o[0] = p0[0]; o[1] = p0[1]; o[2] = rcv[0]; o[3] = rcv[1]; }
        epi.store16(row, odd ? cb + 16 + (fq - 1) * 4 : cb + fq * 4, o);
      }
  __syncthreads();
}

struct EpiBF {
  bf16_t* out; int ldo;
  DI void side(int, int, const f32x4&) const {}
  DI u32x2 pack(const f32x4& a) const { u32x2 o; o[0] = pack2(a[0], a[1]); o[1] = pack2(a[2], a[3]); return o; }
  DI void store16(int row, int col, const u32x4& v) const { *(u32x4*)(out + (size_t)row * ldo + col) = v; }
  DI float scale(int) const { return 1.f; }
  DI void operator()(int row, int col, const f32x4& a, float) const { (*this)(row, col, a); }
  DI void operator()(int row, int col, const f32x4& a) const {
    u32x2 o; o[0] = pack2(a[0], a[1]); o[1] = pack2(a[2], a[3]);
    *(u32x2*)(out + (size_t)row * ldo + col) = o;
  }
};
struct EpiRelu2 {
  bf16_t* out; int ldo;
  DI void side(int, int, const f32x4&) const {}
  DI u32x2 pack(const f32x4& a) const {
    float r0 = fmaxf(a[0], 0.f), r1 = fmaxf(a[1], 0.f), r2 = fmaxf(a[2], 0.f), r3 = fmaxf(a[3], 0.f);
    u32x2 o; o[0] = pack2(r0 * r0, r1 * r1); o[1] = pack2(r2 * r2, r3 * r3); return o;
  }
  DI void store16(int row, int col, const u32x4& v) const { *(u32x4*)(out + (size_t)row * ldo + col) = v; }
  DI void operator()(int row, int col, const f32x4& a) const {
    float r0 = fmaxf(a[0], 0.f), r1 = fmaxf(a[1], 0.f), r2 = fmaxf(a[2], 0.f), r3 = fmaxf(a[3], 0.f);
    u32x2 o; o[0] = pack2(r0 * r0, r1 * r1); o[1] = pack2(r2 * r2, r3 * r3);
    *(u32x2*)(out + (size_t)row * ldo + col) = o;
  }
};
struct EpiU {
  bf16_t* u; float* dt;
  DI void side(int row, int col, const f32x4& a) const { if (col >= U_DT && col < DIN) *(float4*)(dt + (size_t)row * 16 + col - U_DT) = make_float4(a[0], a[1], a[2], a[3]); }
  DI u32x2 pack(const f32x4& a) const { u32x2 o; o[0] = pack2(a[0], a[1]); o[1] = pack2(a[2], a[3]); return o; }
  DI void store16(int row, int col, const u32x4& v) const { if (col < DIN) *(u32x4*)(u + (size_t)row * DIN + col) = v; }
  DI void operator()(int row, int col, const f32x4& a) const {
    if (col < DIN) {
      u32x2 o; o[0] = pack2(a[0], a[1]); o[1] = pack2(a[2], a[3]);
      *(u32x2*)(u + (size_t)row * DIN + col) = o;
      if (col >= U_DT) *(float4*)(dt + (size_t)row * 16 + col - U_DT) = make_float4(a[0], a[1], a[2], a[3]);
    }
  }
};
struct EpiQ {
  bf16_t* q; const float* rs;
  DI float scale(int row) const { return rs[row * 2]; }
  DI void operator()(int row, int col, const f32x4& a, float r) const {
    u32x2 o; o[0] = pack2(a[0] * r, a[1] * r); o[1] = pack2(a[2] * r, a[3] * r);
    *(u32x2*)(q + (size_t)row * 384 + col) = o;
  }
};
struct EpiKV {
  bf16_t* kb; bf16_t* vt; const float* rs;
  DI float scale(int row) const { return rs[row * 2 + 1]; }
  DI void operator()(int row, int col, const f32x4& a, float r) const {
    int b, pos;
    if (row < ML) { b = row >> 12; pos = (row & 4095) + CTX; } else { int rr = row - ML; b = rr >> 8; pos = rr & 255; }
    const int head = col >> 7, d = col & 127;
    if (d < 64) {
      u32x2 o; o[0] = pack2(a[0] * r, a[1] * r); o[1] = pack2(a[2] * r, a[3] * r);
      *(u32x2*)(kb + ((size_t)(b * 4 + head) * LK + pos) * 96 + d) = o;
    } else {
#pragma unroll
      for (int j = 0; j < 4; ++j) vt[((size_t)(b * 4 + head) * 64 + (d - 64 + j)) * LK + pos] = f2bf(a[j] * r);
    }
  }
};

struct EpiPart {
  float* part;
  DI void operator()(int row, int col, const f32x4& a) const {
    *(float4*)(part + (size_t)(row - ML) * DM + col) = make_float4(a[0], a[1], a[2], a[3]);
  }
};
DI void phase_inproj(const Params& p, int layer, int bid, int nb, char* smem) {
  EpiU epi{(bf16_t*)(p.ws + OFF_U), (float*)(p.ws + OFF_DT)};
  const int x = bid & 7, per = nb >> 3;
  for (int rep = 0; rep < REP_GEMM; ++rep)
  for (int q = bid >> 3; q < 85; q += per) {
    const int m = (x >> 1) * 17 + q / 5, n = 5 * (x & 1) + q % 5;
    const int q2 = q + per, m2 = (x >> 1) * 17 + q2 / 5, n2 = 5 * (x & 1) + q2 % 5;
    gemm8_tile((const bf16_t*)(p.ws + OFF_H), DM, wt_ptr(p, layer, WT_IN), 1024, 1024, m * 256, n * 256, smem, epi,
               q == (bid >> 3), q2 < 85, m2 * 256, n2 * 256);
  }
}
DI void phase_wout(const Params& p, int layer, int lid, int nvb, char* smem) {
  const int M = layer == 0 ? MT : ML;
  EpiBF epi{(bf16_t*)(p.ws + OFF_U), DM};
  const int x = lid & 7, per = nvb >> 3;
  for (int rep = 0; rep < REP_GEMM; ++rep)
  for (int q = lid >> 3; q < M / 128; q += per)
    gemm_tile<true>((const bf16_t*)(p.ws + OFF_H), DM, wt_ptr(p, layer, WT_OUT), 1024, ((q >> 3) * 8 + x) * 128, (q & 7) * 128, smem, epi, (const float*)(p.ws + OFF_SSQ));
}
DI void phase_ff1(const Params& p, int layer, int bid, int nb, int vbid, int nvb, char* smem, char* smem_half) {
  EpiRelu2 epi{(bf16_t*)(p.ws + OFF_F1), DFF};
  const int x = bid & 7, per = nb >> 3;
  for (int rep = 0; rep < REP_GEMM; ++rep) {
    for (int q = bid >> 3; q < 128; q += per) {
      const int m = (x >> 2) * 32 + (q >> 2), n = 4 * (x & 3) + (q & 3);
      const int q2 = q + per, m2 = (x >> 2) * 32 + (q2 >> 2), n2 = 4 * (x & 3) + (q2 & 3);
      gemm8_tile((const bf16_t*)(p.ws + OFF_H), DM, wt_ptr(p, layer, WT_FF1), 1024, 1024, m * 256, n * 256, smem, epi,
                 q == (bid >> 3), q2 < 128, m2 * 256, n2 * 256);
    }
    if (layer == 0)
      for (int it = vbid; it < (MC / 128) * 32; it += nvb)
        gemm_tile_glds((const bf16_t*)(p.ws + OFF_H), DM, wt_ptr(p, layer, WT_FF1), 1024, 1024, ML + (it / 32) * 128, (it % 32) * 128, smem_half, epi);
  }
}
DI void phase_ff2(const Params& p, int layer, int bid, int nb, int vbid, int nvb, char* smem, char* smem_half) {
  EpiBF epi{(bf16_t*)(p.ws + OFF_H), DM};
  const int x = bid & 7, per = nb >> 3;
  for (int rep = 0; rep < REP_GEMM; ++rep) {
    for (int q = bid >> 3; q < 32; q += per) {
      const int T = x * 32 + q;
      gemm8_tile((const bf16_t*)(p.ws + OFF_F1), DFF, wt_ptr(p, layer, WT_FF2), 4096, 4096, (T >> 2) * 256, (T & 3) * 256, smem, epi);
    }
    if (layer == 0)
      for (int it = vbid; it < (MC / 128) * 8 * 4; it += nvb) {
        const int tile = it >> 2, ks = it & 3;
        EpiPart ep{(float*)(p.ws + OFF_END2) + (size_t)ks * MC * DM};
        gemm_tile_glds((const bf16_t*)(p.ws + OFF_F1) + ks * 1024, DFF, wt_ptr(p, layer, WT_FF2) + ks * 1024, 4096, 1024, ML + (tile >> 3) * 128, (tile & 7) * 128, smem_half, ep);
      }
  }
}

DI int chunk_row0(int b, int tc) { return tc < 2 ? ML + b * CTX + tc * 128 : b * SEQ + (tc - 2) * 128; }
constexpr int BST = 72;
constexpr int TST = 136;
DI void load_tile_T(bf16_t* dst, const bf16_t* __restrict__ src, int ldg) {
  const int tid = ltid();
#pragma unroll
  for (int i = 0; i < 4; ++i) {
    int c = tid + 256 * i, tok = c & 127, pc = c >> 7;
    u32x4 v = *(const u32x4*)(src + (size_t)tok * ldg + pc * 8);
#pragma unroll
    for (int j = 0; j < 4; ++j) {
      dst[(pc * 8 + 2 * j) * TST + tok] = (bf16_t)(v[j] & 0xffffu);
      dst[(pc * 8 + 2 * j + 1) * TST + tok] = (bf16_t)(v[j] >> 16);
    }
  }
}
DI void chunk_scan(const Params& p, int layer, int row0, int h, float* csf, float* csb, float* dtF, float* dtB, float* tot, float*  ) {
  const int tid = ltid(), w = tid >> 6, lane = tid & 63;
  const float* DT = (const float*)(p.ws + OFF_DT);
  float v;
  if (tid < 128) {
    const float dt = DT[(size_t)(row0 + tid) * 16 + h];
    v = dt * -__expf(p.a_log[layer * 16 + h]);
    dtF[tid] = dt;
  } else {
    const int e = 255 - tid;
    const float dt = DT[(size_t)(row0 + e) * 16 + 8 + h];
    v = dt * -__expf(p.a_log[layer * 16 + 8 + h]);
    dtB[e] = dt;
  }
#pragma unroll
  for (int o = 1; o < 64; o <<= 1) { const float t = __shfl_up(v, o); if (lane >= o) v += t; }
  if (lane == 63) tot[w] = v;
  __syncthreads();
  if (w == 1) v += tot[0];
  if (w == 3) v += tot[2];
  if (tid < 128) csf[tid] = v; else csb[255 - tid] = v;
  __syncthreads();
}

DI void ssd_state_item(const Params& p, int layer, int b, int tc, int h, char* smem) {
  bf16_t* XT = (bf16_t*)smem;
  bf16_t* BT = XT + 64 * TST;
  float* csf = (float*)(BT + 64 * TST);
  float* csb = csf + 128; float* dtF = csb + 128; float* dtB = dtF + 128; float* laF = dtB + 128; float* laB = laF + 128;
  const int tid = ltid(), w = tid >> 6, lane = tid & 63, r = lane & 31, hh = lane >> 5;
  const int row0 = chunk_row0(b, tc);
  const bf16_t* XBC = (const bf16_t*)(p.ws + OFF_XBC);
  load_tile_T(XT, XBC + (size_t)row0 * 768 + h * 64, 768);
  load_tile_T(BT, XBC + (size_t)row0 * 768 + 512 + (h >> 2) * 64, 768);
  chunk_scan(p, layer, row0, h, csf, csb, dtF, dtB, laF, laB);
  __syncthreads();
  if (tid < 128) laF[tid] = dtF[tid] * __expf(csf[127] - csf[tid]);
  else { int t = tid - 128; laB[t] = dtB[t] * __expf(csb[0] - csb[t]); }
  __syncthreads();
  const int d = w >> 1, pt = w & 1;
  const float* wv = d == 0 ? laF : laB;
  f32x16 acc[2];
#pragma unroll
  for (int i = 0; i < 16; ++i) { acc[0][i] = 0.f; acc[1][i] = 0.f; }
#pragma unroll
  for (int s = 0; s < 8; ++s) {
    int l0 = 16 * s + 8 * hh;
    u32x4 xa = *(const u32x4*)(XT + (32 * pt + r) * TST + l0);
    u32x4 sa;
#pragma unroll
    for (int j = 0; j < 4; ++j) sa[j] = pack2(lo2f(xa[j]) * wv[l0 + 2 * j], hi2f(xa[j]) * wv[l0 + 2 * j + 1]);
    bf16x8 af = __builtin_bit_cast(bf16x8, sa);
#pragma unroll
    for (int nt = 0; nt < 2; ++nt) {
      bf16x8 bfr = *(const bf16x8*)(BT + (32 * nt + r) * TST + l0);
      acc[nt] = MFMA32(af, bfr, acc[nt]);
    }
  }
  bf16_t* S = (bf16_t*)(p.ws + OFF_SST) + ((((size_t)d * NB + b) * NCH + tc) * 8 + h) * 4096;
#pragma unroll
  for (int nt = 0; nt < 2; ++nt)
#pragma unroll
    for (int i = 0; i < 16; ++i) S[(32 * pt + crow(i, hh)) * 64 + 32 * nt + r] = f2bf(acc[nt][i]);
  if (tid == 0) {
    float* TD = (float*)(p.ws + OFF_TDEC);
    TD[((0 * NB + b) * NCH + tc) * 8 + h] = __expf(csf[127]);
    TD[((1 * NB + b) * NCH + tc) * 8 + h] = __expf(csb[0]);
  }
  __syncthreads();
}

DI void ssd_pass_item(const Params& p, int it) {
  const int e = it * 256 + ltid();
  const int pn2 = e & 2047, h = (e >> 11) & 7, b = (e >> 14) & 3, d = e >> 16;
  unsigned* S = (unsigned*)(p.ws + OFF_SST);
  const float* TD = (const float*)(p.ws + OFF_TDEC);
  unsigned sv[NCH]; float T[NCH];
#pragma unroll
  for (int i = 0; i < NCH; ++i) {
    int tc = d == 0 ? i : (i < 2 ? 1 - i : NCH + 1 - i);
    sv[i] = S[(((size_t)(d * NB + b) * NCH + tc) * 8 + h) * 2048 + pn2];
    T[i] = TD[((d * NB + b) * NCH + tc) * 8 + h];
  }
  float h0 = 0.f, h1 = 0.f;
#pragma unroll
  for (int i = 0; i < NCH; ++i) {
    int tc = d == 0 ? i : (i < 2 ? 1 - i : NCH + 1 - i);
    S[(((size_t)(d * NB + b) * NCH + tc) * 8 + h) * 2048 + pn2] = pack2(h0, h1);
    h0 = T[i] * h0 + lo2f(sv[i]); h1 = T[i] * h1 + hi2f(sv[i]);
  }
}

DI void ssd_out_item(const Params& p, int layer, int b, int tc, int h, char* smem) {
  bf16_t* XT = (bf16_t*)smem;
  bf16_t* Bs = XT + 64 * TST;
  float* csf = (float*)(Bs + 128 * BST);
  float* csb = csf + 128; float* dtF = csb + 128; float* dtB = dtF + 128; float* laF = dtB + 128; float* laB = laF + 128;
  const int tid = ltid(), w = tid >> 6, lane = tid & 63, r = lane & 31, hh = lane >> 5;
  const int row0 = chunk_row0(b, tc), g = h >> 2;
  const bf16_t* XBC = (const bf16_t*)(p.ws + OFF_XBC);
  load_tile_T(XT, XBC + (size_t)row0 * 768 + h * 64, 768);
#pragma unroll
  for (int i = 0; i < 4; ++i) {
    int c = tid + 256 * i, tok = c >> 3, part = c & 7;
    *(u32x4*)(Bs + tok * BST + part * 8) = *(const u32x4*)(XBC + (size_t)(row0 + tok) * 768 + 512 + g * 64 + part * 8);
  }
  const int l = 32 * w + r;
  bf16x8 cf[4];
#pragma unroll
  for (int ks = 0; ks < 4; ++ks) cf[ks] = *(const bf16x8*)(XBC + (size_t)(row0 + l) * 768 + 640 + g * 64 + 16 * ks + 8 * hh);
  chunk_scan(p, layer, row0, h, csf, csb, dtF, dtB, laF, laB);
  const float csf_l = csf[l], csb_l = csb[l];
  f32x16 yacc[2];
#pragma unroll
  for (int i = 0; i < 16; ++i) { yacc[0][i] = 0.f; yacc[1][i] = 0.f; }
#pragma unroll
  for (int st = 0; st < 4; ++st) {
    f32x16 gacc;
#pragma unroll
    for (int i = 0; i < 16; ++i) gacc[i] = 0.f;
#pragma unroll
    for (int ks = 0; ks < 4; ++ks) {
      bf16x8 af = *(const bf16x8*)(Bs + (32 * st + r) * BST + 16 * ks + 8 * hh);
      gacc = MFMA32(af, cf[ks], gacc);
    }
#pragma unroll
    for (int i = 0; i < 16; ++i) {
      int s = 32 * st + crow(i, hh);
      float f;
      if (s < l) f = __expf(csf_l - csf[s]) * dtF[s];
      else if (s > l) f = __expf(csb_l - csb[s]) * dtB[s];
      else f = dtF[s] + dtB[s];
      gacc[i] *= f;
    }
#pragma unroll
    for (int s2 = 0; s2 < 2; ++s2) {
      bf16x8 mf = pack8(gacc, s2);
      int sb = 32 * st + 16 * s2 + 4 * hh;
#pragma unroll
      for (int pt = 0; pt < 2; ++pt) {
        u32x2 lo = *(const u32x2*)(XT + (32 * pt + r) * TST + sb);
        u32x2 hi = *(const u32x2*)(XT + (32 * pt + r) * TST + sb + 8);
        u32x4 xa; xa[0] = lo[0]; xa[1] = lo[1]; xa[2] = hi[0]; xa[3] = hi[1];
        yacc[pt] = MFMA32(__builtin_bit_cast(bf16x8, xa), mf, yacc[pt]);
      }
    }
  }
#pragma unroll
  for (int d = 0; d < 2; ++d) {
    const bf16_t* Hs = (const bf16_t*)(p.ws + OFF_SST) + ((((size_t)d * NB + b) * NCH + tc) * 8 + h) * 4096;
    const float e = __expf(d == 0 ? csf_l : csb_l);
#pragma unroll
    for (int pt = 0; pt < 2; ++pt) {
      f32x16 t;
#pragma unroll
      for (int i = 0; i < 16; ++i) t[i] = 0.f;
#pragma unroll
      for (int ks = 0; ks < 4; ++ks) {
        bf16x8 af = *(const bf16x8*)(Hs + (32 * pt + r) * 64 + 16 * ks + 8 * hh);
        t = MFMA32(af, cf[ks], t);
      }
#pragma unroll
      for (int i = 0; i < 16; ++i) yacc[pt][i] += e * t[i];
    }
  }
  const int row = row0 + l;
  const float Dh = p.ssd_d[layer * 8 + h];
  const bf16_t* U = (const bf16_t*)(p.ws + OFF_U);
  bf16_t* YM = (bf16_t*)(p.ws + OFF_H);
  float ssq = 0.f;
  u32x2 xvv[2][4], zvv[2][4];
#pragma unroll
  for (int pt = 0; pt < 2; ++pt)
#pragma unroll
    for (int q = 0; q < 4; ++q) {
      const int pp = 32 * pt + 8 * q + 4 * hh;
      xvv[pt][q] = *(const u32x2*)(XBC + (size_t)row * 768 + h * 64 + pp);
      zvv[pt][q] = *(const u32x2*)(U + (size_t)row * DIN + U_Z + h * 64 + pp);
    }
#pragma unroll
  for (int pt = 0; pt < 2; ++pt)
#pragma unroll
    for (int q = 0; q < 4; ++q) {
      const int pp = 32 * pt + 8 * q + 4 * hh;
      const u32x2 xv = xvv[pt][q], zv = zvv[pt][q];
      float y0 = (yacc[pt][4 * q + 0] + Dh * lo2f(xv[0])) * silu_f(lo2f(zv[0]));
      float y1 = (yacc[pt][4 * q + 1] + Dh * hi2f(xv[0])) * silu_f(hi2f(zv[0]));
      float y2 = (yacc[pt][4 * q + 2] + Dh * lo2f(xv[1])) * silu_f(lo2f(zv[1]));
      float y3 = (yacc[pt][4 * q + 3] + Dh * hi2f(xv[1])) * silu_f(hi2f(zv[1]));
      u32x2 o; o[0] = pack2(y0, y1); o[1] = pack2(y2, y3);
      float r0 = lo2f(o[0]), r1 = hi2f(o[0]), r2 = lo2f(o[1]), r3 = hi2f(o[1]);
      ssq += r0 * r0 + r1 * r1 + r2 * r2 + r3 * r3;
      *(u32x2*)(YM + (size_t)row * DM + 512 + h * 64 + pp) = o;
    }
  ssq += __shfl_xor(ssq, 32);
  if (hh == 0) ((float*)(p.ws + OFF_SSQ))[(size_t)row * 8 + h] = ssq;
  __syncthreads();
}

constexpr int KST = 104;
constexpr int VST = 68;
constexpr int ASTG = 64 * KST + 64 * VST;
DI void attn_item(const Params& p, int b, int head, int qrow0, int t0, bool lat, int nkeys, char* smem) {
  bf16_t* Ks = (bf16_t*)smem;
  bf16_t* Vs = Ks + 64 * KST;
  const int tid = ltid(), w = tid >> 6, lane = tid & 63, r = lane & 31, hh = lane >> 5;
  const bf16_t* QB = (const bf16_t*)(p.ws + OFF_QB);
  const bf16_t* KB = (const bf16_t*)(p.ws + OFF_KB) + (size_t)(b * 4 + head) * LK * 96;
  const bf16_t* VT = (const bf16_t*)(p.ws + OFF_VT) + (size_t)(b * 4 + head) * 64 * LK;
  const float qscale = 0.10206207261596575f * 1.4426950408889634f;
  const int qrow = qrow0 + w * 32 + r;
  const int t = t0 + w * 32 + r;
  bf16x8 qf[6];
  {
    const bf16_t* src = QB + (size_t)qrow * 384 + head * 96;
#pragma unroll
    for (int s = 0; s < 4; ++s) {
      u32x4 v = *(const u32x4*)(src + 16 * s + 8 * hh);
      u32x4 o;
#pragma unroll
      for (int j = 0; j < 4; ++j) o[j] = pack2(lo2f(v[j]) * qscale, hi2f(v[j]) * qscale);
      qf[s] = __builtin_bit_cast(bf16x8, o);
    }
#pragma unroll
    for (int s = 4; s < 6; ++s) {
      u32x4 va = *(const u32x4*)(src + 16 * s), vb = *(const u32x4*)(src + 16 * s + 8);
      float posf = s == 4 ? (float)(t >> 6) : (float)(t & 63);
      float o[8];
#pragma unroll
      for (int j = 0; j < 8; ++j) {
        float a = (j & 1) ? hi2f(va[j >> 1]) : lo2f(va[j >> 1]);
        float bb = (j & 1) ? hi2f(vb[j >> 1]) : lo2f(vb[j >> 1]);
        float res;
        if (lat) {
          float invf = exp2f(-(float)(2 * j) * (13.287712379549449f / 16.f));
          float rev = posf * invf * 0.15915494309189535f;
          float cs = __builtin_amdgcn_cosf(rev), sn = __builtin_amdgcn_sinf(rev);
          res = hh == 0 ? a * cs - bb * sn : bb * cs + a * sn;
        } else res = hh == 0 ? a : bb;
        o[j] = res * qscale;
      }
      u32x4 ov; ov[0] = pack2(o[0], o[1]); ov[1] = pack2(o[2], o[3]); ov[2] = pack2(o[4], o[5]); ov[3] = pack2(o[6], o[7]);
      qf[s] = __builtin_bit_cast(bf16x8, ov);
    }
  }
  f32x16 oacc[2];
#pragma unroll
  for (int i = 0; i < 16; ++i) { oacc[0][i] = 0.f; oacc[1][i] = 0.f; }
  float m = -1e30f, lsum = 0.f;
  u32x4 rk[3], rv[2];
  auto gload = [&](int key0) {
#pragma unroll
    for (int i = 0; i < 3; ++i) rk[i] = *(const u32x4*)(KB + (size_t)key0 * 96 + (tid + 256 * i) * 8);
#pragma unroll
    for (int i = 0; i < 2; ++i) { int c = tid + 256 * i; rv[i] = *(const u32x4*)(VT + (size_t)(c >> 3) * LK + key0 + (c & 7) * 8); }
  };
  gload(0);
  const int NT = nkeys / 64;
  for (int kt = 0; kt < NT; ++kt) {
#pragma unroll
    for (int i = 0; i < 3; ++i) { int c = tid + 256 * i; *(u32x4*)(Ks + (c / 12) * KST + (c % 12) * 8) = rk[i]; }
#pragma unroll
    for (int i = 0; i < 2; ++i) {
      int c = tid + 256 * i;
      bf16_t* d = Vs + (c >> 3) * VST + (c & 7) * 8;
      u32x2 a; a[0] = rv[i][0]; a[1] = rv[i][1];
      u32x2 bq; bq[0] = rv[i][2]; bq[1] = rv[i][3];
      *(u32x2*)d = a; *(u32x2*)(d + 4) = bq;
    }
    __syncthreads();
    if (kt + 1 < NT) gload((kt + 1) * 64);
    f32x16 sacc[2];
#pragma unroll
    for (int i = 0; i < 16; ++i) { sacc[0][i] = 0.f; sacc[1][i] = 0.f; }
#pragma unroll
    for (int s = 0; s < 6; ++s)
#pragma unroll
      for (int k2 = 0; k2 < 2; ++k2) {
        bf16x8 af = *(const bf16x8*)(Ks + (32 * k2 + r) * KST + 16 * s + 8 * hh);
        sacc[k2] = MFMA32(af, qf[s], sacc[k2]);
      }
    float mx = sacc[0][0];
#pragma unroll
    for (int i = 0; i < 16; ++i) { mx = fmaxf(mx, sacc[0][i]); mx = fmaxf(mx, sacc[1][i]); }
    mx = fmaxf(mx, __shfl_xor(mx, 32));
    const float mn = fmaxf(m, mx);
    const float alpha = __builtin_amdgcn_exp2f(m - mn);
    m = mn;
    float ps = 0.f;
#pragma unroll
    for (int i = 0; i < 16; ++i) {
      sacc[0][i] = __builtin_amdgcn_exp2f(sacc[0][i] - mn); sacc[1][i] = __builtin_amdgcn_exp2f(sacc[1][i] - mn);
      ps += sacc[0][i] + sacc[1][i];
    }
    lsum = lsum * alpha + ps;
#pragma unroll
    for (int i = 0; i < 16; ++i) { oacc[0][i] *= alpha; oacc[1][i] *= alpha; }
#pragma unroll
    for (int k2 = 0; k2 < 2; ++k2)
#pragma unroll
      for (int s2 = 0; s2 < 2; ++s2) {
        bf16x8 pf = pack8(sacc[k2], s2);
        int kb0 = 32 * k2 + 16 * s2 + 4 * hh;
#pragma unroll
        for (int d = 0; d < 2; ++d) {
          u32x2 lo = *(const u32x2*)(Vs + (32 * d + r) * VST + kb0);
          u32x2 hi = *(const u32x2*)(Vs + (32 * d + r) * VST + kb0 + 8);
          u32x4 va; va[0] = lo[0]; va[1] = lo[1]; va[2] = hi[0]; va[3] = hi[1];
          oacc[d] = MFMA32(__builtin_bit_cast(bf16x8, va), pf, oacc[d]);
        }
      }
    __syncthreads();
  }
  lsum += __shfl_xor(lsum, 32);
  const float inv = 1.f / lsum;
  bf16_t* YM = (bf16_t*)(p.ws + OFF_H) + (size_t)qrow * DM + head * 64;
#pragma unroll
  for (int d = 0; d < 2; ++d)
#pragma unroll
    for (int q = 0; q < 4; ++q) {
      u32x2 o; o[0] = pack2(oacc[d][4 * q] * inv, oacc[d][4 * q + 1] * inv); o[1] = pack2(oacc[d][4 * q + 2] * inv, oacc[d][4 * q + 3] * inv);
      *(u32x2*)(YM + 32 * d + 8 * q + 4 * hh) = o;
    }
}

DI void attn_item8(const Params& p, int b, int head, int qrow0, int t0, bool lat, int nkeys, char* smem) {
  bf16_t* Ks = (bf16_t*)smem;
  bf16_t* Vs = Ks + 64 * KST;
  const int tid = ltid512(), w = tid >> 6, lane = tid & 63, r = lane & 31, hh = lane >> 5;
  const bf16_t* QB = (const bf16_t*)(p.ws + OFF_QB);
  const bf16_t* KB = (const bf16_t*)(p.ws + OFF_KB) + (size_t)(b * 4 + head) * LK * 96;
  const bf16_t* VT = (const bf16_t*)(p.ws + OFF_VT) + (size_t)(b * 4 + head) * 64 * LK;
  const float qscale = 0.10206207261596575f * 1.4426950408889634f;
  const int qrow = qrow0 + w * 32 + r;
  const int t = t0 + w * 32 + r;
  bf16x8 qf[6];
  {
    const bf16_t* src = QB + (size_t)qrow * 384 + head * 96;
#pragma unroll
    for (int s = 0; s < 4; ++s) {
      u32x4 v = *(const u32x4*)(src + 16 * s + 8 * hh);
      u32x4 o;
#pragma unroll
      for (int j = 0; j < 4; ++j) o[j] = pack2(lo2f(v[j]) * qscale, hi2f(v[j]) * qscale);
      qf[s] = __builtin_bit_cast(bf16x8, o);
    }
#pragma unroll
    for (int s = 4; s < 6; ++s) {
      u32x4 va = *(const u32x4*)(src + 16 * s), vb = *(const u32x4*)(src + 16 * s + 8);
      float posf = s == 4 ? (float)(t >> 6) : (float)(t & 63);
      float o[8];
#pragma unroll
      for (int j = 0; j < 8; ++j) {
        float a = (j & 1) ? hi2f(va[j >> 1]) : lo2f(va[j >> 1]);
        float bb = (j & 1) ? hi2f(vb[j >> 1]) : lo2f(vb[j >> 1]);
        float res;
        if (lat) {
          float invf = exp2f(-(float)(2 * j) * (13.287712379549449f / 16.f));
          float rev = posf * invf * 0.15915494309189535f;
          float cs = __builtin_amdgcn_cosf(rev), sn = __builtin_amdgcn_sinf(rev);
          res = hh == 0 ? a * cs - bb * sn : bb * cs + a * sn;
        } else res = hh == 0 ? a : bb;
        o[j] = res * qscale;
      }
      u32x4 ov; ov[0] = pack2(o[0], o[1]); ov[1] = pack2(o[2], o[3]); ov[2] = pack2(o[4], o[5]); ov[3] = pack2(o[6], o[7]);
      qf[s] = __builtin_bit_cast(bf16x8, ov);
    }
  }
  f32x16 oacc[2];
#pragma unroll
  for (int i = 0; i < 16; ++i) { oacc[0][i] = 0.f; oacc[1][i] = 0.f; }
  float m = -1e30f, lsum = 0.f;
  u32x4 rk[2], rv;
  auto gload = [&](int key0) {
    rk[0] = *(const u32x4*)(KB + (size_t)key0 * 96 + tid * 8);
    if (tid < 256) rk[1] = *(const u32x4*)(KB + (size_t)key0 * 96 + (512 + tid) * 8);
    rv = *(const u32x4*)(VT + (size_t)(tid >> 3) * LK + key0 + (tid & 7) * 8);
  };
  const int kro = (tid / 12) * KST + (tid % 12) * 8, kro2 = ((512 + tid) / 12) * KST + ((512 + tid) % 12) * 8;
  auto swrite = [&](int stage) {
    bf16_t* Kd = Ks + stage * ASTG;
    *(u32x4*)(Kd + kro) = rk[0];
    if (tid < 256) *(u32x4*)(Kd + kro2) = rk[1];
    bf16_t* d = Kd + 64 * KST + (tid >> 3) * VST + (tid & 7) * 8;
    u32x2 a; a[0] = rv[0]; a[1] = rv[1];
    u32x2 bq; bq[0] = rv[2]; bq[1] = rv[3];
    *(u32x2*)d = a; *(u32x2*)(d + 4) = bq;
  };
  auto qk = [&](int stage, f32x16 (&sa)[2]) {
    const bf16_t* Kc = Ks + stage * ASTG;
#pragma unroll
    for (int i = 0; i < 16; ++i) { sa[0][i] = 0.f; sa[1][i] = 0.f; }
#pragma unroll
    for (int s = 0; s < 6; ++s)
#pragma unroll
      for (int k2 = 0; k2 < 2; ++k2) {
        bf16x8 af = *(const bf16x8*)(Kc + (32 * k2 + r) * KST + 16 * s + 8 * hh);
        sa[k2] = MFMA32(af, qf[s], sa[k2]);
      }
  };
  const int NT = nkeys / 64;
  f32x16 sacc[2], snext[2];
  gload(0); swrite(0);
  gload(64);
  __syncthreads();
  swrite(1);
  gload(128);
  qk(0, sacc);
  __syncthreads();
  int cur = 0, nxt = 1, nn = 2;
  for (int kt = 0; kt < NT; ++kt) {
    if (kt + 1 < NT) qk(nxt, snext);
    if (kt + 2 < NT) {
      swrite(nn);
      if (kt + 3 < NT) gload((kt + 3) * 64);
    }
    const bf16_t* Vc = Ks + cur * ASTG + 64 * KST;
    float mx = sacc[0][0];
#pragma unroll
    for (int i = 0; i < 16; ++i) { mx = fmaxf(mx, sacc[0][i]); mx = fmaxf(mx, sacc[1][i]); }
    mx = fmaxf(mx, __shfl_xor(mx, 32));
    const float mn = fmaxf(m, mx);
    const float alpha = __builtin_amdgcn_exp2f(m - mn);
    m = mn;
    float ps = 0.f;
#pragma unroll
    for (int i = 0; i < 16; ++i) {
      sacc[0][i] = __builtin_amdgcn_exp2f(sacc[0][i] - mn); sacc[1][i] = __builtin_amdgcn_exp2f(sacc[1][i] - mn);
      ps += sacc[0][i] + sacc[1][i];
    }
    lsum = lsum * alpha + ps;
#pragma unroll
    for (int i = 0; i < 16; ++i) { oacc[0][i] *= alpha; oacc[1][i] *= alpha; }
#pragma unroll
    for (int k2 = 0; k2 < 2; ++k2)
#pragma unroll
      for (int s2 = 0; s2 < 2; ++s2) {
        bf16x8 pf = pack8(sacc[k2], s2);
        int kb0 = 32 * k2 + 16 * s2 + 4 * hh;
#pragma unroll
        for (int d = 0; d < 2; ++d) {
          u32x2 lo = *(const u32x2*)(Vc + (32 * d + r) * VST + kb0);
          u32x2 hi = *(const u32x2*)(Vc + (32 * d + r) * VST + kb0 + 8);
          u32x4 va; va[0] = lo[0]; va[1] = lo[1]; va[2] = hi[0]; va[3] = hi[1];
          oacc[d] = MFMA32(__builtin_bit_cast(bf16x8, va), pf, oacc[d]);
        }
      }
    sacc[0] = snext[0]; sacc[1] = snext[1];
    const int t3 = cur; cur = nxt; nxt = nn; nn = t3;
    __syncthreads();
  }
  lsum += __shfl_xor(lsum, 32);
  const float inv = 1.f / lsum;
  bf16_t* YM = (bf16_t*)(p.ws + OFF_H) + (size_t)qrow * DM + head * 64;
#pragma unroll
  for (int d = 0; d < 2; ++d)
#pragma unroll
    for (int q = 0; q < 4; ++q) {
      u32x2 o; o[0] = pack2(oacc[d][4 * q] * inv, oacc[d][4 * q + 1] * inv); o[1] = pack2(oacc[d][4 * q + 2] * inv, oacc[d][4 * q + 3] * inv);
      *(u32x2*)(YM + 32 * d + 8 * q + 4 * hh) = o;
    }
}

DI void phase_qkv(const Params& p, int layer, int bid, int nb, char* smem) {
  const int MQ = layer == 0 ? MT : ML;
  const int nq = (MQ / 128) * 3, nkv = (MT / 128) * 4, nst = NB * NCH * 8;
  const float* RS = (const float*)(p.ws + OFF_RSTD);
  EpiQ eq{(bf16_t*)(p.ws + OFF_QB), RS};
  EpiKV ekv{(bf16_t*)(p.ws + OFF_KB), (bf16_t*)(p.ws + OFF_VT), RS};
  const bf16_t* U = (const bf16_t*)(p.ws + OFF_U);
  for (int it = bid; it < nq + nkv + nst; it += nb) {
    if (it < nq) gemm_tile<false>(U, DIN, wt_ptr(p, layer, WT_UQ), 256, (it / 3) * 128, (it % 3) * 128, smem, eq);
    else if (it < nq + nkv) { int j = it - nq; gemm_tile<false>(U + U_CKV, DIN, wt_ptr(p, layer, WT_UKV), 128, (j / 4) * 128, (j % 4) * 128, smem, ekv); }
    else { int j = it - nq - nkv; for (int rep = 0; rep < REP_SSD; ++rep) ssd_state_item(p, layer, j / (NCH * 8), (j / 8) % NCH, j & 7, smem); }
  }
}
DI void phase_att(const Params& p, int layer, int bid, int nb, int vbid, int nvb, char* smem, char* sh) {
  for (int it = bid; it < 256; it += nb) {
    const int x = it & 7, j = it >> 3, bh = 2 * x + (j >> 4), qb = j & 15, b = bh >> 2, head = bh & 3;
    for (int rep = 0; rep < REP_ATT; ++rep) attn_item8(p, b, head, b * SEQ + qb * 256, qb * 256, true, LK, smem);
  }
  const int nctx = layer == 0 ? 32 : 0, npass = 512;
  for (int it = vbid; it < nctx + npass; it += nvb) {
    if (it < nctx) { int b = it >> 3, head = (it >> 1) & 3, qb = it & 1; attn_item(p, b, head, ML + b * CTX + qb * 128, qb * 128, false, CTX, sh); }
    else ssd_pass_item(p, it - nctx);
  }
}
DI void phase_ssdout(const Params& p, int layer, int bid, int nb, char* smem) {
  for (int it = bid; it < NB * NCH * 8; it += nb) {
    int b = it / (NCH * 8), tc = (it / 8) % NCH, h = it & 7;
    if (layer == 1 && tc < 2) continue;
    for (int rep = 0; rep < REP_SSD; ++rep) ssd_out_item(p, layer, b, tc, h, smem);
  }
}


#define XB_TMO      128
#define XB_XCNT(j)  (256  + 64 * (j))
#define XB_XSUB(j)  (1280 + 64 * (j))
#define XB_XGEN(j)  (2304 + 64 * (j))
#define XB_TOP      3328
#define XB_TOPGEN   3392
#define XCD_BAR_WORDS 3456
#define XB_SPIN_CAP (1u << 22)
#define LAS __attribute__((address_space(3)))
DI unsigned xb_ld(unsigned* p) { return __hip_atomic_load(p, __ATOMIC_RELAXED, __HIP_MEMORY_SCOPE_AGENT); }
DI unsigned xb_add(unsigned* p, unsigned v) { return __hip_atomic_fetch_add(p, v, __ATOMIC_RELAXED, __HIP_MEMORY_SCOPE_AGENT); }
DI unsigned xb_xcc_id() { return (unsigned)__builtin_amdgcn_s_getreg((3 << 11) | 20) & 0xFu; }
#define XB_SPIN(cond, bar) do { unsigned _sp = 0; while (cond) { __builtin_amdgcn_s_sleep(1); \
    if ((++_sp & 255u) == 0u) { if (xb_ld(&(bar)[XB_TMO])) break; if (_sp > XB_SPIN_CAP) { atomicAdd(&(bar)[XB_TMO], 1u); break; } } } } while (0)
struct XcdBarrier { unsigned* bar; unsigned x; volatile LAS unsigned* st; };
DI XcdBarrier xcd_barrier_post(unsigned* bar, volatile LAS unsigned* st) {
  XcdBarrier b; b.bar = bar; b.x = xb_xcc_id(); b.st = st;
  if (threadIdx.x == 0) (void)xb_add(&bar[XB_XCNT(b.x)], 1u);
  return b;
}
DI void xcd_barrier_complete(unsigned* bar, unsigned x, unsigned& nloc, unsigned& nx) {
  const unsigned G = gridDim.x * gridDim.y * gridDim.z;
  unsigned sum, cnt, mine, sp = 0u;
  for (;;) {
    sum = 0u; cnt = 0u; mine = 0u;
#pragma unroll
    for (unsigned j = 0; j < 16; ++j) { const unsigned c = xb_ld(&bar[XB_XCNT(j)]); sum += c; cnt += (c > 0u) ? 1u : 0u; mine = (j == x) ? c : mine; }
    if (sum == G) break;
    __builtin_amdgcn_s_sleep(1);
    if ((++sp & 255u) == 0u) { if (xb_ld(&bar[XB_TMO])) break; if (sp > XB_SPIN_CAP) { atomicAdd(&bar[XB_TMO], 1u); break; } }
  }
  nloc = mine > 0u ? mine : 1u; nx = cnt > 0u ? cnt : 1u;
}
DI void xcd_barrier(const XcdBarrier& b) {
  asm volatile("s_waitcnt vmcnt(0)" ::: "memory");
  __syncthreads();
  if (threadIdx.x == 0) {
    unsigned* bar = b.bar;
    asm volatile("" : "+s"(bar));
    __builtin_amdgcn_s_waitcnt(0);
    unsigned nloc = b.st[0], nx = b.st[1];
    if (nloc == 0u) { xcd_barrier_complete(bar, b.x, nloc, nx); b.st[0] = nloc; b.st[1] = nx; }
    const unsigned old = xb_add(&bar[XB_XSUB(b.x)], 1u);
    const unsigned gen = old / nloc;
    if (old + 1u == (gen + 1u) * nloc) {
      __builtin_amdgcn_fence(__ATOMIC_RELEASE, "agent");
      asm volatile("s_waitcnt vmcnt(0)" ::: "memory");
      const unsigned og = xb_add(&bar[XB_TOP], 1u);
      const unsigned tg = og / nx;
      if (og + 1u == (tg + 1u) * nx) xb_add(&bar[XB_TOPGEN], 1u);
      else XB_SPIN(xb_ld(&bar[XB_TOPGEN]) == tg, bar);
      __builtin_amdgcn_fence(__ATOMIC_ACQUIRE, "agent");
      xb_add(&bar[XB_XGEN(b.x)], 1u);
      asm volatile("s_waitcnt vmcnt(0)" ::: "memory");
    } else {
      XB_SPIN(xb_ld(&bar[XB_XGEN(b.x)]) == gen, bar);
      __builtin_amdgcn_fence(__ATOMIC_ACQUIRE, "agent");
      asm volatile("s_waitcnt vmcnt(0)" ::: "memory");
    }
  }
  __syncthreads();
}

constexpr int SMEM_BYTES = 2 * GBUF * 2;
enum { PH_PREP0 = 0, PH_H0, PH_INPROJ, PH_PREP, PH_QKV, PH_ATT, PH_SSDOUT, PH_WOUT, PH_POSTMIX, PH_FF1, PH_FF2, PH_POSTFFN, PH_SSDNORM };

struct Ids { int bid, nb, vbid, nvb, lid; };
DI void run_phase(const Params& p, int ph, int layer, const Ids& id, char* smem, char* sh) {
  switch (ph) {
    case PH_PREP0: phase_prep0(p, id.vbid, id.nvb, sh); break;
    case PH_H0: phase_h0(p, id.vbid, id.nvb); break;
    case PH_INPROJ: phase_inproj(p, layer, id.bid, id.nb, smem); break;
    case PH_PREP: phase_prep(p, layer, id.vbid, id.nvb); break;
    case PH_QKV: phase_qkv(p, layer, id.vbid, id.nvb, sh); break;
    case PH_ATT: phase_att(p, layer, id.bid, id.nb, id.vbid, id.nvb, smem, sh); break;
    case PH_SSDOUT: phase_ssdout(p, layer, id.vbid, id.nvb, sh); break;
    case PH_WOUT: phase_wout(p, layer, id.lid, id.nvb, sh); break;
    case PH_POSTMIX: phase_postmix(p, layer, id.vbid, id.nvb); break;
    case PH_FF1: phase_ff1(p, layer, id.bid, id.nb, id.vbid, id.nvb, smem, sh); break;
    case PH_FF2: phase_ff2(p, layer, id.bid, id.nb, id.vbid, id.nvb, smem, sh); break;
    case PH_POSTFFN: phase_postffn(p, layer, id.vbid, id.nvb); break;
  }
}

__global__ void __launch_bounds__(512) mega_kernel(Params p) {
  extern __shared__ __attribute__((aligned(16))) char smem[];
  cg::grid_group grid = cg::this_grid();
  if (p.ws == nullptr) grid.sync();
  const int half = __builtin_amdgcn_readfirstlane((int)(threadIdx.x >> 8));
  Ids id;
  id.bid = blockIdx.x; id.nb = gridDim.x;
  id.vbid = 2 * id.bid + half; id.nvb = 2 * id.nb;
  id.lid = (id.bid & 7) + 8 * (2 * (id.bid >> 3) + half);
  char* sh = smem + half * SMEM_BYTES;
  volatile LAS unsigned* st = (volatile LAS unsigned*)(smem + 2 * SMEM_BYTES - 16);
  if (threadIdx.x == 0) { st[0] = 0u; st[1] = 0u; st[2] = 0u; st[3] = 0u; }
  __syncthreads();
  XcdBarrier xb = xcd_barrier_post((unsigned*)(p.ws + OFF_BAR), st);
#define MK_STEP(PH, LAYER, LAST) do { \
    typedef const void* __attribute__((address_space(4))) * KArgs; \
    KArgs ka = (KArgs)__builtin_amdgcn_kernarg_segment_ptr(); \
    asm volatile("" : "+s"(ka)); \
    Params q; \
    { const void** dst = (const void**)&q; _Pragma("unroll") for (int i = 0; i < 27; ++i) dst[i] = ka[i]; } \
    run_phase(q, PH, LAYER, id, smem, sh); \
    if (!(LAST)) xcd_barrier(xb); } while (0)
  MK_STEP(PH_PREP0, 0, false);
  MK_STEP(PH_H0, 0, false);
  MK_STEP(PH_INPROJ, 0, false); MK_STEP(PH_PREP, 0, false); MK_STEP(PH_QKV, 0, false); MK_STEP(PH_ATT, 0, false); MK_STEP(PH_SSDOUT, 0, false);
  MK_STEP(PH_WOUT, 0, false); MK_STEP(PH_POSTMIX, 0, false); MK_STEP(PH_FF1, 0, false); MK_STEP(PH_FF2, 0, false); MK_STEP(PH_POSTFFN, 0, false);
  MK_STEP(PH_INPROJ, 1, false); MK_STEP(PH_PREP, 1, false); MK_STEP(PH_QKV, 1, false); MK_STEP(PH_ATT, 1, false); MK_STEP(PH_SSDOUT, 1, false);
  MK_STEP(PH_WOUT, 1, false); MK_STEP(PH_POSTMIX, 1, false); MK_STEP(PH_FF1, 1, false); MK_STEP(PH_FF2, 1, false); MK_STEP(PH_POSTFFN, 1, true);
#undef MK_STEP
}

extern "C" void kernel_launch(void* const* d_in, const int* in_sizes, int n_in, void* d_out, int out_size, void* d_ws, size_t ws_size,
                              hipStream_t stream) {
  if (ws_size < WS_NEED) { fprintf(stderr, "workspace too small: %zu < %zu\n", ws_size, (size_t)WS_NEED); return; }
  Params p{};
  const float** f = (const float**)&p;
  for (int i = 0; i < 25; ++i) f[i] = (const float*)d_in[i];
  p.out = (float*)d_out;
  p.ws = (char*)d_ws;
  static int grid_blocks = 0;
  if (!grid_blocks) {
    int dev = 0, cus = 0, per_cu = 0;
    hipGetDevice(&dev);
    hipDeviceGetAttribute(&cus, hipDeviceAttributeMultiprocessorCount, dev);
    hipFuncSetAttribute((const void*)mega_kernel, hipFuncAttributeMaxDynamicSharedMemorySize, 2 * SMEM_BYTES);
    hipOccupancyMaxActiveBlocksPerMultiprocessor(&per_cu, mega_kernel, 512, 2 * SMEM_BYTES);
    if (per_cu > 1) per_cu = 1;
    grid_blocks = cus * per_cu;
  }
  hipMemsetAsync((char*)d_ws + OFF_BAR, 0, XCD_BAR_WORDS * 4, stream);
  void* args[] = {&p};
  hipError_t e = hipLaunchCooperativeKernel((void*)mega_kernel, dim3(grid_blocks), dim3(512), args, 2 * SMEM_BYTES, stream);
  if (e != hipSuccess) fprintf(stderr, "cooperative launch failed: %s (grid %d)\n", hipGetErrorString(e), grid_blocks);
}
```

```cpp
#include <hip/hip_runtime.h>
#include <hip/hip_cooperative_groups.h>
#include <stdint.h>
#include <stdio.h>
namespace cg = cooperative_groups;

#ifndef MEGA
#define MEGA 1
#endif
#ifndef REP_GEMM
#define REP_GEMM 1
#endif
#ifndef REP_ATT
#define REP_ATT 1
#endif
#ifndef REP_SSD
#define REP_SSD 1
#endif

typedef unsigned short bf16_t;
using bf16x8 = __attribute__((ext_vector_type(8))) short;
using s16x4  = __attribute__((ext_vector_type(4))) short;
using f32x4  = __attribute__((ext_vector_type(4))) float;
using f32x16 = __attribute__((ext_vector_type(16))) float;
using u32x4  = __attribute__((ext_vector_type(4))) unsigned;
using u32x2  = __attribute__((ext_vector_type(2))) unsigned;
#define DI __device__ __forceinline__
#define MFMA32(a, b, c) __builtin_amdgcn_mfma_f32_32x32x16_bf16((a), (b), (c), 0, 0, 0)
#define MFMA16(a, b, c) __builtin_amdgcn_mfma_f32_16x16x32_bf16((a), (b), (c), 0, 0, 0)

constexpr int DM = 1024, NB = 4, SEQ = 4096, CTX = 256;
constexpr int ML = NB * SEQ;
constexpr int MC = NB * CTX;
constexpr int MT = ML + MC;
constexpr int DIN = 2480, DINP = 2560;
constexpr int LK = CTX + SEQ;
constexpr int DFF = 4096;
constexpr int NCH = 34;
constexpr float EPS = 1e-6f;
constexpr int U_CKV = 256, U_KR = 384, U_GB = 416, U_GC = 672, U_VAL = 928, U_Z = 1184, U_XBC = 1696, U_DT = 2464;

constexpr size_t AL(size_t x) { return (x + 255) & ~(size_t)255; }
constexpr size_t WT_IN = 0;
constexpr size_t WT_UQ = WT_IN + (size_t)DINP * 1024;
constexpr size_t WT_UKV = WT_UQ + (size_t)384 * 256;
constexpr size_t WT_OUT = WT_UKV + (size_t)512 * 128;
constexpr size_t WT_FF1 = WT_OUT + (size_t)1024 * 1024;
constexpr size_t WT_FF2 = WT_FF1 + (size_t)4096 * 1024;
constexpr size_t WT_ELEMS = WT_FF2 + (size_t)4096 * 1024;
constexpr size_t OFF_WT = 0;
constexpr size_t OFF_MOD = AL(OFF_WT + 2 * WT_ELEMS * 2);
constexpr size_t OFF_XC = AL(OFF_MOD + 2 * 5 * 6144 * 4);
constexpr size_t OFF_H = AL(OFF_XC + (size_t)MC * DM * 4);
constexpr size_t OFF_R1 = AL(OFF_H + (size_t)MT * DM * 2);
constexpr size_t OFF_U = OFF_R1;
constexpr size_t OFF_DT = AL(OFF_U + (size_t)MT * DIN * 2);
constexpr size_t OFF_RSTD = AL(OFF_DT + (size_t)MT * 16 * 4);
constexpr size_t OFF_QB = AL(OFF_RSTD + (size_t)MT * 2 * 4);
constexpr size_t OFF_KB = AL(OFF_QB + (size_t)MT * 384 * 2);
constexpr size_t OFF_VT = AL(OFF_KB + (size_t)NB * 4 * LK * 96 * 2);
constexpr size_t OFF_XBC = AL(OFF_VT + (size_t)NB * 4 * 64 * LK * 2);
constexpr size_t OFF_SST = AL(OFF_XBC + (size_t)MT * 768 * 2);
constexpr size_t OFF_TDEC = AL(OFF_SST + (size_t)2 * NB * NCH * 8 * 4096 * 2);
constexpr size_t OFF_SSQ = AL(OFF_TDEC + (size_t)2 * NB * NCH * 8 * 4);
constexpr size_t OFF_END1 = AL(OFF_SSQ + (size_t)MT * 8 * 4);
constexpr size_t OFF_F1 = OFF_R1;
constexpr size_t OFF_END2 = AL(OFF_F1 + (size_t)MT * DFF * 2);
constexpr size_t OFF_BAR = OFF_END1 > OFF_END2 ? OFF_END1 : OFF_END2;
constexpr size_t WS_NEED = OFF_BAR + 16384;

struct Params {
  const float *x, *c, *ctx, *c_ctx, *w_mod, *b_mod, *g_pre_mix, *w_in, *q_norm, *w_uq, *kv_norm, *w_ukv, *sc_w, *ssd_cw, *ssd_cb,
      *a_log, *dt_bias, *ssd_d, *ssd_norm, *w_out, *g_post_mix, *g_pre_ffn, *w_ff1, *w_ff2, *g_post_ffn;
  float* out;
  char* ws;
};

DI int ltid() { int t = threadIdx.x; asm volatile("" : "+v"(t)); return t & 255; }
DI int ltid512() { int t = threadIdx.x; asm volatile("" : "+v"(t)); return t; }
typedef __bf16 hbf2 __attribute__((ext_vector_type(2)));
typedef float hf2 __attribute__((ext_vector_type(2)));
DI bf16_t f2bf(float x) { return __builtin_bit_cast(bf16_t, (__bf16)x); }
DI float bf2f(unsigned v) { return __uint_as_float(v << 16); }
DI unsigned pack2(float a, float b) { hf2 v = {a, b}; return __builtin_bit_cast(unsigned, __builtin_convertvector(v, hbf2)); }
DI float lo2f(unsigned w) { return __uint_as_float(w << 16); }
DI float hi2f(unsigned w) { return __uint_as_float(w & 0xffff0000u); }
DI float wave_sum(float v) {
#pragma unroll
  for (int o = 32; o > 0; o >>= 1) v += __shfl_xor(v, o);
  return v;
}
DI float silu_f(float x) { return x / (1.f + __expf(-x)); }
DI int crow(int reg, int h) { return (reg & 3) + 8 * (reg >> 2) + 4 * h; }
DI bf16x8 pack8(const f32x16& x, int s) {
  u32x4 p;
  p[0] = pack2(x[8 * s + 0], x[8 * s + 1]); p[1] = pack2(x[8 * s + 2], x[8 * s + 3]);
  p[2] = pack2(x[8 * s + 4], x[8 * s + 5]); p[3] = pack2(x[8 * s + 6], x[8 * s + 7]);
  return __builtin_bit_cast(bf16x8, p);
}
DI const float* xin_row(const Params& p, int layer, int row) {
  if (layer == 0) return row < ML ? p.x + (size_t)row * DM : p.ctx + (size_t)(row - ML) * DM;
  return row < ML ? p.out + (size_t)row * DM : (const float*)(p.ws + OFF_XC) + (size_t)(row - ML) * DM;
}
DI float* xst_row(const Params& p, int row) {
  return row < ML ? p.out + (size_t)row * DM : (float*)(p.ws + OFF_XC) + (size_t)(row - ML) * DM;
}
DI const float* mod_ptr(const Params& p, int layer, int row, int which) {
  int bb = row < ML ? (row >> 12) : 4;
  return (const float*)(p.ws + OFF_MOD) + ((size_t)(layer * 5 + bb) * 6 + which) * DM;
}
DI bf16_t* wt_ptr(const Params& p, int layer, size_t off) { return (bf16_t*)(p.ws + OFF_WT) + (size_t)layer * WT_ELEMS + off; }

DI void transpose_item(const float* __restrict__ w, const float* __restrict__ gk, int gk_from, bf16_t* __restrict__ wt, int K, int N, int kt, int nt, char* smem) {
  float* tile = (float*)smem;
  const int tid = ltid(), tx = tid & 63, ty = tid >> 6;
  const int k0 = kt * 64, n0 = nt * 64;
  const int n = n0 + tx;
  float v[16];
#pragma unroll
  for (int i = 0; i < 16; ++i) {
    int kk = ty + 4 * i;
    v[i] = n < N ? w[(size_t)(k0 + kk) * N + n] : 0.f;
  }
  if (gk) {
#pragma unroll
    for (int i = 0; i < 16; ++i) { int k = k0 + ty + 4 * i; if (k >= gk_from) v[i] *= gk[k - gk_from]; }
  }
#pragma unroll
  for (int i = 0; i < 16; ++i) tile[(ty + 4 * i) * 65 + tx] = v[i];
  __syncthreads();
#pragma unroll
  for (int i = 0; i < 2; ++i) {
    int c = tid + 256 * i, nn = c >> 3, kc = c & 7;
    u32x4 o;
#pragma unroll
    for (int jj = 0; jj < 4; ++jj) o[jj] = pack2(tile[(kc * 8 + 2 * jj) * 65 + nn], tile[(kc * 8 + 2 * jj + 1) * 65 + nn]);
    *(u32x4*)(wt + (size_t)(n0 + nn) * K + k0 + kc * 8) = o;
  }
  __syncthreads();
}

DI void modgemv_item(const Params& p, int layer, int ct, char* smem) {
  float* s = (float*)smem;
  float* red = s + 5 * 1024;
  const int tid = ltid(), w = tid >> 6, lane = tid & 63, ln = lane & 31, kh = lane >> 5;
  for (int i = tid; i < 5 * 1024; i += 256) {
    int bb = i >> 10, k = i & 1023;
    float v = bb < 4 ? p.c[bb * 1024 + k] : p.c_ctx[k];
    s[i] = silu_f(v);
  }
  __syncthreads();
  const float* wm = p.w_mod + (size_t)layer * 1024 * 6144;
  const int n = ct * 32 + ln;
  float acc[5] = {0.f, 0.f, 0.f, 0.f, 0.f};
#pragma unroll 16
  for (int i = 0; i < 128; ++i) {
    const int k = w * 256 + 2 * i + kh;
    float wv = wm[(size_t)k * 6144 + n];
#pragma unroll
    for (int bb = 0; bb < 5; ++bb) acc[bb] += s[bb * 1024 + k] * wv;
  }
#pragma unroll
  for (int bb = 0; bb < 5; ++bb) {
    acc[bb] += __shfl_xor(acc[bb], 32);
    if (kh == 0) red[(w * 5 + bb) * 32 + ln] = acc[bb];
  }
  __syncthreads();
  if (tid < 160) {
    int bb = tid >> 5, l2 = tid & 31;
    float v = red[(0 * 5 + bb) * 32 + l2] + red[(1 * 5 + bb) * 32 + l2] + red[(2 * 5 + bb) * 32 + l2] + red[(3 * 5 + bb) * 32 + l2];
    int nn = ct * 32 + l2;
    v += p.b_mod[layer * 6144 + nn];
    ((float*)(p.ws + OFF_MOD))[(size_t)(layer * 5 + bb) * 6144 + nn] = v;
  }
  __syncthreads();
}

DI void phase_prep0(const Params& p, int bid, int nb, char* smem) {
  constexpr int PER = 2984;
  for (int it = bid; it < 384 + 2 * PER; it += nb) {
    if (it < 384) { modgemv_item(p, it / 192, it % 192, smem); continue; }
    int layer = (it - 384) / PER, j = (it - 384) % PER;
    if (j < 640) transpose_item(p.w_in + (size_t)layer * 1024 * DIN, nullptr, 0, wt_ptr(p, layer, WT_IN), 1024, DIN, j / 40, j % 40, smem);
    else if ((j -= 640) < 24) transpose_item(p.w_uq + (size_t)layer * 256 * 384, p.q_norm + layer * 256, 0, wt_ptr(p, layer, WT_UQ), 256, 384, j / 6, j % 6, smem);
    else if ((j -= 24) < 16) transpose_item(p.w_ukv + (size_t)layer * 128 * 512, p.kv_norm + layer * 128, 0, wt_ptr(p, layer, WT_UKV), 128, 512, j / 8, j % 8, smem);
    else if ((j -= 16) < 256) transpose_item(p.w_out + (size_t)layer * 1024 * 1024, p.ssd_norm + layer * 512, 512, wt_ptr(p, layer, WT_OUT), 1024, 1024, j / 16, j % 16, smem);
    else if ((j -= 256) < 1024) transpose_item(p.w_ff1 + (size_t)layer * 1024 * 4096, nullptr, 0, wt_ptr(p, layer, WT_FF1), 1024, 4096, j / 64, j % 64, smem);
    else { j -= 1024; transpose_item(p.w_ff2 + (size_t)layer * 4096 * 1024, nullptr, 0, wt_ptr(p, layer, WT_FF2), 4096, 1024, j / 16, j % 16, smem); }
  }
}

struct HMod { float4 g[4], s1[4], s0[4]; };
DI void load_hmod(HMod& m, const float* g, const float* sh, const float* sc, int lane) {
#pragma unroll
  for (int i = 0; i < 4; ++i) {
    const int col = lane * 4 + 256 * i;
    m.g[i] = *(const float4*)(g + col); m.s1[i] = *(const float4*)(sc + col); m.s0[i] = *(const float4*)(sh + col);
  }
}
DI void write_h_row(const float4 xv[4], float rstd, const HMod& m, bf16_t* hrow, int lane) {
#pragma unroll
  for (int i = 0; i < 4; ++i) {
    const int col = lane * 4 + 256 * i;
    float a = xv[i].x * rstd * m.g[i].x * (1.f + m.s1[i].x) + m.s0[i].x;
    float b = xv[i].y * rstd * m.g[i].y * (1.f + m.s1[i].y) + m.s0[i].y;
    float c = xv[i].z * rstd * m.g[i].z * (1.f + m.s1[i].z) + m.s0[i].z;
    float d = xv[i].w * rstd * m.g[i].w * (1.f + m.s1[i].w) + m.s0[i].w;
    u32x2 o; o[0] = pack2(a, b); o[1] = pack2(c, d);
    *(u32x2*)(hrow + col) = o;
  }
}
DI float ssq4(const float4 v[4]) {
  float s = 0.f;
#pragma unroll
  for (int i = 0; i < 4; ++i) s += v[i].x * v[i].x + v[i].y * v[i].y + v[i].z * v[i].z + v[i].w * v[i].w;
  return s;
}
DI void load_bf_row(const bf16_t* r, int lane, float4 v[4]) {
#pragma unroll
  for (int i = 0; i < 4; ++i) {
    u32x2 t = *(const u32x2*)(r + lane * 4 + 256 * i);
    v[i] = make_float4(lo2f(t[0]), hi2f(t[0]), lo2f(t[1]), hi2f(t[1]));
  }
}

struct RowVec { float4 c1[4], c2[4], c3[4]; };
DI const float* mod_ptr_b(const Params& p, int layer, int bb, int which) {
  return (const float*)(p.ws + OFF_MOD) + ((size_t)(layer * 5 + bb) * 6 + which) * DM;
}
template <int MODE>
DI void rowwise_phase(const Params& p, int layer, int bid, int nb) {
  const int w = ltid() >> 6, lane = ltid() & 63;
  const int M = (MODE == 0 || layer == 0) ? MT : ML;
  const bool wh = MODE != 2 || layer == 0;
  bf16_t* H = (bf16_t*)(p.ws + OFF_H);
  const bf16_t* Y = MODE == 1 ? (const bf16_t*)(p.ws + OFF_U) : (const bf16_t*)(p.ws + OFF_H);
  const int NW = nb * 4, W = bid * 4 + w, nwb = NW >> 2;
  auto load_vec = [&](RowVec& v, int bb) {
    const float* gate = MODE == 1 ? mod_ptr_b(p, layer, bb, 2) : mod_ptr_b(p, layer, bb, 5);
    const float* gres = MODE == 1 ? p.g_post_mix + layer * DM : p.g_post_ffn + layer * DM;
    const int hl = MODE == 2 ? 1 : layer;
    const float* gn = MODE == 1 ? p.g_pre_ffn + layer * DM : p.g_pre_mix + hl * DM;
    const float* sh = mod_ptr_b(p, hl, bb, MODE == 1 ? 3 : 0);
    const float* sc = mod_ptr_b(p, hl, bb, MODE == 1 ? 4 : 1);
#pragma unroll
    for (int i = 0; i < 4; ++i) {
      const int col = lane * 4 + 256 * i;
      if (MODE != 0) {
        const float4 a = *(const float4*)(gate + col), b = *(const float4*)(gres + col);
        v.c1[i] = make_float4(a.x * b.x, a.y * b.y, a.z * b.z, a.w * b.w);
      }
      if (wh) {
        const float4 g = *(const float4*)(gn + col), s1 = *(const float4*)(sc + col);
        v.c2[i] = make_float4(g.x * (1.f + s1.x), g.y * (1.f + s1.y), g.z * (1.f + s1.z), g.w * (1.f + s1.w));
        v.c3[i] = *(const float4*)(sh + col);
      }
    }
  };
  struct RowIn { u32x2 y[4]; float4 x[4]; };
  auto load_row = [&](RowIn& r, int row) {
    const float* xr = MODE == 2 ? (const float*)xst_row(p, row) : xin_row(p, layer, row);
#pragma unroll
    for (int i = 0; i < 4; ++i) {
      r.x[i] = *(const float4*)(xr + lane * 4 + 256 * i);
      if (MODE != 0) r.y[i] = *(const u32x2*)(Y + (size_t)row * DM + lane * 4 + 256 * i);
    }
  };
  auto finish = [&](float4 (&xv)[4], const float4 (&yv)[4], const RowVec& v, int row) {
    if (MODE != 0) {
      const float rstd = rsqrtf(wave_sum(ssq4(yv)) * (1.f / DM) + EPS);
#pragma unroll
      for (int i = 0; i < 4; ++i) {
        xv[i].x += yv[i].x * rstd * v.c1[i].x; xv[i].y += yv[i].y * rstd * v.c1[i].y;
        xv[i].z += yv[i].z * rstd * v.c1[i].z; xv[i].w += yv[i].w * rstd * v.c1[i].w;
      }
      float* xo = xst_row(p, row);
#pragma unroll
      for (int i = 0; i < 4; ++i) *(float4*)(xo + lane * 4 + 256 * i) = xv[i];
    }
    if (wh) {
      const float rstd1 = rsqrtf(wave_sum(ssq4(xv)) * (1.f / DM) + EPS);
      bf16_t* hrow = H + (size_t)row * DM;
#pragma unroll
      for (int i = 0; i < 4; ++i) {
        u32x2 o;
        o[0] = pack2(xv[i].x * rstd1 * v.c2[i].x + v.c3[i].x, xv[i].y * rstd1 * v.c2[i].y + v.c3[i].y);
        o[1] = pack2(xv[i].z * rstd1 * v.c2[i].z + v.c3[i].z, xv[i].w * rstd1 * v.c2[i].w + v.c3[i].w);
        *(u32x2*)(hrow + lane * 4 + 256 * i) = o;
      }
    }
  };
  auto process = [&](RowIn& r, const RowVec& v, int row) {
    float4 yv[4];
#pragma unroll
    for (int i = 0; i < 4; ++i) yv[i] = make_float4(lo2f(r.y[i][0]), hi2f(r.y[i][0]), lo2f(r.y[i][1]), hi2f(r.y[i][1]));
    finish(r.x, yv, v, row);
  };
  RowVec v;
  {
    const int bb = W / nwb, j = W - bb * nwb, end = SEQ * (bb + 1);
    load_vec(v, bb);
    RowIn ra, rb;
    int row = SEQ * bb + j;
    if (row < end) load_row(ra, row);
    while (row < end) {
      const int rowb = row + nwb;
      const bool hb = rowb < end;
      if (hb) load_row(rb, rowb);
      process(ra, v, row);
      if (!hb) break;
      const int rowa = rowb + nwb;
      const bool ha = rowa < end;
      if (ha) load_row(ra, rowa);
      process(rb, v, rowb);
      if (!ha) break;
      row = rowa;
    }
  }
  if (M > ML) {
    load_vec(v, 4);
    for (int row = ML + W; row < M; row += NW) {
      float4 xv[4], yv[4];
      const float* xr = MODE == 2 ? (const float*)xst_row(p, row) : xin_row(p, layer, row);
#pragma unroll
      for (int i = 0; i < 4; ++i) xv[i] = *(const float4*)(xr + lane * 4 + 256 * i);
      if (MODE == 1) load_bf_row(Y + (size_t)row * DM, lane, yv);
      if (MODE == 2) {
        const float* pp = (const float*)(p.ws + OFF_END2) + (size_t)(row - ML) * DM;
#pragma unroll
        for (int i = 0; i < 4; ++i) {
          float4 a = *(const float4*)(pp + lane * 4 + 256 * i), b = *(const float4*)(pp + (size_t)MC * DM + lane * 4 + 256 * i);
          float4 c = *(const float4*)(pp + (size_t)2 * MC * DM + lane * 4 + 256 * i), d = *(const float4*)(pp + (size_t)3 * MC * DM + lane * 4 + 256 * i);
          yv[i] = make_float4((a.x + b.x) + (c.x + d.x), (a.y + b.y) + (c.y + d.y), (a.z + b.z) + (c.z + d.z), (a.w + b.w) + (c.w + d.w));
        }
      }
      finish(xv, yv, v, row);
    }
  }
}
DI void phase_h0(const Params& p, int bid, int nb) { rowwise_phase<0>(p, 0, bid, nb); }
DI void phase_postmix(const Params& p, int layer, int bid, int nb) { rowwise_phase<1>(p, layer, bid, nb); }
DI void phase_postffn(const Params& p, int layer, int bid, int nb) { rowwise_phase<2>(p, layer, bid, nb); }

DI void phase_prep(const Params& p, int layer, int bid, int nb) {
  const int w = ltid() >> 6, lane = ltid() & 63;
  const bf16_t* U = (const bf16_t*)(p.ws + OFF_U);
  float* DT = (float*)(p.ws + OFF_DT);
  float* RS = (float*)(p.ws + OFF_RSTD);
  bf16_t* KB = (bf16_t*)(p.ws + OFF_KB);
  bf16_t* XBC = (bf16_t*)(p.ws + OFF_XBC);
  bf16_t* YM = (bf16_t*)(p.ws + OFF_H);
  const float* scw = p.sc_w + layer * 3 * 256;
  const float* cw = p.ssd_cw + layer * 3 * 768;
  const float* cb = p.ssd_cb + layer * 768;
  const int c4 = lane * 4;
  const float4 sw0 = *(const float4*)(scw + c4), sw1 = *(const float4*)(scw + 256 + c4), sw2 = *(const float4*)(scw + 512 + c4);
  float4 cwk[3][3], cbi[3];
#pragma unroll
  for (int i = 0; i < 3; ++i) {
    cbi[i] = *(const float4*)(cb + c4 + 256 * i);
#pragma unroll
    for (int k = 0; k < 3; ++k) cwk[i][k] = *(const float4*)(cw + k * 768 + c4 + 256 * i);
  }
  const float dtb = p.dt_bias[layer * 16 + (lane & 15)];
  const float invf = exp2f(-(float)(2 * (lane & 7)) * (13.287712379549449f / 16.f));
  for (int row = bid * 4 + w; row < MT; row += nb * 4) {
    int b, t, L, pos;
    const bool lat = row < ML;
    if (lat) { b = row >> 12; t = row & 4095; L = SEQ; pos = t + CTX; }
    else { int rr = row - ML; b = rr >> 8; t = rr & 255; L = CTX; pos = t; }
    const bf16_t* u0 = U + (size_t)row * DIN;
    const bool hp = t > 0, hn = t < L - 1;
    const bf16_t* um = hp ? u0 - DIN : u0;
    const bf16_t* up = hn ? u0 + DIN : u0;
    const float mp = hp ? 1.f : 0.f, mn = hn ? 1.f : 0.f;
    const u32x2 vq = *(const u32x2*)(u0 + c4);
    const u32x2 vkv = *(const u32x2*)(u0 + U_CKV + (lane & 31) * 4);
    const float kr = bf2f(u0[U_KR + (lane & 31)]);
    const u32x2 gcm = *(const u32x2*)(um + U_GC + c4), gc0 = *(const u32x2*)(u0 + U_GC + c4), gcp = *(const u32x2*)(up + U_GC + c4);
    const u32x2 vvm = *(const u32x2*)(um + U_VAL + c4), vv0 = *(const u32x2*)(u0 + U_VAL + c4), vvp = *(const u32x2*)(up + U_VAL + c4);
    const u32x2 gb = *(const u32x2*)(u0 + U_GB + c4);
    u32x2 xm[3], x0[3], xp[3];
#pragma unroll
    for (int i = 0; i < 3; ++i) {
      xm[i] = *(const u32x2*)(um + U_XBC + c4 + 256 * i);
      x0[i] = *(const u32x2*)(u0 + U_XBC + c4 + 256 * i);
      xp[i] = *(const u32x2*)(up + U_XBC + c4 + 256 * i);
    }
    const float dtr = DT[(size_t)row * 16 + (lane & 15)];
    {
      float a = lo2f(vq[0]), bq = hi2f(vq[0]), c = lo2f(vq[1]), d = hi2f(vq[1]);
      float ss = wave_sum(a * a + bq * bq + c * c + d * d);
      float e = lo2f(vkv[0]), f = hi2f(vkv[0]), g = lo2f(vkv[1]), h = hi2f(vkv[1]);
      float s2 = lane < 32 ? e * e + f * f + g * g + h * h : 0.f;
      s2 = wave_sum(s2);
      if (lane == 0) { RS[row * 2] = rsqrtf(ss * (1.f / 256) + EPS); RS[row * 2 + 1] = rsqrtf(s2 * (1.f / 128) + EPS); }
    }
    {
      const float partner = __shfl_xor(kr, 8);
      float o = kr;
      if (lat) {
        const int grp = (lane & 31) >> 3;
        const float posf = grp < 2 ? (float)(t >> 6) : (float)(t & 63);
        const float rev = posf * invf * 0.15915494309189535f;
        const float cs = __builtin_amdgcn_cosf(rev), sn = __builtin_amdgcn_sinf(rev);
        o = (grp & 1) ? kr * cs + partner * sn : kr * cs - partner * sn;
      }
      if (lane < 32) {
        const bf16_t ob = f2bf(o);
#pragma unroll
        for (int hd = 0; hd < 4; ++hd) KB[((size_t)(b * 4 + hd) * LK + pos) * 96 + 64 + lane] = ob;
      }
    }
    {
      float a0 = sw1.x * lo2f(gc0[0]) * lo2f(vv0[0]) + mp * sw0.x * lo2f(gcm[0]) * lo2f(vvm[0]) + mn * sw2.x * lo2f(gcp[0]) * lo2f(vvp[0]);
      float a1 = sw1.y * hi2f(gc0[0]) * hi2f(vv0[0]) + mp * sw0.y * hi2f(gcm[0]) * hi2f(vvm[0]) + mn * sw2.y * hi2f(gcp[0]) * hi2f(vvp[0]);
      float a2 = sw1.z * lo2f(gc0[1]) * lo2f(vv0[1]) + mp * sw0.z * lo2f(gcm[1]) * lo2f(vvm[1]) + mn * sw2.z * lo2f(gcp[1]) * lo2f(vvp[1]);
      float a3 = sw1.w * hi2f(gc0[1]) * hi2f(vv0[1]) + mp * sw0.w * hi2f(gcm[1]) * hi2f(vvm[1]) + mn * sw2.w * hi2f(gcp[1]) * hi2f(vvp[1]);
      u32x2 o; o[0] = pack2(lo2f(gb[0]) * a0, hi2f(gb[0]) * a1); o[1] = pack2(lo2f(gb[1]) * a2, hi2f(gb[1]) * a3);
      *(u32x2*)(YM + (size_t)row * DM + 256 + c4) = o;
    }
#pragma unroll
    for (int i = 0; i < 3; ++i) {
      float a0 = cbi[i].x + cwk[i][1].x * lo2f(x0[i][0]) + mp * cwk[i][0].x * lo2f(xm[i][0]) + mn * cwk[i][2].x * lo2f(xp[i][0]);
      float a1 = cbi[i].y + cwk[i][1].y * hi2f(x0[i][0]) + mp * cwk[i][0].y * hi2f(xm[i][0]) + mn * cwk[i][2].y * hi2f(xp[i][0]);
      float a2 = cbi[i].z + cwk[i][1].z * lo2f(x0[i][1]) + mp * cwk[i][0].z * lo2f(xm[i][1]) + mn * cwk[i][2].z * lo2f(xp[i][1]);
      float a3 = cbi[i].w + cwk[i][1].w * hi2f(x0[i][1]) + mp * cwk[i][0].w * hi2f(xm[i][1]) + mn * cwk[i][2].w * hi2f(xp[i][1]);
      u32x2 o; o[0] = pack2(silu_f(a0), silu_f(a1)); o[1] = pack2(silu_f(a2), silu_f(a3));
      *(u32x2*)(XBC + (size_t)row * 768 + c4 + 256 * i) = o;
    }
    if (lane < 16) {
      const float v = dtr + dtb;
      const float e = __expf(-fabsf(v));
      DT[(size_t)row * 16 + lane] = fmaxf(v, 0.f) + (e < 1e-3f ? e * (1.f - 0.5f * e) : __logf(1.f + e));
    }
  }
}

DI void phase_ssdnorm(const Params& p, int layer, int bid, int nb) {
  const int w = ltid() >> 6, lane = ltid() & 63;
  const int M = layer == 0 ? MT : ML;
  bf16_t* YM = (bf16_t*)(p.ws + OFF_H);
  const float* SSQ = (const float*)(p.ws + OFF_SSQ);
  const float* ng = p.ssd_norm + layer * 512;
  for (int row = bid * 4 + w; row < M; row += nb * 4) {
    int g = lane >> 5;
    float4 s = *(const float4*)(SSQ + (size_t)row * 8 + g * 4);
    float rstd = rsqrtf((s.x + s.y + s.z + s.w) * (1.f / 256) + EPS);
    bf16_t* ptr = YM + (size_t)row * DM + 512 + lane * 8;
    u32x4 v = *(const u32x4*)ptr;
    float4 g0 = *(const float4*)(ng + lane * 8), g1 = *(const float4*)(ng + lane * 8 + 4);
    u32x4 o;
    o[0] = pack2(lo2f(v[0]) * rstd * g0.x, hi2f(v[0]) * rstd * g0.y);
    o[1] = pack2(lo2f(v[1]) * rstd * g0.z, hi2f(v[1]) * rstd * g0.w);
    o[2] = pack2(lo2f(v[2]) * rstd * g1.x, hi2f(v[2]) * rstd * g1.y);
    o[3] = pack2(lo2f(v[3]) * rstd * g1.z, hi2f(v[3]) * rstd * g1.w);
    *(u32x4*)ptr = o;
  }
}

constexpr int GST = 80;
constexpr int GBUF = 2 * 128 * GST;
template <bool GN, class Epi>
DI void gemm_tile(const bf16_t* __restrict__ A, int lda, const bf16_t* __restrict__ Bt, int K, int row0, int col0, char* smem, Epi epi, const float* __restrict__ ssq = nullptr) {
  bf16_t* S0 = (bf16_t*)smem;
  const int tid = ltid(), wid = tid >> 6, lane = tid & 63, wr = wid >> 1, wc = wid & 1, fr = lane & 15, fq = lane >> 4;
  f32x4 acc[4][4];
#pragma unroll
  for (int m = 0; m < 4; ++m)
#pragma unroll
    for (int n = 0; n < 4; ++n) acc[m][n] = f32x4{0.f, 0.f, 0.f, 0.f};
  u32x4 ra[4], rb[4];
  const int sr = tid >> 3, sp = tid & 7;
  const bf16_t* ga = A + (size_t)(row0 + sr) * lda + sp * 8;
  const bf16_t* gb = Bt + (size_t)(col0 + sr) * K + sp * 8;
  auto gload = [&](int k0) {
#pragma unroll
    for (int i = 0; i < 4; ++i) {
      ra[i] = *(const u32x4*)(ga + (size_t)(32 * i) * lda + k0);
      rb[i] = *(const u32x4*)(gb + (size_t)(32 * i) * K + k0);
    }
  };
  gload(0);
  float gs[4][2];
  if (GN) {
#pragma unroll
    for (int i = 0; i < 4; ++i) {
      const float4 s0 = *(const float4*)(ssq + (size_t)(row0 + sr + 32 * i) * 8), s1 = *(const float4*)(ssq + (size_t)(row0 + sr + 32 * i) * 8 + 4);
      gs[i][0] = rsqrtf((s0.x + s0.y + s0.z + s0.w) * (1.f / 256) + EPS);
      gs[i][1] = rsqrtf((s1.x + s1.y + s1.z + s1.w) * (1.f / 256) + EPS);
    }
  }
  auto swrite = [&](int kt) {
    if (GN && kt >= 8) {
      const int g = (kt - 8) >> 2;
#pragma unroll
      for (int i = 0; i < 4; ++i) {
        const float sc = g ? gs[i][1] : gs[i][0];
#pragma unroll
        for (int jj = 0; jj < 4; ++jj) ra[i][jj] = pack2(lo2f(ra[i][jj]) * sc, hi2f(ra[i][jj]) * sc);
      }
    }
    bf16_t* As = S0 + (kt & 1) * GBUF;
    bf16_t* Bs = As + 128 * GST;
#pragma unroll
    for (int i = 0; i < 4; ++i) {
      *(u32x4*)(As + (sr + 32 * i) * GST + sp * 8) = ra[i];
      *(u32x4*)(Bs + (sr + 32 * i) * GST + sp * 8) = rb[i];
    }
  };
  const int KT = K / 64;
  swrite(0);
  if (KT > 1) gload(64);
  __syncthreads();
  for (int kt = 0; kt < KT; ++kt) {
    const bf16_t* As = S0 + (kt & 1) * GBUF;
    const bf16_t* Bs = As + 128 * GST;
#pragma unroll
    for (int ks = 0; ks < 2; ++ks) {
      bf16x8 af[4], bfr[4];
#pragma unroll
      for (int m = 0; m < 4; ++m) af[m] = *(const bf16x8*)(As + (wr * 64 + m * 16 + fr) * GST + ks * 32 + fq * 8);
#pragma unroll
      for (int n = 0; n < 4; ++n) bfr[n] = *(const bf16x8*)(Bs + (wc * 64 + n * 16 + fr) * GST + ks * 32 + fq * 8);
#pragma unroll
      for (int m = 0; m < 4; ++m)
#pragma unroll
        for (int n = 0; n < 4; ++n) acc[m][n] = MFMA16(bfr[n], af[m], acc[m][n]);
      if (ks == 0 && kt + 1 < KT) {
        swrite(kt + 1);
        if (kt + 2 < KT) gload((kt + 2) * 64);
      }
    }
    __syncthreads();
  }
  float rsc[4];
#pragma unroll
  for (int m = 0; m < 4; ++m) rsc[m] = epi.scale(row0 + wr * 64 + m * 16 + fr);
#pragma unroll
  for (int m = 0; m < 4; ++m)
#pragma unroll
    for (int n = 0; n < 4; ++n) epi(row0 + wr * 64 + m * 16 + fr, col0 + wc * 64 + n * 16 + fq * 4, acc[m][n], rsc[m]);
}

template <class Epi>
DI void gemm_tile_glds(const bf16_t* __restrict__ A, int lda, const bf16_t* __restrict__ Bt, int ldb, int K, int row0, int col0, char* smem, Epi epi) {
  const int tid = ltid(), wid = tid >> 6, lane = tid & 63, wr = wid >> 1, wc = wid & 1, fr = lane & 15, fq = lane >> 4;
  f32x4 acc[4][4];
#pragma unroll
  for (int m = 0; m < 4; ++m)
#pragma unroll
    for (int n = 0; n < 4; ++n) acc[m][n] = f32x4{0.f, 0.f, 0.f, 0.f};
  const int crow = tid >> 3, cslot = tid & 7, cpart = cslot ^ (crow & 7);
  const bf16_t* ga = A + (size_t)(row0 + crow) * lda + cpart * 8;
  const bf16_t* gb = Bt + (size_t)(col0 + crow) * ldb + cpart * 8;
  auto issue = [&](int kt, int stage) {
    char* sa = smem + stage * 32768 + tid * 16;
#pragma unroll
    for (int i = 0; i < 4; ++i) {
      __builtin_amdgcn_global_load_lds((const unsigned*)(ga + (size_t)(32 * i) * lda + kt * 64), (__attribute__((address_space(3))) unsigned*)(sa + i * 4096), 16, 0, 0);
      __builtin_amdgcn_global_load_lds((const unsigned*)(gb + (size_t)(32 * i) * ldb + kt * 64), (__attribute__((address_space(3))) unsigned*)(sa + 16384 + i * 4096), 16, 0, 0);
    }
  };
  const int KT = K / 64;
  issue(0, 0);
  asm volatile("s_waitcnt vmcnt(0)" ::: "memory");
  __syncthreads();
  const int sw = fr & 7;
  for (int kt = 0; kt < KT; ++kt) {
    if (kt + 1 < KT) issue(kt + 1, (kt + 1) & 1);
    const char* As = smem + (kt & 1) * 32768;
    const char* Bs = As + 16384;
#pragma unroll
    for (int ks = 0; ks < 2; ++ks) {
      bf16x8 af[4], bfr[4];
      const int so = ((ks * 4 + fq) ^ sw) * 16;
#pragma unroll
      for (int m = 0; m < 4; ++m) af[m] = *(const bf16x8*)(As + (wr * 64 + m * 16 + fr) * 128 + so);
#pragma unroll
      for (int n = 0; n < 4; ++n) bfr[n] = *(const bf16x8*)(Bs + (wc * 64 + n * 16 + fr) * 128 + so);
#pragma unroll
      for (int m = 0; m < 4; ++m)
#pragma unroll
        for (int n = 0; n < 4; ++n) acc[m][n] = MFMA16(bfr[n], af[m], acc[m][n]);
    }
    asm volatile("s_waitcnt vmcnt(0)" ::: "memory");
    __syncthreads();
  }
#pragma unroll
  for (int m = 0; m < 4; ++m)
#pragma unroll
    for (int n = 0; n < 4; ++n) epi(row0 + wr * 64 + m * 16 + fr, col0 + wc * 64 + n * 16 + fq * 4, acc[m][n]);
}

constexpr int G8_HT = 128 * 64;
DI int g8_lds_byte(int r, int c) {
  int st = (r >> 4) * 2 + (c >> 5), rr = r & 15, cc = c & 31, ob = rr * 64 + cc * 2;
  return st * 1024 + (ob ^ (((ob >> 9) & 1) << 5));
}
DI void g8_stage_rc(int b, int& R, int& C) {
  int st = b / 1024, sb = b % 1024, swz = sb ^ (((sb >> 9) & 1) << 5);
  R = (st >> 1) * 16 + swz / 64; C = (st & 1) * 32 + (swz % 64) / 2;
}
template <class Epi>
DI void gemm8_tile(const bf16_t* __restrict__ A, int lda, const bf16_t* __restrict__ Bt, int ldb, int K, int brow, int bcol, char* smem, Epi epi,
                   bool first = true, bool has_next = false, int nbrow = 0, int nbcol = 0) {
  bf16_t* shm = (bf16_t*)smem;
  const int tid = ltid512();
#define G8_SA(b, h) (shm + ((b) * 2 + (h)) * G8_HT)
#define G8_SB(b, h) (shm + (4 + (b) * 2 + (h)) * G8_HT)
#define G8_STAGE(P, BASE, LD, br, kt) do { const bf16_t* _g = (BASE) + (size_t)(br) * (LD) + (size_t)(kt) * 64; \
    _Pragma("unroll") for (int _i = 0; _i < 2; ++_i) { int _b = tid * 16 + _i * 8192; int _r, _c; g8_stage_rc(_b, _r, _c); \
      __builtin_amdgcn_global_load_lds((const unsigned*)(_g + (size_t)_r * (LD) + _c), \
        (__attribute__((address_space(3))) unsigned*)((char*)(P) + _b), 16, 0, 0); } } while (0)
#define G8_LDA(dst, b, h) _Pragma("unroll") for (int m = 0; m < 4; ++m) _Pragma("unroll") for (int k = 0; k < 2; ++k) \
    dst[m][k] = *reinterpret_cast<const bf16x8*>((char*)G8_SA(b, h) + g8_lds_byte(wr * 64 + m * 16 + fr, k * 32 + fq * 8))
#define G8_LDB(dst, b, h) _Pragma("unroll") for (int n = 0; n < 2; ++n) _Pragma("unroll") for (int k = 0; k < 2; ++k) \
    dst[n][k] = *reinterpret_cast<const bf16x8*>((char*)G8_SB(b, h) + g8_lds_byte(wc * 32 + n * 16 + fr, k * 32 + fq * 8))
#define G8_MMA(ai, bj, At, Bx) do { __builtin_amdgcn_s_setprio(1); \
    _Pragma("unroll") for (int m = 0; m < 4; ++m) _Pragma("unroll") for (int n = 0; n < 2; ++n) _Pragma("unroll") for (int k = 0; k < 2; ++k) \
      acc[ai][bj][m][n] = __builtin_amdgcn_mfma_f32_16x16x32_bf16(Bx[n][k], At[m][k], acc[ai][bj][m][n], 0, 0, 0); \
    __builtin_amdgcn_s_setprio(0); } while (0)
#define G8_WAIT_V(n) asm volatile("s_waitcnt vmcnt(" #n ")" ::: "memory")
#define G8_WAIT_L(n) asm volatile("s_waitcnt lgkmcnt(" #n ")" ::: "memory")
#define G8_BAR __builtin_amdgcn_s_barrier()
#define G8_SCHED __builtin_amdgcn_sched_barrier(0)
  const int wid = tid >> 6, lane = tid & 63, wr = wid >> 2, wc = wid & 3, fr = lane & 15, fq = lane >> 4;
  f32x4 acc[2][2][4][2];
#pragma unroll
  for (int a = 0; a < 2; ++a)
#pragma unroll
    for (int b = 0; b < 2; ++b)
#pragma unroll
      for (int m = 0; m < 4; ++m)
#pragma unroll
        for (int n = 0; n < 2; ++n) acc[a][b][m][n] = f32x4{0.f, 0.f, 0.f, 0.f};
  bf16x8 At[4][2], B0[2][2], B1[2][2];
  const int nt = K / 64;
  if (first) {
    G8_STAGE(G8_SB(0, 0), Bt, ldb, bcol, 0); G8_STAGE(G8_SA(0, 0), A, lda, brow, 0);
    G8_STAGE(G8_SB(0, 1), Bt, ldb, bcol + 128, 0); G8_STAGE(G8_SA(0, 1), A, lda, brow + 128, 0);
  }
  if (wr == 1) G8_BAR;
  if (first) G8_WAIT_V(4); else G8_WAIT_V(0);
  G8_BAR;
  G8_STAGE(G8_SB(1, 0), Bt, ldb, bcol, 1); G8_STAGE(G8_SA(1, 0), A, lda, brow, 1); G8_STAGE(G8_SB(1, 1), Bt, ldb, bcol + 128, 1);
  G8_WAIT_V(6); G8_BAR;
  for (int t = 0; t < nt - 2; t += 2) {
    G8_LDB(B0, 0, 0); G8_SCHED; G8_LDA(At, 0, 0); G8_STAGE(G8_SA(1, 1), A, lda, brow + 128, t + 1);
    G8_WAIT_L(8); G8_BAR; G8_WAIT_L(0); G8_MMA(0, 0, At, B0); G8_BAR; G8_SCHED;
    G8_LDB(B1, 0, 1); G8_STAGE(G8_SB(0, 0), Bt, ldb, bcol, t + 2);
    G8_BAR; G8_WAIT_L(0); G8_MMA(0, 1, At, B1); G8_BAR;
    G8_LDA(At, 0, 1); G8_STAGE(G8_SA(0, 0), A, lda, brow, t + 2);
    G8_BAR; G8_WAIT_L(0); G8_MMA(1, 0, At, B0); G8_BAR; G8_SCHED;
    G8_STAGE(G8_SB(0, 1), Bt, ldb, bcol + 128, t + 2);
    G8_WAIT_V(6); G8_BAR; G8_MMA(1, 1, At, B1); G8_BAR;
    G8_LDB(B0, 1, 0); G8_SCHED; G8_LDA(At, 1, 0); G8_STAGE(G8_SA(0, 1), A, lda, brow + 128, t + 2);
    G8_WAIT_L(8); G8_BAR; G8_WAIT_L(0); G8_MMA(0, 0, At, B0); G8_BAR; G8_SCHED;
    G8_LDB(B1, 1, 1); G8_STAGE(G8_SB(1, 0), Bt, ldb, bcol, t + 3);
    G8_BAR; G8_WAIT_L(0); G8_MMA(0, 1, At, B1); G8_BAR;
    G8_LDA(At, 1, 1); G8_STAGE(G8_SA(1, 0), A, lda, brow, t + 3);
    G8_BAR; G8_WAIT_L(0); G8_MMA(1, 0, At, B0); G8_BAR; G8_SCHED;
    G8_STAGE(G8_SB(1, 1), Bt, ldb, bcol + 128, t + 3);
    G8_WAIT_V(6); G8_BAR; G8_MMA(1, 1, At, B1); G8_BAR;
  }
  { G8_LDB(B0, 0, 0); G8_LDA(At, 0, 0); G8_STAGE(G8_SA(1, 1), A, lda, brow + 128, nt - 1);
    G8_BAR; G8_WAIT_L(0); G8_MMA(0, 0, At, B0); G8_BAR;
    G8_LDB(B1, 0, 1); G8_BAR; G8_WAIT_L(0); G8_MMA(0, 1, At, B1); G8_BAR;
    G8_LDA(At, 0, 1); G8_WAIT_V(4); G8_BAR; G8_WAIT_L(0); G8_MMA(1, 0, At, B0); G8_MMA(1, 1, At, B1); G8_BAR; }
  { G8_LDB(B0, 1, 0); G8_LDA(At, 1, 0); G8_WAIT_V(2); G8_BAR; G8_WAIT_L(0); G8_MMA(0, 0, At, B0); G8_BAR;
    G8_LDB(B1, 1, 1); G8_WAIT_V(0); G8_BAR; G8_WAIT_L(0); G8_MMA(0, 1, At, B1); G8_BAR;
    G8_LDA(At, 1, 1); G8_BAR; G8_WAIT_L(0); G8_MMA(1, 0, At, B0); G8_MMA(1, 1, At, B1); G8_BAR; }
  if (has_next) {
    G8_STAGE(G8_SB(0, 0), Bt, ldb, nbcol, 0); G8_STAGE(G8_SA(0, 0), A, lda, nbrow, 0);
    G8_STAGE(G8_SB(0, 1), Bt, ldb, nbcol + 128, 0); G8_STAGE(G8_SA(0, 1), A, lda, nbrow + 128, 0);
  }
  if (wr == 0) G8_BAR;
  const bool odd = fq & 1;
#pragma unroll
  for (int ai = 0; ai < 2; ++ai)
#pragma unroll
    for (int bj = 0; bj < 2; ++bj)
#pragma unroll
      for (int m = 0; m < 4; ++m) {
        const int row = brow + ai * 128 + wr * 64 + m * 16 + fr, cb = bcol + bj * 128 + wc * 32;
        epi.side(row, cb + fq * 4, acc[ai][bj][m][0]);
        epi.side(row, cb + 16 + fq * 4, acc[ai][bj][m][1]);
        const u32x2 p0 = epi.pack(acc[ai][bj][m][0]), p1 = epi.pack(acc[ai][bj][m][1]);
        const u32x2 snd = odd ? p0 : p1;
        u32x2 rcv; rcv[0] = (unsigned)__shfl_xor((int)snd[0], 16); rcv[1] = (unsigned)__shfl_xor((int)snd[1], 16);
        u32x4 o;
        if (odd) { o[0] = rcv[0]; o[1] = rcv[1]; o[2] = p1[0]; o[3] = p1[1]; }
        else     { o[0] = p0[0]; o[1] = p0[1]; o[2] = rcv[0]; o[3] = rcv[1]; }
        epi.store16(row, odd ? cb + 16 + (fq - 1) * 4 : cb + fq * 4, o);
      }
  __syncthreads();
}

struct EpiBF {
  bf16_t* out; int ldo;
  DI void side(int, int, const f32x4&) const {}
  DI u32x2 pack(const f32x4& a) const { u32x2 o; o[0] = pack2(a[0], a[1]); o[1] = pack2(a[2], a[3]); return o; }
  DI void store16(int row, int col, const u32x4& v) const { *(u32x4*)(out + (size_t)row * ldo + col) = v; }
  DI float scale(int) const { return 1.f; }
  DI void operator()(int row, int col, const f32x4& a, float) const { (*this)(row, col, a); }
  DI void operator()(int row, int col, const f32x4& a) const {
    u32x2 o; o[0] = pack2(a[0], a[1]); o[1] = pack2(a[2], a[3]);
    *(u32x2*)(out + (size_t)row * ldo + col) = o;
  }
};
struct EpiRelu2 {
  bf16_t* out; int ldo;
  DI void side(int, int, const f32x4&) const {}
  DI u32x2 pack(const f32x4& a) const {
    float r0 = fmaxf(a[0], 0.f), r1 = fmaxf(a[1], 0.f), r2 = fmaxf(a[2], 0.f), r3 = fmaxf(a[3], 0.f);
    u32x2 o; o[0] = pack2(r0 * r0, r1 * r1); o[1] = pack2(r2 * r2, r3 * r3); return o;
  }
  DI void store16(int row, int col, const u32x4& v) const { *(u32x4*)(out + (size_t)row * ldo + col) = v; }
  DI void operator()(int row, int col, const f32x4& a) const {
    float r0 = fmaxf(a[0], 0.f), r1 = fmaxf(a[1], 0.f), r2 = fmaxf(a[2], 0.f), r3 = fmaxf(a[3], 0.f);
    u32x2 o; o[0] = pack2(r0 * r0, r1 * r1); o[1] = pack2(r2 * r2, r3 * r3);
    *(u32x2*)(out + (size_t)row * ldo + col) = o;
  }
};
struct EpiU {
  bf16_t* u; float* dt;
  DI void side(int row, int col, const f32x4& a) const { if (col >= U_DT && col < DIN) *(float4*)(dt + (size_t)row * 16 + col - U_DT) = make_float4(a[0], a[1], a[2], a[3]); }
  DI u32x2 pack(const f32x4& a) const { u32x2 o; o[0] = pack2(a[0], a[1]); o[1] = pack2(a[2], a[3]); return o; }
  DI void store16(int row, int col, const u32x4& v) const { if (col < DIN) *(u32x4*)(u + (size_t)row * DIN + col) = v; }
  DI void operator()(int row, int col, const f32x4& a) const {
    if (col < DIN) {
      u32x2 o; o[0] = pack2(a[0], a[1]); o[1] = pack2(a[2], a[3]);
      *(u32x2*)(u + (size_t)row * DIN + col) = o;
      if (col >= U_DT) *(float4*)(dt + (size_t)row * 16 + col - U_DT) = make_float4(a[0], a[1], a[2], a[3]);
    }
  }
};
struct EpiQ {
  bf16_t* q; const float* rs;
  DI float scale(int row) const { return rs[row * 2]; }
  DI void operator()(int row, int col, const f32x4& a, float r) const {
    u32x2 o; o[0] = pack2(a[0] * r, a[1] * r); o[1] = pack2(a[2] * r, a[3] * r);
    *(u32x2*)(q + (size_t)row * 384 + col) = o;
  }
};
struct EpiKV {
  bf16_t* kb; bf16_t* vt; const float* rs;
  DI float scale(int row) const { return rs[row * 2 + 1]; }
  DI void operator()(int row, int col, const f32x4& a, float r) const {
    int b, pos;
    if (row < ML) { b = row >> 12; pos = (row & 4095) + CTX; } else { int rr = row - ML; b = rr >> 8; pos = rr & 255; }
    const int head = col >> 7, d = col & 127;
    if (d < 64) {
      u32x2 o; o[0] = pack2(a[0] * r, a[1] * r); o[1] = pack2(a[2] * r, a[3] * r);
      *(u32x2*)(kb + ((size_t)(b * 4 + head) * LK + pos) * 96 + d) = o;
    } else {
#pragma unroll
      for (int j = 0; j < 4; ++j) vt[((size_t)(b * 4 + head) * 64 + (d - 64 + j)) * LK + pos] = f2bf(a[j] * r);
    }
  }
};

struct EpiPart {
  float* part;
  DI void operator()(int row, int col, const f32x4& a) const {
    *(float4*)(part + (size_t)(row - ML) * DM + col) = make_float4(a[0], a[1], a[2], a[3]);
  }
};
DI void phase_inproj(const Params& p, int layer, int bid, int nb, char* smem) {
  EpiU epi{(bf16_t*)(p.ws + OFF_U), (float*)(p.ws + OFF_DT)};
  const int x = bid & 7, per = nb >> 3;
  for (int rep = 0; rep < REP_GEMM; ++rep)
  for (int q = bid >> 3; q < 85; q += per) {
    const int m = (x >> 1) * 17 + q / 5, n = 5 * (x & 1) + q % 5;
    const int q2 = q + per, m2 = (x >> 1) * 17 + q2 / 5, n2 = 5 * (x & 1) + q2 % 5;
    gemm8_tile((const bf16_t*)(p.ws + OFF_H), DM, wt_ptr(p, layer, WT_IN), 1024, 1024, m * 256, n * 256, smem, epi,
               q == (bid >> 3), q2 < 85, m2 * 256, n2 * 256);
  }
}
DI void phase_wout(const Params& p, int layer, int lid, int nvb, char* smem) {
  const int M = layer == 0 ? MT : ML;
  EpiBF epi{(bf16_t*)(p.ws + OFF_U), DM};
  const int x = lid & 7, per = nvb >> 3;
  for (int rep = 0; rep < REP_GEMM; ++rep)
  for (int q = lid >> 3; q < M / 128; q += per)
    gemm_tile<true>((const bf16_t*)(p.ws + OFF_H), DM, wt_ptr(p, layer, WT_OUT), 1024, ((q >> 3) * 8 + x) * 128, (q & 7) * 128, smem, epi, (const float*)(p.ws + OFF_SSQ));
}
DI void phase_ff1(const Params& p, int layer, int bid, int nb, int vbid, int nvb, char* smem, char* smem_half) {
  EpiRelu2 epi{(bf16_t*)(p.ws + OFF_F1), DFF};
  const int x = bid & 7, per = nb >> 3;
  for (int rep = 0; rep < REP_GEMM; ++rep) {
    for (int q = bid >> 3; q < 128; q += per) {
      const int m = (x >> 2) * 32 + (q >> 2), n = 4 * (x & 3) + (q & 3);
      const int q2 = q + per, m2 = (x >> 2) * 32 + (q2 >> 2), n2 = 4 * (x & 3) + (q2 & 3);
      gemm8_tile((const bf16_t*)(p.ws + OFF_H), DM, wt_ptr(p, layer, WT_FF1), 1024, 1024, m * 256, n * 256, smem, epi,
                 q == (bid >> 3), q2 < 128, m2 * 256, n2 * 256);
    }
    if (layer == 0)
      for (int it = vbid; it < (MC / 128) * 32; it += nvb)
        gemm_tile_glds((const bf16_t*)(p.ws + OFF_H), DM, wt_ptr(p, layer, WT_FF1), 1024, 1024, ML + (it / 32) * 128, (it % 32) * 128, smem_half, epi);
  }
}
DI void phase_ff2(const Params& p, int layer, int bid, int nb, int vbid, int nvb, char* smem, char* smem_half) {
  EpiBF epi{(bf16_t*)(p.ws + OFF_H), DM};
  const int x = bid & 7, per = nb >> 3;
  for (int rep = 0; rep < REP_GEMM; ++rep) {
    for (int q = bid >> 3; q < 32; q += per) {
      const int T = x * 32 + q;
      gemm8_tile((const bf16_t*)(p.ws + OFF_F1), DFF, wt_ptr(p, layer, WT_FF2), 4096, 4096, (T >> 2) * 256, (T & 3) * 256, smem, epi);
    }
    if (layer == 0)
      for (int it = vbid; it < (MC / 128) * 8 * 4; it += nvb) {
        const int tile = it >> 2, ks = it & 3;
        EpiPart ep{(float*)(p.ws + OFF_END2) + (size_t)ks * MC * DM};
        gemm_tile_glds((const bf16_t*)(p.ws + OFF_F1) + ks * 1024, DFF, wt_ptr(p, layer, WT_FF2) + ks * 1024, 4096, 1024, ML + (tile >> 3) * 128, (tile & 7) * 128, smem_half, ep);
      }
  }
}

DI int chunk_row0(int b, int tc) { return tc < 2 ? ML + b * CTX + tc * 128 : b * SEQ + (tc - 2) * 128; }
constexpr int BST = 72;
constexpr int TST = 136;
DI void load_tile_T(bf16_t* dst, const bf16_t* __restrict__ src, int ldg) {
  const int tid = ltid();
#pragma unroll
  for (int i = 0; i < 4; ++i) {
    int c = tid + 256 * i, tok = c & 127, pc = c >> 7;
    u32x4 v = *(const u32x4*)(src + (size_t)tok * ldg + pc * 8);
#pragma unroll
    for (int j = 0; j < 4; ++j) {
      dst[(pc * 8 + 2 * j) * TST + tok] = (bf16_t)(v[j] & 0xffffu);
      dst[(pc * 8 + 2 * j + 1) * TST + tok] = (bf16_t)(v[j] >> 16);
    }
  }
}
DI void chunk_scan(const Params& p, int layer, int row0, int h, float* csf, float* csb, float* dtF, float* dtB, float* tot, float*  ) {
  const int tid = ltid(), w = tid >> 6, lane = tid & 63;
  const float* DT = (const float*)(p.ws + OFF_DT);
  float v;
  if (tid < 128) {
    const float dt = DT[(size_t)(row0 + tid) * 16 + h];
    v = dt * -__expf(p.a_log[layer * 16 + h]);
    dtF[tid] = dt;
  } else {
    const int e = 255 - tid;
    const float dt = DT[(size_t)(row0 + e) * 16 + 8 + h];
    v = dt * -__expf(p.a_log[layer * 16 + 8 + h]);
    dtB[e] = dt;
  }
#pragma unroll
  for (int o = 1; o < 64; o <<= 1) { const float t = __shfl_up(v, o); if (lane >= o) v += t; }
  if (lane == 63) tot[w] = v;
  __syncthreads();
  if (w == 1) v += tot[0];
  if (w == 3) v += tot[2];
  if (tid < 128) csf[tid] = v; else csb[255 - tid] = v;
  __syncthreads();
}

DI void ssd_state_item(const Params& p, int layer, int b, int tc, int h, char* smem) {
  bf16_t* XT = (bf16_t*)smem;
  bf16_t* BT = XT + 64 * TST;
  float* csf = (float*)(BT + 64 * TST);
  float* csb = csf + 128; float* dtF = csb + 128; float* dtB = dtF + 128; float* laF = dtB + 128; float* laB = laF + 128;
  const int tid = ltid(), w = tid >> 6, lane = tid & 63, r = lane & 31, hh = lane >> 5;
  const int row0 = chunk_row0(b, tc);
  const bf16_t* XBC = (const bf16_t*)(p.ws + OFF_XBC);
  load_tile_T(XT, XBC + (size_t)row0 * 768 + h * 64, 768);
  load_tile_T(BT, XBC + (size_t)row0 * 768 + 512 + (h >> 2) * 64, 768);
  chunk_scan(p, layer, row0, h, csf, csb, dtF, dtB, laF, laB);
  __syncthreads();
  if (tid < 128) laF[tid] = dtF[tid] * __expf(csf[127] - csf[tid]);
  else { int t = tid - 128; laB[t] = dtB[t] * __expf(csb[0] - csb[t]); }
  __syncthreads();
  const int d = w >> 1, pt = w & 1;
  const float* wv = d == 0 ? laF : laB;
  f32x16 acc[2];
#pragma unroll
  for (int i = 0; i < 16; ++i) { acc[0][i] = 0.f; acc[1][i] = 0.f; }
#pragma unroll
  for (int s = 0; s < 8; ++s) {
    int l0 = 16 * s + 8 * hh;
    u32x4 xa = *(const u32x4*)(XT + (32 * pt + r) * TST + l0);
    u32x4 sa;
#pragma unroll
    for (int j = 0; j < 4; ++j) sa[j] = pack2(lo2f(xa[j]) * wv[l0 + 2 * j], hi2f(xa[j]) * wv[l0 + 2 * j + 1]);
    bf16x8 af = __builtin_bit_cast(bf16x8, sa);
#pragma unroll
    for (int nt = 0; nt < 2; ++nt) {
      bf16x8 bfr = *(const bf16x8*)(BT + (32 * nt + r) * TST + l0);
      acc[nt] = MFMA32(af, bfr, acc[nt]);
    }
  }
  bf16_t* S = (bf16_t*)(p.ws + OFF_SST) + ((((size_t)d * NB + b) * NCH + tc) * 8 + h) * 4096;
#pragma unroll
  for (int nt = 0; nt < 2; ++nt)
#pragma unroll
    for (int i = 0; i < 16; ++i) S[(32 * pt + crow(i, hh)) * 64 + 32 * nt + r] = f2bf(acc[nt][i]);
  if (tid == 0) {
    float* TD = (float*)(p.ws + OFF_TDEC);
    TD[((0 * NB + b) * NCH + tc) * 8 + h] = __expf(csf[127]);
    TD[((1 * NB + b) * NCH + tc) * 8 + h] = __expf(csb[0]);
  }
  __syncthreads();
}

DI void ssd_pass_item(const Params& p, int it) {
  const int e = it * 256 + ltid();
  const int pn2 = e & 2047, h = (e >> 11) & 7, b = (e >> 14) & 3, d = e >> 16;
  unsigned* S = (unsigned*)(p.ws + OFF_SST);
  const float* TD = (const float*)(p.ws + OFF_TDEC);
  unsigned sv[NCH]; float T[NCH];
#pragma unroll
  for (int i = 0; i < NCH; ++i) {
    int tc = d == 0 ? i : (i < 2 ? 1 - i : NCH + 1 - i);
    sv[i] = S[(((size_t)(d * NB + b) * NCH + tc) * 8 + h) * 2048 + pn2];
    T[i] = TD[((d * NB + b) * NCH + tc) * 8 + h];
  }
  float h0 = 0.f, h1 = 0.f;
#pragma unroll
  for (int i = 0; i < NCH; ++i) {
    int tc = d == 0 ? i : (i < 2 ? 1 - i : NCH + 1 - i);
    S[(((size_t)(d * NB + b) * NCH + tc) * 8 + h) * 2048 + pn2] = pack2(h0, h1);
    h0 = T[i] * h0 + lo2f(sv[i]); h1 = T[i] * h1 + hi2f(sv[i]);
  }
}

DI void ssd_out_item(const Params& p, int layer, int b, int tc, int h, char* smem) {
  bf16_t* XT = (bf16_t*)smem;
  bf16_t* Bs = XT + 64 * TST;
  float* csf = (float*)(Bs + 128 * BST);
  float* csb = csf + 128; float* dtF = csb + 128; float* dtB = dtF + 128; float* laF = dtB + 128; float* laB = laF + 128;
  const int tid = ltid(), w = tid >> 6, lane = tid & 63, r = lane & 31, hh = lane >> 5;
  const int row0 = chunk_row0(b, tc), g = h >> 2;
  const bf16_t* XBC = (const bf16_t*)(p.ws + OFF_XBC);
  load_tile_T(XT, XBC + (size_t)row0 * 768 + h * 64, 768);
#pragma unroll
  for (int i = 0; i < 4; ++i) {
    int c = tid + 256 * i, tok = c >> 3, part = c & 7;
    *(u32x4*)(Bs + tok * BST + part * 8) = *(const u32x4*)(XBC + (size_t)(row0 + tok) * 768 + 512 + g * 64 + part * 8);
  }
  const int l = 32 * w + r;
  bf16x8 cf[4];
#pragma unroll
  for (int ks = 0; ks < 4; ++ks) cf[ks] = *(const bf16x8*)(XBC + (size_t)(row0 + l) * 768 + 640 + g * 64 + 16 * ks + 8 * hh);
  chunk_scan(p, layer, row0, h, csf, csb, dtF, dtB, laF, laB);
  const float csf_l = csf[l], csb_l = csb[l];
  f32x16 yacc[2];
#pragma unroll
  for (int i = 0; i < 16; ++i) { yacc[0][i] = 0.f; yacc[1][i] = 0.f; }
#pragma unroll
  for (int st = 0; st < 4; ++st) {
    f32x16 gacc;
#pragma unroll
    for (int i = 0; i < 16; ++i) gacc[i] = 0.f;
#pragma unroll
    for (int ks = 0; ks < 4; ++ks) {
      bf16x8 af = *(const bf16x8*)(Bs + (32 * st + r) * BST + 16 * ks + 8 * hh);
      gacc = MFMA32(af, cf[ks], gacc);
    }
#pragma unroll
    for (int i = 0; i < 16; ++i) {
      int s = 32 * st + crow(i, hh);
      float f;
      if (s < l) f = __expf(csf_l - csf[s]) * dtF[s];
      else if (s > l) f = __expf(csb_l - csb[s]) * dtB[s];
      else f = dtF[s] + dtB[s];
      gacc[i] *= f;
    }
#pragma unroll
    for (int s2 = 0; s2 < 2; ++s2) {
      bf16x8 mf = pack8(gacc, s2);
      int sb = 32 * st + 16 * s2 + 4 * hh;
#pragma unroll
      for (int pt = 0; pt < 2; ++pt) {
        u32x2 lo = *(const u32x2*)(XT + (32 * pt + r) * TST + sb);
        u32x2 hi = *(const u32x2*)(XT + (32 * pt + r) * TST + sb + 8);
        u32x4 xa; xa[0] = lo[0]; xa[1] = lo[1]; xa[2] = hi[0]; xa[3] = hi[1];
        yacc[pt] = MFMA32(__builtin_bit_cast(bf16x8, xa), mf, yacc[pt]);
      }
    }
  }
#pragma unroll
  for (int d = 0; d < 2; ++d) {
    const bf16_t* Hs = (const bf16_t*)(p.ws + OFF_SST) + ((((size_t)d * NB + b) * NCH + tc) * 8 + h) * 4096;
    const float e = __expf(d == 0 ? csf_l : csb_l);
#pragma unroll
    for (int pt = 0; pt < 2; ++pt) {
      f32x16 t;
#pragma unroll
      for (int i = 0; i < 16; ++i) t[i] = 0.f;
#pragma unroll
      for (int ks = 0; ks < 4; ++ks) {
        bf16x8 af = *(const bf16x8*)(Hs + (32 * pt + r) * 64 + 16 * ks + 8 * hh);
        t = MFMA32(af, cf[ks], t);
      }
#pragma unroll
      for (int i = 0; i < 16; ++i) yacc[pt][i] += e * t[i];
    }
  }
  const int row = row0 + l;
  const float Dh = p.ssd_d[layer * 8 + h];
  const bf16_t* U = (const bf16_t*)(p.ws + OFF_U);
  bf16_t* YM = (bf16_t*)(p.ws + OFF_H);
  float ssq = 0.f;
  u32x2 xvv[2][4], zvv[2][4];
#pragma unroll
  for (int pt = 0; pt < 2; ++pt)
#pragma unroll
    for (int q = 0; q < 4; ++q) {
      const int pp = 32 * pt + 8 * q + 4 * hh;
      xvv[pt][q] = *(const u32x2*)(XBC + (size_t)row * 768 + h * 64 + pp);
      zvv[pt][q] = *(const u32x2*)(U + (size_t)row * DIN + U_Z + h * 64 + pp);
    }
#pragma unroll
  for (int pt = 0; pt < 2; ++pt)
#pragma unroll
    for (int q = 0; q < 4; ++q) {
      const int pp = 32 * pt + 8 * q + 4 * hh;
      const u32x2 xv = xvv[pt][q], zv = zvv[pt][q];
      float y0 = (yacc[pt][4 * q + 0] + Dh * lo2f(xv[0])) * silu_f(lo2f(zv[0]));
      float y1 = (yacc[pt][4 * q + 1] + Dh * hi2f(xv[0])) * silu_f(hi2f(zv[0]));
      float y2 = (yacc[pt][4 * q + 2] + Dh * lo2f(xv[1])) * silu_f(lo2f(zv[1]));
      float y3 = (yacc[pt][4 * q + 3] + Dh * hi2f(xv[1])) * silu_f(hi2f(zv[1]));
      u32x2 o; o[0] = pack2(y0, y1); o[1] = pack2(y2, y3);
      float r0 = lo2f(o[0]), r1 = hi2f(o[0]), r2 = lo2f(o[1]), r3 = hi2f(o[1]);
      ssq += r0 * r0 + r1 * r1 + r2 * r2 + r3 * r3;
      *(u32x2*)(YM + (size_t)row * DM + 512 + h * 64 + pp) = o;
    }
  ssq += __shfl_xor(ssq, 32);
  if (hh == 0) ((float*)(p.ws + OFF_SSQ))[(size_t)row * 8 + h] = ssq;
  __syncthreads();
}

constexpr int KST = 104;
constexpr int VST = 68;
constexpr int ASTG = 64 * KST + 64 * VST;
DI void attn_item(const Params& p, int b, int head, int qrow0, int t0, bool lat, int nkeys, char* smem) {
  bf16_t* Ks = (bf16_t*)smem;
  bf16_t* Vs = Ks + 64 * KST;
  const int tid = ltid(), w = tid >> 6, lane = tid & 63, r = lane & 31, hh = lane >> 5;
  const bf16_t* QB = (const bf16_t*)(p.ws + OFF_QB);
  const bf16_t* KB = (const bf16_t*)(p.ws + OFF_KB) + (size_t)(b * 4 + head) * LK * 96;
  const bf16_t* VT = (const bf16_t*)(p.ws + OFF_VT) + (size_t)(b * 4 + head) * 64 * LK;
  const float qscale = 0.10206207261596575f * 1.4426950408889634f;
  const int qrow = qrow0 + w * 32 + r;
  const int t = t0 + w * 32 + r;
  bf16x8 qf[6];
  {
    const bf16_t* src = QB + (size_t)qrow * 384 + head * 96;
#pragma unroll
    for (int s = 0; s < 4; ++s) {
      u32x4 v = *(const u32x4*)(src + 16 * s + 8 * hh);
      u32x4 o;
#pragma unroll
      for (int j = 0; j < 4; ++j) o[j] = pack2(lo2f(v[j]) * qscale, hi2f(v[j]) * qscale);
      qf[s] = __builtin_bit_cast(bf16x8, o);
    }
#pragma unroll
    for (int s = 4; s < 6; ++s) {
      u32x4 va = *(const u32x4*)(src + 16 * s), vb = *(const u32x4*)(src + 16 * s + 8);
      float posf = s == 4 ? (float)(t >> 6) : (float)(t & 63);
      float o[8];
#pragma unroll
      for (int j = 0; j < 8; ++j) {
        float a = (j & 1) ? hi2f(va[j >> 1]) : lo2f(va[j >> 1]);
        float bb = (j & 1) ? hi2f(vb[j >> 1]) : lo2f(vb[j >> 1]);
        float res;
        if (lat) {
          float invf = exp2f(-(float)(2 * j) * (13.287712379549449f / 16.f));
          float rev = posf * invf * 0.15915494309189535f;
          float cs = __builtin_amdgcn_cosf(rev), sn = __builtin_amdgcn_sinf(rev);
          res = hh == 0 ? a * cs - bb * sn : bb * cs + a * sn;
        } else res = hh == 0 ? a : bb;
        o[j] = res * qscale;
      }
      u32x4 ov; ov[0] = pack2(o[0], o[1]); ov[1] = pack2(o[2], o[3]); ov[2] = pack2(o[4], o[5]); ov[3] = pack2(o[6], o[7]);
      qf[s] = __builtin_bit_cast(bf16x8, ov);
    }
  }
  f32x16 oacc[2];
#pragma unroll
  for (int i = 0; i < 16; ++i) { oacc[0][i] = 0.f; oacc[1][i] = 0.f; }
  float m = -1e30f, lsum = 0.f;
  u32x4 rk[3], rv[2];
  auto gload = [&](int key0) {
#pragma unroll
    for (int i = 0; i < 3; ++i) rk[i] = *(const u32x4*)(KB + (size_t)key0 * 96 + (tid + 256 * i) * 8);
#pragma unroll
    for (int i = 0; i < 2; ++i) { int c = tid + 256 * i; rv[i] = *(const u32x4*)(VT + (size_t)(c >> 3) * LK + key0 + (c & 7) * 8); }
  };
  gload(0);
  const int NT = nkeys / 64;
  for (int kt = 0; kt < NT; ++kt) {
#pragma unroll
    for (int i = 0; i < 3; ++i) { int c = tid + 256 * i; *(u32x4*)(Ks + (c / 12) * KST + (c % 12) * 8) = rk[i]; }
#pragma unroll
    for (int i = 0; i < 2; ++i) {
      int c = tid + 256 * i;
      bf16_t* d = Vs + (c >> 3) * VST + (c & 7) * 8;
      u32x2 a; a[0] = rv[i][0]; a[1] = rv[i][1];
      u32x2 bq; bq[0] = rv[i][2]; bq[1] = rv[i][3];
      *(u32x2*)d = a; *(u32x2*)(d + 4) = bq;
    }
    __syncthreads();
    if (kt + 1 < NT) gload((kt + 1) * 64);
    f32x16 sacc[2];
#pragma unroll
    for (int i = 0; i < 16; ++i) { sacc[0][i] = 0.f; sacc[1][i] = 0.f; }
#pragma unroll
    for (int s = 0; s < 6; ++s)
#pragma unroll
      for (int k2 = 0; k2 < 2; ++k2) {
        bf16x8 af = *(const bf16x8*)(Ks + (32 * k2 + r) * KST + 16 * s + 8 * hh);
        sacc[k2] = MFMA32(af, qf[s], sacc[k2]);
      }
    float mx = sacc[0][0];
#pragma unroll
    for (int i = 0; i < 16; ++i) { mx = fmaxf(mx, sacc[0][i]); mx = fmaxf(mx, sacc[1][i]); }
    mx = fmaxf(mx, __shfl_xor(mx, 32));
    const float mn = fmaxf(m, mx);
    const float alpha = __builtin_amdgcn_exp2f(m - mn);
    m = mn;
    float ps = 0.f;
#pragma unroll
    for (int i = 0; i < 16; ++i) {
      sacc[0][i] = __builtin_amdgcn_exp2f(sacc[0][i] - mn); sacc[1][i] = __builtin_amdgcn_exp2f(sacc[1][i] - mn);
      ps += sacc[0][i] + sacc[1][i];
    }
    lsum = lsum * alpha + ps;
#pragma unroll
    for (int i = 0; i < 16; ++i) { oacc[0][i] *= alpha; oacc[1][i] *= alpha; }
#pragma unroll
    for (int k2 = 0; k2 < 2; ++k2)
#pragma unroll
      for (int s2 = 0; s2 < 2; ++s2) {
        bf16x8 pf = pack8(sacc[k2], s2);
        int kb0 = 32 * k2 + 16 * s2 + 4 * hh;
#pragma unroll
        for (int d = 0; d < 2; ++d) {
          u32x2 lo = *(const u32x2*)(Vs + (32 * d + r) * VST + kb0);
          u32x2 hi = *(const u32x2*)(Vs + (32 * d + r) * VST + kb0 + 8);
          u32x4 va; va[0] = lo[0]; va[1] = lo[1]; va[2] = hi[0]; va[3] = hi[1];
          oacc[d] = MFMA32(__builtin_bit_cast(bf16x8, va), pf, oacc[d]);
        }
      }
    __syncthreads();
  }
  lsum += __shfl_xor(lsum, 32);
  const float inv = 1.f / lsum;
  bf16_t* YM = (bf16_t*)(p.ws + OFF_H) + (size_t)qrow * DM + head * 64;
#pragma unroll
  for (int d = 0; d < 2; ++d)
#pragma unroll
    for (int q = 0; q < 4; ++q) {
      u32x2 o; o[0] = pack2(oacc[d][4 * q] * inv, oacc[d][4 * q + 1] * inv); o[1] = pack2(oacc[d][4 * q + 2] * inv, oacc[d][4 * q + 3] * inv);
      *(u32x2*)(YM + 32 * d + 8 * q + 4 * hh) = o;
    }
}

DI void attn_item8(const Params& p, int b, int head, int qrow0, int t0, bool lat, int nkeys, char* smem) {
  bf16_t* Ks = (bf16_t*)smem;
  bf16_t* Vs = Ks + 64 * KST;
  const int tid = ltid512(), w = tid >> 6, lane = tid & 63, r = lane & 31, hh = lane >> 5;
  const bf16_t* QB = (const bf16_t*)(p.ws + OFF_QB);
  const bf16_t* KB = (const bf16_t*)(p.ws + OFF_KB) + (size_t)(b * 4 + head) * LK * 96;
  const bf16_t* VT = (const bf16_t*)(p.ws + OFF_VT) + (size_t)(b * 4 + head) * 64 * LK;
  const float qscale = 0.10206207261596575f * 1.4426950408889634f;
  const int qrow = qrow0 + w * 32 + r;
  const int t = t0 + w * 32 + r;
  bf16x8 qf[6];
  {
    const bf16_t* src = QB + (size_t)qrow * 384 + head * 96;
#pragma unroll
    for (int s = 0; s < 4; ++s) {
      u32x4 v = *(const u32x4*)(src + 16 * s + 8 * hh);
      u32x4 o;
#pragma unroll
      for (int j = 0; j < 4; ++j) o[j] = pack2(lo2f(v[j]) * qscale, hi2f(v[j]) * qscale);
      qf[s] = __builtin_bit_cast(bf16x8, o);
    }
#pragma unroll
    for (int s = 4; s < 6; ++s) {
      u32x4 va = *(const u32x4*)(src + 16 * s), vb = *(const u32x4*)(src + 16 * s + 8);
      float posf = s == 4 ? (float)(t >> 6) : (float)(t & 63);
      float o[8];
#pragma unroll
      for (int j = 0; j < 8; ++j) {
        float a = (j & 1) ? hi2f(va[j >> 1]) : lo2f(va[j >> 1]);
        float bb = (j & 1) ? hi2f(vb[j >> 1]) : lo2f(vb[j >> 1]);
        float res;
        if (lat) {
          float invf = exp2f(-(float)(2 * j) * (13.287712379549449f / 16.f));
          float rev = posf * invf * 0.15915494309189535f;
          float cs = __builtin_amdgcn_cosf(rev), sn = __builtin_amdgcn_sinf(rev);
          res = hh == 0 ? a * cs - bb * sn : bb * cs + a * sn;
        } else res = hh == 0 ? a : bb;
        o[j] = res * qscale;
      }
      u32x4 ov; ov[0] = pack2(o[0], o[1]); ov[1] = pack2(o[2], o[3]); ov[2] = pack2(o[4], o[5]); ov[3] = pack2(o[6], o[7]);
      qf[s] = __builtin_bit_cast(bf16x8, ov);
    }
  }
  f32x16 oacc[2];
#pragma unroll
  for (int i = 0; i < 16; ++i) { oacc[0][i] = 0.f; oacc[1][i] = 0.f; }
  float m = -1e30f, lsum = 0.f;
  u32x4 rk[2], rv;
  auto gload = [&](int key0) {
    rk[0] = *(const u32x4*)(KB + (size_t)key0 * 96 + tid * 8);
    if (tid < 256) rk[1] = *(const u32x4*)(KB + (size_t)key0 * 96 + (512 + tid) * 8);
    rv = *(const u32x4*)(VT + (size_t)(tid >> 3) * LK + key0 + (tid & 7) * 8);
  };
  const int kro = (tid / 12) * KST + (tid % 12) * 8, kro2 = ((512 + tid) / 12) * KST + ((512 + tid) % 12) * 8;
  auto swrite = [&](int stage) {
    bf16_t* Kd = Ks + stage * ASTG;
    *(u32x4*)(Kd + kro) = rk[0];
    if (tid < 256) *(u32x4*)(Kd + kro2) = rk[1];
    bf16_t* d = Kd + 64 * KST + (tid >> 3) * VST + (tid & 7) * 8;
    u32x2 a; a[0] = rv[0]; a[1] = rv[1];
    u32x2 bq; bq[0] = rv[2]; bq[1] = rv[3];
    *(u32x2*)d = a; *(u32x2*)(d + 4) = bq;
  };
  auto qk = [&](int stage, f32x16 (&sa)[2]) {
    const bf16_t* Kc = Ks + stage * ASTG;
#pragma unroll
    for (int i = 0; i < 16; ++i) { sa[0][i] = 0.f; sa[1][i] = 0.f; }
#pragma unroll
    for (int s = 0; s < 6; ++s)
#pragma unroll
      for (int k2 = 0; k2 < 2; ++k2) {
        bf16x8 af = *(const bf16x8*)(Kc + (32 * k2 + r) * KST + 16 * s + 8 * hh);
        sa[k2] = MFMA32(af, qf[s], sa[k2]);
      }
  };
  const int NT = nkeys / 64;
  f32x16 sacc[2], snext[2];
  gload(0); swrite(0);
  gload(64);
  __syncthreads();
  swrite(1);
  gload(128);
  qk(0, sacc);
  __syncthreads();
  int cur = 0, nxt = 1, nn = 2;
  for (int kt = 0; kt < NT; ++kt) {
    if (kt + 1 < NT) qk(nxt, snext);
    if (kt + 2 < NT) {
      swrite(nn);
      if (kt + 3 < NT) gload((kt + 3) * 64);
    }
    const bf16_t* Vc = Ks + cur * ASTG + 64 * KST;
    float mx = sacc[0][0];
#pragma unroll
    for (int i = 0; i < 16; ++i) { mx = fmaxf(mx, sacc[0][i]); mx = fmaxf(mx, sacc[1][i]); }
    mx = fmaxf(mx, __shfl_xor(mx, 32));
    const float mn = fmaxf(m, mx);
    const float alpha = __builtin_amdgcn_exp2f(m - mn);
    m = mn;
    float ps = 0.f;
#pragma unroll
    for (int i = 0; i < 16; ++i) {
      sacc[0][i] = __builtin_amdgcn_exp2f(sacc[0][i] - mn); sacc[1][i] = __builtin_amdgcn_exp2f(sacc[1][i] - mn);
      ps += sacc[0][i] + sacc[1][i];
    }
    lsum = lsum * alpha + ps;
#pragma unroll
    for (int i = 0; i < 16; ++i) { oacc[0][i] *= alpha; oacc[1][i] *= alpha; }
#pragma unroll
    for (int k2 = 0; k2 < 2; ++k2)
#pragma unroll
      for (int s2 = 0; s2 < 2; ++s2) {
        bf16x8 pf = pack8(sacc[k2], s2);
        int kb0 = 32 * k2 + 16 * s2 + 4 * hh;
#pragma unroll
        for (int d = 0; d < 2; ++d) {
          u32x2 lo = *(const u32x2*)(Vc + (32 * d + r) * VST + kb0);
          u32x2 hi = *(const u32x2*)(Vc + (32 * d + r) * VST + kb0 + 8);
          u32x4 va; va[0] = lo[0]; va[1] = lo[1]; va[2] = hi[0]; va[3] = hi[1];
          oacc[d] = MFMA32(__builtin_bit_cast(bf16x8, va), pf, oacc[d]);
        }
      }
    sacc[0] = snext[0]; sacc[1] = snext[1];
    const int t3 = cur; cur = nxt; nxt = nn; nn = t3;
    __syncthreads();
  }
  lsum += __shfl_xor(lsum, 32);
  const float inv = 1.f / lsum;
  bf16_t* YM = (bf16_t*)(p.ws + OFF_H) + (size_t)qrow * DM + head * 64;
#pragma unroll
  for (int d = 0; d < 2; ++d)
#pragma unroll
    for (int q = 0; q < 4; ++q) {
      u32x2 o; o[0] = pack2(oacc[d][4 * q] * inv, oacc[d][4 * q + 1] * inv); o[1] = pack2(oacc[d][4 * q + 2] * inv, oacc[d][4 * q + 3] * inv);
      *(u32x2*)(YM + 32 * d + 8 * q + 4 * hh) = o;
    }
}

DI void phase_qkv(const Params& p, int layer, int bid, int nb, char* smem) {
  const int MQ = layer == 0 ? MT : ML;
  const int nq = (MQ / 128) * 3, nkv = (MT / 128) * 4, nst = NB * NCH * 8;
  const float* RS = (const float*)(p.ws + OFF_RSTD);
  EpiQ eq{(bf16_t*)(p.ws + OFF_QB), RS};
  EpiKV ekv{(bf16_t*)(p.ws + OFF_KB), (bf16_t*)(p.ws + OFF_VT), RS};
  const bf16_t* U = (const bf16_t*)(p.ws + OFF_U);
  for (int it = bid; it < nq + nkv + nst; it += nb) {
    if (it < nq) gemm_tile<false>(U, DIN, wt_ptr(p, layer, WT_UQ), 256, (it / 3) * 128, (it % 3) * 128, smem, eq);
    else if (it < nq + nkv) { int j = it - nq; gemm_tile<false>(U + U_CKV, DIN, wt_ptr(p, layer, WT_UKV), 128, (j / 4) * 128, (j % 4) * 128, smem, ekv); }
    else { int j = it - nq - nkv; for (int rep = 0; rep < REP_SSD; ++rep) ssd_state_item(p, layer, j / (NCH * 8), (j / 8) % NCH, j & 7, smem); }
  }
}
DI void phase_att(const Params& p, int layer, int bid, int nb, int vbid, int nvb, char* smem, char* sh) {
  for (int it = bid; it < 256; it += nb) {
    const int x = it & 7, j = it >> 3, bh = 2 * x + (j >> 4), qb = j & 15, b = bh >> 2, head = bh & 3;
    for (int rep = 0; rep < REP_ATT; ++rep) attn_item8(p, b, head, b * SEQ + qb * 256, qb * 256, true, LK, smem);
  }
  for (int it = vbid; it < 512; it += nvb) ssd_pass_item(p, it);
}
DI void phase_ssdout(const Params& p, int layer, int bid, int nb, char* smem) {
  const int nout = NB * NCH * 8, nctx = layer == 0 ? 32 : 0;
  for (int it = bid; it < nout + nctx; it += nb) {
    if (it < nout) {
      int b = it / (NCH * 8), tc = (it / 8) % NCH, h = it & 7;
      if (layer == 1 && tc < 2) continue;
      for (int rep = 0; rep < REP_SSD; ++rep) ssd_out_item(p, layer, b, tc, h, smem);
    } else {
      const int j = it - nout, b = j >> 3, head = (j >> 1) & 3, qb = j & 1;
      attn_item(p, b, head, ML + b * CTX + qb * 128, qb * 128, false, CTX, smem);
    }
  }
}


#define XB_TMO      128
#define XB_XCNT(j)  (256  + 64 * (j))
#define XB_XSUB(j)  (1280 + 64 * (j))
#define XB_XGEN(j)  (2304 + 64 * (j))
#define XB_TOP      3328
#define XB_TOPGEN   3392
#define XCD_BAR_WORDS 3456
#define XB_SPIN_CAP (1u << 22)
#define LAS __attribute__((address_space(3)))
DI unsigned xb_ld(unsigned* p) { return __hip_atomic_load(p, __ATOMIC_RELAXED, __HIP_MEMORY_SCOPE_AGENT); }
DI unsigned xb_add(unsigned* p, unsigned v) { return __hip_atomic_fetch_add(p, v, __ATOMIC_RELAXED, __HIP_MEMORY_SCOPE_AGENT); }
DI unsigned xb_xcc_id() { return (unsigned)__builtin_amdgcn_s_getreg((3 << 11) | 20) & 0xFu; }
#define XB_SPIN(cond, bar) do { unsigned _sp = 0; while (cond) { __builtin_amdgcn_s_sleep(1); \
    if ((++_sp & 255u) == 0u) { if (xb_ld(&(bar)[XB_TMO])) break; if (_sp > XB_SPIN_CAP) { atomicAdd(&(bar)[XB_TMO], 1u); break; } } } } while (0)
struct XcdBarrier { unsigned* bar; unsigned x; volatile LAS unsigned* st; };
DI XcdBarrier xcd_barrier_post(unsigned* bar, volatile LAS unsigned* st) {
  XcdBarrier b; b.bar = bar; b.x = xb_xcc_id(); b.st = st;
  if (threadIdx.x == 0) (void)xb_add(&bar[XB_XCNT(b.x)], 1u);
  return b;
}
DI void xcd_barrier_complete(unsigned* bar, unsigned x, unsigned& nloc, unsigned& nx) {
  const unsigned G = gridDim.x * gridDim.y * gridDim.z;
  unsigned sum, cnt, mine, sp = 0u;
  for (;;) {
    sum = 0u; cnt = 0u; mine = 0u;
#pragma unroll
    for (unsigned j = 0; j < 16; ++j) { const unsigned c = xb_ld(&bar[XB_XCNT(j)]); sum += c; cnt += (c > 0u) ? 1u : 0u; mine = (j == x) ? c : mine; }
    if (sum == G) break;
    __builtin_amdgcn_s_sleep(1);
    if ((++sp & 255u) == 0u) { if (xb_ld(&bar[XB_TMO])) break; if (sp > XB_SPIN_CAP) { atomicAdd(&bar[XB_TMO], 1u); break; } }
  }
  nloc = mine > 0u ? mine : 1u; nx = cnt > 0u ? cnt : 1u;
}
DI void xcd_barrier(const XcdBarrier& b) {
  asm volatile("s_waitcnt vmcnt(0)" ::: "memory");
  __syncthreads();
  if (threadIdx.x == 0) {
    unsigned* bar = b.bar;
    asm volatile("" : "+s"(bar));
    __builtin_amdgcn_s_waitcnt(0);
    unsigned nloc = b.st[0], nx = b.st[1];
    if (nloc == 0u) { xcd_barrier_complete(bar, b.x, nloc, nx); b.st[0] = nloc; b.st[1] = nx; }
    const unsigned old = xb_add(&bar[XB_XSUB(b.x)], 1u);
    const unsigned gen = old / nloc;
    if (old + 1u == (gen + 1u) * nloc) {
      __builtin_amdgcn_fence(__ATOMIC_RELEASE, "agent");
      asm volatile("s_waitcnt vmcnt(0)" ::: "memory");
      const unsigned og = xb_add(&bar[XB_TOP], 1u);
      const unsigned tg = og / nx;
      if (og + 1u == (tg + 1u) * nx) xb_add(&bar[XB_TOPGEN], 1u);
      else XB_SPIN(xb_ld(&bar[XB_TOPGEN]) == tg, bar);
      __builtin_amdgcn_fence(__ATOMIC_ACQUIRE, "agent");
      xb_add(&bar[XB_XGEN(b.x)], 1u);
      asm volatile("s_waitcnt vmcnt(0)" ::: "memory");
    } else {
      XB_SPIN(xb_ld(&bar[XB_XGEN(b.x)]) == gen, bar);
      __builtin_amdgcn_fence(__ATOMIC_ACQUIRE, "agent");
      asm volatile("s_waitcnt vmcnt(0)" ::: "memory");
    }
  }
  __syncthreads();
}

constexpr int SMEM_BYTES = 2 * GBUF * 2;
enum { PH_PREP0 = 0, PH_H0, PH_INPROJ, PH_PREP, PH_QKV, PH_ATT, PH_SSDOUT, PH_WOUT, PH_POSTMIX, PH_FF1, PH_FF2, PH_POSTFFN, PH_SSDNORM };

struct Ids { int bid, nb, vbid, nvb, lid; };
DI void run_phase(const Params& p, int ph, int layer, const Ids& id, char* smem, char* sh) {
  switch (ph) {
    case PH_PREP0: phase_prep0(p, id.vbid, id.nvb, sh); break;
    case PH_H0: phase_h0(p, id.vbid, id.nvb); break;
    case PH_INPROJ: phase_inproj(p, layer, id.bid, id.nb, smem); break;
    case PH_PREP: phase_prep(p, layer, id.vbid, id.nvb); break;
    case PH_QKV: phase_qkv(p, layer, id.vbid, id.nvb, sh); break;
    case PH_ATT: phase_att(p, layer, id.bid, id.nb, id.vbid, id.nvb, smem, sh); break;
    case PH_SSDOUT: phase_ssdout(p, layer, id.vbid, id.nvb, sh); break;
    case PH_WOUT: phase_wout(p, layer, id.lid, id.nvb, sh); break;
    case PH_POSTMIX: phase_postmix(p, layer, id.vbid, id.nvb); break;
    case PH_FF1: phase_ff1(p, layer, id.bid, id.nb, id.vbid, id.nvb, smem, sh); break;
    case PH_FF2: phase_ff2(p, layer, id.bid, id.nb, id.vbid, id.nvb, smem, sh); break;
    case PH_POSTFFN: phase_postffn(p, layer, id.vbid, id.nvb); break;
  }
}

__global__ void __launch_bounds__(512) mega_kernel(Params p) {
  extern __shared__ __attribute__((aligned(16))) char smem[];
  cg::grid_group grid = cg::this_grid();
  if (p.ws == nullptr) grid.sync();
  const int half = __builtin_amdgcn_readfirstlane((int)(threadIdx.x >> 8));
  Ids id;
  id.bid = blockIdx.x; id.nb = gridDim.x;
  id.vbid = 2 * id.bid + half; id.nvb = 2 * id.nb;
  id.lid = (id.bid & 7) + 8 * (2 * (id.bid >> 3) + half);
  char* sh = smem + half * SMEM_BYTES;
  volatile LAS unsigned* st = (volatile LAS unsigned*)(smem + 2 * SMEM_BYTES - 16);
  if (threadIdx.x == 0) { st[0] = 0u; st[1] = 0u; st[2] = 0u; st[3] = 0u; }
  __syncthreads();
  XcdBarrier xb = xcd_barrier_post((unsigned*)(p.ws + OFF_BAR), st);
#define MK_STEP(PH, LAYER, LAST) do { \
    typedef const void* __attribute__((address_space(4))) * KArgs; \
    KArgs ka = (KArgs)__builtin_amdgcn_kernarg_segment_ptr(); \
    asm volatile("" : "+s"(ka)); \
    Params q; \
    { const void** dst = (const void**)&q; _Pragma("unroll") for (int i = 0; i < 27; ++i) dst[i] = ka[i]; } \
    run_phase(q, PH, LAYER, id, smem, sh); \
    if (!(LAST)) xcd_barrier(xb); } while (0)
  MK_STEP(PH_PREP0, 0, false);
  MK_STEP(PH_H0, 0, false);
  MK_STEP(PH_INPROJ, 0, false); MK_STEP(PH_PREP, 0, false); MK_STEP(PH_QKV, 0, false); MK_STEP(PH_ATT, 0, false); MK_STEP(PH_SSDOUT, 0, false);
  MK_STEP(PH_WOUT, 0, false); MK_STEP(PH_POSTMIX, 0, false); MK_STEP(PH_FF1, 0, false); MK_STEP(PH_FF2, 0, false); MK_STEP(PH_POSTFFN, 0, false);
  MK_STEP(PH_INPROJ, 1, false); MK_STEP(PH_PREP, 1, false); MK_STEP(PH_QKV, 1, false); MK_STEP(PH_ATT, 1, false); MK_STEP(PH_SSDOUT, 1, false);
  MK_STEP(PH_WOUT, 1, false); MK_STEP(PH_POSTMIX, 1, false); MK_STEP(PH_FF1, 1, false); MK_STEP(PH_FF2, 1, false); MK_STEP(PH_POSTFFN, 1, true);
#undef MK_STEP
}

extern "C" void kernel_launch(void* const* d_in, const int* in_sizes, int n_in, void* d_out, int out_size, void* d_ws, size_t ws_size,
                              hipStream_t stream) {
  if (ws_size < WS_NEED) { fprintf(stderr, "workspace too small: %zu < %zu\n", ws_size, (size_t)WS_NEED); return; }
  Params p{};
  const float** f = (const float**)&p;
  for (int i = 0; i < 25; ++i) f[i] = (const float*)d_in[i];
  p.out = (float*)d_out;
  p.ws = (char*)d_ws;
  static int grid_blocks = 0;
  if (!grid_blocks) {
    int dev = 0, cus = 0, per_cu = 0;
    hipGetDevice(&dev);
    hipDeviceGetAttribute(&cus, hipDeviceAttributeMultiprocessorCount, dev);
    hipFuncSetAttribute((const void*)mega_kernel, hipFuncAttributeMaxDynamicSharedMemorySize, 2 * SMEM_BYTES);
    hipOccupancyMaxActiveBlocksPerMultiprocessor(&per_cu, mega_kernel, 512, 2 * SMEM_BYTES);
    if (per_cu > 1) per_cu = 1;
    grid_blocks = cus * per_cu;
  }
  hipMemsetAsync((char*)d_ws + OFF_BAR, 0, XCD_BAR_WORDS * 4, stream);
  void* args[] = {&p};
  hipError_t e = hipLaunchCooperativeKernel((void*)mega_kernel, dim3(grid_blocks), dim3(512), args, 2 * SMEM_BYTES, stream);
  if (e != hipSuccess) fprintf(stderr, "cooperative launch failed: %s (grid %d)\n", hipGetErrorString(e), grid_blocks);
}
```

```cpp
#include <hip/hip_runtime.h>
#include <hip/hip_cooperative_groups.h>
#include <stdint.h>
#include <stdio.h>
namespace cg = cooperative_groups;

#ifndef MEGA
#define MEGA 1
#endif
#ifndef REP_GEMM
#define REP_GEMM 1
#endif
#ifndef REP_ATT
#define REP_ATT 1
#endif
#ifndef REP_SSD
#define REP_SSD 1
#endif

typedef unsigned short bf16_t;
using bf16x8 = __attribute__((ext_vector_type(8))) short;
using s16x4  = __attribute__((ext_vector_type(4))) short;
using f32x4  = __attribute__((ext_vector_type(4))) float;
using f32x16 = __attribute__((ext_vector_type(16))) float;
using u32x4  = __attribute__((ext_vector_type(4))) unsigned;
using u32x2  = __attribute__((ext_vector_type(2))) unsigned;
#define DI __device__ __forceinline__
#define MFMA32(a, b, c) __builtin_amdgcn_mfma_f32_32x32x16_bf16((a), (b), (c), 0, 0, 0)
#define MFMA16(a, b, c) __builtin_amdgcn_mfma_f32_16x16x32_bf16((a), (b), (c), 0, 0, 0)

constexpr int DM = 1024, NB = 4, SEQ = 4096, CTX = 256;
constexpr int ML = NB * SEQ;
constexpr int MC = NB * CTX;
constexpr int MT = ML + MC;
constexpr int DIN = 2480, DINP = 2560;
constexpr int LK = CTX + SEQ;
constexpr int DFF = 4096;
constexpr int NCH = 34;
constexpr float EPS = 1e-6f;
constexpr int U_CKV = 256, U_KR = 384, U_GB = 416, U_GC = 672, U_VAL = 928, U_Z = 1184, U_XBC = 1696, U_DT = 2464;

constexpr size_t AL(size_t x) { return (x + 255) & ~(size_t)255; }
constexpr size_t WT_IN = 0;
constexpr size_t WT_UQ = WT_IN + (size_t)DINP * 1024;
constexpr size_t WT_UKV = WT_UQ + (size_t)384 * 256;
constexpr size_t WT_OUT = WT_UKV + (size_t)512 * 128;
constexpr size_t WT_FF1 = WT_OUT + (size_t)1024 * 1024;
constexpr size_t WT_FF2 = WT_FF1 + (size_t)4096 * 1024;
constexpr size_t WT_ELEMS = WT_FF2 + (size_t)4096 * 1024;
constexpr size_t OFF_WT = 0;
constexpr size_t OFF_MOD = AL(OFF_WT + 2 * WT_ELEMS * 2);
constexpr size_t OFF_XC = AL(OFF_MOD + 2 * 5 * 6144 * 4);
constexpr size_t OFF_H = AL(OFF_XC + (size_t)MC * DM * 4);
constexpr size_t OFF_R1 = AL(OFF_H + (size_t)MT * DM * 2);
constexpr size_t OFF_U = OFF_R1;
constexpr size_t OFF_DT = AL(OFF_U + (size_t)MT * DIN * 2);
constexpr size_t OFF_RSTD = AL(OFF_DT + (size_t)MT * 16 * 4);
constexpr size_t OFF_QB = AL(OFF_RSTD + (size_t)MT * 2 * 4);
constexpr size_t OFF_KB = AL(OFF_QB + (size_t)MT * 384 * 2);
constexpr size_t OFF_VT = AL(OFF_KB + (size_t)NB * 4 * LK * 96 * 2);
constexpr size_t OFF_XBC = AL(OFF_VT + (size_t)NB * 4 * 64 * LK * 2);
constexpr size_t OFF_SST = AL(OFF_XBC + (size_t)MT * 768 * 2);
constexpr size_t OFF_TDEC = AL(OFF_SST + (size_t)2 * NB * NCH * 8 * 4096 * 2);
constexpr size_t OFF_SSQ = AL(OFF_TDEC + (size_t)2 * NB * NCH * 8 * 4);
constexpr size_t OFF_END1 = AL(OFF_SSQ + (size_t)MT * 8 * 4);
constexpr size_t OFF_F1 = OFF_R1;
constexpr size_t OFF_END2 = AL(OFF_F1 + (size_t)MT * DFF * 2);
constexpr size_t OFF_BAR = OFF_END1 > OFF_END2 ? OFF_END1 : OFF_END2;
constexpr size_t WS_NEED = OFF_BAR + 16384;

struct Params {
  const float *x, *c, *ctx, *c_ctx, *w_mod, *b_mod, *g_pre_mix, *w_in, *q_norm, *w_uq, *kv_norm, *w_ukv, *sc_w, *ssd_cw, *ssd_cb,
      *a_log, *dt_bias, *ssd_d, *ssd_norm, *w_out, *g_post_mix, *g_pre_ffn, *w_ff1, *w_ff2, *g_post_ffn;
  float* out;
  char* ws;
};

DI int ltid() { int t = threadIdx.x; asm volatile("" : "+v"(t)); return t & 255; }
DI int ltid512() { int t = threadIdx.x; asm volatile("" : "+v"(t)); return t; }
typedef __bf16 hbf2 __attribute__((ext_vector_type(2)));
typedef float hf2 __attribute__((ext_vector_type(2)));
DI bf16_t f2bf(float x) { return __builtin_bit_cast(bf16_t, (__bf16)x); }
DI float bf2f(unsigned v) { return __uint_as_float(v << 16); }
DI unsigned pack2(float a, float b) { hf2 v = {a, b}; return __builtin_bit_cast(unsigned, __builtin_convertvector(v, hbf2)); }
DI float lo2f(unsigned w) { return __uint_as_float(w << 16); }
DI float hi2f(unsigned w) { return __uint_as_float(w & 0xffff0000u); }
DI float wave_sum(float v) {
#pragma unroll
  for (int o = 32; o > 0; o >>= 1) v += __shfl_xor(v, o);
  return v;
}
DI float silu_f(float x) { return x / (1.f + __expf(-x)); }
DI int crow(int reg, int h) { return (reg & 3) + 8 * (reg >> 2) + 4 * h; }
DI bf16x8 pack8(const f32x16& x, int s) {
  u32x4 p;
  p[0] = pack2(x[8 * s + 0], x[8 * s + 1]); p[1] = pack2(x[8 * s + 2], x[8 * s + 3]);
  p[2] = pack2(x[8 * s + 4], x[8 * s + 5]); p[3] = pack2(x[8 * s + 6], x[8 * s + 7]);
  return __builtin_bit_cast(bf16x8, p);
}
DI const float* xin_row(const Params& p, int layer, int row) {
  if (layer == 0) return row < ML ? p.x + (size_t)row * DM : p.ctx + (size_t)(row - ML) * DM;
  return row < ML ? p.out + (size_t)row * DM : (const float*)(p.ws + OFF_XC) + (size_t)(row - ML) * DM;
}
DI float* xst_row(const Params& p, int row) {
  return row < ML ? p.out + (size_t)row * DM : (float*)(p.ws + OFF_XC) + (size_t)(row - ML) * DM;
}
DI const float* mod_ptr(const Params& p, int layer, int row, int which) {
  int bb = row < ML ? (row >> 12) : 4;
  return (const float*)(p.ws + OFF_MOD) + ((size_t)(layer * 5 + bb) * 6 + which) * DM;
}
DI bf16_t* wt_ptr(const Params& p, int layer, size_t off) { return (bf16_t*)(p.ws + OFF_WT) + (size_t)layer * WT_ELEMS + off; }

DI void transpose_item(const float* __restrict__ w, const float* __restrict__ gk, int gk_from, bf16_t* __restrict__ wt, int K, int N, int kt, int nt, char* smem) {
  float* tile = (float*)smem;
  const int tid = ltid(), tx = tid & 63, ty = tid >> 6;
  const int k0 = kt * 64, n0 = nt * 64;
  const int n = n0 + tx;
  float v[16];
#pragma unroll
  for (int i = 0; i < 16; ++i) {
    int kk = ty + 4 * i;
    v[i] = n < N ? w[(size_t)(k0 + kk) * N + n] : 0.f;
  }
  if (gk) {
#pragma unroll
    for (int i = 0; i < 16; ++i) { int k = k0 + ty + 4 * i; if (k >= gk_from) v[i] *= gk[k - gk_from]; }
  }
#pragma unroll
  for (int i = 0; i < 16; ++i) tile[(ty + 4 * i) * 65 + tx] = v[i];
  __syncthreads();
#pragma unroll
  for (int i = 0; i < 2; ++i) {
    int c = tid + 256 * i, nn = c >> 3, kc = c & 7;
    u32x4 o;
#pragma unroll
    for (int jj = 0; jj < 4; ++jj) o[jj] = pack2(tile[(kc * 8 + 2 * jj) * 65 + nn], tile[(kc * 8 + 2 * jj + 1) * 65 + nn]);
    *(u32x4*)(wt + (size_t)(n0 + nn) * K + k0 + kc * 8) = o;
  }
  __syncthreads();
}

DI void modgemv_item(const Params& p, int layer, int ct, char* smem) {
  float* s = (float*)smem;
  float* red = s + 5 * 1024;
  const int tid = ltid(), w = tid >> 6, lane = tid & 63, ln = lane & 31, kh = lane >> 5;
  for (int i = tid; i < 5 * 1024; i += 256) {
    int bb = i >> 10, k = i & 1023;
    float v = bb < 4 ? p.c[bb * 1024 + k] : p.c_ctx[k];
    s[i] = silu_f(v);
  }
  __syncthreads();
  const float* wm = p.w_mod + (size_t)layer * 1024 * 6144;
  const int n = ct * 32 + ln;
  float acc[5] = {0.f, 0.f, 0.f, 0.f, 0.f};
#pragma unroll 16
  for (int i = 0; i < 128; ++i) {
    const int k = w * 256 + 2 * i + kh;
    float wv = wm[(size_t)k * 6144 + n];
#pragma unroll
    for (int bb = 0; bb < 5; ++bb) acc[bb] += s[bb * 1024 + k] * wv;
  }
#pragma unroll
  for (int bb = 0; bb < 5; ++bb) {
    acc[bb] += __shfl_xor(acc[bb], 32);
    if (kh == 0) red[(w * 5 + bb) * 32 + ln] = acc[bb];
  }
  __syncthreads();
  if (tid < 160) {
    int bb = tid >> 5, l2 = tid & 31;
    float v = red[(0 * 5 + bb) * 32 + l2] + red[(1 * 5 + bb) * 32 + l2] + red[(2 * 5 + bb) * 32 + l2] + red[(3 * 5 + bb) * 32 + l2];
    int nn = ct * 32 + l2;
    v += p.b_mod[layer * 6144 + nn];
    ((float*)(p.ws + OFF_MOD))[(size_t)(layer * 5 + bb) * 6144 + nn] = v;
  }
  __syncthreads();
}

constexpr int WT_ITEMS = 2984;
DI void wt_item(const Params& p, int layer, int j, char* smem) {
  if (j < 640) transpose_item(p.w_in + (size_t)layer * 1024 * DIN, nullptr, 0, wt_ptr(p, layer, WT_IN), 1024, DIN, j / 40, j % 40, smem);
  else if ((j -= 640) < 24) transpose_item(p.w_uq + (size_t)layer * 256 * 384, p.q_norm + layer * 256, 0, wt_ptr(p, layer, WT_UQ), 256, 384, j / 6, j % 6, smem);
  else if ((j -= 24) < 16) transpose_item(p.w_ukv + (size_t)layer * 128 * 512, p.kv_norm + layer * 128, 0, wt_ptr(p, layer, WT_UKV), 128, 512, j / 8, j % 8, smem);
  else if ((j -= 16) < 256) transpose_item(p.w_out + (size_t)layer * 1024 * 1024, p.ssd_norm + layer * 512, 512, wt_ptr(p, layer, WT_OUT), 1024, 1024, j / 16, j % 16, smem);
  else if ((j -= 256) < 1024) transpose_item(p.w_ff1 + (size_t)layer * 1024 * 4096, nullptr, 0, wt_ptr(p, layer, WT_FF1), 1024, 4096, j / 64, j % 64, smem);
  else { j -= 1024; transpose_item(p.w_ff2 + (size_t)layer * 4096 * 1024, nullptr, 0, wt_ptr(p, layer, WT_FF2), 4096, 1024, j / 16, j % 16, smem); }
}
DI void phase_prep0(const Params& p, int bid, int nb, char* smem) {
  for (int it = bid; it < 384 + 640; it += nb) {
    if (it < 384) modgemv_item(p, it / 192, it % 192, smem);
    else wt_item(p, 0, it - 384, smem);
  }
}
struct HMod { float4 g[4], s1[4], s0[4]; };
DI void load_hmod(HMod& m, const float* g, const float* sh, const float* sc, int lane) {
#pragma unroll
  for (int i = 0; i < 4; ++i) {
    const int col = lane * 4 + 256 * i;
    m.g[i] = *(const float4*)(g + col); m.s1[i] = *(const float4*)(sc + col); m.s0[i] = *(const float4*)(sh + col);
  }
}
DI void write_h_row(const float4 xv[4], float rstd, const HMod& m, bf16_t* hrow, int lane) {
#pragma unroll
  for (int i = 0; i < 4; ++i) {
    const int col = lane * 4 + 256 * i;
    float a = xv[i].x * rstd * m.g[i].x * (1.f + m.s1[i].x) + m.s0[i].x;
    float b = xv[i].y * rstd * m.g[i].y * (1.f + m.s1[i].y) + m.s0[i].y;
    float c = xv[i].z * rstd * m.g[i].z * (1.f + m.s1[i].z) + m.s0[i].z;
    float d = xv[i].w * rstd * m.g[i].w * (1.f + m.s1[i].w) + m.s0[i].w;
    u32x2 o; o[0] = pack2(a, b); o[1] = pack2(c, d);
    *(u32x2*)(hrow + col) = o;
  }
}
DI float ssq4(const float4 v[4]) {
  float s = 0.f;
#pragma unroll
  for (int i = 0; i < 4; ++i) s += v[i].x * v[i].x + v[i].y * v[i].y + v[i].z * v[i].z + v[i].w * v[i].w;
  return s;
}
DI void load_bf_row(const bf16_t* r, int lane, float4 v[4]) {
#pragma unroll
  for (int i = 0; i < 4; ++i) {
    u32x2 t = *(const u32x2*)(r + lane * 4 + 256 * i);
    v[i] = make_float4(lo2f(t[0]), hi2f(t[0]), lo2f(t[1]), hi2f(t[1]));
  }
}

struct RowVec { float4 c1[4], c2[4], c3[4]; };
DI const float* mod_ptr_b(const Params& p, int layer, int bb, int which) {
  return (const float*)(p.ws + OFF_MOD) + ((size_t)(layer * 5 + bb) * 6 + which) * DM;
}
template <int MODE>
DI void rowwise_phase(const Params& p, int layer, int bid, int nb) {
  const int w = ltid() >> 6, lane = ltid() & 63;
  const int M = (MODE == 0 || layer == 0) ? MT : ML;
  const bool wh = MODE != 2 || layer == 0;
  bf16_t* H = (bf16_t*)(p.ws + OFF_H);
  const bf16_t* Y = MODE == 1 ? (const bf16_t*)(p.ws + OFF_U) : (const bf16_t*)(p.ws + OFF_H);
  const int NW = nb * 4, W = bid * 4 + w, nwb = NW >> 2;
  auto load_vec = [&](RowVec& v, int bb) {
    const float* gate = MODE == 1 ? mod_ptr_b(p, layer, bb, 2) : mod_ptr_b(p, layer, bb, 5);
    const float* gres = MODE == 1 ? p.g_post_mix + layer * DM : p.g_post_ffn + layer * DM;
    const int hl = MODE == 2 ? 1 : layer;
    const float* gn = MODE == 1 ? p.g_pre_ffn + layer * DM : p.g_pre_mix + hl * DM;
    const float* sh = mod_ptr_b(p, hl, bb, MODE == 1 ? 3 : 0);
    const float* sc = mod_ptr_b(p, hl, bb, MODE == 1 ? 4 : 1);
#pragma unroll
    for (int i = 0; i < 4; ++i) {
      const int col = lane * 4 + 256 * i;
      if (MODE != 0) {
        const float4 a = *(const float4*)(gate + col), b = *(const float4*)(gres + col);
        v.c1[i] = make_float4(a.x * b.x, a.y * b.y, a.z * b.z, a.w * b.w);
      }
      if (wh) {
        const float4 g = *(const float4*)(gn + col), s1 = *(const float4*)(sc + col);
        v.c2[i] = make_float4(g.x * (1.f + s1.x), g.y * (1.f + s1.y), g.z * (1.f + s1.z), g.w * (1.f + s1.w));
        v.c3[i] = *(const float4*)(sh + col);
      }
    }
  };
  struct RowIn { u32x2 y[4]; float4 x[4]; };
  auto load_row = [&](RowIn& r, int row) {
    const float* xr = MODE == 2 ? (const float*)xst_row(p, row) : xin_row(p, layer, row);
#pragma unroll
    for (int i = 0; i < 4; ++i) {
      r.x[i] = *(const float4*)(xr + lane * 4 + 256 * i);
      if (MODE != 0) r.y[i] = *(const u32x2*)(Y + (size_t)row * DM + lane * 4 + 256 * i);
    }
  };
  auto finish = [&](float4 (&xv)[4], const float4 (&yv)[4], const RowVec& v, int row) {
    if (MODE != 0) {
      const float rstd = rsqrtf(wave_sum(ssq4(yv)) * (1.f / DM) + EPS);
#pragma unroll
      for (int i = 0; i < 4; ++i) {
        xv[i].x += yv[i].x * rstd * v.c1[i].x; xv[i].y += yv[i].y * rstd * v.c1[i].y;
        xv[i].z += yv[i].z * rstd * v.c1[i].z; xv[i].w += yv[i].w * rstd * v.c1[i].w;
      }
      float* xo = xst_row(p, row);
#pragma unroll
      for (int i = 0; i < 4; ++i) *(float4*)(xo + lane * 4 + 256 * i) = xv[i];
    }
    if (wh) {
      const float rstd1 = rsqrtf(wave_sum(ssq4(xv)) * (1.f / DM) + EPS);
      bf16_t* hrow = H + (size_t)row * DM;
#pragma unroll
      for (int i = 0; i < 4; ++i) {
        u32x2 o;
        o[0] = pack2(xv[i].x * rstd1 * v.c2[i].x + v.c3[i].x, xv[i].y * rstd1 * v.c2[i].y + v.c3[i].y);
        o[1] = pack2(xv[i].z * rstd1 * v.c2[i].z + v.c3[i].z, xv[i].w * rstd1 * v.c2[i].w + v.c3[i].w);
        *(u32x2*)(hrow + lane * 4 + 256 * i) = o;
      }
    }
  };
  auto process = [&](RowIn& r, const RowVec& v, int row) {
    float4 yv[4];
#pragma unroll
    for (int i = 0; i < 4; ++i) yv[i] = make_float4(lo2f(r.y[i][0]), hi2f(r.y[i][0]), lo2f(r.y[i][1]), hi2f(r.y[i][1]));
    finish(r.x, yv, v, row);
  };
  RowVec v;
  {
    const int bb = W / nwb, j = W - bb * nwb, end = SEQ * (bb + 1);
    load_vec(v, bb);
    RowIn ra, rb;
    int row = SEQ * bb + j;
    if (row < end) load_row(ra, row);
    while (row < end) {
      const int rowb = row + nwb;
      const bool hb = rowb < end;
      if (hb) load_row(rb, rowb);
      process(ra, v, row);
      if (!hb) break;
      const int rowa = rowb + nwb;
      const bool ha = rowa < end;
      if (ha) load_row(ra, rowa);
      process(rb, v, rowb);
      if (!ha) break;
      row = rowa;
    }
  }
  if (M > ML) {
    load_vec(v, 4);
    for (int row = ML + W; row < M; row += NW) {
      float4 xv[4], yv[4];
      const float* xr = MODE == 2 ? (const float*)xst_row(p, row) : xin_row(p, layer, row);
#pragma unroll
      for (int i = 0; i < 4; ++i) xv[i] = *(const float4*)(xr + lane * 4 + 256 * i);
      if (MODE == 1) load_bf_row(Y + (size_t)row * DM, lane, yv);
      if (MODE == 2) {
        const float* pp = (const float*)(p.ws + OFF_END2) + (size_t)(row - ML) * DM;
#pragma unroll
        for (int i = 0; i < 4; ++i) {
          float4 a = *(const float4*)(pp + lane * 4 + 256 * i), b = *(const float4*)(pp + (size_t)MC * DM + lane * 4 + 256 * i);
          float4 c = *(const float4*)(pp + (size_t)2 * MC * DM + lane * 4 + 256 * i), d = *(const float4*)(pp + (size_t)3 * MC * DM + lane * 4 + 256 * i);
          yv[i] = make_float4((a.x + b.x) + (c.x + d.x), (a.y + b.y) + (c.y + d.y), (a.z + b.z) + (c.z + d.z), (a.w + b.w) + (c.w + d.w));
        }
      }
      finish(xv, yv, v, row);
    }
  }
}
DI void phase_h0(const Params& p, int bid, int nb) { rowwise_phase<0>(p, 0, bid, nb); }
DI void phase_postmix(const Params& p, int layer, int bid, int nb) { rowwise_phase<1>(p, layer, bid, nb); }
DI void phase_postffn(const Params& p, int layer, int bid, int nb) { rowwise_phase<2>(p, layer, bid, nb); }

DI void phase_prep(const Params& p, int layer, int bid, int nb) {
  const int w = ltid() >> 6, lane = ltid() & 63;
  const bf16_t* U = (const bf16_t*)(p.ws + OFF_U);
  float* DT = (float*)(p.ws + OFF_DT);
  float* RS = (float*)(p.ws + OFF_RSTD);
  bf16_t* KB = (bf16_t*)(p.ws + OFF_KB);
  bf16_t* XBC = (bf16_t*)(p.ws + OFF_XBC);
  bf16_t* YM = (bf16_t*)(p.ws + OFF_H);
  const float* scw = p.sc_w + layer * 3 * 256;
  const float* cw = p.ssd_cw + layer * 3 * 768;
  const float* cb = p.ssd_cb + layer * 768;
  const int c4 = lane * 4;
  const float4 sw0 = *(const float4*)(scw + c4), sw1 = *(const float4*)(scw + 256 + c4), sw2 = *(const float4*)(scw + 512 + c4);
  float4 cwk[3][3], cbi[3];
#pragma unroll
  for (int i = 0; i < 3; ++i) {
    cbi[i] = *(const float4*)(cb + c4 + 256 * i);
#pragma unroll
    for (int k = 0; k < 3; ++k) cwk[i][k] = *(const float4*)(cw + k * 768 + c4 + 256 * i);
  }
  const float dtb = p.dt_bias[layer * 16 + (lane & 15)];
  const float invf = exp2f(-(float)(2 * (lane & 7)) * (13.287712379549449f / 16.f));
  for (int row = bid * 4 + w; row < MT; row += nb * 4) {
    int b, t, L, pos;
    const bool lat = row < ML;
    if (lat) { b = row >> 12; t = row & 4095; L = SEQ; pos = t + CTX; }
    else { int rr = row - ML; b = rr >> 8; t = rr & 255; L = CTX; pos = t; }
    const bf16_t* u0 = U + (size_t)row * DIN;
    const bool hp = t > 0, hn = t < L - 1;
    const bf16_t* um = hp ? u0 - DIN : u0;
    const bf16_t* up = hn ? u0 + DIN : u0;
    const float mp = hp ? 1.f : 0.f, mn = hn ? 1.f : 0.f;
    const u32x2 vq = *(const u32x2*)(u0 + c4);
    const u32x2 vkv = *(const u32x2*)(u0 + U_CKV + (lane & 31) * 4);
    const float kr = bf2f(u0[U_KR + (lane & 31)]);
    const u32x2 gcm = *(const u32x2*)(um + U_GC + c4), gc0 = *(const u32x2*)(u0 + U_GC + c4), gcp = *(const u32x2*)(up + U_GC + c4);
    const u32x2 vvm = *(const u32x2*)(um + U_VAL + c4), vv0 = *(const u32x2*)(u0 + U_VAL + c4), vvp = *(const u32x2*)(up + U_VAL + c4);
    const u32x2 gb = *(const u32x2*)(u0 + U_GB + c4);
    u32x2 xm[3], x0[3], xp[3];
#pragma unroll
    for (int i = 0; i < 3; ++i) {
      xm[i] = *(const u32x2*)(um + U_XBC + c4 + 256 * i);
      x0[i] = *(const u32x2*)(u0 + U_XBC + c4 + 256 * i);
      xp[i] = *(const u32x2*)(up + U_XBC + c4 + 256 * i);
    }
    const float dtr = DT[(size_t)row * 16 + (lane & 15)];
    {
      float a = lo2f(vq[0]), bq = hi2f(vq[0]), c = lo2f(vq[1]), d = hi2f(vq[1]);
      float ss = wave_sum(a * a + bq * bq + c * c + d * d);
      float e = lo2f(vkv[0]), f = hi2f(vkv[0]), g = lo2f(vkv[1]), h = hi2f(vkv[1]);
      float s2 = lane < 32 ? e * e + f * f + g * g + h * h : 0.f;
      s2 = wave_sum(s2);
      if (lane == 0) { RS[row * 2] = rsqrtf(ss * (1.f / 256) + EPS); RS[row * 2 + 1] = rsqrtf(s2 * (1.f / 128) + EPS); }
    }
    {
      const float partner = __shfl_xor(kr, 8);
      float o = kr;
      if (lat) {
        const int grp = (lane & 31) >> 3;
        const float posf = grp < 2 ? (float)(t >> 6) : (float)(t & 63);
        const float rev = posf * invf * 0.15915494309189535f;
        const float cs = __builtin_amdgcn_cosf(rev), sn = __builtin_amdgcn_sinf(rev);
        o = (grp & 1) ? kr * cs + partner * sn : kr * cs - partner * sn;
      }
      if (lane < 32) {
        const bf16_t ob = f2bf(o);
#pragma unroll
        for (int hd = 0; hd < 4; ++hd) KB[((size_t)(b * 4 + hd) * LK + pos) * 96 + 64 + lane] = ob;
      }
    }
    {
      float a0 = sw1.x * lo2f(gc0[0]) * lo2f(vv0[0]) + mp * sw0.x * lo2f(gcm[0]) * lo2f(vvm[0]) + mn * sw2.x * lo2f(gcp[0]) * lo2f(vvp[0]);
      float a1 = sw1.y * hi2f(gc0[0]) * hi2f(vv0[0]) + mp * sw0.y * hi2f(gcm[0]) * hi2f(vvm[0]) + mn * sw2.y * hi2f(gcp[0]) * hi2f(vvp[0]);
      float a2 = sw1.z * lo2f(gc0[1]) * lo2f(vv0[1]) + mp * sw0.z * lo2f(gcm[1]) * lo2f(vvm[1]) + mn * sw2.z * lo2f(gcp[1]) * lo2f(vvp[1]);
      float a3 = sw1.w * hi2f(gc0[1]) * hi2f(vv0[1]) + mp * sw0.w * hi2f(gcm[1]) * hi2f(vvm[1]) + mn * sw2.w * hi2f(gcp[1]) * hi2f(vvp[1]);
      u32x2 o; o[0] = pack2(lo2f(gb[0]) * a0, hi2f(gb[0]) * a1); o[1] = pack2(lo2f(gb[1]) * a2, hi2f(gb[1]) * a3);
      *(u32x2*)(YM + (size_t)row * DM + 256 + c4) = o;
    }
#pragma unroll
    for (int i = 0; i < 3; ++i) {
      float a0 = cbi[i].x + cwk[i][1].x * lo2f(x0[i][0]) + mp * cwk[i][0].x * lo2f(xm[i][0]) + mn * cwk[i][2].x * lo2f(xp[i][0]);
      float a1 = cbi[i].y + cwk[i][1].y * hi2f(x0[i][0]) + mp * cwk[i][0].y * hi2f(xm[i][0]) + mn * cwk[i][2].y * hi2f(xp[i][0]);
      float a2 = cbi[i].z + cwk[i][1].z * lo2f(x0[i][1]) + mp * cwk[i][0].z * lo2f(xm[i][1]) + mn * cwk[i][2].z * lo2f(xp[i][1]);
      float a3 = cbi[i].w + cwk[i][1].w * hi2f(x0[i][1]) + mp * cwk[i][0].w * hi2f(xm[i][1]) + mn * cwk[i][2].w * hi2f(xp[i][1]);
      u32x2 o; o[0] = pack2(silu_f(a0), silu_f(a1)); o[1] = pack2(silu_f(a2), silu_f(a3));
      *(u32x2*)(XBC + (size_t)row * 768 + c4 + 256 * i) = o;
    }
    if (lane < 16) {
      const float v = dtr + dtb;
      const float e = __expf(-fabsf(v));
      DT[(size_t)row * 16 + lane] = fmaxf(v, 0.f) + (e < 1e-3f ? e * (1.f - 0.5f * e) : __logf(1.f + e));
    }
  }
}

DI void phase_ssdnorm(const Params& p, int layer, int bid, int nb) {
  const int w = ltid() >> 6, lane = ltid() & 63;
  const int M = layer == 0 ? MT : ML;
  bf16_t* YM = (bf16_t*)(p.ws + OFF_H);
  const float* SSQ = (const float*)(p.ws + OFF_SSQ);
  const float* ng = p.ssd_norm + layer * 512;
  for (int row = bid * 4 + w; row < M; row += nb * 4) {
    int g = lane >> 5;
    float4 s = *(const float4*)(SSQ + (size_t)row * 8 + g * 4);
    float rstd = rsqrtf((s.x + s.y + s.z + s.w) * (1.f / 256) + EPS);
    bf16_t* ptr = YM + (size_t)row * DM + 512 + lane * 8;
    u32x4 v = *(const u32x4*)ptr;
    float4 g0 = *(const float4*)(ng + lane * 8), g1 = *(const float4*)(ng + lane * 8 + 4);
    u32x4 o;
    o[0] = pack2(lo2f(v[0]) * rstd * g0.x, hi2f(v[0]) * rstd * g0.y);
    o[1] = pack2(lo2f(v[1]) * rstd * g0.z, hi2f(v[1]) * rstd * g0.w);
    o[2] = pack2(lo2f(v[2]) * rstd * g1.x, hi2f(v[2]) * rstd * g1.y);
    o[3] = pack2(lo2f(v[3]) * rstd * g1.z, hi2f(v[3]) * rstd * g1.w);
    *(u32x4*)ptr = o;
  }
}

constexpr int GST = 80;
constexpr int GBUF = 2 * 128 * GST;
template <bool GN, class Epi>
DI void gemm_tile(const bf16_t* __restrict__ A, int lda, const bf16_t* __restrict__ Bt, int K, int row0, int col0, char* smem, Epi epi, const float* __restrict__ ssq = nullptr) {
  bf16_t* S0 = (bf16_t*)smem;
  const int tid = ltid(), wid = tid >> 6, lane = tid & 63, wr = wid >> 1, wc = wid & 1, fr = lane & 15, fq = lane >> 4;
  f32x4 acc[4][4];
#pragma unroll
  for (int m = 0; m < 4; ++m)
#pragma unroll
    for (int n = 0; n < 4; ++n) acc[m][n] = f32x4{0.f, 0.f, 0.f, 0.f};
  u32x4 ra[4], rb[4];
  const int sr = tid >> 3, sp = tid & 7;
  const bf16_t* ga = A + (size_t)(row0 + sr) * lda + sp * 8;
  const bf16_t* gb = Bt + (size_t)(col0 + sr) * K + sp * 8;
  auto gload = [&](int k0) {
#pragma unroll
    for (int i = 0; i < 4; ++i) {
      ra[i] = *(const u32x4*)(ga + (size_t)(32 * i) * lda + k0);
      rb[i] = *(const u32x4*)(gb + (size_t)(32 * i) * K + k0);
    }
  };
  gload(0);
  float gs[4][2];
  if (GN) {
#pragma unroll
    for (int i = 0; i < 4; ++i) {
      const float4 s0 = *(const float4*)(ssq + (size_t)(row0 + sr + 32 * i) * 8), s1 = *(const float4*)(ssq + (size_t)(row0 + sr + 32 * i) * 8 + 4);
      gs[i][0] = rsqrtf((s0.x + s0.y + s0.z + s0.w) * (1.f / 256) + EPS);
      gs[i][1] = rsqrtf((s1.x + s1.y + s1.z + s1.w) * (1.f / 256) + EPS);
    }
  }
  auto swrite = [&](int kt) {
    if (GN && kt >= 8) {
      const int g = (kt - 8) >> 2;
#pragma unroll
      for (int i = 0; i < 4; ++i) {
        const float sc = g ? gs[i][1] : gs[i][0];
#pragma unroll
        for (int jj = 0; jj < 4; ++jj) ra[i][jj] = pack2(lo2f(ra[i][jj]) * sc, hi2f(ra[i][jj]) * sc);
      }
    }
    bf16_t* As = S0 + (kt & 1) * GBUF;
    bf16_t* Bs = As + 128 * GST;
#pragma unroll
    for (int i = 0; i < 4; ++i) {
      *(u32x4*)(As + (sr + 32 * i) * GST + sp * 8) = ra[i];
      *(u32x4*)(Bs + (sr + 32 * i) * GST + sp * 8) = rb[i];
    }
  };
  const int KT = K / 64;
  swrite(0);
  if (KT > 1) gload(64);
  __syncthreads();
  for (int kt = 0; kt < KT; ++kt) {
    const bf16_t* As = S0 + (kt & 1) * GBUF;
    const bf16_t* Bs = As + 128 * GST;
#pragma unroll
    for (int ks = 0; ks < 2; ++ks) {
      bf16x8 af[4], bfr[4];
#pragma unroll
      for (int m = 0; m < 4; ++m) af[m] = *(const bf16x8*)(As + (wr * 64 + m * 16 + fr) * GST + ks * 32 + fq * 8);
#pragma unroll
      for (int n = 0; n < 4; ++n) bfr[n] = *(const bf16x8*)(Bs + (wc * 64 + n * 16 + fr) * GST + ks * 32 + fq * 8);
#pragma unroll
      for (int m = 0; m < 4; ++m)
#pragma unroll
        for (int n = 0; n < 4; ++n) acc[m][n] = MFMA16(bfr[n], af[m], acc[m][n]);
      if (ks == 0 && kt + 1 < KT) {
        swrite(kt + 1);
        if (kt + 2 < KT) gload((kt + 2) * 64);
      }
    }
    __syncthreads();
  }
  float rsc[4];
#pragma unroll
  for (int m = 0; m < 4; ++m) rsc[m] = epi.scale(row0 + wr * 64 + m * 16 + fr);
#pragma unroll
  for (int m = 0; m < 4; ++m)
#pragma unroll
    for (int n = 0; n < 4; ++n) epi(row0 + wr * 64 + m * 16 + fr, col0 + wc * 64 + n * 16 + fq * 4, acc[m][n], rsc[m]);
}

template <class Epi>
DI void gemm_tile_glds(const bf16_t* __restrict__ A, int lda, const bf16_t* __restrict__ Bt, int ldb, int K, int row0, int col0, char* smem, Epi epi) {
  const int tid = ltid(), wid = tid >> 6, lane = tid & 63, wr = wid >> 1, wc = wid & 1, fr = lane & 15, fq = lane >> 4;
  f32x4 acc[4][4];
#pragma unroll
  for (int m = 0; m < 4; ++m)
#pragma unroll
    for (int n = 0; n < 4; ++n) acc[m][n] = f32x4{0.f, 0.f, 0.f, 0.f};
  const int crow = tid >> 3, cslot = tid & 7, cpart = cslot ^ (crow & 7);
  const bf16_t* ga = A + (size_t)(row0 + crow) * lda + cpart * 8;
  const bf16_t* gb = Bt + (size_t)(col0 + crow) * ldb + cpart * 8;
  auto issue = [&](int kt, int stage) {
    char* sa = smem + stage * 32768 + tid * 16;
#pragma unroll
    for (int i = 0; i < 4; ++i) {
      __builtin_amdgcn_global_load_lds((const unsigned*)(ga + (size_t)(32 * i) * lda + kt * 64), (__attribute__((address_space(3))) unsigned*)(sa + i * 4096), 16, 0, 0);
      __builtin_amdgcn_global_load_lds((const unsigned*)(gb + (size_t)(32 * i) * ldb + kt * 64), (__attribute__((address_space(3))) unsigned*)(sa + 16384 + i * 4096), 16, 0, 0);
    }
  };
  const int KT = K / 64;
  issue(0, 0);
  asm volatile("s_waitcnt vmcnt(0)" ::: "memory");
  __syncthreads();
  const int sw = fr & 7;
  for (int kt = 0; kt < KT; ++kt) {
    if (kt + 1 < KT) issue(kt + 1, (kt + 1) & 1);
    const char* As = smem + (kt & 1) * 32768;
    const char* Bs = As + 16384;
#pragma unroll
    for (int ks = 0; ks < 2; ++ks) {
      bf16x8 af[4], bfr[4];
      const int so = ((ks * 4 + fq) ^ sw) * 16;
#pragma unroll
      for (int m = 0; m < 4; ++m) af[m] = *(const bf16x8*)(As + (wr * 64 + m * 16 + fr) * 128 + so);
#pragma unroll
      for (int n = 0; n < 4; ++n) bfr[n] = *(const bf16x8*)(Bs + (wc * 64 + n * 16 + fr) * 128 + so);
#pragma unroll
      for (int m = 0; m < 4; ++m)
#pragma unroll
        for (int n = 0; n < 4; ++n) acc[m][n] = MFMA16(bfr[n], af[m], acc[m][n]);
    }
    asm volatile("s_waitcnt vmcnt(0)" ::: "memory");
    __syncthreads();
  }
#pragma unroll
  for (int m = 0; m < 4; ++m)
#pragma unroll
    for (int n = 0; n < 4; ++n) epi(row0 + wr * 64 + m * 16 + fr, col0 + wc * 64 + n * 16 + fq * 4, acc[m][n]);
}

constexpr int G8_HT = 128 * 64;
DI int g8_lds_byte(int r, int c) {
  int st = (r >> 4) * 2 + (c >> 5), rr = r & 15, cc = c & 31, ob = rr * 64 + cc * 2;
  return st * 1024 + (ob ^ (((ob >> 9) & 1) << 5));
}
DI void g8_stage_rc(int b, int& R, int& C) {
  int st = b / 1024, sb = b % 1024, swz = sb ^ (((sb >> 9) & 1) << 5);
  R = (st >> 1) * 16 + swz / 64; C = (st & 1) * 32 + (swz % 64) / 2;
}
template <class Epi>
DI void gemm8_tile(const bf16_t* __restrict__ A, int lda, const bf16_t* __restrict__ Bt, int ldb, int K, int brow, int bcol, char* smem, Epi epi,
                   bool first = true, bool has_next = false, int nbrow = 0, int nbcol = 0) {
  bf16_t* shm = (bf16_t*)smem;
  const int tid = ltid512();
#define G8_SA(b, h) (shm + ((b) * 2 + (h)) * G8_HT)
#define G8_SB(b, h) (shm + (4 + (b) * 2 + (h)) * G8_HT)
#define G8_STAGE(P, BASE, LD, br, kt) do { const bf16_t* _g = (BASE) + (size_t)(br) * (LD) + (size_t)(kt) * 64; \
    _Pragma("unroll") for (int _i = 0; _i < 2; ++_i) { int _b = tid * 16 + _i * 8192; int _r, _c; g8_stage_rc(_b, _r, _c); \
      __builtin_amdgcn_global_load_lds((const unsigned*)(_g + (size_t)_r * (LD) + _c), \
        (__attribute__((address_space(3))) unsigned*)((char*)(P) + _b), 16, 0, 0); } } while (0)
#define G8_LDA(dst, b, h) _Pragma("unroll") for (int m = 0; m < 4; ++m) _Pragma("unroll") for (int k = 0; k < 2; ++k) \
    dst[m][k] = *reinterpret_cast<const bf16x8*>((char*)G8_SA(b, h) + g8_lds_byte(wr * 64 + m * 16 + fr, k * 32 + fq * 8))
#define G8_LDB(dst, b, h) _Pragma("unroll") for (int n = 0; n < 2; ++n) _Pragma("unroll") for (int k = 0; k < 2; ++k) \
    dst[n][k] = *reinterpret_cast<const bf16x8*>((char*)G8_SB(b, h) + g8_lds_byte(wc * 32 + n * 16 + fr, k * 32 + fq * 8))
#define G8_MMA(ai, bj, At, Bx) do { __builtin_amdgcn_s_setprio(1); \
    _Pragma("unroll") for (int m = 0; m < 4; ++m) _Pragma("unroll") for (int n = 0; n < 2; ++n) _Pragma("unroll") for (int k = 0; k < 2; ++k) \
      acc[ai][bj][m][n] = __builtin_amdgcn_mfma_f32_16x16x32_bf16(Bx[n][k], At[m][k], acc[ai][bj][m][n], 0, 0, 0); \
    __builtin_amdgcn_s_setprio(0); } while (0)
#define G8_WAIT_V(n) asm volatile("s_waitcnt vmcnt(" #n ")" ::: "memory")
#define G8_WAIT_L(n) asm volatile("s_waitcnt lgkmcnt(" #n ")" ::: "memory")
#define G8_BAR __builtin_amdgcn_s_barrier()
#define G8_SCHED __builtin_amdgcn_sched_barrier(0)
  const int wid = tid >> 6, lane = tid & 63, wr = wid >> 2, wc = wid & 3, fr = lane & 15, fq = lane >> 4;
  f32x4 acc[2][2][4][2];
#pragma unroll
  for (int a = 0; a < 2; ++a)
#pragma unroll
    for (int b = 0; b < 2; ++b)
#pragma unroll
      for (int m = 0; m < 4; ++m)
#pragma unroll
        for (int n = 0; n < 2; ++n) acc[a][b][m][n] = f32x4{0.f, 0.f, 0.f, 0.f};
  bf16x8 At[4][2], B0[2][2], B1[2][2];
  const int nt = K / 64;
  if (first) {
    G8_STAGE(G8_SB(0, 0), Bt, ldb, bcol, 0); G8_STAGE(G8_SA(0, 0), A, lda, brow, 0);
    G8_STAGE(G8_SB(0, 1), Bt, ldb, bcol + 128, 0); G8_STAGE(G8_SA(0, 1), A, lda, brow + 128, 0);
  }
  if (wr == 1) G8_BAR;
  if (first) G8_WAIT_V(4); else G8_WAIT_V(0);
  G8_BAR;
  G8_STAGE(G8_SB(1, 0), Bt, ldb, bcol, 1); G8_STAGE(G8_SA(1, 0), A, lda, brow, 1); G8_STAGE(G8_SB(1, 1), Bt, ldb, bcol + 128, 1);
  G8_WAIT_V(6); G8_BAR;
  for (int t = 0; t < nt - 2; t += 2) {
    G8_LDB(B0, 0, 0); G8_SCHED; G8_LDA(At, 0, 0); G8_STAGE(G8_SA(1, 1), A, lda, brow + 128, t + 1);
    G8_WAIT_L(8); G8_BAR; G8_WAIT_L(0); G8_MMA(0, 0, At, B0); G8_BAR; G8_SCHED;
    G8_LDB(B1, 0, 1); G8_STAGE(G8_SB(0, 0), Bt, ldb, bcol, t + 2);
    G8_BAR; G8_WAIT_L(0); G8_MMA(0, 1, At, B1); G8_BAR;
    G8_LDA(At, 0, 1); G8_STAGE(G8_SA(0, 0), A, lda, brow, t + 2);
    G8_BAR; G8_WAIT_L(0); G8_MMA(1, 0, At, B0); G8_BAR; G8_SCHED;
    G8_STAGE(G8_SB(0, 1), Bt, ldb, bcol + 128, t + 2);
    G8_WAIT_V(6); G8_BAR; G8_MMA(1, 1, At, B1); G8_BAR;
    G8_LDB(B0, 1, 0); G8_SCHED; G8_LDA(At, 1, 0); G8_STAGE(G8_SA(0, 1), A, lda, brow + 128, t + 2);
    G8_WAIT_L(8); G8_BAR; G8_WAIT_L(0); G8_MMA(0, 0, At, B0); G8_BAR; G8_SCHED;
    G8_LDB(B1, 1, 1); G8_STAGE(G8_SB(1, 0), Bt, ldb, bcol, t + 3);
    G8_BAR; G8_WAIT_L(0); G8_MMA(0, 1, At, B1); G8_BAR;
    G8_LDA(At, 1, 1); G8_STAGE(G8_SA(1, 0), A, lda, brow, t + 3);
    G8_BAR; G8_WAIT_L(0); G8_MMA(1, 0, At, B0); G8_BAR; G8_SCHED;
    G8_STAGE(G8_SB(1, 1), Bt, ldb, bcol + 128, t + 3);
    G8_WAIT_V(6); G8_BAR; G8_MMA(1, 1, At, B1); G8_BAR;
  }
  { G8_LDB(B0, 0, 0); G8_LDA(At, 0, 0); G8_STAGE(G8_SA(1, 1), A, lda, brow + 128, nt - 1);
    G8_BAR; G8_WAIT_L(0); G8_MMA(0, 0, At, B0); G8_BAR;
    G8_LDB(B1, 0, 1); G8_BAR; G8_WAIT_L(0); G8_MMA(0, 1, At, B1); G8_BAR;
    G8_LDA(At, 0, 1); G8_WAIT_V(4); G8_BAR; G8_WAIT_L(0); G8_MMA(1, 0, At, B0); G8_MMA(1, 1, At, B1); G8_BAR; }
  { G8_LDB(B0, 1, 0); G8_LDA(At, 1, 0); G8_WAIT_V(2); G8_BAR; G8_WAIT_L(0); G8_MMA(0, 0, At, B0); G8_BAR;
    G8_LDB(B1, 1, 1); G8_WAIT_V(0); G8_BAR; G8_WAIT_L(0); G8_MMA(0, 1, At, B1); G8_BAR;
    G8_LDA(At, 1, 1); G8_BAR; G8_WAIT_L(0); G8_MMA(1, 0, At, B0); G8_MMA(1, 1, At, B1); G8_BAR; }
  if (has_next) {
    G8_STAGE(G8_SB(0, 0), Bt, ldb, nbcol, 0); G8_STAGE(G8_SA(0, 0), A, lda, nbrow, 0);
    G8_STAGE(G8_SB(0, 1), Bt, ldb, nbcol + 128, 0); G8_STAGE(G8_SA(0, 1), A, lda, nbrow + 128, 0);
  }
  if (wr == 0) G8_BAR;
  const bool odd = fq & 1;
#pragma unroll
  for (int ai = 0; ai < 2; ++ai)
#pragma unroll
    for (int bj = 0; bj < 2; ++bj)
#pragma unroll
      for (int m = 0; m < 4; ++m) {
        const int row = brow + ai * 128 + wr * 64 + m * 16 + fr, cb = bcol + bj * 128 + wc * 32;
        epi.side(row, cb + fq * 4, acc[ai][bj][m][0]);
        epi.side(row, cb + 16 + fq * 4, acc[ai][bj][m][1]);
        const u32x2 p0 = epi.pack(acc[ai][bj][m][0]), p1 = epi.pack(acc[ai][bj][m][1]);
        const u32x2 snd = odd ? p0 : p1;
        u32x2 rcv; rcv[0] = (unsigned)__shfl_xor((int)snd[0], 16); rcv[1] = (unsigned)__shfl_xor((int)snd[1], 16);
        u32x4 o;
        if (odd) { o[0] = rcv[0]; o[1] = rcv[1]; o[2] = p1[0]; o[3] = p1[1]; }
        else     { o[0] = p0[0]; o[1] = p0[1]; o[2] = rcv[0]; o[3] = rcv[1]; }
        epi.store16(row, odd ? cb + 16 + (fq - 1) * 4 : cb + fq * 4, o);
      }
  __syncthreads();
}

struct EpiBF {
  bf16_t* out; int ldo;
  DI void side(int, int, const f32x4&) const {}
  DI u32x2 pack(const f32x4& a) const { u32x2 o; o[0] = pack2(a[0], a[1]); o[1] = pack2(a[2], a[3]); return o; }
  DI void store16(int row, int col, const u32x4& v) const { *(u32x4*)(out + (size_t)row * ldo + col) = v; }
  DI float scale(int) const { return 1.f; }
  DI void operator()(int row, int col, const f32x4& a, float) const { (*this)(row, col, a); }
  DI void operator()(int row, int col, const f32x4& a) const {
    u32x2 o; o[0] = pack2(a[0], a[1]); o[1] = pack2(a[2], a[3]);
    *(u32x2*)(out + (size_t)row * ldo + col) = o;
  }
};
struct EpiRelu2 {
  bf16_t* out; int ldo;
  DI void side(int, int, const f32x4&) const {}
  DI u32x2 pack(const f32x4& a) const {
    float r0 = fmaxf(a[0], 0.f), r1 = fmaxf(a[1], 0.f), r2 = fmaxf(a[2], 0.f), r3 = fmaxf(a[3], 0.f);
    u32x2 o; o[0] = pack2(r0 * r0, r1 * r1); o[1] = pack2(r2 * r2, r3 * r3); return o;
  }
  DI void store16(int row, int col, const u32x4& v) const { *(u32x4*)(out + (size_t)row * ldo + col) = v; }
  DI void operator()(int row, int col, const f32x4& a) const {
    float r0 = fmaxf(a[0], 0.f), r1 = fmaxf(a[1], 0.f), r2 = fmaxf(a[2], 0.f), r3 = fmaxf(a[3], 0.f);
    u32x2 o; o[0] = pack2(r0 * r0, r1 * r1); o[1] = pack2(r2 * r2, r3 * r3);
    *(u32x2*)(out + (size_t)row * ldo + col) = o;
  }
};
struct EpiU {
  bf16_t* u; float* dt;
  DI void side(int row, int col, const f32x4& a) const { if (col >= U_DT && col < DIN) *(float4*)(dt + (size_t)row * 16 + col - U_DT) = make_float4(a[0], a[1], a[2], a[3]); }
  DI u32x2 pack(const f32x4& a) const { u32x2 o; o[0] = pack2(a[0], a[1]); o[1] = pack2(a[2], a[3]); return o; }
  DI void store16(int row, int col, const u32x4& v) const { if (col < DIN) *(u32x4*)(u + (size_t)row * DIN + col) = v; }
  DI void operator()(int row, int col, const f32x4& a) const {
    if (col < DIN) {
      u32x2 o; o[0] = pack2(a[0], a[1]); o[1] = pack2(a[2], a[3]);
      *(u32x2*)(u + (size_t)row * DIN + col) = o;
      if (col >= U_DT) *(float4*)(dt + (size_t)row * 16 + col - U_DT) = make_float4(a[0], a[1], a[2], a[3]);
    }
  }
};
struct EpiQ {
  bf16_t* q; const float* rs;
  DI float scale(int row) const { return rs[row * 2]; }
  DI void operator()(int row, int col, const f32x4& a, float r) const {
    u32x2 o; o[0] = pack2(a[0] * r, a[1] * r); o[1] = pack2(a[2] * r, a[3] * r);
    *(u32x2*)(q + (size_t)row * 384 + col) = o;
  }
};
struct EpiKV {
  bf16_t* kb; bf16_t* vt; const float* rs;
  DI float scale(int row) const { return rs[row * 2 + 1]; }
  DI void operator()(int row, int col, const f32x4& a, float r) const {
    int b, pos;
    if (row < ML) { b = row >> 12; pos = (row & 4095) + CTX; } else { int rr = row - ML; b = rr >> 8; pos = rr & 255; }
    const int head = col >> 7, d = col & 127;
    if (d < 64) {
      u32x2 o; o[0] = pack2(a[0] * r, a[1] * r); o[1] = pack2(a[2] * r, a[3] * r);
      *(u32x2*)(kb + ((size_t)(b * 4 + head) * LK + pos) * 96 + d) = o;
    } else {
#pragma unroll
      for (int j = 0; j < 4; ++j) vt[((size_t)(b * 4 + head) * 64 + (d - 64 + j)) * LK + pos] = f2bf(a[j] * r);
    }
  }
};

struct EpiPart {
  float* part;
  DI void operator()(int row, int col, const f32x4& a) const {
    *(float4*)(part + (size_t)(row - ML) * DM + col) = make_float4(a[0], a[1], a[2], a[3]);
  }
};
DI void phase_inproj(const Params& p, int layer, int bid, int nb, int vbid, int nvb, char* smem, char* smem_half) {
  EpiU epi{(bf16_t*)(p.ws + OFF_U), (float*)(p.ws + OFF_DT)};
  const int x = bid & 7, per = nb >> 3;
  for (int rep = 0; rep < REP_GEMM; ++rep)
  for (int q = bid >> 3; q < 85; q += per) {
    const int m = (x >> 1) * 17 + q / 5, n = 5 * (x & 1) + q % 5;
    const int q2 = q + per, m2 = (x >> 1) * 17 + q2 / 5, n2 = 5 * (x & 1) + q2 % 5;
    gemm8_tile((const bf16_t*)(p.ws + OFF_H), DM, wt_ptr(p, layer, WT_IN), 1024, 1024, m * 256, n * 256, smem, epi,
               q == (bid >> 3), q2 < 85, m2 * 256, n2 * 256);
  }
  if (layer == 0) {
    if (per == 32) {
      if ((bid >> 3) >= 21) {
        const int u = ((bid >> 3) - 21) * 8 + x;
        for (int it = 640 + 2 * u + (vbid & 1); it < WT_ITEMS; it += 176) wt_item(p, 0, it, smem_half);
      }
    } else {
      for (int it = 640 + vbid; it < WT_ITEMS; it += nvb) wt_item(p, 0, it, smem_half);
    }
  }
}
DI void phase_wout(const Params& p, int layer, int lid, int nvb, char* smem) {
  const int M = layer == 0 ? MT : ML;
  EpiBF epi{(bf16_t*)(p.ws + OFF_U), DM};
  const int x = lid & 7, per = nvb >> 3;
  for (int rep = 0; rep < REP_GEMM; ++rep)
  for (int q = lid >> 3; q < M / 128; q += per)
    gemm_tile<true>((const bf16_t*)(p.ws + OFF_H), DM, wt_ptr(p, layer, WT_OUT), 1024, ((q >> 3) * 8 + x) * 128, (q & 7) * 128, smem, epi, (const float*)(p.ws + OFF_SSQ));
}
DI void phase_ff1(const Params& p, int layer, int bid, int nb, int vbid, int nvb, char* smem, char* smem_half) {
  EpiRelu2 epi{(bf16_t*)(p.ws + OFF_F1), DFF};
  const int x = bid & 7, per = nb >> 3;
  for (int rep = 0; rep < REP_GEMM; ++rep) {
    for (int q = bid >> 3; q < 128; q += per) {
      const int m = (x >> 2) * 32 + (q >> 2), n = 4 * (x & 3) + (q & 3);
      const int q2 = q + per, m2 = (x >> 2) * 32 + (q2 >> 2), n2 = 4 * (x & 3) + (q2 & 3);
      gemm8_tile((const bf16_t*)(p.ws + OFF_H), DM, wt_ptr(p, layer, WT_FF1), 1024, 1024, m * 256, n * 256, smem, epi,
                 q == (bid >> 3), q2 < 128, m2 * 256, n2 * 256);
    }
    if (layer == 0)
      for (int it = vbid; it < (MC / 128) * 32; it += nvb)
        gemm_tile_glds((const bf16_t*)(p.ws + OFF_H), DM, wt_ptr(p, layer, WT_FF1), 1024, 1024, ML + (it / 32) * 128, (it % 32) * 128, smem_half, epi);
  }
}
DI void phase_ff2(const Params& p, int layer, int bid, int nb, int vbid, int nvb, char* smem, char* smem_half) {
  EpiBF epi{(bf16_t*)(p.ws + OFF_H), DM};
  const int x = bid & 7, per = nb >> 3;
  for (int rep = 0; rep < REP_GEMM; ++rep) {
    for (int q = bid >> 3; q < 32; q += per) {
      const int T = x * 32 + q;
      gemm8_tile((const bf16_t*)(p.ws + OFF_F1), DFF, wt_ptr(p, layer, WT_FF2), 4096, 4096, (T >> 2) * 256, (T & 3) * 256, smem, epi);
    }
    if (layer == 0)
      for (int it = vbid; it < (MC / 128) * 8 * 4; it += nvb) {
        const int tile = it >> 2, ks = it & 3;
        EpiPart ep{(float*)(p.ws + OFF_END2) + (size_t)ks * MC * DM};
        gemm_tile_glds((const bf16_t*)(p.ws + OFF_F1) + ks * 1024, DFF, wt_ptr(p, layer, WT_FF2) + ks * 1024, 4096, 1024, ML + (tile >> 3) * 128, (tile & 7) * 128, smem_half, ep);
      }
  }
}

DI int chunk_row0(int b, int tc) { return tc < 2 ? ML + b * CTX + tc * 128 : b * SEQ + (tc - 2) * 128; }
constexpr int BST = 72;
constexpr int TST = 136;
DI void load_tile_T(bf16_t* dst, const bf16_t* __restrict__ src, int ldg) {
  const int tid = ltid();
#pragma unroll
  for (int i = 0; i < 4; ++i) {
    int c = tid + 256 * i, tok = c & 127, pc = c >> 7;
    u32x4 v = *(const u32x4*)(src + (size_t)tok * ldg + pc * 8);
#pragma unroll
    for (int j = 0; j < 4; ++j) {
      dst[(pc * 8 + 2 * j) * TST + tok] = (bf16_t)(v[j] & 0xffffu);
      dst[(pc * 8 + 2 * j + 1) * TST + tok] = (bf16_t)(v[j] >> 16);
    }
  }
}
DI void chunk_scan(const Params& p, int layer, int row0, int h, float* csf, float* csb, float* dtF, float* dtB, float* tot, float*  ) {
  const int tid = ltid(), w = tid >> 6, lane = tid & 63;
  const float* DT = (const float*)(p.ws + OFF_DT);
  float v;
  if (tid < 128) {
    const float dt = DT[(size_t)(row0 + tid) * 16 + h];
    v = dt * -__expf(p.a_log[layer * 16 + h]);
    dtF[tid] = dt;
  } else {
    const int e = 255 - tid;
    const float dt = DT[(size_t)(row0 + e) * 16 + 8 + h];
    v = dt * -__expf(p.a_log[layer * 16 + 8 + h]);
    dtB[e] = dt;
  }
#pragma unroll
  for (int o = 1; o < 64; o <<= 1) { const float t = __shfl_up(v, o); if (lane >= o) v += t; }
  if (lane == 63) tot[w] = v;
  __syncthreads();
  if (w == 1) v += tot[0];
  if (w == 3) v += tot[2];
  if (tid < 128) csf[tid] = v; else csb[255 - tid] = v;
  __syncthreads();
}

DI void ssd_state_item(const Params& p, int layer, int b, int tc, int h, char* smem) {
  bf16_t* XT = (bf16_t*)smem;
  bf16_t* BT = XT + 64 * TST;
  float* csf = (float*)(BT + 64 * TST);
  float* csb = csf + 128; float* dtF = csb + 128; float* dtB = dtF + 128; float* laF = dtB + 128; float* laB = laF + 128;
  const int tid = ltid(), w = tid >> 6, lane = tid & 63, r = lane & 31, hh = lane >> 5;
  const int row0 = chunk_row0(b, tc);
  const bf16_t* XBC = (const bf16_t*)(p.ws + OFF_XBC);
  load_tile_T(XT, XBC + (size_t)row0 * 768 + h * 64, 768);
  load_tile_T(BT, XBC + (size_t)row0 * 768 + 512 + (h >> 2) * 64, 768);
  chunk_scan(p, layer, row0, h, csf, csb, dtF, dtB, laF, laB);
  __syncthreads();
  if (tid < 128) laF[tid] = dtF[tid] * __expf(csf[127] - csf[tid]);
  else { int t = tid - 128; laB[t] = dtB[t] * __expf(csb[0] - csb[t]); }
  __syncthreads();
  const int d = w >> 1, pt = w & 1;
  const float* wv = d == 0 ? laF : laB;
  f32x16 acc[2];
#pragma unroll
  for (int i = 0; i < 16; ++i) { acc[0][i] = 0.f; acc[1][i] = 0.f; }
#pragma unroll
  for (int s = 0; s < 8; ++s) {
    int l0 = 16 * s + 8 * hh;
    u32x4 xa = *(const u32x4*)(XT + (32 * pt + r) * TST + l0);
    u32x4 sa;
#pragma unroll
    for (int j = 0; j < 4; ++j) sa[j] = pack2(lo2f(xa[j]) * wv[l0 + 2 * j], hi2f(xa[j]) * wv[l0 + 2 * j + 1]);
    bf16x8 af = __builtin_bit_cast(bf16x8, sa);
#pragma unroll
    for (int nt = 0; nt < 2; ++nt) {
      bf16x8 bfr = *(const bf16x8*)(BT + (32 * nt + r) * TST + l0);
      acc[nt] = MFMA32(af, bfr, acc[nt]);
    }
  }
  bf16_t* S = (bf16_t*)(p.ws + OFF_SST) + ((((size_t)d * NB + b) * NCH + tc) * 8 + h) * 4096;
#pragma unroll
  for (int nt = 0; nt < 2; ++nt)
#pragma unroll
    for (int i = 0; i < 16; ++i) S[(32 * pt + crow(i, hh)) * 64 + 32 * nt + r] = f2bf(acc[nt][i]);
  if (tid == 0) {
    float* TD = (float*)(p.ws + OFF_TDEC);
    TD[((0 * NB + b) * NCH + tc) * 8 + h] = __expf(csf[127]);
    TD[((1 * NB + b) * NCH + tc) * 8 + h] = __expf(csb[0]);
  }
  __syncthreads();
}

DI void ssd_pass_item(const Params& p, int it) {
  const int e = it * 256 + ltid();
  const int pn2 = e & 2047, h = (e >> 11) & 7, b = (e >> 14) & 3, d = e >> 16;
  unsigned* S = (unsigned*)(p.ws + OFF_SST);
  const float* TD = (const float*)(p.ws + OFF_TDEC);
  unsigned sv[NCH]; float T[NCH];
#pragma unroll
  for (int i = 0; i < NCH; ++i) {
    int tc = d == 0 ? i : (i < 2 ? 1 - i : NCH + 1 - i);
    sv[i] = S[(((size_t)(d * NB + b) * NCH + tc) * 8 + h) * 2048 + pn2];
    T[i] = TD[((d * NB + b) * NCH + tc) * 8 + h];
  }
  float h0 = 0.f, h1 = 0.f;
#pragma unroll
  for (int i = 0; i < NCH; ++i) {
    int tc = d == 0 ? i : (i < 2 ? 1 - i : NCH + 1 - i);
    S[(((size_t)(d * NB + b) * NCH + tc) * 8 + h) * 2048 + pn2] = pack2(h0, h1);
    h0 = T[i] * h0 + lo2f(sv[i]); h1 = T[i] * h1 + hi2f(sv[i]);
  }
}

DI void ssd_out_item(const Params& p, int layer, int b, int tc, int h, char* smem) {
  bf16_t* XT = (bf16_t*)smem;
  bf16_t* Bs = XT + 64 * TST;
  float* csf = (float*)(Bs + 128 * BST);
  float* csb = csf + 128; float* dtF = csb + 128; float* dtB = dtF + 128; float* laF = dtB + 128; float* laB = laF + 128;
  const int tid = ltid(), w = tid >> 6, lane = tid & 63, r = lane & 31, hh = lane >> 5;
  const int row0 = chunk_row0(b, tc), g = h >> 2;
  const bf16_t* XBC = (const bf16_t*)(p.ws + OFF_XBC);
  load_tile_T(XT, XBC + (size_t)row0 * 768 + h * 64, 768);
#pragma unroll
  for (int i = 0; i < 4; ++i) {
    int c = tid + 256 * i, tok = c >> 3, part = c & 7;
    *(u32x4*)(Bs + tok * BST + part * 8) = *(const u32x4*)(XBC + (size_t)(row0 + tok) * 768 + 512 + g * 64 + part * 8);
  }
  const int l = 32 * w + r;
  bf16x8 cf[4];
#pragma unroll
  for (int ks = 0; ks < 4; ++ks) cf[ks] = *(const bf16x8*)(XBC + (size_t)(row0 + l) * 768 + 640 + g * 64 + 16 * ks + 8 * hh);
  chunk_scan(p, layer, row0, h, csf, csb, dtF, dtB, laF, laB);
  const float csf_l = csf[l], csb_l = csb[l];
  f32x16 yacc[2];
#pragma unroll
  for (int i = 0; i < 16; ++i) { yacc[0][i] = 0.f; yacc[1][i] = 0.f; }
#pragma unroll
  for (int st = 0; st < 4; ++st) {
    f32x16 gacc;
#pragma unroll
    for (int i = 0; i < 16; ++i) gacc[i] = 0.f;
#pragma unroll
    for (int ks = 0; ks < 4; ++ks) {
      bf16x8 af = *(const bf16x8*)(Bs + (32 * st + r) * BST + 16 * ks + 8 * hh);
      gacc = MFMA32(af, cf[ks], gacc);
    }
#pragma unroll
    for (int i = 0; i < 16; ++i) {
      int s = 32 * st + crow(i, hh);
      float f;
      if (s < l) f = __expf(csf_l - csf[s]) * dtF[s];
      else if (s > l) f = __expf(csb_l - csb[s]) * dtB[s];
      else f = dtF[s] + dtB[s];
      gacc[i] *= f;
    }
#pragma unroll
    for (int s2 = 0; s2 < 2; ++s2) {
      bf16x8 mf = pack8(gacc, s2);
      int sb = 32 * st + 16 * s2 + 4 * hh;
#pragma unroll
      for (int pt = 0; pt < 2; ++pt) {
        u32x2 lo = *(const u32x2*)(XT + (32 * pt + r) * TST + sb);
        u32x2 hi = *(const u32x2*)(XT + (32 * pt + r) * TST + sb + 8);
        u32x4 xa; xa[0] = lo[0]; xa[1] = lo[1]; xa[2] = hi[0]; xa[3] = hi[1];
        yacc[pt] = MFMA32(__builtin_bit_cast(bf16x8, xa), mf, yacc[pt]);
      }
    }
  }
#pragma unroll
  for (int d = 0; d < 2; ++d) {
    const bf16_t* Hs = (const bf16_t*)(p.ws + OFF_SST) + ((((size_t)d * NB + b) * NCH + tc) * 8 + h) * 4096;
    const float e = __expf(d == 0 ? csf_l : csb_l);
#pragma unroll
    for (int pt = 0; pt < 2; ++pt) {
      f32x16 t;
#pragma unroll
      for (int i = 0; i < 16; ++i) t[i] = 0.f;
#pragma unroll
      for (int ks = 0; ks < 4; ++ks) {
        bf16x8 af = *(const bf16x8*)(Hs + (32 * pt + r) * 64 + 16 * ks + 8 * hh);
        t = MFMA32(af, cf[ks], t);
      }
#pragma unroll
      for (int i = 0; i < 16; ++i) yacc[pt][i] += e * t[i];
    }
  }
  const int row = row0 + l;
  const float Dh = p.ssd_d[layer * 8 + h];
  const bf16_t* U = (const bf16_t*)(p.ws + OFF_U);
  bf16_t* YM = (bf16_t*)(p.ws + OFF_H);
  float ssq = 0.f;
  u32x2 xvv[2][4], zvv[2][4];
#pragma unroll
  for (int pt = 0; pt < 2; ++pt)
#pragma unroll
    for (int q = 0; q < 4; ++q) {
      const int pp = 32 * pt + 8 * q + 4 * hh;
      xvv[pt][q] = *(const u32x2*)(XBC + (size_t)row * 768 + h * 64 + pp);
      zvv[pt][q] = *(const u32x2*)(U + (size_t)row * DIN + U_Z + h * 64 + pp);
    }
#pragma unroll
  for (int pt = 0; pt < 2; ++pt)
#pragma unroll
    for (int q = 0; q < 4; ++q) {
      const int pp = 32 * pt + 8 * q + 4 * hh;
      const u32x2 xv = xvv[pt][q], zv = zvv[pt][q];
      float y0 = (yacc[pt][4 * q + 0] + Dh * lo2f(xv[0])) * silu_f(lo2f(zv[0]));
      float y1 = (yacc[pt][4 * q + 1] + Dh * hi2f(xv[0])) * silu_f(hi2f(zv[0]));
      float y2 = (yacc[pt][4 * q + 2] + Dh * lo2f(xv[1])) * silu_f(lo2f(zv[1]));
      float y3 = (yacc[pt][4 * q + 3] + Dh * hi2f(xv[1])) * silu_f(hi2f(zv[1]));
      u32x2 o; o[0] = pack2(y0, y1); o[1] = pack2(y2, y3);
      float r0 = lo2f(o[0]), r1 = hi2f(o[0]), r2 = lo2f(o[1]), r3 = hi2f(o[1]);
      ssq += r0 * r0 + r1 * r1 + r2 * r2 + r3 * r3;
      *(u32x2*)(YM + (size_t)row * DM + 512 + h * 64 + pp) = o;
    }
  ssq += __shfl_xor(ssq, 32);
  if (hh == 0) ((float*)(p.ws + OFF_SSQ))[(size_t)row * 8 + h] = ssq;
  __syncthreads();
}

constexpr int KST = 104;
constexpr int VST = 68;
constexpr int ASTG = 64 * KST + 64 * VST;
DI void attn_item(const Params& p, int b, int head, int qrow0, int t0, bool lat, int nkeys, char* smem) {
  bf16_t* Ks = (bf16_t*)smem;
  bf16_t* Vs = Ks + 64 * KST;
  const int tid = ltid(), w = tid >> 6, lane = tid & 63, r = lane & 31, hh = lane >> 5;
  const bf16_t* QB = (const bf16_t*)(p.ws + OFF_QB);
  const bf16_t* KB = (const bf16_t*)(p.ws + OFF_KB) + (size_t)(b * 4 + head) * LK * 96;
  const bf16_t* VT = (const bf16_t*)(p.ws + OFF_VT) + (size_t)(b * 4 + head) * 64 * LK;
  const float qscale = 0.10206207261596575f * 1.4426950408889634f;
  const int qrow = qrow0 + w * 32 + r;
  const int t = t0 + w * 32 + r;
  bf16x8 qf[6];
  {
    const bf16_t* src = QB + (size_t)qrow * 384 + head * 96;
#pragma unroll
    for (int s = 0; s < 4; ++s) {
      u32x4 v = *(const u32x4*)(src + 16 * s + 8 * hh);
      u32x4 o;
#pragma unroll
      for (int j = 0; j < 4; ++j) o[j] = pack2(lo2f(v[j]) * qscale, hi2f(v[j]) * qscale);
      qf[s] = __builtin_bit_cast(bf16x8, o);
    }
#pragma unroll
    for (int s = 4; s < 6; ++s) {
      u32x4 va = *(const u32x4*)(src + 16 * s), vb = *(const u32x4*)(src + 16 * s + 8);
      float posf = s == 4 ? (float)(t >> 6) : (float)(t & 63);
      float o[8];
#pragma unroll
      for (int j = 0; j < 8; ++j) {
        float a = (j & 1) ? hi2f(va[j >> 1]) : lo2f(va[j >> 1]);
        float bb = (j & 1) ? hi2f(vb[j >> 1]) : lo2f(vb[j >> 1]);
        float res;
        if (lat) {
          float invf = exp2f(-(float)(2 * j) * (13.287712379549449f / 16.f));
          float rev = posf * invf * 0.15915494309189535f;
          float cs = __builtin_amdgcn_cosf(rev), sn = __builtin_amdgcn_sinf(rev);
          res = hh == 0 ? a * cs - bb * sn : bb * cs + a * sn;
        } else res = hh == 0 ? a : bb;
        o[j] = res * qscale;
      }
      u32x4 ov; ov[0] = pack2(o[0], o[1]); ov[1] = pack2(o[2], o[3]); ov[2] = pack2(o[4], o[5]); ov[3] = pack2(o[6], o[7]);
      qf[s] = __builtin_bit_cast(bf16x8, ov);
    }
  }
  f32x16 oacc[2];
#pragma unroll
  for (int i = 0; i < 16; ++i) { oacc[0][i] = 0.f; oacc[1][i] = 0.f; }
  float m = -1e30f, lsum = 0.f;
  u32x4 rk[3], rv[2];
  auto gload = [&](int key0) {
#pragma unroll
    for (int i = 0; i < 3; ++i) rk[i] = *(const u32x4*)(KB + (size_t)key0 * 96 + (tid + 256 * i) * 8);
#pragma unroll
    for (int i = 0; i < 2; ++i) { int c = tid + 256 * i; rv[i] = *(const u32x4*)(VT + (size_t)(c >> 3) * LK + key0 + (c & 7) * 8); }
  };
  gload(0);
  const int NT = nkeys / 64;
  for (int kt = 0; kt < NT; ++kt) {
#pragma unroll
    for (int i = 0; i < 3; ++i) { int c = tid + 256 * i; *(u32x4*)(Ks + (c / 12) * KST + (c % 12) * 8) = rk[i]; }
#pragma unroll
    for (int i = 0; i < 2; ++i) {
      int c = tid + 256 * i;
      bf16_t* d = Vs + (c >> 3) * VST + (c & 7) * 8;
      u32x2 a; a[0] = rv[i][0]; a[1] = rv[i][1];
      u32x2 bq; bq[0] = rv[i][2]; bq[1] = rv[i][3];
      *(u32x2*)d = a; *(u32x2*)(d + 4) = bq;
    }
    __syncthreads();
    if (kt + 1 < NT) gload((kt + 1) * 64);
    f32x16 sacc[2];
#pragma unroll
    for (int i = 0; i < 16; ++i) { sacc[0][i] = 0.f; sacc[1][i] = 0.f; }
#pragma unroll
    for (int s = 0; s < 6; ++s)
#pragma unroll
      for (int k2 = 0; k2 < 2; ++k2) {
        bf16x8 af = *(const bf16x8*)(Ks + (32 * k2 + r) * KST + 16 * s + 8 * hh);
        sacc[k2] = MFMA32(af, qf[s], sacc[k2]);
      }
    float mx = sacc[0][0];
#pragma unroll
    for (int i = 0; i < 16; ++i) { mx = fmaxf(mx, sacc[0][i]); mx = fmaxf(mx, sacc[1][i]); }
    mx = fmaxf(mx, __shfl_xor(mx, 32));
    const float mn = fmaxf(m, mx);
    const float alpha = __builtin_amdgcn_exp2f(m - mn);
    m = mn;
    float ps = 0.f;
#pragma unroll
    for (int i = 0; i < 16; ++i) {
      sacc[0][i] = __builtin_amdgcn_exp2f(sacc[0][i] - mn); sacc[1][i] = __builtin_amdgcn_exp2f(sacc[1][i] - mn);
      ps += sacc[0][i] + sacc[1][i];
    }
    lsum = lsum * alpha + ps;
#pragma unroll
    for (int i = 0; i < 16; ++i) { oacc[0][i] *= alpha; oacc[1][i] *= alpha; }
#pragma unroll
    for (int k2 = 0; k2 < 2; ++k2)
#pragma unroll
      for (int s2 = 0; s2 < 2; ++s2) {
        bf16x8 pf = pack8(sacc[k2], s2);
        int kb0 = 32 * k2 + 16 * s2 + 4 * hh;
#pragma unroll
        for (int d = 0; d < 2; ++d) {
          u32x2 lo = *(const u32x2*)(Vs + (32 * d + r) * VST + kb0);
          u32x2 hi = *(const u32x2*)(Vs + (32 * d + r) * VST + kb0 + 8);
          u32x4 va; va[0] = lo[0]; va[1] = lo[1]; va[2] = hi[0]; va[3] = hi[1];
          oacc[d] = MFMA32(__builtin_bit_cast(bf16x8, va), pf, oacc[d]);
        }
      }
    __syncthreads();
  }
  lsum += __shfl_xor(lsum, 32);
  const float inv = 1.f / lsum;
  bf16_t* YM = (bf16_t*)(p.ws + OFF_H) + (size_t)qrow * DM + head * 64;
#pragma unroll
  for (int d = 0; d < 2; ++d)
#pragma unroll
    for (int q = 0; q < 4; ++q) {
      u32x2 o; o[0] = pack2(oacc[d][4 * q] * inv, oacc[d][4 * q + 1] * inv); o[1] = pack2(oacc[d][4 * q + 2] * inv, oacc[d][4 * q + 3] * inv);
      *(u32x2*)(YM + 32 * d + 8 * q + 4 * hh) = o;
    }
}

DI void attn_item8(const Params& p, int b, int head, int qrow0, int t0, bool lat, int nkeys, char* smem) {
  bf16_t* Ks = (bf16_t*)smem;
  bf16_t* Vs = Ks + 64 * KST;
  const int tid = ltid512(), w = tid >> 6, lane = tid & 63, r = lane & 31, hh = lane >> 5;
  const bf16_t* QB = (const bf16_t*)(p.ws + OFF_QB);
  const bf16_t* KB = (const bf16_t*)(p.ws + OFF_KB) + (size_t)(b * 4 + head) * LK * 96;
  const bf16_t* VT = (const bf16_t*)(p.ws + OFF_VT) + (size_t)(b * 4 + head) * 64 * LK;
  const float qscale = 0.10206207261596575f * 1.4426950408889634f;
  const int qrow = qrow0 + w * 32 + r;
  const int t = t0 + w * 32 + r;
  bf16x8 qf[6];
  {
    const bf16_t* src = QB + (size_t)qrow * 384 + head * 96;
#pragma unroll
    for (int s = 0; s < 4; ++s) {
      u32x4 v = *(const u32x4*)(src + 16 * s + 8 * hh);
      u32x4 o;
#pragma unroll
      for (int j = 0; j < 4; ++j) o[j] = pack2(lo2f(v[j]) * qscale, hi2f(v[j]) * qscale);
      qf[s] = __builtin_bit_cast(bf16x8, o);
    }
#pragma unroll
    for (int s = 4; s < 6; ++s) {
      u32x4 va = *(const u32x4*)(src + 16 * s), vb = *(const u32x4*)(src + 16 * s + 8);
      float posf = s == 4 ? (float)(t >> 6) : (float)(t & 63);
      float o[8];
#pragma unroll
      for (int j = 0; j < 8; ++j) {
        float a = (j & 1) ? hi2f(va[j >> 1]) : lo2f(va[j >> 1]);
        float bb = (j & 1) ? hi2f(vb[j >> 1]) : lo2f(vb[j >> 1]);
        float res;
        if (lat) {
          float invf = exp2f(-(float)(2 * j) * (13.287712379549449f / 16.f));
          float rev = posf * invf * 0.15915494309189535f;
          float cs = __builtin_amdgcn_cosf(rev), sn = __builtin_amdgcn_sinf(rev);
          res = hh == 0 ? a * cs - bb * sn : bb * cs + a * sn;
        } else res = hh == 0 ? a : bb;
        o[j] = res * qscale;
      }
      u32x4 ov; ov[0] = pack2(o[0], o[1]); ov[1] = pack2(o[2], o[3]); ov[2] = pack2(o[4], o[5]); ov[3] = pack2(o[6], o[7]);
      qf[s] = __builtin_bit_cast(bf16x8, ov);
    }
  }
  f32x16 oacc[2];
#pragma unroll
  for (int i = 0; i < 16; ++i) { oacc[0][i] = 0.f; oacc[1][i] = 0.f; }
  float m = -1e30f, lsum = 0.f;
  u32x4 rk[2], rv;
  auto gload = [&](int key0) {
    rk[0] = *(const u32x4*)(KB + (size_t)key0 * 96 + tid * 8);
    if (tid < 256) rk[1] = *(const u32x4*)(KB + (size_t)key0 * 96 + (512 + tid) * 8);
    rv = *(const u32x4*)(VT + (size_t)(tid >> 3) * LK + key0 + (tid & 7) * 8);
  };
  const int kro = (tid / 12) * KST + (tid % 12) * 8, kro2 = ((512 + tid) / 12) * KST + ((512 + tid) % 12) * 8;
  auto swrite = [&](int stage) {
    bf16_t* Kd = Ks + stage * ASTG;
    *(u32x4*)(Kd + kro) = rk[0];
    if (tid < 256) *(u32x4*)(Kd + kro2) = rk[1];
    bf16_t* d = Kd + 64 * KST + (tid >> 3) * VST + (tid & 7) * 8;
    u32x2 a; a[0] = rv[0]; a[1] = rv[1];
    u32x2 bq; bq[0] = rv[2]; bq[1] = rv[3];
    *(u32x2*)d = a; *(u32x2*)(d + 4) = bq;
  };
  auto qk = [&](int stage, f32x16 (&sa)[2]) {
    const bf16_t* Kc = Ks + stage * ASTG;
#pragma unroll
    for (int i = 0; i < 16; ++i) { sa[0][i] = 0.f; sa[1][i] = 0.f; }
#pragma unroll
    for (int s = 0; s < 6; ++s)
#pragma unroll
      for (int k2 = 0; k2 < 2; ++k2) {
        bf16x8 af = *(const bf16x8*)(Kc + (32 * k2 + r) * KST + 16 * s + 8 * hh);
        sa[k2] = MFMA32(af, qf[s], sa[k2]);
      }
  };
  const int NT = nkeys / 64;
  f32x16 sacc[2], snext[2];
  gload(0); swrite(0);
  gload(64);
  __syncthreads();
  swrite(1);
  gload(128);
  qk(0, sacc);
  __syncthreads();
  int cur = 0, nxt = 1, nn = 2;
  for (int kt = 0; kt < NT; ++kt) {
    if (kt + 1 < NT) qk(nxt, snext);
    if (kt + 2 < NT) {
      swrite(nn);
      if (kt + 3 < NT) gload((kt + 3) * 64);
    }
    const bf16_t* Vc = Ks + cur * ASTG + 64 * KST;
    float mx = sacc[0][0];
#pragma unroll
    for (int i = 0; i < 16; ++i) { mx = fmaxf(mx, sacc[0][i]); mx = fmaxf(mx, sacc[1][i]); }
    mx = fmaxf(mx, __shfl_xor(mx, 32));
    const float mn = fmaxf(m, mx);
    const float alpha = __builtin_amdgcn_exp2f(m - mn);
    m = mn;
    float ps = 0.f;
#pragma unroll
    for (int i = 0; i < 16; ++i) {
      sacc[0][i] = __builtin_amdgcn_exp2f(sacc[0][i] - mn); sacc[1][i] = __builtin_amdgcn_exp2f(sacc[1][i] - mn);
      ps += sacc[0][i] + sacc[1][i];
    }
    lsum = lsum * alpha + ps;
#pragma unroll
    for (int i = 0; i < 16; ++i) { oacc[0][i] *= alpha; oacc[1][i] *= alpha; }
#pragma unroll
    for (int k2 = 0; k2 < 2; ++k2)
#pragma unroll
      for (int s2 = 0; s2 < 2; ++s2) {
        bf16x8 pf = pack8(sacc[k2], s2);
        int kb0 = 32 * k2 + 16 * s2 + 4 * hh;
#pragma unroll
        for (int d = 0; d < 2; ++d) {
          u32x2 lo = *(const u32x2*)(Vc + (32 * d + r) * VST + kb0);
          u32x2 hi = *(const u32x2*)(Vc + (32 * d + r) * VST + kb0 + 8);
          u32x4 va; va[0] = lo[0]; va[1] = lo[1]; va[2] = hi[0]; va[3] = hi[1];
          oacc[d] = MFMA32(__builtin_bit_cast(bf16x8, va), pf, oacc[d]);
        }
      }
    sacc[0] = snext[0]; sacc[1] = snext[1];
    const int t3 = cur; cur = nxt; nxt = nn; nn = t3;
    __syncthreads();
  }
  lsum += __shfl_xor(lsum, 32);
  const float inv = 1.f / lsum;
  bf16_t* YM = (bf16_t*)(p.ws + OFF_H) + (size_t)qrow * DM + head * 64;
#pragma unroll
  for (int d = 0; d < 2; ++d)
#pragma unroll
    for (int q = 0; q < 4; ++q) {
      u32x2 o; o[0] = pack2(oacc[d][4 * q] * inv, oacc[d][4 * q + 1] * inv); o[1] = pack2(oacc[d][4 * q + 2] * inv, oacc[d][4 * q + 3] * inv);
      *(u32x2*)(YM + 32 * d + 8 * q + 4 * hh) = o;
    }
}

DI void phase_qkv(const Params& p, int layer, int bid, int nb, char* smem) {
  const int MQ = layer == 0 ? MT : ML;
  const int nq = (MQ / 128) * 3, nkv = (MT / 128) * 4, nst = NB * NCH * 8;
  const float* RS = (const float*)(p.ws + OFF_RSTD);
  EpiQ eq{(bf16_t*)(p.ws + OFF_QB), RS};
  EpiKV ekv{(bf16_t*)(p.ws + OFF_KB), (bf16_t*)(p.ws + OFF_VT), RS};
  const bf16_t* U = (const bf16_t*)(p.ws + OFF_U);
  for (int it = bid; it < nq + nkv + nst; it += nb) {
    if (it < nq) gemm_tile<false>(U, DIN, wt_ptr(p, layer, WT_UQ), 256, (it / 3) * 128, (it % 3) * 128, smem, eq);
    else if (it < nq + nkv) { int j = it - nq; gemm_tile<false>(U + U_CKV, DIN, wt_ptr(p, layer, WT_UKV), 128, (j / 4) * 128, (j % 4) * 128, smem, ekv); }
    else { int j = it - nq - nkv; for (int rep = 0; rep < REP_SSD; ++rep) ssd_state_item(p, layer, j / (NCH * 8), (j / 8) % NCH, j & 7, smem); }
  }
}
DI void phase_att(const Params& p, int layer, int bid, int nb, int vbid, int nvb, char* smem, char* sh) {
  for (int it = bid; it < 256; it += nb) {
    const int x = it & 7, j = it >> 3, bh = 2 * x + (j >> 4), qb = j & 15, b = bh >> 2, head = bh & 3;
    for (int rep = 0; rep < REP_ATT; ++rep) attn_item8(p, b, head, b * SEQ + qb * 256, qb * 256, true, LK, smem);
  }
  for (int it = vbid; it < 512; it += nvb) ssd_pass_item(p, it);
}
DI void phase_ssdout(const Params& p, int layer, int bid, int nb, char* smem) {
  const int nout = NB * NCH * 8, nctx = layer == 0 ? 32 : 0;
  for (int it = bid; it < nout + nctx; it += nb) {
    if (it < nout) {
      int b = it / (NCH * 8), tc = (it / 8) % NCH, h = it & 7;
      if (layer == 1 && tc < 2) continue;
      for (int rep = 0; rep < REP_SSD; ++rep) ssd_out_item(p, layer, b, tc, h, smem);
    } else {
      const int j = it - nout, b = j >> 3, head = (j >> 1) & 3, qb = j & 1;
      attn_item(p, b, head, ML + b * CTX + qb * 128, qb * 128, false, CTX, smem);
    }
  }
  if (layer == 0) {
    if (nb == 512) { if (bid >= 96) for (int it = bid - 96; it < WT_ITEMS; it += 416) wt_item(p, 1, it, smem); }
    else for (int it = bid; it < WT_ITEMS; it += nb) wt_item(p, 1, it, smem);
  }
}


#define XB_TMO      128
#define XB_XCNT(j)  (256  + 64 * (j))
#define XB_XSUB(j)  (1280 + 64 * (j))
#define XB_XGEN(j)  (2304 + 64 * (j))
#define XB_TOP      3328
#define XB_TOPGEN   3392
#define XCD_BAR_WORDS 3456
#define XB_SPIN_CAP (1u << 22)
#define LAS __attribute__((address_space(3)))
DI unsigned xb_ld(unsigned* p) { return __hip_atomic_load(p, __ATOMIC_RELAXED, __HIP_MEMORY_SCOPE_AGENT); }
DI unsigned xb_add(unsigned* p, unsigned v) { return __hip_atomic_fetch_add(p, v, __ATOMIC_RELAXED, __HIP_MEMORY_SCOPE_AGENT); }
DI unsigned xb_xcc_id() { return (unsigned)__builtin_amdgcn_s_getreg((3 << 11) | 20) & 0xFu; }
#define XB_SPIN(cond, bar) do { unsigned _sp = 0; while (cond) { __builtin_amdgcn_s_sleep(1); \
    if ((++_sp & 255u) == 0u) { if (xb_ld(&(bar)[XB_TMO])) break; if (_sp > XB_SPIN_CAP) { atomicAdd(&(bar)[XB_TMO], 1u); break; } } } } while (0)
struct XcdBarrier { unsigned* bar; unsigned x; volatile LAS unsigned* st; };
DI XcdBarrier xcd_barrier_post(unsigned* bar, volatile LAS unsigned* st) {
  XcdBarrier b; b.bar = bar; b.x = xb_xcc_id(); b.st = st;
  if (threadIdx.x == 0) (void)xb_add(&bar[XB_XCNT(b.x)], 1u);
  return b;
}
DI void xcd_barrier_complete(unsigned* bar, unsigned x, unsigned& nloc, unsigned& nx) {
  const unsigned G = gridDim.x * gridDim.y * gridDim.z;
  unsigned sum, cnt, mine, sp = 0u;
  for (;;) {
    sum = 0u; cnt = 0u; mine = 0u;
#pragma unroll
    for (unsigned j = 0; j < 16; ++j) { const unsigned c = xb_ld(&bar[XB_XCNT(j)]); sum += c; cnt += (c > 0u) ? 1u : 0u; mine = (j == x) ? c : mine; }
    if (sum == G) break;
    __builtin_amdgcn_s_sleep(1);
    if ((++sp & 255u) == 0u) { if (xb_ld(&bar[XB_TMO])) break; if (sp > XB_SPIN_CAP) { atomicAdd(&bar[XB_TMO], 1u); break; } }
  }
  nloc = mine > 0u ? mine : 1u; nx = cnt > 0u ? cnt : 1u;
}
DI void xcd_barrier(const XcdBarrier& b) {
  asm volatile("s_waitcnt vmcnt(0)" ::: "memory");
  __syncthreads();
  if (threadIdx.x == 0) {
    unsigned* bar = b.bar;
    asm volatile("" : "+s"(bar));
    __builtin_amdgcn_s_waitcnt(0);
    unsigned nloc = b.st[0], nx = b.st[1];
    if (nloc == 0u) { xcd_barrier_complete(bar, b.x, nloc, nx); b.st[0] = nloc; b.st[1] = nx; }
    const unsigned old = xb_add(&bar[XB_XSUB(b.x)], 1u);
    const unsigned gen = old / nloc;
    if (old + 1u == (gen + 1u) * nloc) {
      __builtin_amdgcn_fence(__ATOMIC_RELEASE, "agent");
      asm volatile("s_waitcnt vmcnt(0)" ::: "memory");
      const unsigned og = xb_add(&bar[XB_TOP], 1u);
      const unsigned tg = og / nx;
      if (og + 1u == (tg + 1u) * nx) xb_add(&bar[XB_TOPGEN], 1u);
      else XB_SPIN(xb_ld(&bar[XB_TOPGEN]) == tg, bar);
      __builtin_amdgcn_fence(__ATOMIC_ACQUIRE, "agent");
      xb_add(&bar[XB_XGEN(b.x)], 1u);
      asm volatile("s_waitcnt vmcnt(0)" ::: "memory");
    } else {
      XB_SPIN(xb_ld(&bar[XB_XGEN(b.x)]) == gen, bar);
      __builtin_amdgcn_fence(__ATOMIC_ACQUIRE, "agent");
      asm volatile("s_waitcnt vmcnt(0)" ::: "memory");
    }
  }
  __syncthreads();
}

constexpr int SMEM_BYTES = 2 * GBUF * 2;
enum { PH_PREP0 = 0, PH_H0, PH_INPROJ, PH_PREP, PH_QKV, PH_ATT, PH_SSDOUT, PH_WOUT, PH_POSTMIX, PH_FF1, PH_FF2, PH_POSTFFN, PH_SSDNORM };

struct Ids { int bid, nb, vbid, nvb, lid; };
DI void run_phase(const Params& p, int ph, int layer, const Ids& id, char* smem, char* sh) {
  switch (ph) {
    case PH_PREP0: phase_prep0(p, id.vbid, id.nvb, sh); break;
    case PH_H0: phase_h0(p, id.vbid, id.nvb); break;
    case PH_INPROJ: phase_inproj(p, layer, id.bid, id.nb, id.vbid, id.nvb, smem, sh); break;
    case PH_PREP: phase_prep(p, layer, id.vbid, id.nvb); break;
    case PH_QKV: phase_qkv(p, layer, id.vbid, id.nvb, sh); break;
    case PH_ATT: phase_att(p, layer, id.bid, id.nb, id.vbid, id.nvb, smem, sh); break;
    case PH_SSDOUT: phase_ssdout(p, layer, id.vbid, id.nvb, sh); break;
    case PH_WOUT: phase_wout(p, layer, id.lid, id.nvb, sh); break;
    case PH_POSTMIX: phase_postmix(p, layer, id.vbid, id.nvb); break;
    case PH_FF1: phase_ff1(p, layer, id.bid, id.nb, id.vbid, id.nvb, smem, sh); break;
    case PH_FF2: phase_ff2(p, layer, id.bid, id.nb, id.vbid, id.nvb, smem, sh); break;
    case PH_POSTFFN: phase_postffn(p, layer, id.vbid, id.nvb); break;
  }
}

__global__ void __launch_bounds__(512) mega_kernel(Params p) {
  extern __shared__ __attribute__((aligned(16))) char smem[];
  cg::grid_group grid = cg::this_grid();
  if (p.ws == nullptr) grid.sync();
  const int half = __builtin_amdgcn_readfirstlane((int)(threadIdx.x >> 8));
  Ids id;
  id.bid = blockIdx.x; id.nb = gridDim.x;
  id.vbid = 2 * id.bid + half; id.nvb = 2 * id.nb;
  id.lid = (id.bid & 7) + 8 * (2 * (id.bid >> 3) + half);
  char* sh = smem + half * SMEM_BYTES;
  volatile LAS unsigned* st = (volatile LAS unsigned*)(smem + 2 * SMEM_BYTES - 16);
  if (threadIdx.x == 0) { st[0] = 0u; st[1] = 0u; st[2] = 0u; st[3] = 0u; }
  __syncthreads();
  XcdBarrier xb = xcd_barrier_post((unsigned*)(p.ws + OFF_BAR), st);
#define MK_STEP(PH, LAYER, LAST) do { \
    typedef const void* __attribute__((address_space(4))) * KArgs; \
    KArgs ka = (KArgs)__builtin_amdgcn_kernarg_segment_ptr(); \
    asm volatile("" : "+s"(ka)); \
    Params q; \
    { const void** dst = (const void**)&q; _Pragma("unroll") for (int i = 0; i < 27; ++i) dst[i] = ka[i]; } \
    run_phase(q, PH, LAYER, id, smem, sh); \
    if (!(LAST)) xcd_barrier(xb); } while (0)
  MK_STEP(PH_PREP0, 0, false);
  MK_STEP(PH_H0, 0, false);
  MK_STEP(PH_INPROJ, 0, false); MK_STEP(PH_PREP, 0, false); MK_STEP(PH_QKV, 0, false); MK_STEP(PH_ATT, 0, false); MK_STEP(PH_SSDOUT, 0, false);
  MK_STEP(PH_WOUT, 0, false); MK_STEP(PH_POSTMIX, 0, false); MK_STEP(PH_FF1, 0, false); MK_STEP(PH_FF2, 0, false); MK_STEP(PH_POSTFFN, 0, false);
  MK_STEP(PH_INPROJ, 1, false); MK_STEP(PH_PREP, 1, false); MK_STEP(PH_QKV, 1, false); MK_STEP(PH_ATT, 1, false); MK_STEP(PH_SSDOUT, 1, false);
  MK_STEP(PH_WOUT, 1, false); MK_STEP(PH_POSTMIX, 1, false); MK_STEP(PH_FF1, 1, false); MK_STEP(PH_FF2, 1, false); MK_STEP(PH_POSTFFN, 1, true);
#undef MK_STEP
}

extern "C" void kernel_launch(void* const* d_in, const int* in_sizes, int n_in, void* d_out, int out_size, void* d_ws, size_t ws_size,
                              hipStream_t stream) {
  if (ws_size < WS_NEED) { fprintf(stderr, "workspace too small: %zu < %zu\n", ws_size, (size_t)WS_NEED); return; }
  Params p{};
  const float** f = (const float**)&p;
  for (int i = 0; i < 25; ++i) f[i] = (const float*)d_in[i];
  p.out = (float*)d_out;
  p.ws = (char*)d_ws;
  static int grid_blocks = 0;
  if (!grid_blocks) {
    int dev = 0, cus = 0, per_cu = 0;
    hipGetDevice(&dev);
    hipDeviceGetAttribute(&cus, hipDeviceAttributeMultiprocessorCount, dev);
    hipFuncSetAttribute((const void*)mega_kernel, hipFuncAttributeMaxDynamicSharedMemorySize, 2 * SMEM_BYTES);
    hipOccupancyMaxActiveBlocksPerMultiprocessor(&per_cu, mega_kernel, 512, 2 * SMEM_BYTES);
    if (per_cu > 1) per_cu = 1;
    grid_blocks = cus * per_cu;
  }
  hipMemsetAsync((char*)d_ws + OFF_BAR, 0, XCD_BAR_WORDS * 4, stream);
  void* args[] = {&p};
  hipError_t e = hipLaunchCooperativeKernel((void*)mega_kernel, dim3(grid_blocks), dim3(512), args, 2 * SMEM_BYTES, stream);
  if (e != hipSuccess) fprintf(stderr, "cooperative launch failed: %s (grid %d)\n", hipGetErrorString(e), grid_blocks);
}
```

```cpp
#include <hip/hip_runtime.h>
#include <hip/hip_cooperative_groups.h>
#include <stdint.h>
#include <stdio.h>
namespace cg = cooperative_groups;

#ifndef MEGA
#define MEGA 1
#endif
#ifndef REP_GEMM
#define REP_GEMM 1
#endif
#ifndef REP_ATT
#define REP_ATT 1
#endif
#ifndef REP_SSD
#define REP_SSD 1
#endif

typedef unsigned short bf16_t;
using bf16x8 = __attribute__((ext_vector_type(8))) short;
using s16x4  = __attribute__((ext_vector_type(4))) short;
using f32x4  = __attribute__((ext_vector_type(4))) float;
using f32x16 = __attribute__((ext_vector_type(16))) float;
using u32x4  = __attribute__((ext_vector_type(4))) unsigned;
using u32x2  = __attribute__((ext_vector_type(2))) unsigned;
#define DI __device__ __forceinline__
#define MFMA32(a, b, c) __builtin_amdgcn_mfma_f32_32x32x16_bf16((a), (b), (c), 0, 0, 0)
#define MFMA16(a, b, c) __builtin_amdgcn_mfma_f32_16x16x32_bf16((a), (b), (c), 0, 0, 0)

constexpr int DM = 1024, NB = 4, SEQ = 4096, CTX = 256;
constexpr int ML = NB * SEQ;
constexpr int MC = NB * CTX;
constexpr int MT = ML + MC;
constexpr int DIN = 2480, DINP = 2560;
constexpr int LK = CTX + SEQ;
constexpr int DFF = 4096;
constexpr int NCH = 34;
constexpr float EPS = 1e-6f;
constexpr int U_CKV = 256, U_KR = 384, U_GB = 416, U_GC = 672, U_VAL = 928, U_Z = 1184, U_XBC = 1696, U_DT = 2464;

constexpr size_t AL(size_t x) { return (x + 255) & ~(size_t)255; }
constexpr size_t WT_IN = 0;
constexpr size_t WT_UQ = WT_IN + (size_t)DINP * 1024;
constexpr size_t WT_UKV = WT_UQ + (size_t)384 * 256;
constexpr size_t WT_OUT = WT_UKV + (size_t)512 * 128;
constexpr size_t WT_FF1 = WT_OUT + (size_t)1024 * 1024;
constexpr size_t WT_FF2 = WT_FF1 + (size_t)4096 * 1024;
constexpr size_t WT_ELEMS = WT_FF2 + (size_t)4096 * 1024;
constexpr size_t OFF_WT = 0;
constexpr size_t OFF_MOD = AL(OFF_WT + 2 * WT_ELEMS * 2);
constexpr size_t OFF_XC = AL(OFF_MOD + 2 * 5 * 6144 * 4);
constexpr size_t OFF_H = AL(OFF_XC + (size_t)MC * DM * 4);
constexpr size_t OFF_R1 = AL(OFF_H + (size_t)MT * DM * 2);
constexpr size_t OFF_U = OFF_R1;
constexpr size_t OFF_DT = AL(OFF_U + (size_t)MT * DIN * 2);
constexpr size_t OFF_RSTD = AL(OFF_DT + (size_t)MT * 16 * 4);
constexpr size_t OFF_QB = AL(OFF_RSTD + (size_t)MT * 2 * 4);
constexpr size_t OFF_KB = AL(OFF_QB + (size_t)MT * 384 * 2);
constexpr size_t OFF_VT = AL(OFF_KB + (size_t)NB * 4 * LK * 96 * 2);
constexpr size_t OFF_XBC = AL(OFF_VT + (size_t)NB * 4 * 64 * LK * 2);
constexpr size_t OFF_SST = AL(OFF_XBC + (size_t)MT * 768 * 2);
constexpr size_t OFF_TDEC = AL(OFF_SST + (size_t)2 * NB * NCH * 8 * 4096 * 2);
constexpr size_t OFF_SSQ = AL(OFF_TDEC + (size_t)2 * NB * NCH * 8 * 4);
constexpr size_t OFF_END1 = AL(OFF_SSQ + (size_t)MT * 8 * 4);
constexpr size_t OFF_F1 = OFF_R1;
constexpr size_t OFF_END2 = AL(OFF_F1 + (size_t)MT * DFF * 2);
constexpr size_t OFF_BAR = OFF_END1 > OFF_END2 ? OFF_END1 : OFF_END2;
constexpr size_t WS_NEED = OFF_BAR + 16384;

struct Params {
  const float *x, *c, *ctx, *c_ctx, *w_mod, *b_mod, *g_pre_mix, *w_in, *q_norm, *w_uq, *kv_norm, *w_ukv, *sc_w, *ssd_cw, *ssd_cb,
      *a_log, *dt_bias, *ssd_d, *ssd_norm, *w_out, *g_post_mix, *g_pre_ffn, *w_ff1, *w_ff2, *g_post_ffn;
  float* out;
  char* ws;
};

DI int ltid() { int t = threadIdx.x; asm volatile("" : "+v"(t)); return t & 255; }
DI int ltid512() { int t = threadIdx.x; asm volatile("" : "+v"(t)); return t; }
typedef __bf16 hbf2 __attribute__((ext_vector_type(2)));
typedef float hf2 __attribute__((ext_vector_type(2)));
DI bf16_t f2bf(float x) { return __builtin_bit_cast(bf16_t, (__bf16)x); }
DI float bf2f(unsigned v) { return __uint_as_float(v << 16); }
DI unsigned pack2(float a, float b) { hf2 v = {a, b}; return __builtin_bit_cast(unsigned, __builtin_convertvector(v, hbf2)); }
DI float lo2f(unsigned w) { return __uint_as_float(w << 16); }
DI float hi2f(unsigned w) { return __uint_as_float(w & 0xffff0000u); }
DI float wave_sum(float v) {
#pragma unroll
  for (int o = 32; o > 0; o >>= 1) v += __shfl_xor(v, o);
  return v;
}
DI float silu_f(float x) { return x / (1.f + __expf(-x)); }
DI int crow(int reg, int h) { return (reg & 3) + 8 * (reg >> 2) + 4 * h; }
DI bf16x8 pack8(const f32x16& x, int s) {
  u32x4 p;
  p[0] = pack2(x[8 * s + 0], x[8 * s + 1]); p[1] = pack2(x[8 * s + 2], x[8 * s + 3]);
  p[2] = pack2(x[8 * s + 4], x[8 * s + 5]); p[3] = pack2(x[8 * s + 6], x[8 * s + 7]);
  return __builtin_bit_cast(bf16x8, p);
}
DI const float* xin_row(const Params& p, int layer, int row) {
  if (layer == 0) return row < ML ? p.x + (size_t)row * DM : p.ctx + (size_t)(row - ML) * DM;
  return row < ML ? p.out + (size_t)row * DM : (const float*)(p.ws + OFF_XC) + (size_t)(row - ML) * DM;
}
DI float* xst_row(const Params& p, int row) {
  return row < ML ? p.out + (size_t)row * DM : (float*)(p.ws + OFF_XC) + (size_t)(row - ML) * DM;
}
DI const float* mod_ptr(const Params& p, int layer, int row, int which) {
  int bb = row < ML ? (row >> 12) : 4;
  return (const float*)(p.ws + OFF_MOD) + ((size_t)(layer * 5 + bb) * 6 + which) * DM;
}
DI bf16_t* wt_ptr(const Params& p, int layer, size_t off) { return (bf16_t*)(p.ws + OFF_WT) + (size_t)layer * WT_ELEMS + off; }

DI void transpose_item(const float* __restrict__ w, const float* __restrict__ gk, int gk_from, bf16_t* __restrict__ wt, int K, int N, int kt, int nt, char* smem) {
  float* tile = (float*)smem;
  const int tid = ltid(), tx = tid & 63, ty = tid >> 6;
  const int k0 = kt * 64, n0 = nt * 64;
  const int n = n0 + tx;
  float v[16];
#pragma unroll
  for (int i = 0; i < 16; ++i) {
    int kk = ty + 4 * i;
    v[i] = n < N ? w[(size_t)(k0 + kk) * N + n] : 0.f;
  }
  if (gk) {
#pragma unroll
    for (int i = 0; i < 16; ++i) { int k = k0 + ty + 4 * i; if (k >= gk_from) v[i] *= gk[k - gk_from]; }
  }
#pragma unroll
  for (int i = 0; i < 16; ++i) tile[(ty + 4 * i) * 65 + tx] = v[i];
  __syncthreads();
#pragma unroll
  for (int i = 0; i < 2; ++i) {
    int c = tid + 256 * i, nn = c >> 3, kc = c & 7;
    u32x4 o;
#pragma unroll
    for (int jj = 0; jj < 4; ++jj) o[jj] = pack2(tile[(kc * 8 + 2 * jj) * 65 + nn], tile[(kc * 8 + 2 * jj + 1) * 65 + nn]);
    *(u32x4*)(wt + (size_t)(n0 + nn) * K + k0 + kc * 8) = o;
  }
  __syncthreads();
}

DI void modgemv_item(const Params& p, int layer, int ct, char* smem) {
  float* s = (float*)smem;
  float* red = s + 5 * 1024;
  const int tid = ltid(), w = tid >> 6, lane = tid & 63, ln = lane & 31, kh = lane >> 5;
  for (int i = tid; i < 5 * 1024; i += 256) {
    int bb = i >> 10, k = i & 1023;
    float v = bb < 4 ? p.c[bb * 1024 + k] : p.c_ctx[k];
    s[i] = silu_f(v);
  }
  __syncthreads();
  const float* wm = p.w_mod + (size_t)layer * 1024 * 6144;
  const int n = ct * 32 + ln;
  float acc[5] = {0.f, 0.f, 0.f, 0.f, 0.f};
#pragma unroll 16
  for (int i = 0; i < 128; ++i) {
    const int k = w * 256 + 2 * i + kh;
    float wv = wm[(size_t)k * 6144 + n];
#pragma unroll
    for (int bb = 0; bb < 5; ++bb) acc[bb] += s[bb * 1024 + k] * wv;
  }
#pragma unroll
  for (int bb = 0; bb < 5; ++bb) {
    acc[bb] += __shfl_xor(acc[bb], 32);
    if (kh == 0) red[(w * 5 + bb) * 32 + ln] = acc[bb];
  }
  __syncthreads();
  if (tid < 160) {
    int bb = tid >> 5, l2 = tid & 31;
    float v = red[(0 * 5 + bb) * 32 + l2] + red[(1 * 5 + bb) * 32 + l2] + red[(2 * 5 + bb) * 32 + l2] + red[(3 * 5 + bb) * 32 + l2];
    int nn = ct * 32 + l2;
    v += p.b_mod[layer * 6144 + nn];
    ((float*)(p.ws + OFF_MOD))[(size_t)(layer * 5 + bb) * 6144 + nn] = v;
  }
  __syncthreads();
}

constexpr int WT_ITEMS = 2984;
DI void wt_item(const Params& p, int layer, int j, char* smem) {
  if (j < 640) transpose_item(p.w_in + (size_t)layer * 1024 * DIN, nullptr, 0, wt_ptr(p, layer, WT_IN), 1024, DIN, j / 40, j % 40, smem);
  else if ((j -= 640) < 24) transpose_item(p.w_uq + (size_t)layer * 256 * 384, p.q_norm + layer * 256, 0, wt_ptr(p, layer, WT_UQ), 256, 384, j / 6, j % 6, smem);
  else if ((j -= 24) < 16) transpose_item(p.w_ukv + (size_t)layer * 128 * 512, p.kv_norm + layer * 128, 0, wt_ptr(p, layer, WT_UKV), 128, 512, j / 8, j % 8, smem);
  else if ((j -= 16) < 256) transpose_item(p.w_out + (size_t)layer * 1024 * 1024, p.ssd_norm + layer * 512, 512, wt_ptr(p, layer, WT_OUT), 1024, 1024, j / 16, j % 16, smem);
  else if ((j -= 256) < 1024) transpose_item(p.w_ff1 + (size_t)layer * 1024 * 4096, nullptr, 0, wt_ptr(p, layer, WT_FF1), 1024, 4096, j / 64, j % 64, smem);
  else { j -= 1024; transpose_item(p.w_ff2 + (size_t)layer * 4096 * 1024, nullptr, 0, wt_ptr(p, layer, WT_FF2), 4096, 1024, j / 16, j % 16, smem); }
}
DI void phase_prep0(const Params& p, int bid, int nb, char* smem) {
  for (int it = bid; it < 384 + 640; it += nb) {
    if (it < 384) modgemv_item(p, it / 192, it % 192, smem);
    else wt_item(p, 0, it - 384, smem);
  }
}
struct HMod { float4 g[4], s1[4], s0[4]; };
DI void load_hmod(HMod& m, const float* g, const float* sh, const float* sc, int lane) {
#pragma unroll
  for (int i = 0; i < 4; ++i) {
    const int col = lane * 4 + 256 * i;
    m.g[i] = *(const float4*)(g + col); m.s1[i] = *(const float4*)(sc + col); m.s0[i] = *(const float4*)(sh + col);
  }
}
DI void write_h_row(const float4 xv[4], float rstd, const HMod& m, bf16_t* hrow, int lane) {
#pragma unroll
  for (int i = 0; i < 4; ++i) {
    const int col = lane * 4 + 256 * i;
    float a = xv[i].x * rstd * m.g[i].x * (1.f + m.s1[i].x) + m.s0[i].x;
    float b = xv[i].y * rstd * m.g[i].y * (1.f + m.s1[i].y) + m.s0[i].y;
    float c = xv[i].z * rstd * m.g[i].z * (1.f + m.s1[i].z) + m.s0[i].z;
    float d = xv[i].w * rstd * m.g[i].w * (1.f + m.s1[i].w) + m.s0[i].w;
    u32x2 o; o[0] = pack2(a, b); o[1] = pack2(c, d);
    *(u32x2*)(hrow + col) = o;
  }
}
DI float ssq4(const float4 v[4]) {
  float s = 0.f;
#pragma unroll
  for (int i = 0; i < 4; ++i) s += v[i].x * v[i].x + v[i].y * v[i].y + v[i].z * v[i].z + v[i].w * v[i].w;
  return s;
}
DI void load_bf_row(const bf16_t* r, int lane, float4 v[4]) {
#pragma unroll
  for (int i = 0; i < 4; ++i) {
    u32x2 t = *(const u32x2*)(r + lane * 4 + 256 * i);
    v[i] = make_float4(lo2f(t[0]), hi2f(t[0]), lo2f(t[1]), hi2f(t[1]));
  }
}

struct RowVec { float4 c1[4], c2[4], c3[4]; };
DI const float* mod_ptr_b(const Params& p, int layer, int bb, int which) {
  return (const float*)(p.ws + OFF_MOD) + ((size_t)(layer * 5 + bb) * 6 + which) * DM;
}
template <int MODE>
DI void rowwise_phase(const Params& p, int layer, int bid, int nb) {
  const int w = ltid() >> 6, lane = ltid() & 63;
  const int M = (MODE == 0 || layer == 0) ? MT : ML;
  const bool wh = MODE != 2 || layer == 0;
  bf16_t* H = (bf16_t*)(p.ws + OFF_H);
  const bf16_t* Y = MODE == 1 ? (const bf16_t*)(p.ws + OFF_U) : (const bf16_t*)(p.ws + OFF_H);
  const int NW = nb * 4, W = bid * 4 + w, nwb = NW >> 2;
  auto load_vec = [&](RowVec& v, int bb) {
    const float* gate = MODE == 1 ? mod_ptr_b(p, layer, bb, 2) : mod_ptr_b(p, layer, bb, 5);
    const float* gres = MODE == 1 ? p.g_post_mix + layer * DM : p.g_post_ffn + layer * DM;
    const int hl = MODE == 2 ? 1 : layer;
    const float* gn = MODE == 1 ? p.g_pre_ffn + layer * DM : p.g_pre_mix + hl * DM;
    const float* sh = mod_ptr_b(p, hl, bb, MODE == 1 ? 3 : 0);
    const float* sc = mod_ptr_b(p, hl, bb, MODE == 1 ? 4 : 1);
#pragma unroll
    for (int i = 0; i < 4; ++i) {
      const int col = lane * 4 + 256 * i;
      if (MODE != 0) {
        const float4 a = *(const float4*)(gate + col), b = *(const float4*)(gres + col);
        v.c1[i] = make_float4(a.x * b.x, a.y * b.y, a.z * b.z, a.w * b.w);
      }
      if (wh) {
        const float4 g = *(const float4*)(gn + col), s1 = *(const float4*)(sc + col);
        v.c2[i] = make_float4(g.x * (1.f + s1.x), g.y * (1.f + s1.y), g.z * (1.f + s1.z), g.w * (1.f + s1.w));
        v.c3[i] = *(const float4*)(sh + col);
      }
    }
  };
  struct RowIn { u32x2 y[4]; float4 x[4]; };
  auto load_row = [&](RowIn& r, int row) {
    const float* xr = MODE == 2 ? (const float*)xst_row(p, row) : xin_row(p, layer, row);
#pragma unroll
    for (int i = 0; i < 4; ++i) {
      r.x[i] = *(const float4*)(xr + lane * 4 + 256 * i);
      if (MODE != 0) r.y[i] = *(const u32x2*)(Y + (size_t)row * DM + lane * 4 + 256 * i);
    }
  };
  auto finish = [&](float4 (&xv)[4], const float4 (&yv)[4], const RowVec& v, int row) {
    if (MODE != 0) {
      const float rstd = rsqrtf(wave_sum(ssq4(yv)) * (1.f / DM) + EPS);
#pragma unroll
      for (int i = 0; i < 4; ++i) {
        xv[i].x += yv[i].x * rstd * v.c1[i].x; xv[i].y += yv[i].y * rstd * v.c1[i].y;
        xv[i].z += yv[i].z * rstd * v.c1[i].z; xv[i].w += yv[i].w * rstd * v.c1[i].w;
      }
      float* xo = xst_row(p, row);
#pragma unroll
      for (int i = 0; i < 4; ++i) *(float4*)(xo + lane * 4 + 256 * i) = xv[i];
    }
    if (wh) {
      const float rstd1 = rsqrtf(wave_sum(ssq4(xv)) * (1.f / DM) + EPS);
      bf16_t* hrow = H + (size_t)row * DM;
#pragma unroll
      for (int i = 0; i < 4; ++i) {
        u32x2 o;
        o[0] = pack2(xv[i].x * rstd1 * v.c2[i].x + v.c3[i].x, xv[i].y * rstd1 * v.c2[i].y + v.c3[i].y);
        o[1] = pack2(xv[i].z * rstd1 * v.c2[i].z + v.c3[i].z, xv[i].w * rstd1 * v.c2[i].w + v.c3[i].w);
        *(u32x2*)(hrow + lane * 4 + 256 * i) = o;
      }
    }
  };
  auto process = [&](RowIn& r, const RowVec& v, int row) {
    float4 yv[4];
#pragma unroll
    for (int i = 0; i < 4; ++i) yv[i] = make_float4(lo2f(r.y[i][0]), hi2f(r.y[i][0]), lo2f(r.y[i][1]), hi2f(r.y[i][1]));
    finish(r.x, yv, v, row);
  };
  RowVec v;
  {
    const int bb = W / nwb, j = W - bb * nwb, end = SEQ * (bb + 1);
    load_vec(v, bb);
    RowIn ra, rb;
    int row = SEQ * bb + j;
    if (row < end) load_row(ra, row);
    while (row < end) {
      const int rowb = row + nwb;
      const bool hb = rowb < end;
      if (hb) load_row(rb, rowb);
      process(ra, v, row);
      if (!hb) break;
      const int rowa = rowb + nwb;
      const bool ha = rowa < end;
      if (ha) load_row(ra, rowa);
      process(rb, v, rowb);
      if (!ha) break;
      row = rowa;
    }
  }
  if (M > ML) {
    load_vec(v, 4);
    for (int row = ML + W; row < M; row += NW) {
      float4 xv[4], yv[4];
      const float* xr = MODE == 2 ? (const float*)xst_row(p, row) : xin_row(p, layer, row);
#pragma unroll
      for (int i = 0; i < 4; ++i) xv[i] = *(const float4*)(xr + lane * 4 + 256 * i);
      if (MODE == 1) load_bf_row(Y + (size_t)row * DM, lane, yv);
      if (MODE == 2) {
        const float* pp = (const float*)(p.ws + OFF_END2) + (size_t)(row - ML) * DM;
#pragma unroll
        for (int i = 0; i < 4; ++i) {
          float4 a = *(const float4*)(pp + lane * 4 + 256 * i), b = *(const float4*)(pp + (size_t)MC * DM + lane * 4 + 256 * i);
          float4 c = *(const float4*)(pp + (size_t)2 * MC * DM + lane * 4 + 256 * i), d = *(const float4*)(pp + (size_t)3 * MC * DM + lane * 4 + 256 * i);
          yv[i] = make_float4((a.x + b.x) + (c.x + d.x), (a.y + b.y) + (c.y + d.y), (a.z + b.z) + (c.z + d.z), (a.w + b.w) + (c.w + d.w));
        }
      }
      finish(xv, yv, v, row);
    }
  }
}
DI void phase_h0(const Params& p, int bid, int nb) { rowwise_phase<0>(p, 0, bid, nb); }
DI void phase_postmix(const Params& p, int layer, int bid, int nb) { rowwise_phase<1>(p, layer, bid, nb); }
DI void phase_postffn(const Params& p, int layer, int bid, int nb) { rowwise_phase<2>(p, layer, bid, nb); }

DI void phase_prep(const Params& p, int layer, int bid, int nb) {
  const int w = ltid() >> 6, lane = ltid() & 63;
  const bf16_t* U = (const bf16_t*)(p.ws + OFF_U);
  float* DT = (float*)(p.ws + OFF_DT);
  float* RS = (float*)(p.ws + OFF_RSTD);
  bf16_t* KB = (bf16_t*)(p.ws + OFF_KB);
  bf16_t* XBC = (bf16_t*)(p.ws + OFF_XBC);
  bf16_t* YM = (bf16_t*)(p.ws + OFF_H);
  const float* scw = p.sc_w + layer * 3 * 256;
  const float* cw = p.ssd_cw + layer * 3 * 768;
  const float* cb = p.ssd_cb + layer * 768;
  const int c4 = lane * 4;
  const float4 sw0 = *(const float4*)(scw + c4), sw1 = *(const float4*)(scw + 256 + c4), sw2 = *(const float4*)(scw + 512 + c4);
  float4 cwk[3][3], cbi[3];
#pragma unroll
  for (int i = 0; i < 3; ++i) {
    cbi[i] = *(const float4*)(cb + c4 + 256 * i);
#pragma unroll
    for (int k = 0; k < 3; ++k) cwk[i][k] = *(const float4*)(cw + k * 768 + c4 + 256 * i);
  }
  const float dtb = p.dt_bias[layer * 16 + (lane & 15)];
  const float invf = exp2f(-(float)(2 * (lane & 7)) * (13.287712379549449f / 16.f));
  for (int row = bid * 4 + w; row < MT; row += nb * 4) {
    int b, t, L, pos;
    const bool lat = row < ML;
    if (lat) { b = row >> 12; t = row & 4095; L = SEQ; pos = t + CTX; }
    else { int rr = row - ML; b = rr >> 8; t = rr & 255; L = CTX; pos = t; }
    const bf16_t* u0 = U + (size_t)row * DIN;
    const bool hp = t > 0, hn = t < L - 1;
    const bf16_t* um = hp ? u0 - DIN : u0;
    const bf16_t* up = hn ? u0 + DIN : u0;
    const float mp = hp ? 1.f : 0.f, mn = hn ? 1.f : 0.f;
    const u32x2 vq = *(const u32x2*)(u0 + c4);
    const u32x2 vkv = *(const u32x2*)(u0 + U_CKV + (lane & 31) * 4);
    const float kr = bf2f(u0[U_KR + (lane & 31)]);
    const u32x2 gcm = *(const u32x2*)(um + U_GC + c4), gc0 = *(const u32x2*)(u0 + U_GC + c4), gcp = *(const u32x2*)(up + U_GC + c4);
    const u32x2 vvm = *(const u32x2*)(um + U_VAL + c4), vv0 = *(const u32x2*)(u0 + U_VAL + c4), vvp = *(const u32x2*)(up + U_VAL + c4);
    const u32x2 gb = *(const u32x2*)(u0 + U_GB + c4);
    u32x2 xm[3], x0[3], xp[3];
#pragma unroll
    for (int i = 0; i < 3; ++i) {
      xm[i] = *(const u32x2*)(um + U_XBC + c4 + 256 * i);
      x0[i] = *(const u32x2*)(u0 + U_XBC + c4 + 256 * i);
      xp[i] = *(const u32x2*)(up + U_XBC + c4 + 256 * i);
    }
    const float dtr = DT[(size_t)row * 16 + (lane & 15)];
    {
      float a = lo2f(vq[0]), bq = hi2f(vq[0]), c = lo2f(vq[1]), d = hi2f(vq[1]);
      float ss = wave_sum(a * a + bq * bq + c * c + d * d);
      float e = lo2f(vkv[0]), f = hi2f(vkv[0]), g = lo2f(vkv[1]), h = hi2f(vkv[1]);
      float s2 = lane < 32 ? e * e + f * f + g * g + h * h : 0.f;
      s2 = wave_sum(s2);
      if (lane == 0) { RS[row * 2] = rsqrtf(ss * (1.f / 256) + EPS); RS[row * 2 + 1] = rsqrtf(s2 * (1.f / 128) + EPS); }
    }
    {
      const float partner = __shfl_xor(kr, 8);
      float o = kr;
      if (lat) {
        const int grp = (lane & 31) >> 3;
        const float posf = grp < 2 ? (float)(t >> 6) : (float)(t & 63);
        const float rev = posf * invf * 0.15915494309189535f;
        const float cs = __builtin_amdgcn_cosf(rev), sn = __builtin_amdgcn_sinf(rev);
        o = (grp & 1) ? kr * cs + partner * sn : kr * cs - partner * sn;
      }
      if (lane < 32) {
        const bf16_t ob = f2bf(o);
#pragma unroll
        for (int hd = 0; hd < 4; ++hd) KB[((size_t)(b * 4 + hd) * LK + pos) * 96 + 64 + lane] = ob;
      }
    }
    {
      float a0 = sw1.x * lo2f(gc0[0]) * lo2f(vv0[0]) + mp * sw0.x * lo2f(gcm[0]) * lo2f(vvm[0]) + mn * sw2.x * lo2f(gcp[0]) * lo2f(vvp[0]);
      float a1 = sw1.y * hi2f(gc0[0]) * hi2f(vv0[0]) + mp * sw0.y * hi2f(gcm[0]) * hi2f(vvm[0]) + mn * sw2.y * hi2f(gcp[0]) * hi2f(vvp[0]);
      float a2 = sw1.z * lo2f(gc0[1]) * lo2f(vv0[1]) + mp * sw0.z * lo2f(gcm[1]) * lo2f(vvm[1]) + mn * sw2.z * lo2f(gcp[1]) * lo2f(vvp[1]);
      float a3 = sw1.w * hi2f(gc0[1]) * hi2f(vv0[1]) + mp * sw0.w * hi2f(gcm[1]) * hi2f(vvm[1]) + mn * sw2.w * hi2f(gcp[1]) * hi2f(vvp[1]);
      u32x2 o; o[0] = pack2(lo2f(gb[0]) * a0, hi2f(gb[0]) * a1); o[1] = pack2(lo2f(gb[1]) * a2, hi2f(gb[1]) * a3);
      *(u32x2*)(YM + (size_t)row * DM + 256 + c4) = o;
    }
#pragma unroll
    for (int i = 0; i < 3; ++i) {
      float a0 = cbi[i].x + cwk[i][1].x * lo2f(x0[i][0]) + mp * cwk[i][0].x * lo2f(xm[i][0]) + mn * cwk[i][2].x * lo2f(xp[i][0]);
      float a1 = cbi[i].y + cwk[i][1].y * hi2f(x0[i][0]) + mp * cwk[i][0].y * hi2f(xm[i][0]) + mn * cwk[i][2].y * hi2f(xp[i][0]);
      float a2 = cbi[i].z + cwk[i][1].z * lo2f(x0[i][1]) + mp * cwk[i][0].z * lo2f(xm[i][1]) + mn * cwk[i][2].z * lo2f(xp[i][1]);
      float a3 = cbi[i].w + cwk[i][1].w * hi2f(x0[i][1]) + mp * cwk[i][0].w * hi2f(xm[i][1]) + mn * cwk[i][2].w * hi2f(xp[i][1]);
      u32x2 o; o[0] = pack2(silu_f(a0), silu_f(a1)); o[1] = pack2(silu_f(a2), silu_f(a3));
      *(u32x2*)(XBC + (size_t)row * 768 + c4 + 256 * i) = o;
    }
    if (lane < 16) {
      const float v = dtr + dtb;
      const float e = __expf(-fabsf(v));
      DT[(size_t)row * 16 + lane] = fmaxf(v, 0.f) + (e < 1e-3f ? e * (1.f - 0.5f * e) : __logf(1.f + e));
    }
  }
}

DI void phase_ssdnorm(const Params& p, int layer, int bid, int nb) {
  const int w = ltid() >> 6, lane = ltid() & 63;
  const int M = layer == 0 ? MT : ML;
  bf16_t* YM = (bf16_t*)(p.ws + OFF_H);
  const float* SSQ = (const float*)(p.ws + OFF_SSQ);
  const float* ng = p.ssd_norm + layer * 512;
  for (int row = bid * 4 + w; row < M; row += nb * 4) {
    int g = lane >> 5;
    float4 s = *(const float4*)(SSQ + (size_t)row * 8 + g * 4);
    float rstd = rsqrtf((s.x + s.y + s.z + s.w) * (1.f / 256) + EPS);
    bf16_t* ptr = YM + (size_t)row * DM + 512 + lane * 8;
    u32x4 v = *(const u32x4*)ptr;
    float4 g0 = *(const float4*)(ng + lane * 8), g1 = *(const float4*)(ng + lane * 8 + 4);
    u32x4 o;
    o[0] = pack2(lo2f(v[0]) * rstd * g0.x, hi2f(v[0]) * rstd * g0.y);
    o[1] = pack2(lo2f(v[1]) * rstd * g0.z, hi2f(v[1]) * rstd * g0.w);
    o[2] = pack2(lo2f(v[2]) * rstd * g1.x, hi2f(v[2]) * rstd * g1.y);
    o[3] = pack2(lo2f(v[3]) * rstd * g1.z, hi2f(v[3]) * rstd * g1.w);
    *(u32x4*)ptr = o;
  }
}

constexpr int GST = 80;
constexpr int GBUF = 2 * 128 * GST;
template <bool GN, class Epi>
DI void gemm_tile(const bf16_t* __restrict__ A, int lda, const bf16_t* __restrict__ Bt, int K, int row0, int col0, char* smem, Epi epi, const float* __restrict__ ssq = nullptr) {
  bf16_t* S0 = (bf16_t*)smem;
  const int tid = ltid(), wid = tid >> 6, lane = tid & 63, wr = wid >> 1, wc = wid & 1, fr = lane & 15, fq = lane >> 4;
  f32x4 acc[4][4];
#pragma unroll
  for (int m = 0; m < 4; ++m)
#pragma unroll
    for (int n = 0; n < 4; ++n) acc[m][n] = f32x4{0.f, 0.f, 0.f, 0.f};
  u32x4 ra[4], rb[4];
  const int sr = tid >> 3, sp = tid & 7;
  const bf16_t* ga = A + (size_t)(row0 + sr) * lda + sp * 8;
  const bf16_t* gb = Bt + (size_t)(col0 + sr) * K + sp * 8;
  auto gload = [&](int k0) {
#pragma unroll
    for (int i = 0; i < 4; ++i) {
      ra[i] = *(const u32x4*)(ga + (size_t)(32 * i) * lda + k0);
      rb[i] = *(const u32x4*)(gb + (size_t)(32 * i) * K + k0);
    }
  };
  gload(0);
  float gs[4][2];
  if (GN) {
#pragma unroll
    for (int i = 0; i < 4; ++i) {
      const float4 s0 = *(const float4*)(ssq + (size_t)(row0 + sr + 32 * i) * 8), s1 = *(const float4*)(ssq + (size_t)(row0 + sr + 32 * i) * 8 + 4);
      gs[i][0] = rsqrtf((s0.x + s0.y + s0.z + s0.w) * (1.f / 256) + EPS);
      gs[i][1] = rsqrtf((s1.x + s1.y + s1.z + s1.w) * (1.f / 256) + EPS);
    }
  }
  auto swrite = [&](int kt) {
    if (GN && kt >= 8) {
      const int g = (kt - 8) >> 2;
#pragma unroll
      for (int i = 0; i < 4; ++i) {
        const float sc = g ? gs[i][1] : gs[i][0];
#pragma unroll
        for (int jj = 0; jj < 4; ++jj) ra[i][jj] = pack2(lo2f(ra[i][jj]) * sc, hi2f(ra[i][jj]) * sc);
      }
    }
    bf16_t* As = S0 + (kt & 1) * GBUF;
    bf16_t* Bs = As + 128 * GST;
#pragma unroll
    for (int i = 0; i < 4; ++i) {
      *(u32x4*)(As + (sr + 32 * i) * GST + sp * 8) = ra[i];
      *(u32x4*)(Bs + (sr + 32 * i) * GST + sp * 8) = rb[i];
    }
  };
  const int KT = K / 64;
  swrite(0);
  if (KT > 1) gload(64);
  __syncthreads();
  for (int kt = 0; kt < KT; ++kt) {
    const bf16_t* As = S0 + (kt & 1) * GBUF;
    const bf16_t* Bs = As + 128 * GST;
#pragma unroll
    for (int ks = 0; ks < 2; ++ks) {
      bf16x8 af[4], bfr[4];
#pragma unroll
      for (int m = 0; m < 4; ++m) af[m] = *(const bf16x8*)(As + (wr * 64 + m * 16 + fr) * GST + ks * 32 + fq * 8);
#pragma unroll
      for (int n = 0; n < 4; ++n) bfr[n] = *(const bf16x8*)(Bs + (wc * 64 + n * 16 + fr) * GST + ks * 32 + fq * 8);
#pragma unroll
      for (int m = 0; m < 4; ++m)
#pragma unroll
        for (int n = 0; n < 4; ++n) acc[m][n] = MFMA16(bfr[n], af[m], acc[m][n]);
      if (ks == 0 && kt + 1 < KT) {
        swrite(kt + 1);
        if (kt + 2 < KT) gload((kt + 2) * 64);
      }
    }
    __syncthreads();
  }
  float rsc[4];
#pragma unroll
  for (int m = 0; m < 4; ++m) rsc[m] = epi.scale(row0 + wr * 64 + m * 16 + fr);
#pragma unroll
  for (int m = 0; m < 4; ++m)
#pragma unroll
    for (int n = 0; n < 4; ++n) epi(row0 + wr * 64 + m * 16 + fr, col0 + wc * 64 + n * 16 + fq * 4, acc[m][n], rsc[m]);
}

template <class Epi>
DI void gemm_tile_glds(const bf16_t* __restrict__ A, int lda, const bf16_t* __restrict__ Bt, int ldb, int K, int row0, int col0, char* smem, Epi epi) {
  const int tid = ltid(), wid = tid >> 6, lane = tid & 63, wr = wid >> 1, wc = wid & 1, fr = lane & 15, fq = lane >> 4;
  f32x4 acc[4][4];
#pragma unroll
  for (int m = 0; m < 4; ++m)
#pragma unroll
    for (int n = 0; n < 4; ++n) acc[m][n] = f32x4{0.f, 0.f, 0.f, 0.f};
  const int crow = tid >> 3, cslot = tid & 7, cpart = cslot ^ (crow & 7);
  const bf16_t* ga = A + (size_t)(row0 + crow) * lda + cpart * 8;
  const bf16_t* gb = Bt + (size_t)(col0 + crow) * ldb + cpart * 8;
  auto issue = [&](int kt, int stage) {
    char* sa = smem + stage * 32768 + tid * 16;
#pragma unroll
    for (int i = 0; i < 4; ++i) {
      __builtin_amdgcn_global_load_lds((const unsigned*)(ga + (size_t)(32 * i) * lda + kt * 64), (__attribute__((address_space(3))) unsigned*)(sa + i * 4096), 16, 0, 0);
      __builtin_amdgcn_global_load_lds((const unsigned*)(gb + (size_t)(32 * i) * ldb + kt * 64), (__attribute__((address_space(3))) unsigned*)(sa + 16384 + i * 4096), 16, 0, 0);
    }
  };
  const int KT = K / 64;
  issue(0, 0);
  asm volatile("s_waitcnt vmcnt(0)" ::: "memory");
  __syncthreads();
  const int sw = fr & 7;
  for (int kt = 0; kt < KT; ++kt) {
    if (kt + 1 < KT) issue(kt + 1, (kt + 1) & 1);
    const char* As = smem + (kt & 1) * 32768;
    const char* Bs = As + 16384;
#pragma unroll
    for (int ks = 0; ks < 2; ++ks) {
      bf16x8 af[4], bfr[4];
      const int so = ((ks * 4 + fq) ^ sw) * 16;
#pragma unroll
      for (int m = 0; m < 4; ++m) af[m] = *(const bf16x8*)(As + (wr * 64 + m * 16 + fr) * 128 + so);
#pragma unroll
      for (int n = 0; n < 4; ++n) bfr[n] = *(const bf16x8*)(Bs + (wc * 64 + n * 16 + fr) * 128 + so);
#pragma unroll
      for (int m = 0; m < 4; ++m)
#pragma unroll
        for (int n = 0; n < 4; ++n) acc[m][n] = MFMA16(bfr[n], af[m], acc[m][n]);
    }
    asm volatile("s_waitcnt vmcnt(0)" ::: "memory");
    __syncthreads();
  }
#pragma unroll
  for (int m = 0; m < 4; ++m)
#pragma unroll
    for (int n = 0; n < 4; ++n) epi(row0 + wr * 64 + m * 16 + fr, col0 + wc * 64 + n * 16 + fq * 4, acc[m][n]);
}

constexpr int G8_HT = 128 * 64;
DI int g8_lds_byte(int r, int c) {
  int st = (r >> 4) * 2 + (c >> 5), rr = r & 15, cc = c & 31, ob = rr * 64 + cc * 2;
  return st * 1024 + (ob ^ (((ob >> 9) & 1) << 5));
}
DI void g8_stage_rc(int b, int& R, int& C) {
  int st = b / 1024, sb = b % 1024, swz = sb ^ (((sb >> 9) & 1) << 5);
  R = (st >> 1) * 16 + swz / 64; C = (st & 1) * 32 + (swz % 64) / 2;
}
template <class Epi>
DI void gemm8_tile(const bf16_t* __restrict__ A, int lda, const bf16_t* __restrict__ Bt, int ldb, int K, int brow, int bcol, char* smem, Epi epi,
                   bool first = true, bool has_next = false, int nbrow = 0, int nbcol = 0) {
  bf16_t* shm = (bf16_t*)smem;
  const int tid = ltid512();
#define G8_SA(b, h) (shm + ((b) * 2 + (h)) * G8_HT)
#define G8_SB(b, h) (shm + (4 + (b) * 2 + (h)) * G8_HT)
#define G8_STAGE(P, BASE, LD, br, kt) do { const bf16_t* _g = (BASE) + (size_t)(br) * (LD) + (size_t)(kt) * 64; \
    _Pragma("unroll") for (int _i = 0; _i < 2; ++_i) { int _b = tid * 16 + _i * 8192; int _r, _c; g8_stage_rc(_b, _r, _c); \
      __builtin_amdgcn_global_load_lds((const unsigned*)(_g + (size_t)_r * (LD) + _c), \
        (__attribute__((address_space(3))) unsigned*)((char*)(P) + _b), 16, 0, 0); } } while (0)
#define G8_LDA(dst, b, h) _Pragma("unroll") for (int m = 0; m < 4; ++m) _Pragma("unroll") for (int k = 0; k < 2; ++k) \
    dst[m][k] = *reinterpret_cast<const bf16x8*>((char*)G8_SA(b, h) + g8_lds_byte(wr * 64 + m * 16 + fr, k * 32 + fq * 8))
#define G8_LDB(dst, b, h) _Pragma("unroll") for (int n = 0; n < 2; ++n) _Pragma("unroll") for (int k = 0; k < 2; ++k) \
    dst[n][k] = *reinterpret_cast<const bf16x8*>((char*)G8_SB(b, h) + g8_lds_byte(wc * 32 + n * 16 + fr, k * 32 + fq * 8))
#define G8_MMA(ai, bj, At, Bx) do { __builtin_amdgcn_s_setprio(1); \
    _Pragma("unroll") for (int m = 0; m < 4; ++m) _Pragma("unroll") for (int n = 0; n < 2; ++n) _Pragma("unroll") for (int k = 0; k < 2; ++k) \
      acc[ai][bj][m][n] = __builtin_amdgcn_mfma_f32_16x16x32_bf16(Bx[n][k], At[m][k], acc[ai][bj][m][n], 0, 0, 0); \
    __builtin_amdgcn_s_setprio(0); } while (0)
#define G8_WAIT_V(n) asm volatile("s_waitcnt vmcnt(" #n ")" ::: "memory")
#define G8_WAIT_L(n) asm volatile("s_waitcnt lgkmcnt(" #n ")" ::: "memory")
#define G8_BAR __builtin_amdgcn_s_barrier()
#define G8_SCHED __builtin_amdgcn_sched_barrier(0)
  const int wid = tid >> 6, lane = tid & 63, wr = wid >> 2, wc = wid & 3, fr = lane & 15, fq = lane >> 4;
  f32x4 acc[2][2][4][2];
#pragma unroll
  for (int a = 0; a < 2; ++a)
#pragma unroll
    for (int b = 0; b < 2; ++b)
#pragma unroll
      for (int m = 0; m < 4; ++m)
#pragma unroll
        for (int n = 0; n < 2; ++n) acc[a][b][m][n] = f32x4{0.f, 0.f, 0.f, 0.f};
  bf16x8 At[4][2], B0[2][2], B1[2][2];
  const int nt = K / 64;
  if (first) {
    G8_STAGE(G8_SB(0, 0), Bt, ldb, bcol, 0); G8_STAGE(G8_SA(0, 0), A, lda, brow, 0);
    G8_STAGE(G8_SB(0, 1), Bt, ldb, bcol + 128, 0); G8_STAGE(G8_SA(0, 1), A, lda, brow + 128, 0);
  }
  if (wr == 1) G8_BAR;
  if (first) G8_WAIT_V(4); else G8_WAIT_V(0);
  G8_BAR;
  G8_STAGE(G8_SB(1, 0), Bt, ldb, bcol, 1); G8_STAGE(G8_SA(1, 0), A, lda, brow, 1); G8_STAGE(G8_SB(1, 1), Bt, ldb, bcol + 128, 1);
  G8_WAIT_V(6); G8_BAR;
  for (int t = 0; t < nt - 2; t += 2) {
    G8_LDB(B0, 0, 0); G8_SCHED; G8_LDA(At, 0, 0); G8_STAGE(G8_SA(1, 1), A, lda, brow + 128, t + 1);
    G8_WAIT_L(8); G8_BAR; G8_WAIT_L(0); G8_MMA(0, 0, At, B0); G8_BAR; G8_SCHED;
    G8_LDB(B1, 0, 1); G8_STAGE(G8_SB(0, 0), Bt, ldb, bcol, t + 2);
    G8_BAR; G8_WAIT_L(0); G8_MMA(0, 1, At, B1); G8_BAR;
    G8_LDA(At, 0, 1); G8_STAGE(G8_SA(0, 0), A, lda, brow, t + 2);
    G8_BAR; G8_WAIT_L(0); G8_MMA(1, 0, At, B0); G8_BAR; G8_SCHED;
    G8_STAGE(G8_SB(0, 1), Bt, ldb, bcol + 128, t + 2);
    G8_WAIT_V(6); G8_BAR; G8_MMA(1, 1, At, B1); G8_BAR;
    G8_LDB(B0, 1, 0); G8_SCHED; G8_LDA(At, 1, 0); G8_STAGE(G8_SA(0, 1), A, lda, brow + 128, t + 2);
    G8_WAIT_L(8); G8_BAR; G8_WAIT_L(0); G8_MMA(0, 0, At, B0); G8_BAR; G8_SCHED;
    G8_LDB(B1, 1, 1); G8_STAGE(G8_SB(1, 0), Bt, ldb, bcol, t + 3);
    G8_BAR; G8_WAIT_L(0); G8_MMA(0, 1, At, B1); G8_BAR;
    G8_LDA(At, 1, 1); G8_STAGE(G8_SA(1, 0), A, lda, brow, t + 3);
    G8_BAR; G8_WAIT_L(0); G8_MMA(1, 0, At, B0); G8_BAR; G8_SCHED;
    G8_STAGE(G8_SB(1, 1), Bt, ldb, bcol + 128, t + 3);
    G8_WAIT_V(6); G8_BAR; G8_MMA(1, 1, At, B1); G8_BAR;
  }
  { G8_LDB(B0, 0, 0); G8_LDA(At, 0, 0); G8_STAGE(G8_SA(1, 1), A, lda, brow + 128, nt - 1);
    G8_BAR; G8_WAIT_L(0); G8_MMA(0, 0, At, B0); G8_BAR;
    G8_LDB(B1, 0, 1); G8_BAR; G8_WAIT_L(0); G8_MMA(0, 1, At, B1); G8_BAR;
    G8_LDA(At, 0, 1); G8_WAIT_V(4); G8_BAR; G8_WAIT_L(0); G8_MMA(1, 0, At, B0); G8_MMA(1, 1, At, B1); G8_BAR; }
  { G8_LDB(B0, 1, 0); G8_LDA(At, 1, 0); G8_WAIT_V(2); G8_BAR; G8_WAIT_L(0); G8_MMA(0, 0, At, B0); G8_BAR;
    G8_LDB(B1, 1, 1); G8_WAIT_V(0); G8_BAR; G8_WAIT_L(0); G8_MMA(0, 1, At, B1); G8_BAR;
    G8_LDA(At, 1, 1); G8_BAR; G8_WAIT_L(0); G8_MMA(1, 0, At, B0); G8_MMA(1, 1, At, B1); G8_BAR; }
  if (has_next) {
    G8_STAGE(G8_SB(0, 0), Bt, ldb, nbcol, 0); G8_STAGE(G8_SA(0, 0), A, lda, nbrow, 0);
    G8_STAGE(G8_SB(0, 1), Bt, ldb, nbcol + 128, 0); G8_STAGE(G8_SA(0, 1), A, lda, nbrow + 128, 0);
  }
  if (wr == 0) G8_BAR;
  const bool odd = fq & 1;
#pragma unroll
  for (int ai = 0; ai < 2; ++ai)
#pragma unroll
    for (int bj = 0; bj < 2; ++bj)
#pragma unroll
      for (int m = 0; m < 4; ++m) {
        const int row = brow + ai * 128 + wr * 64 + m * 16 + fr, cb = bcol + bj * 128 + wc * 32;
        epi.side(row, cb + fq * 4, acc[ai][bj][m][0]);
        epi.side(row, cb + 16 + fq * 4, acc[ai][bj][m][1]);
        const u32x2 p0 = epi.pack(acc[ai][bj][m][0]), p1 = epi.pack(acc[ai][bj][m][1]);
        const u32x2 snd = odd ? p0 : p1;
        u32x2 rcv; rcv[0] = (unsigned)__shfl_xor((int)snd[0], 16); rcv[1] = (unsigned)__shfl_xor((int)snd[1], 16);
        u32x4 o;
        if (odd) { o[0] = rcv[0]; o[1] = rcv[1]; o[2] = p1[0]; o[3] = p1[1]; }
        else     { o[0] = p0[0]; o[1] = p0[1]; o[2] = rcv[0]; o[3] = rcv[1]; }
        epi.store16(row, odd ? cb + 16 + (fq - 1) * 4 : cb + fq * 4, o);
      }
  __syncthreads();
}

struct EpiBF {
  bf16_t* out; int ldo;
  DI void side(int, int, const f32x4&) const {}
  DI u32x2 pack(const f32x4& a) const { u32x2 o; o[0] = pack2(a[0], a[1]); o[1] = pack2(a[2], a[3]); return o; }
  DI void store16(int row, int col, const u32x4& v) const { *(u32x4*)(out + (size_t)row * ldo + col) = v; }
  DI float scale(int) const { return 1.f; }
  DI void operator()(int row, int col, const f32x4& a, float) const { (*this)(row, col, a); }
  DI void operator()(int row, int col, const f32x4& a) const {
    u32x2 o; o[0] = pack2(a[0], a[1]); o[1] = pack2(a[2], a[3]);
    *(u32x2*)(out + (size_t)row * ldo + col) = o;
  }
};
struct EpiRelu2 {
  bf16_t* out; int ldo;
  DI void side(int, int, const f32x4&) const {}
  DI u32x2 pack(const f32x4& a) const {
    float r0 = fmaxf(a[0], 0.f), r1 = fmaxf(a[1], 0.f), r2 = fmaxf(a[2], 0.f), r3 = fmaxf(a[3], 0.f);
    u32x2 o; o[0] = pack2(r0 * r0, r1 * r1); o[1] = pack2(r2 * r2, r3 * r3); return o;
  }
  DI void store16(int row, int col, const u32x4& v) const { *(u32x4*)(out + (size_t)row * ldo + col) = v; }
  DI void operator()(int row, int col, const f32x4& a) const {
    float r0 = fmaxf(a[0], 0.f), r1 = fmaxf(a[1], 0.f), r2 = fmaxf(a[2], 0.f), r3 = fmaxf(a[3], 0.f);
    u32x2 o; o[0] = pack2(r0 * r0, r1 * r1); o[1] = pack2(r2 * r2, r3 * r3);
    *(u32x2*)(out + (size_t)row * ldo + col) = o;
  }
};
struct EpiU {
  bf16_t* u; float* dt;
  DI void side(int row, int col, const f32x4& a) const { if (col >= U_DT && col < DIN) *(float4*)(dt + (size_t)row * 16 + col - U_DT) = make_float4(a[0], a[1], a[2], a[3]); }
  DI u32x2 pack(const f32x4& a) const { u32x2 o; o[0] = pack2(a[0], a[1]); o[1] = pack2(a[2], a[3]); return o; }
  DI void store16(int row, int col, const u32x4& v) const { if (col < DIN) *(u32x4*)(u + (size_t)row * DIN + col) = v; }
  DI void operator()(int row, int col, const f32x4& a) const {
    if (col < DIN) {
      u32x2 o; o[0] = pack2(a[0], a[1]); o[1] = pack2(a[2], a[3]);
      *(u32x2*)(u + (size_t)row * DIN + col) = o;
      if (col >= U_DT) *(float4*)(dt + (size_t)row * 16 + col - U_DT) = make_float4(a[0], a[1], a[2], a[3]);
    }
  }
};
struct EpiQ {
  bf16_t* q; const float* rs;
  DI float scale(int row) const { return rs[row * 2]; }
  DI void operator()(int row, int col, const f32x4& a, float r) const {
    u32x2 o; o[0] = pack2(a[0] * r, a[1] * r); o[1] = pack2(a[2] * r, a[3] * r);
    *(u32x2*)(q + (size_t)row * 384 + col) = o;
  }
};
struct EpiKV {
  bf16_t* kb; bf16_t* vt; const float* rs;
  DI float scale(int row) const { return rs[row * 2 + 1]; }
  DI void operator()(int row, int col, const f32x4& a, float r) const {
    int b, pos;
    if (row < ML) { b = row >> 12; pos = (row & 4095) + CTX; } else { int rr = row - ML; b = rr >> 8; pos = rr & 255; }
    const int head = col >> 7, d = col & 127;
    if (d < 64) {
      u32x2 o; o[0] = pack2(a[0] * r, a[1] * r); o[1] = pack2(a[2] * r, a[3] * r);
      *(u32x2*)(kb + ((size_t)(b * 4 + head) * LK + pos) * 96 + d) = o;
    } else {
#pragma unroll
      for (int j = 0; j < 4; ++j) vt[((size_t)(b * 4 + head) * 64 + (d - 64 + j)) * LK + pos] = f2bf(a[j] * r);
    }
  }
};

struct EpiPart {
  float* part;
  DI void operator()(int row, int col, const f32x4& a) const {
    *(float4*)(part + (size_t)(row - ML) * DM + col) = make_float4(a[0], a[1], a[2], a[3]);
  }
};
DI void phase_inproj(const Params& p, int layer, int bid, int nb, int vbid, int nvb, char* smem, char* smem_half) {
  EpiU epi{(bf16_t*)(p.ws + OFF_U), (float*)(p.ws + OFF_DT)};
  const int x = bid & 7, per = nb >> 3;
  for (int rep = 0; rep < REP_GEMM; ++rep)
  for (int q = bid >> 3; q < 85; q += per) {
    const int m = (x >> 1) * 17 + q / 5, n = 5 * (x & 1) + q % 5;
    const int q2 = q + per, m2 = (x >> 1) * 17 + q2 / 5, n2 = 5 * (x & 1) + q2 % 5;
    gemm8_tile((const bf16_t*)(p.ws + OFF_H), DM, wt_ptr(p, layer, WT_IN), 1024, 1024, m * 256, n * 256, smem, epi,
               q == (bid >> 3), q2 < 85, m2 * 256, n2 * 256);
  }
  if (layer == 0) {
    if (per == 32) {
      if ((bid >> 3) >= 21) {
        const int u = ((bid >> 3) - 21) * 8 + x;
        for (int it = 640 + 2 * u + (vbid & 1); it < WT_ITEMS; it += 176) wt_item(p, 0, it, smem_half);
      }
    } else {
      for (int it = 640 + vbid; it < WT_ITEMS; it += nvb) wt_item(p, 0, it, smem_half);
    }
  }
}
DI void phase_wout(const Params& p, int layer, int lid, int nvb, char* smem) {
  const int M = layer == 0 ? MT : ML;
  EpiBF epi{(bf16_t*)(p.ws + OFF_U), DM};
  const int x = lid & 7, per = nvb >> 3;
  for (int rep = 0; rep < REP_GEMM; ++rep)
  for (int q = lid >> 3; q < M / 128; q += per)
    gemm_tile<true>((const bf16_t*)(p.ws + OFF_H), DM, wt_ptr(p, layer, WT_OUT), 1024, ((q >> 3) * 8 + x) * 128, (q & 7) * 128, smem, epi, (const float*)(p.ws + OFF_SSQ));
}
DI void phase_ff1(const Params& p, int layer, int bid, int nb, int vbid, int nvb, char* smem, char* smem_half) {
  EpiRelu2 epi{(bf16_t*)(p.ws + OFF_F1), DFF};
  const int x = bid & 7, per = nb >> 3;
  for (int rep = 0; rep < REP_GEMM; ++rep) {
    for (int q = bid >> 3; q < 128; q += per) {
      const int m = (x >> 2) * 32 + (q >> 2), n = 4 * (x & 3) + (q & 3);
      const int q2 = q + per, m2 = (x >> 2) * 32 + (q2 >> 2), n2 = 4 * (x & 3) + (q2 & 3);
      gemm8_tile((const bf16_t*)(p.ws + OFF_H), DM, wt_ptr(p, layer, WT_FF1), 1024, 1024, m * 256, n * 256, smem, epi,
                 q == (bid >> 3), q2 < 128, m2 * 256, n2 * 256);
    }
    if (layer == 0)
      for (int it = vbid; it < (MC / 128) * 32; it += nvb)
        gemm_tile_glds((const bf16_t*)(p.ws + OFF_H), DM, wt_ptr(p, layer, WT_FF1), 1024, 1024, ML + (it / 32) * 128, (it % 32) * 128, smem_half, epi);
  }
}
DI void phase_ff2(const Params& p, int layer, int bid, int nb, int vbid, int nvb, char* smem, char* smem_half) {
  EpiBF epi{(bf16_t*)(p.ws + OFF_H), DM};
  const int x = bid & 7, per = nb >> 3;
  for (int rep = 0; rep < REP_GEMM; ++rep) {
    for (int q = bid >> 3; q < 32; q += per) {
      const int T = x * 32 + q;
      gemm8_tile((const bf16_t*)(p.ws + OFF_F1), DFF, wt_ptr(p, layer, WT_FF2), 4096, 4096, (T >> 2) * 256, (T & 3) * 256, smem, epi);
    }
    if (layer == 0)
      for (int it = vbid; it < (MC / 128) * 8 * 4; it += nvb) {
        const int tile = it >> 2, ks = it & 3;
        EpiPart ep{(float*)(p.ws + OFF_END2) + (size_t)ks * MC * DM};
        gemm_tile_glds((const bf16_t*)(p.ws + OFF_F1) + ks * 1024, DFF, wt_ptr(p, layer, WT_FF2) + ks * 1024, 4096, 1024, ML + (tile >> 3) * 128, (tile & 7) * 128, smem_half, ep);
      }
  }
}

DI int chunk_row0(int b, int tc) { return tc < 2 ? ML + b * CTX + tc * 128 : b * SEQ + (tc - 2) * 128; }
constexpr int BST = 72;
constexpr int TST = 136;
DI void load_tile_T(bf16_t* dst, const bf16_t* __restrict__ src, int ldg) {
  const int tid = ltid();
#pragma unroll
  for (int i = 0; i < 4; ++i) {
    int c = tid + 256 * i, tok = c & 127, pc = c >> 7;
    u32x4 v = *(const u32x4*)(src + (size_t)tok * ldg + pc * 8);
#pragma unroll
    for (int j = 0; j < 4; ++j) {
      dst[(pc * 8 + 2 * j) * TST + tok] = (bf16_t)(v[j] & 0xffffu);
      dst[(pc * 8 + 2 * j + 1) * TST + tok] = (bf16_t)(v[j] >> 16);
    }
  }
}
DI void chunk_scan(const Params& p, int layer, int row0, int h, float* csf, float* csb, float* dtF, float* dtB, float* tot, float*  ) {
  const int tid = ltid(), w = tid >> 6, lane = tid & 63;
  const float* DT = (const float*)(p.ws + OFF_DT);
  float v;
  if (tid < 128) {
    const float dt = DT[(size_t)(row0 + tid) * 16 + h];
    v = dt * -__expf(p.a_log[layer * 16 + h]);
    dtF[tid] = dt;
  } else {
    const int e = 255 - tid;
    const float dt = DT[(size_t)(row0 + e) * 16 + 8 + h];
    v = dt * -__expf(p.a_log[layer * 16 + 8 + h]);
    dtB[e] = dt;
  }
#pragma unroll
  for (int o = 1; o < 64; o <<= 1) { const float t = __shfl_up(v, o); if (lane >= o) v += t; }
  if (lane == 63) tot[w] = v;
  __syncthreads();
  if (w == 1) v += tot[0];
  if (w == 3) v += tot[2];
  if (tid < 128) csf[tid] = v; else csb[255 - tid] = v;
  __syncthreads();
}

DI void ssd_state_item(const Params& p, int layer, int b, int tc, int h, char* smem) {
  bf16_t* XT = (bf16_t*)smem;
  bf16_t* BT = XT + 64 * TST;
  float* csf = (float*)(BT + 64 * TST);
  float* csb = csf + 128; float* dtF = csb + 128; float* dtB = dtF + 128; float* laF = dtB + 128; float* laB = laF + 128;
  const int tid = ltid(), w = tid >> 6, lane = tid & 63, r = lane & 31, hh = lane >> 5;
  const int row0 = chunk_row0(b, tc);
  const bf16_t* XBC = (const bf16_t*)(p.ws + OFF_XBC);
  load_tile_T(XT, XBC + (size_t)row0 * 768 + h * 64, 768);
  load_tile_T(BT, XBC + (size_t)row0 * 768 + 512 + (h >> 2) * 64, 768);
  chunk_scan(p, layer, row0, h, csf, csb, dtF, dtB, laF, laB);
  __syncthreads();
  if (tid < 128) laF[tid] = dtF[tid] * __expf(csf[127] - csf[tid]);
  else { int t = tid - 128; laB[t] = dtB[t] * __expf(csb[0] - csb[t]); }
  __syncthreads();
  const int d = w >> 1, pt = w & 1;
  const float* wv = d == 0 ? laF : laB;
  f32x16 acc[2];
#pragma unroll
  for (int i = 0; i < 16; ++i) { acc[0][i] = 0.f; acc[1][i] = 0.f; }
#pragma unroll
  for (int s = 0; s < 8; ++s) {
    int l0 = 16 * s + 8 * hh;
    u32x4 xa = *(const u32x4*)(XT + (32 * pt + r) * TST + l0);
    u32x4 sa;
#pragma unroll
    for (int j = 0; j < 4; ++j) sa[j] = pack2(lo2f(xa[j]) * wv[l0 + 2 * j], hi2f(xa[j]) * wv[l0 + 2 * j + 1]);
    bf16x8 af = __builtin_bit_cast(bf16x8, sa);
#pragma unroll
    for (int nt = 0; nt < 2; ++nt) {
      bf16x8 bfr = *(const bf16x8*)(BT + (32 * nt + r) * TST + l0);
      acc[nt] = MFMA32(af, bfr, acc[nt]);
    }
  }
  bf16_t* S = (bf16_t*)(p.ws + OFF_SST) + ((((size_t)d * NB + b) * NCH + tc) * 8 + h) * 4096;
#pragma unroll
  for (int nt = 0; nt < 2; ++nt)
#pragma unroll
    for (int i = 0; i < 16; ++i) S[(32 * pt + crow(i, hh)) * 64 + 32 * nt + r] = f2bf(acc[nt][i]);
  if (tid == 0) {
    float* TD = (float*)(p.ws + OFF_TDEC);
    TD[((0 * NB + b) * NCH + tc) * 8 + h] = __expf(csf[127]);
    TD[((1 * NB + b) * NCH + tc) * 8 + h] = __expf(csb[0]);
  }
  __syncthreads();
}

DI void ssd_pass_item(const Params& p, int it) {
  const int e = it * 256 + ltid();
  const int pn2 = e & 2047, h = (e >> 11) & 7, b = (e >> 14) & 3, d = e >> 16;
  unsigned* S = (unsigned*)(p.ws + OFF_SST);
  const float* TD = (const float*)(p.ws + OFF_TDEC);
  unsigned sv[NCH]; float T[NCH];
#pragma unroll
  for (int i = 0; i < NCH; ++i) {
    int tc = d == 0 ? i : (i < 2 ? 1 - i : NCH + 1 - i);
    sv[i] = S[(((size_t)(d * NB + b) * NCH + tc) * 8 + h) * 2048 + pn2];
    T[i] = TD[((d * NB + b) * NCH + tc) * 8 + h];
  }
  float h0 = 0.f, h1 = 0.f;
#pragma unroll
  for (int i = 0; i < NCH; ++i) {
    int tc = d == 0 ? i : (i < 2 ? 1 - i : NCH + 1 - i);
    S[(((size_t)(d * NB + b) * NCH + tc) * 8 + h) * 2048 + pn2] = pack2(h0, h1);
    h0 = T[i] * h0 + lo2f(sv[i]); h1 = T[i] * h1 + hi2f(sv[i]);
  }
}

DI void ssd_out_item(const Params& p, int layer, int b, int tc, int h, char* smem) {
  bf16_t* XT = (bf16_t*)smem;
  bf16_t* Bs = XT + 64 * TST;
  float* csf = (float*)(Bs + 128 * BST);
  float* csb = csf + 128; float* dtF = csb + 128; float* dtB = dtF + 128; float* laF = dtB + 128; float* laB = laF + 128;
  const int tid = ltid(), w = tid >> 6, lane = tid & 63, r = lane & 31, hh = lane >> 5;
  const int row0 = chunk_row0(b, tc), g = h >> 2;
  const bf16_t* XBC = (const bf16_t*)(p.ws + OFF_XBC);
  load_tile_T(XT, XBC + (size_t)row0 * 768 + h * 64, 768);
#pragma unroll
  for (int i = 0; i < 4; ++i) {
    int c = tid + 256 * i, tok = c >> 3, part = c & 7;
    *(u32x4*)(Bs + tok * BST + part * 8) = *(const u32x4*)(XBC + (size_t)(row0 + tok) * 768 + 512 + g * 64 + part * 8);
  }
  const int l = 32 * w + r;
  bf16x8 cf[4];
#pragma unroll
  for (int ks = 0; ks < 4; ++ks) cf[ks] = *(const bf16x8*)(XBC + (size_t)(row0 + l) * 768 + 640 + g * 64 + 16 * ks + 8 * hh);
  chunk_scan(p, layer, row0, h, csf, csb, dtF, dtB, laF, laB);
  const float csf_l = csf[l], csb_l = csb[l];
  f32x16 yacc[2];
#pragma unroll
  for (int i = 0; i < 16; ++i) { yacc[0][i] = 0.f; yacc[1][i] = 0.f; }
#pragma unroll
  for (int st = 0; st < 4; ++st) {
    f32x16 gacc;
#pragma unroll
    for (int i = 0; i < 16; ++i) gacc[i] = 0.f;
#pragma unroll
    for (int ks = 0; ks < 4; ++ks) {
      bf16x8 af = *(const bf16x8*)(Bs + (32 * st + r) * BST + 16 * ks + 8 * hh);
      gacc = MFMA32(af, cf[ks], gacc);
    }
#pragma unroll
    for (int i = 0; i < 16; ++i) {
      int s = 32 * st + crow(i, hh);
      float f;
      if (s < l) f = __expf(csf_l - csf[s]) * dtF[s];
      else if (s > l) f = __expf(csb_l - csb[s]) * dtB[s];
      else f = dtF[s] + dtB[s];
      gacc[i] *= f;
    }
#pragma unroll
    for (int s2 = 0; s2 < 2; ++s2) {
      bf16x8 mf = pack8(gacc, s2);
      int sb = 32 * st + 16 * s2 + 4 * hh;
#pragma unroll
      for (int pt = 0; pt < 2; ++pt) {
        u32x2 lo = *(const u32x2*)(XT + (32 * pt + r) * TST + sb);
        u32x2 hi = *(const u32x2*)(XT + (32 * pt + r) * TST + sb + 8);
        u32x4 xa; xa[0] = lo[0]; xa[1] = lo[1]; xa[2] = hi[0]; xa[3] = hi[1];
        yacc[pt] = MFMA32(__builtin_bit_cast(bf16x8, xa), mf, yacc[pt]);
      }
    }
  }
#pragma unroll
  for (int d = 0; d < 2; ++d) {
    const bf16_t* Hs = (const bf16_t*)(p.ws + OFF_SST) + ((((size_t)d * NB + b) * NCH + tc) * 8 + h) * 4096;
    const float e = __expf(d == 0 ? csf_l : csb_l);
#pragma unroll
    for (int pt = 0; pt < 2; ++pt) {
      f32x16 t;
#pragma unroll
      for (int i = 0; i < 16; ++i) t[i] = 0.f;
#pragma unroll
      for (int ks = 0; ks < 4; ++ks) {
        bf16x8 af = *(const bf16x8*)(Hs + (32 * pt + r) * 64 + 16 * ks + 8 * hh);
        t = MFMA32(af, cf[ks], t);
      }
#pragma unroll
      for (int i = 0; i < 16; ++i) yacc[pt][i] += e * t[i];
    }
  }
  const int row = row0 + l;
  const float Dh = p.ssd_d[layer * 8 + h];
  const bf16_t* U = (const bf16_t*)(p.ws + OFF_U);
  bf16_t* YM = (bf16_t*)(p.ws + OFF_H);
  float ssq = 0.f;
  u32x2 xvv[2][4], zvv[2][4];
#pragma unroll
  for (int pt = 0; pt < 2; ++pt)
#pragma unroll
    for (int q = 0; q < 4; ++q) {
      const int pp = 32 * pt + 8 * q + 4 * hh;
      xvv[pt][q] = *(const u32x2*)(XBC + (size_t)row * 768 + h * 64 + pp);
      zvv[pt][q] = *(const u32x2*)(U + (size_t)row * DIN + U_Z + h * 64 + pp);
    }
#pragma unroll
  for (int pt = 0; pt < 2; ++pt)
#pragma unroll
    for (int q = 0; q < 4; ++q) {
      const int pp = 32 * pt + 8 * q + 4 * hh;
      const u32x2 xv = xvv[pt][q], zv = zvv[pt][q];
      float y0 = (yacc[pt][4 * q + 0] + Dh * lo2f(xv[0])) * silu_f(lo2f(zv[0]));
      float y1 = (yacc[pt][4 * q + 1] + Dh * hi2f(xv[0])) * silu_f(hi2f(zv[0]));
      float y2 = (yacc[pt][4 * q + 2] + Dh * lo2f(xv[1])) * silu_f(lo2f(zv[1]));
      float y3 = (yacc[pt][4 * q + 3] + Dh * hi2f(xv[1])) * silu_f(hi2f(zv[1]));
      u32x2 o; o[0] = pack2(y0, y1); o[1] = pack2(y2, y3);
      float r0 = lo2f(o[0]), r1 = hi2f(o[0]), r2 = lo2f(o[1]), r3 = hi2f(o[1]);
      ssq += r0 * r0 + r1 * r1 + r2 * r2 + r3 * r3;
      *(u32x2*)(YM + (size_t)row * DM + 512 + h * 64 + pp) = o;
    }
  ssq += __shfl_xor(ssq, 32);
  if (hh == 0) ((float*)(p.ws + OFF_SSQ))[(size_t)row * 8 + h] = ssq;
  __syncthreads();
}

constexpr int KST = 104;
constexpr int VST = 68;
constexpr int ASTG = 64 * KST + 64 * VST;
DI void attn_item(const Params& p, int b, int head, int qrow0, int t0, bool lat, int nkeys, char* smem) {
  bf16_t* Ks = (bf16_t*)smem;
  bf16_t* Vs = Ks + 64 * KST;
  const int tid = ltid(), w = tid >> 6, lane = tid & 63, r = lane & 31, hh = lane >> 5;
  const bf16_t* QB = (const bf16_t*)(p.ws + OFF_QB);
  const bf16_t* KB = (const bf16_t*)(p.ws + OFF_KB) + (size_t)(b * 4 + head) * LK * 96;
  const bf16_t* VT = (const bf16_t*)(p.ws + OFF_VT) + (size_t)(b * 4 + head) * 64 * LK;
  const float qscale = 0.10206207261596575f * 1.4426950408889634f;
  const int qrow = qrow0 + w * 32 + r;
  const int t = t0 + w * 32 + r;
  bf16x8 qf[6];
  {
    const bf16_t* src = QB + (size_t)qrow * 384 + head * 96;
#pragma unroll
    for (int s = 0; s < 4; ++s) {
      u32x4 v = *(const u32x4*)(src + 16 * s + 8 * hh);
      u32x4 o;
#pragma unroll
      for (int j = 0; j < 4; ++j) o[j] = pack2(lo2f(v[j]) * qscale, hi2f(v[j]) * qscale);
      qf[s] = __builtin_bit_cast(bf16x8, o);
    }
#pragma unroll
    for (int s = 4; s < 6; ++s) {
      u32x4 va = *(const u32x4*)(src + 16 * s), vb = *(const u32x4*)(src + 16 * s + 8);
      float posf = s == 4 ? (float)(t >> 6) : (float)(t & 63);
      float o[8];
#pragma unroll
      for (int j = 0; j < 8; ++j) {
        float a = (j & 1) ? hi2f(va[j >> 1]) : lo2f(va[j >> 1]);
        float bb = (j & 1) ? hi2f(vb[j >> 1]) : lo2f(vb[j >> 1]);
        float res;
        if (lat) {
          float invf = exp2f(-(float)(2 * j) * (13.287712379549449f / 16.f));
          float rev = posf * invf * 0.15915494309189535f;
          float cs = __builtin_amdgcn_cosf(rev), sn = __builtin_amdgcn_sinf(rev);
          res = hh == 0 ? a * cs - bb * sn : bb * cs + a * sn;
        } else res = hh == 0 ? a : bb;
        o[j] = res * qscale;
      }
      u32x4 ov; ov[0] = pack2(o[0], o[1]); ov[1] = pack2(o[2], o[3]); ov[2] = pack2(o[4], o[5]); ov[3] = pack2(o[6], o[7]);
      qf[s] = __builtin_bit_cast(bf16x8, ov);
    }
  }
  f32x16 oacc[2];
#pragma unroll
  for (int i = 0; i < 16; ++i) { oacc[0][i] = 0.f; oacc[1][i] = 0.f; }
  float m = -1e30f, lsum = 0.f;
  u32x4 rk[3], rv[2];
  auto gload = [&](int key0) {
#pragma unroll
    for (int i = 0; i < 3; ++i) rk[i] = *(const u32x4*)(KB + (size_t)key0 * 96 + (tid + 256 * i) * 8);
#pragma unroll
    for (int i = 0; i < 2; ++i) { int c = tid + 256 * i; rv[i] = *(const u32x4*)(VT + (size_t)(c >> 3) * LK + key0 + (c & 7) * 8); }
  };
  gload(0);
  const int NT = nkeys / 64;
  for (int kt = 0; kt < NT; ++kt) {
#pragma unroll
    for (int i = 0; i < 3; ++i) { int c = tid + 256 * i; *(u32x4*)(Ks + (c / 12) * KST + (c % 12) * 8) = rk[i]; }
#pragma unroll
    for (int i = 0; i < 2; ++i) {
      int c = tid + 256 * i;
      bf16_t* d = Vs + (c >> 3) * VST + (c & 7) * 8;
      u32x2 a; a[0] = rv[i][0]; a[1] = rv[i][1];
      u32x2 bq; bq[0] = rv[i][2]; bq[1] = rv[i][3];
      *(u32x2*)d = a; *(u32x2*)(d + 4) = bq;
    }
    __syncthreads();
    if (kt + 1 < NT) gload((kt + 1) * 64);
    f32x16 sacc[2];
#pragma unroll
    for (int i = 0; i < 16; ++i) { sacc[0][i] = 0.f; sacc[1][i] = 0.f; }
#pragma unroll
    for (int s = 0; s < 6; ++s)
#pragma unroll
      for (int k2 = 0; k2 < 2; ++k2) {
        bf16x8 af = *(const bf16x8*)(Ks + (32 * k2 + r) * KST + 16 * s + 8 * hh);
        sacc[k2] = MFMA32(af, qf[s], sacc[k2]);
      }
    float mx = sacc[0][0];
#pragma unroll
    for (int i = 0; i < 16; ++i) { mx = fmaxf(mx, sacc[0][i]); mx = fmaxf(mx, sacc[1][i]); }
    mx = fmaxf(mx, __shfl_xor(mx, 32));
    const float mn = fmaxf(m, mx);
    const float alpha = __builtin_amdgcn_exp2f(m - mn);
    m = mn;
    float ps = 0.f;
#pragma unroll
    for (int i = 0; i < 16; ++i) {
      sacc[0][i] = __builtin_amdgcn_exp2f(sacc[0][i] - mn); sacc[1][i] = __builtin_amdgcn_exp2f(sacc[1][i] - mn);
      ps += sacc[0][i] + sacc[1][i];
    }
    lsum = lsum * alpha + ps;
#pragma unroll
    for (int i = 0; i < 16; ++i) { oacc[0][i] *= alpha; oacc[1][i] *= alpha; }
#pragma unroll
    for (int k2 = 0; k2 < 2; ++k2)
#pragma unroll
      for (int s2 = 0; s2 < 2; ++s2) {
        bf16x8 pf = pack8(sacc[k2], s2);
        int kb0 = 32 * k2 + 16 * s2 + 4 * hh;
#pragma unroll
        for (int d = 0; d < 2; ++d) {
          u32x2 lo = *(const u32x2*)(Vs + (32 * d + r) * VST + kb0);
          u32x2 hi = *(const u32x2*)(Vs + (32 * d + r) * VST + kb0 + 8);
          u32x4 va; va[0] = lo[0]; va[1] = lo[1]; va[2] = hi[0]; va[3] = hi[1];
          oacc[d] = MFMA32(__builtin_bit_cast(bf16x8, va), pf, oacc[d]);
        }
      }
    __syncthreads();
  }
  lsum += __shfl_xor(lsum, 32);
  const float inv = 1.f / lsum;
  bf16_t* YM = (bf16_t*)(p.ws + OFF_H) + (size_t)qrow * DM + head * 64;
#pragma unroll
  for (int d = 0; d < 2; ++d)
#pragma unroll
    for (int q = 0; q < 4; ++q) {
      u32x2 o; o[0] = pack2(oacc[d][4 * q] * inv, oacc[d][4 * q + 1] * inv); o[1] = pack2(oacc[d][4 * q + 2] * inv, oacc[d][4 * q + 3] * inv);
      *(u32x2*)(YM + 32 * d + 8 * q + 4 * hh) = o;
    }
}

DI void attn_item8(const Params& p, int b, int head, int qrow0, int t0, bool lat, int nkeys, char* smem) {
  bf16_t* Ks = (bf16_t*)smem;
  bf16_t* Vs = Ks + 64 * KST;
  const int tid = ltid512(), w = tid >> 6, lane = tid & 63, r = lane & 31, hh = lane >> 5;
  const bf16_t* QB = (const bf16_t*)(p.ws + OFF_QB);
  const bf16_t* KB = (const bf16_t*)(p.ws + OFF_KB) + (size_t)(b * 4 + head) * LK * 96;
  const bf16_t* VT = (const bf16_t*)(p.ws + OFF_VT) + (size_t)(b * 4 + head) * 64 * LK;
  const float qscale = 0.10206207261596575f * 1.4426950408889634f;
  const int qrow = qrow0 + w * 32 + r;
  const int t = t0 + w * 32 + r;
  bf16x8 qf[6];
  {
    const bf16_t* src = QB + (size_t)qrow * 384 + head * 96;
#pragma unroll
    for (int s = 0; s < 4; ++s) {
      u32x4 v = *(const u32x4*)(src + 16 * s + 8 * hh);
      u32x4 o;
#pragma unroll
      for (int j = 0; j < 4; ++j) o[j] = pack2(lo2f(v[j]) * qscale, hi2f(v[j]) * qscale);
      qf[s] = __builtin_bit_cast(bf16x8, o);
    }
#pragma unroll
    for (int s = 4; s < 6; ++s) {
      u32x4 va = *(const u32x4*)(src + 16 * s), vb = *(const u32x4*)(src + 16 * s + 8);
      float posf = s == 4 ? (float)(t >> 6) : (float)(t & 63);
      float o[8];
#pragma unroll
      for (int j = 0; j < 8; ++j) {
        float a = (j & 1) ? hi2f(va[j >> 1]) : lo2f(va[j >> 1]);
        float bb = (j & 1) ? hi2f(vb[j >> 1]) : lo2f(vb[j >> 1]);
        float res;
        if (lat) {
          float invf = exp2f(-(float)(2 * j) * (13.287712379549449f / 16.f));
          float rev = posf * invf * 0.15915494309189535f;
          float cs = __builtin_amdgcn_cosf(rev), sn = __builtin_amdgcn_sinf(rev);
          res = hh == 0 ? a * cs - bb * sn : bb * cs + a * sn;
        } else res = hh == 0 ? a : bb;
        o[j] = res * qscale;
      }
      u32x4 ov; ov[0] = pack2(o[0], o[1]); ov[1] = pack2(o[2], o[3]); ov[2] = pack2(o[4], o[5]); ov[3] = pack2(o[6], o[7]);
      qf[s] = __builtin_bit_cast(bf16x8, ov);
    }
  }
  f32x16 oacc[2];
#pragma unroll
  for (int i = 0; i < 16; ++i) { oacc[0][i] = 0.f; oacc[1][i] = 0.f; }
  float m = -1e30f, lsum = 0.f;
  u32x4 rk[2], rv;
  auto gload = [&](int key0) {
    rk[0] = *(const u32x4*)(KB + (size_t)key0 * 96 + tid * 8);
    if (tid < 256) rk[1] = *(const u32x4*)(KB + (size_t)key0 * 96 + (512 + tid) * 8);
    rv = *(const u32x4*)(VT + (size_t)(tid >> 3) * LK + key0 + (tid & 7) * 8);
  };
  const int kro = (tid / 12) * KST + (tid % 12) * 8, kro2 = ((512 + tid) / 12) * KST + ((512 + tid) % 12) * 8;
  auto swrite = [&](int stage) {
    bf16_t* Kd = Ks + stage * ASTG;
    *(u32x4*)(Kd + kro) = rk[0];
    if (tid < 256) *(u32x4*)(Kd + kro2) = rk[1];
    bf16_t* d = Kd + 64 * KST + (tid >> 3) * VST + (tid & 7) * 8;
    u32x2 a; a[0] = rv[0]; a[1] = rv[1];
    u32x2 bq; bq[0] = rv[2]; bq[1] = rv[3];
    *(u32x2*)d = a; *(u32x2*)(d + 4) = bq;
  };
  auto qk = [&](int stage, f32x16 (&sa)[2]) {
    const bf16_t* Kc = Ks + stage * ASTG;
#pragma unroll
    for (int i = 0; i < 16; ++i) { sa[0][i] = 0.f; sa[1][i] = 0.f; }
#pragma unroll
    for (int s = 0; s < 6; ++s)
#pragma unroll
      for (int k2 = 0; k2 < 2; ++k2) {
        bf16x8 af = *(const bf16x8*)(Kc + (32 * k2 + r) * KST + 16 * s + 8 * hh);
        sa[k2] = MFMA32(af, qf[s], sa[k2]);
      }
  };
  const int NT = nkeys / 64;
  f32x16 sacc[2], snext[2];
  gload(0); swrite(0);
  gload(64);
  __syncthreads();
  swrite(1);
  gload(128);
  qk(0, sacc);
  __syncthreads();
  int cur = 0, nxt = 1, nn = 2;
  for (int kt = 0; kt < NT; ++kt) {
    if (kt + 1 < NT) qk(nxt, snext);
    if (kt + 2 < NT) {
      swrite(nn);
      if (kt + 3 < NT) gload((kt + 3) * 64);
    }
    const bf16_t* Vc = Ks + cur * ASTG + 64 * KST;
    float mx = sacc[0][0];
#pragma unroll
    for (int i = 0; i < 16; ++i) { mx = fmaxf(mx, sacc[0][i]); mx = fmaxf(mx, sacc[1][i]); }
    mx = fmaxf(mx, __shfl_xor(mx, 32));
    const float mn = fmaxf(m, mx);
    const float alpha = __builtin_amdgcn_exp2f(m - mn);
    m = mn;
    float ps = 0.f;
#pragma unroll
    for (int i = 0; i < 16; ++i) {
      sacc[0][i] = __builtin_amdgcn_exp2f(sacc[0][i] - mn); sacc[1][i] = __builtin_amdgcn_exp2f(sacc[1][i] - mn);
      ps += sacc[0][i] + sacc[1][i];
    }
    lsum = lsum * alpha + ps;
#pragma unroll
    for (int i = 0; i < 16; ++i) { oacc[0][i] *= alpha; oacc[1][i] *= alpha; }
#pragma unroll
    for (int k2 = 0; k2 < 2; ++k2)
#pragma unroll
      for (int s2 = 0; s2 < 2; ++s2) {
        bf16x8 pf = pack8(sacc[k2], s2);
        int kb0 = 32 * k2 + 16 * s2 + 4 * hh;
#pragma unroll
        for (int d = 0; d < 2; ++d) {
          u32x2 lo = *(const u32x2*)(Vc + (32 * d + r) * VST + kb0);
          u32x2 hi = *(const u32x2*)(Vc + (32 * d + r) * VST + kb0 + 8);
          u32x4 va; va[0] = lo[0]; va[1] = lo[1]; va[2] = hi[0]; va[3] = hi[1];
          oacc[d] = MFMA32(__builtin_bit_cast(bf16x8, va), pf, oacc[d]);
        }
      }
    sacc[0] = snext[0]; sacc[1] = snext[1];
    const int t3 = cur; cur = nxt; nxt = nn; nn = t3;
    __syncthreads();
  }
  lsum += __shfl_xor(lsum, 32);
  const float inv = 1.f / lsum;
  bf16_t* YM = (bf16_t*)(p.ws + OFF_H) + (size_t)qrow * DM + head * 64;
#pragma unroll
  for (int d = 0; d < 2; ++d)
#pragma unroll
    for (int q = 0; q < 4; ++q) {
      u32x2 o; o[0] = pack2(oacc[d][4 * q] * inv, oacc[d][4 * q + 1] * inv); o[1] = pack2(oacc[d][4 * q + 2] * inv, oacc[d][4 * q + 3] * inv);
      *(u32x2*)(YM + 32 * d + 8 * q + 4 * hh) = o;
    }
}

DI void attn_item8b(const Params& p, int b, int head, int qrow0, int t0, bool lat, int nkeys, char* smem) {
  bf16_t* Ks = (bf16_t*)smem;
  bf16_t* Vs = Ks + 64 * KST;
  const int tid = ltid512(), w = tid >> 6, lane = tid & 63, r = lane & 31, hh = lane >> 5;
  const bf16_t* QB = (const bf16_t*)(p.ws + OFF_QB);
  const bf16_t* KB = (const bf16_t*)(p.ws + OFF_KB) + (size_t)(b * 4 + head) * LK * 96;
  const bf16_t* VT = (const bf16_t*)(p.ws + OFF_VT) + (size_t)(b * 4 + head) * 64 * LK;
  const float qscale = 0.10206207261596575f * 1.4426950408889634f;
  const int qrow = qrow0 + w * 32 + r;
  const int t = t0 + w * 32 + r;
  bf16x8 qf[6];
  {
    const bf16_t* src = QB + (size_t)qrow * 384 + head * 96;
#pragma unroll
    for (int s = 0; s < 4; ++s) {
      u32x4 v = *(const u32x4*)(src + 16 * s + 8 * hh);
      u32x4 o;
#pragma unroll
      for (int j = 0; j < 4; ++j) o[j] = pack2(lo2f(v[j]) * qscale, hi2f(v[j]) * qscale);
      qf[s] = __builtin_bit_cast(bf16x8, o);
    }
#pragma unroll
    for (int s = 4; s < 6; ++s) {
      u32x4 va = *(const u32x4*)(src + 16 * s), vb = *(const u32x4*)(src + 16 * s + 8);
      float posf = s == 4 ? (float)(t >> 6) : (float)(t & 63);
      float o[8];
#pragma unroll
      for (int j = 0; j < 8; ++j) {
        float a = (j & 1) ? hi2f(va[j >> 1]) : lo2f(va[j >> 1]);
        float bb = (j & 1) ? hi2f(vb[j >> 1]) : lo2f(vb[j >> 1]);
        float res;
        if (lat) {
          float invf = exp2f(-(float)(2 * j) * (13.287712379549449f / 16.f));
          float rev = posf * invf * 0.15915494309189535f;
          float cs = __builtin_amdgcn_cosf(rev), sn = __builtin_amdgcn_sinf(rev);
          res = hh == 0 ? a * cs - bb * sn : bb * cs + a * sn;
        } else res = hh == 0 ? a : bb;
        o[j] = res * qscale;
      }
      u32x4 ov; ov[0] = pack2(o[0], o[1]); ov[1] = pack2(o[2], o[3]); ov[2] = pack2(o[4], o[5]); ov[3] = pack2(o[6], o[7]);
      qf[s] = __builtin_bit_cast(bf16x8, ov);
    }
  }
  f32x16 oacc[2];
#pragma unroll
  for (int i = 0; i < 16; ++i) { oacc[0][i] = 0.f; oacc[1][i] = 0.f; }
  float m = -1e30f, lsum = 0.f;
  constexpr int VS2 = 132;
  constexpr int STG = 128 * KST + 64 * VS2;
  u32x4 rk[3], rv[2];
  auto gload = [&](int key0) {
#pragma unroll
    for (int i = 0; i < 3; ++i) rk[i] = *(const u32x4*)(KB + (size_t)key0 * 96 + (tid + 512 * i) * 8);
#pragma unroll
    for (int i = 0; i < 2; ++i) { const int c = tid + 512 * i; rv[i] = *(const u32x4*)(VT + (size_t)(c >> 4) * LK + key0 + (c & 15) * 8); }
  };
  int kro[3], vro[2];
#pragma unroll
  for (int i = 0; i < 3; ++i) { const int c = tid + 512 * i; kro[i] = (c / 12) * KST + (c % 12) * 8; }
#pragma unroll
  for (int i = 0; i < 2; ++i) { const int c = tid + 512 * i; vro[i] = 128 * KST + (c >> 4) * VS2 + (c & 15) * 8; }
  auto swrite = [&](int stage) {
    bf16_t* Kd = Ks + stage * STG;
#pragma unroll
    for (int i = 0; i < 3; ++i) *(u32x4*)(Kd + kro[i]) = rk[i];
#pragma unroll
    for (int i = 0; i < 2; ++i) {
      u32x2 a; a[0] = rv[i][0]; a[1] = rv[i][1];
      u32x2 bq; bq[0] = rv[i][2]; bq[1] = rv[i][3];
      *(u32x2*)(Kd + vro[i]) = a; *(u32x2*)(Kd + vro[i] + 4) = bq;
    }
  };
  const int NT = nkeys / 128;
  gload(0); swrite(0);
  if (NT > 1) gload(128);
  __syncthreads();
  for (int kt = 0; kt < NT; ++kt) {
    const bf16_t* Kc = Ks + (kt & 1) * STG;
    const bf16_t* Vc = Kc + 128 * KST;
    if (kt + 1 < NT) {
      swrite((kt + 1) & 1);
      if (kt + 2 < NT) gload((kt + 2) * 128);
    }
    f32x16 sacc[4];
#pragma unroll
    for (int k2 = 0; k2 < 4; ++k2)
#pragma unroll
      for (int i = 0; i < 16; ++i) sacc[k2][i] = 0.f;
#pragma unroll
    for (int s = 0; s < 6; ++s)
#pragma unroll
      for (int k2 = 0; k2 < 4; ++k2) {
        bf16x8 af = *(const bf16x8*)(Kc + (32 * k2 + r) * KST + 16 * s + 8 * hh);
        sacc[k2] = MFMA32(af, qf[s], sacc[k2]);
      }
    float mx = sacc[0][0];
#pragma unroll
    for (int k2 = 0; k2 < 4; ++k2)
#pragma unroll
      for (int i = 0; i < 16; ++i) mx = fmaxf(mx, sacc[k2][i]);
    mx = fmaxf(mx, __shfl_xor(mx, 32));
    const float mn = fmaxf(m, mx);
    const float alpha = __builtin_amdgcn_exp2f(m - mn);
    m = mn;
    float ps = 0.f;
#pragma unroll
    for (int k2 = 0; k2 < 4; ++k2)
#pragma unroll
      for (int i = 0; i < 16; ++i) { sacc[k2][i] = __builtin_amdgcn_exp2f(sacc[k2][i] - mn); ps += sacc[k2][i]; }
    lsum = lsum * alpha + ps;
#pragma unroll
    for (int i = 0; i < 16; ++i) { oacc[0][i] *= alpha; oacc[1][i] *= alpha; }
#pragma unroll
    for (int k2 = 0; k2 < 4; ++k2)
#pragma unroll
      for (int s2 = 0; s2 < 2; ++s2) {
        bf16x8 pf = pack8(sacc[k2], s2);
        const int kb0 = 32 * k2 + 16 * s2 + 4 * hh;
#pragma unroll
        for (int d = 0; d < 2; ++d) {
          u32x2 lo = *(const u32x2*)(Vc + (32 * d + r) * VS2 + kb0);
          u32x2 hi = *(const u32x2*)(Vc + (32 * d + r) * VS2 + kb0 + 8);
          u32x4 va; va[0] = lo[0]; va[1] = lo[1]; va[2] = hi[0]; va[3] = hi[1];
          oacc[d] = MFMA32(__builtin_bit_cast(bf16x8, va), pf, oacc[d]);
        }
      }
    __syncthreads();
  }
  lsum += __shfl_xor(lsum, 32);
  const float inv = 1.f / lsum;
  bf16_t* YM = (bf16_t*)(p.ws + OFF_H) + (size_t)qrow * DM + head * 64;
#pragma unroll
  for (int d = 0; d < 2; ++d)
#pragma unroll
    for (int q = 0; q < 4; ++q) {
      u32x2 o; o[0] = pack2(oacc[d][4 * q] * inv, oacc[d][4 * q + 1] * inv); o[1] = pack2(oacc[d][4 * q + 2] * inv, oacc[d][4 * q + 3] * inv);
      *(u32x2*)(YM + 32 * d + 8 * q + 4 * hh) = o;
    }
}

DI void phase_qkv(const Params& p, int layer, int bid, int nb, char* smem) {
  const int MQ = layer == 0 ? MT : ML;
  const int nq = (MQ / 128) * 3, nkv = (MT / 128) * 4, nst = NB * NCH * 8;
  const float* RS = (const float*)(p.ws + OFF_RSTD);
  EpiQ eq{(bf16_t*)(p.ws + OFF_QB), RS};
  EpiKV ekv{(bf16_t*)(p.ws + OFF_KB), (bf16_t*)(p.ws + OFF_VT), RS};
  const bf16_t* U = (const bf16_t*)(p.ws + OFF_U);
  for (int it = bid; it < nq + nkv + nst; it += nb) {
    if (it < nq) gemm_tile<false>(U, DIN, wt_ptr(p, layer, WT_UQ), 256, (it / 3) * 128, (it % 3) * 128, smem, eq);
    else if (it < nq + nkv) { int j = it - nq; gemm_tile<false>(U + U_CKV, DIN, wt_ptr(p, layer, WT_UKV), 128, (j / 4) * 128, (j % 4) * 128, smem, ekv); }
    else { int j = it - nq - nkv; for (int rep = 0; rep < REP_SSD; ++rep) ssd_state_item(p, layer, j / (NCH * 8), (j / 8) % NCH, j & 7, smem); }
  }
}
DI void phase_att(const Params& p, int layer, int bid, int nb, int vbid, int nvb, char* smem, char* sh) {
  for (int it = bid; it < 256; it += nb) {
    const int x = it & 7, j = it >> 3, bh = 2 * x + (j >> 4), qb = j & 15, b = bh >> 2, head = bh & 3;
    for (int rep = 0; rep < REP_ATT; ++rep) attn_item8b(p, b, head, b * SEQ + qb * 256, qb * 256, true, LK, smem);
  }
  for (int it = vbid; it < 512; it += nvb) ssd_pass_item(p, it);
}
DI void phase_ssdout(const Params& p, int layer, int bid, int nb, char* smem) {
  const int nout = NB * NCH * 8, nctx = layer == 0 ? 32 : 0;
  for (int it = bid; it < nout + nctx; it += nb) {
    if (it < nout) {
      int b = it / (NCH * 8), tc = (it / 8) % NCH, h = it & 7;
      if (layer == 1 && tc < 2) continue;
      for (int rep = 0; rep < REP_SSD; ++rep) ssd_out_item(p, layer, b, tc, h, smem);
    } else {
      const int j = it - nout, b = j >> 3, head = (j >> 1) & 3, qb = j & 1;
      attn_item(p, b, head, ML + b * CTX + qb * 128, qb * 128, false, CTX, smem);
    }
  }
  if (layer == 0) {
    if (nb == 512) { if (bid >= 96) for (int it = bid - 96; it < WT_ITEMS; it += 416) wt_item(p, 1, it, smem); }
    else for (int it = bid; it < WT_ITEMS; it += nb) wt_item(p, 1, it, smem);
  }
}


#define XB_TMO      128
#define XB_XCNT(j)  (256  + 64 * (j))
#define XB_XSUB(j)  (1280 + 64 * (j))
#define XB_XGEN(j)  (2304 + 64 * (j))
#define XB_TOP      3328
#define XB_TOPGEN   3392
#define XCD_BAR_WORDS 3456
#define XB_SPIN_CAP (1u << 22)
#define LAS __attribute__((address_space(3)))
DI unsigned xb_ld(unsigned* p) { return __hip_atomic_load(p, __ATOMIC_RELAXED, __HIP_MEMORY_SCOPE_AGENT); }
DI unsigned xb_add(unsigned* p, unsigned v) { return __hip_atomic_fetch_add(p, v, __ATOMIC_RELAXED, __HIP_MEMORY_SCOPE_AGENT); }
DI unsigned xb_xcc_id() { return (unsigned)__builtin_amdgcn_s_getreg((3 << 11) | 20) & 0xFu; }
#define XB_SPIN(cond, bar) do { unsigned _sp = 0; while (cond) { __builtin_amdgcn_s_sleep(1); \
    if ((++_sp & 255u) == 0u) { if (xb_ld(&(bar)[XB_TMO])) break; if (_sp > XB_SPIN_CAP) { atomicAdd(&(bar)[XB_TMO], 1u); break; } } } } while (0)
struct XcdBarrier { unsigned* bar; unsigned x; volatile LAS unsigned* st; };
DI XcdBarrier xcd_barrier_post(unsigned* bar, volatile LAS unsigned* st) {
  XcdBarrier b; b.bar = bar; b.x = xb_xcc_id(); b.st = st;
  if (threadIdx.x == 0) (void)xb_add(&bar[XB_XCNT(b.x)], 1u);
  return b;
}
DI void xcd_barrier_complete(unsigned* bar, unsigned x, unsigned& nloc, unsigned& nx) {
  const unsigned G = gridDim.x * gridDim.y * gridDim.z;
  unsigned sum, cnt, mine, sp = 0u;
  for (;;) {
    sum = 0u; cnt = 0u; mine = 0u;
#pragma unroll
    for (unsigned j = 0; j < 16; ++j) { const unsigned c = xb_ld(&bar[XB_XCNT(j)]); sum += c; cnt += (c > 0u) ? 1u : 0u; mine = (j == x) ? c : mine; }
    if (sum == G) break;
    __builtin_amdgcn_s_sleep(1);
    if ((++sp & 255u) == 0u) { if (xb_ld(&bar[XB_TMO])) break; if (sp > XB_SPIN_CAP) { atomicAdd(&bar[XB_TMO], 1u); break; } }
  }
  nloc = mine > 0u ? mine : 1u; nx = cnt > 0u ? cnt : 1u;
}
DI void xcd_barrier(const XcdBarrier& b) {
  asm volatile("s_waitcnt vmcnt(0)" ::: "memory");
  __syncthreads();
  if (threadIdx.x == 0) {
    unsigned* bar = b.bar;
    asm volatile("" : "+s"(bar));
    __builtin_amdgcn_s_waitcnt(0);
    unsigned nloc = b.st[0], nx = b.st[1];
    if (nloc == 0u) { xcd_barrier_complete(bar, b.x, nloc, nx); b.st[0] = nloc; b.st[1] = nx; }
    const unsigned old = xb_add(&bar[XB_XSUB(b.x)], 1u);
    const unsigned gen = old / nloc;
    if (old + 1u == (gen + 1u) * nloc) {
      __builtin_amdgcn_fence(__ATOMIC_RELEASE, "agent");
      asm volatile("s_waitcnt vmcnt(0)" ::: "memory");
      const unsigned og = xb_add(&bar[XB_TOP], 1u);
      const unsigned tg = og / nx;
      if (og + 1u == (tg + 1u) * nx) xb_add(&bar[XB_TOPGEN], 1u);
      else XB_SPIN(xb_ld(&bar[XB_TOPGEN]) == tg, bar);
      __builtin_amdgcn_fence(__ATOMIC_ACQUIRE, "agent");
      xb_add(&bar[XB_XGEN(b.x)], 1u);
      asm volatile("s_waitcnt vmcnt(0)" ::: "memory");
    } else {
      XB_SPIN(xb_ld(&bar[XB_XGEN(b.x)]) == gen, bar);
      __builtin_amdgcn_fence(__ATOMIC_ACQUIRE, "agent");
      asm volatile("s_waitcnt vmcnt(0)" ::: "memory");
    }
  }
  __syncthreads();
}

constexpr int SMEM_BYTES = 2 * GBUF * 2;
enum { PH_PREP0 = 0, PH_H0, PH_INPROJ, PH_PREP, PH_QKV, PH_ATT, PH_SSDOUT, PH_WOUT, PH_POSTMIX, PH_FF1, PH_FF2, PH_POSTFFN, PH_SSDNORM };

struct Ids { int bid, nb, vbid, nvb, lid; };
DI void run_phase(const Params& p, int ph, int layer, const Ids& id, char* smem, char* sh) {
  switch (ph) {
    case PH_PREP0: phase_prep0(p, id.vbid, id.nvb, sh); break;
    case PH_H0: phase_h0(p, id.vbid, id.nvb); break;
    case PH_INPROJ: phase_inproj(p, layer, id.bid, id.nb, id.vbid, id.nvb, smem, sh); break;
    case PH_PREP: phase_prep(p, layer, id.vbid, id.nvb); break;
    case PH_QKV: phase_qkv(p, layer, id.vbid, id.nvb, sh); break;
    case PH_ATT: phase_att(p, layer, id.bid, id.nb, id.vbid, id.nvb, smem, sh); break;
    case PH_SSDOUT: phase_ssdout(p, layer, id.vbid, id.nvb, sh); break;
    case PH_WOUT: phase_wout(p, layer, id.lid, id.nvb, sh); break;
    case PH_POSTMIX: phase_postmix(p, layer, id.vbid, id.nvb); break;
    case PH_FF1: phase_ff1(p, layer, id.bid, id.nb, id.vbid, id.nvb, smem, sh); break;
    case PH_FF2: phase_ff2(p, layer, id.bid, id.nb, id.vbid, id.nvb, smem, sh); break;
    case PH_POSTFFN: phase_postffn(p, layer, id.vbid, id.nvb); break;
  }
}

__global__ void __launch_bounds__(512) mega_kernel(Params p) {
  extern __shared__ __attribute__((aligned(16))) char smem[];
  cg::grid_group grid = cg::this_grid();
  if (p.ws == nullptr) grid.sync();
  const int half = __builtin_amdgcn_readfirstlane((int)(threadIdx.x >> 8));
  Ids id;
  id.bid = blockIdx.x; id.nb = gridDim.x;
  id.vbid = 2 * id.bid + half; id.nvb = 2 * id.nb;
  id.lid = (id.bid & 7) + 8 * (2 * (id.bid >> 3) + half);
  char* sh = smem + half * SMEM_BYTES;
  volatile LAS unsigned* st = (volatile LAS unsigned*)(smem + 2 * SMEM_BYTES - 16);
  if (threadIdx.x == 0) { st[0] = 0u; st[1] = 0u; st[2] = 0u; st[3] = 0u; }
  __syncthreads();
  XcdBarrier xb = xcd_barrier_post((unsigned*)(p.ws + OFF_BAR), st);
#define MK_STEP(PH, LAYER, LAST) do { \
    typedef const void* __attribute__((address_space(4))) * KArgs; \
    KArgs ka = (KArgs)__builtin_amdgcn_kernarg_segment_ptr(); \
    asm volatile("" : "+s"(ka)); \
    Params q; \
    { const void** dst = (const void**)&q; _Pragma("unroll") for (int i = 0; i < 27; ++i) dst[i] = ka[i]; } \
    run_phase(q, PH, LAYER, id, smem, sh); \
    if (!(LAST)) xcd_barrier(xb); } while (0)
  MK_STEP(PH_PREP0, 0, false);
  MK_STEP(PH_H0, 0, false);
  MK_STEP(PH_INPROJ, 0, false); MK_STEP(PH_PREP, 0, false); MK_STEP(PH_QKV, 0, false); MK_STEP(PH_ATT, 0, false); MK_STEP(PH_SSDOUT, 0, false);
  MK_STEP(PH_WOUT, 0, false); MK_STEP(PH_POSTMIX, 0, false); MK_STEP(PH_FF1, 0, false); MK_STEP(PH_FF2, 0, false); MK_STEP(PH_POSTFFN, 0, false);
  MK_STEP(PH_INPROJ, 1, false); MK_STEP(PH_PREP, 1, false); MK_STEP(PH_QKV, 1, false); MK_STEP(PH_ATT, 1, false); MK_STEP(PH_SSDOUT, 1, false);
  MK_STEP(PH_WOUT, 1, false); MK_STEP(PH_POSTMIX, 1, false); MK_STEP(PH_FF1, 1, false); MK_STEP(PH_FF2, 1, false); MK_STEP(PH_POSTFFN, 1, true);
#undef MK_STEP
}

extern "C" void kernel_launch(void* const* d_in, const int* in_sizes, int n_in, void* d_out, int out_size, void* d_ws, size_t ws_size,
                              hipStream_t stream) {
  if (ws_size < WS_NEED) { fprintf(stderr, "workspace too small: %zu < %zu\n", ws_size, (size_t)WS_NEED); return; }
  Params p{};
  const float** f = (const float**)&p;
  for (int i = 0; i < 25; ++i) f[i] = (const float*)d_in[i];
  p.out = (float*)d_out;
  p.ws = (char*)d_ws;
  static int grid_blocks = 0;
  if (!grid_blocks) {
    int dev = 0, cus = 0, per_cu = 0;
    hipGetDevice(&dev);
    hipDeviceGetAttribute(&cus, hipDeviceAttributeMultiprocessorCount, dev);
    hipFuncSetAttribute((const void*)mega_kernel, hipFuncAttributeMaxDynamicSharedMemorySize, 2 * SMEM_BYTES);
    hipOccupancyMaxActiveBlocksPerMultiprocessor(&per_cu, mega_kernel, 512, 2 * SMEM_BYTES);
    if (per_cu > 1) per_cu = 1;
    grid_blocks = cus * per_cu;
  }
  hipMemsetAsync((char*)d_ws + OFF_BAR, 0, XCD_BAR_WORDS * 4, stream);
  void* args[] = {&p};
  hipError_t e = hipLaunchCooperativeKernel((void*)mega_kernel, dim3(grid_blocks), dim3(512), args, 2 * SMEM_BYTES, stream);
  if (e != hipSuccess) fprintf(stderr, "cooperative launch failed: %s (grid %d)\n", hipGetErrorString(e), grid_blocks);
}
```

```cpp
#include <hip/hip_runtime.h>
#include <hip/hip_cooperative_groups.h>
#include <stdint.h>
#include <stdio.h>
namespace cg = cooperative_groups;

#ifndef MEGA
#define MEGA 1
#endif
#ifndef REP_GEMM
#define REP_GEMM 1
#endif
#ifndef REP_ATT
#define REP_ATT 1
#endif
#ifndef REP_SSD
#define REP_SSD 1
#endif

typedef unsigned short bf16_t;
using bf16x8 = __attribute__((ext_vector_type(8))) short;
using s16x4  = __attribute__((ext_vector_type(4))) short;
using f32x4  = __attribute__((ext_vector_type(4))) float;
using f32x16 = __attribute__((ext_vector_type(16))) float;
using u32x4  = __attribute__((ext_vector_type(4))) unsigned;
using u32x2  = __attribute__((ext_vector_type(2))) unsigned;
#define DI __device__ __forceinline__
#define MFMA32(a, b, c) __builtin_amdgcn_mfma_f32_32x32x16_bf16((a), (b), (c), 0, 0, 0)
#define MFMA16(a, b, c) __builtin_amdgcn_mfma_f32_16x16x32_bf16((a), (b), (c), 0, 0, 0)

constexpr int DM = 1024, NB = 4, SEQ = 4096, CTX = 256;
constexpr int ML = NB * SEQ;
constexpr int MC = NB * CTX;
constexpr int MT = ML + MC;
constexpr int DIN = 2480, DINP = 2560;
constexpr int LK = CTX + SEQ;
constexpr int DFF = 4096;
constexpr int NCH = 34;
constexpr float EPS = 1e-6f;
constexpr int U_CKV = 256, U_KR = 384, U_GB = 416, U_GC = 672, U_VAL = 928, U_Z = 1184, U_XBC = 1696, U_DT = 2464;

constexpr size_t AL(size_t x) { return (x + 255) & ~(size_t)255; }
constexpr size_t WT_IN = 0;
constexpr size_t WT_UQ = WT_IN + (size_t)DINP * 1024;
constexpr size_t WT_UKV = WT_UQ + (size_t)384 * 256;
constexpr size_t WT_OUT = WT_UKV + (size_t)512 * 128;
constexpr size_t WT_FF1 = WT_OUT + (size_t)1024 * 1024;
constexpr size_t WT_FF2 = WT_FF1 + (size_t)4096 * 1024;
constexpr size_t WT_ELEMS = WT_FF2 + (size_t)4096 * 1024;
constexpr size_t OFF_WT = 0;
constexpr size_t OFF_MOD = AL(OFF_WT + 2 * WT_ELEMS * 2);
constexpr size_t OFF_XC = AL(OFF_MOD + 2 * 5 * 6144 * 4);
constexpr size_t OFF_H = AL(OFF_XC + (size_t)MC * DM * 4);
constexpr size_t OFF_R1 = AL(OFF_H + (size_t)MT * DM * 2);
constexpr size_t OFF_U = OFF_R1;
constexpr size_t OFF_DT = AL(OFF_U + (size_t)MT * DIN * 2);
constexpr size_t OFF_RSTD = AL(OFF_DT + (size_t)MT * 16 * 4);
constexpr size_t OFF_QB = AL(OFF_RSTD + (size_t)MT * 2 * 4);
constexpr size_t OFF_KB = AL(OFF_QB + (size_t)MT * 384 * 2);
constexpr size_t OFF_VT = AL(OFF_KB + (size_t)NB * 4 * LK * 96 * 2);
constexpr size_t OFF_XBC = AL(OFF_VT + (size_t)NB * 4 * 64 * LK * 2);
constexpr size_t OFF_SST = AL(OFF_XBC + (size_t)MT * 768 * 2);
constexpr size_t OFF_TDEC = AL(OFF_SST + (size_t)2 * NB * NCH * 8 * 4096 * 2);
constexpr size_t OFF_SSQ = AL(OFF_TDEC + (size_t)2 * NB * NCH * 8 * 4);
constexpr size_t OFF_END1 = AL(OFF_SSQ + (size_t)MT * 8 * 4);
constexpr size_t OFF_F1 = OFF_R1;
constexpr size_t OFF_END2 = AL(OFF_F1 + (size_t)MT * DFF * 2);
constexpr size_t OFF_BAR = OFF_END1 > OFF_END2 ? OFF_END1 : OFF_END2;
constexpr size_t WS_NEED = OFF_BAR + 16384;

struct Params {
  const float *x, *c, *ctx, *c_ctx, *w_mod, *b_mod, *g_pre_mix, *w_in, *q_norm, *w_uq, *kv_norm, *w_ukv, *sc_w, *ssd_cw, *ssd_cb,
      *a_log, *dt_bias, *ssd_d, *ssd_norm, *w_out, *g_post_mix, *g_pre_ffn, *w_ff1, *w_ff2, *g_post_ffn;
  float* out;
  char* ws;
};

DI int ltid() { int t = threadIdx.x; asm volatile("" : "+v"(t)); return t & 255; }
DI int ltid512() { int t = threadIdx.x; asm volatile("" : "+v"(t)); return t; }
typedef __bf16 hbf2 __attribute__((ext_vector_type(2)));
typedef float hf2 __attribute__((ext_vector_type(2)));
DI bf16_t f2bf(float x) { return __builtin_bit_cast(bf16_t, (__bf16)x); }
DI float bf2f(unsigned v) { return __uint_as_float(v << 16); }
DI unsigned pack2(float a, float b) { hf2 v = {a, b}; return __builtin_bit_cast(unsigned, __builtin_convertvector(v, hbf2)); }
DI float lo2f(unsigned w) { return __uint_as_float(w << 16); }
DI float hi2f(unsigned w) { return __uint_as_float(w & 0xffff0000u); }
DI float wave_sum(float v) {
#pragma unroll
  for (int o = 32; o > 0; o >>= 1) v += __shfl_xor(v, o);
  return v;
}
DI float silu_f(float x) { return x / (1.f + __expf(-x)); }
DI int crow(int reg, int h) { return (reg & 3) + 8 * (reg >> 2) + 4 * h; }
DI bf16x8 pack8(const f32x16& x, int s) {
  u32x4 p;
  p[0] = pack2(x[8 * s + 0], x[8 * s + 1]); p[1] = pack2(x[8 * s + 2], x[8 * s + 3]);
  p[2] = pack2(x[8 * s + 4], x[8 * s + 5]); p[3] = pack2(x[8 * s + 6], x[8 * s + 7]);
  return __builtin_bit_cast(bf16x8, p);
}
DI const float* xin_row(const Params& p, int layer, int row) {
  if (layer == 0) return row < ML ? p.x + (size_t)row * DM : p.ctx + (size_t)(row - ML) * DM;
  return row < ML ? p.out + (size_t)row * DM : (const float*)(p.ws + OFF_XC) + (size_t)(row - ML) * DM;
}
DI float* xst_row(const Params& p, int row) {
  return row < ML ? p.out + (size_t)row * DM : (float*)(p.ws + OFF_XC) + (size_t)(row - ML) * DM;
}
DI const float* mod_ptr(const Params& p, int layer, int row, int which) {
  int bb = row < ML ? (row >> 12) : 4;
  return (const float*)(p.ws + OFF_MOD) + ((size_t)(layer * 5 + bb) * 6 + which) * DM;
}
DI bf16_t* wt_ptr(const Params& p, int layer, size_t off) { return (bf16_t*)(p.ws + OFF_WT) + (size_t)layer * WT_ELEMS + off; }

DI void transpose_item(const float* __restrict__ w, const float* __restrict__ gk, int gk_from, bf16_t* __restrict__ wt, int K, int N, int kt, int nt, char* smem) {
  float* tile = (float*)smem;
  const int tid = ltid(), tx = tid & 63, ty = tid >> 6;
  const int k0 = kt * 64, n0 = nt * 64;
  const int n = n0 + tx;
  float v[16];
#pragma unroll
  for (int i = 0; i < 16; ++i) {
    int kk = ty + 4 * i;
    v[i] = n < N ? w[(size_t)(k0 + kk) * N + n] : 0.f;
  }
  if (gk) {
#pragma unroll
    for (int i = 0; i < 16; ++i) { int k = k0 + ty + 4 * i; if (k >= gk_from) v[i] *= gk[k - gk_from]; }
  }
#pragma unroll
  for (int i = 0; i < 16; ++i) tile[(ty + 4 * i) * 65 + tx] = v[i];
  __syncthreads();
#pragma unroll
  for (int i = 0; i < 2; ++i) {
    int c = tid + 256 * i, nn = c >> 3, kc = c & 7;
    u32x4 o;
#pragma unroll
    for (int jj = 0; jj < 4; ++jj) o[jj] = pack2(tile[(kc * 8 + 2 * jj) * 65 + nn], tile[(kc * 8 + 2 * jj + 1) * 65 + nn]);
    *(u32x4*)(wt + (size_t)(n0 + nn) * K + k0 + kc * 8) = o;
  }
  __syncthreads();
}

DI void modgemv_item(const Params& p, int layer, int ct, char* smem) {
  float* s = (float*)smem;
  float* red = s + 5 * 1024;
  const int tid = ltid(), w = tid >> 6, lane = tid & 63, ln = lane & 31, kh = lane >> 5;
  for (int i = tid; i < 5 * 1024; i += 256) {
    int bb = i >> 10, k = i & 1023;
    float v = bb < 4 ? p.c[bb * 1024 + k] : p.c_ctx[k];
    s[i] = silu_f(v);
  }
  __syncthreads();
  const float* wm = p.w_mod + (size_t)layer * 1024 * 6144;
  const int n = ct * 32 + ln;
  float acc[5] = {0.f, 0.f, 0.f, 0.f, 0.f};
#pragma unroll 16
  for (int i = 0; i < 128; ++i) {
    const int k = w * 256 + 2 * i + kh;
    float wv = wm[(size_t)k * 6144 + n];
#pragma unroll
    for (int bb = 0; bb < 5; ++bb) acc[bb] += s[bb * 1024 + k] * wv;
  }
#pragma unroll
  for (int bb = 0; bb < 5; ++bb) {
    acc[bb] += __shfl_xor(acc[bb], 32);
    if (kh == 0) red[(w * 5 + bb) * 32 + ln] = acc[bb];
  }
  __syncthreads();
  if (tid < 160) {
    int bb = tid >> 5, l2 = tid & 31;
    float v = red[(0 * 5 + bb) * 32 + l2] + red[(1 * 5 + bb) * 32 + l2] + red[(2 * 5 + bb) * 32 + l2] + red[(3 * 5 + bb) * 32 + l2];
    int nn = ct * 32 + l2;
    v += p.b_mod[layer * 6144 + nn];
    ((float*)(p.ws + OFF_MOD))[(size_t)(layer * 5 + bb) * 6144 + nn] = v;
  }
  __syncthreads();
}

constexpr int WT_ITEMS = 2984;
DI void wt_item(const Params& p, int layer, int j, char* smem) {
  if (j < 640) transpose_item(p.w_in + (size_t)layer * 1024 * DIN, nullptr, 0, wt_ptr(p, layer, WT_IN), 1024, DIN, j / 40, j % 40, smem);
  else if ((j -= 640) < 24) transpose_item(p.w_uq + (size_t)layer * 256 * 384, p.q_norm + layer * 256, 0, wt_ptr(p, layer, WT_UQ), 256, 384, j / 6, j % 6, smem);
  else if ((j -= 24) < 16) transpose_item(p.w_ukv + (size_t)layer * 128 * 512, p.kv_norm + layer * 128, 0, wt_ptr(p, layer, WT_UKV), 128, 512, j / 8, j % 8, smem);
  else if ((j -= 16) < 256) transpose_item(p.w_out + (size_t)layer * 1024 * 1024, p.ssd_norm + layer * 512, 512, wt_ptr(p, layer, WT_OUT), 1024, 1024, j / 16, j % 16, smem);
  else if ((j -= 256) < 1024) transpose_item(p.w_ff1 + (size_t)layer * 1024 * 4096, nullptr, 0, wt_ptr(p, layer, WT_FF1), 1024, 4096, j / 64, j % 64, smem);
  else { j -= 1024; transpose_item(p.w_ff2 + (size_t)layer * 4096 * 1024, nullptr, 0, wt_ptr(p, layer, WT_FF2), 4096, 1024, j / 16, j % 16, smem); }
}
DI void phase_prep0(const Params& p, int bid, int nb, char* smem) {
  for (int it = bid; it < 384 + 640; it += nb) {
    if (it < 384) modgemv_item(p, it / 192, it % 192, smem);
    else wt_item(p, 0, it - 384, smem);
  }
}
struct HMod { float4 g[4], s1[4], s0[4]; };
DI void load_hmod(HMod& m, const float* g, const float* sh, const float* sc, int lane) {
#pragma unroll
  for (int i = 0; i < 4; ++i) {
    const int col = lane * 4 + 256 * i;
    m.g[i] = *(const float4*)(g + col); m.s1[i] = *(const float4*)(sc + col); m.s0[i] = *(const float4*)(sh + col);
  }
}
DI void write_h_row(const float4 xv[4], float rstd, const HMod& m, bf16_t* hrow, int lane) {
#pragma unroll
  for (int i = 0; i < 4; ++i) {
    const int col = lane * 4 + 256 * i;
    float a = xv[i].x * rstd * m.g[i].x * (1.f + m.s1[i].x) + m.s0[i].x;
    float b = xv[i].y * rstd * m.g[i].y * (1.f + m.s1[i].y) + m.s0[i].y;
    float c = xv[i].z * rstd * m.g[i].z * (1.f + m.s1[i].z) + m.s0[i].z;
    float d = xv[i].w * rstd * m.g[i].w * (1.f + m.s1[i].w) + m.s0[i].w;
    u32x2 o; o[0] = pack2(a, b); o[1] = pack2(c, d);
    *(u32x2*)(hrow + col) = o;
  }
}
DI float ssq4(const float4 v[4]) {
  float s = 0.f;
#pragma unroll
  for (int i = 0; i < 4; ++i) s += v[i].x * v[i].x + v[i].y * v[i].y + v[i].z * v[i].z + v[i].w * v[i].w;
  return s;
}
DI void load_bf_row(const bf16_t* r, int lane, float4 v[4]) {
#pragma unroll
  for (int i = 0; i < 4; ++i) {
    u32x2 t = *(const u32x2*)(r + lane * 4 + 256 * i);
    v[i] = make_float4(lo2f(t[0]), hi2f(t[0]), lo2f(t[1]), hi2f(t[1]));
  }
}

struct RowVec { float4 c1[4], c2[4], c3[4]; };
DI const float* mod_ptr_b(const Params& p, int layer, int bb, int which) {
  return (const float*)(p.ws + OFF_MOD) + ((size_t)(layer * 5 + bb) * 6 + which) * DM;
}
template <int MODE>
DI void rowwise_phase(const Params& p, int layer, int bid, int nb) {
  const int w = ltid() >> 6, lane = ltid() & 63;
  const int M = (MODE == 0 || layer == 0) ? MT : ML;
  const bool wh = MODE != 2 || layer == 0;
  bf16_t* H = (bf16_t*)(p.ws + OFF_H);
  const bf16_t* Y = MODE == 1 ? (const bf16_t*)(p.ws + OFF_U) : (const bf16_t*)(p.ws + OFF_H);
  const int NW = nb * 4, W = bid * 4 + w, nwb = NW >> 2;
  auto load_vec = [&](RowVec& v, int bb) {
    const float* gate = MODE == 1 ? mod_ptr_b(p, layer, bb, 2) : mod_ptr_b(p, layer, bb, 5);
    const float* gres = MODE == 1 ? p.g_post_mix + layer * DM : p.g_post_ffn + layer * DM;
    const int hl = MODE == 2 ? 1 : layer;
    const float* gn = MODE == 1 ? p.g_pre_ffn + layer * DM : p.g_pre_mix + hl * DM;
    const float* sh = mod_ptr_b(p, hl, bb, MODE == 1 ? 3 : 0);
    const float* sc = mod_ptr_b(p, hl, bb, MODE == 1 ? 4 : 1);
#pragma unroll
    for (int i = 0; i < 4; ++i) {
      const int col = lane * 4 + 256 * i;
      if (MODE != 0) {
        const float4 a = *(const float4*)(gate + col), b = *(const float4*)(gres + col);
        v.c1[i] = make_float4(a.x * b.x, a.y * b.y, a.z * b.z, a.w * b.w);
      }
      if (wh) {
        const float4 g = *(const float4*)(gn + col), s1 = *(const float4*)(sc + col);
        v.c2[i] = make_float4(g.x * (1.f + s1.x), g.y * (1.f + s1.y), g.z * (1.f + s1.z), g.w * (1.f + s1.w));
        v.c3[i] = *(const float4*)(sh + col);
      }
    }
  };
  struct RowIn { u32x2 y[4]; float4 x[4]; };
  auto load_row = [&](RowIn& r, int row) {
    const float* xr = MODE == 2 ? (const float*)xst_row(p, row) : xin_row(p, layer, row);
#pragma unroll
    for (int i = 0; i < 4; ++i) {
      r.x[i] = *(const float4*)(xr + lane * 4 + 256 * i);
      if (MODE != 0) r.y[i] = *(const u32x2*)(Y + (size_t)row * DM + lane * 4 + 256 * i);
    }
  };
  auto finish = [&](float4 (&xv)[4], const float4 (&yv)[4], const RowVec& v, int row) {
    if (MODE != 0) {
      const float rstd = rsqrtf(wave_sum(ssq4(yv)) * (1.f / DM) + EPS);
#pragma unroll
      for (int i = 0; i < 4; ++i) {
        xv[i].x += yv[i].x * rstd * v.c1[i].x; xv[i].y += yv[i].y * rstd * v.c1[i].y;
        xv[i].z += yv[i].z * rstd * v.c1[i].z; xv[i].w += yv[i].w * rstd * v.c1[i].w;
      }
      float* xo = xst_row(p, row);
#pragma unroll
      for (int i = 0; i < 4; ++i) *(float4*)(xo + lane * 4 + 256 * i) = xv[i];
    }
    if (wh) {
      const float rstd1 = rsqrtf(wave_sum(ssq4(xv)) * (1.f / DM) + EPS);
      bf16_t* hrow = H + (size_t)row * DM;
#pragma unroll
      for (int i = 0; i < 4; ++i) {
        u32x2 o;
        o[0] = pack2(xv[i].x * rstd1 * v.c2[i].x + v.c3[i].x, xv[i].y * rstd1 * v.c2[i].y + v.c3[i].y);
        o[1] = pack2(xv[i].z * rstd1 * v.c2[i].z + v.c3[i].z, xv[i].w * rstd1 * v.c2[i].w + v.c3[i].w);
        *(u32x2*)(hrow + lane * 4 + 256 * i) = o;
      }
    }
  };
  auto process = [&](RowIn& r, const RowVec& v, int row) {
    float4 yv[4];
#pragma unroll
    for (int i = 0; i < 4; ++i) yv[i] = make_float4(lo2f(r.y[i][0]), hi2f(r.y[i][0]), lo2f(r.y[i][1]), hi2f(r.y[i][1]));
    finish(r.x, yv, v, row);
  };
  RowVec v;
  {
    const int bb = W / nwb, j = W - bb * nwb, end = SEQ * (bb + 1);
    load_vec(v, bb);
    RowIn ra, rb;
    int row = SEQ * bb + j;
    if (row < end) load_row(ra, row);
    while (row < end) {
      const int rowb = row + nwb;
      const bool hb = rowb < end;
      if (hb) load_row(rb, rowb);
      process(ra, v, row);
      if (!hb) break;
      const int rowa = rowb + nwb;
      const bool ha = rowa < end;
      if (ha) load_row(ra, rowa);
      process(rb, v, rowb);
      if (!ha) break;
      row = rowa;
    }
  }
  if (M > ML) {
    load_vec(v, 4);
    for (int row = ML + W; row < M; row += NW) {
      float4 xv[4], yv[4];
      const float* xr = MODE == 2 ? (const float*)xst_row(p, row) : xin_row(p, layer, row);
#pragma unroll
      for (int i = 0; i < 4; ++i) xv[i] = *(const float4*)(xr + lane * 4 + 256 * i);
      if (MODE == 1) load_bf_row(Y + (size_t)row * DM, lane, yv);
      if (MODE == 2) {
        const float* pp = (const float*)(p.ws + OFF_END2) + (size_t)(row - ML) * DM;
#pragma unroll
        for (int i = 0; i < 4; ++i) {
          float4 a = *(const float4*)(pp + lane * 4 + 256 * i), b = *(const float4*)(pp + (size_t)MC * DM + lane * 4 + 256 * i);
          float4 c = *(const float4*)(pp + (size_t)2 * MC * DM + lane * 4 + 256 * i), d = *(const float4*)(pp + (size_t)3 * MC * DM + lane * 4 + 256 * i);
          yv[i] = make_float4((a.x + b.x) + (c.x + d.x), (a.y + b.y) + (c.y + d.y), (a.z + b.z) + (c.z + d.z), (a.w + b.w) + (c.w + d.w));
        }
      }
      finish(xv, yv, v, row);
    }
  }
}
DI void phase_h0(const Params& p, int bid, int nb) { rowwise_phase<0>(p, 0, bid, nb); }
DI void phase_postmix(const Params& p, int layer, int bid, int nb) { rowwise_phase<1>(p, layer, bid, nb); }
DI void phase_postffn(const Params& p, int layer, int bid, int nb) { rowwise_phase<2>(p, layer, bid, nb); }

DI void phase_prep(const Params& p, int layer, int bid, int nb) {
  const int w = ltid() >> 6, lane = ltid() & 63;
  const bf16_t* U = (const bf16_t*)(p.ws + OFF_U);
  float* DT = (float*)(p.ws + OFF_DT);
  float* RS = (float*)(p.ws + OFF_RSTD);
  bf16_t* KB = (bf16_t*)(p.ws + OFF_KB);
  bf16_t* XBC = (bf16_t*)(p.ws + OFF_XBC);
  bf16_t* YM = (bf16_t*)(p.ws + OFF_H);
  const float* scw = p.sc_w + layer * 3 * 256;
  const float* cw = p.ssd_cw + layer * 3 * 768;
  const float* cb = p.ssd_cb + layer * 768;
  const int c4 = lane * 4;
  const float4 sw0 = *(const float4*)(scw + c4), sw1 = *(const float4*)(scw + 256 + c4), sw2 = *(const float4*)(scw + 512 + c4);
  float4 cwk[3][3], cbi[3];
#pragma unroll
  for (int i = 0; i < 3; ++i) {
    cbi[i] = *(const float4*)(cb + c4 + 256 * i);
#pragma unroll
    for (int k = 0; k < 3; ++k) cwk[i][k] = *(const float4*)(cw + k * 768 + c4 + 256 * i);
  }
  const float dtb = p.dt_bias[layer * 16 + (lane & 15)];
  const float invf = exp2f(-(float)(2 * (lane & 7)) * (13.287712379549449f / 16.f));
  for (int row = bid * 4 + w; row < MT; row += nb * 4) {
    int b, t, L, pos;
    const bool lat = row < ML;
    if (lat) { b = row >> 12; t = row & 4095; L = SEQ; pos = t + CTX; }
    else { int rr = row - ML; b = rr >> 8; t = rr & 255; L = CTX; pos = t; }
    const bf16_t* u0 = U + (size_t)row * DIN;
    const bool hp = t > 0, hn = t < L - 1;
    const bf16_t* um = hp ? u0 - DIN : u0;
    const bf16_t* up = hn ? u0 + DIN : u0;
    const float mp = hp ? 1.f : 0.f, mn = hn ? 1.f : 0.f;
    const u32x2 vq = *(const u32x2*)(u0 + c4);
    const u32x2 vkv = *(const u32x2*)(u0 + U_CKV + (lane & 31) * 4);
    const float kr = bf2f(u0[U_KR + (lane & 31)]);
    const u32x2 gcm = *(const u32x2*)(um + U_GC + c4), gc0 = *(const u32x2*)(u0 + U_GC + c4), gcp = *(const u32x2*)(up + U_GC + c4);
    const u32x2 vvm = *(const u32x2*)(um + U_VAL + c4), vv0 = *(const u32x2*)(u0 + U_VAL + c4), vvp = *(const u32x2*)(up + U_VAL + c4);
    const u32x2 gb = *(const u32x2*)(u0 + U_GB + c4);
    u32x2 xm[3], x0[3], xp[3];
#pragma unroll
    for (int i = 0; i < 3; ++i) {
      xm[i] = *(const u32x2*)(um + U_XBC + c4 + 256 * i);
      x0[i] = *(const u32x2*)(u0 + U_XBC + c4 + 256 * i);
      xp[i] = *(const u32x2*)(up + U_XBC + c4 + 256 * i);
    }
    const float dtr = DT[(size_t)row * 16 + (lane & 15)];
    {
      float a = lo2f(vq[0]), bq = hi2f(vq[0]), c = lo2f(vq[1]), d = hi2f(vq[1]);
      float ss = wave_sum(a * a + bq * bq + c * c + d * d);
      float e = lo2f(vkv[0]), f = hi2f(vkv[0]), g = lo2f(vkv[1]), h = hi2f(vkv[1]);
      float s2 = lane < 32 ? e * e + f * f + g * g + h * h : 0.f;
      s2 = wave_sum(s2);
      if (lane == 0) { RS[row * 2] = rsqrtf(ss * (1.f / 256) + EPS); RS[row * 2 + 1] = rsqrtf(s2 * (1.f / 128) + EPS); }
    }
    {
      const float partner = __shfl_xor(kr, 8);
      float o = kr;
      if (lat) {
        const int grp = (lane & 31) >> 3;
        const float posf = grp < 2 ? (float)(t >> 6) : (float)(t & 63);
        const float rev = posf * invf * 0.15915494309189535f;
        const float cs = __builtin_amdgcn_cosf(rev), sn = __builtin_amdgcn_sinf(rev);
        o = (grp & 1) ? kr * cs + partner * sn : kr * cs - partner * sn;
      }
      if (lane < 32) {
        const bf16_t ob = f2bf(o);
#pragma unroll
        for (int hd = 0; hd < 4; ++hd) KB[((size_t)(b * 4 + hd) * LK + pos) * 96 + 64 + lane] = ob;
      }
    }
    {
      float a0 = sw1.x * lo2f(gc0[0]) * lo2f(vv0[0]) + mp * sw0.x * lo2f(gcm[0]) * lo2f(vvm[0]) + mn * sw2.x * lo2f(gcp[0]) * lo2f(vvp[0]);
      float a1 = sw1.y * hi2f(gc0[0]) * hi2f(vv0[0]) + mp * sw0.y * hi2f(gcm[0]) * hi2f(vvm[0]) + mn * sw2.y * hi2f(gcp[0]) * hi2f(vvp[0]);
      float a2 = sw1.z * lo2f(gc0[1]) * lo2f(vv0[1]) + mp * sw0.z * lo2f(gcm[1]) * lo2f(vvm[1]) + mn * sw2.z * lo2f(gcp[1]) * lo2f(vvp[1]);
      float a3 = sw1.w * hi2f(gc0[1]) * hi2f(vv0[1]) + mp * sw0.w * hi2f(gcm[1]) * hi2f(vvm[1]) + mn * sw2.w * hi2f(gcp[1]) * hi2f(vvp[1]);
      u32x2 o; o[0] = pack2(lo2f(gb[0]) * a0, hi2f(gb[0]) * a1); o[1] = pack2(lo2f(gb[1]) * a2, hi2f(gb[1]) * a3);
      *(u32x2*)(YM + (size_t)row * DM + 256 + c4) = o;
    }
#pragma unroll
    for (int i = 0; i < 3; ++i) {
      float a0 = cbi[i].x + cwk[i][1].x * lo2f(x0[i][0]) + mp * cwk[i][0].x * lo2f(xm[i][0]) + mn * cwk[i][2].x * lo2f(xp[i][0]);
      float a1 = cbi[i].y + cwk[i][1].y * hi2f(x0[i][0]) + mp * cwk[i][0].y * hi2f(xm[i][0]) + mn * cwk[i][2].y * hi2f(xp[i][0]);
      float a2 = cbi[i].z + cwk[i][1].z * lo2f(x0[i][1]) + mp * cwk[i][0].z * lo2f(xm[i][1]) + mn * cwk[i][2].z * lo2f(xp[i][1]);
      float a3 = cbi[i].w + cwk[i][1].w * hi2f(x0[i][1]) + mp * cwk[i][0].w * hi2f(xm[i][1]) + mn * cwk[i][2].w * hi2f(xp[i][1]);
      u32x2 o; o[0] = pack2(silu_f(a0), silu_f(a1)); o[1] = pack2(silu_f(a2), silu_f(a3));
      *(u32x2*)(XBC + (size_t)row * 768 + c4 + 256 * i) = o;
    }
    if (lane < 16) {
      const float v = dtr + dtb;
      const float e = __expf(-fabsf(v));
      DT[(size_t)row * 16 + lane] = fmaxf(v, 0.f) + (e < 1e-3f ? e * (1.f - 0.5f * e) : __logf(1.f + e));
    }
  }
}

DI void phase_ssdnorm(const Params& p, int layer, int bid, int nb) {
  const int w = ltid() >> 6, lane = ltid() & 63;
  const int M = layer == 0 ? MT : ML;
  bf16_t* YM = (bf16_t*)(p.ws + OFF_H);
  const float* SSQ = (const float*)(p.ws + OFF_SSQ);
  const float* ng = p.ssd_norm + layer * 512;
  for (int row = bid * 4 + w; row < M; row += nb * 4) {
    int g = lane >> 5;
    float4 s = *(const float4*)(SSQ + (size_t)row * 8 + g * 4);
    float rstd = rsqrtf((s.x + s.y + s.z + s.w) * (1.f / 256) + EPS);
    bf16_t* ptr = YM + (size_t)row * DM + 512 + lane * 8;
    u32x4 v = *(const u32x4*)ptr;
    float4 g0 = *(const float4*)(ng + lane * 8), g1 = *(const float4*)(ng + lane * 8 + 4);
    u32x4 o;
    o[0] = pack2(lo2f(v[0]) * rstd * g0.x, hi2f(v[0]) * rstd * g0.y);
    o[1] = pack2(lo2f(v[1]) * rstd * g0.z, hi2f(v[1]) * rstd * g0.w);
    o[2] = pack2(lo2f(v[2]) * rstd * g1.x, hi2f(v[2]) * rstd * g1.y);
    o[3] = pack2(lo2f(v[3]) * rstd * g1.z, hi2f(v[3]) * rstd * g1.w);
    *(u32x4*)ptr = o;
  }
}

constexpr int GST = 80;
constexpr int GBUF = 2 * 128 * GST;
template <bool GN, class Epi>
DI void gemm_tile(const bf16_t* __restrict__ A, int lda, const bf16_t* __restrict__ Bt, int K, int row0, int col0, char* smem, Epi epi, const float* __restrict__ ssq = nullptr) {
  bf16_t* S0 = (bf16_t*)smem;
  const int tid = ltid(), wid = tid >> 6, lane = tid & 63, wr = wid >> 1, wc = wid & 1, fr = lane & 15, fq = lane >> 4;
  f32x4 acc[4][4];
#pragma unroll
  for (int m = 0; m < 4; ++m)
#pragma unroll
    for (int n = 0; n < 4; ++n) acc[m][n] = f32x4{0.f, 0.f, 0.f, 0.f};
  u32x4 ra[4], rb[4];
  const int sr = tid >> 3, sp = tid & 7;
  const bf16_t* ga = A + (size_t)(row0 + sr) * lda + sp * 8;
  const bf16_t* gb = Bt + (size_t)(col0 + sr) * K + sp * 8;
  auto gload = [&](int k0) {
#pragma unroll
    for (int i = 0; i < 4; ++i) {
      ra[i] = *(const u32x4*)(ga + (size_t)(32 * i) * lda + k0);
      rb[i] = *(const u32x4*)(gb + (size_t)(32 * i) * K + k0);
    }
  };
  gload(0);
  float gs[4][2];
  if (GN) {
#pragma unroll
    for (int i = 0; i < 4; ++i) {
      const float4 s0 = *(const float4*)(ssq + (size_t)(row0 + sr + 32 * i) * 8), s1 = *(const float4*)(ssq + (size_t)(row0 + sr + 32 * i) * 8 + 4);
      gs[i][0] = rsqrtf((s0.x + s0.y + s0.z + s0.w) * (1.f / 256) + EPS);
      gs[i][1] = rsqrtf((s1.x + s1.y + s1.z + s1.w) * (1.f / 256) + EPS);
    }
  }
  auto swrite = [&](int kt) {
    if (GN && kt >= 8) {
      const int g = (kt - 8) >> 2;
#pragma unroll
      for (int i = 0; i < 4; ++i) {
        const float sc = g ? gs[i][1] : gs[i][0];
#pragma unroll
        for (int jj = 0; jj < 4; ++jj) ra[i][jj] = pack2(lo2f(ra[i][jj]) * sc, hi2f(ra[i][jj]) * sc);
      }
    }
    bf16_t* As = S0 + (kt & 1) * GBUF;
    bf16_t* Bs = As + 128 * GST;
#pragma unroll
    for (int i = 0; i < 4; ++i) {
      *(u32x4*)(As + (sr + 32 * i) * GST + sp * 8) = ra[i];
      *(u32x4*)(Bs + (sr + 32 * i) * GST + sp * 8) = rb[i];
    }
  };
  const int KT = K / 64;
  swrite(0);
  if (KT > 1) gload(64);
  __syncthreads();
  for (int kt = 0; kt < KT; ++kt) {
    const bf16_t* As = S0 + (kt & 1) * GBUF;
    const bf16_t* Bs = As + 128 * GST;
#pragma unroll
    for (int ks = 0; ks < 2; ++ks) {
      bf16x8 af[4], bfr[4];
#pragma unroll
      for (int m = 0; m < 4; ++m) af[m] = *(const bf16x8*)(As + (wr * 64 + m * 16 + fr) * GST + ks * 32 + fq * 8);
#pragma unroll
      for (int n = 0; n < 4; ++n) bfr[n] = *(const bf16x8*)(Bs + (wc * 64 + n * 16 + fr) * GST + ks * 32 + fq * 8);
#pragma unroll
      for (int m = 0; m < 4; ++m)
#pragma unroll
        for (int n = 0; n < 4; ++n) acc[m][n] = MFMA16(bfr[n], af[m], acc[m][n]);
      if (ks == 0 && kt + 1 < KT) {
        swrite(kt + 1);
        if (kt + 2 < KT) gload((kt + 2) * 64);
      }
    }
    __syncthreads();
  }
  float rsc[4];
#pragma unroll
  for (int m = 0; m < 4; ++m) rsc[m] = epi.scale(row0 + wr * 64 + m * 16 + fr);
#pragma unroll
  for (int m = 0; m < 4; ++m)
#pragma unroll
    for (int n = 0; n < 4; ++n) epi(row0 + wr * 64 + m * 16 + fr, col0 + wc * 64 + n * 16 + fq * 4, acc[m][n], rsc[m]);
}

template <class Epi>
DI void gemm_tile_glds(const bf16_t* __restrict__ A, int lda, const bf16_t* __restrict__ Bt, int ldb, int K, int row0, int col0, char* smem, Epi epi) {
  const int tid = ltid(), wid = tid >> 6, lane = tid & 63, wr = wid >> 1, wc = wid & 1, fr = lane & 15, fq = lane >> 4;
  f32x4 acc[4][4];
#pragma unroll
  for (int m = 0; m < 4; ++m)
#pragma unroll
    for (int n = 0; n < 4; ++n) acc[m][n] = f32x4{0.f, 0.f, 0.f, 0.f};
  const int crow = tid >> 3, cslot = tid & 7, cpart = cslot ^ (crow & 7);
  const bf16_t* ga = A + (size_t)(row0 + crow) * lda + cpart * 8;
  const bf16_t* gb = Bt + (size_t)(col0 + crow) * ldb + cpart * 8;
  auto issue = [&](int kt, int stage) {
    char* sa = smem + stage * 32768 + tid * 16;
#pragma unroll
    for (int i = 0; i < 4; ++i) {
      __builtin_amdgcn_global_load_lds((const unsigned*)(ga + (size_t)(32 * i) * lda + kt * 64), (__attribute__((address_space(3))) unsigned*)(sa + i * 4096), 16, 0, 0);
      __builtin_amdgcn_global_load_lds((const unsigned*)(gb + (size_t)(32 * i) * ldb + kt * 64), (__attribute__((address_space(3))) unsigned*)(sa + 16384 + i * 4096), 16, 0, 0);
    }
  };
  const int KT = K / 64;
  issue(0, 0);
  asm volatile("s_waitcnt vmcnt(0)" ::: "memory");
  __syncthreads();
  const int sw = fr & 7;
  for (int kt = 0; kt < KT; ++kt) {
    if (kt + 1 < KT) issue(kt + 1, (kt + 1) & 1);
    const char* As = smem + (kt & 1) * 32768;
    const char* Bs = As + 16384;
#pragma unroll
    for (int ks = 0; ks < 2; ++ks) {
      bf16x8 af[4], bfr[4];
      const int so = ((ks * 4 + fq) ^ sw) * 16;
#pragma unroll
      for (int m = 0; m < 4; ++m) af[m] = *(const bf16x8*)(As + (wr * 64 + m * 16 + fr) * 128 + so);
#pragma unroll
      for (int n = 0; n < 4; ++n) bfr[n] = *(const bf16x8*)(Bs + (wc * 64 + n * 16 + fr) * 128 + so);
#pragma unroll
      for (int m = 0; m < 4; ++m)
#pragma unroll
        for (int n = 0; n < 4; ++n) acc[m][n] = MFMA16(bfr[n], af[m], acc[m][n]);
    }
    asm volatile("s_waitcnt vmcnt(0)" ::: "memory");
    __syncthreads();
  }
#pragma unroll
  for (int m = 0; m < 4; ++m)
#pragma unroll
    for (int n = 0; n < 4; ++n) epi(row0 + wr * 64 + m * 16 + fr, col0 + wc * 64 + n * 16 + fq * 4, acc[m][n]);
}

constexpr int G8_HT = 128 * 64;
DI int g8_lds_byte(int r, int c) {
  int st = (r >> 4) * 2 + (c >> 5), rr = r & 15, cc = c & 31, ob = rr * 64 + cc * 2;
  return st * 1024 + (ob ^ (((ob >> 9) & 1) << 5));
}
DI void g8_stage_rc(int b, int& R, int& C) {
  int st = b / 1024, sb = b % 1024, swz = sb ^ (((sb >> 9) & 1) << 5);
  R = (st >> 1) * 16 + swz / 64; C = (st & 1) * 32 + (swz % 64) / 2;
}
template <class Epi>
DI void gemm8_tile(const bf16_t* __restrict__ A, int lda, const bf16_t* __restrict__ Bt, int ldb, int K, int brow, int bcol, char* smem, Epi epi,
                   bool first = true, bool has_next = false, int nbrow = 0, int nbcol = 0) {
  bf16_t* shm = (bf16_t*)smem;
  const int tid = ltid512();
#define G8_SA(b, h) (shm + ((b) * 2 + (h)) * G8_HT)
#define G8_SB(b, h) (shm + (4 + (b) * 2 + (h)) * G8_HT)
#define G8_STAGE(P, BASE, LD, br, kt) do { const bf16_t* _g = (BASE) + (size_t)(br) * (LD) + (size_t)(kt) * 64; \
    _Pragma("unroll") for (int _i = 0; _i < 2; ++_i) { int _b = tid * 16 + _i * 8192; int _r, _c; g8_stage_rc(_b, _r, _c); \
      __builtin_amdgcn_global_load_lds((const unsigned*)(_g + (size_t)_r * (LD) + _c), \
        (__attribute__((address_space(3))) unsigned*)((char*)(P) + _b), 16, 0, 0); } } while (0)
#define G8_LDA(dst, b, h) _Pragma("unroll") for (int m = 0; m < 4; ++m) _Pragma("unroll") for (int k = 0; k < 2; ++k) \
    dst[m][k] = *reinterpret_cast<const bf16x8*>((char*)G8_SA(b, h) + g8_lds_byte(wr * 64 + m * 16 + fr, k * 32 + fq * 8))
#define G8_LDB(dst, b, h) _Pragma("unroll") for (int n = 0; n < 2; ++n) _Pragma("unroll") for (int k = 0; k < 2; ++k) \
    dst[n][k] = *reinterpret_cast<const bf16x8*>((char*)G8_SB(b, h) + g8_lds_byte(wc * 32 + n * 16 + fr, k * 32 + fq * 8))
#define G8_MMA(ai, bj, At, Bx) do { __builtin_amdgcn_s_setprio(1); \
    _Pragma("unroll") for (int m = 0; m < 4; ++m) _Pragma("unroll") for (int n = 0; n < 2; ++n) _Pragma("unroll") for (int k = 0; k < 2; ++k) \
      acc[ai][bj][m][n] = __builtin_amdgcn_mfma_f32_16x16x32_bf16(Bx[n][k], At[m][k], acc[ai][bj][m][n], 0, 0, 0); \
    __builtin_amdgcn_s_setprio(0); } while (0)
#define G8_WAIT_V(n) asm volatile("s_waitcnt vmcnt(" #n ")" ::: "memory")
#define G8_WAIT_L(n) asm volatile("s_waitcnt lgkmcnt(" #n ")" ::: "memory")
#define G8_BAR __builtin_amdgcn_s_barrier()
#define G8_SCHED __builtin_amdgcn_sched_barrier(0)
  const int wid = tid >> 6, lane = tid & 63, wr = wid >> 2, wc = wid & 3, fr = lane & 15, fq = lane >> 4;
  f32x4 acc[2][2][4][2];
#pragma unroll
  for (int a = 0; a < 2; ++a)
#pragma unroll
    for (int b = 0; b < 2; ++b)
#pragma unroll
      for (int m = 0; m < 4; ++m)
#pragma unroll
        for (int n = 0; n < 2; ++n) acc[a][b][m][n] = f32x4{0.f, 0.f, 0.f, 0.f};
  bf16x8 At[4][2], B0[2][2], B1[2][2];
  const int nt = K / 64;
  if (first) {
    G8_STAGE(G8_SB(0, 0), Bt, ldb, bcol, 0); G8_STAGE(G8_SA(0, 0), A, lda, brow, 0);
    G8_STAGE(G8_SB(0, 1), Bt, ldb, bcol + 128, 0); G8_STAGE(G8_SA(0, 1), A, lda, brow + 128, 0);
  }
  if (wr == 1) G8_BAR;
  if (first) G8_WAIT_V(4); else G8_WAIT_V(0);
  G8_BAR;
  G8_STAGE(G8_SB(1, 0), Bt, ldb, bcol, 1); G8_STAGE(G8_SA(1, 0), A, lda, brow, 1); G8_STAGE(G8_SB(1, 1), Bt, ldb, bcol + 128, 1);
  G8_WAIT_V(6); G8_BAR;
  for (int t = 0; t < nt - 2; t += 2) {
    G8_LDB(B0, 0, 0); G8_SCHED; G8_LDA(At, 0, 0); G8_STAGE(G8_SA(1, 1), A, lda, brow + 128, t + 1);
    G8_WAIT_L(8); G8_BAR; G8_WAIT_L(0); G8_MMA(0, 0, At, B0); G8_BAR; G8_SCHED;
    G8_LDB(B1, 0, 1); G8_STAGE(G8_SB(0, 0), Bt, ldb, bcol, t + 2);
    G8_BAR; G8_WAIT_L(0); G8_MMA(0, 1, At, B1); G8_BAR;
    G8_LDA(At, 0, 1); G8_STAGE(G8_SA(0, 0), A, lda, brow, t + 2);
    G8_BAR; G8_WAIT_L(0); G8_MMA(1, 0, At, B0); G8_BAR; G8_SCHED;
    G8_STAGE(G8_SB(0, 1), Bt, ldb, bcol + 128, t + 2);
    G8_WAIT_V(6); G8_BAR; G8_MMA(1, 1, At, B1); G8_BAR;
    G8_LDB(B0, 1, 0); G8_SCHED; G8_LDA(At, 1, 0); G8_STAGE(G8_SA(0, 1), A, lda, brow + 128, t + 2);
    G8_WAIT_L(8); G8_BAR; G8_WAIT_L(0); G8_MMA(0, 0, At, B0); G8_BAR; G8_SCHED;
    G8_LDB(B1, 1, 1); G8_STAGE(G8_SB(1, 0), Bt, ldb, bcol, t + 3);
    G8_BAR; G8_WAIT_L(0); G8_MMA(0, 1, At, B1); G8_BAR;
    G8_LDA(At, 1, 1); G8_STAGE(G8_SA(1, 0), A, lda, brow, t + 3);
    G8_BAR; G8_WAIT_L(0); G8_MMA(1, 0, At, B0); G8_BAR; G8_SCHED;
    G8_STAGE(G8_SB(1, 1), Bt, ldb, bcol + 128, t + 3);
    G8_WAIT_V(6); G8_BAR; G8_MMA(1, 1, At, B1); G8_BAR;
  }
  { G8_LDB(B0, 0, 0); G8_LDA(At, 0, 0); G8_STAGE(G8_SA(1, 1), A, lda, brow + 128, nt - 1);
    G8_BAR; G8_WAIT_L(0); G8_MMA(0, 0, At, B0); G8_BAR;
    G8_LDB(B1, 0, 1); G8_BAR; G8_WAIT_L(0); G8_MMA(0, 1, At, B1); G8_BAR;
    G8_LDA(At, 0, 1); G8_WAIT_V(4); G8_BAR; G8_WAIT_L(0); G8_MMA(1, 0, At, B0); G8_MMA(1, 1, At, B1); G8_BAR; }
  { G8_LDB(B0, 1, 0); G8_LDA(At, 1, 0); G8_WAIT_V(2); G8_BAR; G8_WAIT_L(0); G8_MMA(0, 0, At, B0); G8_BAR;
    G8_LDB(B1, 1, 1); G8_WAIT_V(0); G8_BAR; G8_WAIT_L(0); G8_MMA(0, 1, At, B1); G8_BAR;
    G8_LDA(At, 1, 1); G8_BAR; G8_WAIT_L(0); G8_MMA(1, 0, At, B0); G8_MMA(1, 1, At, B1); G8_BAR; }
  if (has_next) {
    G8_STAGE(G8_SB(0, 0), Bt, ldb, nbcol, 0); G8_STAGE(G8_SA(0, 0), A, lda, nbrow, 0);
    G8_STAGE(G8_SB(0, 1), Bt, ldb, nbcol + 128, 0); G8_STAGE(G8_SA(0, 1), A, lda, nbrow + 128, 0);
  }
  if (wr == 0) G8_BAR;
  const bool odd = fq & 1;
#pragma unroll
  for (int ai = 0; ai < 2; ++ai)
#pragma unroll
    for (int bj = 0; bj < 2; ++bj)
#pragma unroll
      for (int m = 0; m < 4; ++m) {
        const int row = brow + ai * 128 + wr * 64 + m * 16 + fr, cb = bcol + bj * 128 + wc * 32;
        epi.side(row, cb + fq * 4, acc[ai][bj][m][0]);
        epi.side(row, cb + 16 + fq * 4, acc[ai][bj][m][1]);
        const u32x2 p0 = epi.pack(acc[ai][bj][m][0]), p1 = epi.pack(acc[ai][bj][m][1]);
        const u32x2 snd = odd ? p0 : p1;
        u32x2 rcv; rcv[0] = (unsigned)__shfl_xor((int)snd[0], 16); rcv[1] = (unsigned)__shfl_xor((int)snd[1], 16);
        u32x4 o;
        if (odd) { o[0] = rcv[0]; o[1] = rcv[1]; o[2] = p1[0]; o[3] = p1[1]; }
        else     { o[0] = p0[0]; o[1] = p0[1]; o[2] = rcv[0]; o[3] = rcv[1]; }
        epi.store16(row, odd ? cb + 16 + (fq - 1) * 4 : cb + fq * 4, o);
      }
  __syncthreads();
}

struct EpiBF {
  bf16_t* out; int ldo;
  DI void side(int, int, const f32x4&) const {}
  DI u32x2 pack(const f32x4& a) const { u32x2 o; o[0] = pack2(a[0], a[1]); o[1] = pack2(a[2], a[3]); return o; }
  DI void store16(int row, int col, const u32x4& v) const { *(u32x4*)(out + (size_t)row * ldo + col) = v; }
  DI float scale(int) const { return 1.f; }
  DI void operator()(int row, int col, const f32x4& a, float) const { (*this)(row, col, a); }
  DI void operator()(int row, int col, const f32x4& a) const {
    u32x2 o; o[0] = pack2(a[0], a[1]); o[1] = pack2(a[2], a[3]);
    *(u32x2*)(out + (size_t)row * ldo + col) = o;
  }
};
struct EpiRelu2 {
  bf16_t* out; int ldo;
  DI void side(int, int, const f32x4&) const {}
  DI u32x2 pack(const f32x4& a) const {
    float r0 = fmaxf(a[0], 0.f), r1 = fmaxf(a[1], 0.f), r2 = fmaxf(a[2], 0.f), r3 = fmaxf(a[3], 0.f);
    u32x2 o; o[0] = pack2(r0 * r0, r1 * r1); o[1] = pack2(r2 * r2, r3 * r3); return o;
  }
  DI void store16(int row, int col, const u32x4& v) const { *(u32x4*)(out + (size_t)row * ldo + col) = v; }
  DI void operator()(int row, int col, const f32x4& a) const {
    float r0 = fmaxf(a[0], 0.f), r1 = fmaxf(a[1], 0.f), r2 = fmaxf(a[2], 0.f), r3 = fmaxf(a[3], 0.f);
    u32x2 o; o[0] = pack2(r0 * r0, r1 * r1); o[1] = pack2(r2 * r2, r3 * r3);
    *(u32x2*)(out + (size_t)row * ldo + col) = o;
  }
};
struct EpiU {
  bf16_t* u; float* dt;
  DI void side(int row, int col, const f32x4& a) const { if (col >= U_DT && col < DIN) *(float4*)(dt + (size_t)row * 16 + col - U_DT) = make_float4(a[0], a[1], a[2], a[3]); }
  DI u32x2 pack(const f32x4& a) const { u32x2 o; o[0] = pack2(a[0], a[1]); o[1] = pack2(a[2], a[3]); return o; }
  DI void store16(int row, int col, const u32x4& v) const { if (col < DIN) *(u32x4*)(u + (size_t)row * DIN + col) = v; }
  DI void operator()(int row, int col, const f32x4& a) const {
    if (col < DIN) {
      u32x2 o; o[0] = pack2(a[0], a[1]); o[1] = pack2(a[2], a[3]);
      *(u32x2*)(u + (size_t)row * DIN + col) = o;
      if (col >= U_DT) *(float4*)(dt + (size_t)row * 16 + col - U_DT) = make_float4(a[0], a[1], a[2], a[3]);
    }
  }
};
struct EpiQ {
  bf16_t* q; const float* rs;
  DI float scale(int row) const { return rs[row * 2]; }
  DI void operator()(int row, int col, const f32x4& a, float r) const {
    u32x2 o; o[0] = pack2(a[0] * r, a[1] * r); o[1] = pack2(a[2] * r, a[3] * r);
    *(u32x2*)(q + (size_t)row * 384 + col) = o;
  }
};
struct EpiKV {
  bf16_t* kb; bf16_t* vt; const float* rs;
  DI float scale(int row) const { return rs[row * 2 + 1]; }
  DI void operator()(int row, int col, const f32x4& a, float r) const {
    int b, pos;
    if (row < ML) { b = row >> 12; pos = (row & 4095) + CTX; } else { int rr = row - ML; b = rr >> 8; pos = rr & 255; }
    const int head = col >> 7, d = col & 127;
    if (d < 64) {
      u32x2 o; o[0] = pack2(a[0] * r, a[1] * r); o[1] = pack2(a[2] * r, a[3] * r);
      *(u32x2*)(kb + ((size_t)(b * 4 + head) * LK + pos) * 96 + d) = o;
    } else {
#pragma unroll
      for (int j = 0; j < 4; ++j) vt[((size_t)(b * 4 + head) * 64 + (d - 64 + j)) * LK + pos] = f2bf(a[j] * r);
    }
  }
};

struct EpiPart {
  float* part;
  DI void operator()(int row, int col, const f32x4& a) const {
    *(float4*)(part + (size_t)(row - ML) * DM + col) = make_float4(a[0], a[1], a[2], a[3]);
  }
};
DI void phase_inproj(const Params& p, int layer, int bid, int nb, int vbid, int nvb, char* smem, char* smem_half) {
  EpiU epi{(bf16_t*)(p.ws + OFF_U), (float*)(p.ws + OFF_DT)};
  const int x = bid & 7, per = nb >> 3;
  for (int rep = 0; rep < REP_GEMM; ++rep)
  for (int q = bid >> 3; q < 85; q += per) {
    const int m = (x >> 1) * 17 + q / 5, n = 5 * (x & 1) + q % 5;
    const int q2 = q + per, m2 = (x >> 1) * 17 + q2 / 5, n2 = 5 * (x & 1) + q2 % 5;
    gemm8_tile((const bf16_t*)(p.ws + OFF_H), DM, wt_ptr(p, layer, WT_IN), 1024, 1024, m * 256, n * 256, smem, epi,
               q == (bid >> 3), q2 < 85, m2 * 256, n2 * 256);
  }
  if (layer == 0) {
    if (per == 32) {
      if ((bid >> 3) >= 21) {
        const int u = ((bid >> 3) - 21) * 8 + x;
        for (int it = 640 + 2 * u + (vbid & 1); it < WT_ITEMS; it += 176) wt_item(p, 0, it, smem_half);
      }
    } else {
      for (int it = 640 + vbid; it < WT_ITEMS; it += nvb) wt_item(p, 0, it, smem_half);
    }
  }
}
DI void phase_wout(const Params& p, int layer, int lid, int nvb, char* smem) {
  const int M = layer == 0 ? MT : ML;
  EpiBF epi{(bf16_t*)(p.ws + OFF_U), DM};
  const int x = lid & 7, per = nvb >> 3;
  for (int rep = 0; rep < REP_GEMM; ++rep)
  for (int q = lid >> 3; q < M / 128; q += per)
    gemm_tile<true>((const bf16_t*)(p.ws + OFF_H), DM, wt_ptr(p, layer, WT_OUT), 1024, ((q >> 3) * 8 + x) * 128, (q & 7) * 128, smem, epi, (const float*)(p.ws + OFF_SSQ));
}
DI void phase_ff1(const Params& p, int layer, int bid, int nb, int vbid, int nvb, char* smem, char* smem_half) {
  EpiRelu2 epi{(bf16_t*)(p.ws + OFF_F1), DFF};
  const int x = bid & 7, per = nb >> 3;
  for (int rep = 0; rep < REP_GEMM; ++rep) {
    for (int q = bid >> 3; q < 128; q += per) {
      const int m = (x >> 2) * 32 + (q >> 2), n = 4 * (x & 3) + (q & 3);
      const int q2 = q + per, m2 = (x >> 2) * 32 + (q2 >> 2), n2 = 4 * (x & 3) + (q2 & 3);
      gemm8_tile((const bf16_t*)(p.ws + OFF_H), DM, wt_ptr(p, layer, WT_FF1), 1024, 1024, m * 256, n * 256, smem, epi,
                 q == (bid >> 3), q2 < 128, m2 * 256, n2 * 256);
    }
    if (layer == 0)
      for (int it = vbid; it < (MC / 128) * 32; it += nvb)
        gemm_tile_glds((const bf16_t*)(p.ws + OFF_H), DM, wt_ptr(p, layer, WT_FF1), 1024, 1024, ML + (it / 32) * 128, (it % 32) * 128, smem_half, epi);
  }
}
DI void phase_ff2(const Params& p, int layer, int bid, int nb, int vbid, int nvb, char* smem, char* smem_half) {
  EpiBF epi{(bf16_t*)(p.ws + OFF_H), DM};
  const int x = bid & 7, per = nb >> 3;
  for (int rep = 0; rep < REP_GEMM; ++rep) {
    for (int q = bid >> 3; q < 32; q += per) {
      const int T = x * 32 + q;
      gemm8_tile((const bf16_t*)(p.ws + OFF_F1), DFF, wt_ptr(p, layer, WT_FF2), 4096, 4096, (T >> 2) * 256, (T & 3) * 256, smem, epi);
    }
    if (layer == 0)
      for (int it = vbid; it < (MC / 128) * 8 * 4; it += nvb) {
        const int tile = it >> 2, ks = it & 3;
        EpiPart ep{(float*)(p.ws + OFF_END2) + (size_t)ks * MC * DM};
        gemm_tile_glds((const bf16_t*)(p.ws + OFF_F1) + ks * 1024, DFF, wt_ptr(p, layer, WT_FF2) + ks * 1024, 4096, 1024, ML + (tile >> 3) * 128, (tile & 7) * 128, smem_half, ep);
      }
  }
}

DI int chunk_row0(int b, int tc) { return tc < 2 ? ML + b * CTX + tc * 128 : b * SEQ + (tc - 2) * 128; }
constexpr int BST = 72;
constexpr int TST = 136;
DI void load_tile_T(bf16_t* dst, const bf16_t* __restrict__ src, int ldg) {
  const int tid = ltid();
#pragma unroll
  for (int i = 0; i < 4; ++i) {
    int c = tid + 256 * i, tok = c & 127, pc = c >> 7;
    u32x4 v = *(const u32x4*)(src + (size_t)tok * ldg + pc * 8);
#pragma unroll
    for (int j = 0; j < 4; ++j) {
      dst[(pc * 8 + 2 * j) * TST + tok] = (bf16_t)(v[j] & 0xffffu);
      dst[(pc * 8 + 2 * j + 1) * TST + tok] = (bf16_t)(v[j] >> 16);
    }
  }
}
DI void chunk_scan(const Params& p, int layer, int row0, int h, float* csf, float* csb, float* dtF, float* dtB, float* tot, float*  ) {
  const int tid = ltid(), w = tid >> 6, lane = tid & 63;
  const float* DT = (const float*)(p.ws + OFF_DT);
  float v;
  if (tid < 128) {
    const float dt = DT[(size_t)(row0 + tid) * 16 + h];
    v = dt * -__expf(p.a_log[layer * 16 + h]);
    dtF[tid] = dt;
  } else {
    const int e = 255 - tid;
    const float dt = DT[(size_t)(row0 + e) * 16 + 8 + h];
    v = dt * -__expf(p.a_log[layer * 16 + 8 + h]);
    dtB[e] = dt;
  }
#pragma unroll
  for (int o = 1; o < 64; o <<= 1) { const float t = __shfl_up(v, o); if (lane >= o) v += t; }
  if (lane == 63) tot[w] = v;
  __syncthreads();
  if (w == 1) v += tot[0];
  if (w == 3) v += tot[2];
  if (tid < 128) csf[tid] = v; else csb[255 - tid] = v;
  __syncthreads();
}

DI void ssd_state_item(const Params& p, int layer, int b, int tc, int h, char* smem) {
  bf16_t* XT = (bf16_t*)smem;
  bf16_t* BT = XT + 64 * TST;
  float* csf = (float*)(BT + 64 * TST);
  float* csb = csf + 128; float* dtF = csb + 128; float* dtB = dtF + 128; float* laF = dtB + 128; float* laB = laF + 128;
  const int tid = ltid(), w = tid >> 6, lane = tid & 63, r = lane & 31, hh = lane >> 5;
  const int row0 = chunk_row0(b, tc);
  const bf16_t* XBC = (const bf16_t*)(p.ws + OFF_XBC);
  load_tile_T(XT, XBC + (size_t)row0 * 768 + h * 64, 768);
  load_tile_T(BT, XBC + (size_t)row0 * 768 + 512 + (h >> 2) * 64, 768);
  chunk_scan(p, layer, row0, h, csf, csb, dtF, dtB, laF, laB);
  __syncthreads();
  if (tid < 128) laF[tid] = dtF[tid] * __expf(csf[127] - csf[tid]);
  else { int t = tid - 128; laB[t] = dtB[t] * __expf(csb[0] - csb[t]); }
  __syncthreads();
  const int d = w >> 1, pt = w & 1;
  const float* wv = d == 0 ? laF : laB;
  f32x16 acc[2];
#pragma unroll
  for (int i = 0; i < 16; ++i) { acc[0][i] = 0.f; acc[1][i] = 0.f; }
#pragma unroll
  for (int s = 0; s < 8; ++s) {
    int l0 = 16 * s + 8 * hh;
    u32x4 xa = *(const u32x4*)(XT + (32 * pt + r) * TST + l0);
    u32x4 sa;
#pragma unroll
    for (int j = 0; j < 4; ++j) sa[j] = pack2(lo2f(xa[j]) * wv[l0 + 2 * j], hi2f(xa[j]) * wv[l0 + 2 * j + 1]);
    bf16x8 af = __builtin_bit_cast(bf16x8, sa);
#pragma unroll
    for (int nt = 0; nt < 2; ++nt) {
      bf16x8 bfr = *(const bf16x8*)(BT + (32 * nt + r) * TST + l0);
      acc[nt] = MFMA32(af, bfr, acc[nt]);
    }
  }
  bf16_t* S = (bf16_t*)(p.ws + OFF_SST) + ((((size_t)d * NB + b) * NCH + tc) * 8 + h) * 4096;
#pragma unroll
  for (int nt = 0; nt < 2; ++nt)
#pragma unroll
    for (int i = 0; i < 16; ++i) S[(32 * pt + crow(i, hh)) * 64 + 32 * nt + r] = f2bf(acc[nt][i]);
  if (tid == 0) {
    float* TD = (float*)(p.ws + OFF_TDEC);
    TD[((0 * NB + b) * NCH + tc) * 8 + h] = __expf(csf[127]);
    TD[((1 * NB + b) * NCH + tc) * 8 + h] = __expf(csb[0]);
  }
  __syncthreads();
}

DI void ssd_pass_item(const Params& p, int it) {
  const int e = it * 256 + ltid();
  const int pn2 = e & 2047, h = (e >> 11) & 7, b = (e >> 14) & 3, d = e >> 16;
  unsigned* S = (unsigned*)(p.ws + OFF_SST);
  const float* TD = (const float*)(p.ws + OFF_TDEC);
  unsigned sv[NCH]; float T[NCH];
#pragma unroll
  for (int i = 0; i < NCH; ++i) {
    int tc = d == 0 ? i : (i < 2 ? 1 - i : NCH + 1 - i);
    sv[i] = S[(((size_t)(d * NB + b) * NCH + tc) * 8 + h) * 2048 + pn2];
    T[i] = TD[((d * NB + b) * NCH + tc) * 8 + h];
  }
  float h0 = 0.f, h1 = 0.f;
#pragma unroll
  for (int i = 0; i < NCH; ++i) {
    int tc = d == 0 ? i : (i < 2 ? 1 - i : NCH + 1 - i);
    S[(((size_t)(d * NB + b) * NCH + tc) * 8 + h) * 2048 + pn2] = pack2(h0, h1);
    h0 = T[i] * h0 + lo2f(sv[i]); h1 = T[i] * h1 + hi2f(sv[i]);
  }
}

DI void ssd_out_item(const Params& p, int layer, int b, int tc, int h, char* smem) {
  bf16_t* XT = (bf16_t*)smem;
  bf16_t* Bs = XT + 64 * TST;
  float* csf = (float*)(Bs + 128 * BST);
  float* csb = csf + 128; float* dtF = csb + 128; float* dtB = dtF + 128; float* laF = dtB + 128; float* laB = laF + 128;
  const int tid = ltid(), w = tid >> 6, lane = tid & 63, r = lane & 31, hh = lane >> 5;
  const int row0 = chunk_row0(b, tc), g = h >> 2;
  const bf16_t* XBC = (const bf16_t*)(p.ws + OFF_XBC);
  load_tile_T(XT, XBC + (size_t)row0 * 768 + h * 64, 768);
#pragma unroll
  for (int i = 0; i < 4; ++i) {
    int c = tid + 256 * i, tok = c >> 3, part = c & 7;
    *(u32x4*)(Bs + tok * BST + part * 8) = *(const u32x4*)(XBC + (size_t)(row0 + tok) * 768 + 512 + g * 64 + part * 8);
  }
  const int l = 32 * w + r;
  bf16x8 cf[4];
#pragma unroll
  for (int ks = 0; ks < 4; ++ks) cf[ks] = *(const bf16x8*)(XBC + (size_t)(row0 + l) * 768 + 640 + g * 64 + 16 * ks + 8 * hh);
  chunk_scan(p, layer, row0, h, csf, csb, dtF, dtB, laF, laB);
  const float csf_l = csf[l], csb_l = csb[l];
  f32x16 yacc[2];
#pragma unroll
  for (int i = 0; i < 16; ++i) { yacc[0][i] = 0.f; yacc[1][i] = 0.f; }
#pragma unroll
  for (int st = 0; st < 4; ++st) {
    f32x16 gacc;
#pragma unroll
    for (int i = 0; i < 16; ++i) gacc[i] = 0.f;
#pragma unroll
    for (int ks = 0; ks < 4; ++ks) {
      bf16x8 af = *(const bf16x8*)(Bs + (32 * st + r) * BST + 16 * ks + 8 * hh);
      gacc = MFMA32(af, cf[ks], gacc);
    }
#pragma unroll
    for (int i = 0; i < 16; ++i) {
      int s = 32 * st + crow(i, hh);
      float f;
      if (s < l) f = __expf(csf_l - csf[s]) * dtF[s];
      else if (s > l) f = __expf(csb_l - csb[s]) * dtB[s];
      else f = dtF[s] + dtB[s];
      gacc[i] *= f;
    }
#pragma unroll
    for (int s2 = 0; s2 < 2; ++s2) {
      bf16x8 mf = pack8(gacc, s2);
      int sb = 32 * st + 16 * s2 + 4 * hh;
#pragma unroll
      for (int pt = 0; pt < 2; ++pt) {
        u32x2 lo = *(const u32x2*)(XT + (32 * pt + r) * TST + sb);
        u32x2 hi = *(const u32x2*)(XT + (32 * pt + r) * TST + sb + 8);
        u32x4 xa; xa[0] = lo[0]; xa[1] = lo[1]; xa[2] = hi[0]; xa[3] = hi[1];
        yacc[pt] = MFMA32(__builtin_bit_cast(bf16x8, xa), mf, yacc[pt]);
      }
    }
  }
#pragma unroll
  for (int d = 0; d < 2; ++d) {
    const bf16_t* Hs = (const bf16_t*)(p.ws + OFF_SST) + ((((size_t)d * NB + b) * NCH + tc) * 8 + h) * 4096;
    const float e = __expf(d == 0 ? csf_l : csb_l);
#pragma unroll
    for (int pt = 0; pt < 2; ++pt) {
      f32x16 t;
#pragma unroll
      for (int i = 0; i < 16; ++i) t[i] = 0.f;
#pragma unroll
      for (int ks = 0; ks < 4; ++ks) {
        bf16x8 af = *(const bf16x8*)(Hs + (32 * pt + r) * 64 + 16 * ks + 8 * hh);
        t = MFMA32(af, cf[ks], t);
      }
#pragma unroll
      for (int i = 0; i < 16; ++i) yacc[pt][i] += e * t[i];
    }
  }
  const int row = row0 + l;
  const float Dh = p.ssd_d[layer * 8 + h];
  const bf16_t* U = (const bf16_t*)(p.ws + OFF_U);
  bf16_t* YM = (bf16_t*)(p.ws + OFF_H);
  float ssq = 0.f;
  u32x2 xvv[2][4], zvv[2][4];
#pragma unroll
  for (int pt = 0; pt < 2; ++pt)
#pragma unroll
    for (int q = 0; q < 4; ++q) {
      const int pp = 32 * pt + 8 * q + 4 * hh;
      xvv[pt][q] = *(const u32x2*)(XBC + (size_t)row * 768 + h * 64 + pp);
      zvv[pt][q] = *(const u32x2*)(U + (size_t)row * DIN + U_Z + h * 64 + pp);
    }
#pragma unroll
  for (int pt = 0; pt < 2; ++pt)
#pragma unroll
    for (int q = 0; q < 4; ++q) {
      const int pp = 32 * pt + 8 * q + 4 * hh;
      const u32x2 xv = xvv[pt][q], zv = zvv[pt][q];
      float y0 = (yacc[pt][4 * q + 0] + Dh * lo2f(xv[0])) * silu_f(lo2f(zv[0]));
      float y1 = (yacc[pt][4 * q + 1] + Dh * hi2f(xv[0])) * silu_f(hi2f(zv[0]));
      float y2 = (yacc[pt][4 * q + 2] + Dh * lo2f(xv[1])) * silu_f(lo2f(zv[1]));
      float y3 = (yacc[pt][4 * q + 3] + Dh * hi2f(xv[1])) * silu_f(hi2f(zv[1]));
      u32x2 o; o[0] = pack2(y0, y1); o[1] = pack2(y2, y3);
      float r0 = lo2f(o[0]), r1 = hi2f(o[0]), r2 = lo2f(o[1]), r3 = hi2f(o[1]);
      ssq += r0 * r0 + r1 * r1 + r2 * r2 + r3 * r3;
      *(u32x2*)(YM + (size_t)row * DM + 512 + h * 64 + pp) = o;
    }
  ssq += __shfl_xor(ssq, 32);
  if (hh == 0) ((float*)(p.ws + OFF_SSQ))[(size_t)row * 8 + h] = ssq;
  __syncthreads();
}

constexpr int KST = 104;
constexpr int VST = 68;
constexpr int ASTG = 64 * KST + 64 * VST;
DI void attn_item(const Params& p, int b, int head, int qrow0, int t0, bool lat, int nkeys, char* smem) {
  bf16_t* Ks = (bf16_t*)smem;
  bf16_t* Vs = Ks + 64 * KST;
  const int tid = ltid(), w = tid >> 6, lane = tid & 63, r = lane & 31, hh = lane >> 5;
  const bf16_t* QB = (const bf16_t*)(p.ws + OFF_QB);
  const bf16_t* KB = (const bf16_t*)(p.ws + OFF_KB) + (size_t)(b * 4 + head) * LK * 96;
  const bf16_t* VT = (const bf16_t*)(p.ws + OFF_VT) + (size_t)(b * 4 + head) * 64 * LK;
  const float qscale = 0.10206207261596575f * 1.4426950408889634f;
  const int qrow = qrow0 + w * 32 + r;
  const int t = t0 + w * 32 + r;
  bf16x8 qf[6];
  {
    const bf16_t* src = QB + (size_t)qrow * 384 + head * 96;
#pragma unroll
    for (int s = 0; s < 4; ++s) {
      u32x4 v = *(const u32x4*)(src + 16 * s + 8 * hh);
      u32x4 o;
#pragma unroll
      for (int j = 0; j < 4; ++j) o[j] = pack2(lo2f(v[j]) * qscale, hi2f(v[j]) * qscale);
      qf[s] = __builtin_bit_cast(bf16x8, o);
    }
#pragma unroll
    for (int s = 4; s < 6; ++s) {
      u32x4 va = *(const u32x4*)(src + 16 * s), vb = *(const u32x4*)(src + 16 * s + 8);
      float posf = s == 4 ? (float)(t >> 6) : (float)(t & 63);
      float o[8];
#pragma unroll
      for (int j = 0; j < 8; ++j) {
        float a = (j & 1) ? hi2f(va[j >> 1]) : lo2f(va[j >> 1]);
        float bb = (j & 1) ? hi2f(vb[j >> 1]) : lo2f(vb[j >> 1]);
        float res;
        if (lat) {
          float invf = exp2f(-(float)(2 * j) * (13.287712379549449f / 16.f));
          float rev = posf * invf * 0.15915494309189535f;
          float cs = __builtin_amdgcn_cosf(rev), sn = __builtin_amdgcn_sinf(rev);
          res = hh == 0 ? a * cs - bb * sn : bb * cs + a * sn;
        } else res = hh == 0 ? a : bb;
        o[j] = res * qscale;
      }
      u32x4 ov; ov[0] = pack2(o[0], o[1]); ov[1] = pack2(o[2], o[3]); ov[2] = pack2(o[4], o[5]); ov[3] = pack2(o[6], o[7]);
      qf[s] = __builtin_bit_cast(bf16x8, ov);
    }
  }
  f32x16 oacc[2];
#pragma unroll
  for (int i = 0; i < 16; ++i) { oacc[0][i] = 0.f; oacc[1][i] = 0.f; }
  float m = -1e30f, lsum = 0.f;
  u32x4 rk[3], rv[2];
  auto gload = [&](int key0) {
#pragma unroll
    for (int i = 0; i < 3; ++i) rk[i] = *(const u32x4*)(KB + (size_t)key0 * 96 + (tid + 256 * i) * 8);
#pragma unroll
    for (int i = 0; i < 2; ++i) { int c = tid + 256 * i; rv[i] = *(const u32x4*)(VT + (size_t)(c >> 3) * LK + key0 + (c & 7) * 8); }
  };
  gload(0);
  const int NT = nkeys / 64;
  for (int kt = 0; kt < NT; ++kt) {
#pragma unroll
    for (int i = 0; i < 3; ++i) { int c = tid + 256 * i; *(u32x4*)(Ks + (c / 12) * KST + (c % 12) * 8) = rk[i]; }
#pragma unroll
    for (int i = 0; i < 2; ++i) {
      int c = tid + 256 * i;
      bf16_t* d = Vs + (c >> 3) * VST + (c & 7) * 8;
      u32x2 a; a[0] = rv[i][0]; a[1] = rv[i][1];
      u32x2 bq; bq[0] = rv[i][2]; bq[1] = rv[i][3];
      *(u32x2*)d = a; *(u32x2*)(d + 4) = bq;
    }
    __syncthreads();
    if (kt + 1 < NT) gload((kt + 1) * 64);
    f32x16 sacc[2];
#pragma unroll
    for (int i = 0; i < 16; ++i) { sacc[0][i] = 0.f; sacc[1][i] = 0.f; }
#pragma unroll
    for (int s = 0; s < 6; ++s)
#pragma unroll
      for (int k2 = 0; k2 < 2; ++k2) {
        bf16x8 af = *(const bf16x8*)(Ks + (32 * k2 + r) * KST + 16 * s + 8 * hh);
        sacc[k2] = MFMA32(af, qf[s], sacc[k2]);
      }
    float mx = sacc[0][0];
#pragma unroll
    for (int i = 0; i < 16; ++i) { mx = fmaxf(mx, sacc[0][i]); mx = fmaxf(mx, sacc[1][i]); }
    mx = fmaxf(mx, __shfl_xor(mx, 32));
    const float mn = fmaxf(m, mx);
    const float alpha = __builtin_amdgcn_exp2f(m - mn);
    m = mn;
    float ps = 0.f;
#pragma unroll
    for (int i = 0; i < 16; ++i) {
      sacc[0][i] = __builtin_amdgcn_exp2f(sacc[0][i] - mn); sacc[1][i] = __builtin_amdgcn_exp2f(sacc[1][i] - mn);
      ps += sacc[0][i] + sacc[1][i];
    }
    lsum = lsum * alpha + ps;
#pragma unroll
    for (int i = 0; i < 16; ++i) { oacc[0][i] *= alpha; oacc[1][i] *= alpha; }
#pragma unroll
    for (int k2 = 0; k2 < 2; ++k2)
#pragma unroll
      for (int s2 = 0; s2 < 2; ++s2) {
        bf16x8 pf = pack8(sacc[k2], s2);
        int kb0 = 32 * k2 + 16 * s2 + 4 * hh;
#pragma unroll
        for (int d = 0; d < 2; ++d) {
          u32x2 lo = *(const u32x2*)(Vs + (32 * d + r) * VST + kb0);
          u32x2 hi = *(const u32x2*)(Vs + (32 * d + r) * VST + kb0 + 8);
          u32x4 va; va[0] = lo[0]; va[1] = lo[1]; va[2] = hi[0]; va[3] = hi[1];
          oacc[d] = MFMA32(__builtin_bit_cast(bf16x8, va), pf, oacc[d]);
        }
      }
    __syncthreads();
  }
  lsum += __shfl_xor(lsum, 32);
  const float inv = 1.f / lsum;
  bf16_t* YM = (bf16_t*)(p.ws + OFF_H) + (size_t)qrow * DM + head * 64;
#pragma unroll
  for (int d = 0; d < 2; ++d)
#pragma unroll
    for (int q = 0; q < 4; ++q) {
      u32x2 o; o[0] = pack2(oacc[d][4 * q] * inv, oacc[d][4 * q + 1] * inv); o[1] = pack2(oacc[d][4 * q + 2] * inv, oacc[d][4 * q + 3] * inv);
      *(u32x2*)(YM + 32 * d + 8 * q + 4 * hh) = o;
    }
}

DI void attn_item8(const Params& p, int b, int head, int qrow0, int t0, bool lat, int nkeys, char* smem) {
  bf16_t* Ks = (bf16_t*)smem;
  bf16_t* Vs = Ks + 64 * KST;
  const int tid = ltid512(), w = tid >> 6, lane = tid & 63, r = lane & 31, hh = lane >> 5;
  const bf16_t* QB = (const bf16_t*)(p.ws + OFF_QB);
  const bf16_t* KB = (const bf16_t*)(p.ws + OFF_KB) + (size_t)(b * 4 + head) * LK * 96;
  const bf16_t* VT = (const bf16_t*)(p.ws + OFF_VT) + (size_t)(b * 4 + head) * 64 * LK;
  const float qscale = 0.10206207261596575f * 1.4426950408889634f;
  const int qrow = qrow0 + w * 32 + r;
  const int t = t0 + w * 32 + r;
  bf16x8 qf[6];
  {
    const bf16_t* src = QB + (size_t)qrow * 384 + head * 96;
#pragma unroll
    for (int s = 0; s < 4; ++s) {
      u32x4 v = *(const u32x4*)(src + 16 * s + 8 * hh);
      u32x4 o;
#pragma unroll
      for (int j = 0; j < 4; ++j) o[j] = pack2(lo2f(v[j]) * qscale, hi2f(v[j]) * qscale);
      qf[s] = __builtin_bit_cast(bf16x8, o);
    }
#pragma unroll
    for (int s = 4; s < 6; ++s) {
      u32x4 va = *(const u32x4*)(src + 16 * s), vb = *(const u32x4*)(src + 16 * s + 8);
      float posf = s == 4 ? (float)(t >> 6) : (float)(t & 63);
      float o[8];
#pragma unroll
      for (int j = 0; j < 8; ++j) {
        float a = (j & 1) ? hi2f(va[j >> 1]) : lo2f(va[j >> 1]);
        float bb = (j & 1) ? hi2f(vb[j >> 1]) : lo2f(vb[j >> 1]);
        float res;
        if (lat) {
          float invf = exp2f(-(float)(2 * j) * (13.287712379549449f / 16.f));
          float rev = posf * invf * 0.15915494309189535f;
          float cs = __builtin_amdgcn_cosf(rev), sn = __builtin_amdgcn_sinf(rev);
          res = hh == 0 ? a * cs - bb * sn : bb * cs + a * sn;
        } else res = hh == 0 ? a : bb;
        o[j] = res * qscale;
      }
      u32x4 ov; ov[0] = pack2(o[0], o[1]); ov[1] = pack2(o[2], o[3]); ov[2] = pack2(o[4], o[5]); ov[3] = pack2(o[6], o[7]);
      qf[s] = __builtin_bit_cast(bf16x8, ov);
    }
  }
  f32x16 oacc[2];
#pragma unroll
  for (int i = 0; i < 16; ++i) { oacc[0][i] = 0.f; oacc[1][i] = 0.f; }
  float m = -1e30f, lsum = 0.f;
  u32x4 rk[2], rv;
  auto gload = [&](int key0) {
    rk[0] = *(const u32x4*)(KB + (size_t)key0 * 96 + tid * 8);
    if (tid < 256) rk[1] = *(const u32x4*)(KB + (size_t)key0 * 96 + (512 + tid) * 8);
    rv = *(const u32x4*)(VT + (size_t)(tid >> 3) * LK + key0 + (tid & 7) * 8);
  };
  const int kro = (tid / 12) * KST + (tid % 12) * 8, kro2 = ((512 + tid) / 12) * KST + ((512 + tid) % 12) * 8;
  auto swrite = [&](int stage) {
    bf16_t* Kd = Ks + stage * ASTG;
    *(u32x4*)(Kd + kro) = rk[0];
    if (tid < 256) *(u32x4*)(Kd + kro2) = rk[1];
    bf16_t* d = Kd + 64 * KST + (tid >> 3) * VST + (tid & 7) * 8;
    u32x2 a; a[0] = rv[0]; a[1] = rv[1];
    u32x2 bq; bq[0] = rv[2]; bq[1] = rv[3];
    *(u32x2*)d = a; *(u32x2*)(d + 4) = bq;
  };
  auto qk = [&](int stage, f32x16 (&sa)[2]) {
    const bf16_t* Kc = Ks + stage * ASTG;
#pragma unroll
    for (int i = 0; i < 16; ++i) { sa[0][i] = 0.f; sa[1][i] = 0.f; }
#pragma unroll
    for (int s = 0; s < 6; ++s)
#pragma unroll
      for (int k2 = 0; k2 < 2; ++k2) {
        bf16x8 af = *(const bf16x8*)(Kc + (32 * k2 + r) * KST + 16 * s + 8 * hh);
        sa[k2] = MFMA32(af, qf[s], sa[k2]);
      }
  };
  const int NT = nkeys / 64;
  f32x16 sacc[2], snext[2];
  gload(0); swrite(0);
  gload(64);
  __syncthreads();
  swrite(1);
  gload(128);
  qk(0, sacc);
  __syncthreads();
  int cur = 0, nxt = 1, nn = 2;
  for (int kt = 0; kt < NT; ++kt) {
    if (kt + 1 < NT) qk(nxt, snext);
    if (kt + 2 < NT) {
      swrite(nn);
      if (kt + 3 < NT) gload((kt + 3) * 64);
    }
    const bf16_t* Vc = Ks + cur * ASTG + 64 * KST;
    float mx = sacc[0][0];
#pragma unroll
    for (int i = 0; i < 16; ++i) { mx = fmaxf(mx, sacc[0][i]); mx = fmaxf(mx, sacc[1][i]); }
    mx = fmaxf(mx, __shfl_xor(mx, 32));
    const float mn = fmaxf(m, mx);
    const float alpha = __builtin_amdgcn_exp2f(m - mn);
    m = mn;
    float ps = 0.f;
#pragma unroll
    for (int i = 0; i < 16; ++i) {
      sacc[0][i] = __builtin_amdgcn_exp2f(sacc[0][i] - mn); sacc[1][i] = __builtin_amdgcn_exp2f(sacc[1][i] - mn);
      ps += sacc[0][i] + sacc[1][i];
    }
    lsum = lsum * alpha + ps;
#pragma unroll
    for (int i = 0; i < 16; ++i) { oacc[0][i] *= alpha; oacc[1][i] *= alpha; }
#pragma unroll
    for (int k2 = 0; k2 < 2; ++k2)
#pragma unroll
      for (int s2 = 0; s2 < 2; ++s2) {
        bf16x8 pf = pack8(sacc[k2], s2);
        int kb0 = 32 * k2 + 16 * s2 + 4 * hh;
#pragma unroll
        for (int d = 0; d < 2; ++d) {
          u32x2 lo = *(const u32x2*)(Vc + (32 * d + r) * VST + kb0);
          u32x2 hi = *(const u32x2*)(Vc + (32 * d + r) * VST + kb0 + 8);
          u32x4 va; va[0] = lo[0]; va[1] = lo[1]; va[2] = hi[0]; va[3] = hi[1];
          oacc[d] = MFMA32(__builtin_bit_cast(bf16x8, va), pf, oacc[d]);
        }
      }
    sacc[0] = snext[0]; sacc[1] = snext[1];
    const int t3 = cur; cur = nxt; nxt = nn; nn = t3;
    __syncthreads();
  }
  lsum += __shfl_xor(lsum, 32);
  const float inv = 1.f / lsum;
  bf16_t* YM = (bf16_t*)(p.ws + OFF_H) + (size_t)qrow * DM + head * 64;
#pragma unroll
  for (int d = 0; d < 2; ++d)
#pragma unroll
    for (int q = 0; q < 4; ++q) {
      u32x2 o; o[0] = pack2(oacc[d][4 * q] * inv, oacc[d][4 * q + 1] * inv); o[1] = pack2(oacc[d][4 * q + 2] * inv, oacc[d][4 * q + 3] * inv);
      *(u32x2*)(YM + 32 * d + 8 * q + 4 * hh) = o;
    }
}

DI void attn_item8b(const Params& p, int b, int head, int qrow0, int t0, bool lat, int nkeys, char* smem) {
  bf16_t* Ks = (bf16_t*)smem;
  bf16_t* Vs = Ks + 64 * KST;
  const int tid = ltid512(), w = tid >> 6, lane = tid & 63, r = lane & 31, hh = lane >> 5;
  const bf16_t* QB = (const bf16_t*)(p.ws + OFF_QB);
  const bf16_t* KB = (const bf16_t*)(p.ws + OFF_KB) + (size_t)(b * 4 + head) * LK * 96;
  const bf16_t* VT = (const bf16_t*)(p.ws + OFF_VT) + (size_t)(b * 4 + head) * 64 * LK;
  const float qscale = 0.10206207261596575f * 1.4426950408889634f;
  const int qrow = qrow0 + w * 32 + r;
  const int t = t0 + w * 32 + r;
  bf16x8 qf[6];
  {
    const bf16_t* src = QB + (size_t)qrow * 384 + head * 96;
#pragma unroll
    for (int s = 0; s < 4; ++s) {
      u32x4 v = *(const u32x4*)(src + 16 * s + 8 * hh);
      u32x4 o;
#pragma unroll
      for (int j = 0; j < 4; ++j) o[j] = pack2(lo2f(v[j]) * qscale, hi2f(v[j]) * qscale);
      qf[s] = __builtin_bit_cast(bf16x8, o);
    }
#pragma unroll
    for (int s = 4; s < 6; ++s) {
      u32x4 va = *(const u32x4*)(src + 16 * s), vb = *(const u32x4*)(src + 16 * s + 8);
      float posf = s == 4 ? (float)(t >> 6) : (float)(t & 63);
      float o[8];
#pragma unroll
      for (int j = 0; j < 8; ++j) {
        float a = (j & 1) ? hi2f(va[j >> 1]) : lo2f(va[j >> 1]);
        float bb = (j & 1) ? hi2f(vb[j >> 1]) : lo2f(vb[j >> 1]);
        float res;
        if (lat) {
          float invf = exp2f(-(float)(2 * j) * (13.287712379549449f / 16.f));
          float rev = posf * invf * 0.15915494309189535f;
          float cs = __builtin_amdgcn_cosf(rev), sn = __builtin_amdgcn_sinf(rev);
          res = hh == 0 ? a * cs - bb * sn : bb * cs + a * sn;
        } else res = hh == 0 ? a : bb;
        o[j] = res * qscale;
      }
      u32x4 ov; ov[0] = pack2(o[0], o[1]); ov[1] = pack2(o[2], o[3]); ov[2] = pack2(o[4], o[5]); ov[3] = pack2(o[6], o[7]);
      qf[s] = __builtin_bit_cast(bf16x8, ov);
    }
  }
  f32x16 oacc[2];
#pragma unroll
  for (int i = 0; i < 16; ++i) { oacc[0][i] = 0.f; oacc[1][i] = 0.f; }
  float m = -1e30f, lsum = 0.f;
  constexpr int VS2 = 132;
  constexpr int STG = 128 * KST + 64 * VS2;
  u32x4 rk[3], rv[2];
  auto gload = [&](int key0) {
#pragma unroll
    for (int i = 0; i < 3; ++i) rk[i] = *(const u32x4*)(KB + (size_t)key0 * 96 + (tid + 512 * i) * 8);
#pragma unroll
    for (int i = 0; i < 2; ++i) { const int c = tid + 512 * i; rv[i] = *(const u32x4*)(VT + (size_t)(c >> 4) * LK + key0 + (c & 15) * 8); }
  };
  int kro[3], vro[2];
#pragma unroll
  for (int i = 0; i < 3; ++i) { const int c = tid + 512 * i; kro[i] = (c / 12) * KST + (c % 12) * 8; }
#pragma unroll
  for (int i = 0; i < 2; ++i) { const int c = tid + 512 * i; vro[i] = 128 * KST + (c >> 4) * VS2 + (c & 15) * 8; }
  auto swrite = [&](int stage) {
    bf16_t* Kd = Ks + stage * STG;
#pragma unroll
    for (int i = 0; i < 3; ++i) *(u32x4*)(Kd + kro[i]) = rk[i];
#pragma unroll
    for (int i = 0; i < 2; ++i) {
      u32x2 a; a[0] = rv[i][0]; a[1] = rv[i][1];
      u32x2 bq; bq[0] = rv[i][2]; bq[1] = rv[i][3];
      *(u32x2*)(Kd + vro[i]) = a; *(u32x2*)(Kd + vro[i] + 4) = bq;
    }
  };
  const int NT = nkeys / 128;
  gload(0); swrite(0);
  if (NT > 1) gload(128);
  __syncthreads();
  for (int kt = 0; kt < NT; ++kt) {
    const bf16_t* Kc = Ks + (kt & 1) * STG;
    const bf16_t* Vc = Kc + 128 * KST;
    if (kt + 1 < NT) {
      swrite((kt + 1) & 1);
      if (kt + 2 < NT) gload((kt + 2) * 128);
    }
    f32x16 sacc[4];
#pragma unroll
    for (int k2 = 0; k2 < 4; ++k2)
#pragma unroll
      for (int i = 0; i < 16; ++i) sacc[k2][i] = 0.f;
#pragma unroll
    for (int s = 0; s < 6; ++s)
#pragma unroll
      for (int k2 = 0; k2 < 4; ++k2) {
        bf16x8 af = *(const bf16x8*)(Kc + (32 * k2 + r) * KST + 16 * s + 8 * hh);
        sacc[k2] = MFMA32(af, qf[s], sacc[k2]);
      }
    float mx = sacc[0][0];
#pragma unroll
    for (int k2 = 0; k2 < 4; ++k2)
#pragma unroll
      for (int i = 0; i < 16; ++i) mx = fmaxf(mx, sacc[k2][i]);
    mx = fmaxf(mx, __shfl_xor(mx, 32));
    const float mn = fmaxf(m, mx);
    if (__any(mn > m)) {
      const float alpha = __builtin_amdgcn_exp2f(m - mn);
      lsum *= alpha;
#pragma unroll
      for (int i = 0; i < 16; ++i) { oacc[0][i] *= alpha; oacc[1][i] *= alpha; }
      m = mn;
    }
    float ps = 0.f;
#pragma unroll
    for (int k2 = 0; k2 < 4; ++k2)
#pragma unroll
      for (int i = 0; i < 16; ++i) { sacc[k2][i] = __builtin_amdgcn_exp2f(sacc[k2][i] - m); ps += sacc[k2][i]; }
    lsum += ps;
#pragma unroll
    for (int k2 = 0; k2 < 4; ++k2)
#pragma unroll
      for (int s2 = 0; s2 < 2; ++s2) {
        bf16x8 pf = pack8(sacc[k2], s2);
        const int kb0 = 32 * k2 + 16 * s2 + 4 * hh;
#pragma unroll
        for (int d = 0; d < 2; ++d) {
          u32x2 lo = *(const u32x2*)(Vc + (32 * d + r) * VS2 + kb0);
          u32x2 hi = *(const u32x2*)(Vc + (32 * d + r) * VS2 + kb0 + 8);
          u32x4 va; va[0] = lo[0]; va[1] = lo[1]; va[2] = hi[0]; va[3] = hi[1];
          oacc[d] = MFMA32(__builtin_bit_cast(bf16x8, va), pf, oacc[d]);
        }
      }
    __syncthreads();
  }
  lsum += __shfl_xor(lsum, 32);
  const float inv = 1.f / lsum;
  bf16_t* YM = (bf16_t*)(p.ws + OFF_H) + (size_t)qrow * DM + head * 64;
#pragma unroll
  for (int d = 0; d < 2; ++d)
#pragma unroll
    for (int q = 0; q < 4; ++q) {
      u32x2 o; o[0] = pack2(oacc[d][4 * q] * inv, oacc[d][4 * q + 1] * inv); o[1] = pack2(oacc[d][4 * q + 2] * inv, oacc[d][4 * q + 3] * inv);
      *(u32x2*)(YM + 32 * d + 8 * q + 4 * hh) = o;
    }
}

DI void phase_qkv(const Params& p, int layer, int bid, int nb, char* smem) {
  const int MQ = layer == 0 ? MT : ML;
  const int nq = (MQ / 128) * 3, nkv = (MT / 128) * 4, nst = NB * NCH * 8;
  const float* RS = (const float*)(p.ws + OFF_RSTD);
  EpiQ eq{(bf16_t*)(p.ws + OFF_QB), RS};
  EpiKV ekv{(bf16_t*)(p.ws + OFF_KB), (bf16_t*)(p.ws + OFF_VT), RS};
  const bf16_t* U = (const bf16_t*)(p.ws + OFF_U);
  for (int it = bid; it < nq + nkv + nst; it += nb) {
    if (it < nq) gemm_tile<false>(U, DIN, wt_ptr(p, layer, WT_UQ), 256, (it / 3) * 128, (it % 3) * 128, smem, eq);
    else if (it < nq + nkv) { int j = it - nq; gemm_tile<false>(U + U_CKV, DIN, wt_ptr(p, layer, WT_UKV), 128, (j / 4) * 128, (j % 4) * 128, smem, ekv); }
    else { int j = it - nq - nkv; for (int rep = 0; rep < REP_SSD; ++rep) ssd_state_item(p, layer, j / (NCH * 8), (j / 8) % NCH, j & 7, smem); }
  }
}
DI void phase_att(const Params& p, int layer, int bid, int nb, int vbid, int nvb, char* smem, char* sh) {
  for (int it = bid; it < 256; it += nb) {
    const int x = it & 7, j = it >> 3, bh = 2 * x + (j >> 4), qb = j & 15, b = bh >> 2, head = bh & 3;
    for (int rep = 0; rep < REP_ATT; ++rep) attn_item8b(p, b, head, b * SEQ + qb * 256, qb * 256, true, LK, smem);
  }
  for (int it = vbid; it < 512; it += nvb) ssd_pass_item(p, it);
}
DI void phase_ssdout(const Params& p, int layer, int bid, int nb, char* smem) {
  const int nout = NB * NCH * 8, nctx = layer == 0 ? 32 : 0;
  for (int it = bid; it < nout + nctx; it += nb) {
    if (it < nout) {
      int b = it / (NCH * 8), tc = (it / 8) % NCH, h = it & 7;
      if (layer == 1 && tc < 2) continue;
      for (int rep = 0; rep < REP_SSD; ++rep) ssd_out_item(p, layer, b, tc, h, smem);
    } else {
      const int j = it - nout, b = j >> 3, head = (j >> 1) & 3, qb = j & 1;
      attn_item(p, b, head, ML + b * CTX + qb * 128, qb * 128, false, CTX, smem);
    }
  }
  if (layer == 0) {
    if (nb == 512) { if (bid >= 96) for (int it = bid - 96; it < WT_ITEMS; it += 416) wt_item(p, 1, it, smem); }
    else for (int it = bid; it < WT_ITEMS; it += nb) wt_item(p, 1, it, smem);
  }
}


#define XB_TMO      128
#define XB_XCNT(j)  (256  + 64 * (j))
#define XB_XSUB(j)  (1280 + 64 * (j))
#define XB_XGEN(j)  (2304 + 64 * (j))
#define XB_TOP      3328
#define XB_TOPGEN   3392
#define XCD_BAR_WORDS 3456
#define XB_SPIN_CAP (1u << 22)
#define LAS __attribute__((address_space(3)))
DI unsigned xb_ld(unsigned* p) { return __hip_atomic_load(p, __ATOMIC_RELAXED, __HIP_MEMORY_SCOPE_AGENT); }
DI unsigned xb_add(unsigned* p, unsigned v) { return __hip_atomic_fetch_add(p, v, __ATOMIC_RELAXED, __HIP_MEMORY_SCOPE_AGENT); }
DI unsigned xb_xcc_id() { return (unsigned)__builtin_amdgcn_s_getreg((3 << 11) | 20) & 0xFu; }
#define XB_SPIN(cond, bar) do { unsigned _sp = 0; while (cond) { __builtin_amdgcn_s_sleep(1); \
    if ((++_sp & 255u) == 0u) { if (xb_ld(&(bar)[XB_TMO])) break; if (_sp > XB_SPIN_CAP) { atomicAdd(&(bar)[XB_TMO], 1u); break; } } } } while (0)
struct XcdBarrier { unsigned* bar; unsigned x; volatile LAS unsigned* st; };
DI XcdBarrier xcd_barrier_post(unsigned* bar, volatile LAS unsigned* st) {
  XcdBarrier b; b.bar = bar; b.x = xb_xcc_id(); b.st = st;
  if (threadIdx.x == 0) (void)xb_add(&bar[XB_XCNT(b.x)], 1u);
  return b;
}
DI void xcd_barrier_complete(unsigned* bar, unsigned x, unsigned& nloc, unsigned& nx) {
  const unsigned G = gridDim.x * gridDim.y * gridDim.z;
  unsigned sum, cnt, mine, sp = 0u;
  for (;;) {
    sum = 0u; cnt = 0u; mine = 0u;
#pragma unroll
    for (unsigned j = 0; j < 16; ++j) { const unsigned c = xb_ld(&bar[XB_XCNT(j)]); sum += c; cnt += (c > 0u) ? 1u : 0u; mine = (j == x) ? c : mine; }
    if (sum == G) break;
    __builtin_amdgcn_s_sleep(1);
    if ((++sp & 255u) == 0u) { if (xb_ld(&bar[XB_TMO])) break; if (sp > XB_SPIN_CAP) { atomicAdd(&bar[XB_TMO], 1u); break; } }
  }
  nloc = mine > 0u ? mine : 1u; nx = cnt > 0u ? cnt : 1u;
}
DI void xcd_barrier(const XcdBarrier& b) {
  asm volatile("s_waitcnt vmcnt(0)" ::: "memory");
  __syncthreads();
  if (threadIdx.x == 0) {
    unsigned* bar = b.bar;
    asm volatile("" : "+s"(bar));
    __builtin_amdgcn_s_waitcnt(0);
    unsigned nloc = b.st[0], nx = b.st[1];
    if (nloc == 0u) { xcd_barrier_complete(bar, b.x, nloc, nx); b.st[0] = nloc; b.st[1] = nx; }
    const unsigned old = xb_add(&bar[XB_XSUB(b.x)], 1u);
    const unsigned gen = old / nloc;
    if (old + 1u == (gen + 1u) * nloc) {
      __builtin_amdgcn_fence(__ATOMIC_RELEASE, "agent");
      asm volatile("s_waitcnt vmcnt(0)" ::: "memory");
      const unsigned og = xb_add(&bar[XB_TOP], 1u);
      const unsigned tg = og / nx;
      if (og + 1u == (tg + 1u) * nx) xb_add(&bar[XB_TOPGEN], 1u);
      else XB_SPIN(xb_ld(&bar[XB_TOPGEN]) == tg, bar);
      __builtin_amdgcn_fence(__ATOMIC_ACQUIRE, "agent");
      xb_add(&bar[XB_XGEN(b.x)], 1u);
      asm volatile("s_waitcnt vmcnt(0)" ::: "memory");
    } else {
      XB_SPIN(xb_ld(&bar[XB_XGEN(b.x)]) == gen, bar);
      __builtin_amdgcn_fence(__ATOMIC_ACQUIRE, "agent");
      asm volatile("s_waitcnt vmcnt(0)" ::: "memory");
    }
  }
  __syncthreads();
}

constexpr int SMEM_BYTES = 2 * GBUF * 2;
enum { PH_PREP0 = 0, PH_H0, PH_INPROJ, PH_PREP, PH_QKV, PH_ATT, PH_SSDOUT, PH_WOUT, PH_POSTMIX, PH_FF1, PH_FF2, PH_POSTFFN, PH_SSDNORM };

struct Ids { int bid, nb, vbid, nvb, lid; };
DI void run_phase(const Params& p, int ph, int layer, const Ids& id, char* smem, char* sh) {
  switch (ph) {
    case PH_PREP0: phase_prep0(p, id.vbid, id.nvb, sh); break;
    case PH_H0: phase_h0(p, id.vbid, id.nvb); break;
    case PH_INPROJ: phase_inproj(p, layer, id.bid, id.nb, id.vbid, id.nvb, smem, sh); break;
    case PH_PREP: phase_prep(p, layer, id.vbid, id.nvb); break;
    case PH_QKV: phase_qkv(p, layer, id.vbid, id.nvb, sh); break;
    case PH_ATT: phase_att(p, layer, id.bid, id.nb, id.vbid, id.nvb, smem, sh); break;
    case PH_SSDOUT: phase_ssdout(p, layer, id.vbid, id.nvb, sh); break;
    case PH_WOUT: phase_wout(p, layer, id.lid, id.nvb, sh); break;
    case PH_POSTMIX: phase_postmix(p, layer, id.vbid, id.nvb); break;
    case PH_FF1: phase_ff1(p, layer, id.bid, id.nb, id.vbid, id.nvb, smem, sh); break;
    case PH_FF2: phase_ff2(p, layer, id.bid, id.nb, id.vbid, id.nvb, smem, sh); break;
    case PH_POSTFFN: phase_postffn(p, layer, id.vbid, id.nvb); break;
  }
}

__global__ void __launch_bounds__(512) mega_kernel(Params p) {
  extern __shared__ __attribute__((aligned(16))) char smem[];
  cg::grid_group grid = cg::this_grid();
  if (p.ws == nullptr) grid.sync();
  const int half = __builtin_amdgcn_readfirstlane((int)(threadIdx.x >> 8));
  Ids id;
  id.bid = blockIdx.x; id.nb = gridDim.x;
  id.vbid = 2 * id.bid + half; id.nvb = 2 * id.nb;
  id.lid = (id.bid & 7) + 8 * (2 * (id.bid >> 3) + half);
  char* sh = smem + half * SMEM_BYTES;
  volatile LAS unsigned* st = (volatile LAS unsigned*)(smem + 2 * SMEM_BYTES - 16);
  if (threadIdx.x == 0) { st[0] = 0u; st[1] = 0u; st[2] = 0u; st[3] = 0u; }
  __syncthreads();
  XcdBarrier xb = xcd_barrier_post((unsigned*)(p.ws + OFF_BAR), st);
#define MK_STEP(PH, LAYER, LAST) do { \
    typedef const void* __attribute__((address_space(4))) * KArgs; \
    KArgs ka = (KArgs)__builtin_amdgcn_kernarg_segment_ptr(); \
    asm volatile("" : "+s"(ka)); \
    Params q; \
    { const void** dst = (const void**)&q; _Pragma("unroll") for (int i = 0; i < 27; ++i) dst[i] = ka[i]; } \
    run_phase(q, PH, LAYER, id, smem, sh); \
    if (!(LAST)) xcd_barrier(xb); } while (0)
  MK_STEP(PH_PREP0, 0, false);
  MK_STEP(PH_H0, 0, false);
  MK_STEP(PH_INPROJ, 0, false); MK_STEP(PH_PREP, 0, false); MK_STEP(PH_QKV, 0, false); MK_STEP(PH_ATT, 0, false); MK_STEP(PH_SSDOUT, 0, false);
  MK_STEP(PH_WOUT, 0, false); MK_STEP(PH_POSTMIX, 0, false); MK_STEP(PH_FF1, 0, false); MK_STEP(PH_FF2, 0, false); MK_STEP(PH_POSTFFN, 0, false);
  MK_STEP(PH_INPROJ, 1, false); MK_STEP(PH_PREP, 1, false); MK_STEP(PH_QKV, 1, false); MK_STEP(PH_ATT, 1, false); MK_STEP(PH_SSDOUT, 1, false);
  MK_STEP(PH_WOUT, 1, false); MK_STEP(PH_POSTMIX, 1, false); MK_STEP(PH_FF1, 1, false); MK_STEP(PH_FF2, 1, false); MK_STEP(PH_POSTFFN, 1, true);
#undef MK_STEP
}

extern "C" void kernel_launch(void* const* d_in, const int* in_sizes, int n_in, void* d_out, int out_size, void* d_ws, size_t ws_size,
                              hipStream_t stream) {
  if (ws_size < WS_NEED) { fprintf(stderr, "workspace too small: %zu < %zu\n", ws_size, (size_t)WS_NEED); return; }
  Params p{};
  const float** f = (const float**)&p;
  for (int i = 0; i < 25; ++i) f[i] = (const float*)d_in[i];
  p.out = (float*)d_out;
  p.ws = (char*)d_ws;
  static int grid_blocks = 0;
  if (!grid_blocks) {
    int dev = 0, cus = 0, per_cu = 0;
    hipGetDevice(&dev);
    hipDeviceGetAttribute(&cus, hipDeviceAttributeMultiprocessorCount, dev);
    hipFuncSetAttribute((const void*)mega_kernel, hipFuncAttributeMaxDynamicSharedMemorySize, 2 * SMEM_BYTES);
    hipOccupancyMaxActiveBlocksPerMultiprocessor(&per_cu, mega_kernel, 512, 2 * SMEM_BYTES);
    if (per_cu > 1) per_cu = 1;
    grid_blocks = cus * per_cu;
  }
  hipMemsetAsync((char*)d_ws + OFF_BAR, 0, XCD_BAR_WORDS * 4, stream);
  void* args[] = {&p};
  hipError_t e = hipLaunchCooperativeKernel((void*)mega_kernel, dim3(grid_blocks), dim3(512), args, 2 * SMEM_BYTES, stream);
  if (e != hipSuccess) fprintf(stderr, "cooperative launch failed: %s (grid %d)\n", hipGetErrorString(e), grid_blocks);
}
```

```cpp
#include <hip/hip_runtime.h>
#include <hip/hip_cooperative_groups.h>
#include <stdint.h>
#include <stdio.h>
namespace cg = cooperative_groups;

#ifndef MEGA
#define MEGA 1
#endif
#ifndef REP_GEMM
#define REP_GEMM 1
#endif
#ifndef REP_ATT
#define REP_ATT 1
#endif
#ifndef REP_SSD
#define REP_SSD 1
#endif

typedef unsigned short bf16_t;
using bf16x8 = __attribute__((ext_vector_type(8))) short;
using s16x4  = __attribute__((ext_vector_type(4))) short;
using f32x4  = __attribute__((ext_vector_type(4))) float;
using f32x16 = __attribute__((ext_vector_type(16))) float;
using u32x4  = __attribute__((ext_vector_type(4))) unsigned;
using u32x2  = __attribute__((ext_vector_type(2))) unsigned;
#define DI __device__ __forceinline__
#define MFMA32(a, b, c) __builtin_amdgcn_mfma_f32_32x32x16_bf16((a), (b), (c), 0, 0, 0)
#define MFMA16(a, b, c) __builtin_amdgcn_mfma_f32_16x16x32_bf16((a), (b), (c), 0, 0, 0)

constexpr int DM = 1024, NB = 4, SEQ = 4096, CTX = 256;
constexpr int ML = NB * SEQ;
constexpr int MC = NB * CTX;
constexpr int MT = ML + MC;
constexpr int DIN = 2480, DINP = 2560;
constexpr int LK = CTX + SEQ;
constexpr int DFF = 4096;
constexpr int NCH = 34;
constexpr float EPS = 1e-6f;
constexpr int U_CKV = 256, U_KR = 384, U_GB = 416, U_GC = 672, U_VAL = 928, U_Z = 1184, U_XBC = 1696, U_DT = 2464;

constexpr size_t AL(size_t x) { return (x + 255) & ~(size_t)255; }
constexpr size_t WT_IN = 0;
constexpr size_t WT_UQ = WT_IN + (size_t)DINP * 1024;
constexpr size_t WT_UKV = WT_UQ + (size_t)384 * 256;
constexpr size_t WT_OUT = WT_UKV + (size_t)512 * 128;
constexpr size_t WT_FF1 = WT_OUT + (size_t)1024 * 1024;
constexpr size_t WT_FF2 = WT_FF1 + (size_t)4096 * 1024;
constexpr size_t WT_ELEMS = WT_FF2 + (size_t)4096 * 1024;
constexpr size_t OFF_WT = 0;
constexpr size_t OFF_MOD = AL(OFF_WT + 2 * WT_ELEMS * 2);
constexpr size_t OFF_XC = AL(OFF_MOD + 2 * 5 * 6144 * 4);
constexpr size_t OFF_H = AL(OFF_XC + (size_t)MC * DM * 4);
constexpr size_t OFF_R1 = AL(OFF_H + (size_t)MT * DM * 2);
constexpr size_t OFF_U = OFF_R1;
constexpr size_t OFF_DT = AL(OFF_U + (size_t)MT * DIN * 2);
constexpr size_t OFF_RSTD = AL(OFF_DT + (size_t)MT * 16 * 4);
constexpr size_t OFF_QB = AL(OFF_RSTD + (size_t)MT * 2 * 4);
constexpr size_t OFF_KB = AL(OFF_QB + (size_t)MT * 384 * 2);
constexpr size_t OFF_VT = AL(OFF_KB + (size_t)NB * 4 * LK * 96 * 2);
constexpr size_t OFF_XBC = AL(OFF_VT + (size_t)NB * 4 * 64 * LK * 2);
constexpr size_t OFF_SST = AL(OFF_XBC + (size_t)MT * 768 * 2);
constexpr size_t OFF_TDEC = AL(OFF_SST + (size_t)2 * NB * NCH * 8 * 4096 * 2);
constexpr size_t OFF_SSQ = AL(OFF_TDEC + (size_t)2 * NB * NCH * 8 * 4);
constexpr size_t OFF_END1 = AL(OFF_SSQ + (size_t)MT * 8 * 4);
constexpr size_t OFF_F1 = OFF_R1;
constexpr size_t OFF_END2 = AL(OFF_F1 + (size_t)MT * DFF * 2);
constexpr size_t OFF_BAR = OFF_END1 > OFF_END2 ? OFF_END1 : OFF_END2;
constexpr size_t WS_NEED = OFF_BAR + 16384;

struct Params {
  const float *x, *c, *ctx, *c_ctx, *w_mod, *b_mod, *g_pre_mix, *w_in, *q_norm, *w_uq, *kv_norm, *w_ukv, *sc_w, *ssd_cw, *ssd_cb,
      *a_log, *dt_bias, *ssd_d, *ssd_norm, *w_out, *g_post_mix, *g_pre_ffn, *w_ff1, *w_ff2, *g_post_ffn;
  float* out;
  char* ws;
};

DI int ltid() { int t = threadIdx.x; asm volatile("" : "+v"(t)); return t & 255; }
DI int ltid512() { int t = threadIdx.x; asm volatile("" : "+v"(t)); return t; }
typedef __bf16 hbf2 __attribute__((ext_vector_type(2)));
typedef float hf2 __attribute__((ext_vector_type(2)));
DI bf16_t f2bf(float x) { return __builtin_bit_cast(bf16_t, (__bf16)x); }
DI float bf2f(unsigned v) { return __uint_as_float(v << 16); }
DI unsigned pack2(float a, float b) { hf2 v = {a, b}; return __builtin_bit_cast(unsigned, __builtin_convertvector(v, hbf2)); }
DI float lo2f(unsigned w) { return __uint_as_float(w << 16); }
DI float hi2f(unsigned w) { return __uint_as_float(w & 0xffff0000u); }
DI float wave_sum(float v) {
#pragma unroll
  for (int o = 32; o > 0; o >>= 1) v += __shfl_xor(v, o);
  return v;
}
DI float silu_f(float x) { return x / (1.f + __expf(-x)); }
DI int crow(int reg, int h) { return (reg & 3) + 8 * (reg >> 2) + 4 * h; }
DI bf16x8 pack8(const f32x16& x, int s) {
  u32x4 p;
  p[0] = pack2(x[8 * s + 0], x[8 * s + 1]); p[1] = pack2(x[8 * s + 2], x[8 * s + 3]);
  p[2] = pack2(x[8 * s + 4], x[8 * s + 5]); p[3] = pack2(x[8 * s + 6], x[8 * s + 7]);
  return __builtin_bit_cast(bf16x8, p);
}
DI const float* xin_row(const Params& p, int layer, int row) {
  if (layer == 0) return row < ML ? p.x + (size_t)row * DM : p.ctx + (size_t)(row - ML) * DM;
  return row < ML ? p.out + (size_t)row * DM : (const float*)(p.ws + OFF_XC) + (size_t)(row - ML) * DM;
}
DI float* xst_row(const Params& p, int row) {
  return row < ML ? p.out + (size_t)row * DM : (float*)(p.ws + OFF_XC) + (size_t)(row - ML) * DM;
}
DI const float* mod_ptr(const Params& p, int layer, int row, int which) {
  int bb = row < ML ? (row >> 12) : 4;
  return (const float*)(p.ws + OFF_MOD) + ((size_t)(layer * 5 + bb) * 6 + which) * DM;
}
DI bf16_t* wt_ptr(const Params& p, int layer, size_t off) { return (bf16_t*)(p.ws + OFF_WT) + (size_t)layer * WT_ELEMS + off; }

DI void transpose_item(const float* __restrict__ w, const float* __restrict__ gk, int gk_from, bf16_t* __restrict__ wt, int K, int N, int kt, int nt, char* smem) {
  float* tile = (float*)smem;
  const int tid = ltid(), tx = tid & 63, ty = tid >> 6;
  const int k0 = kt * 64, n0 = nt * 64;
  const int n = n0 + tx;
  float v[16];
#pragma unroll
  for (int i = 0; i < 16; ++i) {
    int kk = ty + 4 * i;
    v[i] = n < N ? w[(size_t)(k0 + kk) * N + n] : 0.f;
  }
  if (gk) {
#pragma unroll
    for (int i = 0; i < 16; ++i) { int k = k0 + ty + 4 * i; if (k >= gk_from) v[i] *= gk[k - gk_from]; }
  }
#pragma unroll
  for (int i = 0; i < 16; ++i) tile[(ty + 4 * i) * 65 + tx] = v[i];
  __syncthreads();
#pragma unroll
  for (int i = 0; i < 2; ++i) {
    int c = tid + 256 * i, nn = c >> 3, kc = c & 7;
    u32x4 o;
#pragma unroll
    for (int jj = 0; jj < 4; ++jj) o[jj] = pack2(tile[(kc * 8 + 2 * jj) * 65 + nn], tile[(kc * 8 + 2 * jj + 1) * 65 + nn]);
    *(u32x4*)(wt + (size_t)(n0 + nn) * K + k0 + kc * 8) = o;
  }
  __syncthreads();
}

DI void modgemv_item(const Params& p, int layer, int ct, char* smem) {
  float* s = (float*)smem;
  float* red = s + 5 * 1024;
  const int tid = ltid(), w = tid >> 6, lane = tid & 63, ln = lane & 31, kh = lane >> 5;
  for (int i = tid; i < 5 * 1024; i += 256) {
    int bb = i >> 10, k = i & 1023;
    float v = bb < 4 ? p.c[bb * 1024 + k] : p.c_ctx[k];
    s[i] = silu_f(v);
  }
  __syncthreads();
  const float* wm = p.w_mod + (size_t)layer * 1024 * 6144;
  const int n = ct * 32 + ln;
  float acc[5] = {0.f, 0.f, 0.f, 0.f, 0.f};
#pragma unroll 16
  for (int i = 0; i < 128; ++i) {
    const int k = w * 256 + 2 * i + kh;
    float wv = wm[(size_t)k * 6144 + n];
#pragma unroll
    for (int bb = 0; bb < 5; ++bb) acc[bb] += s[bb * 1024 + k] * wv;
  }
#pragma unroll
  for (int bb = 0; bb < 5; ++bb) {
    acc[bb] += __shfl_xor(acc[bb], 32);
    if (kh == 0) red[(w * 5 + bb) * 32 + ln] = acc[bb];
  }
  __syncthreads();
  if (tid < 160) {
    int bb = tid >> 5, l2 = tid & 31;
    float v = red[(0 * 5 + bb) * 32 + l2] + red[(1 * 5 + bb) * 32 + l2] + red[(2 * 5 + bb) * 32 + l2] + red[(3 * 5 + bb) * 32 + l2];
    int nn = ct * 32 + l2;
    v += p.b_mod[layer * 6144 + nn];
    ((float*)(p.ws + OFF_MOD))[(size_t)(layer * 5 + bb) * 6144 + nn] = v;
  }
  __syncthreads();
}

constexpr int WT_ITEMS = 2984;
DI void wt_item(const Params& p, int layer, int j, char* smem) {
  if (j < 640) transpose_item(p.w_in + (size_t)layer * 1024 * DIN, nullptr, 0, wt_ptr(p, layer, WT_IN), 1024, DIN, j / 40, j % 40, smem);
  else if ((j -= 640) < 24) transpose_item(p.w_uq + (size_t)layer * 256 * 384, p.q_norm + layer * 256, 0, wt_ptr(p, layer, WT_UQ), 256, 384, j / 6, j % 6, smem);
  else if ((j -= 24) < 16) transpose_item(p.w_ukv + (size_t)layer * 128 * 512, p.kv_norm + layer * 128, 0, wt_ptr(p, layer, WT_UKV), 128, 512, j / 8, j % 8, smem);
  else if ((j -= 16) < 256) transpose_item(p.w_out + (size_t)layer * 1024 * 1024, p.ssd_norm + layer * 512, 512, wt_ptr(p, layer, WT_OUT), 1024, 1024, j / 16, j % 16, smem);
  else if ((j -= 256) < 1024) transpose_item(p.w_ff1 + (size_t)layer * 1024 * 4096, nullptr, 0, wt_ptr(p, layer, WT_FF1), 1024, 4096, j / 64, j % 64, smem);
  else { j -= 1024; transpose_item(p.w_ff2 + (size_t)layer * 4096 * 1024, nullptr, 0, wt_ptr(p, layer, WT_FF2), 4096, 1024, j / 16, j % 16, smem); }
}
DI void phase_prep0(const Params& p, int bid, int nb, char* smem) {
  for (int it = bid; it < 384 + 640; it += nb) {
    if (it < 384) modgemv_item(p, it / 192, it % 192, smem);
    else wt_item(p, 0, it - 384, smem);
  }
}
struct HMod { float4 g[4], s1[4], s0[4]; };
DI void load_hmod(HMod& m, const float* g, const float* sh, const float* sc, int lane) {
#pragma unroll
  for (int i = 0; i < 4; ++i) {
    const int col = lane * 4 + 256 * i;
    m.g[i] = *(const float4*)(g + col); m.s1[i] = *(const float4*)(sc + col); m.s0[i] = *(const float4*)(sh + col);
  }
}
DI void write_h_row(const float4 xv[4], float rstd, const HMod& m, bf16_t* hrow, int lane) {
#pragma unroll
  for (int i = 0; i < 4; ++i) {
    const int col = lane * 4 + 256 * i;
    float a = xv[i].x * rstd * m.g[i].x * (1.f + m.s1[i].x) + m.s0[i].x;
    float b = xv[i].y * rstd * m.g[i].y * (1.f + m.s1[i].y) + m.s0[i].y;
    float c = xv[i].z * rstd * m.g[i].z * (1.f + m.s1[i].z) + m.s0[i].z;
    float d = xv[i].w * rstd * m.g[i].w * (1.f + m.s1[i].w) + m.s0[i].w;
    u32x2 o; o[0] = pack2(a, b); o[1] = pack2(c, d);
    *(u32x2*)(hrow + col) = o;
  }
}
DI float ssq4(const float4 v[4]) {
  float s = 0.f;
#pragma unroll
  for (int i = 0; i < 4; ++i) s += v[i].x * v[i].x + v[i].y * v[i].y + v[i].z * v[i].z + v[i].w * v[i].w;
  return s;
}
DI void load_bf_row(const bf16_t* r, int lane, float4 v[4]) {
#pragma unroll
  for (int i = 0; i < 4; ++i) {
    u32x2 t = *(const u32x2*)(r + lane * 4 + 256 * i);
    v[i] = make_float4(lo2f(t[0]), hi2f(t[0]), lo2f(t[1]), hi2f(t[1]));
  }
}

struct RowVec { float4 c1[4], c2[4], c3[4]; };
DI const float* mod_ptr_b(const Params& p, int layer, int bb, int which) {
  return (const float*)(p.ws + OFF_MOD) + ((size_t)(layer * 5 + bb) * 6 + which) * DM;
}
template <int MODE>
DI void rowwise_phase(const Params& p, int layer, int bid, int nb) {
  const int w = ltid() >> 6, lane = ltid() & 63;
  const int M = (MODE == 0 || layer == 0) ? MT : ML;
  const bool wh = MODE != 2 || layer == 0;
  bf16_t* H = (bf16_t*)(p.ws + OFF_H);
  const bf16_t* Y = MODE == 1 ? (const bf16_t*)(p.ws + OFF_U) : (const bf16_t*)(p.ws + OFF_H);
  const int NW = nb * 4, W = bid * 4 + w, nwb = NW >> 2;
  auto load_vec = [&](RowVec& v, int bb) {
    const float* gate = MODE == 1 ? mod_ptr_b(p, layer, bb, 2) : mod_ptr_b(p, layer, bb, 5);
    const float* gres = MODE == 1 ? p.g_post_mix + layer * DM : p.g_post_ffn + layer * DM;
    const int hl = MODE == 2 ? 1 : layer;
    const float* gn = MODE == 1 ? p.g_pre_ffn + layer * DM : p.g_pre_mix + hl * DM;
    const float* sh = mod_ptr_b(p, hl, bb, MODE == 1 ? 3 : 0);
    const float* sc = mod_ptr_b(p, hl, bb, MODE == 1 ? 4 : 1);
#pragma unroll
    for (int i = 0; i < 4; ++i) {
      const int col = lane * 4 + 256 * i;
      if (MODE != 0) {
        const float4 a = *(const float4*)(gate + col), b = *(const float4*)(gres + col);
        v.c1[i] = make_float4(a.x * b.x, a.y * b.y, a.z * b.z, a.w * b.w);
      }
      if (wh) {
        const float4 g = *(const float4*)(gn + col), s1 = *(const float4*)(sc + col);
        v.c2[i] = make_float4(g.x * (1.f + s1.x), g.y * (1.f + s1.y), g.z * (1.f + s1.z), g.w * (1.f + s1.w));
        v.c3[i] = *(const float4*)(sh + col);
      }
    }
  };
  struct RowIn { u32x2 y[4]; float4 x[4]; };
  auto load_row = [&](RowIn& r, int row) {
    const float* xr = MODE == 2 ? (const float*)xst_row(p, row) : xin_row(p, layer, row);
#pragma unroll
    for (int i = 0; i < 4; ++i) {
      r.x[i] = *(const float4*)(xr + lane * 4 + 256 * i);
      if (MODE != 0) r.y[i] = *(const u32x2*)(Y + (size_t)row * DM + lane * 4 + 256 * i);
    }
  };
  auto finish = [&](float4 (&xv)[4], const float4 (&yv)[4], const RowVec& v, int row) {
    if (MODE != 0) {
      const float rstd = rsqrtf(wave_sum(ssq4(yv)) * (1.f / DM) + EPS);
#pragma unroll
      for (int i = 0; i < 4; ++i) {
        xv[i].x += yv[i].x * rstd * v.c1[i].x; xv[i].y += yv[i].y * rstd * v.c1[i].y;
        xv[i].z += yv[i].z * rstd * v.c1[i].z; xv[i].w += yv[i].w * rstd * v.c1[i].w;
      }
      float* xo = xst_row(p, row);
#pragma unroll
      for (int i = 0; i < 4; ++i) *(float4*)(xo + lane * 4 + 256 * i) = xv[i];
    }
    if (wh) {
      const float rstd1 = rsqrtf(wave_sum(ssq4(xv)) * (1.f / DM) + EPS);
      bf16_t* hrow = H + (size_t)row * DM;
#pragma unroll
      for (int i = 0; i < 4; ++i) {
        u32x2 o;
        o[0] = pack2(xv[i].x * rstd1 * v.c2[i].x + v.c3[i].x, xv[i].y * rstd1 * v.c2[i].y + v.c3[i].y);
        o[1] = pack2(xv[i].z * rstd1 * v.c2[i].z + v.c3[i].z, xv[i].w * rstd1 * v.c2[i].w + v.c3[i].w);
        *(u32x2*)(hrow + lane * 4 + 256 * i) = o;
      }
    }
  };
  auto process = [&](RowIn& r, const RowVec& v, int row) {
    float4 yv[4];
#pragma unroll
    for (int i = 0; i < 4; ++i) yv[i] = make_float4(lo2f(r.y[i][0]), hi2f(r.y[i][0]), lo2f(r.y[i][1]), hi2f(r.y[i][1]));
    finish(r.x, yv, v, row);
  };
  RowVec v;
  {
    const int bb = W / nwb, j = W - bb * nwb, end = SEQ * (bb + 1);
    load_vec(v, bb);
    RowIn ra, rb;
    int row = SEQ * bb + j;
    if (row < end) load_row(ra, row);
    while (row < end) {
      const int rowb = row + nwb;
      const bool hb = rowb < end;
      if (hb) load_row(rb, rowb);
      process(ra, v, row);
      if (!hb) break;
      const int rowa = rowb + nwb;
      const bool ha = rowa < end;
      if (ha) load_row(ra, rowa);
      process(rb, v, rowb);
      if (!ha) break;
      row = rowa;
    }
  }
  if (M > ML) {
    load_vec(v, 4);
    for (int row = ML + W; row < M; row += NW) {
      float4 xv[4], yv[4];
      const float* xr = MODE == 2 ? (const float*)xst_row(p, row) : xin_row(p, layer, row);
#pragma unroll
      for (int i = 0; i < 4; ++i) xv[i] = *(const float4*)(xr + lane * 4 + 256 * i);
      if (MODE == 1) load_bf_row(Y + (size_t)row * DM, lane, yv);
      if (MODE == 2) {
        const float* pp = (const float*)(p.ws + OFF_END2) + (size_t)(row - ML) * DM;
#pragma unroll
        for (int i = 0; i < 4; ++i) {
          float4 a = *(const float4*)(pp + lane * 4 + 256 * i), b = *(const float4*)(pp + (size_t)MC * DM + lane * 4 + 256 * i);
          float4 c = *(const float4*)(pp + (size_t)2 * MC * DM + lane * 4 + 256 * i), d = *(const float4*)(pp + (size_t)3 * MC * DM + lane * 4 + 256 * i);
          yv[i] = make_float4((a.x + b.x) + (c.x + d.x), (a.y + b.y) + (c.y + d.y), (a.z + b.z) + (c.z + d.z), (a.w + b.w) + (c.w + d.w));
        }
      }
      finish(xv, yv, v, row);
    }
  }
}
DI void phase_h0(const Params& p, int bid, int nb) { rowwise_phase<0>(p, 0, bid, nb); }
DI void phase_postmix(const Params& p, int layer, int bid, int nb) { rowwise_phase<1>(p, layer, bid, nb); }
DI void phase_postffn(const Params& p, int layer, int bid, int nb) { rowwise_phase<2>(p, layer, bid, nb); }

DI void phase_prep(const Params& p, int layer, int bid, int nb) {
  const int w = ltid() >> 6, lane = ltid() & 63;
  const bf16_t* U = (const bf16_t*)(p.ws + OFF_U);
  float* DT = (float*)(p.ws + OFF_DT);
  float* RS = (float*)(p.ws + OFF_RSTD);
  bf16_t* KB = (bf16_t*)(p.ws + OFF_KB);
  bf16_t* XBC = (bf16_t*)(p.ws + OFF_XBC);
  bf16_t* YM = (bf16_t*)(p.ws + OFF_H);
  const float* scw = p.sc_w + layer * 3 * 256;
  const float* cw = p.ssd_cw + layer * 3 * 768;
  const float* cb = p.ssd_cb + layer * 768;
  const int c4 = lane * 4;
  const float4 sw0 = *(const float4*)(scw + c4), sw1 = *(const float4*)(scw + 256 + c4), sw2 = *(const float4*)(scw + 512 + c4);
  float4 cwk[3][3], cbi[3];
#pragma unroll
  for (int i = 0; i < 3; ++i) {
    cbi[i] = *(const float4*)(cb + c4 + 256 * i);
#pragma unroll
    for (int k = 0; k < 3; ++k) cwk[i][k] = *(const float4*)(cw + k * 768 + c4 + 256 * i);
  }
  const float dtb = p.dt_bias[layer * 16 + (lane & 15)];
  const float invf = exp2f(-(float)(2 * (lane & 7)) * (13.287712379549449f / 16.f));
  for (int row = bid * 4 + w; row < MT; row += nb * 4) {
    int b, t, L, pos;
    const bool lat = row < ML;
    if (lat) { b = row >> 12; t = row & 4095; L = SEQ; pos = t + CTX; }
    else { int rr = row - ML; b = rr >> 8; t = rr & 255; L = CTX; pos = t; }
    const bf16_t* u0 = U + (size_t)row * DIN;
    const bool hp = t > 0, hn = t < L - 1;
    const bf16_t* um = hp ? u0 - DIN : u0;
    const bf16_t* up = hn ? u0 + DIN : u0;
    const float mp = hp ? 1.f : 0.f, mn = hn ? 1.f : 0.f;
    const u32x2 vq = *(const u32x2*)(u0 + c4);
    const u32x2 vkv = *(const u32x2*)(u0 + U_CKV + (lane & 31) * 4);
    const float kr = bf2f(u0[U_KR + (lane & 31)]);
    const u32x2 gcm = *(const u32x2*)(um + U_GC + c4), gc0 = *(const u32x2*)(u0 + U_GC + c4), gcp = *(const u32x2*)(up + U_GC + c4);
    const u32x2 vvm = *(const u32x2*)(um + U_VAL + c4), vv0 = *(const u32x2*)(u0 + U_VAL + c4), vvp = *(const u32x2*)(up + U_VAL + c4);
    const u32x2 gb = *(const u32x2*)(u0 + U_GB + c4);
    u32x2 xm[3], x0[3], xp[3];
#pragma unroll
    for (int i = 0; i < 3; ++i) {
      xm[i] = *(const u32x2*)(um + U_XBC + c4 + 256 * i);
      x0[i] = *(const u32x2*)(u0 + U_XBC + c4 + 256 * i);
      xp[i] = *(const u32x2*)(up + U_XBC + c4 + 256 * i);
    }
    const float dtr = DT[(size_t)row * 16 + (lane & 15)];
    {
      float a = lo2f(vq[0]), bq = hi2f(vq[0]), c = lo2f(vq[1]), d = hi2f(vq[1]);
      float ss = wave_sum(a * a + bq * bq + c * c + d * d);
      float e = lo2f(vkv[0]), f = hi2f(vkv[0]), g = lo2f(vkv[1]), h = hi2f(vkv[1]);
      float s2 = lane < 32 ? e * e + f * f + g * g + h * h : 0.f;
      s2 = wave_sum(s2);
      if (lane == 0) { RS[row * 2] = rsqrtf(ss * (1.f / 256) + EPS); RS[row * 2 + 1] = rsqrtf(s2 * (1.f / 128) + EPS); }
    }
    {
      const float partner = __shfl_xor(kr, 8);
      float o = kr;
      if (lat) {
        const int grp = (lane & 31) >> 3;
        const float posf = grp < 2 ? (float)(t >> 6) : (float)(t & 63);
        const float rev = posf * invf * 0.15915494309189535f;
        const float cs = __builtin_amdgcn_cosf(rev), sn = __builtin_amdgcn_sinf(rev);
        o = (grp & 1) ? kr * cs + partner * sn : kr * cs - partner * sn;
      }
      if (lane < 32) {
        const bf16_t ob = f2bf(o);
#pragma unroll
        for (int hd = 0; hd < 4; ++hd) KB[((size_t)(b * 4 + hd) * LK + pos) * 96 + 64 + lane] = ob;
      }
    }
    {
      float a0 = sw1.x * lo2f(gc0[0]) * lo2f(vv0[0]) + mp * sw0.x * lo2f(gcm[0]) * lo2f(vvm[0]) + mn * sw2.x * lo2f(gcp[0]) * lo2f(vvp[0]);
      float a1 = sw1.y * hi2f(gc0[0]) * hi2f(vv0[0]) + mp * sw0.y * hi2f(gcm[0]) * hi2f(vvm[0]) + mn * sw2.y * hi2f(gcp[0]) * hi2f(vvp[0]);
      float a2 = sw1.z * lo2f(gc0[1]) * lo2f(vv0[1]) + mp * sw0.z * lo2f(gcm[1]) * lo2f(vvm[1]) + mn * sw2.z * lo2f(gcp[1]) * lo2f(vvp[1]);
      float a3 = sw1.w * hi2f(gc0[1]) * hi2f(vv0[1]) + mp * sw0.w * hi2f(gcm[1]) * hi2f(vvm[1]) + mn * sw2.w * hi2f(gcp[1]) * hi2f(vvp[1]);
      u32x2 o; o[0] = pack2(lo2f(gb[0]) * a0, hi2f(gb[0]) * a1); o[1] = pack2(lo2f(gb[1]) * a2, hi2f(gb[1]) * a3);
      *(u32x2*)(YM + (size_t)row * DM + 256 + c4) = o;
    }
#pragma unroll
    for (int i = 0; i < 3; ++i) {
      float a0 = cbi[i].x + cwk[i][1].x * lo2f(x0[i][0]) + mp * cwk[i][0].x * lo2f(xm[i][0]) + mn * cwk[i][2].x * lo2f(xp[i][0]);
      float a1 = cbi[i].y + cwk[i][1].y * hi2f(x0[i][0]) + mp * cwk[i][0].y * hi2f(xm[i][0]) + mn * cwk[i][2].y * hi2f(xp[i][0]);
      float a2 = cbi[i].z + cwk[i][1].z * lo2f(x0[i][1]) + mp * cwk[i][0].z * lo2f(xm[i][1]) + mn * cwk[i][2].z * lo2f(xp[i][1]);
      float a3 = cbi[i].w + cwk[i][1].w * hi2f(x0[i][1]) + mp * cwk[i][0].w * hi2f(xm[i][1]) + mn * cwk[i][2].w * hi2f(xp[i][1]);
      u32x2 o; o[0] = pack2(silu_f(a0), silu_f(a1)); o[1] = pack2(silu_f(a2), silu_f(a3));
      *(u32x2*)(XBC + (size_t)row * 768 + c4 + 256 * i) = o;
    }
    if (lane < 16) {
      const float v = dtr + dtb;
      const float e = __expf(-fabsf(v));
      DT[(size_t)row * 16 + lane] = fmaxf(v, 0.f) + (e < 1e-3f ? e * (1.f - 0.5f * e) : __logf(1.f + e));
    }
  }
}

DI void phase_ssdnorm(const Params& p, int layer, int bid, int nb) {
  const int w = ltid() >> 6, lane = ltid() & 63;
  const int M = layer == 0 ? MT : ML;
  bf16_t* YM = (bf16_t*)(p.ws + OFF_H);
  const float* SSQ = (const float*)(p.ws + OFF_SSQ);
  const float* ng = p.ssd_norm + layer * 512;
  for (int row = bid * 4 + w; row < M; row += nb * 4) {
    int g = lane >> 5;
    float4 s = *(const float4*)(SSQ + (size_t)row * 8 + g * 4);
    float rstd = rsqrtf((s.x + s.y + s.z + s.w) * (1.f / 256) + EPS);
    bf16_t* ptr = YM + (size_t)row * DM + 512 + lane * 8;
    u32x4 v = *(const u32x4*)ptr;
    float4 g0 = *(const float4*)(ng + lane * 8), g1 = *(const float4*)(ng + lane * 8 + 4);
    u32x4 o;
    o[0] = pack2(lo2f(v[0]) * rstd * g0.x, hi2f(v[0]) * rstd * g0.y);
    o[1] = pack2(lo2f(v[1]) * rstd * g0.z, hi2f(v[1]) * rstd * g0.w);
    o[2] = pack2(lo2f(v[2]) * rstd * g1.x, hi2f(v[2]) * rstd * g1.y);
    o[3] = pack2(lo2f(v[3]) * rstd * g1.z, hi2f(v[3]) * rstd * g1.w);
    *(u32x4*)ptr = o;
  }
}

constexpr int GST = 80;
constexpr int GBUF = 2 * 128 * GST;
template <bool GN, class Epi>
DI void gemm_tile(const bf16_t* __restrict__ A, int lda, const bf16_t* __restrict__ Bt, int K, int row0, int col0, char* smem, Epi epi, const float* __restrict__ ssq = nullptr) {
  bf16_t* S0 = (bf16_t*)smem;
  const int tid = ltid(), wid = tid >> 6, lane = tid & 63, wr = wid >> 1, wc = wid & 1, fr = lane & 15, fq = lane >> 4;
  f32x4 acc[4][4];
#pragma unroll
  for (int m = 0; m < 4; ++m)
#pragma unroll
    for (int n = 0; n < 4; ++n) acc[m][n] = f32x4{0.f, 0.f, 0.f, 0.f};
  u32x4 ra[4], rb[4];
  const int sr = tid >> 3, sp = tid & 7;
  const bf16_t* ga = A + (size_t)(row0 + sr) * lda + sp * 8;
  const bf16_t* gb = Bt + (size_t)(col0 + sr) * K + sp * 8;
  auto gload = [&](int k0) {
#pragma unroll
    for (int i = 0; i < 4; ++i) {
      ra[i] = *(const u32x4*)(ga + (size_t)(32 * i) * lda + k0);
      rb[i] = *(const u32x4*)(gb + (size_t)(32 * i) * K + k0);
    }
  };
  gload(0);
  float gs[4][2];
  if (GN) {
#pragma unroll
    for (int i = 0; i < 4; ++i) {
      const float4 s0 = *(const float4*)(ssq + (size_t)(row0 + sr + 32 * i) * 8), s1 = *(const float4*)(ssq + (size_t)(row0 + sr + 32 * i) * 8 + 4);
      gs[i][0] = rsqrtf((s0.x + s0.y + s0.z + s0.w) * (1.f / 256) + EPS);
      gs[i][1] = rsqrtf((s1.x + s1.y + s1.z + s1.w) * (1.f / 256) + EPS);
    }
  }
  auto swrite = [&](int kt) {
    if (GN && kt >= 8) {
      const int g = (kt - 8) >> 2;
#pragma unroll
      for (int i = 0; i < 4; ++i) {
        const float sc = g ? gs[i][1] : gs[i][0];
#pragma unroll
        for (int jj = 0; jj < 4; ++jj) ra[i][jj] = pack2(lo2f(ra[i][jj]) * sc, hi2f(ra[i][jj]) * sc);
      }
    }
    bf16_t* As = S0 + (kt & 1) * GBUF;
    bf16_t* Bs = As + 128 * GST;
#pragma unroll
    for (int i = 0; i < 4; ++i) {
      *(u32x4*)(As + (sr + 32 * i) * GST + sp * 8) = ra[i];
      *(u32x4*)(Bs + (sr + 32 * i) * GST + sp * 8) = rb[i];
    }
  };
  const int KT = K / 64;
  swrite(0);
  if (KT > 1) gload(64);
  __syncthreads();
  for (int kt = 0; kt < KT; ++kt) {
    const bf16_t* As = S0 + (kt & 1) * GBUF;
    const bf16_t* Bs = As + 128 * GST;
#pragma unroll
    for (int ks = 0; ks < 2; ++ks) {
      bf16x8 af[4], bfr[4];
#pragma unroll
      for (int m = 0; m < 4; ++m) af[m] = *(const bf16x8*)(As + (wr * 64 + m * 16 + fr) * GST + ks * 32 + fq * 8);
#pragma unroll
      for (int n = 0; n < 4; ++n) bfr[n] = *(const bf16x8*)(Bs + (wc * 64 + n * 16 + fr) * GST + ks * 32 + fq * 8);
#pragma unroll
      for (int m = 0; m < 4; ++m)
#pragma unroll
        for (int n = 0; n < 4; ++n) acc[m][n] = MFMA16(bfr[n], af[m], acc[m][n]);
      if (ks == 0 && kt + 1 < KT) {
        swrite(kt + 1);
        if (kt + 2 < KT) gload((kt + 2) * 64);
      }
    }
    __syncthreads();
  }
  float rsc[4];
#pragma unroll
  for (int m = 0; m < 4; ++m) rsc[m] = epi.scale(row0 + wr * 64 + m * 16 + fr);
#pragma unroll
  for (int m = 0; m < 4; ++m)
#pragma unroll
    for (int n = 0; n < 4; ++n) epi(row0 + wr * 64 + m * 16 + fr, col0 + wc * 64 + n * 16 + fq * 4, acc[m][n], rsc[m]);
}

template <class Epi>
DI void gemm_tile_glds(const bf16_t* __restrict__ A, int lda, const bf16_t* __restrict__ Bt, int ldb, int K, int row0, int col0, char* smem, Epi epi) {
  const int tid = ltid(), wid = tid >> 6, lane = tid & 63, wr = wid >> 1, wc = wid & 1, fr = lane & 15, fq = lane >> 4;
  f32x4 acc[4][4];
#pragma unroll
  for (int m = 0; m < 4; ++m)
#pragma unroll
    for (int n = 0; n < 4; ++n) acc[m][n] = f32x4{0.f, 0.f, 0.f, 0.f};
  const int crow = tid >> 3, cslot = tid & 7, cpart = cslot ^ (crow & 7);
  const bf16_t* ga = A + (size_t)(row0 + crow) * lda + cpart * 8;
  const bf16_t* gb = Bt + (size_t)(col0 + crow) * ldb + cpart * 8;
  auto issue = [&](int kt, int stage) {
    char* sa = smem + stage * 32768 + tid * 16;
#pragma unroll
    for (int i = 0; i < 4; ++i) {
      __builtin_amdgcn_global_load_lds((const unsigned*)(ga + (size_t)(32 * i) * lda + kt * 64), (__attribute__((address_space(3))) unsigned*)(sa + i * 4096), 16, 0, 0);
      __builtin_amdgcn_global_load_lds((const unsigned*)(gb + (size_t)(32 * i) * ldb + kt * 64), (__attribute__((address_space(3))) unsigned*)(sa + 16384 + i * 4096), 16, 0, 0);
    }
  };
  const int KT = K / 64;
  issue(0, 0);
  asm volatile("s_waitcnt vmcnt(0)" ::: "memory");
  __syncthreads();
  const int sw = fr & 7;
  for (int kt = 0; kt < KT; ++kt) {
    if (kt + 1 < KT) issue(kt + 1, (kt + 1) & 1);
    const char* As = smem + (kt & 1) * 32768;
    const char* Bs = As + 16384;
#pragma unroll
    for (int ks = 0; ks < 2; ++ks) {
      bf16x8 af[4], bfr[4];
      const int so = ((ks * 4 + fq) ^ sw) * 16;
#pragma unroll
      for (int m = 0; m < 4; ++m) af[m] = *(const bf16x8*)(As + (wr * 64 + m * 16 + fr) * 128 + so);
#pragma unroll
      for (int n = 0; n < 4; ++n) bfr[n] = *(const bf16x8*)(Bs + (wc * 64 + n * 16 + fr) * 128 + so);
#pragma unroll
      for (int m = 0; m < 4; ++m)
#pragma unroll
        for (int n = 0; n < 4; ++n) acc[m][n] = MFMA16(bfr[n], af[m], acc[m][n]);
    }
    asm volatile("s_waitcnt vmcnt(0)" ::: "memory");
    __syncthreads();
  }
#pragma unroll
  for (int m = 0; m < 4; ++m)
#pragma unroll
    for (int n = 0; n < 4; ++n) epi(row0 + wr * 64 + m * 16 + fr, col0 + wc * 64 + n * 16 + fq * 4, acc[m][n]);
}

constexpr int G8_HT = 128 * 64;
DI int g8_lds_byte(int r, int c) {
  int st = (r >> 4) * 2 + (c >> 5), rr = r & 15, cc = c & 31, ob = rr * 64 + cc * 2;
  return st * 1024 + (ob ^ (((ob >> 9) & 1) << 5));
}
DI void g8_stage_rc(int b, int& R, int& C) {
  int st = b / 1024, sb = b % 1024, swz = sb ^ (((sb >> 9) & 1) << 5);
  R = (st >> 1) * 16 + swz / 64; C = (st & 1) * 32 + (swz % 64) / 2;
}
template <bool GN = false, class Epi>
DI void gemm8_tile(const bf16_t* __restrict__ A, int lda, const bf16_t* __restrict__ Bt, int ldb, int K, int brow, int bcol, char* smem, Epi epi,
                   bool first = true, bool has_next = false, int nbrow = 0, int nbcol = 0, const float* __restrict__ ssq = nullptr) {
  bf16_t* shm = (bf16_t*)smem;
  const int tid = ltid512();
  float* gsl = (float*)(smem + 8 * G8_HT * 2);
  if (GN) {
    if (tid < 256) {
      const float* sp = ssq + (size_t)(brow + tid) * 8;
      const float4 s0 = *(const float4*)sp, s1 = *(const float4*)(sp + 4);
      gsl[tid] = rsqrtf((s0.x + s0.y + s0.z + s0.w) * (1.f / 256) + EPS);
      gsl[256 + tid] = rsqrtf((s1.x + s1.y + s1.z + s1.w) * (1.f / 256) + EPS);
    }
    __syncthreads();
  }
#define G8_SA(b, h) (shm + ((b) * 2 + (h)) * G8_HT)
#define G8_SB(b, h) (shm + (4 + (b) * 2 + (h)) * G8_HT)
#define G8_STAGE(P, BASE, LD, br, kt) do { const bf16_t* _g = (BASE) + (size_t)(br) * (LD) + (size_t)(kt) * 64; \
    _Pragma("unroll") for (int _i = 0; _i < 2; ++_i) { int _b = tid * 16 + _i * 8192; int _r, _c; g8_stage_rc(_b, _r, _c); \
      __builtin_amdgcn_global_load_lds((const unsigned*)(_g + (size_t)_r * (LD) + _c), \
        (__attribute__((address_space(3))) unsigned*)((char*)(P) + _b), 16, 0, 0); } } while (0)
#define G8_LDA(dst, b, h) _Pragma("unroll") for (int m = 0; m < 4; ++m) _Pragma("unroll") for (int k = 0; k < 2; ++k) \
    dst[m][k] = *reinterpret_cast<const bf16x8*>((char*)G8_SA(b, h) + g8_lds_byte(wr * 64 + m * 16 + fr, k * 32 + fq * 8))
#define G8_LDB(dst, b, h) _Pragma("unroll") for (int n = 0; n < 2; ++n) _Pragma("unroll") for (int k = 0; k < 2; ++k) \
    dst[n][k] = *reinterpret_cast<const bf16x8*>((char*)G8_SB(b, h) + g8_lds_byte(wc * 32 + n * 16 + fr, k * 32 + fq * 8))
#define G8_MMA(ai, bj, At, Bx) do { __builtin_amdgcn_s_setprio(1); \
    _Pragma("unroll") for (int m = 0; m < 4; ++m) _Pragma("unroll") for (int n = 0; n < 2; ++n) _Pragma("unroll") for (int k = 0; k < 2; ++k) \
      acc[ai][bj][m][n] = __builtin_amdgcn_mfma_f32_16x16x32_bf16(Bx[n][k], At[m][k], acc[ai][bj][m][n], 0, 0, 0); \
    __builtin_amdgcn_s_setprio(0); } while (0)
#define G8_WAIT_V(n) asm volatile("s_waitcnt vmcnt(" #n ")" ::: "memory")
#define G8_WAIT_L(n) asm volatile("s_waitcnt lgkmcnt(" #n ")" ::: "memory")
#define G8_BAR __builtin_amdgcn_s_barrier()
#define G8_SCHED __builtin_amdgcn_sched_barrier(0)
  const int wid = tid >> 6, lane = tid & 63, wr = wid >> 2, wc = wid & 3, fr = lane & 15, fq = lane >> 4;
  f32x4 acc[2][2][4][2];
#pragma unroll
  for (int a = 0; a < 2; ++a)
#pragma unroll
    for (int b = 0; b < 2; ++b)
#pragma unroll
      for (int m = 0; m < 4; ++m)
#pragma unroll
        for (int n = 0; n < 2; ++n) acc[a][b][m][n] = f32x4{0.f, 0.f, 0.f, 0.f};
  bf16x8 At[4][2], B0[2][2], B1[2][2];
  const int nt = K / 64;
  if (first) {
    G8_STAGE(G8_SB(0, 0), Bt, ldb, bcol, 0); G8_STAGE(G8_SA(0, 0), A, lda, brow, 0);
    G8_STAGE(G8_SB(0, 1), Bt, ldb, bcol + 128, 0); G8_STAGE(G8_SA(0, 1), A, lda, brow + 128, 0);
  }
  if (wr == 1) G8_BAR;
  if (first) G8_WAIT_V(4); else G8_WAIT_V(0);
  G8_BAR;
  G8_STAGE(G8_SB(1, 0), Bt, ldb, bcol, 1); G8_STAGE(G8_SA(1, 0), A, lda, brow, 1); G8_STAGE(G8_SB(1, 1), Bt, ldb, bcol + 128, 1);
  G8_WAIT_V(6); G8_BAR;
  for (int t = 0; t < nt - 2; t += 2) {
    if (GN && (t == 8 || t == 12)) {
#pragma unroll
      for (int ai = 0; ai < 2; ++ai)
#pragma unroll
        for (int m = 0; m < 4; ++m) {
          const int rl = ai * 128 + wr * 64 + m * 16 + fr;
          const float f = t == 8 ? 1.f / gsl[rl] : gsl[rl] / gsl[256 + rl];
#pragma unroll
          for (int bj = 0; bj < 2; ++bj)
#pragma unroll
            for (int n = 0; n < 2; ++n) acc[ai][bj][m][n] *= f;
        }
    }
    G8_LDB(B0, 0, 0); G8_SCHED; G8_LDA(At, 0, 0); G8_STAGE(G8_SA(1, 1), A, lda, brow + 128, t + 1);
    G8_WAIT_L(8); G8_BAR; G8_WAIT_L(0); G8_MMA(0, 0, At, B0); G8_BAR; G8_SCHED;
    G8_LDB(B1, 0, 1); G8_STAGE(G8_SB(0, 0), Bt, ldb, bcol, t + 2);
    G8_BAR; G8_WAIT_L(0); G8_MMA(0, 1, At, B1); G8_BAR;
    G8_LDA(At, 0, 1); G8_STAGE(G8_SA(0, 0), A, lda, brow, t + 2);
    G8_BAR; G8_WAIT_L(0); G8_MMA(1, 0, At, B0); G8_BAR; G8_SCHED;
    G8_STAGE(G8_SB(0, 1), Bt, ldb, bcol + 128, t + 2);
    G8_WAIT_V(6); G8_BAR; G8_MMA(1, 1, At, B1); G8_BAR;
    G8_LDB(B0, 1, 0); G8_SCHED; G8_LDA(At, 1, 0); G8_STAGE(G8_SA(0, 1), A, lda, brow + 128, t + 2);
    G8_WAIT_L(8); G8_BAR; G8_WAIT_L(0); G8_MMA(0, 0, At, B0); G8_BAR; G8_SCHED;
    G8_LDB(B1, 1, 1); G8_STAGE(G8_SB(1, 0), Bt, ldb, bcol, t + 3);
    G8_BAR; G8_WAIT_L(0); G8_MMA(0, 1, At, B1); G8_BAR;
    G8_LDA(At, 1, 1); G8_STAGE(G8_SA(1, 0), A, lda, brow, t + 3);
    G8_BAR; G8_WAIT_L(0); G8_MMA(1, 0, At, B0); G8_BAR; G8_SCHED;
    G8_STAGE(G8_SB(1, 1), Bt, ldb, bcol + 128, t + 3);
    G8_WAIT_V(6); G8_BAR; G8_MMA(1, 1, At, B1); G8_BAR;
  }
  { G8_LDB(B0, 0, 0); G8_LDA(At, 0, 0); G8_STAGE(G8_SA(1, 1), A, lda, brow + 128, nt - 1);
    G8_BAR; G8_WAIT_L(0); G8_MMA(0, 0, At, B0); G8_BAR;
    G8_LDB(B1, 0, 1); G8_BAR; G8_WAIT_L(0); G8_MMA(0, 1, At, B1); G8_BAR;
    G8_LDA(At, 0, 1); G8_WAIT_V(4); G8_BAR; G8_WAIT_L(0); G8_MMA(1, 0, At, B0); G8_MMA(1, 1, At, B1); G8_BAR; }
  { G8_LDB(B0, 1, 0); G8_LDA(At, 1, 0); G8_WAIT_V(2); G8_BAR; G8_WAIT_L(0); G8_MMA(0, 0, At, B0); G8_BAR;
    G8_LDB(B1, 1, 1); G8_WAIT_V(0); G8_BAR; G8_WAIT_L(0); G8_MMA(0, 1, At, B1); G8_BAR;
    G8_LDA(At, 1, 1); G8_BAR; G8_WAIT_L(0); G8_MMA(1, 0, At, B0); G8_MMA(1, 1, At, B1); G8_BAR; }
  if (GN) {
#pragma unroll
    for (int ai = 0; ai < 2; ++ai)
#pragma unroll
      for (int m = 0; m < 4; ++m) {
        const float f = gsl[256 + ai * 128 + wr * 64 + m * 16 + fr];
#pragma unroll
        for (int bj = 0; bj < 2; ++bj)
#pragma unroll
          for (int n = 0; n < 2; ++n) acc[ai][bj][m][n] *= f;
      }
  }
  if (has_next) {
    G8_STAGE(G8_SB(0, 0), Bt, ldb, nbcol, 0); G8_STAGE(G8_SA(0, 0), A, lda, nbrow, 0);
    G8_STAGE(G8_SB(0, 1), Bt, ldb, nbcol + 128, 0); G8_STAGE(G8_SA(0, 1), A, lda, nbrow + 128, 0);
  }
  if (wr == 0) G8_BAR;
  const bool odd = fq & 1;
#pragma unroll
  for (int ai = 0; ai < 2; ++ai)
#pragma unroll
    for (int bj = 0; bj < 2; ++bj)
#pragma unroll
      for (int m = 0; m < 4; ++m) {
        const int row = brow + ai * 128 + wr * 64 + m * 16 + fr, cb = bcol + bj * 128 + wc * 32;
        epi.side(row, cb + fq * 4, acc[ai][bj][m][0]);
        epi.side(row, cb + 16 + fq * 4, acc[ai][bj][m][1]);
        const u32x2 p0 = epi.pack(acc[ai][bj][m][0]), p1 = epi.pack(acc[ai][bj][m][1]);
        const u32x2 snd = odd ? p0 : p1;
        u32x2 rcv; rcv[0] = (unsigned)__shfl_xor((int)snd[0], 16); rcv[1] = (unsigned)__shfl_xor((int)snd[1], 16);
        u32x4 o;
        if (odd) { o[0] = rcv[0]; o[1] = rcv[1]; o[2] = p1[0]; o[3] = p1[1]; }
        else     { o[0] = p0[0]; o[1] = p0[1]; o[2] = rcv[0]; o[3] = rcv[1]; }
        epi.store16(row, odd ? cb + 16 + (fq - 1) * 4 : cb + fq * 4, o);
      }
  __syncthreads();
}

struct EpiBF {
  bf16_t* out; int ldo;
  DI void side(int, int, const f32x4&) const {}
  DI u32x2 pack(const f32x4& a) const { u32x2 o; o[0] = pack2(a[0], a[1]); o[1] = pack2(a[2], a[3]); return o; }
  DI void store16(int row, int col, const u32x4& v) const { *(u32x4*)(out + (size_t)row * ldo + col) = v; }
  DI float scale(int) const { return 1.f; }
  DI void operator()(int row, int col, const f32x4& a, float) const { (*this)(row, col, a); }
  DI void operator()(int row, int col, const f32x4& a) const {
    u32x2 o; o[0] = pack2(a[0], a[1]); o[1] = pack2(a[2], a[3]);
    *(u32x2*)(out + (size_t)row * ldo + col) = o;
  }
};
struct EpiRelu2 {
  bf16_t* out; int ldo;
  DI void side(int, int, const f32x4&) const {}
  DI u32x2 pack(const f32x4& a) const {
    float r0 = fmaxf(a[0], 0.f), r1 = fmaxf(a[1], 0.f), r2 = fmaxf(a[2], 0.f), r3 = fmaxf(a[3], 0.f);
    u32x2 o; o[0] = pack2(r0 * r0, r1 * r1); o[1] = pack2(r2 * r2, r3 * r3); return o;
  }
  DI void store16(int row, int col, const u32x4& v) const { *(u32x4*)(out + (size_t)row * ldo + col) = v; }
  DI void operator()(int row, int col, const f32x4& a) const {
    float r0 = fmaxf(a[0], 0.f), r1 = fmaxf(a[1], 0.f), r2 = fmaxf(a[2], 0.f), r3 = fmaxf(a[3], 0.f);
    u32x2 o; o[0] = pack2(r0 * r0, r1 * r1); o[1] = pack2(r2 * r2, r3 * r3);
    *(u32x2*)(out + (size_t)row * ldo + col) = o;
  }
};
struct EpiU {
  bf16_t* u; float* dt;
  DI void side(int row, int col, const f32x4& a) const { if (col >= U_DT && col < DIN) *(float4*)(dt + (size_t)row * 16 + col - U_DT) = make_float4(a[0], a[1], a[2], a[3]); }
  DI u32x2 pack(const f32x4& a) const { u32x2 o; o[0] = pack2(a[0], a[1]); o[1] = pack2(a[2], a[3]); return o; }
  DI void store16(int row, int col, const u32x4& v) const { if (col < DIN) *(u32x4*)(u + (size_t)row * DIN + col) = v; }
  DI void operator()(int row, int col, const f32x4& a) const {
    if (col < DIN) {
      u32x2 o; o[0] = pack2(a[0], a[1]); o[1] = pack2(a[2], a[3]);
      *(u32x2*)(u + (size_t)row * DIN + col) = o;
      if (col >= U_DT) *(float4*)(dt + (size_t)row * 16 + col - U_DT) = make_float4(a[0], a[1], a[2], a[3]);
    }
  }
};
struct EpiQ {
  bf16_t* q; const float* rs;
  DI float scale(int row) const { return rs[row * 2]; }
  DI void operator()(int row, int col, const f32x4& a, float r) const {
    u32x2 o; o[0] = pack2(a[0] * r, a[1] * r); o[1] = pack2(a[2] * r, a[3] * r);
    *(u32x2*)(q + (size_t)row * 384 + col) = o;
  }
};
struct EpiKV {
  bf16_t* kb; bf16_t* vt; const float* rs;
  DI float scale(int row) const { return rs[row * 2 + 1]; }
  DI void operator()(int row, int col, const f32x4& a, float r) const {
    int b, pos;
    if (row < ML) { b = row >> 12; pos = (row & 4095) + CTX; } else { int rr = row - ML; b = rr >> 8; pos = rr & 255; }
    const int head = col >> 7, d = col & 127;
    if (d < 64) {
      u32x2 o; o[0] = pack2(a[0] * r, a[1] * r); o[1] = pack2(a[2] * r, a[3] * r);
      *(u32x2*)(kb + ((size_t)(b * 4 + head) * LK + pos) * 96 + d) = o;
    } else {
#pragma unroll
      for (int j = 0; j < 4; ++j) vt[((size_t)(b * 4 + head) * 64 + (d - 64 + j)) * LK + pos] = f2bf(a[j] * r);
    }
  }
};

struct EpiPart {
  float* part;
  DI void operator()(int row, int col, const f32x4& a) const {
    *(float4*)(part + (size_t)(row - ML) * DM + col) = make_float4(a[0], a[1], a[2], a[3]);
  }
};
DI void phase_inproj(const Params& p, int layer, int bid, int nb, int vbid, int nvb, char* smem, char* smem_half) {
  EpiU epi{(bf16_t*)(p.ws + OFF_U), (float*)(p.ws + OFF_DT)};
  const int x = bid & 7, per = nb >> 3;
  for (int rep = 0; rep < REP_GEMM; ++rep)
  for (int q = bid >> 3; q < 85; q += per) {
    const int m = (x >> 1) * 17 + q / 5, n = 5 * (x & 1) + q % 5;
    const int q2 = q + per, m2 = (x >> 1) * 17 + q2 / 5, n2 = 5 * (x & 1) + q2 % 5;
    gemm8_tile((const bf16_t*)(p.ws + OFF_H), DM, wt_ptr(p, layer, WT_IN), 1024, 1024, m * 256, n * 256, smem, epi,
               q == (bid >> 3), q2 < 85, m2 * 256, n2 * 256);
  }
  if (layer == 0) {
    if (per == 32) {
      if ((bid >> 3) >= 21) {
        const int u = ((bid >> 3) - 21) * 8 + x;
        for (int it = 640 + 2 * u + (vbid & 1); it < WT_ITEMS; it += 176) wt_item(p, 0, it, smem_half);
      }
    } else {
      for (int it = 640 + vbid; it < WT_ITEMS; it += nvb) wt_item(p, 0, it, smem_half);
    }
  }
}
DI void phase_wout(const Params& p, int layer, int bid, int nb, int vbid, int nvb, char* smem, char* smem_half) {
  EpiBF epi{(bf16_t*)(p.ws + OFF_U), DM};
  const float* ssq = (const float*)(p.ws + OFF_SSQ);
  const int x = bid & 7, per = nb >> 3;
  for (int rep = 0; rep < REP_GEMM; ++rep) {
    for (int q = bid >> 3; q < 32; q += per) {
      const int T = x * 32 + q;
      gemm8_tile<true>((const bf16_t*)(p.ws + OFF_H), DM, wt_ptr(p, layer, WT_OUT), 1024, 1024, (T >> 2) * 256, (T & 3) * 256, smem, epi,
                       true, false, 0, 0, ssq);
    }
    if (layer == 0)
      for (int it = vbid; it < (MC / 128) * 8; it += nvb)
        gemm_tile<true>((const bf16_t*)(p.ws + OFF_H), DM, wt_ptr(p, layer, WT_OUT), 1024, ML + (it >> 3) * 128, (it & 7) * 128, smem_half, epi, ssq);
  }
}
DI void phase_ff1(const Params& p, int layer, int bid, int nb, int vbid, int nvb, char* smem, char* smem_half) {
  EpiRelu2 epi{(bf16_t*)(p.ws + OFF_F1), DFF};
  const int x = bid & 7, per = nb >> 3;
  for (int rep = 0; rep < REP_GEMM; ++rep) {
    for (int q = bid >> 3; q < 128; q += per) {
      const int m = (x >> 2) * 32 + (q >> 2), n = 4 * (x & 3) + (q & 3);
      const int q2 = q + per, m2 = (x >> 2) * 32 + (q2 >> 2), n2 = 4 * (x & 3) + (q2 & 3);
      gemm8_tile((const bf16_t*)(p.ws + OFF_H), DM, wt_ptr(p, layer, WT_FF1), 1024, 1024, m * 256, n * 256, smem, epi,
                 q == (bid >> 3), q2 < 128, m2 * 256, n2 * 256);
    }
    if (layer == 0)
      for (int it = vbid; it < (MC / 128) * 32; it += nvb)
        gemm_tile_glds((const bf16_t*)(p.ws + OFF_H), DM, wt_ptr(p, layer, WT_FF1), 1024, 1024, ML + (it / 32) * 128, (it % 32) * 128, smem_half, epi);
  }
}
DI void phase_ff2(const Params& p, int layer, int bid, int nb, int vbid, int nvb, char* smem, char* smem_half) {
  EpiBF epi{(bf16_t*)(p.ws + OFF_H), DM};
  const int x = bid & 7, per = nb >> 3;
  for (int rep = 0; rep < REP_GEMM; ++rep) {
    for (int q = bid >> 3; q < 32; q += per) {
      const int T = x * 32 + q;
      gemm8_tile((const bf16_t*)(p.ws + OFF_F1), DFF, wt_ptr(p, layer, WT_FF2), 4096, 4096, (T >> 2) * 256, (T & 3) * 256, smem, epi);
    }
    if (layer == 0)
      for (int it = vbid; it < (MC / 128) * 8 * 4; it += nvb) {
        const int tile = it >> 2, ks = it & 3;
        EpiPart ep{(float*)(p.ws + OFF_END2) + (size_t)ks * MC * DM};
        gemm_tile_glds((const bf16_t*)(p.ws + OFF_F1) + ks * 1024, DFF, wt_ptr(p, layer, WT_FF2) + ks * 1024, 4096, 1024, ML + (tile >> 3) * 128, (tile & 7) * 128, smem_half, ep);
      }
  }
}

DI int chunk_row0(int b, int tc) { return tc < 2 ? ML + b * CTX + tc * 128 : b * SEQ + (tc - 2) * 128; }
constexpr int BST = 72;
constexpr int TST = 136;
DI void load_tile_T(bf16_t* dst, const bf16_t* __restrict__ src, int ldg) {
  const int tid = ltid();
#pragma unroll
  for (int i = 0; i < 4; ++i) {
    int c = tid + 256 * i, tok = c & 127, pc = c >> 7;
    u32x4 v = *(const u32x4*)(src + (size_t)tok * ldg + pc * 8);
#pragma unroll
    for (int j = 0; j < 4; ++j) {
      dst[(pc * 8 + 2 * j) * TST + tok] = (bf16_t)(v[j] & 0xffffu);
      dst[(pc * 8 + 2 * j + 1) * TST + tok] = (bf16_t)(v[j] >> 16);
    }
  }
}
DI void chunk_scan(const Params& p, int layer, int row0, int h, float* csf, float* csb, float* dtF, float* dtB, float* tot, float*  ) {
  const int tid = ltid(), w = tid >> 6, lane = tid & 63;
  const float* DT = (const float*)(p.ws + OFF_DT);
  float v;
  if (tid < 128) {
    const float dt = DT[(size_t)(row0 + tid) * 16 + h];
    v = dt * -__expf(p.a_log[layer * 16 + h]);
    dtF[tid] = dt;
  } else {
    const int e = 255 - tid;
    const float dt = DT[(size_t)(row0 + e) * 16 + 8 + h];
    v = dt * -__expf(p.a_log[layer * 16 + 8 + h]);
    dtB[e] = dt;
  }
#pragma unroll
  for (int o = 1; o < 64; o <<= 1) { const float t = __shfl_up(v, o); if (lane >= o) v += t; }
  if (lane == 63) tot[w] = v;
  __syncthreads();
  if (w == 1) v += tot[0];
  if (w == 3) v += tot[2];
  if (tid < 128) csf[tid] = v; else csb[255 - tid] = v;
  __syncthreads();
}

DI void ssd_state_item(const Params& p, int layer, int b, int tc, int h, char* smem) {
  bf16_t* XT = (bf16_t*)smem;
  bf16_t* BT = XT + 64 * TST;
  float* csf = (float*)(BT + 64 * TST);
  float* csb = csf + 128; float* dtF = csb + 128; float* dtB = dtF + 128; float* laF = dtB + 128; float* laB = laF + 128;
  const int tid = ltid(), w = tid >> 6, lane = tid & 63, r = lane & 31, hh = lane >> 5;
  const int row0 = chunk_row0(b, tc);
  const bf16_t* XBC = (const bf16_t*)(p.ws + OFF_XBC);
  load_tile_T(XT, XBC + (size_t)row0 * 768 + h * 64, 768);
  load_tile_T(BT, XBC + (size_t)row0 * 768 + 512 + (h >> 2) * 64, 768);
  chunk_scan(p, layer, row0, h, csf, csb, dtF, dtB, laF, laB);
  __syncthreads();
  if (tid < 128) laF[tid] = dtF[tid] * __expf(csf[127] - csf[tid]);
  else { int t = tid - 128; laB[t] = dtB[t] * __expf(csb[0] - csb[t]); }
  __syncthreads();
  const int d = w >> 1, pt = w & 1;
  const float* wv = d == 0 ? laF : laB;
  f32x16 acc[2];
#pragma unroll
  for (int i = 0; i < 16; ++i) { acc[0][i] = 0.f; acc[1][i] = 0.f; }
#pragma unroll
  for (int s = 0; s < 8; ++s) {
    int l0 = 16 * s + 8 * hh;
    u32x4 xa = *(const u32x4*)(XT + (32 * pt + r) * TST + l0);
    u32x4 sa;
#pragma unroll
    for (int j = 0; j < 4; ++j) sa[j] = pack2(lo2f(xa[j]) * wv[l0 + 2 * j], hi2f(xa[j]) * wv[l0 + 2 * j + 1]);
    bf16x8 af = __builtin_bit_cast(bf16x8, sa);
#pragma unroll
    for (int nt = 0; nt < 2; ++nt) {
      bf16x8 bfr = *(const bf16x8*)(BT + (32 * nt + r) * TST + l0);
      acc[nt] = MFMA32(af, bfr, acc[nt]);
    }
  }
  bf16_t* S = (bf16_t*)(p.ws + OFF_SST) + ((((size_t)d * NB + b) * NCH + tc) * 8 + h) * 4096;
#pragma unroll
  for (int nt = 0; nt < 2; ++nt)
#pragma unroll
    for (int i = 0; i < 16; ++i) S[(32 * pt + crow(i, hh)) * 64 + 32 * nt + r] = f2bf(acc[nt][i]);
  if (tid == 0) {
    float* TD = (float*)(p.ws + OFF_TDEC);
    TD[((0 * NB + b) * NCH + tc) * 8 + h] = __expf(csf[127]);
    TD[((1 * NB + b) * NCH + tc) * 8 + h] = __expf(csb[0]);
  }
  __syncthreads();
}

DI void ssd_pass_item(const Params& p, int it) {
  const int e = it * 256 + ltid();
  const int pn2 = e & 2047, h = (e >> 11) & 7, b = (e >> 14) & 3, d = e >> 16;
  unsigned* S = (unsigned*)(p.ws + OFF_SST);
  const float* TD = (const float*)(p.ws + OFF_TDEC);
  unsigned sv[NCH]; float T[NCH];
#pragma unroll
  for (int i = 0; i < NCH; ++i) {
    int tc = d == 0 ? i : (i < 2 ? 1 - i : NCH + 1 - i);
    sv[i] = S[(((size_t)(d * NB + b) * NCH + tc) * 8 + h) * 2048 + pn2];
    T[i] = TD[((d * NB + b) * NCH + tc) * 8 + h];
  }
  float h0 = 0.f, h1 = 0.f;
#pragma unroll
  for (int i = 0; i < NCH; ++i) {
    int tc = d == 0 ? i : (i < 2 ? 1 - i : NCH + 1 - i);
    S[(((size_t)(d * NB + b) * NCH + tc) * 8 + h) * 2048 + pn2] = pack2(h0, h1);
    h0 = T[i] * h0 + lo2f(sv[i]); h1 = T[i] * h1 + hi2f(sv[i]);
  }
}

DI void ssd_out_item(const Params& p, int layer, int b, int tc, int h, char* smem) {
  bf16_t* XT = (bf16_t*)smem;
  bf16_t* Bs = XT + 64 * TST;
  float* csf = (float*)(Bs + 128 * BST);
  float* csb = csf + 128; float* dtF = csb + 128; float* dtB = dtF + 128; float* laF = dtB + 128; float* laB = laF + 128;
  const int tid = ltid(), w = tid >> 6, lane = tid & 63, r = lane & 31, hh = lane >> 5;
  const int row0 = chunk_row0(b, tc), g = h >> 2;
  const bf16_t* XBC = (const bf16_t*)(p.ws + OFF_XBC);
  load_tile_T(XT, XBC + (size_t)row0 * 768 + h * 64, 768);
#pragma unroll
  for (int i = 0; i < 4; ++i) {
    int c = tid + 256 * i, tok = c >> 3, part = c & 7;
    *(u32x4*)(Bs + tok * BST + part * 8) = *(const u32x4*)(XBC + (size_t)(row0 + tok) * 768 + 512 + g * 64 + part * 8);
  }
  const int l = 32 * w + r;
  bf16x8 cf[4];
#pragma unroll
  for (int ks = 0; ks < 4; ++ks) cf[ks] = *(const bf16x8*)(XBC + (size_t)(row0 + l) * 768 + 640 + g * 64 + 16 * ks + 8 * hh);
  chunk_scan(p, layer, row0, h, csf, csb, dtF, dtB, laF, laB);
  const float csf_l = csf[l], csb_l = csb[l];
  f32x16 yacc[2];
#pragma unroll
  for (int i = 0; i < 16; ++i) { yacc[0][i] = 0.f; yacc[1][i] = 0.f; }
#pragma unroll
  for (int st = 0; st < 4; ++st) {
    f32x16 gacc;
#pragma unroll
    for (int i = 0; i < 16; ++i) gacc[i] = 0.f;
#pragma unroll
    for (int ks = 0; ks < 4; ++ks) {
      bf16x8 af = *(const bf16x8*)(Bs + (32 * st + r) * BST + 16 * ks + 8 * hh);
      gacc = MFMA32(af, cf[ks], gacc);
    }
#pragma unroll
    for (int i = 0; i < 16; ++i) {
      int s = 32 * st + crow(i, hh);
      float f;
      if (s < l) f = __expf(csf_l - csf[s]) * dtF[s];
      else if (s > l) f = __expf(csb_l - csb[s]) * dtB[s];
      else f = dtF[s] + dtB[s];
      gacc[i] *= f;
    }
#pragma unroll
    for (int s2 = 0; s2 < 2; ++s2) {
      bf16x8 mf = pack8(gacc, s2);
      int sb = 32 * st + 16 * s2 + 4 * hh;
#pragma unroll
      for (int pt = 0; pt < 2; ++pt) {
        u32x2 lo = *(const u32x2*)(XT + (32 * pt + r) * TST + sb);
        u32x2 hi = *(const u32x2*)(XT + (32 * pt + r) * TST + sb + 8);
        u32x4 xa; xa[0] = lo[0]; xa[1] = lo[1]; xa[2] = hi[0]; xa[3] = hi[1];
        yacc[pt] = MFMA32(__builtin_bit_cast(bf16x8, xa), mf, yacc[pt]);
      }
    }
  }
#pragma unroll
  for (int d = 0; d < 2; ++d) {
    const bf16_t* Hs = (const bf16_t*)(p.ws + OFF_SST) + ((((size_t)d * NB + b) * NCH + tc) * 8 + h) * 4096;
    const float e = __expf(d == 0 ? csf_l : csb_l);
#pragma unroll
    for (int pt = 0; pt < 2; ++pt) {
      f32x16 t;
#pragma unroll
      for (int i = 0; i < 16; ++i) t[i] = 0.f;
#pragma unroll
      for (int ks = 0; ks < 4; ++ks) {
        bf16x8 af = *(const bf16x8*)(Hs + (32 * pt + r) * 64 + 16 * ks + 8 * hh);
        t = MFMA32(af, cf[ks], t);
      }
#pragma unroll
      for (int i = 0; i < 16; ++i) yacc[pt][i] += e * t[i];
    }
  }
  const int row = row0 + l;
  const float Dh = p.ssd_d[layer * 8 + h];
  const bf16_t* U = (const bf16_t*)(p.ws + OFF_U);
  bf16_t* YM = (bf16_t*)(p.ws + OFF_H);
  float ssq = 0.f;
  u32x2 xvv[2][4], zvv[2][4];
#pragma unroll
  for (int pt = 0; pt < 2; ++pt)
#pragma unroll
    for (int q = 0; q < 4; ++q) {
      const int pp = 32 * pt + 8 * q + 4 * hh;
      xvv[pt][q] = *(const u32x2*)(XBC + (size_t)row * 768 + h * 64 + pp);
      zvv[pt][q] = *(const u32x2*)(U + (size_t)row * DIN + U_Z + h * 64 + pp);
    }
#pragma unroll
  for (int pt = 0; pt < 2; ++pt)
#pragma unroll
    for (int q = 0; q < 4; ++q) {
      const int pp = 32 * pt + 8 * q + 4 * hh;
      const u32x2 xv = xvv[pt][q], zv = zvv[pt][q];
      float y0 = (yacc[pt][4 * q + 0] + Dh * lo2f(xv[0])) * silu_f(lo2f(zv[0]));
      float y1 = (yacc[pt][4 * q + 1] + Dh * hi2f(xv[0])) * silu_f(hi2f(zv[0]));
      float y2 = (yacc[pt][4 * q + 2] + Dh * lo2f(xv[1])) * silu_f(lo2f(zv[1]));
      float y3 = (yacc[pt][4 * q + 3] + Dh * hi2f(xv[1])) * silu_f(hi2f(zv[1]));
      u32x2 o; o[0] = pack2(y0, y1); o[1] = pack2(y2, y3);
      float r0 = lo2f(o[0]), r1 = hi2f(o[0]), r2 = lo2f(o[1]), r3 = hi2f(o[1]);
      ssq += r0 * r0 + r1 * r1 + r2 * r2 + r3 * r3;
      *(u32x2*)(YM + (size_t)row * DM + 512 + h * 64 + pp) = o;
    }
  ssq += __shfl_xor(ssq, 32);
  if (hh == 0) ((float*)(p.ws + OFF_SSQ))[(size_t)row * 8 + h] = ssq;
  __syncthreads();
}

constexpr int KST = 104;
constexpr int VST = 68;
constexpr int ASTG = 64 * KST + 64 * VST;
DI void attn_item(const Params& p, int b, int head, int qrow0, int t0, bool lat, int nkeys, char* smem) {
  bf16_t* Ks = (bf16_t*)smem;
  bf16_t* Vs = Ks + 64 * KST;
  const int tid = ltid(), w = tid >> 6, lane = tid & 63, r = lane & 31, hh = lane >> 5;
  const bf16_t* QB = (const bf16_t*)(p.ws + OFF_QB);
  const bf16_t* KB = (const bf16_t*)(p.ws + OFF_KB) + (size_t)(b * 4 + head) * LK * 96;
  const bf16_t* VT = (const bf16_t*)(p.ws + OFF_VT) + (size_t)(b * 4 + head) * 64 * LK;
  const float qscale = 0.10206207261596575f * 1.4426950408889634f;
  const int qrow = qrow0 + w * 32 + r;
  const int t = t0 + w * 32 + r;
  bf16x8 qf[6];
  {
    const bf16_t* src = QB + (size_t)qrow * 384 + head * 96;
#pragma unroll
    for (int s = 0; s < 4; ++s) {
      u32x4 v = *(const u32x4*)(src + 16 * s + 8 * hh);
      u32x4 o;
#pragma unroll
      for (int j = 0; j < 4; ++j) o[j] = pack2(lo2f(v[j]) * qscale, hi2f(v[j]) * qscale);
      qf[s] = __builtin_bit_cast(bf16x8, o);
    }
#pragma unroll
    for (int s = 4; s < 6; ++s) {
      u32x4 va = *(const u32x4*)(src + 16 * s), vb = *(const u32x4*)(src + 16 * s + 8);
      float posf = s == 4 ? (float)(t >> 6) : (float)(t & 63);
      float o[8];
#pragma unroll
      for (int j = 0; j < 8; ++j) {
        float a = (j & 1) ? hi2f(va[j >> 1]) : lo2f(va[j >> 1]);
        float bb = (j & 1) ? hi2f(vb[j >> 1]) : lo2f(vb[j >> 1]);
        float res;
        if (lat) {
          float invf = exp2f(-(float)(2 * j) * (13.287712379549449f / 16.f));
          float rev = posf * invf * 0.15915494309189535f;
          float cs = __builtin_amdgcn_cosf(rev), sn = __builtin_amdgcn_sinf(rev);
          res = hh == 0 ? a * cs - bb * sn : bb * cs + a * sn;
        } else res = hh == 0 ? a : bb;
        o[j] = res * qscale;
      }
      u32x4 ov; ov[0] = pack2(o[0], o[1]); ov[1] = pack2(o[2], o[3]); ov[2] = pack2(o[4], o[5]); ov[3] = pack2(o[6], o[7]);
      qf[s] = __builtin_bit_cast(bf16x8, ov);
    }
  }
  f32x16 oacc[2];
#pragma unroll
  for (int i = 0; i < 16; ++i) { oacc[0][i] = 0.f; oacc[1][i] = 0.f; }
  float m = -1e30f, lsum = 0.f;
  u32x4 rk[3], rv[2];
  auto gload = [&](int key0) {
#pragma unroll
    for (int i = 0; i < 3; ++i) rk[i] = *(const u32x4*)(KB + (size_t)key0 * 96 + (tid + 256 * i) * 8);
#pragma unroll
    for (int i = 0; i < 2; ++i) { int c = tid + 256 * i; rv[i] = *(const u32x4*)(VT + (size_t)(c >> 3) * LK + key0 + (c & 7) * 8); }
  };
  gload(0);
  const int NT = nkeys / 64;
  for (int kt = 0; kt < NT; ++kt) {
#pragma unroll
    for (int i = 0; i < 3; ++i) { int c = tid + 256 * i; *(u32x4*)(Ks + (c / 12) * KST + (c % 12) * 8) = rk[i]; }
#pragma unroll
    for (int i = 0; i < 2; ++i) {
      int c = tid + 256 * i;
      bf16_t* d = Vs + (c >> 3) * VST + (c & 7) * 8;
      u32x2 a; a[0] = rv[i][0]; a[1] = rv[i][1];
      u32x2 bq; bq[0] = rv[i][2]; bq[1] = rv[i][3];
      *(u32x2*)d = a; *(u32x2*)(d + 4) = bq;
    }
    __syncthreads();
    if (kt + 1 < NT) gload((kt + 1) * 64);
    f32x16 sacc[2];
#pragma unroll
    for (int i = 0; i < 16; ++i) { sacc[0][i] = 0.f; sacc[1][i] = 0.f; }
#pragma unroll
    for (int s = 0; s < 6; ++s)
#pragma unroll
      for (int k2 = 0; k2 < 2; ++k2) {
        bf16x8 af = *(const bf16x8*)(Ks + (32 * k2 + r) * KST + 16 * s + 8 * hh);
        sacc[k2] = MFMA32(af, qf[s], sacc[k2]);
      }
    float mx = sacc[0][0];
#pragma unroll
    for (int i = 0; i < 16; ++i) { mx = fmaxf(mx, sacc[0][i]); mx = fmaxf(mx, sacc[1][i]); }
    mx = fmaxf(mx, __shfl_xor(mx, 32));
    const float mn = fmaxf(m, mx);
    const float alpha = __builtin_amdgcn_exp2f(m - mn);
    m = mn;
    float ps = 0.f;
#pragma unroll
    for (int i = 0; i < 16; ++i) {
      sacc[0][i] = __builtin_amdgcn_exp2f(sacc[0][i] - mn); sacc[1][i] = __builtin_amdgcn_exp2f(sacc[1][i] - mn);
      ps += sacc[0][i] + sacc[1][i];
    }
    lsum = lsum * alpha + ps;
#pragma unroll
    for (int i = 0; i < 16; ++i) { oacc[0][i] *= alpha; oacc[1][i] *= alpha; }
#pragma unroll
    for (int k2 = 0; k2 < 2; ++k2)
#pragma unroll
      for (int s2 = 0; s2 < 2; ++s2) {
        bf16x8 pf = pack8(sacc[k2], s2);
        int kb0 = 32 * k2 + 16 * s2 + 4 * hh;
#pragma unroll
        for (int d = 0; d < 2; ++d) {
          u32x2 lo = *(const u32x2*)(Vs + (32 * d + r) * VST + kb0);
          u32x2 hi = *(const u32x2*)(Vs + (32 * d + r) * VST + kb0 + 8);
          u32x4 va; va[0] = lo[0]; va[1] = lo[1]; va[2] = hi[0]; va[3] = hi[1];
          oacc[d] = MFMA32(__builtin_bit_cast(bf16x8, va), pf, oacc[d]);
        }
      }
    __syncthreads();
  }
  lsum += __shfl_xor(lsum, 32);
  const float inv = 1.f / lsum;
  bf16_t* YM = (bf16_t*)(p.ws + OFF_H) + (size_t)qrow * DM + head * 64;
#pragma unroll
  for (int d = 0; d < 2; ++d)
#pragma unroll
    for (int q = 0; q < 4; ++q) {
      u32x2 o; o[0] = pack2(oacc[d][4 * q] * inv, oacc[d][4 * q + 1] * inv); o[1] = pack2(oacc[d][4 * q + 2] * inv, oacc[d][4 * q + 3] * inv);
      *(u32x2*)(YM + 32 * d + 8 * q + 4 * hh) = o;
    }
}

DI void attn_item8(const Params& p, int b, int head, int qrow0, int t0, bool lat, int nkeys, char* smem) {
  bf16_t* Ks = (bf16_t*)smem;
  bf16_t* Vs = Ks + 64 * KST;
  const int tid = ltid512(), w = tid >> 6, lane = tid & 63, r = lane & 31, hh = lane >> 5;
  const bf16_t* QB = (const bf16_t*)(p.ws + OFF_QB);
  const bf16_t* KB = (const bf16_t*)(p.ws + OFF_KB) + (size_t)(b * 4 + head) * LK * 96;
  const bf16_t* VT = (const bf16_t*)(p.ws + OFF_VT) + (size_t)(b * 4 + head) * 64 * LK;
  const float qscale = 0.10206207261596575f * 1.4426950408889634f;
  const int qrow = qrow0 + w * 32 + r;
  const int t = t0 + w * 32 + r;
  bf16x8 qf[6];
  {
    const bf16_t* src = QB + (size_t)qrow * 384 + head * 96;
#pragma unroll
    for (int s = 0; s < 4; ++s) {
      u32x4 v = *(const u32x4*)(src + 16 * s + 8 * hh);
      u32x4 o;
#pragma unroll
      for (int j = 0; j < 4; ++j) o[j] = pack2(lo2f(v[j]) * qscale, hi2f(v[j]) * qscale);
      qf[s] = __builtin_bit_cast(bf16x8, o);
    }
#pragma unroll
    for (int s = 4; s < 6; ++s) {
      u32x4 va = *(const u32x4*)(src + 16 * s), vb = *(const u32x4*)(src + 16 * s + 8);
      float posf = s == 4 ? (float)(t >> 6) : (float)(t & 63);
      float o[8];
#pragma unroll
      for (int j = 0; j < 8; ++j) {
        float a = (j & 1) ? hi2f(va[j >> 1]) : lo2f(va[j >> 1]);
        float bb = (j & 1) ? hi2f(vb[j >> 1]) : lo2f(vb[j >> 1]);
        float res;
        if (lat) {
          float invf = exp2f(-(float)(2 * j) * (13.287712379549449f / 16.f));
          float rev = posf * invf * 0.15915494309189535f;
          float cs = __builtin_amdgcn_cosf(rev), sn = __builtin_amdgcn_sinf(rev);
          res = hh == 0 ? a * cs - bb * sn : bb * cs + a * sn;
        } else res = hh == 0 ? a : bb;
        o[j] = res * qscale;
      }
      u32x4 ov; ov[0] = pack2(o[0], o[1]); ov[1] = pack2(o[2], o[3]); ov[2] = pack2(o[4], o[5]); ov[3] = pack2(o[6], o[7]);
      qf[s] = __builtin_bit_cast(bf16x8, ov);
    }
  }
  f32x16 oacc[2];
#pragma unroll
  for (int i = 0; i < 16; ++i) { oacc[0][i] = 0.f; oacc[1][i] = 0.f; }
  float m = -1e30f, lsum = 0.f;
  u32x4 rk[2], rv;
  auto gload = [&](int key0) {
    rk[0] = *(const u32x4*)(KB + (size_t)key0 * 96 + tid * 8);
    if (tid < 256) rk[1] = *(const u32x4*)(KB + (size_t)key0 * 96 + (512 + tid) * 8);
    rv = *(const u32x4*)(VT + (size_t)(tid >> 3) * LK + key0 + (tid & 7) * 8);
  };
  const int kro = (tid / 12) * KST + (tid % 12) * 8, kro2 = ((512 + tid) / 12) * KST + ((512 + tid) % 12) * 8;
  auto swrite = [&](int stage) {
    bf16_t* Kd = Ks + stage * ASTG;
    *(u32x4*)(Kd + kro) = rk[0];
    if (tid < 256) *(u32x4*)(Kd + kro2) = rk[1];
    bf16_t* d = Kd + 64 * KST + (tid >> 3) * VST + (tid & 7) * 8;
    u32x2 a; a[0] = rv[0]; a[1] = rv[1];
    u32x2 bq; bq[0] = rv[2]; bq[1] = rv[3];
    *(u32x2*)d = a; *(u32x2*)(d + 4) = bq;
  };
  auto qk = [&](int stage, f32x16 (&sa)[2]) {
    const bf16_t* Kc = Ks + stage * ASTG;
#pragma unroll
    for (int i = 0; i < 16; ++i) { sa[0][i] = 0.f; sa[1][i] = 0.f; }
#pragma unroll
    for (int s = 0; s < 6; ++s)
#pragma unroll
      for (int k2 = 0; k2 < 2; ++k2) {
        bf16x8 af = *(const bf16x8*)(Kc + (32 * k2 + r) * KST + 16 * s + 8 * hh);
        sa[k2] = MFMA32(af, qf[s], sa[k2]);
      }
  };
  const int NT = nkeys / 64;
  f32x16 sacc[2], snext[2];
  gload(0); swrite(0);
  gload(64);
  __syncthreads();
  swrite(1);
  gload(128);
  qk(0, sacc);
  __syncthreads();
  int cur = 0, nxt = 1, nn = 2;
  for (int kt = 0; kt < NT; ++kt) {
    if (kt + 1 < NT) qk(nxt, snext);
    if (kt + 2 < NT) {
      swrite(nn);
      if (kt + 3 < NT) gload((kt + 3) * 64);
    }
    const bf16_t* Vc = Ks + cur * ASTG + 64 * KST;
    float mx = sacc[0][0];
#pragma unroll
    for (int i = 0; i < 16; ++i) { mx = fmaxf(mx, sacc[0][i]); mx = fmaxf(mx, sacc[1][i]); }
    mx = fmaxf(mx, __shfl_xor(mx, 32));
    const float mn = fmaxf(m, mx);
    const float alpha = __builtin_amdgcn_exp2f(m - mn);
    m = mn;
    float ps = 0.f;
#pragma unroll
    for (int i = 0; i < 16; ++i) {
      sacc[0][i] = __builtin_amdgcn_exp2f(sacc[0][i] - mn); sacc[1][i] = __builtin_amdgcn_exp2f(sacc[1][i] - mn);
      ps += sacc[0][i] + sacc[1][i];
    }
    lsum = lsum * alpha + ps;
#pragma unroll
    for (int i = 0; i < 16; ++i) { oacc[0][i] *= alpha; oacc[1][i] *= alpha; }
#pragma unroll
    for (int k2 = 0; k2 < 2; ++k2)
#pragma unroll
      for (int s2 = 0; s2 < 2; ++s2) {
        bf16x8 pf = pack8(sacc[k2], s2);
        int kb0 = 32 * k2 + 16 * s2 + 4 * hh;
#pragma unroll
        for (int d = 0; d < 2; ++d) {
          u32x2 lo = *(const u32x2*)(Vc + (32 * d + r) * VST + kb0);
          u32x2 hi = *(const u32x2*)(Vc + (32 * d + r) * VST + kb0 + 8);
          u32x4 va; va[0] = lo[0]; va[1] = lo[1]; va[2] = hi[0]; va[3] = hi[1];
          oacc[d] = MFMA32(__builtin_bit_cast(bf16x8, va), pf, oacc[d]);
        }
      }
    sacc[0] = snext[0]; sacc[1] = snext[1];
    const int t3 = cur; cur = nxt; nxt = nn; nn = t3;
    __syncthreads();
  }
  lsum += __shfl_xor(lsum, 32);
  const float inv = 1.f / lsum;
  bf16_t* YM = (bf16_t*)(p.ws + OFF_H) + (size_t)qrow * DM + head * 64;
#pragma unroll
  for (int d = 0; d < 2; ++d)
#pragma unroll
    for (int q = 0; q < 4; ++q) {
      u32x2 o; o[0] = pack2(oacc[d][4 * q] * inv, oacc[d][4 * q + 1] * inv); o[1] = pack2(oacc[d][4 * q + 2] * inv, oacc[d][4 * q + 3] * inv);
      *(u32x2*)(YM + 32 * d + 8 * q + 4 * hh) = o;
    }
}

DI void attn_item8b(const Params& p, int b, int head, int qrow0, int t0, bool lat, int nkeys, char* smem) {
  bf16_t* Ks = (bf16_t*)smem;
  bf16_t* Vs = Ks + 64 * KST;
  const int tid = ltid512(), w = tid >> 6, lane = tid & 63, r = lane & 31, hh = lane >> 5;
  const bf16_t* QB = (const bf16_t*)(p.ws + OFF_QB);
  const bf16_t* KB = (const bf16_t*)(p.ws + OFF_KB) + (size_t)(b * 4 + head) * LK * 96;
  const bf16_t* VT = (const bf16_t*)(p.ws + OFF_VT) + (size_t)(b * 4 + head) * 64 * LK;
  const float qscale = 0.10206207261596575f * 1.4426950408889634f;
  const int qrow = qrow0 + w * 32 + r;
  const int t = t0 + w * 32 + r;
  bf16x8 qf[6];
  {
    const bf16_t* src = QB + (size_t)qrow * 384 + head * 96;
#pragma unroll
    for (int s = 0; s < 4; ++s) {
      u32x4 v = *(const u32x4*)(src + 16 * s + 8 * hh);
      u32x4 o;
#pragma unroll
      for (int j = 0; j < 4; ++j) o[j] = pack2(lo2f(v[j]) * qscale, hi2f(v[j]) * qscale);
      qf[s] = __builtin_bit_cast(bf16x8, o);
    }
#pragma unroll
    for (int s = 4; s < 6; ++s) {
      u32x4 va = *(const u32x4*)(src + 16 * s), vb = *(const u32x4*)(src + 16 * s + 8);
      float posf = s == 4 ? (float)(t >> 6) : (float)(t & 63);
      float o[8];
#pragma unroll
      for (int j = 0; j < 8; ++j) {
        float a = (j & 1) ? hi2f(va[j >> 1]) : lo2f(va[j >> 1]);
        float bb = (j & 1) ? hi2f(vb[j >> 1]) : lo2f(vb[j >> 1]);
        float res;
        if (lat) {
          float invf = exp2f(-(float)(2 * j) * (13.287712379549449f / 16.f));
          float rev = posf * invf * 0.15915494309189535f;
          float cs = __builtin_amdgcn_cosf(rev), sn = __builtin_amdgcn_sinf(rev);
          res = hh == 0 ? a * cs - bb * sn : bb * cs + a * sn;
        } else res = hh == 0 ? a : bb;
        o[j] = res * qscale;
      }
      u32x4 ov; ov[0] = pack2(o[0], o[1]); ov[1] = pack2(o[2], o[3]); ov[2] = pack2(o[4], o[5]); ov[3] = pack2(o[6], o[7]);
      qf[s] = __builtin_bit_cast(bf16x8, ov);
    }
  }
  f32x16 oacc[2];
#pragma unroll
  for (int i = 0; i < 16; ++i) { oacc[0][i] = 0.f; oacc[1][i] = 0.f; }
  float m = -1e30f, lsum = 0.f;
  constexpr int VS2 = 132;
  constexpr int STG = 128 * KST + 64 * VS2;
  u32x4 rk[3], rv[2];
  auto gload = [&](int key0) {
#pragma unroll
    for (int i = 0; i < 3; ++i) rk[i] = *(const u32x4*)(KB + (size_t)key0 * 96 + (tid + 512 * i) * 8);
#pragma unroll
    for (int i = 0; i < 2; ++i) { const int c = tid + 512 * i; rv[i] = *(const u32x4*)(VT + (size_t)(c >> 4) * LK + key0 + (c & 15) * 8); }
  };
  int kro[3], vro[2];
#pragma unroll
  for (int i = 0; i < 3; ++i) { const int c = tid + 512 * i; kro[i] = (c / 12) * KST + (c % 12) * 8; }
#pragma unroll
  for (int i = 0; i < 2; ++i) { const int c = tid + 512 * i; vro[i] = 128 * KST + (c >> 4) * VS2 + (c & 15) * 8; }
  auto swrite = [&](int stage) {
    bf16_t* Kd = Ks + stage * STG;
#pragma unroll
    for (int i = 0; i < 3; ++i) *(u32x4*)(Kd + kro[i]) = rk[i];
#pragma unroll
    for (int i = 0; i < 2; ++i) {
      u32x2 a; a[0] = rv[i][0]; a[1] = rv[i][1];
      u32x2 bq; bq[0] = rv[i][2]; bq[1] = rv[i][3];
      *(u32x2*)(Kd + vro[i]) = a; *(u32x2*)(Kd + vro[i] + 4) = bq;
    }
  };
  const int NT = nkeys / 128;
  gload(0); swrite(0);
  if (NT > 1) gload(128);
  __syncthreads();
  for (int kt = 0; kt < NT; ++kt) {
    const bf16_t* Kc = Ks + (kt & 1) * STG;
    const bf16_t* Vc = Kc + 128 * KST;
    if (kt + 1 < NT) {
      swrite((kt + 1) & 1);
      if (kt + 2 < NT) gload((kt + 2) * 128);
    }
    f32x16 sacc[4];
#pragma unroll
    for (int k2 = 0; k2 < 4; ++k2)
#pragma unroll
      for (int i = 0; i < 16; ++i) sacc[k2][i] = 0.f;
#pragma unroll
    for (int s = 0; s < 6; ++s)
#pragma unroll
      for (int k2 = 0; k2 < 4; ++k2) {
        bf16x8 af = *(const bf16x8*)(Kc + (32 * k2 + r) * KST + 16 * s + 8 * hh);
        sacc[k2] = MFMA32(af, qf[s], sacc[k2]);
      }
    float mx = sacc[0][0];
#pragma unroll
    for (int k2 = 0; k2 < 4; ++k2)
#pragma unroll
      for (int i = 0; i < 16; ++i) mx = fmaxf(mx, sacc[k2][i]);
    mx = fmaxf(mx, __shfl_xor(mx, 32));
    const float mn = fmaxf(m, mx);
    if (__any(mn > m)) {
      const float alpha = __builtin_amdgcn_exp2f(m - mn);
      lsum *= alpha;
#pragma unroll
      for (int i = 0; i < 16; ++i) { oacc[0][i] *= alpha; oacc[1][i] *= alpha; }
      m = mn;
    }
    float ps = 0.f;
#pragma unroll
    for (int k2 = 0; k2 < 4; ++k2)
#pragma unroll
      for (int i = 0; i < 16; ++i) { sacc[k2][i] = __builtin_amdgcn_exp2f(sacc[k2][i] - m); ps += sacc[k2][i]; }
    lsum += ps;
#pragma unroll
    for (int k2 = 0; k2 < 4; ++k2)
#pragma unroll
      for (int s2 = 0; s2 < 2; ++s2) {
        bf16x8 pf = pack8(sacc[k2], s2);
        const int kb0 = 32 * k2 + 16 * s2 + 4 * hh;
#pragma unroll
        for (int d = 0; d < 2; ++d) {
          u32x2 lo = *(const u32x2*)(Vc + (32 * d + r) * VS2 + kb0);
          u32x2 hi = *(const u32x2*)(Vc + (32 * d + r) * VS2 + kb0 + 8);
          u32x4 va; va[0] = lo[0]; va[1] = lo[1]; va[2] = hi[0]; va[3] = hi[1];
          oacc[d] = MFMA32(__builtin_bit_cast(bf16x8, va), pf, oacc[d]);
        }
      }
    __syncthreads();
  }
  lsum += __shfl_xor(lsum, 32);
  const float inv = 1.f / lsum;
  bf16_t* YM = (bf16_t*)(p.ws + OFF_H) + (size_t)qrow * DM + head * 64;
#pragma unroll
  for (int d = 0; d < 2; ++d)
#pragma unroll
    for (int q = 0; q < 4; ++q) {
      u32x2 o; o[0] = pack2(oacc[d][4 * q] * inv, oacc[d][4 * q + 1] * inv); o[1] = pack2(oacc[d][4 * q + 2] * inv, oacc[d][4 * q + 3] * inv);
      *(u32x2*)(YM + 32 * d + 8 * q + 4 * hh) = o;
    }
}

DI void phase_qkv(const Params& p, int layer, int bid, int nb, char* smem) {
  const int MQ = layer == 0 ? MT : ML;
  const int nq = (MQ / 128) * 3, nkv = (MT / 128) * 4, nst = NB * NCH * 8;
  const float* RS = (const float*)(p.ws + OFF_RSTD);
  EpiQ eq{(bf16_t*)(p.ws + OFF_QB), RS};
  EpiKV ekv{(bf16_t*)(p.ws + OFF_KB), (bf16_t*)(p.ws + OFF_VT), RS};
  const bf16_t* U = (const bf16_t*)(p.ws + OFF_U);
  for (int it = bid; it < nq + nkv + nst; it += nb) {
    if (it < nq) gemm_tile<false>(U, DIN, wt_ptr(p, layer, WT_UQ), 256, (it / 3) * 128, (it % 3) * 128, smem, eq);
    else if (it < nq + nkv) { int j = it - nq; gemm_tile<false>(U + U_CKV, DIN, wt_ptr(p, layer, WT_UKV), 128, (j / 4) * 128, (j % 4) * 128, smem, ekv); }
    else { int j = it - nq - nkv; for (int rep = 0; rep < REP_SSD; ++rep) ssd_state_item(p, layer, j / (NCH * 8), (j / 8) % NCH, j & 7, smem); }
  }
}
DI void phase_att(const Params& p, int layer, int bid, int nb, int vbid, int nvb, char* smem, char* sh) {
  for (int it = bid; it < 256; it += nb) {
    const int x = it & 7, j = it >> 3, bh = 2 * x + (j >> 4), qb = j & 15, b = bh >> 2, head = bh & 3;
    for (int rep = 0; rep < REP_ATT; ++rep) attn_item8b(p, b, head, b * SEQ + qb * 256, qb * 256, true, LK, smem);
  }
  for (int it = vbid; it < 512; it += nvb) ssd_pass_item(p, it);
}
DI void phase_ssdout(const Params& p, int layer, int bid, int nb, char* smem) {
  const int nout = NB * NCH * 8, nctx = layer == 0 ? 32 : 0;
  for (int it = bid; it < nout + nctx; it += nb) {
    if (it < nout) {
      int b = it / (NCH * 8), tc = (it / 8) % NCH, h = it & 7;
      if (layer == 1 && tc < 2) continue;
      for (int rep = 0; rep < REP_SSD; ++rep) ssd_out_item(p, layer, b, tc, h, smem);
    } else {
      const int j = it - nout, b = j >> 3, head = (j >> 1) & 3, qb = j & 1;
      attn_item(p, b, head, ML + b * CTX + qb * 128, qb * 128, false, CTX, smem);
    }
  }
  if (layer == 0) {
    if (nb == 512) { if (bid >= 96) for (int it = bid - 96; it < WT_ITEMS; it += 416) wt_item(p, 1, it, smem); }
    else for (int it = bid; it < WT_ITEMS; it += nb) wt_item(p, 1, it, smem);
  }
}


#define XB_TMO      128
#define XB_XCNT(j)  (256  + 64 * (j))
#define XB_XSUB(j)  (1280 + 64 * (j))
#define XB_XGEN(j)  (2304 + 64 * (j))
#define XB_TOP      3328
#define XB_TOPGEN   3392
#define XCD_BAR_WORDS 3456
#define XB_SPIN_CAP (1u << 22)
#define LAS __attribute__((address_space(3)))
DI unsigned xb_ld(unsigned* p) { return __hip_atomic_load(p, __ATOMIC_RELAXED, __HIP_MEMORY_SCOPE_AGENT); }
DI unsigned xb_add(unsigned* p, unsigned v) { return __hip_atomic_fetch_add(p, v, __ATOMIC_RELAXED, __HIP_MEMORY_SCOPE_AGENT); }
DI unsigned xb_xcc_id() { return (unsigned)__builtin_amdgcn_s_getreg((3 << 11) | 20) & 0xFu; }
#define XB_SPIN(cond, bar) do { unsigned _sp = 0; while (cond) { __builtin_amdgcn_s_sleep(1); \
    if ((++_sp & 255u) == 0u) { if (xb_ld(&(bar)[XB_TMO])) break; if (_sp > XB_SPIN_CAP) { atomicAdd(&(bar)[XB_TMO], 1u); break; } } } } while (0)
struct XcdBarrier { unsigned* bar; unsigned x; volatile LAS unsigned* st; };
DI XcdBarrier xcd_barrier_post(unsigned* bar, volatile LAS unsigned* st) {
  XcdBarrier b; b.bar = bar; b.x = xb_xcc_id(); b.st = st;
  if (threadIdx.x == 0) (void)xb_add(&bar[XB_XCNT(b.x)], 1u);
  return b;
}
DI void xcd_barrier_complete(unsigned* bar, unsigned x, unsigned& nloc, unsigned& nx) {
  const unsigned G = gridDim.x * gridDim.y * gridDim.z;
  unsigned sum, cnt, mine, sp = 0u;
  for (;;) {
    sum = 0u; cnt = 0u; mine = 0u;
#pragma unroll
    for (unsigned j = 0; j < 16; ++j) { const unsigned c = xb_ld(&bar[XB_XCNT(j)]); sum += c; cnt += (c > 0u) ? 1u : 0u; mine = (j == x) ? c : mine; }
    if (sum == G) break;
    __builtin_amdgcn_s_sleep(1);
    if ((++sp & 255u) == 0u) { if (xb_ld(&bar[XB_TMO])) break; if (sp > XB_SPIN_CAP) { atomicAdd(&bar[XB_TMO], 1u); break; } }
  }
  nloc = mine > 0u ? mine : 1u; nx = cnt > 0u ? cnt : 1u;
}
DI void xcd_barrier(const XcdBarrier& b) {
  asm volatile("s_waitcnt vmcnt(0)" ::: "memory");
  __syncthreads();
  if (threadIdx.x == 0) {
    unsigned* bar = b.bar;
    asm volatile("" : "+s"(bar));
    __builtin_amdgcn_s_waitcnt(0);
    unsigned nloc = b.st[0], nx = b.st[1];
    if (nloc == 0u) { xcd_barrier_complete(bar, b.x, nloc, nx); b.st[0] = nloc; b.st[1] = nx; }
    const unsigned old = xb_add(&bar[XB_XSUB(b.x)], 1u);
    const unsigned gen = old / nloc;
    if (old + 1u == (gen + 1u) * nloc) {
      __builtin_amdgcn_fence(__ATOMIC_RELEASE, "agent");
      asm volatile("s_waitcnt vmcnt(0)" ::: "memory");
      const unsigned og = xb_add(&bar[XB_TOP], 1u);
      const unsigned tg = og / nx;
      if (og + 1u == (tg + 1u) * nx) xb_add(&bar[XB_TOPGEN], 1u);
      else XB_SPIN(xb_ld(&bar[XB_TOPGEN]) == tg, bar);
      __builtin_amdgcn_fence(__ATOMIC_ACQUIRE, "agent");
      xb_add(&bar[XB_XGEN(b.x)], 1u);
      asm volatile("s_waitcnt vmcnt(0)" ::: "memory");
    } else {
      XB_SPIN(xb_ld(&bar[XB_XGEN(b.x)]) == gen, bar);
      __builtin_amdgcn_fence(__ATOMIC_ACQUIRE, "agent");
      asm volatile("s_waitcnt vmcnt(0)" ::: "memory");
    }
  }
  __syncthreads();
}

constexpr int SMEM_BYTES = 2 * GBUF * 2;
enum { PH_PREP0 = 0, PH_H0, PH_INPROJ, PH_PREP, PH_QKV, PH_ATT, PH_SSDOUT, PH_WOUT, PH_POSTMIX, PH_FF1, PH_FF2, PH_POSTFFN, PH_SSDNORM };

struct Ids { int bid, nb, vbid, nvb, lid; };
DI void run_phase(const Params& p, int ph, int layer, const Ids& id, char* smem, char* sh) {
  switch (ph) {
    case PH_PREP0: phase_prep0(p, id.vbid, id.nvb, sh); break;
    case PH_H0: phase_h0(p, id.vbid, id.nvb); break;
    case PH_INPROJ: phase_inproj(p, layer, id.bid, id.nb, id.vbid, id.nvb, smem, sh); break;
    case PH_PREP: phase_prep(p, layer, id.vbid, id.nvb); break;
    case PH_QKV: phase_qkv(p, layer, id.vbid, id.nvb, sh); break;
    case PH_ATT: phase_att(p, layer, id.bid, id.nb, id.vbid, id.nvb, smem, sh); break;
    case PH_SSDOUT: phase_ssdout(p, layer, id.vbid, id.nvb, sh); break;
    case PH_WOUT: phase_wout(p, layer, id.bid, id.nb, id.vbid, id.nvb, smem, sh); break;
    case PH_POSTMIX: phase_postmix(p, layer, id.vbid, id.nvb); break;
    case PH_FF1: phase_ff1(p, layer, id.bid, id.nb, id.vbid, id.nvb, smem, sh); break;
    case PH_FF2: phase_ff2(p, layer, id.bid, id.nb, id.vbid, id.nvb, smem, sh); break;
    case PH_POSTFFN: phase_postffn(p, layer, id.vbid, id.nvb); break;
  }
}

__global__ void __launch_bounds__(512) mega_kernel(Params p) {
  extern __shared__ __attribute__((aligned(16))) char smem[];
  cg::grid_group grid = cg::this_grid();
  if (p.ws == nullptr) grid.sync();
  const int half = __builtin_amdgcn_readfirstlane((int)(threadIdx.x >> 8));
  Ids id;
  id.bid = blockIdx.x; id.nb = gridDim.x;
  id.vbid = 2 * id.bid + half; id.nvb = 2 * id.nb;
  id.lid = (id.bid & 7) + 8 * (2 * (id.bid >> 3) + half);
  char* sh = smem + half * SMEM_BYTES;
  volatile LAS unsigned* st = (volatile LAS unsigned*)(smem + 2 * SMEM_BYTES - 16);
  if (threadIdx.x == 0) { st[0] = 0u; st[1] = 0u; st[2] = 0u; st[3] = 0u; }
  __syncthreads();
  XcdBarrier xb = xcd_barrier_post((unsigned*)(p.ws + OFF_BAR), st);
#define MK_STEP(PH, LAYER, LAST) do { \
    typedef const void* __attribute__((address_space(4))) * KArgs; \
    KArgs ka = (KArgs)__builtin_amdgcn_kernarg_segment_ptr(); \
    asm volatile("" : "+s"(ka)); \
    Params q; \
    { const void** dst = (const void**)&q; _Pragma("unroll") for (int i = 0; i < 27; ++i) dst[i] = ka[i]; } \
    run_phase(q, PH, LAYER, id, smem, sh); \
    if (!(LAST)) xcd_barrier(xb); } while (0)
  MK_STEP(PH_PREP0, 0, false);
  MK_STEP(PH_H0, 0, false);
  MK_STEP(PH_INPROJ, 0, false); MK_STEP(PH_PREP, 0, false); MK_STEP(PH_QKV, 0, false); MK_STEP(PH_ATT, 0, false); MK_STEP(PH_SSDOUT, 0, false);
  MK_STEP(PH_WOUT, 0, false); MK_STEP(PH_POSTMIX, 0, false); MK_STEP(PH_FF1, 0, false); MK_STEP(PH_FF2, 0, false); MK_STEP(PH_POSTFFN, 0, false);
  MK_STEP(PH_INPROJ, 1, false); MK_STEP(PH_PREP, 1, false); MK_STEP(PH_QKV, 1, false); MK_STEP(PH_ATT, 1, false); MK_STEP(PH_SSDOUT, 1, false);
  MK_STEP(PH_WOUT, 1, false); MK_STEP(PH_POSTMIX, 1, false); MK_STEP(PH_FF1, 1, false); MK_STEP(PH_FF2, 1, false); MK_STEP(PH_POSTFFN, 1, true);
#undef MK_STEP
}

extern "C" void kernel_launch(void* const* d_in, const int* in_sizes, int n_in, void* d_out, int out_size, void* d_ws, size_t ws_size,
                              hipStream_t stream) {
  if (ws_size < WS_NEED) { fprintf(stderr, "workspace too small: %zu < %zu\n", ws_size, (size_t)WS_NEED); return; }
  Params p{};
  const float** f = (const float**)&p;
  for (int i = 0; i < 25; ++i) f[i] = (const float*)d_in[i];
  p.out = (float*)d_out;
  p.ws = (char*)d_ws;
  static int grid_blocks = 0;
  if (!grid_blocks) {
    int dev = 0, cus = 0, per_cu = 0;
    hipGetDevice(&dev);
    hipDeviceGetAttribute(&cus, hipDeviceAttributeMultiprocessorCount, dev);
    hipFuncSetAttribute((const void*)mega_kernel, hipFuncAttributeMaxDynamicSharedMemorySize, 2 * SMEM_BYTES);
    hipOccupancyMaxActiveBlocksPerMultiprocessor(&per_cu, mega_kernel, 512, 2 * SMEM_BYTES);
    if (per_cu > 1) per_cu = 1;
    grid_blocks = cus * per_cu;
  }
  hipMemsetAsync((char*)d_ws + OFF_BAR, 0, XCD_BAR_WORDS * 4, stream);
  void* args[] = {&p};
  hipError_t e = hipLaunchCooperativeKernel((void*)mega_kernel, dim3(grid_blocks), dim3(512), args, 2 * SMEM_BYTES, stream);
  if (e != hipSuccess) fprintf(stderr, "cooperative launch failed: %s (grid %d)\n", hipGetErrorString(e), grid_blocks);
}
```

```cpp
#include <hip/hip_runtime.h>
#include <hip/hip_cooperative_groups.h>
#include <stdint.h>
#include <stdio.h>
namespace cg = cooperative_groups;

#ifndef MEGA
#define MEGA 1
#endif
#ifndef REP_GEMM
#define REP_GEMM 1
#endif
#ifndef REP_ATT
#define REP_ATT 1
#endif
#ifndef REP_SSD
#define REP_SSD 1
#endif

typedef unsigned short bf16_t;
using bf16x8 = __attribute__((ext_vector_type(8))) short;
using s16x4  = __attribute__((ext_vector_type(4))) short;
using f32x4  = __attribute__((ext_vector_type(4))) float;
using f32x16 = __attribute__((ext_vector_type(16))) float;
using u32x4  = __attribute__((ext_vector_type(4))) unsigned;
using u32x2  = __attribute__((ext_vector_type(2))) unsigned;
#define DI __device__ __forceinline__
#define MFMA32(a, b, c) __builtin_amdgcn_mfma_f32_32x32x16_bf16((a), (b), (c), 0, 0, 0)
#define MFMA16(a, b, c) __builtin_amdgcn_mfma_f32_16x16x32_bf16((a), (b), (c), 0, 0, 0)

constexpr int DM = 1024, NB = 4, SEQ = 4096, CTX = 256;
constexpr int ML = NB * SEQ;
constexpr int MC = NB * CTX;
constexpr int MT = ML + MC;
constexpr int DIN = 2480, DINP = 2560;
constexpr int LK = CTX + SEQ;
constexpr int DFF = 4096;
constexpr int NCH = 34;
constexpr float EPS = 1e-6f;
constexpr int U_CKV = 256, U_KR = 384, U_GB = 416, U_GC = 672, U_VAL = 928, U_Z = 1184, U_XBC = 1696, U_DT = 2464;

constexpr size_t AL(size_t x) { return (x + 255) & ~(size_t)255; }
constexpr size_t WT_IN = 0;
constexpr size_t WT_UQ = WT_IN + (size_t)DINP * 1024;
constexpr size_t WT_UKV = WT_UQ + (size_t)384 * 256;
constexpr size_t WT_OUT = WT_UKV + (size_t)512 * 128;
constexpr size_t WT_FF1 = WT_OUT + (size_t)1024 * 1024;
constexpr size_t WT_FF2 = WT_FF1 + (size_t)4096 * 1024;
constexpr size_t WT_ELEMS = WT_FF2 + (size_t)4096 * 1024;
constexpr size_t OFF_WT = 0;
constexpr size_t OFF_MOD = AL(OFF_WT + 2 * WT_ELEMS * 2);
constexpr size_t OFF_XC = AL(OFF_MOD + 2 * 5 * 6144 * 4);
constexpr size_t OFF_H = AL(OFF_XC + (size_t)MC * DM * 4);
constexpr size_t OFF_R1 = AL(OFF_H + (size_t)MT * DM * 2);
constexpr size_t OFF_U = OFF_R1;
constexpr size_t OFF_DT = AL(OFF_U + (size_t)MT * DIN * 2);
constexpr size_t OFF_RSTD = AL(OFF_DT + (size_t)MT * 16 * 4);
constexpr size_t OFF_QB = AL(OFF_RSTD + (size_t)MT * 2 * 4);
constexpr size_t OFF_KB = AL(OFF_QB + (size_t)MT * 384 * 2);
constexpr size_t OFF_VT = AL(OFF_KB + (size_t)NB * 4 * LK * 96 * 2);
constexpr size_t OFF_XBC = AL(OFF_VT + (size_t)NB * 4 * 64 * LK * 2);
constexpr size_t OFF_SST = AL(OFF_XBC + (size_t)MT * 768 * 2);
constexpr size_t OFF_TDEC = AL(OFF_SST + (size_t)2 * NB * NCH * 8 * 4096 * 2);
constexpr size_t OFF_SSQ = AL(OFF_TDEC + (size_t)2 * NB * NCH * 8 * 4);
constexpr size_t OFF_END1 = AL(OFF_SSQ + (size_t)MT * 8 * 4);
constexpr size_t OFF_F1 = OFF_R1;
constexpr size_t OFF_END2 = AL(OFF_F1 + (size_t)MT * DFF * 2);
constexpr size_t OFF_BAR = OFF_END1 > OFF_END2 ? OFF_END1 : OFF_END2;
constexpr size_t WS_NEED = OFF_BAR + 16384;

struct Params {
  const float *x, *c, *ctx, *c_ctx, *w_mod, *b_mod, *g_pre_mix, *w_in, *q_norm, *w_uq, *kv_norm, *w_ukv, *sc_w, *ssd_cw, *ssd_cb,
      *a_log, *dt_bias, *ssd_d, *ssd_norm, *w_out, *g_post_mix, *g_pre_ffn, *w_ff1, *w_ff2, *g_post_ffn;
  float* out;
  char* ws;
};

DI int ltid() { int t = threadIdx.x; asm volatile("" : "+v"(t)); return t & 255; }
DI int ltid512() { int t = threadIdx.x; asm volatile("" : "+v"(t)); return t; }
typedef __bf16 hbf2 __attribute__((ext_vector_type(2)));
typedef float hf2 __attribute__((ext_vector_type(2)));
DI bf16_t f2bf(float x) { return __builtin_bit_cast(bf16_t, (__bf16)x); }
DI float bf2f(unsigned v) { return __uint_as_float(v << 16); }
DI unsigned pack2(float a, float b) { hf2 v = {a, b}; return __builtin_bit_cast(unsigned, __builtin_convertvector(v, hbf2)); }
DI float lo2f(unsigned w) { return __uint_as_float(w << 16); }
DI float hi2f(unsigned w) { return __uint_as_float(w & 0xffff0000u); }
DI float wave_sum(float v) {
#pragma unroll
  for (int o = 32; o > 0; o >>= 1) v += __shfl_xor(v, o);
  return v;
}
DI float silu_f(float x) { return x / (1.f + __expf(-x)); }
DI int crow(int reg, int h) { return (reg & 3) + 8 * (reg >> 2) + 4 * h; }
DI bf16x8 pack8(const f32x16& x, int s) {
  u32x4 p;
  p[0] = pack2(x[8 * s + 0], x[8 * s + 1]); p[1] = pack2(x[8 * s + 2], x[8 * s + 3]);
  p[2] = pack2(x[8 * s + 4], x[8 * s + 5]); p[3] = pack2(x[8 * s + 6], x[8 * s + 7]);
  return __builtin_bit_cast(bf16x8, p);
}
DI const float* xin_row(const Params& p, int layer, int row) {
  if (layer == 0) return row < ML ? p.x + (size_t)row * DM : p.ctx + (size_t)(row - ML) * DM;
  return row < ML ? p.out + (size_t)row * DM : (const float*)(p.ws + OFF_XC) + (size_t)(row - ML) * DM;
}
DI float* xst_row(const Params& p, int row) {
  return row < ML ? p.out + (size_t)row * DM : (float*)(p.ws + OFF_XC) + (size_t)(row - ML) * DM;
}
DI const float* mod_ptr(const Params& p, int layer, int row, int which) {
  int bb = row < ML ? (row >> 12) : 4;
  return (const float*)(p.ws + OFF_MOD) + ((size_t)(layer * 5 + bb) * 6 + which) * DM;
}
DI bf16_t* wt_ptr(const Params& p, int layer, size_t off) { return (bf16_t*)(p.ws + OFF_WT) + (size_t)layer * WT_ELEMS + off; }

DI void transpose_item(const float* __restrict__ w, const float* __restrict__ gk, int gk_from, bf16_t* __restrict__ wt, int K, int N, int kt, int nt, char* smem) {
  float* tile = (float*)smem;
  const int tid = ltid(), tx = tid & 63, ty = tid >> 6;
  const int k0 = kt * 64, n0 = nt * 64;
  const int n = n0 + tx;
  float v[16];
#pragma unroll
  for (int i = 0; i < 16; ++i) {
    int kk = ty + 4 * i;
    v[i] = n < N ? w[(size_t)(k0 + kk) * N + n] : 0.f;
  }
  if (gk) {
#pragma unroll
    for (int i = 0; i < 16; ++i) { int k = k0 + ty + 4 * i; if (k >= gk_from) v[i] *= gk[k - gk_from]; }
  }
#pragma unroll
  for (int i = 0; i < 16; ++i) tile[(ty + 4 * i) * 65 + tx] = v[i];
  __syncthreads();
#pragma unroll
  for (int i = 0; i < 2; ++i) {
    int c = tid + 256 * i, nn = c >> 3, kc = c & 7;
    u32x4 o;
#pragma unroll
    for (int jj = 0; jj < 4; ++jj) o[jj] = pack2(tile[(kc * 8 + 2 * jj) * 65 + nn], tile[(kc * 8 + 2 * jj + 1) * 65 + nn]);
    *(u32x4*)(wt + (size_t)(n0 + nn) * K + k0 + kc * 8) = o;
  }
  __syncthreads();
}

DI void modgemv_item(const Params& p, int layer, int ct, char* smem) {
  float* s = (float*)smem;
  float* red = s + 5 * 1024;
  const int tid = ltid(), w = tid >> 6, lane = tid & 63, ln = lane & 31, kh = lane >> 5;
  for (int i = tid; i < 5 * 1024; i += 256) {
    int bb = i >> 10, k = i & 1023;
    float v = bb < 4 ? p.c[bb * 1024 + k] : p.c_ctx[k];
    s[i] = silu_f(v);
  }
  __syncthreads();
  const float* wm = p.w_mod + (size_t)layer * 1024 * 6144;
  const int n = ct * 32 + ln;
  float acc[5] = {0.f, 0.f, 0.f, 0.f, 0.f};
#pragma unroll 16
  for (int i = 0; i < 128; ++i) {
    const int k = w * 256 + 2 * i + kh;
    float wv = wm[(size_t)k * 6144 + n];
#pragma unroll
    for (int bb = 0; bb < 5; ++bb) acc[bb] += s[bb * 1024 + k] * wv;
  }
#pragma unroll
  for (int bb = 0; bb < 5; ++bb) {
    acc[bb] += __shfl_xor(acc[bb], 32);
    if (kh == 0) red[(w * 5 + bb) * 32 + ln] = acc[bb];
  }
  __syncthreads();
  if (tid < 160) {
    int bb = tid >> 5, l2 = tid & 31;
    float v = red[(0 * 5 + bb) * 32 + l2] + red[(1 * 5 + bb) * 32 + l2] + red[(2 * 5 + bb) * 32 + l2] + red[(3 * 5 + bb) * 32 + l2];
    int nn = ct * 32 + l2;
    v += p.b_mod[layer * 6144 + nn];
    ((float*)(p.ws + OFF_MOD))[(size_t)(layer * 5 + bb) * 6144 + nn] = v;
  }
  __syncthreads();
}

constexpr int WT_ITEMS = 2984;
DI void wt_item(const Params& p, int layer, int j, char* smem) {
  if (j < 640) transpose_item(p.w_in + (size_t)layer * 1024 * DIN, nullptr, 0, wt_ptr(p, layer, WT_IN), 1024, DIN, j / 40, j % 40, smem);
  else if ((j -= 640) < 24) transpose_item(p.w_uq + (size_t)layer * 256 * 384, p.q_norm + layer * 256, 0, wt_ptr(p, layer, WT_UQ), 256, 384, j / 6, j % 6, smem);
  else if ((j -= 24) < 16) transpose_item(p.w_ukv + (size_t)layer * 128 * 512, p.kv_norm + layer * 128, 0, wt_ptr(p, layer, WT_UKV), 128, 512, j / 8, j % 8, smem);
  else if ((j -= 16) < 256) transpose_item(p.w_out + (size_t)layer * 1024 * 1024, p.ssd_norm + layer * 512, 512, wt_ptr(p, layer, WT_OUT), 1024, 1024, j / 16, j % 16, smem);
  else if ((j -= 256) < 1024) transpose_item(p.w_ff1 + (size_t)layer * 1024 * 4096, nullptr, 0, wt_ptr(p, layer, WT_FF1), 1024, 4096, j / 64, j % 64, smem);
  else { j -= 1024; transpose_item(p.w_ff2 + (size_t)layer * 4096 * 1024, nullptr, 0, wt_ptr(p, layer, WT_FF2), 4096, 1024, j / 16, j % 16, smem); }
}
DI void phase_prep0(const Params& p, int bid, int nb, char* smem) {
  for (int it = bid; it < 384 + 640; it += nb) {
    if (it < 384) modgemv_item(p, it / 192, it % 192, smem);
    else wt_item(p, 0, it - 384, smem);
  }
}
struct HMod { float4 g[4], s1[4], s0[4]; };
DI void load_hmod(HMod& m, const float* g, const float* sh, const float* sc, int lane) {
#pragma unroll
  for (int i = 0; i < 4; ++i) {
    const int col = lane * 4 + 256 * i;
    m.g[i] = *(const float4*)(g + col); m.s1[i] = *(const float4*)(sc + col); m.s0[i] = *(const float4*)(sh + col);
  }
}
DI void write_h_row(const float4 xv[4], float rstd, const HMod& m, bf16_t* hrow, int lane) {
#pragma unroll
  for (int i = 0; i < 4; ++i) {
    const int col = lane * 4 + 256 * i;
    float a = xv[i].x * rstd * m.g[i].x * (1.f + m.s1[i].x) + m.s0[i].x;
    float b = xv[i].y * rstd * m.g[i].y * (1.f + m.s1[i].y) + m.s0[i].y;
    float c = xv[i].z * rstd * m.g[i].z * (1.f + m.s1[i].z) + m.s0[i].z;
    float d = xv[i].w * rstd * m.g[i].w * (1.f + m.s1[i].w) + m.s0[i].w;
    u32x2 o; o[0] = pack2(a, b); o[1] = pack2(c, d);
    *(u32x2*)(hrow + col) = o;
  }
}
DI float ssq4(const float4 v[4]) {
  float s = 0.f;
#pragma unroll
  for (int i = 0; i < 4; ++i) s += v[i].x * v[i].x + v[i].y * v[i].y + v[i].z * v[i].z + v[i].w * v[i].w;
  return s;
}
DI void load_bf_row(const bf16_t* r, int lane, float4 v[4]) {
#pragma unroll
  for (int i = 0; i < 4; ++i) {
    u32x2 t = *(const u32x2*)(r + lane * 4 + 256 * i);
    v[i] = make_float4(lo2f(t[0]), hi2f(t[0]), lo2f(t[1]), hi2f(t[1]));
  }
}

struct RowVec { float4 c1[4], c2[4], c3[4]; };
DI const float* mod_ptr_b(const Params& p, int layer, int bb, int which) {
  return (const float*)(p.ws + OFF_MOD) + ((size_t)(layer * 5 + bb) * 6 + which) * DM;
}
template <int MODE>
DI void rowwise_phase(const Params& p, int layer, int bid, int nb) {
  const int w = ltid() >> 6, lane = ltid() & 63;
  const int M = (MODE == 0 || layer == 0) ? MT : ML;
  const bool wh = MODE != 2 || layer == 0;
  bf16_t* H = (bf16_t*)(p.ws + OFF_H);
  const bf16_t* Y = MODE == 1 ? (const bf16_t*)(p.ws + OFF_U) : (const bf16_t*)(p.ws + OFF_H);
  const int NW = nb * 4, W = bid * 4 + w, nwb = NW >> 2;
  auto load_vec = [&](RowVec& v, int bb) {
    const float* gate = MODE == 1 ? mod_ptr_b(p, layer, bb, 2) : mod_ptr_b(p, layer, bb, 5);
    const float* gres = MODE == 1 ? p.g_post_mix + layer * DM : p.g_post_ffn + layer * DM;
    const int hl = MODE == 2 ? 1 : layer;
    const float* gn = MODE == 1 ? p.g_pre_ffn + layer * DM : p.g_pre_mix + hl * DM;
    const float* sh = mod_ptr_b(p, hl, bb, MODE == 1 ? 3 : 0);
    const float* sc = mod_ptr_b(p, hl, bb, MODE == 1 ? 4 : 1);
#pragma unroll
    for (int i = 0; i < 4; ++i) {
      const int col = lane * 4 + 256 * i;
      if (MODE != 0) {
        const float4 a = *(const float4*)(gate + col), b = *(const float4*)(gres + col);
        v.c1[i] = make_float4(a.x * b.x, a.y * b.y, a.z * b.z, a.w * b.w);
      }
      if (wh) {
        const float4 g = *(const float4*)(gn + col), s1 = *(const float4*)(sc + col);
        v.c2[i] = make_float4(g.x * (1.f + s1.x), g.y * (1.f + s1.y), g.z * (1.f + s1.z), g.w * (1.f + s1.w));
        v.c3[i] = *(const float4*)(sh + col);
      }
    }
  };
  struct RowIn { u32x2 y[4]; float4 x[4]; };
  auto load_row = [&](RowIn& r, int row) {
    const float* xr = MODE == 2 ? (const float*)xst_row(p, row) : xin_row(p, layer, row);
#pragma unroll
    for (int i = 0; i < 4; ++i) {
      r.x[i] = *(const float4*)(xr + lane * 4 + 256 * i);
      if (MODE != 0) r.y[i] = *(const u32x2*)(Y + (size_t)row * DM + lane * 4 + 256 * i);
    }
  };
  auto finish = [&](float4 (&xv)[4], const float4 (&yv)[4], const RowVec& v, int row) {
    if (MODE != 0) {
      const float rstd = rsqrtf(wave_sum(ssq4(yv)) * (1.f / DM) + EPS);
#pragma unroll
      for (int i = 0; i < 4; ++i) {
        xv[i].x += yv[i].x * rstd * v.c1[i].x; xv[i].y += yv[i].y * rstd * v.c1[i].y;
        xv[i].z += yv[i].z * rstd * v.c1[i].z; xv[i].w += yv[i].w * rstd * v.c1[i].w;
      }
      float* xo = xst_row(p, row);
#pragma unroll
      for (int i = 0; i < 4; ++i) *(float4*)(xo + lane * 4 + 256 * i) = xv[i];
    }
    if (wh) {
      const float rstd1 = rsqrtf(wave_sum(ssq4(xv)) * (1.f / DM) + EPS);
      bf16_t* hrow = H + (size_t)row * DM;
#pragma unroll
      for (int i = 0; i < 4; ++i) {
        u32x2 o;
        o[0] = pack2(xv[i].x * rstd1 * v.c2[i].x + v.c3[i].x, xv[i].y * rstd1 * v.c2[i].y + v.c3[i].y);
        o[1] = pack2(xv[i].z * rstd1 * v.c2[i].z + v.c3[i].z, xv[i].w * rstd1 * v.c2[i].w + v.c3[i].w);
        *(u32x2*)(hrow + lane * 4 + 256 * i) = o;
      }
    }
  };
  auto process = [&](RowIn& r, const RowVec& v, int row) {
    float4 yv[4];
#pragma unroll
    for (int i = 0; i < 4; ++i) yv[i] = make_float4(lo2f(r.y[i][0]), hi2f(r.y[i][0]), lo2f(r.y[i][1]), hi2f(r.y[i][1]));
    finish(r.x, yv, v, row);
  };
  RowVec v;
  {
    const int bb = W / nwb, j = W - bb * nwb, end = SEQ * (bb + 1);
    load_vec(v, bb);
    RowIn ra, rb;
    int row = SEQ * bb + j;
    if (row < end) load_row(ra, row);
    while (row < end) {
      const int rowb = row + nwb;
      const bool hb = rowb < end;
      if (hb) load_row(rb, rowb);
      process(ra, v, row);
      if (!hb) break;
      const int rowa = rowb + nwb;
      const bool ha = rowa < end;
      if (ha) load_row(ra, rowa);
      process(rb, v, rowb);
      if (!ha) break;
      row = rowa;
    }
  }
  if (M > ML) {
    load_vec(v, 4);
    for (int row = ML + W; row < M; row += NW) {
      float4 xv[4], yv[4];
      const float* xr = MODE == 2 ? (const float*)xst_row(p, row) : xin_row(p, layer, row);
#pragma unroll
      for (int i = 0; i < 4; ++i) xv[i] = *(const float4*)(xr + lane * 4 + 256 * i);
      if (MODE != 0) {
        const float* pp = (const float*)(p.ws + (MODE == 1 ? OFF_QB : OFF_END2)) + (size_t)(row - ML) * DM;
#pragma unroll
        for (int i = 0; i < 4; ++i) {
          float4 a = *(const float4*)(pp + lane * 4 + 256 * i), b = *(const float4*)(pp + (size_t)MC * DM + lane * 4 + 256 * i);
          float4 c = *(const float4*)(pp + (size_t)2 * MC * DM + lane * 4 + 256 * i), d = *(const float4*)(pp + (size_t)3 * MC * DM + lane * 4 + 256 * i);
          yv[i] = make_float4((a.x + b.x) + (c.x + d.x), (a.y + b.y) + (c.y + d.y), (a.z + b.z) + (c.z + d.z), (a.w + b.w) + (c.w + d.w));
        }
      }
      finish(xv, yv, v, row);
    }
  }
}
DI void phase_h0(const Params& p, int bid, int nb) { rowwise_phase<0>(p, 0, bid, nb); }
DI void phase_postmix(const Params& p, int layer, int bid, int nb) { rowwise_phase<1>(p, layer, bid, nb); }
DI void phase_postffn(const Params& p, int layer, int bid, int nb) { rowwise_phase<2>(p, layer, bid, nb); }

DI void phase_prep(const Params& p, int layer, int bid, int nb) {
  const int w = ltid() >> 6, lane = ltid() & 63;
  const bf16_t* U = (const bf16_t*)(p.ws + OFF_U);
  float* DT = (float*)(p.ws + OFF_DT);
  float* RS = (float*)(p.ws + OFF_RSTD);
  bf16_t* KB = (bf16_t*)(p.ws + OFF_KB);
  bf16_t* XBC = (bf16_t*)(p.ws + OFF_XBC);
  bf16_t* YM = (bf16_t*)(p.ws + OFF_H);
  const float* scw = p.sc_w + layer * 3 * 256;
  const float* cw = p.ssd_cw + layer * 3 * 768;
  const float* cb = p.ssd_cb + layer * 768;
  const int c4 = lane * 4;
  const float4 sw0 = *(const float4*)(scw + c4), sw1 = *(const float4*)(scw + 256 + c4), sw2 = *(const float4*)(scw + 512 + c4);
  float4 cwk[3][3], cbi[3];
#pragma unroll
  for (int i = 0; i < 3; ++i) {
    cbi[i] = *(const float4*)(cb + c4 + 256 * i);
#pragma unroll
    for (int k = 0; k < 3; ++k) cwk[i][k] = *(const float4*)(cw + k * 768 + c4 + 256 * i);
  }
  const float dtb = p.dt_bias[layer * 16 + (lane & 15)];
  const float invf = exp2f(-(float)(2 * (lane & 7)) * (13.287712379549449f / 16.f));
  for (int row = bid * 4 + w; row < MT; row += nb * 4) {
    int b, t, L, pos;
    const bool lat = row < ML;
    if (lat) { b = row >> 12; t = row & 4095; L = SEQ; pos = t + CTX; }
    else { int rr = row - ML; b = rr >> 8; t = rr & 255; L = CTX; pos = t; }
    const bf16_t* u0 = U + (size_t)row * DIN;
    const bool hp = t > 0, hn = t < L - 1;
    const bf16_t* um = hp ? u0 - DIN : u0;
    const bf16_t* up = hn ? u0 + DIN : u0;
    const float mp = hp ? 1.f : 0.f, mn = hn ? 1.f : 0.f;
    const u32x2 vq = *(const u32x2*)(u0 + c4);
    const u32x2 vkv = *(const u32x2*)(u0 + U_CKV + (lane & 31) * 4);
    const float kr = bf2f(u0[U_KR + (lane & 31)]);
    const u32x2 gcm = *(const u32x2*)(um + U_GC + c4), gc0 = *(const u32x2*)(u0 + U_GC + c4), gcp = *(const u32x2*)(up + U_GC + c4);
    const u32x2 vvm = *(const u32x2*)(um + U_VAL + c4), vv0 = *(const u32x2*)(u0 + U_VAL + c4), vvp = *(const u32x2*)(up + U_VAL + c4);
    const u32x2 gb = *(const u32x2*)(u0 + U_GB + c4);
    u32x2 xm[3], x0[3], xp[3];
#pragma unroll
    for (int i = 0; i < 3; ++i) {
      xm[i] = *(const u32x2*)(um + U_XBC + c4 + 256 * i);
      x0[i] = *(const u32x2*)(u0 + U_XBC + c4 + 256 * i);
      xp[i] = *(const u32x2*)(up + U_XBC + c4 + 256 * i);
    }
    const float dtr = DT[(size_t)row * 16 + (lane & 15)];
    {
      float a = lo2f(vq[0]), bq = hi2f(vq[0]), c = lo2f(vq[1]), d = hi2f(vq[1]);
      float ss = wave_sum(a * a + bq * bq + c * c + d * d);
      float e = lo2f(vkv[0]), f = hi2f(vkv[0]), g = lo2f(vkv[1]), h = hi2f(vkv[1]);
      float s2 = lane < 32 ? e * e + f * f + g * g + h * h : 0.f;
      s2 = wave_sum(s2);
      if (lane == 0) { RS[row * 2] = rsqrtf(ss * (1.f / 256) + EPS); RS[row * 2 + 1] = rsqrtf(s2 * (1.f / 128) + EPS); }
    }
    {
      const float partner = __shfl_xor(kr, 8);
      float o = kr;
      if (lat) {
        const int grp = (lane & 31) >> 3;
        const float posf = grp < 2 ? (float)(t >> 6) : (float)(t & 63);
        const float rev = posf * invf * 0.15915494309189535f;
        const float cs = __builtin_amdgcn_cosf(rev), sn = __builtin_amdgcn_sinf(rev);
        o = (grp & 1) ? kr * cs + partner * sn : kr * cs - partner * sn;
      }
      if (lane < 32) {
        const bf16_t ob = f2bf(o);
#pragma unroll
        for (int hd = 0; hd < 4; ++hd) KB[((size_t)(b * 4 + hd) * LK + pos) * 96 + 64 + lane] = ob;
      }
    }
    {
      float a0 = sw1.x * lo2f(gc0[0]) * lo2f(vv0[0]) + mp * sw0.x * lo2f(gcm[0]) * lo2f(vvm[0]) + mn * sw2.x * lo2f(gcp[0]) * lo2f(vvp[0]);
      float a1 = sw1.y * hi2f(gc0[0]) * hi2f(vv0[0]) + mp * sw0.y * hi2f(gcm[0]) * hi2f(vvm[0]) + mn * sw2.y * hi2f(gcp[0]) * hi2f(vvp[0]);
      float a2 = sw1.z * lo2f(gc0[1]) * lo2f(vv0[1]) + mp * sw0.z * lo2f(gcm[1]) * lo2f(vvm[1]) + mn * sw2.z * lo2f(gcp[1]) * lo2f(vvp[1]);
      float a3 = sw1.w * hi2f(gc0[1]) * hi2f(vv0[1]) + mp * sw0.w * hi2f(gcm[1]) * hi2f(vvm[1]) + mn * sw2.w * hi2f(gcp[1]) * hi2f(vvp[1]);
      u32x2 o; o[0] = pack2(lo2f(gb[0]) * a0, hi2f(gb[0]) * a1); o[1] = pack2(lo2f(gb[1]) * a2, hi2f(gb[1]) * a3);
      *(u32x2*)(YM + (size_t)row * DM + 256 + c4) = o;
    }
#pragma unroll
    for (int i = 0; i < 3; ++i) {
      float a0 = cbi[i].x + cwk[i][1].x * lo2f(x0[i][0]) + mp * cwk[i][0].x * lo2f(xm[i][0]) + mn * cwk[i][2].x * lo2f(xp[i][0]);
      float a1 = cbi[i].y + cwk[i][1].y * hi2f(x0[i][0]) + mp * cwk[i][0].y * hi2f(xm[i][0]) + mn * cwk[i][2].y * hi2f(xp[i][0]);
      float a2 = cbi[i].z + cwk[i][1].z * lo2f(x0[i][1]) + mp * cwk[i][0].z * lo2f(xm[i][1]) + mn * cwk[i][2].z * lo2f(xp[i][1]);
      float a3 = cbi[i].w + cwk[i][1].w * hi2f(x0[i][1]) + mp * cwk[i][0].w * hi2f(xm[i][1]) + mn * cwk[i][2].w * hi2f(xp[i][1]);
      u32x2 o; o[0] = pack2(silu_f(a0), silu_f(a1)); o[1] = pack2(silu_f(a2), silu_f(a3));
      *(u32x2*)(XBC + (size_t)row * 768 + c4 + 256 * i) = o;
    }
    if (lane < 16) {
      const float v = dtr + dtb;
      const float e = __expf(-fabsf(v));
      DT[(size_t)row * 16 + lane] = fmaxf(v, 0.f) + (e < 1e-3f ? e * (1.f - 0.5f * e) : __logf(1.f + e));
    }
  }
}

DI void phase_ssdnorm(const Params& p, int layer, int bid, int nb) {
  const int w = ltid() >> 6, lane = ltid() & 63;
  const int M = layer == 0 ? MT : ML;
  bf16_t* YM = (bf16_t*)(p.ws + OFF_H);
  const float* SSQ = (const float*)(p.ws + OFF_SSQ);
  const float* ng = p.ssd_norm + layer * 512;
  for (int row = bid * 4 + w; row < M; row += nb * 4) {
    int g = lane >> 5;
    float4 s = *(const float4*)(SSQ + (size_t)row * 8 + g * 4);
    float rstd = rsqrtf((s.x + s.y + s.z + s.w) * (1.f / 256) + EPS);
    bf16_t* ptr = YM + (size_t)row * DM + 512 + lane * 8;
    u32x4 v = *(const u32x4*)ptr;
    float4 g0 = *(const float4*)(ng + lane * 8), g1 = *(const float4*)(ng + lane * 8 + 4);
    u32x4 o;
    o[0] = pack2(lo2f(v[0]) * rstd * g0.x, hi2f(v[0]) * rstd * g0.y);
    o[1] = pack2(lo2f(v[1]) * rstd * g0.z, hi2f(v[1]) * rstd * g0.w);
    o[2] = pack2(lo2f(v[2]) * rstd * g1.x, hi2f(v[2]) * rstd * g1.y);
    o[3] = pack2(lo2f(v[3]) * rstd * g1.z, hi2f(v[3]) * rstd * g1.w);
    *(u32x4*)ptr = o;
  }
}

constexpr int GST = 80;
constexpr int GBUF = 2 * 128 * GST;
template <bool GN, class Epi>
DI void gemm_tile(const bf16_t* __restrict__ A, int lda, const bf16_t* __restrict__ Bt, int K, int row0, int col0, char* smem, Epi epi, const float* __restrict__ ssq = nullptr) {
  bf16_t* S0 = (bf16_t*)smem;
  const int tid = ltid(), wid = tid >> 6, lane = tid & 63, wr = wid >> 1, wc = wid & 1, fr = lane & 15, fq = lane >> 4;
  f32x4 acc[4][4];
#pragma unroll
  for (int m = 0; m < 4; ++m)
#pragma unroll
    for (int n = 0; n < 4; ++n) acc[m][n] = f32x4{0.f, 0.f, 0.f, 0.f};
  u32x4 ra[4], rb[4];
  const int sr = tid >> 3, sp = tid & 7;
  const bf16_t* ga = A + (size_t)(row0 + sr) * lda + sp * 8;
  const bf16_t* gb = Bt + (size_t)(col0 + sr) * K + sp * 8;
  auto gload = [&](int k0) {
#pragma unroll
    for (int i = 0; i < 4; ++i) {
      ra[i] = *(const u32x4*)(ga + (size_t)(32 * i) * lda + k0);
      rb[i] = *(const u32x4*)(gb + (size_t)(32 * i) * K + k0);
    }
  };
  gload(0);
  float gs[4][2];
  if (GN) {
#pragma unroll
    for (int i = 0; i < 4; ++i) {
      const float4 s0 = *(const float4*)(ssq + (size_t)(row0 + sr + 32 * i) * 8), s1 = *(const float4*)(ssq + (size_t)(row0 + sr + 32 * i) * 8 + 4);
      gs[i][0] = rsqrtf((s0.x + s0.y + s0.z + s0.w) * (1.f / 256) + EPS);
      gs[i][1] = rsqrtf((s1.x + s1.y + s1.z + s1.w) * (1.f / 256) + EPS);
    }
  }
  auto swrite = [&](int kt) {
    if (GN && kt >= 8) {
      const int g = (kt - 8) >> 2;
#pragma unroll
      for (int i = 0; i < 4; ++i) {
        const float sc = g ? gs[i][1] : gs[i][0];
#pragma unroll
        for (int jj = 0; jj < 4; ++jj) ra[i][jj] = pack2(lo2f(ra[i][jj]) * sc, hi2f(ra[i][jj]) * sc);
      }
    }
    bf16_t* As = S0 + (kt & 1) * GBUF;
    bf16_t* Bs = As + 128 * GST;
#pragma unroll
    for (int i = 0; i < 4; ++i) {
      *(u32x4*)(As + (sr + 32 * i) * GST + sp * 8) = ra[i];
      *(u32x4*)(Bs + (sr + 32 * i) * GST + sp * 8) = rb[i];
    }
  };
  const int KT = K / 64;
  swrite(0);
  if (KT > 1) gload(64);
  __syncthreads();
  for (int kt = 0; kt < KT; ++kt) {
    const bf16_t* As = S0 + (kt & 1) * GBUF;
    const bf16_t* Bs = As + 128 * GST;
#pragma unroll
    for (int ks = 0; ks < 2; ++ks) {
      bf16x8 af[4], bfr[4];
#pragma unroll
      for (int m = 0; m < 4; ++m) af[m] = *(const bf16x8*)(As + (wr * 64 + m * 16 + fr) * GST + ks * 32 + fq * 8);
#pragma unroll
      for (int n = 0; n < 4; ++n) bfr[n] = *(const bf16x8*)(Bs + (wc * 64 + n * 16 + fr) * GST + ks * 32 + fq * 8);
#pragma unroll
      for (int m = 0; m < 4; ++m)
#pragma unroll
        for (int n = 0; n < 4; ++n) acc[m][n] = MFMA16(bfr[n], af[m], acc[m][n]);
      if (ks == 0 && kt + 1 < KT) {
        swrite(kt + 1);
        if (kt + 2 < KT) gload((kt + 2) * 64);
      }
    }
    __syncthreads();
  }
  float rsc[4];
#pragma unroll
  for (int m = 0; m < 4; ++m) rsc[m] = epi.scale(row0 + wr * 64 + m * 16 + fr);
#pragma unroll
  for (int m = 0; m < 4; ++m)
#pragma unroll
    for (int n = 0; n < 4; ++n) epi(row0 + wr * 64 + m * 16 + fr, col0 + wc * 64 + n * 16 + fq * 4, acc[m][n], rsc[m]);
}

template <class Epi>
DI void gemm_tile_glds(const bf16_t* __restrict__ A, int lda, const bf16_t* __restrict__ Bt, int ldb, int K, int row0, int col0, char* smem, Epi epi) {
  const int tid = ltid(), wid = tid >> 6, lane = tid & 63, wr = wid >> 1, wc = wid & 1, fr = lane & 15, fq = lane >> 4;
  f32x4 acc[4][4];
#pragma unroll
  for (int m = 0; m < 4; ++m)
#pragma unroll
    for (int n = 0; n < 4; ++n) acc[m][n] = f32x4{0.f, 0.f, 0.f, 0.f};
  const int crow = tid >> 3, cslot = tid & 7, cpart = cslot ^ (crow & 7);
  const bf16_t* ga = A + (size_t)(row0 + crow) * lda + cpart * 8;
  const bf16_t* gb = Bt + (size_t)(col0 + crow) * ldb + cpart * 8;
  auto issue = [&](int kt, int stage) {
    char* sa = smem + stage * 32768 + tid * 16;
#pragma unroll
    for (int i = 0; i < 4; ++i) {
      __builtin_amdgcn_global_load_lds((const unsigned*)(ga + (size_t)(32 * i) * lda + kt * 64), (__attribute__((address_space(3))) unsigned*)(sa + i * 4096), 16, 0, 0);
      __builtin_amdgcn_global_load_lds((const unsigned*)(gb + (size_t)(32 * i) * ldb + kt * 64), (__attribute__((address_space(3))) unsigned*)(sa + 16384 + i * 4096), 16, 0, 0);
    }
  };
  const int KT = K / 64;
  issue(0, 0);
  asm volatile("s_waitcnt vmcnt(0)" ::: "memory");
  __syncthreads();
  const int sw = fr & 7;
  for (int kt = 0; kt < KT; ++kt) {
    if (kt + 1 < KT) issue(kt + 1, (kt + 1) & 1);
    const char* As = smem + (kt & 1) * 32768;
    const char* Bs = As + 16384;
#pragma unroll
    for (int ks = 0; ks < 2; ++ks) {
      bf16x8 af[4], bfr[4];
      const int so = ((ks * 4 + fq) ^ sw) * 16;
#pragma unroll
      for (int m = 0; m < 4; ++m) af[m] = *(const bf16x8*)(As + (wr * 64 + m * 16 + fr) * 128 + so);
#pragma unroll
      for (int n = 0; n < 4; ++n) bfr[n] = *(const bf16x8*)(Bs + (wc * 64 + n * 16 + fr) * 128 + so);
#pragma unroll
      for (int m = 0; m < 4; ++m)
#pragma unroll
        for (int n = 0; n < 4; ++n) acc[m][n] = MFMA16(bfr[n], af[m], acc[m][n]);
    }
    asm volatile("s_waitcnt vmcnt(0)" ::: "memory");
    __syncthreads();
  }
  float rsc[4];
#pragma unroll
  for (int m = 0; m < 4; ++m) rsc[m] = epi.scale(row0 + wr * 64 + m * 16 + fr);
#pragma unroll
  for (int m = 0; m < 4; ++m)
#pragma unroll
    for (int n = 0; n < 4; ++n) epi(row0 + wr * 64 + m * 16 + fr, col0 + wc * 64 + n * 16 + fq * 4, acc[m][n], rsc[m]);
}

constexpr int G8_HT = 128 * 64;
DI int g8_lds_byte(int r, int c) {
  int st = (r >> 4) * 2 + (c >> 5), rr = r & 15, cc = c & 31, ob = rr * 64 + cc * 2;
  return st * 1024 + (ob ^ (((ob >> 9) & 1) << 5));
}
DI void g8_stage_rc(int b, int& R, int& C) {
  int st = b / 1024, sb = b % 1024, swz = sb ^ (((sb >> 9) & 1) << 5);
  R = (st >> 1) * 16 + swz / 64; C = (st & 1) * 32 + (swz % 64) / 2;
}
template <bool GN = false, class Epi>
DI void gemm8_tile(const bf16_t* __restrict__ A, int lda, const bf16_t* __restrict__ Bt, int ldb, int K, int brow, int bcol, char* smem, Epi epi,
                   bool first = true, bool has_next = false, int nbrow = 0, int nbcol = 0, const float* __restrict__ ssq = nullptr) {
  bf16_t* shm = (bf16_t*)smem;
  const int tid = ltid512();
  float* gsl = (float*)(smem + 8 * G8_HT * 2);
  if (GN) {
    if (tid < 256) {
      const float* sp = ssq + (size_t)(brow + tid) * 8;
      const float4 s0 = *(const float4*)sp, s1 = *(const float4*)(sp + 4);
      gsl[tid] = rsqrtf((s0.x + s0.y + s0.z + s0.w) * (1.f / 256) + EPS);
      gsl[256 + tid] = rsqrtf((s1.x + s1.y + s1.z + s1.w) * (1.f / 256) + EPS);
    }
    __syncthreads();
  }
#define G8_SA(b, h) (shm + ((b) * 2 + (h)) * G8_HT)
#define G8_SB(b, h) (shm + (4 + (b) * 2 + (h)) * G8_HT)
#define G8_STAGE(P, BASE, LD, br, kt) do { const bf16_t* _g = (BASE) + (size_t)(br) * (LD) + (size_t)(kt) * 64; \
    _Pragma("unroll") for (int _i = 0; _i < 2; ++_i) { int _b = tid * 16 + _i * 8192; int _r, _c; g8_stage_rc(_b, _r, _c); \
      __builtin_amdgcn_global_load_lds((const unsigned*)(_g + (size_t)_r * (LD) + _c), \
        (__attribute__((address_space(3))) unsigned*)((char*)(P) + _b), 16, 0, 0); } } while (0)
#define G8_LDA(dst, b, h) _Pragma("unroll") for (int m = 0; m < 4; ++m) _Pragma("unroll") for (int k = 0; k < 2; ++k) \
    dst[m][k] = *reinterpret_cast<const bf16x8*>((char*)G8_SA(b, h) + g8_lds_byte(wr * 64 + m * 16 + fr, k * 32 + fq * 8))
#define G8_LDB(dst, b, h) _Pragma("unroll") for (int n = 0; n < 2; ++n) _Pragma("unroll") for (int k = 0; k < 2; ++k) \
    dst[n][k] = *reinterpret_cast<const bf16x8*>((char*)G8_SB(b, h) + g8_lds_byte(wc * 32 + n * 16 + fr, k * 32 + fq * 8))
#define G8_MMA(ai, bj, At, Bx) do { __builtin_amdgcn_s_setprio(1); \
    _Pragma("unroll") for (int m = 0; m < 4; ++m) _Pragma("unroll") for (int n = 0; n < 2; ++n) _Pragma("unroll") for (int k = 0; k < 2; ++k) \
      acc[ai][bj][m][n] = __builtin_amdgcn_mfma_f32_16x16x32_bf16(Bx[n][k], At[m][k], acc[ai][bj][m][n], 0, 0, 0); \
    __builtin_amdgcn_s_setprio(0); } while (0)
#define G8_WAIT_V(n) asm volatile("s_waitcnt vmcnt(" #n ")" ::: "memory")
#define G8_WAIT_L(n) asm volatile("s_waitcnt lgkmcnt(" #n ")" ::: "memory")
#define G8_BAR __builtin_amdgcn_s_barrier()
#define G8_SCHED __builtin_amdgcn_sched_barrier(0)
  const int wid = tid >> 6, lane = tid & 63, wr = wid >> 2, wc = wid & 3, fr = lane & 15, fq = lane >> 4;
  f32x4 acc[2][2][4][2];
#pragma unroll
  for (int a = 0; a < 2; ++a)
#pragma unroll
    for (int b = 0; b < 2; ++b)
#pragma unroll
      for (int m = 0; m < 4; ++m)
#pragma unroll
        for (int n = 0; n < 2; ++n) acc[a][b][m][n] = f32x4{0.f, 0.f, 0.f, 0.f};
  bf16x8 At[4][2], B0[2][2], B1[2][2];
  const int nt = K / 64;
  if (first) {
    G8_STAGE(G8_SB(0, 0), Bt, ldb, bcol, 0); G8_STAGE(G8_SA(0, 0), A, lda, brow, 0);
    G8_STAGE(G8_SB(0, 1), Bt, ldb, bcol + 128, 0); G8_STAGE(G8_SA(0, 1), A, lda, brow + 128, 0);
  }
  if (wr == 1) G8_BAR;
  if (first) G8_WAIT_V(4); else G8_WAIT_V(0);
  G8_BAR;
  G8_STAGE(G8_SB(1, 0), Bt, ldb, bcol, 1); G8_STAGE(G8_SA(1, 0), A, lda, brow, 1); G8_STAGE(G8_SB(1, 1), Bt, ldb, bcol + 128, 1);
  G8_WAIT_V(6); G8_BAR;
  for (int t = 0; t < nt - 2; t += 2) {
    if (GN && (t == 8 || t == 12)) {
#pragma unroll
      for (int ai = 0; ai < 2; ++ai)
#pragma unroll
        for (int m = 0; m < 4; ++m) {
          const int rl = ai * 128 + wr * 64 + m * 16 + fr;
          const float f = t == 8 ? 1.f / gsl[rl] : gsl[rl] / gsl[256 + rl];
#pragma unroll
          for (int bj = 0; bj < 2; ++bj)
#pragma unroll
            for (int n = 0; n < 2; ++n) acc[ai][bj][m][n] *= f;
        }
    }
    G8_LDB(B0, 0, 0); G8_SCHED; G8_LDA(At, 0, 0); G8_STAGE(G8_SA(1, 1), A, lda, brow + 128, t + 1);
    G8_WAIT_L(8); G8_BAR; G8_WAIT_L(0); G8_MMA(0, 0, At, B0); G8_BAR; G8_SCHED;
    G8_LDB(B1, 0, 1); G8_STAGE(G8_SB(0, 0), Bt, ldb, bcol, t + 2);
    G8_BAR; G8_WAIT_L(0); G8_MMA(0, 1, At, B1); G8_BAR;
    G8_LDA(At, 0, 1); G8_STAGE(G8_SA(0, 0), A, lda, brow, t + 2);
    G8_BAR; G8_WAIT_L(0); G8_MMA(1, 0, At, B0); G8_BAR; G8_SCHED;
    G8_STAGE(G8_SB(0, 1), Bt, ldb, bcol + 128, t + 2);
    G8_WAIT_V(6); G8_BAR; G8_MMA(1, 1, At, B1); G8_BAR;
    G8_LDB(B0, 1, 0); G8_SCHED; G8_LDA(At, 1, 0); G8_STAGE(G8_SA(0, 1), A, lda, brow + 128, t + 2);
    G8_WAIT_L(8); G8_BAR; G8_WAIT_L(0); G8_MMA(0, 0, At, B0); G8_BAR; G8_SCHED;
    G8_LDB(B1, 1, 1); G8_STAGE(G8_SB(1, 0), Bt, ldb, bcol, t + 3);
    G8_BAR; G8_WAIT_L(0); G8_MMA(0, 1, At, B1); G8_BAR;
    G8_LDA(At, 1, 1); G8_STAGE(G8_SA(1, 0), A, lda, brow, t + 3);
    G8_BAR; G8_WAIT_L(0); G8_MMA(1, 0, At, B0); G8_BAR; G8_SCHED;
    G8_STAGE(G8_SB(1, 1), Bt, ldb, bcol + 128, t + 3);
    G8_WAIT_V(6); G8_BAR; G8_MMA(1, 1, At, B1); G8_BAR;
  }
  { G8_LDB(B0, 0, 0); G8_LDA(At, 0, 0); G8_STAGE(G8_SA(1, 1), A, lda, brow + 128, nt - 1);
    G8_BAR; G8_WAIT_L(0); G8_MMA(0, 0, At, B0); G8_BAR;
    G8_LDB(B1, 0, 1); G8_BAR; G8_WAIT_L(0); G8_MMA(0, 1, At, B1); G8_BAR;
    G8_LDA(At, 0, 1); G8_WAIT_V(4); G8_BAR; G8_WAIT_L(0); G8_MMA(1, 0, At, B0); G8_MMA(1, 1, At, B1); G8_BAR; }
  { G8_LDB(B0, 1, 0); G8_LDA(At, 1, 0); G8_WAIT_V(2); G8_BAR; G8_WAIT_L(0); G8_MMA(0, 0, At, B0); G8_BAR;
    G8_LDB(B1, 1, 1); G8_WAIT_V(0); G8_BAR; G8_WAIT_L(0); G8_MMA(0, 1, At, B1); G8_BAR;
    G8_LDA(At, 1, 1); G8_BAR; G8_WAIT_L(0); G8_MMA(1, 0, At, B0); G8_MMA(1, 1, At, B1); G8_BAR; }
  if (GN) {
#pragma unroll
    for (int ai = 0; ai < 2; ++ai)
#pragma unroll
      for (int m = 0; m < 4; ++m) {
        const float f = gsl[256 + ai * 128 + wr * 64 + m * 16 + fr];
#pragma unroll
        for (int bj = 0; bj < 2; ++bj)
#pragma unroll
          for (int n = 0; n < 2; ++n) acc[ai][bj][m][n] *= f;
      }
  }
  if (has_next) {
    G8_STAGE(G8_SB(0, 0), Bt, ldb, nbcol, 0); G8_STAGE(G8_SA(0, 0), A, lda, nbrow, 0);
    G8_STAGE(G8_SB(0, 1), Bt, ldb, nbcol + 128, 0); G8_STAGE(G8_SA(0, 1), A, lda, nbrow + 128, 0);
  }
  if (wr == 0) G8_BAR;
  const bool odd = fq & 1;
#pragma unroll
  for (int ai = 0; ai < 2; ++ai)
#pragma unroll
    for (int bj = 0; bj < 2; ++bj)
#pragma unroll
      for (int m = 0; m < 4; ++m) {
        const int row = brow + ai * 128 + wr * 64 + m * 16 + fr, cb = bcol + bj * 128 + wc * 32;
        epi.side(row, cb + fq * 4, acc[ai][bj][m][0]);
        epi.side(row, cb + 16 + fq * 4, acc[ai][bj][m][1]);
        const u32x2 p0 = epi.pack(acc[ai][bj][m][0]), p1 = epi.pack(acc[ai][bj][m][1]);
        const u32x2 snd = odd ? p0 : p1;
        u32x2 rcv; rcv[0] = (unsigned)__shfl_xor((int)snd[0], 16); rcv[1] = (unsigned)__shfl_xor((int)snd[1], 16);
        u32x4 o;
        if (odd) { o[0] = rcv[0]; o[1] = rcv[1]; o[2] = p1[0]; o[3] = p1[1]; }
        else     { o[0] = p0[0]; o[1] = p0[1]; o[2] = rcv[0]; o[3] = rcv[1]; }
        epi.store16(row, odd ? cb + 16 + (fq - 1) * 4 : cb + fq * 4, o);
      }
  __syncthreads();
}

struct EpiBF {
  bf16_t* out; int ldo;
  DI void side(int, int, const f32x4&) const {}
  DI u32x2 pack(const f32x4& a) const { u32x2 o; o[0] = pack2(a[0], a[1]); o[1] = pack2(a[2], a[3]); return o; }
  DI void store16(int row, int col, const u32x4& v) const { *(u32x4*)(out + (size_t)row * ldo + col) = v; }
  DI float scale(int) const { return 1.f; }
  DI void operator()(int row, int col, const f32x4& a, float) const { (*this)(row, col, a); }
  DI void operator()(int row, int col, const f32x4& a) const {
    u32x2 o; o[0] = pack2(a[0], a[1]); o[1] = pack2(a[2], a[3]);
    *(u32x2*)(out + (size_t)row * ldo + col) = o;
  }
};
struct EpiRelu2 {
  bf16_t* out; int ldo;
  DI float scale(int) const { return 1.f; }
  DI void operator()(int row, int col, const f32x4& a, float) const { (*this)(row, col, a); }
  DI void side(int, int, const f32x4&) const {}
  DI u32x2 pack(const f32x4& a) const {
    float r0 = fmaxf(a[0], 0.f), r1 = fmaxf(a[1], 0.f), r2 = fmaxf(a[2], 0.f), r3 = fmaxf(a[3], 0.f);
    u32x2 o; o[0] = pack2(r0 * r0, r1 * r1); o[1] = pack2(r2 * r2, r3 * r3); return o;
  }
  DI void store16(int row, int col, const u32x4& v) const { *(u32x4*)(out + (size_t)row * ldo + col) = v; }
  DI void operator()(int row, int col, const f32x4& a) const {
    float r0 = fmaxf(a[0], 0.f), r1 = fmaxf(a[1], 0.f), r2 = fmaxf(a[2], 0.f), r3 = fmaxf(a[3], 0.f);
    u32x2 o; o[0] = pack2(r0 * r0, r1 * r1); o[1] = pack2(r2 * r2, r3 * r3);
    *(u32x2*)(out + (size_t)row * ldo + col) = o;
  }
};
struct EpiU {
  bf16_t* u; float* dt;
  DI void side(int row, int col, const f32x4& a) const { if (col >= U_DT && col < DIN) *(float4*)(dt + (size_t)row * 16 + col - U_DT) = make_float4(a[0], a[1], a[2], a[3]); }
  DI u32x2 pack(const f32x4& a) const { u32x2 o; o[0] = pack2(a[0], a[1]); o[1] = pack2(a[2], a[3]); return o; }
  DI void store16(int row, int col, const u32x4& v) const { if (col < DIN) *(u32x4*)(u + (size_t)row * DIN + col) = v; }
  DI void operator()(int row, int col, const f32x4& a) const {
    if (col < DIN) {
      u32x2 o; o[0] = pack2(a[0], a[1]); o[1] = pack2(a[2], a[3]);
      *(u32x2*)(u + (size_t)row * DIN + col) = o;
      if (col >= U_DT) *(float4*)(dt + (size_t)row * 16 + col - U_DT) = make_float4(a[0], a[1], a[2], a[3]);
    }
  }
};
struct EpiQ {
  bf16_t* q; const float* rs;
  DI float scale(int row) const { return rs[row * 2]; }
  DI void operator()(int row, int col, const f32x4& a, float r) const {
    u32x2 o; o[0] = pack2(a[0] * r, a[1] * r); o[1] = pack2(a[2] * r, a[3] * r);
    *(u32x2*)(q + (size_t)row * 384 + col) = o;
  }
};
struct EpiKV {
  bf16_t* kb; bf16_t* vt; const float* rs;
  DI float scale(int row) const { return rs[row * 2 + 1]; }
  DI void operator()(int row, int col, const f32x4& a, float r) const {
    int b, pos;
    if (row < ML) { b = row >> 12; pos = (row & 4095) + CTX; } else { int rr = row - ML; b = rr >> 8; pos = rr & 255; }
    const int head = col >> 7, d = col & 127;
    if (d < 64) {
      u32x2 o; o[0] = pack2(a[0] * r, a[1] * r); o[1] = pack2(a[2] * r, a[3] * r);
      *(u32x2*)(kb + ((size_t)(b * 4 + head) * LK + pos) * 96 + d) = o;
    } else {
#pragma unroll
      for (int j = 0; j < 4; ++j) vt[((size_t)(b * 4 + head) * 64 + (d - 64 + j)) * LK + pos] = f2bf(a[j] * r);
    }
  }
};

struct EpiPartS {
  float* part; const float* ssq; int g;
  DI float scale(int row) const {
    if (g < 0) return 1.f;
    const float4 sq = *(const float4*)(ssq + (size_t)row * 8 + g * 4);
    return rsqrtf((sq.x + sq.y + sq.z + sq.w) * (1.f / 256) + EPS);
  }
  DI void operator()(int row, int col, const f32x4& a, float r) const {
    *(float4*)(part + (size_t)(row - ML) * DM + col) = make_float4(a[0] * r, a[1] * r, a[2] * r, a[3] * r);
  }
};
struct EpiPart {
  float* part;
  DI float scale(int) const { return 1.f; }
  DI void operator()(int row, int col, const f32x4& a, float) const { (*this)(row, col, a); }
  DI void operator()(int row, int col, const f32x4& a) const {
    *(float4*)(part + (size_t)(row - ML) * DM + col) = make_float4(a[0], a[1], a[2], a[3]);
  }
};
DI void phase_inproj(const Params& p, int layer, int bid, int nb, int vbid, int nvb, char* smem, char* smem_half) {
  EpiU epi{(bf16_t*)(p.ws + OFF_U), (float*)(p.ws + OFF_DT)};
  const int x = bid & 7, per = nb >> 3;
  for (int rep = 0; rep < REP_GEMM; ++rep)
  for (int q = bid >> 3; q < 85; q += per) {
    const int m = (x >> 1) * 17 + q / 5, n = 5 * (x & 1) + q % 5;
    const int q2 = q + per, m2 = (x >> 1) * 17 + q2 / 5, n2 = 5 * (x & 1) + q2 % 5;
    gemm8_tile((const bf16_t*)(p.ws + OFF_H), DM, wt_ptr(p, layer, WT_IN), 1024, 1024, m * 256, n * 256, smem, epi,
               q == (bid >> 3), q2 < 85, m2 * 256, n2 * 256);
  }
  if (layer == 0) {
    if (per == 32) {
      if ((bid >> 3) >= 21) {
        const int u = ((bid >> 3) - 21) * 8 + x;
        for (int it = 640 + 2 * u + (vbid & 1); it < WT_ITEMS; it += 176) wt_item(p, 0, it, smem_half);
      }
    } else {
      for (int it = 640 + vbid; it < WT_ITEMS; it += nvb) wt_item(p, 0, it, smem_half);
    }
  }
}
DI void phase_wout(const Params& p, int layer, int bid, int nb, int vbid, int nvb, char* smem, char* smem_half) {
  EpiBF epi{(bf16_t*)(p.ws + OFF_U), DM};
  const float* ssq = (const float*)(p.ws + OFF_SSQ);
  const int x = bid & 7, per = nb >> 3;
  for (int rep = 0; rep < REP_GEMM; ++rep) {
    for (int q = bid >> 3; q < 32; q += per) {
      const int T = x * 32 + q;
      gemm8_tile<true>((const bf16_t*)(p.ws + OFF_H), DM, wt_ptr(p, layer, WT_OUT), 1024, 1024, (T >> 2) * 256, (T & 3) * 256, smem, epi,
                       true, false, 0, 0, ssq);
    }
    if (layer == 0)
      for (int it = vbid; it < (MC / 128) * 8 * 4; it += nvb) {
        const int tile = it >> 2, ks = it & 3;
        EpiPartS ep{(float*)(p.ws + OFF_QB) + (size_t)ks * MC * DM, ssq, ks - 2};
        gemm_tile_glds((const bf16_t*)(p.ws + OFF_H) + ks * 256, DM, wt_ptr(p, layer, WT_OUT) + ks * 256, 1024, 256, ML + (tile >> 3) * 128, (tile & 7) * 128, smem_half, ep);
      }
  }
}
DI void phase_ff1(const Params& p, int layer, int bid, int nb, int vbid, int nvb, char* smem, char* smem_half) {
  EpiRelu2 epi{(bf16_t*)(p.ws + OFF_F1), DFF};
  const int x = bid & 7, per = nb >> 3;
  for (int rep = 0; rep < REP_GEMM; ++rep) {
    for (int q = bid >> 3; q < 128; q += per) {
      const int m = (x >> 2) * 32 + (q >> 2), n = 4 * (x & 3) + (q & 3);
      const int q2 = q + per, m2 = (x >> 2) * 32 + (q2 >> 2), n2 = 4 * (x & 3) + (q2 & 3);
      gemm8_tile((const bf16_t*)(p.ws + OFF_H), DM, wt_ptr(p, layer, WT_FF1), 1024, 1024, m * 256, n * 256, smem, epi,
                 q == (bid >> 3), q2 < 128, m2 * 256, n2 * 256);
    }
    if (layer == 0)
      for (int it = vbid; it < (MC / 128) * 32; it += nvb)
        gemm_tile_glds((const bf16_t*)(p.ws + OFF_H), DM, wt_ptr(p, layer, WT_FF1), 1024, 1024, ML + (it / 32) * 128, (it % 32) * 128, smem_half, epi);
  }
}
DI void phase_ff2(const Params& p, int layer, int bid, int nb, int vbid, int nvb, char* smem, char* smem_half) {
  EpiBF epi{(bf16_t*)(p.ws + OFF_H), DM};
  const int x = bid & 7, per = nb >> 3;
  for (int rep = 0; rep < REP_GEMM; ++rep) {
    for (int q = bid >> 3; q < 32; q += per) {
      const int T = x * 32 + q;
      gemm8_tile((const bf16_t*)(p.ws + OFF_F1), DFF, wt_ptr(p, layer, WT_FF2), 4096, 4096, (T >> 2) * 256, (T & 3) * 256, smem, epi);
    }
    if (layer == 0)
      for (int it = vbid; it < (MC / 128) * 8 * 4; it += nvb) {
        const int tile = it >> 2, ks = it & 3;
        EpiPart ep{(float*)(p.ws + OFF_END2) + (size_t)ks * MC * DM};
        gemm_tile_glds((const bf16_t*)(p.ws + OFF_F1) + ks * 1024, DFF, wt_ptr(p, layer, WT_FF2) + ks * 1024, 4096, 1024, ML + (tile >> 3) * 128, (tile & 7) * 128, smem_half, ep);
      }
  }
}

DI int chunk_row0(int b, int tc) { return tc < 2 ? ML + b * CTX + tc * 128 : b * SEQ + (tc - 2) * 128; }
constexpr int BST = 72;
constexpr int TST = 136;
DI void load_tile_T(bf16_t* dst, const bf16_t* __restrict__ src, int ldg) {
  const int tid = ltid();
#pragma unroll
  for (int i = 0; i < 4; ++i) {
    int c = tid + 256 * i, tok = c & 127, pc = c >> 7;
    u32x4 v = *(const u32x4*)(src + (size_t)tok * ldg + pc * 8);
#pragma unroll
    for (int j = 0; j < 4; ++j) {
      dst[(pc * 8 + 2 * j) * TST + tok] = (bf16_t)(v[j] & 0xffffu);
      dst[(pc * 8 + 2 * j + 1) * TST + tok] = (bf16_t)(v[j] >> 16);
    }
  }
}
DI void chunk_scan(const Params& p, int layer, int row0, int h, float* csf, float* csb, float* dtF, float* dtB, float* tot, float*  ) {
  const int tid = ltid(), w = tid >> 6, lane = tid & 63;
  const float* DT = (const float*)(p.ws + OFF_DT);
  float v;
  if (tid < 128) {
    const float dt = DT[(size_t)(row0 + tid) * 16 + h];
    v = dt * -__expf(p.a_log[layer * 16 + h]);
    dtF[tid] = dt;
  } else {
    const int e = 255 - tid;
    const float dt = DT[(size_t)(row0 + e) * 16 + 8 + h];
    v = dt * -__expf(p.a_log[layer * 16 + 8 + h]);
    dtB[e] = dt;
  }
#pragma unroll
  for (int o = 1; o < 64; o <<= 1) { const float t = __shfl_up(v, o); if (lane >= o) v += t; }
  if (lane == 63) tot[w] = v;
  __syncthreads();
  if (w == 1) v += tot[0];
  if (w == 3) v += tot[2];
  if (tid < 128) csf[tid] = v; else csb[255 - tid] = v;
  __syncthreads();
}

DI void ssd_state_item(const Params& p, int layer, int b, int tc, int h, char* smem) {
  bf16_t* XT = (bf16_t*)smem;
  bf16_t* BT = XT + 64 * TST;
  float* csf = (float*)(BT + 64 * TST);
  float* csb = csf + 128; float* dtF = csb + 128; float* dtB = dtF + 128; float* laF = dtB + 128; float* laB = laF + 128;
  const int tid = ltid(), w = tid >> 6, lane = tid & 63, r = lane & 31, hh = lane >> 5;
  const int row0 = chunk_row0(b, tc);
  const bf16_t* XBC = (const bf16_t*)(p.ws + OFF_XBC);
  load_tile_T(XT, XBC + (size_t)row0 * 768 + h * 64, 768);
  load_tile_T(BT, XBC + (size_t)row0 * 768 + 512 + (h >> 2) * 64, 768);
  chunk_scan(p, layer, row0, h, csf, csb, dtF, dtB, laF, laB);
  __syncthreads();
  if (tid < 128) laF[tid] = dtF[tid] * __expf(csf[127] - csf[tid]);
  else { int t = tid - 128; laB[t] = dtB[t] * __expf(csb[0] - csb[t]); }
  __syncthreads();
  const int d = w >> 1, pt = w & 1;
  const float* wv = d == 0 ? laF : laB;
  f32x16 acc[2];
#pragma unroll
  for (int i = 0; i < 16; ++i) { acc[0][i] = 0.f; acc[1][i] = 0.f; }
#pragma unroll
  for (int s = 0; s < 8; ++s) {
    int l0 = 16 * s + 8 * hh;
    u32x4 xa = *(const u32x4*)(XT + (32 * pt + r) * TST + l0);
    u32x4 sa;
#pragma unroll
    for (int j = 0; j < 4; ++j) sa[j] = pack2(lo2f(xa[j]) * wv[l0 + 2 * j], hi2f(xa[j]) * wv[l0 + 2 * j + 1]);
    bf16x8 af = __builtin_bit_cast(bf16x8, sa);
#pragma unroll
    for (int nt = 0; nt < 2; ++nt) {
      bf16x8 bfr = *(const bf16x8*)(BT + (32 * nt + r) * TST + l0);
      acc[nt] = MFMA32(af, bfr, acc[nt]);
    }
  }
  bf16_t* S = (bf16_t*)(p.ws + OFF_SST) + ((((size_t)d * NB + b) * NCH + tc) * 8 + h) * 4096;
#pragma unroll
  for (int nt = 0; nt < 2; ++nt)
#pragma unroll
    for (int i = 0; i < 16; ++i) S[(32 * pt + crow(i, hh)) * 64 + 32 * nt + r] = f2bf(acc[nt][i]);
  if (tid == 0) {
    float* TD = (float*)(p.ws + OFF_TDEC);
    TD[((0 * NB + b) * NCH + tc) * 8 + h] = __expf(csf[127]);
    TD[((1 * NB + b) * NCH + tc) * 8 + h] = __expf(csb[0]);
  }
  __syncthreads();
}

DI void ssd_pass_item(const Params& p, int it) {
  const int e = it * 256 + ltid();
  const int pn2 = e & 2047, h = (e >> 11) & 7, b = (e >> 14) & 3, d = e >> 16;
  unsigned* S = (unsigned*)(p.ws + OFF_SST);
  const float* TD = (const float*)(p.ws + OFF_TDEC);
  unsigned sv[NCH]; float T[NCH];
#pragma unroll
  for (int i = 0; i < NCH; ++i) {
    int tc = d == 0 ? i : (i < 2 ? 1 - i : NCH + 1 - i);
    sv[i] = S[(((size_t)(d * NB + b) * NCH + tc) * 8 + h) * 2048 + pn2];
    T[i] = TD[((d * NB + b) * NCH + tc) * 8 + h];
  }
  float h0 = 0.f, h1 = 0.f;
#pragma unroll
  for (int i = 0; i < NCH; ++i) {
    int tc = d == 0 ? i : (i < 2 ? 1 - i : NCH + 1 - i);
    S[(((size_t)(d * NB + b) * NCH + tc) * 8 + h) * 2048 + pn2] = pack2(h0, h1);
    h0 = T[i] * h0 + lo2f(sv[i]); h1 = T[i] * h1 + hi2f(sv[i]);
  }
}

DI void ssd_out_item(const Params& p, int layer, int b, int tc, int h, char* smem) {
  bf16_t* XT = (bf16_t*)smem;
  bf16_t* Bs = XT + 64 * TST;
  float* csf = (float*)(Bs + 128 * BST);
  float* csb = csf + 128; float* dtF = csb + 128; float* dtB = dtF + 128; float* laF = dtB + 128; float* laB = laF + 128;
  const int tid = ltid(), w = tid >> 6, lane = tid & 63, r = lane & 31, hh = lane >> 5;
  const int row0 = chunk_row0(b, tc), g = h >> 2;
  const bf16_t* XBC = (const bf16_t*)(p.ws + OFF_XBC);
  load_tile_T(XT, XBC + (size_t)row0 * 768 + h * 64, 768);
#pragma unroll
  for (int i = 0; i < 4; ++i) {
    int c = tid + 256 * i, tok = c >> 3, part = c & 7;
    *(u32x4*)(Bs + tok * BST + part * 8) = *(const u32x4*)(XBC + (size_t)(row0 + tok) * 768 + 512 + g * 64 + part * 8);
  }
  const int l = 32 * w + r;
  bf16x8 cf[4];
#pragma unroll
  for (int ks = 0; ks < 4; ++ks) cf[ks] = *(const bf16x8*)(XBC + (size_t)(row0 + l) * 768 + 640 + g * 64 + 16 * ks + 8 * hh);
  chunk_scan(p, layer, row0, h, csf, csb, dtF, dtB, laF, laB);
  const float csf_l = csf[l], csb_l = csb[l];
  f32x16 yacc[2];
#pragma unroll
  for (int i = 0; i < 16; ++i) { yacc[0][i] = 0.f; yacc[1][i] = 0.f; }
#pragma unroll
  for (int st = 0; st < 4; ++st) {
    f32x16 gacc;
#pragma unroll
    for (int i = 0; i < 16; ++i) gacc[i] = 0.f;
#pragma unroll
    for (int ks = 0; ks < 4; ++ks) {
      bf16x8 af = *(const bf16x8*)(Bs + (32 * st + r) * BST + 16 * ks + 8 * hh);
      gacc = MFMA32(af, cf[ks], gacc);
    }
#pragma unroll
    for (int i = 0; i < 16; ++i) {
      int s = 32 * st + crow(i, hh);
      float f;
      if (s < l) f = __expf(csf_l - csf[s]) * dtF[s];
      else if (s > l) f = __expf(csb_l - csb[s]) * dtB[s];
      else f = dtF[s] + dtB[s];
      gacc[i] *= f;
    }
#pragma unroll
    for (int s2 = 0; s2 < 2; ++s2) {
      bf16x8 mf = pack8(gacc, s2);
      int sb = 32 * st + 16 * s2 + 4 * hh;
#pragma unroll
      for (int pt = 0; pt < 2; ++pt) {
        u32x2 lo = *(const u32x2*)(XT + (32 * pt + r) * TST + sb);
        u32x2 hi = *(const u32x2*)(XT + (32 * pt + r) * TST + sb + 8);
        u32x4 xa; xa[0] = lo[0]; xa[1] = lo[1]; xa[2] = hi[0]; xa[3] = hi[1];
        yacc[pt] = MFMA32(__builtin_bit_cast(bf16x8, xa), mf, yacc[pt]);
      }
    }
  }
#pragma unroll
  for (int d = 0; d < 2; ++d) {
    const bf16_t* Hs = (const bf16_t*)(p.ws + OFF_SST) + ((((size_t)d * NB + b) * NCH + tc) * 8 + h) * 4096;
    const float e = __expf(d == 0 ? csf_l : csb_l);
#pragma unroll
    for (int pt = 0; pt < 2; ++pt) {
      f32x16 t;
#pragma unroll
      for (int i = 0; i < 16; ++i) t[i] = 0.f;
#pragma unroll
      for (int ks = 0; ks < 4; ++ks) {
        bf16x8 af = *(const bf16x8*)(Hs + (32 * pt + r) * 64 + 16 * ks + 8 * hh);
        t = MFMA32(af, cf[ks], t);
      }
#pragma unroll
      for (int i = 0; i < 16; ++i) yacc[pt][i] += e * t[i];
    }
  }
  const int row = row0 + l;
  const float Dh = p.ssd_d[layer * 8 + h];
  const bf16_t* U = (const bf16_t*)(p.ws + OFF_U);
  bf16_t* YM = (bf16_t*)(p.ws + OFF_H);
  float ssq = 0.f;
  u32x2 xvv[2][4], zvv[2][4];
#pragma unroll
  for (int pt = 0; pt < 2; ++pt)
#pragma unroll
    for (int q = 0; q < 4; ++q) {
      const int pp = 32 * pt + 8 * q + 4 * hh;
      xvv[pt][q] = *(const u32x2*)(XBC + (size_t)row * 768 + h * 64 + pp);
      zvv[pt][q] = *(const u32x2*)(U + (size_t)row * DIN + U_Z + h * 64 + pp);
    }
#pragma unroll
  for (int pt = 0; pt < 2; ++pt)
#pragma unroll
    for (int q = 0; q < 4; ++q) {
      const int pp = 32 * pt + 8 * q + 4 * hh;
      const u32x2 xv = xvv[pt][q], zv = zvv[pt][q];
      float y0 = (yacc[pt][4 * q + 0] + Dh * lo2f(xv[0])) * silu_f(lo2f(zv[0]));
      float y1 = (yacc[pt][4 * q + 1] + Dh * hi2f(xv[0])) * silu_f(hi2f(zv[0]));
      float y2 = (yacc[pt][4 * q + 2] + Dh * lo2f(xv[1])) * silu_f(lo2f(zv[1]));
      float y3 = (yacc[pt][4 * q + 3] + Dh * hi2f(xv[1])) * silu_f(hi2f(zv[1]));
      u32x2 o; o[0] = pack2(y0, y1); o[1] = pack2(y2, y3);
      float r0 = lo2f(o[0]), r1 = hi2f(o[0]), r2 = lo2f(o[1]), r3 = hi2f(o[1]);
      ssq += r0 * r0 + r1 * r1 + r2 * r2 + r3 * r3;
      *(u32x2*)(YM + (size_t)row * DM + 512 + h * 64 + pp) = o;
    }
  ssq += __shfl_xor(ssq, 32);
  if (hh == 0) ((float*)(p.ws + OFF_SSQ))[(size_t)row * 8 + h] = ssq;
  __syncthreads();
}

constexpr int KST = 104;
constexpr int VST = 68;
constexpr int ASTG = 64 * KST + 64 * VST;
DI void attn_item(const Params& p, int b, int head, int qrow0, int t0, bool lat, int nkeys, char* smem) {
  bf16_t* Ks = (bf16_t*)smem;
  bf16_t* Vs = Ks + 64 * KST;
  const int tid = ltid(), w = tid >> 6, lane = tid & 63, r = lane & 31, hh = lane >> 5;
  const bf16_t* QB = (const bf16_t*)(p.ws + OFF_QB);
  const bf16_t* KB = (const bf16_t*)(p.ws + OFF_KB) + (size_t)(b * 4 + head) * LK * 96;
  const bf16_t* VT = (const bf16_t*)(p.ws + OFF_VT) + (size_t)(b * 4 + head) * 64 * LK;
  const float qscale = 0.10206207261596575f * 1.4426950408889634f;
  const int qrow = qrow0 + w * 32 + r;
  const int t = t0 + w * 32 + r;
  bf16x8 qf[6];
  {
    const bf16_t* src = QB + (size_t)qrow * 384 + head * 96;
#pragma unroll
    for (int s = 0; s < 4; ++s) {
      u32x4 v = *(const u32x4*)(src + 16 * s + 8 * hh);
      u32x4 o;
#pragma unroll
      for (int j = 0; j < 4; ++j) o[j] = pack2(lo2f(v[j]) * qscale, hi2f(v[j]) * qscale);
      qf[s] = __builtin_bit_cast(bf16x8, o);
    }
#pragma unroll
    for (int s = 4; s < 6; ++s) {
      u32x4 va = *(const u32x4*)(src + 16 * s), vb = *(const u32x4*)(src + 16 * s + 8);
      float posf = s == 4 ? (float)(t >> 6) : (float)(t & 63);
      float o[8];
#pragma unroll
      for (int j = 0; j < 8; ++j) {
        float a = (j & 1) ? hi2f(va[j >> 1]) : lo2f(va[j >> 1]);
        float bb = (j & 1) ? hi2f(vb[j >> 1]) : lo2f(vb[j >> 1]);
        float res;
        if (lat) {
          float invf = exp2f(-(float)(2 * j) * (13.287712379549449f / 16.f));
          float rev = posf * invf * 0.15915494309189535f;
          float cs = __builtin_amdgcn_cosf(rev), sn = __builtin_amdgcn_sinf(rev);
          res = hh == 0 ? a * cs - bb * sn : bb * cs + a * sn;
        } else res = hh == 0 ? a : bb;
        o[j] = res * qscale;
      }
      u32x4 ov; ov[0] = pack2(o[0], o[1]); ov[1] = pack2(o[2], o[3]); ov[2] = pack2(o[4], o[5]); ov[3] = pack2(o[6], o[7]);
      qf[s] = __builtin_bit_cast(bf16x8, ov);
    }
  }
  f32x16 oacc[2];
#pragma unroll
  for (int i = 0; i < 16; ++i) { oacc[0][i] = 0.f; oacc[1][i] = 0.f; }
  float m = -1e30f, lsum = 0.f;
  u32x4 rk[3], rv[2];
  auto gload = [&](int key0) {
#pragma unroll
    for (int i = 0; i < 3; ++i) rk[i] = *(const u32x4*)(KB + (size_t)key0 * 96 + (tid + 256 * i) * 8);
#pragma unroll
    for (int i = 0; i < 2; ++i) { int c = tid + 256 * i; rv[i] = *(const u32x4*)(VT + (size_t)(c >> 3) * LK + key0 + (c & 7) * 8); }
  };
  gload(0);
  const int NT = nkeys / 64;
  for (int kt = 0; kt < NT; ++kt) {
#pragma unroll
    for (int i = 0; i < 3; ++i) { int c = tid + 256 * i; *(u32x4*)(Ks + (c / 12) * KST + (c % 12) * 8) = rk[i]; }
#pragma unroll
    for (int i = 0; i < 2; ++i) {
      int c = tid + 256 * i;
      bf16_t* d = Vs + (c >> 3) * VST + (c & 7) * 8;
      u32x2 a; a[0] = rv[i][0]; a[1] = rv[i][1];
      u32x2 bq; bq[0] = rv[i][2]; bq[1] = rv[i][3];
      *(u32x2*)d = a; *(u32x2*)(d + 4) = bq;
    }
    __syncthreads();
    if (kt + 1 < NT) gload((kt + 1) * 64);
    f32x16 sacc[2];
#pragma unroll
    for (int i = 0; i < 16; ++i) { sacc[0][i] = 0.f; sacc[1][i] = 0.f; }
#pragma unroll
    for (int s = 0; s < 6; ++s)
#pragma unroll
      for (int k2 = 0; k2 < 2; ++k2) {
        bf16x8 af = *(const bf16x8*)(Ks + (32 * k2 + r) * KST + 16 * s + 8 * hh);
        sacc[k2] = MFMA32(af, qf[s], sacc[k2]);
      }
    float mx = sacc[0][0];
#pragma unroll
    for (int i = 0; i < 16; ++i) { mx = fmaxf(mx, sacc[0][i]); mx = fmaxf(mx, sacc[1][i]); }
    mx = fmaxf(mx, __shfl_xor(mx, 32));
    const float mn = fmaxf(m, mx);
    const float alpha = __builtin_amdgcn_exp2f(m - mn);
    m = mn;
    float ps = 0.f;
#pragma unroll
    for (int i = 0; i < 16; ++i) {
      sacc[0][i] = __builtin_amdgcn_exp2f(sacc[0][i] - mn); sacc[1][i] = __builtin_amdgcn_exp2f(sacc[1][i] - mn);
      ps += sacc[0][i] + sacc[1][i];
    }
    lsum = lsum * alpha + ps;
#pragma unroll
    for (int i = 0; i < 16; ++i) { oacc[0][i] *= alpha; oacc[1][i] *= alpha; }
#pragma unroll
    for (int k2 = 0; k2 < 2; ++k2)
#pragma unroll
      for (int s2 = 0; s2 < 2; ++s2) {
        bf16x8 pf = pack8(sacc[k2], s2);
        int kb0 = 32 * k2 + 16 * s2 + 4 * hh;
#pragma unroll
        for (int d = 0; d < 2; ++d) {
          u32x2 lo = *(const u32x2*)(Vs + (32 * d + r) * VST + kb0);
          u32x2 hi = *(const u32x2*)(Vs + (32 * d + r) * VST + kb0 + 8);
          u32x4 va; va[0] = lo[0]; va[1] = lo[1]; va[2] = hi[0]; va[3] = hi[1];
          oacc[d] = MFMA32(__builtin_bit_cast(bf16x8, va), pf, oacc[d]);
        }
      }
    __syncthreads();
  }
  lsum += __shfl_xor(lsum, 32);
  const float inv = 1.f / lsum;
  bf16_t* YM = (bf16_t*)(p.ws + OFF_H) + (size_t)qrow * DM + head * 64;
#pragma unroll
  for (int d = 0; d < 2; ++d)
#pragma unroll
    for (int q = 0; q < 4; ++q) {
      u32x2 o; o[0] = pack2(oacc[d][4 * q] * inv, oacc[d][4 * q + 1] * inv); o[1] = pack2(oacc[d][4 * q + 2] * inv, oacc[d][4 * q + 3] * inv);
      *(u32x2*)(YM + 32 * d + 8 * q + 4 * hh) = o;
    }
}

DI void attn_item8(const Params& p, int b, int head, int qrow0, int t0, bool lat, int nkeys, char* smem) {
  bf16_t* Ks = (bf16_t*)smem;
  bf16_t* Vs = Ks + 64 * KST;
  const int tid = ltid512(), w = tid >> 6, lane = tid & 63, r = lane & 31, hh = lane >> 5;
  const bf16_t* QB = (const bf16_t*)(p.ws + OFF_QB);
  const bf16_t* KB = (const bf16_t*)(p.ws + OFF_KB) + (size_t)(b * 4 + head) * LK * 96;
  const bf16_t* VT = (const bf16_t*)(p.ws + OFF_VT) + (size_t)(b * 4 + head) * 64 * LK;
  const float qscale = 0.10206207261596575f * 1.4426950408889634f;
  const int qrow = qrow0 + w * 32 + r;
  const int t = t0 + w * 32 + r;
  bf16x8 qf[6];
  {
    const bf16_t* src = QB + (size_t)qrow * 384 + head * 96;
#pragma unroll
    for (int s = 0; s < 4; ++s) {
      u32x4 v = *(const u32x4*)(src + 16 * s + 8 * hh);
      u32x4 o;
#pragma unroll
      for (int j = 0; j < 4; ++j) o[j] = pack2(lo2f(v[j]) * qscale, hi2f(v[j]) * qscale);
      qf[s] = __builtin_bit_cast(bf16x8, o);
    }
#pragma unroll
    for (int s = 4; s < 6; ++s) {
      u32x4 va = *(const u32x4*)(src + 16 * s), vb = *(const u32x4*)(src + 16 * s + 8);
      float posf = s == 4 ? (float)(t >> 6) : (float)(t & 63);
      float o[8];
#pragma unroll
      for (int j = 0; j < 8; ++j) {
        float a = (j & 1) ? hi2f(va[j >> 1]) : lo2f(va[j >> 1]);
        float bb = (j & 1) ? hi2f(vb[j >> 1]) : lo2f(vb[j >> 1]);
        float res;
        if (lat) {
          float invf = exp2f(-(float)(2 * j) * (13.287712379549449f / 16.f));
          float rev = posf * invf * 0.15915494309189535f;
          float cs = __builtin_amdgcn_cosf(rev), sn = __builtin_amdgcn_sinf(rev);
          res = hh == 0 ? a * cs - bb * sn : bb * cs + a * sn;
        } else res = hh == 0 ? a : bb;
        o[j] = res * qscale;
      }
      u32x4 ov; ov[0] = pack2(o[0], o[1]); ov[1] = pack2(o[2], o[3]); ov[2] = pack2(o[4], o[5]); ov[3] = pack2(o[6], o[7]);
      qf[s] = __builtin_bit_cast(bf16x8, ov);
    }
  }
  f32x16 oacc[2];
#pragma unroll
  for (int i = 0; i < 16; ++i) { oacc[0][i] = 0.f; oacc[1][i] = 0.f; }
  float m = -1e30f, lsum = 0.f;
  u32x4 rk[2], rv;
  auto gload = [&](int key0) {
    rk[0] = *(const u32x4*)(KB + (size_t)key0 * 96 + tid * 8);
    if (tid < 256) rk[1] = *(const u32x4*)(KB + (size_t)key0 * 96 + (512 + tid) * 8);
    rv = *(const u32x4*)(VT + (size_t)(tid >> 3) * LK + key0 + (tid & 7) * 8);
  };
  const int kro = (tid / 12) * KST + (tid % 12) * 8, kro2 = ((512 + tid) / 12) * KST + ((512 + tid) % 12) * 8;
  auto swrite = [&](int stage) {
    bf16_t* Kd = Ks + stage * ASTG;
    *(u32x4*)(Kd + kro) = rk[0];
    if (tid < 256) *(u32x4*)(Kd + kro2) = rk[1];
    bf16_t* d = Kd + 64 * KST + (tid >> 3) * VST + (tid & 7) * 8;
    u32x2 a; a[0] = rv[0]; a[1] = rv[1];
    u32x2 bq; bq[0] = rv[2]; bq[1] = rv[3];
    *(u32x2*)d = a; *(u32x2*)(d + 4) = bq;
  };
  auto qk = [&](int stage, f32x16 (&sa)[2]) {
    const bf16_t* Kc = Ks + stage * ASTG;
#pragma unroll
    for (int i = 0; i < 16; ++i) { sa[0][i] = 0.f; sa[1][i] = 0.f; }
#pragma unroll
    for (int s = 0; s < 6; ++s)
#pragma unroll
      for (int k2 = 0; k2 < 2; ++k2) {
        bf16x8 af = *(const bf16x8*)(Kc + (32 * k2 + r) * KST + 16 * s + 8 * hh);
        sa[k2] = MFMA32(af, qf[s], sa[k2]);
      }
  };
  const int NT = nkeys / 64;
  f32x16 sacc[2], snext[2];
  gload(0); swrite(0);
  gload(64);
  __syncthreads();
  swrite(1);
  gload(128);
  qk(0, sacc);
  __syncthreads();
  int cur = 0, nxt = 1, nn = 2;
  for (int kt = 0; kt < NT; ++kt) {
    if (kt + 1 < NT) qk(nxt, snext);
    if (kt + 2 < NT) {
      swrite(nn);
      if (kt + 3 < NT) gload((kt + 3) * 64);
    }
    const bf16_t* Vc = Ks + cur * ASTG + 64 * KST;
    float mx = sacc[0][0];
#pragma unroll
    for (int i = 0; i < 16; ++i) { mx = fmaxf(mx, sacc[0][i]); mx = fmaxf(mx, sacc[1][i]); }
    mx = fmaxf(mx, __shfl_xor(mx, 32));
    const float mn = fmaxf(m, mx);
    const float alpha = __builtin_amdgcn_exp2f(m - mn);
    m = mn;
    float ps = 0.f;
#pragma unroll
    for (int i = 0; i < 16; ++i) {
      sacc[0][i] = __builtin_amdgcn_exp2f(sacc[0][i] - mn); sacc[1][i] = __builtin_amdgcn_exp2f(sacc[1][i] - mn);
      ps += sacc[0][i] + sacc[1][i];
    }
    lsum = lsum * alpha + ps;
#pragma unroll
    for (int i = 0; i < 16; ++i) { oacc[0][i] *= alpha; oacc[1][i] *= alpha; }
#pragma unroll
    for (int k2 = 0; k2 < 2; ++k2)
#pragma unroll
      for (int s2 = 0; s2 < 2; ++s2) {
        bf16x8 pf = pack8(sacc[k2], s2);
        int kb0 = 32 * k2 + 16 * s2 + 4 * hh;
#pragma unroll
        for (int d = 0; d < 2; ++d) {
          u32x2 lo = *(const u32x2*)(Vc + (32 * d + r) * VST + kb0);
          u32x2 hi = *(const u32x2*)(Vc + (32 * d + r) * VST + kb0 + 8);
          u32x4 va; va[0] = lo[0]; va[1] = lo[1]; va[2] = hi[0]; va[3] = hi[1];
          oacc[d] = MFMA32(__builtin_bit_cast(bf16x8, va), pf, oacc[d]);
        }
      }
    sacc[0] = snext[0]; sacc[1] = snext[1];
    const int t3 = cur; cur = nxt; nxt = nn; nn = t3;
    __syncthreads();
  }
  lsum += __shfl_xor(lsum, 32);
  const float inv = 1.f / lsum;
  bf16_t* YM = (bf16_t*)(p.ws + OFF_H) + (size_t)qrow * DM + head * 64;
#pragma unroll
  for (int d = 0; d < 2; ++d)
#pragma unroll
    for (int q = 0; q < 4; ++q) {
      u32x2 o; o[0] = pack2(oacc[d][4 * q] * inv, oacc[d][4 * q + 1] * inv); o[1] = pack2(oacc[d][4 * q + 2] * inv, oacc[d][4 * q + 3] * inv);
      *(u32x2*)(YM + 32 * d + 8 * q + 4 * hh) = o;
    }
}

DI void attn_item8b(const Params& p, int b, int head, int qrow0, int t0, bool lat, int nkeys, char* smem) {
  bf16_t* Ks = (bf16_t*)smem;
  bf16_t* Vs = Ks + 64 * KST;
  const int tid = ltid512(), w = tid >> 6, lane = tid & 63, r = lane & 31, hh = lane >> 5;
  const bf16_t* QB = (const bf16_t*)(p.ws + OFF_QB);
  const bf16_t* KB = (const bf16_t*)(p.ws + OFF_KB) + (size_t)(b * 4 + head) * LK * 96;
  const bf16_t* VT = (const bf16_t*)(p.ws + OFF_VT) + (size_t)(b * 4 + head) * 64 * LK;
  const float qscale = 0.10206207261596575f * 1.4426950408889634f;
  const int qrow = qrow0 + w * 32 + r;
  const int t = t0 + w * 32 + r;
  bf16x8 qf[6];
  {
    const bf16_t* src = QB + (size_t)qrow * 384 + head * 96;
#pragma unroll
    for (int s = 0; s < 4; ++s) {
      u32x4 v = *(const u32x4*)(src + 16 * s + 8 * hh);
      u32x4 o;
#pragma unroll
      for (int j = 0; j < 4; ++j) o[j] = pack2(lo2f(v[j]) * qscale, hi2f(v[j]) * qscale);
      qf[s] = __builtin_bit_cast(bf16x8, o);
    }
#pragma unroll
    for (int s = 4; s < 6; ++s) {
      u32x4 va = *(const u32x4*)(src + 16 * s), vb = *(const u32x4*)(src + 16 * s + 8);
      float posf = s == 4 ? (float)(t >> 6) : (float)(t & 63);
      float o[8];
#pragma unroll
      for (int j = 0; j < 8; ++j) {
        float a = (j & 1) ? hi2f(va[j >> 1]) : lo2f(va[j >> 1]);
        float bb = (j & 1) ? hi2f(vb[j >> 1]) : lo2f(vb[j >> 1]);
        float res;
        if (lat) {
          float invf = exp2f(-(float)(2 * j) * (13.287712379549449f / 16.f));
          float rev = posf * invf * 0.15915494309189535f;
          float cs = __builtin_amdgcn_cosf(rev), sn = __builtin_amdgcn_sinf(rev);
          res = hh == 0 ? a * cs - bb * sn : bb * cs + a * sn;
        } else res = hh == 0 ? a : bb;
        o[j] = res * qscale;
      }
      u32x4 ov; ov[0] = pack2(o[0], o[1]); ov[1] = pack2(o[2], o[3]); ov[2] = pack2(o[4], o[5]); ov[3] = pack2(o[6], o[7]);
      qf[s] = __builtin_bit_cast(bf16x8, ov);
    }
  }
  f32x16 oacc[2];
#pragma unroll
  for (int i = 0; i < 16; ++i) { oacc[0][i] = 0.f; oacc[1][i] = 0.f; }
  float m = -1e30f, lsum = 0.f;
  constexpr int VS2 = 132;
  constexpr int STG = 128 * KST + 64 * VS2;
  u32x4 rk[3], rv[2];
  auto gload = [&](int key0) {
#pragma unroll
    for (int i = 0; i < 3; ++i) rk[i] = *(const u32x4*)(KB + (size_t)key0 * 96 + (tid + 512 * i) * 8);
#pragma unroll
    for (int i = 0; i < 2; ++i) { const int c = tid + 512 * i; rv[i] = *(const u32x4*)(VT + (size_t)(c >> 4) * LK + key0 + (c & 15) * 8); }
  };
  int kro[3], vro[2];
#pragma unroll
  for (int i = 0; i < 3; ++i) { const int c = tid + 512 * i; kro[i] = (c / 12) * KST + (c % 12) * 8; }
#pragma unroll
  for (int i = 0; i < 2; ++i) { const int c = tid + 512 * i; vro[i] = 128 * KST + (c >> 4) * VS2 + (c & 15) * 8; }
  auto swrite = [&](int stage) {
    bf16_t* Kd = Ks + stage * STG;
#pragma unroll
    for (int i = 0; i < 3; ++i) *(u32x4*)(Kd + kro[i]) = rk[i];
#pragma unroll
    for (int i = 0; i < 2; ++i) {
      u32x2 a; a[0] = rv[i][0]; a[1] = rv[i][1];
      u32x2 bq; bq[0] = rv[i][2]; bq[1] = rv[i][3];
      *(u32x2*)(Kd + vro[i]) = a; *(u32x2*)(Kd + vro[i] + 4) = bq;
    }
  };
  const int NT = nkeys / 128;
  gload(0); swrite(0);
  if (NT > 1) gload(128);
  __syncthreads();
  for (int kt = 0; kt < NT; ++kt) {
    const bf16_t* Kc = Ks + (kt & 1) * STG;
    const bf16_t* Vc = Kc + 128 * KST;
    if (kt + 1 < NT) {
      swrite((kt + 1) & 1);
      if (kt + 2 < NT) gload((kt + 2) * 128);
    }
    f32x16 sacc[4];
#pragma unroll
    for (int k2 = 0; k2 < 4; ++k2)
#pragma unroll
      for (int i = 0; i < 16; ++i) sacc[k2][i] = 0.f;
#pragma unroll
    for (int s = 0; s < 6; ++s)
#pragma unroll
      for (int k2 = 0; k2 < 4; ++k2) {
        bf16x8 af = *(const bf16x8*)(Kc + (32 * k2 + r) * KST + 16 * s + 8 * hh);
        sacc[k2] = MFMA32(af, qf[s], sacc[k2]);
      }
    float mx = sacc[0][0];
#pragma unroll
    for (int k2 = 0; k2 < 4; ++k2)
#pragma unroll
      for (int i = 0; i < 16; ++i) mx = fmaxf(mx, sacc[k2][i]);
    mx = fmaxf(mx, __shfl_xor(mx, 32));
    const float mn = fmaxf(m, mx);
    if (__any(mn > m)) {
      const float alpha = __builtin_amdgcn_exp2f(m - mn);
      lsum *= alpha;
#pragma unroll
      for (int i = 0; i < 16; ++i) { oacc[0][i] *= alpha; oacc[1][i] *= alpha; }
      m = mn;
    }
    float ps = 0.f;
#pragma unroll
    for (int k2 = 0; k2 < 4; ++k2)
#pragma unroll
      for (int i = 0; i < 16; ++i) { sacc[k2][i] = __builtin_amdgcn_exp2f(sacc[k2][i] - m); ps += sacc[k2][i]; }
    lsum += ps;
#pragma unroll
    for (int k2 = 0; k2 < 4; ++k2)
#pragma unroll
      for (int s2 = 0; s2 < 2; ++s2) {
        bf16x8 pf = pack8(sacc[k2], s2);
        const int kb0 = 32 * k2 + 16 * s2 + 4 * hh;
#pragma unroll
        for (int d = 0; d < 2; ++d) {
          u32x2 lo = *(const u32x2*)(Vc + (32 * d + r) * VS2 + kb0);
          u32x2 hi = *(const u32x2*)(Vc + (32 * d + r) * VS2 + kb0 + 8);
          u32x4 va; va[0] = lo[0]; va[1] = lo[1]; va[2] = hi[0]; va[3] = hi[1];
          oacc[d] = MFMA32(__builtin_bit_cast(bf16x8, va), pf, oacc[d]);
        }
      }
    __syncthreads();
  }
  lsum += __shfl_xor(lsum, 32);
  const float inv = 1.f / lsum;
  bf16_t* YM = (bf16_t*)(p.ws + OFF_H) + (size_t)qrow * DM + head * 64;
#pragma unroll
  for (int d = 0; d < 2; ++d)
#pragma unroll
    for (int q = 0; q < 4; ++q) {
      u32x2 o; o[0] = pack2(oacc[d][4 * q] * inv, oacc[d][4 * q + 1] * inv); o[1] = pack2(oacc[d][4 * q + 2] * inv, oacc[d][4 * q + 3] * inv);
      *(u32x2*)(YM + 32 * d + 8 * q + 4 * hh) = o;
    }
}

DI void phase_qkv(const Params& p, int layer, int bid, int nb, char* smem) {
  const int MQ = layer == 0 ? MT : ML;
  const int nq = (MQ / 128) * 3, nkv = (MT / 128) * 4, nst = NB * NCH * 8;
  const float* RS = (const float*)(p.ws + OFF_RSTD);
  EpiQ eq{(bf16_t*)(p.ws + OFF_QB), RS};
  EpiKV ekv{(bf16_t*)(p.ws + OFF_KB), (bf16_t*)(p.ws + OFF_VT), RS};
  const bf16_t* U = (const bf16_t*)(p.ws + OFF_U);
  for (int it = bid; it < nq + nkv + nst; it += nb) {
    if (it < nq) gemm_tile<false>(U, DIN, wt_ptr(p, layer, WT_UQ), 256, (it / 3) * 128, (it % 3) * 128, smem, eq);
    else if (it < nq + nkv) { int j = it - nq; gemm_tile<false>(U + U_CKV, DIN, wt_ptr(p, layer, WT_UKV), 128, (j / 4) * 128, (j % 4) * 128, smem, ekv); }
    else { int j = it - nq - nkv; for (int rep = 0; rep < REP_SSD; ++rep) ssd_state_item(p, layer, j / (NCH * 8), (j / 8) % NCH, j & 7, smem); }
  }
}
DI void phase_att(const Params& p, int layer, int bid, int nb, int vbid, int nvb, char* smem, char* sh) {
  for (int it = bid; it < 256; it += nb) {
    const int x = it & 7, j = it >> 3, bh = 2 * x + (j >> 4), qb = j & 15, b = bh >> 2, head = bh & 3;
    for (int rep = 0; rep < REP_ATT; ++rep) attn_item8b(p, b, head, b * SEQ + qb * 256, qb * 256, true, LK, smem);
  }
  for (int it = vbid; it < 512; it += nvb) ssd_pass_item(p, it);
}
DI void phase_ssdout(const Params& p, int layer, int bid, int nb, char* smem) {
  const int nout = NB * NCH * 8, nctx = layer == 0 ? 32 : 0;
  for (int it = bid; it < nout + nctx; it += nb) {
    if (it < nout) {
      int b = it / (NCH * 8), tc = (it / 8) % NCH, h = it & 7;
      if (layer == 1 && tc < 2) continue;
      for (int rep = 0; rep < REP_SSD; ++rep) ssd_out_item(p, layer, b, tc, h, smem);
    } else {
      const int j = it - nout, b = j >> 3, head = (j >> 1) & 3, qb = j & 1;
      attn_item(p, b, head, ML + b * CTX + qb * 128, qb * 128, false, CTX, smem);
    }
  }
  if (layer == 0) {
    if (nb == 512) { if (bid >= 96) for (int it = bid - 96; it < WT_ITEMS; it += 416) wt_item(p, 1, it, smem); }
    else for (int it = bid; it < WT_ITEMS; it += nb) wt_item(p, 1, it, smem);
  }
}


#define XB_TMO      128
#define XB_XCNT(j)  (256  + 64 * (j))
#define XB_XSUB(j)  (1280 + 64 * (j))
#define XB_XGEN(j)  (2304 + 64 * (j))
#define XB_TOP      3328
#define XB_TOPGEN   3392
#define XCD_BAR_WORDS 3456
#define XB_SPIN_CAP (1u << 22)
#define LAS __attribute__((address_space(3)))
DI unsigned xb_ld(unsigned* p) { return __hip_atomic_load(p, __ATOMIC_RELAXED, __HIP_MEMORY_SCOPE_AGENT); }
DI unsigned xb_add(unsigned* p, unsigned v) { return __hip_atomic_fetch_add(p, v, __ATOMIC_RELAXED, __HIP_MEMORY_SCOPE_AGENT); }
DI unsigned xb_xcc_id() { return (unsigned)__builtin_amdgcn_s_getreg((3 << 11) | 20) & 0xFu; }
#define XB_SPIN(cond, bar) do { unsigned _sp = 0; while (cond) { __builtin_amdgcn_s_sleep(1); \
    if ((++_sp & 255u) == 0u) { if (xb_ld(&(bar)[XB_TMO])) break; if (_sp > XB_SPIN_CAP) { atomicAdd(&(bar)[XB_TMO], 1u); break; } } } } while (0)
struct XcdBarrier { unsigned* bar; unsigned x; volatile LAS unsigned* st; };
DI XcdBarrier xcd_barrier_post(unsigned* bar, volatile LAS unsigned* st) {
  XcdBarrier b; b.bar = bar; b.x = xb_xcc_id(); b.st = st;
  if (threadIdx.x == 0) (void)xb_add(&bar[XB_XCNT(b.x)], 1u);
  return b;
}
DI void xcd_barrier_complete(unsigned* bar, unsigned x, unsigned& nloc, unsigned& nx) {
  const unsigned G = gridDim.x * gridDim.y * gridDim.z;
  unsigned sum, cnt, mine, sp = 0u;
  for (;;) {
    sum = 0u; cnt = 0u; mine = 0u;
#pragma unroll
    for (unsigned j = 0; j < 16; ++j) { const unsigned c = xb_ld(&bar[XB_XCNT(j)]); sum += c; cnt += (c > 0u) ? 1u : 0u; mine = (j == x) ? c : mine; }
    if (sum == G) break;
    __builtin_amdgcn_s_sleep(1);
    if ((++sp & 255u) == 0u) { if (xb_ld(&bar[XB_TMO])) break; if (sp > XB_SPIN_CAP) { atomicAdd(&bar[XB_TMO], 1u); break; } }
  }
  nloc = mine > 0u ? mine : 1u; nx = cnt > 0u ? cnt : 1u;
}
DI void xcd_barrier(const XcdBarrier& b) {
  asm volatile("s_waitcnt vmcnt(0)" ::: "memory");
  __syncthreads();
  if (threadIdx.x == 0) {
    unsigned* bar = b.bar;
    asm volatile("" : "+s"(bar));
    __builtin_amdgcn_s_waitcnt(0);
    unsigned nloc = b.st[0], nx = b.st[1];
    if (nloc == 0u) { xcd_barrier_complete(bar, b.x, nloc, nx); b.st[0] = nloc; b.st[1] = nx; }
    const unsigned old = xb_add(&bar[XB_XSUB(b.x)], 1u);
    const unsigned gen = old / nloc;
    if (old + 1u == (gen + 1u) * nloc) {
      __builtin_amdgcn_fence(__ATOMIC_RELEASE, "agent");
      asm volatile("s_waitcnt vmcnt(0)" ::: "memory");
      const unsigned og = xb_add(&bar[XB_TOP], 1u);
      const unsigned tg = og / nx;
      if (og + 1u == (tg + 1u) * nx) xb_add(&bar[XB_TOPGEN], 1u);
      else XB_SPIN(xb_ld(&bar[XB_TOPGEN]) == tg, bar);
      __builtin_amdgcn_fence(__ATOMIC_ACQUIRE, "agent");
      xb_add(&bar[XB_XGEN(b.x)], 1u);
      asm volatile("s_waitcnt vmcnt(0)" ::: "memory");
    } else {
      XB_SPIN(xb_ld(&bar[XB_XGEN(b.x)]) == gen, bar);
      __builtin_amdgcn_fence(__ATOMIC_ACQUIRE, "agent");
      asm volatile("s_waitcnt vmcnt(0)" ::: "memory");
    }
  }
  __syncthreads();
}

constexpr int SMEM_BYTES = 2 * GBUF * 2;
enum { PH_PREP0 = 0, PH_H0, PH_INPROJ, PH_PREP, PH_QKV, PH_ATT, PH_SSDOUT, PH_WOUT, PH_POSTMIX, PH_FF1, PH_FF2, PH_POSTFFN, PH_SSDNORM };

struct Ids { int bid, nb, vbid, nvb, lid; };
DI void run_phase(const Params& p, int ph, int layer, const Ids& id, char* smem, char* sh) {
  switch (ph) {
    case PH_PREP0: phase_prep0(p, id.vbid, id.nvb, sh); break;
    case PH_H0: phase_h0(p, id.vbid, id.nvb); break;
    case PH_INPROJ: phase_inproj(p, layer, id.bid, id.nb, id.vbid, id.nvb, smem, sh); break;
    case PH_PREP: phase_prep(p, layer, id.vbid, id.nvb); break;
    case PH_QKV: phase_qkv(p, layer, id.vbid, id.nvb, sh); break;
    case PH_ATT: phase_att(p, layer, id.bid, id.nb, id.vbid, id.nvb, smem, sh); break;
    case PH_SSDOUT: phase_ssdout(p, layer, id.vbid, id.nvb, sh); break;
    case PH_WOUT: phase_wout(p, layer, id.bid, id.nb, id.vbid, id.nvb, smem, sh); break;
    case PH_POSTMIX: phase_postmix(p, layer, id.vbid, id.nvb); break;
    case PH_FF1: phase_ff1(p, layer, id.bid, id.nb, id.vbid, id.nvb, smem, sh); break;
    case PH_FF2: phase_ff2(p, layer, id.bid, id.nb, id.vbid, id.nvb, smem, sh); break;
    case PH_POSTFFN: phase_postffn(p, layer, id.vbid, id.nvb); break;
  }
}

__global__ void __launch_bounds__(512) mega_kernel(Params p) {
  extern __shared__ __attribute__((aligned(16))) char smem[];
  cg::grid_group grid = cg::this_grid();
  if (p.ws == nullptr) grid.sync();
  const int half = __builtin_amdgcn_readfirstlane((int)(threadIdx.x >> 8));
  Ids id;
  id.bid = blockIdx.x; id.nb = gridDim.x;
  id.vbid = 2 * id.bid + half; id.nvb = 2 * id.nb;
  id.lid = (id.bid & 7) + 8 * (2 * (id.bid >> 3) + half);
  char* sh = smem + half * SMEM_BYTES;
  volatile LAS unsigned* st = (volatile LAS unsigned*)(smem + 2 * SMEM_BYTES - 16);
  if (threadIdx.x == 0) { st[0] = 0u; st[1] = 0u; st[2] = 0u; st[3] = 0u; }
  __syncthreads();
  XcdBarrier xb = xcd_barrier_post((unsigned*)(p.ws + OFF_BAR), st);
#define MK_STEP(PH, LAYER, LAST) do { \
    typedef const void* __attribute__((address_space(4))) * KArgs; \
    KArgs ka = (KArgs)__builtin_amdgcn_kernarg_segment_ptr(); \
    asm volatile("" : "+s"(ka)); \
    Params q; \
    { const void** dst = (const void**)&q; _Pragma("unroll") for (int i = 0; i < 27; ++i) dst[i] = ka[i]; } \
    run_phase(q, PH, LAYER, id, smem, sh); \
    if (!(LAST)) xcd_barrier(xb); } while (0)
  MK_STEP(PH_PREP0, 0, false);
  MK_STEP(PH_H0, 0, false);
  MK_STEP(PH_INPROJ, 0, false); MK_STEP(PH_PREP, 0, false); MK_STEP(PH_QKV, 0, false); MK_STEP(PH_ATT, 0, false); MK_STEP(PH_SSDOUT, 0, false);
  MK_STEP(PH_WOUT, 0, false); MK_STEP(PH_POSTMIX, 0, false); MK_STEP(PH_FF1, 0, false); MK_STEP(PH_FF2, 0, false); MK_STEP(PH_POSTFFN, 0, false);
  MK_STEP(PH_INPROJ, 1, false); MK_STEP(PH_PREP, 1, false); MK_STEP(PH_QKV, 1, false); MK_STEP(PH_ATT, 1, false); MK_STEP(PH_SSDOUT, 1, false);
  MK_STEP(PH_WOUT, 1, false); MK_STEP(PH_POSTMIX, 1, false); MK_STEP(PH_FF1, 1, false); MK_STEP(PH_FF2, 1, false); MK_STEP(PH_POSTFFN, 1, true);
#undef MK_STEP
}

extern "C" void kernel_launch(void* const* d_in, const int* in_sizes, int n_in, void* d_out, int out_size, void* d_ws, size_t ws_size,
                              hipStream_t stream) {
  if (ws_size < WS_NEED) { fprintf(stderr, "workspace too small: %zu < %zu\n", ws_size, (size_t)WS_NEED); return; }
  Params p{};
  const float** f = (const float**)&p;
  for (int i = 0; i < 25; ++i) f[i] = (const float*)d_in[i];
  p.out = (float*)d_out;
  p.ws = (char*)d_ws;
  static int grid_blocks = 0;
  if (!grid_blocks) {
    int dev = 0, cus = 0, per_cu = 0;
    hipGetDevice(&dev);
    hipDeviceGetAttribute(&cus, hipDeviceAttributeMultiprocessorCount, dev);
    hipFuncSetAttribute((const void*)mega_kernel, hipFuncAttributeMaxDynamicSharedMemorySize, 2 * SMEM_BYTES);
    hipOccupancyMaxActiveBlocksPerMultiprocessor(&per_cu, mega_kernel, 512, 2 * SMEM_BYTES);
    if (per_cu > 1) per_cu = 1;
    grid_blocks = cus * per_cu;
  }
  hipMemsetAsync((char*)d_ws + OFF_BAR, 0, XCD_BAR_WORDS * 4, stream);
  void* args[] = {&p};
  hipError_t e = hipLaunchCooperativeKernel((void*)mega_kernel, dim3(grid_blocks), dim3(512), args, 2 * SMEM_BYTES, stream);
  if (e != hipSuccess) fprintf(stderr, "cooperative launch failed: %s (grid %d)\n", hipGetErrorString(e), grid_blocks);
}
```

```cpp
#include <hip/hip_runtime.h>
#include <hip/hip_cooperative_groups.h>
#include <stdint.h>
#include <stdio.h>
namespace cg = cooperative_groups;

#ifndef MEGA
#define MEGA 1
#endif
#ifndef REP_GEMM
#define REP_GEMM 1
#endif
#ifndef REP_ATT
#define REP_ATT 1
#endif
#ifndef REP_SSD
#define REP_SSD 1
#endif

typedef unsigned short bf16_t;
using bf16x8 = __attribute__((ext_vector_type(8))) short;
using s16x4  = __attribute__((ext_vector_type(4))) short;
using f32x4  = __attribute__((ext_vector_type(4))) float;
using f32x16 = __attribute__((ext_vector_type(16))) float;
using u32x4  = __attribute__((ext_vector_type(4))) unsigned;
using u32x2  = __attribute__((ext_vector_type(2))) unsigned;
#define DI __device__ __forceinline__
#define MFMA32(a, b, c) __builtin_amdgcn_mfma_f32_32x32x16_bf16((a), (b), (c), 0, 0, 0)
#define MFMA16(a, b, c) __builtin_amdgcn_mfma_f32_16x16x32_bf16((a), (b), (c), 0, 0, 0)

constexpr int DM = 1024, NB = 4, SEQ = 4096, CTX = 256;
constexpr int ML = NB * SEQ;
constexpr int MC = NB * CTX;
constexpr int MT = ML + MC;
constexpr int DIN = 2480, DINP = 2560;
constexpr int LK = CTX + SEQ;
constexpr int DFF = 4096;
constexpr int NCH = 34;
constexpr float EPS = 1e-6f;
constexpr int U_CKV = 256, U_KR = 384, U_GB = 416, U_GC = 672, U_VAL = 928, U_Z = 1184, U_XBC = 1696, U_DT = 2464;

constexpr size_t AL(size_t x) { return (x + 255) & ~(size_t)255; }
constexpr size_t WT_IN = 0;
constexpr size_t WT_UQ = WT_IN + (size_t)DINP * 1024;
constexpr size_t WT_UKV = WT_UQ + (size_t)384 * 256;
constexpr size_t WT_OUT = WT_UKV + (size_t)512 * 128;
constexpr size_t WT_FF1 = WT_OUT + (size_t)1024 * 1024;
constexpr size_t WT_FF2 = WT_FF1 + (size_t)4096 * 1024;
constexpr size_t WT_ELEMS = WT_FF2 + (size_t)4096 * 1024;
constexpr size_t OFF_WT = 0;
constexpr size_t OFF_MOD = AL(OFF_WT + 2 * WT_ELEMS * 2);
constexpr size_t OFF_XC = AL(OFF_MOD + 2 * 5 * 6144 * 4);
constexpr size_t OFF_H = AL(OFF_XC + (size_t)MC * DM * 4);
constexpr size_t OFF_R1 = AL(OFF_H + (size_t)MT * DM * 2);
constexpr size_t OFF_U = OFF_R1;
constexpr size_t OFF_DT = AL(OFF_U + (size_t)MT * DIN * 2);
constexpr size_t OFF_RSTD = AL(OFF_DT + (size_t)MT * 16 * 4);
constexpr size_t OFF_QB = AL(OFF_RSTD + (size_t)MT * 2 * 4);
constexpr size_t OFF_KB = AL(OFF_QB + (size_t)MT * 384 * 2);
constexpr size_t OFF_VT = AL(OFF_KB + (size_t)NB * 4 * LK * 96 * 2);
constexpr size_t OFF_XBC = AL(OFF_VT + (size_t)NB * 4 * 64 * LK * 2);
constexpr size_t OFF_SST = AL(OFF_XBC + (size_t)MT * 768 * 2);
constexpr size_t OFF_TDEC = AL(OFF_SST + (size_t)2 * NB * NCH * 8 * 4096 * 2);
constexpr size_t OFF_SSQ = AL(OFF_TDEC + (size_t)2 * NB * NCH * 8 * 4);
constexpr size_t OFF_END1 = AL(OFF_SSQ + (size_t)MT * 8 * 4);
constexpr size_t OFF_F1 = OFF_R1;
constexpr size_t OFF_END2 = AL(OFF_F1 + (size_t)MT * DFF * 2);
constexpr size_t WS_NEED = (size_t)256 << 20;
constexpr size_t OFF_BAR = WS_NEED - 16384;
static_assert(OFF_END1 <= OFF_BAR && OFF_END2 + (size_t)8 * MC * DM * 4 <= OFF_BAR, "workspace layout overflows 256 MiB");

struct Params {
  const float *x, *c, *ctx, *c_ctx, *w_mod, *b_mod, *g_pre_mix, *w_in, *q_norm, *w_uq, *kv_norm, *w_ukv, *sc_w, *ssd_cw, *ssd_cb,
      *a_log, *dt_bias, *ssd_d, *ssd_norm, *w_out, *g_post_mix, *g_pre_ffn, *w_ff1, *w_ff2, *g_post_ffn;
  float* out;
  char* ws;
};

DI int ltid() { int t = threadIdx.x; asm volatile("" : "+v"(t)); return t & 255; }
DI int ltid512() { int t = threadIdx.x; asm volatile("" : "+v"(t)); return t; }
typedef __bf16 hbf2 __attribute__((ext_vector_type(2)));
typedef float hf2 __attribute__((ext_vector_type(2)));
DI bf16_t f2bf(float x) { return __builtin_bit_cast(bf16_t, (__bf16)x); }
DI float bf2f(unsigned v) { return __uint_as_float(v << 16); }
DI unsigned pack2(float a, float b) { hf2 v = {a, b}; return __builtin_bit_cast(unsigned, __builtin_convertvector(v, hbf2)); }
DI float lo2f(unsigned w) { return __uint_as_float(w << 16); }
DI float hi2f(unsigned w) { return __uint_as_float(w & 0xffff0000u); }
DI float wave_sum(float v) {
#pragma unroll
  for (int o = 32; o > 0; o >>= 1) v += __shfl_xor(v, o);
  return v;
}
DI float silu_f(float x) { return x / (1.f + __expf(-x)); }
DI int crow(int reg, int h) { return (reg & 3) + 8 * (reg >> 2) + 4 * h; }
DI bf16x8 pack8(const f32x16& x, int s) {
  u32x4 p;
  p[0] = pack2(x[8 * s + 0], x[8 * s + 1]); p[1] = pack2(x[8 * s + 2], x[8 * s + 3]);
  p[2] = pack2(x[8 * s + 4], x[8 * s + 5]); p[3] = pack2(x[8 * s + 6], x[8 * s + 7]);
  return __builtin_bit_cast(bf16x8, p);
}
DI const float* xin_row(const Params& p, int layer, int row) {
  if (layer == 0) return row < ML ? p.x + (size_t)row * DM : p.ctx + (size_t)(row - ML) * DM;
  return row < ML ? p.out + (size_t)row * DM : (const float*)(p.ws + OFF_XC) + (size_t)(row - ML) * DM;
}
DI float* xst_row(const Params& p, int row) {
  return row < ML ? p.out + (size_t)row * DM : (float*)(p.ws + OFF_XC) + (size_t)(row - ML) * DM;
}
DI const float* mod_ptr(const Params& p, int layer, int row, int which) {
  int bb = row < ML ? (row >> 12) : 4;
  return (const float*)(p.ws + OFF_MOD) + ((size_t)(layer * 5 + bb) * 6 + which) * DM;
}
DI bf16_t* wt_ptr(const Params& p, int layer, size_t off) { return (bf16_t*)(p.ws + OFF_WT) + (size_t)layer * WT_ELEMS + off; }

DI void transpose_item(const float* __restrict__ w, const float* __restrict__ gk, int gk_from, bf16_t* __restrict__ wt, int K, int N, int kt, int nt, char* smem) {
  float* tile = (float*)smem;
  const int tid = ltid(), tx = tid & 63, ty = tid >> 6;
  const int k0 = kt * 64, n0 = nt * 64;
  const int n = n0 + tx;
  float v[16];
#pragma unroll
  for (int i = 0; i < 16; ++i) {
    int kk = ty + 4 * i;
    v[i] = n < N ? w[(size_t)(k0 + kk) * N + n] : 0.f;
  }
  if (gk) {
#pragma unroll
    for (int i = 0; i < 16; ++i) { int k = k0 + ty + 4 * i; if (k >= gk_from) v[i] *= gk[k - gk_from]; }
  }
#pragma unroll
  for (int i = 0; i < 16; ++i) tile[(ty + 4 * i) * 65 + tx] = v[i];
  __syncthreads();
#pragma unroll
  for (int i = 0; i < 2; ++i) {
    int c = tid + 256 * i, nn = c >> 3, kc = c & 7;
    u32x4 o;
#pragma unroll
    for (int jj = 0; jj < 4; ++jj) o[jj] = pack2(tile[(kc * 8 + 2 * jj) * 65 + nn], tile[(kc * 8 + 2 * jj + 1) * 65 + nn]);
    *(u32x4*)(wt + (size_t)(n0 + nn) * K + k0 + kc * 8) = o;
  }
  __syncthreads();
}

DI void modgemv_item(const Params& p, int layer, int ct, char* smem) {
  float* s = (float*)smem;
  float* red = s + 5 * 1024;
  const int tid = ltid(), w = tid >> 6, lane = tid & 63, ln = lane & 31, kh = lane >> 5;
  for (int i = tid; i < 5 * 1024; i += 256) {
    int bb = i >> 10, k = i & 1023;
    float v = bb < 4 ? p.c[bb * 1024 + k] : p.c_ctx[k];
    s[i] = silu_f(v);
  }
  __syncthreads();
  const float* wm = p.w_mod + (size_t)layer * 1024 * 6144;
  const int n = ct * 32 + ln;
  float acc[5] = {0.f, 0.f, 0.f, 0.f, 0.f};
#pragma unroll 16
  for (int i = 0; i < 128; ++i) {
    const int k = w * 256 + 2 * i + kh;
    float wv = wm[(size_t)k * 6144 + n];
#pragma unroll
    for (int bb = 0; bb < 5; ++bb) acc[bb] += s[bb * 1024 + k] * wv;
  }
#pragma unroll
  for (int bb = 0; bb < 5; ++bb) {
    acc[bb] += __shfl_xor(acc[bb], 32);
    if (kh == 0) red[(w * 5 + bb) * 32 + ln] = acc[bb];
  }
  __syncthreads();
  if (tid < 160) {
    int bb = tid >> 5, l2 = tid & 31;
    float v = red[(0 * 5 + bb) * 32 + l2] + red[(1 * 5 + bb) * 32 + l2] + red[(2 * 5 + bb) * 32 + l2] + red[(3 * 5 + bb) * 32 + l2];
    int nn = ct * 32 + l2;
    v += p.b_mod[layer * 6144 + nn];
    ((float*)(p.ws + OFF_MOD))[(size_t)(layer * 5 + bb) * 6144 + nn] = v;
  }
  __syncthreads();
}

constexpr int WT_ITEMS = 2984;
DI void wt_item(const Params& p, int layer, int j, char* smem) {
  if (j < 640) transpose_item(p.w_in + (size_t)layer * 1024 * DIN, nullptr, 0, wt_ptr(p, layer, WT_IN), 1024, DIN, j / 40, j % 40, smem);
  else if ((j -= 640) < 24) transpose_item(p.w_uq + (size_t)layer * 256 * 384, p.q_norm + layer * 256, 0, wt_ptr(p, layer, WT_UQ), 256, 384, j / 6, j % 6, smem);
  else if ((j -= 24) < 16) transpose_item(p.w_ukv + (size_t)layer * 128 * 512, p.kv_norm + layer * 128, 0, wt_ptr(p, layer, WT_UKV), 128, 512, j / 8, j % 8, smem);
  else if ((j -= 16) < 256) transpose_item(p.w_out + (size_t)layer * 1024 * 1024, p.ssd_norm + layer * 512, 512, wt_ptr(p, layer, WT_OUT), 1024, 1024, j / 16, j % 16, smem);
  else if ((j -= 256) < 1024) transpose_item(p.w_ff1 + (size_t)layer * 1024 * 4096, nullptr, 0, wt_ptr(p, layer, WT_FF1), 1024, 4096, j / 64, j % 64, smem);
  else { j -= 1024; transpose_item(p.w_ff2 + (size_t)layer * 4096 * 1024, nullptr, 0, wt_ptr(p, layer, WT_FF2), 4096, 1024, j / 16, j % 16, smem); }
}
DI void phase_prep0(const Params& p, int bid, int nb, char* smem) {
  for (int it = bid; it < 384 + 640; it += nb) {
    if (it < 384) modgemv_item(p, it / 192, it % 192, smem);
    else wt_item(p, 0, it - 384, smem);
  }
}
struct HMod { float4 g[4], s1[4], s0[4]; };
DI void load_hmod(HMod& m, const float* g, const float* sh, const float* sc, int lane) {
#pragma unroll
  for (int i = 0; i < 4; ++i) {
    const int col = lane * 4 + 256 * i;
    m.g[i] = *(const float4*)(g + col); m.s1[i] = *(const float4*)(sc + col); m.s0[i] = *(const float4*)(sh + col);
  }
}
DI void write_h_row(const float4 xv[4], float rstd, const HMod& m, bf16_t* hrow, int lane) {
#pragma unroll
  for (int i = 0; i < 4; ++i) {
    const int col = lane * 4 + 256 * i;
    float a = xv[i].x * rstd * m.g[i].x * (1.f + m.s1[i].x) + m.s0[i].x;
    float b = xv[i].y * rstd * m.g[i].y * (1.f + m.s1[i].y) + m.s0[i].y;
    float c = xv[i].z * rstd * m.g[i].z * (1.f + m.s1[i].z) + m.s0[i].z;
    float d = xv[i].w * rstd * m.g[i].w * (1.f + m.s1[i].w) + m.s0[i].w;
    u32x2 o; o[0] = pack2(a, b); o[1] = pack2(c, d);
    *(u32x2*)(hrow + col) = o;
  }
}
DI float ssq4(const float4 v[4]) {
  float s = 0.f;
#pragma unroll
  for (int i = 0; i < 4; ++i) s += v[i].x * v[i].x + v[i].y * v[i].y + v[i].z * v[i].z + v[i].w * v[i].w;
  return s;
}
DI void load_bf_row(const bf16_t* r, int lane, float4 v[4]) {
#pragma unroll
  for (int i = 0; i < 4; ++i) {
    u32x2 t = *(const u32x2*)(r + lane * 4 + 256 * i);
    v[i] = make_float4(lo2f(t[0]), hi2f(t[0]), lo2f(t[1]), hi2f(t[1]));
  }
}

struct RowVec { float4 c1[4], c2[4], c3[4]; };
DI const float* mod_ptr_b(const Params& p, int layer, int bb, int which) {
  return (const float*)(p.ws + OFF_MOD) + ((size_t)(layer * 5 + bb) * 6 + which) * DM;
}
template <int MODE>
DI void rowwise_phase(const Params& p, int layer, int bid, int nb) {
  const int w = ltid() >> 6, lane = ltid() & 63;
  const int M = (MODE == 0 || layer == 0) ? MT : ML;
  const bool wh = MODE != 2 || layer == 0;
  bf16_t* H = (bf16_t*)(p.ws + OFF_H);
  const bf16_t* Y = MODE == 1 ? (const bf16_t*)(p.ws + OFF_U) : (const bf16_t*)(p.ws + OFF_H);
  const int NW = nb * 4, W = bid * 4 + w, nwb = NW >> 2;
  auto load_vec = [&](RowVec& v, int bb) {
    const float* gate = MODE == 1 ? mod_ptr_b(p, layer, bb, 2) : mod_ptr_b(p, layer, bb, 5);
    const float* gres = MODE == 1 ? p.g_post_mix + layer * DM : p.g_post_ffn + layer * DM;
    const int hl = MODE == 2 ? 1 : layer;
    const float* gn = MODE == 1 ? p.g_pre_ffn + layer * DM : p.g_pre_mix + hl * DM;
    const float* sh = mod_ptr_b(p, hl, bb, MODE == 1 ? 3 : 0);
    const float* sc = mod_ptr_b(p, hl, bb, MODE == 1 ? 4 : 1);
#pragma unroll
    for (int i = 0; i < 4; ++i) {
      const int col = lane * 4 + 256 * i;
      if (MODE != 0) {
        const float4 a = *(const float4*)(gate + col), b = *(const float4*)(gres + col);
        v.c1[i] = make_float4(a.x * b.x, a.y * b.y, a.z * b.z, a.w * b.w);
      }
      if (wh) {
        const float4 g = *(const float4*)(gn + col), s1 = *(const float4*)(sc + col);
        v.c2[i] = make_float4(g.x * (1.f + s1.x), g.y * (1.f + s1.y), g.z * (1.f + s1.z), g.w * (1.f + s1.w));
        v.c3[i] = *(const float4*)(sh + col);
      }
    }
  };
  struct RowIn { u32x2 y[4]; float4 x[4]; };
  auto load_row = [&](RowIn& r, int row) {
    const float* xr = MODE == 2 ? (const float*)xst_row(p, row) : xin_row(p, layer, row);
#pragma unroll
    for (int i = 0; i < 4; ++i) {
      r.x[i] = *(const float4*)(xr + lane * 4 + 256 * i);
      if (MODE != 0) r.y[i] = *(const u32x2*)(Y + (size_t)row * DM + lane * 4 + 256 * i);
    }
  };
  auto finish = [&](float4 (&xv)[4], const float4 (&yv)[4], const RowVec& v, int row) {
    if (MODE != 0) {
      const float rstd = rsqrtf(wave_sum(ssq4(yv)) * (1.f / DM) + EPS);
#pragma unroll
      for (int i = 0; i < 4; ++i) {
        xv[i].x += yv[i].x * rstd * v.c1[i].x; xv[i].y += yv[i].y * rstd * v.c1[i].y;
        xv[i].z += yv[i].z * rstd * v.c1[i].z; xv[i].w += yv[i].w * rstd * v.c1[i].w;
      }
      float* xo = xst_row(p, row);
#pragma unroll
      for (int i = 0; i < 4; ++i) *(float4*)(xo + lane * 4 + 256 * i) = xv[i];
    }
    if (wh) {
      const float rstd1 = rsqrtf(wave_sum(ssq4(xv)) * (1.f / DM) + EPS);
      bf16_t* hrow = H + (size_t)row * DM;
#pragma unroll
      for (int i = 0; i < 4; ++i) {
        u32x2 o;
        o[0] = pack2(xv[i].x * rstd1 * v.c2[i].x + v.c3[i].x, xv[i].y * rstd1 * v.c2[i].y + v.c3[i].y);
        o[1] = pack2(xv[i].z * rstd1 * v.c2[i].z + v.c3[i].z, xv[i].w * rstd1 * v.c2[i].w + v.c3[i].w);
        *(u32x2*)(hrow + lane * 4 + 256 * i) = o;
      }
    }
  };
  auto process = [&](RowIn& r, const RowVec& v, int row) {
    float4 yv[4];
#pragma unroll
    for (int i = 0; i < 4; ++i) yv[i] = make_float4(lo2f(r.y[i][0]), hi2f(r.y[i][0]), lo2f(r.y[i][1]), hi2f(r.y[i][1]));
    finish(r.x, yv, v, row);
  };
  RowVec v;
  {
    const int bb = W / nwb, j = W - bb * nwb, end = SEQ * (bb + 1);
    load_vec(v, bb);
    RowIn ra, rb;
    int row = SEQ * bb + j;
    if (row < end) load_row(ra, row);
    while (row < end) {
      const int rowb = row + nwb;
      const bool hb = rowb < end;
      if (hb) load_row(rb, rowb);
      process(ra, v, row);
      if (!hb) break;
      const int rowa = rowb + nwb;
      const bool ha = rowa < end;
      if (ha) load_row(ra, rowa);
      process(rb, v, rowb);
      if (!ha) break;
      row = rowa;
    }
  }
  if (M > ML) {
    load_vec(v, 4);
    for (int row = ML + W; row < M; row += NW) {
      float4 xv[4], yv[4];
      const float* xr = MODE == 2 ? (const float*)xst_row(p, row) : xin_row(p, layer, row);
#pragma unroll
      for (int i = 0; i < 4; ++i) xv[i] = *(const float4*)(xr + lane * 4 + 256 * i);
      if (MODE != 0) {
        const float* pp = (const float*)(p.ws + (MODE == 1 ? OFF_QB : OFF_END2)) + (size_t)(row - ML) * DM;
#pragma unroll
        for (int i = 0; i < 4; ++i) {
          float4 a = *(const float4*)(pp + lane * 4 + 256 * i), b = *(const float4*)(pp + (size_t)MC * DM + lane * 4 + 256 * i);
          float4 c = *(const float4*)(pp + (size_t)2 * MC * DM + lane * 4 + 256 * i), d = *(const float4*)(pp + (size_t)3 * MC * DM + lane * 4 + 256 * i);
          yv[i] = make_float4((a.x + b.x) + (c.x + d.x), (a.y + b.y) + (c.y + d.y), (a.z + b.z) + (c.z + d.z), (a.w + b.w) + (c.w + d.w));
          if (MODE == 2) {
            const float* p2 = pp + (size_t)4 * MC * DM;
            float4 e = *(const float4*)(p2 + lane * 4 + 256 * i), f = *(const float4*)(p2 + (size_t)MC * DM + lane * 4 + 256 * i);
            float4 g = *(const float4*)(p2 + (size_t)2 * MC * DM + lane * 4 + 256 * i), h = *(const float4*)(p2 + (size_t)3 * MC * DM + lane * 4 + 256 * i);
            yv[i].x += (e.x + f.x) + (g.x + h.x); yv[i].y += (e.y + f.y) + (g.y + h.y);
            yv[i].z += (e.z + f.z) + (g.z + h.z); yv[i].w += (e.w + f.w) + (g.w + h.w);
          }
        }
      }
      finish(xv, yv, v, row);
    }
  }
}
DI void phase_h0(const Params& p, int bid, int nb) { rowwise_phase<0>(p, 0, bid, nb); }
DI void phase_postmix(const Params& p, int layer, int bid, int nb) { rowwise_phase<1>(p, layer, bid, nb); }
DI void phase_postffn(const Params& p, int layer, int bid, int nb) { rowwise_phase<2>(p, layer, bid, nb); }

DI void phase_prep(const Params& p, int layer, int bid, int nb) {
  const int w = ltid() >> 6, lane = ltid() & 63;
  const bf16_t* U = (const bf16_t*)(p.ws + OFF_U);
  float* DT = (float*)(p.ws + OFF_DT);
  float* RS = (float*)(p.ws + OFF_RSTD);
  bf16_t* KB = (bf16_t*)(p.ws + OFF_KB);
  bf16_t* XBC = (bf16_t*)(p.ws + OFF_XBC);
  bf16_t* YM = (bf16_t*)(p.ws + OFF_H);
  const float* scw = p.sc_w + layer * 3 * 256;
  const float* cw = p.ssd_cw + layer * 3 * 768;
  const float* cb = p.ssd_cb + layer * 768;
  const int c4 = lane * 4;
  const float4 sw0 = *(const float4*)(scw + c4), sw1 = *(const float4*)(scw + 256 + c4), sw2 = *(const float4*)(scw + 512 + c4);
  float4 cwk[3][3], cbi[3];
#pragma unroll
  for (int i = 0; i < 3; ++i) {
    cbi[i] = *(const float4*)(cb + c4 + 256 * i);
#pragma unroll
    for (int k = 0; k < 3; ++k) cwk[i][k] = *(const float4*)(cw + k * 768 + c4 + 256 * i);
  }
  const float dtb = p.dt_bias[layer * 16 + (lane & 15)];
  const float invf = exp2f(-(float)(2 * (lane & 7)) * (13.287712379549449f / 16.f));
  for (int row = bid * 4 + w; row < MT; row += nb * 4) {
    int b, t, L, pos;
    const bool lat = row < ML;
    if (lat) { b = row >> 12; t = row & 4095; L = SEQ; pos = t + CTX; }
    else { int rr = row - ML; b = rr >> 8; t = rr & 255; L = CTX; pos = t; }
    const bf16_t* u0 = U + (size_t)row * DIN;
    const bool hp = t > 0, hn = t < L - 1;
    const bf16_t* um = hp ? u0 - DIN : u0;
    const bf16_t* up = hn ? u0 + DIN : u0;
    const float mp = hp ? 1.f : 0.f, mn = hn ? 1.f : 0.f;
    const u32x2 vq = *(const u32x2*)(u0 + c4);
    const u32x2 vkv = *(const u32x2*)(u0 + U_CKV + (lane & 31) * 4);
    const float kr = bf2f(u0[U_KR + (lane & 31)]);
    const u32x2 gcm = *(const u32x2*)(um + U_GC + c4), gc0 = *(const u32x2*)(u0 + U_GC + c4), gcp = *(const u32x2*)(up + U_GC + c4);
    const u32x2 vvm = *(const u32x2*)(um + U_VAL + c4), vv0 = *(const u32x2*)(u0 + U_VAL + c4), vvp = *(const u32x2*)(up + U_VAL + c4);
    const u32x2 gb = *(const u32x2*)(u0 + U_GB + c4);
    u32x2 xm[3], x0[3], xp[3];
#pragma unroll
    for (int i = 0; i < 3; ++i) {
      xm[i] = *(const u32x2*)(um + U_XBC + c4 + 256 * i);
      x0[i] = *(const u32x2*)(u0 + U_XBC + c4 + 256 * i);
      xp[i] = *(const u32x2*)(up + U_XBC + c4 + 256 * i);
    }
    const float dtr = DT[(size_t)row * 16 + (lane & 15)];
    {
      float a = lo2f(vq[0]), bq = hi2f(vq[0]), c = lo2f(vq[1]), d = hi2f(vq[1]);
      float ss = wave_sum(a * a + bq * bq + c * c + d * d);
      float e = lo2f(vkv[0]), f = hi2f(vkv[0]), g = lo2f(vkv[1]), h = hi2f(vkv[1]);
      float s2 = lane < 32 ? e * e + f * f + g * g + h * h : 0.f;
      s2 = wave_sum(s2);
      if (lane == 0) { RS[row * 2] = rsqrtf(ss * (1.f / 256) + EPS); RS[row * 2 + 1] = rsqrtf(s2 * (1.f / 128) + EPS); }
    }
    {
      const float partner = __shfl_xor(kr, 8);
      float o = kr;
      if (lat) {
        const int grp = (lane & 31) >> 3;
        const float posf = grp < 2 ? (float)(t >> 6) : (float)(t & 63);
        const float rev = posf * invf * 0.15915494309189535f;
        const float cs = __builtin_amdgcn_cosf(rev), sn = __builtin_amdgcn_sinf(rev);
        o = (grp & 1) ? kr * cs + partner * sn : kr * cs - partner * sn;
      }
      if (lane < 32) {
        const bf16_t ob = f2bf(o);
#pragma unroll
        for (int hd = 0; hd < 4; ++hd) KB[((size_t)(b * 4 + hd) * LK + pos) * 96 + 64 + lane] = ob;
      }
    }
    {
      float a0 = sw1.x * lo2f(gc0[0]) * lo2f(vv0[0]) + mp * sw0.x * lo2f(gcm[0]) * lo2f(vvm[0]) + mn * sw2.x * lo2f(gcp[0]) * lo2f(vvp[0]);
      float a1 = sw1.y * hi2f(gc0[0]) * hi2f(vv0[0]) + mp * sw0.y * hi2f(gcm[0]) * hi2f(vvm[0]) + mn * sw2.y * hi2f(gcp[0]) * hi2f(vvp[0]);
      float a2 = sw1.z * lo2f(gc0[1]) * lo2f(vv0[1]) + mp * sw0.z * lo2f(gcm[1]) * lo2f(vvm[1]) + mn * sw2.z * lo2f(gcp[1]) * lo2f(vvp[1]);
      float a3 = sw1.w * hi2f(gc0[1]) * hi2f(vv0[1]) + mp * sw0.w * hi2f(gcm[1]) * hi2f(vvm[1]) + mn * sw2.w * hi2f(gcp[1]) * hi2f(vvp[1]);
      u32x2 o; o[0] = pack2(lo2f(gb[0]) * a0, hi2f(gb[0]) * a1); o[1] = pack2(lo2f(gb[1]) * a2, hi2f(gb[1]) * a3);
      *(u32x2*)(YM + (size_t)row * DM + 256 + c4) = o;
    }
#pragma unroll
    for (int i = 0; i < 3; ++i) {
      float a0 = cbi[i].x + cwk[i][1].x * lo2f(x0[i][0]) + mp * cwk[i][0].x * lo2f(xm[i][0]) + mn * cwk[i][2].x * lo2f(xp[i][0]);
      float a1 = cbi[i].y + cwk[i][1].y * hi2f(x0[i][0]) + mp * cwk[i][0].y * hi2f(xm[i][0]) + mn * cwk[i][2].y * hi2f(xp[i][0]);
      float a2 = cbi[i].z + cwk[i][1].z * lo2f(x0[i][1]) + mp * cwk[i][0].z * lo2f(xm[i][1]) + mn * cwk[i][2].z * lo2f(xp[i][1]);
      float a3 = cbi[i].w + cwk[i][1].w * hi2f(x0[i][1]) + mp * cwk[i][0].w * hi2f(xm[i][1]) + mn * cwk[i][2].w * hi2f(xp[i][1]);
      u32x2 o; o[0] = pack2(silu_f(a0), silu_f(a1)); o[1] = pack2(silu_f(a2), silu_f(a3));
      *(u32x2*)(XBC + (size_t)row * 768 + c4 + 256 * i) = o;
    }
    if (lane < 16) {
      const float v = dtr + dtb;
      const float e = __expf(-fabsf(v));
      DT[(size_t)row * 16 + lane] = fmaxf(v, 0.f) + (e < 1e-3f ? e * (1.f - 0.5f * e) : __logf(1.f + e));
    }
  }
}

DI void phase_ssdnorm(const Params& p, int layer, int bid, int nb) {
  const int w = ltid() >> 6, lane = ltid() & 63;
  const int M = layer == 0 ? MT : ML;
  bf16_t* YM = (bf16_t*)(p.ws + OFF_H);
  const float* SSQ = (const float*)(p.ws + OFF_SSQ);
  const float* ng = p.ssd_norm + layer * 512;
  for (int row = bid * 4 + w; row < M; row += nb * 4) {
    int g = lane >> 5;
    float4 s = *(const float4*)(SSQ + (size_t)row * 8 + g * 4);
    float rstd = rsqrtf((s.x + s.y + s.z + s.w) * (1.f / 256) + EPS);
    bf16_t* ptr = YM + (size_t)row * DM + 512 + lane * 8;
    u32x4 v = *(const u32x4*)ptr;
    float4 g0 = *(const float4*)(ng + lane * 8), g1 = *(const float4*)(ng + lane * 8 + 4);
    u32x4 o;
    o[0] = pack2(lo2f(v[0]) * rstd * g0.x, hi2f(v[0]) * rstd * g0.y);
    o[1] = pack2(lo2f(v[1]) * rstd * g0.z, hi2f(v[1]) * rstd * g0.w);
    o[2] = pack2(lo2f(v[2]) * rstd * g1.x, hi2f(v[2]) * rstd * g1.y);
    o[3] = pack2(lo2f(v[3]) * rstd * g1.z, hi2f(v[3]) * rstd * g1.w);
    *(u32x4*)ptr = o;
  }
}

constexpr int GST = 80;
constexpr int GBUF = 2 * 128 * GST;
template <bool GN, class Epi>
DI void gemm_tile(const bf16_t* __restrict__ A, int lda, const bf16_t* __restrict__ Bt, int K, int row0, int col0, char* smem, Epi epi, const float* __restrict__ ssq = nullptr) {
  bf16_t* S0 = (bf16_t*)smem;
  const int tid = ltid(), wid = tid >> 6, lane = tid & 63, wr = wid >> 1, wc = wid & 1, fr = lane & 15, fq = lane >> 4;
  f32x4 acc[4][4];
#pragma unroll
  for (int m = 0; m < 4; ++m)
#pragma unroll
    for (int n = 0; n < 4; ++n) acc[m][n] = f32x4{0.f, 0.f, 0.f, 0.f};
  u32x4 ra[4], rb[4];
  const int sr = tid >> 3, sp = tid & 7;
  const bf16_t* ga = A + (size_t)(row0 + sr) * lda + sp * 8;
  const bf16_t* gb = Bt + (size_t)(col0 + sr) * K + sp * 8;
  auto gload = [&](int k0) {
#pragma unroll
    for (int i = 0; i < 4; ++i) {
      ra[i] = *(const u32x4*)(ga + (size_t)(32 * i) * lda + k0);
      rb[i] = *(const u32x4*)(gb + (size_t)(32 * i) * K + k0);
    }
  };
  gload(0);
  float gs[4][2];
  if (GN) {
#pragma unroll
    for (int i = 0; i < 4; ++i) {
      const float4 s0 = *(const float4*)(ssq + (size_t)(row0 + sr + 32 * i) * 8), s1 = *(const float4*)(ssq + (size_t)(row0 + sr + 32 * i) * 8 + 4);
      gs[i][0] = rsqrtf((s0.x + s0.y + s0.z + s0.w) * (1.f / 256) + EPS);
      gs[i][1] = rsqrtf((s1.x + s1.y + s1.z + s1.w) * (1.f / 256) + EPS);
    }
  }
  auto swrite = [&](int kt) {
    if (GN && kt >= 8) {
      const int g = (kt - 8) >> 2;
#pragma unroll
      for (int i = 0; i < 4; ++i) {
        const float sc = g ? gs[i][1] : gs[i][0];
#pragma unroll
        for (int jj = 0; jj < 4; ++jj) ra[i][jj] = pack2(lo2f(ra[i][jj]) * sc, hi2f(ra[i][jj]) * sc);
      }
    }
    bf16_t* As = S0 + (kt & 1) * GBUF;
    bf16_t* Bs = As + 128 * GST;
#pragma unroll
    for (int i = 0; i < 4; ++i) {
      *(u32x4*)(As + (sr + 32 * i) * GST + sp * 8) = ra[i];
      *(u32x4*)(Bs + (sr + 32 * i) * GST + sp * 8) = rb[i];
    }
  };
  const int KT = K / 64;
  swrite(0);
  if (KT > 1) gload(64);
  __syncthreads();
  for (int kt = 0; kt < KT; ++kt) {
    const bf16_t* As = S0 + (kt & 1) * GBUF;
    const bf16_t* Bs = As + 128 * GST;
#pragma unroll
    for (int ks = 0; ks < 2; ++ks) {
      bf16x8 af[4], bfr[4];
#pragma unroll
      for (int m = 0; m < 4; ++m) af[m] = *(const bf16x8*)(As + (wr * 64 + m * 16 + fr) * GST + ks * 32 + fq * 8);
#pragma unroll
      for (int n = 0; n < 4; ++n) bfr[n] = *(const bf16x8*)(Bs + (wc * 64 + n * 16 + fr) * GST + ks * 32 + fq * 8);
#pragma unroll
      for (int m = 0; m < 4; ++m)
#pragma unroll
        for (int n = 0; n < 4; ++n) acc[m][n] = MFMA16(bfr[n], af[m], acc[m][n]);
      if (ks == 0 && kt + 1 < KT) {
        swrite(kt + 1);
        if (kt + 2 < KT) gload((kt + 2) * 64);
      }
    }
    __syncthreads();
  }
  float rsc[4];
#pragma unroll
  for (int m = 0; m < 4; ++m) rsc[m] = epi.scale(row0 + wr * 64 + m * 16 + fr);
#pragma unroll
  for (int m = 0; m < 4; ++m)
#pragma unroll
    for (int n = 0; n < 4; ++n) epi(row0 + wr * 64 + m * 16 + fr, col0 + wc * 64 + n * 16 + fq * 4, acc[m][n], rsc[m]);
}

template <class Epi>
DI void gemm_tile_glds(const bf16_t* __restrict__ A, int lda, const bf16_t* __restrict__ Bt, int ldb, int K, int row0, int col0, char* smem, Epi epi) {
  const int tid = ltid(), wid = tid >> 6, lane = tid & 63, wr = wid >> 1, wc = wid & 1, fr = lane & 15, fq = lane >> 4;
  f32x4 acc[4][4];
#pragma unroll
  for (int m = 0; m < 4; ++m)
#pragma unroll
    for (int n = 0; n < 4; ++n) acc[m][n] = f32x4{0.f, 0.f, 0.f, 0.f};
  const int crow = tid >> 3, cslot = tid & 7, cpart = cslot ^ (crow & 7);
  const bf16_t* ga = A + (size_t)(row0 + crow) * lda + cpart * 8;
  const bf16_t* gb = Bt + (size_t)(col0 + crow) * ldb + cpart * 8;
  auto issue = [&](int kt, int stage) {
    char* sa = smem + stage * 32768 + tid * 16;
#pragma unroll
    for (int i = 0; i < 4; ++i) {
      __builtin_amdgcn_global_load_lds((const unsigned*)(ga + (size_t)(32 * i) * lda + kt * 64), (__attribute__((address_space(3))) unsigned*)(sa + i * 4096), 16, 0, 0);
      __builtin_amdgcn_global_load_lds((const unsigned*)(gb + (size_t)(32 * i) * ldb + kt * 64), (__attribute__((address_space(3))) unsigned*)(sa + 16384 + i * 4096), 16, 0, 0);
    }
  };
  const int KT = K / 64;
  issue(0, 0);
  asm volatile("s_waitcnt vmcnt(0)" ::: "memory");
  __syncthreads();
  const int sw = fr & 7;
  for (int kt = 0; kt < KT; ++kt) {
    if (kt + 1 < KT) issue(kt + 1, (kt + 1) & 1);
    const char* As = smem + (kt & 1) * 32768;
    const char* Bs = As + 16384;
#pragma unroll
    for (int ks = 0; ks < 2; ++ks) {
      bf16x8 af[4], bfr[4];
      const int so = ((ks * 4 + fq) ^ sw) * 16;
#pragma unroll
      for (int m = 0; m < 4; ++m) af[m] = *(const bf16x8*)(As + (wr * 64 + m * 16 + fr) * 128 + so);
#pragma unroll
      for (int n = 0; n < 4; ++n) bfr[n] = *(const bf16x8*)(Bs + (wc * 64 + n * 16 + fr) * 128 + so);
#pragma unroll
      for (int m = 0; m < 4; ++m)
#pragma unroll
        for (int n = 0; n < 4; ++n) acc[m][n] = MFMA16(bfr[n], af[m], acc[m][n]);
    }
    asm volatile("s_waitcnt vmcnt(0)" ::: "memory");
    __syncthreads();
  }
  float rsc[4];
#pragma unroll
  for (int m = 0; m < 4; ++m) rsc[m] = epi.scale(row0 + wr * 64 + m * 16 + fr);
#pragma unroll
  for (int m = 0; m < 4; ++m)
#pragma unroll
    for (int n = 0; n < 4; ++n) epi(row0 + wr * 64 + m * 16 + fr, col0 + wc * 64 + n * 16 + fq * 4, acc[m][n], rsc[m]);
}

constexpr int G8_HT = 128 * 64;
DI int g8_lds_byte(int r, int c) {
  int st = (r >> 4) * 2 + (c >> 5), rr = r & 15, cc = c & 31, ob = rr * 64 + cc * 2;
  return st * 1024 + (ob ^ (((ob >> 9) & 1) << 5));
}
DI void g8_stage_rc(int b, int& R, int& C) {
  int st = b / 1024, sb = b % 1024, swz = sb ^ (((sb >> 9) & 1) << 5);
  R = (st >> 1) * 16 + swz / 64; C = (st & 1) * 32 + (swz % 64) / 2;
}
template <bool GN = false, class Epi>
DI void gemm8_tile(const bf16_t* __restrict__ A, int lda, const bf16_t* __restrict__ Bt, int ldb, int K, int brow, int bcol, char* smem, Epi epi,
                   bool first = true, bool has_next = false, int nbrow = 0, int nbcol = 0, const float* __restrict__ ssq = nullptr) {
  bf16_t* shm = (bf16_t*)smem;
  const int tid = ltid512();
  float* gsl = (float*)(smem + 8 * G8_HT * 2);
  if (GN) {
    if (tid < 256) {
      const float* sp = ssq + (size_t)(brow + tid) * 8;
      const float4 s0 = *(const float4*)sp, s1 = *(const float4*)(sp + 4);
      gsl[tid] = rsqrtf((s0.x + s0.y + s0.z + s0.w) * (1.f / 256) + EPS);
      gsl[256 + tid] = rsqrtf((s1.x + s1.y + s1.z + s1.w) * (1.f / 256) + EPS);
    }
    __syncthreads();
  }
#define G8_SA(b, h) (shm + ((b) * 2 + (h)) * G8_HT)
#define G8_SB(b, h) (shm + (4 + (b) * 2 + (h)) * G8_HT)
#define G8_STAGE(P, BASE, LD, br, kt) do { const bf16_t* _g = (BASE) + (size_t)(br) * (LD) + (size_t)(kt) * 64; \
    _Pragma("unroll") for (int _i = 0; _i < 2; ++_i) { int _b = tid * 16 + _i * 8192; int _r, _c; g8_stage_rc(_b, _r, _c); \
      __builtin_amdgcn_global_load_lds((const unsigned*)(_g + (size_t)_r * (LD) + _c), \
        (__attribute__((address_space(3))) unsigned*)((char*)(P) + _b), 16, 0, 0); } } while (0)
#define G8_LDA(dst, b, h) _Pragma("unroll") for (int m = 0; m < 4; ++m) _Pragma("unroll") for (int k = 0; k < 2; ++k) \
    dst[m][k] = *reinterpret_cast<const bf16x8*>((char*)G8_SA(b, h) + g8_lds_byte(wr * 64 + m * 16 + fr, k * 32 + fq * 8))
#define G8_LDB(dst, b, h) _Pragma("unroll") for (int n = 0; n < 2; ++n) _Pragma("unroll") for (int k = 0; k < 2; ++k) \
    dst[n][k] = *reinterpret_cast<const bf16x8*>((char*)G8_SB(b, h) + g8_lds_byte(wc * 32 + n * 16 + fr, k * 32 + fq * 8))
#define G8_MMA(ai, bj, At, Bx) do { __builtin_amdgcn_s_setprio(1); \
    _Pragma("unroll") for (int m = 0; m < 4; ++m) _Pragma("unroll") for (int n = 0; n < 2; ++n) _Pragma("unroll") for (int k = 0; k < 2; ++k) \
      acc[ai][bj][m][n] = __builtin_amdgcn_mfma_f32_16x16x32_bf16(Bx[n][k], At[m][k], acc[ai][bj][m][n], 0, 0, 0); \
    __builtin_amdgcn_s_setprio(0); } while (0)
#define G8_WAIT_V(n) asm volatile("s_waitcnt vmcnt(" #n ")" ::: "memory")
#define G8_WAIT_L(n) asm volatile("s_waitcnt lgkmcnt(" #n ")" ::: "memory")
#define G8_BAR __builtin_amdgcn_s_barrier()
#define G8_SCHED __builtin_amdgcn_sched_barrier(0)
  const int wid = tid >> 6, lane = tid & 63, wr = wid >> 2, wc = wid & 3, fr = lane & 15, fq = lane >> 4;
  f32x4 acc[2][2][4][2];
#pragma unroll
  for (int a = 0; a < 2; ++a)
#pragma unroll
    for (int b = 0; b < 2; ++b)
#pragma unroll
      for (int m = 0; m < 4; ++m)
#pragma unroll
        for (int n = 0; n < 2; ++n) acc[a][b][m][n] = f32x4{0.f, 0.f, 0.f, 0.f};
  bf16x8 At[4][2], B0[2][2], B1[2][2];
  const int nt = K / 64;
  if (first) {
    G8_STAGE(G8_SB(0, 0), Bt, ldb, bcol, 0); G8_STAGE(G8_SA(0, 0), A, lda, brow, 0);
    G8_STAGE(G8_SB(0, 1), Bt, ldb, bcol + 128, 0); G8_STAGE(G8_SA(0, 1), A, lda, brow + 128, 0);
  }
  if (wr == 1) G8_BAR;
  if (first) G8_WAIT_V(4); else G8_WAIT_V(0);
  G8_BAR;
  G8_STAGE(G8_SB(1, 0), Bt, ldb, bcol, 1); G8_STAGE(G8_SA(1, 0), A, lda, brow, 1); G8_STAGE(G8_SB(1, 1), Bt, ldb, bcol + 128, 1);
  G8_WAIT_V(6); G8_BAR;
  for (int t = 0; t < nt - 2; t += 2) {
    if (GN && (t == 8 || t == 12)) {
#pragma unroll
      for (int ai = 0; ai < 2; ++ai)
#pragma unroll
        for (int m = 0; m < 4; ++m) {
          const int rl = ai * 128 + wr * 64 + m * 16 + fr;
          const float f = t == 8 ? 1.f / gsl[rl] : gsl[rl] / gsl[256 + rl];
#pragma unroll
          for (int bj = 0; bj < 2; ++bj)
#pragma unroll
            for (int n = 0; n < 2; ++n) acc[ai][bj][m][n] *= f;
        }
    }
    G8_LDB(B0, 0, 0); G8_SCHED; G8_LDA(At, 0, 0); G8_STAGE(G8_SA(1, 1), A, lda, brow + 128, t + 1);
    G8_WAIT_L(8); G8_BAR; G8_WAIT_L(0); G8_MMA(0, 0, At, B0); G8_BAR; G8_SCHED;
    G8_LDB(B1, 0, 1); G8_STAGE(G8_SB(0, 0), Bt, ldb, bcol, t + 2);
    G8_BAR; G8_WAIT_L(0); G8_MMA(0, 1, At, B1); G8_BAR;
    G8_LDA(At, 0, 1); G8_STAGE(G8_SA(0, 0), A, lda, brow, t + 2);
    G8_BAR; G8_WAIT_L(0); G8_MMA(1, 0, At, B0); G8_BAR; G8_SCHED;
    G8_STAGE(G8_SB(0, 1), Bt, ldb, bcol + 128, t + 2);
    G8_WAIT_V(6); G8_BAR; G8_MMA(1, 1, At, B1); G8_BAR;
    G8_LDB(B0, 1, 0); G8_SCHED; G8_LDA(At, 1, 0); G8_STAGE(G8_SA(0, 1), A, lda, brow + 128, t + 2);
    G8_WAIT_L(8); G8_BAR; G8_WAIT_L(0); G8_MMA(0, 0, At, B0); G8_BAR; G8_SCHED;
    G8_LDB(B1, 1, 1); G8_STAGE(G8_SB(1, 0), Bt, ldb, bcol, t + 3);
    G8_BAR; G8_WAIT_L(0); G8_MMA(0, 1, At, B1); G8_BAR;
    G8_LDA(At, 1, 1); G8_STAGE(G8_SA(1, 0), A, lda, brow, t + 3);
    G8_BAR; G8_WAIT_L(0); G8_MMA(1, 0, At, B0); G8_BAR; G8_SCHED;
    G8_STAGE(G8_SB(1, 1), Bt, ldb, bcol + 128, t + 3);
    G8_WAIT_V(6); G8_BAR; G8_MMA(1, 1, At, B1); G8_BAR;
  }
  { G8_LDB(B0, 0, 0); G8_LDA(At, 0, 0); G8_STAGE(G8_SA(1, 1), A, lda, brow + 128, nt - 1);
    G8_BAR; G8_WAIT_L(0); G8_MMA(0, 0, At, B0); G8_BAR;
    G8_LDB(B1, 0, 1); G8_BAR; G8_WAIT_L(0); G8_MMA(0, 1, At, B1); G8_BAR;
    G8_LDA(At, 0, 1); G8_WAIT_V(4); G8_BAR; G8_WAIT_L(0); G8_MMA(1, 0, At, B0); G8_MMA(1, 1, At, B1); G8_BAR; }
  { G8_LDB(B0, 1, 0); G8_LDA(At, 1, 0); G8_WAIT_V(2); G8_BAR; G8_WAIT_L(0); G8_MMA(0, 0, At, B0); G8_BAR;
    G8_LDB(B1, 1, 1); G8_WAIT_V(0); G8_BAR; G8_WAIT_L(0); G8_MMA(0, 1, At, B1); G8_BAR;
    G8_LDA(At, 1, 1); G8_BAR; G8_WAIT_L(0); G8_MMA(1, 0, At, B0); G8_MMA(1, 1, At, B1); G8_BAR; }
  if (GN) {
#pragma unroll
    for (int ai = 0; ai < 2; ++ai)
#pragma unroll
      for (int m = 0; m < 4; ++m) {
        const float f = gsl[256 + ai * 128 + wr * 64 + m * 16 + fr];
#pragma unroll
        for (int bj = 0; bj < 2; ++bj)
#pragma unroll
          for (int n = 0; n < 2; ++n) acc[ai][bj][m][n] *= f;
      }
  }
  if (has_next) {
    G8_STAGE(G8_SB(0, 0), Bt, ldb, nbcol, 0); G8_STAGE(G8_SA(0, 0), A, lda, nbrow, 0);
    G8_STAGE(G8_SB(0, 1), Bt, ldb, nbcol + 128, 0); G8_STAGE(G8_SA(0, 1), A, lda, nbrow + 128, 0);
  }
  if (wr == 0) G8_BAR;
  const bool odd = fq & 1;
#pragma unroll
  for (int ai = 0; ai < 2; ++ai)
#pragma unroll
    for (int bj = 0; bj < 2; ++bj)
#pragma unroll
      for (int m = 0; m < 4; ++m) {
        const int row = brow + ai * 128 + wr * 64 + m * 16 + fr, cb = bcol + bj * 128 + wc * 32;
        epi.side(row, cb + fq * 4, acc[ai][bj][m][0]);
        epi.side(row, cb + 16 + fq * 4, acc[ai][bj][m][1]);
        const u32x2 p0 = epi.pack(acc[ai][bj][m][0]), p1 = epi.pack(acc[ai][bj][m][1]);
        const u32x2 snd = odd ? p0 : p1;
        u32x2 rcv; rcv[0] = (unsigned)__shfl_xor((int)snd[0], 16); rcv[1] = (unsigned)__shfl_xor((int)snd[1], 16);
        u32x4 o;
        if (odd) { o[0] = rcv[0]; o[1] = rcv[1]; o[2] = p1[0]; o[3] = p1[1]; }
        else     { o[0] = p0[0]; o[1] = p0[1]; o[2] = rcv[0]; o[3] = rcv[1]; }
        epi.store16(row, odd ? cb + 16 + (fq - 1) * 4 : cb + fq * 4, o);
      }
  __syncthreads();
}

struct EpiBF {
  bf16_t* out; int ldo;
  DI void side(int, int, const f32x4&) const {}
  DI u32x2 pack(const f32x4& a) const { u32x2 o; o[0] = pack2(a[0], a[1]); o[1] = pack2(a[2], a[3]); return o; }
  DI void store16(int row, int col, const u32x4& v) const { *(u32x4*)(out + (size_t)row * ldo + col) = v; }
  DI float scale(int) const { return 1.f; }
  DI void operator()(int row, int col, const f32x4& a, float) const { (*this)(row, col, a); }
  DI void operator()(int row, int col, const f32x4& a) const {
    u32x2 o; o[0] = pack2(a[0], a[1]); o[1] = pack2(a[2], a[3]);
    *(u32x2*)(out + (size_t)row * ldo + col) = o;
  }
};
struct EpiRelu2 {
  bf16_t* out; int ldo;
  DI float scale(int) const { return 1.f; }
  DI void operator()(int row, int col, const f32x4& a, float) const { (*this)(row, col, a); }
  DI void side(int, int, const f32x4&) const {}
  DI u32x2 pack(const f32x4& a) const {
    float r0 = fmaxf(a[0], 0.f), r1 = fmaxf(a[1], 0.f), r2 = fmaxf(a[2], 0.f), r3 = fmaxf(a[3], 0.f);
    u32x2 o; o[0] = pack2(r0 * r0, r1 * r1); o[1] = pack2(r2 * r2, r3 * r3); return o;
  }
  DI void store16(int row, int col, const u32x4& v) const { *(u32x4*)(out + (size_t)row * ldo + col) = v; }
  DI void operator()(int row, int col, const f32x4& a) const {
    float r0 = fmaxf(a[0], 0.f), r1 = fmaxf(a[1], 0.f), r2 = fmaxf(a[2], 0.f), r3 = fmaxf(a[3], 0.f);
    u32x2 o; o[0] = pack2(r0 * r0, r1 * r1); o[1] = pack2(r2 * r2, r3 * r3);
    *(u32x2*)(out + (size_t)row * ldo + col) = o;
  }
};
struct EpiU {
  bf16_t* u; float* dt;
  DI void side(int row, int col, const f32x4& a) const { if (col >= U_DT && col < DIN) *(float4*)(dt + (size_t)row * 16 + col - U_DT) = make_float4(a[0], a[1], a[2], a[3]); }
  DI u32x2 pack(const f32x4& a) const { u32x2 o; o[0] = pack2(a[0], a[1]); o[1] = pack2(a[2], a[3]); return o; }
  DI void store16(int row, int col, const u32x4& v) const { if (col < DIN) *(u32x4*)(u + (size_t)row * DIN + col) = v; }
  DI void operator()(int row, int col, const f32x4& a) const {
    if (col < DIN) {
      u32x2 o; o[0] = pack2(a[0], a[1]); o[1] = pack2(a[2], a[3]);
      *(u32x2*)(u + (size_t)row * DIN + col) = o;
      if (col >= U_DT) *(float4*)(dt + (size_t)row * 16 + col - U_DT) = make_float4(a[0], a[1], a[2], a[3]);
    }
  }
};
struct EpiQ {
  bf16_t* q; const float* rs;
  DI float scale(int row) const { return rs[row * 2]; }
  DI void operator()(int row, int col, const f32x4& a, float r) const {
    u32x2 o; o[0] = pack2(a[0] * r, a[1] * r); o[1] = pack2(a[2] * r, a[3] * r);
    *(u32x2*)(q + (size_t)row * 384 + col) = o;
  }
};
struct EpiKV {
  bf16_t* kb; bf16_t* vt; const float* rs;
  DI float scale(int row) const { return rs[row * 2 + 1]; }
  DI void operator()(int row, int col, const f32x4& a, float r) const {
    int b, pos;
    if (row < ML) { b = row >> 12; pos = (row & 4095) + CTX; } else { int rr = row - ML; b = rr >> 8; pos = rr & 255; }
    const int head = col >> 7, d = col & 127;
    if (d < 64) {
      u32x2 o; o[0] = pack2(a[0] * r, a[1] * r); o[1] = pack2(a[2] * r, a[3] * r);
      *(u32x2*)(kb + ((size_t)(b * 4 + head) * LK + pos) * 96 + d) = o;
    } else {
#pragma unroll
      for (int j = 0; j < 4; ++j) vt[((size_t)(b * 4 + head) * 64 + (d - 64 + j)) * LK + pos] = f2bf(a[j] * r);
    }
  }
};

struct EpiPartS {
  float* part; const float* ssq; int g;
  DI float scale(int row) const {
    if (g < 0) return 1.f;
    const float4 sq = *(const float4*)(ssq + (size_t)row * 8 + g * 4);
    return rsqrtf((sq.x + sq.y + sq.z + sq.w) * (1.f / 256) + EPS);
  }
  DI void operator()(int row, int col, const f32x4& a, float r) const {
    *(float4*)(part + (size_t)(row - ML) * DM + col) = make_float4(a[0] * r, a[1] * r, a[2] * r, a[3] * r);
  }
};
struct EpiPart {
  float* part;
  DI float scale(int) const { return 1.f; }
  DI void operator()(int row, int col, const f32x4& a, float) const { (*this)(row, col, a); }
  DI void operator()(int row, int col, const f32x4& a) const {
    *(float4*)(part + (size_t)(row - ML) * DM + col) = make_float4(a[0], a[1], a[2], a[3]);
  }
};
DI void phase_inproj(const Params& p, int layer, int bid, int nb, int vbid, int nvb, char* smem, char* smem_half) {
  EpiU epi{(bf16_t*)(p.ws + OFF_U), (float*)(p.ws + OFF_DT)};
  const int x = bid & 7, per = nb >> 3;
  for (int rep = 0; rep < REP_GEMM; ++rep)
  for (int q = bid >> 3; q < 85; q += per) {
    const int m = (x >> 1) * 17 + q / 5, n = 5 * (x & 1) + q % 5;
    const int q2 = q + per, m2 = (x >> 1) * 17 + q2 / 5, n2 = 5 * (x & 1) + q2 % 5;
    gemm8_tile((const bf16_t*)(p.ws + OFF_H), DM, wt_ptr(p, layer, WT_IN), 1024, 1024, m * 256, n * 256, smem, epi,
               q == (bid >> 3), q2 < 85, m2 * 256, n2 * 256);
  }
  if (layer == 0) {
    if (per == 32) {
      if ((bid >> 3) >= 21) {
        const int u = ((bid >> 3) - 21) * 8 + x;
        for (int it = 640 + 2 * u + (vbid & 1); it < WT_ITEMS; it += 176) wt_item(p, 0, it, smem_half);
      }
    } else {
      for (int it = 640 + vbid; it < WT_ITEMS; it += nvb) wt_item(p, 0, it, smem_half);
    }
  }
}
DI void phase_wout(const Params& p, int layer, int bid, int nb, int vbid, int nvb, char* smem, char* smem_half) {
  EpiBF epi{(bf16_t*)(p.ws + OFF_U), DM};
  const float* ssq = (const float*)(p.ws + OFF_SSQ);
  const int x = bid & 7, per = nb >> 3;
  for (int rep = 0; rep < REP_GEMM; ++rep) {
    for (int q = bid >> 3; q < 32; q += per) {
      const int T = x * 32 + q;
      gemm8_tile<true>((const bf16_t*)(p.ws + OFF_H), DM, wt_ptr(p, layer, WT_OUT), 1024, 1024, (T >> 2) * 256, (T & 3) * 256, smem, epi,
                       true, false, 0, 0, ssq);
    }
    if (layer == 0)
      for (int it = vbid; it < (MC / 128) * 8 * 4; it += nvb) {
        const int tile = it >> 2, ks = it & 3;
        EpiPartS ep{(float*)(p.ws + OFF_QB) + (size_t)ks * MC * DM, ssq, ks - 2};
        gemm_tile_glds((const bf16_t*)(p.ws + OFF_H) + ks * 256, DM, wt_ptr(p, layer, WT_OUT) + ks * 256, 1024, 256, ML + (tile >> 3) * 128, (tile & 7) * 128, smem_half, ep);
      }
  }
}
DI void phase_ff1(const Params& p, int layer, int bid, int nb, int vbid, int nvb, char* smem, char* smem_half) {
  EpiRelu2 epi{(bf16_t*)(p.ws + OFF_F1), DFF};
  const int x = bid & 7, per = nb >> 3;
  for (int rep = 0; rep < REP_GEMM; ++rep) {
    for (int q = bid >> 3; q < 128; q += per) {
      const int m = (x >> 2) * 32 + (q >> 2), n = 4 * (x & 3) + (q & 3);
      const int q2 = q + per, m2 = (x >> 2) * 32 + (q2 >> 2), n2 = 4 * (x & 3) + (q2 & 3);
      gemm8_tile((const bf16_t*)(p.ws + OFF_H), DM, wt_ptr(p, layer, WT_FF1), 1024, 1024, m * 256, n * 256, smem, epi,
                 q == (bid >> 3), q2 < 128, m2 * 256, n2 * 256);
    }
    if (layer == 0)
      for (int it = vbid; it < (MC / 128) * 32; it += nvb)
        gemm_tile_glds((const bf16_t*)(p.ws + OFF_H), DM, wt_ptr(p, layer, WT_FF1), 1024, 1024, ML + (it / 32) * 128, (it % 32) * 128, smem_half, epi);
  }
}
DI void phase_ff2(const Params& p, int layer, int bid, int nb, int vbid, int nvb, char* smem, char* smem_half) {
  EpiBF epi{(bf16_t*)(p.ws + OFF_H), DM};
  const int x = bid & 7, per = nb >> 3;
  for (int rep = 0; rep < REP_GEMM; ++rep) {
    for (int q = bid >> 3; q < 32; q += per) {
      const int T = x * 32 + q;
      gemm8_tile((const bf16_t*)(p.ws + OFF_F1), DFF, wt_ptr(p, layer, WT_FF2), 4096, 4096, (T >> 2) * 256, (T & 3) * 256, smem, epi);
    }
    if (layer == 0)
      for (int it = vbid; it < (MC / 128) * 8 * 8; it += nvb) {
        const int tile = it >> 3, ks = it & 7;
        EpiPart ep{(float*)(p.ws + OFF_END2) + (size_t)ks * MC * DM};
        gemm_tile_glds((const bf16_t*)(p.ws + OFF_F1) + ks * 512, DFF, wt_ptr(p, layer, WT_FF2) + ks * 512, 4096, 512, ML + (tile >> 3) * 128, (tile & 7) * 128, smem_half, ep);
      }
  }
}

DI int chunk_row0(int b, int tc) { return tc < 2 ? ML + b * CTX + tc * 128 : b * SEQ + (tc - 2) * 128; }
constexpr int BST = 72;
constexpr int TST = 136;
DI void load_tile_T(bf16_t* dst, const bf16_t* __restrict__ src, int ldg) {
  const int tid = ltid();
#pragma unroll
  for (int i = 0; i < 4; ++i) {
    int c = tid + 256 * i, tok = c & 127, pc = c >> 7;
    u32x4 v = *(const u32x4*)(src + (size_t)tok * ldg + pc * 8);
#pragma unroll
    for (int j = 0; j < 4; ++j) {
      dst[(pc * 8 + 2 * j) * TST + tok] = (bf16_t)(v[j] & 0xffffu);
      dst[(pc * 8 + 2 * j + 1) * TST + tok] = (bf16_t)(v[j] >> 16);
    }
  }
}
DI void chunk_scan(const Params& p, int layer, int row0, int h, float* csf, float* csb, float* dtF, float* dtB, float* tot, float*  ) {
  const int tid = ltid(), w = tid >> 6, lane = tid & 63;
  const float* DT = (const float*)(p.ws + OFF_DT);
  float v;
  if (tid < 128) {
    const float dt = DT[(size_t)(row0 + tid) * 16 + h];
    v = dt * -__expf(p.a_log[layer * 16 + h]);
    dtF[tid] = dt;
  } else {
    const int e = 255 - tid;
    const float dt = DT[(size_t)(row0 + e) * 16 + 8 + h];
    v = dt * -__expf(p.a_log[layer * 16 + 8 + h]);
    dtB[e] = dt;
  }
#pragma unroll
  for (int o = 1; o < 64; o <<= 1) { const float t = __shfl_up(v, o); if (lane >= o) v += t; }
  if (lane == 63) tot[w] = v;
  __syncthreads();
  if (w == 1) v += tot[0];
  if (w == 3) v += tot[2];
  if (tid < 128) csf[tid] = v; else csb[255 - tid] = v;
  __syncthreads();
}

DI void ssd_state_item(const Params& p, int layer, int b, int tc, int h, char* smem) {
  bf16_t* XT = (bf16_t*)smem;
  bf16_t* BT = XT + 64 * TST;
  float* csf = (float*)(BT + 64 * TST);
  float* csb = csf + 128; float* dtF = csb + 128; float* dtB = dtF + 128; float* laF = dtB + 128; float* laB = laF + 128;
  const int tid = ltid(), w = tid >> 6, lane = tid & 63, r = lane & 31, hh = lane >> 5;
  const int row0 = chunk_row0(b, tc);
  const bf16_t* XBC = (const bf16_t*)(p.ws + OFF_XBC);
  load_tile_T(XT, XBC + (size_t)row0 * 768 + h * 64, 768);
  load_tile_T(BT, XBC + (size_t)row0 * 768 + 512 + (h >> 2) * 64, 768);
  chunk_scan(p, layer, row0, h, csf, csb, dtF, dtB, laF, laB);
  __syncthreads();
  if (tid < 128) laF[tid] = dtF[tid] * __expf(csf[127] - csf[tid]);
  else { int t = tid - 128; laB[t] = dtB[t] * __expf(csb[0] - csb[t]); }
  __syncthreads();
  const int d = w >> 1, pt = w & 1;
  const float* wv = d == 0 ? laF : laB;
  f32x16 acc[2];
#pragma unroll
  for (int i = 0; i < 16; ++i) { acc[0][i] = 0.f; acc[1][i] = 0.f; }
#pragma unroll
  for (int s = 0; s < 8; ++s) {
    int l0 = 16 * s + 8 * hh;
    u32x4 xa = *(const u32x4*)(XT + (32 * pt + r) * TST + l0);
    u32x4 sa;
#pragma unroll
    for (int j = 0; j < 4; ++j) sa[j] = pack2(lo2f(xa[j]) * wv[l0 + 2 * j], hi2f(xa[j]) * wv[l0 + 2 * j + 1]);
    bf16x8 af = __builtin_bit_cast(bf16x8, sa);
#pragma unroll
    for (int nt = 0; nt < 2; ++nt) {
      bf16x8 bfr = *(const bf16x8*)(BT + (32 * nt + r) * TST + l0);
      acc[nt] = MFMA32(af, bfr, acc[nt]);
    }
  }
  bf16_t* S = (bf16_t*)(p.ws + OFF_SST) + ((((size_t)d * NB + b) * NCH + tc) * 8 + h) * 4096;
#pragma unroll
  for (int nt = 0; nt < 2; ++nt)
#pragma unroll
    for (int i = 0; i < 16; ++i) S[(32 * pt + crow(i, hh)) * 64 + 32 * nt + r] = f2bf(acc[nt][i]);
  if (tid == 0) {
    float* TD = (float*)(p.ws + OFF_TDEC);
    TD[((0 * NB + b) * NCH + tc) * 8 + h] = __expf(csf[127]);
    TD[((1 * NB + b) * NCH + tc) * 8 + h] = __expf(csb[0]);
  }
  __syncthreads();
}

DI void ssd_pass_item(const Params& p, int it) {
  const int e = it * 256 + ltid();
  const int pn2 = e & 2047, h = (e >> 11) & 7, b = (e >> 14) & 3, d = e >> 16;
  unsigned* S = (unsigned*)(p.ws + OFF_SST);
  const float* TD = (const float*)(p.ws + OFF_TDEC);
  unsigned sv[NCH]; float T[NCH];
#pragma unroll
  for (int i = 0; i < NCH; ++i) {
    int tc = d == 0 ? i : (i < 2 ? 1 - i : NCH + 1 - i);
    sv[i] = S[(((size_t)(d * NB + b) * NCH + tc) * 8 + h) * 2048 + pn2];
    T[i] = TD[((d * NB + b) * NCH + tc) * 8 + h];
  }
  float h0 = 0.f, h1 = 0.f;
#pragma unroll
  for (int i = 0; i < NCH; ++i) {
    int tc = d == 0 ? i : (i < 2 ? 1 - i : NCH + 1 - i);
    S[(((size_t)(d * NB + b) * NCH + tc) * 8 + h) * 2048 + pn2] = pack2(h0, h1);
    h0 = T[i] * h0 + lo2f(sv[i]); h1 = T[i] * h1 + hi2f(sv[i]);
  }
}

DI void ssd_out_item(const Params& p, int layer, int b, int tc, int h, char* smem) {
  bf16_t* XT = (bf16_t*)smem;
  bf16_t* Bs = XT + 64 * TST;
  float* csf = (float*)(Bs + 128 * BST);
  float* csb = csf + 128; float* dtF = csb + 128; float* dtB = dtF + 128; float* laF = dtB + 128; float* laB = laF + 128;
  const int tid = ltid(), w = tid >> 6, lane = tid & 63, r = lane & 31, hh = lane >> 5;
  const int row0 = chunk_row0(b, tc), g = h >> 2;
  const bf16_t* XBC = (const bf16_t*)(p.ws + OFF_XBC);
  load_tile_T(XT, XBC + (size_t)row0 * 768 + h * 64, 768);
#pragma unroll
  for (int i = 0; i < 4; ++i) {
    int c = tid + 256 * i, tok = c >> 3, part = c & 7;
    *(u32x4*)(Bs + tok * BST + part * 8) = *(const u32x4*)(XBC + (size_t)(row0 + tok) * 768 + 512 + g * 64 + part * 8);
  }
  const int l = 32 * w + r;
  bf16x8 cf[4];
#pragma unroll
  for (int ks = 0; ks < 4; ++ks) cf[ks] = *(const bf16x8*)(XBC + (size_t)(row0 + l) * 768 + 640 + g * 64 + 16 * ks + 8 * hh);
  chunk_scan(p, layer, row0, h, csf, csb, dtF, dtB, laF, laB);
  const float csf_l = csf[l], csb_l = csb[l];
  f32x16 yacc[2];
#pragma unroll
  for (int i = 0; i < 16; ++i) { yacc[0][i] = 0.f; yacc[1][i] = 0.f; }
#pragma unroll
  for (int st = 0; st < 4; ++st) {
    f32x16 gacc;
#pragma unroll
    for (int i = 0; i < 16; ++i) gacc[i] = 0.f;
#pragma unroll
    for (int ks = 0; ks < 4; ++ks) {
      bf16x8 af = *(const bf16x8*)(Bs + (32 * st + r) * BST + 16 * ks + 8 * hh);
      gacc = MFMA32(af, cf[ks], gacc);
    }
#pragma unroll
    for (int i = 0; i < 16; ++i) {
      int s = 32 * st + crow(i, hh);
      float f;
      if (s < l) f = __expf(csf_l - csf[s]) * dtF[s];
      else if (s > l) f = __expf(csb_l - csb[s]) * dtB[s];
      else f = dtF[s] + dtB[s];
      gacc[i] *= f;
    }
#pragma unroll
    for (int s2 = 0; s2 < 2; ++s2) {
      bf16x8 mf = pack8(gacc, s2);
      int sb = 32 * st + 16 * s2 + 4 * hh;
#pragma unroll
      for (int pt = 0; pt < 2; ++pt) {
        u32x2 lo = *(const u32x2*)(XT + (32 * pt + r) * TST + sb);
        u32x2 hi = *(const u32x2*)(XT + (32 * pt + r) * TST + sb + 8);
        u32x4 xa; xa[0] = lo[0]; xa[1] = lo[1]; xa[2] = hi[0]; xa[3] = hi[1];
        yacc[pt] = MFMA32(__builtin_bit_cast(bf16x8, xa), mf, yacc[pt]);
      }
    }
  }
#pragma unroll
  for (int d = 0; d < 2; ++d) {
    const bf16_t* Hs = (const bf16_t*)(p.ws + OFF_SST) + ((((size_t)d * NB + b) * NCH + tc) * 8 + h) * 4096;
    const float e = __expf(d == 0 ? csf_l : csb_l);
#pragma unroll
    for (int pt = 0; pt < 2; ++pt) {
      f32x16 t;
#pragma unroll
      for (int i = 0; i < 16; ++i) t[i] = 0.f;
#pragma unroll
      for (int ks = 0; ks < 4; ++ks) {
        bf16x8 af = *(const bf16x8*)(Hs + (32 * pt + r) * 64 + 16 * ks + 8 * hh);
        t = MFMA32(af, cf[ks], t);
      }
#pragma unroll
      for (int i = 0; i < 16; ++i) yacc[pt][i] += e * t[i];
    }
  }
  const int row = row0 + l;
  const float Dh = p.ssd_d[layer * 8 + h];
  const bf16_t* U = (const bf16_t*)(p.ws + OFF_U);
  bf16_t* YM = (bf16_t*)(p.ws + OFF_H);
  float ssq = 0.f;
  u32x2 xvv[2][4], zvv[2][4];
#pragma unroll
  for (int pt = 0; pt < 2; ++pt)
#pragma unroll
    for (int q = 0; q < 4; ++q) {
      const int pp = 32 * pt + 8 * q + 4 * hh;
      xvv[pt][q] = *(const u32x2*)(XBC + (size_t)row * 768 + h * 64 + pp);
      zvv[pt][q] = *(const u32x2*)(U + (size_t)row * DIN + U_Z + h * 64 + pp);
    }
#pragma unroll
  for (int pt = 0; pt < 2; ++pt)
#pragma unroll
    for (int q = 0; q < 4; ++q) {
      const int pp = 32 * pt + 8 * q + 4 * hh;
      const u32x2 xv = xvv[pt][q], zv = zvv[pt][q];
      float y0 = (yacc[pt][4 * q + 0] + Dh * lo2f(xv[0])) * silu_f(lo2f(zv[0]));
      float y1 = (yacc[pt][4 * q + 1] + Dh * hi2f(xv[0])) * silu_f(hi2f(zv[0]));
      float y2 = (yacc[pt][4 * q + 2] + Dh * lo2f(xv[1])) * silu_f(lo2f(zv[1]));
      float y3 = (yacc[pt][4 * q + 3] + Dh * hi2f(xv[1])) * silu_f(hi2f(zv[1]));
      u32x2 o; o[0] = pack2(y0, y1); o[1] = pack2(y2, y3);
      float r0 = lo2f(o[0]), r1 = hi2f(o[0]), r2 = lo2f(o[1]), r3 = hi2f(o[1]);
      ssq += r0 * r0 + r1 * r1 + r2 * r2 + r3 * r3;
      *(u32x2*)(YM + (size_t)row * DM + 512 + h * 64 + pp) = o;
    }
  ssq += __shfl_xor(ssq, 32);
  if (hh == 0) ((float*)(p.ws + OFF_SSQ))[(size_t)row * 8 + h] = ssq;
  __syncthreads();
}

constexpr int KST = 104;
constexpr int VST = 68;
constexpr int ASTG = 64 * KST + 64 * VST;
DI void attn_item(const Params& p, int b, int head, int qrow0, int t0, bool lat, int nkeys, char* smem) {
  bf16_t* Ks = (bf16_t*)smem;
  bf16_t* Vs = Ks + 64 * KST;
  const int tid = ltid(), w = tid >> 6, lane = tid & 63, r = lane & 31, hh = lane >> 5;
  const bf16_t* QB = (const bf16_t*)(p.ws + OFF_QB);
  const bf16_t* KB = (const bf16_t*)(p.ws + OFF_KB) + (size_t)(b * 4 + head) * LK * 96;
  const bf16_t* VT = (const bf16_t*)(p.ws + OFF_VT) + (size_t)(b * 4 + head) * 64 * LK;
  const float qscale = 0.10206207261596575f * 1.4426950408889634f;
  const int qrow = qrow0 + w * 32 + r;
  const int t = t0 + w * 32 + r;
  bf16x8 qf[6];
  {
    const bf16_t* src = QB + (size_t)qrow * 384 + head * 96;
#pragma unroll
    for (int s = 0; s < 4; ++s) {
      u32x4 v = *(const u32x4*)(src + 16 * s + 8 * hh);
      u32x4 o;
#pragma unroll
      for (int j = 0; j < 4; ++j) o[j] = pack2(lo2f(v[j]) * qscale, hi2f(v[j]) * qscale);
      qf[s] = __builtin_bit_cast(bf16x8, o);
    }
#pragma unroll
    for (int s = 4; s < 6; ++s) {
      u32x4 va = *(const u32x4*)(src + 16 * s), vb = *(const u32x4*)(src + 16 * s + 8);
      float posf = s == 4 ? (float)(t >> 6) : (float)(t & 63);
      float o[8];
#pragma unroll
      for (int j = 0; j < 8; ++j) {
        float a = (j & 1) ? hi2f(va[j >> 1]) : lo2f(va[j >> 1]);
        float bb = (j & 1) ? hi2f(vb[j >> 1]) : lo2f(vb[j >> 1]);
        float res;
        if (lat) {
          float invf = exp2f(-(float)(2 * j) * (13.287712379549449f / 16.f));
          float rev = posf * invf * 0.15915494309189535f;
          float cs = __builtin_amdgcn_cosf(rev), sn = __builtin_amdgcn_sinf(rev);
          res = hh == 0 ? a * cs - bb * sn : bb * cs + a * sn;
        } else res = hh == 0 ? a : bb;
        o[j] = res * qscale;
      }
      u32x4 ov; ov[0] = pack2(o[0], o[1]); ov[1] = pack2(o[2], o[3]); ov[2] = pack2(o[4], o[5]); ov[3] = pack2(o[6], o[7]);
      qf[s] = __builtin_bit_cast(bf16x8, ov);
    }
  }
  f32x16 oacc[2];
#pragma unroll
  for (int i = 0; i < 16; ++i) { oacc[0][i] = 0.f; oacc[1][i] = 0.f; }
  float m = -1e30f, lsum = 0.f;
  u32x4 rk[3], rv[2];
  auto gload = [&](int key0) {
#pragma unroll
    for (int i = 0; i < 3; ++i) rk[i] = *(const u32x4*)(KB + (size_t)key0 * 96 + (tid + 256 * i) * 8);
#pragma unroll
    for (int i = 0; i < 2; ++i) { int c = tid + 256 * i; rv[i] = *(const u32x4*)(VT + (size_t)(c >> 3) * LK + key0 + (c & 7) * 8); }
  };
  gload(0);
  const int NT = nkeys / 64;
  for (int kt = 0; kt < NT; ++kt) {
#pragma unroll
    for (int i = 0; i < 3; ++i) { int c = tid + 256 * i; *(u32x4*)(Ks + (c / 12) * KST + (c % 12) * 8) = rk[i]; }
#pragma unroll
    for (int i = 0; i < 2; ++i) {
      int c = tid + 256 * i;
      bf16_t* d = Vs + (c >> 3) * VST + (c & 7) * 8;
      u32x2 a; a[0] = rv[i][0]; a[1] = rv[i][1];
      u32x2 bq; bq[0] = rv[i][2]; bq[1] = rv[i][3];
      *(u32x2*)d = a; *(u32x2*)(d + 4) = bq;
    }
    __syncthreads();
    if (kt + 1 < NT) gload((kt + 1) * 64);
    f32x16 sacc[2];
#pragma unroll
    for (int i = 0; i < 16; ++i) { sacc[0][i] = 0.f; sacc[1][i] = 0.f; }
#pragma unroll
    for (int s = 0; s < 6; ++s)
#pragma unroll
      for (int k2 = 0; k2 < 2; ++k2) {
        bf16x8 af = *(const bf16x8*)(Ks + (32 * k2 + r) * KST + 16 * s + 8 * hh);
        sacc[k2] = MFMA32(af, qf[s], sacc[k2]);
      }
    float mx = sacc[0][0];
#pragma unroll
    for (int i = 0; i < 16; ++i) { mx = fmaxf(mx, sacc[0][i]); mx = fmaxf(mx, sacc[1][i]); }
    mx = fmaxf(mx, __shfl_xor(mx, 32));
    const float mn = fmaxf(m, mx);
    const float alpha = __builtin_amdgcn_exp2f(m - mn);
    m = mn;
    float ps = 0.f;
#pragma unroll
    for (int i = 0; i < 16; ++i) {
      sacc[0][i] = __builtin_amdgcn_exp2f(sacc[0][i] - mn); sacc[1][i] = __builtin_amdgcn_exp2f(sacc[1][i] - mn);
      ps += sacc[0][i] + sacc[1][i];
    }
    lsum = lsum * alpha + ps;
#pragma unroll
    for (int i = 0; i < 16; ++i) { oacc[0][i] *= alpha; oacc[1][i] *= alpha; }
#pragma unroll
    for (int k2 = 0; k2 < 2; ++k2)
#pragma unroll
      for (int s2 = 0; s2 < 2; ++s2) {
        bf16x8 pf = pack8(sacc[k2], s2);
        int kb0 = 32 * k2 + 16 * s2 + 4 * hh;
#pragma unroll
        for (int d = 0; d < 2; ++d) {
          u32x2 lo = *(const u32x2*)(Vs + (32 * d + r) * VST + kb0);
          u32x2 hi = *(const u32x2*)(Vs + (32 * d + r) * VST + kb0 + 8);
          u32x4 va; va[0] = lo[0]; va[1] = lo[1]; va[2] = hi[0]; va[3] = hi[1];
          oacc[d] = MFMA32(__builtin_bit_cast(bf16x8, va), pf, oacc[d]);
        }
      }
    __syncthreads();
  }
  lsum += __shfl_xor(lsum, 32);
  const float inv = 1.f / lsum;
  bf16_t* YM = (bf16_t*)(p.ws + OFF_H) + (size_t)qrow * DM + head * 64;
#pragma unroll
  for (int d = 0; d < 2; ++d)
#pragma unroll
    for (int q = 0; q < 4; ++q) {
      u32x2 o; o[0] = pack2(oacc[d][4 * q] * inv, oacc[d][4 * q + 1] * inv); o[1] = pack2(oacc[d][4 * q + 2] * inv, oacc[d][4 * q + 3] * inv);
      *(u32x2*)(YM + 32 * d + 8 * q + 4 * hh) = o;
    }
}

DI void attn_item8(const Params& p, int b, int head, int qrow0, int t0, bool lat, int nkeys, char* smem) {
  bf16_t* Ks = (bf16_t*)smem;
  bf16_t* Vs = Ks + 64 * KST;
  const int tid = ltid512(), w = tid >> 6, lane = tid & 63, r = lane & 31, hh = lane >> 5;
  const bf16_t* QB = (const bf16_t*)(p.ws + OFF_QB);
  const bf16_t* KB = (const bf16_t*)(p.ws + OFF_KB) + (size_t)(b * 4 + head) * LK * 96;
  const bf16_t* VT = (const bf16_t*)(p.ws + OFF_VT) + (size_t)(b * 4 + head) * 64 * LK;
  const float qscale = 0.10206207261596575f * 1.4426950408889634f;
  const int qrow = qrow0 + w * 32 + r;
  const int t = t0 + w * 32 + r;
  bf16x8 qf[6];
  {
    const bf16_t* src = QB + (size_t)qrow * 384 + head * 96;
#pragma unroll
    for (int s = 0; s < 4; ++s) {
      u32x4 v = *(const u32x4*)(src + 16 * s + 8 * hh);
      u32x4 o;
#pragma unroll
      for (int j = 0; j < 4; ++j) o[j] = pack2(lo2f(v[j]) * qscale, hi2f(v[j]) * qscale);
      qf[s] = __builtin_bit_cast(bf16x8, o);
    }
#pragma unroll
    for (int s = 4; s < 6; ++s) {
      u32x4 va = *(const u32x4*)(src + 16 * s), vb = *(const u32x4*)(src + 16 * s + 8);
      float posf = s == 4 ? (float)(t >> 6) : (float)(t & 63);
      float o[8];
#pragma unroll
      for (int j = 0; j < 8; ++j) {
        float a = (j & 1) ? hi2f(va[j >> 1]) : lo2f(va[j >> 1]);
        float bb = (j & 1) ? hi2f(vb[j >> 1]) : lo2f(vb[j >> 1]);
        float res;
        if (lat) {
          float invf = exp2f(-(float)(2 * j) * (13.287712379549449f / 16.f));
          float rev = posf * invf * 0.15915494309189535f;
          float cs = __builtin_amdgcn_cosf(rev), sn = __builtin_amdgcn_sinf(rev);
          res = hh == 0 ? a * cs - bb * sn : bb * cs + a * sn;
        } else res = hh == 0 ? a : bb;
        o[j] = res * qscale;
      }
      u32x4 ov; ov[0] = pack2(o[0], o[1]); ov[1] = pack2(o[2], o[3]); ov[2] = pack2(o[4], o[5]); ov[3] = pack2(o[6], o[7]);
      qf[s] = __builtin_bit_cast(bf16x8, ov);
    }
  }
  f32x16 oacc[2];
#pragma unroll
  for (int i = 0; i < 16; ++i) { oacc[0][i] = 0.f; oacc[1][i] = 0.f; }
  float m = -1e30f, lsum = 0.f;
  u32x4 rk[2], rv;
  auto gload = [&](int key0) {
    rk[0] = *(const u32x4*)(KB + (size_t)key0 * 96 + tid * 8);
    if (tid < 256) rk[1] = *(const u32x4*)(KB + (size_t)key0 * 96 + (512 + tid) * 8);
    rv = *(const u32x4*)(VT + (size_t)(tid >> 3) * LK + key0 + (tid & 7) * 8);
  };
  const int kro = (tid / 12) * KST + (tid % 12) * 8, kro2 = ((512 + tid) / 12) * KST + ((512 + tid) % 12) * 8;
  auto swrite = [&](int stage) {
    bf16_t* Kd = Ks + stage * ASTG;
    *(u32x4*)(Kd + kro) = rk[0];
    if (tid < 256) *(u32x4*)(Kd + kro2) = rk[1];
    bf16_t* d = Kd + 64 * KST + (tid >> 3) * VST + (tid & 7) * 8;
    u32x2 a; a[0] = rv[0]; a[1] = rv[1];
    u32x2 bq; bq[0] = rv[2]; bq[1] = rv[3];
    *(u32x2*)d = a; *(u32x2*)(d + 4) = bq;
  };
  auto qk = [&](int stage, f32x16 (&sa)[2]) {
    const bf16_t* Kc = Ks + stage * ASTG;
#pragma unroll
    for (int i = 0; i < 16; ++i) { sa[0][i] = 0.f; sa[1][i] = 0.f; }
#pragma unroll
    for (int s = 0; s < 6; ++s)
#pragma unroll
      for (int k2 = 0; k2 < 2; ++k2) {
        bf16x8 af = *(const bf16x8*)(Kc + (32 * k2 + r) * KST + 16 * s + 8 * hh);
        sa[k2] = MFMA32(af, qf[s], sa[k2]);
      }
  };
  const int NT = nkeys / 64;
  f32x16 sacc[2], snext[2];
  gload(0); swrite(0);
  gload(64);
  __syncthreads();
  swrite(1);
  gload(128);
  qk(0, sacc);
  __syncthreads();
  int cur = 0, nxt = 1, nn = 2;
  for (int kt = 0; kt < NT; ++kt) {
    if (kt + 1 < NT) qk(nxt, snext);
    if (kt + 2 < NT) {
      swrite(nn);
      if (kt + 3 < NT) gload((kt + 3) * 64);
    }
    const bf16_t* Vc = Ks + cur * ASTG + 64 * KST;
    float mx = sacc[0][0];
#pragma unroll
    for (int i = 0; i < 16; ++i) { mx = fmaxf(mx, sacc[0][i]); mx = fmaxf(mx, sacc[1][i]); }
    mx = fmaxf(mx, __shfl_xor(mx, 32));
    const float mn = fmaxf(m, mx);
    const float alpha = __builtin_amdgcn_exp2f(m - mn);
    m = mn;
    float ps = 0.f;
#pragma unroll
    for (int i = 0; i < 16; ++i) {
      sacc[0][i] = __builtin_amdgcn_exp2f(sacc[0][i] - mn); sacc[1][i] = __builtin_amdgcn_exp2f(sacc[1][i] - mn);
      ps += sacc[0][i] + sacc[1][i];
    }
    lsum = lsum * alpha + ps;
#pragma unroll
    for (int i = 0; i < 16; ++i) { oacc[0][i] *= alpha; oacc[1][i] *= alpha; }
#pragma unroll
    for (int k2 = 0; k2 < 2; ++k2)
#pragma unroll
      for (int s2 = 0; s2 < 2; ++s2) {
        bf16x8 pf = pack8(sacc[k2], s2);
        int kb0 = 32 * k2 + 16 * s2 + 4 * hh;
#pragma unroll
        for (int d = 0; d < 2; ++d) {
          u32x2 lo = *(const u32x2*)(Vc + (32 * d + r) * VST + kb0);
          u32x2 hi = *(const u32x2*)(Vc + (32 * d + r) * VST + kb0 + 8);
          u32x4 va; va[0] = lo[0]; va[1] = lo[1]; va[2] = hi[0]; va[3] = hi[1];
          oacc[d] = MFMA32(__builtin_bit_cast(bf16x8, va), pf, oacc[d]);
        }
      }
    sacc[0] = snext[0]; sacc[1] = snext[1];
    const int t3 = cur; cur = nxt; nxt = nn; nn = t3;
    __syncthreads();
  }
  lsum += __shfl_xor(lsum, 32);
  const float inv = 1.f / lsum;
  bf16_t* YM = (bf16_t*)(p.ws + OFF_H) + (size_t)qrow * DM + head * 64;
#pragma unroll
  for (int d = 0; d < 2; ++d)
#pragma unroll
    for (int q = 0; q < 4; ++q) {
      u32x2 o; o[0] = pack2(oacc[d][4 * q] * inv, oacc[d][4 * q + 1] * inv); o[1] = pack2(oacc[d][4 * q + 2] * inv, oacc[d][4 * q + 3] * inv);
      *(u32x2*)(YM + 32 * d + 8 * q + 4 * hh) = o;
    }
}

DI void attn_item8b(const Params& p, int b, int head, int qrow0, int t0, bool lat, int nkeys, char* smem) {
  bf16_t* Ks = (bf16_t*)smem;
  bf16_t* Vs = Ks + 64 * KST;
  const int tid = ltid512(), w = tid >> 6, lane = tid & 63, r = lane & 31, hh = lane >> 5;
  const bf16_t* QB = (const bf16_t*)(p.ws + OFF_QB);
  const bf16_t* KB = (const bf16_t*)(p.ws + OFF_KB) + (size_t)(b * 4 + head) * LK * 96;
  const bf16_t* VT = (const bf16_t*)(p.ws + OFF_VT) + (size_t)(b * 4 + head) * 64 * LK;
  const float qscale = 0.10206207261596575f * 1.4426950408889634f;
  const int qrow = qrow0 + w * 32 + r;
  const int t = t0 + w * 32 + r;
  bf16x8 qf[6];
  {
    const bf16_t* src = QB + (size_t)qrow * 384 + head * 96;
#pragma unroll
    for (int s = 0; s < 4; ++s) {
      u32x4 v = *(const u32x4*)(src + 16 * s + 8 * hh);
      u32x4 o;
#pragma unroll
      for (int j = 0; j < 4; ++j) o[j] = pack2(lo2f(v[j]) * qscale, hi2f(v[j]) * qscale);
      qf[s] = __builtin_bit_cast(bf16x8, o);
    }
#pragma unroll
    for (int s = 4; s < 6; ++s) {
      u32x4 va = *(const u32x4*)(src + 16 * s), vb = *(const u32x4*)(src + 16 * s + 8);
      float posf = s == 4 ? (float)(t >> 6) : (float)(t & 63);
      float o[8];
#pragma unroll
      for (int j = 0; j < 8; ++j) {
        float a = (j & 1) ? hi2f(va[j >> 1]) : lo2f(va[j >> 1]);
        float bb = (j & 1) ? hi2f(vb[j >> 1]) : lo2f(vb[j >> 1]);
        float res;
        if (lat) {
          float invf = exp2f(-(float)(2 * j) * (13.287712379549449f / 16.f));
          float rev = posf * invf * 0.15915494309189535f;
          float cs = __builtin_amdgcn_cosf(rev), sn = __builtin_amdgcn_sinf(rev);
          res = hh == 0 ? a * cs - bb * sn : bb * cs + a * sn;
        } else res = hh == 0 ? a : bb;
        o[j] = res * qscale;
      }
      u32x4 ov; ov[0] = pack2(o[0], o[1]); ov[1] = pack2(o[2], o[3]); ov[2] = pack2(o[4], o[5]); ov[3] = pack2(o[6], o[7]);
      qf[s] = __builtin_bit_cast(bf16x8, ov);
    }
  }
  f32x16 oacc[2];
#pragma unroll
  for (int i = 0; i < 16; ++i) { oacc[0][i] = 0.f; oacc[1][i] = 0.f; }
  float m = -1e30f, lsum = 0.f;
  constexpr int VS2 = 132;
  constexpr int STG = 128 * KST + 64 * VS2;
  u32x4 rk[3], rv[2];
  auto gload = [&](int key0) {
#pragma unroll
    for (int i = 0; i < 3; ++i) rk[i] = *(const u32x4*)(KB + (size_t)key0 * 96 + (tid + 512 * i) * 8);
#pragma unroll
    for (int i = 0; i < 2; ++i) { const int c = tid + 512 * i; rv[i] = *(const u32x4*)(VT + (size_t)(c >> 4) * LK + key0 + (c & 15) * 8); }
  };
  int kro[3], vro[2];
#pragma unroll
  for (int i = 0; i < 3; ++i) { const int c = tid + 512 * i; kro[i] = (c / 12) * KST + (c % 12) * 8; }
#pragma unroll
  for (int i = 0; i < 2; ++i) { const int c = tid + 512 * i; vro[i] = 128 * KST + (c >> 4) * VS2 + (c & 15) * 8; }
  auto swrite = [&](int stage) {
    bf16_t* Kd = Ks + stage * STG;
#pragma unroll
    for (int i = 0; i < 3; ++i) *(u32x4*)(Kd + kro[i]) = rk[i];
#pragma unroll
    for (int i = 0; i < 2; ++i) {
      u32x2 a; a[0] = rv[i][0]; a[1] = rv[i][1];
      u32x2 bq; bq[0] = rv[i][2]; bq[1] = rv[i][3];
      *(u32x2*)(Kd + vro[i]) = a; *(u32x2*)(Kd + vro[i] + 4) = bq;
    }
  };
  const int NT = nkeys / 128;
  gload(0); swrite(0);
  if (NT > 1) gload(128);
  __syncthreads();
  for (int kt = 0; kt < NT; ++kt) {
    const bf16_t* Kc = Ks + (kt & 1) * STG;
    const bf16_t* Vc = Kc + 128 * KST;
    if (kt + 1 < NT) {
      swrite((kt + 1) & 1);
      if (kt + 2 < NT) gload((kt + 2) * 128);
    }
    f32x16 sacc[4];
#pragma unroll
    for (int k2 = 0; k2 < 4; ++k2)
#pragma unroll
      for (int i = 0; i < 16; ++i) sacc[k2][i] = 0.f;
#pragma unroll
    for (int s = 0; s < 6; ++s)
#pragma unroll
      for (int k2 = 0; k2 < 4; ++k2) {
        bf16x8 af = *(const bf16x8*)(Kc + (32 * k2 + r) * KST + 16 * s + 8 * hh);
        sacc[k2] = MFMA32(af, qf[s], sacc[k2]);
      }
    float mx = sacc[0][0];
#pragma unroll
    for (int k2 = 0; k2 < 4; ++k2)
#pragma unroll
      for (int i = 0; i < 16; ++i) mx = fmaxf(mx, sacc[k2][i]);
    mx = fmaxf(mx, __shfl_xor(mx, 32));
    const float mn = fmaxf(m, mx);
    if (__any(mn > m)) {
      const float alpha = __builtin_amdgcn_exp2f(m - mn);
      lsum *= alpha;
#pragma unroll
      for (int i = 0; i < 16; ++i) { oacc[0][i] *= alpha; oacc[1][i] *= alpha; }
      m = mn;
    }
    float ps = 0.f;
#pragma unroll
    for (int k2 = 0; k2 < 4; ++k2)
#pragma unroll
      for (int i = 0; i < 16; ++i) { sacc[k2][i] = __builtin_amdgcn_exp2f(sacc[k2][i] - m); ps += sacc[k2][i]; }
    lsum += ps;
#pragma unroll
    for (int k2 = 0; k2 < 4; ++k2)
#pragma unroll
      for (int s2 = 0; s2 < 2; ++s2) {
        bf16x8 pf = pack8(sacc[k2], s2);
        const int kb0 = 32 * k2 + 16 * s2 + 4 * hh;
#pragma unroll
        for (int d = 0; d < 2; ++d) {
          u32x2 lo = *(const u32x2*)(Vc + (32 * d + r) * VS2 + kb0);
          u32x2 hi = *(const u32x2*)(Vc + (32 * d + r) * VS2 + kb0 + 8);
          u32x4 va; va[0] = lo[0]; va[1] = lo[1]; va[2] = hi[0]; va[3] = hi[1];
          oacc[d] = MFMA32(__builtin_bit_cast(bf16x8, va), pf, oacc[d]);
        }
      }
    __syncthreads();
  }
  lsum += __shfl_xor(lsum, 32);
  const float inv = 1.f / lsum;
  bf16_t* YM = (bf16_t*)(p.ws + OFF_H) + (size_t)qrow * DM + head * 64;
#pragma unroll
  for (int d = 0; d < 2; ++d)
#pragma unroll
    for (int q = 0; q < 4; ++q) {
      u32x2 o; o[0] = pack2(oacc[d][4 * q] * inv, oacc[d][4 * q + 1] * inv); o[1] = pack2(oacc[d][4 * q + 2] * inv, oacc[d][4 * q + 3] * inv);
      *(u32x2*)(YM + 32 * d + 8 * q + 4 * hh) = o;
    }
}

DI void phase_qkv(const Params& p, int layer, int bid, int nb, char* smem) {
  const int MQ = layer == 0 ? MT : ML;
  const int nq = (MQ / 128) * 3, nkv = (MT / 128) * 4, nst = NB * NCH * 8;
  const float* RS = (const float*)(p.ws + OFF_RSTD);
  EpiQ eq{(bf16_t*)(p.ws + OFF_QB), RS};
  EpiKV ekv{(bf16_t*)(p.ws + OFF_KB), (bf16_t*)(p.ws + OFF_VT), RS};
  const bf16_t* U = (const bf16_t*)(p.ws + OFF_U);
  for (int it = bid; it < nq + nkv + nst; it += nb) {
    if (it < nq) gemm_tile<false>(U, DIN, wt_ptr(p, layer, WT_UQ), 256, (it / 3) * 128, (it % 3) * 128, smem, eq);
    else if (it < nq + nkv) { int j = it - nq; gemm_tile<false>(U + U_CKV, DIN, wt_ptr(p, layer, WT_UKV), 128, (j / 4) * 128, (j % 4) * 128, smem, ekv); }
    else { int j = it - nq - nkv; for (int rep = 0; rep < REP_SSD; ++rep) ssd_state_item(p, layer, j / (NCH * 8), (j / 8) % NCH, j & 7, smem); }
  }
}
DI void phase_att(const Params& p, int layer, int bid, int nb, int vbid, int nvb, char* smem, char* sh) {
  for (int it = bid; it < 256; it += nb) {
    const int x = it & 7, j = it >> 3, bh = 2 * x + (j >> 4), qb = j & 15, b = bh >> 2, head = bh & 3;
    for (int rep = 0; rep < REP_ATT; ++rep) attn_item8b(p, b, head, b * SEQ + qb * 256, qb * 256, true, LK, smem);
  }
  for (int it = vbid; it < 512; it += nvb) ssd_pass_item(p, it);
}
DI void phase_ssdout(const Params& p, int layer, int bid, int nb, char* smem) {
  const int nout = NB * NCH * 8, nctx = layer == 0 ? 32 : 0;
  for (int it = bid; it < nout + nctx; it += nb) {
    if (it < nout) {
      int b = it / (NCH * 8), tc = (it / 8) % NCH, h = it & 7;
      if (layer == 1 && tc < 2) continue;
      for (int rep = 0; rep < REP_SSD; ++rep) ssd_out_item(p, layer, b, tc, h, smem);
    } else {
      const int j = it - nout, b = j >> 3, head = (j >> 1) & 3, qb = j & 1;
      attn_item(p, b, head, ML + b * CTX + qb * 128, qb * 128, false, CTX, smem);
    }
  }
  if (layer == 0) {
    if (nb == 512) { if (bid >= 96) for (int it = bid - 96; it < WT_ITEMS; it += 416) wt_item(p, 1, it, smem); }
    else for (int it = bid; it < WT_ITEMS; it += nb) wt_item(p, 1, it, smem);
  }
}


#define XB_TMO      128
#define XB_XCNT(j)  (256  + 64 * (j))
#define XB_XSUB(j)  (1280 + 64 * (j))
#define XB_XGEN(j)  (2304 + 64 * (j))
#define XB_TOP      3328
#define XB_TOPGEN   3392
#define XCD_BAR_WORDS 3456
#define XB_SPIN_CAP (1u << 22)
#define LAS __attribute__((address_space(3)))
DI unsigned xb_ld(unsigned* p) { return __hip_atomic_load(p, __ATOMIC_RELAXED, __HIP_MEMORY_SCOPE_AGENT); }
DI unsigned xb_add(unsigned* p, unsigned v) { return __hip_atomic_fetch_add(p, v, __ATOMIC_RELAXED, __HIP_MEMORY_SCOPE_AGENT); }
DI unsigned xb_xcc_id() { return (unsigned)__builtin_amdgcn_s_getreg((3 << 11) | 20) & 0xFu; }
#define XB_SPIN(cond, bar) do { unsigned _sp = 0; while (cond) { __builtin_amdgcn_s_sleep(1); \
    if ((++_sp & 255u) == 0u) { if (xb_ld(&(bar)[XB_TMO])) break; if (_sp > XB_SPIN_CAP) { atomicAdd(&(bar)[XB_TMO], 1u); break; } } } } while (0)
struct XcdBarrier { unsigned* bar; unsigned x; volatile LAS unsigned* st; };
DI XcdBarrier xcd_barrier_post(unsigned* bar, volatile LAS unsigned* st) {
  XcdBarrier b; b.bar = bar; b.x = xb_xcc_id(); b.st = st;
  if (threadIdx.x == 0) (void)xb_add(&bar[XB_XCNT(b.x)], 1u);
  return b;
}
DI void xcd_barrier_complete(unsigned* bar, unsigned x, unsigned& nloc, unsigned& nx) {
  const unsigned G = gridDim.x * gridDim.y * gridDim.z;
  unsigned sum, cnt, mine, sp = 0u;
  for (;;) {
    sum = 0u; cnt = 0u; mine = 0u;
#pragma unroll
    for (unsigned j = 0; j < 16; ++j) { const unsigned c = xb_ld(&bar[XB_XCNT(j)]); sum += c; cnt += (c > 0u) ? 1u : 0u; mine = (j == x) ? c : mine; }
    if (sum == G) break;
    __builtin_amdgcn_s_sleep(1);
    if ((++sp & 255u) == 0u) { if (xb_ld(&bar[XB_TMO])) break; if (sp > XB_SPIN_CAP) { atomicAdd(&bar[XB_TMO], 1u); break; } }
  }
  nloc = mine > 0u ? mine : 1u; nx = cnt > 0u ? cnt : 1u;
}
DI void xcd_barrier(const XcdBarrier& b) {
  asm volatile("s_waitcnt vmcnt(0)" ::: "memory");
  __syncthreads();
  if (threadIdx.x == 0) {
    unsigned* bar = b.bar;
    asm volatile("" : "+s"(bar));
    __builtin_amdgcn_s_waitcnt(0);
    unsigned nloc = b.st[0], nx = b.st[1];
    if (nloc == 0u) { xcd_barrier_complete(bar, b.x, nloc, nx); b.st[0] = nloc; b.st[1] = nx; }
    const unsigned old = xb_add(&bar[XB_XSUB(b.x)], 1u);
    const unsigned gen = old / nloc;
    if (old + 1u == (gen + 1u) * nloc) {
      __builtin_amdgcn_fence(__ATOMIC_RELEASE, "agent");
      asm volatile("s_waitcnt vmcnt(0)" ::: "memory");
      const unsigned og = xb_add(&bar[XB_TOP], 1u);
      const unsigned tg = og / nx;
      if (og + 1u == (tg + 1u) * nx) xb_add(&bar[XB_TOPGEN], 1u);
      else XB_SPIN(xb_ld(&bar[XB_TOPGEN]) == tg, bar);
      __builtin_amdgcn_fence(__ATOMIC_ACQUIRE, "agent");
      xb_add(&bar[XB_XGEN(b.x)], 1u);
      asm volatile("s_waitcnt vmcnt(0)" ::: "memory");
    } else {
      XB_SPIN(xb_ld(&bar[XB_XGEN(b.x)]) == gen, bar);
      __builtin_amdgcn_fence(__ATOMIC_ACQUIRE, "agent");
      asm volatile("s_waitcnt vmcnt(0)" ::: "memory");
    }
  }
  __syncthreads();
}

constexpr int SMEM_BYTES = 2 * GBUF * 2;
enum { PH_PREP0 = 0, PH_H0, PH_INPROJ, PH_PREP, PH_QKV, PH_ATT, PH_SSDOUT, PH_WOUT, PH_POSTMIX, PH_FF1, PH_FF2, PH_POSTFFN, PH_SSDNORM };

struct Ids { int bid, nb, vbid, nvb, lid; };
DI void run_phase(const Params& p, int ph, int layer, const Ids& id, char* smem, char* sh) {
  switch (ph) {
    case PH_PREP0: phase_prep0(p, id.vbid, id.nvb, sh); break;
    case PH_H0: phase_h0(p, id.vbid, id.nvb); break;
    case PH_INPROJ: phase_inproj(p, layer, id.bid, id.nb, id.vbid, id.nvb, smem, sh); break;
    case PH_PREP: phase_prep(p, layer, id.vbid, id.nvb); break;
    case PH_QKV: phase_qkv(p, layer, id.vbid, id.nvb, sh); break;
    case PH_ATT: phase_att(p, layer, id.bid, id.nb, id.vbid, id.nvb, smem, sh); break;
    case PH_SSDOUT: phase_ssdout(p, layer, id.vbid, id.nvb, sh); break;
    case PH_WOUT: phase_wout(p, layer, id.bid, id.nb, id.vbid, id.nvb, smem, sh); break;
    case PH_POSTMIX: phase_postmix(p, layer, id.vbid, id.nvb); break;
    case PH_FF1: phase_ff1(p, layer, id.bid, id.nb, id.vbid, id.nvb, smem, sh); break;
    case PH_FF2: phase_ff2(p, layer, id.bid, id.nb, id.vbid, id.nvb, smem, sh); break;
    case PH_POSTFFN: phase_postffn(p, layer, id.vbid, id.nvb); break;
  }
}

__global__ void __launch_bounds__(512) mega_kernel(Params p) {
  extern __shared__ __attribute__((aligned(16))) char smem[];
  cg::grid_group grid = cg::this_grid();
  if (p.ws == nullptr) grid.sync();
  const int half = __builtin_amdgcn_readfirstlane((int)(threadIdx.x >> 8));
  Ids id;
  id.bid = blockIdx.x; id.nb = gridDim.x;
  id.vbid = 2 * id.bid + half; id.nvb = 2 * id.nb;
  id.lid = (id.bid & 7) + 8 * (2 * (id.bid >> 3) + half);
  char* sh = smem + half * SMEM_BYTES;
  volatile LAS unsigned* st = (volatile LAS unsigned*)(smem + 2 * SMEM_BYTES - 16);
  if (threadIdx.x == 0) { st[0] = 0u; st[1] = 0u; st[2] = 0u; st[3] = 0u; }
  __syncthreads();
  XcdBarrier xb = xcd_barrier_post((unsigned*)(p.ws + OFF_BAR), st);
#define MK_STEP(PH, LAYER, LAST) do { \
    typedef const void* __attribute__((address_space(4))) * KArgs; \
    KArgs ka = (KArgs)__builtin_amdgcn_kernarg_segment_ptr(); \
    asm volatile("" : "+s"(ka)); \
    Params q; \
    { const void** dst = (const void**)&q; _Pragma("unroll") for (int i = 0; i < 27; ++i) dst[i] = ka[i]; } \
    run_phase(q, PH, LAYER, id, smem, sh); \
    if (!(LAST)) xcd_barrier(xb); } while (0)
  MK_STEP(PH_PREP0, 0, false);
  MK_STEP(PH_H0, 0, false);
  MK_STEP(PH_INPROJ, 0, false); MK_STEP(PH_PREP, 0, false); MK_STEP(PH_QKV, 0, false); MK_STEP(PH_ATT, 0, false); MK_STEP(PH_SSDOUT, 0, false);
  MK_STEP(PH_WOUT, 0, false); MK_STEP(PH_POSTMIX, 0, false); MK_STEP(PH_FF1, 0, false); MK_STEP(PH_FF2, 0, false); MK_STEP(PH_POSTFFN, 0, false);
  MK_STEP(PH_INPROJ, 1, false); MK_STEP(PH_PREP, 1, false); MK_STEP(PH_QKV, 1, false); MK_STEP(PH_ATT, 1, false); MK_STEP(PH_SSDOUT, 1, false);
  MK_STEP(PH_WOUT, 1, false); MK_STEP(PH_POSTMIX, 1, false); MK_STEP(PH_FF1, 1, false); MK_STEP(PH_FF2, 1, false); MK_STEP(PH_POSTFFN, 1, true);
#undef MK_STEP
}

extern "C" void kernel_launch(void* const* d_in, const int* in_sizes, int n_in, void* d_out, int out_size, void* d_ws, size_t ws_size,
                              hipStream_t stream) {
  if (ws_size < WS_NEED) { fprintf(stderr, "workspace too small: %zu < %zu\n", ws_size, (size_t)WS_NEED); return; }
  Params p{};
  const float** f = (const float**)&p;
  for (int i = 0; i < 25; ++i) f[i] = (const float*)d_in[i];
  p.out = (float*)d_out;
  p.ws = (char*)d_ws;
  static int grid_blocks = 0;
  if (!grid_blocks) {
    int dev = 0, cus = 0, per_cu = 0;
    hipGetDevice(&dev);
    hipDeviceGetAttribute(&cus, hipDeviceAttributeMultiprocessorCount, dev);
    hipFuncSetAttribute((const void*)mega_kernel, hipFuncAttributeMaxDynamicSharedMemorySize, 2 * SMEM_BYTES);
    hipOccupancyMaxActiveBlocksPerMultiprocessor(&per_cu, mega_kernel, 512, 2 * SMEM_BYTES);
    if (per_cu > 1) per_cu = 1;
    grid_blocks = cus * per_cu;
  }
  hipMemsetAsync((char*)d_ws + OFF_BAR, 0, XCD_BAR_WORDS * 4, stream);
  void* args[] = {&p};
  hipError_t e = hipLaunchCooperativeKernel((void*)mega_kernel, dim3(grid_blocks), dim3(512), args, 2 * SMEM_BYTES, stream);
  if (e != hipSuccess) fprintf(stderr, "cooperative launch failed: %s (grid %d)\n", hipGetErrorString(e), grid_blocks);
}
```

```cpp
#include <hip/hip_runtime.h>
#include <hip/hip_cooperative_groups.h>
#include <stdint.h>
#include <stdio.h>
namespace cg = cooperative_groups;

#ifndef MEGA
#define MEGA 1
#endif
#ifndef REP_GEMM
#define REP_GEMM 1
#endif
#ifndef REP_ATT
#define REP_ATT 1
#endif
#ifndef REP_SSD
#define REP_SSD 1
#endif

typedef unsigned short bf16_t;
using bf16x8 = __attribute__((ext_vector_type(8))) short;
using s16x4  = __attribute__((ext_vector_type(4))) short;
using f32x4  = __attribute__((ext_vector_type(4))) float;
using f32x16 = __attribute__((ext_vector_type(16))) float;
using u32x4  = __attribute__((ext_vector_type(4))) unsigned;
using u32x2  = __attribute__((ext_vector_type(2))) unsigned;
#define DI __device__ __forceinline__
#define MFMA32(a, b, c) __builtin_amdgcn_mfma_f32_32x32x16_bf16((a), (b), (c), 0, 0, 0)
#define MFMA16(a, b, c) __builtin_amdgcn_mfma_f32_16x16x32_bf16((a), (b), (c), 0, 0, 0)

constexpr int DM = 1024, NB = 4, SEQ = 4096, CTX = 256;
constexpr int ML = NB * SEQ;
constexpr int MC = NB * CTX;
constexpr int MT = ML + MC;
constexpr int DIN = 2480, DINP = 2560;
constexpr int LK = CTX + SEQ;
constexpr int DFF = 4096;
constexpr int NCH = 34;
constexpr float EPS = 1e-6f;
constexpr int U_CKV = 256, U_KR = 384, U_GB = 416, U_GC = 672, U_VAL = 928, U_Z = 1184, U_XBC = 1696, U_DT = 2464;

constexpr size_t AL(size_t x) { return (x + 255) & ~(size_t)255; }
constexpr size_t WT_IN = 0;
constexpr size_t WT_UQ = WT_IN + (size_t)DINP * 1024;
constexpr size_t WT_UKV = WT_UQ + (size_t)384 * 256;
constexpr size_t WT_OUT = WT_UKV + (size_t)512 * 128;
constexpr size_t WT_FF1 = WT_OUT + (size_t)1024 * 1024;
constexpr size_t WT_FF2 = WT_FF1 + (size_t)4096 * 1024;
constexpr size_t WT_ELEMS = WT_FF2 + (size_t)4096 * 1024;
constexpr size_t OFF_WT = 0;
constexpr size_t OFF_MOD = AL(OFF_WT + 2 * WT_ELEMS * 2);
constexpr size_t OFF_XC = AL(OFF_MOD + 2 * 5 * 6144 * 4);
constexpr size_t OFF_H = AL(OFF_XC + (size_t)MC * DM * 4);
constexpr size_t OFF_R1 = AL(OFF_H + (size_t)MT * DM * 2);
constexpr size_t OFF_U = OFF_R1;
constexpr size_t OFF_DT = AL(OFF_U + (size_t)MT * DIN * 2);
constexpr size_t OFF_RSTD = AL(OFF_DT + (size_t)MT * 16 * 4);
constexpr size_t OFF_QB = AL(OFF_RSTD + (size_t)MT * 2 * 4);
constexpr size_t OFF_KB = AL(OFF_QB + (size_t)MT * 384 * 2);
constexpr size_t OFF_VT = AL(OFF_KB + (size_t)NB * 4 * LK * 96 * 2);
constexpr size_t OFF_XBC = AL(OFF_VT + (size_t)NB * 4 * 64 * LK * 2);
constexpr size_t OFF_SST = AL(OFF_XBC + (size_t)MT * 768 * 2);
constexpr size_t OFF_TDEC = AL(OFF_SST + (size_t)2 * NB * NCH * 8 * 4096 * 2);
constexpr size_t OFF_SSQ = AL(OFF_TDEC + (size_t)2 * NB * NCH * 8 * 4);
constexpr size_t OFF_END1 = AL(OFF_SSQ + (size_t)MT * 8 * 4);
constexpr size_t OFF_F1 = OFF_R1;
constexpr size_t OFF_END2 = AL(OFF_F1 + (size_t)MT * DFF * 2);
constexpr size_t WS_NEED = (size_t)256 << 20;
constexpr size_t OFF_BAR = WS_NEED - 16384;
static_assert(OFF_END1 <= OFF_BAR && OFF_END2 + (size_t)8 * MC * DM * 4 <= OFF_BAR, "workspace layout overflows 256 MiB");

struct Params {
  const float *x, *c, *ctx, *c_ctx, *w_mod, *b_mod, *g_pre_mix, *w_in, *q_norm, *w_uq, *kv_norm, *w_ukv, *sc_w, *ssd_cw, *ssd_cb,
      *a_log, *dt_bias, *ssd_d, *ssd_norm, *w_out, *g_post_mix, *g_pre_ffn, *w_ff1, *w_ff2, *g_post_ffn;
  float* out;
  char* ws;
};

DI int ltid() { int t = threadIdx.x; asm volatile("" : "+v"(t)); return t & 255; }
DI int ltid512() { int t = threadIdx.x; asm volatile("" : "+v"(t)); return t; }
typedef __bf16 hbf2 __attribute__((ext_vector_type(2)));
typedef float hf2 __attribute__((ext_vector_type(2)));
DI bf16_t f2bf(float x) { return __builtin_bit_cast(bf16_t, (__bf16)x); }
DI float bf2f(unsigned v) { return __uint_as_float(v << 16); }
DI unsigned pack2(float a, float b) { hf2 v = {a, b}; return __builtin_bit_cast(unsigned, __builtin_convertvector(v, hbf2)); }
DI float lo2f(unsigned w) { return __uint_as_float(w << 16); }
DI float hi2f(unsigned w) { return __uint_as_float(w & 0xffff0000u); }
DI float wave_sum(float v) {
#pragma unroll
  for (int o = 32; o > 0; o >>= 1) v += __shfl_xor(v, o);
  return v;
}
DI float silu_f(float x) { return x / (1.f + __expf(-x)); }
DI int crow(int reg, int h) { return (reg & 3) + 8 * (reg >> 2) + 4 * h; }
DI bf16x8 pack8(const f32x16& x, int s) {
  u32x4 p;
  p[0] = pack2(x[8 * s + 0], x[8 * s + 1]); p[1] = pack2(x[8 * s + 2], x[8 * s + 3]);
  p[2] = pack2(x[8 * s + 4], x[8 * s + 5]); p[3] = pack2(x[8 * s + 6], x[8 * s + 7]);
  return __builtin_bit_cast(bf16x8, p);
}
DI const float* xin_row(const Params& p, int layer, int row) {
  if (layer == 0) return row < ML ? p.x + (size_t)row * DM : p.ctx + (size_t)(row - ML) * DM;
  return row < ML ? p.out + (size_t)row * DM : (const float*)(p.ws + OFF_XC) + (size_t)(row - ML) * DM;
}
DI float* xst_row(const Params& p, int row) {
  return row < ML ? p.out + (size_t)row * DM : (float*)(p.ws + OFF_XC) + (size_t)(row - ML) * DM;
}
DI const float* mod_ptr(const Params& p, int layer, int row, int which) {
  int bb = row < ML ? (row >> 12) : 4;
  return (const float*)(p.ws + OFF_MOD) + ((size_t)(layer * 5 + bb) * 6 + which) * DM;
}
DI bf16_t* wt_ptr(const Params& p, int layer, size_t off) { return (bf16_t*)(p.ws + OFF_WT) + (size_t)layer * WT_ELEMS + off; }

DI void transpose_item(const float* __restrict__ w, const float* __restrict__ gk, int gk_from, bf16_t* __restrict__ wt, int K, int N, int kt, int nt, char* smem) {
  float* tile = (float*)smem;
  const int tid = ltid(), tx = tid & 63, ty = tid >> 6;
  const int k0 = kt * 64, n0 = nt * 64;
  const int n = n0 + tx;
  float v[16];
#pragma unroll
  for (int i = 0; i < 16; ++i) {
    int kk = ty + 4 * i;
    v[i] = n < N ? w[(size_t)(k0 + kk) * N + n] : 0.f;
  }
  if (gk) {
#pragma unroll
    for (int i = 0; i < 16; ++i) { int k = k0 + ty + 4 * i; if (k >= gk_from) v[i] *= gk[k - gk_from]; }
  }
#pragma unroll
  for (int i = 0; i < 16; ++i) tile[(ty + 4 * i) * 65 + tx] = v[i];
  __syncthreads();
#pragma unroll
  for (int i = 0; i < 2; ++i) {
    int c = tid + 256 * i, nn = c >> 3, kc = c & 7;
    u32x4 o;
#pragma unroll
    for (int jj = 0; jj < 4; ++jj) o[jj] = pack2(tile[(kc * 8 + 2 * jj) * 65 + nn], tile[(kc * 8 + 2 * jj + 1) * 65 + nn]);
    *(u32x4*)(wt + (size_t)(n0 + nn) * K + k0 + kc * 8) = o;
  }
  __syncthreads();
}

DI void modgemv_item(const Params& p, int layer, int ct, char* smem) {
  float* s = (float*)smem;
  float* red = s + 5 * 1024;
  const int tid = ltid(), w = tid >> 6, lane = tid & 63, ln = lane & 31, kh = lane >> 5;
  for (int i = tid; i < 5 * 1024; i += 256) {
    int bb = i >> 10, k = i & 1023;
    float v = bb < 4 ? p.c[bb * 1024 + k] : p.c_ctx[k];
    s[i] = silu_f(v);
  }
  __syncthreads();
  const float* wm = p.w_mod + (size_t)layer * 1024 * 6144;
  const int n = ct * 32 + ln;
  float acc[5] = {0.f, 0.f, 0.f, 0.f, 0.f};
#pragma unroll 16
  for (int i = 0; i < 128; ++i) {
    const int k = w * 256 + 2 * i + kh;
    float wv = wm[(size_t)k * 6144 + n];
#pragma unroll
    for (int bb = 0; bb < 5; ++bb) acc[bb] += s[bb * 1024 + k] * wv;
  }
#pragma unroll
  for (int bb = 0; bb < 5; ++bb) {
    acc[bb] += __shfl_xor(acc[bb], 32);
    if (kh == 0) red[(w * 5 + bb) * 32 + ln] = acc[bb];
  }
  __syncthreads();
  if (tid < 160) {
    int bb = tid >> 5, l2 = tid & 31;
    float v = red[(0 * 5 + bb) * 32 + l2] + red[(1 * 5 + bb) * 32 + l2] + red[(2 * 5 + bb) * 32 + l2] + red[(3 * 5 + bb) * 32 + l2];
    int nn = ct * 32 + l2;
    v += p.b_mod[layer * 6144 + nn];
    ((float*)(p.ws + OFF_MOD))[(size_t)(layer * 5 + bb) * 6144 + nn] = v;
  }
  __syncthreads();
}

constexpr int WT_ITEMS = 2984;
DI void wt_item(const Params& p, int layer, int j, char* smem) {
  if (j < 640) transpose_item(p.w_in + (size_t)layer * 1024 * DIN, nullptr, 0, wt_ptr(p, layer, WT_IN), 1024, DIN, j / 40, j % 40, smem);
  else if ((j -= 640) < 24) transpose_item(p.w_uq + (size_t)layer * 256 * 384, p.q_norm + layer * 256, 0, wt_ptr(p, layer, WT_UQ), 256, 384, j / 6, j % 6, smem);
  else if ((j -= 24) < 16) transpose_item(p.w_ukv + (size_t)layer * 128 * 512, p.kv_norm + layer * 128, 0, wt_ptr(p, layer, WT_UKV), 128, 512, j / 8, j % 8, smem);
  else if ((j -= 16) < 256) transpose_item(p.w_out + (size_t)layer * 1024 * 1024, p.ssd_norm + layer * 512, 512, wt_ptr(p, layer, WT_OUT), 1024, 1024, j / 16, j % 16, smem);
  else if ((j -= 256) < 1024) transpose_item(p.w_ff1 + (size_t)layer * 1024 * 4096, nullptr, 0, wt_ptr(p, layer, WT_FF1), 1024, 4096, j / 64, j % 64, smem);
  else { j -= 1024; transpose_item(p.w_ff2 + (size_t)layer * 4096 * 1024, nullptr, 0, wt_ptr(p, layer, WT_FF2), 4096, 1024, j / 16, j % 16, smem); }
}
DI void phase_prep0(const Params& p, int bid, int nb, char* smem) {
  for (int it = bid; it < 384 + 640; it += nb) {
    if (it < 384) modgemv_item(p, it / 192, it % 192, smem);
    else wt_item(p, 0, it - 384, smem);
  }
}
struct HMod { float4 g[4], s1[4], s0[4]; };
DI void load_hmod(HMod& m, const float* g, const float* sh, const float* sc, int lane) {
#pragma unroll
  for (int i = 0; i < 4; ++i) {
    const int col = lane * 4 + 256 * i;
    m.g[i] = *(const float4*)(g + col); m.s1[i] = *(const float4*)(sc + col); m.s0[i] = *(const float4*)(sh + col);
  }
}
DI void write_h_row(const float4 xv[4], float rstd, const HMod& m, bf16_t* hrow, int lane) {
#pragma unroll
  for (int i = 0; i < 4; ++i) {
    const int col = lane * 4 + 256 * i;
    float a = xv[i].x * rstd * m.g[i].x * (1.f + m.s1[i].x) + m.s0[i].x;
    float b = xv[i].y * rstd * m.g[i].y * (1.f + m.s1[i].y) + m.s0[i].y;
    float c = xv[i].z * rstd * m.g[i].z * (1.f + m.s1[i].z) + m.s0[i].z;
    float d = xv[i].w * rstd * m.g[i].w * (1.f + m.s1[i].w) + m.s0[i].w;
    u32x2 o; o[0] = pack2(a, b); o[1] = pack2(c, d);
    *(u32x2*)(hrow + col) = o;
  }
}
DI float ssq4(const float4 v[4]) {
  float s = 0.f;
#pragma unroll
  for (int i = 0; i < 4; ++i) s += v[i].x * v[i].x + v[i].y * v[i].y + v[i].z * v[i].z + v[i].w * v[i].w;
  return s;
}
DI void load_bf_row(const bf16_t* r, int lane, float4 v[4]) {
#pragma unroll
  for (int i = 0; i < 4; ++i) {
    u32x2 t = *(const u32x2*)(r + lane * 4 + 256 * i);
    v[i] = make_float4(lo2f(t[0]), hi2f(t[0]), lo2f(t[1]), hi2f(t[1]));
  }
}

struct RowVec { float4 c1[4], c2[4], c3[4]; };
DI const float* mod_ptr_b(const Params& p, int layer, int bb, int which) {
  return (const float*)(p.ws + OFF_MOD) + ((size_t)(layer * 5 + bb) * 6 + which) * DM;
}
template <int MODE>
DI void rowwise_phase(const Params& p, int layer, int bid, int nb) {
  const int w = ltid() >> 6, lane = ltid() & 63;
  const int M = (MODE == 0 || layer == 0) ? MT : ML;
  const bool wh = MODE != 2 || layer == 0;
  bf16_t* H = (bf16_t*)(p.ws + OFF_H);
  const bf16_t* Y = MODE == 1 ? (const bf16_t*)(p.ws + OFF_U) : (const bf16_t*)(p.ws + OFF_H);
  const int NW = nb * 4, W = bid * 4 + w, nwb = NW >> 2;
  auto load_vec = [&](RowVec& v, int bb) {
    const float* gate = MODE == 1 ? mod_ptr_b(p, layer, bb, 2) : mod_ptr_b(p, layer, bb, 5);
    const float* gres = MODE == 1 ? p.g_post_mix + layer * DM : p.g_post_ffn + layer * DM;
    const int hl = MODE == 2 ? 1 : layer;
    const float* gn = MODE == 1 ? p.g_pre_ffn + layer * DM : p.g_pre_mix + hl * DM;
    const float* sh = mod_ptr_b(p, hl, bb, MODE == 1 ? 3 : 0);
    const float* sc = mod_ptr_b(p, hl, bb, MODE == 1 ? 4 : 1);
#pragma unroll
    for (int i = 0; i < 4; ++i) {
      const int col = lane * 4 + 256 * i;
      if (MODE != 0) {
        const float4 a = *(const float4*)(gate + col), b = *(const float4*)(gres + col);
        v.c1[i] = make_float4(a.x * b.x, a.y * b.y, a.z * b.z, a.w * b.w);
      }
      if (wh) {
        const float4 g = *(const float4*)(gn + col), s1 = *(const float4*)(sc + col);
        v.c2[i] = make_float4(g.x * (1.f + s1.x), g.y * (1.f + s1.y), g.z * (1.f + s1.z), g.w * (1.f + s1.w));
        v.c3[i] = *(const float4*)(sh + col);
      }
    }
  };
  struct RowIn { u32x2 y[4]; float4 x[4]; };
  auto load_row = [&](RowIn& r, int row) {
    const float* xr = MODE == 2 ? (const float*)xst_row(p, row) : xin_row(p, layer, row);
#pragma unroll
    for (int i = 0; i < 4; ++i) {
      r.x[i] = *(const float4*)(xr + lane * 4 + 256 * i);
      if (MODE != 0) r.y[i] = *(const u32x2*)(Y + (size_t)row * DM + lane * 4 + 256 * i);
    }
  };
  auto finish = [&](float4 (&xv)[4], const float4 (&yv)[4], const RowVec& v, int row) {
    if (MODE != 0) {
      const float rstd = rsqrtf(wave_sum(ssq4(yv)) * (1.f / DM) + EPS);
#pragma unroll
      for (int i = 0; i < 4; ++i) {
        xv[i].x += yv[i].x * rstd * v.c1[i].x; xv[i].y += yv[i].y * rstd * v.c1[i].y;
        xv[i].z += yv[i].z * rstd * v.c1[i].z; xv[i].w += yv[i].w * rstd * v.c1[i].w;
      }
      float* xo = xst_row(p, row);
#pragma unroll
      for (int i = 0; i < 4; ++i) *(float4*)(xo + lane * 4 + 256 * i) = xv[i];
    }
    if (wh) {
      const float rstd1 = rsqrtf(wave_sum(ssq4(xv)) * (1.f / DM) + EPS);
      bf16_t* hrow = H + (size_t)row * DM;
#pragma unroll
      for (int i = 0; i < 4; ++i) {
        u32x2 o;
        o[0] = pack2(xv[i].x * rstd1 * v.c2[i].x + v.c3[i].x, xv[i].y * rstd1 * v.c2[i].y + v.c3[i].y);
        o[1] = pack2(xv[i].z * rstd1 * v.c2[i].z + v.c3[i].z, xv[i].w * rstd1 * v.c2[i].w + v.c3[i].w);
        *(u32x2*)(hrow + lane * 4 + 256 * i) = o;
      }
    }
  };
  auto process = [&](RowIn& r, const RowVec& v, int row) {
    float4 yv[4];
#pragma unroll
    for (int i = 0; i < 4; ++i) yv[i] = make_float4(lo2f(r.y[i][0]), hi2f(r.y[i][0]), lo2f(r.y[i][1]), hi2f(r.y[i][1]));
    finish(r.x, yv, v, row);
  };
  RowVec v;
  {
    const int bb = W / nwb, j = W - bb * nwb, end = SEQ * (bb + 1);
    load_vec(v, bb);
    RowIn ra, rb;
    int row = SEQ * bb + j;
    if (row < end) load_row(ra, row);
    while (row < end) {
      const int rowb = row + nwb;
      const bool hb = rowb < end;
      if (hb) load_row(rb, rowb);
      process(ra, v, row);
      if (!hb) break;
      const int rowa = rowb + nwb;
      const bool ha = rowa < end;
      if (ha) load_row(ra, rowa);
      process(rb, v, rowb);
      if (!ha) break;
      row = rowa;
    }
  }
  if (M > ML) {
    load_vec(v, 4);
    for (int row = ML + W; row < M; row += NW) {
      float4 xv[4], yv[4];
      const float* xr = MODE == 2 ? (const float*)xst_row(p, row) : xin_row(p, layer, row);
#pragma unroll
      for (int i = 0; i < 4; ++i) xv[i] = *(const float4*)(xr + lane * 4 + 256 * i);
      if (MODE != 0) {
        const float* pp = (const float*)(p.ws + (MODE == 1 ? OFF_QB : OFF_END2)) + (size_t)(row - ML) * DM;
#pragma unroll
        for (int i = 0; i < 4; ++i) {
          float4 a = *(const float4*)(pp + lane * 4 + 256 * i), b = *(const float4*)(pp + (size_t)MC * DM + lane * 4 + 256 * i);
          float4 c = *(const float4*)(pp + (size_t)2 * MC * DM + lane * 4 + 256 * i), d = *(const float4*)(pp + (size_t)3 * MC * DM + lane * 4 + 256 * i);
          yv[i] = make_float4((a.x + b.x) + (c.x + d.x), (a.y + b.y) + (c.y + d.y), (a.z + b.z) + (c.z + d.z), (a.w + b.w) + (c.w + d.w));
          if (MODE == 2) {
            const float* p2 = pp + (size_t)4 * MC * DM;
            float4 e = *(const float4*)(p2 + lane * 4 + 256 * i), f = *(const float4*)(p2 + (size_t)MC * DM + lane * 4 + 256 * i);
            float4 g = *(const float4*)(p2 + (size_t)2 * MC * DM + lane * 4 + 256 * i), h = *(const float4*)(p2 + (size_t)3 * MC * DM + lane * 4 + 256 * i);
            yv[i].x += (e.x + f.x) + (g.x + h.x); yv[i].y += (e.y + f.y) + (g.y + h.y);
            yv[i].z += (e.z + f.z) + (g.z + h.z); yv[i].w += (e.w + f.w) + (g.w + h.w);
          }
        }
      }
      finish(xv, yv, v, row);
    }
  }
}
DI void phase_h0(const Params& p, int bid, int nb) { rowwise_phase<0>(p, 0, bid, nb); }
DI void phase_postmix(const Params& p, int layer, int bid, int nb) { rowwise_phase<1>(p, layer, bid, nb); }
DI void phase_postffn(const Params& p, int layer, int bid, int nb) { rowwise_phase<2>(p, layer, bid, nb); }

DI void phase_prep(const Params& p, int layer, int bid, int nb) {
  const int w = ltid() >> 6, lane = ltid() & 63;
  const bf16_t* U = (const bf16_t*)(p.ws + OFF_U);
  float* DT = (float*)(p.ws + OFF_DT);
  float* RS = (float*)(p.ws + OFF_RSTD);
  bf16_t* KB = (bf16_t*)(p.ws + OFF_KB);
  bf16_t* XBC = (bf16_t*)(p.ws + OFF_XBC);
  bf16_t* YM = (bf16_t*)(p.ws + OFF_H);
  const float* scw = p.sc_w + layer * 3 * 256;
  const float* cw = p.ssd_cw + layer * 3 * 768;
  const float* cb = p.ssd_cb + layer * 768;
  const int c4 = lane * 4;
  const float4 sw0 = *(const float4*)(scw + c4), sw1 = *(const float4*)(scw + 256 + c4), sw2 = *(const float4*)(scw + 512 + c4);
  float4 cwk[3][3], cbi[3];
#pragma unroll
  for (int i = 0; i < 3; ++i) {
    cbi[i] = *(const float4*)(cb + c4 + 256 * i);
#pragma unroll
    for (int k = 0; k < 3; ++k) cwk[i][k] = *(const float4*)(cw + k * 768 + c4 + 256 * i);
  }
  const float dtb = p.dt_bias[layer * 16 + (lane & 15)];
  const float invf = exp2f(-(float)(2 * (lane & 7)) * (13.287712379549449f / 16.f));
  for (int row = bid * 4 + w; row < MT; row += nb * 4) {
    int b, t, L, pos;
    const bool lat = row < ML;
    if (lat) { b = row >> 12; t = row & 4095; L = SEQ; pos = t + CTX; }
    else { int rr = row - ML; b = rr >> 8; t = rr & 255; L = CTX; pos = t; }
    const bf16_t* u0 = U + (size_t)row * DIN;
    const bool hp = t > 0, hn = t < L - 1;
    const bf16_t* um = hp ? u0 - DIN : u0;
    const bf16_t* up = hn ? u0 + DIN : u0;
    const float mp = hp ? 1.f : 0.f, mn = hn ? 1.f : 0.f;
    const u32x2 vq = *(const u32x2*)(u0 + c4);
    const u32x2 vkv = *(const u32x2*)(u0 + U_CKV + (lane & 31) * 4);
    const float kr = bf2f(u0[U_KR + (lane & 31)]);
    const u32x2 gcm = *(const u32x2*)(um + U_GC + c4), gc0 = *(const u32x2*)(u0 + U_GC + c4), gcp = *(const u32x2*)(up + U_GC + c4);
    const u32x2 vvm = *(const u32x2*)(um + U_VAL + c4), vv0 = *(const u32x2*)(u0 + U_VAL + c4), vvp = *(const u32x2*)(up + U_VAL + c4);
    const u32x2 gb = *(const u32x2*)(u0 + U_GB + c4);
    u32x2 xm[3], x0[3], xp[3];
#pragma unroll
    for (int i = 0; i < 3; ++i) {
      xm[i] = *(const u32x2*)(um + U_XBC + c4 + 256 * i);
      x0[i] = *(const u32x2*)(u0 + U_XBC + c4 + 256 * i);
      xp[i] = *(const u32x2*)(up + U_XBC + c4 + 256 * i);
    }
    const float dtr = DT[(size_t)row * 16 + (lane & 15)];
    {
      float a = lo2f(vq[0]), bq = hi2f(vq[0]), c = lo2f(vq[1]), d = hi2f(vq[1]);
      float ss = wave_sum(a * a + bq * bq + c * c + d * d);
      float e = lo2f(vkv[0]), f = hi2f(vkv[0]), g = lo2f(vkv[1]), h = hi2f(vkv[1]);
      float s2 = lane < 32 ? e * e + f * f + g * g + h * h : 0.f;
      s2 = wave_sum(s2);
      if (lane == 0) { RS[row * 2] = rsqrtf(ss * (1.f / 256) + EPS); RS[row * 2 + 1] = rsqrtf(s2 * (1.f / 128) + EPS); }
    }
    {
      const float partner = __shfl_xor(kr, 8);
      float o = kr;
      if (lat) {
        const int grp = (lane & 31) >> 3;
        const float posf = grp < 2 ? (float)(t >> 6) : (float)(t & 63);
        const float rev = posf * invf * 0.15915494309189535f;
        const float cs = __builtin_amdgcn_cosf(rev), sn = __builtin_amdgcn_sinf(rev);
        o = (grp & 1) ? kr * cs + partner * sn : kr * cs - partner * sn;
      }
      if (lane < 32) {
        const bf16_t ob = f2bf(o);
#pragma unroll
        for (int hd = 0; hd < 4; ++hd) KB[((size_t)(b * 4 + hd) * LK + pos) * 96 + 64 + lane] = ob;
      }
    }
    {
      float a0 = sw1.x * lo2f(gc0[0]) * lo2f(vv0[0]) + mp * sw0.x * lo2f(gcm[0]) * lo2f(vvm[0]) + mn * sw2.x * lo2f(gcp[0]) * lo2f(vvp[0]);
      float a1 = sw1.y * hi2f(gc0[0]) * hi2f(vv0[0]) + mp * sw0.y * hi2f(gcm[0]) * hi2f(vvm[0]) + mn * sw2.y * hi2f(gcp[0]) * hi2f(vvp[0]);
      float a2 = sw1.z * lo2f(gc0[1]) * lo2f(vv0[1]) + mp * sw0.z * lo2f(gcm[1]) * lo2f(vvm[1]) + mn * sw2.z * lo2f(gcp[1]) * lo2f(vvp[1]);
      float a3 = sw1.w * hi2f(gc0[1]) * hi2f(vv0[1]) + mp * sw0.w * hi2f(gcm[1]) * hi2f(vvm[1]) + mn * sw2.w * hi2f(gcp[1]) * hi2f(vvp[1]);
      u32x2 o; o[0] = pack2(lo2f(gb[0]) * a0, hi2f(gb[0]) * a1); o[1] = pack2(lo2f(gb[1]) * a2, hi2f(gb[1]) * a3);
      *(u32x2*)(YM + (size_t)row * DM + 256 + c4) = o;
    }
#pragma unroll
    for (int i = 0; i < 3; ++i) {
      float a0 = cbi[i].x + cwk[i][1].x * lo2f(x0[i][0]) + mp * cwk[i][0].x * lo2f(xm[i][0]) + mn * cwk[i][2].x * lo2f(xp[i][0]);
      float a1 = cbi[i].y + cwk[i][1].y * hi2f(x0[i][0]) + mp * cwk[i][0].y * hi2f(xm[i][0]) + mn * cwk[i][2].y * hi2f(xp[i][0]);
      float a2 = cbi[i].z + cwk[i][1].z * lo2f(x0[i][1]) + mp * cwk[i][0].z * lo2f(xm[i][1]) + mn * cwk[i][2].z * lo2f(xp[i][1]);
      float a3 = cbi[i].w + cwk[i][1].w * hi2f(x0[i][1]) + mp * cwk[i][0].w * hi2f(xm[i][1]) + mn * cwk[i][2].w * hi2f(xp[i][1]);
      u32x2 o; o[0] = pack2(silu_f(a0), silu_f(a1)); o[1] = pack2(silu_f(a2), silu_f(a3));
      *(u32x2*)(XBC + (size_t)row * 768 + c4 + 256 * i) = o;
    }
    if (lane < 16) {
      const float v = dtr + dtb;
      const float e = __expf(-fabsf(v));
      DT[(size_t)row * 16 + lane] = fmaxf(v, 0.f) + (e < 1e-3f ? e * (1.f - 0.5f * e) : __logf(1.f + e));
    }
  }
}

DI void phase_ssdnorm(const Params& p, int layer, int bid, int nb) {
  const int w = ltid() >> 6, lane = ltid() & 63;
  const int M = layer == 0 ? MT : ML;
  bf16_t* YM = (bf16_t*)(p.ws + OFF_H);
  const float* SSQ = (const float*)(p.ws + OFF_SSQ);
  const float* ng = p.ssd_norm + layer * 512;
  for (int row = bid * 4 + w; row < M; row += nb * 4) {
    int g = lane >> 5;
    float4 s = *(const float4*)(SSQ + (size_t)row * 8 + g * 4);
    float rstd = rsqrtf((s.x + s.y + s.z + s.w) * (1.f / 256) + EPS);
    bf16_t* ptr = YM + (size_t)row * DM + 512 + lane * 8;
    u32x4 v = *(const u32x4*)ptr;
    float4 g0 = *(const float4*)(ng + lane * 8), g1 = *(const float4*)(ng + lane * 8 + 4);
    u32x4 o;
    o[0] = pack2(lo2f(v[0]) * rstd * g0.x, hi2f(v[0]) * rstd * g0.y);
    o[1] = pack2(lo2f(v[1]) * rstd * g0.z, hi2f(v[1]) * rstd * g0.w);
    o[2] = pack2(lo2f(v[2]) * rstd * g1.x, hi2f(v[2]) * rstd * g1.y);
    o[3] = pack2(lo2f(v[3]) * rstd * g1.z, hi2f(v[3]) * rstd * g1.w);
    *(u32x4*)ptr = o;
  }
}

constexpr int GST = 80;
constexpr int GBUF = 2 * 128 * GST;
template <bool GN, class Epi>
DI void gemm_tile(const bf16_t* __restrict__ A, int lda, const bf16_t* __restrict__ Bt, int K, int row0, int col0, char* smem, Epi epi, const float* __restrict__ ssq = nullptr) {
  bf16_t* S0 = (bf16_t*)smem;
  const int tid = ltid(), wid = tid >> 6, lane = tid & 63, wr = wid >> 1, wc = wid & 1, fr = lane & 15, fq = lane >> 4;
  f32x4 acc[4][4];
#pragma unroll
  for (int m = 0; m < 4; ++m)
#pragma unroll
    for (int n = 0; n < 4; ++n) acc[m][n] = f32x4{0.f, 0.f, 0.f, 0.f};
  u32x4 ra[4], rb[4];
  const int sr = tid >> 3, sp = tid & 7;
  const bf16_t* ga = A + (size_t)(row0 + sr) * lda + sp * 8;
  const bf16_t* gb = Bt + (size_t)(col0 + sr) * K + sp * 8;
  auto gload = [&](int k0) {
#pragma unroll
    for (int i = 0; i < 4; ++i) {
      ra[i] = *(const u32x4*)(ga + (size_t)(32 * i) * lda + k0);
      rb[i] = *(const u32x4*)(gb + (size_t)(32 * i) * K + k0);
    }
  };
  gload(0);
  float gs[4][2];
  if (GN) {
#pragma unroll
    for (int i = 0; i < 4; ++i) {
      const float4 s0 = *(const float4*)(ssq + (size_t)(row0 + sr + 32 * i) * 8), s1 = *(const float4*)(ssq + (size_t)(row0 + sr + 32 * i) * 8 + 4);
      gs[i][0] = rsqrtf((s0.x + s0.y + s0.z + s0.w) * (1.f / 256) + EPS);
      gs[i][1] = rsqrtf((s1.x + s1.y + s1.z + s1.w) * (1.f / 256) + EPS);
    }
  }
  auto swrite = [&](int kt) {
    if (GN && kt >= 8) {
      const int g = (kt - 8) >> 2;
#pragma unroll
      for (int i = 0; i < 4; ++i) {
        const float sc = g ? gs[i][1] : gs[i][0];
#pragma unroll
        for (int jj = 0; jj < 4; ++jj) ra[i][jj] = pack2(lo2f(ra[i][jj]) * sc, hi2f(ra[i][jj]) * sc);
      }
    }
    bf16_t* As = S0 + (kt & 1) * GBUF;
    bf16_t* Bs = As + 128 * GST;
#pragma unroll
    for (int i = 0; i < 4; ++i) {
      *(u32x4*)(As + (sr + 32 * i) * GST + sp * 8) = ra[i];
      *(u32x4*)(Bs + (sr + 32 * i) * GST + sp * 8) = rb[i];
    }
  };
  const int KT = K / 64;
  swrite(0);
  if (KT > 1) gload(64);
  __syncthreads();
  for (int kt = 0; kt < KT; ++kt) {
    const bf16_t* As = S0 + (kt & 1) * GBUF;
    const bf16_t* Bs = As + 128 * GST;
#pragma unroll
    for (int ks = 0; ks < 2; ++ks) {
      bf16x8 af[4], bfr[4];
#pragma unroll
      for (int m = 0; m < 4; ++m) af[m] = *(const bf16x8*)(As + (wr * 64 + m * 16 + fr) * GST + ks * 32 + fq * 8);
#pragma unroll
      for (int n = 0; n < 4; ++n) bfr[n] = *(const bf16x8*)(Bs + (wc * 64 + n * 16 + fr) * GST + ks * 32 + fq * 8);
#pragma unroll
      for (int m = 0; m < 4; ++m)
#pragma unroll
        for (int n = 0; n < 4; ++n) acc[m][n] = MFMA16(bfr[n], af[m], acc[m][n]);
      if (ks == 0 && kt + 1 < KT) {
        swrite(kt + 1);
        if (kt + 2 < KT) gload((kt + 2) * 64);
      }
    }
    __syncthreads();
  }
  float rsc[4];
#pragma unroll
  for (int m = 0; m < 4; ++m) rsc[m] = epi.scale(row0 + wr * 64 + m * 16 + fr);
#pragma unroll
  for (int m = 0; m < 4; ++m)
#pragma unroll
    for (int n = 0; n < 4; ++n) epi(row0 + wr * 64 + m * 16 + fr, col0 + wc * 64 + n * 16 + fq * 4, acc[m][n], rsc[m]);
}

template <int MR = 4, class Epi>
DI void gemm_tile_glds(const bf16_t* __restrict__ A, int lda, const bf16_t* __restrict__ Bt, int ldb, int K, int row0, int col0, char* smem, Epi epi) {
  const int tid = ltid(), wid = tid >> 6, lane = tid & 63, wr = wid >> 1, wc = wid & 1, fr = lane & 15, fq = lane >> 4;
  f32x4 acc[MR][4];
#pragma unroll
  for (int m = 0; m < MR; ++m)
#pragma unroll
    for (int n = 0; n < 4; ++n) acc[m][n] = f32x4{0.f, 0.f, 0.f, 0.f};
  const int crow = tid >> 3, cslot = tid & 7, cpart = cslot ^ (crow & 7);
  const bf16_t* ga = A + (size_t)(row0 + crow) * lda + cpart * 8;
  const bf16_t* gb = Bt + (size_t)(col0 + crow) * ldb + cpart * 8;
  auto issue = [&](int kt, int stage) {
    char* sa = smem + stage * 32768 + tid * 16;
#pragma unroll
    for (int i = 0; i < MR; ++i)
      __builtin_amdgcn_global_load_lds((const unsigned*)(ga + (size_t)(32 * i) * lda + kt * 64), (__attribute__((address_space(3))) unsigned*)(sa + i * 4096), 16, 0, 0);
#pragma unroll
    for (int i = 0; i < 4; ++i)
      __builtin_amdgcn_global_load_lds((const unsigned*)(gb + (size_t)(32 * i) * ldb + kt * 64), (__attribute__((address_space(3))) unsigned*)(sa + 16384 + i * 4096), 16, 0, 0);
  };
  const int KT = K / 64;
  issue(0, 0);
  asm volatile("s_waitcnt vmcnt(0)" ::: "memory");
  __syncthreads();
  const int sw = fr & 7;
  for (int kt = 0; kt < KT; ++kt) {
    if (kt + 1 < KT) issue(kt + 1, (kt + 1) & 1);
    const char* As = smem + (kt & 1) * 32768;
    const char* Bs = As + 16384;
#pragma unroll
    for (int ks = 0; ks < 2; ++ks) {
      bf16x8 af[MR], bfr[4];
      const int so = ((ks * 4 + fq) ^ sw) * 16;
#pragma unroll
      for (int m = 0; m < MR; ++m) af[m] = *(const bf16x8*)(As + (wr * 16 * MR + m * 16 + fr) * 128 + so);
#pragma unroll
      for (int n = 0; n < 4; ++n) bfr[n] = *(const bf16x8*)(Bs + (wc * 64 + n * 16 + fr) * 128 + so);
#pragma unroll
      for (int m = 0; m < MR; ++m)
#pragma unroll
        for (int n = 0; n < 4; ++n) acc[m][n] = MFMA16(bfr[n], af[m], acc[m][n]);
    }
    asm volatile("s_waitcnt vmcnt(0)" ::: "memory");
    __syncthreads();
  }
  float rsc[MR];
#pragma unroll
  for (int m = 0; m < MR; ++m) rsc[m] = epi.scale(row0 + wr * 16 * MR + m * 16 + fr);
#pragma unroll
  for (int m = 0; m < MR; ++m)
#pragma unroll
    for (int n = 0; n < 4; ++n) epi(row0 + wr * 16 * MR + m * 16 + fr, col0 + wc * 64 + n * 16 + fq * 4, acc[m][n], rsc[m]);
}

constexpr int G8_HT = 128 * 64;
DI int g8_lds_byte(int r, int c) {
  int st = (r >> 4) * 2 + (c >> 5), rr = r & 15, cc = c & 31, ob = rr * 64 + cc * 2;
  return st * 1024 + (ob ^ (((ob >> 9) & 1) << 5));
}
DI void g8_stage_rc(int b, int& R, int& C) {
  int st = b / 1024, sb = b % 1024, swz = sb ^ (((sb >> 9) & 1) << 5);
  R = (st >> 1) * 16 + swz / 64; C = (st & 1) * 32 + (swz % 64) / 2;
}
template <bool GN = false, class Epi>
DI void gemm8_tile(const bf16_t* __restrict__ A, int lda, const bf16_t* __restrict__ Bt, int ldb, int K, int brow, int bcol, char* smem, Epi epi,
                   bool first = true, bool has_next = false, int nbrow = 0, int nbcol = 0, const float* __restrict__ ssq = nullptr) {
  bf16_t* shm = (bf16_t*)smem;
  const int tid = ltid512();
  float* gsl = (float*)(smem + 8 * G8_HT * 2);
  if (GN) {
    if (tid < 256) {
      const float* sp = ssq + (size_t)(brow + tid) * 8;
      const float4 s0 = *(const float4*)sp, s1 = *(const float4*)(sp + 4);
      gsl[tid] = rsqrtf((s0.x + s0.y + s0.z + s0.w) * (1.f / 256) + EPS);
      gsl[256 + tid] = rsqrtf((s1.x + s1.y + s1.z + s1.w) * (1.f / 256) + EPS);
    }
    __syncthreads();
  }
#define G8_SA(b, h) (shm + ((b) * 2 + (h)) * G8_HT)
#define G8_SB(b, h) (shm + (4 + (b) * 2 + (h)) * G8_HT)
#define G8_STAGE(P, BASE, LD, br, kt) do { const bf16_t* _g = (BASE) + (size_t)(br) * (LD) + (size_t)(kt) * 64; \
    _Pragma("unroll") for (int _i = 0; _i < 2; ++_i) { int _b = tid * 16 + _i * 8192; int _r, _c; g8_stage_rc(_b, _r, _c); \
      __builtin_amdgcn_global_load_lds((const unsigned*)(_g + (size_t)_r * (LD) + _c), \
        (__attribute__((address_space(3))) unsigned*)((char*)(P) + _b), 16, 0, 0); } } while (0)
#define G8_LDA(dst, b, h) _Pragma("unroll") for (int m = 0; m < 4; ++m) _Pragma("unroll") for (int k = 0; k < 2; ++k) \
    dst[m][k] = *reinterpret_cast<const bf16x8*>((char*)G8_SA(b, h) + g8_lds_byte(wr * 64 + m * 16 + fr, k * 32 + fq * 8))
#define G8_LDB(dst, b, h) _Pragma("unroll") for (int n = 0; n < 2; ++n) _Pragma("unroll") for (int k = 0; k < 2; ++k) \
    dst[n][k] = *reinterpret_cast<const bf16x8*>((char*)G8_SB(b, h) + g8_lds_byte(wc * 32 + n * 16 + fr, k * 32 + fq * 8))
#define G8_MMA(ai, bj, At, Bx) do { __builtin_amdgcn_s_setprio(1); \
    _Pragma("unroll") for (int m = 0; m < 4; ++m) _Pragma("unroll") for (int n = 0; n < 2; ++n) _Pragma("unroll") for (int k = 0; k < 2; ++k) \
      acc[ai][bj][m][n] = __builtin_amdgcn_mfma_f32_16x16x32_bf16(Bx[n][k], At[m][k], acc[ai][bj][m][n], 0, 0, 0); \
    __builtin_amdgcn_s_setprio(0); } while (0)
#define G8_WAIT_V(n) asm volatile("s_waitcnt vmcnt(" #n ")" ::: "memory")
#define G8_WAIT_L(n) asm volatile("s_waitcnt lgkmcnt(" #n ")" ::: "memory")
#define G8_BAR __builtin_amdgcn_s_barrier()
#define G8_SCHED __builtin_amdgcn_sched_barrier(0)
  const int wid = tid >> 6, lane = tid & 63, wr = wid >> 2, wc = wid & 3, fr = lane & 15, fq = lane >> 4;
  f32x4 acc[2][2][4][2];
#pragma unroll
  for (int a = 0; a < 2; ++a)
#pragma unroll
    for (int b = 0; b < 2; ++b)
#pragma unroll
      for (int m = 0; m < 4; ++m)
#pragma unroll
        for (int n = 0; n < 2; ++n) acc[a][b][m][n] = f32x4{0.f, 0.f, 0.f, 0.f};
  bf16x8 At[4][2], B0[2][2], B1[2][2];
  const int nt = K / 64;
  if (first) {
    G8_STAGE(G8_SB(0, 0), Bt, ldb, bcol, 0); G8_STAGE(G8_SA(0, 0), A, lda, brow, 0);
    G8_STAGE(G8_SB(0, 1), Bt, ldb, bcol + 128, 0); G8_STAGE(G8_SA(0, 1), A, lda, brow + 128, 0);
  }
  if (wr == 1) G8_BAR;
  if (first) G8_WAIT_V(4); else G8_WAIT_V(0);
  G8_BAR;
  G8_STAGE(G8_SB(1, 0), Bt, ldb, bcol, 1); G8_STAGE(G8_SA(1, 0), A, lda, brow, 1); G8_STAGE(G8_SB(1, 1), Bt, ldb, bcol + 128, 1);
  G8_WAIT_V(6); G8_BAR;
  for (int t = 0; t < nt - 2; t += 2) {
    if (GN && (t == 8 || t == 12)) {
#pragma unroll
      for (int ai = 0; ai < 2; ++ai)
#pragma unroll
        for (int m = 0; m < 4; ++m) {
          const int rl = ai * 128 + wr * 64 + m * 16 + fr;
          const float f = t == 8 ? 1.f / gsl[rl] : gsl[rl] / gsl[256 + rl];
#pragma unroll
          for (int bj = 0; bj < 2; ++bj)
#pragma unroll
            for (int n = 0; n < 2; ++n) acc[ai][bj][m][n] *= f;
        }
    }
    G8_LDB(B0, 0, 0); G8_SCHED; G8_LDA(At, 0, 0); G8_STAGE(G8_SA(1, 1), A, lda, brow + 128, t + 1);
    G8_WAIT_L(8); G8_BAR; G8_WAIT_L(0); G8_MMA(0, 0, At, B0); G8_BAR; G8_SCHED;
    G8_LDB(B1, 0, 1); G8_STAGE(G8_SB(0, 0), Bt, ldb, bcol, t + 2);
    G8_BAR; G8_WAIT_L(0); G8_MMA(0, 1, At, B1); G8_BAR;
    G8_LDA(At, 0, 1); G8_STAGE(G8_SA(0, 0), A, lda, brow, t + 2);
    G8_BAR; G8_WAIT_L(0); G8_MMA(1, 0, At, B0); G8_BAR; G8_SCHED;
    G8_STAGE(G8_SB(0, 1), Bt, ldb, bcol + 128, t + 2);
    G8_WAIT_V(6); G8_BAR; G8_MMA(1, 1, At, B1); G8_BAR;
    G8_LDB(B0, 1, 0); G8_SCHED; G8_LDA(At, 1, 0); G8_STAGE(G8_SA(0, 1), A, lda, brow + 128, t + 2);
    G8_WAIT_L(8); G8_BAR; G8_WAIT_L(0); G8_MMA(0, 0, At, B0); G8_BAR; G8_SCHED;
    G8_LDB(B1, 1, 1); G8_STAGE(G8_SB(1, 0), Bt, ldb, bcol, t + 3);
    G8_BAR; G8_WAIT_L(0); G8_MMA(0, 1, At, B1); G8_BAR;
    G8_LDA(At, 1, 1); G8_STAGE(G8_SA(1, 0), A, lda, brow, t + 3);
    G8_BAR; G8_WAIT_L(0); G8_MMA(1, 0, At, B0); G8_BAR; G8_SCHED;
    G8_STAGE(G8_SB(1, 1), Bt, ldb, bcol + 128, t + 3);
    G8_WAIT_V(6); G8_BAR; G8_MMA(1, 1, At, B1); G8_BAR;
  }
  { G8_LDB(B0, 0, 0); G8_LDA(At, 0, 0); G8_STAGE(G8_SA(1, 1), A, lda, brow + 128, nt - 1);
    G8_BAR; G8_WAIT_L(0); G8_MMA(0, 0, At, B0); G8_BAR;
    G8_LDB(B1, 0, 1); G8_BAR; G8_WAIT_L(0); G8_MMA(0, 1, At, B1); G8_BAR;
    G8_LDA(At, 0, 1); G8_WAIT_V(4); G8_BAR; G8_WAIT_L(0); G8_MMA(1, 0, At, B0); G8_MMA(1, 1, At, B1); G8_BAR; }
  { G8_LDB(B0, 1, 0); G8_LDA(At, 1, 0); G8_WAIT_V(2); G8_BAR; G8_WAIT_L(0); G8_MMA(0, 0, At, B0); G8_BAR;
    G8_LDB(B1, 1, 1); G8_WAIT_V(0); G8_BAR; G8_WAIT_L(0); G8_MMA(0, 1, At, B1); G8_BAR;
    G8_LDA(At, 1, 1); G8_BAR; G8_WAIT_L(0); G8_MMA(1, 0, At, B0); G8_MMA(1, 1, At, B1); G8_BAR; }
  if (GN) {
#pragma unroll
    for (int ai = 0; ai < 2; ++ai)
#pragma unroll
      for (int m = 0; m < 4; ++m) {
        const float f = gsl[256 + ai * 128 + wr * 64 + m * 16 + fr];
#pragma unroll
        for (int bj = 0; bj < 2; ++bj)
#pragma unroll
          for (int n = 0; n < 2; ++n) acc[ai][bj][m][n] *= f;
      }
  }
  if (has_next) {
    G8_STAGE(G8_SB(0, 0), Bt, ldb, nbcol, 0); G8_STAGE(G8_SA(0, 0), A, lda, nbrow, 0);
    G8_STAGE(G8_SB(0, 1), Bt, ldb, nbcol + 128, 0); G8_STAGE(G8_SA(0, 1), A, lda, nbrow + 128, 0);
  }
  if (wr == 0) G8_BAR;
  const bool odd = fq & 1;
#pragma unroll
  for (int ai = 0; ai < 2; ++ai)
#pragma unroll
    for (int bj = 0; bj < 2; ++bj)
#pragma unroll
      for (int m = 0; m < 4; ++m) {
        const int row = brow + ai * 128 + wr * 64 + m * 16 + fr, cb = bcol + bj * 128 + wc * 32;
        epi.side(row, cb + fq * 4, acc[ai][bj][m][0]);
        epi.side(row, cb + 16 + fq * 4, acc[ai][bj][m][1]);
        const u32x2 p0 = epi.pack(acc[ai][bj][m][0]), p1 = epi.pack(acc[ai][bj][m][1]);
        const u32x2 snd = odd ? p0 : p1;
        u32x2 rcv; rcv[0] = (unsigned)__shfl_xor((int)snd[0], 16); rcv[1] = (unsigned)__shfl_xor((int)snd[1], 16);
        u32x4 o;
        if (odd) { o[0] = rcv[0]; o[1] = rcv[1]; o[2] = p1[0]; o[3] = p1[1]; }
        else     { o[0] = p0[0]; o[1] = p0[1]; o[2] = rcv[0]; o[3] = rcv[1]; }
        epi.store16(row, odd ? cb + 16 + (fq - 1) * 4 : cb + fq * 4, o);
      }
  __syncthreads();
}

struct EpiBF {
  bf16_t* out; int ldo;
  DI void side(int, int, const f32x4&) const {}
  DI u32x2 pack(const f32x4& a) const { u32x2 o; o[0] = pack2(a[0], a[1]); o[1] = pack2(a[2], a[3]); return o; }
  DI void store16(int row, int col, const u32x4& v) const { *(u32x4*)(out + (size_t)row * ldo + col) = v; }
  DI float scale(int) const { return 1.f; }
  DI void operator()(int row, int col, const f32x4& a, float) const { (*this)(row, col, a); }
  DI void operator()(int row, int col, const f32x4& a) const {
    u32x2 o; o[0] = pack2(a[0], a[1]); o[1] = pack2(a[2], a[3]);
    *(u32x2*)(out + (size_t)row * ldo + col) = o;
  }
};
struct EpiRelu2 {
  bf16_t* out; int ldo;
  DI float scale(int) const { return 1.f; }
  DI void operator()(int row, int col, const f32x4& a, float) const { (*this)(row, col, a); }
  DI void side(int, int, const f32x4&) const {}
  DI u32x2 pack(const f32x4& a) const {
    float r0 = fmaxf(a[0], 0.f), r1 = fmaxf(a[1], 0.f), r2 = fmaxf(a[2], 0.f), r3 = fmaxf(a[3], 0.f);
    u32x2 o; o[0] = pack2(r0 * r0, r1 * r1); o[1] = pack2(r2 * r2, r3 * r3); return o;
  }
  DI void store16(int row, int col, const u32x4& v) const { *(u32x4*)(out + (size_t)row * ldo + col) = v; }
  DI void operator()(int row, int col, const f32x4& a) const {
    float r0 = fmaxf(a[0], 0.f), r1 = fmaxf(a[1], 0.f), r2 = fmaxf(a[2], 0.f), r3 = fmaxf(a[3], 0.f);
    u32x2 o; o[0] = pack2(r0 * r0, r1 * r1); o[1] = pack2(r2 * r2, r3 * r3);
    *(u32x2*)(out + (size_t)row * ldo + col) = o;
  }
};
struct EpiU {
  bf16_t* u; float* dt;
  DI void side(int row, int col, const f32x4& a) const { if (col >= U_DT && col < DIN) *(float4*)(dt + (size_t)row * 16 + col - U_DT) = make_float4(a[0], a[1], a[2], a[3]); }
  DI u32x2 pack(const f32x4& a) const { u32x2 o; o[0] = pack2(a[0], a[1]); o[1] = pack2(a[2], a[3]); return o; }
  DI void store16(int row, int col, const u32x4& v) const { if (col < DIN) *(u32x4*)(u + (size_t)row * DIN + col) = v; }
  DI void operator()(int row, int col, const f32x4& a) const {
    if (col < DIN) {
      u32x2 o; o[0] = pack2(a[0], a[1]); o[1] = pack2(a[2], a[3]);
      *(u32x2*)(u + (size_t)row * DIN + col) = o;
      if (col >= U_DT) *(float4*)(dt + (size_t)row * 16 + col - U_DT) = make_float4(a[0], a[1], a[2], a[3]);
    }
  }
};
struct EpiQ {
  bf16_t* q; const float* rs;
  DI float scale(int row) const { return rs[row * 2]; }
  DI void operator()(int row, int col, const f32x4& a, float r) const {
    u32x2 o; o[0] = pack2(a[0] * r, a[1] * r); o[1] = pack2(a[2] * r, a[3] * r);
    *(u32x2*)(q + (size_t)row * 384 + col) = o;
  }
};
struct EpiKV {
  bf16_t* kb; bf16_t* vt; const float* rs;
  DI float scale(int row) const { return rs[row * 2 + 1]; }
  DI void operator()(int row, int col, const f32x4& a, float r) const {
    int b, pos;
    if (row < ML) { b = row >> 12; pos = (row & 4095) + CTX; } else { int rr = row - ML; b = rr >> 8; pos = rr & 255; }
    const int head = col >> 7, d = col & 127;
    if (d < 64) {
      u32x2 o; o[0] = pack2(a[0] * r, a[1] * r); o[1] = pack2(a[2] * r, a[3] * r);
      *(u32x2*)(kb + ((size_t)(b * 4 + head) * LK + pos) * 96 + d) = o;
    } else {
#pragma unroll
      for (int j = 0; j < 4; ++j) vt[((size_t)(b * 4 + head) * 64 + (d - 64 + j)) * LK + pos] = f2bf(a[j] * r);
    }
  }
};

struct EpiPartS {
  float* part; const float* ssq; int g;
  DI float scale(int row) const {
    if (g < 0) return 1.f;
    const float4 sq = *(const float4*)(ssq + (size_t)row * 8 + g * 4);
    return rsqrtf((sq.x + sq.y + sq.z + sq.w) * (1.f / 256) + EPS);
  }
  DI void operator()(int row, int col, const f32x4& a, float r) const {
    *(float4*)(part + (size_t)(row - ML) * DM + col) = make_float4(a[0] * r, a[1] * r, a[2] * r, a[3] * r);
  }
};
struct EpiPart {
  float* part;
  DI float scale(int) const { return 1.f; }
  DI void operator()(int row, int col, const f32x4& a, float) const { (*this)(row, col, a); }
  DI void operator()(int row, int col, const f32x4& a) const {
    *(float4*)(part + (size_t)(row - ML) * DM + col) = make_float4(a[0], a[1], a[2], a[3]);
  }
};
DI void phase_inproj(const Params& p, int layer, int bid, int nb, int vbid, int nvb, char* smem, char* smem_half) {
  EpiU epi{(bf16_t*)(p.ws + OFF_U), (float*)(p.ws + OFF_DT)};
  const int x = bid & 7, per = nb >> 3;
  for (int rep = 0; rep < REP_GEMM; ++rep)
  for (int q = bid >> 3; q < 85; q += per) {
    const int m = (x >> 1) * 17 + q / 5, n = 5 * (x & 1) + q % 5;
    const int q2 = q + per, m2 = (x >> 1) * 17 + q2 / 5, n2 = 5 * (x & 1) + q2 % 5;
    gemm8_tile((const bf16_t*)(p.ws + OFF_H), DM, wt_ptr(p, layer, WT_IN), 1024, 1024, m * 256, n * 256, smem, epi,
               q == (bid >> 3), q2 < 85, m2 * 256, n2 * 256);
  }
  if (layer == 0) {
    if (per == 32) {
      if ((bid >> 3) >= 21) {
        const int u = ((bid >> 3) - 21) * 8 + x;
        for (int it = 640 + 2 * u + (vbid & 1); it < WT_ITEMS; it += 176) wt_item(p, 0, it, smem_half);
      }
    } else {
      for (int it = 640 + vbid; it < WT_ITEMS; it += nvb) wt_item(p, 0, it, smem_half);
    }
  }
}
DI void phase_wout(const Params& p, int layer, int bid, int nb, int vbid, int nvb, char* smem, char* smem_half) {
  EpiBF epi{(bf16_t*)(p.ws + OFF_U), DM};
  const float* ssq = (const float*)(p.ws + OFF_SSQ);
  const int x = bid & 7, per = nb >> 3;
  for (int rep = 0; rep < REP_GEMM; ++rep) {
    for (int q = bid >> 3; q < 32; q += per) {
      const int T = x * 32 + q;
      gemm8_tile<true>((const bf16_t*)(p.ws + OFF_H), DM, wt_ptr(p, layer, WT_OUT), 1024, 1024, (T >> 2) * 256, (T & 3) * 256, smem, epi,
                       true, false, 0, 0, ssq);
    }
    if (layer == 0)
      for (int it = vbid; it < (MC / 128) * 8 * 4; it += nvb) {
        const int tile = it >> 2, ks = it & 3;
        EpiPartS ep{(float*)(p.ws + OFF_QB) + (size_t)ks * MC * DM, ssq, ks - 2};
        gemm_tile_glds((const bf16_t*)(p.ws + OFF_H) + ks * 256, DM, wt_ptr(p, layer, WT_OUT) + ks * 256, 1024, 256, ML + (tile >> 3) * 128, (tile & 7) * 128, smem_half, ep);
      }
  }
}
DI void phase_ff1(const Params& p, int layer, int bid, int nb, int vbid, int nvb, char* smem, char* smem_half) {
  EpiRelu2 epi{(bf16_t*)(p.ws + OFF_F1), DFF};
  const int x = bid & 7, per = nb >> 3;
  for (int rep = 0; rep < REP_GEMM; ++rep) {
    for (int q = bid >> 3; q < 128; q += per) {
      const int m = (x >> 2) * 32 + (q >> 2), n = 4 * (x & 3) + (q & 3);
      const int q2 = q + per, m2 = (x >> 2) * 32 + (q2 >> 2), n2 = 4 * (x & 3) + (q2 & 3);
      gemm8_tile((const bf16_t*)(p.ws + OFF_H), DM, wt_ptr(p, layer, WT_FF1), 1024, 1024, m * 256, n * 256, smem, epi,
                 q == (bid >> 3), q2 < 128, m2 * 256, n2 * 256);
    }
    if (layer == 0)
      for (int it = vbid; it < (MC / 64) * 32; it += nvb)
        gemm_tile_glds<2>((const bf16_t*)(p.ws + OFF_H), DM, wt_ptr(p, layer, WT_FF1), 1024, 1024, ML + (it / 32) * 64, (it % 32) * 128, smem_half, epi);
  }
}
DI void phase_ff2(const Params& p, int layer, int bid, int nb, int vbid, int nvb, char* smem, char* smem_half) {
  EpiBF epi{(bf16_t*)(p.ws + OFF_H), DM};
  const int x = bid & 7, per = nb >> 3;
  for (int rep = 0; rep < REP_GEMM; ++rep) {
    for (int q = bid >> 3; q < 32; q += per) {
      const int T = x * 32 + q;
      gemm8_tile((const bf16_t*)(p.ws + OFF_F1), DFF, wt_ptr(p, layer, WT_FF2), 4096, 4096, (T >> 2) * 256, (T & 3) * 256, smem, epi);
    }
    if (layer == 0)
      for (int it = vbid; it < (MC / 128) * 8 * 8; it += nvb) {
        const int tile = it >> 3, ks = it & 7;
        EpiPart ep{(float*)(p.ws + OFF_END2) + (size_t)ks * MC * DM};
        gemm_tile_glds((const bf16_t*)(p.ws + OFF_F1) + ks * 512, DFF, wt_ptr(p, layer, WT_FF2) + ks * 512, 4096, 512, ML + (tile >> 3) * 128, (tile & 7) * 128, smem_half, ep);
      }
  }
}

DI int chunk_row0(int b, int tc) { return tc < 2 ? ML + b * CTX + tc * 128 : b * SEQ + (tc - 2) * 128; }
constexpr int BST = 72;
constexpr int TST = 136;
DI void load_tile_T(bf16_t* dst, const bf16_t* __restrict__ src, int ldg) {
  const int tid = ltid();
#pragma unroll
  for (int i = 0; i < 4; ++i) {
    int c = tid + 256 * i, tok = c & 127, pc = c >> 7;
    u32x4 v = *(const u32x4*)(src + (size_t)tok * ldg + pc * 8);
#pragma unroll
    for (int j = 0; j < 4; ++j) {
      dst[(pc * 8 + 2 * j) * TST + tok] = (bf16_t)(v[j] & 0xffffu);
      dst[(pc * 8 + 2 * j + 1) * TST + tok] = (bf16_t)(v[j] >> 16);
    }
  }
}
DI void chunk_scan(const Params& p, int layer, int row0, int h, float* csf, float* csb, float* dtF, float* dtB, float* tot, float*  ) {
  const int tid = ltid(), w = tid >> 6, lane = tid & 63;
  const float* DT = (const float*)(p.ws + OFF_DT);
  float v;
  if (tid < 128) {
    const float dt = DT[(size_t)(row0 + tid) * 16 + h];
    v = dt * -__expf(p.a_log[layer * 16 + h]);
    dtF[tid] = dt;
  } else {
    const int e = 255 - tid;
    const float dt = DT[(size_t)(row0 + e) * 16 + 8 + h];
    v = dt * -__expf(p.a_log[layer * 16 + 8 + h]);
    dtB[e] = dt;
  }
#pragma unroll
  for (int o = 1; o < 64; o <<= 1) { const float t = __shfl_up(v, o); if (lane >= o) v += t; }
  if (lane == 63) tot[w] = v;
  __syncthreads();
  if (w == 1) v += tot[0];
  if (w == 3) v += tot[2];
  if (tid < 128) csf[tid] = v; else csb[255 - tid] = v;
  __syncthreads();
}

DI void ssd_state_item(const Params& p, int layer, int b, int tc, int h, char* smem) {
  bf16_t* XT = (bf16_t*)smem;
  bf16_t* BT = XT + 64 * TST;
  float* csf = (float*)(BT + 64 * TST);
  float* csb = csf + 128; float* dtF = csb + 128; float* dtB = dtF + 128; float* laF = dtB + 128; float* laB = laF + 128;
  const int tid = ltid(), w = tid >> 6, lane = tid & 63, r = lane & 31, hh = lane >> 5;
  const int row0 = chunk_row0(b, tc);
  const bf16_t* XBC = (const bf16_t*)(p.ws + OFF_XBC);
  load_tile_T(XT, XBC + (size_t)row0 * 768 + h * 64, 768);
  load_tile_T(BT, XBC + (size_t)row0 * 768 + 512 + (h >> 2) * 64, 768);
  chunk_scan(p, layer, row0, h, csf, csb, dtF, dtB, laF, laB);
  __syncthreads();
  if (tid < 128) laF[tid] = dtF[tid] * __expf(csf[127] - csf[tid]);
  else { int t = tid - 128; laB[t] = dtB[t] * __expf(csb[0] - csb[t]); }
  __syncthreads();
  const int d = w >> 1, pt = w & 1;
  const float* wv = d == 0 ? laF : laB;
  f32x16 acc[2];
#pragma unroll
  for (int i = 0; i < 16; ++i) { acc[0][i] = 0.f; acc[1][i] = 0.f; }
#pragma unroll
  for (int s = 0; s < 8; ++s) {
    int l0 = 16 * s + 8 * hh;
    u32x4 xa = *(const u32x4*)(XT + (32 * pt + r) * TST + l0);
    u32x4 sa;
#pragma unroll
    for (int j = 0; j < 4; ++j) sa[j] = pack2(lo2f(xa[j]) * wv[l0 + 2 * j], hi2f(xa[j]) * wv[l0 + 2 * j + 1]);
    bf16x8 af = __builtin_bit_cast(bf16x8, sa);
#pragma unroll
    for (int nt = 0; nt < 2; ++nt) {
      bf16x8 bfr = *(const bf16x8*)(BT + (32 * nt + r) * TST + l0);
      acc[nt] = MFMA32(af, bfr, acc[nt]);
    }
  }
  bf16_t* S = (bf16_t*)(p.ws + OFF_SST) + ((((size_t)d * NB + b) * NCH + tc) * 8 + h) * 4096;
#pragma unroll
  for (int nt = 0; nt < 2; ++nt)
#pragma unroll
    for (int i = 0; i < 16; ++i) S[(32 * pt + crow(i, hh)) * 64 + 32 * nt + r] = f2bf(acc[nt][i]);
  if (tid == 0) {
    float* TD = (float*)(p.ws + OFF_TDEC);
    TD[((0 * NB + b) * NCH + tc) * 8 + h] = __expf(csf[127]);
    TD[((1 * NB + b) * NCH + tc) * 8 + h] = __expf(csb[0]);
  }
  __syncthreads();
}

DI void ssd_pass_item(const Params& p, int it) {
  const int e = it * 256 + ltid();
  const int pn2 = e & 2047, h = (e >> 11) & 7, b = (e >> 14) & 3, d = e >> 16;
  unsigned* S = (unsigned*)(p.ws + OFF_SST);
  const float* TD = (const float*)(p.ws + OFF_TDEC);
  unsigned sv[NCH]; float T[NCH];
#pragma unroll
  for (int i = 0; i < NCH; ++i) {
    int tc = d == 0 ? i : (i < 2 ? 1 - i : NCH + 1 - i);
    sv[i] = S[(((size_t)(d * NB + b) * NCH + tc) * 8 + h) * 2048 + pn2];
    T[i] = TD[((d * NB + b) * NCH + tc) * 8 + h];
  }
  float h0 = 0.f, h1 = 0.f;
#pragma unroll
  for (int i = 0; i < NCH; ++i) {
    int tc = d == 0 ? i : (i < 2 ? 1 - i : NCH + 1 - i);
    S[(((size_t)(d * NB + b) * NCH + tc) * 8 + h) * 2048 + pn2] = pack2(h0, h1);
    h0 = T[i] * h0 + lo2f(sv[i]); h1 = T[i] * h1 + hi2f(sv[i]);
  }
}

DI void ssd_out_item(const Params& p, int layer, int b, int tc, int h, char* smem) {
  bf16_t* XT = (bf16_t*)smem;
  bf16_t* Bs = XT + 64 * TST;
  float* csf = (float*)(Bs + 128 * BST);
  float* csb = csf + 128; float* dtF = csb + 128; float* dtB = dtF + 128; float* laF = dtB + 128; float* laB = laF + 128;
  const int tid = ltid(), w = tid >> 6, lane = tid & 63, r = lane & 31, hh = lane >> 5;
  const int row0 = chunk_row0(b, tc), g = h >> 2;
  const bf16_t* XBC = (const bf16_t*)(p.ws + OFF_XBC);
  load_tile_T(XT, XBC + (size_t)row0 * 768 + h * 64, 768);
#pragma unroll
  for (int i = 0; i < 4; ++i) {
    int c = tid + 256 * i, tok = c >> 3, part = c & 7;
    *(u32x4*)(Bs + tok * BST + part * 8) = *(const u32x4*)(XBC + (size_t)(row0 + tok) * 768 + 512 + g * 64 + part * 8);
  }
  const int l = 32 * w + r;
  bf16x8 cf[4];
#pragma unroll
  for (int ks = 0; ks < 4; ++ks) cf[ks] = *(const bf16x8*)(XBC + (size_t)(row0 + l) * 768 + 640 + g * 64 + 16 * ks + 8 * hh);
  chunk_scan(p, layer, row0, h, csf, csb, dtF, dtB, laF, laB);
  const float csf_l = csf[l], csb_l = csb[l];
  f32x16 yacc[2];
#pragma unroll
  for (int i = 0; i < 16; ++i) { yacc[0][i] = 0.f; yacc[1][i] = 0.f; }
#pragma unroll
  for (int st = 0; st < 4; ++st) {
    f32x16 gacc;
#pragma unroll
    for (int i = 0; i < 16; ++i) gacc[i] = 0.f;
#pragma unroll
    for (int ks = 0; ks < 4; ++ks) {
      bf16x8 af = *(const bf16x8*)(Bs + (32 * st + r) * BST + 16 * ks + 8 * hh);
      gacc = MFMA32(af, cf[ks], gacc);
    }
#pragma unroll
    for (int i = 0; i < 16; ++i) {
      int s = 32 * st + crow(i, hh);
      float f;
      if (s < l) f = __expf(csf_l - csf[s]) * dtF[s];
      else if (s > l) f = __expf(csb_l - csb[s]) * dtB[s];
      else f = dtF[s] + dtB[s];
      gacc[i] *= f;
    }
#pragma unroll
    for (int s2 = 0; s2 < 2; ++s2) {
      bf16x8 mf = pack8(gacc, s2);
      int sb = 32 * st + 16 * s2 + 4 * hh;
#pragma unroll
      for (int pt = 0; pt < 2; ++pt) {
        u32x2 lo = *(const u32x2*)(XT + (32 * pt + r) * TST + sb);
        u32x2 hi = *(const u32x2*)(XT + (32 * pt + r) * TST + sb + 8);
        u32x4 xa; xa[0] = lo[0]; xa[1] = lo[1]; xa[2] = hi[0]; xa[3] = hi[1];
        yacc[pt] = MFMA32(__builtin_bit_cast(bf16x8, xa), mf, yacc[pt]);
      }
    }
  }
#pragma unroll
  for (int d = 0; d < 2; ++d) {
    const bf16_t* Hs = (const bf16_t*)(p.ws + OFF_SST) + ((((size_t)d * NB + b) * NCH + tc) * 8 + h) * 4096;
    const float e = __expf(d == 0 ? csf_l : csb_l);
#pragma unroll
    for (int pt = 0; pt < 2; ++pt) {
      f32x16 t;
#pragma unroll
      for (int i = 0; i < 16; ++i) t[i] = 0.f;
#pragma unroll
      for (int ks = 0; ks < 4; ++ks) {
        bf16x8 af = *(const bf16x8*)(Hs + (32 * pt + r) * 64 + 16 * ks + 8 * hh);
        t = MFMA32(af, cf[ks], t);
      }
#pragma unroll
      for (int i = 0; i < 16; ++i) yacc[pt][i] += e * t[i];
    }
  }
  const int row = row0 + l;
  const float Dh = p.ssd_d[layer * 8 + h];
  const bf16_t* U = (const bf16_t*)(p.ws + OFF_U);
  bf16_t* YM = (bf16_t*)(p.ws + OFF_H);
  float ssq = 0.f;
  u32x2 xvv[2][4], zvv[2][4];
#pragma unroll
  for (int pt = 0; pt < 2; ++pt)
#pragma unroll
    for (int q = 0; q < 4; ++q) {
      const int pp = 32 * pt + 8 * q + 4 * hh;
      xvv[pt][q] = *(const u32x2*)(XBC + (size_t)row * 768 + h * 64 + pp);
      zvv[pt][q] = *(const u32x2*)(U + (size_t)row * DIN + U_Z + h * 64 + pp);
    }
#pragma unroll
  for (int pt = 0; pt < 2; ++pt)
#pragma unroll
    for (int q = 0; q < 4; ++q) {
      const int pp = 32 * pt + 8 * q + 4 * hh;
      const u32x2 xv = xvv[pt][q], zv = zvv[pt][q];
      float y0 = (yacc[pt][4 * q + 0] + Dh * lo2f(xv[0])) * silu_f(lo2f(zv[0]));
      float y1 = (yacc[pt][4 * q + 1] + Dh * hi2f(xv[0])) * silu_f(hi2f(zv[0]));
      float y2 = (yacc[pt][4 * q + 2] + Dh * lo2f(xv[1])) * silu_f(lo2f(zv[1]));
      float y3 = (yacc[pt][4 * q + 3] + Dh * hi2f(xv[1])) * silu_f(hi2f(zv[1]));
      u32x2 o; o[0] = pack2(y0, y1); o[1] = pack2(y2, y3);
      float r0 = lo2f(o[0]), r1 = hi2f(o[0]), r2 = lo2f(o[1]), r3 = hi2f(o[1]);
      ssq += r0 * r0 + r1 * r1 + r2 * r2 + r3 * r3;
      *(u32x2*)(YM + (size_t)row * DM + 512 + h * 64 + pp) = o;
    }
  ssq += __shfl_xor(ssq, 32);
  if (hh == 0) ((float*)(p.ws + OFF_SSQ))[(size_t)row * 8 + h] = ssq;
  __syncthreads();
}

constexpr int KST = 104;
constexpr int VST = 68;
constexpr int ASTG = 64 * KST + 64 * VST;
DI void attn_item(const Params& p, int b, int head, int qrow0, int t0, bool lat, int nkeys, char* smem) {
  bf16_t* Ks = (bf16_t*)smem;
  bf16_t* Vs = Ks + 64 * KST;
  const int tid = ltid(), w = tid >> 6, lane = tid & 63, r = lane & 31, hh = lane >> 5;
  const bf16_t* QB = (const bf16_t*)(p.ws + OFF_QB);
  const bf16_t* KB = (const bf16_t*)(p.ws + OFF_KB) + (size_t)(b * 4 + head) * LK * 96;
  const bf16_t* VT = (const bf16_t*)(p.ws + OFF_VT) + (size_t)(b * 4 + head) * 64 * LK;
  const float qscale = 0.10206207261596575f * 1.4426950408889634f;
  const int qrow = qrow0 + w * 32 + r;
  const int t = t0 + w * 32 + r;
  bf16x8 qf[6];
  {
    const bf16_t* src = QB + (size_t)qrow * 384 + head * 96;
#pragma unroll
    for (int s = 0; s < 4; ++s) {
      u32x4 v = *(const u32x4*)(src + 16 * s + 8 * hh);
      u32x4 o;
#pragma unroll
      for (int j = 0; j < 4; ++j) o[j] = pack2(lo2f(v[j]) * qscale, hi2f(v[j]) * qscale);
      qf[s] = __builtin_bit_cast(bf16x8, o);
    }
#pragma unroll
    for (int s = 4; s < 6; ++s) {
      u32x4 va = *(const u32x4*)(src + 16 * s), vb = *(const u32x4*)(src + 16 * s + 8);
      float posf = s == 4 ? (float)(t >> 6) : (float)(t & 63);
      float o[8];
#pragma unroll
      for (int j = 0; j < 8; ++j) {
        float a = (j & 1) ? hi2f(va[j >> 1]) : lo2f(va[j >> 1]);
        float bb = (j & 1) ? hi2f(vb[j >> 1]) : lo2f(vb[j >> 1]);
        float res;
        if (lat) {
          float invf = exp2f(-(float)(2 * j) * (13.287712379549449f / 16.f));
          float rev = posf * invf * 0.15915494309189535f;
          float cs = __builtin_amdgcn_cosf(rev), sn = __builtin_amdgcn_sinf(rev);
          res = hh == 0 ? a * cs - bb * sn : bb * cs + a * sn;
        } else res = hh == 0 ? a : bb;
        o[j] = res * qscale;
      }
      u32x4 ov; ov[0] = pack2(o[0], o[1]); ov[1] = pack2(o[2], o[3]); ov[2] = pack2(o[4], o[5]); ov[3] = pack2(o[6], o[7]);
      qf[s] = __builtin_bit_cast(bf16x8, ov);
    }
  }
  f32x16 oacc[2];
#pragma unroll
  for (int i = 0; i < 16; ++i) { oacc[0][i] = 0.f; oacc[1][i] = 0.f; }
  float m = -1e30f, lsum = 0.f;
  u32x4 rk[3], rv[2];
  auto gload = [&](int key0) {
#pragma unroll
    for (int i = 0; i < 3; ++i) rk[i] = *(const u32x4*)(KB + (size_t)key0 * 96 + (tid + 256 * i) * 8);
#pragma unroll
    for (int i = 0; i < 2; ++i) { int c = tid + 256 * i; rv[i] = *(const u32x4*)(VT + (size_t)(c >> 3) * LK + key0 + (c & 7) * 8); }
  };
  gload(0);
  const int NT = nkeys / 64;
  for (int kt = 0; kt < NT; ++kt) {
#pragma unroll
    for (int i = 0; i < 3; ++i) { int c = tid + 256 * i; *(u32x4*)(Ks + (c / 12) * KST + (c % 12) * 8) = rk[i]; }
#pragma unroll
    for (int i = 0; i < 2; ++i) {
      int c = tid + 256 * i;
      bf16_t* d = Vs + (c >> 3) * VST + (c & 7) * 8;
      u32x2 a; a[0] = rv[i][0]; a[1] = rv[i][1];
      u32x2 bq; bq[0] = rv[i][2]; bq[1] = rv[i][3];
      *(u32x2*)d = a; *(u32x2*)(d + 4) = bq;
    }
    __syncthreads();
    if (kt + 1 < NT) gload((kt + 1) * 64);
    f32x16 sacc[2];
#pragma unroll
    for (int i = 0; i < 16; ++i) { sacc[0][i] = 0.f; sacc[1][i] = 0.f; }
#pragma unroll
    for (int s = 0; s < 6; ++s)
#pragma unroll
      for (int k2 = 0; k2 < 2; ++k2) {
        bf16x8 af = *(const bf16x8*)(Ks + (32 * k2 + r) * KST + 16 * s + 8 * hh);
        sacc[k2] = MFMA32(af, qf[s], sacc[k2]);
      }
    float mx = sacc[0][0];
#pragma unroll
    for (int i = 0; i < 16; ++i) { mx = fmaxf(mx, sacc[0][i]); mx = fmaxf(mx, sacc[1][i]); }
    mx = fmaxf(mx, __shfl_xor(mx, 32));
    const float mn = fmaxf(m, mx);
    const float alpha = __builtin_amdgcn_exp2f(m - mn);
    m = mn;
    float ps = 0.f;
#pragma unroll
    for (int i = 0; i < 16; ++i) {
      sacc[0][i] = __builtin_amdgcn_exp2f(sacc[0][i] - mn); sacc[1][i] = __builtin_amdgcn_exp2f(sacc[1][i] - mn);
      ps += sacc[0][i] + sacc[1][i];
    }
    lsum = lsum * alpha + ps;
#pragma unroll
    for (int i = 0; i < 16; ++i) { oacc[0][i] *= alpha; oacc[1][i] *= alpha; }
#pragma unroll
    for (int k2 = 0; k2 < 2; ++k2)
#pragma unroll
      for (int s2 = 0; s2 < 2; ++s2) {
        bf16x8 pf = pack8(sacc[k2], s2);
        int kb0 = 32 * k2 + 16 * s2 + 4 * hh;
#pragma unroll
        for (int d = 0; d < 2; ++d) {
          u32x2 lo = *(const u32x2*)(Vs + (32 * d + r) * VST + kb0);
          u32x2 hi = *(const u32x2*)(Vs + (32 * d + r) * VST + kb0 + 8);
          u32x4 va; va[0] = lo[0]; va[1] = lo[1]; va[2] = hi[0]; va[3] = hi[1];
          oacc[d] = MFMA32(__builtin_bit_cast(bf16x8, va), pf, oacc[d]);
        }
      }
    __syncthreads();
  }
  lsum += __shfl_xor(lsum, 32);
  const float inv = 1.f / lsum;
  bf16_t* YM = (bf16_t*)(p.ws + OFF_H) + (size_t)qrow * DM + head * 64;
#pragma unroll
  for (int d = 0; d < 2; ++d)
#pragma unroll
    for (int q = 0; q < 4; ++q) {
      u32x2 o; o[0] = pack2(oacc[d][4 * q] * inv, oacc[d][4 * q + 1] * inv); o[1] = pack2(oacc[d][4 * q + 2] * inv, oacc[d][4 * q + 3] * inv);
      *(u32x2*)(YM + 32 * d + 8 * q + 4 * hh) = o;
    }
}

DI void attn_item8(const Params& p, int b, int head, int qrow0, int t0, bool lat, int nkeys, char* smem) {
  bf16_t* Ks = (bf16_t*)smem;
  bf16_t* Vs = Ks + 64 * KST;
  const int tid = ltid512(), w = tid >> 6, lane = tid & 63, r = lane & 31, hh = lane >> 5;
  const bf16_t* QB = (const bf16_t*)(p.ws + OFF_QB);
  const bf16_t* KB = (const bf16_t*)(p.ws + OFF_KB) + (size_t)(b * 4 + head) * LK * 96;
  const bf16_t* VT = (const bf16_t*)(p.ws + OFF_VT) + (size_t)(b * 4 + head) * 64 * LK;
  const float qscale = 0.10206207261596575f * 1.4426950408889634f;
  const int qrow = qrow0 + w * 32 + r;
  const int t = t0 + w * 32 + r;
  bf16x8 qf[6];
  {
    const bf16_t* src = QB + (size_t)qrow * 384 + head * 96;
#pragma unroll
    for (int s = 0; s < 4; ++s) {
      u32x4 v = *(const u32x4*)(src + 16 * s + 8 * hh);
      u32x4 o;
#pragma unroll
      for (int j = 0; j < 4; ++j) o[j] = pack2(lo2f(v[j]) * qscale, hi2f(v[j]) * qscale);
      qf[s] = __builtin_bit_cast(bf16x8, o);
    }
#pragma unroll
    for (int s = 4; s < 6; ++s) {
      u32x4 va = *(const u32x4*)(src + 16 * s), vb = *(const u32x4*)(src + 16 * s + 8);
      float posf = s == 4 ? (float)(t >> 6) : (float)(t & 63);
      float o[8];
#pragma unroll
      for (int j = 0; j < 8; ++j) {
        float a = (j & 1) ? hi2f(va[j >> 1]) : lo2f(va[j >> 1]);
        float bb = (j & 1) ? hi2f(vb[j >> 1]) : lo2f(vb[j >> 1]);
        float res;
        if (lat) {
          float invf = exp2f(-(float)(2 * j) * (13.287712379549449f / 16.f));
          float rev = posf * invf * 0.15915494309189535f;
          float cs = __builtin_amdgcn_cosf(rev), sn = __builtin_amdgcn_sinf(rev);
          res = hh == 0 ? a * cs - bb * sn : bb * cs + a * sn;
        } else res = hh == 0 ? a : bb;
        o[j] = res * qscale;
      }
      u32x4 ov; ov[0] = pack2(o[0], o[1]); ov[1] = pack2(o[2], o[3]); ov[2] = pack2(o[4], o[5]); ov[3] = pack2(o[6], o[7]);
      qf[s] = __builtin_bit_cast(bf16x8, ov);
    }
  }
  f32x16 oacc[2];
#pragma unroll
  for (int i = 0; i < 16; ++i) { oacc[0][i] = 0.f; oacc[1][i] = 0.f; }
  float m = -1e30f, lsum = 0.f;
  u32x4 rk[2], rv;
  auto gload = [&](int key0) {
    rk[0] = *(const u32x4*)(KB + (size_t)key0 * 96 + tid * 8);
    if (tid < 256) rk[1] = *(const u32x4*)(KB + (size_t)key0 * 96 + (512 + tid) * 8);
    rv = *(const u32x4*)(VT + (size_t)(tid >> 3) * LK + key0 + (tid & 7) * 8);
  };
  const int kro = (tid / 12) * KST + (tid % 12) * 8, kro2 = ((512 + tid) / 12) * KST + ((512 + tid) % 12) * 8;
  auto swrite = [&](int stage) {
    bf16_t* Kd = Ks + stage * ASTG;
    *(u32x4*)(Kd + kro) = rk[0];
    if (tid < 256) *(u32x4*)(Kd + kro2) = rk[1];
    bf16_t* d = Kd + 64 * KST + (tid >> 3) * VST + (tid & 7) * 8;
    u32x2 a; a[0] = rv[0]; a[1] = rv[1];
    u32x2 bq; bq[0] = rv[2]; bq[1] = rv[3];
    *(u32x2*)d = a; *(u32x2*)(d + 4) = bq;
  };
  auto qk = [&](int stage, f32x16 (&sa)[2]) {
    const bf16_t* Kc = Ks + stage * ASTG;
#pragma unroll
    for (int i = 0; i < 16; ++i) { sa[0][i] = 0.f; sa[1][i] = 0.f; }
#pragma unroll
    for (int s = 0; s < 6; ++s)
#pragma unroll
      for (int k2 = 0; k2 < 2; ++k2) {
        bf16x8 af = *(const bf16x8*)(Kc + (32 * k2 + r) * KST + 16 * s + 8 * hh);
        sa[k2] = MFMA32(af, qf[s], sa[k2]);
      }
  };
  const int NT = nkeys / 64;
  f32x16 sacc[2], snext[2];
  gload(0); swrite(0);
  gload(64);
  __syncthreads();
  swrite(1);
  gload(128);
  qk(0, sacc);
  __syncthreads();
  int cur = 0, nxt = 1, nn = 2;
  for (int kt = 0; kt < NT; ++kt) {
    if (kt + 1 < NT) qk(nxt, snext);
    if (kt + 2 < NT) {
      swrite(nn);
      if (kt + 3 < NT) gload((kt + 3) * 64);
    }
    const bf16_t* Vc = Ks + cur * ASTG + 64 * KST;
    float mx = sacc[0][0];
#pragma unroll
    for (int i = 0; i < 16; ++i) { mx = fmaxf(mx, sacc[0][i]); mx = fmaxf(mx, sacc[1][i]); }
    mx = fmaxf(mx, __shfl_xor(mx, 32));
    const float mn = fmaxf(m, mx);
    const float alpha = __builtin_amdgcn_exp2f(m - mn);
    m = mn;
    float ps = 0.f;
#pragma unroll
    for (int i = 0; i < 16; ++i) {
      sacc[0][i] = __builtin_amdgcn_exp2f(sacc[0][i] - mn); sacc[1][i] = __builtin_amdgcn_exp2f(sacc[1][i] - mn);
      ps += sacc[0][i] + sacc[1][i];
    }
    lsum = lsum * alpha + ps;
#pragma unroll
    for (int i = 0; i < 16; ++i) { oacc[0][i] *= alpha; oacc[1][i] *= alpha; }
#pragma unroll
    for (int k2 = 0; k2 < 2; ++k2)
#pragma unroll
      for (int s2 = 0; s2 < 2; ++s2) {
        bf16x8 pf = pack8(sacc[k2], s2);
        int kb0 = 32 * k2 + 16 * s2 + 4 * hh;
#pragma unroll
        for (int d = 0; d < 2; ++d) {
          u32x2 lo = *(const u32x2*)(Vc + (32 * d + r) * VST + kb0);
          u32x2 hi = *(const u32x2*)(Vc + (32 * d + r) * VST + kb0 + 8);
          u32x4 va; va[0] = lo[0]; va[1] = lo[1]; va[2] = hi[0]; va[3] = hi[1];
          oacc[d] = MFMA32(__builtin_bit_cast(bf16x8, va), pf, oacc[d]);
        }
      }
    sacc[0] = snext[0]; sacc[1] = snext[1];
    const int t3 = cur; cur = nxt; nxt = nn; nn = t3;
    __syncthreads();
  }
  lsum += __shfl_xor(lsum, 32);
  const float inv = 1.f / lsum;
  bf16_t* YM = (bf16_t*)(p.ws + OFF_H) + (size_t)qrow * DM + head * 64;
#pragma unroll
  for (int d = 0; d < 2; ++d)
#pragma unroll
    for (int q = 0; q < 4; ++q) {
      u32x2 o; o[0] = pack2(oacc[d][4 * q] * inv, oacc[d][4 * q + 1] * inv); o[1] = pack2(oacc[d][4 * q + 2] * inv, oacc[d][4 * q + 3] * inv);
      *(u32x2*)(YM + 32 * d + 8 * q + 4 * hh) = o;
    }
}

DI void attn_item8b(const Params& p, int b, int head, int qrow0, int t0, bool lat, int nkeys, char* smem) {
  bf16_t* Ks = (bf16_t*)smem;
  bf16_t* Vs = Ks + 64 * KST;
  const int tid = ltid512(), w = tid >> 6, lane = tid & 63, r = lane & 31, hh = lane >> 5;
  const bf16_t* QB = (const bf16_t*)(p.ws + OFF_QB);
  const bf16_t* KB = (const bf16_t*)(p.ws + OFF_KB) + (size_t)(b * 4 + head) * LK * 96;
  const bf16_t* VT = (const bf16_t*)(p.ws + OFF_VT) + (size_t)(b * 4 + head) * 64 * LK;
  const float qscale = 0.10206207261596575f * 1.4426950408889634f;
  const int qrow = qrow0 + w * 32 + r;
  const int t = t0 + w * 32 + r;
  bf16x8 qf[6];
  {
    const bf16_t* src = QB + (size_t)qrow * 384 + head * 96;
#pragma unroll
    for (int s = 0; s < 4; ++s) {
      u32x4 v = *(const u32x4*)(src + 16 * s + 8 * hh);
      u32x4 o;
#pragma unroll
      for (int j = 0; j < 4; ++j) o[j] = pack2(lo2f(v[j]) * qscale, hi2f(v[j]) * qscale);
      qf[s] = __builtin_bit_cast(bf16x8, o);
    }
#pragma unroll
    for (int s = 4; s < 6; ++s) {
      u32x4 va = *(const u32x4*)(src + 16 * s), vb = *(const u32x4*)(src + 16 * s + 8);
      float posf = s == 4 ? (float)(t >> 6) : (float)(t & 63);
      float o[8];
#pragma unroll
      for (int j = 0; j < 8; ++j) {
        float a = (j & 1) ? hi2f(va[j >> 1]) : lo2f(va[j >> 1]);
        float bb = (j & 1) ? hi2f(vb[j >> 1]) : lo2f(vb[j >> 1]);
        float res;
        if (lat) {
          float invf = exp2f(-(float)(2 * j) * (13.287712379549449f / 16.f));
          float rev = posf * invf * 0.15915494309189535f;
          float cs = __builtin_amdgcn_cosf(rev), sn = __builtin_amdgcn_sinf(rev);
          res = hh == 0 ? a * cs - bb * sn : bb * cs + a * sn;
        } else res = hh == 0 ? a : bb;
        o[j] = res * qscale;
      }
      u32x4 ov; ov[0] = pack2(o[0], o[1]); ov[1] = pack2(o[2], o[3]); ov[2] = pack2(o[4], o[5]); ov[3] = pack2(o[6], o[7]);
      qf[s] = __builtin_bit_cast(bf16x8, ov);
    }
  }
  f32x16 oacc[2];
#pragma unroll
  for (int i = 0; i < 16; ++i) { oacc[0][i] = 0.f; oacc[1][i] = 0.f; }
  float m = -1e30f, lsum = 0.f;
  constexpr int VS2 = 132;
  constexpr int STG = 128 * KST + 64 * VS2;
  u32x4 rk[3], rv[2];
  auto gload = [&](int key0) {
#pragma unroll
    for (int i = 0; i < 3; ++i) rk[i] = *(const u32x4*)(KB + (size_t)key0 * 96 + (tid + 512 * i) * 8);
#pragma unroll
    for (int i = 0; i < 2; ++i) { const int c = tid + 512 * i; rv[i] = *(const u32x4*)(VT + (size_t)(c >> 4) * LK + key0 + (c & 15) * 8); }
  };
  int kro[3], vro[2];
#pragma unroll
  for (int i = 0; i < 3; ++i) { const int c = tid + 512 * i; kro[i] = (c / 12) * KST + (c % 12) * 8; }
#pragma unroll
  for (int i = 0; i < 2; ++i) { const int c = tid + 512 * i; vro[i] = 128 * KST + (c >> 4) * VS2 + (c & 15) * 8; }
  auto swrite = [&](int stage) {
    bf16_t* Kd = Ks + stage * STG;
#pragma unroll
    for (int i = 0; i < 3; ++i) *(u32x4*)(Kd + kro[i]) = rk[i];
#pragma unroll
    for (int i = 0; i < 2; ++i) {
      u32x2 a; a[0] = rv[i][0]; a[1] = rv[i][1];
      u32x2 bq; bq[0] = rv[i][2]; bq[1] = rv[i][3];
      *(u32x2*)(Kd + vro[i]) = a; *(u32x2*)(Kd + vro[i] + 4) = bq;
    }
  };
  const int NT = nkeys / 128;
  gload(0); swrite(0);
  if (NT > 1) gload(128);
  __syncthreads();
  for (int kt = 0; kt < NT; ++kt) {
    const bf16_t* Kc = Ks + (kt & 1) * STG;
    const bf16_t* Vc = Kc + 128 * KST;
    if (kt + 1 < NT) {
      swrite((kt + 1) & 1);
      if (kt + 2 < NT) gload((kt + 2) * 128);
    }
    f32x16 sacc[4];
#pragma unroll
    for (int k2 = 0; k2 < 4; ++k2)
#pragma unroll
      for (int i = 0; i < 16; ++i) sacc[k2][i] = 0.f;
#pragma unroll
    for (int s = 0; s < 6; ++s)
#pragma unroll
      for (int k2 = 0; k2 < 4; ++k2) {
        bf16x8 af = *(const bf16x8*)(Kc + (32 * k2 + r) * KST + 16 * s + 8 * hh);
        sacc[k2] = MFMA32(af, qf[s], sacc[k2]);
      }
    float mx = sacc[0][0];
#pragma unroll
    for (int k2 = 0; k2 < 4; ++k2)
#pragma unroll
      for (int i = 0; i < 16; ++i) mx = fmaxf(mx, sacc[k2][i]);
    mx = fmaxf(mx, __shfl_xor(mx, 32));
    const float mn = fmaxf(m, mx);
    if (__any(mn > m)) {
      const float alpha = __builtin_amdgcn_exp2f(m - mn);
      lsum *= alpha;
#pragma unroll
      for (int i = 0; i < 16; ++i) { oacc[0][i] *= alpha; oacc[1][i] *= alpha; }
      m = mn;
    }
    float ps = 0.f;
#pragma unroll
    for (int k2 = 0; k2 < 4; ++k2)
#pragma unroll
      for (int i = 0; i < 16; ++i) { sacc[k2][i] = __builtin_amdgcn_exp2f(sacc[k2][i] - m); ps += sacc[k2][i]; }
    lsum += ps;
#pragma unroll
    for (int k2 = 0; k2 < 4; ++k2)
#pragma unroll
      for (int s2 = 0; s2 < 2; ++s2) {
        bf16x8 pf = pack8(sacc[k2], s2);
        const int kb0 = 32 * k2 + 16 * s2 + 4 * hh;
#pragma unroll
        for (int d = 0; d < 2; ++d) {
          u32x2 lo = *(const u32x2*)(Vc + (32 * d + r) * VS2 + kb0);
          u32x2 hi = *(const u32x2*)(Vc + (32 * d + r) * VS2 + kb0 + 8);
          u32x4 va; va[0] = lo[0]; va[1] = lo[1]; va[2] = hi[0]; va[3] = hi[1];
          oacc[d] = MFMA32(__builtin_bit_cast(bf16x8, va), pf, oacc[d]);
        }
      }
    __syncthreads();
  }
  lsum += __shfl_xor(lsum, 32);
  const float inv = 1.f / lsum;
  bf16_t* YM = (bf16_t*)(p.ws + OFF_H) + (size_t)qrow * DM + head * 64;
#pragma unroll
  for (int d = 0; d < 2; ++d)
#pragma unroll
    for (int q = 0; q < 4; ++q) {
      u32x2 o; o[0] = pack2(oacc[d][4 * q] * inv, oacc[d][4 * q + 1] * inv); o[1] = pack2(oacc[d][4 * q + 2] * inv, oacc[d][4 * q + 3] * inv);
      *(u32x2*)(YM + 32 * d + 8 * q + 4 * hh) = o;
    }
}

DI void phase_qkv(const Params& p, int layer, int bid, int nb, char* smem) {
  const int MQ = layer == 0 ? MT : ML;
  const int nq = (MQ / 128) * 3, nkv = (MT / 128) * 4, nst = NB * NCH * 8;
  const float* RS = (const float*)(p.ws + OFF_RSTD);
  EpiQ eq{(bf16_t*)(p.ws + OFF_QB), RS};
  EpiKV ekv{(bf16_t*)(p.ws + OFF_KB), (bf16_t*)(p.ws + OFF_VT), RS};
  const bf16_t* U = (const bf16_t*)(p.ws + OFF_U);
  for (int it = bid; it < nq + nkv + nst; it += nb) {
    if (it < nq) gemm_tile<false>(U, DIN, wt_ptr(p, layer, WT_UQ), 256, (it / 3) * 128, (it % 3) * 128, smem, eq);
    else if (it < nq + nkv) { int j = it - nq; gemm_tile<false>(U + U_CKV, DIN, wt_ptr(p, layer, WT_UKV), 128, (j / 4) * 128, (j % 4) * 128, smem, ekv); }
    else { int j = it - nq - nkv; for (int rep = 0; rep < REP_SSD; ++rep) ssd_state_item(p, layer, j / (NCH * 8), (j / 8) % NCH, j & 7, smem); }
  }
}
DI void phase_att(const Params& p, int layer, int bid, int nb, int vbid, int nvb, char* smem, char* sh) {
  for (int it = bid; it < 256; it += nb) {
    const int x = it & 7, j = it >> 3, bh = 2 * x + (j >> 4), qb = j & 15, b = bh >> 2, head = bh & 3;
    for (int rep = 0; rep < REP_ATT; ++rep) attn_item8b(p, b, head, b * SEQ + qb * 256, qb * 256, true, LK, smem);
  }
  for (int it = vbid; it < 512; it += nvb) ssd_pass_item(p, it);
}
DI void phase_ssdout(const Params& p, int layer, int bid, int nb, char* smem) {
  const int nout = NB * NCH * 8, nctx = layer == 0 ? 32 : 0;
  for (int it = bid; it < nout + nctx; it += nb) {
    if (it < nout) {
      int b = it / (NCH * 8), tc = (it / 8) % NCH, h = it & 7;
      if (layer == 1 && tc < 2) continue;
      for (int rep = 0; rep < REP_SSD; ++rep) ssd_out_item(p, layer, b, tc, h, smem);
    } else {
      const int j = it - nout, b = j >> 3, head = (j >> 1) & 3, qb = j & 1;
      attn_item(p, b, head, ML + b * CTX + qb * 128, qb * 128, false, CTX, smem);
    }
  }
  if (layer == 0) {
    if (nb == 512) { if (bid >= 96) for (int it = bid - 96; it < WT_ITEMS; it += 416) wt_item(p, 1, it, smem); }
    else for (int it = bid; it < WT_ITEMS; it += nb) wt_item(p, 1, it, smem);
  }
}


#define XB_TMO      128
#define XB_XCNT(j)  (256  + 64 * (j))
#define XB_XSUB(j)  (1280 + 64 * (j))
#define XB_XGEN(j)  (2304 + 64 * (j))
#define XB_TOP      3328
#define XB_TOPGEN   3392
#define XCD_BAR_WORDS 3456
#define XB_SPIN_CAP (1u << 22)
#define LAS __attribute__((address_space(3)))
DI unsigned xb_ld(unsigned* p) { return __hip_atomic_load(p, __ATOMIC_RELAXED, __HIP_MEMORY_SCOPE_AGENT); }
DI unsigned xb_add(unsigned* p, unsigned v) { return __hip_atomic_fetch_add(p, v, __ATOMIC_RELAXED, __HIP_MEMORY_SCOPE_AGENT); }
DI unsigned xb_xcc_id() { return (unsigned)__builtin_amdgcn_s_getreg((3 << 11) | 20) & 0xFu; }
#define XB_SPIN(cond, bar) do { unsigned _sp = 0; while (cond) { __builtin_amdgcn_s_sleep(1); \
    if ((++_sp & 255u) == 0u) { if (xb_ld(&(bar)[XB_TMO])) break; if (_sp > XB_SPIN_CAP) { atomicAdd(&(bar)[XB_TMO], 1u); break; } } } } while (0)
struct XcdBarrier { unsigned* bar; unsigned x; volatile LAS unsigned* st; };
DI XcdBarrier xcd_barrier_post(unsigned* bar, volatile LAS unsigned* st) {
  XcdBarrier b; b.bar = bar; b.x = xb_xcc_id(); b.st = st;
  if (threadIdx.x == 0) (void)xb_add(&bar[XB_XCNT(b.x)], 1u);
  return b;
}
DI void xcd_barrier_complete(unsigned* bar, unsigned x, unsigned& nloc, unsigned& nx) {
  const unsigned G = gridDim.x * gridDim.y * gridDim.z;
  unsigned sum, cnt, mine, sp = 0u;
  for (;;) {
    sum = 0u; cnt = 0u; mine = 0u;
#pragma unroll
    for (unsigned j = 0; j < 16; ++j) { const unsigned c = xb_ld(&bar[XB_XCNT(j)]); sum += c; cnt += (c > 0u) ? 1u : 0u; mine = (j == x) ? c : mine; }
    if (sum == G) break;
    __builtin_amdgcn_s_sleep(1);
    if ((++sp & 255u) == 0u) { if (xb_ld(&bar[XB_TMO])) break; if (sp > XB_SPIN_CAP) { atomicAdd(&bar[XB_TMO], 1u); break; } }
  }
  nloc = mine > 0u ? mine : 1u; nx = cnt > 0u ? cnt : 1u;
}
DI void xcd_barrier(const XcdBarrier& b) {
  asm volatile("s_waitcnt vmcnt(0)" ::: "memory");
  __syncthreads();
  if (threadIdx.x == 0) {
    unsigned* bar = b.bar;
    asm volatile("" : "+s"(bar));
    __builtin_amdgcn_s_waitcnt(0);
    unsigned nloc = b.st[0], nx = b.st[1];
    if (nloc == 0u) { xcd_barrier_complete(bar, b.x, nloc, nx); b.st[0] = nloc; b.st[1] = nx; }
    const unsigned old = xb_add(&bar[XB_XSUB(b.x)], 1u);
    const unsigned gen = old / nloc;
    if (old + 1u == (gen + 1u) * nloc) {
      __builtin_amdgcn_fence(__ATOMIC_RELEASE, "agent");
      asm volatile("s_waitcnt vmcnt(0)" ::: "memory");
      const unsigned og = xb_add(&bar[XB_TOP], 1u);
      const unsigned tg = og / nx;
      if (og + 1u == (tg + 1u) * nx) xb_add(&bar[XB_TOPGEN], 1u);
      else XB_SPIN(xb_ld(&bar[XB_TOPGEN]) == tg, bar);
      __builtin_amdgcn_fence(__ATOMIC_ACQUIRE, "agent");
      xb_add(&bar[XB_XGEN(b.x)], 1u);
      asm volatile("s_waitcnt vmcnt(0)" ::: "memory");
    } else {
      XB_SPIN(xb_ld(&bar[XB_XGEN(b.x)]) == gen, bar);
      __builtin_amdgcn_fence(__ATOMIC_ACQUIRE, "agent");
      asm volatile("s_waitcnt vmcnt(0)" ::: "memory");
    }
  }
  __syncthreads();
}

constexpr int SMEM_BYTES = 2 * GBUF * 2;
enum { PH_PREP0 = 0, PH_H0, PH_INPROJ, PH_PREP, PH_QKV, PH_ATT, PH_SSDOUT, PH_WOUT, PH_POSTMIX, PH_FF1, PH_FF2, PH_POSTFFN, PH_SSDNORM };

struct Ids { int bid, nb, vbid, nvb, lid; };
DI void run_phase(const Params& p, int ph, int layer, const Ids& id, char* smem, char* sh) {
  switch (ph) {
    case PH_PREP0: phase_prep0(p, id.vbid, id.nvb, sh); break;
    case PH_H0: phase_h0(p, id.vbid, id.nvb); break;
    case PH_INPROJ: phase_inproj(p, layer, id.bid, id.nb, id.vbid, id.nvb, smem, sh); break;
    case PH_PREP: phase_prep(p, layer, id.vbid, id.nvb); break;
    case PH_QKV: phase_qkv(p, layer, id.vbid, id.nvb, sh); break;
    case PH_ATT: phase_att(p, layer, id.bid, id.nb, id.vbid, id.nvb, smem, sh); break;
    case PH_SSDOUT: phase_ssdout(p, layer, id.vbid, id.nvb, sh); break;
    case PH_WOUT: phase_wout(p, layer, id.bid, id.nb, id.vbid, id.nvb, smem, sh); break;
    case PH_POSTMIX: phase_postmix(p, layer, id.vbid, id.nvb); break;
    case PH_FF1: phase_ff1(p, layer, id.bid, id.nb, id.vbid, id.nvb, smem, sh); break;
    case PH_FF2: phase_ff2(p, layer, id.bid, id.nb, id.vbid, id.nvb, smem, sh); break;
    case PH_POSTFFN: phase_postffn(p, layer, id.vbid, id.nvb); break;
  }
}

__global__ void __launch_bounds__(512) mega_kernel(Params p) {
  extern __shared__ __attribute__((aligned(16))) char smem[];
  cg::grid_group grid = cg::this_grid();
  if (p.ws == nullptr) grid.sync();
  const int half = __builtin_amdgcn_readfirstlane((int)(threadIdx.x >> 8));
  Ids id;
  id.bid = blockIdx.x; id.nb = gridDim.x;
  id.vbid = 2 * id.bid + half; id.nvb = 2 * id.nb;
  id.lid = (id.bid & 7) + 8 * (2 * (id.bid >> 3) + half);
  char* sh = smem + half * SMEM_BYTES;
  volatile LAS unsigned* st = (volatile LAS unsigned*)(smem + 2 * SMEM_BYTES - 16);
  if (threadIdx.x == 0) { st[0] = 0u; st[1] = 0u; st[2] = 0u; st[3] = 0u; }
  __syncthreads();
  XcdBarrier xb = xcd_barrier_post((unsigned*)(p.ws + OFF_BAR), st);
#define MK_STEP(PH, LAYER, LAST) do { \
    typedef const void* __attribute__((address_space(4))) * KArgs; \
    KArgs ka = (KArgs)__builtin_amdgcn_kernarg_segment_ptr(); \
    asm volatile("" : "+s"(ka)); \
    Params q; \
    { const void** dst = (const void**)&q; _Pragma("unroll") for (int i = 0; i < 27; ++i) dst[i] = ka[i]; } \
    run_phase(q, PH, LAYER, id, smem, sh); \
    if (!(LAST)) xcd_barrier(xb); } while (0)
  MK_STEP(PH_PREP0, 0, false);
  MK_STEP(PH_H0, 0, false);
  MK_STEP(PH_INPROJ, 0, false); MK_STEP(PH_PREP, 0, false); MK_STEP(PH_QKV, 0, false); MK_STEP(PH_ATT, 0, false); MK_STEP(PH_SSDOUT, 0, false);
  MK_STEP(PH_WOUT, 0, false); MK_STEP(PH_POSTMIX, 0, false); MK_STEP(PH_FF1, 0, false); MK_STEP(PH_FF2, 0, false); MK_STEP(PH_POSTFFN, 0, false);
  MK_STEP(PH_INPROJ, 1, false); MK_STEP(PH_PREP, 1, false); MK_STEP(PH_QKV, 1, false); MK_STEP(PH_ATT, 1, false); MK_STEP(PH_SSDOUT, 1, false);
  MK_STEP(PH_WOUT, 1, false); MK_STEP(PH_POSTMIX, 1, false); MK_STEP(PH_FF1, 1, false); MK_STEP(PH_FF2, 1, false); MK_STEP(PH_POSTFFN, 1, true);
#undef MK_STEP
}

extern "C" void kernel_launch(void* const* d_in, const int* in_sizes, int n_in, void* d_out, int out_size, void* d_ws, size_t ws_size,
                              hipStream_t stream) {
  if (ws_size < WS_NEED) { fprintf(stderr, "workspace too small: %zu < %zu\n", ws_size, (size_t)WS_NEED); return; }
  Params p{};
  const float** f = (const float**)&p;
  for (int i = 0; i < 25; ++i) f[i] = (const float*)d_in[i];
  p.out = (float*)d_out;
  p.ws = (char*)d_ws;
  static int grid_blocks = 0;
  if (!grid_blocks) {
    int dev = 0, cus = 0, per_cu = 0;
    hipGetDevice(&dev);
    hipDeviceGetAttribute(&cus, hipDeviceAttributeMultiprocessorCount, dev);
    hipFuncSetAttribute((const void*)mega_kernel, hipFuncAttributeMaxDynamicSharedMemorySize, 2 * SMEM_BYTES);
    hipOccupancyMaxActiveBlocksPerMultiprocessor(&per_cu, mega_kernel, 512, 2 * SMEM_BYTES);
    if (per_cu > 1) per_cu = 1;
    grid_blocks = cus * per_cu;
  }
  hipMemsetAsync((char*)d_ws + OFF_BAR, 0, XCD_BAR_WORDS * 4, stream);
  void* args[] = {&p};
  hipError_t e = hipLaunchCooperativeKernel((void*)mega_kernel, dim3(grid_blocks), dim3(512), args, 2 * SMEM_BYTES, stream);
  if (e != hipSuccess) fprintf(stderr, "cooperative launch failed: %s (grid %d)\n", hipGetErrorString(e), grid_blocks);
}
```

```cpp
#include <hip/hip_runtime.h>
#include <hip/hip_cooperative_groups.h>
#include <stdint.h>
#include <stdio.h>
namespace cg = cooperative_groups;

#ifndef MEGA
#define MEGA 1
#endif
#ifndef REP_GEMM
#define REP_GEMM 1
#endif
#ifndef REP_ATT
#define REP_ATT 1
#endif
#ifndef REP_SSD
#define REP_SSD 1
#endif

typedef unsigned short bf16_t;
using bf16x8 = __attribute__((ext_vector_type(8))) short;
using s16x4  = __attribute__((ext_vector_type(4))) short;
using f32x4  = __attribute__((ext_vector_type(4))) float;
using f32x16 = __attribute__((ext_vector_type(16))) float;
using u32x4  = __attribute__((ext_vector_type(4))) unsigned;
using u32x2  = __attribute__((ext_vector_type(2))) unsigned;
#define DI __device__ __forceinline__
#define MFMA32(a, b, c) __builtin_amdgcn_mfma_f32_32x32x16_bf16((a), (b), (c), 0, 0, 0)
#define MFMA16(a, b, c) __builtin_amdgcn_mfma_f32_16x16x32_bf16((a), (b), (c), 0, 0, 0)

constexpr int DM = 1024, NB = 4, SEQ = 4096, CTX = 256;
constexpr int ML = NB * SEQ;
constexpr int MC = NB * CTX;
constexpr int MT = ML + MC;
constexpr int DIN = 2480, DINP = 2560;
constexpr int LK = CTX + SEQ;
constexpr int DFF = 4096;
constexpr int NCH = 34;
constexpr float EPS = 1e-6f;
constexpr int U_CKV = 256, U_KR = 384, U_GB = 416, U_GC = 672, U_VAL = 928, U_Z = 1184, U_XBC = 1696, U_DT = 2464;

constexpr size_t AL(size_t x) { return (x + 255) & ~(size_t)255; }
constexpr size_t WT_IN = 0;
constexpr size_t WT_UQ = WT_IN + (size_t)DINP * 1024;
constexpr size_t WT_UKV = WT_UQ + (size_t)384 * 256;
constexpr size_t WT_OUT = WT_UKV + (size_t)512 * 128;
constexpr size_t WT_FF1 = WT_OUT + (size_t)1024 * 1024;
constexpr size_t WT_FF2 = WT_FF1 + (size_t)4096 * 1024;
constexpr size_t WT_ELEMS = WT_FF2 + (size_t)4096 * 1024;
constexpr size_t OFF_WT = 0;
constexpr size_t OFF_MOD = AL(OFF_WT + 2 * WT_ELEMS * 2);
constexpr size_t OFF_XC = AL(OFF_MOD + 2 * 5 * 6144 * 4);
constexpr size_t OFF_H = AL(OFF_XC + (size_t)MC * DM * 4);
constexpr size_t OFF_R1 = AL(OFF_H + (size_t)MT * DM * 2);
constexpr size_t OFF_U = OFF_R1;
constexpr size_t OFF_DT = AL(OFF_U + (size_t)MT * DIN * 2);
constexpr size_t OFF_RSTD = AL(OFF_DT + (size_t)MT * 16 * 4);
constexpr size_t OFF_QB = AL(OFF_RSTD + (size_t)MT * 2 * 4);
constexpr size_t OFF_KB = AL(OFF_QB + (size_t)MT * 384 * 2);
constexpr size_t OFF_VT = AL(OFF_KB + (size_t)NB * 4 * LK * 96 * 2);
constexpr size_t OFF_XBC = AL(OFF_VT + (size_t)NB * 4 * 64 * LK * 2);
constexpr size_t OFF_SST = AL(OFF_XBC + (size_t)MT * 768 * 2);
constexpr size_t OFF_TDEC = AL(OFF_SST + (size_t)2 * NB * NCH * 8 * 4096 * 2);
constexpr size_t OFF_SSQ = AL(OFF_TDEC + (size_t)2 * NB * NCH * 8 * 4);
constexpr size_t OFF_END1 = AL(OFF_SSQ + (size_t)MT * 8 * 4);
constexpr size_t OFF_F1 = OFF_R1;
constexpr size_t OFF_END2 = AL(OFF_F1 + (size_t)MT * DFF * 2);
constexpr size_t WS_NEED = (size_t)256 << 20;
constexpr size_t OFF_BAR = WS_NEED - 16384;
static_assert(OFF_END1 <= OFF_BAR && OFF_END2 + (size_t)8 * MC * DM * 4 <= OFF_BAR, "workspace layout overflows 256 MiB");

struct Params {
  const float *x, *c, *ctx, *c_ctx, *w_mod, *b_mod, *g_pre_mix, *w_in, *q_norm, *w_uq, *kv_norm, *w_ukv, *sc_w, *ssd_cw, *ssd_cb,
      *a_log, *dt_bias, *ssd_d, *ssd_norm, *w_out, *g_post_mix, *g_pre_ffn, *w_ff1, *w_ff2, *g_post_ffn;
  float* out;
  char* ws;
};

DI int ltid() { int t = threadIdx.x; asm volatile("" : "+v"(t)); return t & 255; }
DI int ltid512() { int t = threadIdx.x; asm volatile("" : "+v"(t)); return t; }
typedef __bf16 hbf2 __attribute__((ext_vector_type(2)));
typedef float hf2 __attribute__((ext_vector_type(2)));
DI bf16_t f2bf(float x) { return __builtin_bit_cast(bf16_t, (__bf16)x); }
DI float bf2f(unsigned v) { return __uint_as_float(v << 16); }
DI unsigned pack2(float a, float b) { hf2 v = {a, b}; return __builtin_bit_cast(unsigned, __builtin_convertvector(v, hbf2)); }
DI float lo2f(unsigned w) { return __uint_as_float(w << 16); }
DI float hi2f(unsigned w) { return __uint_as_float(w & 0xffff0000u); }
DI float wave_sum(float v) {
#pragma unroll
  for (int o = 32; o > 0; o >>= 1) v += __shfl_xor(v, o);
  return v;
}
DI float silu_f(float x) { return x / (1.f + __expf(-x)); }
DI int crow(int reg, int h) { return (reg & 3) + 8 * (reg >> 2) + 4 * h; }
DI bf16x8 pack8(const f32x16& x, int s) {
  u32x4 p;
  p[0] = pack2(x[8 * s + 0], x[8 * s + 1]); p[1] = pack2(x[8 * s + 2], x[8 * s + 3]);
  p[2] = pack2(x[8 * s + 4], x[8 * s + 5]); p[3] = pack2(x[8 * s + 6], x[8 * s + 7]);
  return __builtin_bit_cast(bf16x8, p);
}
DI const float* xin_row(const Params& p, int layer, int row) {
  if (layer == 0) return row < ML ? p.x + (size_t)row * DM : p.ctx + (size_t)(row - ML) * DM;
  return row < ML ? p.out + (size_t)row * DM : (const float*)(p.ws + OFF_XC) + (size_t)(row - ML) * DM;
}
DI float* xst_row(const Params& p, int row) {
  return row < ML ? p.out + (size_t)row * DM : (float*)(p.ws + OFF_XC) + (size_t)(row - ML) * DM;
}
DI const float* mod_ptr(const Params& p, int layer, int row, int which) {
  int bb = row < ML ? (row >> 12) : 4;
  return (const float*)(p.ws + OFF_MOD) + ((size_t)(layer * 5 + bb) * 6 + which) * DM;
}
DI bf16_t* wt_ptr(const Params& p, int layer, size_t off) { return (bf16_t*)(p.ws + OFF_WT) + (size_t)layer * WT_ELEMS + off; }

DI void transpose_item(const float* __restrict__ w, const float* __restrict__ gk, int gk_from, bf16_t* __restrict__ wt, int K, int N, int kt, int nt, char* smem) {
  float* tile = (float*)smem;
  const int tid = ltid(), tx = tid & 63, ty = tid >> 6;
  const int k0 = kt * 64, n0 = nt * 64;
  const int n = n0 + tx;
  float v[16];
#pragma unroll
  for (int i = 0; i < 16; ++i) {
    int kk = ty + 4 * i;
    v[i] = n < N ? w[(size_t)(k0 + kk) * N + n] : 0.f;
  }
  if (gk) {
#pragma unroll
    for (int i = 0; i < 16; ++i) { int k = k0 + ty + 4 * i; if (k >= gk_from) v[i] *= gk[k - gk_from]; }
  }
#pragma unroll
  for (int i = 0; i < 16; ++i) tile[(ty + 4 * i) * 65 + tx] = v[i];
  __syncthreads();
#pragma unroll
  for (int i = 0; i < 2; ++i) {
    int c = tid + 256 * i, nn = c >> 3, kc = c & 7;
    u32x4 o;
#pragma unroll
    for (int jj = 0; jj < 4; ++jj) o[jj] = pack2(tile[(kc * 8 + 2 * jj) * 65 + nn], tile[(kc * 8 + 2 * jj + 1) * 65 + nn]);
    *(u32x4*)(wt + (size_t)(n0 + nn) * K + k0 + kc * 8) = o;
  }
  __syncthreads();
}

DI void modgemv_item(const Params& p, int layer, int ct, char* smem) {
  float* s = (float*)smem;
  float* red = s + 5 * 1024;
  const int tid = ltid(), w = tid >> 6, lane = tid & 63, ln = lane & 31, kh = lane >> 5;
  for (int i = tid; i < 5 * 1024; i += 256) {
    int bb = i >> 10, k = i & 1023;
    float v = bb < 4 ? p.c[bb * 1024 + k] : p.c_ctx[k];
    s[i] = silu_f(v);
  }
  __syncthreads();
  const float* wm = p.w_mod + (size_t)layer * 1024 * 6144;
  const int n = ct * 32 + ln;
  float acc[5] = {0.f, 0.f, 0.f, 0.f, 0.f};
#pragma unroll 16
  for (int i = 0; i < 128; ++i) {
    const int k = w * 256 + 2 * i + kh;
    float wv = wm[(size_t)k * 6144 + n];
#pragma unroll
    for (int bb = 0; bb < 5; ++bb) acc[bb] += s[bb * 1024 + k] * wv;
  }
#pragma unroll
  for (int bb = 0; bb < 5; ++bb) {
    acc[bb] += __shfl_xor(acc[bb], 32);
    if (kh == 0) red[(w * 5 + bb) * 32 + ln] = acc[bb];
  }
  __syncthreads();
  if (tid < 160) {
    int bb = tid >> 5, l2 = tid & 31;
    float v = red[(0 * 5 + bb) * 32 + l2] + red[(1 * 5 + bb) * 32 + l2] + red[(2 * 5 + bb) * 32 + l2] + red[(3 * 5 + bb) * 32 + l2];
    int nn = ct * 32 + l2;
    v += p.b_mod[layer * 6144 + nn];
    ((float*)(p.ws + OFF_MOD))[(size_t)(layer * 5 + bb) * 6144 + nn] = v;
  }
  __syncthreads();
}

constexpr int WT_ITEMS = 2984;
DI void wt_item(const Params& p, int layer, int j, char* smem) {
  if (j < 640) transpose_item(p.w_in + (size_t)layer * 1024 * DIN, nullptr, 0, wt_ptr(p, layer, WT_IN), 1024, DIN, j / 40, j % 40, smem);
  else if ((j -= 640) < 24) transpose_item(p.w_uq + (size_t)layer * 256 * 384, p.q_norm + layer * 256, 0, wt_ptr(p, layer, WT_UQ), 256, 384, j / 6, j % 6, smem);
  else if ((j -= 24) < 16) transpose_item(p.w_ukv + (size_t)layer * 128 * 512, p.kv_norm + layer * 128, 0, wt_ptr(p, layer, WT_UKV), 128, 512, j / 8, j % 8, smem);
  else if ((j -= 16) < 256) transpose_item(p.w_out + (size_t)layer * 1024 * 1024, p.ssd_norm + layer * 512, 512, wt_ptr(p, layer, WT_OUT), 1024, 1024, j / 16, j % 16, smem);
  else if ((j -= 256) < 1024) transpose_item(p.w_ff1 + (size_t)layer * 1024 * 4096, nullptr, 0, wt_ptr(p, layer, WT_FF1), 1024, 4096, j / 64, j % 64, smem);
  else { j -= 1024; transpose_item(p.w_ff2 + (size_t)layer * 4096 * 1024, nullptr, 0, wt_ptr(p, layer, WT_FF2), 4096, 1024, j / 16, j % 16, smem); }
}
DI void phase_prep0(const Params& p, int bid, int nb, char* smem) {
  for (int it = bid; it < 384 + 640; it += nb) {
    if (it < 384) modgemv_item(p, it / 192, it % 192, smem);
    else wt_item(p, 0, it - 384, smem);
  }
}
struct HMod { float4 g[4], s1[4], s0[4]; };
DI void load_hmod(HMod& m, const float* g, const float* sh, const float* sc, int lane) {
#pragma unroll
  for (int i = 0; i < 4; ++i) {
    const int col = lane * 4 + 256 * i;
    m.g[i] = *(const float4*)(g + col); m.s1[i] = *(const float4*)(sc + col); m.s0[i] = *(const float4*)(sh + col);
  }
}
DI void write_h_row(const float4 xv[4], float rstd, const HMod& m, bf16_t* hrow, int lane) {
#pragma unroll
  for (int i = 0; i < 4; ++i) {
    const int col = lane * 4 + 256 * i;
    float a = xv[i].x * rstd * m.g[i].x * (1.f + m.s1[i].x) + m.s0[i].x;
    float b = xv[i].y * rstd * m.g[i].y * (1.f + m.s1[i].y) + m.s0[i].y;
    float c = xv[i].z * rstd * m.g[i].z * (1.f + m.s1[i].z) + m.s0[i].z;
    float d = xv[i].w * rstd * m.g[i].w * (1.f + m.s1[i].w) + m.s0[i].w;
    u32x2 o; o[0] = pack2(a, b); o[1] = pack2(c, d);
    *(u32x2*)(hrow + col) = o;
  }
}
DI float ssq4(const float4 v[4]) {
  float s = 0.f;
#pragma unroll
  for (int i = 0; i < 4; ++i) s += v[i].x * v[i].x + v[i].y * v[i].y + v[i].z * v[i].z + v[i].w * v[i].w;
  return s;
}
DI void load_bf_row(const bf16_t* r, int lane, float4 v[4]) {
#pragma unroll
  for (int i = 0; i < 4; ++i) {
    u32x2 t = *(const u32x2*)(r + lane * 4 + 256 * i);
    v[i] = make_float4(lo2f(t[0]), hi2f(t[0]), lo2f(t[1]), hi2f(t[1]));
  }
}

struct RowVec { float4 c1[4], c2[4], c3[4]; };
DI const float* mod_ptr_b(const Params& p, int layer, int bb, int which) {
  return (const float*)(p.ws + OFF_MOD) + ((size_t)(layer * 5 + bb) * 6 + which) * DM;
}
template <int MODE>
DI void rowwise_phase(const Params& p, int layer, int bid, int nb) {
  const int w = ltid() >> 6, lane = ltid() & 63;
  const int M = (MODE == 0 || layer == 0) ? MT : ML;
  const bool wh = MODE != 2 || layer == 0;
  bf16_t* H = (bf16_t*)(p.ws + OFF_H);
  const bf16_t* Y = MODE == 1 ? (const bf16_t*)(p.ws + OFF_U) : (const bf16_t*)(p.ws + OFF_H);
  const int NW = nb * 4, W = bid * 4 + w, nwb = NW >> 2;
  auto load_vec = [&](RowVec& v, int bb) {
    const float* gate = MODE == 1 ? mod_ptr_b(p, layer, bb, 2) : mod_ptr_b(p, layer, bb, 5);
    const float* gres = MODE == 1 ? p.g_post_mix + layer * DM : p.g_post_ffn + layer * DM;
    const int hl = MODE == 2 ? 1 : layer;
    const float* gn = MODE == 1 ? p.g_pre_ffn + layer * DM : p.g_pre_mix + hl * DM;
    const float* sh = mod_ptr_b(p, hl, bb, MODE == 1 ? 3 : 0);
    const float* sc = mod_ptr_b(p, hl, bb, MODE == 1 ? 4 : 1);
#pragma unroll
    for (int i = 0; i < 4; ++i) {
      const int col = lane * 4 + 256 * i;
      if (MODE != 0) {
        const float4 a = *(const float4*)(gate + col), b = *(const float4*)(gres + col);
        v.c1[i] = make_float4(a.x * b.x, a.y * b.y, a.z * b.z, a.w * b.w);
      }
      if (wh) {
        const float4 g = *(const float4*)(gn + col), s1 = *(const float4*)(sc + col);
        v.c2[i] = make_float4(g.x * (1.f + s1.x), g.y * (1.f + s1.y), g.z * (1.f + s1.z), g.w * (1.f + s1.w));
        v.c3[i] = *(const float4*)(sh + col);
      }
    }
  };
  struct RowIn { u32x2 y[4]; float4 x[4]; };
  auto load_row = [&](RowIn& r, int row) {
    const float* xr = MODE == 2 ? (const float*)xst_row(p, row) : xin_row(p, layer, row);
#pragma unroll
    for (int i = 0; i < 4; ++i) {
      r.x[i] = *(const float4*)(xr + lane * 4 + 256 * i);
      if (MODE != 0) r.y[i] = *(const u32x2*)(Y + (size_t)row * DM + lane * 4 + 256 * i);
    }
  };
  auto finish = [&](float4 (&xv)[4], const float4 (&yv)[4], const RowVec& v, int row) {
    if (MODE != 0) {
      const float rstd = rsqrtf(wave_sum(ssq4(yv)) * (1.f / DM) + EPS);
#pragma unroll
      for (int i = 0; i < 4; ++i) {
        xv[i].x += yv[i].x * rstd * v.c1[i].x; xv[i].y += yv[i].y * rstd * v.c1[i].y;
        xv[i].z += yv[i].z * rstd * v.c1[i].z; xv[i].w += yv[i].w * rstd * v.c1[i].w;
      }
      float* xo = xst_row(p, row);
#pragma unroll
      for (int i = 0; i < 4; ++i) *(float4*)(xo + lane * 4 + 256 * i) = xv[i];
    }
    if (wh) {
      const float rstd1 = rsqrtf(wave_sum(ssq4(xv)) * (1.f / DM) + EPS);
      bf16_t* hrow = H + (size_t)row * DM;
#pragma unroll
      for (int i = 0; i < 4; ++i) {
        u32x2 o;
        o[0] = pack2(xv[i].x * rstd1 * v.c2[i].x + v.c3[i].x, xv[i].y * rstd1 * v.c2[i].y + v.c3[i].y);
        o[1] = pack2(xv[i].z * rstd1 * v.c2[i].z + v.c3[i].z, xv[i].w * rstd1 * v.c2[i].w + v.c3[i].w);
        *(u32x2*)(hrow + lane * 4 + 256 * i) = o;
      }
    }
  };
  auto process = [&](RowIn& r, const RowVec& v, int row) {
    float4 yv[4];
#pragma unroll
    for (int i = 0; i < 4; ++i) yv[i] = make_float4(lo2f(r.y[i][0]), hi2f(r.y[i][0]), lo2f(r.y[i][1]), hi2f(r.y[i][1]));
    finish(r.x, yv, v, row);
  };
  RowVec v;
  {
    const int bb = W / nwb, j = W - bb * nwb, end = SEQ * (bb + 1);
    load_vec(v, bb);
    RowIn ra, rb;
    int row = SEQ * bb + j;
    if (row < end) load_row(ra, row);
    while (row < end) {
      const int rowb = row + nwb;
      const bool hb = rowb < end;
      if (hb) load_row(rb, rowb);
      process(ra, v, row);
      if (!hb) break;
      const int rowa = rowb + nwb;
      const bool ha = rowa < end;
      if (ha) load_row(ra, rowa);
      process(rb, v, rowb);
      if (!ha) break;
      row = rowa;
    }
  }
  if (M > ML) {
    load_vec(v, 4);
    for (int row = ML + W; row < M; row += NW) {
      float4 xv[4], yv[4];
      const float* xr = MODE == 2 ? (const float*)xst_row(p, row) : xin_row(p, layer, row);
#pragma unroll
      for (int i = 0; i < 4; ++i) xv[i] = *(const float4*)(xr + lane * 4 + 256 * i);
      if (MODE != 0) {
        const float* pp = (const float*)(p.ws + (MODE == 1 ? OFF_QB : OFF_END2)) + (size_t)(row - ML) * DM;
#pragma unroll
        for (int i = 0; i < 4; ++i) {
          float4 a = *(const float4*)(pp + lane * 4 + 256 * i), b = *(const float4*)(pp + (size_t)MC * DM + lane * 4 + 256 * i);
          float4 c = *(const float4*)(pp + (size_t)2 * MC * DM + lane * 4 + 256 * i), d = *(const float4*)(pp + (size_t)3 * MC * DM + lane * 4 + 256 * i);
          yv[i] = make_float4((a.x + b.x) + (c.x + d.x), (a.y + b.y) + (c.y + d.y), (a.z + b.z) + (c.z + d.z), (a.w + b.w) + (c.w + d.w));
          if (MODE != 0) {
            const float* p2 = pp + (size_t)4 * MC * DM;
            float4 e = *(const float4*)(p2 + lane * 4 + 256 * i), f = *(const float4*)(p2 + (size_t)MC * DM + lane * 4 + 256 * i);
            float4 g = *(const float4*)(p2 + (size_t)2 * MC * DM + lane * 4 + 256 * i), h = *(const float4*)(p2 + (size_t)3 * MC * DM + lane * 4 + 256 * i);
            yv[i].x += (e.x + f.x) + (g.x + h.x); yv[i].y += (e.y + f.y) + (g.y + h.y);
            yv[i].z += (e.z + f.z) + (g.z + h.z); yv[i].w += (e.w + f.w) + (g.w + h.w);
          }
        }
      }
      finish(xv, yv, v, row);
    }
  }
}
DI void phase_h0(const Params& p, int bid, int nb) { rowwise_phase<0>(p, 0, bid, nb); }
DI void phase_postmix(const Params& p, int layer, int bid, int nb) { rowwise_phase<1>(p, layer, bid, nb); }
DI void phase_postffn(const Params& p, int layer, int bid, int nb) { rowwise_phase<2>(p, layer, bid, nb); }

DI void phase_prep(const Params& p, int layer, int bid, int nb) {
  const int w = ltid() >> 6, lane = ltid() & 63;
  const bf16_t* U = (const bf16_t*)(p.ws + OFF_U);
  float* DT = (float*)(p.ws + OFF_DT);
  float* RS = (float*)(p.ws + OFF_RSTD);
  bf16_t* KB = (bf16_t*)(p.ws + OFF_KB);
  bf16_t* XBC = (bf16_t*)(p.ws + OFF_XBC);
  bf16_t* YM = (bf16_t*)(p.ws + OFF_H);
  const float* scw = p.sc_w + layer * 3 * 256;
  const float* cw = p.ssd_cw + layer * 3 * 768;
  const float* cb = p.ssd_cb + layer * 768;
  const int c4 = lane * 4;
  const float4 sw0 = *(const float4*)(scw + c4), sw1 = *(const float4*)(scw + 256 + c4), sw2 = *(const float4*)(scw + 512 + c4);
  float4 cwk[3][3], cbi[3];
#pragma unroll
  for (int i = 0; i < 3; ++i) {
    cbi[i] = *(const float4*)(cb + c4 + 256 * i);
#pragma unroll
    for (int k = 0; k < 3; ++k) cwk[i][k] = *(const float4*)(cw + k * 768 + c4 + 256 * i);
  }
  const float dtb = p.dt_bias[layer * 16 + (lane & 15)];
  const float invf = exp2f(-(float)(2 * (lane & 7)) * (13.287712379549449f / 16.f));
  for (int row = bid * 4 + w; row < MT; row += nb * 4) {
    int b, t, L, pos;
    const bool lat = row < ML;
    if (lat) { b = row >> 12; t = row & 4095; L = SEQ; pos = t + CTX; }
    else { int rr = row - ML; b = rr >> 8; t = rr & 255; L = CTX; pos = t; }
    const bf16_t* u0 = U + (size_t)row * DIN;
    const bool hp = t > 0, hn = t < L - 1;
    const bf16_t* um = hp ? u0 - DIN : u0;
    const bf16_t* up = hn ? u0 + DIN : u0;
    const float mp = hp ? 1.f : 0.f, mn = hn ? 1.f : 0.f;
    const u32x2 vq = *(const u32x2*)(u0 + c4);
    const u32x2 vkv = *(const u32x2*)(u0 + U_CKV + (lane & 31) * 4);
    const float kr = bf2f(u0[U_KR + (lane & 31)]);
    const u32x2 gcm = *(const u32x2*)(um + U_GC + c4), gc0 = *(const u32x2*)(u0 + U_GC + c4), gcp = *(const u32x2*)(up + U_GC + c4);
    const u32x2 vvm = *(const u32x2*)(um + U_VAL + c4), vv0 = *(const u32x2*)(u0 + U_VAL + c4), vvp = *(const u32x2*)(up + U_VAL + c4);
    const u32x2 gb = *(const u32x2*)(u0 + U_GB + c4);
    u32x2 xm[3], x0[3], xp[3];
#pragma unroll
    for (int i = 0; i < 3; ++i) {
      xm[i] = *(const u32x2*)(um + U_XBC + c4 + 256 * i);
      x0[i] = *(const u32x2*)(u0 + U_XBC + c4 + 256 * i);
      xp[i] = *(const u32x2*)(up + U_XBC + c4 + 256 * i);
    }
    const float dtr = DT[(size_t)row * 16 + (lane & 15)];
    {
      float a = lo2f(vq[0]), bq = hi2f(vq[0]), c = lo2f(vq[1]), d = hi2f(vq[1]);
      float ss = wave_sum(a * a + bq * bq + c * c + d * d);
      float e = lo2f(vkv[0]), f = hi2f(vkv[0]), g = lo2f(vkv[1]), h = hi2f(vkv[1]);
      float s2 = lane < 32 ? e * e + f * f + g * g + h * h : 0.f;
      s2 = wave_sum(s2);
      if (lane == 0) { RS[row * 2] = rsqrtf(ss * (1.f / 256) + EPS); RS[row * 2 + 1] = rsqrtf(s2 * (1.f / 128) + EPS); }
    }
    {
      const float partner = __shfl_xor(kr, 8);
      float o = kr;
      if (lat) {
        const int grp = (lane & 31) >> 3;
        const float posf = grp < 2 ? (float)(t >> 6) : (float)(t & 63);
        const float rev = posf * invf * 0.15915494309189535f;
        const float cs = __builtin_amdgcn_cosf(rev), sn = __builtin_amdgcn_sinf(rev);
        o = (grp & 1) ? kr * cs + partner * sn : kr * cs - partner * sn;
      }
      if (lane < 32) {
        const bf16_t ob = f2bf(o);
#pragma unroll
        for (int hd = 0; hd < 4; ++hd) KB[((size_t)(b * 4 + hd) * LK + pos) * 96 + 64 + lane] = ob;
      }
    }
    {
      float a0 = sw1.x * lo2f(gc0[0]) * lo2f(vv0[0]) + mp * sw0.x * lo2f(gcm[0]) * lo2f(vvm[0]) + mn * sw2.x * lo2f(gcp[0]) * lo2f(vvp[0]);
      float a1 = sw1.y * hi2f(gc0[0]) * hi2f(vv0[0]) + mp * sw0.y * hi2f(gcm[0]) * hi2f(vvm[0]) + mn * sw2.y * hi2f(gcp[0]) * hi2f(vvp[0]);
      float a2 = sw1.z * lo2f(gc0[1]) * lo2f(vv0[1]) + mp * sw0.z * lo2f(gcm[1]) * lo2f(vvm[1]) + mn * sw2.z * lo2f(gcp[1]) * lo2f(vvp[1]);
      float a3 = sw1.w * hi2f(gc0[1]) * hi2f(vv0[1]) + mp * sw0.w * hi2f(gcm[1]) * hi2f(vvm[1]) + mn * sw2.w * hi2f(gcp[1]) * hi2f(vvp[1]);
      u32x2 o; o[0] = pack2(lo2f(gb[0]) * a0, hi2f(gb[0]) * a1); o[1] = pack2(lo2f(gb[1]) * a2, hi2f(gb[1]) * a3);
      *(u32x2*)(YM + (size_t)row * DM + 256 + c4) = o;
    }
#pragma unroll
    for (int i = 0; i < 3; ++i) {
      float a0 = cbi[i].x + cwk[i][1].x * lo2f(x0[i][0]) + mp * cwk[i][0].x * lo2f(xm[i][0]) + mn * cwk[i][2].x * lo2f(xp[i][0]);
      float a1 = cbi[i].y + cwk[i][1].y * hi2f(x0[i][0]) + mp * cwk[i][0].y * hi2f(xm[i][0]) + mn * cwk[i][2].y * hi2f(xp[i][0]);
      float a2 = cbi[i].z + cwk[i][1].z * lo2f(x0[i][1]) + mp * cwk[i][0].z * lo2f(xm[i][1]) + mn * cwk[i][2].z * lo2f(xp[i][1]);
      float a3 = cbi[i].w + cwk[i][1].w * hi2f(x0[i][1]) + mp * cwk[i][0].w * hi2f(xm[i][1]) + mn * cwk[i][2].w * hi2f(xp[i][1]);
      u32x2 o; o[0] = pack2(silu_f(a0), silu_f(a1)); o[1] = pack2(silu_f(a2), silu_f(a3));
      *(u32x2*)(XBC + (size_t)row * 768 + c4 + 256 * i) = o;
    }
    if (lane < 16) {
      const float v = dtr + dtb;
      const float e = __expf(-fabsf(v));
      DT[(size_t)row * 16 + lane] = fmaxf(v, 0.f) + (e < 1e-3f ? e * (1.f - 0.5f * e) : __logf(1.f + e));
    }
  }
}

DI void phase_ssdnorm(const Params& p, int layer, int bid, int nb) {
  const int w = ltid() >> 6, lane = ltid() & 63;
  const int M = layer == 0 ? MT : ML;
  bf16_t* YM = (bf16_t*)(p.ws + OFF_H);
  const float* SSQ = (const float*)(p.ws + OFF_SSQ);
  const float* ng = p.ssd_norm + layer * 512;
  for (int row = bid * 4 + w; row < M; row += nb * 4) {
    int g = lane >> 5;
    float4 s = *(const float4*)(SSQ + (size_t)row * 8 + g * 4);
    float rstd = rsqrtf((s.x + s.y + s.z + s.w) * (1.f / 256) + EPS);
    bf16_t* ptr = YM + (size_t)row * DM + 512 + lane * 8;
    u32x4 v = *(const u32x4*)ptr;
    float4 g0 = *(const float4*)(ng + lane * 8), g1 = *(const float4*)(ng + lane * 8 + 4);
    u32x4 o;
    o[0] = pack2(lo2f(v[0]) * rstd * g0.x, hi2f(v[0]) * rstd * g0.y);
    o[1] = pack2(lo2f(v[1]) * rstd * g0.z, hi2f(v[1]) * rstd * g0.w);
    o[2] = pack2(lo2f(v[2]) * rstd * g1.x, hi2f(v[2]) * rstd * g1.y);
    o[3] = pack2(lo2f(v[3]) * rstd * g1.z, hi2f(v[3]) * rstd * g1.w);
    *(u32x4*)ptr = o;
  }
}

constexpr int GST = 80;
constexpr int GBUF = 2 * 128 * GST;
template <bool GN, class Epi>
DI void gemm_tile(const bf16_t* __restrict__ A, int lda, const bf16_t* __restrict__ Bt, int K, int row0, int col0, char* smem, Epi epi, const float* __restrict__ ssq = nullptr) {
  bf16_t* S0 = (bf16_t*)smem;
  const int tid = ltid(), wid = tid >> 6, lane = tid & 63, wr = wid >> 1, wc = wid & 1, fr = lane & 15, fq = lane >> 4;
  f32x4 acc[4][4];
#pragma unroll
  for (int m = 0; m < 4; ++m)
#pragma unroll
    for (int n = 0; n < 4; ++n) acc[m][n] = f32x4{0.f, 0.f, 0.f, 0.f};
  u32x4 ra[4], rb[4];
  const int sr = tid >> 3, sp = tid & 7;
  const bf16_t* ga = A + (size_t)(row0 + sr) * lda + sp * 8;
  const bf16_t* gb = Bt + (size_t)(col0 + sr) * K + sp * 8;
  auto gload = [&](int k0) {
#pragma unroll
    for (int i = 0; i < 4; ++i) {
      ra[i] = *(const u32x4*)(ga + (size_t)(32 * i) * lda + k0);
      rb[i] = *(const u32x4*)(gb + (size_t)(32 * i) * K + k0);
    }
  };
  gload(0);
  float gs[4][2];
  if (GN) {
#pragma unroll
    for (int i = 0; i < 4; ++i) {
      const float4 s0 = *(const float4*)(ssq + (size_t)(row0 + sr + 32 * i) * 8), s1 = *(const float4*)(ssq + (size_t)(row0 + sr + 32 * i) * 8 + 4);
      gs[i][0] = rsqrtf((s0.x + s0.y + s0.z + s0.w) * (1.f / 256) + EPS);
      gs[i][1] = rsqrtf((s1.x + s1.y + s1.z + s1.w) * (1.f / 256) + EPS);
    }
  }
  auto swrite = [&](int kt) {
    if (GN && kt >= 8) {
      const int g = (kt - 8) >> 2;
#pragma unroll
      for (int i = 0; i < 4; ++i) {
        const float sc = g ? gs[i][1] : gs[i][0];
#pragma unroll
        for (int jj = 0; jj < 4; ++jj) ra[i][jj] = pack2(lo2f(ra[i][jj]) * sc, hi2f(ra[i][jj]) * sc);
      }
    }
    bf16_t* As = S0 + (kt & 1) * GBUF;
    bf16_t* Bs = As + 128 * GST;
#pragma unroll
    for (int i = 0; i < 4; ++i) {
      *(u32x4*)(As + (sr + 32 * i) * GST + sp * 8) = ra[i];
      *(u32x4*)(Bs + (sr + 32 * i) * GST + sp * 8) = rb[i];
    }
  };
  const int KT = K / 64;
  swrite(0);
  if (KT > 1) gload(64);
  __syncthreads();
  for (int kt = 0; kt < KT; ++kt) {
    const bf16_t* As = S0 + (kt & 1) * GBUF;
    const bf16_t* Bs = As + 128 * GST;
#pragma unroll
    for (int ks = 0; ks < 2; ++ks) {
      bf16x8 af[4], bfr[4];
#pragma unroll
      for (int m = 0; m < 4; ++m) af[m] = *(const bf16x8*)(As + (wr * 64 + m * 16 + fr) * GST + ks * 32 + fq * 8);
#pragma unroll
      for (int n = 0; n < 4; ++n) bfr[n] = *(const bf16x8*)(Bs + (wc * 64 + n * 16 + fr) * GST + ks * 32 + fq * 8);
#pragma unroll
      for (int m = 0; m < 4; ++m)
#pragma unroll
        for (int n = 0; n < 4; ++n) acc[m][n] = MFMA16(bfr[n], af[m], acc[m][n]);
      if (ks == 0 && kt + 1 < KT) {
        swrite(kt + 1);
        if (kt + 2 < KT) gload((kt + 2) * 64);
      }
    }
    __syncthreads();
  }
  float rsc[4];
#pragma unroll
  for (int m = 0; m < 4; ++m) rsc[m] = epi.scale(row0 + wr * 64 + m * 16 + fr);
#pragma unroll
  for (int m = 0; m < 4; ++m)
#pragma unroll
    for (int n = 0; n < 4; ++n) epi(row0 + wr * 64 + m * 16 + fr, col0 + wc * 64 + n * 16 + fq * 4, acc[m][n], rsc[m]);
}

template <int MR = 4, class Epi>
DI void gemm_tile_glds(const bf16_t* __restrict__ A, int lda, const bf16_t* __restrict__ Bt, int ldb, int K, int row0, int col0, char* smem, Epi epi) {
  const int tid = ltid(), wid = tid >> 6, lane = tid & 63, wr = wid >> 1, wc = wid & 1, fr = lane & 15, fq = lane >> 4;
  f32x4 acc[MR][4];
#pragma unroll
  for (int m = 0; m < MR; ++m)
#pragma unroll
    for (int n = 0; n < 4; ++n) acc[m][n] = f32x4{0.f, 0.f, 0.f, 0.f};
  const int crow = tid >> 3, cslot = tid & 7, cpart = cslot ^ (crow & 7);
  const bf16_t* ga = A + (size_t)(row0 + crow) * lda + cpart * 8;
  const bf16_t* gb = Bt + (size_t)(col0 + crow) * ldb + cpart * 8;
  auto issue = [&](int kt, int stage) {
    char* sa = smem + stage * 32768 + tid * 16;
#pragma unroll
    for (int i = 0; i < MR; ++i)
      __builtin_amdgcn_global_load_lds((const unsigned*)(ga + (size_t)(32 * i) * lda + kt * 64), (__attribute__((address_space(3))) unsigned*)(sa + i * 4096), 16, 0, 0);
#pragma unroll
    for (int i = 0; i < 4; ++i)
      __builtin_amdgcn_global_load_lds((const unsigned*)(gb + (size_t)(32 * i) * ldb + kt * 64), (__attribute__((address_space(3))) unsigned*)(sa + 16384 + i * 4096), 16, 0, 0);
  };
  const int KT = K / 64;
  issue(0, 0);
  asm volatile("s_waitcnt vmcnt(0)" ::: "memory");
  __syncthreads();
  const int sw = fr & 7;
  for (int kt = 0; kt < KT; ++kt) {
    if (kt + 1 < KT) issue(kt + 1, (kt + 1) & 1);
    const char* As = smem + (kt & 1) * 32768;
    const char* Bs = As + 16384;
#pragma unroll
    for (int ks = 0; ks < 2; ++ks) {
      bf16x8 af[MR], bfr[4];
      const int so = ((ks * 4 + fq) ^ sw) * 16;
#pragma unroll
      for (int m = 0; m < MR; ++m) af[m] = *(const bf16x8*)(As + (wr * 16 * MR + m * 16 + fr) * 128 + so);
#pragma unroll
      for (int n = 0; n < 4; ++n) bfr[n] = *(const bf16x8*)(Bs + (wc * 64 + n * 16 + fr) * 128 + so);
#pragma unroll
      for (int m = 0; m < MR; ++m)
#pragma unroll
        for (int n = 0; n < 4; ++n) acc[m][n] = MFMA16(bfr[n], af[m], acc[m][n]);
    }
    asm volatile("s_waitcnt vmcnt(0)" ::: "memory");
    __syncthreads();
  }
  float rsc[MR];
#pragma unroll
  for (int m = 0; m < MR; ++m) rsc[m] = epi.scale(row0 + wr * 16 * MR + m * 16 + fr);
#pragma unroll
  for (int m = 0; m < MR; ++m)
#pragma unroll
    for (int n = 0; n < 4; ++n) epi(row0 + wr * 16 * MR + m * 16 + fr, col0 + wc * 64 + n * 16 + fq * 4, acc[m][n], rsc[m]);
}

constexpr int G8_HT = 128 * 64;
DI int g8_lds_byte(int r, int c) {
  int st = (r >> 4) * 2 + (c >> 5), rr = r & 15, cc = c & 31, ob = rr * 64 + cc * 2;
  return st * 1024 + (ob ^ (((ob >> 9) & 1) << 5));
}
DI void g8_stage_rc(int b, int& R, int& C) {
  int st = b / 1024, sb = b % 1024, swz = sb ^ (((sb >> 9) & 1) << 5);
  R = (st >> 1) * 16 + swz / 64; C = (st & 1) * 32 + (swz % 64) / 2;
}
template <bool GN = false, class Epi>
DI void gemm8_tile(const bf16_t* __restrict__ A, int lda, const bf16_t* __restrict__ Bt, int ldb, int K, int brow, int bcol, char* smem, Epi epi,
                   bool first = true, bool has_next = false, int nbrow = 0, int nbcol = 0, const float* __restrict__ ssq = nullptr) {
  bf16_t* shm = (bf16_t*)smem;
  const int tid = ltid512();
  float* gsl = (float*)(smem + 8 * G8_HT * 2);
  if (GN) {
    if (tid < 256) {
      const float* sp = ssq + (size_t)(brow + tid) * 8;
      const float4 s0 = *(const float4*)sp, s1 = *(const float4*)(sp + 4);
      gsl[tid] = rsqrtf((s0.x + s0.y + s0.z + s0.w) * (1.f / 256) + EPS);
      gsl[256 + tid] = rsqrtf((s1.x + s1.y + s1.z + s1.w) * (1.f / 256) + EPS);
    }
    __syncthreads();
  }
#define G8_SA(b, h) (shm + ((b) * 2 + (h)) * G8_HT)
#define G8_SB(b, h) (shm + (4 + (b) * 2 + (h)) * G8_HT)
#define G8_STAGE(P, BASE, LD, br, kt) do { const bf16_t* _g = (BASE) + (size_t)(br) * (LD) + (size_t)(kt) * 64; \
    _Pragma("unroll") for (int _i = 0; _i < 2; ++_i) { int _b = tid * 16 + _i * 8192; int _r, _c; g8_stage_rc(_b, _r, _c); \
      __builtin_amdgcn_global_load_lds((const unsigned*)(_g + (size_t)_r * (LD) + _c), \
        (__attribute__((address_space(3))) unsigned*)((char*)(P) + _b), 16, 0, 0); } } while (0)
#define G8_LDA(dst, b, h) _Pragma("unroll") for (int m = 0; m < 4; ++m) _Pragma("unroll") for (int k = 0; k < 2; ++k) \
    dst[m][k] = *reinterpret_cast<const bf16x8*>((char*)G8_SA(b, h) + g8_lds_byte(wr * 64 + m * 16 + fr, k * 32 + fq * 8))
#define G8_LDB(dst, b, h) _Pragma("unroll") for (int n = 0; n < 2; ++n) _Pragma("unroll") for (int k = 0; k < 2; ++k) \
    dst[n][k] = *reinterpret_cast<const bf16x8*>((char*)G8_SB(b, h) + g8_lds_byte(wc * 32 + n * 16 + fr, k * 32 + fq * 8))
#define G8_MMA(ai, bj, At, Bx) do { __builtin_amdgcn_s_setprio(1); \
    _Pragma("unroll") for (int m = 0; m < 4; ++m) _Pragma("unroll") for (int n = 0; n < 2; ++n) _Pragma("unroll") for (int k = 0; k < 2; ++k) \
      acc[ai][bj][m][n] = __builtin_amdgcn_mfma_f32_16x16x32_bf16(Bx[n][k], At[m][k], acc[ai][bj][m][n], 0, 0, 0); \
    __builtin_amdgcn_s_setprio(0); } while (0)
#define G8_WAIT_V(n) asm volatile("s_waitcnt vmcnt(" #n ")" ::: "memory")
#define G8_WAIT_L(n) asm volatile("s_waitcnt lgkmcnt(" #n ")" ::: "memory")
#define G8_BAR __builtin_amdgcn_s_barrier()
#define G8_SCHED __builtin_amdgcn_sched_barrier(0)
  const int wid = tid >> 6, lane = tid & 63, wr = wid >> 2, wc = wid & 3, fr = lane & 15, fq = lane >> 4;
  f32x4 acc[2][2][4][2];
#pragma unroll
  for (int a = 0; a < 2; ++a)
#pragma unroll
    for (int b = 0; b < 2; ++b)
#pragma unroll
      for (int m = 0; m < 4; ++m)
#pragma unroll
        for (int n = 0; n < 2; ++n) acc[a][b][m][n] = f32x4{0.f, 0.f, 0.f, 0.f};
  bf16x8 At[4][2], B0[2][2], B1[2][2];
  const int nt = K / 64;
  if (first) {
    G8_STAGE(G8_SB(0, 0), Bt, ldb, bcol, 0); G8_STAGE(G8_SA(0, 0), A, lda, brow, 0);
    G8_STAGE(G8_SB(0, 1), Bt, ldb, bcol + 128, 0); G8_STAGE(G8_SA(0, 1), A, lda, brow + 128, 0);
  }
  if (wr == 1) G8_BAR;
  if (first) G8_WAIT_V(4); else G8_WAIT_V(0);
  G8_BAR;
  G8_STAGE(G8_SB(1, 0), Bt, ldb, bcol, 1); G8_STAGE(G8_SA(1, 0), A, lda, brow, 1); G8_STAGE(G8_SB(1, 1), Bt, ldb, bcol + 128, 1);
  G8_WAIT_V(6); G8_BAR;
  for (int t = 0; t < nt - 2; t += 2) {
    if (GN && (t == 8 || t == 12)) {
#pragma unroll
      for (int ai = 0; ai < 2; ++ai)
#pragma unroll
        for (int m = 0; m < 4; ++m) {
          const int rl = ai * 128 + wr * 64 + m * 16 + fr;
          const float f = t == 8 ? 1.f / gsl[rl] : gsl[rl] / gsl[256 + rl];
#pragma unroll
          for (int bj = 0; bj < 2; ++bj)
#pragma unroll
            for (int n = 0; n < 2; ++n) acc[ai][bj][m][n] *= f;
        }
    }
    G8_LDB(B0, 0, 0); G8_SCHED; G8_LDA(At, 0, 0); G8_STAGE(G8_SA(1, 1), A, lda, brow + 128, t + 1);
    G8_WAIT_L(8); G8_BAR; G8_WAIT_L(0); G8_MMA(0, 0, At, B0); G8_BAR; G8_SCHED;
    G8_LDB(B1, 0, 1); G8_STAGE(G8_SB(0, 0), Bt, ldb, bcol, t + 2);
    G8_BAR; G8_WAIT_L(0); G8_MMA(0, 1, At, B1); G8_BAR;
    G8_LDA(At, 0, 1); G8_STAGE(G8_SA(0, 0), A, lda, brow, t + 2);
    G8_BAR; G8_WAIT_L(0); G8_MMA(1, 0, At, B0); G8_BAR; G8_SCHED;
    G8_STAGE(G8_SB(0, 1), Bt, ldb, bcol + 128, t + 2);
    G8_WAIT_V(6); G8_BAR; G8_MMA(1, 1, At, B1); G8_BAR;
    G8_LDB(B0, 1, 0); G8_SCHED; G8_LDA(At, 1, 0); G8_STAGE(G8_SA(0, 1), A, lda, brow + 128, t + 2);
    G8_WAIT_L(8); G8_BAR; G8_WAIT_L(0); G8_MMA(0, 0, At, B0); G8_BAR; G8_SCHED;
    G8_LDB(B1, 1, 1); G8_STAGE(G8_SB(1, 0), Bt, ldb, bcol, t + 3);
    G8_BAR; G8_WAIT_L(0); G8_MMA(0, 1, At, B1); G8_BAR;
    G8_LDA(At, 1, 1); G8_STAGE(G8_SA(1, 0), A, lda, brow, t + 3);
    G8_BAR; G8_WAIT_L(0); G8_MMA(1, 0, At, B0); G8_BAR; G8_SCHED;
    G8_STAGE(G8_SB(1, 1), Bt, ldb, bcol + 128, t + 3);
    G8_WAIT_V(6); G8_BAR; G8_MMA(1, 1, At, B1); G8_BAR;
  }
  { G8_LDB(B0, 0, 0); G8_LDA(At, 0, 0); G8_STAGE(G8_SA(1, 1), A, lda, brow + 128, nt - 1);
    G8_BAR; G8_WAIT_L(0); G8_MMA(0, 0, At, B0); G8_BAR;
    G8_LDB(B1, 0, 1); G8_BAR; G8_WAIT_L(0); G8_MMA(0, 1, At, B1); G8_BAR;
    G8_LDA(At, 0, 1); G8_WAIT_V(4); G8_BAR; G8_WAIT_L(0); G8_MMA(1, 0, At, B0); G8_MMA(1, 1, At, B1); G8_BAR; }
  { G8_LDB(B0, 1, 0); G8_LDA(At, 1, 0); G8_WAIT_V(2); G8_BAR; G8_WAIT_L(0); G8_MMA(0, 0, At, B0); G8_BAR;
    G8_LDB(B1, 1, 1); G8_WAIT_V(0); G8_BAR; G8_WAIT_L(0); G8_MMA(0, 1, At, B1); G8_BAR;
    G8_LDA(At, 1, 1); G8_BAR; G8_WAIT_L(0); G8_MMA(1, 0, At, B0); G8_MMA(1, 1, At, B1); G8_BAR; }
  if (GN) {
#pragma unroll
    for (int ai = 0; ai < 2; ++ai)
#pragma unroll
      for (int m = 0; m < 4; ++m) {
        const float f = gsl[256 + ai * 128 + wr * 64 + m * 16 + fr];
#pragma unroll
        for (int bj = 0; bj < 2; ++bj)
#pragma unroll
          for (int n = 0; n < 2; ++n) acc[ai][bj][m][n] *= f;
      }
  }
  if (has_next) {
    G8_STAGE(G8_SB(0, 0), Bt, ldb, nbcol, 0); G8_STAGE(G8_SA(0, 0), A, lda, nbrow, 0);
    G8_STAGE(G8_SB(0, 1), Bt, ldb, nbcol + 128, 0); G8_STAGE(G8_SA(0, 1), A, lda, nbrow + 128, 0);
  }
  if (wr == 0) G8_BAR;
  const bool odd = fq & 1;
#pragma unroll
  for (int ai = 0; ai < 2; ++ai)
#pragma unroll
    for (int bj = 0; bj < 2; ++bj)
#pragma unroll
      for (int m = 0; m < 4; ++m) {
        const int row = brow + ai * 128 + wr * 64 + m * 16 + fr, cb = bcol + bj * 128 + wc * 32;
        epi.side(row, cb + fq * 4, acc[ai][bj][m][0]);
        epi.side(row, cb + 16 + fq * 4, acc[ai][bj][m][1]);
        const u32x2 p0 = epi.pack(acc[ai][bj][m][0]), p1 = epi.pack(acc[ai][bj][m][1]);
        const u32x2 snd = odd ? p0 : p1;
        u32x2 rcv; rcv[0] = (unsigned)__shfl_xor((int)snd[0], 16); rcv[1] = (unsigned)__shfl_xor((int)snd[1], 16);
        u32x4 o;
        if (odd) { o[0] = rcv[0]; o[1] = rcv[1]; o[2] = p1[0]; o[3] = p1[1]; }
        else     { o[0] = p0[0]; o[1] = p0[1]; o[2] = rcv[0]; o[3] = rcv[1]; }
        epi.store16(row, odd ? cb + 16 + (fq - 1) * 4 : cb + fq * 4, o);
      }
  __syncthreads();
}

struct EpiBF {
  bf16_t* out; int ldo;
  DI void side(int, int, const f32x4&) const {}
  DI u32x2 pack(const f32x4& a) const { u32x2 o; o[0] = pack2(a[0], a[1]); o[1] = pack2(a[2], a[3]); return o; }
  DI void store16(int row, int col, const u32x4& v) const { *(u32x4*)(out + (size_t)row * ldo + col) = v; }
  DI float scale(int) const { return 1.f; }
  DI void operator()(int row, int col, const f32x4& a, float) const { (*this)(row, col, a); }
  DI void operator()(int row, int col, const f32x4& a) const {
    u32x2 o; o[0] = pack2(a[0], a[1]); o[1] = pack2(a[2], a[3]);
    *(u32x2*)(out + (size_t)row * ldo + col) = o;
  }
};
struct EpiRelu2 {
  bf16_t* out; int ldo;
  DI float scale(int) const { return 1.f; }
  DI void operator()(int row, int col, const f32x4& a, float) const { (*this)(row, col, a); }
  DI void side(int, int, const f32x4&) const {}
  DI u32x2 pack(const f32x4& a) const {
    float r0 = fmaxf(a[0], 0.f), r1 = fmaxf(a[1], 0.f), r2 = fmaxf(a[2], 0.f), r3 = fmaxf(a[3], 0.f);
    u32x2 o; o[0] = pack2(r0 * r0, r1 * r1); o[1] = pack2(r2 * r2, r3 * r3); return o;
  }
  DI void store16(int row, int col, const u32x4& v) const { *(u32x4*)(out + (size_t)row * ldo + col) = v; }
  DI void operator()(int row, int col, const f32x4& a) const {
    float r0 = fmaxf(a[0], 0.f), r1 = fmaxf(a[1], 0.f), r2 = fmaxf(a[2], 0.f), r3 = fmaxf(a[3], 0.f);
    u32x2 o; o[0] = pack2(r0 * r0, r1 * r1); o[1] = pack2(r2 * r2, r3 * r3);
    *(u32x2*)(out + (size_t)row * ldo + col) = o;
  }
};
struct EpiU {
  bf16_t* u; float* dt;
  DI void side(int row, int col, const f32x4& a) const { if (col >= U_DT && col < DIN) *(float4*)(dt + (size_t)row * 16 + col - U_DT) = make_float4(a[0], a[1], a[2], a[3]); }
  DI u32x2 pack(const f32x4& a) const { u32x2 o; o[0] = pack2(a[0], a[1]); o[1] = pack2(a[2], a[3]); return o; }
  DI void store16(int row, int col, const u32x4& v) const { if (col < DIN) *(u32x4*)(u + (size_t)row * DIN + col) = v; }
  DI void operator()(int row, int col, const f32x4& a) const {
    if (col < DIN) {
      u32x2 o; o[0] = pack2(a[0], a[1]); o[1] = pack2(a[2], a[3]);
      *(u32x2*)(u + (size_t)row * DIN + col) = o;
      if (col >= U_DT) *(float4*)(dt + (size_t)row * 16 + col - U_DT) = make_float4(a[0], a[1], a[2], a[3]);
    }
  }
};
struct EpiQ {
  bf16_t* q; const float* rs;
  DI float scale(int row) const { return rs[row * 2]; }
  DI void operator()(int row, int col, const f32x4& a, float r) const {
    u32x2 o; o[0] = pack2(a[0] * r, a[1] * r); o[1] = pack2(a[2] * r, a[3] * r);
    *(u32x2*)(q + (size_t)row * 384 + col) = o;
  }
};
struct EpiKV {
  bf16_t* kb; bf16_t* vt; const float* rs;
  DI float scale(int row) const { return rs[row * 2 + 1]; }
  DI void operator()(int row, int col, const f32x4& a, float r) const {
    int b, pos;
    if (row < ML) { b = row >> 12; pos = (row & 4095) + CTX; } else { int rr = row - ML; b = rr >> 8; pos = rr & 255; }
    const int head = col >> 7, d = col & 127;
    if (d < 64) {
      u32x2 o; o[0] = pack2(a[0] * r, a[1] * r); o[1] = pack2(a[2] * r, a[3] * r);
      *(u32x2*)(kb + ((size_t)(b * 4 + head) * LK + pos) * 96 + d) = o;
    } else {
#pragma unroll
      for (int j = 0; j < 4; ++j) vt[((size_t)(b * 4 + head) * 64 + (d - 64 + j)) * LK + pos] = f2bf(a[j] * r);
    }
  }
};

struct EpiPartS {
  float* part; const float* ssq; int g;
  DI float scale(int row) const {
    if (g < 0) return 1.f;
    const float4 sq = *(const float4*)(ssq + (size_t)row * 8 + g * 4);
    return rsqrtf((sq.x + sq.y + sq.z + sq.w) * (1.f / 256) + EPS);
  }
  DI void operator()(int row, int col, const f32x4& a, float r) const {
    *(float4*)(part + (size_t)(row - ML) * DM + col) = make_float4(a[0] * r, a[1] * r, a[2] * r, a[3] * r);
  }
};
struct EpiPart {
  float* part;
  DI float scale(int) const { return 1.f; }
  DI void operator()(int row, int col, const f32x4& a, float) const { (*this)(row, col, a); }
  DI void operator()(int row, int col, const f32x4& a) const {
    *(float4*)(part + (size_t)(row - ML) * DM + col) = make_float4(a[0], a[1], a[2], a[3]);
  }
};
DI void phase_inproj(const Params& p, int layer, int bid, int nb, int vbid, int nvb, char* smem, char* smem_half) {
  EpiU epi{(bf16_t*)(p.ws + OFF_U), (float*)(p.ws + OFF_DT)};
  const int x = bid & 7, per = nb >> 3;
  for (int rep = 0; rep < REP_GEMM; ++rep)
  for (int q = bid >> 3; q < 85; q += per) {
    const int m = (x >> 1) * 17 + q / 5, n = 5 * (x & 1) + q % 5;
    const int q2 = q + per, m2 = (x >> 1) * 17 + q2 / 5, n2 = 5 * (x & 1) + q2 % 5;
    gemm8_tile((const bf16_t*)(p.ws + OFF_H), DM, wt_ptr(p, layer, WT_IN), 1024, 1024, m * 256, n * 256, smem, epi,
               q == (bid >> 3), q2 < 85, m2 * 256, n2 * 256);
  }
  if (layer == 0) {
    if (per == 32) {
      if ((bid >> 3) >= 21) {
        const int u = ((bid >> 3) - 21) * 8 + x;
        for (int it = 640 + 2 * u + (vbid & 1); it < WT_ITEMS; it += 176) wt_item(p, 0, it, smem_half);
      }
    } else {
      for (int it = 640 + vbid; it < WT_ITEMS; it += nvb) wt_item(p, 0, it, smem_half);
    }
  }
}
DI void phase_wout(const Params& p, int layer, int bid, int nb, int vbid, int nvb, char* smem, char* smem_half) {
  EpiBF epi{(bf16_t*)(p.ws + OFF_U), DM};
  const float* ssq = (const float*)(p.ws + OFF_SSQ);
  const int x = bid & 7, per = nb >> 3;
  for (int rep = 0; rep < REP_GEMM; ++rep) {
    for (int q = bid >> 3; q < 32; q += per) {
      const int T = x * 32 + q;
      gemm8_tile<true>((const bf16_t*)(p.ws + OFF_H), DM, wt_ptr(p, layer, WT_OUT), 1024, 1024, (T >> 2) * 256, (T & 3) * 256, smem, epi,
                       true, false, 0, 0, ssq);
    }
    if (layer == 0)
      for (int it = vbid; it < (MC / 128) * 8 * 8; it += nvb) {
        const int tile = it >> 3, ks = it & 7;
        EpiPartS ep{(float*)(p.ws + OFF_QB) + (size_t)ks * MC * DM, ssq, ks < 4 ? -1 : (ks - 4) >> 1};
        gemm_tile_glds((const bf16_t*)(p.ws + OFF_H) + ks * 128, DM, wt_ptr(p, layer, WT_OUT) + ks * 128, 1024, 128, ML + (tile >> 3) * 128, (tile & 7) * 128, smem_half, ep);
      }
  }
}
DI void phase_ff1(const Params& p, int layer, int bid, int nb, int vbid, int nvb, char* smem, char* smem_half) {
  EpiRelu2 epi{(bf16_t*)(p.ws + OFF_F1), DFF};
  const int x = bid & 7, per = nb >> 3;
  for (int rep = 0; rep < REP_GEMM; ++rep) {
    for (int q = bid >> 3; q < 128; q += per) {
      const int m = (x >> 2) * 32 + (q >> 2), n = 4 * (x & 3) + (q & 3);
      const int q2 = q + per, m2 = (x >> 2) * 32 + (q2 >> 2), n2 = 4 * (x & 3) + (q2 & 3);
      gemm8_tile((const bf16_t*)(p.ws + OFF_H), DM, wt_ptr(p, layer, WT_FF1), 1024, 1024, m * 256, n * 256, smem, epi,
                 q == (bid >> 3), q2 < 128, m2 * 256, n2 * 256);
    }
    if (layer == 0)
      for (int it = vbid; it < (MC / 64) * 32; it += nvb)
        gemm_tile_glds<2>((const bf16_t*)(p.ws + OFF_H), DM, wt_ptr(p, layer, WT_FF1), 1024, 1024, ML + (it / 32) * 64, (it % 32) * 128, smem_half, epi);
  }
}
DI void phase_ff2(const Params& p, int layer, int bid, int nb, int vbid, int nvb, char* smem, char* smem_half) {
  EpiBF epi{(bf16_t*)(p.ws + OFF_H), DM};
  const int x = bid & 7, per = nb >> 3;
  for (int rep = 0; rep < REP_GEMM; ++rep) {
    for (int q = bid >> 3; q < 32; q += per) {
      const int T = x * 32 + q;
      gemm8_tile((const bf16_t*)(p.ws + OFF_F1), DFF, wt_ptr(p, layer, WT_FF2), 4096, 4096, (T >> 2) * 256, (T & 3) * 256, smem, epi);
    }
    if (layer == 0)
      for (int it = vbid; it < (MC / 128) * 8 * 8; it += nvb) {
        const int tile = it >> 3, ks = it & 7;
        EpiPart ep{(float*)(p.ws + OFF_END2) + (size_t)ks * MC * DM};
        gemm_tile_glds((const bf16_t*)(p.ws + OFF_F1) + ks * 512, DFF, wt_ptr(p, layer, WT_FF2) + ks * 512, 4096, 512, ML + (tile >> 3) * 128, (tile & 7) * 128, smem_half, ep);
      }
  }
}

DI int chunk_row0(int b, int tc) { return tc < 2 ? ML + b * CTX + tc * 128 : b * SEQ + (tc - 2) * 128; }
constexpr int BST = 72;
constexpr int TST = 136;
DI void load_tile_T(bf16_t* dst, const bf16_t* __restrict__ src, int ldg) {
  const int tid = ltid();
#pragma unroll
  for (int i = 0; i < 4; ++i) {
    int c = tid + 256 * i, tok = c & 127, pc = c >> 7;
    u32x4 v = *(const u32x4*)(src + (size_t)tok * ldg + pc * 8);
#pragma unroll
    for (int j = 0; j < 4; ++j) {
      dst[(pc * 8 + 2 * j) * TST + tok] = (bf16_t)(v[j] & 0xffffu);
      dst[(pc * 8 + 2 * j + 1) * TST + tok] = (bf16_t)(v[j] >> 16);
    }
  }
}
DI void chunk_scan(const Params& p, int layer, int row0, int h, float* csf, float* csb, float* dtF, float* dtB, float* tot, float*  ) {
  const int tid = ltid(), w = tid >> 6, lane = tid & 63;
  const float* DT = (const float*)(p.ws + OFF_DT);
  float v;
  if (tid < 128) {
    const float dt = DT[(size_t)(row0 + tid) * 16 + h];
    v = dt * -__expf(p.a_log[layer * 16 + h]);
    dtF[tid] = dt;
  } else {
    const int e = 255 - tid;
    const float dt = DT[(size_t)(row0 + e) * 16 + 8 + h];
    v = dt * -__expf(p.a_log[layer * 16 + 8 + h]);
    dtB[e] = dt;
  }
#pragma unroll
  for (int o = 1; o < 64; o <<= 1) { const float t = __shfl_up(v, o); if (lane >= o) v += t; }
  if (lane == 63) tot[w] = v;
  __syncthreads();
  if (w == 1) v += tot[0];
  if (w == 3) v += tot[2];
  if (tid < 128) csf[tid] = v; else csb[255 - tid] = v;
  __syncthreads();
}

DI void ssd_state_item(const Params& p, int layer, int b, int tc, int h, char* smem) {
  bf16_t* XT = (bf16_t*)smem;
  bf16_t* BT = XT + 64 * TST;
  float* csf = (float*)(BT + 64 * TST);
  float* csb = csf + 128; float* dtF = csb + 128; float* dtB = dtF + 128; float* laF = dtB + 128; float* laB = laF + 128;
  const int tid = ltid(), w = tid >> 6, lane = tid & 63, r = lane & 31, hh = lane >> 5;
  const int row0 = chunk_row0(b, tc);
  const bf16_t* XBC = (const bf16_t*)(p.ws + OFF_XBC);
  load_tile_T(XT, XBC + (size_t)row0 * 768 + h * 64, 768);
  load_tile_T(BT, XBC + (size_t)row0 * 768 + 512 + (h >> 2) * 64, 768);
  chunk_scan(p, layer, row0, h, csf, csb, dtF, dtB, laF, laB);
  __syncthreads();
  if (tid < 128) laF[tid] = dtF[tid] * __expf(csf[127] - csf[tid]);
  else { int t = tid - 128; laB[t] = dtB[t] * __expf(csb[0] - csb[t]); }
  __syncthreads();
  const int d = w >> 1, pt = w & 1;
  const float* wv = d == 0 ? laF : laB;
  f32x16 acc[2];
#pragma unroll
  for (int i = 0; i < 16; ++i) { acc[0][i] = 0.f; acc[1][i] = 0.f; }
#pragma unroll
  for (int s = 0; s < 8; ++s) {
    int l0 = 16 * s + 8 * hh;
    u32x4 xa = *(const u32x4*)(XT + (32 * pt + r) * TST + l0);
    u32x4 sa;
#pragma unroll
    for (int j = 0; j < 4; ++j) sa[j] = pack2(lo2f(xa[j]) * wv[l0 + 2 * j], hi2f(xa[j]) * wv[l0 + 2 * j + 1]);
    bf16x8 af = __builtin_bit_cast(bf16x8, sa);
#pragma unroll
    for (int nt = 0; nt < 2; ++nt) {
      bf16x8 bfr = *(const bf16x8*)(BT + (32 * nt + r) * TST + l0);
      acc[nt] = MFMA32(af, bfr, acc[nt]);
    }
  }
  bf16_t* S = (bf16_t*)(p.ws + OFF_SST) + ((((size_t)d * NB + b) * NCH + tc) * 8 + h) * 4096;
#pragma unroll
  for (int nt = 0; nt < 2; ++nt)
#pragma unroll
    for (int i = 0; i < 16; ++i) S[(32 * pt + crow(i, hh)) * 64 + 32 * nt + r] = f2bf(acc[nt][i]);
  if (tid == 0) {
    float* TD = (float*)(p.ws + OFF_TDEC);
    TD[((0 * NB + b) * NCH + tc) * 8 + h] = __expf(csf[127]);
    TD[((1 * NB + b) * NCH + tc) * 8 + h] = __expf(csb[0]);
  }
  __syncthreads();
}

DI void ssd_pass_item(const Params& p, int it) {
  const int e = it * 256 + ltid();
  const int pn2 = e & 2047, h = (e >> 11) & 7, b = (e >> 14) & 3, d = e >> 16;
  unsigned* S = (unsigned*)(p.ws + OFF_SST);
  const float* TD = (const float*)(p.ws + OFF_TDEC);
  unsigned sv[NCH]; float T[NCH];
#pragma unroll
  for (int i = 0; i < NCH; ++i) {
    int tc = d == 0 ? i : (i < 2 ? 1 - i : NCH + 1 - i);
    sv[i] = S[(((size_t)(d * NB + b) * NCH + tc) * 8 + h) * 2048 + pn2];
    T[i] = TD[((d * NB + b) * NCH + tc) * 8 + h];
  }
  float h0 = 0.f, h1 = 0.f;
#pragma unroll
  for (int i = 0; i < NCH; ++i) {
    int tc = d == 0 ? i : (i < 2 ? 1 - i : NCH + 1 - i);
    S[(((size_t)(d * NB + b) * NCH + tc) * 8 + h) * 2048 + pn2] = pack2(h0, h1);
    h0 = T[i] * h0 + lo2f(sv[i]); h1 = T[i] * h1 + hi2f(sv[i]);
  }
}

DI void ssd_out_item(const Params& p, int layer, int b, int tc, int h, char* smem) {
  bf16_t* XT = (bf16_t*)smem;
  bf16_t* Bs = XT + 64 * TST;
  float* csf = (float*)(Bs + 128 * BST);
  float* csb = csf + 128; float* dtF = csb + 128; float* dtB = dtF + 128; float* laF = dtB + 128; float* laB = laF + 128;
  const int tid = ltid(), w = tid >> 6, lane = tid & 63, r = lane & 31, hh = lane >> 5;
  const int row0 = chunk_row0(b, tc), g = h >> 2;
  const bf16_t* XBC = (const bf16_t*)(p.ws + OFF_XBC);
  load_tile_T(XT, XBC + (size_t)row0 * 768 + h * 64, 768);
#pragma unroll
  for (int i = 0; i < 4; ++i) {
    int c = tid + 256 * i, tok = c >> 3, part = c & 7;
    *(u32x4*)(Bs + tok * BST + part * 8) = *(const u32x4*)(XBC + (size_t)(row0 + tok) * 768 + 512 + g * 64 + part * 8);
  }
  const int l = 32 * w + r;
  bf16x8 cf[4];
#pragma unroll
  for (int ks = 0; ks < 4; ++ks) cf[ks] = *(const bf16x8*)(XBC + (size_t)(row0 + l) * 768 + 640 + g * 64 + 16 * ks + 8 * hh);
  chunk_scan(p, layer, row0, h, csf, csb, dtF, dtB, laF, laB);
  const float csf_l = csf[l], csb_l = csb[l];
  f32x16 yacc[2];
#pragma unroll
  for (int i = 0; i < 16; ++i) { yacc[0][i] = 0.f; yacc[1][i] = 0.f; }
#pragma unroll
  for (int st = 0; st < 4; ++st) {
    f32x16 gacc;
#pragma unroll
    for (int i = 0; i < 16; ++i) gacc[i] = 0.f;
#pragma unroll
    for (int ks = 0; ks < 4; ++ks) {
      bf16x8 af = *(const bf16x8*)(Bs + (32 * st + r) * BST + 16 * ks + 8 * hh);
      gacc = MFMA32(af, cf[ks], gacc);
    }
#pragma unroll
    for (int i = 0; i < 16; ++i) {
      int s = 32 * st + crow(i, hh);
      float f;
      if (s < l) f = __expf(csf_l - csf[s]) * dtF[s];
      else if (s > l) f = __expf(csb_l - csb[s]) * dtB[s];
      else f = dtF[s] + dtB[s];
      gacc[i] *= f;
    }
#pragma unroll
    for (int s2 = 0; s2 < 2; ++s2) {
      bf16x8 mf = pack8(gacc, s2);
      int sb = 32 * st + 16 * s2 + 4 * hh;
#pragma unroll
      for (int pt = 0; pt < 2; ++pt) {
        u32x2 lo = *(const u32x2*)(XT + (32 * pt + r) * TST + sb);
        u32x2 hi = *(const u32x2*)(XT + (32 * pt + r) * TST + sb + 8);
        u32x4 xa; xa[0] = lo[0]; xa[1] = lo[1]; xa[2] = hi[0]; xa[3] = hi[1];
        yacc[pt] = MFMA32(__builtin_bit_cast(bf16x8, xa), mf, yacc[pt]);
      }
    }
  }
#pragma unroll
  for (int d = 0; d < 2; ++d) {
    const bf16_t* Hs = (const bf16_t*)(p.ws + OFF_SST) + ((((size_t)d * NB + b) * NCH + tc) * 8 + h) * 4096;
    const float e = __expf(d == 0 ? csf_l : csb_l);
#pragma unroll
    for (int pt = 0; pt < 2; ++pt) {
      f32x16 t;
#pragma unroll
      for (int i = 0; i < 16; ++i) t[i] = 0.f;
#pragma unroll
      for (int ks = 0; ks < 4; ++ks) {
        bf16x8 af = *(const bf16x8*)(Hs + (32 * pt + r) * 64 + 16 * ks + 8 * hh);
        t = MFMA32(af, cf[ks], t);
      }
#pragma unroll
      for (int i = 0; i < 16; ++i) yacc[pt][i] += e * t[i];
    }
  }
  const int row = row0 + l;
  const float Dh = p.ssd_d[layer * 8 + h];
  const bf16_t* U = (const bf16_t*)(p.ws + OFF_U);
  bf16_t* YM = (bf16_t*)(p.ws + OFF_H);
  float ssq = 0.f;
  u32x2 xvv[2][4], zvv[2][4];
#pragma unroll
  for (int pt = 0; pt < 2; ++pt)
#pragma unroll
    for (int q = 0; q < 4; ++q) {
      const int pp = 32 * pt + 8 * q + 4 * hh;
      xvv[pt][q] = *(const u32x2*)(XBC + (size_t)row * 768 + h * 64 + pp);
      zvv[pt][q] = *(const u32x2*)(U + (size_t)row * DIN + U_Z + h * 64 + pp);
    }
#pragma unroll
  for (int pt = 0; pt < 2; ++pt)
#pragma unroll
    for (int q = 0; q < 4; ++q) {
      const int pp = 32 * pt + 8 * q + 4 * hh;
      const u32x2 xv = xvv[pt][q], zv = zvv[pt][q];
      float y0 = (yacc[pt][4 * q + 0] + Dh * lo2f(xv[0])) * silu_f(lo2f(zv[0]));
      float y1 = (yacc[pt][4 * q + 1] + Dh * hi2f(xv[0])) * silu_f(hi2f(zv[0]));
      float y2 = (yacc[pt][4 * q + 2] + Dh * lo2f(xv[1])) * silu_f(lo2f(zv[1]));
      float y3 = (yacc[pt][4 * q + 3] + Dh * hi2f(xv[1])) * silu_f(hi2f(zv[1]));
      u32x2 o; o[0] = pack2(y0, y1); o[1] = pack2(y2, y3);
      float r0 = lo2f(o[0]), r1 = hi2f(o[0]), r2 = lo2f(o[1]), r3 = hi2f(o[1]);
      ssq += r0 * r0 + r1 * r1 + r2 * r2 + r3 * r3;
      *(u32x2*)(YM + (size_t)row * DM + 512 + h * 64 + pp) = o;
    }
  ssq += __shfl_xor(ssq, 32);
  if (hh == 0) ((float*)(p.ws + OFF_SSQ))[(size_t)row * 8 + h] = ssq;
  __syncthreads();
}

constexpr int KST = 104;
constexpr int VST = 68;
constexpr int ASTG = 64 * KST + 64 * VST;
DI void attn_item(const Params& p, int b, int head, int qrow0, int t0, bool lat, int nkeys, char* smem) {
  bf16_t* Ks = (bf16_t*)smem;
  bf16_t* Vs = Ks + 64 * KST;
  const int tid = ltid(), w = tid >> 6, lane = tid & 63, r = lane & 31, hh = lane >> 5;
  const bf16_t* QB = (const bf16_t*)(p.ws + OFF_QB);
  const bf16_t* KB = (const bf16_t*)(p.ws + OFF_KB) + (size_t)(b * 4 + head) * LK * 96;
  const bf16_t* VT = (const bf16_t*)(p.ws + OFF_VT) + (size_t)(b * 4 + head) * 64 * LK;
  const float qscale = 0.10206207261596575f * 1.4426950408889634f;
  const int qrow = qrow0 + w * 32 + r;
  const int t = t0 + w * 32 + r;
  bf16x8 qf[6];
  {
    const bf16_t* src = QB + (size_t)qrow * 384 + head * 96;
#pragma unroll
    for (int s = 0; s < 4; ++s) {
      u32x4 v = *(const u32x4*)(src + 16 * s + 8 * hh);
      u32x4 o;
#pragma unroll
      for (int j = 0; j < 4; ++j) o[j] = pack2(lo2f(v[j]) * qscale, hi2f(v[j]) * qscale);
      qf[s] = __builtin_bit_cast(bf16x8, o);
    }
#pragma unroll
    for (int s = 4; s < 6; ++s) {
      u32x4 va = *(const u32x4*)(src + 16 * s), vb = *(const u32x4*)(src + 16 * s + 8);
      float posf = s == 4 ? (float)(t >> 6) : (float)(t & 63);
      float o[8];
#pragma unroll
      for (int j = 0; j < 8; ++j) {
        float a = (j & 1) ? hi2f(va[j >> 1]) : lo2f(va[j >> 1]);
        float bb = (j & 1) ? hi2f(vb[j >> 1]) : lo2f(vb[j >> 1]);
        float res;
        if (lat) {
          float invf = exp2f(-(float)(2 * j) * (13.287712379549449f / 16.f));
          float rev = posf * invf * 0.15915494309189535f;
          float cs = __builtin_amdgcn_cosf(rev), sn = __builtin_amdgcn_sinf(rev);
          res = hh == 0 ? a * cs - bb * sn : bb * cs + a * sn;
        } else res = hh == 0 ? a : bb;
        o[j] = res * qscale;
      }
      u32x4 ov; ov[0] = pack2(o[0], o[1]); ov[1] = pack2(o[2], o[3]); ov[2] = pack2(o[4], o[5]); ov[3] = pack2(o[6], o[7]);
      qf[s] = __builtin_bit_cast(bf16x8, ov);
    }
  }
  f32x16 oacc[2];
#pragma unroll
  for (int i = 0; i < 16; ++i) { oacc[0][i] = 0.f; oacc[1][i] = 0.f; }
  float m = -1e30f, lsum = 0.f;
  u32x4 rk[3], rv[2];
  auto gload = [&](int key0) {
#pragma unroll
    for (int i = 0; i < 3; ++i) rk[i] = *(const u32x4*)(KB + (size_t)key0 * 96 + (tid + 256 * i) * 8);
#pragma unroll
    for (int i = 0; i < 2; ++i) { int c = tid + 256 * i; rv[i] = *(const u32x4*)(VT + (size_t)(c >> 3) * LK + key0 + (c & 7) * 8); }
  };
  gload(0);
  const int NT = nkeys / 64;
  for (int kt = 0; kt < NT; ++kt) {
#pragma unroll
    for (int i = 0; i < 3; ++i) { int c = tid + 256 * i; *(u32x4*)(Ks + (c / 12) * KST + (c % 12) * 8) = rk[i]; }
#pragma unroll
    for (int i = 0; i < 2; ++i) {
      int c = tid + 256 * i;
      bf16_t* d = Vs + (c >> 3) * VST + (c & 7) * 8;
      u32x2 a; a[0] = rv[i][0]; a[1] = rv[i][1];
      u32x2 bq; bq[0] = rv[i][2]; bq[1] = rv[i][3];
      *(u32x2*)d = a; *(u32x2*)(d + 4) = bq;
    }
    __syncthreads();
    if (kt + 1 < NT) gload((kt + 1) * 64);
    f32x16 sacc[2];
#pragma unroll
    for (int i = 0; i < 16; ++i) { sacc[0][i] = 0.f; sacc[1][i] = 0.f; }
#pragma unroll
    for (int s = 0; s < 6; ++s)
#pragma unroll
      for (int k2 = 0; k2 < 2; ++k2) {
        bf16x8 af = *(const bf16x8*)(Ks + (32 * k2 + r) * KST + 16 * s + 8 * hh);
        sacc[k2] = MFMA32(af, qf[s], sacc[k2]);
      }
    float mx = sacc[0][0];
#pragma unroll
    for (int i = 0; i < 16; ++i) { mx = fmaxf(mx, sacc[0][i]); mx = fmaxf(mx, sacc[1][i]); }
    mx = fmaxf(mx, __shfl_xor(mx, 32));
    const float mn = fmaxf(m, mx);
    const float alpha = __builtin_amdgcn_exp2f(m - mn);
    m = mn;
    float ps = 0.f;
#pragma unroll
    for (int i = 0; i < 16; ++i) {
      sacc[0][i] = __builtin_amdgcn_exp2f(sacc[0][i] - mn); sacc[1][i] = __builtin_amdgcn_exp2f(sacc[1][i] - mn);
      ps += sacc[0][i] + sacc[1][i];
    }
    lsum = lsum * alpha + ps;
#pragma unroll
    for (int i = 0; i < 16; ++i) { oacc[0][i] *= alpha; oacc[1][i] *= alpha; }
#pragma unroll
    for (int k2 = 0; k2 < 2; ++k2)
#pragma unroll
      for (int s2 = 0; s2 < 2; ++s2) {
        bf16x8 pf = pack8(sacc[k2], s2);
        int kb0 = 32 * k2 + 16 * s2 + 4 * hh;
#pragma unroll
        for (int d = 0; d < 2; ++d) {
          u32x2 lo = *(const u32x2*)(Vs + (32 * d + r) * VST + kb0);
          u32x2 hi = *(const u32x2*)(Vs + (32 * d + r) * VST + kb0 + 8);
          u32x4 va; va[0] = lo[0]; va[1] = lo[1]; va[2] = hi[0]; va[3] = hi[1];
          oacc[d] = MFMA32(__builtin_bit_cast(bf16x8, va), pf, oacc[d]);
        }
      }
    __syncthreads();
  }
  lsum += __shfl_xor(lsum, 32);
  const float inv = 1.f / lsum;
  bf16_t* YM = (bf16_t*)(p.ws + OFF_H) + (size_t)qrow * DM + head * 64;
#pragma unroll
  for (int d = 0; d < 2; ++d)
#pragma unroll
    for (int q = 0; q < 4; ++q) {
      u32x2 o; o[0] = pack2(oacc[d][4 * q] * inv, oacc[d][4 * q + 1] * inv); o[1] = pack2(oacc[d][4 * q + 2] * inv, oacc[d][4 * q + 3] * inv);
      *(u32x2*)(YM + 32 * d + 8 * q + 4 * hh) = o;
    }
}

DI void attn_item8(const Params& p, int b, int head, int qrow0, int t0, bool lat, int nkeys, char* smem) {
  bf16_t* Ks = (bf16_t*)smem;
  bf16_t* Vs = Ks + 64 * KST;
  const int tid = ltid512(), w = tid >> 6, lane = tid & 63, r = lane & 31, hh = lane >> 5;
  const bf16_t* QB = (const bf16_t*)(p.ws + OFF_QB);
  const bf16_t* KB = (const bf16_t*)(p.ws + OFF_KB) + (size_t)(b * 4 + head) * LK * 96;
  const bf16_t* VT = (const bf16_t*)(p.ws + OFF_VT) + (size_t)(b * 4 + head) * 64 * LK;
  const float qscale = 0.10206207261596575f * 1.4426950408889634f;
  const int qrow = qrow0 + w * 32 + r;
  const int t = t0 + w * 32 + r;
  bf16x8 qf[6];
  {
    const bf16_t* src = QB + (size_t)qrow * 384 + head * 96;
#pragma unroll
    for (int s = 0; s < 4; ++s) {
      u32x4 v = *(const u32x4*)(src + 16 * s + 8 * hh);
      u32x4 o;
#pragma unroll
      for (int j = 0; j < 4; ++j) o[j] = pack2(lo2f(v[j]) * qscale, hi2f(v[j]) * qscale);
      qf[s] = __builtin_bit_cast(bf16x8, o);
    }
#pragma unroll
    for (int s = 4; s < 6; ++s) {
      u32x4 va = *(const u32x4*)(src + 16 * s), vb = *(const u32x4*)(src + 16 * s + 8);
      float posf = s == 4 ? (float)(t >> 6) : (float)(t & 63);
      float o[8];
#pragma unroll
      for (int j = 0; j < 8; ++j) {
        float a = (j & 1) ? hi2f(va[j >> 1]) : lo2f(va[j >> 1]);
        float bb = (j & 1) ? hi2f(vb[j >> 1]) : lo2f(vb[j >> 1]);
        float res;
        if (lat) {
          float invf = exp2f(-(float)(2 * j) * (13.287712379549449f / 16.f));
          float rev = posf * invf * 0.15915494309189535f;
          float cs = __builtin_amdgcn_cosf(rev), sn = __builtin_amdgcn_sinf(rev);
          res = hh == 0 ? a * cs - bb * sn : bb * cs + a * sn;
        } else res = hh == 0 ? a : bb;
        o[j] = res * qscale;
      }
      u32x4 ov; ov[0] = pack2(o[0], o[1]); ov[1] = pack2(o[2], o[3]); ov[2] = pack2(o[4], o[5]); ov[3] = pack2(o[6], o[7]);
      qf[s] = __builtin_bit_cast(bf16x8, ov);
    }
  }
  f32x16 oacc[2];
#pragma unroll
  for (int i = 0; i < 16; ++i) { oacc[0][i] = 0.f; oacc[1][i] = 0.f; }
  float m = -1e30f, lsum = 0.f;
  u32x4 rk[2], rv;
  auto gload = [&](int key0) {
    rk[0] = *(const u32x4*)(KB + (size_t)key0 * 96 + tid * 8);
    if (tid < 256) rk[1] = *(const u32x4*)(KB + (size_t)key0 * 96 + (512 + tid) * 8);
    rv = *(const u32x4*)(VT + (size_t)(tid >> 3) * LK + key0 + (tid & 7) * 8);
  };
  const int kro = (tid / 12) * KST + (tid % 12) * 8, kro2 = ((512 + tid) / 12) * KST + ((512 + tid) % 12) * 8;
  auto swrite = [&](int stage) {
    bf16_t* Kd = Ks + stage * ASTG;
    *(u32x4*)(Kd + kro) = rk[0];
    if (tid < 256) *(u32x4*)(Kd + kro2) = rk[1];
    bf16_t* d = Kd + 64 * KST + (tid >> 3) * VST + (tid & 7) * 8;
    u32x2 a; a[0] = rv[0]; a[1] = rv[1];
    u32x2 bq; bq[0] = rv[2]; bq[1] = rv[3];
    *(u32x2*)d = a; *(u32x2*)(d + 4) = bq;
  };
  auto qk = [&](int stage, f32x16 (&sa)[2]) {
    const bf16_t* Kc = Ks + stage * ASTG;
#pragma unroll
    for (int i = 0; i < 16; ++i) { sa[0][i] = 0.f; sa[1][i] = 0.f; }
#pragma unroll
    for (int s = 0; s < 6; ++s)
#pragma unroll
      for (int k2 = 0; k2 < 2; ++k2) {
        bf16x8 af = *(const bf16x8*)(Kc + (32 * k2 + r) * KST + 16 * s + 8 * hh);
        sa[k2] = MFMA32(af, qf[s], sa[k2]);
      }
  };
  const int NT = nkeys / 64;
  f32x16 sacc[2], snext[2];
  gload(0); swrite(0);
  gload(64);
  __syncthreads();
  swrite(1);
  gload(128);
  qk(0, sacc);
  __syncthreads();
  int cur = 0, nxt = 1, nn = 2;
  for (int kt = 0; kt < NT; ++kt) {
    if (kt + 1 < NT) qk(nxt, snext);
    if (kt + 2 < NT) {
      swrite(nn);
      if (kt + 3 < NT) gload((kt + 3) * 64);
    }
    const bf16_t* Vc = Ks + cur * ASTG + 64 * KST;
    float mx = sacc[0][0];
#pragma unroll
    for (int i = 0; i < 16; ++i) { mx = fmaxf(mx, sacc[0][i]); mx = fmaxf(mx, sacc[1][i]); }
    mx = fmaxf(mx, __shfl_xor(mx, 32));
    const float mn = fmaxf(m, mx);
    const float alpha = __builtin_amdgcn_exp2f(m - mn);
    m = mn;
    float ps = 0.f;
#pragma unroll
    for (int i = 0; i < 16; ++i) {
      sacc[0][i] = __builtin_amdgcn_exp2f(sacc[0][i] - mn); sacc[1][i] = __builtin_amdgcn_exp2f(sacc[1][i] - mn);
      ps += sacc[0][i] + sacc[1][i];
    }
    lsum = lsum * alpha + ps;
#pragma unroll
    for (int i = 0; i < 16; ++i) { oacc[0][i] *= alpha; oacc[1][i] *= alpha; }
#pragma unroll
    for (int k2 = 0; k2 < 2; ++k2)
#pragma unroll
      for (int s2 = 0; s2 < 2; ++s2) {
        bf16x8 pf = pack8(sacc[k2], s2);
        int kb0 = 32 * k2 + 16 * s2 + 4 * hh;
#pragma unroll
        for (int d = 0; d < 2; ++d) {
          u32x2 lo = *(const u32x2*)(Vc + (32 * d + r) * VST + kb0);
          u32x2 hi = *(const u32x2*)(Vc + (32 * d + r) * VST + kb0 + 8);
          u32x4 va; va[0] = lo[0]; va[1] = lo[1]; va[2] = hi[0]; va[3] = hi[1];
          oacc[d] = MFMA32(__builtin_bit_cast(bf16x8, va), pf, oacc[d]);
        }
      }
    sacc[0] = snext[0]; sacc[1] = snext[1];
    const int t3 = cur; cur = nxt; nxt = nn; nn = t3;
    __syncthreads();
  }
  lsum += __shfl_xor(lsum, 32);
  const float inv = 1.f / lsum;
  bf16_t* YM = (bf16_t*)(p.ws + OFF_H) + (size_t)qrow * DM + head * 64;
#pragma unroll
  for (int d = 0; d < 2; ++d)
#pragma unroll
    for (int q = 0; q < 4; ++q) {
      u32x2 o; o[0] = pack2(oacc[d][4 * q] * inv, oacc[d][4 * q + 1] * inv); o[1] = pack2(oacc[d][4 * q + 2] * inv, oacc[d][4 * q + 3] * inv);
      *(u32x2*)(YM + 32 * d + 8 * q + 4 * hh) = o;
    }
}

DI void attn_item8b(const Params& p, int b, int head, int qrow0, int t0, bool lat, int nkeys, char* smem) {
  bf16_t* Ks = (bf16_t*)smem;
  bf16_t* Vs = Ks + 64 * KST;
  const int tid = ltid512(), w = tid >> 6, lane = tid & 63, r = lane & 31, hh = lane >> 5;
  const bf16_t* QB = (const bf16_t*)(p.ws + OFF_QB);
  const bf16_t* KB = (const bf16_t*)(p.ws + OFF_KB) + (size_t)(b * 4 + head) * LK * 96;
  const bf16_t* VT = (const bf16_t*)(p.ws + OFF_VT) + (size_t)(b * 4 + head) * 64 * LK;
  const float qscale = 0.10206207261596575f * 1.4426950408889634f;
  const int qrow = qrow0 + w * 32 + r;
  const int t = t0 + w * 32 + r;
  bf16x8 qf[6];
  {
    const bf16_t* src = QB + (size_t)qrow * 384 + head * 96;
#pragma unroll
    for (int s = 0; s < 4; ++s) {
      u32x4 v = *(const u32x4*)(src + 16 * s + 8 * hh);
      u32x4 o;
#pragma unroll
      for (int j = 0; j < 4; ++j) o[j] = pack2(lo2f(v[j]) * qscale, hi2f(v[j]) * qscale);
      qf[s] = __builtin_bit_cast(bf16x8, o);
    }
#pragma unroll
    for (int s = 4; s < 6; ++s) {
      u32x4 va = *(const u32x4*)(src + 16 * s), vb = *(const u32x4*)(src + 16 * s + 8);
      float posf = s == 4 ? (float)(t >> 6) : (float)(t & 63);
      float o[8];
#pragma unroll
      for (int j = 0; j < 8; ++j) {
        float a = (j & 1) ? hi2f(va[j >> 1]) : lo2f(va[j >> 1]);
        float bb = (j & 1) ? hi2f(vb[j >> 1]) : lo2f(vb[j >> 1]);
        float res;
        if (lat) {
          float invf = exp2f(-(float)(2 * j) * (13.287712379549449f / 16.f));
          float rev = posf * invf * 0.15915494309189535f;
          float cs = __builtin_amdgcn_cosf(rev), sn = __builtin_amdgcn_sinf(rev);
          res = hh == 0 ? a * cs - bb * sn : bb * cs + a * sn;
        } else res = hh == 0 ? a : bb;
        o[j] = res * qscale;
      }
      u32x4 ov; ov[0] = pack2(o[0], o[1]); ov[1] = pack2(o[2], o[3]); ov[2] = pack2(o[4], o[5]); ov[3] = pack2(o[6], o[7]);
      qf[s] = __builtin_bit_cast(bf16x8, ov);
    }
  }
  f32x16 oacc[2];
#pragma unroll
  for (int i = 0; i < 16; ++i) { oacc[0][i] = 0.f; oacc[1][i] = 0.f; }
  float m = -1e30f, lsum = 0.f;
  constexpr int VS2 = 132;
  constexpr int STG = 128 * KST + 64 * VS2;
  u32x4 rk[3], rv[2];
  auto gload = [&](int key0) {
#pragma unroll
    for (int i = 0; i < 3; ++i) rk[i] = *(const u32x4*)(KB + (size_t)key0 * 96 + (tid + 512 * i) * 8);
#pragma unroll
    for (int i = 0; i < 2; ++i) { const int c = tid + 512 * i; rv[i] = *(const u32x4*)(VT + (size_t)(c >> 4) * LK + key0 + (c & 15) * 8); }
  };
  int kro[3], vro[2];
#pragma unroll
  for (int i = 0; i < 3; ++i) { const int c = tid + 512 * i; kro[i] = (c / 12) * KST + (c % 12) * 8; }
#pragma unroll
  for (int i = 0; i < 2; ++i) { const int c = tid + 512 * i; vro[i] = 128 * KST + (c >> 4) * VS2 + (c & 15) * 8; }
  auto swrite = [&](int stage) {
    bf16_t* Kd = Ks + stage * STG;
#pragma unroll
    for (int i = 0; i < 3; ++i) *(u32x4*)(Kd + kro[i]) = rk[i];
#pragma unroll
    for (int i = 0; i < 2; ++i) {
      u32x2 a; a[0] = rv[i][0]; a[1] = rv[i][1];
      u32x2 bq; bq[0] = rv[i][2]; bq[1] = rv[i][3];
      *(u32x2*)(Kd + vro[i]) = a; *(u32x2*)(Kd + vro[i] + 4) = bq;
    }
  };
  const int NT = nkeys / 128;
  gload(0); swrite(0);
  if (NT > 1) gload(128);
  __syncthreads();
  for (int kt = 0; kt < NT; ++kt) {
    const bf16_t* Kc = Ks + (kt & 1) * STG;
    const bf16_t* Vc = Kc + 128 * KST;
    if (kt + 1 < NT) {
      swrite((kt + 1) & 1);
      if (kt + 2 < NT) gload((kt + 2) * 128);
    }
    f32x16 sacc[4];
#pragma unroll
    for (int k2 = 0; k2 < 4; ++k2)
#pragma unroll
      for (int i = 0; i < 16; ++i) sacc[k2][i] = 0.f;
#pragma unroll
    for (int s = 0; s < 6; ++s)
#pragma unroll
      for (int k2 = 0; k2 < 4; ++k2) {
        bf16x8 af = *(const bf16x8*)(Kc + (32 * k2 + r) * KST + 16 * s + 8 * hh);
        sacc[k2] = MFMA32(af, qf[s], sacc[k2]);
      }
    float mx = sacc[0][0];
#pragma unroll
    for (int k2 = 0; k2 < 4; ++k2)
#pragma unroll
      for (int i = 0; i < 16; ++i) mx = fmaxf(mx, sacc[k2][i]);
    mx = fmaxf(mx, __shfl_xor(mx, 32));
    const float mn = fmaxf(m, mx);
    if (__any(mn > m)) {
      const float alpha = __builtin_amdgcn_exp2f(m - mn);
      lsum *= alpha;
#pragma unroll
      for (int i = 0; i < 16; ++i) { oacc[0][i] *= alpha; oacc[1][i] *= alpha; }
      m = mn;
    }
    float ps = 0.f;
#pragma unroll
    for (int k2 = 0; k2 < 4; ++k2)
#pragma unroll
      for (int i = 0; i < 16; ++i) { sacc[k2][i] = __builtin_amdgcn_exp2f(sacc[k2][i] - m); ps += sacc[k2][i]; }
    lsum += ps;
#pragma unroll
    for (int k2 = 0; k2 < 4; ++k2)
#pragma unroll
      for (int s2 = 0; s2 < 2; ++s2) {
        bf16x8 pf = pack8(sacc[k2], s2);
        const int kb0 = 32 * k2 + 16 * s2 + 4 * hh;
#pragma unroll
        for (int d = 0; d < 2; ++d) {
          u32x2 lo = *(const u32x2*)(Vc + (32 * d + r) * VS2 + kb0);
          u32x2 hi = *(const u32x2*)(Vc + (32 * d + r) * VS2 + kb0 + 8);
          u32x4 va; va[0] = lo[0]; va[1] = lo[1]; va[2] = hi[0]; va[3] = hi[1];
          oacc[d] = MFMA32(__builtin_bit_cast(bf16x8, va), pf, oacc[d]);
        }
      }
    __syncthreads();
  }
  lsum += __shfl_xor(lsum, 32);
  const float inv = 1.f / lsum;
  bf16_t* YM = (bf16_t*)(p.ws + OFF_H) + (size_t)qrow * DM + head * 64;
#pragma unroll
  for (int d = 0; d < 2; ++d)
#pragma unroll
    for (int q = 0; q < 4; ++q) {
      u32x2 o; o[0] = pack2(oacc[d][4 * q] * inv, oacc[d][4 * q + 1] * inv); o[1] = pack2(oacc[d][4 * q + 2] * inv, oacc[d][4 * q + 3] * inv);
      *(u32x2*)(YM + 32 * d + 8 * q + 4 * hh) = o;
    }
}

DI void phase_qkv(const Params& p, int layer, int bid, int nb, char* smem) {
  const int MQ = layer == 0 ? MT : ML;
  const int nq = (MQ / 128) * 3, nkv = (MT / 128) * 4, nst = NB * NCH * 8;
  const float* RS = (const float*)(p.ws + OFF_RSTD);
  EpiQ eq{(bf16_t*)(p.ws + OFF_QB), RS};
  EpiKV ekv{(bf16_t*)(p.ws + OFF_KB), (bf16_t*)(p.ws + OFF_VT), RS};
  const bf16_t* U = (const bf16_t*)(p.ws + OFF_U);
  for (int it = bid; it < nq + nkv + nst; it += nb) {
    if (it < nq) gemm_tile<false>(U, DIN, wt_ptr(p, layer, WT_UQ), 256, (it / 3) * 128, (it % 3) * 128, smem, eq);
    else if (it < nq + nkv) { int j = it - nq; gemm_tile<false>(U + U_CKV, DIN, wt_ptr(p, layer, WT_UKV), 128, (j / 4) * 128, (j % 4) * 128, smem, ekv); }
    else { int j = it - nq - nkv; for (int rep = 0; rep < REP_SSD; ++rep) ssd_state_item(p, layer, j / (NCH * 8), (j / 8) % NCH, j & 7, smem); }
  }
}
DI void phase_att(const Params& p, int layer, int bid, int nb, int vbid, int nvb, char* smem, char* sh) {
  for (int it = bid; it < 256; it += nb) {
    const int x = it & 7, j = it >> 3, bh = 2 * x + (j >> 4), qb = j & 15, b = bh >> 2, head = bh & 3;
    for (int rep = 0; rep < REP_ATT; ++rep) attn_item8b(p, b, head, b * SEQ + qb * 256, qb * 256, true, LK, smem);
  }
  for (int it = vbid; it < 512; it += nvb) ssd_pass_item(p, it);
}
DI void phase_ssdout(const Params& p, int layer, int bid, int nb, char* smem) {
  const int nout = NB * NCH * 8, nctx = layer == 0 ? 32 : 0;
  for (int it = bid; it < nout + nctx; it += nb) {
    if (it < nout) {
      int b = it / (NCH * 8), tc = (it / 8) % NCH, h = it & 7;
      if (layer == 1 && tc < 2) continue;
      for (int rep = 0; rep < REP_SSD; ++rep) ssd_out_item(p, layer, b, tc, h, smem);
    } else {
      const int j = it - nout, b = j >> 3, head = (j >> 1) & 3, qb = j & 1;
      attn_item(p, b, head, ML + b * CTX + qb * 128, qb * 128, false, CTX, smem);
    }
  }
  if (layer == 0) {
    if (nb == 512) { if (bid >= 96) for (int it = bid - 96; it < WT_ITEMS; it += 416) wt_item(p, 1, it, smem); }
    else for (int it = bid; it < WT_ITEMS; it += nb) wt_item(p, 1, it, smem);
  }
}


#define XB_TMO      128
#define XB_XCNT(j)  (256  + 64 * (j))
#define XB_XSUB(j)  (1280 + 64 * (j))
#define XB_XGEN(j)  (2304 + 64 * (j))
#define XB_TOP      3328
#define XB_TOPGEN   3392
#define XCD_BAR_WORDS 3456
#define XB_SPIN_CAP (1u << 22)
#define LAS __attribute__((address_space(3)))
DI unsigned xb_ld(unsigned* p) { return __hip_atomic_load(p, __ATOMIC_RELAXED, __HIP_MEMORY_SCOPE_AGENT); }
DI unsigned xb_add(unsigned* p, unsigned v) { return __hip_atomic_fetch_add(p, v, __ATOMIC_RELAXED, __HIP_MEMORY_SCOPE_AGENT); }
DI unsigned xb_xcc_id() { return (unsigned)__builtin_amdgcn_s_getreg((3 << 11) | 20) & 0xFu; }
#define XB_SPIN(cond, bar) do { unsigned _sp = 0; while (cond) { __builtin_amdgcn_s_sleep(1); \
    if ((++_sp & 255u) == 0u) { if (xb_ld(&(bar)[XB_TMO])) break; if (_sp > XB_SPIN_CAP) { atomicAdd(&(bar)[XB_TMO], 1u); break; } } } } while (0)
struct XcdBarrier { unsigned* bar; unsigned x; volatile LAS unsigned* st; };
DI XcdBarrier xcd_barrier_post(unsigned* bar, volatile LAS unsigned* st) {
  XcdBarrier b; b.bar = bar; b.x = xb_xcc_id(); b.st = st;
  if (threadIdx.x == 0) (void)xb_add(&bar[XB_XCNT(b.x)], 1u);
  return b;
}
DI void xcd_barrier_complete(unsigned* bar, unsigned x, unsigned& nloc, unsigned& nx) {
  const unsigned G = gridDim.x * gridDim.y * gridDim.z;
  unsigned sum, cnt, mine, sp = 0u;
  for (;;) {
    sum = 0u; cnt = 0u; mine = 0u;
#pragma unroll
    for (unsigned j = 0; j < 16; ++j) { const unsigned c = xb_ld(&bar[XB_XCNT(j)]); sum += c; cnt += (c > 0u) ? 1u : 0u; mine = (j == x) ? c : mine; }
    if (sum == G) break;
    __builtin_amdgcn_s_sleep(1);
    if ((++sp & 255u) == 0u) { if (xb_ld(&bar[XB_TMO])) break; if (sp > XB_SPIN_CAP) { atomicAdd(&bar[XB_TMO], 1u); break; } }
  }
  nloc = mine > 0u ? mine : 1u; nx = cnt > 0u ? cnt : 1u;
}
DI void xcd_barrier(const XcdBarrier& b) {
  asm volatile("s_waitcnt vmcnt(0)" ::: "memory");
  __syncthreads();
  if (threadIdx.x == 0) {
    unsigned* bar = b.bar;
    asm volatile("" : "+s"(bar));
    __builtin_amdgcn_s_waitcnt(0);
    unsigned nloc = b.st[0], nx = b.st[1];
    if (nloc == 0u) { xcd_barrier_complete(bar, b.x, nloc, nx); b.st[0] = nloc; b.st[1] = nx; }
    const unsigned old = xb_add(&bar[XB_XSUB(b.x)], 1u);
    const unsigned gen = old / nloc;
    if (old + 1u == (gen + 1u) * nloc) {
      __builtin_amdgcn_fence(__ATOMIC_RELEASE, "agent");
      asm volatile("s_waitcnt vmcnt(0)" ::: "memory");
      const unsigned og = xb_add(&bar[XB_TOP], 1u);
      const unsigned tg = og / nx;
      if (og + 1u == (tg + 1u) * nx) xb_add(&bar[XB_TOPGEN], 1u);
      else XB_SPIN(xb_ld(&bar[XB_TOPGEN]) == tg, bar);
      __builtin_amdgcn_fence(__ATOMIC_ACQUIRE, "agent");
      xb_add(&bar[XB_XGEN(b.x)], 1u);
      asm volatile("s_waitcnt vmcnt(0)" ::: "memory");
    } else {
      XB_SPIN(xb_ld(&bar[XB_XGEN(b.x)]) == gen, bar);
      __builtin_amdgcn_fence(__ATOMIC_ACQUIRE, "agent");
      asm volatile("s_waitcnt vmcnt(0)" ::: "memory");
    }
  }
  __syncthreads();
}

constexpr int SMEM_BYTES = 2 * GBUF * 2;
enum { PH_PREP0 = 0, PH_H0, PH_INPROJ, PH_PREP, PH_QKV, PH_ATT, PH_SSDOUT, PH_WOUT, PH_POSTMIX, PH_FF1, PH_FF2, PH_POSTFFN, PH_SSDNORM };

struct Ids { int bid, nb, vbid, nvb, lid; };
DI void run_phase(const Params& p, int ph, int layer, const Ids& id, char* smem, char* sh) {
  switch (ph) {
    case PH_PREP0: phase_prep0(p, id.vbid, id.nvb, sh); break;
    case PH_H0: phase_h0(p, id.vbid, id.nvb); break;
    case PH_INPROJ: phase_inproj(p, layer, id.bid, id.nb, id.vbid, id.nvb, smem, sh); break;
    case PH_PREP: phase_prep(p, layer, id.vbid, id.nvb); break;
    case PH_QKV: phase_qkv(p, layer, id.vbid, id.nvb, sh); break;
    case PH_ATT: phase_att(p, layer, id.bid, id.nb, id.vbid, id.nvb, smem, sh); break;
    case PH_SSDOUT: phase_ssdout(p, layer, id.vbid, id.nvb, sh); break;
    case PH_WOUT: phase_wout(p, layer, id.bid, id.nb, id.vbid, id.nvb, smem, sh); break;
    case PH_POSTMIX: phase_postmix(p, layer, id.vbid, id.nvb); break;
    case PH_FF1: phase_ff1(p, layer, id.bid, id.nb, id.vbid, id.nvb, smem, sh); break;
    case PH_FF2: phase_ff2(p, layer, id.bid, id.nb, id.vbid, id.nvb, smem, sh); break;
    case PH_POSTFFN: phase_postffn(p, layer, id.vbid, id.nvb); break;
  }
}

__global__ void __launch_bounds__(512) mega_kernel(Params p) {
  extern __shared__ __attribute__((aligned(16))) char smem[];
  cg::grid_group grid = cg::this_grid();
  if (p.ws == nullptr) grid.sync();
  const int half = __builtin_amdgcn_readfirstlane((int)(threadIdx.x >> 8));
  Ids id;
  id.bid = blockIdx.x; id.nb = gridDim.x;
  id.vbid = 2 * id.bid + half; id.nvb = 2 * id.nb;
  id.lid = (id.bid & 7) + 8 * (2 * (id.bid >> 3) + half);
  char* sh = smem + half * SMEM_BYTES;
  volatile LAS unsigned* st = (volatile LAS unsigned*)(smem + 2 * SMEM_BYTES - 16);
  if (threadIdx.x == 0) { st[0] = 0u; st[1] = 0u; st[2] = 0u; st[3] = 0u; }
  __syncthreads();
  XcdBarrier xb = xcd_barrier_post((unsigned*)(p.ws + OFF_BAR), st);
#define MK_STEP(PH, LAYER, LAST) do { \
    typedef const void* __attribute__((address_space(4))) * KArgs; \
    KArgs ka = (KArgs)__builtin_amdgcn_kernarg_segment_ptr(); \
    asm volatile("" : "+s"(ka)); \
    Params q; \
    { const void** dst = (const void**)&q; _Pragma("unroll") for (int i = 0; i < 27; ++i) dst[i] = ka[i]; } \
    run_phase(q, PH, LAYER, id, smem, sh); \
    if (!(LAST)) xcd_barrier(xb); } while (0)
  MK_STEP(PH_PREP0, 0, false);
  MK_STEP(PH_H0, 0, false);
  MK_STEP(PH_INPROJ, 0, false); MK_STEP(PH_PREP, 0, false); MK_STEP(PH_QKV, 0, false); MK_STEP(PH_ATT, 0, false); MK_STEP(PH_SSDOUT, 0, false);
  MK_STEP(PH_WOUT, 0, false); MK_STEP(PH_POSTMIX, 0, false); MK_STEP(PH_FF1, 0, false); MK_STEP(PH_FF2, 0, false); MK_STEP(PH_POSTFFN, 0, false);
  MK_STEP(PH_INPROJ, 1, false); MK_STEP(PH_PREP, 1, false); MK_STEP(PH_QKV, 1, false); MK_STEP(PH_ATT, 1, false); MK_STEP(PH_SSDOUT, 1, false);
  MK_STEP(PH_WOUT, 1, false); MK_STEP(PH_POSTMIX, 1, false); MK_STEP(PH_FF1, 1, false); MK_STEP(PH_FF2, 1, false); MK_STEP(PH_POSTFFN, 1, true);
#undef MK_STEP
}

extern "C" void kernel_launch(void* const* d_in, const int* in_sizes, int n_in, void* d_out, int out_size, void* d_ws, size_t ws_size,
                              hipStream_t stream) {
  if (ws_size < WS_NEED) { fprintf(stderr, "workspace too small: %zu < %zu\n", ws_size, (size_t)WS_NEED); return; }
  Params p{};
  const float** f = (const float**)&p;
  for (int i = 0; i < 25; ++i) f[i] = (const float*)d_in[i];
  p.out = (float*)d_out;
  p.ws = (char*)d_ws;
  static int grid_blocks = 0;
  if (!grid_blocks) {
    int dev = 0, cus = 0, per_cu = 0;
    hipGetDevice(&dev);
    hipDeviceGetAttribute(&cus, hipDeviceAttributeMultiprocessorCount, dev);
    hipFuncSetAttribute((const void*)mega_kernel, hipFuncAttributeMaxDynamicSharedMemorySize, 2 * SMEM_BYTES);
    hipOccupancyMaxActiveBlocksPerMultiprocessor(&per_cu, mega_kernel, 512, 2 * SMEM_BYTES);
    if (per_cu > 1) per_cu = 1;
    grid_blocks = cus * per_cu;
  }
  hipMemsetAsync((char*)d_ws + OFF_BAR, 0, XCD_BAR_WORDS * 4, stream);
  void* args[] = {&p};
  hipError_t e = hipLaunchCooperativeKernel((void*)mega_kernel, dim3(grid_blocks), dim3(512), args, 2 * SMEM_BYTES, stream);
  if (e != hipSuccess) fprintf(stderr, "cooperative launch failed: %s (grid %d)\n", hipGetErrorString(e), grid_blocks);
}
```
